# Optimizing an MI355X kernel written in HIP

```python
import math
import jax, jax.numpy as jnp
from jax import lax
import numpy as np

D_MODEL = 2048
BATCH = 4
SEQ = 4096
DEPTH = 1

N_META = 16
BLOCK = 128
PAD = BLOCK - N_META

ATT_WIDTH = D_MODEL // 2
ATT_HEAD_DIM = 64
ATT_Q_HEADS = ATT_WIDTH // ATT_HEAD_DIM
ATT_KV_HEADS = 2
ATT_GROUP = ATT_Q_HEADS // ATT_KV_HEADS
ATT_KV_WIDTH = ATT_KV_HEADS * ATT_HEAD_DIM
WINDOW = 128
ROPE_THETA = 10000.0

RET_WIDTH = D_MODEL - ATT_WIDTH
RET_HEAD_DIM = 256
RET_HEADS = RET_WIDTH // RET_HEAD_DIM

MIX_WIDTH = ATT_WIDTH + RET_WIDTH
SPLITS = [ATT_WIDTH,
          ATT_WIDTH + ATT_KV_WIDTH,
          ATT_WIDTH + 2 * ATT_KV_WIDTH,
          ATT_WIDTH + 2 * ATT_KV_WIDTH + RET_WIDTH,
          ATT_WIDTH + 2 * ATT_KV_WIDTH + 2 * RET_WIDTH,
          ATT_WIDTH + 2 * ATT_KV_WIDTH + 3 * RET_WIDTH]
IN_COLS = ATT_WIDTH + 2 * ATT_KV_WIDTH + 4 * RET_WIDTH

PEER_HEADS = 8
PEER_N_KEYS = 128
PEER_N_EXPERTS = PEER_N_KEYS * PEER_N_KEYS
PEER_D_KEY = 256
PEER_HALF = PEER_D_KEY // 2
PEER_TOPK = 16
PEER_TOKEN_BLOCK = 128

DEEPNORM_ALPHA = (2 * DEPTH) ** 0.25
DEEPNORM_BETA = (8 * DEPTH) ** -0.25
LN_EPS = 1e-5
GN_EPS = 1e-5
NEG = -1e30

kernel_name = "hymba_swa_sink_retnet_peer_deepnorm"


def layer_norm(x, g, b):
    xf = x.astype(jnp.float32)
    mu = jnp.mean(xf, axis=-1, keepdims=True)
    var = jnp.mean(jnp.square(xf - mu), axis=-1, keepdims=True)
    y = (xf - mu) * lax.rsqrt(var + LN_EPS) * g.astype(jnp.float32) + b.astype(jnp.float32)
    return y.astype(x.dtype)


def rope(t, pos):
    dh = t.shape[-1]
    inv = ROPE_THETA ** (-jnp.arange(0, dh, 2, dtype=jnp.float32) / dh)
    ang = pos.astype(jnp.float32)[:, None] * inv[None, :]
    cos = jnp.cos(ang)[None, :, None, :]
    sin = jnp.sin(ang)[None, :, None, :]
    tf = t.astype(jnp.float32)
    t1, t2 = tf[..., : dh // 2], tf[..., dh // 2:]
    return jnp.concatenate([t1 * cos - t2 * sin, t2 * cos + t1 * sin], axis=-1).astype(t.dtype)


def sliding_window_attention(q, k, v, sinks):
    B, Lp = q.shape[0], q.shape[1]
    nb = Lp // BLOCK
    qb = q.reshape(B, nb, BLOCK, ATT_KV_HEADS, ATT_GROUP, ATT_HEAD_DIM).astype(jnp.float32)

    def with_prev(t):
        tb = t.reshape(B, nb, BLOCK, ATT_KV_HEADS, ATT_HEAD_DIM).astype(jnp.float32)
        prev = jnp.concatenate([jnp.zeros_like(tb[:, :1]), tb[:, :-1]], axis=1)
        return jnp.concatenate([prev, tb], axis=2)

    kb, vb = with_prev(k), with_prev(v)
    scores = jnp.einsum('bnqhgd,bnkhd->bnhgqk', qb, kb) * (ATT_HEAD_DIM ** -0.5)
    blk = jnp.arange(nb)[:, None] * BLOCK
    qpos = blk + jnp.arange(BLOCK)[None, :]
    kpos = blk - BLOCK + jnp.arange(2 * BLOCK)[None, :]
    diff = qpos[:, :, None] - kpos[:, None, :]
    mask = (diff >= 0) & (diff < WINDOW) & (kpos[:, None, :] >= PAD)
    scores = jnp.where(mask[None, :, None, None], scores, NEG)
    sink = sinks.astype(jnp.float32).reshape(1, 1, ATT_KV_HEADS, ATT_GROUP, 1, 1)
    m = jnp.maximum(jnp.max(scores, axis=-1, keepdims=True), sink)
    p = jnp.exp(scores - m)
    denom = jnp.sum(p, axis=-1, keepdims=True) + jnp.exp(sink - m)
    p = p / denom
    out = jnp.einsum('bnhgqk,bnkhd->bnqhgd', p, vb)
    return out.reshape(B, Lp, ATT_Q_HEADS * ATT_HEAD_DIM).astype(q.dtype)


def chunkwise_retention(q, k, v):
    B, Lp = q.shape[0], q.shape[1]
    nb = Lp // BLOCK
    log_gamma = jnp.log(1.0 - 2.0 ** (-5.0 - jnp.arange(RET_HEADS, dtype=jnp.float32)))
    idx = jnp.arange(BLOCK, dtype=jnp.float32)
    rel = idx[:, None] - idx[None, :]
    inner_decay = jnp.where(rel[None] >= 0,
                            jnp.exp(jnp.maximum(rel, 0.0)[None] * log_gamma[:, None, None]), 0.0)
    q_decay = jnp.exp((idx[None, :] + 1.0) * log_gamma[:, None])[:, :, None]
    k_decay = jnp.exp((BLOCK - 1.0 - idx[None, :]) * log_gamma[:, None])[:, :, None]
    chunk_decay = jnp.exp(BLOCK * log_gamma)[:, None, None]

    def to_chunks(t):
        return t.astype(jnp.float32).reshape(B, nb, BLOCK, RET_HEADS, t.shape[-1]).transpose(1, 0, 3, 2, 4)

    qs, ks, vs = to_chunks(q), to_chunks(k * (RET_HEAD_DIM ** -0.5)), to_chunks(v)

    def step(state, inp):
        qc, kc, vc = inp
        att = jnp.einsum('bhid,bhjd->bhij', qc, kc) * inner_decay
        o = jnp.einsum('bhij,bhje->bhie', att, vc) + jnp.einsum('bhid,bhde->bhie', qc * q_decay, state)
        state = state * chunk_decay + jnp.einsum('bhjd,bhje->bhde', kc * k_decay, vc)
        return state, o

    state0 = jnp.zeros((B, RET_HEADS, RET_HEAD_DIM, v.shape[-1]), jnp.float32)
    _, o = lax.scan(step, state0, (qs, ks, vs))
    return o.transpose(1, 0, 3, 2, 4).reshape(B, Lp, RET_HEADS, v.shape[-1])


def hybrid_mixer(h, w_in, sinks, w_out, pos, key_valid):
    B, Lp, _ = h.shape
    proj = h @ w_in
    aq, ak, av, rq, rk, rv, rg = jnp.split(proj, SPLITS, axis=-1)
    aq = rope(aq.reshape(B, Lp, ATT_Q_HEADS, ATT_HEAD_DIM), pos)
    ak = rope(ak.reshape(B, Lp, ATT_KV_HEADS, ATT_HEAD_DIM), pos)
    av = av.reshape(B, Lp, ATT_KV_HEADS, ATT_HEAD_DIM)
    att_out = sliding_window_attention(aq, ak, av, sinks)
    rq = rope(rq.reshape(B, Lp, RET_HEADS, RET_HEAD_DIM), pos)
    rk = rope((rk * key_valid).reshape(B, Lp, RET_HEADS, RET_HEAD_DIM), pos)
    rv = rv.reshape(B, Lp, RET_HEADS, RET_HEAD_DIM)
    ret = chunkwise_retention(rq, rk, rv)
    mu = jnp.mean(ret, axis=-1, keepdims=True)
    var = jnp.mean(jnp.square(ret - mu), axis=-1, keepdims=True)
    ret = ((ret - mu) * lax.rsqrt(var + GN_EPS)).reshape(B, Lp, RET_WIDTH)
    ret_out = (jax.nn.silu(rg.astype(jnp.float32)) * ret).astype(h.dtype)
    mixed = jnp.concatenate([att_out, ret_out], axis=-1)
    return mixed @ w_out


def peer(h, wq, subkeys, u_tab, v_tab):
    B, Lp, D = h.shape
    T = B * Lp
    t = h.reshape(T, D)
    q = (t @ wq).reshape(T, PEER_HEADS, 2, PEER_HALF).astype(jnp.float32)
    s = jnp.einsum('thpc,hpnc->thpn', q, subkeys.astype(jnp.float32))
    sv, si = lax.top_k(s, PEER_TOPK)
    cand = (sv[:, :, 0, :, None] + sv[:, :, 1, None, :]).reshape(T, PEER_HEADS, PEER_TOPK * PEER_TOPK)
    fv, fi = lax.top_k(cand, PEER_TOPK)
    i1 = jnp.take_along_axis(si[:, :, 0], fi // PEER_TOPK, axis=-1)
    i2 = jnp.take_along_axis(si[:, :, 1], fi % PEER_TOPK, axis=-1)
    ids = (i1 * PEER_N_KEYS + i2).reshape(T, PEER_HEADS * PEER_TOPK)
    gates = jax.nn.softmax(fv, axis=-1).reshape(T, PEER_HEADS * PEER_TOPK)
    nblk = T // PEER_TOKEN_BLOCK

    def expert_block(args):
        tb, idb, gb = args
        u = jnp.take(u_tab, idb, axis=0)
        a = jax.nn.gelu(jnp.einsum('td,ted->te', tb, u).astype(jnp.float32), approximate=False)
        vv = jnp.take(v_tab, idb, axis=0)
        return jnp.einsum('te,ted->td', (gb * a).astype(vv.dtype), vv)

    out = lax.map(expert_block, (t.reshape(nblk, PEER_TOKEN_BLOCK, D),
                                 ids.reshape(nblk, PEER_TOKEN_BLOCK, -1),
                                 gates.reshape(nblk, PEER_TOKEN_BLOCK, -1)))
    return out.reshape(B, Lp, D).astype(h.dtype)


def setup_inputs(seed: int = 0) -> dict:
    key = jax.random.key(seed)
    ks = jax.random.split(key, 16)
    nrm = lambda k, shape: jax.random.normal(k, shape, jnp.float32)
    x = nrm(ks[0], (BATCH, SEQ, D_MODEL))
    meta_tokens = nrm(ks[1], (N_META, D_MODEL))
    ln_in_g = 1.0 + 0.02 * nrm(ks[2], (D_MODEL,))
    ln_in_b = 0.02 * nrm(ks[3], (D_MODEL,))
    beta = DEEPNORM_BETA
    col_scale = jnp.concatenate([
        jnp.ones((ATT_WIDTH + ATT_KV_WIDTH,), jnp.float32),
        jnp.full((ATT_KV_WIDTH,), beta, jnp.float32),
        jnp.ones((2 * RET_WIDTH,), jnp.float32),
        jnp.full((RET_WIDTH,), beta, jnp.float32),
        jnp.ones((RET_WIDTH,), jnp.float32)])
    w_in = nrm(ks[4], (DEPTH, D_MODEL, IN_COLS)) * (D_MODEL ** -0.5) * col_scale
    att_sinks = 0.5 * nrm(ks[5], (DEPTH, ATT_Q_HEADS))
    w_out = nrm(ks[6], (DEPTH, MIX_WIDTH, D_MODEL)) * (MIX_WIDTH ** -0.5) * beta
    ln_mix_g = 1.0 + 0.02 * nrm(ks[7], (DEPTH, D_MODEL))
    ln_mix_b = 0.02 * nrm(ks[8], (DEPTH, D_MODEL))
    peer_wq = nrm(ks[9], (DEPTH, D_MODEL, PEER_HEADS * PEER_D_KEY)) * (D_MODEL ** -0.5)
    peer_subkeys = nrm(ks[10], (DEPTH, PEER_HEADS, 2, PEER_N_KEYS, PEER_HALF)) * (PEER_HALF ** -0.5)
    peer_u = nrm(ks[11], (DEPTH, PEER_N_EXPERTS, D_MODEL)) * (D_MODEL ** -0.5)
    peer_v = nrm(ks[12], (DEPTH, PEER_N_EXPERTS, D_MODEL)) * beta
    ln_ffn_g = 1.0 + 0.02 * nrm(ks[13], (DEPTH, D_MODEL))
    ln_ffn_b = 0.02 * nrm(ks[14], (DEPTH, D_MODEL))
    return {"x": x, "meta_tokens": meta_tokens, "ln_in_g": ln_in_g, "ln_in_b": ln_in_b,
            "w_in": w_in, "att_sinks": att_sinks, "w_out": w_out,
            "ln_mix_g": ln_mix_g, "ln_mix_b": ln_mix_b,
            "peer_wq": peer_wq, "peer_subkeys": peer_subkeys, "peer_u": peer_u, "peer_v": peer_v,
            "ln_ffn_g": ln_ffn_g, "ln_ffn_b": ln_ffn_b}


def reference(x, meta_tokens, ln_in_g, ln_in_b, w_in, att_sinks, w_out, ln_mix_g, ln_mix_b,
              peer_wq, peer_subkeys, peer_u, peer_v, ln_ffn_g, ln_ffn_b):
    B = x.shape[0]
    pad = jnp.zeros((B, PAD, D_MODEL), x.dtype)
    meta = jnp.broadcast_to(meta_tokens.astype(x.dtype)[None], (B, N_META, D_MODEL))
    h = jnp.concatenate([pad, meta, x], axis=1)
    Lp = h.shape[1]
    slot = jnp.arange(Lp, dtype=jnp.int32)
    pos = slot - PAD
    key_valid = (slot >= PAD)[None, :, None].astype(x.dtype)
    h = layer_norm(h, ln_in_g, ln_in_b)
    for l in range(DEPTH):
        mix = hybrid_mixer(h, w_in[l], att_sinks[l], w_out[l], pos, key_valid)
        h = layer_norm(DEEPNORM_ALPHA * h + mix, ln_mix_g[l], ln_mix_b[l])
        ffn = peer(h, peer_wq[l], peer_subkeys[l], peer_u[l], peer_v[l])
        h = layer_norm(DEEPNORM_ALPHA * h + ffn, ln_ffn_g[l], ln_ffn_b[l])
    return h[:, BLOCK:]
```

```cpp
#include <hip/hip_runtime.h>
#include <cstdio>
#include <cstdint>
#include <cmath>
namespace pg8 {
#define PG8_LAS __attribute__((address_space(3)))
typedef unsigned short bf16_t;
typedef short bf16x8 __attribute__((ext_vector_type(8)));
typedef float f32x4 __attribute__((ext_vector_type(4)));
typedef unsigned u32x4 __attribute__((ext_vector_type(4)));
constexpr int BM = 256, BK = 64, HALF = 128, HTB = HALF * BK * 2  , STAGE_BYTES = 8 * HTB, NXCD = 8, WGM = 8;

__host__ __device__ __forceinline__ int lds_byte(int r, int c) { const int st = (r >> 4) * 2 + (c >> 5), rr = r & 15, cc = c & 31, ob = rr * 64 + cc * 2; return st * 1024 + (ob ^ (((ob >> 9) & 1) << 5)); }
__host__ __device__ __forceinline__ void stage_rc(int b, int& R, int& C) { const int st = b / 1024, sb = b % 1024, swz = sb ^ (((sb >> 9) & 1) << 5); R = (st >> 1) * 16 + swz / 64; C = (st & 1) * 32 + (swz % 64) / 2; }
__host__ __device__ __forceinline__ int perm32(int rho) { const int n = rho >> 4, i = rho & 15; return 8 * (i >> 2) + 4 * n + (i & 3); }

struct Unit { int pm, pn; };
struct Gemm { const bf16_t* A; const bf16_t* Bt; int M, N, K; };

struct StaticOrder {
    int nM, nN, nwg, G, c;
    __host__ __device__ void init(int M, int N, int G_, int c_) { nM = M / BM; nN = N / BM; nwg = nM * nN; G = G_; c = c_; }
    __host__ __device__ bool next(int i, Unit& u) const {
        const long L = (long)i * G + c; if (L >= nwg) return false;
        int wgid = (int)L; { const int q = nwg / NXCD, r = nwg % NXCD, xcd = wgid % NXCD, off = wgid / NXCD; wgid = (xcd < r ? xcd * (q + 1) : r * (q + 1) + (xcd - r) * q) + off; }
        const int nig = WGM * nN, gid = wgid / nig, fm = gid * WGM, gsz = (nM - fm) < WGM ? (nM - fm) : WGM;
        u.pm = fm + ((wgid % nig) % gsz); u.pn = (wgid % nig) / gsz; return true;
    }
    __device__ __forceinline__ void a_ready(const Unit&) const {}
    __device__ __forceinline__ void done(const Unit&) const {}
};

__device__ __forceinline__ unsigned cvt_pk_bf16(float lo, float hi) { unsigned r; asm volatile("v_cvt_pk_bf16_f32 %0, %1, %2" : "=v"(r) : "v"(lo), "v"(hi)); return r; }
typedef float f32x2 __attribute__((ext_vector_type(2)));

template <int MODE> struct EpiGen {
    static constexpr bool PERM = true, AFTER_DRAIN = false;
    bf16_t* O; int ldc; const bf16_t* R; float alpha;
    bf16_t *QR, *KA, *VA, *RK, *RV, *RG;
    __device__ __forceinline__ void operator()(const f32x4 (&acc)[2][2][4][2], const Unit& u, int wr, int wc, int fr, int fq) const {
        const int row0 = u.pm * BM + wr * 64 + fr;
#pragma unroll
        for (int bj = 0; bj < 2; ++bj) {
            const int col = u.pn * BM + bj * HALF + wc * 32 + 8 * fq;
            bf16_t* base = O; int ld = ldc; int cc = col;
            if (MODE == 0) {
                if (col < 1024)      { base = QR; ld = 2048; cc = col; }
                else if (col < 1152) { base = KA; ld = 128;  cc = col - 1024; }
                else if (col < 1280) { base = VA; ld = 128;  cc = col - 1152; }
                else if (col < 2304) { base = QR; ld = 2048; cc = col - 1280 + 1024; }
                else if (col < 3328) { base = RK; ld = 1024; cc = col - 2304; }
                else if (col < 4352) { base = RV; ld = 1024; cc = col - 3328; }
                else                 { base = RG; ld = 1024; cc = col - 4352; }
            }
#pragma unroll
            for (int ai = 0; ai < 2; ++ai)
#pragma unroll
                for (int m = 0; m < 4; ++m) {
                    const int row = row0 + ai * HALF + m * 16;
                    f32x4 v0 = acc[ai][bj][m][0], v1 = acc[ai][bj][m][1];
                    if (MODE == 1) {
                        const u32x4 r = *(const u32x4*)(R + (size_t)row * ldc + col);
                        v0[0] += alpha * __uint_as_float(r.x << 16); v0[1] += alpha * __uint_as_float(r.x & 0xffff0000u);
                        v0[2] += alpha * __uint_as_float(r.y << 16); v0[3] += alpha * __uint_as_float(r.y & 0xffff0000u);
                        v1[0] += alpha * __uint_as_float(r.z << 16); v1[1] += alpha * __uint_as_float(r.z & 0xffff0000u);
                        v1[2] += alpha * __uint_as_float(r.w << 16); v1[3] += alpha * __uint_as_float(r.w & 0xffff0000u);
                    }
                    u32x4 w; w.x = cvt_pk_bf16(v0[0], v0[1]); w.y = cvt_pk_bf16(v0[2], v0[3]); w.z = cvt_pk_bf16(v1[0], v1[1]); w.w = cvt_pk_bf16(v1[2], v1[3]);
                    *(u32x4*)(base + (size_t)row * ld + cc) = w;
                }
        }
    }
};
template <class Epi, class Sched, bool ALIGN_EPI = false, bool SP2 = false>
__device__ __forceinline__ void gemm_phase(PG8_LAS unsigned char* lds, const Gemm g, const Sched& S, const Epi& E) {
    const int tid = threadIdx.x, wid = __builtin_amdgcn_readfirstlane(tid >> 6), lane = tid & 63, wr = wid >> 2, wc = wid & 3, fr = lane & 15, fq = lane >> 4;
    const int K = g.K, nt = K / BK;
    unsigned voffA[2], voffB[2];
#pragma unroll
    for (int i = 0; i < 2; ++i) { int R, C; stage_rc(tid * 16 + i * 8192, R, C); const int Rb = Epi::PERM ? ((R & ~31) + perm32(R & 31)) : R;
        voffA[i] = (unsigned)(R * K + C) * 2u; voffB[i] = (unsigned)(Rb * K + C) * 2u; }
    const size_t kstep = (size_t)(BK * 2);
    const size_t hstep = (size_t)HALF * K * 2;
    const size_t tstep = 2 * hstep;
    const unsigned ldsw = (unsigned)wid * 1024u;
    const int aoff = lds_byte(wr * 64 + fr, fq * 8), boff = lds_byte(wc * 32 + fr, fq * 8);
#define PG8_SA(b, h) (((b) * 2 + (h)) * HTB)
#define PG8_SB(b, h) ((4 + (b) * 2 + (h)) * HTB)
#define PG8_STAGE(bufoff, gbase, voff) do { _Pragma("unroll") for (int _i = 0; _i < 2; ++_i) \
        __builtin_amdgcn_global_load_lds((const unsigned*)((const char*)(gbase) + (voff)[_i]), (PG8_LAS unsigned*)(lds + (bufoff) + ldsw + _i * 8192), 16, 0, 0); } while (0)
#define PG8_LDA(dst, b, h) do { _Pragma("unroll") for (int m = 0; m < 4; ++m) _Pragma("unroll") for (int k = 0; k < 2; ++k) dst[m][k] = *(const PG8_LAS bf16x8*)(lds + PG8_SA(b, h) + aoff + m * 2048 + k * 1024); } while (0)
#define PG8_LDB(dst, b, h) do { _Pragma("unroll") for (int n = 0; n < 2; ++n) _Pragma("unroll") for (int k = 0; k < 2; ++k) dst[n][k] = *(const PG8_LAS bf16x8*)(lds + PG8_SB(b, h) + boff + n * 2048 + k * 1024); } while (0)
#define PG8_MMA(ai, bj, At, Bt) do { __builtin_amdgcn_s_setprio(1); _Pragma("unroll") for (int m = 0; m < 4; ++m) _Pragma("unroll") for (int n = 0; n < 2; ++n) _Pragma("unroll") for (int k = 0; k < 2; ++k) \
        acc[ai][bj][m][n] = __builtin_amdgcn_mfma_f32_16x16x32_bf16(Bt[n][k], At[m][k], acc[ai][bj][m][n], 0, 0, 0); __builtin_amdgcn_s_setprio(0); } while (0)
#define PG8_WAIT_V(n) asm volatile("s_waitcnt vmcnt(" #n ")" ::: "memory")
#define PG8_WAIT_L(n) asm volatile("s_waitcnt lgkmcnt(" #n ")" ::: "memory")
#define PG8_BAR __builtin_amdgcn_s_barrier()
#define PG8_SCHED __builtin_amdgcn_sched_barrier(0)
    Unit cur, nxt; int ui = 0;
    if (!S.next(0, cur)) return;
    f32x4 acc[2][2][4][2];
#pragma unroll
    for (int a = 0; a < 2; ++a)
#pragma unroll
        for (int b = 0; b < 2; ++b)
#pragma unroll
            for (int m = 0; m < 4; ++m)
#pragma unroll
                for (int n = 0; n < 2; ++n) acc[a][b][m][n] = (f32x4){0.f, 0.f, 0.f, 0.f};
    bf16x8 At[4][2], B0[2][2], B1[2][2];
    const char* cA = (const char*)g.A + (size_t)cur.pm * tstep; const char* cB = (const char*)g.Bt + (size_t)cur.pn * tstep;
    S.a_ready(cur);
    if constexpr (SP2) {
        PG8_STAGE(PG8_SB(0, 0), cB, voffB); PG8_STAGE(PG8_SB(0, 1), cB + hstep, voffB); PG8_STAGE(PG8_SA(0, 0), cA, voffA); PG8_STAGE(PG8_SA(0, 1), cA + hstep, voffA);
        if (wr == 1) PG8_BAR;
        PG8_WAIT_V(2); PG8_BAR;
        PG8_STAGE(PG8_SB(1, 0), cB + kstep, voffB); PG8_STAGE(PG8_SA(1, 0), cA + kstep, voffA); PG8_STAGE(PG8_SB(1, 1), cB + hstep + kstep, voffB);
        PG8_WAIT_V(6); PG8_BAR;
    } else {
        PG8_STAGE(PG8_SB(0, 0), cB, voffB); PG8_STAGE(PG8_SA(0, 0), cA, voffA); PG8_STAGE(PG8_SB(0, 1), cB + hstep, voffB); PG8_STAGE(PG8_SA(0, 1), cA + hstep, voffA);
        if (wr == 1) PG8_BAR;
        PG8_WAIT_V(4); PG8_BAR;
        PG8_STAGE(PG8_SB(1, 0), cB + kstep, voffB); PG8_STAGE(PG8_SA(1, 0), cA + kstep, voffA); PG8_STAGE(PG8_SB(1, 1), cB + hstep + kstep, voffB);
        PG8_WAIT_V(6); PG8_BAR;
    }
    for (;;) {
        const bool has_next = S.next(ui + 1, nxt);
        const char* nA = has_next ? (const char*)g.A + (size_t)nxt.pm * tstep : cA; const char* nB = has_next ? (const char*)g.Bt + (size_t)nxt.pn * tstep : cB;
        for (int t = 0; t < nt; t += 2) {
            const bool last = (t == nt - 2);
            const char* a1 = cA + (size_t)(t + 1) * kstep;
            const char* a2 = last ? nA : cA + (size_t)(t + 2) * kstep; const char* b2 = last ? nB : cB + (size_t)(t + 2) * kstep;
            const char* a3 = a2 + kstep; const char* b3 = b2 + kstep;
            if (last && has_next) S.a_ready(nxt);
            if constexpr (SP2) {
            PG8_LDB(B0, 0, 0); PG8_LDB(B1, 0, 1); PG8_SCHED; PG8_LDA(At, 0, 0); PG8_STAGE(PG8_SA(1, 1), a1 + hstep, voffA);
            PG8_WAIT_V(8); PG8_WAIT_L(0); PG8_BAR; PG8_MMA(0, 0, At, B0); PG8_MMA(0, 1, At, B1); PG8_BAR; PG8_SCHED;
            PG8_LDA(At, 0, 1); PG8_STAGE(PG8_SB(0, 0), b2, voffB); PG8_STAGE(PG8_SB(0, 1), b2 + hstep, voffB); PG8_STAGE(PG8_SA(0, 0), a2, voffA);
            PG8_WAIT_V(8); PG8_WAIT_L(0); PG8_BAR; PG8_MMA(1, 0, At, B0); PG8_MMA(1, 1, At, B1); PG8_BAR; PG8_SCHED;
            PG8_LDB(B0, 1, 0); PG8_LDB(B1, 1, 1); PG8_SCHED; PG8_LDA(At, 1, 0); PG8_STAGE(PG8_SA(0, 1), a2 + hstep, voffA);
            PG8_WAIT_V(8); PG8_WAIT_L(0); PG8_BAR; PG8_MMA(0, 0, At, B0); PG8_MMA(0, 1, At, B1); PG8_BAR; PG8_SCHED;
            PG8_LDA(At, 1, 1); PG8_STAGE(PG8_SB(1, 0), b3, voffB); PG8_STAGE(PG8_SB(1, 1), b3 + hstep, voffB); PG8_STAGE(PG8_SA(1, 0), a3, voffA);
            PG8_WAIT_V(8); PG8_WAIT_L(0); PG8_BAR; PG8_MMA(1, 0, At, B0); PG8_MMA(1, 1, At, B1); PG8_BAR; PG8_SCHED;
            } else {
            PG8_LDB(B0, 0, 0); PG8_SCHED; PG8_LDA(At, 0, 0); PG8_STAGE(PG8_SA(1, 1), a1 + hstep, voffA);
            PG8_WAIT_L(8); PG8_BAR; PG8_WAIT_L(0); PG8_MMA(0, 0, At, B0); PG8_BAR; PG8_SCHED;
            PG8_LDB(B1, 0, 1); PG8_STAGE(PG8_SB(0, 0), b2, voffB);
            PG8_BAR; PG8_WAIT_L(0); PG8_MMA(0, 1, At, B1); PG8_BAR;
            PG8_LDA(At, 0, 1); PG8_STAGE(PG8_SA(0, 0), a2, voffA);
            PG8_BAR; PG8_WAIT_L(0); PG8_MMA(1, 0, At, B0); PG8_BAR; PG8_SCHED;
            PG8_STAGE(PG8_SB(0, 1), b2 + hstep, voffB);
            PG8_WAIT_V(6); PG8_BAR; PG8_MMA(1, 1, At, B1); PG8_BAR;
            PG8_LDB(B0, 1, 0); PG8_SCHED; PG8_LDA(At, 1, 0); PG8_STAGE(PG8_SA(0, 1), a2 + hstep, voffA);
            PG8_WAIT_L(8); PG8_BAR; PG8_WAIT_L(0); PG8_MMA(0, 0, At, B0); PG8_BAR; PG8_SCHED;
            PG8_LDB(B1, 1, 1); PG8_STAGE(PG8_SB(1, 0), b3, voffB);
            PG8_BAR; PG8_WAIT_L(0); PG8_MMA(0, 1, At, B1); PG8_BAR;
            PG8_LDA(At, 1, 1); PG8_STAGE(PG8_SA(1, 0), a3, voffA);
            PG8_BAR; PG8_WAIT_L(0); PG8_MMA(1, 0, At, B0); PG8_BAR; PG8_SCHED;
            PG8_STAGE(PG8_SB(1, 1), b3 + hstep, voffB);
            PG8_WAIT_V(6); PG8_BAR; PG8_MMA(1, 1, At, B1); PG8_BAR;
            }
        }
        if constexpr (ALIGN_EPI) { if (wr == 0) PG8_BAR; }
        if constexpr (!Epi::AFTER_DRAIN) { E(acc, cur, wr, wc, fr, fq); S.done(cur); }
        if (!has_next) break;
#pragma unroll
        for (int a = 0; a < 2; ++a)
#pragma unroll
            for (int b = 0; b < 2; ++b)
#pragma unroll
                for (int m = 0; m < 4; ++m)
#pragma unroll
                    for (int n = 0; n < 2; ++n) acc[a][b][m][n] = (f32x4){0.f, 0.f, 0.f, 0.f};
        cur = nxt; cA = nA; cB = nB; ++ui;
        if constexpr (ALIGN_EPI) { if (wr == 1) PG8_BAR; }
    }
    PG8_WAIT_V(0);
    if constexpr (!ALIGN_EPI) { if (wr == 0) PG8_BAR; }
    PG8_BAR;
    if constexpr (Epi::AFTER_DRAIN) { E.fused(acc, cur, wr, wc, fr, fq, lds, wid, lane); S.done(cur); }
#undef PG8_SA
#undef PG8_SB
#undef PG8_STAGE
#undef PG8_LDA
#undef PG8_LDB
#undef PG8_MMA
#undef PG8_WAIT_V
#undef PG8_WAIT_L
#undef PG8_BAR
#undef PG8_SCHED
}
}

constexpr int NWAVES = 8;
constexpr int DM = 2048, NB = 4, SEQ = 4096, NTOK = NB * SEQ;
constexpr int NMETA = 16, NVALID = NTOK + NMETA, MROWS = 16640;
constexpr int IN_COLS = 5376;
constexpr float LN_EPS = 1e-5f, GN_EPS = 1e-5f;
constexpr float ALPHA = 1.189207115002721f;
constexpr float LOG2E = 1.4426950408889634f;
constexpr float QSCALE = 0.125f * LOG2E;

constexpr size_t MiB = 1u << 20;
constexpr size_t WS_CTL = 0, CTL_ZERO_BYTES = 1 * MiB;
constexpr size_t SZ_SK = (size_t)16 * 128 * 128 * 2, SZ_ROPE_R = (size_t)4112 * 128 * 8, SZ_ROPE_A = (size_t)4112 * 32 * 8;
constexpr size_t SZ_W2T = (size_t)DM * DM * 2, SZ_W1T = (size_t)IN_COLS * DM * 2, SZ_TAB = (size_t)16384 * DM * 2;
constexpr size_t SZ_ROWS2K = (size_t)MROWS * 2048 * 2, SZ_ROWS1K = (size_t)MROWS * 1024 * 2, SZ_ROWS128 = (size_t)MROWS * 128 * 2;
constexpr size_t SZ_TOK2K = (size_t)NTOK * 2048 * 2, SZ_ST = (size_t)16 * 32 * 256 * 256 * 2, SZ_IDS = (size_t)NTOK * 128 * 4;
constexpr size_t al256(size_t x) { return (x + 255) & ~(size_t)255; }
constexpr size_t WS_SK = 1 * MiB;
constexpr size_t WS_ROPE_R = al256(WS_SK + SZ_SK);
constexpr size_t WS_ROPE_A = al256(WS_ROPE_R + SZ_ROPE_R);
constexpr size_t WS_W2T = al256(WS_ROPE_A + SZ_ROPE_A), WS_W3T = al256(WS_W2T + SZ_W2T), WS_W1T = al256(WS_W3T + SZ_W2T);
constexpr size_t WS_UT = al256(WS_W1T + SZ_W1T), WS_VT = al256(WS_UT + SZ_TAB);
constexpr size_t WS_H0 = al256(WS_VT + SZ_TAB);
constexpr size_t WS_QR = al256(WS_H0 + SZ_ROWS2K);
constexpr size_t WS_KA = al256(WS_QR + SZ_ROWS2K), WS_VA = al256(WS_KA + SZ_ROWS128);
constexpr size_t WS_RK = al256(WS_VA + SZ_ROWS128), WS_RV = al256(WS_RK + SZ_ROWS1K), WS_RG = al256(WS_RV + SZ_ROWS1K);
constexpr size_t WS_ST = al256(WS_RG + SZ_ROWS1K);
constexpr size_t WS_Y = WS_RK;
constexpr size_t WS_H1 = WS_ST;
constexpr size_t WS_IDS = al256(WS_ST + SZ_ST), WS_GATES = al256(WS_IDS + SZ_IDS);
constexpr size_t WS_END = al256(WS_GATES + SZ_IDS);
static_assert(WS_Y + SZ_TOK2K <= WS_RG, "Y overlays RK|RV only");
static_assert(SZ_TOK2K <= SZ_ST && (size_t)NTOK * 1024 * 4 <= SZ_ST, "H1 / RET_RAW fit the state region");
static_assert(WS_END <= (size_t)512 * MiB, "workspace map fits 4 x largest tensor");
constexpr int CW_TMO = 0, CW_BAR = 4096;

constexpr int RING_OFF = 0, RING_BYTES = 131072;
constexpr int LDSCTL_OFF = RING_BYTES, MISC_OFF = LDSCTL_OFF + 320;
constexpr int LDS_BYTES = 147456;

#define GAS __attribute__((address_space(1)))
#define LAS __attribute__((address_space(3)))
typedef unsigned short bf16;
typedef unsigned v4u __attribute__((ext_vector_type(4)));
typedef unsigned v2u __attribute__((ext_vector_type(2)));
typedef float f32x4 __attribute__((ext_vector_type(4)));
typedef float f32x2 __attribute__((ext_vector_type(2)));
typedef GAS unsigned gu32;
#define RLX_AGENT __ATOMIC_RELAXED, __HIP_MEMORY_SCOPE_AGENT
#define LDS_WAIT() asm volatile("s_waitcnt lgkmcnt(0)" ::: "memory")
#define VM_WAIT() asm volatile("s_waitcnt vmcnt(0)" ::: "memory")
__device__ __forceinline__ unsigned f2bf(float f) { unsigned u = __builtin_bit_cast(unsigned, f); return (u + 0x7fffu + ((u >> 16) & 1u)) >> 16; }
__device__ __forceinline__ unsigned pk2(float lo, float hi) { return f2bf(lo) | (f2bf(hi) << 16); }
__device__ __forceinline__ float bflo(unsigned w) { return __uint_as_float(w << 16); }
__device__ __forceinline__ float bfhi(unsigned w) { return __uint_as_float(w & 0xffff0000u); }
__device__ __forceinline__ float bf2f(bf16 h) { return __uint_as_float((unsigned)h << 16); }

#define XB_TMO      128
#define XB_XCNT(j)  (256  + 64 * (j))
#define XB_XSUB(j)  (1280 + 64 * (j))
#define XB_XGEN(j)  (2304 + 64 * (j))
#define XB_TOP      3328
#define XB_TOPGEN   3392
#define XCD_BAR_WORDS 3456
#define XB_SPIN_CAP (1u << 18)

__device__ __forceinline__ unsigned xb_ld(unsigned* p)              { return __hip_atomic_load(p, __ATOMIC_RELAXED, __HIP_MEMORY_SCOPE_AGENT); }
__device__ __forceinline__ unsigned xb_add(unsigned* p, unsigned v) { return __hip_atomic_fetch_add(p, v, __ATOMIC_RELAXED, __HIP_MEMORY_SCOPE_AGENT); }
__device__ __forceinline__ unsigned xb_xcc_id() { return (unsigned)__builtin_amdgcn_s_getreg((3 << 11) | 20) & 0xFu; }
#define XB_SPIN(cond, bar) do { unsigned _sp = 0; while (cond) { __builtin_amdgcn_s_sleep(1); \
    if ((++_sp & 255u) == 0u) { if (xb_ld(&(bar)[XB_TMO])) break; if (_sp > XB_SPIN_CAP) { atomicAdd(&(bar)[XB_TMO], 1u); break; } } } } while (0)

struct XcdBarrier {
    unsigned* bar; unsigned x;
    volatile LAS unsigned* st;
};

__device__ __forceinline__ XcdBarrier xcd_barrier_post(unsigned* bar, volatile LAS unsigned* st) {
    XcdBarrier b; b.bar = bar; b.x = xb_xcc_id(); b.st = st;
    if (threadIdx.x == 0) (void)xb_add(&bar[XB_XCNT(b.x)], 1u);
    return b;
}
__device__ __forceinline__ void xcd_barrier_complete(unsigned* bar, unsigned x, unsigned& nloc, unsigned& nx) {
    const unsigned G = gridDim.x * gridDim.y * gridDim.z;
    unsigned sum, cnt, mine, sp = 0u;
    for (;;) {
        sum = 0u; cnt = 0u; mine = 0u;
#pragma unroll
        for (unsigned j = 0; j < 16; ++j) { const unsigned c = xb_ld(&bar[XB_XCNT(j)]); sum += c; cnt += (c > 0u) ? 1u : 0u; mine = (j == x) ? c : mine; }
        if (sum == G) break;
        __builtin_amdgcn_s_sleep(1);
        if ((++sp & 255u) == 0u) { if (xb_ld(&bar[XB_TMO])) break; if (sp > XB_SPIN_CAP) { atomicAdd(&bar[XB_TMO], 1u); break; } }
    }
    nloc = mine > 0u ? mine : 1u; nx = cnt > 0u ? cnt : 1u;
}

__device__ __forceinline__ void xcd_barrier(const XcdBarrier& b) {
    asm volatile("s_waitcnt vmcnt(0)" ::: "memory");
    __syncthreads();
    if (threadIdx.x == 0) {
        unsigned* bar = b.bar;
        __builtin_amdgcn_s_waitcnt(0);
        unsigned nloc = b.st[0], nx = b.st[1];
        if (nloc == 0u) { xcd_barrier_complete(bar, b.x, nloc, nx); b.st[0] = nloc; b.st[1] = nx; }
        const unsigned old = xb_add(&bar[XB_XSUB(b.x)], 1u);
        const unsigned gen = old / nloc;
        if (old + 1u == (gen + 1u) * nloc) {
            __builtin_amdgcn_fence(__ATOMIC_RELEASE, "agent");
            asm volatile("s_waitcnt vmcnt(0)" ::: "memory");
            const unsigned og = xb_add(&bar[XB_TOP], 1u);
            const unsigned tg = og / nx;
            if (og + 1u == (tg + 1u) * nx) xb_add(&bar[XB_TOPGEN], 1u);
            else XB_SPIN(xb_ld(&bar[XB_TOPGEN]) == tg, bar);
            __builtin_amdgcn_fence(__ATOMIC_ACQUIRE, "agent");
            xb_add(&bar[XB_XGEN(b.x)], 1u);
            asm volatile("s_waitcnt vmcnt(0)" ::: "memory");
        } else {
            XB_SPIN(xb_ld(&bar[XB_XGEN(b.x)]) == gen, bar);
            __builtin_amdgcn_fence(__ATOMIC_ACQUIRE, "agent");
            asm volatile("s_waitcnt vmcnt(0)" ::: "memory");
        }
    }
    __syncthreads();
}


__device__ __forceinline__ float wave_sum(float v) {
#pragma unroll
    for (int o = 1; o < 64; o <<= 1) v += __shfl_xor(v, o);
    return v;
}
__device__ __forceinline__ float gelu_erf(float v) {
    const float av = fabsf(v), d = av * 0.2316418882f + 1.0f;
    const float t = __builtin_amdgcn_rcpf(d);
    float q = t * 0.5307027145f + (-0.7265760135f); q = q * t + 0.7107068705f; q = q * t + (-0.142248368f); q = q * t + 0.127414796f; q = q * t;
    const float e = __builtin_amdgcn_exp2f((v * v) * (-0.72134752044f));
    const float m = v * (q * e);
    return v < 0.f ? m : v - m;
}

struct Args { const float* in[15]; float* out; unsigned char* ws; };

__device__ __forceinline__ void p0_transpose_item(const float* W, int K, int N, bf16* WT, LAS float* scr, int item, int lane) {
    const int nblk = N / 32, kb = item / nblk, nb = item % nblk, k0 = 64 * kb, n0 = 32 * nb;
#pragma unroll 8
    for (int i = 0; i < 32; ++i) { const int kk = 2 * i + (lane >> 5); scr[kk * 33 + (lane & 31)] = W[(size_t)(k0 + kk) * N + n0 + (lane & 31)]; }
    LDS_WAIT(); asm volatile("" ::: "memory");
    const int c = lane & 7;
#pragma unroll
    for (int j = 0; j < 4; ++j) { const int n = (lane >> 3) + 8 * j; const LAS float* s = scr + (8 * c) * 33 + n;
        v4u o; o.x = pk2(s[0 * 33], s[1 * 33]); o.y = pk2(s[2 * 33], s[3 * 33]); o.z = pk2(s[4 * 33], s[5 * 33]); o.w = pk2(s[6 * 33], s[7 * 33]);
        *(GAS v4u*)(WT + (size_t)(n0 + n) * K + k0 + 8 * c) = o; }
    LDS_WAIT(); asm volatile("" ::: "memory");
}
__device__ __forceinline__ void ln_row_f32_to_bf16(const float* xrow, const float* g, const float* bta, bf16* orow, int lane) {
    const GAS f32x4* xr = (const GAS f32x4*)xrow + lane;
    f32x4 v[8]; float s = 0.f;
#pragma unroll
    for (int j = 0; j < 8; ++j) { v[j] = xr[64 * j]; s += (v[j].x + v[j].y) + (v[j].z + v[j].w); }
    const float mean = wave_sum(s) * (1.f / DM); float s2 = 0.f;
#pragma unroll
    for (int j = 0; j < 8; ++j) { v[j] = v[j] - mean; s2 += (v[j].x * v[j].x + v[j].y * v[j].y) + (v[j].z * v[j].z + v[j].w * v[j].w); }
    const float rstd = 1.f / sqrtf(wave_sum(s2) * (1.f / DM) + LN_EPS);
    GAS v2u* o8 = (GAS v2u*)orow + lane;
#pragma unroll
    for (int j = 0; j < 8; ++j) { const f32x4 gg = ((const GAS f32x4*)g)[lane + 64 * j], bb = ((const GAS f32x4*)bta)[lane + 64 * j];
        v2u o; o.x = pk2(v[j].x * rstd * gg.x + bb.x, v[j].y * rstd * gg.y + bb.y); o.y = pk2(v[j].z * rstd * gg.z + bb.z, v[j].w * rstd * gg.w + bb.w); o8[64 * j] = o; }
}
__device__ __forceinline__ void ln_row_bf16_to_bf16(const bf16* xrow, const float* g, const float* bta, bf16* orow, int lane) {
    const GAS v4u* xr = (const GAS v4u*)xrow + lane;
    float v[32]; float s = 0.f;
#pragma unroll
    for (int j = 0; j < 4; ++j) { const v4u w = xr[64 * j];
        v[8 * j + 0] = bflo(w.x); v[8 * j + 1] = bfhi(w.x); v[8 * j + 2] = bflo(w.y); v[8 * j + 3] = bfhi(w.y);
        v[8 * j + 4] = bflo(w.z); v[8 * j + 5] = bfhi(w.z); v[8 * j + 6] = bflo(w.w); v[8 * j + 7] = bfhi(w.w); }
#pragma unroll
    for (int i = 0; i < 32; ++i) s += v[i];
    const float mean = wave_sum(s) * (1.f / DM); float s2 = 0.f;
#pragma unroll
    for (int i = 0; i < 32; ++i) { v[i] -= mean; s2 += v[i] * v[i]; }
    const float rstd = 1.f / sqrtf(wave_sum(s2) * (1.f / DM) + LN_EPS);
    GAS v4u* o16 = (GAS v4u*)orow + lane;
#pragma unroll
    for (int j = 0; j < 4; ++j) {
        const GAS f32x4* gp = (const GAS f32x4*)g + 2 * (lane + 64 * j); const GAS f32x4* bp = (const GAS f32x4*)bta + 2 * (lane + 64 * j);
        const f32x4 g0 = gp[0], g1 = gp[1], b0 = bp[0], b1 = bp[1];
        v4u o; o.x = pk2(v[8 * j + 0] * rstd * g0.x + b0.x, v[8 * j + 1] * rstd * g0.y + b0.y); o.y = pk2(v[8 * j + 2] * rstd * g0.z + b0.z, v[8 * j + 3] * rstd * g0.w + b0.w);
        o.z = pk2(v[8 * j + 4] * rstd * g1.x + b1.x, v[8 * j + 5] * rstd * g1.y + b1.y); o.w = pk2(v[8 * j + 6] * rstd * g1.z + b1.z, v[8 * j + 7] * rstd * g1.w + b1.w);
        o16[64 * j] = o; }
}
__device__ __forceinline__ void row_pos(int r, int& pos, int& ipos) {
    if (r < NTOK) { const int s = r & (SEQ - 1); pos = NMETA + s; ipos = s & 127; }
    else { int j = r - NTOK; if (j > NMETA - 1) j = NMETA - 1; pos = j; ipos = 112 + j; }
}
__device__ __forceinline__ float log2_gamma(int h) { return log2f(1.0f - exp2f(-5.0f - (float)h)); }

__global__ void __launch_bounds__(NWAVES * 64, 2) mk_fwd(Args args) {
    extern __shared__ __attribute__((aligned(16))) unsigned char lds[];
    LAS unsigned char* L = (LAS unsigned char*)lds;
    volatile LAS unsigned* MISC = (volatile LAS unsigned*)(L + MISC_OFF);
    const int tid = threadIdx.x, lane = tid & 63, wave = __builtin_amdgcn_readfirstlane(tid >> 6);
    const int G = gridDim.x, bx = blockIdx.x;
    const int vcu = (G % 8 == 0) ? (bx % 8) * (G / 8) + bx / 8 : bx;
    unsigned char* ws = args.ws;
    gu32* ctl = (gu32*)(ws + WS_CTL);
    const float* x = args.in[0]; const float* meta = args.in[1]; const float* ln_in_g = args.in[2]; const float* ln_in_b = args.in[3];
    const float* w_in = args.in[4]; const float* sinks = args.in[5]; const float* w_out = args.in[6]; const float* ln_mix_g = args.in[7]; const float* ln_mix_b = args.in[8];
    const float* wq = args.in[9]; const float* subkeys = args.in[10]; const float* u_tab = args.in[11]; const float* v_tab = args.in[12];
    const float* ln_ffn_g = args.in[13]; const float* ln_ffn_b = args.in[14];
    float* out = args.out;
    bf16* W1T = (bf16*)(ws + WS_W1T); bf16* W2T = (bf16*)(ws + WS_W2T); bf16* W3T = (bf16*)(ws + WS_W3T);
    bf16* H0 = (bf16*)(ws + WS_H0); bf16* QR = (bf16*)(ws + WS_QR); bf16* KA = (bf16*)(ws + WS_KA); bf16* VA = (bf16*)(ws + WS_VA);
    bf16* RK = (bf16*)(ws + WS_RK); bf16* RV = (bf16*)(ws + WS_RV); bf16* RG = (bf16*)(ws + WS_RG);
    bf16* Y = (bf16*)(ws + WS_Y); bf16* H1 = (bf16*)(ws + WS_H1); bf16* Q3 = (bf16*)(ws + WS_QR);
    float* RET_RAW = (float*)(ws + WS_ST);
    f32x2* ROPE_R = (f32x2*)(ws + WS_ROPE_R); f32x2* ROPE_A = (f32x2*)(ws + WS_ROPE_A);
    int* IDS = (int*)(ws + WS_IDS); float* GATES = (float*)(ws + WS_GATES);

    for (int u = tid; u < (LDS_BYTES - LDSCTL_OFF) / 4; u += NWAVES * 64) ((LAS unsigned*)(L + LDSCTL_OFF))[u] = 0u;
    __syncthreads();
    XcdBarrier bar = xcd_barrier_post((unsigned*)(ctl + CW_BAR), MISC + 8);
#define GRID_BAR() xcd_barrier(bar)
    const int gw = vcu * NWAVES + wave, NGW = G * NWAVES;
    const int gt = gw * 64 + lane, NGT = NGW * 64;

    {
        LAS float* scr = (LAS float*)(L + RING_OFF + wave * 16384);
        constexpr int I_1 = (DM / 64) * (IN_COLS / 32), I_2 = (DM / 64) * (DM / 32), I_3 = I_2;
        for (int it = gw; it < I_1 + I_2 + I_3; it += NGW) {
            int r = it;
            if (r < I_1) { p0_transpose_item(w_in, DM, IN_COLS, W1T, scr, r, lane); continue; } r -= I_1;
            if (r < I_2) { p0_transpose_item(w_out, DM, DM, W2T, scr, r, lane); continue; } r -= I_2;
            p0_transpose_item(wq, DM, DM, W3T, scr, r, lane);
        }
        for (int m = gw; m < MROWS; m += NGW) {
            if (m < NTOK) ln_row_f32_to_bf16(x + (size_t)m * DM, ln_in_g, ln_in_b, H0 + (size_t)m * DM, lane);
            else if (m < NVALID) ln_row_f32_to_bf16(meta + (size_t)(m - NTOK) * DM, ln_in_g, ln_in_b, H0 + (size_t)m * DM, lane);
            else { GAS v4u* o = (GAS v4u*)(H0 + (size_t)m * DM) + lane;
#pragma unroll
                for (int j = 0; j < 4; ++j) o[64 * j] = (v4u){0u, 0u, 0u, 0u}; }
        }
        for (int e = gt; e < 4112 * 128; e += NGT) { const int pos = e >> 7, i = e & 127; const float inv = powf(10000.0f, -(float)(2 * i) / 256.0f); float sn, cs; sincosf((float)pos * inv, &sn, &cs); ROPE_R[e] = (f32x2){cs, sn}; }
        for (int e = gt; e < 4112 * 32; e += NGT) { const int pos = e >> 5, i = e & 31; const float inv = powf(10000.0f, -(float)(2 * i) / 64.0f); float sn, cs; sincosf((float)pos * inv, &sn, &cs); ROPE_A[e] = (f32x2){cs, sn}; }
    }
    GRID_BAR();

    {
        pg8::Gemm g{H0, W1T, MROWS, IN_COLS, DM}; pg8::StaticOrder S; S.init(MROWS, IN_COLS, G, bx);
        pg8::EpiGen<0> E{nullptr, 0, nullptr, 0.f, QR, KA, VA, RK, RV, RG};
        pg8::gemm_phase<pg8::EpiGen<0>, pg8::StaticOrder, true, true>(L + RING_OFF, g, S, E);
    }
    GRID_BAR();

    for (int r = gw; r < NVALID; r += NGW) {
        int pos, ipos; row_pos(r, pos, ipos);
        bf16* qr = QR + (size_t)r * 2048; bf16* ka = KA + (size_t)r * 128; bf16* rk = RK + (size_t)r * 1024; bf16* rg = RG + (size_t)r * 1024;
        for (int idx = lane; idx < 512; idx += 64) { const int a = idx >> 5, i = idx & 31; const f32x2 cs = ROPE_A[pos * 32 + i];
            const float x1 = bf2f(qr[64 * a + i]), x2 = bf2f(qr[64 * a + 32 + i]);
            qr[64 * a + i] = (bf16)f2bf((x1 * cs.x - x2 * cs.y) * QSCALE); qr[64 * a + 32 + i] = (bf16)f2bf((x2 * cs.x + x1 * cs.y) * QSCALE); }
        { const int a = lane >> 5, i = lane & 31; const f32x2 cs = ROPE_A[pos * 32 + i];
            const float x1 = bf2f(ka[64 * a + i]), x2 = bf2f(ka[64 * a + 32 + i]);
            ka[64 * a + i] = (bf16)f2bf(x1 * cs.x - x2 * cs.y); ka[64 * a + 32 + i] = (bf16)f2bf(x2 * cs.x + x1 * cs.y); }
        for (int idx = lane; idx < 512; idx += 64) { const int h = idx >> 7, i = idx & 127; const f32x2 cs = ROPE_R[pos * 128 + i];
            const float lg = log2_gamma(h); const float qs = exp2f((float)(ipos + 1) * lg), ks = 0.0625f * exp2f(-(float)(ipos + 1) * lg);
            { const float x1 = bf2f(qr[1024 + 256 * h + i]), x2 = bf2f(qr[1024 + 256 * h + 128 + i]);
              qr[1024 + 256 * h + i] = (bf16)f2bf((x1 * cs.x - x2 * cs.y) * qs); qr[1024 + 256 * h + 128 + i] = (bf16)f2bf((x2 * cs.x + x1 * cs.y) * qs); }
            { const float x1 = bf2f(rk[256 * h + i]), x2 = bf2f(rk[256 * h + 128 + i]);
              rk[256 * h + i] = (bf16)f2bf((x1 * cs.x - x2 * cs.y) * ks); rk[256 * h + 128 + i] = (bf16)f2bf((x2 * cs.x + x1 * cs.y) * ks); } }
        for (int idx = lane; idx < 1024; idx += 64) { const float v = bf2f(rg[idx]); rg[idx] = (bf16)f2bf(v / (1.0f + __expf(-v))); }
    }
    GRID_BAR();

    for (int id = gt; id < NTOK * 16; id += NGT) {
        const int r = id >> 4, hq = id & 15, g2 = hq >> 3; const int b = r >> 12, s = r & 4095;
        float q[64];
        { const v4u* qp = (const v4u*)(QR + (size_t)r * 2048 + hq * 64);
#pragma unroll
          for (int j = 0; j < 8; ++j) { const v4u w = qp[j]; q[8 * j + 0] = bflo(w.x); q[8 * j + 1] = bfhi(w.x); q[8 * j + 2] = bflo(w.y); q[8 * j + 3] = bfhi(w.y); q[8 * j + 4] = bflo(w.z); q[8 * j + 5] = bfhi(w.z); q[8 * j + 6] = bflo(w.w); q[8 * j + 7] = bfhi(w.w); } }
        float m = sinks[hq] * LOG2E, l = 1.0f; float o[64];
#pragma unroll
        for (int d = 0; d < 64; ++d) o[d] = 0.f;
        const int slot = 128 + s;
        for (int ks = slot - 127; ks <= slot; ++ks) {
            if (ks < 112) continue;
            const int krow = (ks >= 128) ? (b * SEQ + ks - 128) : (NTOK + ks - 112);
            const v4u* kp = (const v4u*)(KA + (size_t)krow * 128 + g2 * 64); const v4u* vp = (const v4u*)(VA + (size_t)krow * 128 + g2 * 64);
            float sc = 0.f;
#pragma unroll
            for (int j = 0; j < 8; ++j) { const v4u w = kp[j]; sc += q[8 * j + 0] * bflo(w.x) + q[8 * j + 1] * bfhi(w.x) + q[8 * j + 2] * bflo(w.y) + q[8 * j + 3] * bfhi(w.y) + q[8 * j + 4] * bflo(w.z) + q[8 * j + 5] * bfhi(w.z) + q[8 * j + 6] * bflo(w.w) + q[8 * j + 7] * bfhi(w.w); }
            const float mn = fmaxf(m, sc); const float f = exp2f(m - mn), p = exp2f(sc - mn); m = mn; l = l * f + p;
#pragma unroll
            for (int j = 0; j < 8; ++j) { const v4u w = vp[j];
                o[8 * j + 0] = o[8 * j + 0] * f + p * bflo(w.x); o[8 * j + 1] = o[8 * j + 1] * f + p * bfhi(w.x); o[8 * j + 2] = o[8 * j + 2] * f + p * bflo(w.y); o[8 * j + 3] = o[8 * j + 3] * f + p * bfhi(w.y);
                o[8 * j + 4] = o[8 * j + 4] * f + p * bflo(w.z); o[8 * j + 5] = o[8 * j + 5] * f + p * bfhi(w.z); o[8 * j + 6] = o[8 * j + 6] * f + p * bflo(w.w); o[8 * j + 7] = o[8 * j + 7] * f + p * bfhi(w.w); }
        }
        const float il = 1.0f / l;
        v4u* op = (v4u*)(QR + (size_t)r * 2048 + hq * 64);
#pragma unroll
        for (int j = 0; j < 8; ++j) { v4u w; w.x = pk2(o[8 * j + 0] * il, o[8 * j + 1] * il); w.y = pk2(o[8 * j + 2] * il, o[8 * j + 3] * il); w.z = pk2(o[8 * j + 4] * il, o[8 * j + 5] * il); w.w = pk2(o[8 * j + 6] * il, o[8 * j + 7] * il); op[j] = w; }
    }

    for (int u = bx; u < 256; u += G) {
        const int b = u >> 6, h = (u >> 4) & 3, e0 = (u & 15) * 16;
        const int e = tid & 15, dg = tid >> 4, d0 = dg * 8;
        const float g128 = exp2f(128.0f * log2_gamma(h));
        LAS float* part = (LAS float*)(L + RING_OFF);
        float st[8];
#pragma unroll
        for (int i = 0; i < 8; ++i) st[i] = 0.f;
        for (int n = 0; n < NMETA + SEQ; ++n) {
            const int row = (n < NMETA) ? (NTOK + n) : (b * SEQ + n - NMETA);
            if (n >= NMETA && ((n - NMETA) & 127) == 0) {
#pragma unroll
                for (int i = 0; i < 8; ++i) st[i] *= g128; }
            const v4u kw = *(const v4u*)(RK + (size_t)row * 1024 + 256 * h + d0);
            const v4u qw = *(const v4u*)(QR + (size_t)row * 2048 + 1024 + 256 * h + d0);
            const float vv = bf2f(RV[(size_t)row * 1024 + 256 * h + e0 + e]);
            st[0] += bflo(kw.x) * vv; st[1] += bfhi(kw.x) * vv; st[2] += bflo(kw.y) * vv; st[3] += bfhi(kw.y) * vv;
            st[4] += bflo(kw.z) * vv; st[5] += bfhi(kw.z) * vv; st[6] += bflo(kw.w) * vv; st[7] += bfhi(kw.w) * vv;
            float p = bflo(qw.x) * st[0] + bfhi(qw.x) * st[1] + bflo(qw.y) * st[2] + bfhi(qw.y) * st[3] + bflo(qw.z) * st[4] + bfhi(qw.z) * st[5] + bflo(qw.w) * st[6] + bfhi(qw.w) * st[7];
            p += __shfl_xor(p, 16); p += __shfl_xor(p, 32);
            LAS float* pb = part + (n & 1) * 128;
            if (lane < 16) pb[wave * 16 + lane] = p;
            __syncthreads();
            if (tid < 16 && n >= NMETA) { float sacc = 0.f;
#pragma unroll
                for (int w = 0; w < 8; ++w) sacc += pb[w * 16 + tid];
                RET_RAW[(size_t)row * 1024 + 256 * h + e0 + tid] = sacc; }
        }
        __syncthreads();
    }
    GRID_BAR();

    for (int id = gt; id < NTOK * 4; id += NGT) {
        const int r = id >> 2, h = id & 3;
        const float* rr = RET_RAW + (size_t)r * 1024 + 256 * h;
        float s = 0.f; for (int e = 0; e < 256; ++e) s += rr[e];
        const float mu = s * (1.f / 256.f); float s2 = 0.f; for (int e = 0; e < 256; ++e) { const float d = rr[e] - mu; s2 += d * d; }
        const float rstd = 1.0f / sqrtf(s2 * (1.f / 256.f) + GN_EPS);
        const bf16* gp = RG + (size_t)r * 1024 + 256 * h; bf16* op = QR + (size_t)r * 2048 + 1024 + 256 * h;
        for (int e = 0; e < 256; ++e) op[e] = (bf16)f2bf((rr[e] - mu) * rstd * bf2f(gp[e]));
    }
    GRID_BAR();

    {
        pg8::Gemm g{QR, W2T, NTOK, DM, DM}; pg8::StaticOrder S; S.init(NTOK, DM, G, bx);
        pg8::EpiGen<1> E{Y, DM, H0, ALPHA, nullptr, nullptr, nullptr, nullptr, nullptr, nullptr};
        pg8::gemm_phase<pg8::EpiGen<1>, pg8::StaticOrder, true, true>(L + RING_OFF, g, S, E);
    }
    GRID_BAR();

    for (int m = gw; m < NTOK; m += NGW) ln_row_bf16_to_bf16(Y + (size_t)m * DM, ln_mix_g, ln_mix_b, H1 + (size_t)m * DM, lane);
    GRID_BAR();

    {
        pg8::Gemm g{H1, W3T, NTOK, DM, DM}; pg8::StaticOrder S; S.init(NTOK, DM, G, bx);
        pg8::EpiGen<2> E{Q3, DM, nullptr, 0.f, nullptr, nullptr, nullptr, nullptr, nullptr, nullptr};
        pg8::gemm_phase<pg8::EpiGen<2>, pg8::StaticOrder, true, true>(L + RING_OFF, g, S, E);
    }
    GRID_BAR();

    for (int id = gt; id < NTOK * 8; id += NGT) {
        const int tok = id >> 3, hd = id & 7;
        float sv[2][16]; int si[2][16];
#pragma unroll
        for (int p = 0; p < 2; ++p) {
            float q[128];
            { const v4u* qp = (const v4u*)(Q3 + (size_t)tok * DM + hd * 256 + p * 128);
#pragma unroll
              for (int j = 0; j < 16; ++j) { const v4u w = qp[j]; q[8 * j + 0] = bflo(w.x); q[8 * j + 1] = bfhi(w.x); q[8 * j + 2] = bflo(w.y); q[8 * j + 3] = bfhi(w.y); q[8 * j + 4] = bflo(w.z); q[8 * j + 5] = bfhi(w.z); q[8 * j + 6] = bflo(w.w); q[8 * j + 7] = bfhi(w.w); } }
            float tv[16]; int ti[16];
#pragma unroll
            for (int j = 0; j < 16; ++j) { tv[j] = -3.0e38f; ti[j] = 0; }
            for (int n = 0; n < 128; ++n) {
                const f32x4* sk = (const f32x4*)(subkeys + ((size_t)((hd * 2 + p) * 128 + n)) * 128);
                float sc = 0.f;
#pragma unroll
                for (int c = 0; c < 32; ++c) { const f32x4 w = sk[c]; sc += q[4 * c] * w.x + q[4 * c + 1] * w.y + q[4 * c + 2] * w.z + q[4 * c + 3] * w.w; }
                float v = sc; int vi = n;
#pragma unroll
                for (int j = 0; j < 16; ++j) { const bool gtb = v > tv[j]; const float nv = gtb ? tv[j] : v; const int ni = gtb ? ti[j] : vi; tv[j] = gtb ? v : tv[j]; ti[j] = gtb ? vi : ti[j]; v = nv; vi = ni; }
            }
#pragma unroll
            for (int j = 0; j < 16; ++j) { sv[p][j] = tv[j]; si[p][j] = ti[j]; }
        }
        float fv[16]; int fi[16];
#pragma unroll
        for (int j = 0; j < 16; ++j) { fv[j] = -3.0e38f; fi[j] = 0; }
#pragma unroll
        for (int i = 0; i < 16; ++i)
#pragma unroll
            for (int j = 0; j < 16; ++j) if ((i + 1) * (j + 1) <= 16) {
                float v = sv[0][i] + sv[1][j]; int vi = si[0][i] * 128 + si[1][j];
#pragma unroll
                for (int k = 0; k < 16; ++k) { const bool gtb = v > fv[k]; const float nv = gtb ? fv[k] : v; const int ni = gtb ? fi[k] : vi; fv[k] = gtb ? v : fv[k]; fi[k] = gtb ? vi : fi[k]; v = nv; vi = ni; }
            }
        float den = 0.f; float ev[16];
#pragma unroll
        for (int k = 0; k < 16; ++k) { ev[k] = __expf(fv[k] - fv[0]); den += ev[k]; }
        const float iden = 1.0f / den;
#pragma unroll
        for (int k = 0; k < 16; ++k) { IDS[(size_t)tok * 128 + hd * 16 + k] = fi[k]; GATES[(size_t)tok * 128 + hd * 16 + k] = ev[k] * iden; }
    }
    GRID_BAR();

    for (int tok = gw; tok < NTOK; tok += NGW) {
        float hv[32], ov[32];
        { const v2u* hp = (const v2u*)(H1 + (size_t)tok * DM) + lane;
#pragma unroll
          for (int i = 0; i < 8; ++i) { const v2u w = hp[64 * i]; hv[4 * i] = bflo(w.x); hv[4 * i + 1] = bfhi(w.x); hv[4 * i + 2] = bflo(w.y); hv[4 * i + 3] = bfhi(w.y); } }
#pragma unroll
        for (int i = 0; i < 32; ++i) ov[i] = 0.f;
        for (int e = 0; e < 128; ++e) {
            const int eid = __builtin_amdgcn_readfirstlane(IDS[(size_t)tok * 128 + e]); const float gte = GATES[(size_t)tok * 128 + e];
            const f32x4* up = (const f32x4*)(u_tab + (size_t)eid * DM) + lane; const f32x4* vp = (const f32x4*)(v_tab + (size_t)eid * DM) + lane;
            float dot = 0.f;
#pragma unroll
            for (int i = 0; i < 8; ++i) { const f32x4 w = up[64 * i]; dot += hv[4 * i] * w.x + hv[4 * i + 1] * w.y + hv[4 * i + 2] * w.z + hv[4 * i + 3] * w.w; }
            dot = wave_sum(dot);
            const float c = gte * gelu_erf(dot);
#pragma unroll
            for (int i = 0; i < 8; ++i) { const f32x4 w = vp[64 * i]; ov[4 * i] += c * w.x; ov[4 * i + 1] += c * w.y; ov[4 * i + 2] += c * w.z; ov[4 * i + 3] += c * w.w; }
        }
        float s = 0.f;
#pragma unroll
        for (int i = 0; i < 32; ++i) { ov[i] += ALPHA * hv[i]; s += ov[i]; }
        const float mean = wave_sum(s) * (1.f / DM); float s2 = 0.f;
#pragma unroll
        for (int i = 0; i < 32; ++i) { ov[i] -= mean; s2 += ov[i] * ov[i]; }
        const float rstd = 1.0f / sqrtf(wave_sum(s2) * (1.f / DM) + LN_EPS);
        f32x4* op = (f32x4*)(out + (size_t)tok * DM) + lane;
#pragma unroll
        for (int i = 0; i < 8; ++i) { const f32x4 gg = ((const f32x4*)ln_ffn_g)[lane + 64 * i], bb = ((const f32x4*)ln_ffn_b)[lane + 64 * i];
            op[64 * i] = (f32x4){ov[4 * i] * rstd * gg.x + bb.x, ov[4 * i + 1] * rstd * gg.y + bb.y, ov[4 * i + 2] * rstd * gg.z + bb.z, ov[4 * i + 3] * rstd * gg.w + bb.w}; }
    }
}

extern "C" void kernel_launch(void* const* d_in, const int* in_sizes, int n_in, void* d_out, int out_size, void* d_ws, size_t ws_size, hipStream_t stream) {
    static int grid = 0;
    if (grid == 0) {
        if (n_in != 15 || out_size != NTOK * DM || ws_size < WS_END) { fprintf(stderr, "kernel_launch: unexpected shapes (n_in %d out %d ws %zu)\n", n_in, out_size, ws_size); grid = -1; return; }
        int dev = 0, cus = 0, per_cu = 0;
        if (hipGetDevice(&dev) != hipSuccess || hipDeviceGetAttribute(&cus, hipDeviceAttributeMultiprocessorCount, dev) != hipSuccess) { grid = -1; return; }
        if (hipFuncSetAttribute((const void*)mk_fwd, hipFuncAttributeMaxDynamicSharedMemorySize, LDS_BYTES) != hipSuccess) { fprintf(stderr, "kernel_launch: hipFuncSetAttribute failed\n"); grid = -1; return; }
        if (hipOccupancyMaxActiveBlocksPerMultiprocessor(&per_cu, (const void*)mk_fwd, NWAVES * 64, LDS_BYTES) != hipSuccess || per_cu < 1) { fprintf(stderr, "kernel_launch: occupancy query says %d\n", per_cu); }
        (void)hipGetLastError();
        grid = cus;
    }
    if (grid < 0) return;
    if (hipMemsetAsync((char*)d_ws + WS_CTL, 0, CTL_ZERO_BYTES, stream) != hipSuccess) return;
    Args a{};
    for (int i = 0; i < 15; ++i) a.in[i] = (const float*)d_in[i];
    a.out = (float*)d_out; a.ws = (unsigned char*)d_ws;
    hipLaunchKernelGGL(mk_fwd, dim3(grid), dim3(NWAVES * 64), LDS_BYTES, stream, a);
}
```

```cpp
#include <hip/hip_runtime.h>
#include <cstdio>
#include <cstdint>
#include <cmath>
namespace pg8 {
#define PG8_LAS __attribute__((address_space(3)))
typedef unsigned short bf16_t;
typedef short bf16x8 __attribute__((ext_vector_type(8)));
typedef float f32x4 __attribute__((ext_vector_type(4)));
typedef unsigned u32x4 __attribute__((ext_vector_type(4)));
constexpr int BM = 256, BK = 64, HALF = 128, HTB = HALF * BK * 2  , STAGE_BYTES = 8 * HTB, NXCD = 8, WGM = 8;

__host__ __device__ __forceinline__ int lds_byte(int r, int c) { const int st = (r >> 4) * 2 + (c >> 5), rr = r & 15, cc = c & 31, ob = rr * 64 + cc * 2; return st * 1024 + (ob ^ (((ob >> 9) & 1) << 5)); }
__host__ __device__ __forceinline__ void stage_rc(int b, int& R, int& C) { const int st = b / 1024, sb = b % 1024, swz = sb ^ (((sb >> 9) & 1) << 5); R = (st >> 1) * 16 + swz / 64; C = (st & 1) * 32 + (swz % 64) / 2; }
__host__ __device__ __forceinline__ int perm32(int rho) { const int n = rho >> 4, i = rho & 15; return 8 * (i >> 2) + 4 * n + (i & 3); }

struct Unit { int pm, pn; };
struct Gemm { const bf16_t* A; const bf16_t* Bt; int M, N, K; };

struct StaticOrder {
    int nM, nN, nwg, G, c;
    __host__ __device__ void init(int M, int N, int G_, int c_) { nM = M / BM; nN = N / BM; nwg = nM * nN; G = G_; c = c_; }
    __host__ __device__ bool next(int i, Unit& u) const {
        const long L = (long)i * G + c; if (L >= nwg) return false;
        int wgid = (int)L; { const int q = nwg / NXCD, r = nwg % NXCD, xcd = wgid % NXCD, off = wgid / NXCD; wgid = (xcd < r ? xcd * (q + 1) : r * (q + 1) + (xcd - r) * q) + off; }
        const int nig = WGM * nN, gid = wgid / nig, fm = gid * WGM, gsz = (nM - fm) < WGM ? (nM - fm) : WGM;
        u.pm = fm + ((wgid % nig) % gsz); u.pn = (wgid % nig) / gsz; return true;
    }
    __device__ __forceinline__ void a_ready(const Unit&) const {}
    __device__ __forceinline__ void done(const Unit&) const {}
};

__device__ __forceinline__ unsigned cvt_pk_bf16(float lo, float hi) { unsigned r; asm volatile("v_cvt_pk_bf16_f32 %0, %1, %2" : "=v"(r) : "v"(lo), "v"(hi)); return r; }
typedef float f32x2 __attribute__((ext_vector_type(2)));

template <int MODE> struct EpiGen {
    static constexpr bool PERM = true, AFTER_DRAIN = false;
    bf16_t* O; int ldc; const bf16_t* R; float alpha;
    bf16_t *QR, *KA, *VA, *RK, *RV, *RG;
    __device__ __forceinline__ void operator()(const f32x4 (&acc)[2][2][4][2], const Unit& u, int wr, int wc, int fr, int fq) const {
        const int row0 = u.pm * BM + wr * 64 + fr;
#pragma unroll
        for (int bj = 0; bj < 2; ++bj) {
            const int col = u.pn * BM + bj * HALF + wc * 32 + 8 * fq;
            bf16_t* base = O; int ld = ldc; int cc = col;
            if (MODE == 0) {
                if (col < 1024)      { base = QR; ld = 2048; cc = col; }
                else if (col < 1152) { base = KA; ld = 128;  cc = col - 1024; }
                else if (col < 1280) { base = VA; ld = 128;  cc = col - 1152; }
                else if (col < 2304) { base = QR; ld = 2048; cc = col - 1280 + 1024; }
                else if (col < 3328) { base = RK; ld = 1024; cc = col - 2304; }
                else if (col < 4352) { base = RV; ld = 1024; cc = col - 3328; }
                else                 { base = RG; ld = 1024; cc = col - 4352; }
            }
#pragma unroll
            for (int ai = 0; ai < 2; ++ai)
#pragma unroll
                for (int m = 0; m < 4; ++m) {
                    const int row = row0 + ai * HALF + m * 16;
                    f32x4 v0 = acc[ai][bj][m][0], v1 = acc[ai][bj][m][1];
                    if (MODE == 1) {
                        const u32x4 r = *(const u32x4*)(R + (size_t)row * ldc + col);
                        v0[0] += alpha * __uint_as_float(r.x << 16); v0[1] += alpha * __uint_as_float(r.x & 0xffff0000u);
                        v0[2] += alpha * __uint_as_float(r.y << 16); v0[3] += alpha * __uint_as_float(r.y & 0xffff0000u);
                        v1[0] += alpha * __uint_as_float(r.z << 16); v1[1] += alpha * __uint_as_float(r.z & 0xffff0000u);
                        v1[2] += alpha * __uint_as_float(r.w << 16); v1[3] += alpha * __uint_as_float(r.w & 0xffff0000u);
                    }
                    u32x4 w; w.x = cvt_pk_bf16(v0[0], v0[1]); w.y = cvt_pk_bf16(v0[2], v0[3]); w.z = cvt_pk_bf16(v1[0], v1[1]); w.w = cvt_pk_bf16(v1[2], v1[3]);
                    *(u32x4*)(base + (size_t)row * ld + cc) = w;
                }
        }
    }
};
template <class Epi, class Sched, bool ALIGN_EPI = false, bool SP2 = false>
__device__ __forceinline__ void gemm_phase(PG8_LAS unsigned char* lds, const Gemm g, const Sched& S, const Epi& E) {
    const int tid = threadIdx.x, wid = __builtin_amdgcn_readfirstlane(tid >> 6), lane = tid & 63, wr = wid >> 2, wc = wid & 3, fr = lane & 15, fq = lane >> 4;
    const int K = g.K, nt = K / BK;
    unsigned voffA[2], voffB[2];
#pragma unroll
    for (int i = 0; i < 2; ++i) { int R, C; stage_rc(tid * 16 + i * 8192, R, C); const int Rb = Epi::PERM ? ((R & ~31) + perm32(R & 31)) : R;
        voffA[i] = (unsigned)(R * K + C) * 2u; voffB[i] = (unsigned)(Rb * K + C) * 2u; }
    const size_t kstep = (size_t)(BK * 2);
    const size_t hstep = (size_t)HALF * K * 2;
    const size_t tstep = 2 * hstep;
    const unsigned ldsw = (unsigned)wid * 1024u;
    const int aoff = lds_byte(wr * 64 + fr, fq * 8), boff = lds_byte(wc * 32 + fr, fq * 8);
#define PG8_SA(b, h) (((b) * 2 + (h)) * HTB)
#define PG8_SB(b, h) ((4 + (b) * 2 + (h)) * HTB)
#define PG8_STAGE(bufoff, gbase, voff) do { _Pragma("unroll") for (int _i = 0; _i < 2; ++_i) \
        __builtin_amdgcn_global_load_lds((const unsigned*)((const char*)(gbase) + (voff)[_i]), (PG8_LAS unsigned*)(lds + (bufoff) + ldsw + _i * 8192), 16, 0, 0); } while (0)
#define PG8_LDA(dst, b, h) do { _Pragma("unroll") for (int m = 0; m < 4; ++m) _Pragma("unroll") for (int k = 0; k < 2; ++k) dst[m][k] = *(const PG8_LAS bf16x8*)(lds + PG8_SA(b, h) + aoff + m * 2048 + k * 1024); } while (0)
#define PG8_LDB(dst, b, h) do { _Pragma("unroll") for (int n = 0; n < 2; ++n) _Pragma("unroll") for (int k = 0; k < 2; ++k) dst[n][k] = *(const PG8_LAS bf16x8*)(lds + PG8_SB(b, h) + boff + n * 2048 + k * 1024); } while (0)
#define PG8_MMA(ai, bj, At, Bt) do { __builtin_amdgcn_s_setprio(1); _Pragma("unroll") for (int m = 0; m < 4; ++m) _Pragma("unroll") for (int n = 0; n < 2; ++n) _Pragma("unroll") for (int k = 0; k < 2; ++k) \
        acc[ai][bj][m][n] = __builtin_amdgcn_mfma_f32_16x16x32_bf16(Bt[n][k], At[m][k], acc[ai][bj][m][n], 0, 0, 0); __builtin_amdgcn_s_setprio(0); } while (0)
#define PG8_WAIT_V(n) asm volatile("s_waitcnt vmcnt(" #n ")" ::: "memory")
#define PG8_WAIT_L(n) asm volatile("s_waitcnt lgkmcnt(" #n ")" ::: "memory")
#define PG8_BAR __builtin_amdgcn_s_barrier()
#define PG8_SCHED __builtin_amdgcn_sched_barrier(0)
    Unit cur, nxt; int ui = 0;
    if (!S.next(0, cur)) return;
    f32x4 acc[2][2][4][2];
#pragma unroll
    for (int a = 0; a < 2; ++a)
#pragma unroll
        for (int b = 0; b < 2; ++b)
#pragma unroll
            for (int m = 0; m < 4; ++m)
#pragma unroll
                for (int n = 0; n < 2; ++n) acc[a][b][m][n] = (f32x4){0.f, 0.f, 0.f, 0.f};
    bf16x8 At[4][2], B0[2][2], B1[2][2];
    const char* cA = (const char*)g.A + (size_t)cur.pm * tstep; const char* cB = (const char*)g.Bt + (size_t)cur.pn * tstep;
    S.a_ready(cur);
    if constexpr (SP2) {
        PG8_STAGE(PG8_SB(0, 0), cB, voffB); PG8_STAGE(PG8_SB(0, 1), cB + hstep, voffB); PG8_STAGE(PG8_SA(0, 0), cA, voffA); PG8_STAGE(PG8_SA(0, 1), cA + hstep, voffA);
        if (wr == 1) PG8_BAR;
        PG8_WAIT_V(2); PG8_BAR;
        PG8_STAGE(PG8_SB(1, 0), cB + kstep, voffB); PG8_STAGE(PG8_SA(1, 0), cA + kstep, voffA); PG8_STAGE(PG8_SB(1, 1), cB + hstep + kstep, voffB);
        PG8_WAIT_V(6); PG8_BAR;
    } else {
        PG8_STAGE(PG8_SB(0, 0), cB, voffB); PG8_STAGE(PG8_SA(0, 0), cA, voffA); PG8_STAGE(PG8_SB(0, 1), cB + hstep, voffB); PG8_STAGE(PG8_SA(0, 1), cA + hstep, voffA);
        if (wr == 1) PG8_BAR;
        PG8_WAIT_V(4); PG8_BAR;
        PG8_STAGE(PG8_SB(1, 0), cB + kstep, voffB); PG8_STAGE(PG8_SA(1, 0), cA + kstep, voffA); PG8_STAGE(PG8_SB(1, 1), cB + hstep + kstep, voffB);
        PG8_WAIT_V(6); PG8_BAR;
    }
    for (;;) {
        const bool has_next = S.next(ui + 1, nxt);
        const char* nA = has_next ? (const char*)g.A + (size_t)nxt.pm * tstep : cA; const char* nB = has_next ? (const char*)g.Bt + (size_t)nxt.pn * tstep : cB;
        for (int t = 0; t < nt; t += 2) {
            const bool last = (t == nt - 2);
            const char* a1 = cA + (size_t)(t + 1) * kstep;
            const char* a2 = last ? nA : cA + (size_t)(t + 2) * kstep; const char* b2 = last ? nB : cB + (size_t)(t + 2) * kstep;
            const char* a3 = a2 + kstep; const char* b3 = b2 + kstep;
            if (last && has_next) S.a_ready(nxt);
            if constexpr (SP2) {
            PG8_LDB(B0, 0, 0); PG8_LDB(B1, 0, 1); PG8_SCHED; PG8_LDA(At, 0, 0); PG8_STAGE(PG8_SA(1, 1), a1 + hstep, voffA);
            PG8_WAIT_V(8); PG8_WAIT_L(0); PG8_BAR; PG8_MMA(0, 0, At, B0); PG8_MMA(0, 1, At, B1); PG8_BAR; PG8_SCHED;
            PG8_LDA(At, 0, 1); PG8_STAGE(PG8_SB(0, 0), b2, voffB); PG8_STAGE(PG8_SB(0, 1), b2 + hstep, voffB); PG8_STAGE(PG8_SA(0, 0), a2, voffA);
            PG8_WAIT_V(8); PG8_WAIT_L(0); PG8_BAR; PG8_MMA(1, 0, At, B0); PG8_MMA(1, 1, At, B1); PG8_BAR; PG8_SCHED;
            PG8_LDB(B0, 1, 0); PG8_LDB(B1, 1, 1); PG8_SCHED; PG8_LDA(At, 1, 0); PG8_STAGE(PG8_SA(0, 1), a2 + hstep, voffA);
            PG8_WAIT_V(8); PG8_WAIT_L(0); PG8_BAR; PG8_MMA(0, 0, At, B0); PG8_MMA(0, 1, At, B1); PG8_BAR; PG8_SCHED;
            PG8_LDA(At, 1, 1); PG8_STAGE(PG8_SB(1, 0), b3, voffB); PG8_STAGE(PG8_SB(1, 1), b3 + hstep, voffB); PG8_STAGE(PG8_SA(1, 0), a3, voffA);
            PG8_WAIT_V(8); PG8_WAIT_L(0); PG8_BAR; PG8_MMA(1, 0, At, B0); PG8_MMA(1, 1, At, B1); PG8_BAR; PG8_SCHED;
            } else {
            PG8_LDB(B0, 0, 0); PG8_SCHED; PG8_LDA(At, 0, 0); PG8_STAGE(PG8_SA(1, 1), a1 + hstep, voffA);
            PG8_WAIT_L(8); PG8_BAR; PG8_WAIT_L(0); PG8_MMA(0, 0, At, B0); PG8_BAR; PG8_SCHED;
            PG8_LDB(B1, 0, 1); PG8_STAGE(PG8_SB(0, 0), b2, voffB);
            PG8_BAR; PG8_WAIT_L(0); PG8_MMA(0, 1, At, B1); PG8_BAR;
            PG8_LDA(At, 0, 1); PG8_STAGE(PG8_SA(0, 0), a2, voffA);
            PG8_BAR; PG8_WAIT_L(0); PG8_MMA(1, 0, At, B0); PG8_BAR; PG8_SCHED;
            PG8_STAGE(PG8_SB(0, 1), b2 + hstep, voffB);
            PG8_WAIT_V(6); PG8_BAR; PG8_MMA(1, 1, At, B1); PG8_BAR;
            PG8_LDB(B0, 1, 0); PG8_SCHED; PG8_LDA(At, 1, 0); PG8_STAGE(PG8_SA(0, 1), a2 + hstep, voffA);
            PG8_WAIT_L(8); PG8_BAR; PG8_WAIT_L(0); PG8_MMA(0, 0, At, B0); PG8_BAR; PG8_SCHED;
            PG8_LDB(B1, 1, 1); PG8_STAGE(PG8_SB(1, 0), b3, voffB);
            PG8_BAR; PG8_WAIT_L(0); PG8_MMA(0, 1, At, B1); PG8_BAR;
            PG8_LDA(At, 1, 1); PG8_STAGE(PG8_SA(1, 0), a3, voffA);
            PG8_BAR; PG8_WAIT_L(0); PG8_MMA(1, 0, At, B0); PG8_BAR; PG8_SCHED;
            PG8_STAGE(PG8_SB(1, 1), b3 + hstep, voffB);
            PG8_WAIT_V(6); PG8_BAR; PG8_MMA(1, 1, At, B1); PG8_BAR;
            }
        }
        if constexpr (ALIGN_EPI) { if (wr == 0) PG8_BAR; }
        if constexpr (!Epi::AFTER_DRAIN) { E(acc, cur, wr, wc, fr, fq); S.done(cur); }
        if (!has_next) break;
#pragma unroll
        for (int a = 0; a < 2; ++a)
#pragma unroll
            for (int b = 0; b < 2; ++b)
#pragma unroll
                for (int m = 0; m < 4; ++m)
#pragma unroll
                    for (int n = 0; n < 2; ++n) acc[a][b][m][n] = (f32x4){0.f, 0.f, 0.f, 0.f};
        cur = nxt; cA = nA; cB = nB; ++ui;
        if constexpr (ALIGN_EPI) { if (wr == 1) PG8_BAR; }
    }
    PG8_WAIT_V(0);
    if constexpr (!ALIGN_EPI) { if (wr == 0) PG8_BAR; }
    PG8_BAR;
    if constexpr (Epi::AFTER_DRAIN) { E.fused(acc, cur, wr, wc, fr, fq, lds, wid, lane); S.done(cur); }
#undef PG8_SA
#undef PG8_SB
#undef PG8_STAGE
#undef PG8_LDA
#undef PG8_LDB
#undef PG8_MMA
#undef PG8_WAIT_V
#undef PG8_WAIT_L
#undef PG8_BAR
#undef PG8_SCHED
}
}

constexpr int NWAVES = 8;
constexpr int DM = 2048, NB = 4, SEQ = 4096, NTOK = NB * SEQ;
constexpr int NMETA = 16, NVALID = NTOK + NMETA, MROWS = 16640;
constexpr int IN_COLS = 5376;
constexpr float LN_EPS = 1e-5f, GN_EPS = 1e-5f;
constexpr float ALPHA = 1.189207115002721f;
constexpr float LOG2E = 1.4426950408889634f;
constexpr float QSCALE = 0.125f * LOG2E;

constexpr size_t MiB = 1u << 20;
constexpr size_t WS_CTL = 0, CTL_ZERO_BYTES = 1 * MiB;
constexpr size_t SZ_SK = (size_t)16 * 128 * 128 * 2, SZ_ROPE_R = (size_t)4112 * 128 * 8, SZ_ROPE_A = (size_t)4112 * 32 * 8;
constexpr size_t SZ_W2T = (size_t)DM * DM * 2, SZ_W1T = (size_t)IN_COLS * DM * 2, SZ_TAB = (size_t)16384 * DM * 2;
constexpr size_t SZ_ROWS2K = (size_t)MROWS * 2048 * 2, SZ_ROWS1K = (size_t)MROWS * 1024 * 2, SZ_ROWS128 = (size_t)MROWS * 128 * 2;
constexpr size_t SZ_TOK2K = (size_t)NTOK * 2048 * 2, SZ_ST = (size_t)16 * 32 * 256 * 256 * 2, SZ_IDS = (size_t)NTOK * 128 * 4;
constexpr size_t al256(size_t x) { return (x + 255) & ~(size_t)255; }
constexpr size_t WS_SK = 1 * MiB;
constexpr size_t WS_ROPE_R = al256(WS_SK + SZ_SK);
constexpr size_t WS_ROPE_A = al256(WS_ROPE_R + SZ_ROPE_R);
constexpr size_t WS_W2T = al256(WS_ROPE_A + SZ_ROPE_A), WS_W3T = al256(WS_W2T + SZ_W2T), WS_W1T = al256(WS_W3T + SZ_W2T);
constexpr size_t WS_UT = al256(WS_W1T + SZ_W1T), WS_VT = al256(WS_UT + SZ_TAB);
constexpr size_t WS_H0 = al256(WS_VT + SZ_TAB);
constexpr size_t WS_QR = al256(WS_H0 + SZ_ROWS2K);
constexpr size_t WS_KA = al256(WS_QR + SZ_ROWS2K), WS_VA = al256(WS_KA + SZ_ROWS128);
constexpr size_t WS_RK = al256(WS_VA + SZ_ROWS128), WS_RV = al256(WS_RK + SZ_ROWS1K), WS_RG = al256(WS_RV + SZ_ROWS1K);
constexpr size_t WS_ST = al256(WS_RG + SZ_ROWS1K);
constexpr size_t WS_Y = WS_RK;
constexpr size_t WS_H1 = WS_ST;
constexpr size_t WS_IDS = al256(WS_ST + SZ_ST), WS_GATES = al256(WS_IDS + SZ_IDS);
constexpr size_t WS_END = al256(WS_GATES + SZ_IDS);
static_assert(WS_Y + SZ_TOK2K <= WS_RG, "Y overlays RK|RV only");
static_assert(SZ_TOK2K <= SZ_ST && (size_t)NTOK * 1024 * 4 <= SZ_ST, "H1 / RET_RAW fit the state region");
static_assert(WS_END <= (size_t)512 * MiB, "workspace map fits 4 x largest tensor");
constexpr int CW_TMO = 0, CW_BAR = 4096;

constexpr int RING_OFF = 0, RING_BYTES = 131072;
constexpr int LDSCTL_OFF = RING_BYTES, MISC_OFF = LDSCTL_OFF + 320;
constexpr int LDS_BYTES = 147456;

#define GAS __attribute__((address_space(1)))
#define LAS __attribute__((address_space(3)))
typedef unsigned short bf16;
typedef unsigned v4u __attribute__((ext_vector_type(4)));
typedef unsigned v2u __attribute__((ext_vector_type(2)));
typedef float f32x4 __attribute__((ext_vector_type(4)));
typedef float f32x2 __attribute__((ext_vector_type(2)));
typedef GAS unsigned gu32;
typedef __bf16 bf16x2_t __attribute__((ext_vector_type(2)));
#define RLX_AGENT __ATOMIC_RELAXED, __HIP_MEMORY_SCOPE_AGENT
#define LDS_WAIT() asm volatile("s_waitcnt lgkmcnt(0)" ::: "memory")
#define VM_WAIT() asm volatile("s_waitcnt vmcnt(0)" ::: "memory")
__device__ __forceinline__ unsigned f2bf(float f) { unsigned u = __builtin_bit_cast(unsigned, f); return (u + 0x7fffu + ((u >> 16) & 1u)) >> 16; }
__device__ __forceinline__ unsigned pk2(float lo, float hi) { return f2bf(lo) | (f2bf(hi) << 16); }
__device__ __forceinline__ float bflo(unsigned w) { return __uint_as_float(w << 16); }
__device__ __forceinline__ float bfhi(unsigned w) { return __uint_as_float(w & 0xffff0000u); }
__device__ __forceinline__ float bf2f(bf16 h) { return __uint_as_float((unsigned)h << 16); }

#define XB_TMO      128
#define XB_XCNT(j)  (256  + 64 * (j))
#define XB_XSUB(j)  (1280 + 64 * (j))
#define XB_XGEN(j)  (2304 + 64 * (j))
#define XB_TOP      3328
#define XB_TOPGEN   3392
#define XCD_BAR_WORDS 3456
#define XB_SPIN_CAP (1u << 18)

__device__ __forceinline__ unsigned xb_ld(unsigned* p)              { return __hip_atomic_load(p, __ATOMIC_RELAXED, __HIP_MEMORY_SCOPE_AGENT); }
__device__ __forceinline__ unsigned xb_add(unsigned* p, unsigned v) { return __hip_atomic_fetch_add(p, v, __ATOMIC_RELAXED, __HIP_MEMORY_SCOPE_AGENT); }
__device__ __forceinline__ unsigned xb_xcc_id() { return (unsigned)__builtin_amdgcn_s_getreg((3 << 11) | 20) & 0xFu; }
#define XB_SPIN(cond, bar) do { unsigned _sp = 0; while (cond) { __builtin_amdgcn_s_sleep(1); \
    if ((++_sp & 255u) == 0u) { if (xb_ld(&(bar)[XB_TMO])) break; if (_sp > XB_SPIN_CAP) { atomicAdd(&(bar)[XB_TMO], 1u); break; } } } } while (0)

struct XcdBarrier {
    unsigned* bar; unsigned x;
    volatile LAS unsigned* st;
};

__device__ __forceinline__ XcdBarrier xcd_barrier_post(unsigned* bar, volatile LAS unsigned* st) {
    XcdBarrier b; b.bar = bar; b.x = xb_xcc_id(); b.st = st;
    if (threadIdx.x == 0) (void)xb_add(&bar[XB_XCNT(b.x)], 1u);
    return b;
}
__device__ __forceinline__ void xcd_barrier_complete(unsigned* bar, unsigned x, unsigned& nloc, unsigned& nx) {
    const unsigned G = gridDim.x * gridDim.y * gridDim.z;
    unsigned sum, cnt, mine, sp = 0u;
    for (;;) {
        sum = 0u; cnt = 0u; mine = 0u;
#pragma unroll
        for (unsigned j = 0; j < 16; ++j) { const unsigned c = xb_ld(&bar[XB_XCNT(j)]); sum += c; cnt += (c > 0u) ? 1u : 0u; mine = (j == x) ? c : mine; }
        if (sum == G) break;
        __builtin_amdgcn_s_sleep(1);
        if ((++sp & 255u) == 0u) { if (xb_ld(&bar[XB_TMO])) break; if (sp > XB_SPIN_CAP) { atomicAdd(&bar[XB_TMO], 1u); break; } }
    }
    nloc = mine > 0u ? mine : 1u; nx = cnt > 0u ? cnt : 1u;
}

__device__ __forceinline__ void xcd_barrier(const XcdBarrier& b) {
    asm volatile("s_waitcnt vmcnt(0)" ::: "memory");
    __syncthreads();
    if (threadIdx.x == 0) {
        unsigned* bar = b.bar;
        __builtin_amdgcn_s_waitcnt(0);
        unsigned nloc = b.st[0], nx = b.st[1];
        if (nloc == 0u) { xcd_barrier_complete(bar, b.x, nloc, nx); b.st[0] = nloc; b.st[1] = nx; }
        const unsigned old = xb_add(&bar[XB_XSUB(b.x)], 1u);
        const unsigned gen = old / nloc;
        if (old + 1u == (gen + 1u) * nloc) {
            __builtin_amdgcn_fence(__ATOMIC_RELEASE, "agent");
            asm volatile("s_waitcnt vmcnt(0)" ::: "memory");
            const unsigned og = xb_add(&bar[XB_TOP], 1u);
            const unsigned tg = og / nx;
            if (og + 1u == (tg + 1u) * nx) xb_add(&bar[XB_TOPGEN], 1u);
            else XB_SPIN(xb_ld(&bar[XB_TOPGEN]) == tg, bar);
            __builtin_amdgcn_fence(__ATOMIC_ACQUIRE, "agent");
            xb_add(&bar[XB_XGEN(b.x)], 1u);
            asm volatile("s_waitcnt vmcnt(0)" ::: "memory");
        } else {
            XB_SPIN(xb_ld(&bar[XB_XGEN(b.x)]) == gen, bar);
            __builtin_amdgcn_fence(__ATOMIC_ACQUIRE, "agent");
            asm volatile("s_waitcnt vmcnt(0)" ::: "memory");
        }
    }
    __syncthreads();
}


__device__ __forceinline__ float dot2bf(unsigned a, unsigned b, float c) { asm("v_dot2c_f32_bf16 %0, %1, %2" : "+v"(c) : "v"(a), "v"(b)); return c; }
__device__ __forceinline__ float wave_sum(float v) {
#pragma unroll
    for (int o = 1; o < 64; o <<= 1) v += __shfl_xor(v, o);
    return v;
}
__device__ __forceinline__ float gelu_erf(float v) {
    const float av = fabsf(v), d = av * 0.2316418882f + 1.0f;
    const float t = __builtin_amdgcn_rcpf(d);
    float q = t * 0.5307027145f + (-0.7265760135f); q = q * t + 0.7107068705f; q = q * t + (-0.142248368f); q = q * t + 0.127414796f; q = q * t;
    const float e = __builtin_amdgcn_exp2f((v * v) * (-0.72134752044f));
    const float m = v * (q * e);
    return v < 0.f ? m : v - m;
}

struct Args { const float* in[15]; float* out; unsigned char* ws; };

__device__ __forceinline__ void p0_transpose_item(const float* W, int K, int N, bf16* WT, LAS float* scr, int item, int lane) {
    const int nblk = N / 32, kb = item / nblk, nb = item % nblk, k0 = 64 * kb, n0 = 32 * nb;
#pragma unroll 8
    for (int i = 0; i < 32; ++i) { const int kk = 2 * i + (lane >> 5); scr[kk * 33 + (lane & 31)] = W[(size_t)(k0 + kk) * N + n0 + (lane & 31)]; }
    LDS_WAIT(); asm volatile("" ::: "memory");
    const int c = lane & 7;
#pragma unroll
    for (int j = 0; j < 4; ++j) { const int n = (lane >> 3) + 8 * j; const LAS float* s = scr + (8 * c) * 33 + n;
        v4u o; o.x = pk2(s[0 * 33], s[1 * 33]); o.y = pk2(s[2 * 33], s[3 * 33]); o.z = pk2(s[4 * 33], s[5 * 33]); o.w = pk2(s[6 * 33], s[7 * 33]);
        *(GAS v4u*)(WT + (size_t)(n0 + n) * K + k0 + 8 * c) = o; }
    LDS_WAIT(); asm volatile("" ::: "memory");
}
__device__ __forceinline__ void ln_row_f32_to_bf16(const float* xrow, const float* g, const float* bta, bf16* orow, int lane) {
    const GAS f32x4* xr = (const GAS f32x4*)xrow + lane;
    f32x4 v[8]; float s = 0.f;
#pragma unroll
    for (int j = 0; j < 8; ++j) { v[j] = xr[64 * j]; s += (v[j].x + v[j].y) + (v[j].z + v[j].w); }
    const float mean = wave_sum(s) * (1.f / DM); float s2 = 0.f;
#pragma unroll
    for (int j = 0; j < 8; ++j) { v[j] = v[j] - mean; s2 += (v[j].x * v[j].x + v[j].y * v[j].y) + (v[j].z * v[j].z + v[j].w * v[j].w); }
    const float rstd = 1.f / sqrtf(wave_sum(s2) * (1.f / DM) + LN_EPS);
    GAS v2u* o8 = (GAS v2u*)orow + lane;
#pragma unroll
    for (int j = 0; j < 8; ++j) { const f32x4 gg = ((const GAS f32x4*)g)[lane + 64 * j], bb = ((const GAS f32x4*)bta)[lane + 64 * j];
        v2u o; o.x = pk2(v[j].x * rstd * gg.x + bb.x, v[j].y * rstd * gg.y + bb.y); o.y = pk2(v[j].z * rstd * gg.z + bb.z, v[j].w * rstd * gg.w + bb.w); o8[64 * j] = o; }
}
__device__ __forceinline__ void ln_row_bf16_to_bf16(const bf16* xrow, const float* g, const float* bta, bf16* orow, int lane) {
    const GAS v4u* xr = (const GAS v4u*)xrow + lane;
    float v[32]; float s = 0.f;
#pragma unroll
    for (int j = 0; j < 4; ++j) { const v4u w = xr[64 * j];
        v[8 * j + 0] = bflo(w.x); v[8 * j + 1] = bfhi(w.x); v[8 * j + 2] = bflo(w.y); v[8 * j + 3] = bfhi(w.y);
        v[8 * j + 4] = bflo(w.z); v[8 * j + 5] = bfhi(w.z); v[8 * j + 6] = bflo(w.w); v[8 * j + 7] = bfhi(w.w); }
#pragma unroll
    for (int i = 0; i < 32; ++i) s += v[i];
    const float mean = wave_sum(s) * (1.f / DM); float s2 = 0.f;
#pragma unroll
    for (int i = 0; i < 32; ++i) { v[i] -= mean; s2 += v[i] * v[i]; }
    const float rstd = 1.f / sqrtf(wave_sum(s2) * (1.f / DM) + LN_EPS);
    GAS v4u* o16 = (GAS v4u*)orow + lane;
#pragma unroll
    for (int j = 0; j < 4; ++j) {
        const GAS f32x4* gp = (const GAS f32x4*)g + 2 * (lane + 64 * j); const GAS f32x4* bp = (const GAS f32x4*)bta + 2 * (lane + 64 * j);
        const f32x4 g0 = gp[0], g1 = gp[1], b0 = bp[0], b1 = bp[1];
        v4u o; o.x = pk2(v[8 * j + 0] * rstd * g0.x + b0.x, v[8 * j + 1] * rstd * g0.y + b0.y); o.y = pk2(v[8 * j + 2] * rstd * g0.z + b0.z, v[8 * j + 3] * rstd * g0.w + b0.w);
        o.z = pk2(v[8 * j + 4] * rstd * g1.x + b1.x, v[8 * j + 5] * rstd * g1.y + b1.y); o.w = pk2(v[8 * j + 6] * rstd * g1.z + b1.z, v[8 * j + 7] * rstd * g1.w + b1.w);
        o16[64 * j] = o; }
}
__device__ __forceinline__ void row_pos(int r, int& pos, int& ipos) {
    if (r < NTOK) { const int s = r & (SEQ - 1); pos = NMETA + s; ipos = s & 127; }
    else { int j = r - NTOK; if (j > NMETA - 1) j = NMETA - 1; pos = j; ipos = 112 + j; }
}
__device__ __forceinline__ float log2_gamma(int h) { return log2f(1.0f - exp2f(-5.0f - (float)h)); }


typedef short bf16x8 __attribute__((ext_vector_type(8)));
typedef short s16x4 __attribute__((ext_vector_type(4)));
#define MFMA16(a, b, c) __builtin_amdgcn_mfma_f32_16x16x32_bf16((a), (b), (c), 0, 0, 0)
__device__ __forceinline__ s16x4 tr16(LAS const unsigned char* p) { return __builtin_bit_cast(s16x4, __builtin_amdgcn_ds_read_tr16_b64_v4i16((LAS s16x4*)p)); }
__device__ __forceinline__ bf16x8 cat8(s16x4 a, s16x4 b) { return __builtin_shufflevector(a, b, 0, 1, 2, 3, 4, 5, 6, 7); }
__device__ __forceinline__ unsigned cvtpk(float lo, float hi) { unsigned r; asm("v_cvt_pk_bf16_f32 %0, %1, %2" : "=v"(r) : "v"(lo), "v"(hi)); return r; }

__device__ __forceinline__ void scan_unit(LAS unsigned char* L, int u, const bf16* RK, const bf16* RV, bf16* ST, int tid, int lane, int wave) {
    const int bh = u >> 4, di = (u >> 2) & 3, ei = u & 3, b = bh >> 2, h = bh & 3;
    const float g128 = exp2f(128.0f * log2_gamma(h));
    const int li = lane & 15, g = lane >> 4, q = li >> 2, p4 = li & 3;
    const int eb = wave >> 1, db0 = 2 * (wave & 1);
    f32x4 acc[2]; acc[0] = (f32x4){0.f, 0.f, 0.f, 0.f}; acc[1] = acc[0];
    v4u kreg[2], vreg[2];
#define SCAN_LOAD(cc) do { _Pragma("unroll") for (int i_ = 0; i_ < 2; ++i_) { const int cid_ = tid + 512 * i_, row_ = cid_ >> 3, c16_ = cid_ & 7; \
        int srow_; bool ok_ = true; if ((cc) < 0) { ok_ = row_ >= 112; srow_ = NTOK + (ok_ ? row_ - 112 : 0); } else srow_ = b * SEQ + (cc) * 128 + row_; \
        const v4u kz_ = *(const GAS v4u*)(RK + (size_t)srow_ * 1024 + h * 256 + di * 64 + c16_ * 8), vz_ = *(const GAS v4u*)(RV + (size_t)srow_ * 1024 + h * 256 + ei * 64 + c16_ * 8); \
        kreg[i_] = ok_ ? kz_ : (v4u){0u, 0u, 0u, 0u}; vreg[i_] = ok_ ? vz_ : (v4u){0u, 0u, 0u, 0u}; } } while (0)
#define SCAN_WRITE(bufp) do { _Pragma("unroll") for (int i_ = 0; i_ < 2; ++i_) { const int cid_ = tid + 512 * i_, row_ = cid_ >> 3, c16_ = cid_ & 7; \
        *(LAS v4u*)((bufp) + row_ * 128 + c16_ * 16) = kreg[i_]; *(LAS v4u*)((bufp) + 16384 + row_ * 128 + c16_ * 16) = vreg[i_]; } } while (0)
    SCAN_LOAD(-1); SCAN_WRITE(L); __syncthreads();
    int cur = 0;
    for (int cc = -1; cc <= 30; ++cc) {
        if (cc < 30) SCAN_LOAD(cc + 1);
        LAS const unsigned char* Kt = L + cur * 32768; LAS const unsigned char* Vt = Kt + 16384;
#pragma unroll
        for (int ks = 0; ks < 4; ++ks) {
            const int r0 = (32 * ks + 8 * g + q) * 128;
            const bf16x8 a = cat8(tr16(Vt + r0 + (16 * eb + 4 * p4) * 2), tr16(Vt + r0 + 512 + (16 * eb + 4 * p4) * 2));
#pragma unroll
            for (int n = 0; n < 2; ++n) {
                const bf16x8 bb = cat8(tr16(Kt + r0 + (16 * (db0 + n) + 4 * p4) * 2), tr16(Kt + r0 + 512 + (16 * (db0 + n) + 4 * p4) * 2));
                acc[n] = MFMA16(a, bb, acc[n]);
            }
        }
#pragma unroll
        for (int n = 0; n < 2; ++n) {
            acc[n] = acc[n] * g128;
            bf16* sp = ST + ((size_t)(bh * 32 + cc + 1) * 256 + (64 * ei + 16 * eb + 4 * g)) * 256 + 64 * di + 16 * (db0 + n) + li;
#pragma unroll
            for (int r = 0; r < 4; ++r) sp[(size_t)r * 256] = (bf16)f2bf(acc[n][r]);
        }
        if (cc < 30) SCAN_WRITE(L + (cur ^ 1) * 32768);
        __syncthreads(); cur ^= 1;
    }
#undef SCAN_LOAD
#undef SCAN_WRITE
}

__device__ __forceinline__ void retout_unit(LAS unsigned char* L, int u, bf16* QR, const bf16* RK, const bf16* RV, const bf16* RG, const bf16* ST, int tid, int lane, int wave) {
    const int bh = u >> 5, c = u & 31, b = bh >> 2, h = bh & 3;
    const int R0 = b * SEQ + c * 128;
    const int li = lane & 15, g = lane >> 4, q = li >> 2, p4 = li & 3;
    LAS unsigned char* RA = L; LAS unsigned char* RB = L + 65536;
#pragma unroll
    for (int i = 0; i < 8; ++i) { const int cid = tid + 512 * i, j = cid >> 5, ch = cid & 31;
        const v4u kz = *(const GAS v4u*)(RK + (size_t)(R0 + j) * 1024 + h * 256 + ch * 8), vz = *(const GAS v4u*)(RV + (size_t)(R0 + j) * 1024 + h * 256 + ch * 8);
        *(LAS v4u*)(RA + j * 512 + ((ch ^ (j & 15)) << 4)) = kz; *(LAS v4u*)(RB + j * 512 + ((ch ^ ((j & 7) << 1)) << 4)) = vz; }
    bf16x8 qf[8];
    { const GAS v4u* qp = (const GAS v4u*)(QR + (size_t)(R0 + 16 * wave + li) * 2048 + 1024 + h * 256 + 8 * g);
#pragma unroll
      for (int ks = 0; ks < 8; ++ks) qf[ks] = __builtin_bit_cast(bf16x8, qp[4 * ks]); }
    __syncthreads();
    f32x4 st[8];
#pragma unroll
    for (int jt = 0; jt < 8; ++jt) st[jt] = (f32x4){0.f, 0.f, 0.f, 0.f};
#pragma unroll
    for (int jt = 0; jt < 8; ++jt) if (jt <= wave) {
        const int j = 16 * jt + li;
#pragma unroll
        for (int ks = 0; ks < 8; ++ks) { const bf16x8 a = *(LAS const bf16x8*)(RA + j * 512 + (((4 * ks + g) ^ li) << 4)); st[jt] = MFMA16(a, qf[ks], st[jt]); }
        if (jt == wave) {
#pragma unroll
            for (int r = 0; r < 4; ++r) if (4 * g + r > li) st[jt][r] = 0.f; }
    }
    bf16x8 pf[4];
#pragma unroll
    for (int s = 0; s < 4; ++s) { v4u w; w.x = cvtpk(st[2 * s][0], st[2 * s][1]); w.y = cvtpk(st[2 * s][2], st[2 * s][3]); w.z = cvtpk(st[2 * s + 1][0], st[2 * s + 1][1]); w.w = cvtpk(st[2 * s + 1][2], st[2 * s + 1][3]); pf[s] = __builtin_bit_cast(bf16x8, w); }
    __syncthreads();
    const bf16* Sg = ST + (size_t)(bh * 32 + c) * 65536;
#define RO_STAGE_ST(dst, s0) do { _Pragma("unroll") for (int i_ = 0; i_ < 8; ++i_) { const int cid_ = tid + 512 * i_, sl_ = cid_ >> 11, e_ = (cid_ >> 3) & 255, ch_ = cid_ & 7; \
        const v4u z_ = *(const GAS v4u*)(Sg + (size_t)e_ * 256 + 64 * ((s0) + sl_) + ch_ * 8); *(LAS v4u*)((dst) + sl_ * 32768 + e_ * 128 + ((ch_ ^ (e_ & 7)) << 4)) = z_; } } while (0)
    RO_STAGE_ST(RA, 0);
    f32x4 o[16];
#pragma unroll
    for (int et = 0; et < 16; ++et) o[et] = (f32x4){0.f, 0.f, 0.f, 0.f};
#pragma unroll
    for (int s = 0; s < 4; ++s) if (2 * s <= wave) {
        const int r1 = 32 * s + 4 * g + q, r2 = r1 + 16;
#pragma unroll
        for (int et = 0; et < 16; ++et) {
            const int chn = 2 * et + (p4 >> 1);
            const bf16x8 a = cat8(tr16(RB + r1 * 512 + ((chn ^ ((r1 & 7) << 1)) << 4) + (p4 & 1) * 8), tr16(RB + r2 * 512 + ((chn ^ ((r2 & 7) << 1)) << 4) + (p4 & 1) * 8));
            o[et] = MFMA16(a, pf[s], o[et]);
        }
    }
    __syncthreads();
    RO_STAGE_ST(RB, 2);
#define RO_STATE_MMA(src, s0) do { _Pragma("unroll") for (int sl_ = 0; sl_ < 2; ++sl_) _Pragma("unroll") for (int k2_ = 0; k2_ < 2; ++k2_) _Pragma("unroll") for (int et = 0; et < 16; ++et) { \
        const int e_ = 16 * et + li; const bf16x8 a_ = *(LAS const bf16x8*)((src) + sl_ * 32768 + e_ * 128 + (((4 * k2_ + g) ^ (e_ & 7)) << 4)); \
        o[et] = MFMA16(a_, qf[2 * ((s0) + sl_) + k2_], o[et]); } } while (0)
    RO_STATE_MMA(RA, 0);
    __syncthreads();
    RO_STATE_MMA(RB, 2);
#undef RO_STAGE_ST
#undef RO_STATE_MMA
    float s1 = 0.f;
#pragma unroll
    for (int et = 0; et < 16; ++et) s1 += (o[et][0] + o[et][1]) + (o[et][2] + o[et][3]);
    s1 += __shfl_xor(s1, 16); s1 += __shfl_xor(s1, 32);
    const float mu = s1 * (1.0f / 256.0f); float s2 = 0.f;
#pragma unroll
    for (int et = 0; et < 16; ++et) { o[et] = o[et] - mu; s2 += (o[et][0] * o[et][0] + o[et][1] * o[et][1]) + (o[et][2] * o[et][2] + o[et][3] * o[et][3]); }
    s2 += __shfl_xor(s2, 16); s2 += __shfl_xor(s2, 32);
    const float rstd = 1.0f / sqrtf(s2 * (1.0f / 256.0f) + GN_EPS);
    const int row = R0 + 16 * wave + li;
    const GAS v2u* gp = (const GAS v2u*)(RG + (size_t)row * 1024 + h * 256 + 4 * g); GAS v2u* op = (GAS v2u*)(QR + (size_t)row * 2048 + 1024 + h * 256 + 4 * g);
#pragma unroll
    for (int et = 0; et < 16; ++et) { const v2u gz = gp[4 * et]; v2u w;
        w.x = cvtpk(o[et][0] * rstd * bflo(gz.x), o[et][1] * rstd * bfhi(gz.x)); w.y = cvtpk(o[et][2] * rstd * bflo(gz.y), o[et][3] * rstd * bfhi(gz.y)); op[4 * et] = w; }
    __syncthreads();
}

__global__ void __launch_bounds__(NWAVES * 64, 2) mk_fwd(Args args) {
    extern __shared__ __attribute__((aligned(16))) unsigned char lds[];
    LAS unsigned char* L = (LAS unsigned char*)lds;
    volatile LAS unsigned* MISC = (volatile LAS unsigned*)(L + MISC_OFF);
    const int tid = threadIdx.x, lane = tid & 63, wave = __builtin_amdgcn_readfirstlane(tid >> 6);
    const int G = gridDim.x, bx = blockIdx.x;
    const int vcu = (G % 8 == 0) ? (bx % 8) * (G / 8) + bx / 8 : bx;
    unsigned char* ws = args.ws;
    gu32* ctl = (gu32*)(ws + WS_CTL);
    const float* x = args.in[0]; const float* meta = args.in[1]; const float* ln_in_g = args.in[2]; const float* ln_in_b = args.in[3];
    const float* w_in = args.in[4]; const float* sinks = args.in[5]; const float* w_out = args.in[6]; const float* ln_mix_g = args.in[7]; const float* ln_mix_b = args.in[8];
    const float* wq = args.in[9]; const float* subkeys = args.in[10]; const float* u_tab = args.in[11]; const float* v_tab = args.in[12];
    const float* ln_ffn_g = args.in[13]; const float* ln_ffn_b = args.in[14];
    float* out = args.out;
    bf16* W1T = (bf16*)(ws + WS_W1T); bf16* W2T = (bf16*)(ws + WS_W2T); bf16* W3T = (bf16*)(ws + WS_W3T);
    bf16* H0 = (bf16*)(ws + WS_H0); bf16* QR = (bf16*)(ws + WS_QR); bf16* KA = (bf16*)(ws + WS_KA); bf16* VA = (bf16*)(ws + WS_VA);
    bf16* RK = (bf16*)(ws + WS_RK); bf16* RV = (bf16*)(ws + WS_RV); bf16* RG = (bf16*)(ws + WS_RG);
    bf16* Y = (bf16*)(ws + WS_Y); bf16* H1 = (bf16*)(ws + WS_H1); bf16* Q3 = (bf16*)(ws + WS_QR);
    bf16* STB = (bf16*)(ws + WS_ST);
    f32x2* ROPE_R = (f32x2*)(ws + WS_ROPE_R); f32x2* ROPE_A = (f32x2*)(ws + WS_ROPE_A);
    int* IDS = (int*)(ws + WS_IDS); float* GATES = (float*)(ws + WS_GATES);
    bf16* UT = (bf16*)(ws + WS_UT); bf16* VT = (bf16*)(ws + WS_VT);

    for (int u = tid; u < (LDS_BYTES - LDSCTL_OFF) / 4; u += NWAVES * 64) ((LAS unsigned*)(L + LDSCTL_OFF))[u] = 0u;
    __syncthreads();
    XcdBarrier bar = xcd_barrier_post((unsigned*)(ctl + CW_BAR), MISC + 8);
#define GRID_BAR() xcd_barrier(bar)
    const int gw = vcu * NWAVES + wave, NGW = G * NWAVES;
    const int gt = gw * 64 + lane, NGT = NGW * 64;

    {
        LAS float* scr = (LAS float*)(L + RING_OFF + wave * 16384);
        constexpr int I_1 = (DM / 64) * (IN_COLS / 32), I_2 = (DM / 64) * (DM / 32), I_3 = I_2;
        for (int it = gw; it < I_1 + I_2 + I_3; it += NGW) {
            int r = it;
            if (r < I_1) { p0_transpose_item(w_in, DM, IN_COLS, W1T, scr, r, lane); continue; } r -= I_1;
            if (r < I_2) { p0_transpose_item(w_out, DM, DM, W2T, scr, r, lane); continue; } r -= I_2;
            p0_transpose_item(wq, DM, DM, W3T, scr, r, lane);
        }
        for (int m = gw; m < MROWS; m += NGW) {
            if (m < NTOK) ln_row_f32_to_bf16(x + (size_t)m * DM, ln_in_g, ln_in_b, H0 + (size_t)m * DM, lane);
            else if (m < NVALID) ln_row_f32_to_bf16(meta + (size_t)(m - NTOK) * DM, ln_in_g, ln_in_b, H0 + (size_t)m * DM, lane);
            else { GAS v4u* o = (GAS v4u*)(H0 + (size_t)m * DM) + lane;
#pragma unroll
                for (int j = 0; j < 4; ++j) o[64 * j] = (v4u){0u, 0u, 0u, 0u}; }
        }
        for (int e = gt; e < 2 * (16384 * DM / 8); e += NGT) {
            const int which = e >= (16384 * DM / 8); const int i8 = which ? e - (16384 * DM / 8) : e;
            const GAS f32x4* src = (const GAS f32x4*)(which ? v_tab : u_tab) + 2 * (size_t)i8; const f32x4 a = src[0], b = src[1];
            v4u o; o.x = pk2(a.x, a.y); o.y = pk2(a.z, a.w); o.z = pk2(b.x, b.y); o.w = pk2(b.z, b.w);
            ((GAS v4u*)(which ? VT : UT))[i8] = o; }
        for (int e = gt; e < 4112 * 128; e += NGT) { const int pos = e >> 7, i = e & 127; const float inv = powf(10000.0f, -(float)(2 * i) / 256.0f); float sn, cs; sincosf((float)pos * inv, &sn, &cs); ROPE_R[e] = (f32x2){cs, sn}; }
        for (int e = gt; e < 4112 * 32; e += NGT) { const int pos = e >> 5, i = e & 31; const float inv = powf(10000.0f, -(float)(2 * i) / 64.0f); float sn, cs; sincosf((float)pos * inv, &sn, &cs); ROPE_A[e] = (f32x2){cs, sn}; }
    }
    GRID_BAR();

    {
        pg8::Gemm g{H0, W1T, MROWS, IN_COLS, DM}; pg8::StaticOrder S; S.init(MROWS, IN_COLS, G, bx);
        pg8::EpiGen<0> E{nullptr, 0, nullptr, 0.f, QR, KA, VA, RK, RV, RG};
        pg8::gemm_phase<pg8::EpiGen<0>, pg8::StaticOrder, true, true>(L + RING_OFF, g, S, E);
    }
    GRID_BAR();

    for (int r = gw; r < NVALID; r += NGW) {
        int pos, ipos; row_pos(r, pos, ipos);
        bf16* qr = QR + (size_t)r * 2048; bf16* ka = KA + (size_t)r * 128; bf16* rk = RK + (size_t)r * 1024; bf16* rg = RG + (size_t)r * 1024;
        for (int idx = lane; idx < 512; idx += 64) { const int a = idx >> 5, i = idx & 31; const f32x2 cs = ROPE_A[pos * 32 + i];
            const float x1 = bf2f(qr[64 * a + i]), x2 = bf2f(qr[64 * a + 32 + i]);
            qr[64 * a + i] = (bf16)f2bf((x1 * cs.x - x2 * cs.y) * QSCALE); qr[64 * a + 32 + i] = (bf16)f2bf((x2 * cs.x + x1 * cs.y) * QSCALE); }
        { const int a = lane >> 5, i = lane & 31; const f32x2 cs = ROPE_A[pos * 32 + i];
            const float x1 = bf2f(ka[64 * a + i]), x2 = bf2f(ka[64 * a + 32 + i]);
            ka[64 * a + i] = (bf16)f2bf(x1 * cs.x - x2 * cs.y); ka[64 * a + 32 + i] = (bf16)f2bf(x2 * cs.x + x1 * cs.y); }
        for (int idx = lane; idx < 512; idx += 64) { const int h = idx >> 7, i = idx & 127; const f32x2 cs = ROPE_R[pos * 128 + i];
            const float lg = log2_gamma(h); const float qs = exp2f((float)(ipos + 1) * lg), ks = 0.0625f * exp2f(-(float)(ipos + 1) * lg);
            { const float x1 = bf2f(qr[1024 + 256 * h + i]), x2 = bf2f(qr[1024 + 256 * h + 128 + i]);
              qr[1024 + 256 * h + i] = (bf16)f2bf((x1 * cs.x - x2 * cs.y) * qs); qr[1024 + 256 * h + 128 + i] = (bf16)f2bf((x2 * cs.x + x1 * cs.y) * qs); }
            { const float x1 = bf2f(rk[256 * h + i]), x2 = bf2f(rk[256 * h + 128 + i]);
              rk[256 * h + i] = (bf16)f2bf((x1 * cs.x - x2 * cs.y) * ks); rk[256 * h + 128 + i] = (bf16)f2bf((x2 * cs.x + x1 * cs.y) * ks); } }
        for (int idx = lane; idx < 1024; idx += 64) { const float v = bf2f(rg[idx]); rg[idx] = (bf16)f2bf(v / (1.0f + __expf(-v))); }
    }
    GRID_BAR();

    for (int id = gt; id < NTOK * 16; id += NGT) {
        const int r = id >> 4, hq = id & 15, g2 = hq >> 3; const int b = r >> 12, s = r & 4095;
        float q[64];
        { const v4u* qp = (const v4u*)(QR + (size_t)r * 2048 + hq * 64);
#pragma unroll
          for (int j = 0; j < 8; ++j) { const v4u w = qp[j]; q[8 * j + 0] = bflo(w.x); q[8 * j + 1] = bfhi(w.x); q[8 * j + 2] = bflo(w.y); q[8 * j + 3] = bfhi(w.y); q[8 * j + 4] = bflo(w.z); q[8 * j + 5] = bfhi(w.z); q[8 * j + 6] = bflo(w.w); q[8 * j + 7] = bfhi(w.w); } }
        float m = sinks[hq] * LOG2E, l = 1.0f; float o[64];
#pragma unroll
        for (int d = 0; d < 64; ++d) o[d] = 0.f;
        const int slot = 128 + s;
        for (int ks = slot - 127; ks <= slot; ++ks) {
            if (ks < 112) continue;
            const int krow = (ks >= 128) ? (b * SEQ + ks - 128) : (NTOK + ks - 112);
            const v4u* kp = (const v4u*)(KA + (size_t)krow * 128 + g2 * 64); const v4u* vp = (const v4u*)(VA + (size_t)krow * 128 + g2 * 64);
            float sc = 0.f;
#pragma unroll
            for (int j = 0; j < 8; ++j) { const v4u w = kp[j]; sc += q[8 * j + 0] * bflo(w.x) + q[8 * j + 1] * bfhi(w.x) + q[8 * j + 2] * bflo(w.y) + q[8 * j + 3] * bfhi(w.y) + q[8 * j + 4] * bflo(w.z) + q[8 * j + 5] * bfhi(w.z) + q[8 * j + 6] * bflo(w.w) + q[8 * j + 7] * bfhi(w.w); }
            const float mn = fmaxf(m, sc); const float f = exp2f(m - mn), p = exp2f(sc - mn); m = mn; l = l * f + p;
#pragma unroll
            for (int j = 0; j < 8; ++j) { const v4u w = vp[j];
                o[8 * j + 0] = o[8 * j + 0] * f + p * bflo(w.x); o[8 * j + 1] = o[8 * j + 1] * f + p * bfhi(w.x); o[8 * j + 2] = o[8 * j + 2] * f + p * bflo(w.y); o[8 * j + 3] = o[8 * j + 3] * f + p * bfhi(w.y);
                o[8 * j + 4] = o[8 * j + 4] * f + p * bflo(w.z); o[8 * j + 5] = o[8 * j + 5] * f + p * bfhi(w.z); o[8 * j + 6] = o[8 * j + 6] * f + p * bflo(w.w); o[8 * j + 7] = o[8 * j + 7] * f + p * bfhi(w.w); }
        }
        const float il = 1.0f / l;
        v4u* op = (v4u*)(QR + (size_t)r * 2048 + hq * 64);
#pragma unroll
        for (int j = 0; j < 8; ++j) { v4u w; w.x = pk2(o[8 * j + 0] * il, o[8 * j + 1] * il); w.y = pk2(o[8 * j + 2] * il, o[8 * j + 3] * il); w.z = pk2(o[8 * j + 4] * il, o[8 * j + 5] * il); w.w = pk2(o[8 * j + 6] * il, o[8 * j + 7] * il); op[j] = w; }
    }

    for (int u = bx; u < 256; u += G) scan_unit(L + RING_OFF, u, RK, RV, STB, tid, lane, wave);
    GRID_BAR();

    for (int u = bx; u < 512; u += G) retout_unit(L + RING_OFF, u, QR, RK, RV, RG, STB, tid, lane, wave);
    GRID_BAR();

    {
        pg8::Gemm g{QR, W2T, NTOK, DM, DM}; pg8::StaticOrder S; S.init(NTOK, DM, G, bx);
        pg8::EpiGen<1> E{Y, DM, H0, ALPHA, nullptr, nullptr, nullptr, nullptr, nullptr, nullptr};
        pg8::gemm_phase<pg8::EpiGen<1>, pg8::StaticOrder, true, true>(L + RING_OFF, g, S, E);
    }
    GRID_BAR();

    for (int m = gw; m < NTOK; m += NGW) ln_row_bf16_to_bf16(Y + (size_t)m * DM, ln_mix_g, ln_mix_b, H1 + (size_t)m * DM, lane);
    GRID_BAR();

    {
        pg8::Gemm g{H1, W3T, NTOK, DM, DM}; pg8::StaticOrder S; S.init(NTOK, DM, G, bx);
        pg8::EpiGen<2> E{Q3, DM, nullptr, 0.f, nullptr, nullptr, nullptr, nullptr, nullptr, nullptr};
        pg8::gemm_phase<pg8::EpiGen<2>, pg8::StaticOrder, true, true>(L + RING_OFF, g, S, E);
    }
    GRID_BAR();

    for (int id = gt; id < NTOK * 8; id += NGT) {
        const int tok = id >> 3, hd = id & 7;
        float sv[2][16]; int si[2][16];
#pragma unroll
        for (int p = 0; p < 2; ++p) {
            float q[128];
            { const v4u* qp = (const v4u*)(Q3 + (size_t)tok * DM + hd * 256 + p * 128);
#pragma unroll
              for (int j = 0; j < 16; ++j) { const v4u w = qp[j]; q[8 * j + 0] = bflo(w.x); q[8 * j + 1] = bfhi(w.x); q[8 * j + 2] = bflo(w.y); q[8 * j + 3] = bfhi(w.y); q[8 * j + 4] = bflo(w.z); q[8 * j + 5] = bfhi(w.z); q[8 * j + 6] = bflo(w.w); q[8 * j + 7] = bfhi(w.w); } }
            float tv[16]; int ti[16];
#pragma unroll
            for (int j = 0; j < 16; ++j) { tv[j] = -3.0e38f; ti[j] = 0; }
            for (int n = 0; n < 128; ++n) {
                const f32x4* sk = (const f32x4*)(subkeys + ((size_t)((hd * 2 + p) * 128 + n)) * 128);
                float sc = 0.f;
#pragma unroll
                for (int c = 0; c < 32; ++c) { const f32x4 w = sk[c]; sc += q[4 * c] * w.x + q[4 * c + 1] * w.y + q[4 * c + 2] * w.z + q[4 * c + 3] * w.w; }
                float v = sc; int vi = n;
#pragma unroll
                for (int j = 0; j < 16; ++j) { const bool gtb = v > tv[j]; const float nv = gtb ? tv[j] : v; const int ni = gtb ? ti[j] : vi; tv[j] = gtb ? v : tv[j]; ti[j] = gtb ? vi : ti[j]; v = nv; vi = ni; }
            }
#pragma unroll
            for (int j = 0; j < 16; ++j) { sv[p][j] = tv[j]; si[p][j] = ti[j]; }
        }
        float fv[16]; int fi[16];
#pragma unroll
        for (int j = 0; j < 16; ++j) { fv[j] = -3.0e38f; fi[j] = 0; }
#pragma unroll
        for (int i = 0; i < 16; ++i)
#pragma unroll
            for (int j = 0; j < 16; ++j) if ((i + 1) * (j + 1) <= 16) {
                float v = sv[0][i] + sv[1][j]; int vi = si[0][i] * 128 + si[1][j];
#pragma unroll
                for (int k = 0; k < 16; ++k) { const bool gtb = v > fv[k]; const float nv = gtb ? fv[k] : v; const int ni = gtb ? fi[k] : vi; fv[k] = gtb ? v : fv[k]; fi[k] = gtb ? vi : fi[k]; v = nv; vi = ni; }
            }
        float den = 0.f; float ev[16];
#pragma unroll
        for (int k = 0; k < 16; ++k) { ev[k] = __expf(fv[k] - fv[0]); den += ev[k]; }
        const float iden = 1.0f / den;
#pragma unroll
        for (int k = 0; k < 16; ++k) { IDS[(size_t)tok * 128 + hd * 16 + k] = fi[k]; GATES[(size_t)tok * 128 + hd * 16 + k] = ev[k] * iden; }
    }
    GRID_BAR();

    for (int tok = gw; tok < NTOK; tok += NGW) {
        v4u hq[4];
        { const GAS v4u* hp = (const GAS v4u*)(H1 + (size_t)tok * DM) + lane;
#pragma unroll
          for (int j = 0; j < 4; ++j) hq[j] = hp[64 * j]; }
        const int idv0 = IDS[(size_t)tok * 128 + lane], idv1 = IDS[(size_t)tok * 128 + 64 + lane];
        const float gv0 = GATES[(size_t)tok * 128 + lane], gv1 = GATES[(size_t)tok * 128 + 64 + lane];
        float ov[32];
#pragma unroll
        for (int i = 0; i < 32; ++i) ov[i] = 0.f;
        v4u ub[4][4], vb[4][4];
#pragma unroll
        for (int p = 0; p < 4; ++p) { const int eid = __builtin_amdgcn_readlane(idv0, p); const GAS v4u* up = (const GAS v4u*)(UT + (size_t)eid * DM) + lane;
#pragma unroll
            for (int j = 0; j < 4; ++j) ub[p][j] = up[64 * j]; }
#pragma unroll 1
        for (int half = 0; half < 2; ++half) {
            const int idv = half ? idv1 : idv0, idn = idv1; const float gv = half ? gv1 : gv0;
#pragma unroll 1
            for (int g = 0; g < 16; ++g) {
#pragma unroll
                for (int p = 0; p < 4; ++p) { const int eid = __builtin_amdgcn_readlane(idv, 4 * g + p); const GAS v4u* vp = (const GAS v4u*)(VT + (size_t)eid * DM) + lane;
#pragma unroll
                    for (int j = 0; j < 4; ++j) vb[p][j] = vp[64 * j]; }
                float dot[4];
#pragma unroll
                for (int p = 0; p < 4; ++p) { float d = 0.f;
#pragma unroll
                    for (int j = 0; j < 4; ++j) {
                        d = dot2bf(ub[p][j].x, hq[j].x, d); d = dot2bf(ub[p][j].y, hq[j].y, d); d = dot2bf(ub[p][j].z, hq[j].z, d); d = dot2bf(ub[p][j].w, hq[j].w, d); }
                    dot[p] = d; }
                if (half == 0 || g < 15) {
                    const int gn = (g + 1) & 15; const int idx = (g == 15) ? idn : idv;
#pragma unroll
                    for (int p = 0; p < 4; ++p) { const int eid = __builtin_amdgcn_readlane(idx, 4 * gn + p); const GAS v4u* up = (const GAS v4u*)(UT + (size_t)eid * DM) + lane;
#pragma unroll
                        for (int j = 0; j < 4; ++j) ub[p][j] = up[64 * j]; }
                }
#pragma unroll
                for (int o = 1; o < 64; o <<= 1) {
#pragma unroll
                    for (int p = 0; p < 4; ++p) dot[p] += __shfl_xor(dot[p], o); }
#pragma unroll
                for (int p = 0; p < 4; ++p) {
                    const float c = __uint_as_float(__builtin_amdgcn_readlane(__float_as_uint(gv), 4 * g + p)) * gelu_erf(dot[p]);
#pragma unroll
                    for (int j = 0; j < 4; ++j) {
                        ov[8 * j + 0] += c * bflo(vb[p][j].x); ov[8 * j + 1] += c * bfhi(vb[p][j].x); ov[8 * j + 2] += c * bflo(vb[p][j].y); ov[8 * j + 3] += c * bfhi(vb[p][j].y);
                        ov[8 * j + 4] += c * bflo(vb[p][j].z); ov[8 * j + 5] += c * bfhi(vb[p][j].z); ov[8 * j + 6] += c * bflo(vb[p][j].w); ov[8 * j + 7] += c * bfhi(vb[p][j].w); }
                }
            }
        }
        float s = 0.f;
#pragma unroll
        for (int j = 0; j < 4; ++j) {
            ov[8 * j + 0] += ALPHA * bflo(hq[j].x); ov[8 * j + 1] += ALPHA * bfhi(hq[j].x); ov[8 * j + 2] += ALPHA * bflo(hq[j].y); ov[8 * j + 3] += ALPHA * bfhi(hq[j].y);
            ov[8 * j + 4] += ALPHA * bflo(hq[j].z); ov[8 * j + 5] += ALPHA * bfhi(hq[j].z); ov[8 * j + 6] += ALPHA * bflo(hq[j].w); ov[8 * j + 7] += ALPHA * bfhi(hq[j].w); }
#pragma unroll
        for (int i = 0; i < 32; ++i) s += ov[i];
        const float mean = wave_sum(s) * (1.f / DM); float s2 = 0.f;
#pragma unroll
        for (int i = 0; i < 32; ++i) { ov[i] -= mean; s2 += ov[i] * ov[i]; }
        const float rstd = 1.0f / sqrtf(wave_sum(s2) * (1.f / DM) + LN_EPS);
#pragma unroll
        for (int j = 0; j < 4; ++j) {
            const GAS f32x4* gp = (const GAS f32x4*)ln_ffn_g + 2 * (lane + 64 * j); const GAS f32x4* bp = (const GAS f32x4*)ln_ffn_b + 2 * (lane + 64 * j);
            const f32x4 g0 = gp[0], g1 = gp[1], b0 = bp[0], b1 = bp[1];
            GAS f32x4* op = (GAS f32x4*)(out + (size_t)tok * DM) + 2 * (lane + 64 * j);
            op[0] = (f32x4){ov[8 * j + 0] * rstd * g0.x + b0.x, ov[8 * j + 1] * rstd * g0.y + b0.y, ov[8 * j + 2] * rstd * g0.z + b0.z, ov[8 * j + 3] * rstd * g0.w + b0.w};
            op[1] = (f32x4){ov[8 * j + 4] * rstd * g1.x + b1.x, ov[8 * j + 5] * rstd * g1.y + b1.y, ov[8 * j + 6] * rstd * g1.z + b1.z, ov[8 * j + 7] * rstd * g1.w + b1.w}; }
    }
}

extern "C" void kernel_launch(void* const* d_in, const int* in_sizes, int n_in, void* d_out, int out_size, void* d_ws, size_t ws_size, hipStream_t stream) {
    static int grid = 0;
    if (grid == 0) {
        if (n_in != 15 || out_size != NTOK * DM || ws_size < WS_END) { fprintf(stderr, "kernel_launch: unexpected shapes (n_in %d out %d ws %zu)\n", n_in, out_size, ws_size); grid = -1; return; }
        int dev = 0, cus = 0, per_cu = 0;
        if (hipGetDevice(&dev) != hipSuccess || hipDeviceGetAttribute(&cus, hipDeviceAttributeMultiprocessorCount, dev) != hipSuccess) { grid = -1; return; }
        if (hipFuncSetAttribute((const void*)mk_fwd, hipFuncAttributeMaxDynamicSharedMemorySize, LDS_BYTES) != hipSuccess) { fprintf(stderr, "kernel_launch: hipFuncSetAttribute failed\n"); grid = -1; return; }
        if (hipOccupancyMaxActiveBlocksPerMultiprocessor(&per_cu, (const void*)mk_fwd, NWAVES * 64, LDS_BYTES) != hipSuccess || per_cu < 1) { fprintf(stderr, "kernel_launch: occupancy query says %d\n", per_cu); }
        (void)hipGetLastError();
        grid = cus;
    }
    if (grid < 0) return;
    if (hipMemsetAsync((char*)d_ws + WS_CTL, 0, CTL_ZERO_BYTES, stream) != hipSuccess) return;
    Args a{};
    for (int i = 0; i < 15; ++i) a.in[i] = (const float*)d_in[i];
    a.out = (float*)d_out; a.ws = (unsigned char*)d_ws;
    hipLaunchKernelGGL(mk_fwd, dim3(grid), dim3(NWAVES * 64), LDS_BYTES, stream, a);
}
```

```cpp
#include <hip/hip_runtime.h>
#include <cstdio>
#include <cstdint>
#include <cmath>
namespace pg8 {
#define PG8_LAS __attribute__((address_space(3)))
typedef unsigned short bf16_t;
typedef short bf16x8 __attribute__((ext_vector_type(8)));
typedef float f32x4 __attribute__((ext_vector_type(4)));
typedef unsigned u32x4 __attribute__((ext_vector_type(4)));
constexpr int BM = 256, BK = 64, HALF = 128, HTB = HALF * BK * 2  , STAGE_BYTES = 8 * HTB, NXCD = 8, WGM = 8;

__host__ __device__ __forceinline__ int lds_byte(int r, int c) { const int st = (r >> 4) * 2 + (c >> 5), rr = r & 15, cc = c & 31, ob = rr * 64 + cc * 2; return st * 1024 + (ob ^ (((ob >> 9) & 1) << 5)); }
__host__ __device__ __forceinline__ void stage_rc(int b, int& R, int& C) { const int st = b / 1024, sb = b % 1024, swz = sb ^ (((sb >> 9) & 1) << 5); R = (st >> 1) * 16 + swz / 64; C = (st & 1) * 32 + (swz % 64) / 2; }
__host__ __device__ __forceinline__ int perm32(int rho) { const int n = rho >> 4, i = rho & 15; return 8 * (i >> 2) + 4 * n + (i & 3); }

struct Unit { int pm, pn; };
struct Gemm { const bf16_t* A; const bf16_t* Bt; int M, N, K; };

struct StaticOrder {
    int nM, nN, nwg, G, c;
    __host__ __device__ void init(int M, int N, int G_, int c_) { nM = M / BM; nN = N / BM; nwg = nM * nN; G = G_; c = c_; }
    __host__ __device__ bool next(int i, Unit& u) const {
        const long L = (long)i * G + c; if (L >= nwg) return false;
        int wgid = (int)L; { const int q = nwg / NXCD, r = nwg % NXCD, xcd = wgid % NXCD, off = wgid / NXCD; wgid = (xcd < r ? xcd * (q + 1) : r * (q + 1) + (xcd - r) * q) + off; }
        const int nig = WGM * nN, gid = wgid / nig, fm = gid * WGM, gsz = (nM - fm) < WGM ? (nM - fm) : WGM;
        u.pm = fm + ((wgid % nig) % gsz); u.pn = (wgid % nig) / gsz; return true;
    }
    __device__ __forceinline__ void a_ready(const Unit&) const {}
    __device__ __forceinline__ void done(const Unit&) const {}
};

__device__ __forceinline__ unsigned cvt_pk_bf16(float lo, float hi) { unsigned r; asm volatile("v_cvt_pk_bf16_f32 %0, %1, %2" : "=v"(r) : "v"(lo), "v"(hi)); return r; }
typedef float f32x2 __attribute__((ext_vector_type(2)));

template <int MODE> struct EpiGen {
    static constexpr bool PERM = true, AFTER_DRAIN = false;
    bf16_t* O; int ldc; const bf16_t* R; float alpha;
    bf16_t *QR, *KA, *VA, *RK, *RV, *RG;
    __device__ __forceinline__ void operator()(const f32x4 (&acc)[2][2][4][2], const Unit& u, int wr, int wc, int fr, int fq) const {
        const int row0 = u.pm * BM + wr * 64 + fr;
#pragma unroll
        for (int bj = 0; bj < 2; ++bj) {
            const int col = u.pn * BM + bj * HALF + wc * 32 + 8 * fq;
            bf16_t* base = O; int ld = ldc; int cc = col;
            if (MODE == 0) {
                if (col < 1024)      { base = QR; ld = 2048; cc = col; }
                else if (col < 1152) { base = KA; ld = 128;  cc = col - 1024; }
                else if (col < 1280) { base = VA; ld = 128;  cc = col - 1152; }
                else if (col < 2304) { base = QR; ld = 2048; cc = col - 1280 + 1024; }
                else if (col < 3328) { base = RK; ld = 1024; cc = col - 2304; }
                else if (col < 4352) { base = RV; ld = 1024; cc = col - 3328; }
                else                 { base = RG; ld = 1024; cc = col - 4352; }
            }
#pragma unroll
            for (int ai = 0; ai < 2; ++ai)
#pragma unroll
                for (int m = 0; m < 4; ++m) {
                    const int row = row0 + ai * HALF + m * 16;
                    f32x4 v0 = acc[ai][bj][m][0], v1 = acc[ai][bj][m][1];
                    if (MODE == 1) {
                        const u32x4 r = *(const u32x4*)(R + (size_t)row * ldc + col);
                        v0[0] += alpha * __uint_as_float(r.x << 16); v0[1] += alpha * __uint_as_float(r.x & 0xffff0000u);
                        v0[2] += alpha * __uint_as_float(r.y << 16); v0[3] += alpha * __uint_as_float(r.y & 0xffff0000u);
                        v1[0] += alpha * __uint_as_float(r.z << 16); v1[1] += alpha * __uint_as_float(r.z & 0xffff0000u);
                        v1[2] += alpha * __uint_as_float(r.w << 16); v1[3] += alpha * __uint_as_float(r.w & 0xffff0000u);
                    }
                    u32x4 w; w.x = cvt_pk_bf16(v0[0], v0[1]); w.y = cvt_pk_bf16(v0[2], v0[3]); w.z = cvt_pk_bf16(v1[0], v1[1]); w.w = cvt_pk_bf16(v1[2], v1[3]);
                    *(u32x4*)(base + (size_t)row * ld + cc) = w;
                }
        }
    }
};
template <class Epi, class Sched, bool ALIGN_EPI = false, bool SP2 = false>
__device__ __forceinline__ void gemm_phase(PG8_LAS unsigned char* lds, const Gemm g, const Sched& S, const Epi& E) {
    const int tid = threadIdx.x, wid = __builtin_amdgcn_readfirstlane(tid >> 6), lane = tid & 63, wr = wid >> 2, wc = wid & 3, fr = lane & 15, fq = lane >> 4;
    const int K = g.K, nt = K / BK;
    unsigned voffA[2], voffB[2];
#pragma unroll
    for (int i = 0; i < 2; ++i) { int R, C; stage_rc(tid * 16 + i * 8192, R, C); const int Rb = Epi::PERM ? ((R & ~31) + perm32(R & 31)) : R;
        voffA[i] = (unsigned)(R * K + C) * 2u; voffB[i] = (unsigned)(Rb * K + C) * 2u; }
    const size_t kstep = (size_t)(BK * 2);
    const size_t hstep = (size_t)HALF * K * 2;
    const size_t tstep = 2 * hstep;
    const unsigned ldsw = (unsigned)wid * 1024u;
    const int aoff = lds_byte(wr * 64 + fr, fq * 8), boff = lds_byte(wc * 32 + fr, fq * 8);
#define PG8_SA(b, h) (((b) * 2 + (h)) * HTB)
#define PG8_SB(b, h) ((4 + (b) * 2 + (h)) * HTB)
#define PG8_STAGE(bufoff, gbase, voff) do { _Pragma("unroll") for (int _i = 0; _i < 2; ++_i) \
        __builtin_amdgcn_global_load_lds((const unsigned*)((const char*)(gbase) + (voff)[_i]), (PG8_LAS unsigned*)(lds + (bufoff) + ldsw + _i * 8192), 16, 0, 0); } while (0)
#define PG8_LDA(dst, b, h) do { _Pragma("unroll") for (int m = 0; m < 4; ++m) _Pragma("unroll") for (int k = 0; k < 2; ++k) dst[m][k] = *(const PG8_LAS bf16x8*)(lds + PG8_SA(b, h) + aoff + m * 2048 + k * 1024); } while (0)
#define PG8_LDB(dst, b, h) do { _Pragma("unroll") for (int n = 0; n < 2; ++n) _Pragma("unroll") for (int k = 0; k < 2; ++k) dst[n][k] = *(const PG8_LAS bf16x8*)(lds + PG8_SB(b, h) + boff + n * 2048 + k * 1024); } while (0)
#define PG8_MMA(ai, bj, At, Bt) do { __builtin_amdgcn_s_setprio(1); _Pragma("unroll") for (int m = 0; m < 4; ++m) _Pragma("unroll") for (int n = 0; n < 2; ++n) _Pragma("unroll") for (int k = 0; k < 2; ++k) \
        acc[ai][bj][m][n] = __builtin_amdgcn_mfma_f32_16x16x32_bf16(Bt[n][k], At[m][k], acc[ai][bj][m][n], 0, 0, 0); __builtin_amdgcn_s_setprio(0); } while (0)
#define PG8_WAIT_V(n) asm volatile("s_waitcnt vmcnt(" #n ")" ::: "memory")
#define PG8_WAIT_L(n) asm volatile("s_waitcnt lgkmcnt(" #n ")" ::: "memory")
#define PG8_BAR __builtin_amdgcn_s_barrier()
#define PG8_SCHED __builtin_amdgcn_sched_barrier(0)
    Unit cur, nxt; int ui = 0;
    if (!S.next(0, cur)) return;
    f32x4 acc[2][2][4][2];
#pragma unroll
    for (int a = 0; a < 2; ++a)
#pragma unroll
        for (int b = 0; b < 2; ++b)
#pragma unroll
            for (int m = 0; m < 4; ++m)
#pragma unroll
                for (int n = 0; n < 2; ++n) acc[a][b][m][n] = (f32x4){0.f, 0.f, 0.f, 0.f};
    bf16x8 At[4][2], B0[2][2], B1[2][2];
    const char* cA = (const char*)g.A + (size_t)cur.pm * tstep; const char* cB = (const char*)g.Bt + (size_t)cur.pn * tstep;
    S.a_ready(cur);
    if constexpr (SP2) {
        PG8_STAGE(PG8_SB(0, 0), cB, voffB); PG8_STAGE(PG8_SB(0, 1), cB + hstep, voffB); PG8_STAGE(PG8_SA(0, 0), cA, voffA); PG8_STAGE(PG8_SA(0, 1), cA + hstep, voffA);
        if (wr == 1) PG8_BAR;
        PG8_WAIT_V(2); PG8_BAR;
        PG8_STAGE(PG8_SB(1, 0), cB + kstep, voffB); PG8_STAGE(PG8_SA(1, 0), cA + kstep, voffA); PG8_STAGE(PG8_SB(1, 1), cB + hstep + kstep, voffB);
        PG8_WAIT_V(6); PG8_BAR;
    } else {
        PG8_STAGE(PG8_SB(0, 0), cB, voffB); PG8_STAGE(PG8_SA(0, 0), cA, voffA); PG8_STAGE(PG8_SB(0, 1), cB + hstep, voffB); PG8_STAGE(PG8_SA(0, 1), cA + hstep, voffA);
        if (wr == 1) PG8_BAR;
        PG8_WAIT_V(4); PG8_BAR;
        PG8_STAGE(PG8_SB(1, 0), cB + kstep, voffB); PG8_STAGE(PG8_SA(1, 0), cA + kstep, voffA); PG8_STAGE(PG8_SB(1, 1), cB + hstep + kstep, voffB);
        PG8_WAIT_V(6); PG8_BAR;
    }
    for (;;) {
        const bool has_next = S.next(ui + 1, nxt);
        const char* nA = has_next ? (const char*)g.A + (size_t)nxt.pm * tstep : cA; const char* nB = has_next ? (const char*)g.Bt + (size_t)nxt.pn * tstep : cB;
        for (int t = 0; t < nt; t += 2) {
            const bool last = (t == nt - 2);
            const char* a1 = cA + (size_t)(t + 1) * kstep;
            const char* a2 = last ? nA : cA + (size_t)(t + 2) * kstep; const char* b2 = last ? nB : cB + (size_t)(t + 2) * kstep;
            const char* a3 = a2 + kstep; const char* b3 = b2 + kstep;
            if (last && has_next) S.a_ready(nxt);
            if constexpr (SP2) {
            PG8_LDB(B0, 0, 0); PG8_LDB(B1, 0, 1); PG8_SCHED; PG8_LDA(At, 0, 0); PG8_STAGE(PG8_SA(1, 1), a1 + hstep, voffA);
            PG8_WAIT_V(8); PG8_WAIT_L(0); PG8_BAR; PG8_MMA(0, 0, At, B0); PG8_MMA(0, 1, At, B1); PG8_BAR; PG8_SCHED;
            PG8_LDA(At, 0, 1); PG8_STAGE(PG8_SB(0, 0), b2, voffB); PG8_STAGE(PG8_SB(0, 1), b2 + hstep, voffB); PG8_STAGE(PG8_SA(0, 0), a2, voffA);
            PG8_WAIT_V(8); PG8_WAIT_L(0); PG8_BAR; PG8_MMA(1, 0, At, B0); PG8_MMA(1, 1, At, B1); PG8_BAR; PG8_SCHED;
            PG8_LDB(B0, 1, 0); PG8_LDB(B1, 1, 1); PG8_SCHED; PG8_LDA(At, 1, 0); PG8_STAGE(PG8_SA(0, 1), a2 + hstep, voffA);
            PG8_WAIT_V(8); PG8_WAIT_L(0); PG8_BAR; PG8_MMA(0, 0, At, B0); PG8_MMA(0, 1, At, B1); PG8_BAR; PG8_SCHED;
            PG8_LDA(At, 1, 1); PG8_STAGE(PG8_SB(1, 0), b3, voffB); PG8_STAGE(PG8_SB(1, 1), b3 + hstep, voffB); PG8_STAGE(PG8_SA(1, 0), a3, voffA);
            PG8_WAIT_V(8); PG8_WAIT_L(0); PG8_BAR; PG8_MMA(1, 0, At, B0); PG8_MMA(1, 1, At, B1); PG8_BAR; PG8_SCHED;
            } else {
            PG8_LDB(B0, 0, 0); PG8_SCHED; PG8_LDA(At, 0, 0); PG8_STAGE(PG8_SA(1, 1), a1 + hstep, voffA);
            PG8_WAIT_L(8); PG8_BAR; PG8_WAIT_L(0); PG8_MMA(0, 0, At, B0); PG8_BAR; PG8_SCHED;
            PG8_LDB(B1, 0, 1); PG8_STAGE(PG8_SB(0, 0), b2, voffB);
            PG8_BAR; PG8_WAIT_L(0); PG8_MMA(0, 1, At, B1); PG8_BAR;
            PG8_LDA(At, 0, 1); PG8_STAGE(PG8_SA(0, 0), a2, voffA);
            PG8_BAR; PG8_WAIT_L(0); PG8_MMA(1, 0, At, B0); PG8_BAR; PG8_SCHED;
            PG8_STAGE(PG8_SB(0, 1), b2 + hstep, voffB);
            PG8_WAIT_V(6); PG8_BAR; PG8_MMA(1, 1, At, B1); PG8_BAR;
            PG8_LDB(B0, 1, 0); PG8_SCHED; PG8_LDA(At, 1, 0); PG8_STAGE(PG8_SA(0, 1), a2 + hstep, voffA);
            PG8_WAIT_L(8); PG8_BAR; PG8_WAIT_L(0); PG8_MMA(0, 0, At, B0); PG8_BAR; PG8_SCHED;
            PG8_LDB(B1, 1, 1); PG8_STAGE(PG8_SB(1, 0), b3, voffB);
            PG8_BAR; PG8_WAIT_L(0); PG8_MMA(0, 1, At, B1); PG8_BAR;
            PG8_LDA(At, 1, 1); PG8_STAGE(PG8_SA(1, 0), a3, voffA);
            PG8_BAR; PG8_WAIT_L(0); PG8_MMA(1, 0, At, B0); PG8_BAR; PG8_SCHED;
            PG8_STAGE(PG8_SB(1, 1), b3 + hstep, voffB);
            PG8_WAIT_V(6); PG8_BAR; PG8_MMA(1, 1, At, B1); PG8_BAR;
            }
        }
        if constexpr (ALIGN_EPI) { if (wr == 0) PG8_BAR; }
        if constexpr (!Epi::AFTER_DRAIN) { E(acc, cur, wr, wc, fr, fq); S.done(cur); }
        if (!has_next) break;
#pragma unroll
        for (int a = 0; a < 2; ++a)
#pragma unroll
            for (int b = 0; b < 2; ++b)
#pragma unroll
                for (int m = 0; m < 4; ++m)
#pragma unroll
                    for (int n = 0; n < 2; ++n) acc[a][b][m][n] = (f32x4){0.f, 0.f, 0.f, 0.f};
        cur = nxt; cA = nA; cB = nB; ++ui;
        if constexpr (ALIGN_EPI) { if (wr == 1) PG8_BAR; }
    }
    PG8_WAIT_V(0);
    if constexpr (!ALIGN_EPI) { if (wr == 0) PG8_BAR; }
    PG8_BAR;
    if constexpr (Epi::AFTER_DRAIN) { E.fused(acc, cur, wr, wc, fr, fq, lds, wid, lane); S.done(cur); }
#undef PG8_SA
#undef PG8_SB
#undef PG8_STAGE
#undef PG8_LDA
#undef PG8_LDB
#undef PG8_MMA
#undef PG8_WAIT_V
#undef PG8_WAIT_L
#undef PG8_BAR
#undef PG8_SCHED
}
}

constexpr int NWAVES = 8;
constexpr int DM = 2048, NB = 4, SEQ = 4096, NTOK = NB * SEQ;
constexpr int NMETA = 16, NVALID = NTOK + NMETA, MROWS = 16640;
constexpr int IN_COLS = 5376;
constexpr float LN_EPS = 1e-5f, GN_EPS = 1e-5f;
constexpr float ALPHA = 1.189207115002721f;
constexpr float LOG2E = 1.4426950408889634f;
constexpr float QSCALE = 0.125f * LOG2E;

constexpr size_t MiB = 1u << 20;
constexpr size_t WS_CTL = 0, CTL_ZERO_BYTES = 1 * MiB;
constexpr size_t SZ_SK = (size_t)16 * 128 * 128 * 2, SZ_ROPE_R = (size_t)4112 * 128 * 8, SZ_ROPE_A = (size_t)4112 * 32 * 8;
constexpr size_t SZ_W2T = (size_t)DM * DM * 2, SZ_W1T = (size_t)IN_COLS * DM * 2, SZ_TAB = (size_t)16384 * DM * 2;
constexpr size_t SZ_ROWS2K = (size_t)MROWS * 2048 * 2, SZ_ROWS1K = (size_t)MROWS * 1024 * 2, SZ_ROWS128 = (size_t)MROWS * 128 * 2;
constexpr size_t SZ_TOK2K = (size_t)NTOK * 2048 * 2, SZ_ST = (size_t)16 * 32 * 256 * 256 * 2, SZ_IDS = (size_t)NTOK * 128 * 4;
constexpr size_t al256(size_t x) { return (x + 255) & ~(size_t)255; }
constexpr size_t WS_SK = 1 * MiB;
constexpr size_t WS_ROPE_R = al256(WS_SK + SZ_SK);
constexpr size_t WS_ROPE_A = al256(WS_ROPE_R + SZ_ROPE_R);
constexpr size_t WS_W2T = al256(WS_ROPE_A + SZ_ROPE_A), WS_W3T = al256(WS_W2T + SZ_W2T), WS_W1T = al256(WS_W3T + SZ_W2T);
constexpr size_t WS_UT = al256(WS_W1T + SZ_W1T), WS_VT = al256(WS_UT + SZ_TAB);
constexpr size_t WS_H0 = al256(WS_VT + SZ_TAB);
constexpr size_t WS_QR = al256(WS_H0 + SZ_ROWS2K);
constexpr size_t WS_KA = al256(WS_QR + SZ_ROWS2K), WS_VA = al256(WS_KA + SZ_ROWS128);
constexpr size_t WS_RK = al256(WS_VA + SZ_ROWS128), WS_RV = al256(WS_RK + SZ_ROWS1K), WS_RG = al256(WS_RV + SZ_ROWS1K);
constexpr size_t WS_ST = al256(WS_RG + SZ_ROWS1K);
constexpr size_t WS_Y = WS_RK;
constexpr size_t WS_H1 = WS_ST;
constexpr size_t WS_IDS = al256(WS_ST + SZ_ST), WS_GATES = al256(WS_IDS + SZ_IDS);
constexpr size_t WS_END = al256(WS_GATES + SZ_IDS);
static_assert(WS_Y + SZ_TOK2K <= WS_RG, "Y overlays RK|RV only");
static_assert(SZ_TOK2K <= SZ_ST && (size_t)NTOK * 1024 * 4 <= SZ_ST, "H1 / RET_RAW fit the state region");
static_assert(WS_END <= (size_t)512 * MiB, "workspace map fits 4 x largest tensor");
constexpr int CW_TMO = 0, CW_BAR = 4096;

constexpr int RING_OFF = 0, RING_BYTES = 131072;
constexpr int LDSCTL_OFF = RING_BYTES, MISC_OFF = LDSCTL_OFF + 320;
constexpr int LDS_BYTES = 147456;

#define GAS __attribute__((address_space(1)))
#define LAS __attribute__((address_space(3)))
typedef unsigned short bf16;
typedef unsigned v4u __attribute__((ext_vector_type(4)));
typedef unsigned v2u __attribute__((ext_vector_type(2)));
typedef float f32x4 __attribute__((ext_vector_type(4)));
typedef float f32x2 __attribute__((ext_vector_type(2)));
typedef GAS unsigned gu32;
typedef __bf16 bf16x2_t __attribute__((ext_vector_type(2)));
#define RLX_AGENT __ATOMIC_RELAXED, __HIP_MEMORY_SCOPE_AGENT
#define LDS_WAIT() asm volatile("s_waitcnt lgkmcnt(0)" ::: "memory")
#define VM_WAIT() asm volatile("s_waitcnt vmcnt(0)" ::: "memory")
__device__ __forceinline__ unsigned f2bf(float f) { unsigned u = __builtin_bit_cast(unsigned, f); return (u + 0x7fffu + ((u >> 16) & 1u)) >> 16; }
__device__ __forceinline__ unsigned pk2(float lo, float hi) { return f2bf(lo) | (f2bf(hi) << 16); }
__device__ __forceinline__ float bflo(unsigned w) { return __uint_as_float(w << 16); }
__device__ __forceinline__ float bfhi(unsigned w) { return __uint_as_float(w & 0xffff0000u); }
__device__ __forceinline__ float bf2f(bf16 h) { return __uint_as_float((unsigned)h << 16); }

#define XB_TMO      128
#define XB_XCNT(j)  (256  + 64 * (j))
#define XB_XSUB(j)  (1280 + 64 * (j))
#define XB_XGEN(j)  (2304 + 64 * (j))
#define XB_TOP      3328
#define XB_TOPGEN   3392
#define XCD_BAR_WORDS 3456
#define XB_SPIN_CAP (1u << 18)

__device__ __forceinline__ unsigned xb_ld(unsigned* p)              { return __hip_atomic_load(p, __ATOMIC_RELAXED, __HIP_MEMORY_SCOPE_AGENT); }
__device__ __forceinline__ unsigned xb_add(unsigned* p, unsigned v) { return __hip_atomic_fetch_add(p, v, __ATOMIC_RELAXED, __HIP_MEMORY_SCOPE_AGENT); }
__device__ __forceinline__ unsigned xb_xcc_id() { return (unsigned)__builtin_amdgcn_s_getreg((3 << 11) | 20) & 0xFu; }
#define XB_SPIN(cond, bar) do { unsigned _sp = 0; while (cond) { __builtin_amdgcn_s_sleep(1); \
    if ((++_sp & 255u) == 0u) { if (xb_ld(&(bar)[XB_TMO])) break; if (_sp > XB_SPIN_CAP) { atomicAdd(&(bar)[XB_TMO], 1u); break; } } } } while (0)

struct XcdBarrier {
    unsigned* bar; unsigned x;
    volatile LAS unsigned* st;
};

__device__ __forceinline__ XcdBarrier xcd_barrier_post(unsigned* bar, volatile LAS unsigned* st) {
    XcdBarrier b; b.bar = bar; b.x = xb_xcc_id(); b.st = st;
    if (threadIdx.x == 0) (void)xb_add(&bar[XB_XCNT(b.x)], 1u);
    return b;
}
__device__ __forceinline__ void xcd_barrier_complete(unsigned* bar, unsigned x, unsigned& nloc, unsigned& nx) {
    const unsigned G = gridDim.x * gridDim.y * gridDim.z;
    unsigned sum, cnt, mine, sp = 0u;
    for (;;) {
        sum = 0u; cnt = 0u; mine = 0u;
#pragma unroll
        for (unsigned j = 0; j < 16; ++j) { const unsigned c = xb_ld(&bar[XB_XCNT(j)]); sum += c; cnt += (c > 0u) ? 1u : 0u; mine = (j == x) ? c : mine; }
        if (sum == G) break;
        __builtin_amdgcn_s_sleep(1);
        if ((++sp & 255u) == 0u) { if (xb_ld(&bar[XB_TMO])) break; if (sp > XB_SPIN_CAP) { atomicAdd(&bar[XB_TMO], 1u); break; } }
    }
    nloc = mine > 0u ? mine : 1u; nx = cnt > 0u ? cnt : 1u;
}

__device__ __forceinline__ void xcd_barrier(const XcdBarrier& b) {
    asm volatile("s_waitcnt vmcnt(0)" ::: "memory");
    __syncthreads();
    if (threadIdx.x == 0) {
        unsigned* bar = b.bar;
        __builtin_amdgcn_s_waitcnt(0);
        unsigned nloc = b.st[0], nx = b.st[1];
        if (nloc == 0u) { xcd_barrier_complete(bar, b.x, nloc, nx); b.st[0] = nloc; b.st[1] = nx; }
        const unsigned old = xb_add(&bar[XB_XSUB(b.x)], 1u);
        const unsigned gen = old / nloc;
        if (old + 1u == (gen + 1u) * nloc) {
            __builtin_amdgcn_fence(__ATOMIC_RELEASE, "agent");
            asm volatile("s_waitcnt vmcnt(0)" ::: "memory");
            const unsigned og = xb_add(&bar[XB_TOP], 1u);
            const unsigned tg = og / nx;
            if (og + 1u == (tg + 1u) * nx) xb_add(&bar[XB_TOPGEN], 1u);
            else XB_SPIN(xb_ld(&bar[XB_TOPGEN]) == tg, bar);
            __builtin_amdgcn_fence(__ATOMIC_ACQUIRE, "agent");
            xb_add(&bar[XB_XGEN(b.x)], 1u);
            asm volatile("s_waitcnt vmcnt(0)" ::: "memory");
        } else {
            XB_SPIN(xb_ld(&bar[XB_XGEN(b.x)]) == gen, bar);
            __builtin_amdgcn_fence(__ATOMIC_ACQUIRE, "agent");
            asm volatile("s_waitcnt vmcnt(0)" ::: "memory");
        }
    }
    __syncthreads();
}


__device__ __forceinline__ float dot2bf(unsigned a, unsigned b, float c) { asm("v_dot2c_f32_bf16 %0, %1, %2" : "+v"(c) : "v"(a), "v"(b)); return c; }
__device__ __forceinline__ float wave_sum(float v) {
#pragma unroll
    for (int o = 1; o < 64; o <<= 1) v += __shfl_xor(v, o);
    return v;
}
__device__ __forceinline__ float gelu_erf(float v) {
    const float av = fabsf(v), d = av * 0.2316418882f + 1.0f;
    const float t = __builtin_amdgcn_rcpf(d);
    float q = t * 0.5307027145f + (-0.7265760135f); q = q * t + 0.7107068705f; q = q * t + (-0.142248368f); q = q * t + 0.127414796f; q = q * t;
    const float e = __builtin_amdgcn_exp2f((v * v) * (-0.72134752044f));
    const float m = v * (q * e);
    return v < 0.f ? m : v - m;
}

struct Args { const float* in[15]; float* out; unsigned char* ws; };

__device__ __forceinline__ void p0_transpose_item(const float* W, int K, int N, bf16* WT, LAS float* scr, int item, int lane) {
    const int nblk = N / 32, kb = item / nblk, nb = item % nblk, k0 = 64 * kb, n0 = 32 * nb;
#pragma unroll 8
    for (int i = 0; i < 32; ++i) { const int kk = 2 * i + (lane >> 5); scr[kk * 33 + (lane & 31)] = W[(size_t)(k0 + kk) * N + n0 + (lane & 31)]; }
    LDS_WAIT(); asm volatile("" ::: "memory");
    const int c = lane & 7;
#pragma unroll
    for (int j = 0; j < 4; ++j) { const int n = (lane >> 3) + 8 * j; const LAS float* s = scr + (8 * c) * 33 + n;
        v4u o; o.x = pk2(s[0 * 33], s[1 * 33]); o.y = pk2(s[2 * 33], s[3 * 33]); o.z = pk2(s[4 * 33], s[5 * 33]); o.w = pk2(s[6 * 33], s[7 * 33]);
        *(GAS v4u*)(WT + (size_t)(n0 + n) * K + k0 + 8 * c) = o; }
    LDS_WAIT(); asm volatile("" ::: "memory");
}
__device__ __forceinline__ void ln_row_f32_to_bf16(const float* xrow, const float* g, const float* bta, bf16* orow, int lane) {
    const GAS f32x4* xr = (const GAS f32x4*)xrow + lane;
    f32x4 v[8]; float s = 0.f;
#pragma unroll
    for (int j = 0; j < 8; ++j) { v[j] = xr[64 * j]; s += (v[j].x + v[j].y) + (v[j].z + v[j].w); }
    const float mean = wave_sum(s) * (1.f / DM); float s2 = 0.f;
#pragma unroll
    for (int j = 0; j < 8; ++j) { v[j] = v[j] - mean; s2 += (v[j].x * v[j].x + v[j].y * v[j].y) + (v[j].z * v[j].z + v[j].w * v[j].w); }
    const float rstd = 1.f / sqrtf(wave_sum(s2) * (1.f / DM) + LN_EPS);
    GAS v2u* o8 = (GAS v2u*)orow + lane;
#pragma unroll
    for (int j = 0; j < 8; ++j) { const f32x4 gg = ((const GAS f32x4*)g)[lane + 64 * j], bb = ((const GAS f32x4*)bta)[lane + 64 * j];
        v2u o; o.x = pk2(v[j].x * rstd * gg.x + bb.x, v[j].y * rstd * gg.y + bb.y); o.y = pk2(v[j].z * rstd * gg.z + bb.z, v[j].w * rstd * gg.w + bb.w); o8[64 * j] = o; }
}
__device__ __forceinline__ void ln_row_bf16_to_bf16(const bf16* xrow, const float* g, const float* bta, bf16* orow, int lane) {
    const GAS v4u* xr = (const GAS v4u*)xrow + lane;
    float v[32]; float s = 0.f;
#pragma unroll
    for (int j = 0; j < 4; ++j) { const v4u w = xr[64 * j];
        v[8 * j + 0] = bflo(w.x); v[8 * j + 1] = bfhi(w.x); v[8 * j + 2] = bflo(w.y); v[8 * j + 3] = bfhi(w.y);
        v[8 * j + 4] = bflo(w.z); v[8 * j + 5] = bfhi(w.z); v[8 * j + 6] = bflo(w.w); v[8 * j + 7] = bfhi(w.w); }
#pragma unroll
    for (int i = 0; i < 32; ++i) s += v[i];
    const float mean = wave_sum(s) * (1.f / DM); float s2 = 0.f;
#pragma unroll
    for (int i = 0; i < 32; ++i) { v[i] -= mean; s2 += v[i] * v[i]; }
    const float rstd = 1.f / sqrtf(wave_sum(s2) * (1.f / DM) + LN_EPS);
    GAS v4u* o16 = (GAS v4u*)orow + lane;
#pragma unroll
    for (int j = 0; j < 4; ++j) {
        const GAS f32x4* gp = (const GAS f32x4*)g + 2 * (lane + 64 * j); const GAS f32x4* bp = (const GAS f32x4*)bta + 2 * (lane + 64 * j);
        const f32x4 g0 = gp[0], g1 = gp[1], b0 = bp[0], b1 = bp[1];
        v4u o; o.x = pk2(v[8 * j + 0] * rstd * g0.x + b0.x, v[8 * j + 1] * rstd * g0.y + b0.y); o.y = pk2(v[8 * j + 2] * rstd * g0.z + b0.z, v[8 * j + 3] * rstd * g0.w + b0.w);
        o.z = pk2(v[8 * j + 4] * rstd * g1.x + b1.x, v[8 * j + 5] * rstd * g1.y + b1.y); o.w = pk2(v[8 * j + 6] * rstd * g1.z + b1.z, v[8 * j + 7] * rstd * g1.w + b1.w);
        o16[64 * j] = o; }
}
__device__ __forceinline__ void row_pos(int r, int& pos, int& ipos) {
    if (r < NTOK) { const int s = r & (SEQ - 1); pos = NMETA + s; ipos = s & 127; }
    else { int j = r - NTOK; if (j > NMETA - 1) j = NMETA - 1; pos = j; ipos = 112 + j; }
}
__device__ __forceinline__ float log2_gamma(int h) { return log2f(1.0f - exp2f(-5.0f - (float)h)); }


typedef short bf16x8 __attribute__((ext_vector_type(8)));
typedef short s16x4 __attribute__((ext_vector_type(4)));
#define MFMA16(a, b, c) __builtin_amdgcn_mfma_f32_16x16x32_bf16((a), (b), (c), 0, 0, 0)
__device__ __forceinline__ s16x4 tr16(LAS const unsigned char* p) { return __builtin_bit_cast(s16x4, __builtin_amdgcn_ds_read_tr16_b64_v4i16((LAS s16x4*)p)); }
__device__ __forceinline__ bf16x8 cat8(s16x4 a, s16x4 b) { return __builtin_shufflevector(a, b, 0, 1, 2, 3, 4, 5, 6, 7); }
__device__ __forceinline__ unsigned cvtpk_s(float lo, float hi) { f32x2 v = {lo, hi}; bf16x2_t b = __builtin_convertvector(v, bf16x2_t); return __builtin_bit_cast(unsigned, b); }
__device__ __forceinline__ unsigned cvtpk(float lo, float hi) { unsigned r; asm("v_cvt_pk_bf16_f32 %0, %1, %2" : "=v"(r) : "v"(lo), "v"(hi)); return r; }

__device__ __forceinline__ void scan_unit(LAS unsigned char* L, int u, const bf16* RK, const bf16* RV, bf16* ST, int tid, int lane, int wave) {
    asm volatile("" : "+v"(tid)); lane = tid & 63;
    const int bh = u >> 4, di = (u >> 2) & 3, ei = u & 3, b = bh >> 2, h = bh & 3;
    const float g128 = exp2f(128.0f * log2_gamma(h));
    const int li = lane & 15, g = lane >> 4, q = li >> 2, p4 = li & 3;
    const int eb = wave >> 1, db0 = 2 * (wave & 1);
    f32x4 acc[2]; acc[0] = (f32x4){0.f, 0.f, 0.f, 0.f}; acc[1] = acc[0];
    v4u kreg[2], vreg[2];
#define SCAN_LOAD(cc) do { _Pragma("unroll") for (int i_ = 0; i_ < 2; ++i_) { const int cid_ = tid + 512 * i_, row_ = cid_ >> 3, c16_ = cid_ & 7; \
        int srow_; bool ok_ = true; if ((cc) < 0) { ok_ = row_ >= 112; srow_ = NTOK + (ok_ ? row_ - 112 : 0); } else srow_ = b * SEQ + (cc) * 128 + row_; \
        const v4u kz_ = *(const GAS v4u*)(RK + (size_t)srow_ * 1024 + h * 256 + di * 64 + c16_ * 8), vz_ = *(const GAS v4u*)(RV + (size_t)srow_ * 1024 + h * 256 + ei * 64 + c16_ * 8); \
        kreg[i_] = ok_ ? kz_ : (v4u){0u, 0u, 0u, 0u}; vreg[i_] = ok_ ? vz_ : (v4u){0u, 0u, 0u, 0u}; } } while (0)
#define SCAN_WRITE(bufp) do { _Pragma("unroll") for (int i_ = 0; i_ < 2; ++i_) { const int cid_ = tid + 512 * i_, row_ = cid_ >> 3, c16_ = cid_ & 7; \
        *(LAS v4u*)((bufp) + row_ * 128 + c16_ * 16) = kreg[i_]; *(LAS v4u*)((bufp) + 16384 + row_ * 128 + c16_ * 16) = vreg[i_]; } } while (0)
    SCAN_LOAD(-1); SCAN_WRITE(L); __syncthreads();
    int cur = 0;
    for (int cc = -1; cc <= 30; ++cc) {
        if (cc < 30) SCAN_LOAD(cc + 1);
        LAS const unsigned char* Kt = L + cur * 32768; LAS const unsigned char* Vt = Kt + 16384;
#pragma unroll
        for (int ks = 0; ks < 4; ++ks) {
            const int r0 = (32 * ks + 8 * g + q) * 128;
            const bf16x8 a = cat8(tr16(Vt + r0 + (16 * eb + 4 * p4) * 2), tr16(Vt + r0 + 512 + (16 * eb + 4 * p4) * 2));
#pragma unroll
            for (int n = 0; n < 2; ++n) {
                const bf16x8 bb = cat8(tr16(Kt + r0 + (16 * (db0 + n) + 4 * p4) * 2), tr16(Kt + r0 + 512 + (16 * (db0 + n) + 4 * p4) * 2));
                acc[n] = MFMA16(a, bb, acc[n]);
            }
        }
#pragma unroll
        for (int n = 0; n < 2; ++n) {
            acc[n] = acc[n] * g128;
            bf16* sp = ST + ((size_t)(bh * 32 + cc + 1) * 256 + (64 * ei + 16 * eb + 4 * g)) * 256 + 64 * di + 16 * (db0 + n) + li;
#pragma unroll
            for (int r = 0; r < 4; ++r) sp[(size_t)r * 256] = (bf16)f2bf(acc[n][r]);
        }
        if (cc < 30) SCAN_WRITE(L + (cur ^ 1) * 32768);
        __syncthreads(); cur ^= 1;
    }
#undef SCAN_LOAD
#undef SCAN_WRITE
}

__device__ __forceinline__ void retout_unit(LAS unsigned char* L, int u, bf16* QR, const bf16* RK, const bf16* RV, const bf16* RG, const bf16* ST, int tid, int lane, int wave) {
    asm volatile("" : "+v"(tid)); lane = tid & 63;
    const int bh = u >> 5, c = u & 31, b = bh >> 2, h = bh & 3;
    const int R0 = b * SEQ + c * 128;
    const int li = lane & 15, g = lane >> 4, q = li >> 2, p4 = li & 3;
    LAS unsigned char* RA = L; LAS unsigned char* RB = L + 65536;
#pragma unroll
    for (int i = 0; i < 8; ++i) { const int cid = tid + 512 * i, j = cid >> 5, ch = cid & 31;
        const v4u kz = *(const GAS v4u*)(RK + (size_t)(R0 + j) * 1024 + h * 256 + ch * 8), vz = *(const GAS v4u*)(RV + (size_t)(R0 + j) * 1024 + h * 256 + ch * 8);
        *(LAS v4u*)(RA + j * 512 + ((ch ^ (j & 15)) << 4)) = kz; *(LAS v4u*)(RB + j * 512 + ((ch ^ ((j & 7) << 1)) << 4)) = vz; }
    bf16x8 qf[8];
    { const GAS v4u* qp = (const GAS v4u*)(QR + (size_t)(R0 + 16 * wave + li) * 2048 + 1024 + h * 256 + 8 * g);
#pragma unroll
      for (int ks = 0; ks < 8; ++ks) qf[ks] = __builtin_bit_cast(bf16x8, qp[4 * ks]); }
    __syncthreads();
    f32x4 st[8];
#pragma unroll
    for (int jt = 0; jt < 8; ++jt) st[jt] = (f32x4){0.f, 0.f, 0.f, 0.f};
#pragma unroll
    for (int jt = 0; jt < 8; ++jt) if (jt <= wave) {
        const int j = 16 * jt + li;
#pragma unroll
        for (int ks = 0; ks < 8; ++ks) { const bf16x8 a = *(LAS const bf16x8*)(RA + j * 512 + (((4 * ks + g) ^ li) << 4)); st[jt] = MFMA16(a, qf[ks], st[jt]); }
        if (jt == wave) {
#pragma unroll
            for (int r = 0; r < 4; ++r) if (4 * g + r > li) st[jt][r] = 0.f; }
    }
    bf16x8 pf[4];
#pragma unroll
    for (int s = 0; s < 4; ++s) { v4u w; w.x = cvtpk_s(st[2 * s][0], st[2 * s][1]); w.y = cvtpk_s(st[2 * s][2], st[2 * s][3]); w.z = cvtpk_s(st[2 * s + 1][0], st[2 * s + 1][1]); w.w = cvtpk_s(st[2 * s + 1][2], st[2 * s + 1][3]); pf[s] = __builtin_bit_cast(bf16x8, w); }
    __syncthreads();
    const bf16* Sg = ST + (size_t)(bh * 32 + c) * 65536;
#define RO_STAGE_ST(dst, s0) do { _Pragma("unroll") for (int i_ = 0; i_ < 8; ++i_) { const int cid_ = tid + 512 * i_, sl_ = cid_ >> 11, e_ = (cid_ >> 3) & 255, ch_ = cid_ & 7; \
        const v4u z_ = *(const GAS v4u*)(Sg + (size_t)e_ * 256 + 64 * ((s0) + sl_) + ch_ * 8); *(LAS v4u*)((dst) + sl_ * 32768 + e_ * 128 + ((ch_ ^ (e_ & 7)) << 4)) = z_; } } while (0)
    RO_STAGE_ST(RA, 0);
    f32x4 o[16];
#pragma unroll
    for (int et = 0; et < 16; ++et) o[et] = (f32x4){0.f, 0.f, 0.f, 0.f};
#pragma unroll
    for (int s = 0; s < 4; ++s) if (2 * s <= wave) {
        const int r1 = 32 * s + 4 * g + q, r2 = r1 + 16;
#pragma unroll
        for (int et = 0; et < 16; ++et) {
            const int chn = 2 * et + (p4 >> 1);
            const bf16x8 a = cat8(tr16(RB + r1 * 512 + ((chn ^ ((r1 & 7) << 1)) << 4) + (p4 & 1) * 8), tr16(RB + r2 * 512 + ((chn ^ ((r2 & 7) << 1)) << 4) + (p4 & 1) * 8));
            o[et] = MFMA16(a, pf[s], o[et]);
        }
    }
    __syncthreads();
    RO_STAGE_ST(RB, 2);
#define RO_STATE_MMA(src, s0) do { _Pragma("unroll") for (int sl_ = 0; sl_ < 2; ++sl_) _Pragma("unroll") for (int k2_ = 0; k2_ < 2; ++k2_) _Pragma("unroll") for (int et = 0; et < 16; ++et) { \
        const int e_ = 16 * et + li; const bf16x8 a_ = *(LAS const bf16x8*)((src) + sl_ * 32768 + e_ * 128 + (((4 * k2_ + g) ^ (e_ & 7)) << 4)); \
        o[et] = MFMA16(a_, qf[2 * ((s0) + sl_) + k2_], o[et]); } } while (0)
    RO_STATE_MMA(RA, 0);
    __syncthreads();
    RO_STATE_MMA(RB, 2);
#undef RO_STAGE_ST
#undef RO_STATE_MMA
    float s1 = 0.f;
#pragma unroll
    for (int et = 0; et < 16; ++et) s1 += (o[et][0] + o[et][1]) + (o[et][2] + o[et][3]);
    s1 += __shfl_xor(s1, 16); s1 += __shfl_xor(s1, 32);
    const float mu = s1 * (1.0f / 256.0f); float s2 = 0.f;
#pragma unroll
    for (int et = 0; et < 16; ++et) { o[et] = o[et] - mu; s2 += (o[et][0] * o[et][0] + o[et][1] * o[et][1]) + (o[et][2] * o[et][2] + o[et][3] * o[et][3]); }
    s2 += __shfl_xor(s2, 16); s2 += __shfl_xor(s2, 32);
    const float rstd = 1.0f / sqrtf(s2 * (1.0f / 256.0f) + GN_EPS);
    const int row = R0 + 16 * wave + li;
    const GAS v2u* gp = (const GAS v2u*)(RG + (size_t)row * 1024 + h * 256 + 4 * g); GAS v2u* op = (GAS v2u*)(QR + (size_t)row * 2048 + 1024 + h * 256 + 4 * g);
#pragma unroll
    for (int et = 0; et < 16; ++et) { const v2u gz = gp[4 * et]; v2u w;
        w.x = cvtpk(o[et][0] * rstd * bflo(gz.x), o[et][1] * rstd * bfhi(gz.x)); w.y = cvtpk(o[et][2] * rstd * bflo(gz.y), o[et][3] * rstd * bfhi(gz.y)); op[4 * et] = w; }
    __syncthreads();
}

typedef float f32x16 __attribute__((ext_vector_type(16)));
#define MFMA32(a, b, c) __builtin_amdgcn_mfma_f32_32x32x16_bf16((a), (b), (c), 0, 0, 0)
__device__ __forceinline__ int crow32(int reg, int hh) { return (reg & 3) + 8 * (reg >> 2) + 4 * hh; }

__device__ __forceinline__ void attn_unit(LAS unsigned char* L, int u, bf16* QR, const bf16* KA, const bf16* VA, const float* sinks, int tid, int lane, int wave) {
    asm volatile("" : "+v"(tid)); lane = tid & 63;
    const int b = u >> 6, j = (u >> 1) & 31, g2 = u & 1, hq = 8 * g2 + wave;
    const int R0 = b * SEQ + 128 * j;
    LAS unsigned char* Kt = L; LAS unsigned char* Vt = L + 32768;
#pragma unroll
    for (int i = 0; i < 4; ++i) { const int cid = tid + 512 * i, kk = cid >> 3, ch = cid & 7;
        int srow; bool ok = true;
        if (kk >= 128) srow = R0 + kk - 128; else if (j > 0) srow = R0 - 128 + kk; else { ok = kk >= 112; srow = NTOK + (ok ? kk - 112 : 0); }
        const v4u kz = *(const GAS v4u*)(KA + (size_t)srow * 128 + g2 * 64 + ch * 8), vz = *(const GAS v4u*)(VA + (size_t)srow * 128 + g2 * 64 + ch * 8);
        *(LAS v4u*)(Kt + kk * 128 + ((ch ^ (kk & 7)) << 4)) = ok ? kz : (v4u){0u, 0u, 0u, 0u};
        *(LAS v4u*)(Vt + kk * 128 + (ch << 4)) = ok ? vz : (v4u){0u, 0u, 0u, 0u}; }
    __syncthreads();
    const int r = lane & 31, hh = lane >> 5, blk = (lane >> 4) & 1, q = (lane & 15) >> 2, p4 = lane & 3;
    const float sk = sinks[hq] * LOG2E;
#pragma unroll 1
    for (int t = 0; t < 4; ++t) {
        const int i0 = 32 * t;
        bf16x8 qf[4];
        { const GAS v4u* qp = (const GAS v4u*)(QR + (size_t)(R0 + i0 + r) * 2048 + hq * 64 + 8 * hh);
#pragma unroll
          for (int ks = 0; ks < 4; ++ks) qf[ks] = __builtin_bit_cast(bf16x8, qp[2 * ks]); }
        f32x16 s[5];
#pragma unroll
        for (int x = 0; x < 5; ++x) {
            const int krow_ = 32 * (t + x) + r;
            f32x16 acc;
#pragma unroll
            for (int e = 0; e < 16; ++e) acc[e] = 0.f;
#pragma unroll
            for (int ks = 0; ks < 4; ++ks) { const bf16x8 a = *(LAS const bf16x8*)(Kt + krow_ * 128 + (((2 * ks + hh) ^ (krow_ & 7)) << 4)); acc = MFMA32(a, qf[ks], acc); }
            s[x] = acc; __builtin_amdgcn_sched_barrier(0);
        }
        float m = sk;
#pragma unroll
        for (int e = 0; e < 16; ++e) { const int cr = crow32(e, hh);
            if (!(cr > r)) s[0][e] = -1.0e30f;
            if (!(cr <= r)) s[4][e] = -1.0e30f; }
        if (j == 0) {
#pragma unroll
            for (int x = 0; x < 4; ++x) if (t + x <= 3) {
#pragma unroll
                for (int e = 0; e < 16; ++e) if (32 * (t + x) + crow32(e, hh) < 112) s[x][e] = -1.0e30f; }
        }
#pragma unroll
        for (int x = 0; x < 5; ++x)
#pragma unroll
            for (int e = 0; e < 16; ++e) m = fmaxf(m, s[x][e]);
        m = fmaxf(m, __shfl_xor(m, 32));
        float l = 0.f;
#pragma unroll
        for (int x = 0; x < 5; ++x)
#pragma unroll
            for (int e = 0; e < 16; ++e) { const float pv = exp2f(s[x][e] - m); s[x][e] = pv; l += pv; }
        l += __shfl_xor(l, 32);
        l += exp2f(sk - m);
        f32x16 o[2];
#pragma unroll
        for (int e = 0; e < 16; ++e) { o[0][e] = 0.f; o[1][e] = 0.f; }
#pragma unroll
        for (int x = 0; x < 5; ++x)
#pragma unroll
            for (int st = 0; st < 2; ++st) {
                v4u w; w.x = cvtpk_s(s[x][8 * st + 0], s[x][8 * st + 1]); w.y = cvtpk_s(s[x][8 * st + 2], s[x][8 * st + 3]); w.z = cvtpk_s(s[x][8 * st + 4], s[x][8 * st + 5]); w.w = cvtpk_s(s[x][8 * st + 6], s[x][8 * st + 7]);
                const bf16x8 pb = __builtin_bit_cast(bf16x8, w);
                const int k1 = 32 * (t + x) + 16 * st + 4 * hh + q, k2 = k1 + 8;
#pragma unroll
                for (int dc = 0; dc < 2; ++dc) {
                    const int cb = ((4 * dc + 2 * blk + (p4 >> 1)) << 4) + 8 * (p4 & 1);
                    const bf16x8 a = cat8(tr16(Vt + k1 * 128 + cb), tr16(Vt + k2 * 128 + cb));
                    o[dc] = MFMA32(a, pb, o[dc]);
                }
                __builtin_amdgcn_sched_barrier(0);
            }
        const float il = 1.0f / l;
        GAS v2u* op = (GAS v2u*)(QR + (size_t)(R0 + i0 + r) * 2048 + hq * 64 + 4 * hh);
#pragma unroll
        for (int dc = 0; dc < 2; ++dc)
#pragma unroll
            for (int g4 = 0; g4 < 4; ++g4) { v2u w; w.x = cvtpk_s(o[dc][4 * g4 + 0] * il, o[dc][4 * g4 + 1] * il); w.y = cvtpk_s(o[dc][4 * g4 + 2] * il, o[dc][4 * g4 + 3] * il); op[8 * dc + 2 * g4] = w; }
    }
    __syncthreads();
}

__device__ __forceinline__ unsigned ord_key(float f) { const unsigned u = __float_as_uint(f); return u ^ ((unsigned)((int)u >> 31) | 0x80000000u); }
__device__ __forceinline__ float ord_val(unsigned k) { return __uint_as_float(k ^ (((int)k < 0) ? 0x80000000u : 0xffffffffu)); }
#define TK_INS(arr, val) do { unsigned v_ = (val); _Pragma("unroll") for (int j_ = 0; j_ < 16; ++j_) { const unsigned hi_ = arr[j_] > v_ ? arr[j_] : v_; v_ = arr[j_] > v_ ? v_ : arr[j_]; arr[j_] = hi_; } } while (0)
__device__ __forceinline__ void topk_unit(LAS unsigned* Lw, int tt, int hd, const bf16* Q3, const bf16* SKB, int* IDS, float* GATES, int lane) {
    asm volatile("" : "+v"(lane));
    const int r = lane & 31, hh = lane >> 5, t0 = tt * 32;
    float sv[2][16];
#pragma unroll
    for (int p = 0; p < 2; ++p) {
        f32x16 acc[4];
#pragma unroll
        for (int nt = 0; nt < 4; ++nt)
#pragma unroll
            for (int e = 0; e < 16; ++e) acc[nt][e] = 0.f;
        const GAS v4u* qp = (const GAS v4u*)(Q3 + (size_t)(t0 + r) * DM + hd * 256 + p * 128 + 8 * hh);
        const GAS v4u* kp = (const GAS v4u*)(SKB + ((size_t)((hd * 2 + p) * 128 + r)) * 128 + 8 * hh);
#pragma unroll 2
        for (int ks = 0; ks < 8; ++ks) { const bf16x8 bq = __builtin_bit_cast(bf16x8, qp[2 * ks]);
#pragma unroll
            for (int nt = 0; nt < 4; ++nt) { const bf16x8 a = __builtin_bit_cast(bf16x8, kp[nt * 32 * 16 + 2 * ks]); acc[nt] = MFMA32(a, bq, acc[nt]); } }
        unsigned tk[16];
#pragma unroll
        for (int j2 = 0; j2 < 16; ++j2) tk[j2] = 0u;
#pragma unroll
        for (int nt = 0; nt < 4; ++nt)
#pragma unroll
            for (int e = 0; e < 16; ++e) { const int n = 32 * nt + crow32(e, hh); TK_INS(tk, (ord_key(acc[nt][e]) & 0xffffff80u) | (unsigned)(127 - n)); }
        unsigned pk[16];
#pragma unroll
        for (int j2 = 0; j2 < 16; ++j2) pk[j2] = (unsigned)__shfl_xor((int)tk[j2], 32);
#pragma unroll
        for (int j2 = 0; j2 < 16; ++j2) TK_INS(tk, pk[j2]);
#pragma unroll
        for (int j2 = 0; j2 < 16; ++j2) { sv[p][j2] = ord_val(tk[j2] & 0xffffff80u); Lw[(p * 16 + j2) * 64 + lane] = 127u - (tk[j2] & 0x7fu); }
    }
    unsigned fk[16];
#pragma unroll
    for (int j2 = 0; j2 < 16; ++j2) fk[j2] = 0u;
#pragma unroll
    for (int i = 0; i < 16; ++i)
#pragma unroll
        for (int j2 = 0; j2 < 16; ++j2) if ((i + 1) * (j2 + 1) <= 16) TK_INS(fk, (ord_key(sv[0][i] + sv[1][j2]) & 0xffffff00u) | (unsigned)(255 - (16 * i + j2)));
    float ev[16]; int idv[16]; float den = 0.f; const float f0 = ord_val(fk[0] & 0xffffff00u);
    LDS_WAIT();
#pragma unroll
    for (int k = 0; k < 16; ++k) { const unsigned idx = 255u - (fk[k] & 0xffu); const unsigned i1 = Lw[(idx >> 4) * 64 + lane], i2 = Lw[(16 + (idx & 15u)) * 64 + lane];
        idv[k] = (int)(i1 * 128u + i2); ev[k] = __expf(ord_val(fk[k] & 0xffffff00u) - f0); den += ev[k]; }
    const float iden = 1.0f / den;
    if (hh == 0) {
        GAS v4u* ip = (GAS v4u*)(IDS + (size_t)(t0 + r) * 128 + hd * 16); GAS f32x4* gp = (GAS f32x4*)(GATES + (size_t)(t0 + r) * 128 + hd * 16);
#pragma unroll
        for (int k4 = 0; k4 < 4; ++k4) { ip[k4] = (v4u){(unsigned)idv[4 * k4], (unsigned)idv[4 * k4 + 1], (unsigned)idv[4 * k4 + 2], (unsigned)idv[4 * k4 + 3]};
            gp[k4] = (f32x4){ev[4 * k4] * iden, ev[4 * k4 + 1] * iden, ev[4 * k4 + 2] * iden, ev[4 * k4 + 3] * iden}; }
    }
    LDS_WAIT();
}

__global__ void __launch_bounds__(NWAVES * 64, 2) mk_fwd(Args args) {
    extern __shared__ __attribute__((aligned(16))) unsigned char lds[];
    LAS unsigned char* L = (LAS unsigned char*)lds;
    volatile LAS unsigned* MISC = (volatile LAS unsigned*)(L + MISC_OFF);
    const int tid = threadIdx.x, lane = tid & 63, wave = __builtin_amdgcn_readfirstlane(tid >> 6);
    const int G = gridDim.x, bx = blockIdx.x;
    const int vcu = (G % 8 == 0) ? (bx % 8) * (G / 8) + bx / 8 : bx;
    unsigned char* ws = args.ws;
    gu32* ctl = (gu32*)(ws + WS_CTL);
    const float* x = args.in[0]; const float* meta = args.in[1]; const float* ln_in_g = args.in[2]; const float* ln_in_b = args.in[3];
    const float* w_in = args.in[4]; const float* sinks = args.in[5]; const float* w_out = args.in[6]; const float* ln_mix_g = args.in[7]; const float* ln_mix_b = args.in[8];
    const float* wq = args.in[9]; const float* subkeys = args.in[10]; const float* u_tab = args.in[11]; const float* v_tab = args.in[12];
    const float* ln_ffn_g = args.in[13]; const float* ln_ffn_b = args.in[14];
    float* out = args.out;
    bf16* W1T = (bf16*)(ws + WS_W1T); bf16* W2T = (bf16*)(ws + WS_W2T); bf16* W3T = (bf16*)(ws + WS_W3T);
    bf16* H0 = (bf16*)(ws + WS_H0); bf16* QR = (bf16*)(ws + WS_QR); bf16* KA = (bf16*)(ws + WS_KA); bf16* VA = (bf16*)(ws + WS_VA);
    bf16* RK = (bf16*)(ws + WS_RK); bf16* RV = (bf16*)(ws + WS_RV); bf16* RG = (bf16*)(ws + WS_RG);
    bf16* Y = (bf16*)(ws + WS_Y); bf16* H1 = (bf16*)(ws + WS_H1); bf16* Q3 = (bf16*)(ws + WS_QR);
    bf16* STB = (bf16*)(ws + WS_ST);
    f32x2* ROPE_R = (f32x2*)(ws + WS_ROPE_R); f32x2* ROPE_A = (f32x2*)(ws + WS_ROPE_A);
    int* IDS = (int*)(ws + WS_IDS); float* GATES = (float*)(ws + WS_GATES);
    bf16* SKB = (bf16*)(ws + WS_SK);
    bf16* UT = (bf16*)(ws + WS_UT); bf16* VT = (bf16*)(ws + WS_VT);

    for (int u = tid; u < (LDS_BYTES - LDSCTL_OFF) / 4; u += NWAVES * 64) ((LAS unsigned*)(L + LDSCTL_OFF))[u] = 0u;
    __syncthreads();
    XcdBarrier bar = xcd_barrier_post((unsigned*)(ctl + CW_BAR), MISC + 8);
#define GRID_BAR() xcd_barrier(bar)
    const int gw = vcu * NWAVES + wave, NGW = G * NWAVES;
    const int gt = gw * 64 + lane, NGT = NGW * 64;

    {
        LAS float* scr = (LAS float*)(L + RING_OFF + wave * 16384);
        constexpr int I_1 = (DM / 64) * (IN_COLS / 32), I_2 = (DM / 64) * (DM / 32), I_3 = I_2;
        for (int it = gw; it < I_1 + I_2 + I_3; it += NGW) {
            int r = it;
            if (r < I_1) { p0_transpose_item(w_in, DM, IN_COLS, W1T, scr, r, lane); continue; } r -= I_1;
            if (r < I_2) { p0_transpose_item(w_out, DM, DM, W2T, scr, r, lane); continue; } r -= I_2;
            p0_transpose_item(wq, DM, DM, W3T, scr, r, lane);
        }
        for (int m = gw; m < MROWS; m += NGW) {
            if (m < NTOK) ln_row_f32_to_bf16(x + (size_t)m * DM, ln_in_g, ln_in_b, H0 + (size_t)m * DM, lane);
            else if (m < NVALID) ln_row_f32_to_bf16(meta + (size_t)(m - NTOK) * DM, ln_in_g, ln_in_b, H0 + (size_t)m * DM, lane);
            else { GAS v4u* o = (GAS v4u*)(H0 + (size_t)m * DM) + lane;
#pragma unroll
                for (int j = 0; j < 4; ++j) o[64 * j] = (v4u){0u, 0u, 0u, 0u}; }
        }
        for (int e = gt; e < 2 * (16384 * DM / 8); e += NGT) {
            const int which = e >= (16384 * DM / 8); const int i8 = which ? e - (16384 * DM / 8) : e;
            const GAS f32x4* src = (const GAS f32x4*)(which ? v_tab : u_tab) + 2 * (size_t)i8; const f32x4 a = src[0], b = src[1];
            v4u o; o.x = pk2(a.x, a.y); o.y = pk2(a.z, a.w); o.z = pk2(b.x, b.y); o.w = pk2(b.z, b.w);
            ((GAS v4u*)(which ? VT : UT))[i8] = o; }
        for (int e = gt; e < 16 * 128 * 128 / 8; e += NGT) { const GAS f32x4* src = (const GAS f32x4*)subkeys + 2 * (size_t)e; const f32x4 a = src[0], b2 = src[1];
            v4u o; o.x = pk2(a.x, a.y); o.y = pk2(a.z, a.w); o.z = pk2(b2.x, b2.y); o.w = pk2(b2.z, b2.w); ((GAS v4u*)SKB)[e] = o; }
        for (int e = gt; e < 4112 * 128; e += NGT) { const int pos = e >> 7, i = e & 127; const float inv = powf(10000.0f, -(float)(2 * i) / 256.0f); float sn, cs; sincosf((float)pos * inv, &sn, &cs); ROPE_R[e] = (f32x2){cs, sn}; }
        for (int e = gt; e < 4112 * 32; e += NGT) { const int pos = e >> 5, i = e & 31; const float inv = powf(10000.0f, -(float)(2 * i) / 64.0f); float sn, cs; sincosf((float)pos * inv, &sn, &cs); ROPE_A[e] = (f32x2){cs, sn}; }
    }
    GRID_BAR();

    {
        pg8::Gemm g{H0, W1T, MROWS, IN_COLS, DM}; pg8::StaticOrder S; S.init(MROWS, IN_COLS, G, bx);
        pg8::EpiGen<0> E{nullptr, 0, nullptr, 0.f, QR, KA, VA, RK, RV, RG};
        pg8::gemm_phase<pg8::EpiGen<0>, pg8::StaticOrder, true, true>(L + RING_OFF, g, S, E);
    }
    GRID_BAR();

    for (int r = gw; r < NVALID; r += NGW) {
        int pos, ipos; row_pos(r, pos, ipos);
        bf16* qr = QR + (size_t)r * 2048; bf16* ka = KA + (size_t)r * 128; bf16* rk = RK + (size_t)r * 1024; bf16* rg = RG + (size_t)r * 1024;
        for (int idx = lane; idx < 512; idx += 64) { const int a = idx >> 5, i = idx & 31; const f32x2 cs = ROPE_A[pos * 32 + i];
            const float x1 = bf2f(qr[64 * a + i]), x2 = bf2f(qr[64 * a + 32 + i]);
            qr[64 * a + i] = (bf16)f2bf((x1 * cs.x - x2 * cs.y) * QSCALE); qr[64 * a + 32 + i] = (bf16)f2bf((x2 * cs.x + x1 * cs.y) * QSCALE); }
        { const int a = lane >> 5, i = lane & 31; const f32x2 cs = ROPE_A[pos * 32 + i];
            const float x1 = bf2f(ka[64 * a + i]), x2 = bf2f(ka[64 * a + 32 + i]);
            ka[64 * a + i] = (bf16)f2bf(x1 * cs.x - x2 * cs.y); ka[64 * a + 32 + i] = (bf16)f2bf(x2 * cs.x + x1 * cs.y); }
        for (int idx = lane; idx < 512; idx += 64) { const int h = idx >> 7, i = idx & 127; const f32x2 cs = ROPE_R[pos * 128 + i];
            const float lg = log2_gamma(h); const float qs = exp2f((float)(ipos + 1) * lg), ks = 0.0625f * exp2f(-(float)(ipos + 1) * lg);
            { const float x1 = bf2f(qr[1024 + 256 * h + i]), x2 = bf2f(qr[1024 + 256 * h + 128 + i]);
              qr[1024 + 256 * h + i] = (bf16)f2bf((x1 * cs.x - x2 * cs.y) * qs); qr[1024 + 256 * h + 128 + i] = (bf16)f2bf((x2 * cs.x + x1 * cs.y) * qs); }
            { const float x1 = bf2f(rk[256 * h + i]), x2 = bf2f(rk[256 * h + 128 + i]);
              rk[256 * h + i] = (bf16)f2bf((x1 * cs.x - x2 * cs.y) * ks); rk[256 * h + 128 + i] = (bf16)f2bf((x2 * cs.x + x1 * cs.y) * ks); } }
        for (int idx = lane; idx < 1024; idx += 64) { const float v = bf2f(rg[idx]); rg[idx] = (bf16)f2bf(v / (1.0f + __expf(-v))); }
    }
    GRID_BAR();

    for (int u = bx; u < 256; u += G) attn_unit(L + RING_OFF, u, QR, KA, VA, sinks, tid, lane, wave);

    for (int u = bx; u < 256; u += G) scan_unit(L + RING_OFF, u, RK, RV, STB, tid, lane, wave);
    GRID_BAR();

    for (int u = bx; u < 512; u += G) retout_unit(L + RING_OFF, u, QR, RK, RV, RG, STB, tid, lane, wave);
    GRID_BAR();

    {
        pg8::Gemm g{QR, W2T, NTOK, DM, DM}; pg8::StaticOrder S; S.init(NTOK, DM, G, bx);
        pg8::EpiGen<1> E{Y, DM, H0, ALPHA, nullptr, nullptr, nullptr, nullptr, nullptr, nullptr};
        pg8::gemm_phase<pg8::EpiGen<1>, pg8::StaticOrder, true, true>(L + RING_OFF, g, S, E);
    }
    GRID_BAR();

    for (int m = gw; m < NTOK; m += NGW) ln_row_bf16_to_bf16(Y + (size_t)m * DM, ln_mix_g, ln_mix_b, H1 + (size_t)m * DM, lane);
    GRID_BAR();

    {
        pg8::Gemm g{H1, W3T, NTOK, DM, DM}; pg8::StaticOrder S; S.init(NTOK, DM, G, bx);
        pg8::EpiGen<2> E{Q3, DM, nullptr, 0.f, nullptr, nullptr, nullptr, nullptr, nullptr, nullptr};
        pg8::gemm_phase<pg8::EpiGen<2>, pg8::StaticOrder, true, true>(L + RING_OFF, g, S, E);
    }
    GRID_BAR();

    for (int un = gw; un < (NTOK / 32) * 8; un += NGW) topk_unit((LAS unsigned*)(L + RING_OFF + wave * 8192), un >> 3, un & 7, Q3, SKB, IDS, GATES, lane);
    GRID_BAR();

    for (int tok = gw; tok < NTOK; tok += NGW) {
        v4u hq[4];
        { const GAS v4u* hp = (const GAS v4u*)(H1 + (size_t)tok * DM) + lane;
#pragma unroll
          for (int j = 0; j < 4; ++j) hq[j] = hp[64 * j]; }
        const int idv0 = IDS[(size_t)tok * 128 + lane], idv1 = IDS[(size_t)tok * 128 + 64 + lane];
        const float gv0 = GATES[(size_t)tok * 128 + lane], gv1 = GATES[(size_t)tok * 128 + 64 + lane];
        float ov[32];
#pragma unroll
        for (int i = 0; i < 32; ++i) ov[i] = 0.f;
        v4u ub[4][4], vb[4][4];
#pragma unroll
        for (int p = 0; p < 4; ++p) { const int eid = __builtin_amdgcn_readlane(idv0, p); const GAS v4u* up = (const GAS v4u*)(UT + (size_t)eid * DM) + lane;
#pragma unroll
            for (int j = 0; j < 4; ++j) ub[p][j] = up[64 * j]; }
#pragma unroll 1
        for (int half = 0; half < 2; ++half) {
            const int idv = half ? idv1 : idv0, idn = idv1; const float gv = half ? gv1 : gv0;
#pragma unroll 1
            for (int g = 0; g < 16; ++g) {
#pragma unroll
                for (int p = 0; p < 4; ++p) { const int eid = __builtin_amdgcn_readlane(idv, 4 * g + p); const GAS v4u* vp = (const GAS v4u*)(VT + (size_t)eid * DM) + lane;
#pragma unroll
                    for (int j = 0; j < 4; ++j) vb[p][j] = vp[64 * j]; }
                float dot[4];
#pragma unroll
                for (int p = 0; p < 4; ++p) { float d = 0.f;
#pragma unroll
                    for (int j = 0; j < 4; ++j) {
                        d = dot2bf(ub[p][j].x, hq[j].x, d); d = dot2bf(ub[p][j].y, hq[j].y, d); d = dot2bf(ub[p][j].z, hq[j].z, d); d = dot2bf(ub[p][j].w, hq[j].w, d); }
                    dot[p] = d; }
                if (half == 0 || g < 15) {
                    const int gn = (g + 1) & 15; const int idx = (g == 15) ? idn : idv;
#pragma unroll
                    for (int p = 0; p < 4; ++p) { const int eid = __builtin_amdgcn_readlane(idx, 4 * gn + p); const GAS v4u* up = (const GAS v4u*)(UT + (size_t)eid * DM) + lane;
#pragma unroll
                        for (int j = 0; j < 4; ++j) ub[p][j] = up[64 * j]; }
                }
#pragma unroll
                for (int o = 1; o < 64; o <<= 1) {
#pragma unroll
                    for (int p = 0; p < 4; ++p) dot[p] += __shfl_xor(dot[p], o); }
#pragma unroll
                for (int p = 0; p < 4; ++p) {
                    const float c = __uint_as_float(__builtin_amdgcn_readlane(__float_as_uint(gv), 4 * g + p)) * gelu_erf(dot[p]);
#pragma unroll
                    for (int j = 0; j < 4; ++j) {
                        ov[8 * j + 0] += c * bflo(vb[p][j].x); ov[8 * j + 1] += c * bfhi(vb[p][j].x); ov[8 * j + 2] += c * bflo(vb[p][j].y); ov[8 * j + 3] += c * bfhi(vb[p][j].y);
                        ov[8 * j + 4] += c * bflo(vb[p][j].z); ov[8 * j + 5] += c * bfhi(vb[p][j].z); ov[8 * j + 6] += c * bflo(vb[p][j].w); ov[8 * j + 7] += c * bfhi(vb[p][j].w); }
                }
            }
        }
        float s = 0.f;
#pragma unroll
        for (int j = 0; j < 4; ++j) {
            ov[8 * j + 0] += ALPHA * bflo(hq[j].x); ov[8 * j + 1] += ALPHA * bfhi(hq[j].x); ov[8 * j + 2] += ALPHA * bflo(hq[j].y); ov[8 * j + 3] += ALPHA * bfhi(hq[j].y);
            ov[8 * j + 4] += ALPHA * bflo(hq[j].z); ov[8 * j + 5] += ALPHA * bfhi(hq[j].z); ov[8 * j + 6] += ALPHA * bflo(hq[j].w); ov[8 * j + 7] += ALPHA * bfhi(hq[j].w); }
#pragma unroll
        for (int i = 0; i < 32; ++i) s += ov[i];
        const float mean = wave_sum(s) * (1.f / DM); float s2 = 0.f;
#pragma unroll
        for (int i = 0; i < 32; ++i) { ov[i] -= mean; s2 += ov[i] * ov[i]; }
        const float rstd = 1.0f / sqrtf(wave_sum(s2) * (1.f / DM) + LN_EPS);
#pragma unroll
        for (int j = 0; j < 4; ++j) {
            const GAS f32x4* gp = (const GAS f32x4*)ln_ffn_g + 2 * (lane + 64 * j); const GAS f32x4* bp = (const GAS f32x4*)ln_ffn_b + 2 * (lane + 64 * j);
            const f32x4 g0 = gp[0], g1 = gp[1], b0 = bp[0], b1 = bp[1];
            GAS f32x4* op = (GAS f32x4*)(out + (size_t)tok * DM) + 2 * (lane + 64 * j);
            op[0] = (f32x4){ov[8 * j + 0] * rstd * g0.x + b0.x, ov[8 * j + 1] * rstd * g0.y + b0.y, ov[8 * j + 2] * rstd * g0.z + b0.z, ov[8 * j + 3] * rstd * g0.w + b0.w};
            op[1] = (f32x4){ov[8 * j + 4] * rstd * g1.x + b1.x, ov[8 * j + 5] * rstd * g1.y + b1.y, ov[8 * j + 6] * rstd * g1.z + b1.z, ov[8 * j + 7] * rstd * g1.w + b1.w}; }
    }
}

extern "C" void kernel_launch(void* const* d_in, const int* in_sizes, int n_in, void* d_out, int out_size, void* d_ws, size_t ws_size, hipStream_t stream) {
    static int grid = 0;
    if (grid == 0) {
        if (n_in != 15 || out_size != NTOK * DM || ws_size < WS_END) { fprintf(stderr, "kernel_launch: unexpected shapes (n_in %d out %d ws %zu)\n", n_in, out_size, ws_size); grid = -1; return; }
        int dev = 0, cus = 0, per_cu = 0;
        if (hipGetDevice(&dev) != hipSuccess || hipDeviceGetAttribute(&cus, hipDeviceAttributeMultiprocessorCount, dev) != hipSuccess) { grid = -1; return; }
        if (hipFuncSetAttribute((const void*)mk_fwd, hipFuncAttributeMaxDynamicSharedMemorySize, LDS_BYTES) != hipSuccess) { fprintf(stderr, "kernel_launch: hipFuncSetAttribute failed\n"); grid = -1; return; }
        if (hipOccupancyMaxActiveBlocksPerMultiprocessor(&per_cu, (const void*)mk_fwd, NWAVES * 64, LDS_BYTES) != hipSuccess || per_cu < 1) { fprintf(stderr, "kernel_launch: occupancy query says %d\n", per_cu); }
        (void)hipGetLastError();
        grid = cus;
    }
    if (grid < 0) return;
    if (hipMemsetAsync((char*)d_ws + WS_CTL, 0, CTL_ZERO_BYTES, stream) != hipSuccess) return;
    Args a{};
    for (int i = 0; i < 15; ++i) a.in[i] = (const float*)d_in[i];
    a.out = (float*)d_out; a.ws = (unsigned char*)d_ws;
    hipLaunchKernelGGL(mk_fwd, dim3(grid), dim3(NWAVES * 64), LDS_BYTES, stream, a);
}
```

```cpp
#include <hip/hip_runtime.h>
#include <cstdio>
#include <cstdint>
#include <cmath>
namespace pg8 {
#define PG8_LAS __attribute__((address_space(3)))
typedef unsigned short bf16_t;
typedef short bf16x8 __attribute__((ext_vector_type(8)));
typedef float f32x4 __attribute__((ext_vector_type(4)));
typedef unsigned u32x4 __attribute__((ext_vector_type(4)));
constexpr int BM = 256, BK = 64, HALF = 128, HTB = HALF * BK * 2  , STAGE_BYTES = 8 * HTB, NXCD = 8, WGM = 8;

__host__ __device__ __forceinline__ int lds_byte(int r, int c) { const int st = (r >> 4) * 2 + (c >> 5), rr = r & 15, cc = c & 31, ob = rr * 64 + cc * 2; return st * 1024 + (ob ^ (((ob >> 9) & 1) << 5)); }
__host__ __device__ __forceinline__ void stage_rc(int b, int& R, int& C) { const int st = b / 1024, sb = b % 1024, swz = sb ^ (((sb >> 9) & 1) << 5); R = (st >> 1) * 16 + swz / 64; C = (st & 1) * 32 + (swz % 64) / 2; }
__host__ __device__ __forceinline__ int perm32(int rho) { const int n = rho >> 4, i = rho & 15; return 8 * (i >> 2) + 4 * n + (i & 3); }

struct Unit { int pm, pn; };
struct Gemm { const bf16_t* A; const bf16_t* Bt; int M, N, K; };

struct StaticOrder {
    int nM, nN, nwg, G, c;
    __host__ __device__ void init(int M, int N, int G_, int c_) { nM = M / BM; nN = N / BM; nwg = nM * nN; G = G_; c = c_; }
    __host__ __device__ bool next(int i, Unit& u) const {
        const long L = (long)i * G + c; if (L >= nwg) return false;
        int wgid = (int)L; { const int q = nwg / NXCD, r = nwg % NXCD, xcd = wgid % NXCD, off = wgid / NXCD; wgid = (xcd < r ? xcd * (q + 1) : r * (q + 1) + (xcd - r) * q) + off; }
        const int nig = WGM * nN, gid = wgid / nig, fm = gid * WGM, gsz = (nM - fm) < WGM ? (nM - fm) : WGM;
        u.pm = fm + ((wgid % nig) % gsz); u.pn = (wgid % nig) / gsz; return true;
    }
    __device__ __forceinline__ void a_ready(const Unit&) const {}
    __device__ __forceinline__ void done(const Unit&) const {}
};

__device__ __forceinline__ unsigned cvt_pk_bf16(float lo, float hi) { unsigned r; asm volatile("v_cvt_pk_bf16_f32 %0, %1, %2" : "=v"(r) : "v"(lo), "v"(hi)); return r; }
typedef float f32x2 __attribute__((ext_vector_type(2)));

template <int MODE> struct EpiGen {
    static constexpr bool PERM = true, AFTER_DRAIN = false;
    bf16_t* O; int ldc; const bf16_t* R; float alpha;
    bf16_t *QR, *KA, *VA, *RK, *RV, *RG;
    __device__ __forceinline__ void operator()(const f32x4 (&acc)[2][2][4][2], const Unit& u, int wr, int wc, int fr, int fq) const {
        const int row0 = u.pm * BM + wr * 64 + fr;
#pragma unroll
        for (int bj = 0; bj < 2; ++bj) {
            const int col = u.pn * BM + bj * HALF + wc * 32 + 8 * fq;
            bf16_t* base = O; int ld = ldc; int cc = col;
            if (MODE == 0) {
                if (col < 1024)      { base = QR; ld = 2048; cc = col; }
                else if (col < 1152) { base = KA; ld = 128;  cc = col - 1024; }
                else if (col < 1280) { base = VA; ld = 128;  cc = col - 1152; }
                else if (col < 2304) { base = QR; ld = 2048; cc = col - 1280 + 1024; }
                else if (col < 3328) { base = RK; ld = 1024; cc = col - 2304; }
                else if (col < 4352) { base = RV; ld = 1024; cc = col - 3328; }
                else                 { base = RG; ld = 1024; cc = col - 4352; }
            }
#pragma unroll
            for (int ai = 0; ai < 2; ++ai)
#pragma unroll
                for (int m = 0; m < 4; ++m) {
                    const int row = row0 + ai * HALF + m * 16;
                    f32x4 v0 = acc[ai][bj][m][0], v1 = acc[ai][bj][m][1];
                    if (MODE == 1) {
                        const u32x4 r = *(const u32x4*)(R + (size_t)row * ldc + col);
                        v0[0] += alpha * __uint_as_float(r.x << 16); v0[1] += alpha * __uint_as_float(r.x & 0xffff0000u);
                        v0[2] += alpha * __uint_as_float(r.y << 16); v0[3] += alpha * __uint_as_float(r.y & 0xffff0000u);
                        v1[0] += alpha * __uint_as_float(r.z << 16); v1[1] += alpha * __uint_as_float(r.z & 0xffff0000u);
                        v1[2] += alpha * __uint_as_float(r.w << 16); v1[3] += alpha * __uint_as_float(r.w & 0xffff0000u);
                    }
                    u32x4 w; w.x = cvt_pk_bf16(v0[0], v0[1]); w.y = cvt_pk_bf16(v0[2], v0[3]); w.z = cvt_pk_bf16(v1[0], v1[1]); w.w = cvt_pk_bf16(v1[2], v1[3]);
                    *(u32x4*)(base + (size_t)row * ld + cc) = w;
                }
        }
    }
};
template <class Epi, class Sched, bool ALIGN_EPI = false, bool SP2 = false>
__device__ __forceinline__ void gemm_phase(PG8_LAS unsigned char* lds, const Gemm g, const Sched& S, const Epi& E) {
    const int tid = threadIdx.x, wid = __builtin_amdgcn_readfirstlane(tid >> 6), lane = tid & 63, wr = wid >> 2, wc = wid & 3, fr = lane & 15, fq = lane >> 4;
    const int K = g.K, nt = K / BK;
    unsigned voffA[2], voffB[2];
#pragma unroll
    for (int i = 0; i < 2; ++i) { int R, C; stage_rc(tid * 16 + i * 8192, R, C); const int Rb = Epi::PERM ? ((R & ~31) + perm32(R & 31)) : R;
        voffA[i] = (unsigned)(R * K + C) * 2u; voffB[i] = (unsigned)(Rb * K + C) * 2u; }
    const size_t kstep = (size_t)(BK * 2);
    const size_t hstep = (size_t)HALF * K * 2;
    const size_t tstep = 2 * hstep;
    const unsigned ldsw = (unsigned)wid * 1024u;
    const int aoff = lds_byte(wr * 64 + fr, fq * 8), boff = lds_byte(wc * 32 + fr, fq * 8);
#define PG8_SA(b, h) (((b) * 2 + (h)) * HTB)
#define PG8_SB(b, h) ((4 + (b) * 2 + (h)) * HTB)
#define PG8_STAGE(bufoff, gbase, voff) do { _Pragma("unroll") for (int _i = 0; _i < 2; ++_i) \
        __builtin_amdgcn_global_load_lds((const unsigned*)((const char*)(gbase) + (voff)[_i]), (PG8_LAS unsigned*)(lds + (bufoff) + ldsw + _i * 8192), 16, 0, 0); } while (0)
#define PG8_LDA(dst, b, h) do { _Pragma("unroll") for (int m = 0; m < 4; ++m) _Pragma("unroll") for (int k = 0; k < 2; ++k) dst[m][k] = *(const PG8_LAS bf16x8*)(lds + PG8_SA(b, h) + aoff + m * 2048 + k * 1024); } while (0)
#define PG8_LDB(dst, b, h) do { _Pragma("unroll") for (int n = 0; n < 2; ++n) _Pragma("unroll") for (int k = 0; k < 2; ++k) dst[n][k] = *(const PG8_LAS bf16x8*)(lds + PG8_SB(b, h) + boff + n * 2048 + k * 1024); } while (0)
#define PG8_MMA(ai, bj, At, Bt) do { __builtin_amdgcn_s_setprio(1); _Pragma("unroll") for (int m = 0; m < 4; ++m) _Pragma("unroll") for (int n = 0; n < 2; ++n) _Pragma("unroll") for (int k = 0; k < 2; ++k) \
        acc[ai][bj][m][n] = __builtin_amdgcn_mfma_f32_16x16x32_bf16(Bt[n][k], At[m][k], acc[ai][bj][m][n], 0, 0, 0); __builtin_amdgcn_s_setprio(0); } while (0)
#define PG8_WAIT_V(n) asm volatile("s_waitcnt vmcnt(" #n ")" ::: "memory")
#define PG8_WAIT_L(n) asm volatile("s_waitcnt lgkmcnt(" #n ")" ::: "memory")
#define PG8_BAR __builtin_amdgcn_s_barrier()
#define PG8_SCHED __builtin_amdgcn_sched_barrier(0)
    Unit cur, nxt; int ui = 0;
    if (!S.next(0, cur)) return;
    f32x4 acc[2][2][4][2];
#pragma unroll
    for (int a = 0; a < 2; ++a)
#pragma unroll
        for (int b = 0; b < 2; ++b)
#pragma unroll
            for (int m = 0; m < 4; ++m)
#pragma unroll
                for (int n = 0; n < 2; ++n) acc[a][b][m][n] = (f32x4){0.f, 0.f, 0.f, 0.f};
    bf16x8 At[4][2], B0[2][2], B1[2][2];
    const char* cA = (const char*)g.A + (size_t)cur.pm * tstep; const char* cB = (const char*)g.Bt + (size_t)cur.pn * tstep;
    S.a_ready(cur);
    if constexpr (SP2) {
        PG8_STAGE(PG8_SB(0, 0), cB, voffB); PG8_STAGE(PG8_SB(0, 1), cB + hstep, voffB); PG8_STAGE(PG8_SA(0, 0), cA, voffA); PG8_STAGE(PG8_SA(0, 1), cA + hstep, voffA);
        if (wr == 1) PG8_BAR;
        PG8_WAIT_V(2); PG8_BAR;
        PG8_STAGE(PG8_SB(1, 0), cB + kstep, voffB); PG8_STAGE(PG8_SA(1, 0), cA + kstep, voffA); PG8_STAGE(PG8_SB(1, 1), cB + hstep + kstep, voffB);
        PG8_WAIT_V(6); PG8_BAR;
    } else {
        PG8_STAGE(PG8_SB(0, 0), cB, voffB); PG8_STAGE(PG8_SA(0, 0), cA, voffA); PG8_STAGE(PG8_SB(0, 1), cB + hstep, voffB); PG8_STAGE(PG8_SA(0, 1), cA + hstep, voffA);
        if (wr == 1) PG8_BAR;
        PG8_WAIT_V(4); PG8_BAR;
        PG8_STAGE(PG8_SB(1, 0), cB + kstep, voffB); PG8_STAGE(PG8_SA(1, 0), cA + kstep, voffA); PG8_STAGE(PG8_SB(1, 1), cB + hstep + kstep, voffB);
        PG8_WAIT_V(6); PG8_BAR;
    }
    for (;;) {
        const bool has_next = S.next(ui + 1, nxt);
        const char* nA = has_next ? (const char*)g.A + (size_t)nxt.pm * tstep : cA; const char* nB = has_next ? (const char*)g.Bt + (size_t)nxt.pn * tstep : cB;
        for (int t = 0; t < nt; t += 2) {
            const bool last = (t == nt - 2);
            const char* a1 = cA + (size_t)(t + 1) * kstep;
            const char* a2 = last ? nA : cA + (size_t)(t + 2) * kstep; const char* b2 = last ? nB : cB + (size_t)(t + 2) * kstep;
            const char* a3 = a2 + kstep; const char* b3 = b2 + kstep;
            if (last && has_next) S.a_ready(nxt);
            if constexpr (SP2) {
            PG8_LDB(B0, 0, 0); PG8_LDB(B1, 0, 1); PG8_SCHED; PG8_LDA(At, 0, 0); PG8_STAGE(PG8_SA(1, 1), a1 + hstep, voffA);
            PG8_WAIT_V(8); PG8_WAIT_L(0); PG8_BAR; PG8_MMA(0, 0, At, B0); PG8_MMA(0, 1, At, B1); PG8_BAR; PG8_SCHED;
            PG8_LDA(At, 0, 1); PG8_STAGE(PG8_SB(0, 0), b2, voffB); PG8_STAGE(PG8_SB(0, 1), b2 + hstep, voffB); PG8_STAGE(PG8_SA(0, 0), a2, voffA);
            PG8_WAIT_V(8); PG8_WAIT_L(0); PG8_BAR; PG8_MMA(1, 0, At, B0); PG8_MMA(1, 1, At, B1); PG8_BAR; PG8_SCHED;
            PG8_LDB(B0, 1, 0); PG8_LDB(B1, 1, 1); PG8_SCHED; PG8_LDA(At, 1, 0); PG8_STAGE(PG8_SA(0, 1), a2 + hstep, voffA);
            PG8_WAIT_V(8); PG8_WAIT_L(0); PG8_BAR; PG8_MMA(0, 0, At, B0); PG8_MMA(0, 1, At, B1); PG8_BAR; PG8_SCHED;
            PG8_LDA(At, 1, 1); PG8_STAGE(PG8_SB(1, 0), b3, voffB); PG8_STAGE(PG8_SB(1, 1), b3 + hstep, voffB); PG8_STAGE(PG8_SA(1, 0), a3, voffA);
            PG8_WAIT_V(8); PG8_WAIT_L(0); PG8_BAR; PG8_MMA(1, 0, At, B0); PG8_MMA(1, 1, At, B1); PG8_BAR; PG8_SCHED;
            } else {
            PG8_LDB(B0, 0, 0); PG8_SCHED; PG8_LDA(At, 0, 0); PG8_STAGE(PG8_SA(1, 1), a1 + hstep, voffA);
            PG8_WAIT_L(8); PG8_BAR; PG8_WAIT_L(0); PG8_MMA(0, 0, At, B0); PG8_BAR; PG8_SCHED;
            PG8_LDB(B1, 0, 1); PG8_STAGE(PG8_SB(0, 0), b2, voffB);
            PG8_BAR; PG8_WAIT_L(0); PG8_MMA(0, 1, At, B1); PG8_BAR;
            PG8_LDA(At, 0, 1); PG8_STAGE(PG8_SA(0, 0), a2, voffA);
            PG8_BAR; PG8_WAIT_L(0); PG8_MMA(1, 0, At, B0); PG8_BAR; PG8_SCHED;
            PG8_STAGE(PG8_SB(0, 1), b2 + hstep, voffB);
            PG8_WAIT_V(6); PG8_BAR; PG8_MMA(1, 1, At, B1); PG8_BAR;
            PG8_LDB(B0, 1, 0); PG8_SCHED; PG8_LDA(At, 1, 0); PG8_STAGE(PG8_SA(0, 1), a2 + hstep, voffA);
            PG8_WAIT_L(8); PG8_BAR; PG8_WAIT_L(0); PG8_MMA(0, 0, At, B0); PG8_BAR; PG8_SCHED;
            PG8_LDB(B1, 1, 1); PG8_STAGE(PG8_SB(1, 0), b3, voffB);
            PG8_BAR; PG8_WAIT_L(0); PG8_MMA(0, 1, At, B1); PG8_BAR;
            PG8_LDA(At, 1, 1); PG8_STAGE(PG8_SA(1, 0), a3, voffA);
            PG8_BAR; PG8_WAIT_L(0); PG8_MMA(1, 0, At, B0); PG8_BAR; PG8_SCHED;
            PG8_STAGE(PG8_SB(1, 1), b3 + hstep, voffB);
            PG8_WAIT_V(6); PG8_BAR; PG8_MMA(1, 1, At, B1); PG8_BAR;
            }
        }
        if constexpr (ALIGN_EPI) { if (wr == 0) PG8_BAR; }
        if constexpr (!Epi::AFTER_DRAIN) { E(acc, cur, wr, wc, fr, fq); S.done(cur); }
        if (!has_next) break;
#pragma unroll
        for (int a = 0; a < 2; ++a)
#pragma unroll
            for (int b = 0; b < 2; ++b)
#pragma unroll
                for (int m = 0; m < 4; ++m)
#pragma unroll
                    for (int n = 0; n < 2; ++n) acc[a][b][m][n] = (f32x4){0.f, 0.f, 0.f, 0.f};
        cur = nxt; cA = nA; cB = nB; ++ui;
        if constexpr (ALIGN_EPI) { if (wr == 1) PG8_BAR; }
    }
    PG8_WAIT_V(0);
    if constexpr (!ALIGN_EPI) { if (wr == 0) PG8_BAR; }
    PG8_BAR;
    if constexpr (Epi::AFTER_DRAIN) { E.fused(acc, cur, wr, wc, fr, fq, lds, wid, lane); S.done(cur); }
#undef PG8_SA
#undef PG8_SB
#undef PG8_STAGE
#undef PG8_LDA
#undef PG8_LDB
#undef PG8_MMA
#undef PG8_WAIT_V
#undef PG8_WAIT_L
#undef PG8_BAR
#undef PG8_SCHED
}
}

constexpr int NWAVES = 8;
constexpr int DM = 2048, NB = 4, SEQ = 4096, NTOK = NB * SEQ;
constexpr int NMETA = 16, NVALID = NTOK + NMETA, MROWS = 16640;
constexpr int IN_COLS = 5376;
constexpr float LN_EPS = 1e-5f, GN_EPS = 1e-5f;
constexpr float ALPHA = 1.189207115002721f;
constexpr float LOG2E = 1.4426950408889634f;
constexpr float QSCALE = 0.125f * LOG2E;

constexpr size_t MiB = 1u << 20;
constexpr size_t WS_CTL = 0, CTL_ZERO_BYTES = 1 * MiB;
constexpr size_t SZ_SK = (size_t)16 * 128 * 128 * 2, SZ_ROPE_R = (size_t)4112 * 128 * 8, SZ_ROPE_A = (size_t)4112 * 32 * 8;
constexpr size_t SZ_W2T = (size_t)DM * DM * 2, SZ_W1T = (size_t)IN_COLS * DM * 2, SZ_TAB = (size_t)16384 * DM * 2;
constexpr size_t SZ_ROWS2K = (size_t)MROWS * 2048 * 2, SZ_ROWS1K = (size_t)MROWS * 1024 * 2, SZ_ROWS128 = (size_t)MROWS * 128 * 2;
constexpr size_t SZ_TOK2K = (size_t)NTOK * 2048 * 2, SZ_ST = (size_t)16 * 32 * 256 * 256 * 2, SZ_IDS = (size_t)NTOK * 128 * 4;
constexpr size_t al256(size_t x) { return (x + 255) & ~(size_t)255; }
constexpr size_t WS_SK = 1 * MiB;
constexpr size_t WS_ROPE_R = al256(WS_SK + SZ_SK);
constexpr size_t WS_ROPE_A = al256(WS_ROPE_R + SZ_ROPE_R);
constexpr size_t WS_W2T = al256(WS_ROPE_A + SZ_ROPE_A), WS_W3T = al256(WS_W2T + SZ_W2T), WS_W1T = al256(WS_W3T + SZ_W2T);
constexpr size_t WS_UT = al256(WS_W1T + SZ_W1T), WS_VT = al256(WS_UT + SZ_TAB);
constexpr size_t WS_H0 = al256(WS_VT + SZ_TAB);
constexpr size_t WS_QR = al256(WS_H0 + SZ_ROWS2K);
constexpr size_t WS_KA = al256(WS_QR + SZ_ROWS2K), WS_VA = al256(WS_KA + SZ_ROWS128);
constexpr size_t WS_RK = al256(WS_VA + SZ_ROWS128), WS_RV = al256(WS_RK + SZ_ROWS1K), WS_RG = al256(WS_RV + SZ_ROWS1K);
constexpr size_t WS_ST = al256(WS_RG + SZ_ROWS1K);
constexpr size_t WS_Y = WS_RK;
constexpr size_t WS_H1 = WS_ST;
constexpr size_t WS_IDS = al256(WS_ST + SZ_ST), WS_GATES = al256(WS_IDS + SZ_IDS);
constexpr size_t WS_END = al256(WS_GATES + SZ_IDS);
static_assert(WS_Y + SZ_TOK2K <= WS_RG, "Y overlays RK|RV only");
static_assert(SZ_TOK2K <= SZ_ST && (size_t)NTOK * 1024 * 4 <= SZ_ST, "H1 / RET_RAW fit the state region");
static_assert(WS_END <= (size_t)512 * MiB, "workspace map fits 4 x largest tensor");
static_assert(WS_RK + (size_t)8 * NTOK * 128 * 4 <= WS_ST && WS_KA + (size_t)NTOK * 128 * 4 <= WS_RK && WS_H0 + (size_t)NTOK * DM * 4 <= WS_KA, "expert-phase overlays (DOTX over RK|RV, CB over KA|VA, Y32 over H0|QR)");
constexpr int CW_TMO = 0, CW_BAR = 4096;

constexpr int RING_OFF = 0, RING_BYTES = 131072;
constexpr int LDSCTL_OFF = RING_BYTES, MISC_OFF = LDSCTL_OFF + 320;
constexpr int LDS_BYTES = 147456;

#define GAS __attribute__((address_space(1)))
#define LAS __attribute__((address_space(3)))
typedef unsigned short bf16;
typedef unsigned v4u __attribute__((ext_vector_type(4)));
typedef unsigned v2u __attribute__((ext_vector_type(2)));
typedef float f32x4 __attribute__((ext_vector_type(4)));
typedef float f32x2 __attribute__((ext_vector_type(2)));
typedef GAS unsigned gu32;
typedef __bf16 bf16x2_t __attribute__((ext_vector_type(2)));
#define RLX_AGENT __ATOMIC_RELAXED, __HIP_MEMORY_SCOPE_AGENT
#define LDS_WAIT() asm volatile("s_waitcnt lgkmcnt(0)" ::: "memory")
#define VM_WAIT() asm volatile("s_waitcnt vmcnt(0)" ::: "memory")
__device__ __forceinline__ unsigned f2bf(float f) { unsigned u = __builtin_bit_cast(unsigned, f); return (u + 0x7fffu + ((u >> 16) & 1u)) >> 16; }
__device__ __forceinline__ unsigned pk2(float lo, float hi) { return f2bf(lo) | (f2bf(hi) << 16); }
__device__ __forceinline__ float bflo(unsigned w) { return __uint_as_float(w << 16); }
__device__ __forceinline__ float bfhi(unsigned w) { return __uint_as_float(w & 0xffff0000u); }
__device__ __forceinline__ float bf2f(bf16 h) { return __uint_as_float((unsigned)h << 16); }

#define XB_TMO      128
#define XB_XCNT(j)  (256  + 64 * (j))
#define XB_XSUB(j)  (1280 + 64 * (j))
#define XB_XGEN(j)  (2304 + 64 * (j))
#define XB_TOP      3328
#define XB_TOPGEN   3392
#define XCD_BAR_WORDS 3456
#define XB_SPIN_CAP (1u << 18)

__device__ __forceinline__ unsigned xb_ld(unsigned* p)              { return __hip_atomic_load(p, __ATOMIC_RELAXED, __HIP_MEMORY_SCOPE_AGENT); }
__device__ __forceinline__ unsigned xb_add(unsigned* p, unsigned v) { return __hip_atomic_fetch_add(p, v, __ATOMIC_RELAXED, __HIP_MEMORY_SCOPE_AGENT); }
__device__ __forceinline__ unsigned xb_xcc_id() { return (unsigned)__builtin_amdgcn_s_getreg((3 << 11) | 20) & 0xFu; }
#define XB_SPIN(cond, bar) do { unsigned _sp = 0; while (cond) { __builtin_amdgcn_s_sleep(1); \
    if ((++_sp & 255u) == 0u) { if (xb_ld(&(bar)[XB_TMO])) break; if (_sp > XB_SPIN_CAP) { atomicAdd(&(bar)[XB_TMO], 1u); break; } } } } while (0)

struct XcdBarrier {
    unsigned* bar; unsigned x;
    volatile LAS unsigned* st;
};

__device__ __forceinline__ XcdBarrier xcd_barrier_post(unsigned* bar, volatile LAS unsigned* st) {
    XcdBarrier b; b.bar = bar; b.x = xb_xcc_id(); b.st = st;
    if (threadIdx.x == 0) (void)xb_add(&bar[XB_XCNT(b.x)], 1u);
    return b;
}
__device__ __forceinline__ void xcd_barrier_complete(unsigned* bar, unsigned x, unsigned& nloc, unsigned& nx) {
    const unsigned G = gridDim.x * gridDim.y * gridDim.z;
    unsigned sum, cnt, mine, sp = 0u;
    for (;;) {
        sum = 0u; cnt = 0u; mine = 0u;
#pragma unroll
        for (unsigned j = 0; j < 16; ++j) { const unsigned c = xb_ld(&bar[XB_XCNT(j)]); sum += c; cnt += (c > 0u) ? 1u : 0u; mine = (j == x) ? c : mine; }
        if (sum == G) break;
        __builtin_amdgcn_s_sleep(1);
        if ((++sp & 255u) == 0u) { if (xb_ld(&bar[XB_TMO])) break; if (sp > XB_SPIN_CAP) { atomicAdd(&bar[XB_TMO], 1u); break; } }
    }
    nloc = mine > 0u ? mine : 1u; nx = cnt > 0u ? cnt : 1u;
}

__device__ __forceinline__ void xcd_barrier(const XcdBarrier& b) {
    asm volatile("s_waitcnt vmcnt(0)" ::: "memory");
    __syncthreads();
    if (threadIdx.x == 0) {
        unsigned* bar = b.bar;
        __builtin_amdgcn_s_waitcnt(0);
        unsigned nloc = b.st[0], nx = b.st[1];
        if (nloc == 0u) { xcd_barrier_complete(bar, b.x, nloc, nx); b.st[0] = nloc; b.st[1] = nx; }
        const unsigned old = xb_add(&bar[XB_XSUB(b.x)], 1u);
        const unsigned gen = old / nloc;
        if (old + 1u == (gen + 1u) * nloc) {
            __builtin_amdgcn_fence(__ATOMIC_RELEASE, "agent");
            asm volatile("s_waitcnt vmcnt(0)" ::: "memory");
            const unsigned og = xb_add(&bar[XB_TOP], 1u);
            const unsigned tg = og / nx;
            if (og + 1u == (tg + 1u) * nx) xb_add(&bar[XB_TOPGEN], 1u);
            else XB_SPIN(xb_ld(&bar[XB_TOPGEN]) == tg, bar);
            __builtin_amdgcn_fence(__ATOMIC_ACQUIRE, "agent");
            xb_add(&bar[XB_XGEN(b.x)], 1u);
            asm volatile("s_waitcnt vmcnt(0)" ::: "memory");
        } else {
            XB_SPIN(xb_ld(&bar[XB_XGEN(b.x)]) == gen, bar);
            __builtin_amdgcn_fence(__ATOMIC_ACQUIRE, "agent");
            asm volatile("s_waitcnt vmcnt(0)" ::: "memory");
        }
    }
    __syncthreads();
}


__device__ __forceinline__ float dot2bf(unsigned a, unsigned b, float c) { asm("v_dot2c_f32_bf16 %0, %1, %2" : "+v"(c) : "v"(a), "v"(b)); return c; }
__device__ __forceinline__ float dot8bf_dpp(v4u a, v4u b) { float c = 0.f; asm("v_dot2c_f32_bf16 %0, %1, %5\n\tv_dot2c_f32_bf16 %0, %2, %6\n\tv_dot2c_f32_bf16 %0, %3, %7\n\tv_dot2c_f32_bf16 %0, %4, %8\n\ts_nop 1" : "+v"(c) : "v"(a.x), "v"(a.y), "v"(a.z), "v"(a.w), "v"(b.x), "v"(b.y), "v"(b.z), "v"(b.w)); return c; }
__device__ __forceinline__ float wave_sum(float v) {
#pragma unroll
    for (int o = 1; o < 64; o <<= 1) v += __shfl_xor(v, o);
    return v;
}
__device__ __forceinline__ float gelu_erf(float v) {
    const float av = fabsf(v), d = av * 0.2316418882f + 1.0f;
    const float t = __builtin_amdgcn_rcpf(d);
    float q = t * 0.5307027145f + (-0.7265760135f); q = q * t + 0.7107068705f; q = q * t + (-0.142248368f); q = q * t + 0.127414796f; q = q * t;
    const float e = __builtin_amdgcn_exp2f((v * v) * (-0.72134752044f));
    const float m = v * (q * e);
    return v < 0.f ? m : v - m;
}

struct Args { const float* in[15]; float* out; unsigned char* ws; };

__device__ __forceinline__ void p0_transpose_item(const float* W, int K, int N, bf16* WT, LAS float* scr, int item, int lane) {
    const int nblk = N / 32, kb = item / nblk, nb = item % nblk, k0 = 64 * kb, n0 = 32 * nb;
#pragma unroll 8
    for (int i = 0; i < 32; ++i) { const int kk = 2 * i + (lane >> 5); scr[kk * 33 + (lane & 31)] = W[(size_t)(k0 + kk) * N + n0 + (lane & 31)]; }
    LDS_WAIT(); asm volatile("" ::: "memory");
    const int c = lane & 7;
#pragma unroll
    for (int j = 0; j < 4; ++j) { const int n = (lane >> 3) + 8 * j; const LAS float* s = scr + (8 * c) * 33 + n;
        v4u o; o.x = pk2(s[0 * 33], s[1 * 33]); o.y = pk2(s[2 * 33], s[3 * 33]); o.z = pk2(s[4 * 33], s[5 * 33]); o.w = pk2(s[6 * 33], s[7 * 33]);
        *(GAS v4u*)(WT + (size_t)(n0 + n) * K + k0 + 8 * c) = o; }
    LDS_WAIT(); asm volatile("" ::: "memory");
}
__device__ __forceinline__ void ln_row_f32_to_bf16(const float* xrow, const float* g, const float* bta, bf16* orow, int lane) {
    const GAS f32x4* xr = (const GAS f32x4*)xrow + lane;
    f32x4 v[8]; float s = 0.f;
#pragma unroll
    for (int j = 0; j < 8; ++j) { v[j] = xr[64 * j]; s += (v[j].x + v[j].y) + (v[j].z + v[j].w); }
    const float mean = wave_sum(s) * (1.f / DM); float s2 = 0.f;
#pragma unroll
    for (int j = 0; j < 8; ++j) { v[j] = v[j] - mean; s2 += (v[j].x * v[j].x + v[j].y * v[j].y) + (v[j].z * v[j].z + v[j].w * v[j].w); }
    const float rstd = 1.f / sqrtf(wave_sum(s2) * (1.f / DM) + LN_EPS);
    GAS v2u* o8 = (GAS v2u*)orow + lane;
#pragma unroll
    for (int j = 0; j < 8; ++j) { const f32x4 gg = ((const GAS f32x4*)g)[lane + 64 * j], bb = ((const GAS f32x4*)bta)[lane + 64 * j];
        v2u o; o.x = pk2(v[j].x * rstd * gg.x + bb.x, v[j].y * rstd * gg.y + bb.y); o.y = pk2(v[j].z * rstd * gg.z + bb.z, v[j].w * rstd * gg.w + bb.w); o8[64 * j] = o; }
}
__device__ __forceinline__ void ln_row_bf16_to_bf16(const bf16* xrow, const float* g, const float* bta, bf16* orow, int lane) {
    const GAS v4u* xr = (const GAS v4u*)xrow + lane;
    float v[32]; float s = 0.f;
#pragma unroll
    for (int j = 0; j < 4; ++j) { const v4u w = xr[64 * j];
        v[8 * j + 0] = bflo(w.x); v[8 * j + 1] = bfhi(w.x); v[8 * j + 2] = bflo(w.y); v[8 * j + 3] = bfhi(w.y);
        v[8 * j + 4] = bflo(w.z); v[8 * j + 5] = bfhi(w.z); v[8 * j + 6] = bflo(w.w); v[8 * j + 7] = bfhi(w.w); }
#pragma unroll
    for (int i = 0; i < 32; ++i) s += v[i];
    const float mean = wave_sum(s) * (1.f / DM); float s2 = 0.f;
#pragma unroll
    for (int i = 0; i < 32; ++i) { v[i] -= mean; s2 += v[i] * v[i]; }
    const float rstd = 1.f / sqrtf(wave_sum(s2) * (1.f / DM) + LN_EPS);
    GAS v4u* o16 = (GAS v4u*)orow + lane;
#pragma unroll
    for (int j = 0; j < 4; ++j) {
        const GAS f32x4* gp = (const GAS f32x4*)g + 2 * (lane + 64 * j); const GAS f32x4* bp = (const GAS f32x4*)bta + 2 * (lane + 64 * j);
        const f32x4 g0 = gp[0], g1 = gp[1], b0 = bp[0], b1 = bp[1];
        v4u o; o.x = pk2(v[8 * j + 0] * rstd * g0.x + b0.x, v[8 * j + 1] * rstd * g0.y + b0.y); o.y = pk2(v[8 * j + 2] * rstd * g0.z + b0.z, v[8 * j + 3] * rstd * g0.w + b0.w);
        o.z = pk2(v[8 * j + 4] * rstd * g1.x + b1.x, v[8 * j + 5] * rstd * g1.y + b1.y); o.w = pk2(v[8 * j + 6] * rstd * g1.z + b1.z, v[8 * j + 7] * rstd * g1.w + b1.w);
        o16[64 * j] = o; }
}
__device__ __forceinline__ void row_pos(int r, int& pos, int& ipos) {
    if (r < NTOK) { const int s = r & (SEQ - 1); pos = NMETA + s; ipos = s & 127; }
    else { int j = r - NTOK; if (j > NMETA - 1) j = NMETA - 1; pos = j; ipos = 112 + j; }
}
__device__ __forceinline__ float log2_gamma(int h) { return log2f(1.0f - exp2f(-5.0f - (float)h)); }


typedef short bf16x8 __attribute__((ext_vector_type(8)));
typedef short s16x4 __attribute__((ext_vector_type(4)));
#define MFMA16(a, b, c) __builtin_amdgcn_mfma_f32_16x16x32_bf16((a), (b), (c), 0, 0, 0)
__device__ __forceinline__ s16x4 tr16(LAS const unsigned char* p) { return __builtin_bit_cast(s16x4, __builtin_amdgcn_ds_read_tr16_b64_v4i16((LAS s16x4*)p)); }
__device__ __forceinline__ bf16x8 cat8(s16x4 a, s16x4 b) { return __builtin_shufflevector(a, b, 0, 1, 2, 3, 4, 5, 6, 7); }
__device__ __forceinline__ unsigned cvtpk_s(float lo, float hi) { f32x2 v = {lo, hi}; bf16x2_t b = __builtin_convertvector(v, bf16x2_t); return __builtin_bit_cast(unsigned, b); }
__device__ __forceinline__ unsigned cvtpk(float lo, float hi) { unsigned r; asm("v_cvt_pk_bf16_f32 %0, %1, %2" : "=v"(r) : "v"(lo), "v"(hi)); return r; }

__device__ __forceinline__ void scan_unit(LAS unsigned char* L, int u, const bf16* RK, const bf16* RV, bf16* ST, int tid, int lane, int wave) {
    asm volatile("" : "+v"(tid)); lane = tid & 63;
    const int bh = u >> 4, di = (u >> 2) & 3, ei = u & 3, b = bh >> 2, h = bh & 3;
    const float g128 = exp2f(128.0f * log2_gamma(h));
    const int li = lane & 15, g = lane >> 4, q = li >> 2, p4 = li & 3;
    const int eb = wave >> 1, db0 = 2 * (wave & 1);
    f32x4 acc[2]; acc[0] = (f32x4){0.f, 0.f, 0.f, 0.f}; acc[1] = acc[0];
    v4u kreg[2], vreg[2];
#define SCAN_LOAD(cc) do { _Pragma("unroll") for (int i_ = 0; i_ < 2; ++i_) { const int cid_ = tid + 512 * i_, row_ = cid_ >> 3, c16_ = cid_ & 7; \
        int srow_; bool ok_ = true; if ((cc) < 0) { ok_ = row_ >= 112; srow_ = NTOK + (ok_ ? row_ - 112 : 0); } else srow_ = b * SEQ + (cc) * 128 + row_; \
        const v4u kz_ = *(const GAS v4u*)(RK + (size_t)srow_ * 1024 + h * 256 + di * 64 + c16_ * 8), vz_ = *(const GAS v4u*)(RV + (size_t)srow_ * 1024 + h * 256 + ei * 64 + c16_ * 8); \
        kreg[i_] = ok_ ? kz_ : (v4u){0u, 0u, 0u, 0u}; vreg[i_] = ok_ ? vz_ : (v4u){0u, 0u, 0u, 0u}; } } while (0)
#define SCAN_WRITE(bufp) do { _Pragma("unroll") for (int i_ = 0; i_ < 2; ++i_) { const int cid_ = tid + 512 * i_, row_ = cid_ >> 3, c16_ = cid_ & 7; \
        *(LAS v4u*)((bufp) + row_ * 128 + c16_ * 16) = kreg[i_]; *(LAS v4u*)((bufp) + 16384 + row_ * 128 + c16_ * 16) = vreg[i_]; } } while (0)
    SCAN_LOAD(-1); SCAN_WRITE(L); __syncthreads();
    int cur = 0;
    for (int cc = -1; cc <= 30; ++cc) {
        if (cc < 30) SCAN_LOAD(cc + 1);
        LAS const unsigned char* Kt = L + cur * 32768; LAS const unsigned char* Vt = Kt + 16384;
#pragma unroll
        for (int ks = 0; ks < 4; ++ks) {
            const int r0 = (32 * ks + 8 * g + q) * 128;
            const bf16x8 a = cat8(tr16(Vt + r0 + (16 * eb + 4 * p4) * 2), tr16(Vt + r0 + 512 + (16 * eb + 4 * p4) * 2));
#pragma unroll
            for (int n = 0; n < 2; ++n) {
                const bf16x8 bb = cat8(tr16(Kt + r0 + (16 * (db0 + n) + 4 * p4) * 2), tr16(Kt + r0 + 512 + (16 * (db0 + n) + 4 * p4) * 2));
                acc[n] = MFMA16(a, bb, acc[n]);
            }
        }
#pragma unroll
        for (int n = 0; n < 2; ++n) {
            acc[n] = acc[n] * g128;
            bf16* sp = ST + ((size_t)(bh * 32 + cc + 1) * 256 + (64 * ei + 16 * eb + 4 * g)) * 256 + 64 * di + 16 * (db0 + n) + li;
#pragma unroll
            for (int r = 0; r < 4; ++r) sp[(size_t)r * 256] = (bf16)f2bf(acc[n][r]);
        }
        if (cc < 30) SCAN_WRITE(L + (cur ^ 1) * 32768);
        __syncthreads(); cur ^= 1;
    }
#undef SCAN_LOAD
#undef SCAN_WRITE
}

__device__ __forceinline__ void retout_unit(LAS unsigned char* L, int u, bf16* QR, const bf16* RK, const bf16* RV, const bf16* RG, const bf16* ST, int tid, int lane, int wave) {
    asm volatile("" : "+v"(tid)); lane = tid & 63;
    const int bh = u >> 5, c = u & 31, b = bh >> 2, h = bh & 3;
    const int R0 = b * SEQ + c * 128;
    const int li = lane & 15, g = lane >> 4, q = li >> 2, p4 = li & 3;
    LAS unsigned char* RA = L; LAS unsigned char* RB = L + 65536;
#pragma unroll
    for (int i = 0; i < 8; ++i) { const int cid = tid + 512 * i, j = cid >> 5, ch = cid & 31;
        const v4u kz = *(const GAS v4u*)(RK + (size_t)(R0 + j) * 1024 + h * 256 + ch * 8), vz = *(const GAS v4u*)(RV + (size_t)(R0 + j) * 1024 + h * 256 + ch * 8);
        *(LAS v4u*)(RA + j * 512 + ((ch ^ (j & 15)) << 4)) = kz; *(LAS v4u*)(RB + j * 512 + ((ch ^ ((j & 7) << 1)) << 4)) = vz; }
    bf16x8 qf[8];
    { const GAS v4u* qp = (const GAS v4u*)(QR + (size_t)(R0 + 16 * wave + li) * 2048 + 1024 + h * 256 + 8 * g);
#pragma unroll
      for (int ks = 0; ks < 8; ++ks) qf[ks] = __builtin_bit_cast(bf16x8, qp[4 * ks]); }
    __syncthreads();
    f32x4 st[8];
#pragma unroll
    for (int jt = 0; jt < 8; ++jt) st[jt] = (f32x4){0.f, 0.f, 0.f, 0.f};
#pragma unroll
    for (int jt = 0; jt < 8; ++jt) if (jt <= wave) {
        const int j = 16 * jt + li;
#pragma unroll
        for (int ks = 0; ks < 8; ++ks) { const bf16x8 a = *(LAS const bf16x8*)(RA + j * 512 + (((4 * ks + g) ^ li) << 4)); st[jt] = MFMA16(a, qf[ks], st[jt]); }
        if (jt == wave) {
#pragma unroll
            for (int r = 0; r < 4; ++r) if (4 * g + r > li) st[jt][r] = 0.f; }
    }
    bf16x8 pf[4];
#pragma unroll
    for (int s = 0; s < 4; ++s) { v4u w; w.x = cvtpk_s(st[2 * s][0], st[2 * s][1]); w.y = cvtpk_s(st[2 * s][2], st[2 * s][3]); w.z = cvtpk_s(st[2 * s + 1][0], st[2 * s + 1][1]); w.w = cvtpk_s(st[2 * s + 1][2], st[2 * s + 1][3]); pf[s] = __builtin_bit_cast(bf16x8, w); }
    __syncthreads();
    const bf16* Sg = ST + (size_t)(bh * 32 + c) * 65536;
#define RO_STAGE_ST(dst, s0) do { _Pragma("unroll") for (int i_ = 0; i_ < 8; ++i_) { const int cid_ = tid + 512 * i_, sl_ = cid_ >> 11, e_ = (cid_ >> 3) & 255, ch_ = cid_ & 7; \
        const v4u z_ = *(const GAS v4u*)(Sg + (size_t)e_ * 256 + 64 * ((s0) + sl_) + ch_ * 8); *(LAS v4u*)((dst) + sl_ * 32768 + e_ * 128 + ((ch_ ^ (e_ & 7)) << 4)) = z_; } } while (0)
    RO_STAGE_ST(RA, 0);
    f32x4 o[16];
#pragma unroll
    for (int et = 0; et < 16; ++et) o[et] = (f32x4){0.f, 0.f, 0.f, 0.f};
#pragma unroll
    for (int s = 0; s < 4; ++s) if (2 * s <= wave) {
        const int r1 = 32 * s + 4 * g + q, r2 = r1 + 16;
#pragma unroll
        for (int et = 0; et < 16; ++et) {
            const int chn = 2 * et + (p4 >> 1);
            const bf16x8 a = cat8(tr16(RB + r1 * 512 + ((chn ^ ((r1 & 7) << 1)) << 4) + (p4 & 1) * 8), tr16(RB + r2 * 512 + ((chn ^ ((r2 & 7) << 1)) << 4) + (p4 & 1) * 8));
            o[et] = MFMA16(a, pf[s], o[et]);
        }
    }
    __syncthreads();
    RO_STAGE_ST(RB, 2);
#define RO_STATE_MMA(src, s0) do { _Pragma("unroll") for (int sl_ = 0; sl_ < 2; ++sl_) _Pragma("unroll") for (int k2_ = 0; k2_ < 2; ++k2_) _Pragma("unroll") for (int et = 0; et < 16; ++et) { \
        const int e_ = 16 * et + li; const bf16x8 a_ = *(LAS const bf16x8*)((src) + sl_ * 32768 + e_ * 128 + (((4 * k2_ + g) ^ (e_ & 7)) << 4)); \
        o[et] = MFMA16(a_, qf[2 * ((s0) + sl_) + k2_], o[et]); } } while (0)
    RO_STATE_MMA(RA, 0);
    __syncthreads();
    RO_STATE_MMA(RB, 2);
#undef RO_STAGE_ST
#undef RO_STATE_MMA
    float s1 = 0.f;
#pragma unroll
    for (int et = 0; et < 16; ++et) s1 += (o[et][0] + o[et][1]) + (o[et][2] + o[et][3]);
    s1 += __shfl_xor(s1, 16); s1 += __shfl_xor(s1, 32);
    const float mu = s1 * (1.0f / 256.0f); float s2 = 0.f;
#pragma unroll
    for (int et = 0; et < 16; ++et) { o[et] = o[et] - mu; s2 += (o[et][0] * o[et][0] + o[et][1] * o[et][1]) + (o[et][2] * o[et][2] + o[et][3] * o[et][3]); }
    s2 += __shfl_xor(s2, 16); s2 += __shfl_xor(s2, 32);
    const float rstd = 1.0f / sqrtf(s2 * (1.0f / 256.0f) + GN_EPS);
    const int row = R0 + 16 * wave + li;
    const GAS v2u* gp = (const GAS v2u*)(RG + (size_t)row * 1024 + h * 256 + 4 * g); GAS v2u* op = (GAS v2u*)(QR + (size_t)row * 2048 + 1024 + h * 256 + 4 * g);
#pragma unroll
    for (int et = 0; et < 16; ++et) { const v2u gz = gp[4 * et]; v2u w;
        w.x = cvtpk(o[et][0] * rstd * bflo(gz.x), o[et][1] * rstd * bfhi(gz.x)); w.y = cvtpk(o[et][2] * rstd * bflo(gz.y), o[et][3] * rstd * bfhi(gz.y)); op[4 * et] = w; }
    __syncthreads();
}

typedef float f32x16 __attribute__((ext_vector_type(16)));
#define MFMA32(a, b, c) __builtin_amdgcn_mfma_f32_32x32x16_bf16((a), (b), (c), 0, 0, 0)
__device__ __forceinline__ int crow32(int reg, int hh) { return (reg & 3) + 8 * (reg >> 2) + 4 * hh; }

__device__ __forceinline__ void attn_unit(LAS unsigned char* L, int u, bf16* QR, const bf16* KA, const bf16* VA, const float* sinks, int tid, int lane, int wave) {
    asm volatile("" : "+v"(tid)); lane = tid & 63;
    const int b = u >> 6, j = (u >> 1) & 31, g2 = u & 1, hq = 8 * g2 + wave;
    const int R0 = b * SEQ + 128 * j;
    LAS unsigned char* Kt = L; LAS unsigned char* Vt = L + 32768;
#pragma unroll
    for (int i = 0; i < 4; ++i) { const int cid = tid + 512 * i, kk = cid >> 3, ch = cid & 7;
        int srow; bool ok = true;
        if (kk >= 128) srow = R0 + kk - 128; else if (j > 0) srow = R0 - 128 + kk; else { ok = kk >= 112; srow = NTOK + (ok ? kk - 112 : 0); }
        const v4u kz = *(const GAS v4u*)(KA + (size_t)srow * 128 + g2 * 64 + ch * 8), vz = *(const GAS v4u*)(VA + (size_t)srow * 128 + g2 * 64 + ch * 8);
        *(LAS v4u*)(Kt + kk * 128 + ((ch ^ (kk & 7)) << 4)) = ok ? kz : (v4u){0u, 0u, 0u, 0u};
        *(LAS v4u*)(Vt + kk * 128 + (ch << 4)) = ok ? vz : (v4u){0u, 0u, 0u, 0u}; }
    __syncthreads();
    const int r = lane & 31, hh = lane >> 5, blk = (lane >> 4) & 1, q = (lane & 15) >> 2, p4 = lane & 3;
    const float sk = sinks[hq] * LOG2E;
#pragma unroll 1
    for (int t = 0; t < 4; ++t) {
        const int i0 = 32 * t;
        bf16x8 qf[4];
        { const GAS v4u* qp = (const GAS v4u*)(QR + (size_t)(R0 + i0 + r) * 2048 + hq * 64 + 8 * hh);
#pragma unroll
          for (int ks = 0; ks < 4; ++ks) qf[ks] = __builtin_bit_cast(bf16x8, qp[2 * ks]); }
        f32x16 s[5];
#pragma unroll
        for (int x = 0; x < 5; ++x) {
            const int krow_ = 32 * (t + x) + r;
            f32x16 acc;
#pragma unroll
            for (int e = 0; e < 16; ++e) acc[e] = 0.f;
#pragma unroll
            for (int ks = 0; ks < 4; ++ks) { const bf16x8 a = *(LAS const bf16x8*)(Kt + krow_ * 128 + (((2 * ks + hh) ^ (krow_ & 7)) << 4)); acc = MFMA32(a, qf[ks], acc); }
            s[x] = acc; __builtin_amdgcn_sched_barrier(0);
        }
        float m = sk;
#pragma unroll
        for (int e = 0; e < 16; ++e) { const int cr = crow32(e, hh);
            if (!(cr > r)) s[0][e] = -1.0e30f;
            if (!(cr <= r)) s[4][e] = -1.0e30f; }
        if (j == 0) {
#pragma unroll
            for (int x = 0; x < 4; ++x) if (t + x <= 3) {
#pragma unroll
                for (int e = 0; e < 16; ++e) if (32 * (t + x) + crow32(e, hh) < 112) s[x][e] = -1.0e30f; }
        }
#pragma unroll
        for (int x = 0; x < 5; ++x)
#pragma unroll
            for (int e = 0; e < 16; ++e) m = fmaxf(m, s[x][e]);
        m = fmaxf(m, __shfl_xor(m, 32));
        float l = 0.f;
#pragma unroll
        for (int x = 0; x < 5; ++x)
#pragma unroll
            for (int e = 0; e < 16; ++e) { const float pv = exp2f(s[x][e] - m); s[x][e] = pv; l += pv; }
        l += __shfl_xor(l, 32);
        l += exp2f(sk - m);
        f32x16 o[2];
#pragma unroll
        for (int e = 0; e < 16; ++e) { o[0][e] = 0.f; o[1][e] = 0.f; }
#pragma unroll
        for (int x = 0; x < 5; ++x)
#pragma unroll
            for (int st = 0; st < 2; ++st) {
                v4u w; w.x = cvtpk_s(s[x][8 * st + 0], s[x][8 * st + 1]); w.y = cvtpk_s(s[x][8 * st + 2], s[x][8 * st + 3]); w.z = cvtpk_s(s[x][8 * st + 4], s[x][8 * st + 5]); w.w = cvtpk_s(s[x][8 * st + 6], s[x][8 * st + 7]);
                const bf16x8 pb = __builtin_bit_cast(bf16x8, w);
                const int k1 = 32 * (t + x) + 16 * st + 4 * hh + q, k2 = k1 + 8;
#pragma unroll
                for (int dc = 0; dc < 2; ++dc) {
                    const int cb = ((4 * dc + 2 * blk + (p4 >> 1)) << 4) + 8 * (p4 & 1);
                    const bf16x8 a = cat8(tr16(Vt + k1 * 128 + cb), tr16(Vt + k2 * 128 + cb));
                    o[dc] = MFMA32(a, pb, o[dc]);
                }
                __builtin_amdgcn_sched_barrier(0);
            }
        const float il = 1.0f / l;
        GAS v2u* op = (GAS v2u*)(QR + (size_t)(R0 + i0 + r) * 2048 + hq * 64 + 4 * hh);
#pragma unroll
        for (int dc = 0; dc < 2; ++dc)
#pragma unroll
            for (int g4 = 0; g4 < 4; ++g4) { v2u w; w.x = cvtpk_s(o[dc][4 * g4 + 0] * il, o[dc][4 * g4 + 1] * il); w.y = cvtpk_s(o[dc][4 * g4 + 2] * il, o[dc][4 * g4 + 3] * il); op[8 * dc + 2 * g4] = w; }
    }
    __syncthreads();
}

__device__ __forceinline__ unsigned ord_key(float f) { const unsigned u = __float_as_uint(f); return u ^ ((unsigned)((int)u >> 31) | 0x80000000u); }
__device__ __forceinline__ float ord_val(unsigned k) { return __uint_as_float(k ^ (((int)k < 0) ? 0x80000000u : 0xffffffffu)); }
#define TK_INS(arr, val) do { unsigned v_ = (val); _Pragma("unroll") for (int j_ = 0; j_ < 16; ++j_) { const unsigned hi_ = arr[j_] > v_ ? arr[j_] : v_; v_ = arr[j_] > v_ ? v_ : arr[j_]; arr[j_] = hi_; } } while (0)
__device__ __forceinline__ void topk_unit(LAS unsigned* Lw, int tt, int hd, const bf16* Q3, const bf16* SKB, int* IDS, float* GATES, int lane) {
    asm volatile("" : "+v"(lane));
    const int r = lane & 31, hh = lane >> 5, t0 = tt * 32;
    float sv[2][16];
#pragma unroll
    for (int p = 0; p < 2; ++p) {
        f32x16 acc[4];
#pragma unroll
        for (int nt = 0; nt < 4; ++nt)
#pragma unroll
            for (int e = 0; e < 16; ++e) acc[nt][e] = 0.f;
        const GAS v4u* qp = (const GAS v4u*)(Q3 + (size_t)(t0 + r) * DM + hd * 256 + p * 128 + 8 * hh);
        const GAS v4u* kp = (const GAS v4u*)(SKB + ((size_t)((hd * 2 + p) * 128 + r)) * 128 + 8 * hh);
#pragma unroll 2
        for (int ks = 0; ks < 8; ++ks) { const bf16x8 bq = __builtin_bit_cast(bf16x8, qp[2 * ks]);
#pragma unroll
            for (int nt = 0; nt < 4; ++nt) { const bf16x8 a = __builtin_bit_cast(bf16x8, kp[nt * 32 * 16 + 2 * ks]); acc[nt] = MFMA32(a, bq, acc[nt]); } }
        unsigned tk[16];
#pragma unroll
        for (int j2 = 0; j2 < 16; ++j2) tk[j2] = 0u;
#pragma unroll
        for (int nt = 0; nt < 4; ++nt)
#pragma unroll
            for (int e = 0; e < 16; ++e) { const int n = 32 * nt + crow32(e, hh); TK_INS(tk, (ord_key(acc[nt][e]) & 0xffffff80u) | (unsigned)(127 - n)); }
        unsigned pk[16];
#pragma unroll
        for (int j2 = 0; j2 < 16; ++j2) pk[j2] = (unsigned)__shfl_xor((int)tk[j2], 32);
#pragma unroll
        for (int j2 = 0; j2 < 16; ++j2) TK_INS(tk, pk[j2]);
#pragma unroll
        for (int j2 = 0; j2 < 16; ++j2) { sv[p][j2] = ord_val(tk[j2] & 0xffffff80u); Lw[(p * 16 + j2) * 64 + lane] = 127u - (tk[j2] & 0x7fu); }
    }
    unsigned fk[16];
#pragma unroll
    for (int j2 = 0; j2 < 16; ++j2) fk[j2] = 0u;
#pragma unroll
    for (int i = 0; i < 16; ++i)
#pragma unroll
        for (int j2 = 0; j2 < 16; ++j2) if ((i + 1) * (j2 + 1) <= 16) TK_INS(fk, (ord_key(sv[0][i] + sv[1][j2]) & 0xffffff00u) | (unsigned)(255 - (16 * i + j2)));
    float ev[16]; int idv[16]; float den = 0.f; const float f0 = ord_val(fk[0] & 0xffffff00u);
    LDS_WAIT();
#pragma unroll
    for (int k = 0; k < 16; ++k) { const unsigned idx = 255u - (fk[k] & 0xffu); const unsigned i1 = Lw[(idx >> 4) * 64 + lane], i2 = Lw[(16 + (idx & 15u)) * 64 + lane];
        idv[k] = (int)(i1 * 128u + i2); ev[k] = __expf(ord_val(fk[k] & 0xffffff00u) - f0); den += ev[k]; }
    const float iden = 1.0f / den;
    if (hh == 0) {
        GAS v4u* ip = (GAS v4u*)(IDS + (size_t)(t0 + r) * 128 + hd * 16); GAS f32x4* gp = (GAS f32x4*)(GATES + (size_t)(t0 + r) * 128 + hd * 16);
#pragma unroll
        for (int k4 = 0; k4 < 4; ++k4) { ip[k4] = (v4u){(unsigned)idv[4 * k4], (unsigned)idv[4 * k4 + 1], (unsigned)idv[4 * k4 + 2], (unsigned)idv[4 * k4 + 3]};
            gp[k4] = (f32x4){ev[4 * k4] * iden, ev[4 * k4 + 1] * iden, ev[4 * k4 + 2] * iden, ev[4 * k4 + 3] * iden}; }
    }
    LDS_WAIT();
}

__global__ void __launch_bounds__(NWAVES * 64, 2) mk_fwd(Args args) {
    extern __shared__ __attribute__((aligned(16))) unsigned char lds[];
    LAS unsigned char* L = (LAS unsigned char*)lds;
    volatile LAS unsigned* MISC = (volatile LAS unsigned*)(L + MISC_OFF);
    const int tid = threadIdx.x, lane = tid & 63, wave = __builtin_amdgcn_readfirstlane(tid >> 6);
    const int G = gridDim.x, bx = blockIdx.x;
    const int vcu = (G % 8 == 0) ? (bx % 8) * (G / 8) + bx / 8 : bx;
    unsigned char* ws = args.ws;
    gu32* ctl = (gu32*)(ws + WS_CTL);
    const float* x = args.in[0]; const float* meta = args.in[1]; const float* ln_in_g = args.in[2]; const float* ln_in_b = args.in[3];
    const float* w_in = args.in[4]; const float* sinks = args.in[5]; const float* w_out = args.in[6]; const float* ln_mix_g = args.in[7]; const float* ln_mix_b = args.in[8];
    const float* wq = args.in[9]; const float* subkeys = args.in[10]; const float* u_tab = args.in[11]; const float* v_tab = args.in[12];
    const float* ln_ffn_g = args.in[13]; const float* ln_ffn_b = args.in[14];
    float* out = args.out;
    bf16* W1T = (bf16*)(ws + WS_W1T); bf16* W2T = (bf16*)(ws + WS_W2T); bf16* W3T = (bf16*)(ws + WS_W3T);
    bf16* H0 = (bf16*)(ws + WS_H0); bf16* QR = (bf16*)(ws + WS_QR); bf16* KA = (bf16*)(ws + WS_KA); bf16* VA = (bf16*)(ws + WS_VA);
    bf16* RK = (bf16*)(ws + WS_RK); bf16* RV = (bf16*)(ws + WS_RV); bf16* RG = (bf16*)(ws + WS_RG);
    bf16* Y = (bf16*)(ws + WS_Y); bf16* H1 = (bf16*)(ws + WS_H1); bf16* Q3 = (bf16*)(ws + WS_QR);
    bf16* STB = (bf16*)(ws + WS_ST);
    f32x2* ROPE_R = (f32x2*)(ws + WS_ROPE_R); f32x2* ROPE_A = (f32x2*)(ws + WS_ROPE_A);
    int* IDS = (int*)(ws + WS_IDS); float* GATES = (float*)(ws + WS_GATES);
    bf16* SKB = (bf16*)(ws + WS_SK);
    bf16* UT = (bf16*)(ws + WS_UT); bf16* VT = (bf16*)(ws + WS_VT);

    for (int u = tid; u < (LDS_BYTES - LDSCTL_OFF) / 4; u += NWAVES * 64) ((LAS unsigned*)(L + LDSCTL_OFF))[u] = 0u;
    __syncthreads();
    XcdBarrier bar; bar.bar = (unsigned*)(ctl + CW_BAR); bar.x = xb_xcc_id(); bar.st = MISC + 8;
    if (tid == 0) MISC[10] = xb_add(&bar.bar[XB_XCNT(bar.x)], 1u);
#define GRID_BAR() xcd_barrier(bar)
    const int gw = vcu * NWAVES + wave, NGW = G * NWAVES;
    const int gt = gw * 64 + lane, NGT = NGW * 64;

    {
        LAS float* scr = (LAS float*)(L + RING_OFF + wave * 16384);
        constexpr int I_1 = (DM / 64) * (IN_COLS / 32), I_2 = (DM / 64) * (DM / 32), I_3 = I_2;
        for (int it = gw; it < I_1 + I_2 + I_3; it += NGW) {
            int r = it;
            if (r < I_1) { p0_transpose_item(w_in, DM, IN_COLS, W1T, scr, r, lane); continue; } r -= I_1;
            if (r < I_2) { p0_transpose_item(w_out, DM, DM, W2T, scr, r, lane); continue; } r -= I_2;
            p0_transpose_item(wq, DM, DM, W3T, scr, r, lane);
        }
        for (int m = gw; m < MROWS; m += NGW) {
            if (m < NTOK) ln_row_f32_to_bf16(x + (size_t)m * DM, ln_in_g, ln_in_b, H0 + (size_t)m * DM, lane);
            else if (m < NVALID) ln_row_f32_to_bf16(meta + (size_t)(m - NTOK) * DM, ln_in_g, ln_in_b, H0 + (size_t)m * DM, lane);
            else { GAS v4u* o = (GAS v4u*)(H0 + (size_t)m * DM) + lane;
#pragma unroll
                for (int j = 0; j < 4; ++j) o[64 * j] = (v4u){0u, 0u, 0u, 0u}; }
        }
        for (int e = gt; e < 2 * (16384 * DM / 8); e += NGT) {
            const int which = e >= (16384 * DM / 8); const int i8 = which ? e - (16384 * DM / 8) : e; const int row = i8 >> 8, c = i8 & 255;
            const GAS f32x4* src = (const GAS f32x4*)(which ? v_tab : u_tab) + 2 * (size_t)i8; const f32x4 a = src[0], b = src[1];
            v4u o; o.x = pk2(a.x, a.y); o.y = pk2(a.z, a.w); o.z = pk2(b.x, b.y); o.w = pk2(b.z, b.w);
            ((GAS v4u*)(which ? VT : UT))[((size_t)(c >> 3) * 16384 + row) * 8 + (c & 7)] = o; }
        for (int e = gt; e < 16 * 128 * 128 / 8; e += NGT) { const GAS f32x4* src = (const GAS f32x4*)subkeys + 2 * (size_t)e; const f32x4 a = src[0], b2 = src[1];
            v4u o; o.x = pk2(a.x, a.y); o.y = pk2(a.z, a.w); o.z = pk2(b2.x, b2.y); o.w = pk2(b2.z, b2.w); ((GAS v4u*)SKB)[e] = o; }
        for (int e = gt; e < 4112 * 128; e += NGT) { const int pos = e >> 7, i = e & 127; const float inv = powf(10000.0f, -(float)(2 * i) / 256.0f); float sn, cs; sincosf((float)pos * inv, &sn, &cs); ROPE_R[e] = (f32x2){cs, sn}; }
        for (int e = gt; e < 4112 * 32; e += NGT) { const int pos = e >> 5, i = e & 31; const float inv = powf(10000.0f, -(float)(2 * i) / 64.0f); float sn, cs; sincosf((float)pos * inv, &sn, &cs); ROPE_A[e] = (f32x2){cs, sn}; }
    }
    GRID_BAR();

    {
        pg8::Gemm g{H0, W1T, MROWS, IN_COLS, DM}; pg8::StaticOrder S; S.init(MROWS, IN_COLS, G, bx);
        pg8::EpiGen<0> E{nullptr, 0, nullptr, 0.f, QR, KA, VA, RK, RV, RG};
        pg8::gemm_phase<pg8::EpiGen<0>, pg8::StaticOrder, true, true>(L + RING_OFF, g, S, E);
    }
    GRID_BAR();

    for (int r = gw; r < NVALID; r += NGW) {
        int pos, ipos; row_pos(r, pos, ipos);
        bf16* qr = QR + (size_t)r * 2048; bf16* ka = KA + (size_t)r * 128; bf16* rk = RK + (size_t)r * 1024; bf16* rg = RG + (size_t)r * 1024;
        for (int idx = lane; idx < 512; idx += 64) { const int a = idx >> 5, i = idx & 31; const f32x2 cs = ROPE_A[pos * 32 + i];
            const float x1 = bf2f(qr[64 * a + i]), x2 = bf2f(qr[64 * a + 32 + i]);
            qr[64 * a + i] = (bf16)f2bf((x1 * cs.x - x2 * cs.y) * QSCALE); qr[64 * a + 32 + i] = (bf16)f2bf((x2 * cs.x + x1 * cs.y) * QSCALE); }
        { const int a = lane >> 5, i = lane & 31; const f32x2 cs = ROPE_A[pos * 32 + i];
            const float x1 = bf2f(ka[64 * a + i]), x2 = bf2f(ka[64 * a + 32 + i]);
            ka[64 * a + i] = (bf16)f2bf(x1 * cs.x - x2 * cs.y); ka[64 * a + 32 + i] = (bf16)f2bf(x2 * cs.x + x1 * cs.y); }
        for (int idx = lane; idx < 512; idx += 64) { const int h = idx >> 7, i = idx & 127; const f32x2 cs = ROPE_R[pos * 128 + i];
            const float lg = log2_gamma(h); const float qs = exp2f((float)(ipos + 1) * lg), ks = 0.0625f * exp2f(-(float)(ipos + 1) * lg);
            { const float x1 = bf2f(qr[1024 + 256 * h + i]), x2 = bf2f(qr[1024 + 256 * h + 128 + i]);
              qr[1024 + 256 * h + i] = (bf16)f2bf((x1 * cs.x - x2 * cs.y) * qs); qr[1024 + 256 * h + 128 + i] = (bf16)f2bf((x2 * cs.x + x1 * cs.y) * qs); }
            { const float x1 = bf2f(rk[256 * h + i]), x2 = bf2f(rk[256 * h + 128 + i]);
              rk[256 * h + i] = (bf16)f2bf((x1 * cs.x - x2 * cs.y) * ks); rk[256 * h + 128 + i] = (bf16)f2bf((x2 * cs.x + x1 * cs.y) * ks); } }
        for (int idx = lane; idx < 1024; idx += 64) { const float v = bf2f(rg[idx]); rg[idx] = (bf16)f2bf(v / (1.0f + __expf(-v))); }
    }
    GRID_BAR();

    for (int u = bx; u < 256; u += G) attn_unit(L + RING_OFF, u, QR, KA, VA, sinks, tid, lane, wave);

    for (int u = bx; u < 256; u += G) scan_unit(L + RING_OFF, u, RK, RV, STB, tid, lane, wave);
    GRID_BAR();

    for (int u = bx; u < 512; u += G) retout_unit(L + RING_OFF, u, QR, RK, RV, RG, STB, tid, lane, wave);
    GRID_BAR();

    {
        pg8::Gemm g{QR, W2T, NTOK, DM, DM}; pg8::StaticOrder S; S.init(NTOK, DM, G, bx);
        pg8::EpiGen<1> E{Y, DM, H0, ALPHA, nullptr, nullptr, nullptr, nullptr, nullptr, nullptr};
        pg8::gemm_phase<pg8::EpiGen<1>, pg8::StaticOrder, true, true>(L + RING_OFF, g, S, E);
    }
    GRID_BAR();

    for (int m = gw; m < NTOK; m += NGW) ln_row_bf16_to_bf16(Y + (size_t)m * DM, ln_mix_g, ln_mix_b, H1 + (size_t)m * DM, lane);
    GRID_BAR();

    {
        pg8::Gemm g{H1, W3T, NTOK, DM, DM}; pg8::StaticOrder S; S.init(NTOK, DM, G, bx);
        pg8::EpiGen<2> E{Q3, DM, nullptr, 0.f, nullptr, nullptr, nullptr, nullptr, nullptr, nullptr};
        pg8::gemm_phase<pg8::EpiGen<2>, pg8::StaticOrder, true, true>(L + RING_OFF, g, S, E);
    }
    GRID_BAR();

    for (int un = gw; un < (NTOK / 32) * 8; un += NGW) topk_unit((LAS unsigned*)(L + RING_OFF + wave * 8192), un >> 3, un & 7, Q3, SKB, IDS, GATES, lane);
    GRID_BAR();

    int nx = 0, xr = 0, nloc = 1;
    { unsigned* bw = (unsigned*)(ctl + CW_BAR);
#pragma unroll
      for (unsigned j2 = 0; j2 < 16; ++j2) { const unsigned cnt = xb_ld(&bw[XB_XCNT(j2)]); nx += cnt > 0u; xr += (j2 < bar.x && cnt > 0u); if (j2 == bar.x) nloc = (int)cnt; }
      nx = __builtin_amdgcn_readfirstlane(nx); xr = __builtin_amdgcn_readfirstlane(xr); nloc = __builtin_amdgcn_readfirstlane(nloc); if (nx < 1) nx = 1; if (nloc < 1) nloc = 1; }
    const int lrank = __builtin_amdgcn_readfirstlane((int)MISC[10]);
    const int wv = lrank * NWAVES + wave, nwv = nloc * NWAVES;
    float* DOTX = (float*)(ws + WS_RK);
    float* CB = (float*)(ws + WS_KA);
    float* Y32 = (float*)(ws + WS_H0);
    {
        int tl = tid; asm volatile("" : "+v"(tl)); const int ln = tl & 63, k = ln >> 3, c8 = ln & 7;
        for (int s = xr; s < 32; s += nx) {
            const bf16* Us = UT + (size_t)s * 16384 * 64;
            v4u nid[4];
            if (wv < NTOK) { const GAS v4u* ip = (const GAS v4u*)(IDS + (size_t)wv * 128 + 16 * k);
#pragma unroll
                for (int i = 0; i < 4; ++i) nid[i] = ip[i]; }
            v4u nhs = (wv < NTOK) ? *(const GAS v4u*)(H1 + (size_t)wv * DM + 64 * s + 8 * c8) : (v4u){0u, 0u, 0u, 0u};
#pragma unroll 1
            for (int t = wv; t < NTOK; t += nwv) {
                v4u id4[4]; const v4u hs = nhs;
#pragma unroll
                for (int i = 0; i < 4; ++i) id4[i] = nid[i];
                v4u ub[16];
#pragma unroll
                for (int i = 0; i < 16; ++i) { const unsigned eid = id4[i >> 2][i & 3]; ub[i] = *(const GAS v4u*)(Us + (size_t)eid * 64 + 8 * c8); }
                const int tn = t + nwv;
                if (tn < NTOK) { const GAS v4u* ip = (const GAS v4u*)(IDS + (size_t)tn * 128 + 16 * k);
#pragma unroll
                    for (int i = 0; i < 4; ++i) nid[i] = ip[i];
                    nhs = *(const GAS v4u*)(H1 + (size_t)tn * DM + 64 * s + 8 * c8); }
                float p[16];
#pragma unroll
                for (int i = 0; i < 16; ++i) { float d = dot8bf_dpp(ub[i], hs);
                    d += __int_as_float(__builtin_amdgcn_update_dpp(0, __float_as_int(d), 0xB1, 0xf, 0xf, true));
                    d += __int_as_float(__builtin_amdgcn_update_dpp(0, __float_as_int(d), 0x4E, 0xf, 0xf, true));
                    d += __int_as_float(__builtin_amdgcn_update_dpp(0, __float_as_int(d), 0x141, 0xf, 0xf, true));
                    p[i] = d; }
                if (c8 == 0) { GAS f32x4* dp = (GAS f32x4*)(DOTX + ((size_t)xr * NTOK + t) * 128 + 16 * k);
                    if (s != xr) {
#pragma unroll
                        for (int i4 = 0; i4 < 4; ++i4) { const f32x4 o = dp[i4]; p[4 * i4] += o.x; p[4 * i4 + 1] += o.y; p[4 * i4 + 2] += o.z; p[4 * i4 + 3] += o.w; } }
#pragma unroll
                    for (int i4 = 0; i4 < 4; ++i4) dp[i4] = (f32x4){p[4 * i4], p[4 * i4 + 1], p[4 * i4 + 2], p[4 * i4 + 3]}; }
            }
        }
    }
    GRID_BAR();
    for (int idx = gt; idx < NTOK * 128; idx += NGT) { float d = 0.f; for (int xx = 0; xx < nx; ++xx) d += DOTX[(size_t)xx * NTOK * 128 + idx]; CB[idx] = GATES[idx] * gelu_erf(d); }
    GRID_BAR();
    {
        int tl = tid; asm volatile("" : "+v"(tl)); const int ln = tl & 63, k = ln >> 3, c8 = ln & 7;
        for (int s = xr; s < 32; s += nx) {
            const bf16* Vs = VT + (size_t)s * 16384 * 64;
            v4u nid[4]; f32x4 ncf[4];
            if (wv < NTOK) { const GAS v4u* ip = (const GAS v4u*)(IDS + (size_t)wv * 128 + 16 * k); const GAS f32x4* cp = (const GAS f32x4*)(CB + (size_t)wv * 128 + 16 * k);
#pragma unroll
                for (int i = 0; i < 4; ++i) { nid[i] = ip[i]; ncf[i] = cp[i]; } }
#pragma unroll 1
            for (int t = wv; t < NTOK; t += nwv) {
                v4u id4[4]; f32x4 cf[4];
#pragma unroll
                for (int i = 0; i < 4; ++i) { id4[i] = nid[i]; cf[i] = ncf[i]; }
                v4u vb[16];
#pragma unroll
                for (int i = 0; i < 16; ++i) { const unsigned eid = id4[i >> 2][i & 3]; vb[i] = *(const GAS v4u*)(Vs + (size_t)eid * 64 + 8 * c8); }
                const v4u hs = *(const GAS v4u*)(H1 + (size_t)t * DM + 64 * s + 8 * c8);
                const int tn = t + nwv;
                if (tn < NTOK) { const GAS v4u* ip = (const GAS v4u*)(IDS + (size_t)tn * 128 + 16 * k); const GAS f32x4* cp = (const GAS f32x4*)(CB + (size_t)tn * 128 + 16 * k);
#pragma unroll
                    for (int i = 0; i < 4; ++i) { nid[i] = ip[i]; ncf[i] = cp[i]; } }
                float acc[8];
#pragma unroll
                for (int j2 = 0; j2 < 8; ++j2) acc[j2] = 0.f;
#pragma unroll
                for (int i = 0; i < 16; ++i) { const float c = cf[i >> 2][i & 3];
                    acc[0] += c * bflo(vb[i].x); acc[1] += c * bfhi(vb[i].x); acc[2] += c * bflo(vb[i].y); acc[3] += c * bfhi(vb[i].y);
                    acc[4] += c * bflo(vb[i].z); acc[5] += c * bfhi(vb[i].z); acc[6] += c * bflo(vb[i].w); acc[7] += c * bfhi(vb[i].w); }
#pragma unroll
                for (int j2 = 0; j2 < 8; ++j2) { acc[j2] += __shfl_xor(acc[j2], 8); acc[j2] += __shfl_xor(acc[j2], 16); acc[j2] += __shfl_xor(acc[j2], 32); }
                if (k == 0) { GAS f32x4* yp = (GAS f32x4*)(Y32 + (size_t)t * DM + 64 * s + 8 * c8);
                    yp[0] = (f32x4){acc[0] + ALPHA * bflo(hs.x), acc[1] + ALPHA * bfhi(hs.x), acc[2] + ALPHA * bflo(hs.y), acc[3] + ALPHA * bfhi(hs.y)};
                    yp[1] = (f32x4){acc[4] + ALPHA * bflo(hs.z), acc[5] + ALPHA * bfhi(hs.z), acc[6] + ALPHA * bflo(hs.w), acc[7] + ALPHA * bfhi(hs.w)}; }
            }
        }
    }
    GRID_BAR();
    for (int m = gw; m < NTOK; m += NGW) {
        const GAS f32x4* xr4 = (const GAS f32x4*)(Y32 + (size_t)m * DM) + lane;
        f32x4 v[8]; float sm = 0.f;
#pragma unroll
        for (int j2 = 0; j2 < 8; ++j2) { v[j2] = xr4[64 * j2]; sm += (v[j2].x + v[j2].y) + (v[j2].z + v[j2].w); }
        const float mean = wave_sum(sm) * (1.f / DM); float s2 = 0.f;
#pragma unroll
        for (int j2 = 0; j2 < 8; ++j2) { v[j2] = v[j2] - mean; s2 += (v[j2].x * v[j2].x + v[j2].y * v[j2].y) + (v[j2].z * v[j2].z + v[j2].w * v[j2].w); }
        const float rstd = 1.f / sqrtf(wave_sum(s2) * (1.f / DM) + LN_EPS);
        GAS f32x4* op = (GAS f32x4*)(out + (size_t)m * DM) + lane;
#pragma unroll
        for (int j2 = 0; j2 < 8; ++j2) { const f32x4 gg = ((const GAS f32x4*)ln_ffn_g)[lane + 64 * j2], bb = ((const GAS f32x4*)ln_ffn_b)[lane + 64 * j2];
            op[64 * j2] = (f32x4){v[j2].x * rstd * gg.x + bb.x, v[j2].y * rstd * gg.y + bb.y, v[j2].z * rstd * gg.z + bb.z, v[j2].w * rstd * gg.w + bb.w}; }
    }
}

extern "C" void kernel_launch(void* const* d_in, const int* in_sizes, int n_in, void* d_out, int out_size, void* d_ws, size_t ws_size, hipStream_t stream) {
    static int grid = 0;
    if (grid == 0) {
        if (n_in != 15 || out_size != NTOK * DM || ws_size < WS_END) { fprintf(stderr, "kernel_launch: unexpected shapes (n_in %d out %d ws %zu)\n", n_in, out_size, ws_size); grid = -1; return; }
        int dev = 0, cus = 0, per_cu = 0;
        if (hipGetDevice(&dev) != hipSuccess || hipDeviceGetAttribute(&cus, hipDeviceAttributeMultiprocessorCount, dev) != hipSuccess) { grid = -1; return; }
        if (hipFuncSetAttribute((const void*)mk_fwd, hipFuncAttributeMaxDynamicSharedMemorySize, LDS_BYTES) != hipSuccess) { fprintf(stderr, "kernel_launch: hipFuncSetAttribute failed\n"); grid = -1; return; }
        if (hipOccupancyMaxActiveBlocksPerMultiprocessor(&per_cu, (const void*)mk_fwd, NWAVES * 64, LDS_BYTES) != hipSuccess || per_cu < 1) { fprintf(stderr, "kernel_launch: occupancy query says %d\n", per_cu); }
        (void)hipGetLastError();
        grid = cus;
    }
    if (grid < 0) return;
    if (hipMemsetAsync((char*)d_ws + WS_CTL, 0, CTL_ZERO_BYTES, stream) != hipSuccess) return;
    Args a{};
    for (int i = 0; i < 15; ++i) a.in[i] = (const float*)d_in[i];
    a.out = (float*)d_out; a.ws = (unsigned char*)d_ws;
    hipLaunchKernelGGL(mk_fwd, dim3(grid), dim3(NWAVES * 64), LDS_BYTES, stream, a);
}
```

```cpp
#include <hip/hip_runtime.h>
#include <cstdio>
#include <cstdint>
#include <cmath>
namespace pg8 {
#define PG8_LAS __attribute__((address_space(3)))
typedef unsigned short bf16_t;
typedef short bf16x8 __attribute__((ext_vector_type(8)));
typedef float f32x4 __attribute__((ext_vector_type(4)));
typedef unsigned u32x4 __attribute__((ext_vector_type(4)));
constexpr int BM = 256, BK = 64, HALF = 128, HTB = HALF * BK * 2  , STAGE_BYTES = 8 * HTB, NXCD = 8, WGM = 8;

__host__ __device__ __forceinline__ int lds_byte(int r, int c) { const int st = (r >> 4) * 2 + (c >> 5), rr = r & 15, cc = c & 31, ob = rr * 64 + cc * 2; return st * 1024 + (ob ^ (((ob >> 9) & 1) << 5)); }
__host__ __device__ __forceinline__ void stage_rc(int b, int& R, int& C) { const int st = b / 1024, sb = b % 1024, swz = sb ^ (((sb >> 9) & 1) << 5); R = (st >> 1) * 16 + swz / 64; C = (st & 1) * 32 + (swz % 64) / 2; }
__host__ __device__ __forceinline__ int perm32(int rho) { const int n = rho >> 4, i = rho & 15; return 8 * (i >> 2) + 4 * n + (i & 3); }

struct Unit { int pm, pn; };
struct Gemm { const bf16_t* A; const bf16_t* Bt; int M, N, K; };

struct StaticOrder {
    int nM, nN, nwg, G, c;
    __host__ __device__ void init(int M, int N, int G_, int c_) { nM = M / BM; nN = N / BM; nwg = nM * nN; G = G_; c = c_; }
    __host__ __device__ bool next(int i, Unit& u) const {
        const long L = (long)i * G + c; if (L >= nwg) return false;
        int wgid = (int)L; { const int q = nwg / NXCD, r = nwg % NXCD, xcd = wgid % NXCD, off = wgid / NXCD; wgid = (xcd < r ? xcd * (q + 1) : r * (q + 1) + (xcd - r) * q) + off; }
        const int nig = WGM * nN, gid = wgid / nig, fm = gid * WGM, gsz = (nM - fm) < WGM ? (nM - fm) : WGM;
        u.pm = fm + ((wgid % nig) % gsz); u.pn = (wgid % nig) / gsz; return true;
    }
    __device__ __forceinline__ void a_ready(const Unit&) const {}
    __device__ __forceinline__ void done(const Unit&) const {}
};

__device__ __forceinline__ unsigned cvt_pk_bf16(float lo, float hi) { unsigned r; asm volatile("v_cvt_pk_bf16_f32 %0, %1, %2" : "=v"(r) : "v"(lo), "v"(hi)); return r; }
typedef float f32x2 __attribute__((ext_vector_type(2)));

template <int MODE> struct EpiGen {
    static constexpr bool PERM = true, AFTER_DRAIN = false;
    bf16_t* O; int ldc; const bf16_t* R; float alpha;
    bf16_t *QR, *KA, *VA, *RK, *RV, *RG;
    __device__ __forceinline__ void operator()(const f32x4 (&acc)[2][2][4][2], const Unit& u, int wr, int wc, int fr, int fq) const {
        const int row0 = u.pm * BM + wr * 64 + fr;
#pragma unroll
        for (int bj = 0; bj < 2; ++bj) {
            const int col = u.pn * BM + bj * HALF + wc * 32 + 8 * fq;
            bf16_t* base = O; int ld = ldc; int cc = col;
            if (MODE == 0) {
                if (col < 1024)      { base = QR; ld = 2048; cc = col; }
                else if (col < 1152) { base = KA; ld = 128;  cc = col - 1024; }
                else if (col < 1280) { base = VA; ld = 128;  cc = col - 1152; }
                else if (col < 2304) { base = QR; ld = 2048; cc = col - 1280 + 1024; }
                else if (col < 3328) { base = RK; ld = 1024; cc = col - 2304; }
                else if (col < 4352) { base = RV; ld = 1024; cc = col - 3328; }
                else                 { base = RG; ld = 1024; cc = col - 4352; }
            }
#pragma unroll
            for (int ai = 0; ai < 2; ++ai)
#pragma unroll
                for (int m = 0; m < 4; ++m) {
                    const int row = row0 + ai * HALF + m * 16;
                    f32x4 v0 = acc[ai][bj][m][0], v1 = acc[ai][bj][m][1];
                    if (MODE == 1) {
                        const u32x4 r = *(const u32x4*)(R + (size_t)row * ldc + col);
                        v0[0] += alpha * __uint_as_float(r.x << 16); v0[1] += alpha * __uint_as_float(r.x & 0xffff0000u);
                        v0[2] += alpha * __uint_as_float(r.y << 16); v0[3] += alpha * __uint_as_float(r.y & 0xffff0000u);
                        v1[0] += alpha * __uint_as_float(r.z << 16); v1[1] += alpha * __uint_as_float(r.z & 0xffff0000u);
                        v1[2] += alpha * __uint_as_float(r.w << 16); v1[3] += alpha * __uint_as_float(r.w & 0xffff0000u);
                    }
                    u32x4 w; w.x = cvt_pk_bf16(v0[0], v0[1]); w.y = cvt_pk_bf16(v0[2], v0[3]); w.z = cvt_pk_bf16(v1[0], v1[1]); w.w = cvt_pk_bf16(v1[2], v1[3]);
                    *(u32x4*)(base + (size_t)row * ld + cc) = w;
                }
        }
    }
};
template <class Epi, class Sched, bool ALIGN_EPI = false, bool SP2 = false>
__device__ __forceinline__ void gemm_phase(PG8_LAS unsigned char* lds, const Gemm g, const Sched& S, const Epi& E) {
    const int tid = threadIdx.x, wid = __builtin_amdgcn_readfirstlane(tid >> 6), lane = tid & 63, wr = wid >> 2, wc = wid & 3, fr = lane & 15, fq = lane >> 4;
    const int K = g.K, nt = K / BK;
    unsigned voffA[2], voffB[2];
#pragma unroll
    for (int i = 0; i < 2; ++i) { int R, C; stage_rc(tid * 16 + i * 8192, R, C); const int Rb = Epi::PERM ? ((R & ~31) + perm32(R & 31)) : R;
        voffA[i] = (unsigned)(R * K + C) * 2u; voffB[i] = (unsigned)(Rb * K + C) * 2u; }
    const size_t kstep = (size_t)(BK * 2);
    const size_t hstep = (size_t)HALF * K * 2;
    const size_t tstep = 2 * hstep;
    const unsigned ldsw = (unsigned)wid * 1024u;
    const int aoff = lds_byte(wr * 64 + fr, fq * 8), boff = lds_byte(wc * 32 + fr, fq * 8);
#define PG8_SA(b, h) (((b) * 2 + (h)) * HTB)
#define PG8_SB(b, h) ((4 + (b) * 2 + (h)) * HTB)
#define PG8_STAGE(bufoff, gbase, voff) do { _Pragma("unroll") for (int _i = 0; _i < 2; ++_i) \
        __builtin_amdgcn_global_load_lds((const unsigned*)((const char*)(gbase) + (voff)[_i]), (PG8_LAS unsigned*)(lds + (bufoff) + ldsw + _i * 8192), 16, 0, 0); } while (0)
#define PG8_LDA(dst, b, h) do { _Pragma("unroll") for (int m = 0; m < 4; ++m) _Pragma("unroll") for (int k = 0; k < 2; ++k) dst[m][k] = *(const PG8_LAS bf16x8*)(lds + PG8_SA(b, h) + aoff + m * 2048 + k * 1024); } while (0)
#define PG8_LDB(dst, b, h) do { _Pragma("unroll") for (int n = 0; n < 2; ++n) _Pragma("unroll") for (int k = 0; k < 2; ++k) dst[n][k] = *(const PG8_LAS bf16x8*)(lds + PG8_SB(b, h) + boff + n * 2048 + k * 1024); } while (0)
#define PG8_MMA(ai, bj, At, Bt) do { __builtin_amdgcn_s_setprio(1); _Pragma("unroll") for (int m = 0; m < 4; ++m) _Pragma("unroll") for (int n = 0; n < 2; ++n) _Pragma("unroll") for (int k = 0; k < 2; ++k) \
        acc[ai][bj][m][n] = __builtin_amdgcn_mfma_f32_16x16x32_bf16(Bt[n][k], At[m][k], acc[ai][bj][m][n], 0, 0, 0); __builtin_amdgcn_s_setprio(0); } while (0)
#define PG8_WAIT_V(n) asm volatile("s_waitcnt vmcnt(" #n ")" ::: "memory")
#define PG8_WAIT_L(n) asm volatile("s_waitcnt lgkmcnt(" #n ")" ::: "memory")
#define PG8_BAR __builtin_amdgcn_s_barrier()
#define PG8_SCHED __builtin_amdgcn_sched_barrier(0)
    Unit cur, nxt; int ui = 0;
    if (!S.next(0, cur)) return;
    f32x4 acc[2][2][4][2];
#pragma unroll
    for (int a = 0; a < 2; ++a)
#pragma unroll
        for (int b = 0; b < 2; ++b)
#pragma unroll
            for (int m = 0; m < 4; ++m)
#pragma unroll
                for (int n = 0; n < 2; ++n) acc[a][b][m][n] = (f32x4){0.f, 0.f, 0.f, 0.f};
    bf16x8 At[4][2], B0[2][2], B1[2][2];
    const char* cA = (const char*)g.A + (size_t)cur.pm * tstep; const char* cB = (const char*)g.Bt + (size_t)cur.pn * tstep;
    S.a_ready(cur);
    if constexpr (SP2) {
        PG8_STAGE(PG8_SB(0, 0), cB, voffB); PG8_STAGE(PG8_SB(0, 1), cB + hstep, voffB); PG8_STAGE(PG8_SA(0, 0), cA, voffA); PG8_STAGE(PG8_SA(0, 1), cA + hstep, voffA);
        if (wr == 1) PG8_BAR;
        PG8_WAIT_V(2); PG8_BAR;
        PG8_STAGE(PG8_SB(1, 0), cB + kstep, voffB); PG8_STAGE(PG8_SA(1, 0), cA + kstep, voffA); PG8_STAGE(PG8_SB(1, 1), cB + hstep + kstep, voffB);
        PG8_WAIT_V(6); PG8_BAR;
    } else {
        PG8_STAGE(PG8_SB(0, 0), cB, voffB); PG8_STAGE(PG8_SA(0, 0), cA, voffA); PG8_STAGE(PG8_SB(0, 1), cB + hstep, voffB); PG8_STAGE(PG8_SA(0, 1), cA + hstep, voffA);
        if (wr == 1) PG8_BAR;
        PG8_WAIT_V(4); PG8_BAR;
        PG8_STAGE(PG8_SB(1, 0), cB + kstep, voffB); PG8_STAGE(PG8_SA(1, 0), cA + kstep, voffA); PG8_STAGE(PG8_SB(1, 1), cB + hstep + kstep, voffB);
        PG8_WAIT_V(6); PG8_BAR;
    }
    for (;;) {
        const bool has_next = S.next(ui + 1, nxt);
        const char* nA = has_next ? (const char*)g.A + (size_t)nxt.pm * tstep : cA; const char* nB = has_next ? (const char*)g.Bt + (size_t)nxt.pn * tstep : cB;
        for (int t = 0; t < nt; t += 2) {
            const bool last = (t == nt - 2);
            const char* a1 = cA + (size_t)(t + 1) * kstep;
            const char* a2 = last ? nA : cA + (size_t)(t + 2) * kstep; const char* b2 = last ? nB : cB + (size_t)(t + 2) * kstep;
            const char* a3 = a2 + kstep; const char* b3 = b2 + kstep;
            if (last && has_next) S.a_ready(nxt);
            if constexpr (SP2) {
            PG8_LDB(B0, 0, 0); PG8_LDB(B1, 0, 1); PG8_SCHED; PG8_LDA(At, 0, 0); PG8_STAGE(PG8_SA(1, 1), a1 + hstep, voffA);
            PG8_WAIT_V(8); PG8_WAIT_L(0); PG8_BAR; PG8_MMA(0, 0, At, B0); PG8_MMA(0, 1, At, B1); PG8_BAR; PG8_SCHED;
            PG8_LDA(At, 0, 1); PG8_STAGE(PG8_SB(0, 0), b2, voffB); PG8_STAGE(PG8_SB(0, 1), b2 + hstep, voffB); PG8_STAGE(PG8_SA(0, 0), a2, voffA);
            PG8_WAIT_V(8); PG8_WAIT_L(0); PG8_BAR; PG8_MMA(1, 0, At, B0); PG8_MMA(1, 1, At, B1); PG8_BAR; PG8_SCHED;
            PG8_LDB(B0, 1, 0); PG8_LDB(B1, 1, 1); PG8_SCHED; PG8_LDA(At, 1, 0); PG8_STAGE(PG8_SA(0, 1), a2 + hstep, voffA);
            PG8_WAIT_V(8); PG8_WAIT_L(0); PG8_BAR; PG8_MMA(0, 0, At, B0); PG8_MMA(0, 1, At, B1); PG8_BAR; PG8_SCHED;
            PG8_LDA(At, 1, 1); PG8_STAGE(PG8_SB(1, 0), b3, voffB); PG8_STAGE(PG8_SB(1, 1), b3 + hstep, voffB); PG8_STAGE(PG8_SA(1, 0), a3, voffA);
            PG8_WAIT_V(8); PG8_WAIT_L(0); PG8_BAR; PG8_MMA(1, 0, At, B0); PG8_MMA(1, 1, At, B1); PG8_BAR; PG8_SCHED;
            } else {
            PG8_LDB(B0, 0, 0); PG8_SCHED; PG8_LDA(At, 0, 0); PG8_STAGE(PG8_SA(1, 1), a1 + hstep, voffA);
            PG8_WAIT_L(8); PG8_BAR; PG8_WAIT_L(0); PG8_MMA(0, 0, At, B0); PG8_BAR; PG8_SCHED;
            PG8_LDB(B1, 0, 1); PG8_STAGE(PG8_SB(0, 0), b2, voffB);
            PG8_BAR; PG8_WAIT_L(0); PG8_MMA(0, 1, At, B1); PG8_BAR;
            PG8_LDA(At, 0, 1); PG8_STAGE(PG8_SA(0, 0), a2, voffA);
            PG8_BAR; PG8_WAIT_L(0); PG8_MMA(1, 0, At, B0); PG8_BAR; PG8_SCHED;
            PG8_STAGE(PG8_SB(0, 1), b2 + hstep, voffB);
            PG8_WAIT_V(6); PG8_BAR; PG8_MMA(1, 1, At, B1); PG8_BAR;
            PG8_LDB(B0, 1, 0); PG8_SCHED; PG8_LDA(At, 1, 0); PG8_STAGE(PG8_SA(0, 1), a2 + hstep, voffA);
            PG8_WAIT_L(8); PG8_BAR; PG8_WAIT_L(0); PG8_MMA(0, 0, At, B0); PG8_BAR; PG8_SCHED;
            PG8_LDB(B1, 1, 1); PG8_STAGE(PG8_SB(1, 0), b3, voffB);
            PG8_BAR; PG8_WAIT_L(0); PG8_MMA(0, 1, At, B1); PG8_BAR;
            PG8_LDA(At, 1, 1); PG8_STAGE(PG8_SA(1, 0), a3, voffA);
            PG8_BAR; PG8_WAIT_L(0); PG8_MMA(1, 0, At, B0); PG8_BAR; PG8_SCHED;
            PG8_STAGE(PG8_SB(1, 1), b3 + hstep, voffB);
            PG8_WAIT_V(6); PG8_BAR; PG8_MMA(1, 1, At, B1); PG8_BAR;
            }
        }
        if constexpr (ALIGN_EPI) { if (wr == 0) PG8_BAR; }
        if constexpr (!Epi::AFTER_DRAIN) { E(acc, cur, wr, wc, fr, fq); S.done(cur); }
        if (!has_next) break;
#pragma unroll
        for (int a = 0; a < 2; ++a)
#pragma unroll
            for (int b = 0; b < 2; ++b)
#pragma unroll
                for (int m = 0; m < 4; ++m)
#pragma unroll
                    for (int n = 0; n < 2; ++n) acc[a][b][m][n] = (f32x4){0.f, 0.f, 0.f, 0.f};
        cur = nxt; cA = nA; cB = nB; ++ui;
        if constexpr (ALIGN_EPI) { if (wr == 1) PG8_BAR; }
    }
    PG8_WAIT_V(0);
    if constexpr (!ALIGN_EPI) { if (wr == 0) PG8_BAR; }
    PG8_BAR;
    if constexpr (Epi::AFTER_DRAIN) { E.fused(acc, cur, wr, wc, fr, fq, lds, wid, lane); S.done(cur); }
#undef PG8_SA
#undef PG8_SB
#undef PG8_STAGE
#undef PG8_LDA
#undef PG8_LDB
#undef PG8_MMA
#undef PG8_WAIT_V
#undef PG8_WAIT_L
#undef PG8_BAR
#undef PG8_SCHED
}
}

constexpr int NWAVES = 8;
constexpr int DM = 2048, NB = 4, SEQ = 4096, NTOK = NB * SEQ;
constexpr int NMETA = 16, NVALID = NTOK + NMETA, MROWS = 16640;
constexpr int IN_COLS = 5376;
constexpr float LN_EPS = 1e-5f, GN_EPS = 1e-5f;
constexpr float ALPHA = 1.189207115002721f;
constexpr float LOG2E = 1.4426950408889634f;
constexpr float QSCALE = 0.125f * LOG2E;
constexpr float U_SCALE = 64.0f, V_SCALE = 4.0f;
constexpr int NSL = 16;

constexpr size_t MiB = 1u << 20;
constexpr size_t WS_CTL = 0, CTL_ZERO_BYTES = 1 * MiB;
constexpr size_t SZ_SK = (size_t)16 * 128 * 128 * 2, SZ_ROPE_R = (size_t)4112 * 128 * 8, SZ_ROPE_A = (size_t)4112 * 32 * 8;
constexpr size_t SZ_W2T = (size_t)DM * DM * 2, SZ_W1T = (size_t)IN_COLS * DM * 2, SZ_TAB = (size_t)16384 * DM * 2;
constexpr size_t SZ_ROWS2K = (size_t)MROWS * 2048 * 2, SZ_ROWS1K = (size_t)MROWS * 1024 * 2, SZ_ROWS128 = (size_t)MROWS * 128 * 2;
constexpr size_t SZ_TOK2K = (size_t)NTOK * 2048 * 2, SZ_ST = (size_t)16 * 32 * 256 * 256 * 2, SZ_IDS = (size_t)NTOK * 128 * 4;
constexpr size_t al256(size_t x) { return (x + 255) & ~(size_t)255; }
constexpr size_t WS_SK = 1 * MiB;
constexpr size_t WS_ROPE_R = al256(WS_SK + SZ_SK);
constexpr size_t WS_ROPE_A = al256(WS_ROPE_R + SZ_ROPE_R);
constexpr size_t WS_W2T = al256(WS_ROPE_A + SZ_ROPE_A), WS_W3T = al256(WS_W2T + SZ_W2T), WS_W1T = al256(WS_W3T + SZ_W2T);
constexpr size_t WS_UT = al256(WS_W1T + SZ_W1T), WS_VT = al256(WS_UT + SZ_TAB);
constexpr size_t WS_H0 = al256(WS_VT + SZ_TAB);
constexpr size_t WS_QR = al256(WS_H0 + SZ_ROWS2K);
constexpr size_t WS_KA = al256(WS_QR + SZ_ROWS2K), WS_VA = al256(WS_KA + SZ_ROWS128);
constexpr size_t WS_RK = al256(WS_VA + SZ_ROWS128), WS_RV = al256(WS_RK + SZ_ROWS1K), WS_RG = al256(WS_RV + SZ_ROWS1K);
constexpr size_t WS_ST = al256(WS_RG + SZ_ROWS1K);
constexpr size_t WS_Y = WS_RK;
constexpr size_t WS_H1 = WS_ST;
constexpr size_t WS_IDS = al256(WS_ST + SZ_ST), WS_GATES = al256(WS_IDS + SZ_IDS);
constexpr size_t WS_END = al256(WS_GATES + SZ_IDS);
static_assert(WS_Y + SZ_TOK2K <= WS_RG, "Y overlays RK|RV only");
static_assert(SZ_TOK2K <= SZ_ST && (size_t)NTOK * 1024 * 4 <= SZ_ST, "H1 / RET_RAW fit the state region");
static_assert(WS_END <= (size_t)512 * MiB, "workspace map fits 4 x largest tensor");
static_assert(WS_RK + (size_t)8 * NTOK * 128 * 4 <= WS_ST && WS_KA + (size_t)NTOK * 128 * 4 <= WS_RK && WS_H0 + (size_t)NTOK * DM * 4 <= WS_KA, "expert-phase overlays (DOTX over RK|RV, CB over KA|VA, Y32 over H0|QR)");
constexpr int CW_TMO = 0, CW_BAR = 4096;

constexpr int RING_OFF = 0, RING_BYTES = 131072;
constexpr int LDSCTL_OFF = RING_BYTES, MISC_OFF = LDSCTL_OFF + 320;
constexpr int LDS_BYTES = 147456;

#define GAS __attribute__((address_space(1)))
#define LAS __attribute__((address_space(3)))
typedef unsigned short bf16;
typedef unsigned v4u __attribute__((ext_vector_type(4)));
typedef unsigned v2u __attribute__((ext_vector_type(2)));
typedef float f32x4 __attribute__((ext_vector_type(4)));
typedef float f32x2 __attribute__((ext_vector_type(2)));
typedef GAS unsigned gu32;
typedef __bf16 bf16x2_t __attribute__((ext_vector_type(2)));
#define RLX_AGENT __ATOMIC_RELAXED, __HIP_MEMORY_SCOPE_AGENT
#define LDS_WAIT() asm volatile("s_waitcnt lgkmcnt(0)" ::: "memory")
#define VM_WAIT() asm volatile("s_waitcnt vmcnt(0)" ::: "memory")
__device__ __forceinline__ unsigned f2bf(float f) { unsigned u = __builtin_bit_cast(unsigned, f); return (u + 0x7fffu + ((u >> 16) & 1u)) >> 16; }
__device__ __forceinline__ unsigned pk2(float lo, float hi) { return f2bf(lo) | (f2bf(hi) << 16); }
__device__ __forceinline__ float bflo(unsigned w) { return __uint_as_float(w << 16); }
__device__ __forceinline__ float bfhi(unsigned w) { return __uint_as_float(w & 0xffff0000u); }
__device__ __forceinline__ float bf2f(bf16 h) { return __uint_as_float((unsigned)h << 16); }

#define XB_TMO      128
#define XB_XCNT(j)  (256  + 64 * (j))
#define XB_XSUB(j)  (1280 + 64 * (j))
#define XB_XGEN(j)  (2304 + 64 * (j))
#define XB_TOP      3328
#define XB_TOPGEN   3392
#define XCD_BAR_WORDS 3456
#define XB_SPIN_CAP (1u << 18)

__device__ __forceinline__ unsigned xb_ld(unsigned* p)              { return __hip_atomic_load(p, __ATOMIC_RELAXED, __HIP_MEMORY_SCOPE_AGENT); }
__device__ __forceinline__ unsigned xb_add(unsigned* p, unsigned v) { return __hip_atomic_fetch_add(p, v, __ATOMIC_RELAXED, __HIP_MEMORY_SCOPE_AGENT); }
__device__ __forceinline__ unsigned xb_xcc_id() { return (unsigned)__builtin_amdgcn_s_getreg((3 << 11) | 20) & 0xFu; }
#define XB_SPIN(cond, bar) do { unsigned _sp = 0; while (cond) { __builtin_amdgcn_s_sleep(1); \
    if ((++_sp & 255u) == 0u) { if (xb_ld(&(bar)[XB_TMO])) break; if (_sp > XB_SPIN_CAP) { atomicAdd(&(bar)[XB_TMO], 1u); break; } } } } while (0)

struct XcdBarrier {
    unsigned* bar; unsigned x;
    volatile LAS unsigned* st;
};

__device__ __forceinline__ XcdBarrier xcd_barrier_post(unsigned* bar, volatile LAS unsigned* st) {
    XcdBarrier b; b.bar = bar; b.x = xb_xcc_id(); b.st = st;
    if (threadIdx.x == 0) (void)xb_add(&bar[XB_XCNT(b.x)], 1u);
    return b;
}
__device__ __forceinline__ void xcd_barrier_complete(unsigned* bar, unsigned x, unsigned& nloc, unsigned& nx) {
    const unsigned G = gridDim.x * gridDim.y * gridDim.z;
    unsigned sum, cnt, mine, sp = 0u;
    for (;;) {
        sum = 0u; cnt = 0u; mine = 0u;
#pragma unroll
        for (unsigned j = 0; j < 16; ++j) { const unsigned c = xb_ld(&bar[XB_XCNT(j)]); sum += c; cnt += (c > 0u) ? 1u : 0u; mine = (j == x) ? c : mine; }
        if (sum == G) break;
        __builtin_amdgcn_s_sleep(1);
        if ((++sp & 255u) == 0u) { if (xb_ld(&bar[XB_TMO])) break; if (sp > XB_SPIN_CAP) { atomicAdd(&bar[XB_TMO], 1u); break; } }
    }
    nloc = mine > 0u ? mine : 1u; nx = cnt > 0u ? cnt : 1u;
}

__device__ __forceinline__ void xcd_barrier(const XcdBarrier& b) {
    asm volatile("s_waitcnt vmcnt(0)" ::: "memory");
    __syncthreads();
    if (threadIdx.x == 0) {
        unsigned* bar = b.bar;
        __builtin_amdgcn_s_waitcnt(0);
        unsigned nloc = b.st[0], nx = b.st[1];
        if (nloc == 0u) { xcd_barrier_complete(bar, b.x, nloc, nx); b.st[0] = nloc; b.st[1] = nx; }
        const unsigned old = xb_add(&bar[XB_XSUB(b.x)], 1u);
        const unsigned gen = old / nloc;
        if (old + 1u == (gen + 1u) * nloc) {
            __builtin_amdgcn_fence(__ATOMIC_RELEASE, "agent");
            asm volatile("s_waitcnt vmcnt(0)" ::: "memory");
            const unsigned og = xb_add(&bar[XB_TOP], 1u);
            const unsigned tg = og / nx;
            if (og + 1u == (tg + 1u) * nx) xb_add(&bar[XB_TOPGEN], 1u);
            else XB_SPIN(xb_ld(&bar[XB_TOPGEN]) == tg, bar);
            __builtin_amdgcn_fence(__ATOMIC_ACQUIRE, "agent");
            xb_add(&bar[XB_XGEN(b.x)], 1u);
            asm volatile("s_waitcnt vmcnt(0)" ::: "memory");
        } else {
            XB_SPIN(xb_ld(&bar[XB_XGEN(b.x)]) == gen, bar);
            __builtin_amdgcn_fence(__ATOMIC_ACQUIRE, "agent");
            asm volatile("s_waitcnt vmcnt(0)" ::: "memory");
        }
    }
    __syncthreads();
}


__device__ __forceinline__ float dot2bf(unsigned a, unsigned b, float c) { asm("v_dot2c_f32_bf16 %0, %1, %2" : "+v"(c) : "v"(a), "v"(b)); return c; }
__device__ __forceinline__ float dot8bf_dpp(v4u a, v4u b) { float c = 0.f; asm("v_dot2c_f32_bf16 %0, %1, %5\n\tv_dot2c_f32_bf16 %0, %2, %6\n\tv_dot2c_f32_bf16 %0, %3, %7\n\tv_dot2c_f32_bf16 %0, %4, %8\n\ts_nop 1" : "+v"(c) : "v"(a.x), "v"(a.y), "v"(a.z), "v"(a.w), "v"(b.x), "v"(b.y), "v"(b.z), "v"(b.w)); return c; }
__device__ __forceinline__ float wave_sum(float v) {
#pragma unroll
    for (int o = 1; o < 64; o <<= 1) v += __shfl_xor(v, o);
    return v;
}
__device__ __forceinline__ float gelu_erf(float v) {
    const float av = fabsf(v), d = av * 0.2316418882f + 1.0f;
    const float t = __builtin_amdgcn_rcpf(d);
    float q = t * 0.5307027145f + (-0.7265760135f); q = q * t + 0.7107068705f; q = q * t + (-0.142248368f); q = q * t + 0.127414796f; q = q * t;
    const float e = __builtin_amdgcn_exp2f((v * v) * (-0.72134752044f));
    const float m = v * (q * e);
    return v < 0.f ? m : v - m;
}

struct Args { const float* in[15]; float* out; unsigned char* ws; };

__device__ __forceinline__ void p0_transpose_item(const float* W, int K, int N, bf16* WT, LAS float* scr, int item, int lane) {
    const int nblk = N / 32, kb = item / nblk, nb = item % nblk, k0 = 64 * kb, n0 = 32 * nb;
#pragma unroll 8
    for (int i = 0; i < 32; ++i) { const int kk = 2 * i + (lane >> 5); scr[kk * 33 + (lane & 31)] = W[(size_t)(k0 + kk) * N + n0 + (lane & 31)]; }
    LDS_WAIT(); asm volatile("" ::: "memory");
    const int c = lane & 7;
#pragma unroll
    for (int j = 0; j < 4; ++j) { const int n = (lane >> 3) + 8 * j; const LAS float* s = scr + (8 * c) * 33 + n;
        v4u o; o.x = pk2(s[0 * 33], s[1 * 33]); o.y = pk2(s[2 * 33], s[3 * 33]); o.z = pk2(s[4 * 33], s[5 * 33]); o.w = pk2(s[6 * 33], s[7 * 33]);
        *(GAS v4u*)(WT + (size_t)(n0 + n) * K + k0 + 8 * c) = o; }
    LDS_WAIT(); asm volatile("" ::: "memory");
}
__device__ __forceinline__ void ln_row_f32_to_bf16(const float* xrow, const float* g, const float* bta, bf16* orow, int lane) {
    const GAS f32x4* xr = (const GAS f32x4*)xrow + lane;
    f32x4 v[8]; float s = 0.f;
#pragma unroll
    for (int j = 0; j < 8; ++j) { v[j] = xr[64 * j]; s += (v[j].x + v[j].y) + (v[j].z + v[j].w); }
    const float mean = wave_sum(s) * (1.f / DM); float s2 = 0.f;
#pragma unroll
    for (int j = 0; j < 8; ++j) { v[j] = v[j] - mean; s2 += (v[j].x * v[j].x + v[j].y * v[j].y) + (v[j].z * v[j].z + v[j].w * v[j].w); }
    const float rstd = 1.f / sqrtf(wave_sum(s2) * (1.f / DM) + LN_EPS);
    GAS v2u* o8 = (GAS v2u*)orow + lane;
#pragma unroll
    for (int j = 0; j < 8; ++j) { const f32x4 gg = ((const GAS f32x4*)g)[lane + 64 * j], bb = ((const GAS f32x4*)bta)[lane + 64 * j];
        v2u o; o.x = pk2(v[j].x * rstd * gg.x + bb.x, v[j].y * rstd * gg.y + bb.y); o.y = pk2(v[j].z * rstd * gg.z + bb.z, v[j].w * rstd * gg.w + bb.w); o8[64 * j] = o; }
}
__device__ __forceinline__ void ln_row_bf16_to_bf16(const bf16* xrow, const float* g, const float* bta, bf16* orow, int lane) {
    const GAS v4u* xr = (const GAS v4u*)xrow + lane;
    float v[32]; float s = 0.f;
#pragma unroll
    for (int j = 0; j < 4; ++j) { const v4u w = xr[64 * j];
        v[8 * j + 0] = bflo(w.x); v[8 * j + 1] = bfhi(w.x); v[8 * j + 2] = bflo(w.y); v[8 * j + 3] = bfhi(w.y);
        v[8 * j + 4] = bflo(w.z); v[8 * j + 5] = bfhi(w.z); v[8 * j + 6] = bflo(w.w); v[8 * j + 7] = bfhi(w.w); }
#pragma unroll
    for (int i = 0; i < 32; ++i) s += v[i];
    const float mean = wave_sum(s) * (1.f / DM); float s2 = 0.f;
#pragma unroll
    for (int i = 0; i < 32; ++i) { v[i] -= mean; s2 += v[i] * v[i]; }
    const float rstd = 1.f / sqrtf(wave_sum(s2) * (1.f / DM) + LN_EPS);
    GAS v4u* o16 = (GAS v4u*)orow + lane;
#pragma unroll
    for (int j = 0; j < 4; ++j) {
        const GAS f32x4* gp = (const GAS f32x4*)g + 2 * (lane + 64 * j); const GAS f32x4* bp = (const GAS f32x4*)bta + 2 * (lane + 64 * j);
        const f32x4 g0 = gp[0], g1 = gp[1], b0 = bp[0], b1 = bp[1];
        v4u o; o.x = pk2(v[8 * j + 0] * rstd * g0.x + b0.x, v[8 * j + 1] * rstd * g0.y + b0.y); o.y = pk2(v[8 * j + 2] * rstd * g0.z + b0.z, v[8 * j + 3] * rstd * g0.w + b0.w);
        o.z = pk2(v[8 * j + 4] * rstd * g1.x + b1.x, v[8 * j + 5] * rstd * g1.y + b1.y); o.w = pk2(v[8 * j + 6] * rstd * g1.z + b1.z, v[8 * j + 7] * rstd * g1.w + b1.w);
        o16[64 * j] = o; }
}
__device__ __forceinline__ void row_pos(int r, int& pos, int& ipos) {
    if (r < NTOK) { const int s = r & (SEQ - 1); pos = NMETA + s; ipos = s & 127; }
    else { int j = r - NTOK; if (j > NMETA - 1) j = NMETA - 1; pos = j; ipos = 112 + j; }
}
__device__ __forceinline__ float log2_gamma(int h) { return log2f(1.0f - exp2f(-5.0f - (float)h)); }


typedef short bf16x8 __attribute__((ext_vector_type(8)));
typedef short s16x4 __attribute__((ext_vector_type(4)));
#define MFMA16(a, b, c) __builtin_amdgcn_mfma_f32_16x16x32_bf16((a), (b), (c), 0, 0, 0)
__device__ __forceinline__ s16x4 tr16(LAS const unsigned char* p) { return __builtin_bit_cast(s16x4, __builtin_amdgcn_ds_read_tr16_b64_v4i16((LAS s16x4*)p)); }
__device__ __forceinline__ bf16x8 cat8(s16x4 a, s16x4 b) { return __builtin_shufflevector(a, b, 0, 1, 2, 3, 4, 5, 6, 7); }
__device__ __forceinline__ unsigned cvtpk_s(float lo, float hi) { f32x2 v = {lo, hi}; bf16x2_t b = __builtin_convertvector(v, bf16x2_t); return __builtin_bit_cast(unsigned, b); }
__device__ __forceinline__ unsigned cvtpk(float lo, float hi) { unsigned r; asm("v_cvt_pk_bf16_f32 %0, %1, %2" : "=v"(r) : "v"(lo), "v"(hi)); return r; }

__device__ __forceinline__ void scan_unit(LAS unsigned char* L, int u, const bf16* RK, const bf16* RV, bf16* ST, int tid, int lane, int wave) {
    asm volatile("" : "+v"(tid)); lane = tid & 63;
    const int bh = u >> 4, di = (u >> 2) & 3, ei = u & 3, b = bh >> 2, h = bh & 3;
    const float g128 = exp2f(128.0f * log2_gamma(h));
    const int li = lane & 15, g = lane >> 4, q = li >> 2, p4 = li & 3;
    const int eb = wave >> 1, db0 = 2 * (wave & 1);
    f32x4 acc[2]; acc[0] = (f32x4){0.f, 0.f, 0.f, 0.f}; acc[1] = acc[0];
    v4u kreg[2], vreg[2];
#define SCAN_LOAD(cc) do { _Pragma("unroll") for (int i_ = 0; i_ < 2; ++i_) { const int cid_ = tid + 512 * i_, row_ = cid_ >> 3, c16_ = cid_ & 7; \
        int srow_; bool ok_ = true; if ((cc) < 0) { ok_ = row_ >= 112; srow_ = NTOK + (ok_ ? row_ - 112 : 0); } else srow_ = b * SEQ + (cc) * 128 + row_; \
        const v4u kz_ = *(const GAS v4u*)(RK + (size_t)srow_ * 1024 + h * 256 + di * 64 + c16_ * 8), vz_ = *(const GAS v4u*)(RV + (size_t)srow_ * 1024 + h * 256 + ei * 64 + c16_ * 8); \
        kreg[i_] = ok_ ? kz_ : (v4u){0u, 0u, 0u, 0u}; vreg[i_] = ok_ ? vz_ : (v4u){0u, 0u, 0u, 0u}; } } while (0)
#define SCAN_WRITE(bufp) do { _Pragma("unroll") for (int i_ = 0; i_ < 2; ++i_) { const int cid_ = tid + 512 * i_, row_ = cid_ >> 3, c16_ = cid_ & 7; \
        *(LAS v4u*)((bufp) + row_ * 128 + c16_ * 16) = kreg[i_]; *(LAS v4u*)((bufp) + 16384 + row_ * 128 + c16_ * 16) = vreg[i_]; } } while (0)
    SCAN_LOAD(-1); SCAN_WRITE(L); __syncthreads();
    int cur = 0;
    for (int cc = -1; cc <= 30; ++cc) {
        if (cc < 30) SCAN_LOAD(cc + 1);
        LAS const unsigned char* Kt = L + cur * 32768; LAS const unsigned char* Vt = Kt + 16384;
#pragma unroll
        for (int ks = 0; ks < 4; ++ks) {
            const int r0 = (32 * ks + 8 * g + q) * 128;
            const bf16x8 a = cat8(tr16(Vt + r0 + (16 * eb + 4 * p4) * 2), tr16(Vt + r0 + 512 + (16 * eb + 4 * p4) * 2));
#pragma unroll
            for (int n = 0; n < 2; ++n) {
                const bf16x8 bb = cat8(tr16(Kt + r0 + (16 * (db0 + n) + 4 * p4) * 2), tr16(Kt + r0 + 512 + (16 * (db0 + n) + 4 * p4) * 2));
                acc[n] = MFMA16(a, bb, acc[n]);
            }
        }
#pragma unroll
        for (int n = 0; n < 2; ++n) {
            acc[n] = acc[n] * g128;
            bf16* sp = ST + ((size_t)(bh * 32 + cc + 1) * 256 + (64 * ei + 16 * eb + 4 * g)) * 256 + 64 * di + 16 * (db0 + n) + li;
#pragma unroll
            for (int r = 0; r < 4; ++r) sp[(size_t)r * 256] = (bf16)f2bf(acc[n][r]);
        }
        if (cc < 30) SCAN_WRITE(L + (cur ^ 1) * 32768);
        __syncthreads(); cur ^= 1;
    }
#undef SCAN_LOAD
#undef SCAN_WRITE
}

__device__ __forceinline__ void retout_unit(LAS unsigned char* L, int u, bf16* QR, const bf16* RK, const bf16* RV, const bf16* RG, const bf16* ST, int tid, int lane, int wave) {
    asm volatile("" : "+v"(tid)); lane = tid & 63;
    const int bh = u >> 5, c = u & 31, b = bh >> 2, h = bh & 3;
    const int R0 = b * SEQ + c * 128;
    const int li = lane & 15, g = lane >> 4, q = li >> 2, p4 = li & 3;
    LAS unsigned char* RA = L; LAS unsigned char* RB = L + 65536;
#pragma unroll
    for (int i = 0; i < 8; ++i) { const int cid = tid + 512 * i, j = cid >> 5, ch = cid & 31;
        const v4u kz = *(const GAS v4u*)(RK + (size_t)(R0 + j) * 1024 + h * 256 + ch * 8), vz = *(const GAS v4u*)(RV + (size_t)(R0 + j) * 1024 + h * 256 + ch * 8);
        *(LAS v4u*)(RA + j * 512 + ((ch ^ (j & 15)) << 4)) = kz; *(LAS v4u*)(RB + j * 512 + ((ch ^ ((j & 7) << 1)) << 4)) = vz; }
    bf16x8 qf[8];
    { const GAS v4u* qp = (const GAS v4u*)(QR + (size_t)(R0 + 16 * wave + li) * 2048 + 1024 + h * 256 + 8 * g);
#pragma unroll
      for (int ks = 0; ks < 8; ++ks) qf[ks] = __builtin_bit_cast(bf16x8, qp[4 * ks]); }
    __syncthreads();
    f32x4 st[8];
#pragma unroll
    for (int jt = 0; jt < 8; ++jt) st[jt] = (f32x4){0.f, 0.f, 0.f, 0.f};
#pragma unroll
    for (int jt = 0; jt < 8; ++jt) if (jt <= wave) {
        const int j = 16 * jt + li;
#pragma unroll
        for (int ks = 0; ks < 8; ++ks) { const bf16x8 a = *(LAS const bf16x8*)(RA + j * 512 + (((4 * ks + g) ^ li) << 4)); st[jt] = MFMA16(a, qf[ks], st[jt]); }
        if (jt == wave) {
#pragma unroll
            for (int r = 0; r < 4; ++r) if (4 * g + r > li) st[jt][r] = 0.f; }
    }
    bf16x8 pf[4];
#pragma unroll
    for (int s = 0; s < 4; ++s) { v4u w; w.x = cvtpk_s(st[2 * s][0], st[2 * s][1]); w.y = cvtpk_s(st[2 * s][2], st[2 * s][3]); w.z = cvtpk_s(st[2 * s + 1][0], st[2 * s + 1][1]); w.w = cvtpk_s(st[2 * s + 1][2], st[2 * s + 1][3]); pf[s] = __builtin_bit_cast(bf16x8, w); }
    __syncthreads();
    const bf16* Sg = ST + (size_t)(bh * 32 + c) * 65536;
#define RO_STAGE_ST(dst, s0) do { _Pragma("unroll") for (int i_ = 0; i_ < 8; ++i_) { const int cid_ = tid + 512 * i_, sl_ = cid_ >> 11, e_ = (cid_ >> 3) & 255, ch_ = cid_ & 7; \
        const v4u z_ = *(const GAS v4u*)(Sg + (size_t)e_ * 256 + 64 * ((s0) + sl_) + ch_ * 8); *(LAS v4u*)((dst) + sl_ * 32768 + e_ * 128 + ((ch_ ^ (e_ & 7)) << 4)) = z_; } } while (0)
    RO_STAGE_ST(RA, 0);
    f32x4 o[16];
#pragma unroll
    for (int et = 0; et < 16; ++et) o[et] = (f32x4){0.f, 0.f, 0.f, 0.f};
#pragma unroll
    for (int s = 0; s < 4; ++s) if (2 * s <= wave) {
        const int r1 = 32 * s + 4 * g + q, r2 = r1 + 16;
#pragma unroll
        for (int et = 0; et < 16; ++et) {
            const int chn = 2 * et + (p4 >> 1);
            const bf16x8 a = cat8(tr16(RB + r1 * 512 + ((chn ^ ((r1 & 7) << 1)) << 4) + (p4 & 1) * 8), tr16(RB + r2 * 512 + ((chn ^ ((r2 & 7) << 1)) << 4) + (p4 & 1) * 8));
            o[et] = MFMA16(a, pf[s], o[et]);
        }
    }
    __syncthreads();
    RO_STAGE_ST(RB, 2);
#define RO_STATE_MMA(src, s0) do { _Pragma("unroll") for (int sl_ = 0; sl_ < 2; ++sl_) _Pragma("unroll") for (int k2_ = 0; k2_ < 2; ++k2_) _Pragma("unroll") for (int et = 0; et < 16; ++et) { \
        const int e_ = 16 * et + li; const bf16x8 a_ = *(LAS const bf16x8*)((src) + sl_ * 32768 + e_ * 128 + (((4 * k2_ + g) ^ (e_ & 7)) << 4)); \
        o[et] = MFMA16(a_, qf[2 * ((s0) + sl_) + k2_], o[et]); } } while (0)
    RO_STATE_MMA(RA, 0);
    __syncthreads();
    RO_STATE_MMA(RB, 2);
#undef RO_STAGE_ST
#undef RO_STATE_MMA
    float s1 = 0.f;
#pragma unroll
    for (int et = 0; et < 16; ++et) s1 += (o[et][0] + o[et][1]) + (o[et][2] + o[et][3]);
    s1 += __shfl_xor(s1, 16); s1 += __shfl_xor(s1, 32);
    const float mu = s1 * (1.0f / 256.0f); float s2 = 0.f;
#pragma unroll
    for (int et = 0; et < 16; ++et) { o[et] = o[et] - mu; s2 += (o[et][0] * o[et][0] + o[et][1] * o[et][1]) + (o[et][2] * o[et][2] + o[et][3] * o[et][3]); }
    s2 += __shfl_xor(s2, 16); s2 += __shfl_xor(s2, 32);
    const float rstd = 1.0f / sqrtf(s2 * (1.0f / 256.0f) + GN_EPS);
    const int row = R0 + 16 * wave + li;
    const GAS v2u* gp = (const GAS v2u*)(RG + (size_t)row * 1024 + h * 256 + 4 * g); GAS v2u* op = (GAS v2u*)(QR + (size_t)row * 2048 + 1024 + h * 256 + 4 * g);
#pragma unroll
    for (int et = 0; et < 16; ++et) { const v2u gz = gp[4 * et]; v2u w;
        w.x = cvtpk(o[et][0] * rstd * bflo(gz.x), o[et][1] * rstd * bfhi(gz.x)); w.y = cvtpk(o[et][2] * rstd * bflo(gz.y), o[et][3] * rstd * bfhi(gz.y)); op[4 * et] = w; }
    __syncthreads();
}

typedef float f32x16 __attribute__((ext_vector_type(16)));
#define MFMA32(a, b, c) __builtin_amdgcn_mfma_f32_32x32x16_bf16((a), (b), (c), 0, 0, 0)
__device__ __forceinline__ int crow32(int reg, int hh) { return (reg & 3) + 8 * (reg >> 2) + 4 * hh; }

__device__ __forceinline__ void attn_unit(LAS unsigned char* L, int u, bf16* QR, const bf16* KA, const bf16* VA, const float* sinks, int tid, int lane, int wave) {
    asm volatile("" : "+v"(tid)); lane = tid & 63;
    const int b = u >> 6, j = (u >> 1) & 31, g2 = u & 1, hq = 8 * g2 + wave;
    const int R0 = b * SEQ + 128 * j;
    LAS unsigned char* Kt = L; LAS unsigned char* Vt = L + 32768;
#pragma unroll
    for (int i = 0; i < 4; ++i) { const int cid = tid + 512 * i, kk = cid >> 3, ch = cid & 7;
        int srow; bool ok = true;
        if (kk >= 128) srow = R0 + kk - 128; else if (j > 0) srow = R0 - 128 + kk; else { ok = kk >= 112; srow = NTOK + (ok ? kk - 112 : 0); }
        const v4u kz = *(const GAS v4u*)(KA + (size_t)srow * 128 + g2 * 64 + ch * 8), vz = *(const GAS v4u*)(VA + (size_t)srow * 128 + g2 * 64 + ch * 8);
        *(LAS v4u*)(Kt + kk * 128 + ((ch ^ (kk & 7)) << 4)) = ok ? kz : (v4u){0u, 0u, 0u, 0u};
        *(LAS v4u*)(Vt + kk * 128 + (ch << 4)) = ok ? vz : (v4u){0u, 0u, 0u, 0u}; }
    __syncthreads();
    const int r = lane & 31, hh = lane >> 5, blk = (lane >> 4) & 1, q = (lane & 15) >> 2, p4 = lane & 3;
    const float sk = sinks[hq] * LOG2E;
#pragma unroll 1
    for (int t = 0; t < 4; ++t) {
        const int i0 = 32 * t;
        bf16x8 qf[4];
        { const GAS v4u* qp = (const GAS v4u*)(QR + (size_t)(R0 + i0 + r) * 2048 + hq * 64 + 8 * hh);
#pragma unroll
          for (int ks = 0; ks < 4; ++ks) qf[ks] = __builtin_bit_cast(bf16x8, qp[2 * ks]); }
        f32x16 s[5];
#pragma unroll
        for (int x = 0; x < 5; ++x) {
            const int krow_ = 32 * (t + x) + r;
            f32x16 acc;
#pragma unroll
            for (int e = 0; e < 16; ++e) acc[e] = 0.f;
#pragma unroll
            for (int ks = 0; ks < 4; ++ks) { const bf16x8 a = *(LAS const bf16x8*)(Kt + krow_ * 128 + (((2 * ks + hh) ^ (krow_ & 7)) << 4)); acc = MFMA32(a, qf[ks], acc); }
            s[x] = acc; __builtin_amdgcn_sched_barrier(0);
        }
        float m = sk;
#pragma unroll
        for (int e = 0; e < 16; ++e) { const int cr = crow32(e, hh);
            if (!(cr > r)) s[0][e] = -1.0e30f;
            if (!(cr <= r)) s[4][e] = -1.0e30f; }
        if (j == 0) {
#pragma unroll
            for (int x = 0; x < 4; ++x) if (t + x <= 3) {
#pragma unroll
                for (int e = 0; e < 16; ++e) if (32 * (t + x) + crow32(e, hh) < 112) s[x][e] = -1.0e30f; }
        }
#pragma unroll
        for (int x = 0; x < 5; ++x)
#pragma unroll
            for (int e = 0; e < 16; ++e) m = fmaxf(m, s[x][e]);
        m = fmaxf(m, __shfl_xor(m, 32));
        float l = 0.f;
#pragma unroll
        for (int x = 0; x < 5; ++x)
#pragma unroll
            for (int e = 0; e < 16; ++e) { const float pv = exp2f(s[x][e] - m); s[x][e] = pv; l += pv; }
        l += __shfl_xor(l, 32);
        l += exp2f(sk - m);
        f32x16 o[2];
#pragma unroll
        for (int e = 0; e < 16; ++e) { o[0][e] = 0.f; o[1][e] = 0.f; }
#pragma unroll
        for (int x = 0; x < 5; ++x)
#pragma unroll
            for (int st = 0; st < 2; ++st) {
                v4u w; w.x = cvtpk_s(s[x][8 * st + 0], s[x][8 * st + 1]); w.y = cvtpk_s(s[x][8 * st + 2], s[x][8 * st + 3]); w.z = cvtpk_s(s[x][8 * st + 4], s[x][8 * st + 5]); w.w = cvtpk_s(s[x][8 * st + 6], s[x][8 * st + 7]);
                const bf16x8 pb = __builtin_bit_cast(bf16x8, w);
                const int k1 = 32 * (t + x) + 16 * st + 4 * hh + q, k2 = k1 + 8;
#pragma unroll
                for (int dc = 0; dc < 2; ++dc) {
                    const int cb = ((4 * dc + 2 * blk + (p4 >> 1)) << 4) + 8 * (p4 & 1);
                    const bf16x8 a = cat8(tr16(Vt + k1 * 128 + cb), tr16(Vt + k2 * 128 + cb));
                    o[dc] = MFMA32(a, pb, o[dc]);
                }
                __builtin_amdgcn_sched_barrier(0);
            }
        const float il = 1.0f / l;
        GAS v2u* op = (GAS v2u*)(QR + (size_t)(R0 + i0 + r) * 2048 + hq * 64 + 4 * hh);
#pragma unroll
        for (int dc = 0; dc < 2; ++dc)
#pragma unroll
            for (int g4 = 0; g4 < 4; ++g4) { v2u w; w.x = cvtpk_s(o[dc][4 * g4 + 0] * il, o[dc][4 * g4 + 1] * il); w.y = cvtpk_s(o[dc][4 * g4 + 2] * il, o[dc][4 * g4 + 3] * il); op[8 * dc + 2 * g4] = w; }
    }
    __syncthreads();
}

__device__ __forceinline__ unsigned ord_key(float f) { const unsigned u = __float_as_uint(f); return u ^ ((unsigned)((int)u >> 31) | 0x80000000u); }
__device__ __forceinline__ float ord_val(unsigned k) { return __uint_as_float(k ^ (((int)k < 0) ? 0x80000000u : 0xffffffffu)); }
#define TK_INS(arr, val) do { unsigned v_ = (val); _Pragma("unroll") for (int j_ = 0; j_ < 16; ++j_) { const unsigned hi_ = arr[j_] > v_ ? arr[j_] : v_; v_ = arr[j_] > v_ ? v_ : arr[j_]; arr[j_] = hi_; } } while (0)
__device__ __forceinline__ void topk_unit(LAS unsigned* Lw, int tt, int hd, const bf16* Q3, const bf16* SKB, unsigned short* IDS, float* GATES, int lane) {
    asm volatile("" : "+v"(lane));
    const int r = lane & 31, hh = lane >> 5, t0 = tt * 32;
    float sv[2][16];
#pragma unroll
    for (int p = 0; p < 2; ++p) {
        f32x16 acc[4];
#pragma unroll
        for (int nt = 0; nt < 4; ++nt)
#pragma unroll
            for (int e = 0; e < 16; ++e) acc[nt][e] = 0.f;
        const GAS v4u* qp = (const GAS v4u*)(Q3 + (size_t)(t0 + r) * DM + hd * 256 + p * 128 + 8 * hh);
        const GAS v4u* kp = (const GAS v4u*)(SKB + ((size_t)((hd * 2 + p) * 128 + r)) * 128 + 8 * hh);
#pragma unroll 2
        for (int ks = 0; ks < 8; ++ks) { const bf16x8 bq = __builtin_bit_cast(bf16x8, qp[2 * ks]);
#pragma unroll
            for (int nt = 0; nt < 4; ++nt) { const bf16x8 a = __builtin_bit_cast(bf16x8, kp[nt * 32 * 16 + 2 * ks]); acc[nt] = MFMA32(a, bq, acc[nt]); } }
        unsigned tk[16];
#pragma unroll
        for (int j2 = 0; j2 < 16; ++j2) tk[j2] = 0u;
#pragma unroll
        for (int nt = 0; nt < 4; ++nt)
#pragma unroll
            for (int e = 0; e < 16; ++e) { const int n = 32 * nt + crow32(e, hh); TK_INS(tk, (ord_key(acc[nt][e]) & 0xffffff80u) | (unsigned)(127 - n)); }
        unsigned pk[16];
#pragma unroll
        for (int j2 = 0; j2 < 16; ++j2) pk[j2] = (unsigned)__shfl_xor((int)tk[j2], 32);
#pragma unroll
        for (int j2 = 0; j2 < 16; ++j2) TK_INS(tk, pk[j2]);
#pragma unroll
        for (int j2 = 0; j2 < 16; ++j2) { sv[p][j2] = ord_val(tk[j2] & 0xffffff80u); Lw[(p * 16 + j2) * 64 + lane] = 127u - (tk[j2] & 0x7fu); }
    }
    unsigned fk[16];
#pragma unroll
    for (int j2 = 0; j2 < 16; ++j2) fk[j2] = 0u;
#pragma unroll
    for (int i = 0; i < 16; ++i)
#pragma unroll
        for (int j2 = 0; j2 < 16; ++j2) if ((i + 1) * (j2 + 1) <= 16) TK_INS(fk, (ord_key(sv[0][i] + sv[1][j2]) & 0xffffff00u) | (unsigned)(255 - (16 * i + j2)));
    float ev[16]; int idv[16]; float den = 0.f; const float f0 = ord_val(fk[0] & 0xffffff00u);
    LDS_WAIT();
#pragma unroll
    for (int k = 0; k < 16; ++k) { const unsigned idx = 255u - (fk[k] & 0xffu); const unsigned i1 = Lw[(idx >> 4) * 64 + lane], i2 = Lw[(16 + (idx & 15u)) * 64 + lane];
        idv[k] = (int)(i1 * 128u + i2); ev[k] = __expf(ord_val(fk[k] & 0xffffff00u) - f0); den += ev[k]; }
    const float iden = 1.0f / den;
    if (hh == 0) {
        GAS v4u* ip = (GAS v4u*)(IDS + (size_t)(t0 + r) * 128 + hd * 16); GAS f32x4* gp = (GAS f32x4*)(GATES + (size_t)(t0 + r) * 128 + hd * 16);
#pragma unroll
        for (int k8 = 0; k8 < 2; ++k8) ip[k8] = (v4u){(unsigned)idv[8 * k8] | ((unsigned)idv[8 * k8 + 1] << 16), (unsigned)idv[8 * k8 + 2] | ((unsigned)idv[8 * k8 + 3] << 16), (unsigned)idv[8 * k8 + 4] | ((unsigned)idv[8 * k8 + 5] << 16), (unsigned)idv[8 * k8 + 6] | ((unsigned)idv[8 * k8 + 7] << 16)};
#pragma unroll
        for (int k4 = 0; k4 < 4; ++k4) gp[k4] = (f32x4){ev[4 * k4] * iden, ev[4 * k4 + 1] * iden, ev[4 * k4 + 2] * iden, ev[4 * k4 + 3] * iden};
    }
    LDS_WAIT();
}

__global__ void __launch_bounds__(NWAVES * 64, 2) mk_fwd(Args args) {
    extern __shared__ __attribute__((aligned(16))) unsigned char lds[];
    LAS unsigned char* L = (LAS unsigned char*)lds;
    volatile LAS unsigned* MISC = (volatile LAS unsigned*)(L + MISC_OFF);
    const int tid = threadIdx.x, lane = tid & 63, wave = __builtin_amdgcn_readfirstlane(tid >> 6);
    const int G = gridDim.x, bx = blockIdx.x;
    const int vcu = (G % 8 == 0) ? (bx % 8) * (G / 8) + bx / 8 : bx;
    unsigned char* ws = args.ws;
    gu32* ctl = (gu32*)(ws + WS_CTL);
    const float* x = args.in[0]; const float* meta = args.in[1]; const float* ln_in_g = args.in[2]; const float* ln_in_b = args.in[3];
    const float* w_in = args.in[4]; const float* sinks = args.in[5]; const float* w_out = args.in[6]; const float* ln_mix_g = args.in[7]; const float* ln_mix_b = args.in[8];
    const float* wq = args.in[9]; const float* subkeys = args.in[10]; const float* u_tab = args.in[11]; const float* v_tab = args.in[12];
    const float* ln_ffn_g = args.in[13]; const float* ln_ffn_b = args.in[14];
    float* out = args.out;
    bf16* W1T = (bf16*)(ws + WS_W1T); bf16* W2T = (bf16*)(ws + WS_W2T); bf16* W3T = (bf16*)(ws + WS_W3T);
    bf16* H0 = (bf16*)(ws + WS_H0); bf16* QR = (bf16*)(ws + WS_QR); bf16* KA = (bf16*)(ws + WS_KA); bf16* VA = (bf16*)(ws + WS_VA);
    bf16* RK = (bf16*)(ws + WS_RK); bf16* RV = (bf16*)(ws + WS_RV); bf16* RG = (bf16*)(ws + WS_RG);
    bf16* Y = (bf16*)(ws + WS_Y); bf16* H1 = (bf16*)(ws + WS_H1); bf16* Q3 = (bf16*)(ws + WS_QR);
    bf16* STB = (bf16*)(ws + WS_ST);
    f32x2* ROPE_R = (f32x2*)(ws + WS_ROPE_R); f32x2* ROPE_A = (f32x2*)(ws + WS_ROPE_A);
    unsigned short* IDS = (unsigned short*)(ws + WS_IDS); float* GATES = (float*)(ws + WS_GATES);
    bf16* SKB = (bf16*)(ws + WS_SK);
    bf16* UT = (bf16*)(ws + WS_UT); bf16* VT = (bf16*)(ws + WS_VT);

    for (int u = tid; u < (LDS_BYTES - LDSCTL_OFF) / 4; u += NWAVES * 64) ((LAS unsigned*)(L + LDSCTL_OFF))[u] = 0u;
    __syncthreads();
    XcdBarrier bar; bar.bar = (unsigned*)(ctl + CW_BAR); bar.x = xb_xcc_id(); bar.st = MISC + 8;
    if (tid == 0) MISC[10] = xb_add(&bar.bar[XB_XCNT(bar.x)], 1u);
#define GRID_BAR() xcd_barrier(bar)
    const int gw = vcu * NWAVES + wave, NGW = G * NWAVES;
    const int gt = gw * 64 + lane, NGT = NGW * 64;

    {
        LAS float* scr = (LAS float*)(L + RING_OFF + wave * 16384);
        constexpr int I_1 = (DM / 64) * (IN_COLS / 32), I_2 = (DM / 64) * (DM / 32), I_3 = I_2;
        for (int it = gw; it < I_1 + I_2 + I_3; it += NGW) {
            int r = it;
            if (r < I_1) { p0_transpose_item(w_in, DM, IN_COLS, W1T, scr, r, lane); continue; } r -= I_1;
            if (r < I_2) { p0_transpose_item(w_out, DM, DM, W2T, scr, r, lane); continue; } r -= I_2;
            p0_transpose_item(wq, DM, DM, W3T, scr, r, lane);
        }
        for (int m = gw; m < MROWS; m += NGW) {
            if (m < NTOK) ln_row_f32_to_bf16(x + (size_t)m * DM, ln_in_g, ln_in_b, H0 + (size_t)m * DM, lane);
            else if (m < NVALID) ln_row_f32_to_bf16(meta + (size_t)(m - NTOK) * DM, ln_in_g, ln_in_b, H0 + (size_t)m * DM, lane);
            else { GAS v4u* o = (GAS v4u*)(H0 + (size_t)m * DM) + lane;
#pragma unroll
                for (int j = 0; j < 4; ++j) o[64 * j] = (v4u){0u, 0u, 0u, 0u}; }
        }
        for (int e = gt; e < 2 * (16384 * DM / 16); e += NGT) {
            const int which = e >= (16384 * DM / 16); const int i16 = which ? e - (16384 * DM / 16) : e; const int row = i16 >> 7, c = i16 & 127;
            const float sc = which ? V_SCALE : U_SCALE;
            const GAS f32x4* src = (const GAS f32x4*)(which ? v_tab : u_tab) + 4 * (size_t)i16; v4u o;
#pragma unroll
            for (int q4 = 0; q4 < 4; ++q4) { const f32x4 a = src[q4]; int w = __builtin_amdgcn_cvt_pk_fp8_f32(a.x * sc, a.y * sc, 0, false); w = __builtin_amdgcn_cvt_pk_fp8_f32(a.z * sc, a.w * sc, w, true); o[q4] = (unsigned)w; }
            ((GAS v4u*)(which ? (void*)VT : (void*)UT))[((size_t)(c >> 3) * 16384 + row) * 8 + (c & 7)] = o; }
        for (int e = gt; e < 16 * 128 * 128 / 8; e += NGT) { const GAS f32x4* src = (const GAS f32x4*)subkeys + 2 * (size_t)e; const f32x4 a = src[0], b2 = src[1];
            v4u o; o.x = pk2(a.x, a.y); o.y = pk2(a.z, a.w); o.z = pk2(b2.x, b2.y); o.w = pk2(b2.z, b2.w); ((GAS v4u*)SKB)[e] = o; }
        for (int e = gt; e < 4112 * 128; e += NGT) { const int pos = e >> 7, i = e & 127; const float inv = powf(10000.0f, -(float)(2 * i) / 256.0f); float sn, cs; sincosf((float)pos * inv, &sn, &cs); ROPE_R[e] = (f32x2){cs, sn}; }
        for (int e = gt; e < 4112 * 32; e += NGT) { const int pos = e >> 5, i = e & 31; const float inv = powf(10000.0f, -(float)(2 * i) / 64.0f); float sn, cs; sincosf((float)pos * inv, &sn, &cs); ROPE_A[e] = (f32x2){cs, sn}; }
    }
    GRID_BAR();

    {
        pg8::Gemm g{H0, W1T, MROWS, IN_COLS, DM}; pg8::StaticOrder S; S.init(MROWS, IN_COLS, G, bx);
        pg8::EpiGen<0> E{nullptr, 0, nullptr, 0.f, QR, KA, VA, RK, RV, RG};
        pg8::gemm_phase<pg8::EpiGen<0>, pg8::StaticOrder, true, true>(L + RING_OFF, g, S, E);
    }
    GRID_BAR();

    for (int r = gw; r < NVALID; r += NGW) {
        int pos, ipos; row_pos(r, pos, ipos);
        bf16* qr = QR + (size_t)r * 2048; bf16* ka = KA + (size_t)r * 128; bf16* rk = RK + (size_t)r * 1024; bf16* rg = RG + (size_t)r * 1024;
        for (int idx = lane; idx < 512; idx += 64) { const int a = idx >> 5, i = idx & 31; const f32x2 cs = ROPE_A[pos * 32 + i];
            const float x1 = bf2f(qr[64 * a + i]), x2 = bf2f(qr[64 * a + 32 + i]);
            qr[64 * a + i] = (bf16)f2bf((x1 * cs.x - x2 * cs.y) * QSCALE); qr[64 * a + 32 + i] = (bf16)f2bf((x2 * cs.x + x1 * cs.y) * QSCALE); }
        { const int a = lane >> 5, i = lane & 31; const f32x2 cs = ROPE_A[pos * 32 + i];
            const float x1 = bf2f(ka[64 * a + i]), x2 = bf2f(ka[64 * a + 32 + i]);
            ka[64 * a + i] = (bf16)f2bf(x1 * cs.x - x2 * cs.y); ka[64 * a + 32 + i] = (bf16)f2bf(x2 * cs.x + x1 * cs.y); }
        for (int idx = lane; idx < 512; idx += 64) { const int h = idx >> 7, i = idx & 127; const f32x2 cs = ROPE_R[pos * 128 + i];
            const float lg = log2_gamma(h); const float qs = exp2f((float)(ipos + 1) * lg), ks = 0.0625f * exp2f(-(float)(ipos + 1) * lg);
            { const float x1 = bf2f(qr[1024 + 256 * h + i]), x2 = bf2f(qr[1024 + 256 * h + 128 + i]);
              qr[1024 + 256 * h + i] = (bf16)f2bf((x1 * cs.x - x2 * cs.y) * qs); qr[1024 + 256 * h + 128 + i] = (bf16)f2bf((x2 * cs.x + x1 * cs.y) * qs); }
            { const float x1 = bf2f(rk[256 * h + i]), x2 = bf2f(rk[256 * h + 128 + i]);
              rk[256 * h + i] = (bf16)f2bf((x1 * cs.x - x2 * cs.y) * ks); rk[256 * h + 128 + i] = (bf16)f2bf((x2 * cs.x + x1 * cs.y) * ks); } }
        for (int idx = lane; idx < 1024; idx += 64) { const float v = bf2f(rg[idx]); rg[idx] = (bf16)f2bf(v / (1.0f + __expf(-v))); }
    }
    GRID_BAR();

    for (int u = bx; u < 256; u += G) attn_unit(L + RING_OFF, u, QR, KA, VA, sinks, tid, lane, wave);

    for (int u = bx; u < 256; u += G) scan_unit(L + RING_OFF, u, RK, RV, STB, tid, lane, wave);
    GRID_BAR();

    for (int u = bx; u < 512; u += G) retout_unit(L + RING_OFF, u, QR, RK, RV, RG, STB, tid, lane, wave);
    GRID_BAR();

    {
        pg8::Gemm g{QR, W2T, NTOK, DM, DM}; pg8::StaticOrder S; S.init(NTOK, DM, G, bx);
        pg8::EpiGen<1> E{Y, DM, H0, ALPHA, nullptr, nullptr, nullptr, nullptr, nullptr, nullptr};
        pg8::gemm_phase<pg8::EpiGen<1>, pg8::StaticOrder, true, true>(L + RING_OFF, g, S, E);
    }
    GRID_BAR();

    for (int m = gw; m < NTOK; m += NGW) ln_row_bf16_to_bf16(Y + (size_t)m * DM, ln_mix_g, ln_mix_b, H1 + (size_t)m * DM, lane);
    GRID_BAR();

    {
        pg8::Gemm g{H1, W3T, NTOK, DM, DM}; pg8::StaticOrder S; S.init(NTOK, DM, G, bx);
        pg8::EpiGen<2> E{Q3, DM, nullptr, 0.f, nullptr, nullptr, nullptr, nullptr, nullptr, nullptr};
        pg8::gemm_phase<pg8::EpiGen<2>, pg8::StaticOrder, true, true>(L + RING_OFF, g, S, E);
    }
    GRID_BAR();

    for (int un = gw; un < (NTOK / 32) * 8; un += NGW) topk_unit((LAS unsigned*)(L + RING_OFF + wave * 8192), un >> 3, un & 7, Q3, SKB, IDS, GATES, lane);
    GRID_BAR();

    int nx = 0, xr = 0, nloc = 1;
    { unsigned* bw = (unsigned*)(ctl + CW_BAR);
#pragma unroll
      for (unsigned j2 = 0; j2 < 16; ++j2) { const unsigned cnt = xb_ld(&bw[XB_XCNT(j2)]); nx += cnt > 0u; xr += (j2 < bar.x && cnt > 0u); if (j2 == bar.x) nloc = (int)cnt; }
      nx = __builtin_amdgcn_readfirstlane(nx); xr = __builtin_amdgcn_readfirstlane(xr); nloc = __builtin_amdgcn_readfirstlane(nloc); if (nx < 1) nx = 1; if (nloc < 1) nloc = 1; }
    const int lrank = __builtin_amdgcn_readfirstlane((int)MISC[10]);
    const int wv = lrank * NWAVES + wave, nwv = nloc * NWAVES;
    float* DOTX = (float*)(ws + WS_RK);
    bf16* CB = (bf16*)(ws + WS_KA);
    float* Y32 = (float*)(ws + WS_H0);
    {
        int tl = tid; asm volatile("" : "+v"(tl)); const int ln = tl & 63, k = ln >> 3, c8 = ln & 7;
        const unsigned char* UT8 = (const unsigned char*)UT;
        for (int s = xr; s < NSL; s += nx) {
            const unsigned char* Us = UT8 + (size_t)s * 16384 * 128;
            const bool first = (s == xr);
            v4u nid[2][2];
#pragma unroll
            for (int z = 0; z < 2; ++z) { const int tz = wv + z * nwv; const int tc = tz < NTOK ? tz : wv; const GAS v4u* ip = (const GAS v4u*)(IDS + (size_t)tc * 128 + 16 * k);
#pragma unroll
                for (int i = 0; i < 2; ++i) nid[z][i] = ip[i]; }
#pragma unroll 1
            for (int t = wv; t < NTOK; t += 2 * nwv) {
                const bool vB = (t + nwv) < NTOK; const int tt[2] = {t, vB ? t + nwv : t};
                v4u ub[2][16]; v4u hs[2][2]; f32x2 old[2];
#pragma unroll
                for (int z = 0; z < 2; ++z) {
#pragma unroll
                    for (int i = 0; i < 16; ++i) { const unsigned eid = (nid[z][i >> 3][(i >> 1) & 3] >> (16 * (i & 1))) & 0xffffu; ub[z][i] = *(const GAS v4u*)(Us + (size_t)eid * 128 + 16 * c8); }
                    { const GAS v4u* hp = (const GAS v4u*)(H1 + (size_t)tt[z] * DM + 128 * s + 16 * c8); hs[z][0] = hp[0]; hs[z][1] = hp[1]; } }
#pragma unroll
                for (int z = 0; z < 2; ++z) old[z] = first ? (f32x2){0.f, 0.f} : *(const GAS f32x2*)(DOTX + ((size_t)xr * NTOK + tt[z]) * 128 + 2 * ln);
#pragma unroll
                for (int z = 0; z < 2; ++z) { const int tz = t + (2 + z) * nwv; const int tc = tz < NTOK ? tz : t; const GAS v4u* ip = (const GAS v4u*)(IDS + (size_t)tc * 128 + 16 * k);
#pragma unroll
                    for (int i = 0; i < 2; ++i) nid[z][i] = ip[i]; }
#pragma unroll
                for (int z = 0; z < 2; ++z) {
                    float p[16]; float hf[16];
#pragma unroll
                    for (int i = 0; i < 2; ++i)
#pragma unroll
                        for (int c4 = 0; c4 < 4; ++c4) { hf[8 * i + 2 * c4] = bflo(hs[z][i][c4]); hf[8 * i + 2 * c4 + 1] = bfhi(hs[z][i][c4]); }
#pragma unroll
                    for (int i = 0; i < 16; ++i) { float d0 = 0.f, d1 = 0.f;
#pragma unroll
                        for (int dw = 0; dw < 4; ++dw) { const f32x2 fl = __builtin_amdgcn_cvt_pk_f32_fp8((int)ub[z][i][dw], false), fh = __builtin_amdgcn_cvt_pk_f32_fp8((int)ub[z][i][dw], true);
                            d0 += fl.x * hf[4 * dw]; d1 += fl.y * hf[4 * dw + 1]; d0 += fh.x * hf[4 * dw + 2]; d1 += fh.y * hf[4 * dw + 3]; }
                        float d = d0 + d1;
                        d += __int_as_float(__builtin_amdgcn_update_dpp(0, __float_as_int(d), 0xB1, 0xf, 0xf, true));
                        d += __int_as_float(__builtin_amdgcn_update_dpp(0, __float_as_int(d), 0x4E, 0xf, 0xf, true));
                        d += __int_as_float(__builtin_amdgcn_update_dpp(0, __float_as_int(d), 0x141, 0xf, 0xf, true));
                        p[i] = d; }
                    float q0 = p[0], q1 = p[1];
#pragma unroll
                    for (int j2 = 1; j2 < 8; ++j2) { q0 = (c8 == j2) ? p[2 * j2] : q0; q1 = (c8 == j2) ? p[2 * j2 + 1] : q1; }
                    if (z == 0 || vB) *(GAS f32x2*)(DOTX + ((size_t)xr * NTOK + tt[z]) * 128 + 2 * ln) = (f32x2){q0 + old[z].x, q1 + old[z].y};
                }
            }
        }
    }
    GRID_BAR();
    for (int idx = gt; idx < NTOK * 128; idx += NGT) { float d = 0.f; for (int xx = 0; xx < nx; ++xx) d += DOTX[(size_t)xx * NTOK * 128 + idx]; CB[idx] = (bf16)f2bf((1.0f / V_SCALE) * GATES[idx] * gelu_erf(d * (1.0f / U_SCALE))); }
    GRID_BAR();
    {
        int tl = tid; asm volatile("" : "+v"(tl)); const int ln = tl & 63, k = ln >> 3, c8 = ln & 7;
        const unsigned char* VT8 = (const unsigned char*)VT;
        for (int s = xr; s < NSL; s += nx) {
            const unsigned char* Vs = VT8 + (size_t)s * 16384 * 128;
            v4u nid[2][2];
#pragma unroll
            for (int z = 0; z < 2; ++z) { const int tz = wv + z * nwv; const int tc = tz < NTOK ? tz : wv; const GAS v4u* ip = (const GAS v4u*)(IDS + (size_t)tc * 128 + 16 * k);
#pragma unroll
                for (int i = 0; i < 2; ++i) nid[z][i] = ip[i]; }
#pragma unroll 1
            for (int t = wv; t < NTOK; t += 2 * nwv) {
                const bool vB = (t + nwv) < NTOK; const int tt[2] = {t, vB ? t + nwv : t};
                v4u vb[2][16]; v4u cf[2][2]; v4u hs[2][2];
#pragma unroll
                for (int z = 0; z < 2; ++z) {
#pragma unroll
                    for (int i = 0; i < 16; ++i) { const unsigned eid = (nid[z][i >> 3][(i >> 1) & 3] >> (16 * (i & 1))) & 0xffffu; vb[z][i] = *(const GAS v4u*)(Vs + (size_t)eid * 128 + 16 * c8); } }
#pragma unroll
                for (int z = 0; z < 2; ++z) { const GAS v4u* hp = (const GAS v4u*)(H1 + (size_t)tt[z] * DM + 128 * s + 16 * c8); hs[z][0] = hp[0]; hs[z][1] = hp[1];
                    const GAS v4u* cp = (const GAS v4u*)(CB + (size_t)tt[z] * 128 + 16 * k); cf[z][0] = cp[0]; cf[z][1] = cp[1]; }
#pragma unroll
                for (int z = 0; z < 2; ++z) { const int tz = t + (2 + z) * nwv; const int tc = tz < NTOK ? tz : t; const GAS v4u* ip = (const GAS v4u*)(IDS + (size_t)tc * 128 + 16 * k);
#pragma unroll
                    for (int i = 0; i < 2; ++i) nid[z][i] = ip[i]; }
#pragma unroll
                for (int z = 0; z < 2; ++z) {
                    float acc[16];
#pragma unroll
                    for (int j2 = 0; j2 < 16; ++j2) acc[j2] = 0.f;
#pragma unroll
                    for (int i = 0; i < 16; ++i) { const unsigned cw = cf[z][i >> 3][(i >> 1) & 3]; const float c = (i & 1) ? bfhi(cw) : bflo(cw);
#pragma unroll
                        for (int dw = 0; dw < 4; ++dw) { const f32x2 fl = __builtin_amdgcn_cvt_pk_f32_fp8((int)vb[z][i][dw], false), fh = __builtin_amdgcn_cvt_pk_f32_fp8((int)vb[z][i][dw], true);
                            acc[4 * dw] += c * fl.x; acc[4 * dw + 1] += c * fl.y; acc[4 * dw + 2] += c * fh.x; acc[4 * dw + 3] += c * fh.y; } }
#pragma unroll
                    for (int j2 = 0; j2 < 16; ++j2) {
                        float a = acc[j2]; a += __int_as_float(__builtin_amdgcn_update_dpp(0, __float_as_int(a), 0x128, 0xf, 0xf, true));
                        { const auto r16 = __builtin_amdgcn_permlane16_swap(__float_as_uint(a), __float_as_uint(a), false, false); a = __uint_as_float(r16[0]) + __uint_as_float(r16[1]); }
                        { const auto r32 = __builtin_amdgcn_permlane32_swap(__float_as_uint(a), __float_as_uint(a), false, false); a = __uint_as_float(r32[0]) + __uint_as_float(r32[1]); }
                        acc[j2] = a; }
                    if (k == 0 && (z == 0 || vB)) { GAS f32x4* yp = (GAS f32x4*)(Y32 + (size_t)tt[z] * DM + 128 * s + 16 * c8);
#pragma unroll
                        for (int i = 0; i < 2; ++i) {
                            yp[2 * i] = (f32x4){acc[8 * i] + ALPHA * bflo(hs[z][i].x), acc[8 * i + 1] + ALPHA * bfhi(hs[z][i].x), acc[8 * i + 2] + ALPHA * bflo(hs[z][i].y), acc[8 * i + 3] + ALPHA * bfhi(hs[z][i].y)};
                            yp[2 * i + 1] = (f32x4){acc[8 * i + 4] + ALPHA * bflo(hs[z][i].z), acc[8 * i + 5] + ALPHA * bfhi(hs[z][i].z), acc[8 * i + 6] + ALPHA * bflo(hs[z][i].w), acc[8 * i + 7] + ALPHA * bfhi(hs[z][i].w)}; } }
                }
            }
        }
    }
    GRID_BAR();
    for (int m = gw; m < NTOK; m += NGW) {
        const GAS f32x4* xr4 = (const GAS f32x4*)(Y32 + (size_t)m * DM) + lane;
        f32x4 v[8]; float sm = 0.f;
#pragma unroll
        for (int j2 = 0; j2 < 8; ++j2) { v[j2] = xr4[64 * j2]; sm += (v[j2].x + v[j2].y) + (v[j2].z + v[j2].w); }
        const float mean = wave_sum(sm) * (1.f / DM); float s2 = 0.f;
#pragma unroll
        for (int j2 = 0; j2 < 8; ++j2) { v[j2] = v[j2] - mean; s2 += (v[j2].x * v[j2].x + v[j2].y * v[j2].y) + (v[j2].z * v[j2].z + v[j2].w * v[j2].w); }
        const float rstd = 1.f / sqrtf(wave_sum(s2) * (1.f / DM) + LN_EPS);
        GAS f32x4* op = (GAS f32x4*)(out + (size_t)m * DM) + lane;
#pragma unroll
        for (int j2 = 0; j2 < 8; ++j2) { const f32x4 gg = ((const GAS f32x4*)ln_ffn_g)[lane + 64 * j2], bb = ((const GAS f32x4*)ln_ffn_b)[lane + 64 * j2];
            op[64 * j2] = (f32x4){v[j2].x * rstd * gg.x + bb.x, v[j2].y * rstd * gg.y + bb.y, v[j2].z * rstd * gg.z + bb.z, v[j2].w * rstd * gg.w + bb.w}; }
    }
}

extern "C" void kernel_launch(void* const* d_in, const int* in_sizes, int n_in, void* d_out, int out_size, void* d_ws, size_t ws_size, hipStream_t stream) {
    static int grid = 0;
    if (grid == 0) {
        if (n_in != 15 || out_size != NTOK * DM || ws_size < WS_END) { fprintf(stderr, "kernel_launch: unexpected shapes (n_in %d out %d ws %zu)\n", n_in, out_size, ws_size); grid = -1; return; }
        int dev = 0, cus = 0, per_cu = 0;
        if (hipGetDevice(&dev) != hipSuccess || hipDeviceGetAttribute(&cus, hipDeviceAttributeMultiprocessorCount, dev) != hipSuccess) { grid = -1; return; }
        if (hipFuncSetAttribute((const void*)mk_fwd, hipFuncAttributeMaxDynamicSharedMemorySize, LDS_BYTES) != hipSuccess) { fprintf(stderr, "kernel_launch: hipFuncSetAttribute failed\n"); grid = -1; return; }
        if (hipOccupancyMaxActiveBlocksPerMultiprocessor(&per_cu, (const void*)mk_fwd, NWAVES * 64, LDS_BYTES) != hipSuccess || per_cu < 1) { fprintf(stderr, "kernel_launch: occupancy query says %d\n", per_cu); }
        (void)hipGetLastError();
        grid = cus;
    }
    if (grid < 0) return;
    if (hipMemsetAsync((char*)d_ws + WS_CTL, 0, CTL_ZERO_BYTES, stream) != hipSuccess) return;
    Args a{};
    for (int i = 0; i < 15; ++i) a.in[i] = (const float*)d_in[i];
    a.out = (float*)d_out; a.ws = (unsigned char*)d_ws;
    hipLaunchKernelGGL(mk_fwd, dim3(grid), dim3(NWAVES * 64), LDS_BYTES, stream, a);
}
```

```cpp
#include <hip/hip_runtime.h>
#include <cstdio>
#include <cstdint>
#include <cmath>
namespace pg8 {
#define PG8_LAS __attribute__((address_space(3)))
typedef unsigned short bf16_t;
typedef short bf16x8 __attribute__((ext_vector_type(8)));
typedef float f32x4 __attribute__((ext_vector_type(4)));
typedef unsigned u32x4 __attribute__((ext_vector_type(4)));
constexpr int BM = 256, BK = 64, HALF = 128, HTB = HALF * BK * 2  , STAGE_BYTES = 8 * HTB, NXCD = 8, WGM = 8;

__host__ __device__ __forceinline__ int lds_byte(int r, int c) { const int st = (r >> 4) * 2 + (c >> 5), rr = r & 15, cc = c & 31, ob = rr * 64 + cc * 2; return st * 1024 + (ob ^ (((ob >> 9) & 1) << 5)); }
__host__ __device__ __forceinline__ void stage_rc(int b, int& R, int& C) { const int st = b / 1024, sb = b % 1024, swz = sb ^ (((sb >> 9) & 1) << 5); R = (st >> 1) * 16 + swz / 64; C = (st & 1) * 32 + (swz % 64) / 2; }
__host__ __device__ __forceinline__ int perm32(int rho) { const int n = rho >> 4, i = rho & 15; return 8 * (i >> 2) + 4 * n + (i & 3); }

struct Unit { int pm, pn; };
struct Gemm { const bf16_t* A; const bf16_t* Bt; int M, N, K; };

struct StaticOrder {
    int nM, nN, nwg, G, c;
    __host__ __device__ void init(int M, int N, int G_, int c_) { nM = M / BM; nN = N / BM; nwg = nM * nN; G = G_; c = c_; }
    __host__ __device__ bool next(int i, Unit& u) const {
        const long L = (long)i * G + c; if (L >= nwg) return false;
        int wgid = (int)L; { const int q = nwg / NXCD, r = nwg % NXCD, xcd = wgid % NXCD, off = wgid / NXCD; wgid = (xcd < r ? xcd * (q + 1) : r * (q + 1) + (xcd - r) * q) + off; }
        const int nig = WGM * nN, gid = wgid / nig, fm = gid * WGM, gsz = (nM - fm) < WGM ? (nM - fm) : WGM;
        u.pm = fm + ((wgid % nig) % gsz); u.pn = (wgid % nig) / gsz; return true;
    }
    __device__ __forceinline__ void a_ready(const Unit&) const {}
    __device__ __forceinline__ void done(const Unit&) const {}
};

__device__ __forceinline__ unsigned cvt_pk_bf16(float lo, float hi) { unsigned r; asm volatile("v_cvt_pk_bf16_f32 %0, %1, %2" : "=v"(r) : "v"(lo), "v"(hi)); return r; }
typedef float f32x2 __attribute__((ext_vector_type(2)));

template <int MODE> struct EpiGen {
    static constexpr bool PERM = true, AFTER_DRAIN = false;
    bf16_t* O; int ldc; const bf16_t* R; float alpha;
    bf16_t *QR, *KA, *VA, *RK, *RV, *RG;
    __device__ __forceinline__ void operator()(const f32x4 (&acc)[2][2][4][2], const Unit& u, int wr, int wc, int fr, int fq) const {
        const int row0 = u.pm * BM + wr * 64 + fr;
#pragma unroll
        for (int bj = 0; bj < 2; ++bj) {
            const int col = u.pn * BM + bj * HALF + wc * 32 + 8 * fq;
            bf16_t* base = O; int ld = ldc; int cc = col;
            if (MODE == 0) {
                if (col < 1024)      { base = QR; ld = 2048; cc = col; }
                else if (col < 1152) { base = KA; ld = 128;  cc = col - 1024; }
                else if (col < 1280) { base = VA; ld = 128;  cc = col - 1152; }
                else if (col < 2304) { base = QR; ld = 2048; cc = col - 1280 + 1024; }
                else if (col < 3328) { base = RK; ld = 1024; cc = col - 2304; }
                else if (col < 4352) { base = RV; ld = 1024; cc = col - 3328; }
                else                 { base = RG; ld = 1024; cc = col - 4352; }
            }
#pragma unroll
            for (int ai = 0; ai < 2; ++ai)
#pragma unroll
                for (int m = 0; m < 4; ++m) {
                    const int row = row0 + ai * HALF + m * 16;
                    f32x4 v0 = acc[ai][bj][m][0], v1 = acc[ai][bj][m][1];
                    if (MODE == 1) {
                        const u32x4 r = *(const u32x4*)(R + (size_t)row * ldc + col);
                        v0[0] += alpha * __uint_as_float(r.x << 16); v0[1] += alpha * __uint_as_float(r.x & 0xffff0000u);
                        v0[2] += alpha * __uint_as_float(r.y << 16); v0[3] += alpha * __uint_as_float(r.y & 0xffff0000u);
                        v1[0] += alpha * __uint_as_float(r.z << 16); v1[1] += alpha * __uint_as_float(r.z & 0xffff0000u);
                        v1[2] += alpha * __uint_as_float(r.w << 16); v1[3] += alpha * __uint_as_float(r.w & 0xffff0000u);
                    }
                    u32x4 w; w.x = cvt_pk_bf16(v0[0], v0[1]); w.y = cvt_pk_bf16(v0[2], v0[3]); w.z = cvt_pk_bf16(v1[0], v1[1]); w.w = cvt_pk_bf16(v1[2], v1[3]);
                    *(u32x4*)(base + (size_t)row * ld + cc) = w;
                }
        }
    }
};
template <class Epi, class Sched, bool ALIGN_EPI = false, bool SP2 = false>
__device__ __forceinline__ void gemm_phase(PG8_LAS unsigned char* lds, const Gemm g, const Sched& S, const Epi& E) {
    const int tid = threadIdx.x, wid = __builtin_amdgcn_readfirstlane(tid >> 6), lane = tid & 63, wr = wid >> 2, wc = wid & 3, fr = lane & 15, fq = lane >> 4;
    const int K = g.K, nt = K / BK;
    unsigned voffA[2], voffB[2];
#pragma unroll
    for (int i = 0; i < 2; ++i) { int R, C; stage_rc(tid * 16 + i * 8192, R, C); const int Rb = Epi::PERM ? ((R & ~31) + perm32(R & 31)) : R;
        voffA[i] = (unsigned)(R * K + C) * 2u; voffB[i] = (unsigned)(Rb * K + C) * 2u; }
    const size_t kstep = (size_t)(BK * 2);
    const size_t hstep = (size_t)HALF * K * 2;
    const size_t tstep = 2 * hstep;
    const unsigned ldsw = (unsigned)wid * 1024u;
    const int aoff = lds_byte(wr * 64 + fr, fq * 8), boff = lds_byte(wc * 32 + fr, fq * 8);
#define PG8_SA(b, h) (((b) * 2 + (h)) * HTB)
#define PG8_SB(b, h) ((4 + (b) * 2 + (h)) * HTB)
#define PG8_STAGE(bufoff, gbase, voff) do { _Pragma("unroll") for (int _i = 0; _i < 2; ++_i) \
        __builtin_amdgcn_global_load_lds((const unsigned*)((const char*)(gbase) + (voff)[_i]), (PG8_LAS unsigned*)(lds + (bufoff) + ldsw + _i * 8192), 16, 0, 0); } while (0)
#define PG8_LDA(dst, b, h) do { _Pragma("unroll") for (int m = 0; m < 4; ++m) _Pragma("unroll") for (int k = 0; k < 2; ++k) dst[m][k] = *(const PG8_LAS bf16x8*)(lds + PG8_SA(b, h) + aoff + m * 2048 + k * 1024); } while (0)
#define PG8_LDB(dst, b, h) do { _Pragma("unroll") for (int n = 0; n < 2; ++n) _Pragma("unroll") for (int k = 0; k < 2; ++k) dst[n][k] = *(const PG8_LAS bf16x8*)(lds + PG8_SB(b, h) + boff + n * 2048 + k * 1024); } while (0)
#define PG8_MMA(ai, bj, At, Bt) do { __builtin_amdgcn_s_setprio(1); _Pragma("unroll") for (int m = 0; m < 4; ++m) _Pragma("unroll") for (int n = 0; n < 2; ++n) _Pragma("unroll") for (int k = 0; k < 2; ++k) \
        acc[ai][bj][m][n] = __builtin_amdgcn_mfma_f32_16x16x32_bf16(Bt[n][k], At[m][k], acc[ai][bj][m][n], 0, 0, 0); __builtin_amdgcn_s_setprio(0); } while (0)
#define PG8_WAIT_V(n) asm volatile("s_waitcnt vmcnt(" #n ")" ::: "memory")
#define PG8_WAIT_L(n) asm volatile("s_waitcnt lgkmcnt(" #n ")" ::: "memory")
#define PG8_BAR __builtin_amdgcn_s_barrier()
#define PG8_SCHED __builtin_amdgcn_sched_barrier(0)
    Unit cur, nxt; int ui = 0;
    if (!S.next(0, cur)) return;
    f32x4 acc[2][2][4][2];
#pragma unroll
    for (int a = 0; a < 2; ++a)
#pragma unroll
        for (int b = 0; b < 2; ++b)
#pragma unroll
            for (int m = 0; m < 4; ++m)
#pragma unroll
                for (int n = 0; n < 2; ++n) acc[a][b][m][n] = (f32x4){0.f, 0.f, 0.f, 0.f};
    bf16x8 At[4][2], B0[2][2], B1[2][2];
    const char* cA = (const char*)g.A + (size_t)cur.pm * tstep; const char* cB = (const char*)g.Bt + (size_t)cur.pn * tstep;
    S.a_ready(cur);
    if constexpr (SP2) {
        PG8_STAGE(PG8_SB(0, 0), cB, voffB); PG8_STAGE(PG8_SB(0, 1), cB + hstep, voffB); PG8_STAGE(PG8_SA(0, 0), cA, voffA); PG8_STAGE(PG8_SA(0, 1), cA + hstep, voffA);
        if (wr == 1) PG8_BAR;
        PG8_WAIT_V(2); PG8_BAR;
        PG8_STAGE(PG8_SB(1, 0), cB + kstep, voffB); PG8_STAGE(PG8_SA(1, 0), cA + kstep, voffA); PG8_STAGE(PG8_SB(1, 1), cB + hstep + kstep, voffB);
        PG8_WAIT_V(6); PG8_BAR;
    } else {
        PG8_STAGE(PG8_SB(0, 0), cB, voffB); PG8_STAGE(PG8_SA(0, 0), cA, voffA); PG8_STAGE(PG8_SB(0, 1), cB + hstep, voffB); PG8_STAGE(PG8_SA(0, 1), cA + hstep, voffA);
        if (wr == 1) PG8_BAR;
        PG8_WAIT_V(4); PG8_BAR;
        PG8_STAGE(PG8_SB(1, 0), cB + kstep, voffB); PG8_STAGE(PG8_SA(1, 0), cA + kstep, voffA); PG8_STAGE(PG8_SB(1, 1), cB + hstep + kstep, voffB);
        PG8_WAIT_V(6); PG8_BAR;
    }
    for (;;) {
        const bool has_next = S.next(ui + 1, nxt);
        const char* nA = has_next ? (const char*)g.A + (size_t)nxt.pm * tstep : cA; const char* nB = has_next ? (const char*)g.Bt + (size_t)nxt.pn * tstep : cB;
        for (int t = 0; t < nt; t += 2) {
            const bool last = (t == nt - 2);
            const char* a1 = cA + (size_t)(t + 1) * kstep;
            const char* a2 = last ? nA : cA + (size_t)(t + 2) * kstep; const char* b2 = last ? nB : cB + (size_t)(t + 2) * kstep;
            const char* a3 = a2 + kstep; const char* b3 = b2 + kstep;
            if (last && has_next) S.a_ready(nxt);
            if constexpr (SP2) {
            PG8_LDB(B0, 0, 0); PG8_LDB(B1, 0, 1); PG8_SCHED; PG8_LDA(At, 0, 0); PG8_STAGE(PG8_SA(1, 1), a1 + hstep, voffA);
            PG8_WAIT_V(8); PG8_WAIT_L(0); PG8_BAR; PG8_MMA(0, 0, At, B0); PG8_MMA(0, 1, At, B1); PG8_BAR; PG8_SCHED;
            PG8_LDA(At, 0, 1); PG8_STAGE(PG8_SB(0, 0), b2, voffB); PG8_STAGE(PG8_SB(0, 1), b2 + hstep, voffB); PG8_STAGE(PG8_SA(0, 0), a2, voffA);
            PG8_WAIT_V(8); PG8_WAIT_L(0); PG8_BAR; PG8_MMA(1, 0, At, B0); PG8_MMA(1, 1, At, B1); PG8_BAR; PG8_SCHED;
            PG8_LDB(B0, 1, 0); PG8_LDB(B1, 1, 1); PG8_SCHED; PG8_LDA(At, 1, 0); PG8_STAGE(PG8_SA(0, 1), a2 + hstep, voffA);
            PG8_WAIT_V(8); PG8_WAIT_L(0); PG8_BAR; PG8_MMA(0, 0, At, B0); PG8_MMA(0, 1, At, B1); PG8_BAR; PG8_SCHED;
            PG8_LDA(At, 1, 1); PG8_STAGE(PG8_SB(1, 0), b3, voffB); PG8_STAGE(PG8_SB(1, 1), b3 + hstep, voffB); PG8_STAGE(PG8_SA(1, 0), a3, voffA);
            PG8_WAIT_V(8); PG8_WAIT_L(0); PG8_BAR; PG8_MMA(1, 0, At, B0); PG8_MMA(1, 1, At, B1); PG8_BAR; PG8_SCHED;
            } else {
            PG8_LDB(B0, 0, 0); PG8_SCHED; PG8_LDA(At, 0, 0); PG8_STAGE(PG8_SA(1, 1), a1 + hstep, voffA);
            PG8_WAIT_L(8); PG8_BAR; PG8_WAIT_L(0); PG8_MMA(0, 0, At, B0); PG8_BAR; PG8_SCHED;
            PG8_LDB(B1, 0, 1); PG8_STAGE(PG8_SB(0, 0), b2, voffB);
            PG8_BAR; PG8_WAIT_L(0); PG8_MMA(0, 1, At, B1); PG8_BAR;
            PG8_LDA(At, 0, 1); PG8_STAGE(PG8_SA(0, 0), a2, voffA);
            PG8_BAR; PG8_WAIT_L(0); PG8_MMA(1, 0, At, B0); PG8_BAR; PG8_SCHED;
            PG8_STAGE(PG8_SB(0, 1), b2 + hstep, voffB);
            PG8_WAIT_V(6); PG8_BAR; PG8_MMA(1, 1, At, B1); PG8_BAR;
            PG8_LDB(B0, 1, 0); PG8_SCHED; PG8_LDA(At, 1, 0); PG8_STAGE(PG8_SA(0, 1), a2 + hstep, voffA);
            PG8_WAIT_L(8); PG8_BAR; PG8_WAIT_L(0); PG8_MMA(0, 0, At, B0); PG8_BAR; PG8_SCHED;
            PG8_LDB(B1, 1, 1); PG8_STAGE(PG8_SB(1, 0), b3, voffB);
            PG8_BAR; PG8_WAIT_L(0); PG8_MMA(0, 1, At, B1); PG8_BAR;
            PG8_LDA(At, 1, 1); PG8_STAGE(PG8_SA(1, 0), a3, voffA);
            PG8_BAR; PG8_WAIT_L(0); PG8_MMA(1, 0, At, B0); PG8_BAR; PG8_SCHED;
            PG8_STAGE(PG8_SB(1, 1), b3 + hstep, voffB);
            PG8_WAIT_V(6); PG8_BAR; PG8_MMA(1, 1, At, B1); PG8_BAR;
            }
        }
        if constexpr (ALIGN_EPI) { if (wr == 0) PG8_BAR; }
        if constexpr (!Epi::AFTER_DRAIN) { E(acc, cur, wr, wc, fr, fq); S.done(cur); }
        if (!has_next) break;
#pragma unroll
        for (int a = 0; a < 2; ++a)
#pragma unroll
            for (int b = 0; b < 2; ++b)
#pragma unroll
                for (int m = 0; m < 4; ++m)
#pragma unroll
                    for (int n = 0; n < 2; ++n) acc[a][b][m][n] = (f32x4){0.f, 0.f, 0.f, 0.f};
        cur = nxt; cA = nA; cB = nB; ++ui;
        if constexpr (ALIGN_EPI) { if (wr == 1) PG8_BAR; }
    }
    PG8_WAIT_V(0);
    if constexpr (!ALIGN_EPI) { if (wr == 0) PG8_BAR; }
    PG8_BAR;
    if constexpr (Epi::AFTER_DRAIN) { E.fused(acc, cur, wr, wc, fr, fq, lds, wid, lane); S.done(cur); }
#undef PG8_SA
#undef PG8_SB
#undef PG8_STAGE
#undef PG8_LDA
#undef PG8_LDB
#undef PG8_MMA
#undef PG8_WAIT_V
#undef PG8_WAIT_L
#undef PG8_BAR
#undef PG8_SCHED
}
}

constexpr int NWAVES = 8;
constexpr int DM = 2048, NB = 4, SEQ = 4096, NTOK = NB * SEQ;
constexpr int NMETA = 16, NVALID = NTOK + NMETA, MROWS = 16640;
constexpr int IN_COLS = 5376;
constexpr float LN_EPS = 1e-5f, GN_EPS = 1e-5f;
constexpr float ALPHA = 1.189207115002721f;
constexpr float LOG2E = 1.4426950408889634f;
constexpr float QSCALE = 0.125f * LOG2E;
constexpr float U_SCALE = 64.0f, V_SCALE = 4.0f;
constexpr int NSL = 16;

constexpr size_t MiB = 1u << 20;
constexpr size_t WS_CTL = 0, CTL_ZERO_BYTES = 1 * MiB;
constexpr size_t SZ_SK = (size_t)16 * 128 * 128 * 2, SZ_ROPE_R = (size_t)4112 * 128 * 8, SZ_ROPE_A = (size_t)4112 * 32 * 8;
constexpr size_t SZ_W2T = (size_t)DM * DM * 2, SZ_W1T = (size_t)IN_COLS * DM * 2, SZ_TAB = (size_t)16384 * DM * 2;
constexpr size_t SZ_ROWS2K = (size_t)MROWS * 2048 * 2, SZ_ROWS1K = (size_t)MROWS * 1024 * 2, SZ_ROWS128 = (size_t)MROWS * 128 * 2;
constexpr size_t SZ_TOK2K = (size_t)NTOK * 2048 * 2, SZ_ST = (size_t)16 * 32 * 256 * 256 * 2, SZ_IDS = (size_t)NTOK * 128 * 4;
constexpr size_t al256(size_t x) { return (x + 255) & ~(size_t)255; }
constexpr size_t WS_SK = 1 * MiB;
constexpr size_t WS_ROPE_R = al256(WS_SK + SZ_SK);
constexpr size_t WS_ROPE_A = al256(WS_ROPE_R + SZ_ROPE_R);
constexpr size_t WS_W2T = al256(WS_ROPE_A + SZ_ROPE_A), WS_W3T = al256(WS_W2T + SZ_W2T), WS_W1T = al256(WS_W3T + SZ_W2T);
constexpr size_t WS_UT = al256(WS_W1T + SZ_W1T), WS_VT = al256(WS_UT + SZ_TAB);
constexpr size_t WS_H0 = al256(WS_VT + SZ_TAB);
constexpr size_t WS_QR = al256(WS_H0 + SZ_ROWS2K);
constexpr size_t WS_KA = al256(WS_QR + SZ_ROWS2K), WS_VA = al256(WS_KA + SZ_ROWS128);
constexpr size_t WS_RK = al256(WS_VA + SZ_ROWS128), WS_RV = al256(WS_RK + SZ_ROWS1K), WS_RG = al256(WS_RV + SZ_ROWS1K);
constexpr size_t WS_ST = al256(WS_RG + SZ_ROWS1K);
constexpr size_t WS_Y = WS_RK;
constexpr size_t WS_H1 = WS_ST;
constexpr size_t WS_IDS = al256(WS_ST + SZ_ST), WS_GATES = al256(WS_IDS + SZ_IDS);
constexpr size_t WS_END = al256(WS_GATES + SZ_IDS);
static_assert(WS_Y + SZ_TOK2K <= WS_RG, "Y overlays RK|RV only");
static_assert(SZ_TOK2K <= SZ_ST && (size_t)NTOK * 1024 * 4 <= SZ_ST, "H1 / RET_RAW fit the state region");
static_assert(WS_END <= (size_t)512 * MiB, "workspace map fits 4 x largest tensor");
static_assert(WS_RK + (size_t)8 * NTOK * 128 * 4 <= WS_ST && WS_KA + (size_t)NTOK * 128 * 4 <= WS_RK && WS_H0 + (size_t)NTOK * DM * 4 <= WS_KA, "expert-phase overlays (DOTX over RK|RV, CB over KA|VA, Y32 over H0|QR)");
constexpr int CW_TMO = 0, CW_BAR = 4096;

constexpr int RING_OFF = 0, RING_BYTES = 131072;
constexpr int LDSCTL_OFF = RING_BYTES, MISC_OFF = LDSCTL_OFF + 320;
constexpr int LDS_BYTES = 147456;

#define GAS __attribute__((address_space(1)))
#define LAS __attribute__((address_space(3)))
typedef unsigned short bf16;
typedef unsigned v4u __attribute__((ext_vector_type(4)));
typedef unsigned v2u __attribute__((ext_vector_type(2)));
typedef float f32x4 __attribute__((ext_vector_type(4)));
typedef float f32x2 __attribute__((ext_vector_type(2)));
typedef GAS unsigned gu32;
typedef __bf16 bf16x2_t __attribute__((ext_vector_type(2)));
#define RLX_AGENT __ATOMIC_RELAXED, __HIP_MEMORY_SCOPE_AGENT
#define LDS_WAIT() asm volatile("s_waitcnt lgkmcnt(0)" ::: "memory")
#define VM_WAIT() asm volatile("s_waitcnt vmcnt(0)" ::: "memory")
__device__ __forceinline__ unsigned f2bf(float f) { unsigned u = __builtin_bit_cast(unsigned, f); return (u + 0x7fffu + ((u >> 16) & 1u)) >> 16; }
__device__ __forceinline__ unsigned pk2(float lo, float hi) { return f2bf(lo) | (f2bf(hi) << 16); }
__device__ __forceinline__ float bflo(unsigned w) { return __uint_as_float(w << 16); }
__device__ __forceinline__ float bfhi(unsigned w) { return __uint_as_float(w & 0xffff0000u); }
__device__ __forceinline__ float bf2f(bf16 h) { return __uint_as_float((unsigned)h << 16); }

#define XB_TMO      128
#define XB_XCNT(j)  (256  + 64 * (j))
#define XB_XSUB(j)  (1280 + 64 * (j))
#define XB_XGEN(j)  (2304 + 64 * (j))
#define XB_TOP      3328
#define XB_TOPGEN   3392
#define XCD_BAR_WORDS 3456
#define XB_SPIN_CAP (1u << 18)

__device__ __forceinline__ unsigned xb_ld(unsigned* p)              { return __hip_atomic_load(p, __ATOMIC_RELAXED, __HIP_MEMORY_SCOPE_AGENT); }
__device__ __forceinline__ unsigned xb_add(unsigned* p, unsigned v) { return __hip_atomic_fetch_add(p, v, __ATOMIC_RELAXED, __HIP_MEMORY_SCOPE_AGENT); }
__device__ __forceinline__ unsigned xb_xcc_id() { return (unsigned)__builtin_amdgcn_s_getreg((3 << 11) | 20) & 0xFu; }
#define XB_SPIN(cond, bar) do { unsigned _sp = 0; while (cond) { __builtin_amdgcn_s_sleep(1); \
    if ((++_sp & 255u) == 0u) { if (xb_ld(&(bar)[XB_TMO])) break; if (_sp > XB_SPIN_CAP) { atomicAdd(&(bar)[XB_TMO], 1u); break; } } } } while (0)

struct XcdBarrier {
    unsigned* bar; unsigned x;
    volatile LAS unsigned* st;
};

__device__ __forceinline__ XcdBarrier xcd_barrier_post(unsigned* bar, volatile LAS unsigned* st) {
    XcdBarrier b; b.bar = bar; b.x = xb_xcc_id(); b.st = st;
    if (threadIdx.x == 0) (void)xb_add(&bar[XB_XCNT(b.x)], 1u);
    return b;
}
__device__ __forceinline__ void xcd_barrier_complete(unsigned* bar, unsigned x, unsigned& nloc, unsigned& nx) {
    const unsigned G = gridDim.x * gridDim.y * gridDim.z;
    unsigned sum, cnt, mine, sp = 0u;
    for (;;) {
        sum = 0u; cnt = 0u; mine = 0u;
#pragma unroll
        for (unsigned j = 0; j < 16; ++j) { const unsigned c = xb_ld(&bar[XB_XCNT(j)]); sum += c; cnt += (c > 0u) ? 1u : 0u; mine = (j == x) ? c : mine; }
        if (sum == G) break;
        __builtin_amdgcn_s_sleep(1);
        if ((++sp & 255u) == 0u) { if (xb_ld(&bar[XB_TMO])) break; if (sp > XB_SPIN_CAP) { atomicAdd(&bar[XB_TMO], 1u); break; } }
    }
    nloc = mine > 0u ? mine : 1u; nx = cnt > 0u ? cnt : 1u;
}

__device__ __forceinline__ void xcd_barrier(const XcdBarrier& b) {
    asm volatile("s_waitcnt vmcnt(0)" ::: "memory");
    __syncthreads();
    if (threadIdx.x == 0) {
        unsigned* bar = b.bar;
        __builtin_amdgcn_s_waitcnt(0);
        unsigned nloc = b.st[0], nx = b.st[1];
        if (nloc == 0u) { xcd_barrier_complete(bar, b.x, nloc, nx); b.st[0] = nloc; b.st[1] = nx; }
        const unsigned old = xb_add(&bar[XB_XSUB(b.x)], 1u);
        const unsigned gen = old / nloc;
        if (old + 1u == (gen + 1u) * nloc) {
            __builtin_amdgcn_fence(__ATOMIC_RELEASE, "agent");
            asm volatile("s_waitcnt vmcnt(0)" ::: "memory");
            const unsigned og = xb_add(&bar[XB_TOP], 1u);
            const unsigned tg = og / nx;
            if (og + 1u == (tg + 1u) * nx) xb_add(&bar[XB_TOPGEN], 1u);
            else XB_SPIN(xb_ld(&bar[XB_TOPGEN]) == tg, bar);
            __builtin_amdgcn_fence(__ATOMIC_ACQUIRE, "agent");
            xb_add(&bar[XB_XGEN(b.x)], 1u);
            asm volatile("s_waitcnt vmcnt(0)" ::: "memory");
        } else {
            XB_SPIN(xb_ld(&bar[XB_XGEN(b.x)]) == gen, bar);
            __builtin_amdgcn_fence(__ATOMIC_ACQUIRE, "agent");
            asm volatile("s_waitcnt vmcnt(0)" ::: "memory");
        }
    }
    __syncthreads();
}


__device__ __forceinline__ float dot2bf(unsigned a, unsigned b, float c) { asm("v_dot2c_f32_bf16 %0, %1, %2" : "+v"(c) : "v"(a), "v"(b)); return c; }
__device__ __forceinline__ float dot8bf_dpp(v4u a, v4u b) { float c = 0.f; asm("v_dot2c_f32_bf16 %0, %1, %5\n\tv_dot2c_f32_bf16 %0, %2, %6\n\tv_dot2c_f32_bf16 %0, %3, %7\n\tv_dot2c_f32_bf16 %0, %4, %8\n\ts_nop 1" : "+v"(c) : "v"(a.x), "v"(a.y), "v"(a.z), "v"(a.w), "v"(b.x), "v"(b.y), "v"(b.z), "v"(b.w)); return c; }
#define DPPF(v, ctrl) __int_as_float(__builtin_amdgcn_update_dpp(0, __float_as_int(v), (ctrl), 0xf, 0xf, true))
__device__ __forceinline__ float wave_sum(float v) {
#pragma unroll
    for (int o = 1; o < 64; o <<= 1) v += __shfl_xor(v, o);
    return v;
}
__device__ __forceinline__ float gelu_erf(float v) {
    const float av = fabsf(v), d = av * 0.2316418882f + 1.0f;
    const float t = __builtin_amdgcn_rcpf(d);
    float q = t * 0.5307027145f + (-0.7265760135f); q = q * t + 0.7107068705f; q = q * t + (-0.142248368f); q = q * t + 0.127414796f; q = q * t;
    const float e = __builtin_amdgcn_exp2f((v * v) * (-0.72134752044f));
    const float m = v * (q * e);
    return v < 0.f ? m : v - m;
}

struct Args { const float* in[15]; float* out; unsigned char* ws; };

__device__ __forceinline__ void p0_transpose_item(const float* W, int K, int N, bf16* WT, LAS float* scr, int item, int lane) {
    const int nblk = N / 32, kb = item / nblk, nb = item % nblk, k0 = 64 * kb, n0 = 32 * nb;
#pragma unroll 8
    for (int i = 0; i < 32; ++i) { const int kk = 2 * i + (lane >> 5); scr[kk * 33 + (lane & 31)] = W[(size_t)(k0 + kk) * N + n0 + (lane & 31)]; }
    LDS_WAIT(); asm volatile("" ::: "memory");
    const int c = lane & 7;
#pragma unroll
    for (int j = 0; j < 4; ++j) { const int n = (lane >> 3) + 8 * j; const LAS float* s = scr + (8 * c) * 33 + n;
        v4u o; o.x = pk2(s[0 * 33], s[1 * 33]); o.y = pk2(s[2 * 33], s[3 * 33]); o.z = pk2(s[4 * 33], s[5 * 33]); o.w = pk2(s[6 * 33], s[7 * 33]);
        *(GAS v4u*)(WT + (size_t)(n0 + n) * K + k0 + 8 * c) = o; }
    LDS_WAIT(); asm volatile("" ::: "memory");
}
__device__ __forceinline__ void ln_row_f32_to_bf16(const float* xrow, const float* g, const float* bta, bf16* orow, int lane) {
    const GAS f32x4* xr = (const GAS f32x4*)xrow + lane;
    f32x4 v[8]; float s = 0.f;
#pragma unroll
    for (int j = 0; j < 8; ++j) { v[j] = xr[64 * j]; s += (v[j].x + v[j].y) + (v[j].z + v[j].w); }
    const float mean = wave_sum(s) * (1.f / DM); float s2 = 0.f;
#pragma unroll
    for (int j = 0; j < 8; ++j) { v[j] = v[j] - mean; s2 += (v[j].x * v[j].x + v[j].y * v[j].y) + (v[j].z * v[j].z + v[j].w * v[j].w); }
    const float rstd = 1.f / sqrtf(wave_sum(s2) * (1.f / DM) + LN_EPS);
    GAS v2u* o8 = (GAS v2u*)orow + lane;
#pragma unroll
    for (int j = 0; j < 8; ++j) { const f32x4 gg = ((const GAS f32x4*)g)[lane + 64 * j], bb = ((const GAS f32x4*)bta)[lane + 64 * j];
        v2u o; o.x = pk2(v[j].x * rstd * gg.x + bb.x, v[j].y * rstd * gg.y + bb.y); o.y = pk2(v[j].z * rstd * gg.z + bb.z, v[j].w * rstd * gg.w + bb.w); o8[64 * j] = o; }
}
__device__ __forceinline__ void ln_row_bf16_to_bf16(const bf16* xrow, const float* g, const float* bta, bf16* orow, int lane) {
    const GAS v4u* xr = (const GAS v4u*)xrow + lane;
    float v[32]; float s = 0.f;
#pragma unroll
    for (int j = 0; j < 4; ++j) { const v4u w = xr[64 * j];
        v[8 * j + 0] = bflo(w.x); v[8 * j + 1] = bfhi(w.x); v[8 * j + 2] = bflo(w.y); v[8 * j + 3] = bfhi(w.y);
        v[8 * j + 4] = bflo(w.z); v[8 * j + 5] = bfhi(w.z); v[8 * j + 6] = bflo(w.w); v[8 * j + 7] = bfhi(w.w); }
#pragma unroll
    for (int i = 0; i < 32; ++i) s += v[i];
    const float mean = wave_sum(s) * (1.f / DM); float s2 = 0.f;
#pragma unroll
    for (int i = 0; i < 32; ++i) { v[i] -= mean; s2 += v[i] * v[i]; }
    const float rstd = 1.f / sqrtf(wave_sum(s2) * (1.f / DM) + LN_EPS);
    GAS v4u* o16 = (GAS v4u*)orow + lane;
#pragma unroll
    for (int j = 0; j < 4; ++j) {
        const GAS f32x4* gp = (const GAS f32x4*)g + 2 * (lane + 64 * j); const GAS f32x4* bp = (const GAS f32x4*)bta + 2 * (lane + 64 * j);
        const f32x4 g0 = gp[0], g1 = gp[1], b0 = bp[0], b1 = bp[1];
        v4u o; o.x = pk2(v[8 * j + 0] * rstd * g0.x + b0.x, v[8 * j + 1] * rstd * g0.y + b0.y); o.y = pk2(v[8 * j + 2] * rstd * g0.z + b0.z, v[8 * j + 3] * rstd * g0.w + b0.w);
        o.z = pk2(v[8 * j + 4] * rstd * g1.x + b1.x, v[8 * j + 5] * rstd * g1.y + b1.y); o.w = pk2(v[8 * j + 6] * rstd * g1.z + b1.z, v[8 * j + 7] * rstd * g1.w + b1.w);
        o16[64 * j] = o; }
}
__device__ __forceinline__ void row_pos(int r, int& pos, int& ipos) {
    if (r < NTOK) { const int s = r & (SEQ - 1); pos = NMETA + s; ipos = s & 127; }
    else { int j = r - NTOK; if (j > NMETA - 1) j = NMETA - 1; pos = j; ipos = 112 + j; }
}
__device__ __forceinline__ float log2_gamma(int h) { return log2f(1.0f - exp2f(-5.0f - (float)h)); }


typedef short bf16x8 __attribute__((ext_vector_type(8)));
typedef short s16x4 __attribute__((ext_vector_type(4)));
#define MFMA16(a, b, c) __builtin_amdgcn_mfma_f32_16x16x32_bf16((a), (b), (c), 0, 0, 0)
__device__ __forceinline__ s16x4 tr16(LAS const unsigned char* p) { return __builtin_bit_cast(s16x4, __builtin_amdgcn_ds_read_tr16_b64_v4i16((LAS s16x4*)p)); }
__device__ __forceinline__ bf16x8 cat8(s16x4 a, s16x4 b) { return __builtin_shufflevector(a, b, 0, 1, 2, 3, 4, 5, 6, 7); }
__device__ __forceinline__ unsigned cvtpk_s(float lo, float hi) { f32x2 v = {lo, hi}; bf16x2_t b = __builtin_convertvector(v, bf16x2_t); return __builtin_bit_cast(unsigned, b); }
__device__ __forceinline__ unsigned cvtpk(float lo, float hi) { unsigned r; asm("v_cvt_pk_bf16_f32 %0, %1, %2" : "=v"(r) : "v"(lo), "v"(hi)); return r; }

__device__ __forceinline__ void scan_unit(LAS unsigned char* L, int u, const bf16* RK, const bf16* RV, bf16* ST, int tid, int lane, int wave) {
    asm volatile("" : "+v"(tid)); lane = tid & 63;
    const int bh = u >> 4, di = (u >> 2) & 3, ei = u & 3, b = bh >> 2, h = bh & 3;
    const float g128 = exp2f(128.0f * log2_gamma(h));
    const int li = lane & 15, g = lane >> 4, q = li >> 2, p4 = li & 3;
    const int eb = wave >> 1, db0 = 2 * (wave & 1);
    f32x4 acc[2]; acc[0] = (f32x4){0.f, 0.f, 0.f, 0.f}; acc[1] = acc[0];
    v4u kreg[2], vreg[2];
#define SCAN_LOAD(cc) do { _Pragma("unroll") for (int i_ = 0; i_ < 2; ++i_) { const int cid_ = tid + 512 * i_, row_ = cid_ >> 3, c16_ = cid_ & 7; \
        int srow_; bool ok_ = true; if ((cc) < 0) { ok_ = row_ >= 112; srow_ = NTOK + (ok_ ? row_ - 112 : 0); } else srow_ = b * SEQ + (cc) * 128 + row_; \
        const v4u kz_ = *(const GAS v4u*)(RK + (size_t)srow_ * 1024 + h * 256 + di * 64 + c16_ * 8), vz_ = *(const GAS v4u*)(RV + (size_t)srow_ * 1024 + h * 256 + ei * 64 + c16_ * 8); \
        kreg[i_] = ok_ ? kz_ : (v4u){0u, 0u, 0u, 0u}; vreg[i_] = ok_ ? vz_ : (v4u){0u, 0u, 0u, 0u}; } } while (0)
#define SCAN_WRITE(bufp) do { _Pragma("unroll") for (int i_ = 0; i_ < 2; ++i_) { const int cid_ = tid + 512 * i_, row_ = cid_ >> 3, c16_ = cid_ & 7; \
        *(LAS v4u*)((bufp) + row_ * 128 + c16_ * 16) = kreg[i_]; *(LAS v4u*)((bufp) + 16384 + row_ * 128 + c16_ * 16) = vreg[i_]; } } while (0)
    SCAN_LOAD(-1); SCAN_WRITE(L); __syncthreads();
    int cur = 0;
    for (int cc = -1; cc <= 30; ++cc) {
        if (cc < 30) SCAN_LOAD(cc + 1);
        LAS const unsigned char* Kt = L + cur * 32768; LAS const unsigned char* Vt = Kt + 16384;
#pragma unroll
        for (int ks = 0; ks < 4; ++ks) {
            const int r0 = (32 * ks + 8 * g + q) * 128;
            const bf16x8 a = cat8(tr16(Vt + r0 + (16 * eb + 4 * p4) * 2), tr16(Vt + r0 + 512 + (16 * eb + 4 * p4) * 2));
#pragma unroll
            for (int n = 0; n < 2; ++n) {
                const bf16x8 bb = cat8(tr16(Kt + r0 + (16 * (db0 + n) + 4 * p4) * 2), tr16(Kt + r0 + 512 + (16 * (db0 + n) + 4 * p4) * 2));
                acc[n] = MFMA16(a, bb, acc[n]);
            }
        }
#pragma unroll
        for (int n = 0; n < 2; ++n) {
            acc[n] = acc[n] * g128;
            bf16* sp = ST + ((size_t)(bh * 32 + cc + 1) * 256 + (64 * ei + 16 * eb + 4 * g)) * 256 + 64 * di + 16 * (db0 + n) + li;
#pragma unroll
            for (int r = 0; r < 4; ++r) sp[(size_t)r * 256] = (bf16)f2bf(acc[n][r]);
        }
        if (cc < 30) SCAN_WRITE(L + (cur ^ 1) * 32768);
        __syncthreads(); cur ^= 1;
    }
#undef SCAN_LOAD
#undef SCAN_WRITE
}

__device__ __forceinline__ void retout_unit(LAS unsigned char* L, int u, bf16* QR, const bf16* RK, const bf16* RV, const bf16* RG, const bf16* ST, int tid, int lane, int wave) {
    asm volatile("" : "+v"(tid)); lane = tid & 63;
    const int bh = u >> 5, c = u & 31, b = bh >> 2, h = bh & 3;
    const int R0 = b * SEQ + c * 128;
    const int li = lane & 15, g = lane >> 4, q = li >> 2, p4 = li & 3;
    LAS unsigned char* RA = L; LAS unsigned char* RB = L + 65536;
#pragma unroll
    for (int i = 0; i < 8; ++i) { const int cid = tid + 512 * i, j = cid >> 5, ch = cid & 31;
        const v4u kz = *(const GAS v4u*)(RK + (size_t)(R0 + j) * 1024 + h * 256 + ch * 8), vz = *(const GAS v4u*)(RV + (size_t)(R0 + j) * 1024 + h * 256 + ch * 8);
        *(LAS v4u*)(RA + j * 512 + ((ch ^ (j & 15)) << 4)) = kz; *(LAS v4u*)(RB + j * 512 + ((ch ^ ((j & 7) << 1)) << 4)) = vz; }
    bf16x8 qf[8];
    { const GAS v4u* qp = (const GAS v4u*)(QR + (size_t)(R0 + 16 * wave + li) * 2048 + 1024 + h * 256 + 8 * g);
#pragma unroll
      for (int ks = 0; ks < 8; ++ks) qf[ks] = __builtin_bit_cast(bf16x8, qp[4 * ks]); }
    __syncthreads();
    f32x4 st[8];
#pragma unroll
    for (int jt = 0; jt < 8; ++jt) st[jt] = (f32x4){0.f, 0.f, 0.f, 0.f};
#pragma unroll
    for (int jt = 0; jt < 8; ++jt) if (jt <= wave) {
        const int j = 16 * jt + li;
#pragma unroll
        for (int ks = 0; ks < 8; ++ks) { const bf16x8 a = *(LAS const bf16x8*)(RA + j * 512 + (((4 * ks + g) ^ li) << 4)); st[jt] = MFMA16(a, qf[ks], st[jt]); }
        if (jt == wave) {
#pragma unroll
            for (int r = 0; r < 4; ++r) if (4 * g + r > li) st[jt][r] = 0.f; }
    }
    bf16x8 pf[4];
#pragma unroll
    for (int s = 0; s < 4; ++s) { v4u w; w.x = cvtpk_s(st[2 * s][0], st[2 * s][1]); w.y = cvtpk_s(st[2 * s][2], st[2 * s][3]); w.z = cvtpk_s(st[2 * s + 1][0], st[2 * s + 1][1]); w.w = cvtpk_s(st[2 * s + 1][2], st[2 * s + 1][3]); pf[s] = __builtin_bit_cast(bf16x8, w); }
    __syncthreads();
    const bf16* Sg = ST + (size_t)(bh * 32 + c) * 65536;
#define RO_STAGE_ST(dst, s0) do { _Pragma("unroll") for (int i_ = 0; i_ < 8; ++i_) { const int cid_ = tid + 512 * i_, sl_ = cid_ >> 11, e_ = (cid_ >> 3) & 255, ch_ = cid_ & 7; \
        const v4u z_ = *(const GAS v4u*)(Sg + (size_t)e_ * 256 + 64 * ((s0) + sl_) + ch_ * 8); *(LAS v4u*)((dst) + sl_ * 32768 + e_ * 128 + ((ch_ ^ (e_ & 7)) << 4)) = z_; } } while (0)
    RO_STAGE_ST(RA, 0);
    f32x4 o[16];
#pragma unroll
    for (int et = 0; et < 16; ++et) o[et] = (f32x4){0.f, 0.f, 0.f, 0.f};
#pragma unroll
    for (int s = 0; s < 4; ++s) if (2 * s <= wave) {
        const int r1 = 32 * s + 4 * g + q, r2 = r1 + 16;
#pragma unroll
        for (int et = 0; et < 16; ++et) {
            const int chn = 2 * et + (p4 >> 1);
            const bf16x8 a = cat8(tr16(RB + r1 * 512 + ((chn ^ ((r1 & 7) << 1)) << 4) + (p4 & 1) * 8), tr16(RB + r2 * 512 + ((chn ^ ((r2 & 7) << 1)) << 4) + (p4 & 1) * 8));
            o[et] = MFMA16(a, pf[s], o[et]);
        }
    }
    __syncthreads();
    RO_STAGE_ST(RB, 2);
#define RO_STATE_MMA(src, s0) do { _Pragma("unroll") for (int sl_ = 0; sl_ < 2; ++sl_) _Pragma("unroll") for (int k2_ = 0; k2_ < 2; ++k2_) _Pragma("unroll") for (int et = 0; et < 16; ++et) { \
        const int e_ = 16 * et + li; const bf16x8 a_ = *(LAS const bf16x8*)((src) + sl_ * 32768 + e_ * 128 + (((4 * k2_ + g) ^ (e_ & 7)) << 4)); \
        o[et] = MFMA16(a_, qf[2 * ((s0) + sl_) + k2_], o[et]); } } while (0)
    RO_STATE_MMA(RA, 0);
    __syncthreads();
    RO_STATE_MMA(RB, 2);
#undef RO_STAGE_ST
#undef RO_STATE_MMA
    float s1 = 0.f;
#pragma unroll
    for (int et = 0; et < 16; ++et) s1 += (o[et][0] + o[et][1]) + (o[et][2] + o[et][3]);
    s1 += __shfl_xor(s1, 16); s1 += __shfl_xor(s1, 32);
    const float mu = s1 * (1.0f / 256.0f); float s2 = 0.f;
#pragma unroll
    for (int et = 0; et < 16; ++et) { o[et] = o[et] - mu; s2 += (o[et][0] * o[et][0] + o[et][1] * o[et][1]) + (o[et][2] * o[et][2] + o[et][3] * o[et][3]); }
    s2 += __shfl_xor(s2, 16); s2 += __shfl_xor(s2, 32);
    const float rstd = 1.0f / sqrtf(s2 * (1.0f / 256.0f) + GN_EPS);
    const int row = R0 + 16 * wave + li;
    const GAS v2u* gp = (const GAS v2u*)(RG + (size_t)row * 1024 + h * 256 + 4 * g); GAS v2u* op = (GAS v2u*)(QR + (size_t)row * 2048 + 1024 + h * 256 + 4 * g);
#pragma unroll
    for (int et = 0; et < 16; ++et) { const v2u gz = gp[4 * et]; v2u w;
        w.x = cvtpk(o[et][0] * rstd * bflo(gz.x), o[et][1] * rstd * bfhi(gz.x)); w.y = cvtpk(o[et][2] * rstd * bflo(gz.y), o[et][3] * rstd * bfhi(gz.y)); op[4 * et] = w; }
    __syncthreads();
}

typedef float f32x16 __attribute__((ext_vector_type(16)));
#define MFMA32(a, b, c) __builtin_amdgcn_mfma_f32_32x32x16_bf16((a), (b), (c), 0, 0, 0)
__device__ __forceinline__ int crow32(int reg, int hh) { return (reg & 3) + 8 * (reg >> 2) + 4 * hh; }

__device__ __forceinline__ void attn_unit(LAS unsigned char* L, int u, bf16* QR, const bf16* KA, const bf16* VA, const float* sinks, int tid, int lane, int wave) {
    asm volatile("" : "+v"(tid)); lane = tid & 63;
    const int b = u >> 6, j = (u >> 1) & 31, g2 = u & 1, hq = 8 * g2 + wave;
    const int R0 = b * SEQ + 128 * j;
    LAS unsigned char* Kt = L; LAS unsigned char* Vt = L + 32768;
#pragma unroll
    for (int i = 0; i < 4; ++i) { const int cid = tid + 512 * i, kk = cid >> 3, ch = cid & 7;
        int srow; bool ok = true;
        if (kk >= 128) srow = R0 + kk - 128; else if (j > 0) srow = R0 - 128 + kk; else { ok = kk >= 112; srow = NTOK + (ok ? kk - 112 : 0); }
        const v4u kz = *(const GAS v4u*)(KA + (size_t)srow * 128 + g2 * 64 + ch * 8), vz = *(const GAS v4u*)(VA + (size_t)srow * 128 + g2 * 64 + ch * 8);
        *(LAS v4u*)(Kt + kk * 128 + ((ch ^ (kk & 7)) << 4)) = ok ? kz : (v4u){0u, 0u, 0u, 0u};
        *(LAS v4u*)(Vt + kk * 128 + (ch << 4)) = ok ? vz : (v4u){0u, 0u, 0u, 0u}; }
    __syncthreads();
    const int r = lane & 31, hh = lane >> 5, blk = (lane >> 4) & 1, q = (lane & 15) >> 2, p4 = lane & 3;
    const float sk = sinks[hq] * LOG2E;
#pragma unroll 1
    for (int t = 0; t < 4; ++t) {
        const int i0 = 32 * t;
        bf16x8 qf[4];
        { const GAS v4u* qp = (const GAS v4u*)(QR + (size_t)(R0 + i0 + r) * 2048 + hq * 64 + 8 * hh);
#pragma unroll
          for (int ks = 0; ks < 4; ++ks) qf[ks] = __builtin_bit_cast(bf16x8, qp[2 * ks]); }
        f32x16 s[5];
#pragma unroll
        for (int x = 0; x < 5; ++x) {
            const int krow_ = 32 * (t + x) + r;
            f32x16 acc;
#pragma unroll
            for (int e = 0; e < 16; ++e) acc[e] = 0.f;
#pragma unroll
            for (int ks = 0; ks < 4; ++ks) { const bf16x8 a = *(LAS const bf16x8*)(Kt + krow_ * 128 + (((2 * ks + hh) ^ (krow_ & 7)) << 4)); acc = MFMA32(a, qf[ks], acc); }
            s[x] = acc; __builtin_amdgcn_sched_barrier(0);
        }
        float m = sk;
#pragma unroll
        for (int e = 0; e < 16; ++e) { const int cr = crow32(e, hh);
            if (!(cr > r)) s[0][e] = -1.0e30f;
            if (!(cr <= r)) s[4][e] = -1.0e30f; }
        if (j == 0) {
#pragma unroll
            for (int x = 0; x < 4; ++x) if (t + x <= 3) {
#pragma unroll
                for (int e = 0; e < 16; ++e) if (32 * (t + x) + crow32(e, hh) < 112) s[x][e] = -1.0e30f; }
        }
#pragma unroll
        for (int x = 0; x < 5; ++x)
#pragma unroll
            for (int e = 0; e < 16; ++e) m = fmaxf(m, s[x][e]);
        m = fmaxf(m, __shfl_xor(m, 32));
        float l = 0.f;
#pragma unroll
        for (int x = 0; x < 5; ++x)
#pragma unroll
            for (int e = 0; e < 16; ++e) { const float pv = exp2f(s[x][e] - m); s[x][e] = pv; l += pv; }
        l += __shfl_xor(l, 32);
        l += exp2f(sk - m);
        f32x16 o[2];
#pragma unroll
        for (int e = 0; e < 16; ++e) { o[0][e] = 0.f; o[1][e] = 0.f; }
#pragma unroll
        for (int x = 0; x < 5; ++x)
#pragma unroll
            for (int st = 0; st < 2; ++st) {
                v4u w; w.x = cvtpk_s(s[x][8 * st + 0], s[x][8 * st + 1]); w.y = cvtpk_s(s[x][8 * st + 2], s[x][8 * st + 3]); w.z = cvtpk_s(s[x][8 * st + 4], s[x][8 * st + 5]); w.w = cvtpk_s(s[x][8 * st + 6], s[x][8 * st + 7]);
                const bf16x8 pb = __builtin_bit_cast(bf16x8, w);
                const int k1 = 32 * (t + x) + 16 * st + 4 * hh + q, k2 = k1 + 8;
#pragma unroll
                for (int dc = 0; dc < 2; ++dc) {
                    const int cb = ((4 * dc + 2 * blk + (p4 >> 1)) << 4) + 8 * (p4 & 1);
                    const bf16x8 a = cat8(tr16(Vt + k1 * 128 + cb), tr16(Vt + k2 * 128 + cb));
                    o[dc] = MFMA32(a, pb, o[dc]);
                }
                __builtin_amdgcn_sched_barrier(0);
            }
        const float il = 1.0f / l;
        GAS v2u* op = (GAS v2u*)(QR + (size_t)(R0 + i0 + r) * 2048 + hq * 64 + 4 * hh);
#pragma unroll
        for (int dc = 0; dc < 2; ++dc)
#pragma unroll
            for (int g4 = 0; g4 < 4; ++g4) { v2u w; w.x = cvtpk_s(o[dc][4 * g4 + 0] * il, o[dc][4 * g4 + 1] * il); w.y = cvtpk_s(o[dc][4 * g4 + 2] * il, o[dc][4 * g4 + 3] * il); op[8 * dc + 2 * g4] = w; }
    }
    __syncthreads();
}

__device__ __forceinline__ unsigned ord_key(float f) { const unsigned u = __float_as_uint(f); return u ^ ((unsigned)((int)u >> 31) | 0x80000000u); }
__device__ __forceinline__ float ord_val(unsigned k) { return __uint_as_float(k ^ (((int)k < 0) ? 0x80000000u : 0xffffffffu)); }
#define TK_INS(arr, val) do { unsigned v_ = (val); _Pragma("unroll") for (int j_ = 0; j_ < 16; ++j_) { const unsigned hi_ = arr[j_] > v_ ? arr[j_] : v_; v_ = arr[j_] > v_ ? v_ : arr[j_]; arr[j_] = hi_; } } while (0)
__device__ __forceinline__ void topk_unit(LAS unsigned* Lw, int tt, int hd, const bf16* Q3, const bf16* SKB, unsigned short* IDS, float* GATES, int lane) {
    asm volatile("" : "+v"(lane));
    const int r = lane & 31, hh = lane >> 5, t0 = tt * 32;
    float sv[2][16];
#pragma unroll
    for (int p = 0; p < 2; ++p) {
        f32x16 acc[4];
#pragma unroll
        for (int nt = 0; nt < 4; ++nt)
#pragma unroll
            for (int e = 0; e < 16; ++e) acc[nt][e] = 0.f;
        const GAS v4u* qp = (const GAS v4u*)(Q3 + (size_t)(t0 + r) * DM + hd * 256 + p * 128 + 8 * hh);
        const GAS v4u* kp = (const GAS v4u*)(SKB + ((size_t)((hd * 2 + p) * 128 + r)) * 128 + 8 * hh);
#pragma unroll 2
        for (int ks = 0; ks < 8; ++ks) { const bf16x8 bq = __builtin_bit_cast(bf16x8, qp[2 * ks]);
#pragma unroll
            for (int nt = 0; nt < 4; ++nt) { const bf16x8 a = __builtin_bit_cast(bf16x8, kp[nt * 32 * 16 + 2 * ks]); acc[nt] = MFMA32(a, bq, acc[nt]); } }
        unsigned tk[16];
#pragma unroll
        for (int j2 = 0; j2 < 16; ++j2) tk[j2] = 0u;
#pragma unroll
        for (int nt = 0; nt < 4; ++nt)
#pragma unroll
            for (int e = 0; e < 16; ++e) { const int n = 32 * nt + crow32(e, hh); TK_INS(tk, (ord_key(acc[nt][e]) & 0xffffff80u) | (unsigned)(127 - n)); }
        unsigned pk[16];
#pragma unroll
        for (int j2 = 0; j2 < 16; ++j2) pk[j2] = (unsigned)__shfl_xor((int)tk[j2], 32);
#pragma unroll
        for (int j2 = 0; j2 < 16; ++j2) TK_INS(tk, pk[j2]);
#pragma unroll
        for (int j2 = 0; j2 < 16; ++j2) { sv[p][j2] = ord_val(tk[j2] & 0xffffff80u); Lw[(p * 16 + j2) * 64 + lane] = 127u - (tk[j2] & 0x7fu); }
    }
    unsigned fk[16];
#pragma unroll
    for (int j2 = 0; j2 < 16; ++j2) fk[j2] = 0u;
#pragma unroll
    for (int i = 0; i < 16; ++i)
#pragma unroll
        for (int j2 = 0; j2 < 16; ++j2) if ((i + 1) * (j2 + 1) <= 16) TK_INS(fk, (ord_key(sv[0][i] + sv[1][j2]) & 0xffffff00u) | (unsigned)(255 - (16 * i + j2)));
    float ev[16]; int idv[16]; float den = 0.f; const float f0 = ord_val(fk[0] & 0xffffff00u);
    LDS_WAIT();
#pragma unroll
    for (int k = 0; k < 16; ++k) { const unsigned idx = 255u - (fk[k] & 0xffu); const unsigned i1 = Lw[(idx >> 4) * 64 + lane], i2 = Lw[(16 + (idx & 15u)) * 64 + lane];
        idv[k] = (int)(i1 * 128u + i2); ev[k] = __expf(ord_val(fk[k] & 0xffffff00u) - f0); den += ev[k]; }
    const float iden = 1.0f / den;
    if (hh == 0) {
        GAS v4u* ip = (GAS v4u*)(IDS + (size_t)(t0 + r) * 128 + hd * 16); GAS f32x4* gp = (GAS f32x4*)(GATES + (size_t)(t0 + r) * 128 + hd * 16);
#pragma unroll
        for (int k8 = 0; k8 < 2; ++k8) ip[k8] = (v4u){(unsigned)idv[8 * k8] | ((unsigned)idv[8 * k8 + 1] << 16), (unsigned)idv[8 * k8 + 2] | ((unsigned)idv[8 * k8 + 3] << 16), (unsigned)idv[8 * k8 + 4] | ((unsigned)idv[8 * k8 + 5] << 16), (unsigned)idv[8 * k8 + 6] | ((unsigned)idv[8 * k8 + 7] << 16)};
#pragma unroll
        for (int k4 = 0; k4 < 4; ++k4) gp[k4] = (f32x4){ev[4 * k4] * iden, ev[4 * k4 + 1] * iden, ev[4 * k4 + 2] * iden, ev[4 * k4 + 3] * iden};
    }
    LDS_WAIT();
}

__global__ void __launch_bounds__(NWAVES * 64, 2) mk_fwd(Args args) {
    extern __shared__ __attribute__((aligned(16))) unsigned char lds[];
    LAS unsigned char* L = (LAS unsigned char*)lds;
    volatile LAS unsigned* MISC = (volatile LAS unsigned*)(L + MISC_OFF);
    const int tid = threadIdx.x, lane = tid & 63, wave = __builtin_amdgcn_readfirstlane(tid >> 6);
    const int G = gridDim.x, bx = blockIdx.x;
    const int vcu = (G % 8 == 0) ? (bx % 8) * (G / 8) + bx / 8 : bx;
    unsigned char* ws = args.ws;
    gu32* ctl = (gu32*)(ws + WS_CTL);
    const float* x = args.in[0]; const float* meta = args.in[1]; const float* ln_in_g = args.in[2]; const float* ln_in_b = args.in[3];
    const float* w_in = args.in[4]; const float* sinks = args.in[5]; const float* w_out = args.in[6]; const float* ln_mix_g = args.in[7]; const float* ln_mix_b = args.in[8];
    const float* wq = args.in[9]; const float* subkeys = args.in[10]; const float* u_tab = args.in[11]; const float* v_tab = args.in[12];
    const float* ln_ffn_g = args.in[13]; const float* ln_ffn_b = args.in[14];
    float* out = args.out;
    bf16* W1T = (bf16*)(ws + WS_W1T); bf16* W2T = (bf16*)(ws + WS_W2T); bf16* W3T = (bf16*)(ws + WS_W3T);
    bf16* H0 = (bf16*)(ws + WS_H0); bf16* QR = (bf16*)(ws + WS_QR); bf16* KA = (bf16*)(ws + WS_KA); bf16* VA = (bf16*)(ws + WS_VA);
    bf16* RK = (bf16*)(ws + WS_RK); bf16* RV = (bf16*)(ws + WS_RV); bf16* RG = (bf16*)(ws + WS_RG);
    bf16* Y = (bf16*)(ws + WS_Y); bf16* H1 = (bf16*)(ws + WS_H1); bf16* Q3 = (bf16*)(ws + WS_QR);
    bf16* STB = (bf16*)(ws + WS_ST);
    f32x2* ROPE_R = (f32x2*)(ws + WS_ROPE_R); f32x2* ROPE_A = (f32x2*)(ws + WS_ROPE_A);
    unsigned short* IDS = (unsigned short*)(ws + WS_IDS); float* GATES = (float*)(ws + WS_GATES);
    bf16* SKB = (bf16*)(ws + WS_SK);
    bf16* UT = (bf16*)(ws + WS_UT); bf16* VT = (bf16*)(ws + WS_VT);

    for (int u = tid; u < (LDS_BYTES - LDSCTL_OFF) / 4; u += NWAVES * 64) ((LAS unsigned*)(L + LDSCTL_OFF))[u] = 0u;
    __syncthreads();
    XcdBarrier bar; bar.bar = (unsigned*)(ctl + CW_BAR); bar.x = xb_xcc_id(); bar.st = MISC + 8;
    if (tid == 0) MISC[10] = xb_add(&bar.bar[XB_XCNT(bar.x)], 1u);
#define GRID_BAR() xcd_barrier(bar)
    const int gw = vcu * NWAVES + wave, NGW = G * NWAVES;
    const int gt = gw * 64 + lane, NGT = NGW * 64;

    {
        LAS float* scr = (LAS float*)(L + RING_OFF + wave * 16384);
        constexpr int I_1 = (DM / 64) * (IN_COLS / 32), I_2 = (DM / 64) * (DM / 32), I_3 = I_2;
        for (int it = gw; it < I_1 + I_2 + I_3; it += NGW) {
            int r = it;
            if (r < I_1) { p0_transpose_item(w_in, DM, IN_COLS, W1T, scr, r, lane); continue; } r -= I_1;
            if (r < I_2) { p0_transpose_item(w_out, DM, DM, W2T, scr, r, lane); continue; } r -= I_2;
            p0_transpose_item(wq, DM, DM, W3T, scr, r, lane);
        }
        for (int m = gw; m < MROWS; m += NGW) {
            if (m < NTOK) ln_row_f32_to_bf16(x + (size_t)m * DM, ln_in_g, ln_in_b, H0 + (size_t)m * DM, lane);
            else if (m < NVALID) ln_row_f32_to_bf16(meta + (size_t)(m - NTOK) * DM, ln_in_g, ln_in_b, H0 + (size_t)m * DM, lane);
            else { GAS v4u* o = (GAS v4u*)(H0 + (size_t)m * DM) + lane;
#pragma unroll
                for (int j = 0; j < 4; ++j) o[64 * j] = (v4u){0u, 0u, 0u, 0u}; }
        }
        for (int e = gt; e < 2 * (16384 * DM / 16); e += NGT) {
            const int which = e >= (16384 * DM / 16); const int i16 = which ? e - (16384 * DM / 16) : e; const int row = i16 >> 7, c = i16 & 127;
            const float sc = which ? V_SCALE : U_SCALE;
            const GAS f32x4* src = (const GAS f32x4*)(which ? v_tab : u_tab) + 4 * (size_t)i16; v4u o;
#pragma unroll
            for (int q4 = 0; q4 < 4; ++q4) { const f32x4 a = src[q4]; int w = __builtin_amdgcn_cvt_pk_fp8_f32(a.x * sc, a.y * sc, 0, false); w = __builtin_amdgcn_cvt_pk_fp8_f32(a.z * sc, a.w * sc, w, true); o[q4] = (unsigned)w; }
            ((GAS v4u*)(which ? (void*)VT : (void*)UT))[((size_t)(c >> 3) * 16384 + row) * 8 + (c & 7)] = o; }
        for (int e = gt; e < 16 * 128 * 128 / 8; e += NGT) { const GAS f32x4* src = (const GAS f32x4*)subkeys + 2 * (size_t)e; const f32x4 a = src[0], b2 = src[1];
            v4u o; o.x = pk2(a.x, a.y); o.y = pk2(a.z, a.w); o.z = pk2(b2.x, b2.y); o.w = pk2(b2.z, b2.w); ((GAS v4u*)SKB)[e] = o; }
        for (int e = gt; e < 4112 * 128; e += NGT) { const int pos = e >> 7, i = e & 127; const float inv = powf(10000.0f, -(float)(2 * i) / 256.0f); float sn, cs; sincosf((float)pos * inv, &sn, &cs); ROPE_R[e] = (f32x2){cs, sn}; }
        for (int e = gt; e < 4112 * 32; e += NGT) { const int pos = e >> 5, i = e & 31; const float inv = powf(10000.0f, -(float)(2 * i) / 64.0f); float sn, cs; sincosf((float)pos * inv, &sn, &cs); ROPE_A[e] = (f32x2){cs, sn}; }
    }
    GRID_BAR();

    {
        pg8::Gemm g{H0, W1T, MROWS, IN_COLS, DM}; pg8::StaticOrder S; S.init(MROWS, IN_COLS, G, bx);
        pg8::EpiGen<0> E{nullptr, 0, nullptr, 0.f, QR, KA, VA, RK, RV, RG};
        pg8::gemm_phase<pg8::EpiGen<0>, pg8::StaticOrder, true, true>(L + RING_OFF, g, S, E);
    }
    GRID_BAR();

    for (int r = gw; r < NVALID; r += NGW) {
        int pos, ipos; row_pos(r, pos, ipos);
        bf16* qr = QR + (size_t)r * 2048; bf16* ka = KA + (size_t)r * 128; bf16* rk = RK + (size_t)r * 1024; bf16* rg = RG + (size_t)r * 1024;
        for (int idx = lane; idx < 512; idx += 64) { const int a = idx >> 5, i = idx & 31; const f32x2 cs = ROPE_A[pos * 32 + i];
            const float x1 = bf2f(qr[64 * a + i]), x2 = bf2f(qr[64 * a + 32 + i]);
            qr[64 * a + i] = (bf16)f2bf((x1 * cs.x - x2 * cs.y) * QSCALE); qr[64 * a + 32 + i] = (bf16)f2bf((x2 * cs.x + x1 * cs.y) * QSCALE); }
        { const int a = lane >> 5, i = lane & 31; const f32x2 cs = ROPE_A[pos * 32 + i];
            const float x1 = bf2f(ka[64 * a + i]), x2 = bf2f(ka[64 * a + 32 + i]);
            ka[64 * a + i] = (bf16)f2bf(x1 * cs.x - x2 * cs.y); ka[64 * a + 32 + i] = (bf16)f2bf(x2 * cs.x + x1 * cs.y); }
        for (int idx = lane; idx < 512; idx += 64) { const int h = idx >> 7, i = idx & 127; const f32x2 cs = ROPE_R[pos * 128 + i];
            const float lg = log2_gamma(h); const float qs = exp2f((float)(ipos + 1) * lg), ks = 0.0625f * exp2f(-(float)(ipos + 1) * lg);
            { const float x1 = bf2f(qr[1024 + 256 * h + i]), x2 = bf2f(qr[1024 + 256 * h + 128 + i]);
              qr[1024 + 256 * h + i] = (bf16)f2bf((x1 * cs.x - x2 * cs.y) * qs); qr[1024 + 256 * h + 128 + i] = (bf16)f2bf((x2 * cs.x + x1 * cs.y) * qs); }
            { const float x1 = bf2f(rk[256 * h + i]), x2 = bf2f(rk[256 * h + 128 + i]);
              rk[256 * h + i] = (bf16)f2bf((x1 * cs.x - x2 * cs.y) * ks); rk[256 * h + 128 + i] = (bf16)f2bf((x2 * cs.x + x1 * cs.y) * ks); } }
        for (int idx = lane; idx < 1024; idx += 64) { const float v = bf2f(rg[idx]); rg[idx] = (bf16)f2bf(v / (1.0f + __expf(-v))); }
    }
    GRID_BAR();

    for (int u = bx; u < 256; u += G) attn_unit(L + RING_OFF, u, QR, KA, VA, sinks, tid, lane, wave);

    for (int u = bx; u < 256; u += G) scan_unit(L + RING_OFF, u, RK, RV, STB, tid, lane, wave);
    GRID_BAR();

    for (int u = bx; u < 512; u += G) retout_unit(L + RING_OFF, u, QR, RK, RV, RG, STB, tid, lane, wave);
    GRID_BAR();

    {
        pg8::Gemm g{QR, W2T, NTOK, DM, DM}; pg8::StaticOrder S; S.init(NTOK, DM, G, bx);
        pg8::EpiGen<1> E{Y, DM, H0, ALPHA, nullptr, nullptr, nullptr, nullptr, nullptr, nullptr};
        pg8::gemm_phase<pg8::EpiGen<1>, pg8::StaticOrder, true, true>(L + RING_OFF, g, S, E);
    }
    GRID_BAR();

    for (int m = gw; m < NTOK; m += NGW) ln_row_bf16_to_bf16(Y + (size_t)m * DM, ln_mix_g, ln_mix_b, H1 + (size_t)m * DM, lane);
    GRID_BAR();

    {
        pg8::Gemm g{H1, W3T, NTOK, DM, DM}; pg8::StaticOrder S; S.init(NTOK, DM, G, bx);
        pg8::EpiGen<2> E{Q3, DM, nullptr, 0.f, nullptr, nullptr, nullptr, nullptr, nullptr, nullptr};
        pg8::gemm_phase<pg8::EpiGen<2>, pg8::StaticOrder, true, true>(L + RING_OFF, g, S, E);
    }
    GRID_BAR();

    for (int un = gw; un < (NTOK / 32) * 8; un += NGW) topk_unit((LAS unsigned*)(L + RING_OFF + wave * 8192), un >> 3, un & 7, Q3, SKB, IDS, GATES, lane);
    GRID_BAR();

    int nx = 0, xr = 0, nloc = 1;
    { unsigned* bw = (unsigned*)(ctl + CW_BAR);
#pragma unroll
      for (unsigned j2 = 0; j2 < 16; ++j2) { const unsigned cnt = xb_ld(&bw[XB_XCNT(j2)]); nx += cnt > 0u; xr += (j2 < bar.x && cnt > 0u); if (j2 == bar.x) nloc = (int)cnt; }
      nx = __builtin_amdgcn_readfirstlane(nx); xr = __builtin_amdgcn_readfirstlane(xr); nloc = __builtin_amdgcn_readfirstlane(nloc); if (nx < 1) nx = 1; if (nloc < 1) nloc = 1; }
    const int lrank = __builtin_amdgcn_readfirstlane((int)MISC[10]);
    const int wv = lrank * NWAVES + wave, nwv = nloc * NWAVES;
    float* DOTX = (float*)(ws + WS_RK);
    bf16* CB = (bf16*)(ws + WS_KA);
    float* Y32 = (float*)(ws + WS_H0);
    {
        int tl = tid; asm volatile("" : "+v"(tl)); const int ln = tl & 63, k = ln >> 3, c8 = ln & 7;
        const unsigned char* UT8 = (const unsigned char*)UT;
        for (int s = xr; s < NSL; s += nx) {
            const unsigned char* Us = UT8 + (size_t)s * 16384 * 128;
            const bool first = (s == xr);
            v4u nid[2][2];
#pragma unroll
            for (int z = 0; z < 2; ++z) { const int tz = wv + z * nwv; const int tc = tz < NTOK ? tz : wv; const GAS v4u* ip = (const GAS v4u*)(IDS + (size_t)tc * 128 + 16 * k);
#pragma unroll
                for (int i = 0; i < 2; ++i) nid[z][i] = ip[i]; }
#pragma unroll 1
            for (int t = wv; t < NTOK; t += 2 * nwv) {
                const bool vB = (t + nwv) < NTOK; const int tt[2] = {t, vB ? t + nwv : t};
                v4u ub[2][16]; v4u hs[2][2]; f32x2 old[2];
#pragma unroll
                for (int z = 0; z < 2; ++z) {
#pragma unroll
                    for (int i = 0; i < 16; ++i) { const int pe = 2 * (i & 7) + (i >> 3); const unsigned eid = (nid[z][pe >> 3][(pe >> 1) & 3] >> (16 * (pe & 1))) & 0xffffu; ub[z][i] = *(const GAS v4u*)(Us + (size_t)eid * 128 + 16 * c8); }
                    { const GAS v4u* hp = (const GAS v4u*)(H1 + (size_t)tt[z] * DM + 128 * s + 16 * c8); hs[z][0] = hp[0]; hs[z][1] = hp[1]; } }
#pragma unroll
                for (int z = 0; z < 2; ++z) old[z] = first ? (f32x2){0.f, 0.f} : *(const GAS f32x2*)(DOTX + ((size_t)xr * NTOK + tt[z]) * 128 + 2 * ln);
#pragma unroll
                for (int z = 0; z < 2; ++z) { const int tz = t + (2 + z) * nwv; const int tc = tz < NTOK ? tz : t; const GAS v4u* ip = (const GAS v4u*)(IDS + (size_t)tc * 128 + 16 * k);
#pragma unroll
                    for (int i = 0; i < 2; ++i) nid[z][i] = ip[i]; }
#pragma unroll
                for (int z = 0; z < 2; ++z) {
                    float p[16]; f32x2 hp2[8];
#pragma unroll
                    for (int i = 0; i < 2; ++i)
#pragma unroll
                        for (int c4 = 0; c4 < 4; ++c4) hp2[4 * i + c4] = (f32x2){bflo(hs[z][i][c4]), bfhi(hs[z][i][c4])};
#pragma unroll
                    for (int i = 0; i < 16; ++i) { f32x2 d2 = {0.f, 0.f};
#pragma unroll
                        for (int dw = 0; dw < 4; ++dw) { const f32x2 fl = __builtin_amdgcn_cvt_pk_f32_fp8((int)ub[z][i][dw], false), fh = __builtin_amdgcn_cvt_pk_f32_fp8((int)ub[z][i][dw], true);
                            d2 = __builtin_elementwise_fma(fl, hp2[2 * dw], d2); d2 = __builtin_elementwise_fma(fh, hp2[2 * dw + 1], d2); }
                        p[i] = d2.x + d2.y; }
                    const bool b0 = (c8 & 1) != 0, b1 = (c8 & 2) != 0, b2 = (c8 & 4) != 0;
                    float r1[8], r2[4], q0, q1;
#pragma unroll
                    for (int m = 0; m < 8; ++m) { const float keep = b0 ? p[2 * m + 1] : p[2 * m], give = b0 ? p[2 * m] : p[2 * m + 1]; r1[m] = keep + DPPF(give, 0xB1); }
#pragma unroll
                    for (int m = 0; m < 4; ++m) { const float keep = b1 ? r1[2 * m + 1] : r1[2 * m], give = b1 ? r1[2 * m] : r1[2 * m + 1]; r2[m] = keep + DPPF(give, 0x4E); }
                    { const float keep = b2 ? r2[1] : r2[0], give = b2 ? r2[0] : r2[1]; const float gl = DPPF(give, 0x104), gr = DPPF(give, 0x114); q0 = keep + (b2 ? gr : gl); }
                    { const float keep = b2 ? r2[3] : r2[2], give = b2 ? r2[2] : r2[3]; const float gl = DPPF(give, 0x104), gr = DPPF(give, 0x114); q1 = keep + (b2 ? gr : gl); }
                    if (z == 0 || vB) *(GAS f32x2*)(DOTX + ((size_t)xr * NTOK + tt[z]) * 128 + 2 * ln) = (f32x2){q0 + old[z].x, q1 + old[z].y};
                }
            }
        }
    }
    GRID_BAR();
    for (int idx = gt; idx < NTOK * 128; idx += NGT) { float d = 0.f; for (int xx = 0; xx < nx; ++xx) d += DOTX[(size_t)xx * NTOK * 128 + idx]; CB[idx] = (bf16)f2bf((1.0f / V_SCALE) * GATES[idx] * gelu_erf(d * (1.0f / U_SCALE))); }
    GRID_BAR();
    {
        int tl = tid; asm volatile("" : "+v"(tl)); const int ln = tl & 63, k = ln >> 3, c8 = ln & 7;
        const unsigned char* VT8 = (const unsigned char*)VT;
        for (int s = xr; s < NSL; s += nx) {
            const unsigned char* Vs = VT8 + (size_t)s * 16384 * 128;
            v4u nid[2][2];
#pragma unroll
            for (int z = 0; z < 2; ++z) { const int tz = wv + z * nwv; const int tc = tz < NTOK ? tz : wv; const GAS v4u* ip = (const GAS v4u*)(IDS + (size_t)tc * 128 + 16 * k);
#pragma unroll
                for (int i = 0; i < 2; ++i) nid[z][i] = ip[i]; }
#pragma unroll 1
            for (int t = wv; t < NTOK; t += 2 * nwv) {
                const bool vB = (t + nwv) < NTOK; const int tt[2] = {t, vB ? t + nwv : t};
                v4u vb[2][16]; v4u cf[2][2]; unsigned hs[2];
#pragma unroll
                for (int z = 0; z < 2; ++z) {
#pragma unroll
                    for (int i = 0; i < 16; ++i) { const unsigned eid = (nid[z][i >> 3][(i >> 1) & 3] >> (16 * (i & 1))) & 0xffffu; vb[z][i] = *(const GAS v4u*)(Vs + (size_t)eid * 128 + 16 * c8); } }
#pragma unroll
                for (int z = 0; z < 2; ++z) { hs[z] = *(const GAS unsigned*)(H1 + (size_t)tt[z] * DM + 128 * s + 16 * c8 + 2 * k);
                    const GAS v4u* cp = (const GAS v4u*)(CB + (size_t)tt[z] * 128 + 16 * k); cf[z][0] = cp[0]; cf[z][1] = cp[1]; }
#pragma unroll
                for (int z = 0; z < 2; ++z) { const int tz = t + (2 + z) * nwv; const int tc = tz < NTOK ? tz : t; const GAS v4u* ip = (const GAS v4u*)(IDS + (size_t)tc * 128 + 16 * k);
#pragma unroll
                    for (int i = 0; i < 2; ++i) nid[z][i] = ip[i]; }
#pragma unroll
                for (int z = 0; z < 2; ++z) {
                    f32x2 accp[8];
#pragma unroll
                    for (int q2 = 0; q2 < 8; ++q2) accp[q2] = (f32x2){0.f, 0.f};
#pragma unroll
                    for (int i = 0; i < 16; ++i) { const unsigned cw = cf[z][i >> 3][(i >> 1) & 3]; const float c = (i & 1) ? bfhi(cw) : bflo(cw); const f32x2 c2 = {c, c};
#pragma unroll
                        for (int dw = 0; dw < 4; ++dw) { const f32x2 fl = __builtin_amdgcn_cvt_pk_f32_fp8((int)vb[z][i][dw], false), fh = __builtin_amdgcn_cvt_pk_f32_fp8((int)vb[z][i][dw], true);
                            accp[2 * dw] = __builtin_elementwise_fma(fl, c2, accp[2 * dw]); accp[2 * dw + 1] = __builtin_elementwise_fma(fh, c2, accp[2 * dw + 1]); } }
                    const bool kb0 = (k & 1) != 0, kb1 = (k & 2) != 0, kb2 = (k & 4) != 0;
                    f32x2 rA[4], rB[2], rC;
#pragma unroll
                    for (int m = 0; m < 4; ++m) { const f32x2 keep = kb0 ? accp[2 * m + 1] : accp[2 * m], give = kb0 ? accp[2 * m] : accp[2 * m + 1];
                        rA[m] = keep + (f32x2){DPPF(give.x, 0x128), DPPF(give.y, 0x128)}; }
#pragma unroll
                    for (int m = 0; m < 2; ++m) { const f32x2 keep = kb1 ? rA[2 * m + 1] : rA[2 * m], give = kb1 ? rA[2 * m] : rA[2 * m + 1];
                        const auto sx = __builtin_amdgcn_permlane16_swap(__float_as_uint(give.x), __float_as_uint(give.x), false, false), sy = __builtin_amdgcn_permlane16_swap(__float_as_uint(give.y), __float_as_uint(give.y), false, false);
                        rB[m] = keep + (f32x2){__uint_as_float(kb1 ? sx[0] : sx[1]), __uint_as_float(kb1 ? sy[0] : sy[1])}; }
                    { const f32x2 keep = kb2 ? rB[1] : rB[0], give = kb2 ? rB[0] : rB[1];
                        const auto sx = __builtin_amdgcn_permlane32_swap(__float_as_uint(give.x), __float_as_uint(give.x), false, false), sy = __builtin_amdgcn_permlane32_swap(__float_as_uint(give.y), __float_as_uint(give.y), false, false);
                        rC = keep + (f32x2){__uint_as_float(kb2 ? sx[0] : sx[1]), __uint_as_float(kb2 ? sy[0] : sy[1])}; }
                    if (z == 0 || vB) *(GAS f32x2*)(Y32 + (size_t)tt[z] * DM + 128 * s + 16 * c8 + 2 * k) = (f32x2){rC.x + ALPHA * bflo(hs[z]), rC.y + ALPHA * bfhi(hs[z])};
                }
            }
        }
    }
    GRID_BAR();
    for (int m = gw; m < NTOK; m += NGW) {
        const GAS f32x4* xr4 = (const GAS f32x4*)(Y32 + (size_t)m * DM) + lane;
        f32x4 v[8]; float sm = 0.f;
#pragma unroll
        for (int j2 = 0; j2 < 8; ++j2) { v[j2] = xr4[64 * j2]; sm += (v[j2].x + v[j2].y) + (v[j2].z + v[j2].w); }
        const float mean = wave_sum(sm) * (1.f / DM); float s2 = 0.f;
#pragma unroll
        for (int j2 = 0; j2 < 8; ++j2) { v[j2] = v[j2] - mean; s2 += (v[j2].x * v[j2].x + v[j2].y * v[j2].y) + (v[j2].z * v[j2].z + v[j2].w * v[j2].w); }
        const float rstd = 1.f / sqrtf(wave_sum(s2) * (1.f / DM) + LN_EPS);
        GAS f32x4* op = (GAS f32x4*)(out + (size_t)m * DM) + lane;
#pragma unroll
        for (int j2 = 0; j2 < 8; ++j2) { const f32x4 gg = ((const GAS f32x4*)ln_ffn_g)[lane + 64 * j2], bb = ((const GAS f32x4*)ln_ffn_b)[lane + 64 * j2];
            op[64 * j2] = (f32x4){v[j2].x * rstd * gg.x + bb.x, v[j2].y * rstd * gg.y + bb.y, v[j2].z * rstd * gg.z + bb.z, v[j2].w * rstd * gg.w + bb.w}; }
    }
}

extern "C" void kernel_launch(void* const* d_in, const int* in_sizes, int n_in, void* d_out, int out_size, void* d_ws, size_t ws_size, hipStream_t stream) {
    static int grid = 0;
    if (grid == 0) {
        if (n_in != 15 || out_size != NTOK * DM || ws_size < WS_END) { fprintf(stderr, "kernel_launch: unexpected shapes (n_in %d out %d ws %zu)\n", n_in, out_size, ws_size); grid = -1; return; }
        int dev = 0, cus = 0, per_cu = 0;
        if (hipGetDevice(&dev) != hipSuccess || hipDeviceGetAttribute(&cus, hipDeviceAttributeMultiprocessorCount, dev) != hipSuccess) { grid = -1; return; }
        if (hipFuncSetAttribute((const void*)mk_fwd, hipFuncAttributeMaxDynamicSharedMemorySize, LDS_BYTES) != hipSuccess) { fprintf(stderr, "kernel_launch: hipFuncSetAttribute failed\n"); grid = -1; return; }
        if (hipOccupancyMaxActiveBlocksPerMultiprocessor(&per_cu, (const void*)mk_fwd, NWAVES * 64, LDS_BYTES) != hipSuccess || per_cu < 1) { fprintf(stderr, "kernel_launch: occupancy query says %d\n", per_cu); }
        (void)hipGetLastError();
        grid = cus;
    }
    if (grid < 0) return;
    if (hipMemsetAsync((char*)d_ws + WS_CTL, 0, CTL_ZERO_BYTES, stream) != hipSuccess) return;
    Args a{};
    for (int i = 0; i < 15; ++i) a.in[i] = (const float*)d_in[i];
    a.out = (float*)d_out; a.ws = (unsigned char*)d_ws;
    hipLaunchKernelGGL(mk_fwd, dim3(grid), dim3(NWAVES * 64), LDS_BYTES, stream, a);
}
```

```cpp
#include <hip/hip_runtime.h>
#include <cstdio>
#include <cstdint>
#include <cmath>
namespace pg8 {
#define PG8_LAS __attribute__((address_space(3)))
typedef unsigned short bf16_t;
typedef short bf16x8 __attribute__((ext_vector_type(8)));
typedef float f32x4 __attribute__((ext_vector_type(4)));
typedef unsigned u32x4 __attribute__((ext_vector_type(4)));
constexpr int BM = 256, BK = 64, HALF = 128, HTB = HALF * BK * 2  , STAGE_BYTES = 8 * HTB, NXCD = 8, WGM = 8;

__host__ __device__ __forceinline__ int lds_byte(int r, int c) { const int st = (r >> 4) * 2 + (c >> 5), rr = r & 15, cc = c & 31, ob = rr * 64 + cc * 2; return st * 1024 + (ob ^ (((ob >> 9) & 1) << 5)); }
__host__ __device__ __forceinline__ void stage_rc(int b, int& R, int& C) { const int st = b / 1024, sb = b % 1024, swz = sb ^ (((sb >> 9) & 1) << 5); R = (st >> 1) * 16 + swz / 64; C = (st & 1) * 32 + (swz % 64) / 2; }
__host__ __device__ __forceinline__ int perm32(int rho) { const int n = rho >> 4, i = rho & 15; return 8 * (i >> 2) + 4 * n + (i & 3); }

struct Unit { int pm, pn; };
struct Gemm { const bf16_t* A; const bf16_t* Bt; int M, N, K; };

struct StaticOrder {
    int nM, nN, nwg, G, c;
    __host__ __device__ void init(int M, int N, int G_, int c_) { nM = M / BM; nN = N / BM; nwg = nM * nN; G = G_; c = c_; }
    __host__ __device__ bool next(int i, Unit& u) const {
        const long L = (long)i * G + c; if (L >= nwg) return false;
        int wgid = (int)L; { const int q = nwg / NXCD, r = nwg % NXCD, xcd = wgid % NXCD, off = wgid / NXCD; wgid = (xcd < r ? xcd * (q + 1) : r * (q + 1) + (xcd - r) * q) + off; }
        const int nig = WGM * nN, gid = wgid / nig, fm = gid * WGM, gsz = (nM - fm) < WGM ? (nM - fm) : WGM;
        u.pm = fm + ((wgid % nig) % gsz); u.pn = (wgid % nig) / gsz; return true;
    }
    __device__ __forceinline__ void a_ready(const Unit&) const {}
    __device__ __forceinline__ void done(const Unit&) const {}
};

__device__ __forceinline__ unsigned cvt_pk_bf16(float lo, float hi) { unsigned r; asm volatile("v_cvt_pk_bf16_f32 %0, %1, %2" : "=v"(r) : "v"(lo), "v"(hi)); return r; }
typedef float f32x2 __attribute__((ext_vector_type(2)));

template <int MODE> struct EpiGen {
    static constexpr bool PERM = true, AFTER_DRAIN = false;
    bf16_t* O; int ldc; const bf16_t* R; float alpha;
    bf16_t *QR, *KA, *VA, *RK, *RV, *RG;
    __device__ __forceinline__ void operator()(const f32x4 (&acc)[2][2][4][2], const Unit& u, int wr, int wc, int fr, int fq) const {
        const int row0 = u.pm * BM + wr * 64 + fr;
#pragma unroll
        for (int bj = 0; bj < 2; ++bj) {
            const int col = u.pn * BM + bj * HALF + wc * 32 + 8 * fq;
            bf16_t* base = O; int ld = ldc; int cc = col;
            if (MODE == 0) {
                if (col < 1024)      { base = QR; ld = 2048; cc = col; }
                else if (col < 1152) { base = KA; ld = 128;  cc = col - 1024; }
                else if (col < 1280) { base = VA; ld = 128;  cc = col - 1152; }
                else if (col < 2304) { base = QR; ld = 2048; cc = col - 1280 + 1024; }
                else if (col < 3328) { base = RK; ld = 1024; cc = col - 2304; }
                else if (col < 4352) { base = RV; ld = 1024; cc = col - 3328; }
                else                 { base = RG; ld = 1024; cc = col - 4352; }
            }
#pragma unroll
            for (int ai = 0; ai < 2; ++ai)
#pragma unroll
                for (int m = 0; m < 4; ++m) {
                    const int row = row0 + ai * HALF + m * 16;
                    f32x4 v0 = acc[ai][bj][m][0], v1 = acc[ai][bj][m][1];
                    if (MODE == 1) {
                        const u32x4 r = *(const u32x4*)(R + (size_t)row * ldc + col);
                        v0[0] += alpha * __uint_as_float(r.x << 16); v0[1] += alpha * __uint_as_float(r.x & 0xffff0000u);
                        v0[2] += alpha * __uint_as_float(r.y << 16); v0[3] += alpha * __uint_as_float(r.y & 0xffff0000u);
                        v1[0] += alpha * __uint_as_float(r.z << 16); v1[1] += alpha * __uint_as_float(r.z & 0xffff0000u);
                        v1[2] += alpha * __uint_as_float(r.w << 16); v1[3] += alpha * __uint_as_float(r.w & 0xffff0000u);
                    }
                    u32x4 w; w.x = cvt_pk_bf16(v0[0], v0[1]); w.y = cvt_pk_bf16(v0[2], v0[3]); w.z = cvt_pk_bf16(v1[0], v1[1]); w.w = cvt_pk_bf16(v1[2], v1[3]);
                    *(u32x4*)(base + (size_t)row * ld + cc) = w;
                }
        }
    }
};

struct EpiProj {
    static constexpr bool PERM = true, AFTER_DRAIN = false;
    bf16_t *QR, *KA, *VA, *RK, *RV, *RG; const float* ropeR; const float* ropeA; float qscale;
    __device__ __forceinline__ void operator()(const f32x4 (&acc)[2][2][4][2], const Unit& u, int wr, int wc, int fr, int fq) const {
        const int pn = u.pn, row0 = u.pm * BM + wr * 64 + fr, c0 = wc * 32 + 8 * fq;
        const bool rope = (pn <= 3) || (pn == 4 && wc < 2) || (pn >= 5 && pn <= 12);
        if (rope) {
            const bool ret = pn >= 5; const int h = ret ? ((pn - 5) & 3) : 0;
            const float lg = __builtin_amdgcn_logf(1.0f - __builtin_amdgcn_exp2f(-5.0f - (float)h));
            bf16_t* base; int ld, cA, cB;
            if (pn <= 3)      { base = QR; ld = 2048; cA = pn * 256 + 64 * wc + 8 * fq; cB = cA + 32; }
            else if (pn == 4) { base = KA; ld = 128;  cA = 64 * wc + 8 * fq; cB = cA + 32; }
            else if (pn <= 8) { base = QR; ld = 2048; cA = 1024 + 256 * h + c0; cB = cA + 128; }
            else              { base = RK; ld = 1024; cA = 256 * h + c0; cB = cA + 128; }
#pragma unroll
            for (int ai = 0; ai < 2; ++ai)
#pragma unroll
                for (int m = 0; m < 4; ++m) {
                    const int row = row0 + ai * HALF + m * 16;
                    int pos, ipos;
                    if (row < 16384) { const int s = row & 4095; pos = 16 + s; ipos = s & 127; } else { int j = row - 16384; if (j > 15) j = 15; pos = j; ipos = 112 + j; }
                    float sc = qscale;
                    if (pn == 4) sc = 1.0f; else if (pn >= 9) sc = 0.0625f * __builtin_amdgcn_exp2f(-(float)(ipos + 1) * lg); else if (pn >= 5) sc = __builtin_amdgcn_exp2f((float)(ipos + 1) * lg);
                    const float* tb = ret ? ropeR + ((size_t)pos * 128 + c0) * 2 : ropeA + ((size_t)pos * 32 + 8 * fq) * 2;
                    const f32x4 t0 = *(const f32x4*)tb, t1 = *(const f32x4*)(tb + 4), t2 = *(const f32x4*)(tb + 8), t3 = *(const f32x4*)(tb + 12);
                    const f32x4 a0 = acc[ai][0][m][0], a1 = acc[ai][0][m][1], b0 = acc[ai][1][m][0], b1 = acc[ai][1][m][1];
                    u32x4 wA, wB;
                    wA.x = cvt_pk_bf16((a0[0] * t0[0] - b0[0] * t0[1]) * sc, (a0[1] * t0[2] - b0[1] * t0[3]) * sc); wA.y = cvt_pk_bf16((a0[2] * t1[0] - b0[2] * t1[1]) * sc, (a0[3] * t1[2] - b0[3] * t1[3]) * sc);
                    wA.z = cvt_pk_bf16((a1[0] * t2[0] - b1[0] * t2[1]) * sc, (a1[1] * t2[2] - b1[1] * t2[3]) * sc); wA.w = cvt_pk_bf16((a1[2] * t3[0] - b1[2] * t3[1]) * sc, (a1[3] * t3[2] - b1[3] * t3[3]) * sc);
                    wB.x = cvt_pk_bf16((b0[0] * t0[0] + a0[0] * t0[1]) * sc, (b0[1] * t0[2] + a0[1] * t0[3]) * sc); wB.y = cvt_pk_bf16((b0[2] * t1[0] + a0[2] * t1[1]) * sc, (b0[3] * t1[2] + a0[3] * t1[3]) * sc);
                    wB.z = cvt_pk_bf16((b1[0] * t2[0] + a1[0] * t2[1]) * sc, (b1[1] * t2[2] + a1[1] * t2[3]) * sc); wB.w = cvt_pk_bf16((b1[2] * t3[0] + a1[2] * t3[1]) * sc, (b1[3] * t3[2] + a1[3] * t3[3]) * sc);
                    *(u32x4*)(base + (size_t)row * ld + cA) = wA; *(u32x4*)(base + (size_t)row * ld + cB) = wB;
                    if (m & 1) asm volatile("" ::: "memory");
                }
        } else {
            const bool silu = pn >= 17;
#pragma unroll
            for (int bj = 0; bj < 2; ++bj) {
                bf16_t* base; int ld, cc;
                if (pn == 4)       { base = VA; ld = 128;  cc = 64 * bj + 32 * (wc - 2) + 8 * fq; }
                else if (pn <= 16) { base = RV; ld = 1024; cc = 256 * (pn - 13) + 128 * bj + c0; }
                else               { base = RG; ld = 1024; cc = 256 * (pn - 17) + 128 * bj + c0; }
#pragma unroll
                for (int ai = 0; ai < 2; ++ai)
#pragma unroll
                    for (int m = 0; m < 4; ++m) {
                        const int row = row0 + ai * HALF + m * 16;
                        f32x4 v0 = acc[ai][bj][m][0], v1 = acc[ai][bj][m][1];
                        if (silu) {
#pragma unroll
                            for (int e = 0; e < 4; ++e) { v0[e] = v0[e] * __builtin_amdgcn_rcpf(1.0f + __builtin_amdgcn_exp2f(-1.4426950408889634f * v0[e])); v1[e] = v1[e] * __builtin_amdgcn_rcpf(1.0f + __builtin_amdgcn_exp2f(-1.4426950408889634f * v1[e])); } }
                        u32x4 w; w.x = cvt_pk_bf16(v0[0], v0[1]); w.y = cvt_pk_bf16(v0[2], v0[3]); w.z = cvt_pk_bf16(v1[0], v1[1]); w.w = cvt_pk_bf16(v1[2], v1[3]);
                        *(u32x4*)(base + (size_t)row * ld + cc) = w;
                    }
            }
        }
    }
};
template <class Epi, class Sched, bool ALIGN_EPI = false, bool SP2 = false>
__device__ __forceinline__ void gemm_phase(PG8_LAS unsigned char* lds, const Gemm g, const Sched& S, const Epi& E) {
    const int tid = threadIdx.x, wid = __builtin_amdgcn_readfirstlane(tid >> 6), lane = tid & 63, wr = wid >> 2, wc = wid & 3, fr = lane & 15, fq = lane >> 4;
    const int K = g.K, nt = K / BK;
    unsigned voffA[2], voffB[2];
#pragma unroll
    for (int i = 0; i < 2; ++i) { int R, C; stage_rc(tid * 16 + i * 8192, R, C); const int Rb = Epi::PERM ? ((R & ~31) + perm32(R & 31)) : R;
        voffA[i] = (unsigned)(R * K + C) * 2u; voffB[i] = (unsigned)(Rb * K + C) * 2u; }
    const size_t kstep = (size_t)(BK * 2);
    const size_t hstep = (size_t)HALF * K * 2;
    const size_t tstep = 2 * hstep;
    const unsigned ldsw = (unsigned)wid * 1024u;
    const int aoff = lds_byte(wr * 64 + fr, fq * 8), boff = lds_byte(wc * 32 + fr, fq * 8);
#define PG8_SA(b, h) (((b) * 2 + (h)) * HTB)
#define PG8_SB(b, h) ((4 + (b) * 2 + (h)) * HTB)
#define PG8_STAGE(bufoff, gbase, voff) do { _Pragma("unroll") for (int _i = 0; _i < 2; ++_i) \
        __builtin_amdgcn_global_load_lds((const unsigned*)((const char*)(gbase) + (voff)[_i]), (PG8_LAS unsigned*)(lds + (bufoff) + ldsw + _i * 8192), 16, 0, 0); } while (0)
#define PG8_LDA(dst, b, h) do { _Pragma("unroll") for (int m = 0; m < 4; ++m) _Pragma("unroll") for (int k = 0; k < 2; ++k) dst[m][k] = *(const PG8_LAS bf16x8*)(lds + PG8_SA(b, h) + aoff + m * 2048 + k * 1024); } while (0)
#define PG8_LDB(dst, b, h) do { _Pragma("unroll") for (int n = 0; n < 2; ++n) _Pragma("unroll") for (int k = 0; k < 2; ++k) dst[n][k] = *(const PG8_LAS bf16x8*)(lds + PG8_SB(b, h) + boff + n * 2048 + k * 1024); } while (0)
#define PG8_MMA(ai, bj, At, Bt) do { __builtin_amdgcn_s_setprio(1); _Pragma("unroll") for (int m = 0; m < 4; ++m) _Pragma("unroll") for (int n = 0; n < 2; ++n) _Pragma("unroll") for (int k = 0; k < 2; ++k) \
        acc[ai][bj][m][n] = __builtin_amdgcn_mfma_f32_16x16x32_bf16(Bt[n][k], At[m][k], acc[ai][bj][m][n], 0, 0, 0); __builtin_amdgcn_s_setprio(0); } while (0)
#define PG8_WAIT_V(n) asm volatile("s_waitcnt vmcnt(" #n ")" ::: "memory")
#define PG8_WAIT_L(n) asm volatile("s_waitcnt lgkmcnt(" #n ")" ::: "memory")
#define PG8_BAR __builtin_amdgcn_s_barrier()
#define PG8_SCHED __builtin_amdgcn_sched_barrier(0)
    Unit cur, nxt; int ui = 0;
    if (!S.next(0, cur)) return;
    f32x4 acc[2][2][4][2];
#pragma unroll
    for (int a = 0; a < 2; ++a)
#pragma unroll
        for (int b = 0; b < 2; ++b)
#pragma unroll
            for (int m = 0; m < 4; ++m)
#pragma unroll
                for (int n = 0; n < 2; ++n) acc[a][b][m][n] = (f32x4){0.f, 0.f, 0.f, 0.f};
    bf16x8 At[4][2], B0[2][2], B1[2][2];
    const char* cA = (const char*)g.A + (size_t)cur.pm * tstep; const char* cB = (const char*)g.Bt + (size_t)cur.pn * tstep;
    S.a_ready(cur);
    if constexpr (SP2) {
        PG8_STAGE(PG8_SB(0, 0), cB, voffB); PG8_STAGE(PG8_SB(0, 1), cB + hstep, voffB); PG8_STAGE(PG8_SA(0, 0), cA, voffA); PG8_STAGE(PG8_SA(0, 1), cA + hstep, voffA);
        if (wr == 1) PG8_BAR;
        PG8_WAIT_V(2); PG8_BAR;
        PG8_STAGE(PG8_SB(1, 0), cB + kstep, voffB); PG8_STAGE(PG8_SA(1, 0), cA + kstep, voffA); PG8_STAGE(PG8_SB(1, 1), cB + hstep + kstep, voffB);
        PG8_WAIT_V(6); PG8_BAR;
    } else {
        PG8_STAGE(PG8_SB(0, 0), cB, voffB); PG8_STAGE(PG8_SA(0, 0), cA, voffA); PG8_STAGE(PG8_SB(0, 1), cB + hstep, voffB); PG8_STAGE(PG8_SA(0, 1), cA + hstep, voffA);
        if (wr == 1) PG8_BAR;
        PG8_WAIT_V(4); PG8_BAR;
        PG8_STAGE(PG8_SB(1, 0), cB + kstep, voffB); PG8_STAGE(PG8_SA(1, 0), cA + kstep, voffA); PG8_STAGE(PG8_SB(1, 1), cB + hstep + kstep, voffB);
        PG8_WAIT_V(6); PG8_BAR;
    }
    for (;;) {
        const bool has_next = S.next(ui + 1, nxt);
        const char* nA = has_next ? (const char*)g.A + (size_t)nxt.pm * tstep : cA; const char* nB = has_next ? (const char*)g.Bt + (size_t)nxt.pn * tstep : cB;
        for (int t = 0; t < nt; t += 2) {
            const bool last = (t == nt - 2);
            const char* a1 = cA + (size_t)(t + 1) * kstep;
            const char* a2 = last ? nA : cA + (size_t)(t + 2) * kstep; const char* b2 = last ? nB : cB + (size_t)(t + 2) * kstep;
            const char* a3 = a2 + kstep; const char* b3 = b2 + kstep;
            if (last && has_next) S.a_ready(nxt);
            if constexpr (SP2) {
            PG8_LDB(B0, 0, 0); PG8_LDB(B1, 0, 1); PG8_SCHED; PG8_LDA(At, 0, 0); PG8_STAGE(PG8_SA(1, 1), a1 + hstep, voffA);
            PG8_WAIT_V(8); PG8_WAIT_L(0); PG8_BAR; PG8_MMA(0, 0, At, B0); PG8_MMA(0, 1, At, B1); PG8_BAR; PG8_SCHED;
            PG8_LDA(At, 0, 1); PG8_STAGE(PG8_SB(0, 0), b2, voffB); PG8_STAGE(PG8_SB(0, 1), b2 + hstep, voffB); PG8_STAGE(PG8_SA(0, 0), a2, voffA);
            PG8_WAIT_V(8); PG8_WAIT_L(0); PG8_BAR; PG8_MMA(1, 0, At, B0); PG8_MMA(1, 1, At, B1); PG8_BAR; PG8_SCHED;
            PG8_LDB(B0, 1, 0); PG8_LDB(B1, 1, 1); PG8_SCHED; PG8_LDA(At, 1, 0); PG8_STAGE(PG8_SA(0, 1), a2 + hstep, voffA);
            PG8_WAIT_V(8); PG8_WAIT_L(0); PG8_BAR; PG8_MMA(0, 0, At, B0); PG8_MMA(0, 1, At, B1); PG8_BAR; PG8_SCHED;
            PG8_LDA(At, 1, 1); PG8_STAGE(PG8_SB(1, 0), b3, voffB); PG8_STAGE(PG8_SB(1, 1), b3 + hstep, voffB); PG8_STAGE(PG8_SA(1, 0), a3, voffA);
            PG8_WAIT_V(8); PG8_WAIT_L(0); PG8_BAR; PG8_MMA(1, 0, At, B0); PG8_MMA(1, 1, At, B1); PG8_BAR; PG8_SCHED;
            } else {
            PG8_LDB(B0, 0, 0); PG8_SCHED; PG8_LDA(At, 0, 0); PG8_STAGE(PG8_SA(1, 1), a1 + hstep, voffA);
            PG8_WAIT_L(8); PG8_BAR; PG8_WAIT_L(0); PG8_MMA(0, 0, At, B0); PG8_BAR; PG8_SCHED;
            PG8_LDB(B1, 0, 1); PG8_STAGE(PG8_SB(0, 0), b2, voffB);
            PG8_BAR; PG8_WAIT_L(0); PG8_MMA(0, 1, At, B1); PG8_BAR;
            PG8_LDA(At, 0, 1); PG8_STAGE(PG8_SA(0, 0), a2, voffA);
            PG8_BAR; PG8_WAIT_L(0); PG8_MMA(1, 0, At, B0); PG8_BAR; PG8_SCHED;
            PG8_STAGE(PG8_SB(0, 1), b2 + hstep, voffB);
            PG8_WAIT_V(6); PG8_BAR; PG8_MMA(1, 1, At, B1); PG8_BAR;
            PG8_LDB(B0, 1, 0); PG8_SCHED; PG8_LDA(At, 1, 0); PG8_STAGE(PG8_SA(0, 1), a2 + hstep, voffA);
            PG8_WAIT_L(8); PG8_BAR; PG8_WAIT_L(0); PG8_MMA(0, 0, At, B0); PG8_BAR; PG8_SCHED;
            PG8_LDB(B1, 1, 1); PG8_STAGE(PG8_SB(1, 0), b3, voffB);
            PG8_BAR; PG8_WAIT_L(0); PG8_MMA(0, 1, At, B1); PG8_BAR;
            PG8_LDA(At, 1, 1); PG8_STAGE(PG8_SA(1, 0), a3, voffA);
            PG8_BAR; PG8_WAIT_L(0); PG8_MMA(1, 0, At, B0); PG8_BAR; PG8_SCHED;
            PG8_STAGE(PG8_SB(1, 1), b3 + hstep, voffB);
            PG8_WAIT_V(6); PG8_BAR; PG8_MMA(1, 1, At, B1); PG8_BAR;
            }
        }
        if constexpr (ALIGN_EPI) { if (wr == 0) PG8_BAR; }
        if constexpr (!Epi::AFTER_DRAIN) { E(acc, cur, wr, wc, fr, fq); S.done(cur); }
        if (!has_next) break;
#pragma unroll
        for (int a = 0; a < 2; ++a)
#pragma unroll
            for (int b = 0; b < 2; ++b)
#pragma unroll
                for (int m = 0; m < 4; ++m)
#pragma unroll
                    for (int n = 0; n < 2; ++n) acc[a][b][m][n] = (f32x4){0.f, 0.f, 0.f, 0.f};
        cur = nxt; cA = nA; cB = nB; ++ui;
        if constexpr (ALIGN_EPI) { if (wr == 1) PG8_BAR; }
    }
    PG8_WAIT_V(0);
    if constexpr (!ALIGN_EPI) { if (wr == 0) PG8_BAR; }
    PG8_BAR;
    if constexpr (Epi::AFTER_DRAIN) { E.fused(acc, cur, wr, wc, fr, fq, lds, wid, lane); S.done(cur); }
#undef PG8_SA
#undef PG8_SB
#undef PG8_STAGE
#undef PG8_LDA
#undef PG8_LDB
#undef PG8_MMA
#undef PG8_WAIT_V
#undef PG8_WAIT_L
#undef PG8_BAR
#undef PG8_SCHED
}
}

constexpr int NWAVES = 8;
constexpr int DM = 2048, NB = 4, SEQ = 4096, NTOK = NB * SEQ;
constexpr int NMETA = 16, NVALID = NTOK + NMETA, MROWS = 16640;
constexpr int IN_COLS = 5376;
constexpr float LN_EPS = 1e-5f, GN_EPS = 1e-5f;
constexpr float ALPHA = 1.189207115002721f;
constexpr float LOG2E = 1.4426950408889634f;
constexpr float QSCALE = 0.125f * LOG2E;
constexpr float U_SCALE = 64.0f, V_SCALE = 4.0f;
constexpr int NSL = 16;

constexpr size_t MiB = 1u << 20;
constexpr size_t WS_CTL = 0, CTL_ZERO_BYTES = 1 * MiB;
constexpr size_t SZ_SK = (size_t)16 * 128 * 128 * 2, SZ_ROPE_R = (size_t)4112 * 128 * 8, SZ_ROPE_A = (size_t)4112 * 32 * 8;
constexpr size_t SZ_W2T = (size_t)DM * DM * 2, SZ_W1T = (size_t)IN_COLS * DM * 2, SZ_TAB = (size_t)16384 * DM * 2;
constexpr size_t SZ_ROWS2K = (size_t)MROWS * 2048 * 2, SZ_ROWS1K = (size_t)MROWS * 1024 * 2, SZ_ROWS128 = (size_t)MROWS * 128 * 2;
constexpr size_t SZ_TOK2K = (size_t)NTOK * 2048 * 2, SZ_ST = (size_t)16 * 32 * 256 * 256 * 2, SZ_IDS = (size_t)NTOK * 128 * 4;
constexpr size_t al256(size_t x) { return (x + 255) & ~(size_t)255; }
constexpr size_t WS_SK = 1 * MiB;
constexpr size_t WS_ROPE_R = al256(WS_SK + SZ_SK);
constexpr size_t WS_ROPE_A = al256(WS_ROPE_R + SZ_ROPE_R);
constexpr size_t WS_W2T = al256(WS_ROPE_A + SZ_ROPE_A), WS_W3T = al256(WS_W2T + SZ_W2T), WS_W1T = al256(WS_W3T + SZ_W2T);
constexpr size_t WS_UT = al256(WS_W1T + SZ_W1T), WS_VT = al256(WS_UT + SZ_TAB);
constexpr size_t WS_H0 = al256(WS_VT + SZ_TAB);
constexpr size_t WS_QR = al256(WS_H0 + SZ_ROWS2K);
constexpr size_t WS_KA = al256(WS_QR + SZ_ROWS2K), WS_VA = al256(WS_KA + SZ_ROWS128);
constexpr size_t WS_RK = al256(WS_VA + SZ_ROWS128), WS_RV = al256(WS_RK + SZ_ROWS1K), WS_RG = al256(WS_RV + SZ_ROWS1K);
constexpr size_t WS_ST = al256(WS_RG + SZ_ROWS1K);
constexpr size_t WS_Y = WS_RK;
constexpr size_t WS_H1 = WS_ST;
constexpr size_t WS_IDS = al256(WS_ST + SZ_ST), WS_GATES = al256(WS_IDS + SZ_IDS);
constexpr size_t WS_END = al256(WS_GATES + SZ_IDS);
static_assert(WS_Y + SZ_TOK2K <= WS_RG, "Y overlays RK|RV only");
static_assert(SZ_TOK2K <= SZ_ST && (size_t)NTOK * 1024 * 4 <= SZ_ST, "H1 / RET_RAW fit the state region");
static_assert(WS_END <= (size_t)512 * MiB, "workspace map fits 4 x largest tensor");
static_assert(WS_RK + (size_t)8 * NTOK * 128 * 4 <= WS_ST && WS_KA + (size_t)NTOK * 128 * 4 <= WS_RK && WS_H0 + (size_t)NTOK * DM * 4 <= WS_KA, "expert-phase overlays (DOTX over RK|RV, CB over KA|VA, Y32 over H0|QR)");
constexpr int CW_TMO = 0, CW_BAR = 4096;

constexpr int RING_OFF = 0, RING_BYTES = 131072;
constexpr int LDSCTL_OFF = RING_BYTES, MISC_OFF = LDSCTL_OFF + 320;
constexpr int LDS_BYTES = 147456;

#define GAS __attribute__((address_space(1)))
#define LAS __attribute__((address_space(3)))
typedef unsigned short bf16;
typedef unsigned v4u __attribute__((ext_vector_type(4)));
typedef unsigned v2u __attribute__((ext_vector_type(2)));
typedef float f32x4 __attribute__((ext_vector_type(4)));
typedef float f32x2 __attribute__((ext_vector_type(2)));
typedef GAS unsigned gu32;
typedef __bf16 bf16x2_t __attribute__((ext_vector_type(2)));
#define RLX_AGENT __ATOMIC_RELAXED, __HIP_MEMORY_SCOPE_AGENT
#define LDS_WAIT() asm volatile("s_waitcnt lgkmcnt(0)" ::: "memory")
#define VM_WAIT() asm volatile("s_waitcnt vmcnt(0)" ::: "memory")
__device__ __forceinline__ unsigned f2bf(float f) { unsigned u = __builtin_bit_cast(unsigned, f); return (u + 0x7fffu + ((u >> 16) & 1u)) >> 16; }
__device__ __forceinline__ unsigned pk2(float lo, float hi) { return f2bf(lo) | (f2bf(hi) << 16); }
__device__ __forceinline__ float bflo(unsigned w) { return __uint_as_float(w << 16); }
__device__ __forceinline__ float bfhi(unsigned w) { return __uint_as_float(w & 0xffff0000u); }
__device__ __forceinline__ float bf2f(bf16 h) { return __uint_as_float((unsigned)h << 16); }

#define XB_TMO      128
#define XB_XCNT(j)  (256  + 64 * (j))
#define XB_XSUB(j)  (1280 + 64 * (j))
#define XB_XGEN(j)  (2304 + 64 * (j))
#define XB_TOP      3328
#define XB_TOPGEN   3392
#define XCD_BAR_WORDS 3456
#define XB_SPIN_CAP (1u << 18)

__device__ __forceinline__ unsigned xb_ld(unsigned* p)              { return __hip_atomic_load(p, __ATOMIC_RELAXED, __HIP_MEMORY_SCOPE_AGENT); }
__device__ __forceinline__ unsigned xb_add(unsigned* p, unsigned v) { return __hip_atomic_fetch_add(p, v, __ATOMIC_RELAXED, __HIP_MEMORY_SCOPE_AGENT); }
__device__ __forceinline__ unsigned xb_xcc_id() { return (unsigned)__builtin_amdgcn_s_getreg((3 << 11) | 20) & 0xFu; }
#define XB_SPIN(cond, bar) do { unsigned _sp = 0; while (cond) { __builtin_amdgcn_s_sleep(1); \
    if ((++_sp & 255u) == 0u) { if (xb_ld(&(bar)[XB_TMO])) break; if (_sp > XB_SPIN_CAP) { atomicAdd(&(bar)[XB_TMO], 1u); break; } } } } while (0)

struct XcdBarrier {
    unsigned* bar; unsigned x;
    volatile LAS unsigned* st;
};

__device__ __forceinline__ XcdBarrier xcd_barrier_post(unsigned* bar, volatile LAS unsigned* st) {
    XcdBarrier b; b.bar = bar; b.x = xb_xcc_id(); b.st = st;
    if (threadIdx.x == 0) (void)xb_add(&bar[XB_XCNT(b.x)], 1u);
    return b;
}
__device__ __forceinline__ void xcd_barrier_complete(unsigned* bar, unsigned x, unsigned& nloc, unsigned& nx) {
    const unsigned G = gridDim.x * gridDim.y * gridDim.z;
    unsigned sum, cnt, mine, sp = 0u;
    for (;;) {
        sum = 0u; cnt = 0u; mine = 0u;
#pragma unroll
        for (unsigned j = 0; j < 16; ++j) { const unsigned c = xb_ld(&bar[XB_XCNT(j)]); sum += c; cnt += (c > 0u) ? 1u : 0u; mine = (j == x) ? c : mine; }
        if (sum == G) break;
        __builtin_amdgcn_s_sleep(1);
        if ((++sp & 255u) == 0u) { if (xb_ld(&bar[XB_TMO])) break; if (sp > XB_SPIN_CAP) { atomicAdd(&bar[XB_TMO], 1u); break; } }
    }
    nloc = mine > 0u ? mine : 1u; nx = cnt > 0u ? cnt : 1u;
}

__device__ __forceinline__ void xcd_barrier(const XcdBarrier& b) {
    asm volatile("s_waitcnt vmcnt(0)" ::: "memory");
    __syncthreads();
    if (threadIdx.x == 0) {
        unsigned* bar = b.bar;
        __builtin_amdgcn_s_waitcnt(0);
        unsigned nloc = b.st[0], nx = b.st[1];
        if (nloc == 0u) { xcd_barrier_complete(bar, b.x, nloc, nx); b.st[0] = nloc; b.st[1] = nx; }
        const unsigned old = xb_add(&bar[XB_XSUB(b.x)], 1u);
        const unsigned gen = old / nloc;
        if (old + 1u == (gen + 1u) * nloc) {
            __builtin_amdgcn_fence(__ATOMIC_RELEASE, "agent");
            asm volatile("s_waitcnt vmcnt(0)" ::: "memory");
            const unsigned og = xb_add(&bar[XB_TOP], 1u);
            const unsigned tg = og / nx;
            if (og + 1u == (tg + 1u) * nx) xb_add(&bar[XB_TOPGEN], 1u);
            else XB_SPIN(xb_ld(&bar[XB_TOPGEN]) == tg, bar);
            __builtin_amdgcn_fence(__ATOMIC_ACQUIRE, "agent");
            xb_add(&bar[XB_XGEN(b.x)], 1u);
            asm volatile("s_waitcnt vmcnt(0)" ::: "memory");
        } else {
            XB_SPIN(xb_ld(&bar[XB_XGEN(b.x)]) == gen, bar);
            __builtin_amdgcn_fence(__ATOMIC_ACQUIRE, "agent");
            asm volatile("s_waitcnt vmcnt(0)" ::: "memory");
        }
    }
    __syncthreads();
}


__device__ __forceinline__ float dot2bf(unsigned a, unsigned b, float c) { asm("v_dot2c_f32_bf16 %0, %1, %2" : "+v"(c) : "v"(a), "v"(b)); return c; }
__device__ __forceinline__ float dot8bf_dpp(v4u a, v4u b) { float c = 0.f; asm("v_dot2c_f32_bf16 %0, %1, %5\n\tv_dot2c_f32_bf16 %0, %2, %6\n\tv_dot2c_f32_bf16 %0, %3, %7\n\tv_dot2c_f32_bf16 %0, %4, %8\n\ts_nop 1" : "+v"(c) : "v"(a.x), "v"(a.y), "v"(a.z), "v"(a.w), "v"(b.x), "v"(b.y), "v"(b.z), "v"(b.w)); return c; }
#define DPPF(v, ctrl) __int_as_float(__builtin_amdgcn_update_dpp(0, __float_as_int(v), (ctrl), 0xf, 0xf, true))
__device__ __forceinline__ float wave_sum(float v) {
#pragma unroll
    for (int o = 1; o < 64; o <<= 1) v += __shfl_xor(v, o);
    return v;
}
__device__ __forceinline__ float gelu_erf(float v) {
    const float av = fabsf(v), d = av * 0.2316418882f + 1.0f;
    const float t = __builtin_amdgcn_rcpf(d);
    float q = t * 0.5307027145f + (-0.7265760135f); q = q * t + 0.7107068705f; q = q * t + (-0.142248368f); q = q * t + 0.127414796f; q = q * t;
    const float e = __builtin_amdgcn_exp2f((v * v) * (-0.72134752044f));
    const float m = v * (q * e);
    return v < 0.f ? m : v - m;
}

struct Args { const float* in[15]; float* out; unsigned char* ws; };

__device__ __forceinline__ int w1_logical_col(int n0p) {
    const int pn = n0p >> 8, blk = (n0p & 255) >> 5, half = blk >> 2, a = blk & 3;
    if (pn <= 3) return pn * 256 + 64 * a + 32 * half;
    if (pn == 4) return (a < 2) ? (1024 + 64 * a + 32 * half) : (1152 + 64 * half + 32 * (a - 2));
    return n0p;
}
template <bool PERMW1> __device__ __forceinline__ void p0_transpose_item(const float* W, int K, int N, bf16* WT, LAS float* scr, int item, int lane) {
    const int nblk = N / 32, kb = item / nblk, nb = item % nblk, k0 = 64 * kb, n0 = 32 * nb; const int ns = PERMW1 ? w1_logical_col(n0) : n0;
#pragma unroll 8
    for (int i = 0; i < 32; ++i) { const int kk = 2 * i + (lane >> 5); scr[kk * 33 + (lane & 31)] = W[(size_t)(k0 + kk) * N + ns + (lane & 31)]; }
    LDS_WAIT(); asm volatile("" ::: "memory");
    const int c = lane & 7;
#pragma unroll
    for (int j = 0; j < 4; ++j) { const int n = (lane >> 3) + 8 * j; const LAS float* s = scr + (8 * c) * 33 + n;
        v4u o; o.x = pk2(s[0 * 33], s[1 * 33]); o.y = pk2(s[2 * 33], s[3 * 33]); o.z = pk2(s[4 * 33], s[5 * 33]); o.w = pk2(s[6 * 33], s[7 * 33]);
        *(GAS v4u*)(WT + (size_t)(n0 + n) * K + k0 + 8 * c) = o; }
    LDS_WAIT(); asm volatile("" ::: "memory");
}
__device__ __forceinline__ void ln_row_f32_to_bf16(const float* xrow, const float* g, const float* bta, bf16* orow, int lane) {
    const GAS f32x4* xr = (const GAS f32x4*)xrow + lane;
    f32x4 v[8]; float s = 0.f;
#pragma unroll
    for (int j = 0; j < 8; ++j) { v[j] = xr[64 * j]; s += (v[j].x + v[j].y) + (v[j].z + v[j].w); }
    const float mean = wave_sum(s) * (1.f / DM); float s2 = 0.f;
#pragma unroll
    for (int j = 0; j < 8; ++j) { v[j] = v[j] - mean; s2 += (v[j].x * v[j].x + v[j].y * v[j].y) + (v[j].z * v[j].z + v[j].w * v[j].w); }
    const float rstd = 1.f / sqrtf(wave_sum(s2) * (1.f / DM) + LN_EPS);
    GAS v2u* o8 = (GAS v2u*)orow + lane;
#pragma unroll
    for (int j = 0; j < 8; ++j) { const f32x4 gg = ((const GAS f32x4*)g)[lane + 64 * j], bb = ((const GAS f32x4*)bta)[lane + 64 * j];
        v2u o; o.x = pk2(v[j].x * rstd * gg.x + bb.x, v[j].y * rstd * gg.y + bb.y); o.y = pk2(v[j].z * rstd * gg.z + bb.z, v[j].w * rstd * gg.w + bb.w); o8[64 * j] = o; }
}
__device__ __forceinline__ void ln_row_bf16_to_bf16(const bf16* xrow, const float* g, const float* bta, bf16* orow, int lane) {
    const GAS v4u* xr = (const GAS v4u*)xrow + lane;
    float v[32]; float s = 0.f;
#pragma unroll
    for (int j = 0; j < 4; ++j) { const v4u w = xr[64 * j];
        v[8 * j + 0] = bflo(w.x); v[8 * j + 1] = bfhi(w.x); v[8 * j + 2] = bflo(w.y); v[8 * j + 3] = bfhi(w.y);
        v[8 * j + 4] = bflo(w.z); v[8 * j + 5] = bfhi(w.z); v[8 * j + 6] = bflo(w.w); v[8 * j + 7] = bfhi(w.w); }
#pragma unroll
    for (int i = 0; i < 32; ++i) s += v[i];
    const float mean = wave_sum(s) * (1.f / DM); float s2 = 0.f;
#pragma unroll
    for (int i = 0; i < 32; ++i) { v[i] -= mean; s2 += v[i] * v[i]; }
    const float rstd = 1.f / sqrtf(wave_sum(s2) * (1.f / DM) + LN_EPS);
    GAS v4u* o16 = (GAS v4u*)orow + lane;
#pragma unroll
    for (int j = 0; j < 4; ++j) {
        const GAS f32x4* gp = (const GAS f32x4*)g + 2 * (lane + 64 * j); const GAS f32x4* bp = (const GAS f32x4*)bta + 2 * (lane + 64 * j);
        const f32x4 g0 = gp[0], g1 = gp[1], b0 = bp[0], b1 = bp[1];
        v4u o; o.x = pk2(v[8 * j + 0] * rstd * g0.x + b0.x, v[8 * j + 1] * rstd * g0.y + b0.y); o.y = pk2(v[8 * j + 2] * rstd * g0.z + b0.z, v[8 * j + 3] * rstd * g0.w + b0.w);
        o.z = pk2(v[8 * j + 4] * rstd * g1.x + b1.x, v[8 * j + 5] * rstd * g1.y + b1.y); o.w = pk2(v[8 * j + 6] * rstd * g1.z + b1.z, v[8 * j + 7] * rstd * g1.w + b1.w);
        o16[64 * j] = o; }
}
__device__ __forceinline__ void row_pos(int r, int& pos, int& ipos) {
    if (r < NTOK) { const int s = r & (SEQ - 1); pos = NMETA + s; ipos = s & 127; }
    else { int j = r - NTOK; if (j > NMETA - 1) j = NMETA - 1; pos = j; ipos = 112 + j; }
}
__device__ __forceinline__ float log2_gamma(int h) { return log2f(1.0f - exp2f(-5.0f - (float)h)); }


typedef short bf16x8 __attribute__((ext_vector_type(8)));
typedef short s16x4 __attribute__((ext_vector_type(4)));
#define MFMA16(a, b, c) __builtin_amdgcn_mfma_f32_16x16x32_bf16((a), (b), (c), 0, 0, 0)
__device__ __forceinline__ s16x4 tr16(LAS const unsigned char* p) { return __builtin_bit_cast(s16x4, __builtin_amdgcn_ds_read_tr16_b64_v4i16((LAS s16x4*)p)); }
__device__ __forceinline__ bf16x8 cat8(s16x4 a, s16x4 b) { return __builtin_shufflevector(a, b, 0, 1, 2, 3, 4, 5, 6, 7); }
__device__ __forceinline__ unsigned cvtpk_s(float lo, float hi) { f32x2 v = {lo, hi}; bf16x2_t b = __builtin_convertvector(v, bf16x2_t); return __builtin_bit_cast(unsigned, b); }
__device__ __forceinline__ unsigned cvtpk(float lo, float hi) { unsigned r; asm("v_cvt_pk_bf16_f32 %0, %1, %2" : "=v"(r) : "v"(lo), "v"(hi)); return r; }

__device__ __forceinline__ void scan_unit(LAS unsigned char* L, int u, const bf16* RK, const bf16* RV, bf16* ST, int tid, int lane, int wave) {
    asm volatile("" : "+v"(tid)); lane = tid & 63;
    const int bh = u >> 4, di = (u >> 2) & 3, ei = u & 3, b = bh >> 2, h = bh & 3;
    const float g128 = exp2f(128.0f * log2_gamma(h));
    const int li = lane & 15, g = lane >> 4, q = li >> 2, p4 = li & 3;
    const int eb = wave >> 1, db0 = 2 * (wave & 1);
    f32x4 acc[2]; acc[0] = (f32x4){0.f, 0.f, 0.f, 0.f}; acc[1] = acc[0];
    v4u kreg[2], vreg[2];
#define SCAN_LOAD(cc) do { _Pragma("unroll") for (int i_ = 0; i_ < 2; ++i_) { const int cid_ = tid + 512 * i_, row_ = cid_ >> 3, c16_ = cid_ & 7; \
        int srow_; bool ok_ = true; if ((cc) < 0) { ok_ = row_ >= 112; srow_ = NTOK + (ok_ ? row_ - 112 : 0); } else srow_ = b * SEQ + (cc) * 128 + row_; \
        const v4u kz_ = *(const GAS v4u*)(RK + (size_t)srow_ * 1024 + h * 256 + di * 64 + c16_ * 8), vz_ = *(const GAS v4u*)(RV + (size_t)srow_ * 1024 + h * 256 + ei * 64 + c16_ * 8); \
        kreg[i_] = ok_ ? kz_ : (v4u){0u, 0u, 0u, 0u}; vreg[i_] = ok_ ? vz_ : (v4u){0u, 0u, 0u, 0u}; } } while (0)
#define SCAN_WRITE(bufp) do { _Pragma("unroll") for (int i_ = 0; i_ < 2; ++i_) { const int cid_ = tid + 512 * i_, row_ = cid_ >> 3, c16_ = cid_ & 7; \
        *(LAS v4u*)((bufp) + row_ * 128 + c16_ * 16) = kreg[i_]; *(LAS v4u*)((bufp) + 16384 + row_ * 128 + c16_ * 16) = vreg[i_]; } } while (0)
    SCAN_LOAD(-1); SCAN_WRITE(L); __syncthreads();
    int cur = 0;
    for (int cc = -1; cc <= 30; ++cc) {
        if (cc < 30) SCAN_LOAD(cc + 1);
        LAS const unsigned char* Kt = L + cur * 32768; LAS const unsigned char* Vt = Kt + 16384;
#pragma unroll
        for (int ks = 0; ks < 4; ++ks) {
            const int r0 = (32 * ks + 8 * g + q) * 128;
            const bf16x8 a = cat8(tr16(Vt + r0 + (16 * eb + 4 * p4) * 2), tr16(Vt + r0 + 512 + (16 * eb + 4 * p4) * 2));
#pragma unroll
            for (int n = 0; n < 2; ++n) {
                const bf16x8 bb = cat8(tr16(Kt + r0 + (16 * (db0 + n) + 4 * p4) * 2), tr16(Kt + r0 + 512 + (16 * (db0 + n) + 4 * p4) * 2));
                acc[n] = MFMA16(a, bb, acc[n]);
            }
        }
#pragma unroll
        for (int n = 0; n < 2; ++n) {
            acc[n] = acc[n] * g128;
            bf16* sp = ST + ((size_t)(bh * 32 + cc + 1) * 256 + (64 * ei + 16 * eb + 4 * g)) * 256 + 64 * di + 16 * (db0 + n) + li;
#pragma unroll
            for (int r = 0; r < 4; ++r) sp[(size_t)r * 256] = (bf16)f2bf(acc[n][r]);
        }
        if (cc < 30) SCAN_WRITE(L + (cur ^ 1) * 32768);
        __syncthreads(); cur ^= 1;
    }
#undef SCAN_LOAD
#undef SCAN_WRITE
}

__device__ __forceinline__ void retout_unit(LAS unsigned char* L, int u, bf16* QR, const bf16* RK, const bf16* RV, const bf16* RG, const bf16* ST, int tid, int lane, int wave) {
    asm volatile("" : "+v"(tid)); lane = tid & 63;
    const int bh = u >> 5, c = u & 31, b = bh >> 2, h = bh & 3;
    const int R0 = b * SEQ + c * 128;
    const int li = lane & 15, g = lane >> 4, q = li >> 2, p4 = li & 3;
    LAS unsigned char* RA = L; LAS unsigned char* RB = L + 65536;
#pragma unroll
    for (int i = 0; i < 8; ++i) { const int cid = tid + 512 * i, j = cid >> 5, ch = cid & 31;
        const v4u kz = *(const GAS v4u*)(RK + (size_t)(R0 + j) * 1024 + h * 256 + ch * 8), vz = *(const GAS v4u*)(RV + (size_t)(R0 + j) * 1024 + h * 256 + ch * 8);
        *(LAS v4u*)(RA + j * 512 + ((ch ^ (j & 15)) << 4)) = kz; *(LAS v4u*)(RB + j * 512 + ((ch ^ ((j & 7) << 1)) << 4)) = vz; }
    bf16x8 qf[8];
    { const GAS v4u* qp = (const GAS v4u*)(QR + (size_t)(R0 + 16 * wave + li) * 2048 + 1024 + h * 256 + 8 * g);
#pragma unroll
      for (int ks = 0; ks < 8; ++ks) qf[ks] = __builtin_bit_cast(bf16x8, qp[4 * ks]); }
    __syncthreads();
    f32x4 st[8];
#pragma unroll
    for (int jt = 0; jt < 8; ++jt) st[jt] = (f32x4){0.f, 0.f, 0.f, 0.f};
#pragma unroll
    for (int jt = 0; jt < 8; ++jt) if (jt <= wave) {
        const int j = 16 * jt + li;
#pragma unroll
        for (int ks = 0; ks < 8; ++ks) { const bf16x8 a = *(LAS const bf16x8*)(RA + j * 512 + (((4 * ks + g) ^ li) << 4)); st[jt] = MFMA16(a, qf[ks], st[jt]); }
        if (jt == wave) {
#pragma unroll
            for (int r = 0; r < 4; ++r) if (4 * g + r > li) st[jt][r] = 0.f; }
    }
    bf16x8 pf[4];
#pragma unroll
    for (int s = 0; s < 4; ++s) { v4u w; w.x = cvtpk_s(st[2 * s][0], st[2 * s][1]); w.y = cvtpk_s(st[2 * s][2], st[2 * s][3]); w.z = cvtpk_s(st[2 * s + 1][0], st[2 * s + 1][1]); w.w = cvtpk_s(st[2 * s + 1][2], st[2 * s + 1][3]); pf[s] = __builtin_bit_cast(bf16x8, w); }
    __syncthreads();
    const bf16* Sg = ST + (size_t)(bh * 32 + c) * 65536;
#define RO_STAGE_ST(dst, s0) do { _Pragma("unroll") for (int i_ = 0; i_ < 8; ++i_) { const int cid_ = tid + 512 * i_, sl_ = cid_ >> 11, e_ = (cid_ >> 3) & 255, ch_ = cid_ & 7; \
        const v4u z_ = *(const GAS v4u*)(Sg + (size_t)e_ * 256 + 64 * ((s0) + sl_) + ch_ * 8); *(LAS v4u*)((dst) + sl_ * 32768 + e_ * 128 + ((ch_ ^ (e_ & 7)) << 4)) = z_; } } while (0)
    RO_STAGE_ST(RA, 0);
    f32x4 o[16];
#pragma unroll
    for (int et = 0; et < 16; ++et) o[et] = (f32x4){0.f, 0.f, 0.f, 0.f};
#pragma unroll
    for (int s = 0; s < 4; ++s) if (2 * s <= wave) {
        const int r1 = 32 * s + 4 * g + q, r2 = r1 + 16;
#pragma unroll
        for (int et = 0; et < 16; ++et) {
            const int chn = 2 * et + (p4 >> 1);
            const bf16x8 a = cat8(tr16(RB + r1 * 512 + ((chn ^ ((r1 & 7) << 1)) << 4) + (p4 & 1) * 8), tr16(RB + r2 * 512 + ((chn ^ ((r2 & 7) << 1)) << 4) + (p4 & 1) * 8));
            o[et] = MFMA16(a, pf[s], o[et]);
        }
    }
    __syncthreads();
    RO_STAGE_ST(RB, 2);
#define RO_STATE_MMA(src, s0) do { _Pragma("unroll") for (int sl_ = 0; sl_ < 2; ++sl_) _Pragma("unroll") for (int k2_ = 0; k2_ < 2; ++k2_) _Pragma("unroll") for (int et = 0; et < 16; ++et) { \
        const int e_ = 16 * et + li; const bf16x8 a_ = *(LAS const bf16x8*)((src) + sl_ * 32768 + e_ * 128 + (((4 * k2_ + g) ^ (e_ & 7)) << 4)); \
        o[et] = MFMA16(a_, qf[2 * ((s0) + sl_) + k2_], o[et]); } } while (0)
    RO_STATE_MMA(RA, 0);
    __syncthreads();
    RO_STATE_MMA(RB, 2);
#undef RO_STAGE_ST
#undef RO_STATE_MMA
    float s1 = 0.f;
#pragma unroll
    for (int et = 0; et < 16; ++et) s1 += (o[et][0] + o[et][1]) + (o[et][2] + o[et][3]);
    s1 += __shfl_xor(s1, 16); s1 += __shfl_xor(s1, 32);
    const float mu = s1 * (1.0f / 256.0f); float s2 = 0.f;
#pragma unroll
    for (int et = 0; et < 16; ++et) { o[et] = o[et] - mu; s2 += (o[et][0] * o[et][0] + o[et][1] * o[et][1]) + (o[et][2] * o[et][2] + o[et][3] * o[et][3]); }
    s2 += __shfl_xor(s2, 16); s2 += __shfl_xor(s2, 32);
    const float rstd = 1.0f / sqrtf(s2 * (1.0f / 256.0f) + GN_EPS);
    const int row = R0 + 16 * wave + li;
    const GAS v2u* gp = (const GAS v2u*)(RG + (size_t)row * 1024 + h * 256 + 4 * g); GAS v2u* op = (GAS v2u*)(QR + (size_t)row * 2048 + 1024 + h * 256 + 4 * g);
#pragma unroll
    for (int et = 0; et < 16; ++et) { const v2u gz = gp[4 * et]; v2u w;
        w.x = cvtpk(o[et][0] * rstd * bflo(gz.x), o[et][1] * rstd * bfhi(gz.x)); w.y = cvtpk(o[et][2] * rstd * bflo(gz.y), o[et][3] * rstd * bfhi(gz.y)); op[4 * et] = w; }
    __syncthreads();
}

typedef float f32x16 __attribute__((ext_vector_type(16)));
#define MFMA32(a, b, c) __builtin_amdgcn_mfma_f32_32x32x16_bf16((a), (b), (c), 0, 0, 0)
__device__ __forceinline__ int crow32(int reg, int hh) { return (reg & 3) + 8 * (reg >> 2) + 4 * hh; }

__device__ __forceinline__ void attn_unit(LAS unsigned char* L, int u, bf16* QR, const bf16* KA, const bf16* VA, const float* sinks, int tid, int lane, int wave) {
    asm volatile("" : "+v"(tid)); lane = tid & 63;
    const int b = u >> 6, j = (u >> 1) & 31, g2 = u & 1, hq = 8 * g2 + wave;
    const int R0 = b * SEQ + 128 * j;
    LAS unsigned char* Kt = L; LAS unsigned char* Vt = L + 32768;
#pragma unroll
    for (int i = 0; i < 4; ++i) { const int cid = tid + 512 * i, kk = cid >> 3, ch = cid & 7;
        int srow; bool ok = true;
        if (kk >= 128) srow = R0 + kk - 128; else if (j > 0) srow = R0 - 128 + kk; else { ok = kk >= 112; srow = NTOK + (ok ? kk - 112 : 0); }
        const v4u kz = *(const GAS v4u*)(KA + (size_t)srow * 128 + g2 * 64 + ch * 8), vz = *(const GAS v4u*)(VA + (size_t)srow * 128 + g2 * 64 + ch * 8);
        *(LAS v4u*)(Kt + kk * 128 + ((ch ^ (kk & 7)) << 4)) = ok ? kz : (v4u){0u, 0u, 0u, 0u};
        *(LAS v4u*)(Vt + kk * 128 + (ch << 4)) = ok ? vz : (v4u){0u, 0u, 0u, 0u}; }
    __syncthreads();
    const int r = lane & 31, hh = lane >> 5, blk = (lane >> 4) & 1, q = (lane & 15) >> 2, p4 = lane & 3;
    const float sk = sinks[hq] * LOG2E;
#pragma unroll 1
    for (int t = 0; t < 4; ++t) {
        const int i0 = 32 * t;
        bf16x8 qf[4];
        { const GAS v4u* qp = (const GAS v4u*)(QR + (size_t)(R0 + i0 + r) * 2048 + hq * 64 + 8 * hh);
#pragma unroll
          for (int ks = 0; ks < 4; ++ks) qf[ks] = __builtin_bit_cast(bf16x8, qp[2 * ks]); }
        f32x16 s[5];
#pragma unroll
        for (int x = 0; x < 5; ++x) {
            const int krow_ = 32 * (t + x) + r;
            f32x16 acc;
#pragma unroll
            for (int e = 0; e < 16; ++e) acc[e] = 0.f;
#pragma unroll
            for (int ks = 0; ks < 4; ++ks) { const bf16x8 a = *(LAS const bf16x8*)(Kt + krow_ * 128 + (((2 * ks + hh) ^ (krow_ & 7)) << 4)); acc = MFMA32(a, qf[ks], acc); }
            s[x] = acc; __builtin_amdgcn_sched_barrier(0);
        }
        float m = sk;
#pragma unroll
        for (int e = 0; e < 16; ++e) { const int cr = crow32(e, hh);
            if (!(cr > r)) s[0][e] = -1.0e30f;
            if (!(cr <= r)) s[4][e] = -1.0e30f; }
        if (j == 0) {
#pragma unroll
            for (int x = 0; x < 4; ++x) if (t + x <= 3) {
#pragma unroll
                for (int e = 0; e < 16; ++e) if (32 * (t + x) + crow32(e, hh) < 112) s[x][e] = -1.0e30f; }
        }
#pragma unroll
        for (int x = 0; x < 5; ++x)
#pragma unroll
            for (int e = 0; e < 16; ++e) m = fmaxf(m, s[x][e]);
        m = fmaxf(m, __shfl_xor(m, 32));
        float l = 0.f;
#pragma unroll
        for (int x = 0; x < 5; ++x)
#pragma unroll
            for (int e = 0; e < 16; ++e) { const float pv = exp2f(s[x][e] - m); s[x][e] = pv; l += pv; }
        l += __shfl_xor(l, 32);
        l += exp2f(sk - m);
        f32x16 o[2];
#pragma unroll
        for (int e = 0; e < 16; ++e) { o[0][e] = 0.f; o[1][e] = 0.f; }
#pragma unroll
        for (int x = 0; x < 5; ++x)
#pragma unroll
            for (int st = 0; st < 2; ++st) {
                v4u w; w.x = cvtpk_s(s[x][8 * st + 0], s[x][8 * st + 1]); w.y = cvtpk_s(s[x][8 * st + 2], s[x][8 * st + 3]); w.z = cvtpk_s(s[x][8 * st + 4], s[x][8 * st + 5]); w.w = cvtpk_s(s[x][8 * st + 6], s[x][8 * st + 7]);
                const bf16x8 pb = __builtin_bit_cast(bf16x8, w);
                const int k1 = 32 * (t + x) + 16 * st + 4 * hh + q, k2 = k1 + 8;
#pragma unroll
                for (int dc = 0; dc < 2; ++dc) {
                    const int cb = ((4 * dc + 2 * blk + (p4 >> 1)) << 4) + 8 * (p4 & 1);
                    const bf16x8 a = cat8(tr16(Vt + k1 * 128 + cb), tr16(Vt + k2 * 128 + cb));
                    o[dc] = MFMA32(a, pb, o[dc]);
                }
                __builtin_amdgcn_sched_barrier(0);
            }
        const float il = 1.0f / l;
        GAS v2u* op = (GAS v2u*)(QR + (size_t)(R0 + i0 + r) * 2048 + hq * 64 + 4 * hh);
#pragma unroll
        for (int dc = 0; dc < 2; ++dc)
#pragma unroll
            for (int g4 = 0; g4 < 4; ++g4) { v2u w; w.x = cvtpk_s(o[dc][4 * g4 + 0] * il, o[dc][4 * g4 + 1] * il); w.y = cvtpk_s(o[dc][4 * g4 + 2] * il, o[dc][4 * g4 + 3] * il); op[8 * dc + 2 * g4] = w; }
    }
    __syncthreads();
}

__device__ __forceinline__ unsigned ord_key(float f) { const unsigned u = __float_as_uint(f); return u ^ ((unsigned)((int)u >> 31) | 0x80000000u); }
__device__ __forceinline__ float ord_val(unsigned k) { return __uint_as_float(k ^ (((int)k < 0) ? 0x80000000u : 0xffffffffu)); }
#define TK_INS(arr, val) do { unsigned v_ = (val); _Pragma("unroll") for (int j_ = 0; j_ < 16; ++j_) { const unsigned hi_ = arr[j_] > v_ ? arr[j_] : v_; v_ = arr[j_] > v_ ? v_ : arr[j_]; arr[j_] = hi_; } } while (0)
__device__ __forceinline__ void topk_unit(LAS unsigned* Lw, int tt, int hd, const bf16* Q3, const bf16* SKB, unsigned short* IDS, float* GATES, int lane) {
    asm volatile("" : "+v"(lane));
    const int r = lane & 31, hh = lane >> 5, t0 = tt * 32;
    float sv[2][16];
#pragma unroll
    for (int p = 0; p < 2; ++p) {
        f32x16 acc[4];
#pragma unroll
        for (int nt = 0; nt < 4; ++nt)
#pragma unroll
            for (int e = 0; e < 16; ++e) acc[nt][e] = 0.f;
        const GAS v4u* qp = (const GAS v4u*)(Q3 + (size_t)(t0 + r) * DM + hd * 256 + p * 128 + 8 * hh);
        const GAS v4u* kp = (const GAS v4u*)(SKB + ((size_t)((hd * 2 + p) * 128 + r)) * 128 + 8 * hh);
#pragma unroll 2
        for (int ks = 0; ks < 8; ++ks) { const bf16x8 bq = __builtin_bit_cast(bf16x8, qp[2 * ks]);
#pragma unroll
            for (int nt = 0; nt < 4; ++nt) { const bf16x8 a = __builtin_bit_cast(bf16x8, kp[nt * 32 * 16 + 2 * ks]); acc[nt] = MFMA32(a, bq, acc[nt]); } }
        unsigned tk[16];
#pragma unroll
        for (int j2 = 0; j2 < 16; ++j2) tk[j2] = 0u;
#pragma unroll
        for (int nt = 0; nt < 4; ++nt)
#pragma unroll
            for (int e = 0; e < 16; ++e) { const int n = 32 * nt + crow32(e, hh); TK_INS(tk, (ord_key(acc[nt][e]) & 0xffffff80u) | (unsigned)(127 - n)); }
        unsigned pk[16];
#pragma unroll
        for (int j2 = 0; j2 < 16; ++j2) pk[j2] = (unsigned)__shfl_xor((int)tk[j2], 32);
#pragma unroll
        for (int j2 = 0; j2 < 16; ++j2) TK_INS(tk, pk[j2]);
#pragma unroll
        for (int j2 = 0; j2 < 16; ++j2) { sv[p][j2] = ord_val(tk[j2] & 0xffffff80u); Lw[(p * 16 + j2) * 64 + lane] = 127u - (tk[j2] & 0x7fu); }
    }
    unsigned fk[16];
#pragma unroll
    for (int j2 = 0; j2 < 16; ++j2) fk[j2] = 0u;
#pragma unroll
    for (int i = 0; i < 16; ++i)
#pragma unroll
        for (int j2 = 0; j2 < 16; ++j2) if ((i + 1) * (j2 + 1) <= 16) TK_INS(fk, (ord_key(sv[0][i] + sv[1][j2]) & 0xffffff00u) | (unsigned)(255 - (16 * i + j2)));
    float ev[16]; int idv[16]; float den = 0.f; const float f0 = ord_val(fk[0] & 0xffffff00u);
    LDS_WAIT();
#pragma unroll
    for (int k = 0; k < 16; ++k) { const unsigned idx = 255u - (fk[k] & 0xffu); const unsigned i1 = Lw[(idx >> 4) * 64 + lane], i2 = Lw[(16 + (idx & 15u)) * 64 + lane];
        idv[k] = (int)(i1 * 128u + i2); ev[k] = __expf(ord_val(fk[k] & 0xffffff00u) - f0); den += ev[k]; }
    const float iden = 1.0f / den;
    if (hh == 0) {
        GAS v4u* ip = (GAS v4u*)(IDS + (size_t)(t0 + r) * 128 + hd * 16); GAS f32x4* gp = (GAS f32x4*)(GATES + (size_t)(t0 + r) * 128 + hd * 16);
#pragma unroll
        for (int k8 = 0; k8 < 2; ++k8) ip[k8] = (v4u){(unsigned)idv[8 * k8] | ((unsigned)idv[8 * k8 + 1] << 16), (unsigned)idv[8 * k8 + 2] | ((unsigned)idv[8 * k8 + 3] << 16), (unsigned)idv[8 * k8 + 4] | ((unsigned)idv[8 * k8 + 5] << 16), (unsigned)idv[8 * k8 + 6] | ((unsigned)idv[8 * k8 + 7] << 16)};
#pragma unroll
        for (int k4 = 0; k4 < 4; ++k4) gp[k4] = (f32x4){ev[4 * k4] * iden, ev[4 * k4 + 1] * iden, ev[4 * k4 + 2] * iden, ev[4 * k4 + 3] * iden};
    }
    LDS_WAIT();
}

__global__ void __launch_bounds__(NWAVES * 64, 2) mk_fwd(Args args) {
    extern __shared__ __attribute__((aligned(16))) unsigned char lds[];
    LAS unsigned char* L = (LAS unsigned char*)lds;
    volatile LAS unsigned* MISC = (volatile LAS unsigned*)(L + MISC_OFF);
    const int tid = threadIdx.x, lane = tid & 63, wave = __builtin_amdgcn_readfirstlane(tid >> 6);
    const int G = gridDim.x, bx = blockIdx.x;
    const int vcu = (G % 8 == 0) ? (bx % 8) * (G / 8) + bx / 8 : bx;
    unsigned char* ws = args.ws;
    gu32* ctl = (gu32*)(ws + WS_CTL);
    const float* x = args.in[0]; const float* meta = args.in[1]; const float* ln_in_g = args.in[2]; const float* ln_in_b = args.in[3];
    const float* w_in = args.in[4]; const float* sinks = args.in[5]; const float* w_out = args.in[6]; const float* ln_mix_g = args.in[7]; const float* ln_mix_b = args.in[8];
    const float* wq = args.in[9]; const float* subkeys = args.in[10]; const float* u_tab = args.in[11]; const float* v_tab = args.in[12];
    const float* ln_ffn_g = args.in[13]; const float* ln_ffn_b = args.in[14];
    float* out = args.out;
    bf16* W1T = (bf16*)(ws + WS_W1T); bf16* W2T = (bf16*)(ws + WS_W2T); bf16* W3T = (bf16*)(ws + WS_W3T);
    bf16* H0 = (bf16*)(ws + WS_H0); bf16* QR = (bf16*)(ws + WS_QR); bf16* KA = (bf16*)(ws + WS_KA); bf16* VA = (bf16*)(ws + WS_VA);
    bf16* RK = (bf16*)(ws + WS_RK); bf16* RV = (bf16*)(ws + WS_RV); bf16* RG = (bf16*)(ws + WS_RG);
    bf16* Y = (bf16*)(ws + WS_Y); bf16* H1 = (bf16*)(ws + WS_H1); bf16* Q3 = (bf16*)(ws + WS_QR);
    bf16* STB = (bf16*)(ws + WS_ST);
    f32x2* ROPE_R = (f32x2*)(ws + WS_ROPE_R); f32x2* ROPE_A = (f32x2*)(ws + WS_ROPE_A);
    unsigned short* IDS = (unsigned short*)(ws + WS_IDS); float* GATES = (float*)(ws + WS_GATES);
    bf16* SKB = (bf16*)(ws + WS_SK);
    bf16* UT = (bf16*)(ws + WS_UT); bf16* VT = (bf16*)(ws + WS_VT);

    for (int u = tid; u < (LDS_BYTES - LDSCTL_OFF) / 4; u += NWAVES * 64) ((LAS unsigned*)(L + LDSCTL_OFF))[u] = 0u;
    __syncthreads();
    XcdBarrier bar; bar.bar = (unsigned*)(ctl + CW_BAR); bar.x = xb_xcc_id(); bar.st = MISC + 8;
    if (tid == 0) MISC[10] = xb_add(&bar.bar[XB_XCNT(bar.x)], 1u);
#define GRID_BAR() xcd_barrier(bar)
    const int gw = vcu * NWAVES + wave, NGW = G * NWAVES;
    const int gt = gw * 64 + lane, NGT = NGW * 64;

    {
        LAS float* scr = (LAS float*)(L + RING_OFF + wave * 16384);
        constexpr int I_1 = (DM / 64) * (IN_COLS / 32), I_2 = (DM / 64) * (DM / 32), I_3 = I_2;
        for (int it = gw; it < I_1 + I_2 + I_3; it += NGW) {
            int r = it;
            if (r < I_1) { p0_transpose_item<true>(w_in, DM, IN_COLS, W1T, scr, r, lane); continue; } r -= I_1;
            if (r < I_2) { p0_transpose_item<false>(w_out, DM, DM, W2T, scr, r, lane); continue; } r -= I_2;
            p0_transpose_item<false>(wq, DM, DM, W3T, scr, r, lane);
        }
        for (int m = gw; m < MROWS; m += NGW) {
            if (m < NTOK) ln_row_f32_to_bf16(x + (size_t)m * DM, ln_in_g, ln_in_b, H0 + (size_t)m * DM, lane);
            else if (m < NVALID) ln_row_f32_to_bf16(meta + (size_t)(m - NTOK) * DM, ln_in_g, ln_in_b, H0 + (size_t)m * DM, lane);
            else { GAS v4u* o = (GAS v4u*)(H0 + (size_t)m * DM) + lane;
#pragma unroll
                for (int j = 0; j < 4; ++j) o[64 * j] = (v4u){0u, 0u, 0u, 0u}; }
        }
        for (int e = gt; e < 2 * (16384 * DM / 16); e += NGT) {
            const int which = e >= (16384 * DM / 16); const int i16 = which ? e - (16384 * DM / 16) : e; const int row = i16 >> 7, c = i16 & 127;
            const float sc = which ? V_SCALE : U_SCALE;
            const GAS f32x4* src = (const GAS f32x4*)(which ? v_tab : u_tab) + 4 * (size_t)i16; v4u o;
#pragma unroll
            for (int q4 = 0; q4 < 4; ++q4) { const f32x4 a = src[q4]; int w = __builtin_amdgcn_cvt_pk_fp8_f32(a.x * sc, a.y * sc, 0, false); w = __builtin_amdgcn_cvt_pk_fp8_f32(a.z * sc, a.w * sc, w, true); o[q4] = (unsigned)w; }
            ((GAS v4u*)(which ? (void*)VT : (void*)UT))[((size_t)(c >> 3) * 16384 + row) * 8 + (c & 7)] = o; }
        for (int e = gt; e < 16 * 128 * 128 / 8; e += NGT) { const GAS f32x4* src = (const GAS f32x4*)subkeys + 2 * (size_t)e; const f32x4 a = src[0], b2 = src[1];
            v4u o; o.x = pk2(a.x, a.y); o.y = pk2(a.z, a.w); o.z = pk2(b2.x, b2.y); o.w = pk2(b2.z, b2.w); ((GAS v4u*)SKB)[e] = o; }
        for (int e = gt; e < 4112 * 128; e += NGT) { const int pos = e >> 7, i = e & 127; const float inv = powf(10000.0f, -(float)(2 * i) / 256.0f); float sn, cs; sincosf((float)pos * inv, &sn, &cs); ROPE_R[e] = (f32x2){cs, sn}; }
        for (int e = gt; e < 4112 * 32; e += NGT) { const int pos = e >> 5, i = e & 31; const float inv = powf(10000.0f, -(float)(2 * i) / 64.0f); float sn, cs; sincosf((float)pos * inv, &sn, &cs); ROPE_A[e] = (f32x2){cs, sn}; }
    }
    GRID_BAR();

    {
        pg8::Gemm g{H0, W1T, MROWS, IN_COLS, DM}; pg8::StaticOrder S; S.init(MROWS, IN_COLS, G, bx);
        pg8::EpiProj E{QR, KA, VA, RK, RV, RG, (const float*)ROPE_R, (const float*)ROPE_A, QSCALE};
        pg8::gemm_phase<pg8::EpiProj, pg8::StaticOrder, true, true>(L + RING_OFF, g, S, E);
    }
    GRID_BAR();

    for (int u = bx; u < 256; u += G) attn_unit(L + RING_OFF, u, QR, KA, VA, sinks, tid, lane, wave);

    for (int u = bx; u < 256; u += G) scan_unit(L + RING_OFF, u, RK, RV, STB, tid, lane, wave);
    GRID_BAR();

    for (int u = bx; u < 512; u += G) retout_unit(L + RING_OFF, u, QR, RK, RV, RG, STB, tid, lane, wave);
    GRID_BAR();

    {
        pg8::Gemm g{QR, W2T, NTOK, DM, DM}; pg8::StaticOrder S; S.init(NTOK, DM, G, bx);
        pg8::EpiGen<1> E{Y, DM, H0, ALPHA, nullptr, nullptr, nullptr, nullptr, nullptr, nullptr};
        pg8::gemm_phase<pg8::EpiGen<1>, pg8::StaticOrder, true, true>(L + RING_OFF, g, S, E);
    }
    GRID_BAR();

    for (int m = gw; m < NTOK; m += NGW) ln_row_bf16_to_bf16(Y + (size_t)m * DM, ln_mix_g, ln_mix_b, H1 + (size_t)m * DM, lane);
    GRID_BAR();

    {
        pg8::Gemm g{H1, W3T, NTOK, DM, DM}; pg8::StaticOrder S; S.init(NTOK, DM, G, bx);
        pg8::EpiGen<2> E{Q3, DM, nullptr, 0.f, nullptr, nullptr, nullptr, nullptr, nullptr, nullptr};
        pg8::gemm_phase<pg8::EpiGen<2>, pg8::StaticOrder, true, true>(L + RING_OFF, g, S, E);
    }
    GRID_BAR();

    for (int un = gw; un < (NTOK / 32) * 8; un += NGW) topk_unit((LAS unsigned*)(L + RING_OFF + wave * 8192), un >> 3, un & 7, Q3, SKB, IDS, GATES, lane);
    GRID_BAR();

    int nx = 0, xr = 0, nloc = 1;
    { unsigned* bw = (unsigned*)(ctl + CW_BAR);
#pragma unroll
      for (unsigned j2 = 0; j2 < 16; ++j2) { const unsigned cnt = xb_ld(&bw[XB_XCNT(j2)]); nx += cnt > 0u; xr += (j2 < bar.x && cnt > 0u); if (j2 == bar.x) nloc = (int)cnt; }
      nx = __builtin_amdgcn_readfirstlane(nx); xr = __builtin_amdgcn_readfirstlane(xr); nloc = __builtin_amdgcn_readfirstlane(nloc); if (nx < 1) nx = 1; if (nloc < 1) nloc = 1; }
    const int lrank = __builtin_amdgcn_readfirstlane((int)MISC[10]);
    const int wv = lrank * NWAVES + wave, nwv = nloc * NWAVES;
    float* DOTX = (float*)(ws + WS_RK);
    bf16* CB = (bf16*)(ws + WS_KA);
    float* Y32 = (float*)(ws + WS_H0);
    {
        int tl = tid; asm volatile("" : "+v"(tl)); const int ln = tl & 63, k = ln >> 3, c8 = ln & 7;
        const unsigned char* UT8 = (const unsigned char*)UT;
        for (int s = xr; s < NSL; s += nx) {
            const unsigned char* Us = UT8 + (size_t)s * 16384 * 128;
            const bool first = (s == xr);
            v4u nid[2][2];
#pragma unroll
            for (int z = 0; z < 2; ++z) { const int tz = wv + z * nwv; const int tc = tz < NTOK ? tz : wv; const GAS v4u* ip = (const GAS v4u*)(IDS + (size_t)tc * 128 + 16 * k);
#pragma unroll
                for (int i = 0; i < 2; ++i) nid[z][i] = ip[i]; }
#pragma unroll 1
            for (int t = wv; t < NTOK; t += 2 * nwv) {
                const bool vB = (t + nwv) < NTOK; const int tt[2] = {t, vB ? t + nwv : t};
                v4u ub[2][16]; v4u hs[2][2]; f32x2 old[2];
#pragma unroll
                for (int z = 0; z < 2; ++z) {
#pragma unroll
                    for (int i = 0; i < 16; ++i) { const int pe = 2 * (i & 7) + (i >> 3); const unsigned eid = (nid[z][pe >> 3][(pe >> 1) & 3] >> (16 * (pe & 1))) & 0xffffu; ub[z][i] = *(const GAS v4u*)(Us + (size_t)eid * 128 + 16 * c8); }
                    { const GAS v4u* hp = (const GAS v4u*)(H1 + (size_t)tt[z] * DM + 128 * s + 16 * c8); hs[z][0] = hp[0]; hs[z][1] = hp[1]; } }
#pragma unroll
                for (int z = 0; z < 2; ++z) old[z] = first ? (f32x2){0.f, 0.f} : *(const GAS f32x2*)(DOTX + ((size_t)xr * NTOK + tt[z]) * 128 + 2 * ln);
#pragma unroll
                for (int z = 0; z < 2; ++z) { const int tz = t + (2 + z) * nwv; const int tc = tz < NTOK ? tz : t; const GAS v4u* ip = (const GAS v4u*)(IDS + (size_t)tc * 128 + 16 * k);
#pragma unroll
                    for (int i = 0; i < 2; ++i) nid[z][i] = ip[i]; }
#pragma unroll
                for (int z = 0; z < 2; ++z) {
                    float p[16]; f32x2 hp2[8];
#pragma unroll
                    for (int i = 0; i < 2; ++i)
#pragma unroll
                        for (int c4 = 0; c4 < 4; ++c4) hp2[4 * i + c4] = (f32x2){bflo(hs[z][i][c4]), bfhi(hs[z][i][c4])};
#pragma unroll
                    for (int i = 0; i < 16; ++i) { f32x2 d2 = {0.f, 0.f};
#pragma unroll
                        for (int dw = 0; dw < 4; ++dw) { const f32x2 fl = __builtin_amdgcn_cvt_pk_f32_fp8((int)ub[z][i][dw], false), fh = __builtin_amdgcn_cvt_pk_f32_fp8((int)ub[z][i][dw], true);
                            d2 = __builtin_elementwise_fma(fl, hp2[2 * dw], d2); d2 = __builtin_elementwise_fma(fh, hp2[2 * dw + 1], d2); }
                        p[i] = d2.x + d2.y; }
                    const bool b0 = (c8 & 1) != 0, b1 = (c8 & 2) != 0, b2 = (c8 & 4) != 0;
                    float r1[8], r2[4], q0, q1;
#pragma unroll
                    for (int m = 0; m < 8; ++m) { const float keep = b0 ? p[2 * m + 1] : p[2 * m], give = b0 ? p[2 * m] : p[2 * m + 1]; r1[m] = keep + DPPF(give, 0xB1); }
#pragma unroll
                    for (int m = 0; m < 4; ++m) { const float keep = b1 ? r1[2 * m + 1] : r1[2 * m], give = b1 ? r1[2 * m] : r1[2 * m + 1]; r2[m] = keep + DPPF(give, 0x4E); }
                    { const float keep = b2 ? r2[1] : r2[0], give = b2 ? r2[0] : r2[1]; const float gl = DPPF(give, 0x104), gr = DPPF(give, 0x114); q0 = keep + (b2 ? gr : gl); }
                    { const float keep = b2 ? r2[3] : r2[2], give = b2 ? r2[2] : r2[3]; const float gl = DPPF(give, 0x104), gr = DPPF(give, 0x114); q1 = keep + (b2 ? gr : gl); }
                    if (z == 0 || vB) *(GAS f32x2*)(DOTX + ((size_t)xr * NTOK + tt[z]) * 128 + 2 * ln) = (f32x2){q0 + old[z].x, q1 + old[z].y};
                }
            }
        }
    }
    GRID_BAR();
    for (int idx = gt; idx < NTOK * 128; idx += NGT) { float d = 0.f; for (int xx = 0; xx < nx; ++xx) d += DOTX[(size_t)xx * NTOK * 128 + idx]; CB[idx] = (bf16)f2bf((1.0f / V_SCALE) * GATES[idx] * gelu_erf(d * (1.0f / U_SCALE))); }
    GRID_BAR();
    {
        int tl = tid; asm volatile("" : "+v"(tl)); const int ln = tl & 63, k = ln >> 3, c8 = ln & 7;
        const unsigned char* VT8 = (const unsigned char*)VT;
        for (int s = xr; s < NSL; s += nx) {
            const unsigned char* Vs = VT8 + (size_t)s * 16384 * 128;
            v4u nid[2][2];
#pragma unroll
            for (int z = 0; z < 2; ++z) { const int tz = wv + z * nwv; const int tc = tz < NTOK ? tz : wv; const GAS v4u* ip = (const GAS v4u*)(IDS + (size_t)tc * 128 + 16 * k);
#pragma unroll
                for (int i = 0; i < 2; ++i) nid[z][i] = ip[i]; }
#pragma unroll 1
            for (int t = wv; t < NTOK; t += 2 * nwv) {
                const bool vB = (t + nwv) < NTOK; const int tt[2] = {t, vB ? t + nwv : t};
                v4u vb[2][16]; v4u cf[2][2]; unsigned hs[2];
#pragma unroll
                for (int z = 0; z < 2; ++z) {
#pragma unroll
                    for (int i = 0; i < 16; ++i) { const unsigned eid = (nid[z][i >> 3][(i >> 1) & 3] >> (16 * (i & 1))) & 0xffffu; vb[z][i] = *(const GAS v4u*)(Vs + (size_t)eid * 128 + 16 * c8); } }
#pragma unroll
                for (int z = 0; z < 2; ++z) { hs[z] = *(const GAS unsigned*)(H1 + (size_t)tt[z] * DM + 128 * s + 16 * c8 + 2 * k);
                    const GAS v4u* cp = (const GAS v4u*)(CB + (size_t)tt[z] * 128 + 16 * k); cf[z][0] = cp[0]; cf[z][1] = cp[1]; }
#pragma unroll
                for (int z = 0; z < 2; ++z) { const int tz = t + (2 + z) * nwv; const int tc = tz < NTOK ? tz : t; const GAS v4u* ip = (const GAS v4u*)(IDS + (size_t)tc * 128 + 16 * k);
#pragma unroll
                    for (int i = 0; i < 2; ++i) nid[z][i] = ip[i]; }
#pragma unroll
                for (int z = 0; z < 2; ++z) {
                    f32x2 accp[8];
#pragma unroll
                    for (int q2 = 0; q2 < 8; ++q2) accp[q2] = (f32x2){0.f, 0.f};
#pragma unroll
                    for (int i = 0; i < 16; ++i) { const unsigned cw = cf[z][i >> 3][(i >> 1) & 3]; const float c = (i & 1) ? bfhi(cw) : bflo(cw); const f32x2 c2 = {c, c};
#pragma unroll
                        for (int dw = 0; dw < 4; ++dw) { const f32x2 fl = __builtin_amdgcn_cvt_pk_f32_fp8((int)vb[z][i][dw], false), fh = __builtin_amdgcn_cvt_pk_f32_fp8((int)vb[z][i][dw], true);
                            accp[2 * dw] = __builtin_elementwise_fma(fl, c2, accp[2 * dw]); accp[2 * dw + 1] = __builtin_elementwise_fma(fh, c2, accp[2 * dw + 1]); } }
                    const bool kb0 = (k & 1) != 0, kb1 = (k & 2) != 0, kb2 = (k & 4) != 0;
                    f32x2 rA[4], rB[2], rC;
#pragma unroll
                    for (int m = 0; m < 4; ++m) { const f32x2 keep = kb0 ? accp[2 * m + 1] : accp[2 * m], give = kb0 ? accp[2 * m] : accp[2 * m + 1];
                        rA[m] = keep + (f32x2){DPPF(give.x, 0x128), DPPF(give.y, 0x128)}; }
#pragma unroll
                    for (int m = 0; m < 2; ++m) { const f32x2 keep = kb1 ? rA[2 * m + 1] : rA[2 * m], give = kb1 ? rA[2 * m] : rA[2 * m + 1];
                        const auto sx = __builtin_amdgcn_permlane16_swap(__float_as_uint(give.x), __float_as_uint(give.x), false, false), sy = __builtin_amdgcn_permlane16_swap(__float_as_uint(give.y), __float_as_uint(give.y), false, false);
                        rB[m] = keep + (f32x2){__uint_as_float(kb1 ? sx[0] : sx[1]), __uint_as_float(kb1 ? sy[0] : sy[1])}; }
                    { const f32x2 keep = kb2 ? rB[1] : rB[0], give = kb2 ? rB[0] : rB[1];
                        const auto sx = __builtin_amdgcn_permlane32_swap(__float_as_uint(give.x), __float_as_uint(give.x), false, false), sy = __builtin_amdgcn_permlane32_swap(__float_as_uint(give.y), __float_as_uint(give.y), false, false);
                        rC = keep + (f32x2){__uint_as_float(kb2 ? sx[0] : sx[1]), __uint_as_float(kb2 ? sy[0] : sy[1])}; }
                    if (z == 0 || vB) *(GAS f32x2*)(Y32 + (size_t)tt[z] * DM + 128 * s + 16 * c8 + 2 * k) = (f32x2){rC.x + ALPHA * bflo(hs[z]), rC.y + ALPHA * bfhi(hs[z])};
                }
            }
        }
    }
    GRID_BAR();
    for (int m = gw; m < NTOK; m += NGW) {
        const GAS f32x4* xr4 = (const GAS f32x4*)(Y32 + (size_t)m * DM) + lane;
        f32x4 v[8]; float sm = 0.f;
#pragma unroll
        for (int j2 = 0; j2 < 8; ++j2) { v[j2] = xr4[64 * j2]; sm += (v[j2].x + v[j2].y) + (v[j2].z + v[j2].w); }
        const float mean = wave_sum(sm) * (1.f / DM); float s2 = 0.f;
#pragma unroll
        for (int j2 = 0; j2 < 8; ++j2) { v[j2] = v[j2] - mean; s2 += (v[j2].x * v[j2].x + v[j2].y * v[j2].y) + (v[j2].z * v[j2].z + v[j2].w * v[j2].w); }
        const float rstd = 1.f / sqrtf(wave_sum(s2) * (1.f / DM) + LN_EPS);
        GAS f32x4* op = (GAS f32x4*)(out + (size_t)m * DM) + lane;
#pragma unroll
        for (int j2 = 0; j2 < 8; ++j2) { const f32x4 gg = ((const GAS f32x4*)ln_ffn_g)[lane + 64 * j2], bb = ((const GAS f32x4*)ln_ffn_b)[lane + 64 * j2];
            op[64 * j2] = (f32x4){v[j2].x * rstd * gg.x + bb.x, v[j2].y * rstd * gg.y + bb.y, v[j2].z * rstd * gg.z + bb.z, v[j2].w * rstd * gg.w + bb.w}; }
    }
}

extern "C" void kernel_launch(void* const* d_in, const int* in_sizes, int n_in, void* d_out, int out_size, void* d_ws, size_t ws_size, hipStream_t stream) {
    static int grid = 0;
    if (grid == 0) {
        if (n_in != 15 || out_size != NTOK * DM || ws_size < WS_END) { fprintf(stderr, "kernel_launch: unexpected shapes (n_in %d out %d ws %zu)\n", n_in, out_size, ws_size); grid = -1; return; }
        int dev = 0, cus = 0, per_cu = 0;
        if (hipGetDevice(&dev) != hipSuccess || hipDeviceGetAttribute(&cus, hipDeviceAttributeMultiprocessorCount, dev) != hipSuccess) { grid = -1; return; }
        if (hipFuncSetAttribute((const void*)mk_fwd, hipFuncAttributeMaxDynamicSharedMemorySize, LDS_BYTES) != hipSuccess) { fprintf(stderr, "kernel_launch: hipFuncSetAttribute failed\n"); grid = -1; return; }
        if (hipOccupancyMaxActiveBlocksPerMultiprocessor(&per_cu, (const void*)mk_fwd, NWAVES * 64, LDS_BYTES) != hipSuccess || per_cu < 1) { fprintf(stderr, "kernel_launch: occupancy query says %d\n", per_cu); }
        (void)hipGetLastError();
        grid = cus;
    }
    if (grid < 0) return;
    if (hipMemsetAsync((char*)d_ws + WS_CTL, 0, CTL_ZERO_BYTES, stream) != hipSuccess) return;
    Args a{};
    for (int i = 0; i < 15; ++i) a.in[i] = (const float*)d_in[i];
    a.out = (float*)d_out; a.ws = (unsigned char*)d_ws;
    hipLaunchKernelGGL(mk_fwd, dim3(grid), dim3(NWAVES * 64), LDS_BYTES, stream, a);
}
```

```cpp
#include <hip/hip_runtime.h>
#include <cstdio>
#include <cstdint>
#include <cmath>
namespace pg8 {
#define PG8_LAS __attribute__((address_space(3)))
typedef unsigned short bf16_t;
typedef short bf16x8 __attribute__((ext_vector_type(8)));
typedef float f32x4 __attribute__((ext_vector_type(4)));
typedef unsigned u32x4 __attribute__((ext_vector_type(4)));
constexpr int BM = 256, BK = 64, HALF = 128, HTB = HALF * BK * 2  , STAGE_BYTES = 8 * HTB, NXCD = 8, WGM = 8;

__host__ __device__ __forceinline__ int lds_byte(int r, int c) { const int st = (r >> 4) * 2 + (c >> 5), rr = r & 15, cc = c & 31, ob = rr * 64 + cc * 2; return st * 1024 + (ob ^ (((ob >> 9) & 1) << 5)); }
__host__ __device__ __forceinline__ void stage_rc(int b, int& R, int& C) { const int st = b / 1024, sb = b % 1024, swz = sb ^ (((sb >> 9) & 1) << 5); R = (st >> 1) * 16 + swz / 64; C = (st & 1) * 32 + (swz % 64) / 2; }
__host__ __device__ __forceinline__ int perm32(int rho) { const int n = rho >> 4, i = rho & 15; return 8 * (i >> 2) + 4 * n + (i & 3); }

struct Unit { int pm, pn; };
struct Gemm { const bf16_t* A; const bf16_t* Bt; int M, N, K; };

struct StaticOrder {
    int nM, nN, nwg, G, c;
    __host__ __device__ void init(int M, int N, int G_, int c_) { nM = M / BM; nN = N / BM; nwg = nM * nN; G = G_; c = c_; }
    __host__ __device__ bool next(int i, Unit& u) const {
        const long L = (long)i * G + c; if (L >= nwg) return false;
        int wgid = (int)L; { const int q = nwg / NXCD, r = nwg % NXCD, xcd = wgid % NXCD, off = wgid / NXCD; wgid = (xcd < r ? xcd * (q + 1) : r * (q + 1) + (xcd - r) * q) + off; }
        const int nig = WGM * nN, gid = wgid / nig, fm = gid * WGM, gsz = (nM - fm) < WGM ? (nM - fm) : WGM;
        u.pm = fm + ((wgid % nig) % gsz); u.pn = (wgid % nig) / gsz; return true;
    }
    __device__ __forceinline__ void a_ready(const Unit&) const {}
    __device__ __forceinline__ void done(const Unit&) const {}
};

__device__ __forceinline__ unsigned cvt_pk_bf16(float lo, float hi) { unsigned r; asm volatile("v_cvt_pk_bf16_f32 %0, %1, %2" : "=v"(r) : "v"(lo), "v"(hi)); return r; }
typedef float f32x2 __attribute__((ext_vector_type(2)));

template <int MODE> struct EpiGen {
    static constexpr bool PERM = true, AFTER_DRAIN = false;
    bf16_t* O; int ldc; const bf16_t* R; float alpha;
    bf16_t *QR, *KA, *VA, *RK, *RV, *RG;
    __device__ __forceinline__ void operator()(const f32x4 (&acc)[2][2][4][2], const Unit& u, int wr, int wc, int fr, int fq) const {
        const int row0 = u.pm * BM + wr * 64 + fr;
#pragma unroll
        for (int bj = 0; bj < 2; ++bj) {
            const int col = u.pn * BM + bj * HALF + wc * 32 + 8 * fq;
            bf16_t* base = O; int ld = ldc; int cc = col;
            if (MODE == 0) {
                if (col < 1024)      { base = QR; ld = 2048; cc = col; }
                else if (col < 1152) { base = KA; ld = 128;  cc = col - 1024; }
                else if (col < 1280) { base = VA; ld = 128;  cc = col - 1152; }
                else if (col < 2304) { base = QR; ld = 2048; cc = col - 1280 + 1024; }
                else if (col < 3328) { base = RK; ld = 1024; cc = col - 2304; }
                else if (col < 4352) { base = RV; ld = 1024; cc = col - 3328; }
                else                 { base = RG; ld = 1024; cc = col - 4352; }
            }
#pragma unroll
            for (int ai = 0; ai < 2; ++ai)
#pragma unroll
                for (int m = 0; m < 4; ++m) {
                    const int row = row0 + ai * HALF + m * 16;
                    f32x4 v0 = acc[ai][bj][m][0], v1 = acc[ai][bj][m][1];
                    if (MODE == 1) {
                        const u32x4 r = *(const u32x4*)(R + (size_t)row * ldc + col);
                        v0[0] += alpha * __uint_as_float(r.x << 16); v0[1] += alpha * __uint_as_float(r.x & 0xffff0000u);
                        v0[2] += alpha * __uint_as_float(r.y << 16); v0[3] += alpha * __uint_as_float(r.y & 0xffff0000u);
                        v1[0] += alpha * __uint_as_float(r.z << 16); v1[1] += alpha * __uint_as_float(r.z & 0xffff0000u);
                        v1[2] += alpha * __uint_as_float(r.w << 16); v1[3] += alpha * __uint_as_float(r.w & 0xffff0000u);
                    }
                    u32x4 w; w.x = cvt_pk_bf16(v0[0], v0[1]); w.y = cvt_pk_bf16(v0[2], v0[3]); w.z = cvt_pk_bf16(v1[0], v1[1]); w.w = cvt_pk_bf16(v1[2], v1[3]);
                    *(u32x4*)(base + (size_t)row * ld + cc) = w;
                }
        }
    }
};

struct EpiProj {
    static constexpr bool PERM = true, AFTER_DRAIN = false;
    bf16_t *QR, *KA, *VA, *RK, *RV, *RG; const float* ropeR; const float* ropeA; float qscale;
    __device__ __forceinline__ void operator()(const f32x4 (&acc)[2][2][4][2], const Unit& u, int wr, int wc, int fr, int fq) const {
        const int pn = u.pn, row0 = u.pm * BM + wr * 64 + fr, c0 = wc * 32 + 8 * fq;
        const bool rope = (pn <= 3) || (pn == 4 && wc < 2) || (pn >= 5 && pn <= 12);
        if (rope) {
            const bool ret = pn >= 5; const int h = ret ? ((pn - 5) & 3) : 0;
            const float lg = __builtin_amdgcn_logf(1.0f - __builtin_amdgcn_exp2f(-5.0f - (float)h));
            bf16_t* base; int ld, cA, cB;
            if (pn <= 3)      { base = QR; ld = 2048; cA = pn * 256 + 64 * wc + 8 * fq; cB = cA + 32; }
            else if (pn == 4) { base = KA; ld = 128;  cA = 64 * wc + 8 * fq; cB = cA + 32; }
            else if (pn <= 8) { base = QR; ld = 2048; cA = 1024 + 256 * h + c0; cB = cA + 128; }
            else              { base = RK; ld = 1024; cA = 256 * h + c0; cB = cA + 128; }
#pragma unroll
            for (int ai = 0; ai < 2; ++ai)
#pragma unroll
                for (int m = 0; m < 4; ++m) {
                    const int row = row0 + ai * HALF + m * 16;
                    int pos, ipos;
                    if (row < 16384) { const int s = row & 4095; pos = 16 + s; ipos = s & 127; } else { int j = row - 16384; if (j > 15) j = 15; pos = j; ipos = 112 + j; }
                    float sc = qscale;
                    if (pn == 4) sc = 1.0f; else if (pn >= 9) sc = 0.0625f * __builtin_amdgcn_exp2f(-(float)(ipos + 1) * lg); else if (pn >= 5) sc = __builtin_amdgcn_exp2f((float)(ipos + 1) * lg);
                    const float* tb = ret ? ropeR + ((size_t)pos * 128 + c0) * 2 : ropeA + ((size_t)pos * 32 + 8 * fq) * 2;
                    const f32x4 t0 = *(const f32x4*)tb, t1 = *(const f32x4*)(tb + 4), t2 = *(const f32x4*)(tb + 8), t3 = *(const f32x4*)(tb + 12);
                    const f32x4 a0 = acc[ai][0][m][0], a1 = acc[ai][0][m][1], b0 = acc[ai][1][m][0], b1 = acc[ai][1][m][1];
                    u32x4 wA, wB;
                    wA.x = cvt_pk_bf16((a0[0] * t0[0] - b0[0] * t0[1]) * sc, (a0[1] * t0[2] - b0[1] * t0[3]) * sc); wA.y = cvt_pk_bf16((a0[2] * t1[0] - b0[2] * t1[1]) * sc, (a0[3] * t1[2] - b0[3] * t1[3]) * sc);
                    wA.z = cvt_pk_bf16((a1[0] * t2[0] - b1[0] * t2[1]) * sc, (a1[1] * t2[2] - b1[1] * t2[3]) * sc); wA.w = cvt_pk_bf16((a1[2] * t3[0] - b1[2] * t3[1]) * sc, (a1[3] * t3[2] - b1[3] * t3[3]) * sc);
                    wB.x = cvt_pk_bf16((b0[0] * t0[0] + a0[0] * t0[1]) * sc, (b0[1] * t0[2] + a0[1] * t0[3]) * sc); wB.y = cvt_pk_bf16((b0[2] * t1[0] + a0[2] * t1[1]) * sc, (b0[3] * t1[2] + a0[3] * t1[3]) * sc);
                    wB.z = cvt_pk_bf16((b1[0] * t2[0] + a1[0] * t2[1]) * sc, (b1[1] * t2[2] + a1[1] * t2[3]) * sc); wB.w = cvt_pk_bf16((b1[2] * t3[0] + a1[2] * t3[1]) * sc, (b1[3] * t3[2] + a1[3] * t3[3]) * sc);
                    *(u32x4*)(base + (size_t)row * ld + cA) = wA; *(u32x4*)(base + (size_t)row * ld + cB) = wB;
                    if (m & 1) asm volatile("" ::: "memory");
                }
        } else {
            const bool silu = pn >= 17;
#pragma unroll
            for (int bj = 0; bj < 2; ++bj) {
                bf16_t* base; int ld, cc;
                if (pn == 4)       { base = VA; ld = 128;  cc = 64 * bj + 32 * (wc - 2) + 8 * fq; }
                else if (pn <= 16) { base = RV; ld = 1024; cc = 256 * (pn - 13) + 128 * bj + c0; }
                else               { base = RG; ld = 1024; cc = 256 * (pn - 17) + 128 * bj + c0; }
#pragma unroll
                for (int ai = 0; ai < 2; ++ai)
#pragma unroll
                    for (int m = 0; m < 4; ++m) {
                        const int row = row0 + ai * HALF + m * 16;
                        f32x4 v0 = acc[ai][bj][m][0], v1 = acc[ai][bj][m][1];
                        if (silu) {
#pragma unroll
                            for (int e = 0; e < 4; ++e) { v0[e] = v0[e] * __builtin_amdgcn_rcpf(1.0f + __builtin_amdgcn_exp2f(-1.4426950408889634f * v0[e])); v1[e] = v1[e] * __builtin_amdgcn_rcpf(1.0f + __builtin_amdgcn_exp2f(-1.4426950408889634f * v1[e])); } }
                        u32x4 w; w.x = cvt_pk_bf16(v0[0], v0[1]); w.y = cvt_pk_bf16(v0[2], v0[3]); w.z = cvt_pk_bf16(v1[0], v1[1]); w.w = cvt_pk_bf16(v1[2], v1[3]);
                        *(u32x4*)(base + (size_t)row * ld + cc) = w;
                    }
            }
        }
    }
};
template <class Epi, class Sched, bool ALIGN_EPI = false, bool SP2 = false>
__device__ __forceinline__ void gemm_phase(PG8_LAS unsigned char* lds, const Gemm g, const Sched& S, const Epi& E) {
    const int tid = threadIdx.x, wid = __builtin_amdgcn_readfirstlane(tid >> 6), lane = tid & 63, wr = wid >> 2, wc = wid & 3, fr = lane & 15, fq = lane >> 4;
    const int K = g.K, nt = K / BK;
    unsigned voffA[2], voffB[2];
#pragma unroll
    for (int i = 0; i < 2; ++i) { int R, C; stage_rc(tid * 16 + i * 8192, R, C); const int Rb = Epi::PERM ? ((R & ~31) + perm32(R & 31)) : R;
        voffA[i] = (unsigned)(R * K + C) * 2u; voffB[i] = (unsigned)(Rb * K + C) * 2u; }
    const size_t kstep = (size_t)(BK * 2);
    const size_t hstep = (size_t)HALF * K * 2;
    const size_t tstep = 2 * hstep;
    const unsigned ldsw = (unsigned)wid * 1024u;
    const int aoff = lds_byte(wr * 64 + fr, fq * 8), boff = lds_byte(wc * 32 + fr, fq * 8);
#define PG8_SA(b, h) (((b) * 2 + (h)) * HTB)
#define PG8_SB(b, h) ((4 + (b) * 2 + (h)) * HTB)
#define PG8_STAGE(bufoff, gbase, voff) do { _Pragma("unroll") for (int _i = 0; _i < 2; ++_i) \
        __builtin_amdgcn_global_load_lds((const unsigned*)((const char*)(gbase) + (voff)[_i]), (PG8_LAS unsigned*)(lds + (bufoff) + ldsw + _i * 8192), 16, 0, 0); } while (0)
#define PG8_LDA(dst, b, h) do { _Pragma("unroll") for (int m = 0; m < 4; ++m) _Pragma("unroll") for (int k = 0; k < 2; ++k) dst[m][k] = *(const PG8_LAS bf16x8*)(lds + PG8_SA(b, h) + aoff + m * 2048 + k * 1024); } while (0)
#define PG8_LDB(dst, b, h) do { _Pragma("unroll") for (int n = 0; n < 2; ++n) _Pragma("unroll") for (int k = 0; k < 2; ++k) dst[n][k] = *(const PG8_LAS bf16x8*)(lds + PG8_SB(b, h) + boff + n * 2048 + k * 1024); } while (0)
#define PG8_MMA(ai, bj, At, Bt) do { __builtin_amdgcn_s_setprio(1); _Pragma("unroll") for (int m = 0; m < 4; ++m) _Pragma("unroll") for (int n = 0; n < 2; ++n) _Pragma("unroll") for (int k = 0; k < 2; ++k) \
        acc[ai][bj][m][n] = __builtin_amdgcn_mfma_f32_16x16x32_bf16(Bt[n][k], At[m][k], acc[ai][bj][m][n], 0, 0, 0); __builtin_amdgcn_s_setprio(0); } while (0)
#define PG8_WAIT_V(n) asm volatile("s_waitcnt vmcnt(" #n ")" ::: "memory")
#define PG8_WAIT_L(n) asm volatile("s_waitcnt lgkmcnt(" #n ")" ::: "memory")
#define PG8_BAR __builtin_amdgcn_s_barrier()
#define PG8_SCHED __builtin_amdgcn_sched_barrier(0)
    Unit cur, nxt; int ui = 0;
    if (!S.next(0, cur)) return;
    f32x4 acc[2][2][4][2];
#pragma unroll
    for (int a = 0; a < 2; ++a)
#pragma unroll
        for (int b = 0; b < 2; ++b)
#pragma unroll
            for (int m = 0; m < 4; ++m)
#pragma unroll
                for (int n = 0; n < 2; ++n) acc[a][b][m][n] = (f32x4){0.f, 0.f, 0.f, 0.f};
    bf16x8 At[4][2], B0[2][2], B1[2][2];
    const char* cA = (const char*)g.A + (size_t)cur.pm * tstep; const char* cB = (const char*)g.Bt + (size_t)cur.pn * tstep;
    S.a_ready(cur);
    if constexpr (SP2) {
        PG8_STAGE(PG8_SB(0, 0), cB, voffB); PG8_STAGE(PG8_SB(0, 1), cB + hstep, voffB); PG8_STAGE(PG8_SA(0, 0), cA, voffA); PG8_STAGE(PG8_SA(0, 1), cA + hstep, voffA);
        if (wr == 1) PG8_BAR;
        PG8_WAIT_V(2); PG8_BAR;
        PG8_STAGE(PG8_SB(1, 0), cB + kstep, voffB); PG8_STAGE(PG8_SA(1, 0), cA + kstep, voffA); PG8_STAGE(PG8_SB(1, 1), cB + hstep + kstep, voffB);
        PG8_WAIT_V(6); PG8_BAR;
    } else {
        PG8_STAGE(PG8_SB(0, 0), cB, voffB); PG8_STAGE(PG8_SA(0, 0), cA, voffA); PG8_STAGE(PG8_SB(0, 1), cB + hstep, voffB); PG8_STAGE(PG8_SA(0, 1), cA + hstep, voffA);
        if (wr == 1) PG8_BAR;
        PG8_WAIT_V(4); PG8_BAR;
        PG8_STAGE(PG8_SB(1, 0), cB + kstep, voffB); PG8_STAGE(PG8_SA(1, 0), cA + kstep, voffA); PG8_STAGE(PG8_SB(1, 1), cB + hstep + kstep, voffB);
        PG8_WAIT_V(6); PG8_BAR;
    }
    for (;;) {
        const bool has_next = S.next(ui + 1, nxt);
        const char* nA = has_next ? (const char*)g.A + (size_t)nxt.pm * tstep : cA; const char* nB = has_next ? (const char*)g.Bt + (size_t)nxt.pn * tstep : cB;
        for (int t = 0; t < nt; t += 2) {
            const bool last = (t == nt - 2);
            const char* a1 = cA + (size_t)(t + 1) * kstep;
            const char* a2 = last ? nA : cA + (size_t)(t + 2) * kstep; const char* b2 = last ? nB : cB + (size_t)(t + 2) * kstep;
            const char* a3 = a2 + kstep; const char* b3 = b2 + kstep;
            if (last && has_next) S.a_ready(nxt);
            if constexpr (SP2) {
            PG8_LDB(B0, 0, 0); PG8_LDB(B1, 0, 1); PG8_SCHED; PG8_LDA(At, 0, 0); PG8_STAGE(PG8_SA(1, 1), a1 + hstep, voffA);
            PG8_WAIT_V(8); PG8_WAIT_L(0); PG8_BAR; PG8_MMA(0, 0, At, B0); PG8_MMA(0, 1, At, B1); PG8_BAR; PG8_SCHED;
            PG8_LDA(At, 0, 1); PG8_STAGE(PG8_SB(0, 0), b2, voffB); PG8_STAGE(PG8_SB(0, 1), b2 + hstep, voffB); PG8_STAGE(PG8_SA(0, 0), a2, voffA);
            PG8_WAIT_V(8); PG8_WAIT_L(0); PG8_BAR; PG8_MMA(1, 0, At, B0); PG8_MMA(1, 1, At, B1); PG8_BAR; PG8_SCHED;
            PG8_LDB(B0, 1, 0); PG8_LDB(B1, 1, 1); PG8_SCHED; PG8_LDA(At, 1, 0); PG8_STAGE(PG8_SA(0, 1), a2 + hstep, voffA);
            PG8_WAIT_V(8); PG8_WAIT_L(0); PG8_BAR; PG8_MMA(0, 0, At, B0); PG8_MMA(0, 1, At, B1); PG8_BAR; PG8_SCHED;
            PG8_LDA(At, 1, 1); PG8_STAGE(PG8_SB(1, 0), b3, voffB); PG8_STAGE(PG8_SB(1, 1), b3 + hstep, voffB); PG8_STAGE(PG8_SA(1, 0), a3, voffA);
            PG8_WAIT_V(8); PG8_WAIT_L(0); PG8_BAR; PG8_MMA(1, 0, At, B0); PG8_MMA(1, 1, At, B1); PG8_BAR; PG8_SCHED;
            } else {
            PG8_LDB(B0, 0, 0); PG8_SCHED; PG8_LDA(At, 0, 0); PG8_STAGE(PG8_SA(1, 1), a1 + hstep, voffA);
            PG8_WAIT_L(8); PG8_BAR; PG8_WAIT_L(0); PG8_MMA(0, 0, At, B0); PG8_BAR; PG8_SCHED;
            PG8_LDB(B1, 0, 1); PG8_STAGE(PG8_SB(0, 0), b2, voffB);
            PG8_BAR; PG8_WAIT_L(0); PG8_MMA(0, 1, At, B1); PG8_BAR;
            PG8_LDA(At, 0, 1); PG8_STAGE(PG8_SA(0, 0), a2, voffA);
            PG8_BAR; PG8_WAIT_L(0); PG8_MMA(1, 0, At, B0); PG8_BAR; PG8_SCHED;
            PG8_STAGE(PG8_SB(0, 1), b2 + hstep, voffB);
            PG8_WAIT_V(6); PG8_BAR; PG8_MMA(1, 1, At, B1); PG8_BAR;
            PG8_LDB(B0, 1, 0); PG8_SCHED; PG8_LDA(At, 1, 0); PG8_STAGE(PG8_SA(0, 1), a2 + hstep, voffA);
            PG8_WAIT_L(8); PG8_BAR; PG8_WAIT_L(0); PG8_MMA(0, 0, At, B0); PG8_BAR; PG8_SCHED;
            PG8_LDB(B1, 1, 1); PG8_STAGE(PG8_SB(1, 0), b3, voffB);
            PG8_BAR; PG8_WAIT_L(0); PG8_MMA(0, 1, At, B1); PG8_BAR;
            PG8_LDA(At, 1, 1); PG8_STAGE(PG8_SA(1, 0), a3, voffA);
            PG8_BAR; PG8_WAIT_L(0); PG8_MMA(1, 0, At, B0); PG8_BAR; PG8_SCHED;
            PG8_STAGE(PG8_SB(1, 1), b3 + hstep, voffB);
            PG8_WAIT_V(6); PG8_BAR; PG8_MMA(1, 1, At, B1); PG8_BAR;
            }
        }
        if constexpr (ALIGN_EPI) { if (wr == 0) PG8_BAR; }
        if constexpr (!Epi::AFTER_DRAIN) { E(acc, cur, wr, wc, fr, fq); S.done(cur); }
        if (!has_next) break;
#pragma unroll
        for (int a = 0; a < 2; ++a)
#pragma unroll
            for (int b = 0; b < 2; ++b)
#pragma unroll
                for (int m = 0; m < 4; ++m)
#pragma unroll
                    for (int n = 0; n < 2; ++n) acc[a][b][m][n] = (f32x4){0.f, 0.f, 0.f, 0.f};
        cur = nxt; cA = nA; cB = nB; ++ui;
        if constexpr (ALIGN_EPI) { if (wr == 1) PG8_BAR; }
    }
    PG8_WAIT_V(0);
    if constexpr (!ALIGN_EPI) { if (wr == 0) PG8_BAR; }
    PG8_BAR;
    if constexpr (Epi::AFTER_DRAIN) { E.fused(acc, cur, wr, wc, fr, fq, lds, wid, lane); S.done(cur); }
#undef PG8_SA
#undef PG8_SB
#undef PG8_STAGE
#undef PG8_LDA
#undef PG8_LDB
#undef PG8_MMA
#undef PG8_WAIT_V
#undef PG8_WAIT_L
#undef PG8_BAR
#undef PG8_SCHED
}
}

constexpr int NWAVES = 8;
constexpr int DM = 2048, NB = 4, SEQ = 4096, NTOK = NB * SEQ;
constexpr int NMETA = 16, NVALID = NTOK + NMETA, MROWS = 16640;
constexpr int IN_COLS = 5376;
constexpr float LN_EPS = 1e-5f, GN_EPS = 1e-5f;
constexpr float ALPHA = 1.189207115002721f;
constexpr float LOG2E = 1.4426950408889634f;
constexpr float QSCALE = 0.125f * LOG2E;
constexpr float U_SCALE = 64.0f, V_SCALE = 4.0f;
constexpr int NSL = 16;

constexpr size_t MiB = 1u << 20;
constexpr size_t WS_CTL = 0, CTL_ZERO_BYTES = 1 * MiB;
constexpr size_t SZ_SK = (size_t)16 * 128 * 128 * 2, SZ_ROPE_R = (size_t)4112 * 128 * 8, SZ_ROPE_A = (size_t)4112 * 32 * 8;
constexpr size_t SZ_W2T = (size_t)DM * DM * 2, SZ_W1T = (size_t)IN_COLS * DM * 2, SZ_TAB = (size_t)16384 * DM * 2;
constexpr size_t SZ_ROWS2K = (size_t)MROWS * 2048 * 2, SZ_ROWS1K = (size_t)MROWS * 1024 * 2, SZ_ROWS128 = (size_t)MROWS * 128 * 2;
constexpr size_t SZ_TOK2K = (size_t)NTOK * 2048 * 2, SZ_ST = (size_t)16 * 32 * 256 * 256 * 2, SZ_IDS = (size_t)NTOK * 128 * 4;
constexpr size_t al256(size_t x) { return (x + 255) & ~(size_t)255; }
constexpr size_t WS_SK = 1 * MiB;
constexpr size_t WS_ROPE_R = al256(WS_SK + SZ_SK);
constexpr size_t WS_ROPE_A = al256(WS_ROPE_R + SZ_ROPE_R);
constexpr size_t WS_W2T = al256(WS_ROPE_A + SZ_ROPE_A), WS_W3T = al256(WS_W2T + SZ_W2T), WS_W1T = al256(WS_W3T + SZ_W2T);
constexpr size_t WS_UT = al256(WS_W1T + SZ_W1T), WS_VT = al256(WS_UT + SZ_TAB);
constexpr size_t WS_H0 = al256(WS_VT + SZ_TAB);
constexpr size_t WS_QR = al256(WS_H0 + SZ_ROWS2K);
constexpr size_t WS_KA = al256(WS_QR + SZ_ROWS2K), WS_VA = al256(WS_KA + SZ_ROWS128);
constexpr size_t WS_RK = al256(WS_VA + SZ_ROWS128), WS_RV = al256(WS_RK + SZ_ROWS1K), WS_RG = al256(WS_RV + SZ_ROWS1K);
constexpr size_t WS_ST = al256(WS_RG + SZ_ROWS1K);
constexpr size_t WS_Y = WS_RK;
constexpr size_t WS_H1 = WS_ST;
constexpr size_t WS_IDS = al256(WS_ST + SZ_ST), WS_GATES = al256(WS_IDS + SZ_IDS);
constexpr size_t WS_END = al256(WS_GATES + SZ_IDS);
static_assert(WS_Y + SZ_TOK2K <= WS_RG, "Y overlays RK|RV only");
static_assert(SZ_TOK2K <= SZ_ST && (size_t)NTOK * 1024 * 4 <= SZ_ST, "H1 / RET_RAW fit the state region");
static_assert(WS_END <= (size_t)512 * MiB, "workspace map fits 4 x largest tensor");
static_assert(WS_RK + (size_t)8 * NTOK * 128 * 4 <= WS_ST && WS_KA + (size_t)NTOK * 128 * 4 <= WS_RK && WS_H0 + (size_t)NTOK * DM * 4 <= WS_KA, "expert-phase overlays (DOTX over RK|RV, CB over KA|VA, Y32 over H0|QR)");
constexpr int CW_TMO = 0, CW_TABQ = 64, CW_BAR = 4096;

constexpr int RING_OFF = 0, RING_BYTES = 131072;
constexpr int LDSCTL_OFF = RING_BYTES, MISC_OFF = LDSCTL_OFF + 320;
constexpr int LDS_BYTES = 147456;

#define GAS __attribute__((address_space(1)))
#define LAS __attribute__((address_space(3)))
typedef unsigned short bf16;
typedef unsigned v4u __attribute__((ext_vector_type(4)));
typedef unsigned v2u __attribute__((ext_vector_type(2)));
typedef float f32x4 __attribute__((ext_vector_type(4)));
typedef float f32x2 __attribute__((ext_vector_type(2)));
typedef GAS unsigned gu32;
typedef __bf16 bf16x2_t __attribute__((ext_vector_type(2)));
#define RLX_AGENT __ATOMIC_RELAXED, __HIP_MEMORY_SCOPE_AGENT
#define LDS_WAIT() asm volatile("s_waitcnt lgkmcnt(0)" ::: "memory")
#define VM_WAIT() asm volatile("s_waitcnt vmcnt(0)" ::: "memory")
__device__ __forceinline__ unsigned f2bf(float f) { unsigned u = __builtin_bit_cast(unsigned, f); return (u + 0x7fffu + ((u >> 16) & 1u)) >> 16; }
__device__ __forceinline__ unsigned pk2(float lo, float hi) { return f2bf(lo) | (f2bf(hi) << 16); }
__device__ __forceinline__ float bflo(unsigned w) { return __uint_as_float(w << 16); }
__device__ __forceinline__ float bfhi(unsigned w) { return __uint_as_float(w & 0xffff0000u); }
__device__ __forceinline__ float bf2f(bf16 h) { return __uint_as_float((unsigned)h << 16); }

#define XB_TMO      128
#define XB_XCNT(j)  (256  + 64 * (j))
#define XB_XSUB(j)  (1280 + 64 * (j))
#define XB_XGEN(j)  (2304 + 64 * (j))
#define XB_TOP      3328
#define XB_TOPGEN   3392
#define XCD_BAR_WORDS 3456
#define XB_SPIN_CAP (1u << 18)

__device__ __forceinline__ unsigned xb_ld(unsigned* p)              { return __hip_atomic_load(p, __ATOMIC_RELAXED, __HIP_MEMORY_SCOPE_AGENT); }
__device__ __forceinline__ unsigned xb_add(unsigned* p, unsigned v) { return __hip_atomic_fetch_add(p, v, __ATOMIC_RELAXED, __HIP_MEMORY_SCOPE_AGENT); }
__device__ __forceinline__ unsigned xb_xcc_id() { return (unsigned)__builtin_amdgcn_s_getreg((3 << 11) | 20) & 0xFu; }
#define XB_SPIN(cond, bar) do { unsigned _sp = 0; while (cond) { __builtin_amdgcn_s_sleep(1); \
    if ((++_sp & 255u) == 0u) { if (xb_ld(&(bar)[XB_TMO])) break; if (_sp > XB_SPIN_CAP) { atomicAdd(&(bar)[XB_TMO], 1u); break; } } } } while (0)

struct XcdBarrier {
    unsigned* bar; unsigned x;
    volatile LAS unsigned* st;
};

__device__ __forceinline__ XcdBarrier xcd_barrier_post(unsigned* bar, volatile LAS unsigned* st) {
    XcdBarrier b; b.bar = bar; b.x = xb_xcc_id(); b.st = st;
    if (threadIdx.x == 0) (void)xb_add(&bar[XB_XCNT(b.x)], 1u);
    return b;
}
__device__ __forceinline__ void xcd_barrier_complete(unsigned* bar, unsigned x, unsigned& nloc, unsigned& nx) {
    const unsigned G = gridDim.x * gridDim.y * gridDim.z;
    unsigned sum, cnt, mine, sp = 0u;
    for (;;) {
        sum = 0u; cnt = 0u; mine = 0u;
#pragma unroll
        for (unsigned j = 0; j < 16; ++j) { const unsigned c = xb_ld(&bar[XB_XCNT(j)]); sum += c; cnt += (c > 0u) ? 1u : 0u; mine = (j == x) ? c : mine; }
        if (sum == G) break;
        __builtin_amdgcn_s_sleep(1);
        if ((++sp & 255u) == 0u) { if (xb_ld(&bar[XB_TMO])) break; if (sp > XB_SPIN_CAP) { atomicAdd(&bar[XB_TMO], 1u); break; } }
    }
    nloc = mine > 0u ? mine : 1u; nx = cnt > 0u ? cnt : 1u;
}

__device__ __forceinline__ void xcd_barrier(const XcdBarrier& b) {
    asm volatile("s_waitcnt vmcnt(0)" ::: "memory");
    __syncthreads();
    if (threadIdx.x == 0) {
        unsigned* bar = b.bar;
        __builtin_amdgcn_s_waitcnt(0);
        unsigned nloc = b.st[0], nx = b.st[1];
        if (nloc == 0u) { xcd_barrier_complete(bar, b.x, nloc, nx); b.st[0] = nloc; b.st[1] = nx; }
        const unsigned old = xb_add(&bar[XB_XSUB(b.x)], 1u);
        const unsigned gen = old / nloc;
        if (old + 1u == (gen + 1u) * nloc) {
            __builtin_amdgcn_fence(__ATOMIC_RELEASE, "agent");
            asm volatile("s_waitcnt vmcnt(0)" ::: "memory");
            const unsigned og = xb_add(&bar[XB_TOP], 1u);
            const unsigned tg = og / nx;
            if (og + 1u == (tg + 1u) * nx) xb_add(&bar[XB_TOPGEN], 1u);
            else XB_SPIN(xb_ld(&bar[XB_TOPGEN]) == tg, bar);
            __builtin_amdgcn_fence(__ATOMIC_ACQUIRE, "agent");
            xb_add(&bar[XB_XGEN(b.x)], 1u);
            asm volatile("s_waitcnt vmcnt(0)" ::: "memory");
        } else {
            XB_SPIN(xb_ld(&bar[XB_XGEN(b.x)]) == gen, bar);
            __builtin_amdgcn_fence(__ATOMIC_ACQUIRE, "agent");
            asm volatile("s_waitcnt vmcnt(0)" ::: "memory");
        }
    }
    __syncthreads();
}


__device__ __forceinline__ float dot2bf(unsigned a, unsigned b, float c) { asm("v_dot2c_f32_bf16 %0, %1, %2" : "+v"(c) : "v"(a), "v"(b)); return c; }
__device__ __forceinline__ float dot8bf_dpp(v4u a, v4u b) { float c = 0.f; asm("v_dot2c_f32_bf16 %0, %1, %5\n\tv_dot2c_f32_bf16 %0, %2, %6\n\tv_dot2c_f32_bf16 %0, %3, %7\n\tv_dot2c_f32_bf16 %0, %4, %8\n\ts_nop 1" : "+v"(c) : "v"(a.x), "v"(a.y), "v"(a.z), "v"(a.w), "v"(b.x), "v"(b.y), "v"(b.z), "v"(b.w)); return c; }
#define DPPF(v, ctrl) __int_as_float(__builtin_amdgcn_update_dpp(0, __float_as_int(v), (ctrl), 0xf, 0xf, true))
__device__ __forceinline__ float wave_sum(float v) {
#pragma unroll
    for (int o = 1; o < 64; o <<= 1) v += __shfl_xor(v, o);
    return v;
}
__device__ __forceinline__ float gelu_erf(float v) {
    const float av = fabsf(v), d = av * 0.2316418882f + 1.0f;
    const float t = __builtin_amdgcn_rcpf(d);
    float q = t * 0.5307027145f + (-0.7265760135f); q = q * t + 0.7107068705f; q = q * t + (-0.142248368f); q = q * t + 0.127414796f; q = q * t;
    const float e = __builtin_amdgcn_exp2f((v * v) * (-0.72134752044f));
    const float m = v * (q * e);
    return v < 0.f ? m : v - m;
}

struct Args { const float* in[15]; float* out; unsigned char* ws; };

__device__ __forceinline__ int w1_logical_col(int n0p) {
    const int pn = n0p >> 8, blk = (n0p & 255) >> 5, half = blk >> 2, a = blk & 3;
    if (pn <= 3) return pn * 256 + 64 * a + 32 * half;
    if (pn == 4) return (a < 2) ? (1024 + 64 * a + 32 * half) : (1152 + 64 * half + 32 * (a - 2));
    return n0p;
}
template <bool PERMW1> __device__ __forceinline__ void p0_transpose_item(const float* W, int K, int N, bf16* WT, LAS float* scr, int item, int lane) {
    const int nblk = N / 32, kb = item / nblk, nb = item % nblk, k0 = 64 * kb, n0 = 32 * nb; const int ns = PERMW1 ? w1_logical_col(n0) : n0;
    float tv[32];
#pragma unroll
    for (int i = 0; i < 32; ++i) { const int kk = 2 * i + (lane >> 5); tv[i] = W[(size_t)(k0 + kk) * N + ns + (lane & 31)]; }
#pragma unroll
    for (int i = 0; i < 32; ++i) { const int kk = 2 * i + (lane >> 5); scr[kk * 33 + (lane & 31)] = tv[i]; }
    LDS_WAIT(); asm volatile("" ::: "memory");
    const int c = lane & 7;
#pragma unroll
    for (int j = 0; j < 4; ++j) { const int n = (lane >> 3) + 8 * j; const LAS float* s = scr + (8 * c) * 33 + n;
        v4u o; o.x = pk2(s[0 * 33], s[1 * 33]); o.y = pk2(s[2 * 33], s[3 * 33]); o.z = pk2(s[4 * 33], s[5 * 33]); o.w = pk2(s[6 * 33], s[7 * 33]);
        *(GAS v4u*)(WT + (size_t)(n0 + n) * K + k0 + 8 * c) = o; }
    LDS_WAIT(); asm volatile("" ::: "memory");
}
__device__ __forceinline__ void ln_row_f32_to_bf16(const float* xrow, const float* g, const float* bta, bf16* orow, int lane) {
    const GAS f32x4* xr = (const GAS f32x4*)xrow + lane;
    f32x4 v[8]; float s = 0.f;
#pragma unroll
    for (int j = 0; j < 8; ++j) { v[j] = xr[64 * j]; s += (v[j].x + v[j].y) + (v[j].z + v[j].w); }
    const float mean = wave_sum(s) * (1.f / DM); float s2 = 0.f;
#pragma unroll
    for (int j = 0; j < 8; ++j) { v[j] = v[j] - mean; s2 += (v[j].x * v[j].x + v[j].y * v[j].y) + (v[j].z * v[j].z + v[j].w * v[j].w); }
    const float rstd = 1.f / sqrtf(wave_sum(s2) * (1.f / DM) + LN_EPS);
    GAS v2u* o8 = (GAS v2u*)orow + lane;
#pragma unroll
    for (int j = 0; j < 8; ++j) { const f32x4 gg = ((const GAS f32x4*)g)[lane + 64 * j], bb = ((const GAS f32x4*)bta)[lane + 64 * j];
        v2u o; o.x = pk2(v[j].x * rstd * gg.x + bb.x, v[j].y * rstd * gg.y + bb.y); o.y = pk2(v[j].z * rstd * gg.z + bb.z, v[j].w * rstd * gg.w + bb.w); o8[64 * j] = o; }
}
__device__ __forceinline__ void ln_row_bf16_to_bf16(const bf16* xrow, const float* g, const float* bta, bf16* orow, int lane) {
    const GAS v4u* xr = (const GAS v4u*)xrow + lane;
    float v[32]; float s = 0.f;
#pragma unroll
    for (int j = 0; j < 4; ++j) { const v4u w = xr[64 * j];
        v[8 * j + 0] = bflo(w.x); v[8 * j + 1] = bfhi(w.x); v[8 * j + 2] = bflo(w.y); v[8 * j + 3] = bfhi(w.y);
        v[8 * j + 4] = bflo(w.z); v[8 * j + 5] = bfhi(w.z); v[8 * j + 6] = bflo(w.w); v[8 * j + 7] = bfhi(w.w); }
#pragma unroll
    for (int i = 0; i < 32; ++i) s += v[i];
    const float mean = wave_sum(s) * (1.f / DM); float s2 = 0.f;
#pragma unroll
    for (int i = 0; i < 32; ++i) { v[i] -= mean; s2 += v[i] * v[i]; }
    const float rstd = 1.f / sqrtf(wave_sum(s2) * (1.f / DM) + LN_EPS);
    GAS v4u* o16 = (GAS v4u*)orow + lane;
#pragma unroll
    for (int j = 0; j < 4; ++j) {
        const GAS f32x4* gp = (const GAS f32x4*)g + 2 * (lane + 64 * j); const GAS f32x4* bp = (const GAS f32x4*)bta + 2 * (lane + 64 * j);
        const f32x4 g0 = gp[0], g1 = gp[1], b0 = bp[0], b1 = bp[1];
        v4u o; o.x = pk2(v[8 * j + 0] * rstd * g0.x + b0.x, v[8 * j + 1] * rstd * g0.y + b0.y); o.y = pk2(v[8 * j + 2] * rstd * g0.z + b0.z, v[8 * j + 3] * rstd * g0.w + b0.w);
        o.z = pk2(v[8 * j + 4] * rstd * g1.x + b1.x, v[8 * j + 5] * rstd * g1.y + b1.y); o.w = pk2(v[8 * j + 6] * rstd * g1.z + b1.z, v[8 * j + 7] * rstd * g1.w + b1.w);
        o16[64 * j] = o; }
}
__device__ __forceinline__ void row_pos(int r, int& pos, int& ipos) {
    if (r < NTOK) { const int s = r & (SEQ - 1); pos = NMETA + s; ipos = s & 127; }
    else { int j = r - NTOK; if (j > NMETA - 1) j = NMETA - 1; pos = j; ipos = 112 + j; }
}
__device__ __forceinline__ float log2_gamma(int h) { return log2f(1.0f - exp2f(-5.0f - (float)h)); }


typedef short bf16x8 __attribute__((ext_vector_type(8)));
typedef short s16x4 __attribute__((ext_vector_type(4)));
#define MFMA16(a, b, c) __builtin_amdgcn_mfma_f32_16x16x32_bf16((a), (b), (c), 0, 0, 0)
__device__ __forceinline__ s16x4 tr16(LAS const unsigned char* p) { return __builtin_bit_cast(s16x4, __builtin_amdgcn_ds_read_tr16_b64_v4i16((LAS s16x4*)p)); }
__device__ __forceinline__ bf16x8 cat8(s16x4 a, s16x4 b) { return __builtin_shufflevector(a, b, 0, 1, 2, 3, 4, 5, 6, 7); }
__device__ __forceinline__ unsigned cvtpk_s(float lo, float hi) { f32x2 v = {lo, hi}; bf16x2_t b = __builtin_convertvector(v, bf16x2_t); return __builtin_bit_cast(unsigned, b); }
__device__ __forceinline__ unsigned cvtpk(float lo, float hi) { unsigned r; asm("v_cvt_pk_bf16_f32 %0, %1, %2" : "=v"(r) : "v"(lo), "v"(hi)); return r; }

__device__ __forceinline__ void scan_unit(LAS unsigned char* L, int u, const bf16* RK, const bf16* RV, bf16* ST, int tid, int lane, int wave) {
    asm volatile("" : "+v"(tid)); lane = tid & 63;
    const int bh = u >> 4, di = (u >> 2) & 3, ei = u & 3, b = bh >> 2, h = bh & 3;
    const float g128 = exp2f(128.0f * log2_gamma(h));
    const int li = lane & 15, g = lane >> 4, q = li >> 2, p4 = li & 3;
    const int eb = wave >> 1, db0 = 2 * (wave & 1);
    f32x4 acc[2]; acc[0] = (f32x4){0.f, 0.f, 0.f, 0.f}; acc[1] = acc[0];
    v4u kA[2], vA[2], kB[2], vB[2];
#define SCAN_LOAD(cc, kreg, vreg) do { _Pragma("unroll") for (int i_ = 0; i_ < 2; ++i_) { const int cid_ = tid + 512 * i_, row_ = cid_ >> 3, c16_ = cid_ & 7; \
        int srow_; bool ok_ = true; if ((cc) < 0) { ok_ = row_ >= 112; srow_ = NTOK + (ok_ ? row_ - 112 : 0); } else srow_ = b * SEQ + (cc) * 128 + row_; \
        const v4u kz_ = *(const GAS v4u*)(RK + (size_t)srow_ * 1024 + h * 256 + di * 64 + c16_ * 8), vz_ = *(const GAS v4u*)(RV + (size_t)srow_ * 1024 + h * 256 + ei * 64 + c16_ * 8); \
        kreg[i_] = ok_ ? kz_ : (v4u){0u, 0u, 0u, 0u}; vreg[i_] = ok_ ? vz_ : (v4u){0u, 0u, 0u, 0u}; } } while (0)
#define SCAN_WRITE(bufp, kreg, vreg) do { _Pragma("unroll") for (int i_ = 0; i_ < 2; ++i_) { const int cid_ = tid + 512 * i_, row_ = cid_ >> 3, c16_ = cid_ & 7; \
        *(LAS v4u*)((bufp) + row_ * 128 + c16_ * 16) = kreg[i_]; *(LAS v4u*)((bufp) + 16384 + row_ * 128 + c16_ * 16) = vreg[i_]; } } while (0)
    SCAN_LOAD(-1, kA, vA); SCAN_WRITE(L, kA, vA); SCAN_LOAD(0, kA, vA); SCAN_LOAD(1, kB, vB); __syncthreads();
    int cur = 0;
    for (int cc = -1; cc <= 29; cc += 2) {
        { LAS const unsigned char* Kt = L + cur * 32768; LAS const unsigned char* Vt = Kt + 16384;
#pragma unroll
          for (int ks = 0; ks < 4; ++ks) { const int r0 = (32 * ks + 8 * g + q) * 128;
              const bf16x8 a = cat8(tr16(Vt + r0 + (16 * eb + 4 * p4) * 2), tr16(Vt + r0 + 512 + (16 * eb + 4 * p4) * 2));
#pragma unroll
              for (int n = 0; n < 2; ++n) { const bf16x8 bb = cat8(tr16(Kt + r0 + (16 * (db0 + n) + 4 * p4) * 2), tr16(Kt + r0 + 512 + (16 * (db0 + n) + 4 * p4) * 2)); acc[n] = MFMA16(a, bb, acc[n]); } }
#pragma unroll
          for (int n = 0; n < 2; ++n) { acc[n] = acc[n] * g128;
              bf16* sp = ST + ((size_t)(bh * 32 + cc + 1) * 256 + (64 * ei + 16 * eb + 4 * g)) * 256 + 64 * di + 16 * (db0 + n) + li;
#pragma unroll
              for (int r = 0; r < 4; ++r) sp[(size_t)r * 256] = (bf16)f2bf(acc[n][r]); }
          SCAN_WRITE(L + (cur ^ 1) * 32768, kA, vA);
          if (cc + 3 <= 30) SCAN_LOAD(cc + 3, kA, vA);
          __syncthreads(); cur ^= 1; }
        { LAS const unsigned char* Kt = L + cur * 32768; LAS const unsigned char* Vt = Kt + 16384;
#pragma unroll
          for (int ks = 0; ks < 4; ++ks) { const int r0 = (32 * ks + 8 * g + q) * 128;
              const bf16x8 a = cat8(tr16(Vt + r0 + (16 * eb + 4 * p4) * 2), tr16(Vt + r0 + 512 + (16 * eb + 4 * p4) * 2));
#pragma unroll
              for (int n = 0; n < 2; ++n) { const bf16x8 bb = cat8(tr16(Kt + r0 + (16 * (db0 + n) + 4 * p4) * 2), tr16(Kt + r0 + 512 + (16 * (db0 + n) + 4 * p4) * 2)); acc[n] = MFMA16(a, bb, acc[n]); } }
#pragma unroll
          for (int n = 0; n < 2; ++n) { acc[n] = acc[n] * g128;
              bf16* sp = ST + ((size_t)(bh * 32 + cc + 2) * 256 + (64 * ei + 16 * eb + 4 * g)) * 256 + 64 * di + 16 * (db0 + n) + li;
#pragma unroll
              for (int r = 0; r < 4; ++r) sp[(size_t)r * 256] = (bf16)f2bf(acc[n][r]); }
          if (cc + 2 <= 30) SCAN_WRITE(L + (cur ^ 1) * 32768, kB, vB);
          if (cc + 4 <= 30) SCAN_LOAD(cc + 4, kB, vB);
          __syncthreads(); cur ^= 1; }
    }
#undef SCAN_LOAD
#undef SCAN_WRITE
}

__device__ __forceinline__ void retout_unit(LAS unsigned char* L, int u, bf16* QR, const bf16* RK, const bf16* RV, const bf16* RG, const bf16* ST, int tid, int lane, int wave) {
    asm volatile("" : "+v"(tid)); lane = tid & 63;
    const int bh = u >> 5, c = u & 31, b = bh >> 2, h = bh & 3;
    const int R0 = b * SEQ + c * 128;
    const int li = lane & 15, g = lane >> 4, q = li >> 2, p4 = li & 3;
    LAS unsigned char* RA = L; LAS unsigned char* RB = L + 65536;
#pragma unroll
    for (int i = 0; i < 8; ++i) { const int cid = tid + 512 * i, j = cid >> 5, ch = cid & 31;
        const v4u kz = *(const GAS v4u*)(RK + (size_t)(R0 + j) * 1024 + h * 256 + ch * 8), vz = *(const GAS v4u*)(RV + (size_t)(R0 + j) * 1024 + h * 256 + ch * 8);
        *(LAS v4u*)(RA + j * 512 + ((ch ^ (j & 15)) << 4)) = kz; *(LAS v4u*)(RB + j * 512 + ((ch ^ ((j & 7) << 1)) << 4)) = vz; }
    bf16x8 qf[8];
    { const GAS v4u* qp = (const GAS v4u*)(QR + (size_t)(R0 + 16 * wave + li) * 2048 + 1024 + h * 256 + 8 * g);
#pragma unroll
      for (int ks = 0; ks < 8; ++ks) qf[ks] = __builtin_bit_cast(bf16x8, qp[4 * ks]); }
    __syncthreads();
    f32x4 st[8];
#pragma unroll
    for (int jt = 0; jt < 8; ++jt) st[jt] = (f32x4){0.f, 0.f, 0.f, 0.f};
#pragma unroll
    for (int jt = 0; jt < 8; ++jt) if (jt <= wave) {
        const int j = 16 * jt + li;
#pragma unroll
        for (int ks = 0; ks < 8; ++ks) { const bf16x8 a = *(LAS const bf16x8*)(RA + j * 512 + (((4 * ks + g) ^ li) << 4)); st[jt] = MFMA16(a, qf[ks], st[jt]); }
        if (jt == wave) {
#pragma unroll
            for (int r = 0; r < 4; ++r) if (4 * g + r > li) st[jt][r] = 0.f; }
    }
    bf16x8 pf[4];
#pragma unroll
    for (int s = 0; s < 4; ++s) { v4u w; w.x = cvtpk_s(st[2 * s][0], st[2 * s][1]); w.y = cvtpk_s(st[2 * s][2], st[2 * s][3]); w.z = cvtpk_s(st[2 * s + 1][0], st[2 * s + 1][1]); w.w = cvtpk_s(st[2 * s + 1][2], st[2 * s + 1][3]); pf[s] = __builtin_bit_cast(bf16x8, w); }
    __syncthreads();
    const bf16* Sg = ST + (size_t)(bh * 32 + c) * 65536;
#define RO_STAGE_ST(dst, s0) do { _Pragma("unroll") for (int i_ = 0; i_ < 8; ++i_) { const int cid_ = tid + 512 * i_, sl_ = cid_ >> 11, e_ = (cid_ >> 3) & 255, ch_ = cid_ & 7; \
        const v4u z_ = *(const GAS v4u*)(Sg + (size_t)e_ * 256 + 64 * ((s0) + sl_) + ch_ * 8); *(LAS v4u*)((dst) + sl_ * 32768 + e_ * 128 + ((ch_ ^ (e_ & 7)) << 4)) = z_; } } while (0)
    RO_STAGE_ST(RA, 0);
    f32x4 o[16];
#pragma unroll
    for (int et = 0; et < 16; ++et) o[et] = (f32x4){0.f, 0.f, 0.f, 0.f};
#pragma unroll
    for (int s = 0; s < 4; ++s) if (2 * s <= wave) {
        const int r1 = 32 * s + 4 * g + q, r2 = r1 + 16;
#pragma unroll
        for (int et = 0; et < 16; ++et) {
            const int chn = 2 * et + (p4 >> 1);
            const bf16x8 a = cat8(tr16(RB + r1 * 512 + ((chn ^ ((r1 & 7) << 1)) << 4) + (p4 & 1) * 8), tr16(RB + r2 * 512 + ((chn ^ ((r2 & 7) << 1)) << 4) + (p4 & 1) * 8));
            o[et] = MFMA16(a, pf[s], o[et]);
        }
    }
    __syncthreads();
    RO_STAGE_ST(RB, 2);
#define RO_STATE_MMA(src, s0) do { _Pragma("unroll") for (int sl_ = 0; sl_ < 2; ++sl_) _Pragma("unroll") for (int k2_ = 0; k2_ < 2; ++k2_) _Pragma("unroll") for (int et = 0; et < 16; ++et) { \
        const int e_ = 16 * et + li; const bf16x8 a_ = *(LAS const bf16x8*)((src) + sl_ * 32768 + e_ * 128 + (((4 * k2_ + g) ^ (e_ & 7)) << 4)); \
        o[et] = MFMA16(a_, qf[2 * ((s0) + sl_) + k2_], o[et]); } } while (0)
    RO_STATE_MMA(RA, 0);
    __syncthreads();
    RO_STATE_MMA(RB, 2);
#undef RO_STAGE_ST
#undef RO_STATE_MMA
    float s1 = 0.f;
#pragma unroll
    for (int et = 0; et < 16; ++et) s1 += (o[et][0] + o[et][1]) + (o[et][2] + o[et][3]);
    s1 += __shfl_xor(s1, 16); s1 += __shfl_xor(s1, 32);
    const float mu = s1 * (1.0f / 256.0f); float s2 = 0.f;
#pragma unroll
    for (int et = 0; et < 16; ++et) { o[et] = o[et] - mu; s2 += (o[et][0] * o[et][0] + o[et][1] * o[et][1]) + (o[et][2] * o[et][2] + o[et][3] * o[et][3]); }
    s2 += __shfl_xor(s2, 16); s2 += __shfl_xor(s2, 32);
    const float rstd = 1.0f / sqrtf(s2 * (1.0f / 256.0f) + GN_EPS);
    const int row = R0 + 16 * wave + li;
    const GAS v2u* gp = (const GAS v2u*)(RG + (size_t)row * 1024 + h * 256 + 4 * g); GAS v2u* op = (GAS v2u*)(QR + (size_t)row * 2048 + 1024 + h * 256 + 4 * g);
#pragma unroll
    for (int et = 0; et < 16; ++et) { const v2u gz = gp[4 * et]; v2u w;
        w.x = cvtpk(o[et][0] * rstd * bflo(gz.x), o[et][1] * rstd * bfhi(gz.x)); w.y = cvtpk(o[et][2] * rstd * bflo(gz.y), o[et][3] * rstd * bfhi(gz.y)); op[4 * et] = w; }
    __syncthreads();
}

typedef float f32x16 __attribute__((ext_vector_type(16)));
#define MFMA32(a, b, c) __builtin_amdgcn_mfma_f32_32x32x16_bf16((a), (b), (c), 0, 0, 0)
__device__ __forceinline__ int crow32(int reg, int hh) { return (reg & 3) + 8 * (reg >> 2) + 4 * hh; }

__device__ __forceinline__ void attn_unit(LAS unsigned char* L, int u, bf16* QR, const bf16* KA, const bf16* VA, const float* sinks, int tid, int lane, int wave) {
    asm volatile("" : "+v"(tid)); lane = tid & 63;
    const int b = u >> 6, j = (u >> 1) & 31, g2 = u & 1, hq = 8 * g2 + wave;
    const int R0 = b * SEQ + 128 * j;
    LAS unsigned char* Kt = L; LAS unsigned char* Vt = L + 32768;
#pragma unroll
    for (int i = 0; i < 4; ++i) { const int cid = tid + 512 * i, kk = cid >> 3, ch = cid & 7;
        int srow; bool ok = true;
        if (kk >= 128) srow = R0 + kk - 128; else if (j > 0) srow = R0 - 128 + kk; else { ok = kk >= 112; srow = NTOK + (ok ? kk - 112 : 0); }
        const v4u kz = *(const GAS v4u*)(KA + (size_t)srow * 128 + g2 * 64 + ch * 8), vz = *(const GAS v4u*)(VA + (size_t)srow * 128 + g2 * 64 + ch * 8);
        *(LAS v4u*)(Kt + kk * 128 + ((ch ^ (kk & 7)) << 4)) = ok ? kz : (v4u){0u, 0u, 0u, 0u};
        *(LAS v4u*)(Vt + kk * 128 + (ch << 4)) = ok ? vz : (v4u){0u, 0u, 0u, 0u}; }
    __syncthreads();
    const int r = lane & 31, hh = lane >> 5, blk = (lane >> 4) & 1, q = (lane & 15) >> 2, p4 = lane & 3;
    const float sk = sinks[hq] * LOG2E;
#pragma unroll 1
    for (int t = 0; t < 4; ++t) {
        const int i0 = 32 * t;
        bf16x8 qf[4];
        { const GAS v4u* qp = (const GAS v4u*)(QR + (size_t)(R0 + i0 + r) * 2048 + hq * 64 + 8 * hh);
#pragma unroll
          for (int ks = 0; ks < 4; ++ks) qf[ks] = __builtin_bit_cast(bf16x8, qp[2 * ks]); }
        f32x16 s[5];
#pragma unroll
        for (int x = 0; x < 5; ++x) {
            const int krow_ = 32 * (t + x) + r;
            f32x16 acc;
#pragma unroll
            for (int e = 0; e < 16; ++e) acc[e] = 0.f;
#pragma unroll
            for (int ks = 0; ks < 4; ++ks) { const bf16x8 a = *(LAS const bf16x8*)(Kt + krow_ * 128 + (((2 * ks + hh) ^ (krow_ & 7)) << 4)); acc = MFMA32(a, qf[ks], acc); }
            s[x] = acc; __builtin_amdgcn_sched_barrier(0);
        }
        float m = sk;
#pragma unroll
        for (int e = 0; e < 16; ++e) { const int cr = crow32(e, hh);
            if (!(cr > r)) s[0][e] = -1.0e30f;
            if (!(cr <= r)) s[4][e] = -1.0e30f; }
        if (j == 0) {
#pragma unroll
            for (int x = 0; x < 4; ++x) if (t + x <= 3) {
#pragma unroll
                for (int e = 0; e < 16; ++e) if (32 * (t + x) + crow32(e, hh) < 112) s[x][e] = -1.0e30f; }
        }
#pragma unroll
        for (int x = 0; x < 5; ++x)
#pragma unroll
            for (int e = 0; e < 16; ++e) m = fmaxf(m, s[x][e]);
        m = fmaxf(m, __shfl_xor(m, 32));
        float l = 0.f;
#pragma unroll
        for (int x = 0; x < 5; ++x)
#pragma unroll
            for (int e = 0; e < 16; ++e) { const float pv = exp2f(s[x][e] - m); s[x][e] = pv; l += pv; }
        l += __shfl_xor(l, 32);
        l += exp2f(sk - m);
        f32x16 o[2];
#pragma unroll
        for (int e = 0; e < 16; ++e) { o[0][e] = 0.f; o[1][e] = 0.f; }
#pragma unroll
        for (int x = 0; x < 5; ++x)
#pragma unroll
            for (int st = 0; st < 2; ++st) {
                v4u w; w.x = cvtpk_s(s[x][8 * st + 0], s[x][8 * st + 1]); w.y = cvtpk_s(s[x][8 * st + 2], s[x][8 * st + 3]); w.z = cvtpk_s(s[x][8 * st + 4], s[x][8 * st + 5]); w.w = cvtpk_s(s[x][8 * st + 6], s[x][8 * st + 7]);
                const bf16x8 pb = __builtin_bit_cast(bf16x8, w);
                const int k1 = 32 * (t + x) + 16 * st + 4 * hh + q, k2 = k1 + 8;
#pragma unroll
                for (int dc = 0; dc < 2; ++dc) {
                    const int cb = ((4 * dc + 2 * blk + (p4 >> 1)) << 4) + 8 * (p4 & 1);
                    const bf16x8 a = cat8(tr16(Vt + k1 * 128 + cb), tr16(Vt + k2 * 128 + cb));
                    o[dc] = MFMA32(a, pb, o[dc]);
                }
                __builtin_amdgcn_sched_barrier(0);
            }
        const float il = 1.0f / l;
        GAS v2u* op = (GAS v2u*)(QR + (size_t)(R0 + i0 + r) * 2048 + hq * 64 + 4 * hh);
#pragma unroll
        for (int dc = 0; dc < 2; ++dc)
#pragma unroll
            for (int g4 = 0; g4 < 4; ++g4) { v2u w; w.x = cvtpk_s(o[dc][4 * g4 + 0] * il, o[dc][4 * g4 + 1] * il); w.y = cvtpk_s(o[dc][4 * g4 + 2] * il, o[dc][4 * g4 + 3] * il); op[8 * dc + 2 * g4] = w; }
    }
    __syncthreads();
}

__device__ __forceinline__ unsigned ord_key(float f) { const unsigned u = __float_as_uint(f); return u ^ ((unsigned)((int)u >> 31) | 0x80000000u); }
__device__ __forceinline__ float ord_val(unsigned k) { return __uint_as_float(k ^ (((int)k < 0) ? 0x80000000u : 0xffffffffu)); }
__device__ __forceinline__ unsigned umed3(unsigned a, unsigned b, unsigned c) { unsigned r; asm("v_med3_u32 %0, %1, %2, %3" : "=v"(r) : "v"(a), "v"(b), "v"(c)); return r; }
#define TK_INS(arr, val) do { const unsigned v_ = (val); _Pragma("unroll") for (int j_ = 15; j_ >= 1; --j_) arr[j_] = umed3(arr[j_ - 1], arr[j_], v_); arr[0] = arr[0] > v_ ? arr[0] : v_; } while (0)
__device__ __forceinline__ void topk_unit(LAS unsigned* Lw, LAS const unsigned char* Lsk, int tt, int hd, const bf16* Q3, unsigned short* IDS, float* GATES, int lane) {
    asm volatile("" : "+v"(lane));
    const int r = lane & 31, hh = lane >> 5, t0 = tt * 32;
    float sv[2][16];
#pragma unroll
    for (int p = 0; p < 2; ++p) {
        f32x16 acc[4];
#pragma unroll
        for (int nt = 0; nt < 4; ++nt)
#pragma unroll
            for (int e = 0; e < 16; ++e) acc[nt][e] = 0.f;
        const GAS v4u* qp = (const GAS v4u*)(Q3 + (size_t)(t0 + r) * DM + hd * 256 + p * 128 + 8 * hh);
        bf16x8 bq[8];
#pragma unroll
        for (int ks = 0; ks < 8; ++ks) bq[ks] = __builtin_bit_cast(bf16x8, qp[2 * ks]);
#pragma unroll
        for (int ks = 0; ks < 8; ++ks) {
#pragma unroll
            for (int nt = 0; nt < 4; ++nt) { const bf16x8 a = *(LAS const bf16x8*)(Lsk + p * 32768 + (32 * nt + r) * 256 + (((2 * ks + hh) ^ (r & 15)) << 4)); acc[nt] = MFMA32(a, bq[ks], acc[nt]); } }
        unsigned tk[16];
#pragma unroll
        for (int j2 = 0; j2 < 16; ++j2) tk[j2] = 0u;
#pragma unroll
        for (int nt = 0; nt < 4; ++nt)
#pragma unroll
            for (int e = 0; e < 16; ++e) { const int n = 32 * nt + crow32(e, hh); TK_INS(tk, (ord_key(acc[nt][e]) & 0xffffff80u) | (unsigned)(127 - n)); }
        unsigned pk[16];
#pragma unroll
        for (int j2 = 0; j2 < 16; ++j2) pk[j2] = (unsigned)__shfl_xor((int)tk[j2], 32);
#pragma unroll
        for (int j2 = 0; j2 < 16; ++j2) TK_INS(tk, pk[j2]);
#pragma unroll
        for (int j2 = 0; j2 < 16; ++j2) { sv[p][j2] = ord_val(tk[j2] & 0xffffff80u); Lw[(p * 16 + j2) * 64 + lane] = 127u - (tk[j2] & 0x7fu); }
    }
    unsigned fk[16];
#pragma unroll
    for (int j2 = 0; j2 < 16; ++j2) fk[j2] = 0u;
#pragma unroll
    for (int i = 0; i < 16; ++i)
#pragma unroll
        for (int j2 = 0; j2 < 16; ++j2) if ((i + 1) * (j2 + 1) <= 16) TK_INS(fk, (ord_key(sv[0][i] + sv[1][j2]) & 0xffffff00u) | (unsigned)(255 - (16 * i + j2)));
    float ev[16]; int idv[16]; float den = 0.f; const float f0 = ord_val(fk[0] & 0xffffff00u);
    LDS_WAIT();
#pragma unroll
    for (int k = 0; k < 16; ++k) { const unsigned idx = 255u - (fk[k] & 0xffu); const unsigned i1 = Lw[(idx >> 4) * 64 + lane], i2 = Lw[(16 + (idx & 15u)) * 64 + lane];
        idv[k] = (int)(i1 * 128u + i2); ev[k] = __expf(ord_val(fk[k] & 0xffffff00u) - f0); den += ev[k]; }
    const float iden = 1.0f / den;
    if (hh == 0) {
        GAS v4u* ip = (GAS v4u*)(IDS + (size_t)(t0 + r) * 128 + hd * 16); GAS f32x4* gp = (GAS f32x4*)(GATES + (size_t)(t0 + r) * 128 + hd * 16);
#pragma unroll
        for (int k8 = 0; k8 < 2; ++k8) ip[k8] = (v4u){(unsigned)idv[8 * k8] | ((unsigned)idv[8 * k8 + 1] << 16), (unsigned)idv[8 * k8 + 2] | ((unsigned)idv[8 * k8 + 3] << 16), (unsigned)idv[8 * k8 + 4] | ((unsigned)idv[8 * k8 + 5] << 16), (unsigned)idv[8 * k8 + 6] | ((unsigned)idv[8 * k8 + 7] << 16)};
#pragma unroll
        for (int k4 = 0; k4 < 4; ++k4) gp[k4] = (f32x4){ev[4 * k4] * iden, ev[4 * k4 + 1] * iden, ev[4 * k4 + 2] * iden, ev[4 * k4 + 3] * iden};
    }
    LDS_WAIT();
}

__global__ void __launch_bounds__(NWAVES * 64, 2) mk_fwd(Args args) {
    extern __shared__ __attribute__((aligned(16))) unsigned char lds[];
    LAS unsigned char* L = (LAS unsigned char*)lds;
    volatile LAS unsigned* MISC = (volatile LAS unsigned*)(L + MISC_OFF);
    const int tid = threadIdx.x, lane = tid & 63, wave = __builtin_amdgcn_readfirstlane(tid >> 6);
    const int G = gridDim.x, bx = blockIdx.x;
    const int vcu = (G % 8 == 0) ? (bx % 8) * (G / 8) + bx / 8 : bx;
    unsigned char* ws = args.ws;
    gu32* ctl = (gu32*)(ws + WS_CTL);
    const float* x = args.in[0]; const float* meta = args.in[1]; const float* ln_in_g = args.in[2]; const float* ln_in_b = args.in[3];
    const float* w_in = args.in[4]; const float* sinks = args.in[5]; const float* w_out = args.in[6]; const float* ln_mix_g = args.in[7]; const float* ln_mix_b = args.in[8];
    const float* wq = args.in[9]; const float* subkeys = args.in[10]; const float* u_tab = args.in[11]; const float* v_tab = args.in[12];
    const float* ln_ffn_g = args.in[13]; const float* ln_ffn_b = args.in[14];
    float* out = args.out;
    bf16* W1T = (bf16*)(ws + WS_W1T); bf16* W2T = (bf16*)(ws + WS_W2T); bf16* W3T = (bf16*)(ws + WS_W3T);
    bf16* H0 = (bf16*)(ws + WS_H0); bf16* QR = (bf16*)(ws + WS_QR); bf16* KA = (bf16*)(ws + WS_KA); bf16* VA = (bf16*)(ws + WS_VA);
    bf16* RK = (bf16*)(ws + WS_RK); bf16* RV = (bf16*)(ws + WS_RV); bf16* RG = (bf16*)(ws + WS_RG);
    bf16* Y = (bf16*)(ws + WS_Y); bf16* H1 = (bf16*)(ws + WS_H1); bf16* Q3 = (bf16*)(ws + WS_QR);
    bf16* STB = (bf16*)(ws + WS_ST);
    f32x2* ROPE_R = (f32x2*)(ws + WS_ROPE_R); f32x2* ROPE_A = (f32x2*)(ws + WS_ROPE_A);
    unsigned short* IDS = (unsigned short*)(ws + WS_IDS); float* GATES = (float*)(ws + WS_GATES);
    bf16* SKB = (bf16*)(ws + WS_SK);
    bf16* UT = (bf16*)(ws + WS_UT); bf16* VT = (bf16*)(ws + WS_VT);

    for (int u = tid; u < (LDS_BYTES - LDSCTL_OFF) / 4; u += NWAVES * 64) ((LAS unsigned*)(L + LDSCTL_OFF))[u] = 0u;
    __syncthreads();
    XcdBarrier bar; bar.bar = (unsigned*)(ctl + CW_BAR); bar.x = xb_xcc_id(); bar.st = MISC + 8;
    if (tid == 0) MISC[10] = xb_add(&bar.bar[XB_XCNT(bar.x)], 1u);
#define GRID_BAR() xcd_barrier(bar)
    const int gw = vcu * NWAVES + wave, NGW = G * NWAVES;
    const int gt = gw * 64 + lane, NGT = NGW * 64;

    {
        LAS float* scr = (LAS float*)(L + RING_OFF + wave * 16384);
        constexpr int I_1 = (DM / 64) * (IN_COLS / 32), I_2 = (DM / 64) * (DM / 32), I_3 = I_2;
        for (int it = gw; it < I_1 + I_2 + I_3; it += NGW) {
            int r = it;
            if (r < I_1) { p0_transpose_item<true>(w_in, DM, IN_COLS, W1T, scr, r, lane); continue; } r -= I_1;
            if (r < I_2) { p0_transpose_item<false>(w_out, DM, DM, W2T, scr, r, lane); continue; } r -= I_2;
            p0_transpose_item<false>(wq, DM, DM, W3T, scr, r, lane);
        }
        for (int m = gw; m < MROWS; m += NGW) {
            if (m < NTOK) ln_row_f32_to_bf16(x + (size_t)m * DM, ln_in_g, ln_in_b, H0 + (size_t)m * DM, lane);
            else if (m < NVALID) ln_row_f32_to_bf16(meta + (size_t)(m - NTOK) * DM, ln_in_g, ln_in_b, H0 + (size_t)m * DM, lane);
            else { GAS v4u* o = (GAS v4u*)(H0 + (size_t)m * DM) + lane;
#pragma unroll
                for (int j = 0; j < 4; ++j) o[64 * j] = (v4u){0u, 0u, 0u, 0u}; }
        }
        for (int e = gt; e < 16 * 128 * 128 / 8; e += NGT) { const GAS f32x4* src = (const GAS f32x4*)subkeys + 2 * (size_t)e; const f32x4 a = src[0], b2 = src[1];
            v4u o; o.x = pk2(a.x, a.y); o.y = pk2(a.z, a.w); o.z = pk2(b2.x, b2.y); o.w = pk2(b2.z, b2.w); ((GAS v4u*)SKB)[e] = o; }
        for (int e = gt; e < 4112 * 128; e += NGT) { const int pos = e >> 7, i = e & 127; const float inv = powf(10000.0f, -(float)(2 * i) / 256.0f); float sn, cs; sincosf((float)pos * inv, &sn, &cs); ROPE_R[e] = (f32x2){cs, sn}; }
        for (int e = gt; e < 4112 * 32; e += NGT) { const int pos = e >> 5, i = e & 31; const float inv = powf(10000.0f, -(float)(2 * i) / 64.0f); float sn, cs; sincosf((float)pos * inv, &sn, &cs); ROPE_A[e] = (f32x2){cs, sn}; }
    }
    GRID_BAR();

    {
        pg8::Gemm g{H0, W1T, MROWS, IN_COLS, DM}; pg8::StaticOrder S; S.init(MROWS, IN_COLS, G, bx);
        pg8::EpiProj E{QR, KA, VA, RK, RV, RG, (const float*)ROPE_R, (const float*)ROPE_A, QSCALE};
        pg8::gemm_phase<pg8::EpiProj, pg8::StaticOrder, true, true>(L + RING_OFF, g, S, E);
    }
    {
        constexpr int NQ = 16384 * DM / 4, CHQ = 16384, NCH = 2 * NQ / CHQ;
        for (;;) {
            int ch = 0; if (lane == 0) ch = (int)__hip_atomic_fetch_add((unsigned*)(ctl + CW_TABQ), 1u, __ATOMIC_RELAXED, __HIP_MEMORY_SCOPE_AGENT);
            ch = __builtin_amdgcn_readfirstlane(ch); if (ch >= NCH) break;
            const int which = ch >= NCH / 2; const float sc = which ? V_SCALE : U_SCALE;
            const GAS f32x4* src = (const GAS f32x4*)(which ? v_tab : u_tab) + (size_t)(ch - which * (NCH / 2)) * CHQ + lane;
            GAS unsigned char* dstb = (GAS unsigned char*)(which ? (void*)VT : (void*)UT);
            const int i4b = (ch - which * (NCH / 2)) * CHQ + lane;
#pragma unroll 1
            for (int it = 0; it < CHQ / 64; it += 8) {
                f32x4 a[8];
#pragma unroll
                for (int u8 = 0; u8 < 8; ++u8) a[u8] = src[(it + u8) * 64];
#pragma unroll
                for (int u8 = 0; u8 < 8; ++u8) { const int i4 = i4b + (it + u8) * 64; const int row = i4 >> 9, q4 = i4 & 511;
                    int w = __builtin_amdgcn_cvt_pk_fp8_f32(a[u8].x * sc, a[u8].y * sc, 0, false); w = __builtin_amdgcn_cvt_pk_fp8_f32(a[u8].z * sc, a[u8].w * sc, w, true);
                    *(GAS unsigned*)(dstb + ((size_t)(q4 >> 5) * 16384 + row) * 128 + (q4 & 31) * 4) = (unsigned)w; }
            }
        }
    }
    GRID_BAR();

    for (int u = bx; u < 256; u += G) attn_unit(L + RING_OFF, u, QR, KA, VA, sinks, tid, lane, wave);

    for (int u = bx; u < 256; u += G) scan_unit(L + RING_OFF, u, RK, RV, STB, tid, lane, wave);
    GRID_BAR();

    for (int u = bx; u < 512; u += G) retout_unit(L + RING_OFF, u, QR, RK, RV, RG, STB, tid, lane, wave);
    GRID_BAR();

    {
        pg8::Gemm g{QR, W2T, NTOK, DM, DM}; pg8::StaticOrder S; S.init(NTOK, DM, G, bx);
        pg8::EpiGen<1> E{Y, DM, H0, ALPHA, nullptr, nullptr, nullptr, nullptr, nullptr, nullptr};
        pg8::gemm_phase<pg8::EpiGen<1>, pg8::StaticOrder, true, true>(L + RING_OFF, g, S, E);
    }
    GRID_BAR();

    for (int m = gw; m < NTOK; m += NGW) ln_row_bf16_to_bf16(Y + (size_t)m * DM, ln_mix_g, ln_mix_b, H1 + (size_t)m * DM, lane);
    GRID_BAR();

    {
        pg8::Gemm g{H1, W3T, NTOK, DM, DM}; pg8::StaticOrder S; S.init(NTOK, DM, G, bx);
        pg8::EpiGen<2> E{Q3, DM, nullptr, 0.f, nullptr, nullptr, nullptr, nullptr, nullptr, nullptr};
        pg8::gemm_phase<pg8::EpiGen<2>, pg8::StaticOrder, true, true>(L + RING_OFF, g, S, E);
    }
    GRID_BAR();

    const bool g8 = (G & 7) == 0; const int nbh = g8 ? (G >> 3) : G, hb = g8 ? (bx >> 3) : bx;
    for (int hd = g8 ? (bx & 7) : 0; hd < 8; hd += g8 ? 8 : 1) {
        __syncthreads();
#pragma unroll
        for (int i = 0; i < 8; ++i) { const int cid = tid + 512 * i, p = cid >> 11, n = (cid >> 4) & 127, ch = cid & 15;
            *(LAS v4u*)(L + RING_OFF + p * 32768 + n * 256 + ((ch ^ (n & 15)) << 4)) = *(const GAS v4u*)(SKB + ((size_t)((hd * 2 + p) * 128 + n)) * 128 + ch * 8); }
        __syncthreads();
        for (int tt = hb * NWAVES + wave; tt < NTOK / 32; tt += nbh * NWAVES) topk_unit((LAS unsigned*)(L + RING_OFF + 65536 + wave * 8192), L + RING_OFF, tt, hd, Q3, IDS, GATES, lane);
    }
    __syncthreads();
    GRID_BAR();

    int nx = 0, xr = 0, nloc = 1;
    { unsigned* bw = (unsigned*)(ctl + CW_BAR);
#pragma unroll
      for (unsigned j2 = 0; j2 < 16; ++j2) { const unsigned cnt = xb_ld(&bw[XB_XCNT(j2)]); nx += cnt > 0u; xr += (j2 < bar.x && cnt > 0u); if (j2 == bar.x) nloc = (int)cnt; }
      nx = __builtin_amdgcn_readfirstlane(nx); xr = __builtin_amdgcn_readfirstlane(xr); nloc = __builtin_amdgcn_readfirstlane(nloc); if (nx < 1) nx = 1; if (nloc < 1) nloc = 1; }
    const int lrank = __builtin_amdgcn_readfirstlane((int)MISC[10]);
    const int wv = lrank * NWAVES + wave, nwv = nloc * NWAVES;
    float* DOTX = (float*)(ws + WS_RK);
    bf16* CB = (bf16*)(ws + WS_KA);
    float* Y32 = (float*)(ws + WS_H0);
    {
        int tl = tid; asm volatile("" : "+v"(tl)); const int ln = tl & 63, k = ln >> 3, c8 = ln & 7;
        const unsigned char* UT8 = (const unsigned char*)UT;
        for (int s = xr; s < NSL; s += nx) {
            const unsigned char* Us = UT8 + (size_t)s * 16384 * 128;
            const bool first = (s == xr);
            v4u nid[2][2];
#pragma unroll
            for (int z = 0; z < 2; ++z) { const int tz = wv + z * nwv; const int tc = tz < NTOK ? tz : wv; const GAS v4u* ip = (const GAS v4u*)(IDS + (size_t)tc * 128 + 16 * k);
#pragma unroll
                for (int i = 0; i < 2; ++i) nid[z][i] = ip[i]; }
#pragma unroll 1
            for (int t = wv; t < NTOK; t += 2 * nwv) {
                const bool vB = (t + nwv) < NTOK; const int tt[2] = {t, vB ? t + nwv : t};
                v4u ub[2][16]; v4u hs[2][2]; f32x2 old[2];
#pragma unroll
                for (int z = 0; z < 2; ++z) {
#pragma unroll
                    for (int i = 0; i < 16; ++i) { const int pe = 2 * (i & 7) + (i >> 3); const unsigned eid = (nid[z][pe >> 3][(pe >> 1) & 3] >> (16 * (pe & 1))) & 0xffffu; ub[z][i] = *(const GAS v4u*)(Us + (size_t)eid * 128 + 16 * c8); }
                    { const GAS v4u* hp = (const GAS v4u*)(H1 + (size_t)tt[z] * DM + 128 * s + 16 * c8); hs[z][0] = hp[0]; hs[z][1] = hp[1]; } }
#pragma unroll
                for (int z = 0; z < 2; ++z) old[z] = first ? (f32x2){0.f, 0.f} : *(const GAS f32x2*)(DOTX + ((size_t)xr * NTOK + tt[z]) * 128 + 2 * ln);
#pragma unroll
                for (int z = 0; z < 2; ++z) { const int tz = t + (2 + z) * nwv; const int tc = tz < NTOK ? tz : t; const GAS v4u* ip = (const GAS v4u*)(IDS + (size_t)tc * 128 + 16 * k);
#pragma unroll
                    for (int i = 0; i < 2; ++i) nid[z][i] = ip[i]; }
#pragma unroll
                for (int z = 0; z < 2; ++z) {
                    float p[16]; f32x2 hp2[8];
#pragma unroll
                    for (int i = 0; i < 2; ++i)
#pragma unroll
                        for (int c4 = 0; c4 < 4; ++c4) hp2[4 * i + c4] = (f32x2){bflo(hs[z][i][c4]), bfhi(hs[z][i][c4])};
#pragma unroll
                    for (int i = 0; i < 16; ++i) { f32x2 d2 = {0.f, 0.f};
#pragma unroll
                        for (int dw = 0; dw < 4; ++dw) { const f32x2 fl = __builtin_amdgcn_cvt_pk_f32_fp8((int)ub[z][i][dw], false), fh = __builtin_amdgcn_cvt_pk_f32_fp8((int)ub[z][i][dw], true);
                            d2 = __builtin_elementwise_fma(fl, hp2[2 * dw], d2); d2 = __builtin_elementwise_fma(fh, hp2[2 * dw + 1], d2); }
                        p[i] = d2.x + d2.y; }
                    const bool b0 = (c8 & 1) != 0, b1 = (c8 & 2) != 0, b2 = (c8 & 4) != 0;
                    float r1[8], r2[4], q0, q1;
#pragma unroll
                    for (int m = 0; m < 8; ++m) { const float keep = b0 ? p[2 * m + 1] : p[2 * m], give = b0 ? p[2 * m] : p[2 * m + 1]; r1[m] = keep + DPPF(give, 0xB1); }
#pragma unroll
                    for (int m = 0; m < 4; ++m) { const float keep = b1 ? r1[2 * m + 1] : r1[2 * m], give = b1 ? r1[2 * m] : r1[2 * m + 1]; r2[m] = keep + DPPF(give, 0x4E); }
                    { const float keep = b2 ? r2[1] : r2[0], give = b2 ? r2[0] : r2[1]; const float gl = DPPF(give, 0x104), gr = DPPF(give, 0x114); q0 = keep + (b2 ? gr : gl); }
                    { const float keep = b2 ? r2[3] : r2[2], give = b2 ? r2[2] : r2[3]; const float gl = DPPF(give, 0x104), gr = DPPF(give, 0x114); q1 = keep + (b2 ? gr : gl); }
                    if (z == 0 || vB) *(GAS f32x2*)(DOTX + ((size_t)xr * NTOK + tt[z]) * 128 + 2 * ln) = (f32x2){q0 + old[z].x, q1 + old[z].y};
                }
            }
        }
    }
    GRID_BAR();
    for (int idx = gt; idx < NTOK * 128; idx += NGT) { float d = 0.f; for (int xx = 0; xx < nx; ++xx) d += DOTX[(size_t)xx * NTOK * 128 + idx]; CB[idx] = (bf16)f2bf((1.0f / V_SCALE) * GATES[idx] * gelu_erf(d * (1.0f / U_SCALE))); }
    GRID_BAR();
    {
        int tl = tid; asm volatile("" : "+v"(tl)); const int ln = tl & 63, k = ln >> 3, c8 = ln & 7;
        const unsigned char* VT8 = (const unsigned char*)VT;
        for (int s = xr; s < NSL; s += nx) {
            const unsigned char* Vs = VT8 + (size_t)s * 16384 * 128;
            v4u nid[2][2];
#pragma unroll
            for (int z = 0; z < 2; ++z) { const int tz = wv + z * nwv; const int tc = tz < NTOK ? tz : wv; const GAS v4u* ip = (const GAS v4u*)(IDS + (size_t)tc * 128 + 16 * k);
#pragma unroll
                for (int i = 0; i < 2; ++i) nid[z][i] = ip[i]; }
#pragma unroll 1
            for (int t = wv; t < NTOK; t += 2 * nwv) {
                const bool vB = (t + nwv) < NTOK; const int tt[2] = {t, vB ? t + nwv : t};
                v4u vb[2][16]; v4u cf[2][2]; unsigned hs[2];
#pragma unroll
                for (int z = 0; z < 2; ++z) {
#pragma unroll
                    for (int i = 0; i < 16; ++i) { const unsigned eid = (nid[z][i >> 3][(i >> 1) & 3] >> (16 * (i & 1))) & 0xffffu; vb[z][i] = *(const GAS v4u*)(Vs + (size_t)eid * 128 + 16 * c8); } }
#pragma unroll
                for (int z = 0; z < 2; ++z) { hs[z] = *(const GAS unsigned*)(H1 + (size_t)tt[z] * DM + 128 * s + 16 * c8 + 2 * k);
                    const GAS v4u* cp = (const GAS v4u*)(CB + (size_t)tt[z] * 128 + 16 * k); cf[z][0] = cp[0]; cf[z][1] = cp[1]; }
#pragma unroll
                for (int z = 0; z < 2; ++z) { const int tz = t + (2 + z) * nwv; const int tc = tz < NTOK ? tz : t; const GAS v4u* ip = (const GAS v4u*)(IDS + (size_t)tc * 128 + 16 * k);
#pragma unroll
                    for (int i = 0; i < 2; ++i) nid[z][i] = ip[i]; }
#pragma unroll
                for (int z = 0; z < 2; ++z) {
                    f32x2 accp[8];
#pragma unroll
                    for (int q2 = 0; q2 < 8; ++q2) accp[q2] = (f32x2){0.f, 0.f};
#pragma unroll
                    for (int i = 0; i < 16; ++i) { const unsigned cw = cf[z][i >> 3][(i >> 1) & 3]; const float c = (i & 1) ? bfhi(cw) : bflo(cw); const f32x2 c2 = {c, c};
#pragma unroll
                        for (int dw = 0; dw < 4; ++dw) { const f32x2 fl = __builtin_amdgcn_cvt_pk_f32_fp8((int)vb[z][i][dw], false), fh = __builtin_amdgcn_cvt_pk_f32_fp8((int)vb[z][i][dw], true);
                            accp[2 * dw] = __builtin_elementwise_fma(fl, c2, accp[2 * dw]); accp[2 * dw + 1] = __builtin_elementwise_fma(fh, c2, accp[2 * dw + 1]); } }
                    const bool kb0 = (k & 1) != 0, kb1 = (k & 2) != 0, kb2 = (k & 4) != 0;
                    f32x2 rA[4], rB[2], rC;
#pragma unroll
                    for (int m = 0; m < 4; ++m) { const f32x2 keep = kb0 ? accp[2 * m + 1] : accp[2 * m], give = kb0 ? accp[2 * m] : accp[2 * m + 1];
                        rA[m] = keep + (f32x2){DPPF(give.x, 0x128), DPPF(give.y, 0x128)}; }
#pragma unroll
                    for (int m = 0; m < 2; ++m) { const f32x2 keep = kb1 ? rA[2 * m + 1] : rA[2 * m], give = kb1 ? rA[2 * m] : rA[2 * m + 1];
                        const auto sx = __builtin_amdgcn_permlane16_swap(__float_as_uint(give.x), __float_as_uint(give.x), false, false), sy = __builtin_amdgcn_permlane16_swap(__float_as_uint(give.y), __float_as_uint(give.y), false, false);
                        rB[m] = keep + (f32x2){__uint_as_float(kb1 ? sx[0] : sx[1]), __uint_as_float(kb1 ? sy[0] : sy[1])}; }
                    { const f32x2 keep = kb2 ? rB[1] : rB[0], give = kb2 ? rB[0] : rB[1];
                        const auto sx = __builtin_amdgcn_permlane32_swap(__float_as_uint(give.x), __float_as_uint(give.x), false, false), sy = __builtin_amdgcn_permlane32_swap(__float_as_uint(give.y), __float_as_uint(give.y), false, false);
                        rC = keep + (f32x2){__uint_as_float(kb2 ? sx[0] : sx[1]), __uint_as_float(kb2 ? sy[0] : sy[1])}; }
                    if (z == 0 || vB) *(GAS f32x2*)(Y32 + (size_t)tt[z] * DM + 128 * s + 16 * c8 + 2 * k) = (f32x2){rC.x + ALPHA * bflo(hs[z]), rC.y + ALPHA * bfhi(hs[z])};
                }
            }
        }
    }
    GRID_BAR();
    for (int m = gw; m < NTOK; m += NGW) {
        const GAS f32x4* xr4 = (const GAS f32x4*)(Y32 + (size_t)m * DM) + lane;
        f32x4 v[8]; float sm = 0.f;
#pragma unroll
        for (int j2 = 0; j2 < 8; ++j2) { v[j2] = xr4[64 * j2]; sm += (v[j2].x + v[j2].y) + (v[j2].z + v[j2].w); }
        const float mean = wave_sum(sm) * (1.f / DM); float s2 = 0.f;
#pragma unroll
        for (int j2 = 0; j2 < 8; ++j2) { v[j2] = v[j2] - mean; s2 += (v[j2].x * v[j2].x + v[j2].y * v[j2].y) + (v[j2].z * v[j2].z + v[j2].w * v[j2].w); }
        const float rstd = 1.f / sqrtf(wave_sum(s2) * (1.f / DM) + LN_EPS);
        GAS f32x4* op = (GAS f32x4*)(out + (size_t)m * DM) + lane;
#pragma unroll
        for (int j2 = 0; j2 < 8; ++j2) { const f32x4 gg = ((const GAS f32x4*)ln_ffn_g)[lane + 64 * j2], bb = ((const GAS f32x4*)ln_ffn_b)[lane + 64 * j2];
            op[64 * j2] = (f32x4){v[j2].x * rstd * gg.x + bb.x, v[j2].y * rstd * gg.y + bb.y, v[j2].z * rstd * gg.z + bb.z, v[j2].w * rstd * gg.w + bb.w}; }
    }
}

extern "C" void kernel_launch(void* const* d_in, const int* in_sizes, int n_in, void* d_out, int out_size, void* d_ws, size_t ws_size, hipStream_t stream) {
    static int grid = 0;
    if (grid == 0) {
        if (n_in != 15 || out_size != NTOK * DM || ws_size < WS_END) { fprintf(stderr, "kernel_launch: unexpected shapes (n_in %d out %d ws %zu)\n", n_in, out_size, ws_size); grid = -1; return; }
        int dev = 0, cus = 0, per_cu = 0;
        if (hipGetDevice(&dev) != hipSuccess || hipDeviceGetAttribute(&cus, hipDeviceAttributeMultiprocessorCount, dev) != hipSuccess) { grid = -1; return; }
        if (hipFuncSetAttribute((const void*)mk_fwd, hipFuncAttributeMaxDynamicSharedMemorySize, LDS_BYTES) != hipSuccess) { fprintf(stderr, "kernel_launch: hipFuncSetAttribute failed\n"); grid = -1; return; }
        if (hipOccupancyMaxActiveBlocksPerMultiprocessor(&per_cu, (const void*)mk_fwd, NWAVES * 64, LDS_BYTES) != hipSuccess || per_cu < 1) { fprintf(stderr, "kernel_launch: occupancy query says %d\n", per_cu); }
        (void)hipGetLastError();
        grid = cus;
    }
    if (grid < 0) return;
    if (hipMemsetAsync((char*)d_ws + WS_CTL, 0, CTL_ZERO_BYTES, stream) != hipSuccess) return;
    Args a{};
    for (int i = 0; i < 15; ++i) a.in[i] = (const float*)d_in[i];
    a.out = (float*)d_out; a.ws = (unsigned char*)d_ws;
    hipLaunchKernelGGL(mk_fwd, dim3(grid), dim3(NWAVES * 64), LDS_BYTES, stream, a);
}
```

```cpp
#include <hip/hip_runtime.h>
#include <cstdio>
#include <cstdint>
#include <cmath>
namespace pg8 {
#define PG8_LAS __attribute__((address_space(3)))
typedef unsigned short bf16_t;
typedef short bf16x8 __attribute__((ext_vector_type(8)));
typedef float f32x4 __attribute__((ext_vector_type(4)));
typedef unsigned u32x4 __attribute__((ext_vector_type(4)));
constexpr int BM = 256, BK = 64, HALF = 128, HTB = HALF * BK * 2  , STAGE_BYTES = 8 * HTB, NXCD = 8, WGM = 8;

__host__ __device__ __forceinline__ int lds_byte(int r, int c) { const int st = (r >> 4) * 2 + (c >> 5), rr = r & 15, cc = c & 31, ob = rr * 64 + cc * 2; return st * 1024 + (ob ^ (((ob >> 9) & 1) << 5)); }
__host__ __device__ __forceinline__ void stage_rc(int b, int& R, int& C) { const int st = b / 1024, sb = b % 1024, swz = sb ^ (((sb >> 9) & 1) << 5); R = (st >> 1) * 16 + swz / 64; C = (st & 1) * 32 + (swz % 64) / 2; }
__host__ __device__ __forceinline__ int perm32(int rho) { const int n = rho >> 4, i = rho & 15; return 8 * (i >> 2) + 4 * n + (i & 3); }

struct Unit { int pm, pn; };
struct Gemm { const bf16_t* A; const bf16_t* Bt; int M, N, K; };

struct StaticOrder {
    int nM, nN, nwg, G, c;
    __host__ __device__ void init(int M, int N, int G_, int c_) { nM = M / BM; nN = N / BM; nwg = nM * nN; G = G_; c = c_; }
    __host__ __device__ bool next(int i, Unit& u) const {
        const long L = (long)i * G + c; if (L >= nwg) return false;
        int wgid = (int)L; { const int q = nwg / NXCD, r = nwg % NXCD, xcd = wgid % NXCD, off = wgid / NXCD; wgid = (xcd < r ? xcd * (q + 1) : r * (q + 1) + (xcd - r) * q) + off; }
        const int nig = WGM * nN, gid = wgid / nig, fm = gid * WGM, gsz = (nM - fm) < WGM ? (nM - fm) : WGM;
        u.pm = fm + ((wgid % nig) % gsz); u.pn = (wgid % nig) / gsz; return true;
    }
    __device__ __forceinline__ void a_ready(const Unit&) const {}
    __device__ __forceinline__ void done(const Unit&) const {}
};

__device__ __forceinline__ unsigned cvt_pk_bf16(float lo, float hi) { unsigned r; asm volatile("v_cvt_pk_bf16_f32 %0, %1, %2" : "=v"(r) : "v"(lo), "v"(hi)); return r; }
typedef float f32x2 __attribute__((ext_vector_type(2)));

template <int MODE> struct EpiGen {
    static constexpr bool PERM = true, AFTER_DRAIN = false;
    bf16_t* O; int ldc; const bf16_t* R; float alpha;
    bf16_t *QR, *KA, *VA, *RK, *RV, *RG;
    __device__ __forceinline__ void operator()(const f32x4 (&acc)[2][2][4][2], const Unit& u, int wr, int wc, int fr, int fq) const {
        const int row0 = u.pm * BM + wr * 64 + fr;
#pragma unroll
        for (int bj = 0; bj < 2; ++bj) {
            const int col = u.pn * BM + bj * HALF + wc * 32 + 8 * fq;
            bf16_t* base = O; int ld = ldc; int cc = col;
            if (MODE == 0) {
                if (col < 1024)      { base = QR; ld = 2048; cc = col; }
                else if (col < 1152) { base = KA; ld = 128;  cc = col - 1024; }
                else if (col < 1280) { base = VA; ld = 128;  cc = col - 1152; }
                else if (col < 2304) { base = QR; ld = 2048; cc = col - 1280 + 1024; }
                else if (col < 3328) { base = RK; ld = 1024; cc = col - 2304; }
                else if (col < 4352) { base = RV; ld = 1024; cc = col - 3328; }
                else                 { base = RG; ld = 1024; cc = col - 4352; }
            }
#pragma unroll
            for (int ai = 0; ai < 2; ++ai)
#pragma unroll
                for (int m = 0; m < 4; ++m) {
                    const int row = row0 + ai * HALF + m * 16;
                    f32x4 v0 = acc[ai][bj][m][0], v1 = acc[ai][bj][m][1];
                    if (MODE == 1) {
                        const u32x4 r = *(const u32x4*)(R + (size_t)row * ldc + col);
                        v0[0] += alpha * __uint_as_float(r.x << 16); v0[1] += alpha * __uint_as_float(r.x & 0xffff0000u);
                        v0[2] += alpha * __uint_as_float(r.y << 16); v0[3] += alpha * __uint_as_float(r.y & 0xffff0000u);
                        v1[0] += alpha * __uint_as_float(r.z << 16); v1[1] += alpha * __uint_as_float(r.z & 0xffff0000u);
                        v1[2] += alpha * __uint_as_float(r.w << 16); v1[3] += alpha * __uint_as_float(r.w & 0xffff0000u);
                    }
                    u32x4 w; w.x = cvt_pk_bf16(v0[0], v0[1]); w.y = cvt_pk_bf16(v0[2], v0[3]); w.z = cvt_pk_bf16(v1[0], v1[1]); w.w = cvt_pk_bf16(v1[2], v1[3]);
                    *(u32x4*)(base + (size_t)row * ld + cc) = w;
                }
        }
    }
};

struct EpiProj {
    static constexpr bool PERM = true, AFTER_DRAIN = false;
    bf16_t *QR, *KA, *VA, *RK, *RV, *RG; const float* ropeR; const float* ropeA; float qscale;
    __device__ __forceinline__ void operator()(const f32x4 (&acc)[2][2][4][2], const Unit& u, int wr, int wc, int fr, int fq) const {
        const int pn = u.pn, row0 = u.pm * BM + wr * 64 + fr, c0 = wc * 32 + 8 * fq;
        const bool rope = (pn <= 3) || (pn == 4 && wc < 2) || (pn >= 5 && pn <= 12);
        if (rope) {
            const bool ret = pn >= 5; const int h = ret ? ((pn - 5) & 3) : 0;
            const float lg = __builtin_amdgcn_logf(1.0f - __builtin_amdgcn_exp2f(-5.0f - (float)h));
            bf16_t* base; int ld, cA, cB;
            if (pn <= 3)      { base = QR; ld = 2048; cA = pn * 256 + 64 * wc + 8 * fq; cB = cA + 32; }
            else if (pn == 4) { base = KA; ld = 128;  cA = 64 * wc + 8 * fq; cB = cA + 32; }
            else if (pn <= 8) { base = QR; ld = 2048; cA = 1024 + 256 * h + c0; cB = cA + 128; }
            else              { base = RK; ld = 1024; cA = 256 * h + c0; cB = cA + 128; }
#pragma unroll
            for (int ai = 0; ai < 2; ++ai)
#pragma unroll
                for (int m = 0; m < 4; ++m) {
                    const int row = row0 + ai * HALF + m * 16;
                    int pos, ipos;
                    if (row < 16384) { const int s = row & 4095; pos = 16 + s; ipos = s & 127; } else { int j = row - 16384; if (j > 15) j = 15; pos = j; ipos = 112 + j; }
                    float sc = qscale;
                    if (pn == 4) sc = 1.0f; else if (pn >= 9) sc = 0.0625f * __builtin_amdgcn_exp2f(-(float)(ipos + 1) * lg); else if (pn >= 5) sc = __builtin_amdgcn_exp2f((float)(ipos + 1) * lg);
                    const float* tb = ret ? ropeR + ((size_t)pos * 128 + c0) * 2 : ropeA + ((size_t)pos * 32 + 8 * fq) * 2;
                    const f32x4 t0 = *(const f32x4*)tb, t1 = *(const f32x4*)(tb + 4), t2 = *(const f32x4*)(tb + 8), t3 = *(const f32x4*)(tb + 12);
                    const f32x4 a0 = acc[ai][0][m][0], a1 = acc[ai][0][m][1], b0 = acc[ai][1][m][0], b1 = acc[ai][1][m][1];
                    u32x4 wA, wB;
                    wA.x = cvt_pk_bf16((a0[0] * t0[0] - b0[0] * t0[1]) * sc, (a0[1] * t0[2] - b0[1] * t0[3]) * sc); wA.y = cvt_pk_bf16((a0[2] * t1[0] - b0[2] * t1[1]) * sc, (a0[3] * t1[2] - b0[3] * t1[3]) * sc);
                    wA.z = cvt_pk_bf16((a1[0] * t2[0] - b1[0] * t2[1]) * sc, (a1[1] * t2[2] - b1[1] * t2[3]) * sc); wA.w = cvt_pk_bf16((a1[2] * t3[0] - b1[2] * t3[1]) * sc, (a1[3] * t3[2] - b1[3] * t3[3]) * sc);
                    wB.x = cvt_pk_bf16((b0[0] * t0[0] + a0[0] * t0[1]) * sc, (b0[1] * t0[2] + a0[1] * t0[3]) * sc); wB.y = cvt_pk_bf16((b0[2] * t1[0] + a0[2] * t1[1]) * sc, (b0[3] * t1[2] + a0[3] * t1[3]) * sc);
                    wB.z = cvt_pk_bf16((b1[0] * t2[0] + a1[0] * t2[1]) * sc, (b1[1] * t2[2] + a1[1] * t2[3]) * sc); wB.w = cvt_pk_bf16((b1[2] * t3[0] + a1[2] * t3[1]) * sc, (b1[3] * t3[2] + a1[3] * t3[3]) * sc);
                    *(u32x4*)(base + (size_t)row * ld + cA) = wA; *(u32x4*)(base + (size_t)row * ld + cB) = wB;
                    if (m & 1) asm volatile("" ::: "memory");
                }
        } else {
            const bool silu = pn >= 17;
#pragma unroll
            for (int bj = 0; bj < 2; ++bj) {
                bf16_t* base; int ld, cc;
                if (pn == 4)       { base = VA; ld = 128;  cc = 64 * bj + 32 * (wc - 2) + 8 * fq; }
                else if (pn <= 16) { base = RV; ld = 1024; cc = 256 * (pn - 13) + 128 * bj + c0; }
                else               { base = RG; ld = 1024; cc = 256 * (pn - 17) + 128 * bj + c0; }
#pragma unroll
                for (int ai = 0; ai < 2; ++ai)
#pragma unroll
                    for (int m = 0; m < 4; ++m) {
                        const int row = row0 + ai * HALF + m * 16;
                        f32x4 v0 = acc[ai][bj][m][0], v1 = acc[ai][bj][m][1];
                        if (silu) {
#pragma unroll
                            for (int e = 0; e < 4; ++e) { v0[e] = v0[e] * __builtin_amdgcn_rcpf(1.0f + __builtin_amdgcn_exp2f(-1.4426950408889634f * v0[e])); v1[e] = v1[e] * __builtin_amdgcn_rcpf(1.0f + __builtin_amdgcn_exp2f(-1.4426950408889634f * v1[e])); } }
                        u32x4 w; w.x = cvt_pk_bf16(v0[0], v0[1]); w.y = cvt_pk_bf16(v0[2], v0[3]); w.z = cvt_pk_bf16(v1[0], v1[1]); w.w = cvt_pk_bf16(v1[2], v1[3]);
                        *(u32x4*)(base + (size_t)row * ld + cc) = w;
                    }
            }
        }
    }
};
template <class Epi, class Sched, bool ALIGN_EPI = false, bool SP2 = false>
__device__ __forceinline__ void gemm_phase(PG8_LAS unsigned char* lds, const Gemm g, const Sched& S, const Epi& E) {
    const int tid = threadIdx.x, wid = __builtin_amdgcn_readfirstlane(tid >> 6), lane = tid & 63, wr = wid >> 2, wc = wid & 3, fr = lane & 15, fq = lane >> 4;
    const int K = g.K, nt = K / BK;
    unsigned voffA[2], voffB[2];
#pragma unroll
    for (int i = 0; i < 2; ++i) { int R, C; stage_rc(tid * 16 + i * 8192, R, C); const int Rb = Epi::PERM ? ((R & ~31) + perm32(R & 31)) : R;
        voffA[i] = (unsigned)(R * K + C) * 2u; voffB[i] = (unsigned)(Rb * K + C) * 2u; }
    const size_t kstep = (size_t)(BK * 2);
    const size_t hstep = (size_t)HALF * K * 2;
    const size_t tstep = 2 * hstep;
    const unsigned ldsw = (unsigned)wid * 1024u;
    const int aoff = lds_byte(wr * 64 + fr, fq * 8), boff = lds_byte(wc * 32 + fr, fq * 8);
#define PG8_SA(b, h) (((b) * 2 + (h)) * HTB)
#define PG8_SB(b, h) ((4 + (b) * 2 + (h)) * HTB)
#define PG8_STAGE(bufoff, gbase, voff) do { _Pragma("unroll") for (int _i = 0; _i < 2; ++_i) \
        __builtin_amdgcn_global_load_lds((const unsigned*)((const char*)(gbase) + (voff)[_i]), (PG8_LAS unsigned*)(lds + (bufoff) + ldsw + _i * 8192), 16, 0, 0); } while (0)
#define PG8_LDA(dst, b, h) do { _Pragma("unroll") for (int m = 0; m < 4; ++m) _Pragma("unroll") for (int k = 0; k < 2; ++k) dst[m][k] = *(const PG8_LAS bf16x8*)(lds + PG8_SA(b, h) + aoff + m * 2048 + k * 1024); } while (0)
#define PG8_LDB(dst, b, h) do { _Pragma("unroll") for (int n = 0; n < 2; ++n) _Pragma("unroll") for (int k = 0; k < 2; ++k) dst[n][k] = *(const PG8_LAS bf16x8*)(lds + PG8_SB(b, h) + boff + n * 2048 + k * 1024); } while (0)
#define PG8_MMA(ai, bj, At, Bt) do { __builtin_amdgcn_s_setprio(1); _Pragma("unroll") for (int m = 0; m < 4; ++m) _Pragma("unroll") for (int n = 0; n < 2; ++n) _Pragma("unroll") for (int k = 0; k < 2; ++k) \
        acc[ai][bj][m][n] = __builtin_amdgcn_mfma_f32_16x16x32_bf16(Bt[n][k], At[m][k], acc[ai][bj][m][n], 0, 0, 0); __builtin_amdgcn_s_setprio(0); } while (0)
#define PG8_WAIT_V(n) asm volatile("s_waitcnt vmcnt(" #n ")" ::: "memory")
#define PG8_WAIT_L(n) asm volatile("s_waitcnt lgkmcnt(" #n ")" ::: "memory")
#define PG8_BAR __builtin_amdgcn_s_barrier()
#define PG8_SCHED __builtin_amdgcn_sched_barrier(0)
    Unit cur, nxt; int ui = 0;
    if (!S.next(0, cur)) return;
    f32x4 acc[2][2][4][2];
#pragma unroll
    for (int a = 0; a < 2; ++a)
#pragma unroll
        for (int b = 0; b < 2; ++b)
#pragma unroll
            for (int m = 0; m < 4; ++m)
#pragma unroll
                for (int n = 0; n < 2; ++n) acc[a][b][m][n] = (f32x4){0.f, 0.f, 0.f, 0.f};
    bf16x8 At[4][2], B0[2][2], B1[2][2];
    const char* cA = (const char*)g.A + (size_t)cur.pm * tstep; const char* cB = (const char*)g.Bt + (size_t)cur.pn * tstep;
    S.a_ready(cur);
    if constexpr (SP2) {
        PG8_STAGE(PG8_SB(0, 0), cB, voffB); PG8_STAGE(PG8_SB(0, 1), cB + hstep, voffB); PG8_STAGE(PG8_SA(0, 0), cA, voffA); PG8_STAGE(PG8_SA(0, 1), cA + hstep, voffA);
        if (wr == 1) PG8_BAR;
        PG8_WAIT_V(2); PG8_BAR;
        PG8_STAGE(PG8_SB(1, 0), cB + kstep, voffB); PG8_STAGE(PG8_SA(1, 0), cA + kstep, voffA); PG8_STAGE(PG8_SB(1, 1), cB + hstep + kstep, voffB);
        PG8_WAIT_V(6); PG8_BAR;
    } else {
        PG8_STAGE(PG8_SB(0, 0), cB, voffB); PG8_STAGE(PG8_SA(0, 0), cA, voffA); PG8_STAGE(PG8_SB(0, 1), cB + hstep, voffB); PG8_STAGE(PG8_SA(0, 1), cA + hstep, voffA);
        if (wr == 1) PG8_BAR;
        PG8_WAIT_V(4); PG8_BAR;
        PG8_STAGE(PG8_SB(1, 0), cB + kstep, voffB); PG8_STAGE(PG8_SA(1, 0), cA + kstep, voffA); PG8_STAGE(PG8_SB(1, 1), cB + hstep + kstep, voffB);
        PG8_WAIT_V(6); PG8_BAR;
    }
    for (;;) {
        const bool has_next = S.next(ui + 1, nxt);
        const char* nA = has_next ? (const char*)g.A + (size_t)nxt.pm * tstep : cA; const char* nB = has_next ? (const char*)g.Bt + (size_t)nxt.pn * tstep : cB;
        for (int t = 0; t < nt; t += 2) {
            const bool last = (t == nt - 2);
            const char* a1 = cA + (size_t)(t + 1) * kstep;
            const char* a2 = last ? nA : cA + (size_t)(t + 2) * kstep; const char* b2 = last ? nB : cB + (size_t)(t + 2) * kstep;
            const char* a3 = a2 + kstep; const char* b3 = b2 + kstep;
            if (last && has_next) S.a_ready(nxt);
            if constexpr (SP2) {
            PG8_LDB(B0, 0, 0); PG8_LDB(B1, 0, 1); PG8_SCHED; PG8_LDA(At, 0, 0); PG8_STAGE(PG8_SA(1, 1), a1 + hstep, voffA);
            PG8_WAIT_V(8); PG8_WAIT_L(0); PG8_BAR; PG8_MMA(0, 0, At, B0); PG8_MMA(0, 1, At, B1); PG8_BAR; PG8_SCHED;
            PG8_LDA(At, 0, 1); PG8_STAGE(PG8_SB(0, 0), b2, voffB); PG8_STAGE(PG8_SB(0, 1), b2 + hstep, voffB); PG8_STAGE(PG8_SA(0, 0), a2, voffA);
            PG8_WAIT_V(8); PG8_WAIT_L(0); PG8_BAR; PG8_MMA(1, 0, At, B0); PG8_MMA(1, 1, At, B1); PG8_BAR; PG8_SCHED;
            PG8_LDB(B0, 1, 0); PG8_LDB(B1, 1, 1); PG8_SCHED; PG8_LDA(At, 1, 0); PG8_STAGE(PG8_SA(0, 1), a2 + hstep, voffA);
            PG8_WAIT_V(8); PG8_WAIT_L(0); PG8_BAR; PG8_MMA(0, 0, At, B0); PG8_MMA(0, 1, At, B1); PG8_BAR; PG8_SCHED;
            PG8_LDA(At, 1, 1); PG8_STAGE(PG8_SB(1, 0), b3, voffB); PG8_STAGE(PG8_SB(1, 1), b3 + hstep, voffB); PG8_STAGE(PG8_SA(1, 0), a3, voffA);
            PG8_WAIT_V(8); PG8_WAIT_L(0); PG8_BAR; PG8_MMA(1, 0, At, B0); PG8_MMA(1, 1, At, B1); PG8_BAR; PG8_SCHED;
            } else {
            PG8_LDB(B0, 0, 0); PG8_SCHED; PG8_LDA(At, 0, 0); PG8_STAGE(PG8_SA(1, 1), a1 + hstep, voffA);
            PG8_WAIT_L(8); PG8_BAR; PG8_WAIT_L(0); PG8_MMA(0, 0, At, B0); PG8_BAR; PG8_SCHED;
            PG8_LDB(B1, 0, 1); PG8_STAGE(PG8_SB(0, 0), b2, voffB);
            PG8_BAR; PG8_WAIT_L(0); PG8_MMA(0, 1, At, B1); PG8_BAR;
            PG8_LDA(At, 0, 1); PG8_STAGE(PG8_SA(0, 0), a2, voffA);
            PG8_BAR; PG8_WAIT_L(0); PG8_MMA(1, 0, At, B0); PG8_BAR; PG8_SCHED;
            PG8_STAGE(PG8_SB(0, 1), b2 + hstep, voffB);
            PG8_WAIT_V(6); PG8_BAR; PG8_MMA(1, 1, At, B1); PG8_BAR;
            PG8_LDB(B0, 1, 0); PG8_SCHED; PG8_LDA(At, 1, 0); PG8_STAGE(PG8_SA(0, 1), a2 + hstep, voffA);
            PG8_WAIT_L(8); PG8_BAR; PG8_WAIT_L(0); PG8_MMA(0, 0, At, B0); PG8_BAR; PG8_SCHED;
            PG8_LDB(B1, 1, 1); PG8_STAGE(PG8_SB(1, 0), b3, voffB);
            PG8_BAR; PG8_WAIT_L(0); PG8_MMA(0, 1, At, B1); PG8_BAR;
            PG8_LDA(At, 1, 1); PG8_STAGE(PG8_SA(1, 0), a3, voffA);
            PG8_BAR; PG8_WAIT_L(0); PG8_MMA(1, 0, At, B0); PG8_BAR; PG8_SCHED;
            PG8_STAGE(PG8_SB(1, 1), b3 + hstep, voffB);
            PG8_WAIT_V(6); PG8_BAR; PG8_MMA(1, 1, At, B1); PG8_BAR;
            }
        }
        if constexpr (ALIGN_EPI) { if (wr == 0) PG8_BAR; }
        if constexpr (!Epi::AFTER_DRAIN) { E(acc, cur, wr, wc, fr, fq); S.done(cur); }
        if (!has_next) break;
#pragma unroll
        for (int a = 0; a < 2; ++a)
#pragma unroll
            for (int b = 0; b < 2; ++b)
#pragma unroll
                for (int m = 0; m < 4; ++m)
#pragma unroll
                    for (int n = 0; n < 2; ++n) acc[a][b][m][n] = (f32x4){0.f, 0.f, 0.f, 0.f};
        cur = nxt; cA = nA; cB = nB; ++ui;
        if constexpr (ALIGN_EPI) { if (wr == 1) PG8_BAR; }
    }
    PG8_WAIT_V(0);
    if constexpr (!ALIGN_EPI) { if (wr == 0) PG8_BAR; }
    PG8_BAR;
    if constexpr (Epi::AFTER_DRAIN) { E.fused(acc, cur, wr, wc, fr, fq, lds, wid, lane); S.done(cur); }
#undef PG8_SA
#undef PG8_SB
#undef PG8_STAGE
#undef PG8_LDA
#undef PG8_LDB
#undef PG8_MMA
#undef PG8_WAIT_V
#undef PG8_WAIT_L
#undef PG8_BAR
#undef PG8_SCHED
}
}

constexpr int NWAVES = 8;
constexpr int DM = 2048, NB = 4, SEQ = 4096, NTOK = NB * SEQ;
constexpr int NMETA = 16, NVALID = NTOK + NMETA, MROWS = 16640;
constexpr int IN_COLS = 5376;
constexpr float LN_EPS = 1e-5f, GN_EPS = 1e-5f;
constexpr float ALPHA = 1.189207115002721f;
constexpr float LOG2E = 1.4426950408889634f;
constexpr float QSCALE = 0.125f * LOG2E;
constexpr float U_SCALE = 64.0f, V_SCALE = 4.0f;
constexpr int NSL = 16;

constexpr size_t MiB = 1u << 20;
constexpr size_t WS_CTL = 0, CTL_ZERO_BYTES = 1 * MiB;
constexpr size_t SZ_SK = (size_t)16 * 128 * 128 * 2, SZ_ROPE_R = (size_t)4112 * 128 * 8, SZ_ROPE_A = (size_t)4112 * 32 * 8;
constexpr size_t SZ_W2T = (size_t)DM * DM * 2, SZ_W1T = (size_t)IN_COLS * DM * 2, SZ_TAB = (size_t)16384 * DM * 2;
constexpr size_t SZ_ROWS2K = (size_t)MROWS * 2048 * 2, SZ_ROWS1K = (size_t)MROWS * 1024 * 2, SZ_ROWS128 = (size_t)MROWS * 128 * 2;
constexpr size_t SZ_TOK2K = (size_t)NTOK * 2048 * 2, SZ_ST = (size_t)16 * 32 * 256 * 256 * 2, SZ_IDS = (size_t)NTOK * 128 * 4;
constexpr size_t al256(size_t x) { return (x + 255) & ~(size_t)255; }
constexpr size_t WS_SK = 1 * MiB;
constexpr size_t WS_ROPE_R = al256(WS_SK + SZ_SK);
constexpr size_t WS_ROPE_A = al256(WS_ROPE_R + SZ_ROPE_R);
constexpr size_t WS_W2T = al256(WS_ROPE_A + SZ_ROPE_A), WS_W3T = al256(WS_W2T + SZ_W2T), WS_W1T = al256(WS_W3T + SZ_W2T);
constexpr size_t WS_UT = al256(WS_W1T + SZ_W1T), WS_VT = al256(WS_UT + SZ_TAB);
constexpr size_t WS_H0 = al256(WS_VT + SZ_TAB);
constexpr size_t WS_QR = al256(WS_H0 + SZ_ROWS2K);
constexpr size_t WS_KA = al256(WS_QR + SZ_ROWS2K), WS_VA = al256(WS_KA + SZ_ROWS128);
constexpr size_t WS_RK = al256(WS_VA + SZ_ROWS128), WS_RV = al256(WS_RK + SZ_ROWS1K), WS_RG = al256(WS_RV + SZ_ROWS1K);
constexpr size_t WS_ST = al256(WS_RG + SZ_ROWS1K);
constexpr size_t WS_Y = WS_RK;
constexpr size_t WS_H1 = WS_ST;
constexpr size_t WS_IDS = al256(WS_ST + SZ_ST), WS_GATES = al256(WS_IDS + SZ_IDS);
constexpr size_t WS_END = al256(WS_GATES + SZ_IDS);
static_assert(WS_Y + SZ_TOK2K <= WS_RG, "Y overlays RK|RV only");
static_assert(SZ_TOK2K <= SZ_ST && (size_t)NTOK * 1024 * 4 <= SZ_ST, "H1 / RET_RAW fit the state region");
static_assert(WS_END <= (size_t)512 * MiB, "workspace map fits 4 x largest tensor");
static_assert(WS_RK + (size_t)8 * NTOK * 128 * 4 <= WS_ST && WS_KA + (size_t)NTOK * 128 * 4 <= WS_RK && WS_H0 + (size_t)NTOK * DM * 4 <= WS_KA, "expert-phase overlays (DOTX over RK|RV, CB over KA|VA, Y32 over H0|QR)");
constexpr int CW_TMO = 0, CW_TABQ = 64, CW_BAR = 4096;

constexpr int RING_OFF = 0, RING_BYTES = 131072;
constexpr int LDSCTL_OFF = RING_BYTES, MISC_OFF = LDSCTL_OFF + 320;
constexpr int LDS_BYTES = 147456;

#define GAS __attribute__((address_space(1)))
#define LAS __attribute__((address_space(3)))
typedef unsigned short bf16;
typedef unsigned v4u __attribute__((ext_vector_type(4)));
typedef unsigned v2u __attribute__((ext_vector_type(2)));
typedef float f32x4 __attribute__((ext_vector_type(4)));
typedef float f32x2 __attribute__((ext_vector_type(2)));
typedef GAS unsigned gu32;
typedef __bf16 bf16x2_t __attribute__((ext_vector_type(2)));
#define RLX_AGENT __ATOMIC_RELAXED, __HIP_MEMORY_SCOPE_AGENT
#define LDS_WAIT() asm volatile("s_waitcnt lgkmcnt(0)" ::: "memory")
#define VM_WAIT() asm volatile("s_waitcnt vmcnt(0)" ::: "memory")
__device__ __forceinline__ unsigned f2bf(float f) { unsigned u = __builtin_bit_cast(unsigned, f); return (u + 0x7fffu + ((u >> 16) & 1u)) >> 16; }
__device__ __forceinline__ unsigned pk2(float lo, float hi) { return f2bf(lo) | (f2bf(hi) << 16); }
__device__ __forceinline__ float bflo(unsigned w) { return __uint_as_float(w << 16); }
__device__ __forceinline__ float bfhi(unsigned w) { return __uint_as_float(w & 0xffff0000u); }
__device__ __forceinline__ float bf2f(bf16 h) { return __uint_as_float((unsigned)h << 16); }

#define XB_TMO      128
#define XB_XCNT(j)  (256  + 64 * (j))
#define XB_XSUB(j)  (1280 + 64 * (j))
#define XB_XGEN(j)  (2304 + 64 * (j))
#define XB_TOP      3328
#define XB_TOPGEN   3392
#define XCD_BAR_WORDS 3456
#define XB_SPIN_CAP (1u << 18)

__device__ __forceinline__ unsigned xb_ld(unsigned* p)              { return __hip_atomic_load(p, __ATOMIC_RELAXED, __HIP_MEMORY_SCOPE_AGENT); }
__device__ __forceinline__ unsigned xb_add(unsigned* p, unsigned v) { return __hip_atomic_fetch_add(p, v, __ATOMIC_RELAXED, __HIP_MEMORY_SCOPE_AGENT); }
__device__ __forceinline__ unsigned xb_xcc_id() { return (unsigned)__builtin_amdgcn_s_getreg((3 << 11) | 20) & 0xFu; }
#define XB_SPIN(cond, bar) do { unsigned _sp = 0; while (cond) { __builtin_amdgcn_s_sleep(1); \
    if ((++_sp & 255u) == 0u) { if (xb_ld(&(bar)[XB_TMO])) break; if (_sp > XB_SPIN_CAP) { atomicAdd(&(bar)[XB_TMO], 1u); break; } } } } while (0)

struct XcdBarrier {
    unsigned* bar; unsigned x;
    volatile LAS unsigned* st;
};

__device__ __forceinline__ XcdBarrier xcd_barrier_post(unsigned* bar, volatile LAS unsigned* st) {
    XcdBarrier b; b.bar = bar; b.x = xb_xcc_id(); b.st = st;
    if (threadIdx.x == 0) (void)xb_add(&bar[XB_XCNT(b.x)], 1u);
    return b;
}
__device__ __forceinline__ void xcd_barrier_complete(unsigned* bar, unsigned x, unsigned& nloc, unsigned& nx) {
    const unsigned G = gridDim.x * gridDim.y * gridDim.z;
    unsigned sum, cnt, mine, sp = 0u;
    for (;;) {
        sum = 0u; cnt = 0u; mine = 0u;
#pragma unroll
        for (unsigned j = 0; j < 16; ++j) { const unsigned c = xb_ld(&bar[XB_XCNT(j)]); sum += c; cnt += (c > 0u) ? 1u : 0u; mine = (j == x) ? c : mine; }
        if (sum == G) break;
        __builtin_amdgcn_s_sleep(1);
        if ((++sp & 255u) == 0u) { if (xb_ld(&bar[XB_TMO])) break; if (sp > XB_SPIN_CAP) { atomicAdd(&bar[XB_TMO], 1u); break; } }
    }
    nloc = mine > 0u ? mine : 1u; nx = cnt > 0u ? cnt : 1u;
}

__device__ __forceinline__ void xcd_barrier(const XcdBarrier& b) {
    asm volatile("s_waitcnt vmcnt(0)" ::: "memory");
    __syncthreads();
    if (threadIdx.x == 0) {
        unsigned* bar = b.bar;
        __builtin_amdgcn_s_waitcnt(0);
        unsigned nloc = b.st[0], nx = b.st[1];
        if (nloc == 0u) { xcd_barrier_complete(bar, b.x, nloc, nx); b.st[0] = nloc; b.st[1] = nx; }
        const unsigned old = xb_add(&bar[XB_XSUB(b.x)], 1u);
        const unsigned gen = old / nloc;
        if (old + 1u == (gen + 1u) * nloc) {
            __builtin_amdgcn_fence(__ATOMIC_RELEASE, "agent");
            asm volatile("s_waitcnt vmcnt(0)" ::: "memory");
            const unsigned og = xb_add(&bar[XB_TOP], 1u);
            const unsigned tg = og / nx;
            if (og + 1u == (tg + 1u) * nx) xb_add(&bar[XB_TOPGEN], 1u);
            else XB_SPIN(xb_ld(&bar[XB_TOPGEN]) == tg, bar);
            __builtin_amdgcn_fence(__ATOMIC_ACQUIRE, "agent");
            xb_add(&bar[XB_XGEN(b.x)], 1u);
            asm volatile("s_waitcnt vmcnt(0)" ::: "memory");
        } else {
            XB_SPIN(xb_ld(&bar[XB_XGEN(b.x)]) == gen, bar);
            __builtin_amdgcn_fence(__ATOMIC_ACQUIRE, "agent");
            asm volatile("s_waitcnt vmcnt(0)" ::: "memory");
        }
    }
    __syncthreads();
}


__device__ __forceinline__ float dot2bf(unsigned a, unsigned b, float c) { asm("v_dot2c_f32_bf16 %0, %1, %2" : "+v"(c) : "v"(a), "v"(b)); return c; }
__device__ __forceinline__ float dot8bf_dpp(v4u a, v4u b) { float c = 0.f; asm("v_dot2c_f32_bf16 %0, %1, %5\n\tv_dot2c_f32_bf16 %0, %2, %6\n\tv_dot2c_f32_bf16 %0, %3, %7\n\tv_dot2c_f32_bf16 %0, %4, %8\n\ts_nop 1" : "+v"(c) : "v"(a.x), "v"(a.y), "v"(a.z), "v"(a.w), "v"(b.x), "v"(b.y), "v"(b.z), "v"(b.w)); return c; }
#define DPPF(v, ctrl) __int_as_float(__builtin_amdgcn_update_dpp(0, __float_as_int(v), (ctrl), 0xf, 0xf, true))
__device__ __forceinline__ float wave_sum(float v) {
#pragma unroll
    for (int o = 1; o < 64; o <<= 1) v += __shfl_xor(v, o);
    return v;
}
__device__ __forceinline__ float gelu_erf(float v) {
    const float av = fabsf(v), d = av * 0.2316418882f + 1.0f;
    const float t = __builtin_amdgcn_rcpf(d);
    float q = t * 0.5307027145f + (-0.7265760135f); q = q * t + 0.7107068705f; q = q * t + (-0.142248368f); q = q * t + 0.127414796f; q = q * t;
    const float e = __builtin_amdgcn_exp2f((v * v) * (-0.72134752044f));
    const float m = v * (q * e);
    return v < 0.f ? m : v - m;
}

struct Args { const float* in[15]; float* out; unsigned char* ws; };

__device__ __forceinline__ int w1_logical_col(int n0p) {
    const int pn = n0p >> 8, blk = (n0p & 255) >> 5, half = blk >> 2, a = blk & 3;
    if (pn <= 3) return pn * 256 + 64 * a + 32 * half;
    if (pn == 4) return (a < 2) ? (1024 + 64 * a + 32 * half) : (1152 + 64 * half + 32 * (a - 2));
    return n0p;
}
template <bool PERMW1> __device__ __forceinline__ void p0_transpose_item(const float* W, int K, int N, bf16* WT, LAS float* scr, int item, int lane) {
    const int nblk = N / 32, kb = item / nblk, nb = item % nblk, k0 = 64 * kb, n0 = 32 * nb; const int ns = PERMW1 ? w1_logical_col(n0) : n0;
    float tv[32];
#pragma unroll
    for (int i = 0; i < 32; ++i) { const int kk = 2 * i + (lane >> 5); tv[i] = W[(size_t)(k0 + kk) * N + ns + (lane & 31)]; }
#pragma unroll
    for (int i = 0; i < 32; ++i) { const int kk = 2 * i + (lane >> 5); scr[kk * 33 + (lane & 31)] = tv[i]; }
    LDS_WAIT(); asm volatile("" ::: "memory");
    const int c = lane & 7;
#pragma unroll
    for (int j = 0; j < 4; ++j) { const int n = (lane >> 3) + 8 * j; const LAS float* s = scr + (8 * c) * 33 + n;
        v4u o; o.x = pk2(s[0 * 33], s[1 * 33]); o.y = pk2(s[2 * 33], s[3 * 33]); o.z = pk2(s[4 * 33], s[5 * 33]); o.w = pk2(s[6 * 33], s[7 * 33]);
        *(GAS v4u*)(WT + (size_t)(n0 + n) * K + k0 + 8 * c) = o; }
    LDS_WAIT(); asm volatile("" ::: "memory");
}
__device__ __forceinline__ void ln_row_f32_to_bf16(const float* xrow, const float* g, const float* bta, bf16* orow, int lane) {
    const GAS f32x4* xr = (const GAS f32x4*)xrow + lane;
    f32x4 v[8]; float s = 0.f;
#pragma unroll
    for (int j = 0; j < 8; ++j) { v[j] = xr[64 * j]; s += (v[j].x + v[j].y) + (v[j].z + v[j].w); }
    const float mean = wave_sum(s) * (1.f / DM); float s2 = 0.f;
#pragma unroll
    for (int j = 0; j < 8; ++j) { v[j] = v[j] - mean; s2 += (v[j].x * v[j].x + v[j].y * v[j].y) + (v[j].z * v[j].z + v[j].w * v[j].w); }
    const float rstd = 1.f / sqrtf(wave_sum(s2) * (1.f / DM) + LN_EPS);
    GAS v2u* o8 = (GAS v2u*)orow + lane;
#pragma unroll
    for (int j = 0; j < 8; ++j) { const f32x4 gg = ((const GAS f32x4*)g)[lane + 64 * j], bb = ((const GAS f32x4*)bta)[lane + 64 * j];
        v2u o; o.x = pk2(v[j].x * rstd * gg.x + bb.x, v[j].y * rstd * gg.y + bb.y); o.y = pk2(v[j].z * rstd * gg.z + bb.z, v[j].w * rstd * gg.w + bb.w); o8[64 * j] = o; }
}
__device__ __forceinline__ void ln_row_bf16_to_bf16(const bf16* xrow, const float* g, const float* bta, bf16* orow, int lane) {
    const GAS v4u* xr = (const GAS v4u*)xrow + lane;
    float v[32]; float s = 0.f;
#pragma unroll
    for (int j = 0; j < 4; ++j) { const v4u w = xr[64 * j];
        v[8 * j + 0] = bflo(w.x); v[8 * j + 1] = bfhi(w.x); v[8 * j + 2] = bflo(w.y); v[8 * j + 3] = bfhi(w.y);
        v[8 * j + 4] = bflo(w.z); v[8 * j + 5] = bfhi(w.z); v[8 * j + 6] = bflo(w.w); v[8 * j + 7] = bfhi(w.w); }
#pragma unroll
    for (int i = 0; i < 32; ++i) s += v[i];
    const float mean = wave_sum(s) * (1.f / DM); float s2 = 0.f;
#pragma unroll
    for (int i = 0; i < 32; ++i) { v[i] -= mean; s2 += v[i] * v[i]; }
    const float rstd = 1.f / sqrtf(wave_sum(s2) * (1.f / DM) + LN_EPS);
    GAS v4u* o16 = (GAS v4u*)orow + lane;
#pragma unroll
    for (int j = 0; j < 4; ++j) {
        const GAS f32x4* gp = (const GAS f32x4*)g + 2 * (lane + 64 * j); const GAS f32x4* bp = (const GAS f32x4*)bta + 2 * (lane + 64 * j);
        const f32x4 g0 = gp[0], g1 = gp[1], b0 = bp[0], b1 = bp[1];
        v4u o; o.x = pk2(v[8 * j + 0] * rstd * g0.x + b0.x, v[8 * j + 1] * rstd * g0.y + b0.y); o.y = pk2(v[8 * j + 2] * rstd * g0.z + b0.z, v[8 * j + 3] * rstd * g0.w + b0.w);
        o.z = pk2(v[8 * j + 4] * rstd * g1.x + b1.x, v[8 * j + 5] * rstd * g1.y + b1.y); o.w = pk2(v[8 * j + 6] * rstd * g1.z + b1.z, v[8 * j + 7] * rstd * g1.w + b1.w);
        o16[64 * j] = o; }
}
__device__ __forceinline__ void row_pos(int r, int& pos, int& ipos) {
    if (r < NTOK) { const int s = r & (SEQ - 1); pos = NMETA + s; ipos = s & 127; }
    else { int j = r - NTOK; if (j > NMETA - 1) j = NMETA - 1; pos = j; ipos = 112 + j; }
}
__device__ __forceinline__ float log2_gamma(int h) { return log2f(1.0f - exp2f(-5.0f - (float)h)); }


typedef short bf16x8 __attribute__((ext_vector_type(8)));
typedef short s16x4 __attribute__((ext_vector_type(4)));
#define MFMA16(a, b, c) __builtin_amdgcn_mfma_f32_16x16x32_bf16((a), (b), (c), 0, 0, 0)
__device__ __forceinline__ s16x4 tr16(LAS const unsigned char* p) { return __builtin_bit_cast(s16x4, __builtin_amdgcn_ds_read_tr16_b64_v4i16((LAS s16x4*)p)); }
__device__ __forceinline__ bf16x8 cat8(s16x4 a, s16x4 b) { return __builtin_shufflevector(a, b, 0, 1, 2, 3, 4, 5, 6, 7); }
__device__ __forceinline__ unsigned cvtpk_s(float lo, float hi) { f32x2 v = {lo, hi}; bf16x2_t b = __builtin_convertvector(v, bf16x2_t); return __builtin_bit_cast(unsigned, b); }
__device__ __forceinline__ unsigned cvtpk(float lo, float hi) { unsigned r; asm("v_cvt_pk_bf16_f32 %0, %1, %2" : "=v"(r) : "v"(lo), "v"(hi)); return r; }

__device__ __forceinline__ void scan_unit(LAS unsigned char* L, int u, const bf16* RK, const bf16* RV, bf16* ST, int tid, int lane, int wave) {
    asm volatile("" : "+v"(tid)); lane = tid & 63;
    const int bh = u >> 4, di = (u >> 2) & 3, ei = u & 3, b = bh >> 2, h = bh & 3;
    const float g128 = exp2f(128.0f * log2_gamma(h));
    const int li = lane & 15, g = lane >> 4, q = li >> 2, p4 = li & 3;
    const int eb = wave >> 1, db0 = 2 * (wave & 1);
    f32x4 acc[2]; acc[0] = (f32x4){0.f, 0.f, 0.f, 0.f}; acc[1] = acc[0];
    v4u kA[2], vA[2], kB[2], vB[2];
#define SCAN_LOAD(cc, kreg, vreg) do { _Pragma("unroll") for (int i_ = 0; i_ < 2; ++i_) { const int cid_ = tid + 512 * i_, row_ = cid_ >> 3, c16_ = cid_ & 7; \
        int srow_; bool ok_ = true; if ((cc) < 0) { ok_ = row_ >= 112; srow_ = NTOK + (ok_ ? row_ - 112 : 0); } else srow_ = b * SEQ + (cc) * 128 + row_; \
        const v4u kz_ = *(const GAS v4u*)(RK + (size_t)srow_ * 1024 + h * 256 + di * 64 + c16_ * 8), vz_ = *(const GAS v4u*)(RV + (size_t)srow_ * 1024 + h * 256 + ei * 64 + c16_ * 8); \
        kreg[i_] = ok_ ? kz_ : (v4u){0u, 0u, 0u, 0u}; vreg[i_] = ok_ ? vz_ : (v4u){0u, 0u, 0u, 0u}; } } while (0)
#define SCAN_WRITE(bufp, kreg, vreg) do { _Pragma("unroll") for (int i_ = 0; i_ < 2; ++i_) { const int cid_ = tid + 512 * i_, row_ = cid_ >> 3, c16_ = cid_ & 7; \
        *(LAS v4u*)((bufp) + row_ * 128 + c16_ * 16) = kreg[i_]; *(LAS v4u*)((bufp) + 16384 + row_ * 128 + c16_ * 16) = vreg[i_]; } } while (0)
    SCAN_LOAD(-1, kA, vA); SCAN_WRITE(L, kA, vA); SCAN_LOAD(0, kA, vA); SCAN_LOAD(1, kB, vB); __syncthreads();
    int cur = 0;
    for (int cc = -1; cc <= 29; cc += 2) {
        { LAS const unsigned char* Kt = L + cur * 32768; LAS const unsigned char* Vt = Kt + 16384;
#pragma unroll
          for (int ks = 0; ks < 4; ++ks) { const int r0 = (32 * ks + 8 * g + q) * 128;
              const bf16x8 a = cat8(tr16(Vt + r0 + (16 * eb + 4 * p4) * 2), tr16(Vt + r0 + 512 + (16 * eb + 4 * p4) * 2));
#pragma unroll
              for (int n = 0; n < 2; ++n) { const bf16x8 bb = cat8(tr16(Kt + r0 + (16 * (db0 + n) + 4 * p4) * 2), tr16(Kt + r0 + 512 + (16 * (db0 + n) + 4 * p4) * 2)); acc[n] = MFMA16(a, bb, acc[n]); } }
#pragma unroll
          for (int n = 0; n < 2; ++n) { acc[n] = acc[n] * g128;
              bf16* sp = ST + ((size_t)(bh * 32 + cc + 1) * 256 + (64 * ei + 16 * eb + 4 * g)) * 256 + 64 * di + 16 * (db0 + n) + li;
#pragma unroll
              for (int r = 0; r < 4; ++r) sp[(size_t)r * 256] = (bf16)f2bf(acc[n][r]); }
          SCAN_WRITE(L + (cur ^ 1) * 32768, kA, vA);
          if (cc + 3 <= 30) SCAN_LOAD(cc + 3, kA, vA);
          __syncthreads(); cur ^= 1; }
        { LAS const unsigned char* Kt = L + cur * 32768; LAS const unsigned char* Vt = Kt + 16384;
#pragma unroll
          for (int ks = 0; ks < 4; ++ks) { const int r0 = (32 * ks + 8 * g + q) * 128;
              const bf16x8 a = cat8(tr16(Vt + r0 + (16 * eb + 4 * p4) * 2), tr16(Vt + r0 + 512 + (16 * eb + 4 * p4) * 2));
#pragma unroll
              for (int n = 0; n < 2; ++n) { const bf16x8 bb = cat8(tr16(Kt + r0 + (16 * (db0 + n) + 4 * p4) * 2), tr16(Kt + r0 + 512 + (16 * (db0 + n) + 4 * p4) * 2)); acc[n] = MFMA16(a, bb, acc[n]); } }
#pragma unroll
          for (int n = 0; n < 2; ++n) { acc[n] = acc[n] * g128;
              bf16* sp = ST + ((size_t)(bh * 32 + cc + 2) * 256 + (64 * ei + 16 * eb + 4 * g)) * 256 + 64 * di + 16 * (db0 + n) + li;
#pragma unroll
              for (int r = 0; r < 4; ++r) sp[(size_t)r * 256] = (bf16)f2bf(acc[n][r]); }
          if (cc + 2 <= 30) SCAN_WRITE(L + (cur ^ 1) * 32768, kB, vB);
          if (cc + 4 <= 30) SCAN_LOAD(cc + 4, kB, vB);
          __syncthreads(); cur ^= 1; }
    }
#undef SCAN_LOAD
#undef SCAN_WRITE
}

__device__ __forceinline__ void retout_unit(LAS unsigned char* L, int u, bf16* QR, const bf16* RK, const bf16* RV, const bf16* RG, const bf16* ST, int tid, int lane, int wave) {
    asm volatile("" : "+v"(tid)); lane = tid & 63;
    const int bh = u >> 5, c = u & 31, b = bh >> 2, h = bh & 3;
    const int R0 = b * SEQ + c * 128;
    const int li = lane & 15, g = lane >> 4, q = li >> 2, p4 = li & 3;
    LAS unsigned char* RA = L; LAS unsigned char* RB = L + 65536;
#pragma unroll
    for (int i = 0; i < 8; ++i) { const int cid = tid + 512 * i, j = cid >> 5, ch = cid & 31;
        const v4u kz = *(const GAS v4u*)(RK + (size_t)(R0 + j) * 1024 + h * 256 + ch * 8), vz = *(const GAS v4u*)(RV + (size_t)(R0 + j) * 1024 + h * 256 + ch * 8);
        *(LAS v4u*)(RA + j * 512 + ((ch ^ (j & 15)) << 4)) = kz; *(LAS v4u*)(RB + j * 512 + ((ch ^ ((j & 7) << 1)) << 4)) = vz; }
    bf16x8 qf[8];
    { const GAS v4u* qp = (const GAS v4u*)(QR + (size_t)(R0 + 16 * wave + li) * 2048 + 1024 + h * 256 + 8 * g);
#pragma unroll
      for (int ks = 0; ks < 8; ++ks) qf[ks] = __builtin_bit_cast(bf16x8, qp[4 * ks]); }
    __syncthreads();
    f32x4 st[8];
#pragma unroll
    for (int jt = 0; jt < 8; ++jt) st[jt] = (f32x4){0.f, 0.f, 0.f, 0.f};
#pragma unroll
    for (int jt = 0; jt < 8; ++jt) if (jt <= wave) {
        const int j = 16 * jt + li;
#pragma unroll
        for (int ks = 0; ks < 8; ++ks) { const bf16x8 a = *(LAS const bf16x8*)(RA + j * 512 + (((4 * ks + g) ^ li) << 4)); st[jt] = MFMA16(a, qf[ks], st[jt]); }
        if (jt == wave) {
#pragma unroll
            for (int r = 0; r < 4; ++r) if (4 * g + r > li) st[jt][r] = 0.f; }
    }
    bf16x8 pf[4];
#pragma unroll
    for (int s = 0; s < 4; ++s) { v4u w; w.x = cvtpk_s(st[2 * s][0], st[2 * s][1]); w.y = cvtpk_s(st[2 * s][2], st[2 * s][3]); w.z = cvtpk_s(st[2 * s + 1][0], st[2 * s + 1][1]); w.w = cvtpk_s(st[2 * s + 1][2], st[2 * s + 1][3]); pf[s] = __builtin_bit_cast(bf16x8, w); }
    __syncthreads();
    const bf16* Sg = ST + (size_t)(bh * 32 + c) * 65536;
#define RO_STAGE_ST(dst, s0) do { _Pragma("unroll") for (int i_ = 0; i_ < 8; ++i_) { const int cid_ = tid + 512 * i_, sl_ = cid_ >> 11, e_ = (cid_ >> 3) & 255, ch_ = cid_ & 7; \
        const v4u z_ = *(const GAS v4u*)(Sg + (size_t)e_ * 256 + 64 * ((s0) + sl_) + ch_ * 8); *(LAS v4u*)((dst) + sl_ * 32768 + e_ * 128 + ((ch_ ^ (e_ & 7)) << 4)) = z_; } } while (0)
    RO_STAGE_ST(RA, 0);
    f32x4 o[16];
#pragma unroll
    for (int et = 0; et < 16; ++et) o[et] = (f32x4){0.f, 0.f, 0.f, 0.f};
#pragma unroll
    for (int s = 0; s < 4; ++s) if (2 * s <= wave) {
        const int r1 = 32 * s + 4 * g + q, r2 = r1 + 16;
#pragma unroll
        for (int et = 0; et < 16; ++et) {
            const int chn = 2 * et + (p4 >> 1);
            const bf16x8 a = cat8(tr16(RB + r1 * 512 + ((chn ^ ((r1 & 7) << 1)) << 4) + (p4 & 1) * 8), tr16(RB + r2 * 512 + ((chn ^ ((r2 & 7) << 1)) << 4) + (p4 & 1) * 8));
            o[et] = MFMA16(a, pf[s], o[et]);
        }
    }
    __syncthreads();
    RO_STAGE_ST(RB, 2);
#define RO_STATE_MMA(src, s0) do { _Pragma("unroll") for (int sl_ = 0; sl_ < 2; ++sl_) _Pragma("unroll") for (int k2_ = 0; k2_ < 2; ++k2_) _Pragma("unroll") for (int et = 0; et < 16; ++et) { \
        const int e_ = 16 * et + li; const bf16x8 a_ = *(LAS const bf16x8*)((src) + sl_ * 32768 + e_ * 128 + (((4 * k2_ + g) ^ (e_ & 7)) << 4)); \
        o[et] = MFMA16(a_, qf[2 * ((s0) + sl_) + k2_], o[et]); } } while (0)
    RO_STATE_MMA(RA, 0);
    __syncthreads();
    RO_STATE_MMA(RB, 2);
#undef RO_STAGE_ST
#undef RO_STATE_MMA
    float s1 = 0.f;
#pragma unroll
    for (int et = 0; et < 16; ++et) s1 += (o[et][0] + o[et][1]) + (o[et][2] + o[et][3]);
    s1 += __shfl_xor(s1, 16); s1 += __shfl_xor(s1, 32);
    const float mu = s1 * (1.0f / 256.0f); float s2 = 0.f;
#pragma unroll
    for (int et = 0; et < 16; ++et) { o[et] = o[et] - mu; s2 += (o[et][0] * o[et][0] + o[et][1] * o[et][1]) + (o[et][2] * o[et][2] + o[et][3] * o[et][3]); }
    s2 += __shfl_xor(s2, 16); s2 += __shfl_xor(s2, 32);
    const float rstd = 1.0f / sqrtf(s2 * (1.0f / 256.0f) + GN_EPS);
    const int row = R0 + 16 * wave + li;
    const GAS v2u* gp = (const GAS v2u*)(RG + (size_t)row * 1024 + h * 256 + 4 * g); GAS v2u* op = (GAS v2u*)(QR + (size_t)row * 2048 + 1024 + h * 256 + 4 * g);
#pragma unroll
    for (int et = 0; et < 16; ++et) { const v2u gz = gp[4 * et]; v2u w;
        w.x = cvtpk(o[et][0] * rstd * bflo(gz.x), o[et][1] * rstd * bfhi(gz.x)); w.y = cvtpk(o[et][2] * rstd * bflo(gz.y), o[et][3] * rstd * bfhi(gz.y)); op[4 * et] = w; }
    __syncthreads();
}

typedef float f32x16 __attribute__((ext_vector_type(16)));
#define MFMA32(a, b, c) __builtin_amdgcn_mfma_f32_32x32x16_bf16((a), (b), (c), 0, 0, 0)
__device__ __forceinline__ int crow32(int reg, int hh) { return (reg & 3) + 8 * (reg >> 2) + 4 * hh; }

__device__ __forceinline__ void attn_unit(LAS unsigned char* L, int u, bf16* QR, const bf16* KA, const bf16* VA, const float* sinks, int tid, int lane, int wave) {
    asm volatile("" : "+v"(tid)); lane = tid & 63;
    const int b = u >> 6, j = (u >> 1) & 31, g2 = u & 1, hq = 8 * g2 + wave;
    const int R0 = b * SEQ + 128 * j;
    LAS unsigned char* Kt = L; LAS unsigned char* Vt = L + 32768;
#pragma unroll
    for (int i = 0; i < 4; ++i) { const int cid = tid + 512 * i, kk = cid >> 3, ch = cid & 7;
        int srow; bool ok = true;
        if (kk >= 128) srow = R0 + kk - 128; else if (j > 0) srow = R0 - 128 + kk; else { ok = kk >= 112; srow = NTOK + (ok ? kk - 112 : 0); }
        const v4u kz = *(const GAS v4u*)(KA + (size_t)srow * 128 + g2 * 64 + ch * 8), vz = *(const GAS v4u*)(VA + (size_t)srow * 128 + g2 * 64 + ch * 8);
        *(LAS v4u*)(Kt + kk * 128 + ((ch ^ (kk & 7)) << 4)) = ok ? kz : (v4u){0u, 0u, 0u, 0u};
        *(LAS v4u*)(Vt + kk * 128 + (ch << 4)) = ok ? vz : (v4u){0u, 0u, 0u, 0u}; }
    __syncthreads();
    const int r = lane & 31, hh = lane >> 5, blk = (lane >> 4) & 1, q = (lane & 15) >> 2, p4 = lane & 3;
    const float sk = sinks[hq] * LOG2E;
#pragma unroll 1
    for (int t = 0; t < 4; ++t) {
        const int i0 = 32 * t;
        bf16x8 qf[4];
        { const GAS v4u* qp = (const GAS v4u*)(QR + (size_t)(R0 + i0 + r) * 2048 + hq * 64 + 8 * hh);
#pragma unroll
          for (int ks = 0; ks < 4; ++ks) qf[ks] = __builtin_bit_cast(bf16x8, qp[2 * ks]); }
        f32x16 s[5];
#pragma unroll
        for (int x = 0; x < 5; ++x) {
            const int krow_ = 32 * (t + x) + r;
            f32x16 acc;
#pragma unroll
            for (int e = 0; e < 16; ++e) acc[e] = 0.f;
#pragma unroll
            for (int ks = 0; ks < 4; ++ks) { const bf16x8 a = *(LAS const bf16x8*)(Kt + krow_ * 128 + (((2 * ks + hh) ^ (krow_ & 7)) << 4)); acc = MFMA32(a, qf[ks], acc); }
            s[x] = acc; __builtin_amdgcn_sched_barrier(0);
        }
        float m = sk;
#pragma unroll
        for (int e = 0; e < 16; ++e) { const int cr = crow32(e, hh);
            if (!(cr > r)) s[0][e] = -1.0e30f;
            if (!(cr <= r)) s[4][e] = -1.0e30f; }
        if (j == 0) {
#pragma unroll
            for (int x = 0; x < 4; ++x) if (t + x <= 3) {
#pragma unroll
                for (int e = 0; e < 16; ++e) if (32 * (t + x) + crow32(e, hh) < 112) s[x][e] = -1.0e30f; }
        }
#pragma unroll
        for (int x = 0; x < 5; ++x)
#pragma unroll
            for (int e = 0; e < 16; ++e) m = fmaxf(m, s[x][e]);
        m = fmaxf(m, __shfl_xor(m, 32));
        float l = 0.f;
#pragma unroll
        for (int x = 0; x < 5; ++x)
#pragma unroll
            for (int e = 0; e < 16; ++e) { const float pv = exp2f(s[x][e] - m); s[x][e] = pv; l += pv; }
        l += __shfl_xor(l, 32);
        l += exp2f(sk - m);
        f32x16 o[2];
#pragma unroll
        for (int e = 0; e < 16; ++e) { o[0][e] = 0.f; o[1][e] = 0.f; }
#pragma unroll
        for (int x = 0; x < 5; ++x)
#pragma unroll
            for (int st = 0; st < 2; ++st) {
                v4u w; w.x = cvtpk_s(s[x][8 * st + 0], s[x][8 * st + 1]); w.y = cvtpk_s(s[x][8 * st + 2], s[x][8 * st + 3]); w.z = cvtpk_s(s[x][8 * st + 4], s[x][8 * st + 5]); w.w = cvtpk_s(s[x][8 * st + 6], s[x][8 * st + 7]);
                const bf16x8 pb = __builtin_bit_cast(bf16x8, w);
                const int k1 = 32 * (t + x) + 16 * st + 4 * hh + q, k2 = k1 + 8;
#pragma unroll
                for (int dc = 0; dc < 2; ++dc) {
                    const int cb = ((4 * dc + 2 * blk + (p4 >> 1)) << 4) + 8 * (p4 & 1);
                    const bf16x8 a = cat8(tr16(Vt + k1 * 128 + cb), tr16(Vt + k2 * 128 + cb));
                    o[dc] = MFMA32(a, pb, o[dc]);
                }
                __builtin_amdgcn_sched_barrier(0);
            }
        const float il = 1.0f / l;
        GAS v2u* op = (GAS v2u*)(QR + (size_t)(R0 + i0 + r) * 2048 + hq * 64 + 4 * hh);
#pragma unroll
        for (int dc = 0; dc < 2; ++dc)
#pragma unroll
            for (int g4 = 0; g4 < 4; ++g4) { v2u w; w.x = cvtpk_s(o[dc][4 * g4 + 0] * il, o[dc][4 * g4 + 1] * il); w.y = cvtpk_s(o[dc][4 * g4 + 2] * il, o[dc][4 * g4 + 3] * il); op[8 * dc + 2 * g4] = w; }
    }
    __syncthreads();
}

__device__ __forceinline__ unsigned ord_key(float f) { const unsigned u = __float_as_uint(f); return u ^ ((unsigned)((int)u >> 31) | 0x80000000u); }
__device__ __forceinline__ float ord_val(unsigned k) { return __uint_as_float(k ^ (((int)k < 0) ? 0x80000000u : 0xffffffffu)); }
__device__ __forceinline__ unsigned umed3(unsigned a, unsigned b, unsigned c) { unsigned r; asm("v_med3_u32 %0, %1, %2, %3" : "=v"(r) : "v"(a), "v"(b), "v"(c)); return r; }
#define TK_INS(arr, val) do { const unsigned v_ = (val); _Pragma("unroll") for (int j_ = 15; j_ >= 1; --j_) arr[j_] = umed3(arr[j_ - 1], arr[j_], v_); arr[0] = arr[0] > v_ ? arr[0] : v_; } while (0)
__device__ __forceinline__ void topk_unit(LAS unsigned* Lw, LAS const unsigned char* Lsk, int tt, int hd, const bf16* Q3, unsigned short* IDS, float* GATES, int lane) {
    asm volatile("" : "+v"(lane));
    const int r = lane & 31, hh = lane >> 5, t0 = tt * 32;
    float sv[2][16];
#pragma unroll
    for (int p = 0; p < 2; ++p) {
        f32x16 acc[4];
#pragma unroll
        for (int nt = 0; nt < 4; ++nt)
#pragma unroll
            for (int e = 0; e < 16; ++e) acc[nt][e] = 0.f;
        const GAS v4u* qp = (const GAS v4u*)(Q3 + (size_t)(t0 + r) * DM + hd * 256 + p * 128 + 8 * hh);
        bf16x8 bq[8];
#pragma unroll
        for (int ks = 0; ks < 8; ++ks) bq[ks] = __builtin_bit_cast(bf16x8, qp[2 * ks]);
#pragma unroll
        for (int ks = 0; ks < 8; ++ks) {
#pragma unroll
            for (int nt = 0; nt < 4; ++nt) { const bf16x8 a = *(LAS const bf16x8*)(Lsk + p * 32768 + (32 * nt + r) * 256 + (((2 * ks + hh) ^ (r & 15)) << 4)); acc[nt] = MFMA32(a, bq[ks], acc[nt]); } }
        unsigned tk[16];
#pragma unroll
        for (int j2 = 0; j2 < 16; ++j2) tk[j2] = 0u;
#pragma unroll
        for (int nt = 0; nt < 4; ++nt)
#pragma unroll
            for (int e = 0; e < 16; ++e) { const int n = 32 * nt + crow32(e, hh); TK_INS(tk, (ord_key(acc[nt][e]) & 0xffffff80u) | (unsigned)(127 - n)); }
        unsigned pk[16];
#pragma unroll
        for (int j2 = 0; j2 < 16; ++j2) pk[j2] = (unsigned)__shfl_xor((int)tk[j2], 32);
#pragma unroll
        for (int j2 = 0; j2 < 16; ++j2) TK_INS(tk, pk[j2]);
#pragma unroll
        for (int j2 = 0; j2 < 16; ++j2) { sv[p][j2] = ord_val(tk[j2] & 0xffffff80u); Lw[(p * 16 + j2) * 64 + lane] = 127u - (tk[j2] & 0x7fu); }
    }
    unsigned fk[16];
#pragma unroll
    for (int j2 = 0; j2 < 16; ++j2) fk[j2] = 0u;
#pragma unroll
    for (int i = 0; i < 16; ++i)
#pragma unroll
        for (int j2 = 0; j2 < 16; ++j2) if ((i + 1) * (j2 + 1) <= 16) TK_INS(fk, (ord_key(sv[0][i] + sv[1][j2]) & 0xffffff00u) | (unsigned)(255 - (16 * i + j2)));
    float ev[16]; int idv[16]; float den = 0.f; const float f0 = ord_val(fk[0] & 0xffffff00u);
    LDS_WAIT();
#pragma unroll
    for (int k = 0; k < 16; ++k) { const unsigned idx = 255u - (fk[k] & 0xffu); const unsigned i1 = Lw[(idx >> 4) * 64 + lane], i2 = Lw[(16 + (idx & 15u)) * 64 + lane];
        idv[k] = (int)(i1 * 128u + i2); ev[k] = __expf(ord_val(fk[k] & 0xffffff00u) - f0); den += ev[k]; }
    const float iden = 1.0f / den;
    if (hh == 0) {
        GAS v4u* ip = (GAS v4u*)(IDS + (size_t)(t0 + r) * 128 + hd * 16); GAS f32x4* gp = (GAS f32x4*)(GATES + (size_t)(t0 + r) * 128 + hd * 16);
#pragma unroll
        for (int k8 = 0; k8 < 2; ++k8) ip[k8] = (v4u){(unsigned)idv[8 * k8] | ((unsigned)idv[8 * k8 + 1] << 16), (unsigned)idv[8 * k8 + 2] | ((unsigned)idv[8 * k8 + 3] << 16), (unsigned)idv[8 * k8 + 4] | ((unsigned)idv[8 * k8 + 5] << 16), (unsigned)idv[8 * k8 + 6] | ((unsigned)idv[8 * k8 + 7] << 16)};
#pragma unroll
        for (int k4 = 0; k4 < 4; ++k4) gp[k4] = (f32x4){ev[4 * k4] * iden, ev[4 * k4 + 1] * iden, ev[4 * k4 + 2] * iden, ev[4 * k4 + 3] * iden};
    }
    LDS_WAIT();
}

__global__ void __launch_bounds__(NWAVES * 64, 2) mk_fwd(Args args) {
    extern __shared__ __attribute__((aligned(16))) unsigned char lds[];
    LAS unsigned char* L = (LAS unsigned char*)lds;
    volatile LAS unsigned* MISC = (volatile LAS unsigned*)(L + MISC_OFF);
    const int tid = threadIdx.x, lane = tid & 63, wave = __builtin_amdgcn_readfirstlane(tid >> 6);
    const int G = gridDim.x, bx = blockIdx.x;
    const int vcu = (G % 8 == 0) ? (bx % 8) * (G / 8) + bx / 8 : bx;
    unsigned char* ws = args.ws;
    gu32* ctl = (gu32*)(ws + WS_CTL);
    const float* x = args.in[0]; const float* meta = args.in[1]; const float* ln_in_g = args.in[2]; const float* ln_in_b = args.in[3];
    const float* w_in = args.in[4]; const float* sinks = args.in[5]; const float* w_out = args.in[6]; const float* ln_mix_g = args.in[7]; const float* ln_mix_b = args.in[8];
    const float* wq = args.in[9]; const float* subkeys = args.in[10]; const float* u_tab = args.in[11]; const float* v_tab = args.in[12];
    const float* ln_ffn_g = args.in[13]; const float* ln_ffn_b = args.in[14];
    float* out = args.out;
    bf16* W1T = (bf16*)(ws + WS_W1T); bf16* W2T = (bf16*)(ws + WS_W2T); bf16* W3T = (bf16*)(ws + WS_W3T);
    bf16* H0 = (bf16*)(ws + WS_H0); bf16* QR = (bf16*)(ws + WS_QR); bf16* KA = (bf16*)(ws + WS_KA); bf16* VA = (bf16*)(ws + WS_VA);
    bf16* RK = (bf16*)(ws + WS_RK); bf16* RV = (bf16*)(ws + WS_RV); bf16* RG = (bf16*)(ws + WS_RG);
    bf16* Y = (bf16*)(ws + WS_Y); bf16* H1 = (bf16*)(ws + WS_H1); bf16* Q3 = (bf16*)(ws + WS_QR);
    bf16* STB = (bf16*)(ws + WS_ST);
    f32x2* ROPE_R = (f32x2*)(ws + WS_ROPE_R); f32x2* ROPE_A = (f32x2*)(ws + WS_ROPE_A);
    unsigned short* IDS = (unsigned short*)(ws + WS_IDS); float* GATES = (float*)(ws + WS_GATES);
    bf16* SKB = (bf16*)(ws + WS_SK);
    bf16* UT = (bf16*)(ws + WS_UT); bf16* VT = (bf16*)(ws + WS_VT);

    for (int u = tid; u < (LDS_BYTES - LDSCTL_OFF) / 4; u += NWAVES * 64) ((LAS unsigned*)(L + LDSCTL_OFF))[u] = 0u;
    __syncthreads();
    XcdBarrier bar; bar.bar = (unsigned*)(ctl + CW_BAR); bar.x = xb_xcc_id(); bar.st = MISC + 8;
    if (tid == 0) MISC[10] = xb_add(&bar.bar[XB_XCNT(bar.x)], 1u);
#define GRID_BAR() xcd_barrier(bar)
    const int gw = vcu * NWAVES + wave, NGW = G * NWAVES;
    const int gt = gw * 64 + lane, NGT = NGW * 64;

    {
        int lane = threadIdx.x; asm volatile("" : "+v"(lane)); lane &= 63; const int gt = gw * 64 + lane;
        LAS float* scr = (LAS float*)(L + RING_OFF + wave * 16384);
        constexpr int I_1 = (DM / 64) * (IN_COLS / 32), I_2 = (DM / 64) * (DM / 32), I_3 = I_2;
        for (int it = gw; it < I_1 + I_2 + I_3; it += NGW) {
            int r = it;
            if (r < I_1) { p0_transpose_item<true>(w_in, DM, IN_COLS, W1T, scr, r, lane); continue; } r -= I_1;
            if (r < I_2) { p0_transpose_item<false>(w_out, DM, DM, W2T, scr, r, lane); continue; } r -= I_2;
            p0_transpose_item<false>(wq, DM, DM, W3T, scr, r, lane);
        }
        for (int m = gw; m < MROWS; m += NGW) {
            if (m < NTOK) ln_row_f32_to_bf16(x + (size_t)m * DM, ln_in_g, ln_in_b, H0 + (size_t)m * DM, lane);
            else if (m < NVALID) ln_row_f32_to_bf16(meta + (size_t)(m - NTOK) * DM, ln_in_g, ln_in_b, H0 + (size_t)m * DM, lane);
            else { GAS v4u* o = (GAS v4u*)(H0 + (size_t)m * DM) + lane;
#pragma unroll
                for (int j = 0; j < 4; ++j) o[64 * j] = (v4u){0u, 0u, 0u, 0u}; }
        }
        for (int e = gt; e < 16 * 128 * 128 / 8; e += NGT) { const GAS f32x4* src = (const GAS f32x4*)subkeys + 2 * (size_t)e; const f32x4 a = src[0], b2 = src[1];
            v4u o; o.x = pk2(a.x, a.y); o.y = pk2(a.z, a.w); o.z = pk2(b2.x, b2.y); o.w = pk2(b2.z, b2.w); ((GAS v4u*)SKB)[e] = o; }
        for (int e = gt; e < 4112 * 128; e += NGT) { const int pos = e >> 7, i = e & 127; const float inv = powf(10000.0f, -(float)(2 * i) / 256.0f); float sn, cs; sincosf((float)pos * inv, &sn, &cs); ROPE_R[e] = (f32x2){cs, sn}; }
        for (int e = gt; e < 4112 * 32; e += NGT) { const int pos = e >> 5, i = e & 31; const float inv = powf(10000.0f, -(float)(2 * i) / 64.0f); float sn, cs; sincosf((float)pos * inv, &sn, &cs); ROPE_A[e] = (f32x2){cs, sn}; }
    }
    GRID_BAR();

    {
        pg8::Gemm g{H0, W1T, MROWS, IN_COLS, DM}; pg8::StaticOrder S; S.init(MROWS, IN_COLS, G, bx);
        pg8::EpiProj E{QR, KA, VA, RK, RV, RG, (const float*)ROPE_R, (const float*)ROPE_A, QSCALE};
        pg8::gemm_phase<pg8::EpiProj, pg8::StaticOrder, true, true>(L + RING_OFF, g, S, E);
    }
    {
        constexpr int NQ = 16384 * DM / 4, CHQ = 16384, NCH = 2 * NQ / CHQ;
        for (;;) {
            int ch = 0; if (lane == 0) ch = (int)__hip_atomic_fetch_add((unsigned*)(ctl + CW_TABQ), 1u, __ATOMIC_RELAXED, __HIP_MEMORY_SCOPE_AGENT);
            ch = __builtin_amdgcn_readfirstlane(ch); if (ch >= NCH) break;
            const int which = ch >= NCH / 2; const float sc = which ? V_SCALE : U_SCALE;
            const GAS f32x4* src = (const GAS f32x4*)(which ? v_tab : u_tab) + (size_t)(ch - which * (NCH / 2)) * CHQ + lane;
            GAS unsigned char* dstb = (GAS unsigned char*)(which ? (void*)VT : (void*)UT);
            const int i4b = (ch - which * (NCH / 2)) * CHQ + lane;
#pragma unroll 1
            for (int it = 0; it < CHQ / 64; it += 8) {
                f32x4 a[8];
#pragma unroll
                for (int u8 = 0; u8 < 8; ++u8) a[u8] = src[(it + u8) * 64];
#pragma unroll
                for (int u8 = 0; u8 < 8; ++u8) { const int i4 = i4b + (it + u8) * 64; const int row = i4 >> 9, q4 = i4 & 511;
                    int w = __builtin_amdgcn_cvt_pk_fp8_f32(a[u8].x * sc, a[u8].y * sc, 0, false); w = __builtin_amdgcn_cvt_pk_fp8_f32(a[u8].z * sc, a[u8].w * sc, w, true);
                    *(GAS unsigned*)(dstb + ((size_t)(q4 >> 5) * 16384 + row) * 128 + (q4 & 31) * 4) = (unsigned)w; }
            }
        }
    }
    GRID_BAR();

    for (int u = bx; u < 256; u += G) attn_unit(L + RING_OFF, u, QR, KA, VA, sinks, tid, lane, wave);

    for (int u = bx; u < 256; u += G) scan_unit(L + RING_OFF, u, RK, RV, STB, tid, lane, wave);
    GRID_BAR();

    for (int u = bx; u < 512; u += G) retout_unit(L + RING_OFF, u, QR, RK, RV, RG, STB, tid, lane, wave);
    GRID_BAR();

    {
        pg8::Gemm g{QR, W2T, NTOK, DM, DM}; pg8::StaticOrder S; S.init(NTOK, DM, G, bx);
        pg8::EpiGen<1> E{Y, DM, H0, ALPHA, nullptr, nullptr, nullptr, nullptr, nullptr, nullptr};
        pg8::gemm_phase<pg8::EpiGen<1>, pg8::StaticOrder, true, true>(L + RING_OFF, g, S, E);
    }
    GRID_BAR();

    for (int m = gw; m < NTOK; m += NGW) ln_row_bf16_to_bf16(Y + (size_t)m * DM, ln_mix_g, ln_mix_b, H1 + (size_t)m * DM, lane);
    GRID_BAR();

    {
        pg8::Gemm g{H1, W3T, NTOK, DM, DM}; pg8::StaticOrder S; S.init(NTOK, DM, G, bx);
        pg8::EpiGen<2> E{Q3, DM, nullptr, 0.f, nullptr, nullptr, nullptr, nullptr, nullptr, nullptr};
        pg8::gemm_phase<pg8::EpiGen<2>, pg8::StaticOrder, true, true>(L + RING_OFF, g, S, E);
    }
    GRID_BAR();

    const bool g8 = (G & 7) == 0; const int nbh = g8 ? (G >> 3) : G, hb = g8 ? (bx >> 3) : bx;
    for (int hd = g8 ? (bx & 7) : 0; hd < 8; hd += g8 ? 8 : 1) {
        __syncthreads();
#pragma unroll
        for (int i = 0; i < 8; ++i) { const int cid = tid + 512 * i, p = cid >> 11, n = (cid >> 4) & 127, ch = cid & 15;
            *(LAS v4u*)(L + RING_OFF + p * 32768 + n * 256 + ((ch ^ (n & 15)) << 4)) = *(const GAS v4u*)(SKB + ((size_t)((hd * 2 + p) * 128 + n)) * 128 + ch * 8); }
        __syncthreads();
        for (int tt = hb * NWAVES + wave; tt < NTOK / 32; tt += nbh * NWAVES) topk_unit((LAS unsigned*)(L + RING_OFF + 65536 + wave * 8192), L + RING_OFF, tt, hd, Q3, IDS, GATES, lane);
    }
    __syncthreads();
    GRID_BAR();

    int nx = 0, xr = 0, nloc = 1;
    { unsigned* bw = (unsigned*)(ctl + CW_BAR);
#pragma unroll
      for (unsigned j2 = 0; j2 < 16; ++j2) { const unsigned cnt = xb_ld(&bw[XB_XCNT(j2)]); nx += cnt > 0u; xr += (j2 < bar.x && cnt > 0u); if (j2 == bar.x) nloc = (int)cnt; }
      nx = __builtin_amdgcn_readfirstlane(nx); xr = __builtin_amdgcn_readfirstlane(xr); nloc = __builtin_amdgcn_readfirstlane(nloc); if (nx < 1) nx = 1; if (nloc < 1) nloc = 1; }
    const int lrank = __builtin_amdgcn_readfirstlane((int)MISC[10]);
    const int wv = lrank * NWAVES + wave, nwv = nloc * NWAVES;
    float* DOTX = (float*)(ws + WS_RK);
    bf16* CB = (bf16*)(ws + WS_KA);
    bf16* YB = (bf16*)(ws + WS_H0);
    {
        int tl = tid; asm volatile("" : "+v"(tl)); const int ln = tl & 63, k = ln >> 3, c8 = ln & 7;
        const unsigned char* UT8 = (const unsigned char*)UT;
        for (int s = xr; s < NSL; s += nx) {
            const unsigned char* Us = UT8 + (size_t)s * 16384 * 128;
            const bool first = (s == xr);
            v4u nid[2][2];
#pragma unroll
            for (int z = 0; z < 2; ++z) { const int tz = wv + z * nwv; const int tc = tz < NTOK ? tz : wv; const GAS v4u* ip = (const GAS v4u*)(IDS + (size_t)tc * 128 + 16 * k);
#pragma unroll
                for (int i = 0; i < 2; ++i) nid[z][i] = ip[i]; }
#pragma unroll 1
            for (int t = wv; t < NTOK; t += 2 * nwv) {
                const bool vB = (t + nwv) < NTOK; const int tt[2] = {t, vB ? t + nwv : t};
                v4u ub[2][16]; v4u hs[2][2]; f32x2 old[2];
#pragma unroll
                for (int z = 0; z < 2; ++z) {
#pragma unroll
                    for (int i = 0; i < 16; ++i) { const int pe = 2 * (i & 7) + (i >> 3); const unsigned eid = (nid[z][pe >> 3][(pe >> 1) & 3] >> (16 * (pe & 1))) & 0xffffu; ub[z][i] = *(const GAS v4u*)(Us + (size_t)eid * 128 + 16 * c8); }
                    { const GAS v4u* hp = (const GAS v4u*)(H1 + (size_t)tt[z] * DM + 128 * s + 16 * c8); hs[z][0] = hp[0]; hs[z][1] = hp[1]; } }
#pragma unroll
                for (int z = 0; z < 2; ++z) old[z] = first ? (f32x2){0.f, 0.f} : *(const GAS f32x2*)(DOTX + ((size_t)xr * NTOK + tt[z]) * 128 + 2 * ln);
#pragma unroll
                for (int z = 0; z < 2; ++z) { const int tz = t + (2 + z) * nwv; const int tc = tz < NTOK ? tz : t; const GAS v4u* ip = (const GAS v4u*)(IDS + (size_t)tc * 128 + 16 * k);
#pragma unroll
                    for (int i = 0; i < 2; ++i) nid[z][i] = ip[i]; }
#pragma unroll
                for (int z = 0; z < 2; ++z) {
                    float p[16]; f32x2 hp2[8];
#pragma unroll
                    for (int i = 0; i < 2; ++i)
#pragma unroll
                        for (int c4 = 0; c4 < 4; ++c4) hp2[4 * i + c4] = (f32x2){bflo(hs[z][i][c4]), bfhi(hs[z][i][c4])};
#pragma unroll
                    for (int i = 0; i < 16; ++i) { f32x2 d2 = {0.f, 0.f};
#pragma unroll
                        for (int dw = 0; dw < 4; ++dw) { const f32x2 fl = __builtin_amdgcn_cvt_pk_f32_fp8((int)ub[z][i][dw], false), fh = __builtin_amdgcn_cvt_pk_f32_fp8((int)ub[z][i][dw], true);
                            d2 = __builtin_elementwise_fma(fl, hp2[2 * dw], d2); d2 = __builtin_elementwise_fma(fh, hp2[2 * dw + 1], d2); }
                        p[i] = d2.x + d2.y; }
                    const bool b0 = (c8 & 1) != 0, b1 = (c8 & 2) != 0, b2 = (c8 & 4) != 0;
                    float r1[8], r2[4], q0, q1;
#pragma unroll
                    for (int m = 0; m < 8; ++m) { const float keep = b0 ? p[2 * m + 1] : p[2 * m], give = b0 ? p[2 * m] : p[2 * m + 1]; r1[m] = keep + DPPF(give, 0xB1); }
#pragma unroll
                    for (int m = 0; m < 4; ++m) { const float keep = b1 ? r1[2 * m + 1] : r1[2 * m], give = b1 ? r1[2 * m] : r1[2 * m + 1]; r2[m] = keep + DPPF(give, 0x4E); }
                    { const float keep = b2 ? r2[1] : r2[0], give = b2 ? r2[0] : r2[1]; const float gl = DPPF(give, 0x104), gr = DPPF(give, 0x114); q0 = keep + (b2 ? gr : gl); }
                    { const float keep = b2 ? r2[3] : r2[2], give = b2 ? r2[2] : r2[3]; const float gl = DPPF(give, 0x104), gr = DPPF(give, 0x114); q1 = keep + (b2 ? gr : gl); }
                    if (z == 0 || vB) *(GAS f32x2*)(DOTX + ((size_t)xr * NTOK + tt[z]) * 128 + 2 * ln) = (f32x2){q0 + old[z].x, q1 + old[z].y};
                }
            }
        }
    }
    GRID_BAR();
    for (int idx = gt; idx < NTOK * 128; idx += NGT) { float d = 0.f; for (int xx = 0; xx < nx; ++xx) d += DOTX[(size_t)xx * NTOK * 128 + idx]; CB[idx] = (bf16)f2bf((1.0f / V_SCALE) * GATES[idx] * gelu_erf(d * (1.0f / U_SCALE))); }
    GRID_BAR();
    {
        int tl = tid; asm volatile("" : "+v"(tl)); const int ln = tl & 63, k = ln >> 3, c8 = ln & 7;
        const unsigned char* VT8 = (const unsigned char*)VT;
        for (int s = xr; s < NSL; s += nx) {
            const unsigned char* Vs = VT8 + (size_t)s * 16384 * 128;
            v4u nid[2][2];
#pragma unroll
            for (int z = 0; z < 2; ++z) { const int tz = wv + z * nwv; const int tc = tz < NTOK ? tz : wv; const GAS v4u* ip = (const GAS v4u*)(IDS + (size_t)tc * 128 + 16 * k);
#pragma unroll
                for (int i = 0; i < 2; ++i) nid[z][i] = ip[i]; }
#pragma unroll 1
            for (int t = wv; t < NTOK; t += 2 * nwv) {
                const bool vB = (t + nwv) < NTOK; const int tt[2] = {t, vB ? t + nwv : t};
                v4u vb[2][16]; v4u cf[2][2]; unsigned hs[2];
#pragma unroll
                for (int z = 0; z < 2; ++z) {
#pragma unroll
                    for (int i = 0; i < 16; ++i) { const unsigned eid = (nid[z][i >> 3][(i >> 1) & 3] >> (16 * (i & 1))) & 0xffffu; vb[z][i] = *(const GAS v4u*)(Vs + (size_t)eid * 128 + 16 * c8); } }
#pragma unroll
                for (int z = 0; z < 2; ++z) { hs[z] = *(const GAS unsigned*)(H1 + (size_t)tt[z] * DM + 128 * s + 16 * c8 + 2 * k);
                    const GAS v4u* cp = (const GAS v4u*)(CB + (size_t)tt[z] * 128 + 16 * k); cf[z][0] = cp[0]; cf[z][1] = cp[1]; }
#pragma unroll
                for (int z = 0; z < 2; ++z) { const int tz = t + (2 + z) * nwv; const int tc = tz < NTOK ? tz : t; const GAS v4u* ip = (const GAS v4u*)(IDS + (size_t)tc * 128 + 16 * k);
#pragma unroll
                    for (int i = 0; i < 2; ++i) nid[z][i] = ip[i]; }
#pragma unroll
                for (int z = 0; z < 2; ++z) {
                    f32x2 accp[8];
#pragma unroll
                    for (int q2 = 0; q2 < 8; ++q2) accp[q2] = (f32x2){0.f, 0.f};
#pragma unroll
                    for (int i = 0; i < 16; ++i) { const unsigned cw = cf[z][i >> 3][(i >> 1) & 3]; const float c = (i & 1) ? bfhi(cw) : bflo(cw); const f32x2 c2 = {c, c};
#pragma unroll
                        for (int dw = 0; dw < 4; ++dw) { const f32x2 fl = __builtin_amdgcn_cvt_pk_f32_fp8((int)vb[z][i][dw], false), fh = __builtin_amdgcn_cvt_pk_f32_fp8((int)vb[z][i][dw], true);
                            accp[2 * dw] = __builtin_elementwise_fma(fl, c2, accp[2 * dw]); accp[2 * dw + 1] = __builtin_elementwise_fma(fh, c2, accp[2 * dw + 1]); } }
                    const bool kb0 = (k & 1) != 0, kb1 = (k & 2) != 0, kb2 = (k & 4) != 0;
                    f32x2 rA[4], rB[2], rC;
#pragma unroll
                    for (int m = 0; m < 4; ++m) { const f32x2 keep = kb0 ? accp[2 * m + 1] : accp[2 * m], give = kb0 ? accp[2 * m] : accp[2 * m + 1];
                        rA[m] = keep + (f32x2){DPPF(give.x, 0x128), DPPF(give.y, 0x128)}; }
#pragma unroll
                    for (int m = 0; m < 2; ++m) { const f32x2 keep = kb1 ? rA[2 * m + 1] : rA[2 * m], give = kb1 ? rA[2 * m] : rA[2 * m + 1];
                        const auto sx = __builtin_amdgcn_permlane16_swap(__float_as_uint(give.x), __float_as_uint(give.x), false, false), sy = __builtin_amdgcn_permlane16_swap(__float_as_uint(give.y), __float_as_uint(give.y), false, false);
                        rB[m] = keep + (f32x2){__uint_as_float(kb1 ? sx[0] : sx[1]), __uint_as_float(kb1 ? sy[0] : sy[1])}; }
                    { const f32x2 keep = kb2 ? rB[1] : rB[0], give = kb2 ? rB[0] : rB[1];
                        const auto sx = __builtin_amdgcn_permlane32_swap(__float_as_uint(give.x), __float_as_uint(give.x), false, false), sy = __builtin_amdgcn_permlane32_swap(__float_as_uint(give.y), __float_as_uint(give.y), false, false);
                        rC = keep + (f32x2){__uint_as_float(kb2 ? sx[0] : sx[1]), __uint_as_float(kb2 ? sy[0] : sy[1])}; }
                    if (z == 0 || vB) *(GAS unsigned*)(YB + (size_t)tt[z] * DM + 128 * s + 16 * c8 + 2 * k) = cvtpk_s(rC.x + ALPHA * bflo(hs[z]), rC.y + ALPHA * bfhi(hs[z]));
                }
            }
        }
    }
    GRID_BAR();
    for (int m = gw; m < NTOK; m += NGW) {
        const GAS v4u* xr4 = (const GAS v4u*)(YB + (size_t)m * DM) + lane;
        float v[32]; float sm = 0.f;
#pragma unroll
        for (int j2 = 0; j2 < 4; ++j2) { const v4u w = xr4[64 * j2];
            v[8 * j2 + 0] = bflo(w.x); v[8 * j2 + 1] = bfhi(w.x); v[8 * j2 + 2] = bflo(w.y); v[8 * j2 + 3] = bfhi(w.y); v[8 * j2 + 4] = bflo(w.z); v[8 * j2 + 5] = bfhi(w.z); v[8 * j2 + 6] = bflo(w.w); v[8 * j2 + 7] = bfhi(w.w); }
#pragma unroll
        for (int i = 0; i < 32; ++i) sm += v[i];
        const float mean = wave_sum(sm) * (1.f / DM); float s2 = 0.f;
#pragma unroll
        for (int i = 0; i < 32; ++i) { v[i] -= mean; s2 += v[i] * v[i]; }
        const float rstd = 1.f / sqrtf(wave_sum(s2) * (1.f / DM) + LN_EPS);
#pragma unroll
        for (int j2 = 0; j2 < 4; ++j2) {
            const GAS f32x4* gp = (const GAS f32x4*)ln_ffn_g + 2 * (lane + 64 * j2); const GAS f32x4* bp = (const GAS f32x4*)ln_ffn_b + 2 * (lane + 64 * j2);
            const f32x4 g0 = gp[0], g1 = gp[1], b0 = bp[0], b1 = bp[1];
            GAS f32x4* op = (GAS f32x4*)(out + (size_t)m * DM) + 2 * (lane + 64 * j2);
            op[0] = (f32x4){v[8 * j2 + 0] * rstd * g0.x + b0.x, v[8 * j2 + 1] * rstd * g0.y + b0.y, v[8 * j2 + 2] * rstd * g0.z + b0.z, v[8 * j2 + 3] * rstd * g0.w + b0.w};
            op[1] = (f32x4){v[8 * j2 + 4] * rstd * g1.x + b1.x, v[8 * j2 + 5] * rstd * g1.y + b1.y, v[8 * j2 + 6] * rstd * g1.z + b1.z, v[8 * j2 + 7] * rstd * g1.w + b1.w}; }
    }
}

extern "C" void kernel_launch(void* const* d_in, const int* in_sizes, int n_in, void* d_out, int out_size, void* d_ws, size_t ws_size, hipStream_t stream) {
    static int grid = 0;
    if (grid == 0) {
        if (n_in != 15 || out_size != NTOK * DM || ws_size < WS_END) { fprintf(stderr, "kernel_launch: unexpected shapes (n_in %d out %d ws %zu)\n", n_in, out_size, ws_size); grid = -1; return; }
        int dev = 0, cus = 0, per_cu = 0;
        if (hipGetDevice(&dev) != hipSuccess || hipDeviceGetAttribute(&cus, hipDeviceAttributeMultiprocessorCount, dev) != hipSuccess) { grid = -1; return; }
        if (hipFuncSetAttribute((const void*)mk_fwd, hipFuncAttributeMaxDynamicSharedMemorySize, LDS_BYTES) != hipSuccess) { fprintf(stderr, "kernel_launch: hipFuncSetAttribute failed\n"); grid = -1; return; }
        if (hipOccupancyMaxActiveBlocksPerMultiprocessor(&per_cu, (const void*)mk_fwd, NWAVES * 64, LDS_BYTES) != hipSuccess || per_cu < 1) { fprintf(stderr, "kernel_launch: occupancy query says %d\n", per_cu); }
        (void)hipGetLastError();
        grid = cus;
    }
    if (grid < 0) return;
    if (hipMemsetAsync((char*)d_ws + WS_CTL, 0, CTL_ZERO_BYTES, stream) != hipSuccess) return;
    Args a{};
    for (int i = 0; i < 15; ++i) a.in[i] = (const float*)d_in[i];
    a.out = (float*)d_out; a.ws = (unsigned char*)d_ws;
    hipLaunchKernelGGL(mk_fwd, dim3(grid), dim3(NWAVES * 64), LDS_BYTES, stream, a);
}
```

```cpp
#include <hip/hip_runtime.h>
#include <cstdio>
#include <cstdint>
#include <cmath>
namespace pg8 {
#define PG8_LAS __attribute__((address_space(3)))
typedef unsigned short bf16_t;
typedef short bf16x8 __attribute__((ext_vector_type(8)));
typedef float f32x4 __attribute__((ext_vector_type(4)));
typedef unsigned u32x4 __attribute__((ext_vector_type(4)));
constexpr int BM = 256, BK = 64, HALF = 128, HTB = HALF * BK * 2  , STAGE_BYTES = 8 * HTB, NXCD = 8, WGM = 8;

__host__ __device__ __forceinline__ int lds_byte(int r, int c) { const int st = (r >> 4) * 2 + (c >> 5), rr = r & 15, cc = c & 31, ob = rr * 64 + cc * 2; return st * 1024 + (ob ^ (((ob >> 9) & 1) << 5)); }
__host__ __device__ __forceinline__ void stage_rc(int b, int& R, int& C) { const int st = b / 1024, sb = b % 1024, swz = sb ^ (((sb >> 9) & 1) << 5); R = (st >> 1) * 16 + swz / 64; C = (st & 1) * 32 + (swz % 64) / 2; }
__host__ __device__ __forceinline__ int perm32(int rho) { const int n = rho >> 4, i = rho & 15; return 8 * (i >> 2) + 4 * n + (i & 3); }

struct Unit { int pm, pn; };
struct Gemm { const bf16_t* A; const bf16_t* Bt; int M, N, K; };

struct StaticOrder {
    int nM, nN, nwg, G, c;
    __host__ __device__ void init(int M, int N, int G_, int c_) { nM = M / BM; nN = N / BM; nwg = nM * nN; G = G_; c = c_; }
    __host__ __device__ bool next(int i, Unit& u) const {
        const long L = (long)i * G + c; if (L >= nwg) return false;
        int wgid = (int)L; { const int q = nwg / NXCD, r = nwg % NXCD, xcd = wgid % NXCD, off = wgid / NXCD; wgid = (xcd < r ? xcd * (q + 1) : r * (q + 1) + (xcd - r) * q) + off; }
        const int nig = WGM * nN, gid = wgid / nig, fm = gid * WGM, gsz = (nM - fm) < WGM ? (nM - fm) : WGM;
        u.pm = fm + ((wgid % nig) % gsz); u.pn = (wgid % nig) / gsz; return true;
    }
    __device__ __forceinline__ void a_ready(const Unit&) const {}
    __device__ __forceinline__ void done(const Unit&) const {}
};

__device__ __forceinline__ unsigned cvt_pk_bf16(float lo, float hi) { unsigned r; asm volatile("v_cvt_pk_bf16_f32 %0, %1, %2" : "=v"(r) : "v"(lo), "v"(hi)); return r; }
typedef float f32x2 __attribute__((ext_vector_type(2)));

template <int MODE> struct EpiGen {
    static constexpr bool PERM = true, AFTER_DRAIN = false;
    bf16_t* O; int ldc; const bf16_t* R; float alpha;
    bf16_t *QR, *KA, *VA, *RK, *RV, *RG;
    __device__ __forceinline__ void operator()(const f32x4 (&acc)[2][2][4][2], const Unit& u, int wr, int wc, int fr, int fq) const {
        const int row0 = u.pm * BM + wr * 64 + fr;
#pragma unroll
        for (int bj = 0; bj < 2; ++bj) {
            const int col = u.pn * BM + bj * HALF + wc * 32 + 8 * fq;
            bf16_t* base = O; int ld = ldc; int cc = col;
            if (MODE == 0) {
                if (col < 1024)      { base = QR; ld = 2048; cc = col; }
                else if (col < 1152) { base = KA; ld = 128;  cc = col - 1024; }
                else if (col < 1280) { base = VA; ld = 128;  cc = col - 1152; }
                else if (col < 2304) { base = QR; ld = 2048; cc = col - 1280 + 1024; }
                else if (col < 3328) { base = RK; ld = 1024; cc = col - 2304; }
                else if (col < 4352) { base = RV; ld = 1024; cc = col - 3328; }
                else                 { base = RG; ld = 1024; cc = col - 4352; }
            }
#pragma unroll
            for (int ai = 0; ai < 2; ++ai)
#pragma unroll
                for (int m = 0; m < 4; ++m) {
                    const int row = row0 + ai * HALF + m * 16;
                    f32x4 v0 = acc[ai][bj][m][0], v1 = acc[ai][bj][m][1];
                    if (MODE == 1) {
                        const u32x4 r = *(const u32x4*)(R + (size_t)row * ldc + col);
                        v0[0] += alpha * __uint_as_float(r.x << 16); v0[1] += alpha * __uint_as_float(r.x & 0xffff0000u);
                        v0[2] += alpha * __uint_as_float(r.y << 16); v0[3] += alpha * __uint_as_float(r.y & 0xffff0000u);
                        v1[0] += alpha * __uint_as_float(r.z << 16); v1[1] += alpha * __uint_as_float(r.z & 0xffff0000u);
                        v1[2] += alpha * __uint_as_float(r.w << 16); v1[3] += alpha * __uint_as_float(r.w & 0xffff0000u);
                    }
                    u32x4 w; w.x = cvt_pk_bf16(v0[0], v0[1]); w.y = cvt_pk_bf16(v0[2], v0[3]); w.z = cvt_pk_bf16(v1[0], v1[1]); w.w = cvt_pk_bf16(v1[2], v1[3]);
                    *(u32x4*)(base + (size_t)row * ld + cc) = w;
                }
        }
    }
};

struct EpiProj {
    static constexpr bool PERM = true, AFTER_DRAIN = false;
    bf16_t *QR, *KA, *VA, *RK, *RV, *RG; float qscale;
    __device__ __forceinline__ void operator()(const f32x4 (&acc)[2][2][4][2], const Unit& u, int wr, int wc, int fr, int fq) const {
        const int pn = u.pn, row0 = u.pm * BM + wr * 64 + fr, c0 = wc * 32 + 8 * fq;
        const bool rope = (pn <= 3) || (pn == 4 && wc < 2) || (pn >= 5 && pn <= 12);
        if (rope) {
            const bool ret = pn >= 5; const int h = ret ? ((pn - 5) & 3) : 0;
            const float lg = __builtin_amdgcn_logf(1.0f - __builtin_amdgcn_exp2f(-5.0f - (float)h));
            float invrev[8];
#pragma unroll
            for (int i8 = 0; i8 < 8; ++i8) { const float ii = (float)((ret ? c0 : 8 * fq) + i8); invrev[i8] = 0.15915494309189535f * __builtin_amdgcn_exp2f(-ii * (ret ? 0.10381025296523008f : 0.4152410118609203f)); }
            bf16_t* base; int ld, cA, cB;
            if (pn <= 3)      { base = QR; ld = 2048; cA = pn * 256 + 64 * wc + 8 * fq; cB = cA + 32; }
            else if (pn == 4) { base = KA; ld = 128;  cA = 64 * wc + 8 * fq; cB = cA + 32; }
            else if (pn <= 8) { base = QR; ld = 2048; cA = 1024 + 256 * h + c0; cB = cA + 128; }
            else              { base = RK; ld = 1024; cA = 256 * h + c0; cB = cA + 128; }
#pragma unroll
            for (int ai = 0; ai < 2; ++ai)
#pragma unroll
                for (int m = 0; m < 4; ++m) {
                    const int row = row0 + ai * HALF + m * 16;
                    int pos, ipos;
                    if (row < 16384) { const int s = row & 4095; pos = 16 + s; ipos = s & 127; } else { int j = row - 16384; if (j > 15) j = 15; pos = j; ipos = 112 + j; }
                    float sc = qscale;
                    if (pn == 4) sc = 1.0f; else if (pn >= 9) sc = 0.0625f * __builtin_amdgcn_exp2f(-(float)(ipos + 1) * lg); else if (pn >= 5) sc = __builtin_amdgcn_exp2f((float)(ipos + 1) * lg);
                    const float pf = (float)pos;
                    float cs[8], sn[8];
#pragma unroll
                    for (int i8 = 0; i8 < 8; ++i8) { const float rev = __builtin_amdgcn_fractf(pf * invrev[i8]); cs[i8] = __builtin_amdgcn_cosf(rev); sn[i8] = __builtin_amdgcn_sinf(rev); }
                    const f32x4 a0 = acc[ai][0][m][0], a1 = acc[ai][0][m][1], b0 = acc[ai][1][m][0], b1 = acc[ai][1][m][1];
                    u32x4 wA, wB;
                    wA.x = cvt_pk_bf16((a0[0] * cs[0] - b0[0] * sn[0]) * sc, (a0[1] * cs[1] - b0[1] * sn[1]) * sc); wA.y = cvt_pk_bf16((a0[2] * cs[2] - b0[2] * sn[2]) * sc, (a0[3] * cs[3] - b0[3] * sn[3]) * sc);
                    wA.z = cvt_pk_bf16((a1[0] * cs[4] - b1[0] * sn[4]) * sc, (a1[1] * cs[5] - b1[1] * sn[5]) * sc); wA.w = cvt_pk_bf16((a1[2] * cs[6] - b1[2] * sn[6]) * sc, (a1[3] * cs[7] - b1[3] * sn[7]) * sc);
                    wB.x = cvt_pk_bf16((b0[0] * cs[0] + a0[0] * sn[0]) * sc, (b0[1] * cs[1] + a0[1] * sn[1]) * sc); wB.y = cvt_pk_bf16((b0[2] * cs[2] + a0[2] * sn[2]) * sc, (b0[3] * cs[3] + a0[3] * sn[3]) * sc);
                    wB.z = cvt_pk_bf16((b1[0] * cs[4] + a1[0] * sn[4]) * sc, (b1[1] * cs[5] + a1[1] * sn[5]) * sc); wB.w = cvt_pk_bf16((b1[2] * cs[6] + a1[2] * sn[6]) * sc, (b1[3] * cs[7] + a1[3] * sn[7]) * sc);
                    *(u32x4*)(base + (size_t)row * ld + cA) = wA; *(u32x4*)(base + (size_t)row * ld + cB) = wB;
                }
        } else {
            const bool silu = pn >= 17;
#pragma unroll
            for (int bj = 0; bj < 2; ++bj) {
                bf16_t* base; int ld, cc;
                if (pn == 4)       { base = VA; ld = 128;  cc = 64 * bj + 32 * (wc - 2) + 8 * fq; }
                else if (pn <= 16) { base = RV; ld = 1024; cc = 256 * (pn - 13) + 128 * bj + c0; }
                else               { base = RG; ld = 1024; cc = 256 * (pn - 17) + 128 * bj + c0; }
#pragma unroll
                for (int ai = 0; ai < 2; ++ai)
#pragma unroll
                    for (int m = 0; m < 4; ++m) {
                        const int row = row0 + ai * HALF + m * 16;
                        f32x4 v0 = acc[ai][bj][m][0], v1 = acc[ai][bj][m][1];
                        if (silu) {
#pragma unroll
                            for (int e = 0; e < 4; ++e) { v0[e] = v0[e] * __builtin_amdgcn_rcpf(1.0f + __builtin_amdgcn_exp2f(-1.4426950408889634f * v0[e])); v1[e] = v1[e] * __builtin_amdgcn_rcpf(1.0f + __builtin_amdgcn_exp2f(-1.4426950408889634f * v1[e])); } }
                        u32x4 w; w.x = cvt_pk_bf16(v0[0], v0[1]); w.y = cvt_pk_bf16(v0[2], v0[3]); w.z = cvt_pk_bf16(v1[0], v1[1]); w.w = cvt_pk_bf16(v1[2], v1[3]);
                        *(u32x4*)(base + (size_t)row * ld + cc) = w;
                    }
            }
        }
    }
};
template <class Epi, class Sched, bool ALIGN_EPI = false, bool SP2 = false>
__device__ __forceinline__ void gemm_phase(PG8_LAS unsigned char* lds, const Gemm g, const Sched& S, const Epi& E) {
    const int tid = threadIdx.x, wid = __builtin_amdgcn_readfirstlane(tid >> 6), lane = tid & 63, wr = wid >> 2, wc = wid & 3, fr = lane & 15, fq = lane >> 4;
    const int K = g.K, nt = K / BK;
    unsigned voffA[2], voffB[2];
#pragma unroll
    for (int i = 0; i < 2; ++i) { int R, C; stage_rc(tid * 16 + i * 8192, R, C); const int Rb = Epi::PERM ? ((R & ~31) + perm32(R & 31)) : R;
        voffA[i] = (unsigned)(R * K + C) * 2u; voffB[i] = (unsigned)(Rb * K + C) * 2u; }
    const size_t kstep = (size_t)(BK * 2);
    const size_t hstep = (size_t)HALF * K * 2;
    const size_t tstep = 2 * hstep;
    const unsigned ldsw = (unsigned)wid * 1024u;
    const int aoff = lds_byte(wr * 64 + fr, fq * 8), boff = lds_byte(wc * 32 + fr, fq * 8);
#define PG8_SA(b, h) (((b) * 2 + (h)) * HTB)
#define PG8_SB(b, h) ((4 + (b) * 2 + (h)) * HTB)
#define PG8_STAGE(bufoff, gbase, voff) do { _Pragma("unroll") for (int _i = 0; _i < 2; ++_i) \
        __builtin_amdgcn_global_load_lds((const unsigned*)((const char*)(gbase) + (voff)[_i]), (PG8_LAS unsigned*)(lds + (bufoff) + ldsw + _i * 8192), 16, 0, 0); } while (0)
#define PG8_LDA(dst, b, h) do { _Pragma("unroll") for (int m = 0; m < 4; ++m) _Pragma("unroll") for (int k = 0; k < 2; ++k) dst[m][k] = *(const PG8_LAS bf16x8*)(lds + PG8_SA(b, h) + aoff + m * 2048 + k * 1024); } while (0)
#define PG8_LDB(dst, b, h) do { _Pragma("unroll") for (int n = 0; n < 2; ++n) _Pragma("unroll") for (int k = 0; k < 2; ++k) dst[n][k] = *(const PG8_LAS bf16x8*)(lds + PG8_SB(b, h) + boff + n * 2048 + k * 1024); } while (0)
#define PG8_MMA(ai, bj, At, Bt) do { __builtin_amdgcn_s_setprio(1); _Pragma("unroll") for (int m = 0; m < 4; ++m) _Pragma("unroll") for (int n = 0; n < 2; ++n) _Pragma("unroll") for (int k = 0; k < 2; ++k) \
        acc[ai][bj][m][n] = __builtin_amdgcn_mfma_f32_16x16x32_bf16(Bt[n][k], At[m][k], acc[ai][bj][m][n], 0, 0, 0); __builtin_amdgcn_s_setprio(0); } while (0)
#define PG8_WAIT_V(n) asm volatile("s_waitcnt vmcnt(" #n ")" ::: "memory")
#define PG8_WAIT_L(n) asm volatile("s_waitcnt lgkmcnt(" #n ")" ::: "memory")
#define PG8_BAR __builtin_amdgcn_s_barrier()
#define PG8_SCHED __builtin_amdgcn_sched_barrier(0)
    Unit cur, nxt; int ui = 0;
    if (!S.next(0, cur)) return;
    f32x4 acc[2][2][4][2];
#pragma unroll
    for (int a = 0; a < 2; ++a)
#pragma unroll
        for (int b = 0; b < 2; ++b)
#pragma unroll
            for (int m = 0; m < 4; ++m)
#pragma unroll
                for (int n = 0; n < 2; ++n) acc[a][b][m][n] = (f32x4){0.f, 0.f, 0.f, 0.f};
    bf16x8 At[4][2], B0[2][2], B1[2][2];
    const char* cA = (const char*)g.A + (size_t)cur.pm * tstep; const char* cB = (const char*)g.Bt + (size_t)cur.pn * tstep;
    S.a_ready(cur);
    if constexpr (SP2) {
        PG8_STAGE(PG8_SB(0, 0), cB, voffB); PG8_STAGE(PG8_SB(0, 1), cB + hstep, voffB); PG8_STAGE(PG8_SA(0, 0), cA, voffA); PG8_STAGE(PG8_SA(0, 1), cA + hstep, voffA);
        if (wr == 1) PG8_BAR;
        PG8_WAIT_V(2); PG8_BAR;
        PG8_STAGE(PG8_SB(1, 0), cB + kstep, voffB); PG8_STAGE(PG8_SA(1, 0), cA + kstep, voffA); PG8_STAGE(PG8_SB(1, 1), cB + hstep + kstep, voffB);
        PG8_WAIT_V(6); PG8_BAR;
    } else {
        PG8_STAGE(PG8_SB(0, 0), cB, voffB); PG8_STAGE(PG8_SA(0, 0), cA, voffA); PG8_STAGE(PG8_SB(0, 1), cB + hstep, voffB); PG8_STAGE(PG8_SA(0, 1), cA + hstep, voffA);
        if (wr == 1) PG8_BAR;
        PG8_WAIT_V(4); PG8_BAR;
        PG8_STAGE(PG8_SB(1, 0), cB + kstep, voffB); PG8_STAGE(PG8_SA(1, 0), cA + kstep, voffA); PG8_STAGE(PG8_SB(1, 1), cB + hstep + kstep, voffB);
        PG8_WAIT_V(6); PG8_BAR;
    }
    for (;;) {
        const bool has_next = S.next(ui + 1, nxt);
        const char* nA = has_next ? (const char*)g.A + (size_t)nxt.pm * tstep : cA; const char* nB = has_next ? (const char*)g.Bt + (size_t)nxt.pn * tstep : cB;
        for (int t = 0; t < nt; t += 2) {
            const bool last = (t == nt - 2);
            const char* a1 = cA + (size_t)(t + 1) * kstep;
            const char* a2 = last ? nA : cA + (size_t)(t + 2) * kstep; const char* b2 = last ? nB : cB + (size_t)(t + 2) * kstep;
            const char* a3 = a2 + kstep; const char* b3 = b2 + kstep;
            if (last && has_next) S.a_ready(nxt);
            if constexpr (SP2) {
            PG8_LDB(B0, 0, 0); PG8_LDB(B1, 0, 1); PG8_SCHED; PG8_LDA(At, 0, 0); PG8_STAGE(PG8_SA(1, 1), a1 + hstep, voffA);
            PG8_WAIT_V(8); PG8_WAIT_L(0); PG8_BAR; PG8_MMA(0, 0, At, B0); PG8_MMA(0, 1, At, B1); PG8_BAR; PG8_SCHED;
            PG8_LDA(At, 0, 1); PG8_STAGE(PG8_SB(0, 0), b2, voffB); PG8_STAGE(PG8_SB(0, 1), b2 + hstep, voffB); PG8_STAGE(PG8_SA(0, 0), a2, voffA);
            PG8_WAIT_V(8); PG8_WAIT_L(0); PG8_BAR; PG8_MMA(1, 0, At, B0); PG8_MMA(1, 1, At, B1); PG8_BAR; PG8_SCHED;
            PG8_LDB(B0, 1, 0); PG8_LDB(B1, 1, 1); PG8_SCHED; PG8_LDA(At, 1, 0); PG8_STAGE(PG8_SA(0, 1), a2 + hstep, voffA);
            PG8_WAIT_V(8); PG8_WAIT_L(0); PG8_BAR; PG8_MMA(0, 0, At, B0); PG8_MMA(0, 1, At, B1); PG8_BAR; PG8_SCHED;
            PG8_LDA(At, 1, 1); PG8_STAGE(PG8_SB(1, 0), b3, voffB); PG8_STAGE(PG8_SB(1, 1), b3 + hstep, voffB); PG8_STAGE(PG8_SA(1, 0), a3, voffA);
            PG8_WAIT_V(8); PG8_WAIT_L(0); PG8_BAR; PG8_MMA(1, 0, At, B0); PG8_MMA(1, 1, At, B1); PG8_BAR; PG8_SCHED;
            } else {
            PG8_LDB(B0, 0, 0); PG8_SCHED; PG8_LDA(At, 0, 0); PG8_STAGE(PG8_SA(1, 1), a1 + hstep, voffA);
            PG8_WAIT_L(8); PG8_BAR; PG8_WAIT_L(0); PG8_MMA(0, 0, At, B0); PG8_BAR; PG8_SCHED;
            PG8_LDB(B1, 0, 1); PG8_STAGE(PG8_SB(0, 0), b2, voffB);
            PG8_BAR; PG8_WAIT_L(0); PG8_MMA(0, 1, At, B1); PG8_BAR;
            PG8_LDA(At, 0, 1); PG8_STAGE(PG8_SA(0, 0), a2, voffA);
            PG8_BAR; PG8_WAIT_L(0); PG8_MMA(1, 0, At, B0); PG8_BAR; PG8_SCHED;
            PG8_STAGE(PG8_SB(0, 1), b2 + hstep, voffB);
            PG8_WAIT_V(6); PG8_BAR; PG8_MMA(1, 1, At, B1); PG8_BAR;
            PG8_LDB(B0, 1, 0); PG8_SCHED; PG8_LDA(At, 1, 0); PG8_STAGE(PG8_SA(0, 1), a2 + hstep, voffA);
            PG8_WAIT_L(8); PG8_BAR; PG8_WAIT_L(0); PG8_MMA(0, 0, At, B0); PG8_BAR; PG8_SCHED;
            PG8_LDB(B1, 1, 1); PG8_STAGE(PG8_SB(1, 0), b3, voffB);
            PG8_BAR; PG8_WAIT_L(0); PG8_MMA(0, 1, At, B1); PG8_BAR;
            PG8_LDA(At, 1, 1); PG8_STAGE(PG8_SA(1, 0), a3, voffA);
            PG8_BAR; PG8_WAIT_L(0); PG8_MMA(1, 0, At, B0); PG8_BAR; PG8_SCHED;
            PG8_STAGE(PG8_SB(1, 1), b3 + hstep, voffB);
            PG8_WAIT_V(6); PG8_BAR; PG8_MMA(1, 1, At, B1); PG8_BAR;
            }
        }
        if constexpr (ALIGN_EPI) { if (wr == 0) PG8_BAR; }
        if constexpr (!Epi::AFTER_DRAIN) { E(acc, cur, wr, wc, fr, fq); S.done(cur); }
        if (!has_next) break;
#pragma unroll
        for (int a = 0; a < 2; ++a)
#pragma unroll
            for (int b = 0; b < 2; ++b)
#pragma unroll
                for (int m = 0; m < 4; ++m)
#pragma unroll
                    for (int n = 0; n < 2; ++n) acc[a][b][m][n] = (f32x4){0.f, 0.f, 0.f, 0.f};
        cur = nxt; cA = nA; cB = nB; ++ui;
        if constexpr (ALIGN_EPI) { if (wr == 1) PG8_BAR; }
    }
    PG8_WAIT_V(0);
    if constexpr (!ALIGN_EPI) { if (wr == 0) PG8_BAR; }
    PG8_BAR;
    if constexpr (Epi::AFTER_DRAIN) { E.fused(acc, cur, wr, wc, fr, fq, lds, wid, lane); S.done(cur); }
#undef PG8_SA
#undef PG8_SB
#undef PG8_STAGE
#undef PG8_LDA
#undef PG8_LDB
#undef PG8_MMA
#undef PG8_WAIT_V
#undef PG8_WAIT_L
#undef PG8_BAR
#undef PG8_SCHED
}
}

constexpr int NWAVES = 8;
constexpr int DM = 2048, NB = 4, SEQ = 4096, NTOK = NB * SEQ;
constexpr int NMETA = 16, NVALID = NTOK + NMETA, MROWS = 16640;
constexpr int IN_COLS = 5376;
constexpr float LN_EPS = 1e-5f, GN_EPS = 1e-5f;
constexpr float ALPHA = 1.189207115002721f;
constexpr float LOG2E = 1.4426950408889634f;
constexpr float QSCALE = 0.125f * LOG2E;
constexpr float U_SCALE = 64.0f, V_SCALE = 4.0f;
constexpr int NSL = 16;

constexpr size_t MiB = 1u << 20;
constexpr size_t WS_CTL = 0, CTL_ZERO_BYTES = 65536;
constexpr size_t SZ_SK = (size_t)16 * 128 * 128 * 2, SZ_ROPE_R = (size_t)4112 * 128 * 8, SZ_ROPE_A = (size_t)4112 * 32 * 8;
constexpr size_t SZ_W2T = (size_t)DM * DM * 2, SZ_W1T = (size_t)IN_COLS * DM * 2, SZ_TAB = (size_t)16384 * DM * 2;
constexpr size_t SZ_ROWS2K = (size_t)MROWS * 2048 * 2, SZ_ROWS1K = (size_t)MROWS * 1024 * 2, SZ_ROWS128 = (size_t)MROWS * 128 * 2;
constexpr size_t SZ_TOK2K = (size_t)NTOK * 2048 * 2, SZ_ST = (size_t)16 * 32 * 256 * 256 * 2, SZ_IDS = (size_t)NTOK * 128 * 4;
constexpr size_t al256(size_t x) { return (x + 255) & ~(size_t)255; }
constexpr size_t WS_SK = 1 * MiB;
constexpr size_t WS_ROPE_R = al256(WS_SK + SZ_SK);
constexpr size_t WS_ROPE_A = al256(WS_ROPE_R + SZ_ROPE_R);
constexpr size_t WS_W2T = al256(WS_ROPE_A + SZ_ROPE_A), WS_W3T = al256(WS_W2T + SZ_W2T), WS_W1T = al256(WS_W3T + SZ_W2T);
constexpr size_t WS_UT = al256(WS_W1T + SZ_W1T), WS_VT = al256(WS_UT + SZ_TAB);
constexpr size_t WS_H0 = al256(WS_VT + SZ_TAB);
constexpr size_t WS_QR = al256(WS_H0 + SZ_ROWS2K);
constexpr size_t WS_KA = al256(WS_QR + SZ_ROWS2K), WS_VA = al256(WS_KA + SZ_ROWS128);
constexpr size_t WS_RK = al256(WS_VA + SZ_ROWS128), WS_RV = al256(WS_RK + SZ_ROWS1K), WS_RG = al256(WS_RV + SZ_ROWS1K);
constexpr size_t WS_ST = al256(WS_RG + SZ_ROWS1K);
constexpr size_t WS_Y = WS_RK;
constexpr size_t WS_H1 = WS_ST;
constexpr size_t WS_IDS = al256(WS_ST + SZ_ST), WS_GATES = al256(WS_IDS + SZ_IDS);
constexpr size_t WS_END = al256(WS_GATES + SZ_IDS);
static_assert(WS_Y + SZ_TOK2K <= WS_RG, "Y overlays RK|RV only");
static_assert(SZ_TOK2K <= SZ_ST && (size_t)NTOK * 1024 * 4 <= SZ_ST, "H1 / RET_RAW fit the state region");
static_assert(WS_END <= (size_t)512 * MiB, "workspace map fits 4 x largest tensor");
static_assert(WS_RK + (size_t)8 * NTOK * 128 * 4 <= WS_ST && WS_KA + (size_t)NTOK * 128 * 4 <= WS_RK && WS_H0 + (size_t)NTOK * DM * 4 <= WS_KA, "expert-phase overlays (DOTX over RK|RV, CB over KA|VA, Y32 over H0|QR)");
constexpr int CW_TMO = 0, CW_TABQ = 64, CW_BAR = 4096;

constexpr int RING_OFF = 0, RING_BYTES = 131072;
constexpr int LDSCTL_OFF = RING_BYTES, MISC_OFF = LDSCTL_OFF + 320;
constexpr int LDS_BYTES = 147456;

#define GAS __attribute__((address_space(1)))
#define LAS __attribute__((address_space(3)))
typedef unsigned short bf16;
typedef unsigned v4u __attribute__((ext_vector_type(4)));
typedef unsigned v2u __attribute__((ext_vector_type(2)));
typedef float f32x4 __attribute__((ext_vector_type(4)));
typedef float f32x2 __attribute__((ext_vector_type(2)));
typedef GAS unsigned gu32;
typedef __bf16 bf16x2_t __attribute__((ext_vector_type(2)));
#define RLX_AGENT __ATOMIC_RELAXED, __HIP_MEMORY_SCOPE_AGENT
#define LDS_WAIT() asm volatile("s_waitcnt lgkmcnt(0)" ::: "memory")
#define VM_WAIT() asm volatile("s_waitcnt vmcnt(0)" ::: "memory")
#define LDS_BAR() do { asm volatile("s_waitcnt lgkmcnt(0)" ::: "memory"); __builtin_amdgcn_s_barrier(); asm volatile("" ::: "memory"); } while (0)
__device__ __forceinline__ unsigned f2bf(float f) { unsigned u = __builtin_bit_cast(unsigned, f); return (u + 0x7fffu + ((u >> 16) & 1u)) >> 16; }
__device__ __forceinline__ unsigned pk2(float lo, float hi) { return f2bf(lo) | (f2bf(hi) << 16); }
__device__ __forceinline__ float bflo(unsigned w) { return __uint_as_float(w << 16); }
__device__ __forceinline__ float bfhi(unsigned w) { return __uint_as_float(w & 0xffff0000u); }
__device__ __forceinline__ float bf2f(bf16 h) { return __uint_as_float((unsigned)h << 16); }

#define XB_TMO      128
#define XB_XCNT(j)  (256  + 64 * (j))
#define XB_XSUB(j)  (1280 + 64 * (j))
#define XB_XGEN(j)  (2304 + 64 * (j))
#define XB_TOP      3328
#define XB_TOPGEN   3392
#define XCD_BAR_WORDS 3456
#define XB_SPIN_CAP (1u << 18)

__device__ __forceinline__ unsigned xb_ld(unsigned* p)              { return __hip_atomic_load(p, __ATOMIC_RELAXED, __HIP_MEMORY_SCOPE_AGENT); }
__device__ __forceinline__ unsigned xb_add(unsigned* p, unsigned v) { return __hip_atomic_fetch_add(p, v, __ATOMIC_RELAXED, __HIP_MEMORY_SCOPE_AGENT); }
__device__ __forceinline__ unsigned xb_xcc_id() { return (unsigned)__builtin_amdgcn_s_getreg((3 << 11) | 20) & 0xFu; }
#define XB_SPIN(cond, bar) do { unsigned _sp = 0; while (cond) { __builtin_amdgcn_s_sleep(1); \
    if ((++_sp & 255u) == 0u) { if (xb_ld(&(bar)[XB_TMO])) break; if (_sp > XB_SPIN_CAP) { atomicAdd(&(bar)[XB_TMO], 1u); break; } } } } while (0)

struct XcdBarrier {
    unsigned* bar; unsigned x;
    volatile LAS unsigned* st;
};

__device__ __forceinline__ XcdBarrier xcd_barrier_post(unsigned* bar, volatile LAS unsigned* st) {
    XcdBarrier b; b.bar = bar; b.x = xb_xcc_id(); b.st = st;
    if (threadIdx.x == 0) (void)xb_add(&bar[XB_XCNT(b.x)], 1u);
    return b;
}
__device__ __forceinline__ void xcd_barrier_complete(unsigned* bar, unsigned x, unsigned& nloc, unsigned& nx) {
    const unsigned G = gridDim.x * gridDim.y * gridDim.z;
    unsigned sum, cnt, mine, sp = 0u;
    for (;;) {
        sum = 0u; cnt = 0u; mine = 0u;
#pragma unroll
        for (unsigned j = 0; j < 16; ++j) { const unsigned c = xb_ld(&bar[XB_XCNT(j)]); sum += c; cnt += (c > 0u) ? 1u : 0u; mine = (j == x) ? c : mine; }
        if (sum == G) break;
        __builtin_amdgcn_s_sleep(1);
        if ((++sp & 255u) == 0u) { if (xb_ld(&bar[XB_TMO])) break; if (sp > XB_SPIN_CAP) { atomicAdd(&bar[XB_TMO], 1u); break; } }
    }
    nloc = mine > 0u ? mine : 1u; nx = cnt > 0u ? cnt : 1u;
}

__device__ __forceinline__ void xcd_barrier(const XcdBarrier& b) {
    asm volatile("s_waitcnt vmcnt(0)" ::: "memory");
    __syncthreads();
    if (threadIdx.x == 0) {
        unsigned* bar = b.bar;
        __builtin_amdgcn_s_waitcnt(0);
        unsigned nloc = b.st[0], nx = b.st[1];
        if (nloc == 0u) { xcd_barrier_complete(bar, b.x, nloc, nx); b.st[0] = nloc; b.st[1] = nx; }
        const unsigned old = xb_add(&bar[XB_XSUB(b.x)], 1u);
        const unsigned gen = old / nloc;
        if (old + 1u == (gen + 1u) * nloc) {
            __builtin_amdgcn_fence(__ATOMIC_RELEASE, "agent");
            asm volatile("s_waitcnt vmcnt(0)" ::: "memory");
            const unsigned og = xb_add(&bar[XB_TOP], 1u);
            const unsigned tg = og / nx;
            if (og + 1u == (tg + 1u) * nx) xb_add(&bar[XB_TOPGEN], 1u);
            else XB_SPIN(xb_ld(&bar[XB_TOPGEN]) == tg, bar);
            __builtin_amdgcn_fence(__ATOMIC_ACQUIRE, "agent");
            xb_add(&bar[XB_XGEN(b.x)], 1u);
            asm volatile("s_waitcnt vmcnt(0)" ::: "memory");
        } else {
            XB_SPIN(xb_ld(&bar[XB_XGEN(b.x)]) == gen, bar);
            __builtin_amdgcn_fence(__ATOMIC_ACQUIRE, "agent");
            asm volatile("s_waitcnt vmcnt(0)" ::: "memory");
        }
    }
    __syncthreads();
}


__device__ __forceinline__ float dot2bf(unsigned a, unsigned b, float c) { asm("v_dot2c_f32_bf16 %0, %1, %2" : "+v"(c) : "v"(a), "v"(b)); return c; }
__device__ __forceinline__ float dot8bf_dpp(v4u a, v4u b) { float c = 0.f; asm("v_dot2c_f32_bf16 %0, %1, %5\n\tv_dot2c_f32_bf16 %0, %2, %6\n\tv_dot2c_f32_bf16 %0, %3, %7\n\tv_dot2c_f32_bf16 %0, %4, %8\n\ts_nop 1" : "+v"(c) : "v"(a.x), "v"(a.y), "v"(a.z), "v"(a.w), "v"(b.x), "v"(b.y), "v"(b.z), "v"(b.w)); return c; }
#define DPPF(v, ctrl) __int_as_float(__builtin_amdgcn_update_dpp(0, __float_as_int(v), (ctrl), 0xf, 0xf, true))
__device__ __forceinline__ float wave_sum(float v) {
#pragma unroll
    for (int o = 1; o < 64; o <<= 1) v += __shfl_xor(v, o);
    return v;
}
__device__ __forceinline__ float gelu_erf(float v) {
    const float av = fabsf(v), d = av * 0.2316418882f + 1.0f;
    const float t = __builtin_amdgcn_rcpf(d);
    float q = t * 0.5307027145f + (-0.7265760135f); q = q * t + 0.7107068705f; q = q * t + (-0.142248368f); q = q * t + 0.127414796f; q = q * t;
    const float e = __builtin_amdgcn_exp2f((v * v) * (-0.72134752044f));
    const float m = v * (q * e);
    return v < 0.f ? m : v - m;
}

struct Args { const float* in[15]; float* out; unsigned char* ws; };

__device__ __forceinline__ int w1_logical_col(int n0p) {
    const int pn = n0p >> 8, blk = (n0p & 255) >> 5, half = blk >> 2, a = blk & 3;
    if (pn <= 3) return pn * 256 + 64 * a + 32 * half;
    if (pn == 4) return (a < 2) ? (1024 + 64 * a + 32 * half) : (1152 + 64 * half + 32 * (a - 2));
    return n0p;
}
template <bool PERMW1> __device__ __forceinline__ void p0_transpose_item(const float* W, int K, int N, bf16* WT, LAS float* scr, int item, int lane) {
    const int nblk = N / 32, kb = item / nblk, nb = item % nblk, k0 = 64 * kb, n0 = 32 * nb; const int ns = PERMW1 ? w1_logical_col(n0) : n0;
    float tv[32];
#pragma unroll
    for (int i = 0; i < 32; ++i) { const int kk = 2 * i + (lane >> 5); tv[i] = W[(size_t)(k0 + kk) * N + ns + (lane & 31)]; }
#pragma unroll
    for (int i = 0; i < 32; ++i) { const int kk = 2 * i + (lane >> 5); scr[kk * 33 + (lane & 31)] = tv[i]; }
    LDS_WAIT(); asm volatile("" ::: "memory");
    const int c = lane & 7;
#pragma unroll
    for (int j = 0; j < 4; ++j) { const int n = (lane >> 3) + 8 * j; const LAS float* s = scr + (8 * c) * 33 + n;
        v4u o; o.x = pk2(s[0 * 33], s[1 * 33]); o.y = pk2(s[2 * 33], s[3 * 33]); o.z = pk2(s[4 * 33], s[5 * 33]); o.w = pk2(s[6 * 33], s[7 * 33]);
        *(GAS v4u*)(WT + (size_t)(n0 + n) * K + k0 + 8 * c) = o; }
    LDS_WAIT(); asm volatile("" ::: "memory");
}
__device__ __forceinline__ void ln_row_f32_to_bf16(const float* xrow, const float* g, const float* bta, bf16* orow, int lane) {
    const GAS f32x4* xr = (const GAS f32x4*)xrow + lane;
    f32x4 v[8]; float s = 0.f;
#pragma unroll
    for (int j = 0; j < 8; ++j) { v[j] = xr[64 * j]; s += (v[j].x + v[j].y) + (v[j].z + v[j].w); }
    const float mean = wave_sum(s) * (1.f / DM); float s2 = 0.f;
#pragma unroll
    for (int j = 0; j < 8; ++j) { v[j] = v[j] - mean; s2 += (v[j].x * v[j].x + v[j].y * v[j].y) + (v[j].z * v[j].z + v[j].w * v[j].w); }
    const float rstd = 1.f / sqrtf(wave_sum(s2) * (1.f / DM) + LN_EPS);
    GAS v2u* o8 = (GAS v2u*)orow + lane;
#pragma unroll
    for (int j = 0; j < 8; ++j) { const f32x4 gg = ((const GAS f32x4*)g)[lane + 64 * j], bb = ((const GAS f32x4*)bta)[lane + 64 * j];
        v2u o; o.x = pk2(v[j].x * rstd * gg.x + bb.x, v[j].y * rstd * gg.y + bb.y); o.y = pk2(v[j].z * rstd * gg.z + bb.z, v[j].w * rstd * gg.w + bb.w); o8[64 * j] = o; }
}
__device__ __forceinline__ void ln_row_bf16_to_bf16(const bf16* xrow, const float* g, const float* bta, bf16* orow, int lane) {
    const GAS v4u* xr = (const GAS v4u*)xrow + lane;
    float v[32]; float s = 0.f;
#pragma unroll
    for (int j = 0; j < 4; ++j) { const v4u w = xr[64 * j];
        v[8 * j + 0] = bflo(w.x); v[8 * j + 1] = bfhi(w.x); v[8 * j + 2] = bflo(w.y); v[8 * j + 3] = bfhi(w.y);
        v[8 * j + 4] = bflo(w.z); v[8 * j + 5] = bfhi(w.z); v[8 * j + 6] = bflo(w.w); v[8 * j + 7] = bfhi(w.w); }
#pragma unroll
    for (int i = 0; i < 32; ++i) s += v[i];
    const float mean = wave_sum(s) * (1.f / DM); float s2 = 0.f;
#pragma unroll
    for (int i = 0; i < 32; ++i) { v[i] -= mean; s2 += v[i] * v[i]; }
    const float rstd = 1.f / sqrtf(wave_sum(s2) * (1.f / DM) + LN_EPS);
    GAS v4u* o16 = (GAS v4u*)orow + lane;
#pragma unroll
    for (int j = 0; j < 4; ++j) {
        const GAS f32x4* gp = (const GAS f32x4*)g + 2 * (lane + 64 * j); const GAS f32x4* bp = (const GAS f32x4*)bta + 2 * (lane + 64 * j);
        const f32x4 g0 = gp[0], g1 = gp[1], b0 = bp[0], b1 = bp[1];
        v4u o; o.x = pk2(v[8 * j + 0] * rstd * g0.x + b0.x, v[8 * j + 1] * rstd * g0.y + b0.y); o.y = pk2(v[8 * j + 2] * rstd * g0.z + b0.z, v[8 * j + 3] * rstd * g0.w + b0.w);
        o.z = pk2(v[8 * j + 4] * rstd * g1.x + b1.x, v[8 * j + 5] * rstd * g1.y + b1.y); o.w = pk2(v[8 * j + 6] * rstd * g1.z + b1.z, v[8 * j + 7] * rstd * g1.w + b1.w);
        o16[64 * j] = o; }
}
__device__ __forceinline__ void row_pos(int r, int& pos, int& ipos) {
    if (r < NTOK) { const int s = r & (SEQ - 1); pos = NMETA + s; ipos = s & 127; }
    else { int j = r - NTOK; if (j > NMETA - 1) j = NMETA - 1; pos = j; ipos = 112 + j; }
}
__device__ __forceinline__ float log2_gamma(int h) { return log2f(1.0f - exp2f(-5.0f - (float)h)); }


typedef short bf16x8 __attribute__((ext_vector_type(8)));
typedef short s16x4 __attribute__((ext_vector_type(4)));
#define MFMA16(a, b, c) __builtin_amdgcn_mfma_f32_16x16x32_bf16((a), (b), (c), 0, 0, 0)
__device__ __forceinline__ s16x4 tr16(LAS const unsigned char* p) { return __builtin_bit_cast(s16x4, __builtin_amdgcn_ds_read_tr16_b64_v4i16((LAS s16x4*)p)); }
__device__ __forceinline__ bf16x8 cat8(s16x4 a, s16x4 b) { return __builtin_shufflevector(a, b, 0, 1, 2, 3, 4, 5, 6, 7); }
__device__ __forceinline__ unsigned cvtpk_s(float lo, float hi) { f32x2 v = {lo, hi}; bf16x2_t b = __builtin_convertvector(v, bf16x2_t); return __builtin_bit_cast(unsigned, b); }
__device__ __forceinline__ unsigned cvtpk(float lo, float hi) { unsigned r; asm("v_cvt_pk_bf16_f32 %0, %1, %2" : "=v"(r) : "v"(lo), "v"(hi)); return r; }

__device__ __forceinline__ void scan_unit(LAS unsigned char* L, int u, const bf16* RK, const bf16* RV, bf16* ST, int tid, int lane, int wave) {
    asm volatile("" : "+v"(tid)); lane = tid & 63;
    const int bh = u >> 4, di = (u >> 2) & 3, ei = u & 3, b = bh >> 2, h = bh & 3;
    const float g128 = exp2f(128.0f * log2_gamma(h));
    const int li = lane & 15, g = lane >> 4, q = li >> 2, p4 = li & 3;
    const int eb = wave >> 1, db0 = 2 * (wave & 1);
    f32x4 acc[2]; acc[0] = (f32x4){0.f, 0.f, 0.f, 0.f}; acc[1] = acc[0];
    v4u kA[2], vA[2], kB[2], vB[2];
#define SCAN_LOAD(cc, kreg, vreg) do { _Pragma("unroll") for (int i_ = 0; i_ < 2; ++i_) { const int cid_ = tid + 512 * i_, row_ = cid_ >> 3, c16_ = cid_ & 7; \
        int srow_; bool ok_ = true; if ((cc) < 0) { ok_ = row_ >= 112; srow_ = NTOK + (ok_ ? row_ - 112 : 0); } else srow_ = b * SEQ + (cc) * 128 + row_; \
        const v4u kz_ = *(const GAS v4u*)(RK + (size_t)srow_ * 1024 + h * 256 + di * 64 + c16_ * 8), vz_ = *(const GAS v4u*)(RV + (size_t)srow_ * 1024 + h * 256 + ei * 64 + c16_ * 8); \
        kreg[i_] = ok_ ? kz_ : (v4u){0u, 0u, 0u, 0u}; vreg[i_] = ok_ ? vz_ : (v4u){0u, 0u, 0u, 0u}; } } while (0)
#define SCAN_WRITE(bufp, kreg, vreg) do { _Pragma("unroll") for (int i_ = 0; i_ < 2; ++i_) { const int cid_ = tid + 512 * i_, row_ = cid_ >> 3, c16_ = cid_ & 7; \
        *(LAS v4u*)((bufp) + row_ * 128 + c16_ * 16) = kreg[i_]; *(LAS v4u*)((bufp) + 16384 + row_ * 128 + c16_ * 16) = vreg[i_]; } } while (0)
    SCAN_LOAD(-1, kA, vA); SCAN_WRITE(L, kA, vA); SCAN_LOAD(0, kA, vA); SCAN_LOAD(1, kB, vB); LDS_BAR();
    int cur = 0;
    for (int cc = -1; cc <= 29; cc += 2) {
        { LAS const unsigned char* Kt = L + cur * 32768; LAS const unsigned char* Vt = Kt + 16384;
#pragma unroll
          for (int ks = 0; ks < 4; ++ks) { const int r0 = (32 * ks + 8 * g + q) * 128;
              const bf16x8 a = cat8(tr16(Vt + r0 + (16 * eb + 4 * p4) * 2), tr16(Vt + r0 + 512 + (16 * eb + 4 * p4) * 2));
#pragma unroll
              for (int n = 0; n < 2; ++n) { const bf16x8 bb = cat8(tr16(Kt + r0 + (16 * (db0 + n) + 4 * p4) * 2), tr16(Kt + r0 + 512 + (16 * (db0 + n) + 4 * p4) * 2)); acc[n] = MFMA16(a, bb, acc[n]); } }
#pragma unroll
          for (int n = 0; n < 2; ++n) { acc[n] = acc[n] * g128;
              bf16* sp = ST + ((size_t)(bh * 32 + cc + 1) * 256 + (64 * ei + 16 * eb + 4 * g)) * 256 + 64 * di + 16 * (db0 + n) + li;
#pragma unroll
              for (int r = 0; r < 4; ++r) sp[(size_t)r * 256] = (bf16)f2bf(acc[n][r]); }
          SCAN_WRITE(L + (cur ^ 1) * 32768, kA, vA);
          if (cc + 3 <= 30) SCAN_LOAD(cc + 3, kA, vA);
          LDS_BAR(); cur ^= 1; }
        { LAS const unsigned char* Kt = L + cur * 32768; LAS const unsigned char* Vt = Kt + 16384;
#pragma unroll
          for (int ks = 0; ks < 4; ++ks) { const int r0 = (32 * ks + 8 * g + q) * 128;
              const bf16x8 a = cat8(tr16(Vt + r0 + (16 * eb + 4 * p4) * 2), tr16(Vt + r0 + 512 + (16 * eb + 4 * p4) * 2));
#pragma unroll
              for (int n = 0; n < 2; ++n) { const bf16x8 bb = cat8(tr16(Kt + r0 + (16 * (db0 + n) + 4 * p4) * 2), tr16(Kt + r0 + 512 + (16 * (db0 + n) + 4 * p4) * 2)); acc[n] = MFMA16(a, bb, acc[n]); } }
#pragma unroll
          for (int n = 0; n < 2; ++n) { acc[n] = acc[n] * g128;
              bf16* sp = ST + ((size_t)(bh * 32 + cc + 2) * 256 + (64 * ei + 16 * eb + 4 * g)) * 256 + 64 * di + 16 * (db0 + n) + li;
#pragma unroll
              for (int r = 0; r < 4; ++r) sp[(size_t)r * 256] = (bf16)f2bf(acc[n][r]); }
          if (cc + 2 <= 30) SCAN_WRITE(L + (cur ^ 1) * 32768, kB, vB);
          if (cc + 4 <= 30) SCAN_LOAD(cc + 4, kB, vB);
          LDS_BAR(); cur ^= 1; }
    }
#undef SCAN_LOAD
#undef SCAN_WRITE
}

__device__ __forceinline__ void retout_unit(LAS unsigned char* L, int u, bf16* QR, const bf16* RK, const bf16* RV, const bf16* RG, const bf16* ST, int tid, int lane, int wave) {
    asm volatile("" : "+v"(tid)); lane = tid & 63;
    const int bh = u >> 5, c = u & 31, b = bh >> 2, h = bh & 3;
    const int R0 = b * SEQ + c * 128;
    const int li = lane & 15, g = lane >> 4, q = li >> 2, p4 = li & 3;
    LAS unsigned char* RA = L; LAS unsigned char* RB = L + 65536;
#pragma unroll
    for (int i = 0; i < 8; ++i) { const int cid = tid + 512 * i, j = cid >> 5, ch = cid & 31;
        const v4u kz = *(const GAS v4u*)(RK + (size_t)(R0 + j) * 1024 + h * 256 + ch * 8), vz = *(const GAS v4u*)(RV + (size_t)(R0 + j) * 1024 + h * 256 + ch * 8);
        *(LAS v4u*)(RA + j * 512 + ((ch ^ (j & 15)) << 4)) = kz; *(LAS v4u*)(RB + j * 512 + ((ch ^ ((j & 7) << 1)) << 4)) = vz; }
    bf16x8 qf[8];
    { const GAS v4u* qp = (const GAS v4u*)(QR + (size_t)(R0 + 16 * wave + li) * 2048 + 1024 + h * 256 + 8 * g);
#pragma unroll
      for (int ks = 0; ks < 8; ++ks) qf[ks] = __builtin_bit_cast(bf16x8, qp[4 * ks]); }
    __syncthreads();
    f32x4 st[8];
#pragma unroll
    for (int jt = 0; jt < 8; ++jt) st[jt] = (f32x4){0.f, 0.f, 0.f, 0.f};
#pragma unroll
    for (int jt = 0; jt < 8; ++jt) if (jt <= wave) {
        const int j = 16 * jt + li;
#pragma unroll
        for (int ks = 0; ks < 8; ++ks) { const bf16x8 a = *(LAS const bf16x8*)(RA + j * 512 + (((4 * ks + g) ^ li) << 4)); st[jt] = MFMA16(a, qf[ks], st[jt]); }
        if (jt == wave) {
#pragma unroll
            for (int r = 0; r < 4; ++r) if (4 * g + r > li) st[jt][r] = 0.f; }
    }
    bf16x8 pf[4];
#pragma unroll
    for (int s = 0; s < 4; ++s) { v4u w; w.x = cvtpk_s(st[2 * s][0], st[2 * s][1]); w.y = cvtpk_s(st[2 * s][2], st[2 * s][3]); w.z = cvtpk_s(st[2 * s + 1][0], st[2 * s + 1][1]); w.w = cvtpk_s(st[2 * s + 1][2], st[2 * s + 1][3]); pf[s] = __builtin_bit_cast(bf16x8, w); }
    __syncthreads();
    const bf16* Sg = ST + (size_t)(bh * 32 + c) * 65536;
#define RO_STAGE_ST(dst, s0) do { _Pragma("unroll") for (int i_ = 0; i_ < 8; ++i_) { const int cid_ = tid + 512 * i_, sl_ = cid_ >> 11, e_ = (cid_ >> 3) & 255, ch_ = cid_ & 7; \
        const v4u z_ = *(const GAS v4u*)(Sg + (size_t)e_ * 256 + 64 * ((s0) + sl_) + ch_ * 8); *(LAS v4u*)((dst) + sl_ * 32768 + e_ * 128 + ((ch_ ^ (e_ & 7)) << 4)) = z_; } } while (0)
    RO_STAGE_ST(RA, 0);
    f32x4 o[16];
#pragma unroll
    for (int et = 0; et < 16; ++et) o[et] = (f32x4){0.f, 0.f, 0.f, 0.f};
#pragma unroll
    for (int s = 0; s < 4; ++s) if (2 * s <= wave) {
        const int r1 = 32 * s + 4 * g + q, r2 = r1 + 16;
#pragma unroll
        for (int et = 0; et < 16; ++et) {
            const int chn = 2 * et + (p4 >> 1);
            const bf16x8 a = cat8(tr16(RB + r1 * 512 + ((chn ^ ((r1 & 7) << 1)) << 4) + (p4 & 1) * 8), tr16(RB + r2 * 512 + ((chn ^ ((r2 & 7) << 1)) << 4) + (p4 & 1) * 8));
            o[et] = MFMA16(a, pf[s], o[et]);
        }
    }
    __syncthreads();
    RO_STAGE_ST(RB, 2);
#define RO_STATE_MMA(src, s0) do { _Pragma("unroll") for (int sl_ = 0; sl_ < 2; ++sl_) _Pragma("unroll") for (int k2_ = 0; k2_ < 2; ++k2_) _Pragma("unroll") for (int et = 0; et < 16; ++et) { \
        const int e_ = 16 * et + li; const bf16x8 a_ = *(LAS const bf16x8*)((src) + sl_ * 32768 + e_ * 128 + (((4 * k2_ + g) ^ (e_ & 7)) << 4)); \
        o[et] = MFMA16(a_, qf[2 * ((s0) + sl_) + k2_], o[et]); } } while (0)
    RO_STATE_MMA(RA, 0);
    __syncthreads();
    RO_STATE_MMA(RB, 2);
#undef RO_STAGE_ST
#undef RO_STATE_MMA
    float s1 = 0.f;
#pragma unroll
    for (int et = 0; et < 16; ++et) s1 += (o[et][0] + o[et][1]) + (o[et][2] + o[et][3]);
    s1 += __shfl_xor(s1, 16); s1 += __shfl_xor(s1, 32);
    const float mu = s1 * (1.0f / 256.0f); float s2 = 0.f;
#pragma unroll
    for (int et = 0; et < 16; ++et) { o[et] = o[et] - mu; s2 += (o[et][0] * o[et][0] + o[et][1] * o[et][1]) + (o[et][2] * o[et][2] + o[et][3] * o[et][3]); }
    s2 += __shfl_xor(s2, 16); s2 += __shfl_xor(s2, 32);
    const float rstd = 1.0f / sqrtf(s2 * (1.0f / 256.0f) + GN_EPS);
    const int row = R0 + 16 * wave + li;
    const GAS v2u* gp = (const GAS v2u*)(RG + (size_t)row * 1024 + h * 256 + 4 * g); GAS v2u* op = (GAS v2u*)(QR + (size_t)row * 2048 + 1024 + h * 256 + 4 * g);
#pragma unroll
    for (int et = 0; et < 16; ++et) { const v2u gz = gp[4 * et]; v2u w;
        w.x = cvtpk(o[et][0] * rstd * bflo(gz.x), o[et][1] * rstd * bfhi(gz.x)); w.y = cvtpk(o[et][2] * rstd * bflo(gz.y), o[et][3] * rstd * bfhi(gz.y)); op[4 * et] = w; }
    __syncthreads();
}

typedef float f32x16 __attribute__((ext_vector_type(16)));
#define MFMA32(a, b, c) __builtin_amdgcn_mfma_f32_32x32x16_bf16((a), (b), (c), 0, 0, 0)
__device__ __forceinline__ int crow32(int reg, int hh) { return (reg & 3) + 8 * (reg >> 2) + 4 * hh; }

__device__ __forceinline__ void attn_unit(LAS unsigned char* L, int u, bf16* QR, const bf16* KA, const bf16* VA, const float* sinks, int tid, int lane, int wave) {
    asm volatile("" : "+v"(tid)); lane = tid & 63;
    const int b = u >> 6, j = (u >> 1) & 31, g2 = u & 1, hq = 8 * g2 + wave;
    const int R0 = b * SEQ + 128 * j;
    LAS unsigned char* Kt = L; LAS unsigned char* Vt = L + 32768;
#pragma unroll
    for (int i = 0; i < 4; ++i) { const int cid = tid + 512 * i, kk = cid >> 3, ch = cid & 7;
        int srow; bool ok = true;
        if (kk >= 128) srow = R0 + kk - 128; else if (j > 0) srow = R0 - 128 + kk; else { ok = kk >= 112; srow = NTOK + (ok ? kk - 112 : 0); }
        const v4u kz = *(const GAS v4u*)(KA + (size_t)srow * 128 + g2 * 64 + ch * 8), vz = *(const GAS v4u*)(VA + (size_t)srow * 128 + g2 * 64 + ch * 8);
        *(LAS v4u*)(Kt + kk * 128 + ((ch ^ (kk & 7)) << 4)) = ok ? kz : (v4u){0u, 0u, 0u, 0u};
        *(LAS v4u*)(Vt + kk * 128 + (ch << 4)) = ok ? vz : (v4u){0u, 0u, 0u, 0u}; }
    __syncthreads();
    const int r = lane & 31, hh = lane >> 5, blk = (lane >> 4) & 1, q = (lane & 15) >> 2, p4 = lane & 3;
    const float sk = sinks[hq] * LOG2E;
#pragma unroll 1
    for (int t = 0; t < 4; ++t) {
        const int i0 = 32 * t;
        bf16x8 qf[4];
        { const GAS v4u* qp = (const GAS v4u*)(QR + (size_t)(R0 + i0 + r) * 2048 + hq * 64 + 8 * hh);
#pragma unroll
          for (int ks = 0; ks < 4; ++ks) qf[ks] = __builtin_bit_cast(bf16x8, qp[2 * ks]); }
        f32x16 s[5];
#pragma unroll
        for (int x = 0; x < 5; ++x) {
            const int krow_ = 32 * (t + x) + r;
            f32x16 acc;
#pragma unroll
            for (int e = 0; e < 16; ++e) acc[e] = 0.f;
#pragma unroll
            for (int ks = 0; ks < 4; ++ks) { const bf16x8 a = *(LAS const bf16x8*)(Kt + krow_ * 128 + (((2 * ks + hh) ^ (krow_ & 7)) << 4)); acc = MFMA32(a, qf[ks], acc); }
            s[x] = acc; __builtin_amdgcn_sched_barrier(0);
        }
        float m = sk;
#pragma unroll
        for (int e = 0; e < 16; ++e) { const int cr = crow32(e, hh);
            if (!(cr > r)) s[0][e] = -1.0e30f;
            if (!(cr <= r)) s[4][e] = -1.0e30f; }
        if (j == 0) {
#pragma unroll
            for (int x = 0; x < 4; ++x) if (t + x <= 3) {
#pragma unroll
                for (int e = 0; e < 16; ++e) if (32 * (t + x) + crow32(e, hh) < 112) s[x][e] = -1.0e30f; }
        }
#pragma unroll
        for (int x = 0; x < 5; ++x)
#pragma unroll
            for (int e = 0; e < 16; ++e) m = fmaxf(m, s[x][e]);
        m = fmaxf(m, __shfl_xor(m, 32));
        float l = 0.f;
#pragma unroll
        for (int x = 0; x < 5; ++x)
#pragma unroll
            for (int e = 0; e < 16; ++e) { const float pv = exp2f(s[x][e] - m); s[x][e] = pv; l += pv; }
        l += __shfl_xor(l, 32);
        l += exp2f(sk - m);
        f32x16 o[2];
#pragma unroll
        for (int e = 0; e < 16; ++e) { o[0][e] = 0.f; o[1][e] = 0.f; }
#pragma unroll
        for (int x = 0; x < 5; ++x)
#pragma unroll
            for (int st = 0; st < 2; ++st) {
                v4u w; w.x = cvtpk_s(s[x][8 * st + 0], s[x][8 * st + 1]); w.y = cvtpk_s(s[x][8 * st + 2], s[x][8 * st + 3]); w.z = cvtpk_s(s[x][8 * st + 4], s[x][8 * st + 5]); w.w = cvtpk_s(s[x][8 * st + 6], s[x][8 * st + 7]);
                const bf16x8 pb = __builtin_bit_cast(bf16x8, w);
                const int k1 = 32 * (t + x) + 16 * st + 4 * hh + q, k2 = k1 + 8;
#pragma unroll
                for (int dc = 0; dc < 2; ++dc) {
                    const int cb = ((4 * dc + 2 * blk + (p4 >> 1)) << 4) + 8 * (p4 & 1);
                    const bf16x8 a = cat8(tr16(Vt + k1 * 128 + cb), tr16(Vt + k2 * 128 + cb));
                    o[dc] = MFMA32(a, pb, o[dc]);
                }
                __builtin_amdgcn_sched_barrier(0);
            }
        const float il = 1.0f / l;
        GAS v2u* op = (GAS v2u*)(QR + (size_t)(R0 + i0 + r) * 2048 + hq * 64 + 4 * hh);
#pragma unroll
        for (int dc = 0; dc < 2; ++dc)
#pragma unroll
            for (int g4 = 0; g4 < 4; ++g4) { v2u w; w.x = cvtpk_s(o[dc][4 * g4 + 0] * il, o[dc][4 * g4 + 1] * il); w.y = cvtpk_s(o[dc][4 * g4 + 2] * il, o[dc][4 * g4 + 3] * il); op[8 * dc + 2 * g4] = w; }
    }
    __syncthreads();
}

__device__ __forceinline__ unsigned ord_key(float f) { const unsigned u = __float_as_uint(f); return u ^ ((unsigned)((int)u >> 31) | 0x80000000u); }
__device__ __forceinline__ float ord_val(unsigned k) { return __uint_as_float(k ^ (((int)k < 0) ? 0x80000000u : 0xffffffffu)); }
__device__ __forceinline__ unsigned umed3(unsigned a, unsigned b, unsigned c) { unsigned r; asm("v_med3_u32 %0, %1, %2, %3" : "=v"(r) : "v"(a), "v"(b), "v"(c)); return r; }
#define TK_INS(arr, val) do { const unsigned v_ = (val); _Pragma("unroll") for (int j_ = 15; j_ >= 1; --j_) arr[j_] = umed3(arr[j_ - 1], arr[j_], v_); arr[0] = arr[0] > v_ ? arr[0] : v_; } while (0)
__device__ __forceinline__ void topk_unit(LAS unsigned* Lw, LAS const unsigned char* Lsk, int tt, int hd, const bf16* Q3, unsigned short* IDS, float* GATES, int lane) {
    asm volatile("" : "+v"(lane));
    const int r = lane & 31, hh = lane >> 5, t0 = tt * 32;
    float sv[2][16];
#pragma unroll
    for (int p = 0; p < 2; ++p) {
        f32x16 acc[4];
#pragma unroll
        for (int nt = 0; nt < 4; ++nt)
#pragma unroll
            for (int e = 0; e < 16; ++e) acc[nt][e] = 0.f;
        const GAS v4u* qp = (const GAS v4u*)(Q3 + (size_t)(t0 + r) * DM + hd * 256 + p * 128 + 8 * hh);
        bf16x8 bq[8];
#pragma unroll
        for (int ks = 0; ks < 8; ++ks) bq[ks] = __builtin_bit_cast(bf16x8, qp[2 * ks]);
#pragma unroll
        for (int ks = 0; ks < 8; ++ks) {
#pragma unroll
            for (int nt = 0; nt < 4; ++nt) { const bf16x8 a = *(LAS const bf16x8*)(Lsk + p * 32768 + (32 * nt + r) * 256 + (((2 * ks + hh) ^ (r & 15)) << 4)); acc[nt] = MFMA32(a, bq[ks], acc[nt]); } }
        unsigned tk[16];
#pragma unroll
        for (int j2 = 0; j2 < 16; ++j2) tk[j2] = 0u;
#pragma unroll
        for (int nt = 0; nt < 4; ++nt)
#pragma unroll
            for (int e = 0; e < 16; ++e) { const int n = 32 * nt + crow32(e, hh); TK_INS(tk, (ord_key(acc[nt][e]) & 0xffffff80u) | (unsigned)(127 - n)); }
        unsigned pk[16];
#pragma unroll
        for (int j2 = 0; j2 < 16; ++j2) pk[j2] = (unsigned)__shfl_xor((int)tk[j2], 32);
#pragma unroll
        for (int j2 = 0; j2 < 16; ++j2) TK_INS(tk, pk[j2]);
#pragma unroll
        for (int j2 = 0; j2 < 16; ++j2) { sv[p][j2] = ord_val(tk[j2] & 0xffffff80u); Lw[(p * 16 + j2) * 64 + lane] = 127u - (tk[j2] & 0x7fu); }
    }
    unsigned fk[16];
#pragma unroll
    for (int j2 = 0; j2 < 16; ++j2) fk[j2] = 0u;
#pragma unroll
    for (int i = 0; i < 16; ++i)
#pragma unroll
        for (int j2 = 0; j2 < 16; ++j2) if ((i + 1) * (j2 + 1) <= 16) TK_INS(fk, (ord_key(sv[0][i] + sv[1][j2]) & 0xffffff00u) | (unsigned)(255 - (16 * i + j2)));
    float ev[16]; int idv[16]; float den = 0.f; const float f0 = ord_val(fk[0] & 0xffffff00u);
    LDS_WAIT();
#pragma unroll
    for (int k = 0; k < 16; ++k) { const unsigned idx = 255u - (fk[k] & 0xffu); const unsigned i1 = Lw[(idx >> 4) * 64 + lane], i2 = Lw[(16 + (idx & 15u)) * 64 + lane];
        idv[k] = (int)(i1 * 128u + i2); ev[k] = __expf(ord_val(fk[k] & 0xffffff00u) - f0); den += ev[k]; }
    const float iden = 1.0f / den;
    if (hh == 0) {
        GAS v4u* ip = (GAS v4u*)(IDS + (size_t)(t0 + r) * 128 + hd * 16); GAS f32x4* gp = (GAS f32x4*)(GATES + (size_t)(t0 + r) * 128 + hd * 16);
#pragma unroll
        for (int k8 = 0; k8 < 2; ++k8) ip[k8] = (v4u){(unsigned)idv[8 * k8] | ((unsigned)idv[8 * k8 + 1] << 16), (unsigned)idv[8 * k8 + 2] | ((unsigned)idv[8 * k8 + 3] << 16), (unsigned)idv[8 * k8 + 4] | ((unsigned)idv[8 * k8 + 5] << 16), (unsigned)idv[8 * k8 + 6] | ((unsigned)idv[8 * k8 + 7] << 16)};
#pragma unroll
        for (int k4 = 0; k4 < 4; ++k4) gp[k4] = (f32x4){ev[4 * k4] * iden, ev[4 * k4 + 1] * iden, ev[4 * k4 + 2] * iden, ev[4 * k4 + 3] * iden};
    }
    LDS_WAIT();
}

__global__ void __launch_bounds__(NWAVES * 64, 2) mk_fwd(Args args) {
    extern __shared__ __attribute__((aligned(16))) unsigned char lds[];
    LAS unsigned char* L = (LAS unsigned char*)lds;
    volatile LAS unsigned* MISC = (volatile LAS unsigned*)(L + MISC_OFF);
    const int tid = threadIdx.x, lane = tid & 63, wave = __builtin_amdgcn_readfirstlane(tid >> 6);
    const int G = gridDim.x, bx = blockIdx.x;
    const int vcu = (G % 8 == 0) ? (bx % 8) * (G / 8) + bx / 8 : bx;
    unsigned char* ws = args.ws;
    gu32* ctl = (gu32*)(ws + WS_CTL);
    const float* x = args.in[0]; const float* meta = args.in[1]; const float* ln_in_g = args.in[2]; const float* ln_in_b = args.in[3];
    const float* w_in = args.in[4]; const float* sinks = args.in[5]; const float* w_out = args.in[6]; const float* ln_mix_g = args.in[7]; const float* ln_mix_b = args.in[8];
    const float* wq = args.in[9]; const float* subkeys = args.in[10]; const float* u_tab = args.in[11]; const float* v_tab = args.in[12];
    const float* ln_ffn_g = args.in[13]; const float* ln_ffn_b = args.in[14];
    float* out = args.out;
    bf16* W1T = (bf16*)(ws + WS_W1T); bf16* W2T = (bf16*)(ws + WS_W2T); bf16* W3T = (bf16*)(ws + WS_W3T);
    bf16* H0 = (bf16*)(ws + WS_H0); bf16* QR = (bf16*)(ws + WS_QR); bf16* KA = (bf16*)(ws + WS_KA); bf16* VA = (bf16*)(ws + WS_VA);
    bf16* RK = (bf16*)(ws + WS_RK); bf16* RV = (bf16*)(ws + WS_RV); bf16* RG = (bf16*)(ws + WS_RG);
    bf16* Y = (bf16*)(ws + WS_Y); bf16* H1 = (bf16*)(ws + WS_H1); bf16* Q3 = (bf16*)(ws + WS_QR);
    bf16* STB = (bf16*)(ws + WS_ST);
    f32x2* ROPE_R = (f32x2*)(ws + WS_ROPE_R); f32x2* ROPE_A = (f32x2*)(ws + WS_ROPE_A);
    unsigned short* IDS = (unsigned short*)(ws + WS_IDS); float* GATES = (float*)(ws + WS_GATES);
    bf16* SKB = (bf16*)(ws + WS_SK);
    bf16* UT = (bf16*)(ws + WS_UT); bf16* VT = (bf16*)(ws + WS_VT);

    for (int u = tid; u < (LDS_BYTES - LDSCTL_OFF) / 4; u += NWAVES * 64) ((LAS unsigned*)(L + LDSCTL_OFF))[u] = 0u;
    __syncthreads();
    XcdBarrier bar; bar.bar = (unsigned*)(ctl + CW_BAR); bar.x = xb_xcc_id(); bar.st = MISC + 8;
    if (tid == 0) MISC[10] = xb_add(&bar.bar[XB_XCNT(bar.x)], 1u);
#define GRID_BAR() xcd_barrier(bar)
    const int gw = vcu * NWAVES + wave, NGW = G * NWAVES;
    const int gt = gw * 64 + lane, NGT = NGW * 64;

    {
        int lane = threadIdx.x; asm volatile("" : "+v"(lane)); lane &= 63; const int gt = gw * 64 + lane;
        LAS float* scr = (LAS float*)(L + RING_OFF + wave * 16384);
        constexpr int I_1 = (DM / 64) * (IN_COLS / 32), I_2 = (DM / 64) * (DM / 32), I_3 = I_2;
        for (int it = gw; it < I_1 + I_2 + I_3; it += NGW) {
            int r = it;
            if (r < I_1) { p0_transpose_item<true>(w_in, DM, IN_COLS, W1T, scr, r, lane); continue; } r -= I_1;
            if (r < I_2) { p0_transpose_item<false>(w_out, DM, DM, W2T, scr, r, lane); continue; } r -= I_2;
            p0_transpose_item<false>(wq, DM, DM, W3T, scr, r, lane);
        }
        for (int m = gw; m < MROWS; m += NGW) {
            if (m < NTOK) ln_row_f32_to_bf16(x + (size_t)m * DM, ln_in_g, ln_in_b, H0 + (size_t)m * DM, lane);
            else if (m < NVALID) ln_row_f32_to_bf16(meta + (size_t)(m - NTOK) * DM, ln_in_g, ln_in_b, H0 + (size_t)m * DM, lane);
            else { GAS v4u* o = (GAS v4u*)(H0 + (size_t)m * DM) + lane;
#pragma unroll
                for (int j = 0; j < 4; ++j) o[64 * j] = (v4u){0u, 0u, 0u, 0u}; }
        }
        for (int e = gt; e < 16 * 128 * 128 / 8; e += NGT) { const GAS f32x4* src = (const GAS f32x4*)subkeys + 2 * (size_t)e; const f32x4 a = src[0], b2 = src[1];
            v4u o; o.x = pk2(a.x, a.y); o.y = pk2(a.z, a.w); o.z = pk2(b2.x, b2.y); o.w = pk2(b2.z, b2.w); ((GAS v4u*)SKB)[e] = o; }
    }
    GRID_BAR();

    {
        pg8::Gemm g{H0, W1T, MROWS, IN_COLS, DM}; pg8::StaticOrder S; S.init(MROWS, IN_COLS, G, bx);
        pg8::EpiProj E{QR, KA, VA, RK, RV, RG, QSCALE};
        pg8::gemm_phase<pg8::EpiProj, pg8::StaticOrder, true, true>(L + RING_OFF, g, S, E);
    }
    {
        constexpr int NQ = 16384 * DM / 4, CHQ = 16384, NCH = 2 * NQ / CHQ;
        for (;;) {
            int ch = 0; if (lane == 0) ch = (int)__hip_atomic_fetch_add((unsigned*)(ctl + CW_TABQ), 1u, __ATOMIC_RELAXED, __HIP_MEMORY_SCOPE_AGENT);
            ch = __builtin_amdgcn_readfirstlane(ch); if (ch >= NCH) break;
            const int which = ch >= NCH / 2; const float sc = which ? V_SCALE : U_SCALE;
            const GAS f32x4* src = (const GAS f32x4*)(which ? v_tab : u_tab) + (size_t)(ch - which * (NCH / 2)) * CHQ + lane;
            GAS unsigned char* dstb = (GAS unsigned char*)(which ? (void*)VT : (void*)UT);
            const int i4b = (ch - which * (NCH / 2)) * CHQ + lane;
#pragma unroll 1
            for (int it = 0; it < CHQ / 64; it += 8) {
                f32x4 a[8];
#pragma unroll
                for (int u8 = 0; u8 < 8; ++u8) a[u8] = src[(it + u8) * 64];
#pragma unroll
                for (int u8 = 0; u8 < 8; ++u8) { const int i4 = i4b + (it + u8) * 64; const int row = i4 >> 9, q4 = i4 & 511;
                    int w = __builtin_amdgcn_cvt_pk_fp8_f32(a[u8].x * sc, a[u8].y * sc, 0, false); w = __builtin_amdgcn_cvt_pk_fp8_f32(a[u8].z * sc, a[u8].w * sc, w, true);
                    *(GAS unsigned*)(dstb + ((size_t)(q4 >> 5) * 16384 + row) * 128 + (q4 & 31) * 4) = (unsigned)w; }
            }
        }
    }
    GRID_BAR();

    for (int u = bx; u < 256; u += G) attn_unit(L + RING_OFF, u, QR, KA, VA, sinks, tid, lane, wave);

    for (int u = bx; u < 256; u += G) scan_unit(L + RING_OFF, u, RK, RV, STB, tid, lane, wave);
    GRID_BAR();

    for (int u = bx; u < 512; u += G) retout_unit(L + RING_OFF, u, QR, RK, RV, RG, STB, tid, lane, wave);
    GRID_BAR();

    {
        pg8::Gemm g{QR, W2T, NTOK, DM, DM}; pg8::StaticOrder S; S.init(NTOK, DM, G, bx);
        pg8::EpiGen<1> E{Y, DM, H0, ALPHA, nullptr, nullptr, nullptr, nullptr, nullptr, nullptr};
        pg8::gemm_phase<pg8::EpiGen<1>, pg8::StaticOrder, true, true>(L + RING_OFF, g, S, E);
    }
    GRID_BAR();

    for (int m = gw; m < NTOK; m += NGW) ln_row_bf16_to_bf16(Y + (size_t)m * DM, ln_mix_g, ln_mix_b, H1 + (size_t)m * DM, lane);
    GRID_BAR();

    {
        pg8::Gemm g{H1, W3T, NTOK, DM, DM}; pg8::StaticOrder S; S.init(NTOK, DM, G, bx);
        pg8::EpiGen<2> E{Q3, DM, nullptr, 0.f, nullptr, nullptr, nullptr, nullptr, nullptr, nullptr};
        pg8::gemm_phase<pg8::EpiGen<2>, pg8::StaticOrder, true, true>(L + RING_OFF, g, S, E);
    }
    GRID_BAR();

    const bool g8 = (G & 7) == 0; const int nbh = g8 ? (G >> 3) : G, hb = g8 ? (bx >> 3) : bx;
    for (int hd = g8 ? (bx & 7) : 0; hd < 8; hd += g8 ? 8 : 1) {
        __syncthreads();
#pragma unroll
        for (int i = 0; i < 8; ++i) { const int cid = tid + 512 * i, p = cid >> 11, n = (cid >> 4) & 127, ch = cid & 15;
            *(LAS v4u*)(L + RING_OFF + p * 32768 + n * 256 + ((ch ^ (n & 15)) << 4)) = *(const GAS v4u*)(SKB + ((size_t)((hd * 2 + p) * 128 + n)) * 128 + ch * 8); }
        __syncthreads();
        for (int tt = hb * NWAVES + wave; tt < NTOK / 32; tt += nbh * NWAVES) topk_unit((LAS unsigned*)(L + RING_OFF + 65536 + wave * 8192), L + RING_OFF, tt, hd, Q3, IDS, GATES, lane);
    }
    __syncthreads();
    GRID_BAR();

    int nx = 0, xr = 0, nloc = 1;
    { unsigned* bw = (unsigned*)(ctl + CW_BAR);
#pragma unroll
      for (unsigned j2 = 0; j2 < 16; ++j2) { const unsigned cnt = xb_ld(&bw[XB_XCNT(j2)]); nx += cnt > 0u; xr += (j2 < bar.x && cnt > 0u); if (j2 == bar.x) nloc = (int)cnt; }
      nx = __builtin_amdgcn_readfirstlane(nx); xr = __builtin_amdgcn_readfirstlane(xr); nloc = __builtin_amdgcn_readfirstlane(nloc); if (nx < 1) nx = 1; if (nloc < 1) nloc = 1; }
    const int lrank = __builtin_amdgcn_readfirstlane((int)MISC[10]);
    const int wv = lrank * NWAVES + wave, nwv = nloc * NWAVES;
    float* DOTX = (float*)(ws + WS_RK);
    bf16* CB = (bf16*)(ws + WS_KA);
    bf16* YB = (bf16*)(ws + WS_H0);
    {
        int tl = tid; asm volatile("" : "+v"(tl)); const int ln = tl & 63, k = ln >> 3, c8 = ln & 7;
        const unsigned char* UT8 = (const unsigned char*)UT;
        for (int s = xr; s < NSL; s += nx) {
            const unsigned char* Us = UT8 + (size_t)s * 16384 * 128;
            const bool first = (s == xr);
            v4u nid[2][2];
#pragma unroll
            for (int z = 0; z < 2; ++z) { const int tz = wv + z * nwv; const int tc = tz < NTOK ? tz : wv; const GAS v4u* ip = (const GAS v4u*)(IDS + (size_t)tc * 128 + 16 * k);
#pragma unroll
                for (int i = 0; i < 2; ++i) nid[z][i] = ip[i]; }
#pragma unroll 1
            for (int t = wv; t < NTOK; t += 2 * nwv) {
                const bool vB = (t + nwv) < NTOK; const int tt[2] = {t, vB ? t + nwv : t};
                v4u ub[2][16]; v4u hs[2][2]; f32x2 old[2];
#pragma unroll
                for (int z = 0; z < 2; ++z) {
#pragma unroll
                    for (int i = 0; i < 16; ++i) { const int pe = 2 * (i & 7) + (i >> 3); const unsigned eid = (nid[z][pe >> 3][(pe >> 1) & 3] >> (16 * (pe & 1))) & 0xffffu; ub[z][i] = *(const GAS v4u*)(Us + (size_t)eid * 128 + 16 * c8); }
                    { const GAS v4u* hp = (const GAS v4u*)(H1 + (size_t)tt[z] * DM + 128 * s + 16 * c8); hs[z][0] = hp[0]; hs[z][1] = hp[1]; } }
#pragma unroll
                for (int z = 0; z < 2; ++z) old[z] = first ? (f32x2){0.f, 0.f} : *(const GAS f32x2*)(DOTX + ((size_t)xr * NTOK + tt[z]) * 128 + 2 * ln);
#pragma unroll
                for (int z = 0; z < 2; ++z) { const int tz = t + (2 + z) * nwv; const int tc = tz < NTOK ? tz : t; const GAS v4u* ip = (const GAS v4u*)(IDS + (size_t)tc * 128 + 16 * k);
#pragma unroll
                    for (int i = 0; i < 2; ++i) nid[z][i] = ip[i]; }
#pragma unroll
                for (int z = 0; z < 2; ++z) {
                    float p[16]; f32x2 hp2[8];
#pragma unroll
                    for (int i = 0; i < 2; ++i)
#pragma unroll
                        for (int c4 = 0; c4 < 4; ++c4) hp2[4 * i + c4] = (f32x2){bflo(hs[z][i][c4]), bfhi(hs[z][i][c4])};
#pragma unroll
                    for (int i = 0; i < 16; ++i) { f32x2 d2 = {0.f, 0.f};
#pragma unroll
                        for (int dw = 0; dw < 4; ++dw) { const f32x2 fl = __builtin_amdgcn_cvt_pk_f32_fp8((int)ub[z][i][dw], false), fh = __builtin_amdgcn_cvt_pk_f32_fp8((int)ub[z][i][dw], true);
                            d2 = __builtin_elementwise_fma(fl, hp2[2 * dw], d2); d2 = __builtin_elementwise_fma(fh, hp2[2 * dw + 1], d2); }
                        p[i] = d2.x + d2.y; }
                    const bool b0 = (c8 & 1) != 0, b1 = (c8 & 2) != 0, b2 = (c8 & 4) != 0;
                    float r1[8], r2[4], q0, q1;
#pragma unroll
                    for (int m = 0; m < 8; ++m) { const float keep = b0 ? p[2 * m + 1] : p[2 * m], give = b0 ? p[2 * m] : p[2 * m + 1]; r1[m] = keep + DPPF(give, 0xB1); }
#pragma unroll
                    for (int m = 0; m < 4; ++m) { const float keep = b1 ? r1[2 * m + 1] : r1[2 * m], give = b1 ? r1[2 * m] : r1[2 * m + 1]; r2[m] = keep + DPPF(give, 0x4E); }
                    { const float keep = b2 ? r2[1] : r2[0], give = b2 ? r2[0] : r2[1]; const float gl = DPPF(give, 0x104), gr = DPPF(give, 0x114); q0 = keep + (b2 ? gr : gl); }
                    { const float keep = b2 ? r2[3] : r2[2], give = b2 ? r2[2] : r2[3]; const float gl = DPPF(give, 0x104), gr = DPPF(give, 0x114); q1 = keep + (b2 ? gr : gl); }
                    if (z == 0 || vB) *(GAS f32x2*)(DOTX + ((size_t)xr * NTOK + tt[z]) * 128 + 2 * ln) = (f32x2){q0 + old[z].x, q1 + old[z].y};
                }
            }
        }
    }
    GRID_BAR();
    for (int idx = gt; idx < NTOK * 128; idx += NGT) { float d = 0.f; for (int xx = 0; xx < nx; ++xx) d += DOTX[(size_t)xx * NTOK * 128 + idx]; CB[idx] = (bf16)f2bf((1.0f / V_SCALE) * GATES[idx] * gelu_erf(d * (1.0f / U_SCALE))); }
    GRID_BAR();
    {
        int tl = tid; asm volatile("" : "+v"(tl)); const int ln = tl & 63, k = ln >> 3, c8 = ln & 7;
        const unsigned char* VT8 = (const unsigned char*)VT;
        for (int s = xr; s < NSL; s += nx) {
            const unsigned char* Vs = VT8 + (size_t)s * 16384 * 128;
            v4u nid[2][2];
#pragma unroll
            for (int z = 0; z < 2; ++z) { const int tz = wv + z * nwv; const int tc = tz < NTOK ? tz : wv; const GAS v4u* ip = (const GAS v4u*)(IDS + (size_t)tc * 128 + 16 * k);
#pragma unroll
                for (int i = 0; i < 2; ++i) nid[z][i] = ip[i]; }
#pragma unroll 1
            for (int t = wv; t < NTOK; t += 2 * nwv) {
                const bool vB = (t + nwv) < NTOK; const int tt[2] = {t, vB ? t + nwv : t};
                v4u vb[2][16]; v4u cf[2][2]; unsigned hs[2];
#pragma unroll
                for (int z = 0; z < 2; ++z) {
#pragma unroll
                    for (int i = 0; i < 16; ++i) { const unsigned eid = (nid[z][i >> 3][(i >> 1) & 3] >> (16 * (i & 1))) & 0xffffu; vb[z][i] = *(const GAS v4u*)(Vs + (size_t)eid * 128 + 16 * c8); } }
#pragma unroll
                for (int z = 0; z < 2; ++z) { hs[z] = *(const GAS unsigned*)(H1 + (size_t)tt[z] * DM + 128 * s + 16 * c8 + 2 * k);
                    const GAS v4u* cp = (const GAS v4u*)(CB + (size_t)tt[z] * 128 + 16 * k); cf[z][0] = cp[0]; cf[z][1] = cp[1]; }
#pragma unroll
                for (int z = 0; z < 2; ++z) { const int tz = t + (2 + z) * nwv; const int tc = tz < NTOK ? tz : t; const GAS v4u* ip = (const GAS v4u*)(IDS + (size_t)tc * 128 + 16 * k);
#pragma unroll
                    for (int i = 0; i < 2; ++i) nid[z][i] = ip[i]; }
#pragma unroll
                for (int z = 0; z < 2; ++z) {
                    f32x2 accp[8];
#pragma unroll
                    for (int q2 = 0; q2 < 8; ++q2) accp[q2] = (f32x2){0.f, 0.f};
#pragma unroll
                    for (int i = 0; i < 16; ++i) { const unsigned cw = cf[z][i >> 3][(i >> 1) & 3]; const float c = (i & 1) ? bfhi(cw) : bflo(cw); const f32x2 c2 = {c, c};
#pragma unroll
                        for (int dw = 0; dw < 4; ++dw) { const f32x2 fl = __builtin_amdgcn_cvt_pk_f32_fp8((int)vb[z][i][dw], false), fh = __builtin_amdgcn_cvt_pk_f32_fp8((int)vb[z][i][dw], true);
                            accp[2 * dw] = __builtin_elementwise_fma(fl, c2, accp[2 * dw]); accp[2 * dw + 1] = __builtin_elementwise_fma(fh, c2, accp[2 * dw + 1]); } }
                    const bool kb0 = (k & 1) != 0, kb1 = (k & 2) != 0, kb2 = (k & 4) != 0;
                    f32x2 rA[4], rB[2], rC;
#pragma unroll
                    for (int m = 0; m < 4; ++m) { const f32x2 keep = kb0 ? accp[2 * m + 1] : accp[2 * m], give = kb0 ? accp[2 * m] : accp[2 * m + 1];
                        rA[m] = keep + (f32x2){DPPF(give.x, 0x128), DPPF(give.y, 0x128)}; }
#pragma unroll
                    for (int m = 0; m < 2; ++m) { const f32x2 keep = kb1 ? rA[2 * m + 1] : rA[2 * m], give = kb1 ? rA[2 * m] : rA[2 * m + 1];
                        const auto sx = __builtin_amdgcn_permlane16_swap(__float_as_uint(give.x), __float_as_uint(give.x), false, false), sy = __builtin_amdgcn_permlane16_swap(__float_as_uint(give.y), __float_as_uint(give.y), false, false);
                        rB[m] = keep + (f32x2){__uint_as_float(kb1 ? sx[0] : sx[1]), __uint_as_float(kb1 ? sy[0] : sy[1])}; }
                    { const f32x2 keep = kb2 ? rB[1] : rB[0], give = kb2 ? rB[0] : rB[1];
                        const auto sx = __builtin_amdgcn_permlane32_swap(__float_as_uint(give.x), __float_as_uint(give.x), false, false), sy = __builtin_amdgcn_permlane32_swap(__float_as_uint(give.y), __float_as_uint(give.y), false, false);
                        rC = keep + (f32x2){__uint_as_float(kb2 ? sx[0] : sx[1]), __uint_as_float(kb2 ? sy[0] : sy[1])}; }
                    if (z == 0 || vB) *(GAS unsigned*)(YB + (size_t)tt[z] * DM + 128 * s + 16 * c8 + 2 * k) = cvtpk_s(rC.x + ALPHA * bflo(hs[z]), rC.y + ALPHA * bfhi(hs[z]));
                }
            }
        }
    }
    GRID_BAR();
    for (int m = gw; m < NTOK; m += NGW) {
        const GAS v4u* xr4 = (const GAS v4u*)(YB + (size_t)m * DM) + lane;
        float v[32]; float sm = 0.f;
#pragma unroll
        for (int j2 = 0; j2 < 4; ++j2) { const v4u w = xr4[64 * j2];
            v[8 * j2 + 0] = bflo(w.x); v[8 * j2 + 1] = bfhi(w.x); v[8 * j2 + 2] = bflo(w.y); v[8 * j2 + 3] = bfhi(w.y); v[8 * j2 + 4] = bflo(w.z); v[8 * j2 + 5] = bfhi(w.z); v[8 * j2 + 6] = bflo(w.w); v[8 * j2 + 7] = bfhi(w.w); }
#pragma unroll
        for (int i = 0; i < 32; ++i) sm += v[i];
        const float mean = wave_sum(sm) * (1.f / DM); float s2 = 0.f;
#pragma unroll
        for (int i = 0; i < 32; ++i) { v[i] -= mean; s2 += v[i] * v[i]; }
        const float rstd = 1.f / sqrtf(wave_sum(s2) * (1.f / DM) + LN_EPS);
#pragma unroll
        for (int j2 = 0; j2 < 4; ++j2) {
            const GAS f32x4* gp = (const GAS f32x4*)ln_ffn_g + 2 * (lane + 64 * j2); const GAS f32x4* bp = (const GAS f32x4*)ln_ffn_b + 2 * (lane + 64 * j2);
            const f32x4 g0 = gp[0], g1 = gp[1], b0 = bp[0], b1 = bp[1];
            GAS f32x4* op = (GAS f32x4*)(out + (size_t)m * DM) + 2 * (lane + 64 * j2);
            op[0] = (f32x4){v[8 * j2 + 0] * rstd * g0.x + b0.x, v[8 * j2 + 1] * rstd * g0.y + b0.y, v[8 * j2 + 2] * rstd * g0.z + b0.z, v[8 * j2 + 3] * rstd * g0.w + b0.w};
            op[1] = (f32x4){v[8 * j2 + 4] * rstd * g1.x + b1.x, v[8 * j2 + 5] * rstd * g1.y + b1.y, v[8 * j2 + 6] * rstd * g1.z + b1.z, v[8 * j2 + 7] * rstd * g1.w + b1.w}; }
    }
}

extern "C" void kernel_launch(void* const* d_in, const int* in_sizes, int n_in, void* d_out, int out_size, void* d_ws, size_t ws_size, hipStream_t stream) {
    static int grid = 0;
    if (grid == 0) {
        if (n_in != 15 || out_size != NTOK * DM || ws_size < WS_END) { fprintf(stderr, "kernel_launch: unexpected shapes (n_in %d out %d ws %zu)\n", n_in, out_size, ws_size); grid = -1; return; }
        int dev = 0, cus = 0, per_cu = 0;
        if (hipGetDevice(&dev) != hipSuccess || hipDeviceGetAttribute(&cus, hipDeviceAttributeMultiprocessorCount, dev) != hipSuccess) { grid = -1; return; }
        if (hipFuncSetAttribute((const void*)mk_fwd, hipFuncAttributeMaxDynamicSharedMemorySize, LDS_BYTES) != hipSuccess) { fprintf(stderr, "kernel_launch: hipFuncSetAttribute failed\n"); grid = -1; return; }
        if (hipOccupancyMaxActiveBlocksPerMultiprocessor(&per_cu, (const void*)mk_fwd, NWAVES * 64, LDS_BYTES) != hipSuccess || per_cu < 1) { fprintf(stderr, "kernel_launch: occupancy query says %d\n", per_cu); }
        (void)hipGetLastError();
        grid = cus;
    }
    if (grid < 0) return;
    if (hipMemsetAsync((char*)d_ws + WS_CTL, 0, CTL_ZERO_BYTES, stream) != hipSuccess) return;
    Args a{};
    for (int i = 0; i < 15; ++i) a.in[i] = (const float*)d_in[i];
    a.out = (float*)d_out; a.ws = (unsigned char*)d_ws;
    hipLaunchKernelGGL(mk_fwd, dim3(grid), dim3(NWAVES * 64), LDS_BYTES, stream, a);
}
```

```cpp
#include <hip/hip_runtime.h>
#include <cstdio>
#include <cstdint>
#include <cmath>
namespace pg8 {
#define PG8_LAS __attribute__((address_space(3)))
typedef unsigned short bf16_t;
typedef short bf16x8 __attribute__((ext_vector_type(8)));
typedef float f32x4 __attribute__((ext_vector_type(4)));
typedef unsigned u32x4 __attribute__((ext_vector_type(4)));
constexpr int BM = 256, BK = 64, HALF = 128, HTB = HALF * BK * 2  , STAGE_BYTES = 8 * HTB, NXCD = 8, WGM = 8;

__host__ __device__ __forceinline__ int lds_byte(int r, int c) { const int st = (r >> 4) * 2 + (c >> 5), rr = r & 15, cc = c & 31, ob = rr * 64 + cc * 2; return st * 1024 + (ob ^ (((ob >> 9) & 1) << 5)); }
__host__ __device__ __forceinline__ void stage_rc(int b, int& R, int& C) { const int st = b / 1024, sb = b % 1024, swz = sb ^ (((sb >> 9) & 1) << 5); R = (st >> 1) * 16 + swz / 64; C = (st & 1) * 32 + (swz % 64) / 2; }
__host__ __device__ __forceinline__ int perm32(int rho) { const int n = rho >> 4, i = rho & 15; return 8 * (i >> 2) + 4 * n + (i & 3); }

struct Unit { int pm, pn; };
struct Gemm { const bf16_t* A; const bf16_t* Bt; int M, N, K; };

struct StaticOrder {
    int nM, nN, nwg, G, c;
    __host__ __device__ void init(int M, int N, int G_, int c_) { nM = M / BM; nN = N / BM; nwg = nM * nN; G = G_; c = c_; }
    __host__ __device__ bool next(int i, Unit& u) const {
        const long L = (long)i * G + c; if (L >= nwg) return false;
        int wgid = (int)L; { const int q = nwg / NXCD, r = nwg % NXCD, xcd = wgid % NXCD, off = wgid / NXCD; wgid = (xcd < r ? xcd * (q + 1) : r * (q + 1) + (xcd - r) * q) + off; }
        const int nig = WGM * nN, gid = wgid / nig, fm = gid * WGM, gsz = (nM - fm) < WGM ? (nM - fm) : WGM;
        u.pm = fm + ((wgid % nig) % gsz); u.pn = (wgid % nig) / gsz; return true;
    }
    __device__ __forceinline__ void a_ready(const Unit&) const {}
    __device__ __forceinline__ void done(const Unit&) const {}
};

__device__ __forceinline__ unsigned cvt_pk_bf16(float lo, float hi) { unsigned r; asm volatile("v_cvt_pk_bf16_f32 %0, %1, %2" : "=v"(r) : "v"(lo), "v"(hi)); return r; }
typedef float f32x2 __attribute__((ext_vector_type(2)));

template <int MODE> struct EpiGen {
    static constexpr bool PERM = true, AFTER_DRAIN = false;
    bf16_t* O; int ldc; const bf16_t* R; float alpha;
    bf16_t *QR, *KA, *VA, *RK, *RV, *RG;
    __device__ __forceinline__ void operator()(const f32x4 (&acc)[2][2][4][2], const Unit& u, int wr, int wc, int fr, int fq) const {
        const int row0 = u.pm * BM + wr * 64 + fr;
#pragma unroll
        for (int bj = 0; bj < 2; ++bj) {
            const int col = u.pn * BM + bj * HALF + wc * 32 + 8 * fq;
            bf16_t* base = O; int ld = ldc; int cc = col;
            if (MODE == 0) {
                if (col < 1024)      { base = QR; ld = 2048; cc = col; }
                else if (col < 1152) { base = KA; ld = 128;  cc = col - 1024; }
                else if (col < 1280) { base = VA; ld = 128;  cc = col - 1152; }
                else if (col < 2304) { base = QR; ld = 2048; cc = col - 1280 + 1024; }
                else if (col < 3328) { base = RK; ld = 1024; cc = col - 2304; }
                else if (col < 4352) { base = RV; ld = 1024; cc = col - 3328; }
                else                 { base = RG; ld = 1024; cc = col - 4352; }
            }
#pragma unroll
            for (int ai = 0; ai < 2; ++ai)
#pragma unroll
                for (int m = 0; m < 4; ++m) {
                    const int row = row0 + ai * HALF + m * 16;
                    f32x4 v0 = acc[ai][bj][m][0], v1 = acc[ai][bj][m][1];
                    if (MODE == 1) {
                        const u32x4 r = *(const u32x4*)(R + (size_t)row * ldc + col);
                        v0[0] += alpha * __uint_as_float(r.x << 16); v0[1] += alpha * __uint_as_float(r.x & 0xffff0000u);
                        v0[2] += alpha * __uint_as_float(r.y << 16); v0[3] += alpha * __uint_as_float(r.y & 0xffff0000u);
                        v1[0] += alpha * __uint_as_float(r.z << 16); v1[1] += alpha * __uint_as_float(r.z & 0xffff0000u);
                        v1[2] += alpha * __uint_as_float(r.w << 16); v1[3] += alpha * __uint_as_float(r.w & 0xffff0000u);
                    }
                    u32x4 w; w.x = cvt_pk_bf16(v0[0], v0[1]); w.y = cvt_pk_bf16(v0[2], v0[3]); w.z = cvt_pk_bf16(v1[0], v1[1]); w.w = cvt_pk_bf16(v1[2], v1[3]);
                    *(u32x4*)(base + (size_t)row * ld + cc) = w;
                }
        }
    }
};

struct EpiProj {
    static constexpr bool PERM = true, AFTER_DRAIN = false;
    bf16_t *QR, *KA, *VA, *RK, *RV, *RG; float qscale;
    __device__ __forceinline__ void operator()(const f32x4 (&acc)[2][2][4][2], const Unit& u, int wr, int wc, int fr, int fq) const {
        const int pn = u.pn, row0 = u.pm * BM + wr * 64 + fr, c0 = wc * 32 + 8 * fq;
        const bool rope = (pn <= 3) || (pn == 4 && wc < 2) || (pn >= 5 && pn <= 12);
        if (rope) {
            const bool ret = pn >= 5; const int h = ret ? ((pn - 5) & 3) : 0;
            const float lg = __builtin_amdgcn_logf(1.0f - __builtin_amdgcn_exp2f(-5.0f - (float)h));
            float invrev[8];
#pragma unroll
            for (int i8 = 0; i8 < 8; ++i8) { const float ii = (float)((ret ? c0 : 8 * fq) + i8); invrev[i8] = 0.15915494309189535f * __builtin_amdgcn_exp2f(-ii * (ret ? 0.10381025296523008f : 0.4152410118609203f)); }
            bf16_t* base; int ld, cA, cB;
            if (pn <= 3)      { base = QR; ld = 2048; cA = pn * 256 + 64 * wc + 8 * fq; cB = cA + 32; }
            else if (pn == 4) { base = KA; ld = 128;  cA = 64 * wc + 8 * fq; cB = cA + 32; }
            else if (pn <= 8) { base = QR; ld = 2048; cA = 1024 + 256 * h + c0; cB = cA + 128; }
            else              { base = RK; ld = 1024; cA = 256 * h + c0; cB = cA + 128; }
#pragma unroll
            for (int ai = 0; ai < 2; ++ai)
#pragma unroll
                for (int m = 0; m < 4; ++m) {
                    const int row = row0 + ai * HALF + m * 16;
                    int pos, ipos;
                    if (row < 16384) { const int s = row & 4095; pos = 16 + s; ipos = s & 127; } else { int j = row - 16384; if (j > 15) j = 15; pos = j; ipos = 112 + j; }
                    float sc = qscale;
                    if (pn == 4) sc = 1.0f; else if (pn >= 9) sc = 0.0625f * __builtin_amdgcn_exp2f(-(float)(ipos + 1) * lg); else if (pn >= 5) sc = __builtin_amdgcn_exp2f((float)(ipos + 1) * lg);
                    const float pf = (float)pos;
                    float cs[8], sn[8];
#pragma unroll
                    for (int i8 = 0; i8 < 8; ++i8) { const float rev = __builtin_amdgcn_fractf(pf * invrev[i8]); cs[i8] = __builtin_amdgcn_cosf(rev); sn[i8] = __builtin_amdgcn_sinf(rev); }
                    const f32x4 a0 = acc[ai][0][m][0], a1 = acc[ai][0][m][1], b0 = acc[ai][1][m][0], b1 = acc[ai][1][m][1];
                    u32x4 wA, wB;
                    wA.x = cvt_pk_bf16((a0[0] * cs[0] - b0[0] * sn[0]) * sc, (a0[1] * cs[1] - b0[1] * sn[1]) * sc); wA.y = cvt_pk_bf16((a0[2] * cs[2] - b0[2] * sn[2]) * sc, (a0[3] * cs[3] - b0[3] * sn[3]) * sc);
                    wA.z = cvt_pk_bf16((a1[0] * cs[4] - b1[0] * sn[4]) * sc, (a1[1] * cs[5] - b1[1] * sn[5]) * sc); wA.w = cvt_pk_bf16((a1[2] * cs[6] - b1[2] * sn[6]) * sc, (a1[3] * cs[7] - b1[3] * sn[7]) * sc);
                    wB.x = cvt_pk_bf16((b0[0] * cs[0] + a0[0] * sn[0]) * sc, (b0[1] * cs[1] + a0[1] * sn[1]) * sc); wB.y = cvt_pk_bf16((b0[2] * cs[2] + a0[2] * sn[2]) * sc, (b0[3] * cs[3] + a0[3] * sn[3]) * sc);
                    wB.z = cvt_pk_bf16((b1[0] * cs[4] + a1[0] * sn[4]) * sc, (b1[1] * cs[5] + a1[1] * sn[5]) * sc); wB.w = cvt_pk_bf16((b1[2] * cs[6] + a1[2] * sn[6]) * sc, (b1[3] * cs[7] + a1[3] * sn[7]) * sc);
                    *(u32x4*)(base + (size_t)row * ld + cA) = wA; *(u32x4*)(base + (size_t)row * ld + cB) = wB;
                }
        } else {
            const bool silu = pn >= 17;
#pragma unroll
            for (int bj = 0; bj < 2; ++bj) {
                bf16_t* base; int ld, cc;
                if (pn == 4)       { base = VA; ld = 128;  cc = 64 * bj + 32 * (wc - 2) + 8 * fq; }
                else if (pn <= 16) { base = RV; ld = 1024; cc = 256 * (pn - 13) + 128 * bj + c0; }
                else               { base = RG; ld = 1024; cc = 256 * (pn - 17) + 128 * bj + c0; }
#pragma unroll
                for (int ai = 0; ai < 2; ++ai)
#pragma unroll
                    for (int m = 0; m < 4; ++m) {
                        const int row = row0 + ai * HALF + m * 16;
                        f32x4 v0 = acc[ai][bj][m][0], v1 = acc[ai][bj][m][1];
                        if (silu) {
#pragma unroll
                            for (int e = 0; e < 4; ++e) { v0[e] = v0[e] * __builtin_amdgcn_rcpf(1.0f + __builtin_amdgcn_exp2f(-1.4426950408889634f * v0[e])); v1[e] = v1[e] * __builtin_amdgcn_rcpf(1.0f + __builtin_amdgcn_exp2f(-1.4426950408889634f * v1[e])); } }
                        u32x4 w; w.x = cvt_pk_bf16(v0[0], v0[1]); w.y = cvt_pk_bf16(v0[2], v0[3]); w.z = cvt_pk_bf16(v1[0], v1[1]); w.w = cvt_pk_bf16(v1[2], v1[3]);
                        *(u32x4*)(base + (size_t)row * ld + cc) = w;
                    }
            }
        }
    }
};
template <class Epi, class Sched, bool ALIGN_EPI = false, bool SP2 = false>
__device__ __forceinline__ void gemm_phase(PG8_LAS unsigned char* lds, const Gemm g, const Sched& S, const Epi& E) {
    const int tid = threadIdx.x, wid = __builtin_amdgcn_readfirstlane(tid >> 6), lane = tid & 63, wr = wid >> 2, wc = wid & 3, fr = lane & 15, fq = lane >> 4;
    const int K = g.K, nt = K / BK;
    unsigned voffA[2], voffB[2];
#pragma unroll
    for (int i = 0; i < 2; ++i) { int R, C; stage_rc(tid * 16 + i * 8192, R, C); const int Rb = Epi::PERM ? ((R & ~31) + perm32(R & 31)) : R;
        voffA[i] = (unsigned)(R * K + C) * 2u; voffB[i] = (unsigned)(Rb * K + C) * 2u; }
    const size_t kstep = (size_t)(BK * 2);
    const size_t hstep = (size_t)HALF * K * 2;
    const size_t tstep = 2 * hstep;
    const unsigned ldsw = (unsigned)wid * 1024u;
    const int aoff = lds_byte(wr * 64 + fr, fq * 8), boff = lds_byte(wc * 32 + fr, fq * 8);
#define PG8_SA(b, h) (((b) * 2 + (h)) * HTB)
#define PG8_SB(b, h) ((4 + (b) * 2 + (h)) * HTB)
#define PG8_STAGE(bufoff, gbase, voff) do { _Pragma("unroll") for (int _i = 0; _i < 2; ++_i) \
        __builtin_amdgcn_global_load_lds((const unsigned*)((const char*)(gbase) + (voff)[_i]), (PG8_LAS unsigned*)(lds + (bufoff) + ldsw + _i * 8192), 16, 0, 0); } while (0)
#define PG8_LDA(dst, b, h) do { _Pragma("unroll") for (int m = 0; m < 4; ++m) _Pragma("unroll") for (int k = 0; k < 2; ++k) dst[m][k] = *(const PG8_LAS bf16x8*)(lds + PG8_SA(b, h) + aoff + m * 2048 + k * 1024); } while (0)
#define PG8_LDB(dst, b, h) do { _Pragma("unroll") for (int n = 0; n < 2; ++n) _Pragma("unroll") for (int k = 0; k < 2; ++k) dst[n][k] = *(const PG8_LAS bf16x8*)(lds + PG8_SB(b, h) + boff + n * 2048 + k * 1024); } while (0)
#define PG8_MMA(ai, bj, At, Bt) do { __builtin_amdgcn_s_setprio(1); _Pragma("unroll") for (int m = 0; m < 4; ++m) _Pragma("unroll") for (int n = 0; n < 2; ++n) _Pragma("unroll") for (int k = 0; k < 2; ++k) \
        acc[ai][bj][m][n] = __builtin_amdgcn_mfma_f32_16x16x32_bf16(Bt[n][k], At[m][k], acc[ai][bj][m][n], 0, 0, 0); __builtin_amdgcn_s_setprio(0); } while (0)
#define PG8_WAIT_V(n) asm volatile("s_waitcnt vmcnt(" #n ")" ::: "memory")
#define PG8_WAIT_L(n) asm volatile("s_waitcnt lgkmcnt(" #n ")" ::: "memory")
#define PG8_BAR __builtin_amdgcn_s_barrier()
#define PG8_SCHED __builtin_amdgcn_sched_barrier(0)
    Unit cur, nxt; int ui = 0;
    if (!S.next(0, cur)) return;
    f32x4 acc[2][2][4][2];
#pragma unroll
    for (int a = 0; a < 2; ++a)
#pragma unroll
        for (int b = 0; b < 2; ++b)
#pragma unroll
            for (int m = 0; m < 4; ++m)
#pragma unroll
                for (int n = 0; n < 2; ++n) acc[a][b][m][n] = (f32x4){0.f, 0.f, 0.f, 0.f};
    bf16x8 At[4][2], B0[2][2], B1[2][2];
    const char* cA = (const char*)g.A + (size_t)cur.pm * tstep; const char* cB = (const char*)g.Bt + (size_t)cur.pn * tstep;
    S.a_ready(cur);
    if constexpr (SP2) {
        PG8_STAGE(PG8_SB(0, 0), cB, voffB); PG8_STAGE(PG8_SB(0, 1), cB + hstep, voffB); PG8_STAGE(PG8_SA(0, 0), cA, voffA); PG8_STAGE(PG8_SA(0, 1), cA + hstep, voffA);
        if (wr == 1) PG8_BAR;
        PG8_WAIT_V(2); PG8_BAR;
        PG8_STAGE(PG8_SB(1, 0), cB + kstep, voffB); PG8_STAGE(PG8_SA(1, 0), cA + kstep, voffA); PG8_STAGE(PG8_SB(1, 1), cB + hstep + kstep, voffB);
        PG8_WAIT_V(6); PG8_BAR;
    } else {
        PG8_STAGE(PG8_SB(0, 0), cB, voffB); PG8_STAGE(PG8_SA(0, 0), cA, voffA); PG8_STAGE(PG8_SB(0, 1), cB + hstep, voffB); PG8_STAGE(PG8_SA(0, 1), cA + hstep, voffA);
        if (wr == 1) PG8_BAR;
        PG8_WAIT_V(4); PG8_BAR;
        PG8_STAGE(PG8_SB(1, 0), cB + kstep, voffB); PG8_STAGE(PG8_SA(1, 0), cA + kstep, voffA); PG8_STAGE(PG8_SB(1, 1), cB + hstep + kstep, voffB);
        PG8_WAIT_V(6); PG8_BAR;
    }
    for (;;) {
        const bool has_next = S.next(ui + 1, nxt);
        const char* nA = has_next ? (const char*)g.A + (size_t)nxt.pm * tstep : cA; const char* nB = has_next ? (const char*)g.Bt + (size_t)nxt.pn * tstep : cB;
        for (int t = 0; t < nt; t += 2) {
            const bool last = (t == nt - 2);
            const char* a1 = cA + (size_t)(t + 1) * kstep;
            const char* a2 = last ? nA : cA + (size_t)(t + 2) * kstep; const char* b2 = last ? nB : cB + (size_t)(t + 2) * kstep;
            const char* a3 = a2 + kstep; const char* b3 = b2 + kstep;
            if (last && has_next) S.a_ready(nxt);
            if constexpr (SP2) {
            PG8_LDB(B0, 0, 0); PG8_LDB(B1, 0, 1); PG8_SCHED; PG8_LDA(At, 0, 0); PG8_STAGE(PG8_SA(1, 1), a1 + hstep, voffA);
            PG8_WAIT_V(8); PG8_WAIT_L(0); PG8_BAR; PG8_MMA(0, 0, At, B0); PG8_MMA(0, 1, At, B1); PG8_BAR; PG8_SCHED;
            PG8_LDA(At, 0, 1); PG8_STAGE(PG8_SB(0, 0), b2, voffB); PG8_STAGE(PG8_SB(0, 1), b2 + hstep, voffB); PG8_STAGE(PG8_SA(0, 0), a2, voffA);
            PG8_WAIT_V(8); PG8_WAIT_L(0); PG8_BAR; PG8_MMA(1, 0, At, B0); PG8_MMA(1, 1, At, B1); PG8_BAR; PG8_SCHED;
            PG8_LDB(B0, 1, 0); PG8_LDB(B1, 1, 1); PG8_SCHED; PG8_LDA(At, 1, 0); PG8_STAGE(PG8_SA(0, 1), a2 + hstep, voffA);
            PG8_WAIT_V(8); PG8_WAIT_L(0); PG8_BAR; PG8_MMA(0, 0, At, B0); PG8_MMA(0, 1, At, B1); PG8_BAR; PG8_SCHED;
            PG8_LDA(At, 1, 1); PG8_STAGE(PG8_SB(1, 0), b3, voffB); PG8_STAGE(PG8_SB(1, 1), b3 + hstep, voffB); PG8_STAGE(PG8_SA(1, 0), a3, voffA);
            PG8_WAIT_V(8); PG8_WAIT_L(0); PG8_BAR; PG8_MMA(1, 0, At, B0); PG8_MMA(1, 1, At, B1); PG8_BAR; PG8_SCHED;
            } else {
            PG8_LDB(B0, 0, 0); PG8_SCHED; PG8_LDA(At, 0, 0); PG8_STAGE(PG8_SA(1, 1), a1 + hstep, voffA);
            PG8_WAIT_L(8); PG8_BAR; PG8_WAIT_L(0); PG8_MMA(0, 0, At, B0); PG8_BAR; PG8_SCHED;
            PG8_LDB(B1, 0, 1); PG8_STAGE(PG8_SB(0, 0), b2, voffB);
            PG8_BAR; PG8_WAIT_L(0); PG8_MMA(0, 1, At, B1); PG8_BAR;
            PG8_LDA(At, 0, 1); PG8_STAGE(PG8_SA(0, 0), a2, voffA);
            PG8_BAR; PG8_WAIT_L(0); PG8_MMA(1, 0, At, B0); PG8_BAR; PG8_SCHED;
            PG8_STAGE(PG8_SB(0, 1), b2 + hstep, voffB);
            PG8_WAIT_V(6); PG8_BAR; PG8_MMA(1, 1, At, B1); PG8_BAR;
            PG8_LDB(B0, 1, 0); PG8_SCHED; PG8_LDA(At, 1, 0); PG8_STAGE(PG8_SA(0, 1), a2 + hstep, voffA);
            PG8_WAIT_L(8); PG8_BAR; PG8_WAIT_L(0); PG8_MMA(0, 0, At, B0); PG8_BAR; PG8_SCHED;
            PG8_LDB(B1, 1, 1); PG8_STAGE(PG8_SB(1, 0), b3, voffB);
            PG8_BAR; PG8_WAIT_L(0); PG8_MMA(0, 1, At, B1); PG8_BAR;
            PG8_LDA(At, 1, 1); PG8_STAGE(PG8_SA(1, 0), a3, voffA);
            PG8_BAR; PG8_WAIT_L(0); PG8_MMA(1, 0, At, B0); PG8_BAR; PG8_SCHED;
            PG8_STAGE(PG8_SB(1, 1), b3 + hstep, voffB);
            PG8_WAIT_V(6); PG8_BAR; PG8_MMA(1, 1, At, B1); PG8_BAR;
            }
        }
        if constexpr (ALIGN_EPI) { if (wr == 0) PG8_BAR; }
        if constexpr (!Epi::AFTER_DRAIN) { E(acc, cur, wr, wc, fr, fq); S.done(cur); }
        if (!has_next) break;
#pragma unroll
        for (int a = 0; a < 2; ++a)
#pragma unroll
            for (int b = 0; b < 2; ++b)
#pragma unroll
                for (int m = 0; m < 4; ++m)
#pragma unroll
                    for (int n = 0; n < 2; ++n) acc[a][b][m][n] = (f32x4){0.f, 0.f, 0.f, 0.f};
        cur = nxt; cA = nA; cB = nB; ++ui;
        if constexpr (ALIGN_EPI) { if (wr == 1) PG8_BAR; }
    }
    PG8_WAIT_V(0);
    if constexpr (!ALIGN_EPI) { if (wr == 0) PG8_BAR; }
    PG8_BAR;
    if constexpr (Epi::AFTER_DRAIN) { E.fused(acc, cur, wr, wc, fr, fq, lds, wid, lane); S.done(cur); }
#undef PG8_SA
#undef PG8_SB
#undef PG8_STAGE
#undef PG8_LDA
#undef PG8_LDB
#undef PG8_MMA
#undef PG8_WAIT_V
#undef PG8_WAIT_L
#undef PG8_BAR
#undef PG8_SCHED
}
}

constexpr int NWAVES = 8;
constexpr int DM = 2048, NB = 4, SEQ = 4096, NTOK = NB * SEQ;
constexpr int NMETA = 16, NVALID = NTOK + NMETA, MROWS = 16640;
constexpr int IN_COLS = 5376;
constexpr float LN_EPS = 1e-5f, GN_EPS = 1e-5f;
constexpr float ALPHA = 1.189207115002721f;
constexpr float LOG2E = 1.4426950408889634f;
constexpr float QSCALE = 0.125f * LOG2E;
constexpr float U_SCALE = 64.0f, V_SCALE = 4.0f;
constexpr int NSL = 16;

constexpr size_t MiB = 1u << 20;
constexpr size_t WS_CTL = 0, CTL_ZERO_BYTES = 65536;
constexpr size_t SZ_SK = (size_t)16 * 128 * 128 * 2, SZ_ROPE_R = (size_t)4112 * 128 * 8, SZ_ROPE_A = (size_t)4112 * 32 * 8;
constexpr size_t SZ_W2T = (size_t)DM * DM * 2, SZ_W1T = (size_t)IN_COLS * DM * 2, SZ_TAB = (size_t)16384 * DM * 2;
constexpr size_t SZ_ROWS2K = (size_t)MROWS * 2048 * 2, SZ_ROWS1K = (size_t)MROWS * 1024 * 2, SZ_ROWS128 = (size_t)MROWS * 128 * 2;
constexpr size_t SZ_TOK2K = (size_t)NTOK * 2048 * 2, SZ_ST = (size_t)16 * 32 * 256 * 256 * 2, SZ_IDS = (size_t)NTOK * 128 * 4;
constexpr size_t al256(size_t x) { return (x + 255) & ~(size_t)255; }
constexpr size_t WS_SK = 1 * MiB;
constexpr size_t WS_ROPE_R = al256(WS_SK + SZ_SK);
constexpr size_t WS_ROPE_A = al256(WS_ROPE_R + SZ_ROPE_R);
constexpr size_t WS_W2T = al256(WS_ROPE_A + SZ_ROPE_A), WS_W3T = al256(WS_W2T + SZ_W2T), WS_W1T = al256(WS_W3T + SZ_W2T);
constexpr size_t WS_UT = al256(WS_W1T + SZ_W1T), WS_VT = al256(WS_UT + SZ_TAB);
constexpr size_t WS_H0 = al256(WS_VT + SZ_TAB);
constexpr size_t WS_QR = al256(WS_H0 + SZ_ROWS2K);
constexpr size_t WS_KA = al256(WS_QR + SZ_ROWS2K), WS_VA = al256(WS_KA + SZ_ROWS128);
constexpr size_t WS_RK = al256(WS_VA + SZ_ROWS128), WS_RV = al256(WS_RK + SZ_ROWS1K), WS_RG = al256(WS_RV + SZ_ROWS1K);
constexpr size_t WS_ST = al256(WS_RG + SZ_ROWS1K);
constexpr size_t WS_Y = WS_RK;
constexpr size_t WS_H1 = WS_ST;
constexpr size_t WS_IDS = al256(WS_ST + SZ_ST), WS_GATES = al256(WS_IDS + SZ_IDS);
constexpr size_t WS_END = al256(WS_GATES + SZ_IDS);
static_assert(WS_Y + SZ_TOK2K <= WS_RG, "Y overlays RK|RV only");
static_assert(SZ_TOK2K <= SZ_ST && (size_t)NTOK * 1024 * 4 <= SZ_ST, "H1 / RET_RAW fit the state region");
static_assert(WS_END <= (size_t)512 * MiB, "workspace map fits 4 x largest tensor");
static_assert(WS_RK + (size_t)8 * NTOK * 128 * 4 <= WS_ST && WS_KA + (size_t)NTOK * 128 * 4 <= WS_RK && WS_H0 + (size_t)NTOK * DM * 4 <= WS_KA, "expert-phase overlays (DOTX over RK|RV, CB over KA|VA, Y32 over H0|QR)");
constexpr int CW_TMO = 0, CW_TABQ = 64, CW_BAR = 4096;

constexpr int RING_OFF = 0, RING_BYTES = 131072;
constexpr int LDSCTL_OFF = RING_BYTES, MISC_OFF = LDSCTL_OFF + 320;
constexpr int LDS_BYTES = 147456;

#define GAS __attribute__((address_space(1)))
#define LAS __attribute__((address_space(3)))
typedef unsigned short bf16;
typedef unsigned v4u __attribute__((ext_vector_type(4)));
typedef unsigned v2u __attribute__((ext_vector_type(2)));
typedef float f32x4 __attribute__((ext_vector_type(4)));
typedef float f32x2 __attribute__((ext_vector_type(2)));
typedef GAS unsigned gu32;
typedef __bf16 bf16x2_t __attribute__((ext_vector_type(2)));
#define RLX_AGENT __ATOMIC_RELAXED, __HIP_MEMORY_SCOPE_AGENT
#define LDS_WAIT() asm volatile("s_waitcnt lgkmcnt(0)" ::: "memory")
#define VM_WAIT() asm volatile("s_waitcnt vmcnt(0)" ::: "memory")
#define LDS_BAR() do { asm volatile("s_waitcnt lgkmcnt(0)" ::: "memory"); __builtin_amdgcn_s_barrier(); asm volatile("" ::: "memory"); } while (0)
__device__ __forceinline__ unsigned f2bf(float f) { unsigned u = __builtin_bit_cast(unsigned, f); return (u + 0x7fffu + ((u >> 16) & 1u)) >> 16; }
__device__ __forceinline__ unsigned pk2(float lo, float hi) { return f2bf(lo) | (f2bf(hi) << 16); }
__device__ __forceinline__ float bflo(unsigned w) { return __uint_as_float(w << 16); }
__device__ __forceinline__ float bfhi(unsigned w) { return __uint_as_float(w & 0xffff0000u); }
__device__ __forceinline__ float bf2f(bf16 h) { return __uint_as_float((unsigned)h << 16); }

#define XB_TMO      128
#define XB_XCNT(j)  (256  + 64 * (j))
#define XB_XSUB(j)  (1280 + 64 * (j))
#define XB_XGEN(j)  (2304 + 64 * (j))
#define XB_TOP      3328
#define XB_TOPGEN   3392
#define XCD_BAR_WORDS 3456
#define XB_SPIN_CAP (1u << 18)

__device__ __forceinline__ unsigned xb_ld(unsigned* p)              { return __hip_atomic_load(p, __ATOMIC_RELAXED, __HIP_MEMORY_SCOPE_AGENT); }
__device__ __forceinline__ unsigned xb_add(unsigned* p, unsigned v) { return __hip_atomic_fetch_add(p, v, __ATOMIC_RELAXED, __HIP_MEMORY_SCOPE_AGENT); }
__device__ __forceinline__ unsigned xb_xcc_id() { return (unsigned)__builtin_amdgcn_s_getreg((3 << 11) | 20) & 0xFu; }
#define XB_SPIN(cond, bar) do { unsigned _sp = 0; while (cond) { __builtin_amdgcn_s_sleep(1); \
    if ((++_sp & 255u) == 0u) { if (xb_ld(&(bar)[XB_TMO])) break; if (_sp > XB_SPIN_CAP) { atomicAdd(&(bar)[XB_TMO], 1u); break; } } } } while (0)

struct XcdBarrier {
    unsigned* bar; unsigned x;
    volatile LAS unsigned* st;
};

__device__ __forceinline__ XcdBarrier xcd_barrier_post(unsigned* bar, volatile LAS unsigned* st) {
    XcdBarrier b; b.bar = bar; b.x = xb_xcc_id(); b.st = st;
    if (threadIdx.x == 0) (void)xb_add(&bar[XB_XCNT(b.x)], 1u);
    return b;
}
__device__ __forceinline__ void xcd_barrier_complete(unsigned* bar, unsigned x, unsigned& nloc, unsigned& nx) {
    const unsigned G = gridDim.x * gridDim.y * gridDim.z;
    unsigned sum, cnt, mine, sp = 0u;
    for (;;) {
        sum = 0u; cnt = 0u; mine = 0u;
#pragma unroll
        for (unsigned j = 0; j < 16; ++j) { const unsigned c = xb_ld(&bar[XB_XCNT(j)]); sum += c; cnt += (c > 0u) ? 1u : 0u; mine = (j == x) ? c : mine; }
        if (sum == G) break;
        __builtin_amdgcn_s_sleep(1);
        if ((++sp & 255u) == 0u) { if (xb_ld(&bar[XB_TMO])) break; if (sp > XB_SPIN_CAP) { atomicAdd(&bar[XB_TMO], 1u); break; } }
    }
    nloc = mine > 0u ? mine : 1u; nx = cnt > 0u ? cnt : 1u;
}

__device__ __forceinline__ void xcd_barrier(const XcdBarrier& b) {
    asm volatile("s_waitcnt vmcnt(0)" ::: "memory");
    __syncthreads();
    if (threadIdx.x == 0) {
        unsigned* bar = b.bar;
        __builtin_amdgcn_s_waitcnt(0);
        unsigned nloc = b.st[0], nx = b.st[1];
        if (nloc == 0u) { xcd_barrier_complete(bar, b.x, nloc, nx); b.st[0] = nloc; b.st[1] = nx; }
        const unsigned old = xb_add(&bar[XB_XSUB(b.x)], 1u);
        const unsigned gen = old / nloc;
        if (old + 1u == (gen + 1u) * nloc) {
            __builtin_amdgcn_fence(__ATOMIC_RELEASE, "agent");
            asm volatile("s_waitcnt vmcnt(0)" ::: "memory");
            const unsigned og = xb_add(&bar[XB_TOP], 1u);
            const unsigned tg = og / nx;
            if (og + 1u == (tg + 1u) * nx) xb_add(&bar[XB_TOPGEN], 1u);
            else XB_SPIN(xb_ld(&bar[XB_TOPGEN]) == tg, bar);
            __builtin_amdgcn_fence(__ATOMIC_ACQUIRE, "agent");
            xb_add(&bar[XB_XGEN(b.x)], 1u);
            asm volatile("s_waitcnt vmcnt(0)" ::: "memory");
        } else {
            XB_SPIN(xb_ld(&bar[XB_XGEN(b.x)]) == gen, bar);
            __builtin_amdgcn_fence(__ATOMIC_ACQUIRE, "agent");
            asm volatile("s_waitcnt vmcnt(0)" ::: "memory");
        }
    }
    __syncthreads();
}


__device__ __forceinline__ float dot2bf(unsigned a, unsigned b, float c) { asm("v_dot2c_f32_bf16 %0, %1, %2" : "+v"(c) : "v"(a), "v"(b)); return c; }
__device__ __forceinline__ float dot8bf_dpp(v4u a, v4u b) { float c = 0.f; asm("v_dot2c_f32_bf16 %0, %1, %5\n\tv_dot2c_f32_bf16 %0, %2, %6\n\tv_dot2c_f32_bf16 %0, %3, %7\n\tv_dot2c_f32_bf16 %0, %4, %8\n\ts_nop 1" : "+v"(c) : "v"(a.x), "v"(a.y), "v"(a.z), "v"(a.w), "v"(b.x), "v"(b.y), "v"(b.z), "v"(b.w)); return c; }
#define DPPF(v, ctrl) __int_as_float(__builtin_amdgcn_update_dpp(0, __float_as_int(v), (ctrl), 0xf, 0xf, true))
__device__ __forceinline__ float wave_sum(float v) {
#pragma unroll
    for (int o = 1; o < 64; o <<= 1) v += __shfl_xor(v, o);
    return v;
}
__device__ __forceinline__ float gelu_erf(float v) {
    const float av = fabsf(v), d = av * 0.2316418882f + 1.0f;
    const float t = __builtin_amdgcn_rcpf(d);
    float q = t * 0.5307027145f + (-0.7265760135f); q = q * t + 0.7107068705f; q = q * t + (-0.142248368f); q = q * t + 0.127414796f; q = q * t;
    const float e = __builtin_amdgcn_exp2f((v * v) * (-0.72134752044f));
    const float m = v * (q * e);
    return v < 0.f ? m : v - m;
}

struct Args { const float* in[15]; float* out; unsigned char* ws; };

__device__ __forceinline__ int w1_logical_col(int n0p) {
    const int pn = n0p >> 8, blk = (n0p & 255) >> 5, half = blk >> 2, a = blk & 3;
    if (pn <= 3) return pn * 256 + 64 * a + 32 * half;
    if (pn == 4) return (a < 2) ? (1024 + 64 * a + 32 * half) : (1152 + 64 * half + 32 * (a - 2));
    return n0p;
}
template <bool PERMW1> __device__ __forceinline__ void p0_transpose_item(const float* W, int K, int N, bf16* WT, LAS float* scr, int item, int lane) {
    const int nblk = N / 32, kb = item / nblk, nb = item % nblk, k0 = 64 * kb, n0 = 32 * nb; const int ns = PERMW1 ? w1_logical_col(n0) : n0;
    float tv[32];
#pragma unroll
    for (int i = 0; i < 32; ++i) { const int kk = 2 * i + (lane >> 5); tv[i] = W[(size_t)(k0 + kk) * N + ns + (lane & 31)]; }
#pragma unroll
    for (int i = 0; i < 32; ++i) { const int kk = 2 * i + (lane >> 5); scr[kk * 33 + (lane & 31)] = tv[i]; }
    LDS_WAIT(); asm volatile("" ::: "memory");
    const int c = lane & 7;
#pragma unroll
    for (int j = 0; j < 4; ++j) { const int n = (lane >> 3) + 8 * j; const LAS float* s = scr + (8 * c) * 33 + n;
        v4u o; o.x = pk2(s[0 * 33], s[1 * 33]); o.y = pk2(s[2 * 33], s[3 * 33]); o.z = pk2(s[4 * 33], s[5 * 33]); o.w = pk2(s[6 * 33], s[7 * 33]);
        *(GAS v4u*)(WT + (size_t)(n0 + n) * K + k0 + 8 * c) = o; }
    LDS_WAIT(); asm volatile("" ::: "memory");
}
__device__ __forceinline__ void ln_row_f32_to_bf16(const float* xrow, const float* g, const float* bta, bf16* orow, int lane) {
    const GAS f32x4* xr = (const GAS f32x4*)xrow + lane;
    f32x4 v[8]; float s = 0.f;
#pragma unroll
    for (int j = 0; j < 8; ++j) { v[j] = xr[64 * j]; s += (v[j].x + v[j].y) + (v[j].z + v[j].w); }
    const float mean = wave_sum(s) * (1.f / DM); float s2 = 0.f;
#pragma unroll
    for (int j = 0; j < 8; ++j) { v[j] = v[j] - mean; s2 += (v[j].x * v[j].x + v[j].y * v[j].y) + (v[j].z * v[j].z + v[j].w * v[j].w); }
    const float rstd = 1.f / sqrtf(wave_sum(s2) * (1.f / DM) + LN_EPS);
    GAS v2u* o8 = (GAS v2u*)orow + lane;
#pragma unroll
    for (int j = 0; j < 8; ++j) { const f32x4 gg = ((const GAS f32x4*)g)[lane + 64 * j], bb = ((const GAS f32x4*)bta)[lane + 64 * j];
        v2u o; o.x = pk2(v[j].x * rstd * gg.x + bb.x, v[j].y * rstd * gg.y + bb.y); o.y = pk2(v[j].z * rstd * gg.z + bb.z, v[j].w * rstd * gg.w + bb.w); o8[64 * j] = o; }
}
__device__ __forceinline__ void ln_row_bf16_to_bf16(const bf16* xrow, const float* g, const float* bta, bf16* orow, int lane) {
    const GAS v4u* xr = (const GAS v4u*)xrow + lane;
    float v[32]; float s = 0.f;
#pragma unroll
    for (int j = 0; j < 4; ++j) { const v4u w = xr[64 * j];
        v[8 * j + 0] = bflo(w.x); v[8 * j + 1] = bfhi(w.x); v[8 * j + 2] = bflo(w.y); v[8 * j + 3] = bfhi(w.y);
        v[8 * j + 4] = bflo(w.z); v[8 * j + 5] = bfhi(w.z); v[8 * j + 6] = bflo(w.w); v[8 * j + 7] = bfhi(w.w); }
#pragma unroll
    for (int i = 0; i < 32; ++i) s += v[i];
    const float mean = wave_sum(s) * (1.f / DM); float s2 = 0.f;
#pragma unroll
    for (int i = 0; i < 32; ++i) { v[i] -= mean; s2 += v[i] * v[i]; }
    const float rstd = 1.f / sqrtf(wave_sum(s2) * (1.f / DM) + LN_EPS);
    GAS v4u* o16 = (GAS v4u*)orow + lane;
#pragma unroll
    for (int j = 0; j < 4; ++j) {
        const GAS f32x4* gp = (const GAS f32x4*)g + 2 * (lane + 64 * j); const GAS f32x4* bp = (const GAS f32x4*)bta + 2 * (lane + 64 * j);
        const f32x4 g0 = gp[0], g1 = gp[1], b0 = bp[0], b1 = bp[1];
        v4u o; o.x = pk2(v[8 * j + 0] * rstd * g0.x + b0.x, v[8 * j + 1] * rstd * g0.y + b0.y); o.y = pk2(v[8 * j + 2] * rstd * g0.z + b0.z, v[8 * j + 3] * rstd * g0.w + b0.w);
        o.z = pk2(v[8 * j + 4] * rstd * g1.x + b1.x, v[8 * j + 5] * rstd * g1.y + b1.y); o.w = pk2(v[8 * j + 6] * rstd * g1.z + b1.z, v[8 * j + 7] * rstd * g1.w + b1.w);
        o16[64 * j] = o; }
}
__device__ __forceinline__ void row_pos(int r, int& pos, int& ipos) {
    if (r < NTOK) { const int s = r & (SEQ - 1); pos = NMETA + s; ipos = s & 127; }
    else { int j = r - NTOK; if (j > NMETA - 1) j = NMETA - 1; pos = j; ipos = 112 + j; }
}
__device__ __forceinline__ float log2_gamma(int h) { return log2f(1.0f - exp2f(-5.0f - (float)h)); }


typedef short bf16x8 __attribute__((ext_vector_type(8)));
typedef short s16x4 __attribute__((ext_vector_type(4)));
#define MFMA16(a, b, c) __builtin_amdgcn_mfma_f32_16x16x32_bf16((a), (b), (c), 0, 0, 0)
__device__ __forceinline__ s16x4 tr16(LAS const unsigned char* p) { return __builtin_bit_cast(s16x4, __builtin_amdgcn_ds_read_tr16_b64_v4i16((LAS s16x4*)p)); }
__device__ __forceinline__ bf16x8 cat8(s16x4 a, s16x4 b) { return __builtin_shufflevector(a, b, 0, 1, 2, 3, 4, 5, 6, 7); }
__device__ __forceinline__ unsigned cvtpk_s(float lo, float hi) { f32x2 v = {lo, hi}; bf16x2_t b = __builtin_convertvector(v, bf16x2_t); return __builtin_bit_cast(unsigned, b); }
__device__ __forceinline__ unsigned cvtpk(float lo, float hi) { unsigned r; asm("v_cvt_pk_bf16_f32 %0, %1, %2" : "=v"(r) : "v"(lo), "v"(hi)); return r; }

__device__ __forceinline__ void scan_unit(LAS unsigned char* L, int u, const bf16* RK, const bf16* RV, bf16* ST, int tid, int lane, int wave) {
    asm volatile("" : "+v"(tid)); lane = tid & 63;
    const int bh = u >> 4, di = (u >> 2) & 3, ei = u & 3, b = bh >> 2, h = bh & 3;
    const float g128 = exp2f(128.0f * log2_gamma(h));
    const int li = lane & 15, g = lane >> 4, q = li >> 2, p4 = li & 3;
    const int eb = wave >> 1, db0 = 2 * (wave & 1);
    f32x4 acc[2]; acc[0] = (f32x4){0.f, 0.f, 0.f, 0.f}; acc[1] = acc[0];
    v4u kA[2], vA[2], kB[2], vB[2];
#define SCAN_LOAD(cc, kreg, vreg) do { _Pragma("unroll") for (int i_ = 0; i_ < 2; ++i_) { const int cid_ = tid + 512 * i_, row_ = cid_ >> 3, c16_ = cid_ & 7; \
        int srow_; bool ok_ = true; if ((cc) < 0) { ok_ = row_ >= 112; srow_ = NTOK + (ok_ ? row_ - 112 : 0); } else srow_ = b * SEQ + (cc) * 128 + row_; \
        const v4u kz_ = *(const GAS v4u*)(RK + (size_t)srow_ * 1024 + h * 256 + di * 64 + c16_ * 8), vz_ = *(const GAS v4u*)(RV + (size_t)srow_ * 1024 + h * 256 + ei * 64 + c16_ * 8); \
        kreg[i_] = ok_ ? kz_ : (v4u){0u, 0u, 0u, 0u}; vreg[i_] = ok_ ? vz_ : (v4u){0u, 0u, 0u, 0u}; } } while (0)
#define SCAN_WRITE(bufp, kreg, vreg) do { _Pragma("unroll") for (int i_ = 0; i_ < 2; ++i_) { const int cid_ = tid + 512 * i_, row_ = cid_ >> 3, c16_ = cid_ & 7; \
        *(LAS v4u*)((bufp) + row_ * 128 + c16_ * 16) = kreg[i_]; *(LAS v4u*)((bufp) + 16384 + row_ * 128 + c16_ * 16) = vreg[i_]; } } while (0)
    SCAN_LOAD(-1, kA, vA); SCAN_WRITE(L, kA, vA); SCAN_LOAD(0, kA, vA); SCAN_LOAD(1, kB, vB); LDS_BAR();
    int cur = 0;
    for (int cc = -1; cc <= 29; cc += 2) {
        { LAS const unsigned char* Kt = L + cur * 32768; LAS const unsigned char* Vt = Kt + 16384;
#pragma unroll
          for (int ks = 0; ks < 4; ++ks) { const int r0 = (32 * ks + 8 * g + q) * 128;
              const bf16x8 a = cat8(tr16(Vt + r0 + (16 * eb + 4 * p4) * 2), tr16(Vt + r0 + 512 + (16 * eb + 4 * p4) * 2));
#pragma unroll
              for (int n = 0; n < 2; ++n) { const bf16x8 bb = cat8(tr16(Kt + r0 + (16 * (db0 + n) + 4 * p4) * 2), tr16(Kt + r0 + 512 + (16 * (db0 + n) + 4 * p4) * 2)); acc[n] = MFMA16(a, bb, acc[n]); } }
#pragma unroll
          for (int n = 0; n < 2; ++n) { acc[n] = acc[n] * g128;
              bf16* sp = ST + ((size_t)(bh * 32 + cc + 1) * 256 + (64 * ei + 16 * eb + 4 * g)) * 256 + 64 * di + 16 * (db0 + n) + li;
#pragma unroll
              for (int r = 0; r < 4; ++r) sp[(size_t)r * 256] = (bf16)f2bf(acc[n][r]); }
          SCAN_WRITE(L + (cur ^ 1) * 32768, kA, vA);
          if (cc + 3 <= 30) SCAN_LOAD(cc + 3, kA, vA);
          LDS_BAR(); cur ^= 1; }
        { LAS const unsigned char* Kt = L + cur * 32768; LAS const unsigned char* Vt = Kt + 16384;
#pragma unroll
          for (int ks = 0; ks < 4; ++ks) { const int r0 = (32 * ks + 8 * g + q) * 128;
              const bf16x8 a = cat8(tr16(Vt + r0 + (16 * eb + 4 * p4) * 2), tr16(Vt + r0 + 512 + (16 * eb + 4 * p4) * 2));
#pragma unroll
              for (int n = 0; n < 2; ++n) { const bf16x8 bb = cat8(tr16(Kt + r0 + (16 * (db0 + n) + 4 * p4) * 2), tr16(Kt + r0 + 512 + (16 * (db0 + n) + 4 * p4) * 2)); acc[n] = MFMA16(a, bb, acc[n]); } }
#pragma unroll
          for (int n = 0; n < 2; ++n) { acc[n] = acc[n] * g128;
              bf16* sp = ST + ((size_t)(bh * 32 + cc + 2) * 256 + (64 * ei + 16 * eb + 4 * g)) * 256 + 64 * di + 16 * (db0 + n) + li;
#pragma unroll
              for (int r = 0; r < 4; ++r) sp[(size_t)r * 256] = (bf16)f2bf(acc[n][r]); }
          if (cc + 2 <= 30) SCAN_WRITE(L + (cur ^ 1) * 32768, kB, vB);
          if (cc + 4 <= 30) SCAN_LOAD(cc + 4, kB, vB);
          LDS_BAR(); cur ^= 1; }
    }
#undef SCAN_LOAD
#undef SCAN_WRITE
}

__device__ __forceinline__ void retout_unit(LAS unsigned char* L, int u, bf16* QR, const bf16* RK, const bf16* RV, const bf16* RG, const bf16* ST, int tid, int lane, int wave) {
    asm volatile("" : "+v"(tid)); lane = tid & 63;
    const int bh = u >> 5, c = u & 31, b = bh >> 2, h = bh & 3;
    const int R0 = b * SEQ + c * 128;
    const int li = lane & 15, g = lane >> 4, q = li >> 2, p4 = li & 3;
    LAS unsigned char* RA = L; LAS unsigned char* RB = L + 65536;
#pragma unroll
    for (int i = 0; i < 8; ++i) { const int cid = tid + 512 * i, j = cid >> 5, ch = cid & 31;
        const v4u kz = *(const GAS v4u*)(RK + (size_t)(R0 + j) * 1024 + h * 256 + ch * 8), vz = *(const GAS v4u*)(RV + (size_t)(R0 + j) * 1024 + h * 256 + ch * 8);
        *(LAS v4u*)(RA + j * 512 + ((ch ^ (j & 15)) << 4)) = kz; *(LAS v4u*)(RB + j * 512 + ((ch ^ ((j & 7) << 1)) << 4)) = vz; }
    bf16x8 qf[8];
    { const GAS v4u* qp = (const GAS v4u*)(QR + (size_t)(R0 + 16 * wave + li) * 2048 + 1024 + h * 256 + 8 * g);
#pragma unroll
      for (int ks = 0; ks < 8; ++ks) qf[ks] = __builtin_bit_cast(bf16x8, qp[4 * ks]); }
    __syncthreads();
    f32x4 st[8];
#pragma unroll
    for (int jt = 0; jt < 8; ++jt) st[jt] = (f32x4){0.f, 0.f, 0.f, 0.f};
#pragma unroll
    for (int jt = 0; jt < 8; ++jt) if (jt <= wave) {
        const int j = 16 * jt + li;
#pragma unroll
        for (int ks = 0; ks < 8; ++ks) { const bf16x8 a = *(LAS const bf16x8*)(RA + j * 512 + (((4 * ks + g) ^ li) << 4)); st[jt] = MFMA16(a, qf[ks], st[jt]); }
        if (jt == wave) {
#pragma unroll
            for (int r = 0; r < 4; ++r) if (4 * g + r > li) st[jt][r] = 0.f; }
    }
    bf16x8 pf[4];
#pragma unroll
    for (int s = 0; s < 4; ++s) { v4u w; w.x = cvtpk_s(st[2 * s][0], st[2 * s][1]); w.y = cvtpk_s(st[2 * s][2], st[2 * s][3]); w.z = cvtpk_s(st[2 * s + 1][0], st[2 * s + 1][1]); w.w = cvtpk_s(st[2 * s + 1][2], st[2 * s + 1][3]); pf[s] = __builtin_bit_cast(bf16x8, w); }
    __syncthreads();
    const bf16* Sg = ST + (size_t)(bh * 32 + c) * 65536;
#define RO_STAGE_ST(dst, s0) do { _Pragma("unroll") for (int i_ = 0; i_ < 8; ++i_) { const int cid_ = tid + 512 * i_, sl_ = cid_ >> 11, e_ = (cid_ >> 3) & 255, ch_ = cid_ & 7; \
        const v4u z_ = *(const GAS v4u*)(Sg + (size_t)e_ * 256 + 64 * ((s0) + sl_) + ch_ * 8); *(LAS v4u*)((dst) + sl_ * 32768 + e_ * 128 + ((ch_ ^ (e_ & 7)) << 4)) = z_; } } while (0)
    RO_STAGE_ST(RA, 0);
    f32x4 o[16];
#pragma unroll
    for (int et = 0; et < 16; ++et) o[et] = (f32x4){0.f, 0.f, 0.f, 0.f};
#pragma unroll
    for (int s = 0; s < 4; ++s) if (2 * s <= wave) {
        const int r1 = 32 * s + 4 * g + q, r2 = r1 + 16;
#pragma unroll
        for (int et = 0; et < 16; ++et) {
            const int chn = 2 * et + (p4 >> 1);
            const bf16x8 a = cat8(tr16(RB + r1 * 512 + ((chn ^ ((r1 & 7) << 1)) << 4) + (p4 & 1) * 8), tr16(RB + r2 * 512 + ((chn ^ ((r2 & 7) << 1)) << 4) + (p4 & 1) * 8));
            o[et] = MFMA16(a, pf[s], o[et]);
        }
    }
    __syncthreads();
    RO_STAGE_ST(RB, 2);
#define RO_STATE_MMA(src, s0) do { _Pragma("unroll") for (int sl_ = 0; sl_ < 2; ++sl_) _Pragma("unroll") for (int k2_ = 0; k2_ < 2; ++k2_) _Pragma("unroll") for (int et = 0; et < 16; ++et) { \
        const int e_ = 16 * et + li; const bf16x8 a_ = *(LAS const bf16x8*)((src) + sl_ * 32768 + e_ * 128 + (((4 * k2_ + g) ^ (e_ & 7)) << 4)); \
        o[et] = MFMA16(a_, qf[2 * ((s0) + sl_) + k2_], o[et]); } } while (0)
    RO_STATE_MMA(RA, 0);
    __syncthreads();
    RO_STATE_MMA(RB, 2);
#undef RO_STAGE_ST
#undef RO_STATE_MMA
    float s1 = 0.f;
#pragma unroll
    for (int et = 0; et < 16; ++et) s1 += (o[et][0] + o[et][1]) + (o[et][2] + o[et][3]);
    s1 += __shfl_xor(s1, 16); s1 += __shfl_xor(s1, 32);
    const float mu = s1 * (1.0f / 256.0f); float s2 = 0.f;
#pragma unroll
    for (int et = 0; et < 16; ++et) { o[et] = o[et] - mu; s2 += (o[et][0] * o[et][0] + o[et][1] * o[et][1]) + (o[et][2] * o[et][2] + o[et][3] * o[et][3]); }
    s2 += __shfl_xor(s2, 16); s2 += __shfl_xor(s2, 32);
    const float rstd = 1.0f / sqrtf(s2 * (1.0f / 256.0f) + GN_EPS);
    const int row = R0 + 16 * wave + li;
    const GAS v2u* gp = (const GAS v2u*)(RG + (size_t)row * 1024 + h * 256 + 4 * g); GAS v2u* op = (GAS v2u*)(QR + (size_t)row * 2048 + 1024 + h * 256 + 4 * g);
#pragma unroll
    for (int et = 0; et < 16; ++et) { const v2u gz = gp[4 * et]; v2u w;
        w.x = cvtpk(o[et][0] * rstd * bflo(gz.x), o[et][1] * rstd * bfhi(gz.x)); w.y = cvtpk(o[et][2] * rstd * bflo(gz.y), o[et][3] * rstd * bfhi(gz.y)); op[4 * et] = w; }
    __syncthreads();
}

typedef float f32x16 __attribute__((ext_vector_type(16)));
#define MFMA32(a, b, c) __builtin_amdgcn_mfma_f32_32x32x16_bf16((a), (b), (c), 0, 0, 0)
__device__ __forceinline__ int crow32(int reg, int hh) { return (reg & 3) + 8 * (reg >> 2) + 4 * hh; }

__device__ __forceinline__ void attn_unit(LAS unsigned char* L, int u, bf16* QR, const bf16* KA, const bf16* VA, const float* sinks, int tid, int lane, int wave) {
    asm volatile("" : "+v"(tid)); lane = tid & 63;
    const int b = u >> 6, j = (u >> 1) & 31, g2 = u & 1, hq = 8 * g2 + wave;
    const int R0 = b * SEQ + 128 * j;
    LAS unsigned char* Kt = L; LAS unsigned char* Vt = L + 32768;
#pragma unroll
    for (int i = 0; i < 4; ++i) { const int cid = tid + 512 * i, kk = cid >> 3, ch = cid & 7;
        int srow; bool ok = true;
        if (kk >= 128) srow = R0 + kk - 128; else if (j > 0) srow = R0 - 128 + kk; else { ok = kk >= 112; srow = NTOK + (ok ? kk - 112 : 0); }
        const v4u kz = *(const GAS v4u*)(KA + (size_t)srow * 128 + g2 * 64 + ch * 8), vz = *(const GAS v4u*)(VA + (size_t)srow * 128 + g2 * 64 + ch * 8);
        *(LAS v4u*)(Kt + kk * 128 + ((ch ^ (kk & 7)) << 4)) = ok ? kz : (v4u){0u, 0u, 0u, 0u};
        *(LAS v4u*)(Vt + kk * 128 + (ch << 4)) = ok ? vz : (v4u){0u, 0u, 0u, 0u}; }
    __syncthreads();
    const int r = lane & 31, hh = lane >> 5, blk = (lane >> 4) & 1, q = (lane & 15) >> 2, p4 = lane & 3;
    const float sk = sinks[hq] * LOG2E;
#pragma unroll 1
    for (int t = 0; t < 4; ++t) {
        const int i0 = 32 * t;
        bf16x8 qf[4];
        { const GAS v4u* qp = (const GAS v4u*)(QR + (size_t)(R0 + i0 + r) * 2048 + hq * 64 + 8 * hh);
#pragma unroll
          for (int ks = 0; ks < 4; ++ks) qf[ks] = __builtin_bit_cast(bf16x8, qp[2 * ks]); }
        f32x16 s[5];
#pragma unroll
        for (int x = 0; x < 5; ++x) {
            const int krow_ = 32 * (t + x) + r;
            f32x16 acc;
#pragma unroll
            for (int e = 0; e < 16; ++e) acc[e] = 0.f;
#pragma unroll
            for (int ks = 0; ks < 4; ++ks) { const bf16x8 a = *(LAS const bf16x8*)(Kt + krow_ * 128 + (((2 * ks + hh) ^ (krow_ & 7)) << 4)); acc = MFMA32(a, qf[ks], acc); }
            s[x] = acc; __builtin_amdgcn_sched_barrier(0);
        }
        float m = sk;
#pragma unroll
        for (int e = 0; e < 16; ++e) { const int cr = crow32(e, hh);
            if (!(cr > r)) s[0][e] = -1.0e30f;
            if (!(cr <= r)) s[4][e] = -1.0e30f; }
        if (j == 0) {
#pragma unroll
            for (int x = 0; x < 4; ++x) if (t + x <= 3) {
#pragma unroll
                for (int e = 0; e < 16; ++e) if (32 * (t + x) + crow32(e, hh) < 112) s[x][e] = -1.0e30f; }
        }
#pragma unroll
        for (int x = 0; x < 5; ++x)
#pragma unroll
            for (int e = 0; e < 16; ++e) m = fmaxf(m, s[x][e]);
        m = fmaxf(m, __shfl_xor(m, 32));
        float l = 0.f;
#pragma unroll
        for (int x = 0; x < 5; ++x)
#pragma unroll
            for (int e = 0; e < 16; ++e) { const float pv = exp2f(s[x][e] - m); s[x][e] = pv; l += pv; }
        l += __shfl_xor(l, 32);
        l += exp2f(sk - m);
        f32x16 o[2];
#pragma unroll
        for (int e = 0; e < 16; ++e) { o[0][e] = 0.f; o[1][e] = 0.f; }
#pragma unroll
        for (int x = 0; x < 5; ++x)
#pragma unroll
            for (int st = 0; st < 2; ++st) {
                v4u w; w.x = cvtpk_s(s[x][8 * st + 0], s[x][8 * st + 1]); w.y = cvtpk_s(s[x][8 * st + 2], s[x][8 * st + 3]); w.z = cvtpk_s(s[x][8 * st + 4], s[x][8 * st + 5]); w.w = cvtpk_s(s[x][8 * st + 6], s[x][8 * st + 7]);
                const bf16x8 pb = __builtin_bit_cast(bf16x8, w);
                const int k1 = 32 * (t + x) + 16 * st + 4 * hh + q, k2 = k1 + 8;
#pragma unroll
                for (int dc = 0; dc < 2; ++dc) {
                    const int cb = ((4 * dc + 2 * blk + (p4 >> 1)) << 4) + 8 * (p4 & 1);
                    const bf16x8 a = cat8(tr16(Vt + k1 * 128 + cb), tr16(Vt + k2 * 128 + cb));
                    o[dc] = MFMA32(a, pb, o[dc]);
                }
                __builtin_amdgcn_sched_barrier(0);
            }
        const float il = 1.0f / l;
        GAS v2u* op = (GAS v2u*)(QR + (size_t)(R0 + i0 + r) * 2048 + hq * 64 + 4 * hh);
#pragma unroll
        for (int dc = 0; dc < 2; ++dc)
#pragma unroll
            for (int g4 = 0; g4 < 4; ++g4) { v2u w; w.x = cvtpk_s(o[dc][4 * g4 + 0] * il, o[dc][4 * g4 + 1] * il); w.y = cvtpk_s(o[dc][4 * g4 + 2] * il, o[dc][4 * g4 + 3] * il); op[8 * dc + 2 * g4] = w; }
    }
    __syncthreads();
}

__device__ __forceinline__ unsigned ord_key(float f) { const unsigned u = __float_as_uint(f); return u ^ ((unsigned)((int)u >> 31) | 0x80000000u); }
__device__ __forceinline__ float ord_val(unsigned k) { return __uint_as_float(k ^ (((int)k < 0) ? 0x80000000u : 0xffffffffu)); }
__device__ __forceinline__ unsigned umed3(unsigned a, unsigned b, unsigned c) { unsigned r; asm("v_med3_u32 %0, %1, %2, %3" : "=v"(r) : "v"(a), "v"(b), "v"(c)); return r; }
#define TK_INS(arr, val) do { const unsigned v_ = (val); _Pragma("unroll") for (int j_ = 15; j_ >= 1; --j_) arr[j_] = umed3(arr[j_ - 1], arr[j_], v_); arr[0] = arr[0] > v_ ? arr[0] : v_; } while (0)
__device__ __forceinline__ void topk_unit(LAS unsigned* Lw, LAS const unsigned char* Lsk, int tt, int hd, const bf16* Q3, unsigned short* IDS, float* GATES, int lane) {
    asm volatile("" : "+v"(lane));
    const int r = lane & 31, hh = lane >> 5, t0 = tt * 32;
    float sv[2][16];
#pragma unroll
    for (int p = 0; p < 2; ++p) {
        f32x16 acc[4];
#pragma unroll
        for (int nt = 0; nt < 4; ++nt)
#pragma unroll
            for (int e = 0; e < 16; ++e) acc[nt][e] = 0.f;
        const GAS v4u* qp = (const GAS v4u*)(Q3 + (size_t)(t0 + r) * DM + hd * 256 + p * 128 + 8 * hh);
        bf16x8 bq[8];
#pragma unroll
        for (int ks = 0; ks < 8; ++ks) bq[ks] = __builtin_bit_cast(bf16x8, qp[2 * ks]);
#pragma unroll
        for (int ks = 0; ks < 8; ++ks) {
#pragma unroll
            for (int nt = 0; nt < 4; ++nt) { const bf16x8 a = *(LAS const bf16x8*)(Lsk + p * 32768 + (32 * nt + r) * 256 + (((2 * ks + hh) ^ (r & 15)) << 4)); acc[nt] = MFMA32(a, bq[ks], acc[nt]); } }
        unsigned tk[16];
#pragma unroll
        for (int j2 = 0; j2 < 16; ++j2) tk[j2] = 0u;
#pragma unroll
        for (int nt = 0; nt < 4; ++nt)
#pragma unroll
            for (int e = 0; e < 16; ++e) { const int n = 32 * nt + crow32(e, hh); TK_INS(tk, (ord_key(acc[nt][e]) & 0xffffff80u) | (unsigned)(127 - n)); }
        unsigned pk[16];
#pragma unroll
        for (int j2 = 0; j2 < 16; ++j2) pk[j2] = (unsigned)__shfl_xor((int)tk[j2], 32);
#pragma unroll
        for (int j2 = 0; j2 < 16; ++j2) TK_INS(tk, pk[j2]);
#pragma unroll
        for (int j2 = 0; j2 < 16; ++j2) { sv[p][j2] = ord_val(tk[j2] & 0xffffff80u); Lw[(p * 16 + j2) * 64 + lane] = 127u - (tk[j2] & 0x7fu); }
    }
    unsigned fk[16];
#pragma unroll
    for (int j2 = 0; j2 < 16; ++j2) fk[j2] = 0u;
#pragma unroll
    for (int i = 0; i < 16; ++i)
#pragma unroll
        for (int j2 = 0; j2 < 16; ++j2) if ((i + 1) * (j2 + 1) <= 16) TK_INS(fk, (ord_key(sv[0][i] + sv[1][j2]) & 0xffffff00u) | (unsigned)(255 - (16 * i + j2)));
    float ev[16]; int idv[16]; float den = 0.f; const float f0 = ord_val(fk[0] & 0xffffff00u);
    LDS_WAIT();
#pragma unroll
    for (int k = 0; k < 16; ++k) { const unsigned idx = 255u - (fk[k] & 0xffu); const unsigned i1 = Lw[(idx >> 4) * 64 + lane], i2 = Lw[(16 + (idx & 15u)) * 64 + lane];
        idv[k] = (int)(i1 * 128u + i2); ev[k] = __expf(ord_val(fk[k] & 0xffffff00u) - f0); den += ev[k]; }
    const float iden = 1.0f / den;
    if (hh == 0) {
        GAS v4u* ip = (GAS v4u*)(IDS + (size_t)(t0 + r) * 128 + hd * 16); GAS f32x4* gp = (GAS f32x4*)(GATES + (size_t)(t0 + r) * 128 + hd * 16);
#pragma unroll
        for (int k8 = 0; k8 < 2; ++k8) ip[k8] = (v4u){(unsigned)idv[8 * k8] | ((unsigned)idv[8 * k8 + 1] << 16), (unsigned)idv[8 * k8 + 2] | ((unsigned)idv[8 * k8 + 3] << 16), (unsigned)idv[8 * k8 + 4] | ((unsigned)idv[8 * k8 + 5] << 16), (unsigned)idv[8 * k8 + 6] | ((unsigned)idv[8 * k8 + 7] << 16)};
#pragma unroll
        for (int k4 = 0; k4 < 4; ++k4) gp[k4] = (f32x4){ev[4 * k4] * iden, ev[4 * k4 + 1] * iden, ev[4 * k4 + 2] * iden, ev[4 * k4 + 3] * iden};
    }
    LDS_WAIT();
}

__global__ void __launch_bounds__(NWAVES * 64, 2) mk_fwd(Args args) {
    extern __shared__ __attribute__((aligned(16))) unsigned char lds[];
    LAS unsigned char* L = (LAS unsigned char*)lds;
    volatile LAS unsigned* MISC = (volatile LAS unsigned*)(L + MISC_OFF);
    const int tid = threadIdx.x, lane = tid & 63, wave = __builtin_amdgcn_readfirstlane(tid >> 6);
    const int G = gridDim.x, bx = blockIdx.x;
    const int vcu = (G % 8 == 0) ? (bx % 8) * (G / 8) + bx / 8 : bx;
    unsigned char* ws = args.ws;
    gu32* ctl = (gu32*)(ws + WS_CTL);
    const float* x = args.in[0]; const float* meta = args.in[1]; const float* ln_in_g = args.in[2]; const float* ln_in_b = args.in[3];
    const float* w_in = args.in[4]; const float* sinks = args.in[5]; const float* w_out = args.in[6]; const float* ln_mix_g = args.in[7]; const float* ln_mix_b = args.in[8];
    const float* wq = args.in[9]; const float* subkeys = args.in[10]; const float* u_tab = args.in[11]; const float* v_tab = args.in[12];
    const float* ln_ffn_g = args.in[13]; const float* ln_ffn_b = args.in[14];
    float* out = args.out;
    bf16* W1T = (bf16*)(ws + WS_W1T); bf16* W2T = (bf16*)(ws + WS_W2T); bf16* W3T = (bf16*)(ws + WS_W3T);
    bf16* H0 = (bf16*)(ws + WS_H0); bf16* QR = (bf16*)(ws + WS_QR); bf16* KA = (bf16*)(ws + WS_KA); bf16* VA = (bf16*)(ws + WS_VA);
    bf16* RK = (bf16*)(ws + WS_RK); bf16* RV = (bf16*)(ws + WS_RV); bf16* RG = (bf16*)(ws + WS_RG);
    bf16* Y = (bf16*)(ws + WS_Y); bf16* H1 = (bf16*)(ws + WS_H1); bf16* Q3 = (bf16*)(ws + WS_QR);
    bf16* STB = (bf16*)(ws + WS_ST);
    unsigned short* IDS = (unsigned short*)(ws + WS_IDS); float* GATES = (float*)(ws + WS_GATES);
    bf16* SKB = (bf16*)(ws + WS_SK);
    bf16* UT = (bf16*)(ws + WS_UT); bf16* VT = (bf16*)(ws + WS_VT);

    for (int u = tid; u < (LDS_BYTES - LDSCTL_OFF) / 4; u += NWAVES * 64) ((LAS unsigned*)(L + LDSCTL_OFF))[u] = 0u;
    __syncthreads();
    XcdBarrier bar; bar.bar = (unsigned*)(ctl + CW_BAR); bar.x = xb_xcc_id(); bar.st = MISC + 8;
    if (tid == 0) MISC[10] = xb_add(&bar.bar[XB_XCNT(bar.x)], 1u);
#define GRID_BAR() xcd_barrier(bar)
    const int gw = vcu * NWAVES + wave, NGW = G * NWAVES;
    const int gt = gw * 64 + lane, NGT = NGW * 64;

    {
        int lane = threadIdx.x; asm volatile("" : "+v"(lane)); lane &= 63; const int gt = gw * 64 + lane;
        LAS float* scr = (LAS float*)(L + RING_OFF + wave * 16384);
        constexpr int I_1 = (DM / 64) * (IN_COLS / 32), I_2 = (DM / 64) * (DM / 32), I_3 = I_2;
        for (int it = gw; it < I_1 + I_2 + I_3; it += NGW) {
            int r = it;
            if (r < I_1) { p0_transpose_item<true>(w_in, DM, IN_COLS, W1T, scr, r, lane); continue; } r -= I_1;
            if (r < I_2) { p0_transpose_item<false>(w_out, DM, DM, W2T, scr, r, lane); continue; } r -= I_2;
            p0_transpose_item<false>(wq, DM, DM, W3T, scr, r, lane);
        }
        for (int m = gw; m < MROWS; m += NGW) {
            if (m < NTOK) ln_row_f32_to_bf16(x + (size_t)m * DM, ln_in_g, ln_in_b, H0 + (size_t)m * DM, lane);
            else if (m < NVALID) ln_row_f32_to_bf16(meta + (size_t)(m - NTOK) * DM, ln_in_g, ln_in_b, H0 + (size_t)m * DM, lane);
            else { GAS v4u* o = (GAS v4u*)(H0 + (size_t)m * DM) + lane;
#pragma unroll
                for (int j = 0; j < 4; ++j) o[64 * j] = (v4u){0u, 0u, 0u, 0u}; }
        }
        for (int e = gt; e < 16 * 128 * 128 / 8; e += NGT) { const GAS f32x4* src = (const GAS f32x4*)subkeys + 2 * (size_t)e; const f32x4 a = src[0], b2 = src[1];
            v4u o; o.x = pk2(a.x, a.y); o.y = pk2(a.z, a.w); o.z = pk2(b2.x, b2.y); o.w = pk2(b2.z, b2.w); ((GAS v4u*)SKB)[e] = o; }
    }
    GRID_BAR();

    {
        pg8::Gemm g{H0, W1T, MROWS, IN_COLS, DM}; pg8::StaticOrder S; S.init(MROWS, IN_COLS, G, bx);
        pg8::EpiProj E{QR, KA, VA, RK, RV, RG, QSCALE};
        pg8::gemm_phase<pg8::EpiProj, pg8::StaticOrder, true, true>(L + RING_OFF, g, S, E);
    }
    {
        constexpr int NQ = 16384 * DM / 4, CHQ = 16384, NCH = 2 * NQ / CHQ;
        for (;;) {
            int ch = 0; if (lane == 0) ch = (int)__hip_atomic_fetch_add((unsigned*)(ctl + CW_TABQ), 1u, __ATOMIC_RELAXED, __HIP_MEMORY_SCOPE_AGENT);
            ch = __builtin_amdgcn_readfirstlane(ch); if (ch >= NCH) break;
            const int which = ch >= NCH / 2; const float sc = which ? V_SCALE : U_SCALE;
            const GAS f32x4* src = (const GAS f32x4*)(which ? v_tab : u_tab) + (size_t)(ch - which * (NCH / 2)) * CHQ + lane;
            GAS unsigned char* dstb = (GAS unsigned char*)(which ? (void*)VT : (void*)UT);
            const int i4b = (ch - which * (NCH / 2)) * CHQ + lane;
#pragma unroll 1
            for (int it = 0; it < CHQ / 64; it += 8) {
                f32x4 a[8];
#pragma unroll
                for (int u8 = 0; u8 < 8; ++u8) a[u8] = src[(it + u8) * 64];
#pragma unroll
                for (int u8 = 0; u8 < 8; ++u8) { const int i4 = i4b + (it + u8) * 64; const int row = i4 >> 9, q4 = i4 & 511;
                    int w = __builtin_amdgcn_cvt_pk_fp8_f32(a[u8].x * sc, a[u8].y * sc, 0, false); w = __builtin_amdgcn_cvt_pk_fp8_f32(a[u8].z * sc, a[u8].w * sc, w, true);
                    *(GAS unsigned*)(dstb + ((size_t)(q4 >> 5) * 16384 + row) * 128 + (q4 & 31) * 4) = (unsigned)w; }
            }
        }
    }
    GRID_BAR();

    for (int u = bx; u < 256; u += G) attn_unit(L + RING_OFF, u, QR, KA, VA, sinks, tid, lane, wave);

    for (int u = bx; u < 256; u += G) scan_unit(L + RING_OFF, u, RK, RV, STB, tid, lane, wave);
    GRID_BAR();

    for (int u = bx; u < 512; u += G) retout_unit(L + RING_OFF, u, QR, RK, RV, RG, STB, tid, lane, wave);
    GRID_BAR();

    {
        pg8::Gemm g{QR, W2T, NTOK, DM, DM}; pg8::StaticOrder S; S.init(NTOK, DM, G, bx);
        pg8::EpiGen<1> E{Y, DM, H0, ALPHA, nullptr, nullptr, nullptr, nullptr, nullptr, nullptr};
        pg8::gemm_phase<pg8::EpiGen<1>, pg8::StaticOrder, true, true>(L + RING_OFF, g, S, E);
    }
    GRID_BAR();

    for (int m = gw; m < NTOK; m += NGW) ln_row_bf16_to_bf16(Y + (size_t)m * DM, ln_mix_g, ln_mix_b, H1 + (size_t)m * DM, lane);
    GRID_BAR();

    {
        pg8::Gemm g{H1, W3T, NTOK, DM, DM}; pg8::StaticOrder S; S.init(NTOK, DM, G, bx);
        pg8::EpiGen<2> E{Q3, DM, nullptr, 0.f, nullptr, nullptr, nullptr, nullptr, nullptr, nullptr};
        pg8::gemm_phase<pg8::EpiGen<2>, pg8::StaticOrder, true, true>(L + RING_OFF, g, S, E);
    }
    GRID_BAR();

    const bool g8 = (G & 7) == 0; const int nbh = g8 ? (G >> 3) : G, hb = g8 ? (bx >> 3) : bx;
    for (int hd = g8 ? (bx & 7) : 0; hd < 8; hd += g8 ? 8 : 1) {
        __syncthreads();
#pragma unroll
        for (int i = 0; i < 8; ++i) { const int cid = tid + 512 * i, p = cid >> 11, n = (cid >> 4) & 127, ch = cid & 15;
            *(LAS v4u*)(L + RING_OFF + p * 32768 + n * 256 + ((ch ^ (n & 15)) << 4)) = *(const GAS v4u*)(SKB + ((size_t)((hd * 2 + p) * 128 + n)) * 128 + ch * 8); }
        __syncthreads();
        for (int tt = hb * NWAVES + wave; tt < NTOK / 32; tt += nbh * NWAVES) topk_unit((LAS unsigned*)(L + RING_OFF + 65536 + wave * 8192), L + RING_OFF, tt, hd, Q3, IDS, GATES, lane);
    }
    __syncthreads();
    GRID_BAR();

    int nx = 0, xr = 0, nloc = 1;
    { unsigned* bw = (unsigned*)(ctl + CW_BAR);
#pragma unroll
      for (unsigned j2 = 0; j2 < 16; ++j2) { const unsigned cnt = xb_ld(&bw[XB_XCNT(j2)]); nx += cnt > 0u; xr += (j2 < bar.x && cnt > 0u); if (j2 == bar.x) nloc = (int)cnt; }
      nx = __builtin_amdgcn_readfirstlane(nx); xr = __builtin_amdgcn_readfirstlane(xr); nloc = __builtin_amdgcn_readfirstlane(nloc); if (nx < 1) nx = 1; if (nloc < 1) nloc = 1; }
    const int lrank = __builtin_amdgcn_readfirstlane((int)MISC[10]);
    const int wv = lrank * NWAVES + wave, nwv = nloc * NWAVES;
    float* DOTX = (float*)(ws + WS_RK);
    bf16* CB = (bf16*)(ws + WS_KA);
    bf16* YB = (bf16*)(ws + WS_H0);
    {
        int tl = tid; asm volatile("" : "+v"(tl)); const int ln = tl & 63, k = ln >> 3, c8 = ln & 7;
        const unsigned char* UT8 = (const unsigned char*)UT;
        for (int s = xr; s < NSL; s += nx) {
            const unsigned char* Us = UT8 + (size_t)s * 16384 * 128;
            const bool first = (s == xr);
            v4u nid[2][2];
#pragma unroll
            for (int z = 0; z < 2; ++z) { const int tz = wv + z * nwv; const int tc = tz < NTOK ? tz : wv; const GAS v4u* ip = (const GAS v4u*)(IDS + (size_t)tc * 128 + 16 * k);
#pragma unroll
                for (int i = 0; i < 2; ++i) nid[z][i] = ip[i]; }
#pragma unroll 1
            for (int t = wv; t < NTOK; t += 2 * nwv) {
                const bool vB = (t + nwv) < NTOK; const int tt[2] = {t, vB ? t + nwv : t};
                v4u ub[2][16]; v4u hs[2][2]; f32x2 old[2];
#pragma unroll
                for (int z = 0; z < 2; ++z) {
#pragma unroll
                    for (int i = 0; i < 16; ++i) { const int pe = 2 * (i & 7) + (i >> 3); const unsigned eid = (nid[z][pe >> 3][(pe >> 1) & 3] >> (16 * (pe & 1))) & 0xffffu; ub[z][i] = *(const GAS v4u*)(Us + (size_t)eid * 128 + 16 * c8); }
                    { const GAS v4u* hp = (const GAS v4u*)(H1 + (size_t)tt[z] * DM + 128 * s + 16 * c8); hs[z][0] = hp[0]; hs[z][1] = hp[1]; } }
#pragma unroll
                for (int z = 0; z < 2; ++z) old[z] = first ? (f32x2){0.f, 0.f} : *(const GAS f32x2*)(DOTX + ((size_t)xr * NTOK + tt[z]) * 128 + 2 * ln);
#pragma unroll
                for (int z = 0; z < 2; ++z) { const int tz = t + (2 + z) * nwv; const int tc = tz < NTOK ? tz : t; const GAS v4u* ip = (const GAS v4u*)(IDS + (size_t)tc * 128 + 16 * k);
#pragma unroll
                    for (int i = 0; i < 2; ++i) nid[z][i] = ip[i]; }
#pragma unroll
                for (int z = 0; z < 2; ++z) {
                    float p[16]; f32x2 hp2[8];
#pragma unroll
                    for (int i = 0; i < 2; ++i)
#pragma unroll
                        for (int c4 = 0; c4 < 4; ++c4) hp2[4 * i + c4] = (f32x2){bflo(hs[z][i][c4]), bfhi(hs[z][i][c4])};
#pragma unroll
                    for (int i = 0; i < 16; ++i) { f32x2 d2 = {0.f, 0.f};
#pragma unroll
                        for (int dw = 0; dw < 4; ++dw) { const f32x2 fl = __builtin_amdgcn_cvt_pk_f32_fp8((int)ub[z][i][dw], false), fh = __builtin_amdgcn_cvt_pk_f32_fp8((int)ub[z][i][dw], true);
                            d2 = __builtin_elementwise_fma(fl, hp2[2 * dw], d2); d2 = __builtin_elementwise_fma(fh, hp2[2 * dw + 1], d2); }
                        p[i] = d2.x + d2.y; }
                    const bool b0 = (c8 & 1) != 0, b1 = (c8 & 2) != 0, b2 = (c8 & 4) != 0;
                    float r1[8], r2[4], q0, q1;
#pragma unroll
                    for (int m = 0; m < 8; ++m) { const float keep = b0 ? p[2 * m + 1] : p[2 * m], give = b0 ? p[2 * m] : p[2 * m + 1]; r1[m] = keep + DPPF(give, 0xB1); }
#pragma unroll
                    for (int m = 0; m < 4; ++m) { const float keep = b1 ? r1[2 * m + 1] : r1[2 * m], give = b1 ? r1[2 * m] : r1[2 * m + 1]; r2[m] = keep + DPPF(give, 0x4E); }
                    { const float keep = b2 ? r2[1] : r2[0], give = b2 ? r2[0] : r2[1]; const float gl = DPPF(give, 0x104), gr = DPPF(give, 0x114); q0 = keep + (b2 ? gr : gl); }
                    { const float keep = b2 ? r2[3] : r2[2], give = b2 ? r2[2] : r2[3]; const float gl = DPPF(give, 0x104), gr = DPPF(give, 0x114); q1 = keep + (b2 ? gr : gl); }
                    if (z == 0 || vB) *(GAS f32x2*)(DOTX + ((size_t)xr * NTOK + tt[z]) * 128 + 2 * ln) = (f32x2){q0 + old[z].x, q1 + old[z].y};
                }
            }
        }
    }
    GRID_BAR();
    for (int idx = gt; idx < NTOK * 128; idx += NGT) { float d = 0.f; for (int xx = 0; xx < nx; ++xx) d += DOTX[(size_t)xx * NTOK * 128 + idx]; CB[idx] = (bf16)f2bf((1.0f / V_SCALE) * GATES[idx] * gelu_erf(d * (1.0f / U_SCALE))); }
    GRID_BAR();
    {
        int tl = tid; asm volatile("" : "+v"(tl)); const int ln = tl & 63, k = ln >> 3, c8 = ln & 7;
        const unsigned char* VT8 = (const unsigned char*)VT;
        for (int s = xr; s < NSL; s += nx) {
            const unsigned char* Vs = VT8 + (size_t)s * 16384 * 128;
            v4u nid[2][2];
#pragma unroll
            for (int z = 0; z < 2; ++z) { const int tz = wv + z * nwv; const int tc = tz < NTOK ? tz : wv; const GAS v4u* ip = (const GAS v4u*)(IDS + (size_t)tc * 128 + 16 * k);
#pragma unroll
                for (int i = 0; i < 2; ++i) nid[z][i] = ip[i]; }
#pragma unroll 1
            for (int t = wv; t < NTOK; t += 2 * nwv) {
                const bool vB = (t + nwv) < NTOK; const int tt[2] = {t, vB ? t + nwv : t};
                v4u vb[2][16]; v4u cf[2][2]; unsigned hs[2];
#pragma unroll
                for (int z = 0; z < 2; ++z) {
#pragma unroll
                    for (int i = 0; i < 16; ++i) { const unsigned eid = (nid[z][i >> 3][(i >> 1) & 3] >> (16 * (i & 1))) & 0xffffu; vb[z][i] = *(const GAS v4u*)(Vs + (size_t)eid * 128 + 16 * c8); } }
#pragma unroll
                for (int z = 0; z < 2; ++z) { hs[z] = *(const GAS unsigned*)(H1 + (size_t)tt[z] * DM + 128 * s + 16 * c8 + 2 * k);
                    const GAS v4u* cp = (const GAS v4u*)(CB + (size_t)tt[z] * 128 + 16 * k); cf[z][0] = cp[0]; cf[z][1] = cp[1]; }
#pragma unroll
                for (int z = 0; z < 2; ++z) { const int tz = t + (2 + z) * nwv; const int tc = tz < NTOK ? tz : t; const GAS v4u* ip = (const GAS v4u*)(IDS + (size_t)tc * 128 + 16 * k);
#pragma unroll
                    for (int i = 0; i < 2; ++i) nid[z][i] = ip[i]; }
#pragma unroll
                for (int z = 0; z < 2; ++z) {
                    f32x2 accp[8];
#pragma unroll
                    for (int q2 = 0; q2 < 8; ++q2) accp[q2] = (f32x2){0.f, 0.f};
#pragma unroll
                    for (int i = 0; i < 16; ++i) { const unsigned cw = cf[z][i >> 3][(i >> 1) & 3]; const float c = (i & 1) ? bfhi(cw) : bflo(cw); const f32x2 c2 = {c, c};
#pragma unroll
                        for (int dw = 0; dw < 4; ++dw) { const f32x2 fl = __builtin_amdgcn_cvt_pk_f32_fp8((int)vb[z][i][dw], false), fh = __builtin_amdgcn_cvt_pk_f32_fp8((int)vb[z][i][dw], true);
                            accp[2 * dw] = __builtin_elementwise_fma(fl, c2, accp[2 * dw]); accp[2 * dw + 1] = __builtin_elementwise_fma(fh, c2, accp[2 * dw + 1]); } }
                    const bool kb0 = (k & 1) != 0, kb1 = (k & 2) != 0, kb2 = (k & 4) != 0;
                    f32x2 rA[4], rB[2], rC;
#pragma unroll
                    for (int m = 0; m < 4; ++m) { const f32x2 keep = kb0 ? accp[2 * m + 1] : accp[2 * m], give = kb0 ? accp[2 * m] : accp[2 * m + 1];
                        rA[m] = keep + (f32x2){DPPF(give.x, 0x128), DPPF(give.y, 0x128)}; }
#pragma unroll
                    for (int m = 0; m < 2; ++m) { const f32x2 keep = kb1 ? rA[2 * m + 1] : rA[2 * m], give = kb1 ? rA[2 * m] : rA[2 * m + 1];
                        const auto sx = __builtin_amdgcn_permlane16_swap(__float_as_uint(give.x), __float_as_uint(give.x), false, false), sy = __builtin_amdgcn_permlane16_swap(__float_as_uint(give.y), __float_as_uint(give.y), false, false);
                        rB[m] = keep + (f32x2){__uint_as_float(kb1 ? sx[0] : sx[1]), __uint_as_float(kb1 ? sy[0] : sy[1])}; }
                    { const f32x2 keep = kb2 ? rB[1] : rB[0], give = kb2 ? rB[0] : rB[1];
                        const auto sx = __builtin_amdgcn_permlane32_swap(__float_as_uint(give.x), __float_as_uint(give.x), false, false), sy = __builtin_amdgcn_permlane32_swap(__float_as_uint(give.y), __float_as_uint(give.y), false, false);
                        rC = keep + (f32x2){__uint_as_float(kb2 ? sx[0] : sx[1]), __uint_as_float(kb2 ? sy[0] : sy[1])}; }
                    if (z == 0 || vB) *(GAS unsigned*)(YB + (size_t)tt[z] * DM + 128 * s + 16 * c8 + 2 * k) = cvtpk_s(rC.x + ALPHA * bflo(hs[z]), rC.y + ALPHA * bfhi(hs[z]));
                }
            }
        }
    }
    GRID_BAR();
    for (int m = gw; m < NTOK; m += NGW) {
        const GAS v4u* xr4 = (const GAS v4u*)(YB + (size_t)m * DM) + lane;
        float v[32]; float sm = 0.f;
#pragma unroll
        for (int j2 = 0; j2 < 4; ++j2) { const v4u w = xr4[64 * j2];
            v[8 * j2 + 0] = bflo(w.x); v[8 * j2 + 1] = bfhi(w.x); v[8 * j2 + 2] = bflo(w.y); v[8 * j2 + 3] = bfhi(w.y); v[8 * j2 + 4] = bflo(w.z); v[8 * j2 + 5] = bfhi(w.z); v[8 * j2 + 6] = bflo(w.w); v[8 * j2 + 7] = bfhi(w.w); }
#pragma unroll
        for (int i = 0; i < 32; ++i) sm += v[i];
        const float mean = wave_sum(sm) * (1.f / DM); float s2 = 0.f;
#pragma unroll
        for (int i = 0; i < 32; ++i) { v[i] -= mean; s2 += v[i] * v[i]; }
        const float rstd = 1.f / sqrtf(wave_sum(s2) * (1.f / DM) + LN_EPS);
#pragma unroll
        for (int j2 = 0; j2 < 4; ++j2) {
            const GAS f32x4* gp = (const GAS f32x4*)ln_ffn_g + 2 * (lane + 64 * j2); const GAS f32x4* bp = (const GAS f32x4*)ln_ffn_b + 2 * (lane + 64 * j2);
            const f32x4 g0 = gp[0], g1 = gp[1], b0 = bp[0], b1 = bp[1];
            GAS f32x4* op = (GAS f32x4*)(out + (size_t)m * DM) + 2 * (lane + 64 * j2);
            op[0] = (f32x4){v[8 * j2 + 0] * rstd * g0.x + b0.x, v[8 * j2 + 1] * rstd * g0.y + b0.y, v[8 * j2 + 2] * rstd * g0.z + b0.z, v[8 * j2 + 3] * rstd * g0.w + b0.w};
            op[1] = (f32x4){v[8 * j2 + 4] * rstd * g1.x + b1.x, v[8 * j2 + 5] * rstd * g1.y + b1.y, v[8 * j2 + 6] * rstd * g1.z + b1.z, v[8 * j2 + 7] * rstd * g1.w + b1.w}; }
    }
}

extern "C" void kernel_launch(void* const* d_in, const int* in_sizes, int n_in, void* d_out, int out_size, void* d_ws, size_t ws_size, hipStream_t stream) {
    static int grid = 0;
    if (grid == 0) {
        if (n_in != 15 || out_size != NTOK * DM || ws_size < WS_END) { fprintf(stderr, "kernel_launch: unexpected shapes (n_in %d out %d ws %zu)\n", n_in, out_size, ws_size); grid = -1; return; }
        int dev = 0, cus = 0, per_cu = 0;
        if (hipGetDevice(&dev) != hipSuccess || hipDeviceGetAttribute(&cus, hipDeviceAttributeMultiprocessorCount, dev) != hipSuccess) { grid = -1; return; }
        if (hipFuncSetAttribute((const void*)mk_fwd, hipFuncAttributeMaxDynamicSharedMemorySize, LDS_BYTES) != hipSuccess) { fprintf(stderr, "kernel_launch: hipFuncSetAttribute failed\n"); grid = -1; return; }
        if (hipOccupancyMaxActiveBlocksPerMultiprocessor(&per_cu, (const void*)mk_fwd, NWAVES * 64, LDS_BYTES) != hipSuccess || per_cu < 1) { fprintf(stderr, "kernel_launch: occupancy query says %d\n", per_cu); }
        (void)hipGetLastError();
        grid = cus;
    }
    if (grid < 0) return;
    if (hipMemsetAsync((char*)d_ws + WS_CTL, 0, CTL_ZERO_BYTES, stream) != hipSuccess) return;
    Args a{};
    for (int i = 0; i < 15; ++i) a.in[i] = (const float*)d_in[i];
    a.out = (float*)d_out; a.ws = (unsigned char*)d_ws;
    hipLaunchKernelGGL(mk_fwd, dim3(grid), dim3(NWAVES * 64), LDS_BYTES, stream, a);
}
```

```cpp
#include <hip/hip_runtime.h>
#include <cstdio>
#include <cstdint>
#include <cmath>
namespace pg8 {
#define PG8_LAS __attribute__((address_space(3)))
typedef unsigned short bf16_t;
typedef short bf16x8 __attribute__((ext_vector_type(8)));
typedef float f32x4 __attribute__((ext_vector_type(4)));
typedef unsigned u32x4 __attribute__((ext_vector_type(4)));
constexpr int BM = 256, BK = 64, HALF = 128, HTB = HALF * BK * 2  , STAGE_BYTES = 8 * HTB, NXCD = 8, WGM = 8;

__host__ __device__ __forceinline__ int lds_byte(int r, int c) { const int st = (r >> 4) * 2 + (c >> 5), rr = r & 15, cc = c & 31, ob = rr * 64 + cc * 2; return st * 1024 + (ob ^ (((ob >> 9) & 1) << 5)); }
__host__ __device__ __forceinline__ void stage_rc(int b, int& R, int& C) { const int st = b / 1024, sb = b % 1024, swz = sb ^ (((sb >> 9) & 1) << 5); R = (st >> 1) * 16 + swz / 64; C = (st & 1) * 32 + (swz % 64) / 2; }
__host__ __device__ __forceinline__ int perm32(int rho) { const int n = rho >> 4, i = rho & 15; return 8 * (i >> 2) + 4 * n + (i & 3); }

struct Unit { int pm, pn; };
struct Gemm { const bf16_t* A; const bf16_t* Bt; int M, N, K; };

struct StaticOrder {
    int nM, nN, nwg, G, c;
    __host__ __device__ void init(int M, int N, int G_, int c_) { nM = M / BM; nN = N / BM; nwg = nM * nN; G = G_; c = c_; }
    __host__ __device__ bool next(int i, Unit& u) const {
        const long L = (long)i * G + c; if (L >= nwg) return false;
        int wgid = (int)L; { const int q = nwg / NXCD, r = nwg % NXCD, xcd = wgid % NXCD, off = wgid / NXCD; wgid = (xcd < r ? xcd * (q + 1) : r * (q + 1) + (xcd - r) * q) + off; }
        const int nig = WGM * nN, gid = wgid / nig, fm = gid * WGM, gsz = (nM - fm) < WGM ? (nM - fm) : WGM;
        u.pm = fm + ((wgid % nig) % gsz); u.pn = (wgid % nig) / gsz; return true;
    }
    __device__ __forceinline__ void a_ready(const Unit&) const {}
    __device__ __forceinline__ void done(const Unit&) const {}
};

__device__ __forceinline__ unsigned cvt_pk_bf16(float lo, float hi) { unsigned r; asm volatile("v_cvt_pk_bf16_f32 %0, %1, %2" : "=v"(r) : "v"(lo), "v"(hi)); return r; }
typedef float f32x2 __attribute__((ext_vector_type(2)));

template <int MODE> struct EpiGen {
    static constexpr bool PERM = true, AFTER_DRAIN = false;
    bf16_t* O; int ldc; const bf16_t* R; float alpha;
    bf16_t *QR, *KA, *VA, *RK, *RV, *RG;
    __device__ __forceinline__ void operator()(const f32x4 (&acc)[2][2][4][2], const Unit& u, int wr, int wc, int fr, int fq) const {
        const int row0 = u.pm * BM + wr * 64 + fr;
#pragma unroll
        for (int bj = 0; bj < 2; ++bj) {
            const int col = u.pn * BM + bj * HALF + wc * 32 + 8 * fq;
            bf16_t* base = O; int ld = ldc; int cc = col;
            if (MODE == 0) {
                if (col < 1024)      { base = QR; ld = 2048; cc = col; }
                else if (col < 1152) { base = KA; ld = 128;  cc = col - 1024; }
                else if (col < 1280) { base = VA; ld = 128;  cc = col - 1152; }
                else if (col < 2304) { base = QR; ld = 2048; cc = col - 1280 + 1024; }
                else if (col < 3328) { base = RK; ld = 1024; cc = col - 2304; }
                else if (col < 4352) { base = RV; ld = 1024; cc = col - 3328; }
                else                 { base = RG; ld = 1024; cc = col - 4352; }
            }
#pragma unroll
            for (int ai = 0; ai < 2; ++ai)
#pragma unroll
                for (int m = 0; m < 4; ++m) {
                    const int row = row0 + ai * HALF + m * 16;
                    f32x4 v0 = acc[ai][bj][m][0], v1 = acc[ai][bj][m][1];
                    if (MODE == 1) {
                        const u32x4 r = *(const u32x4*)(R + (size_t)row * ldc + col);
                        v0[0] += alpha * __uint_as_float(r.x << 16); v0[1] += alpha * __uint_as_float(r.x & 0xffff0000u);
                        v0[2] += alpha * __uint_as_float(r.y << 16); v0[3] += alpha * __uint_as_float(r.y & 0xffff0000u);
                        v1[0] += alpha * __uint_as_float(r.z << 16); v1[1] += alpha * __uint_as_float(r.z & 0xffff0000u);
                        v1[2] += alpha * __uint_as_float(r.w << 16); v1[3] += alpha * __uint_as_float(r.w & 0xffff0000u);
                    }
                    u32x4 w; w.x = cvt_pk_bf16(v0[0], v0[1]); w.y = cvt_pk_bf16(v0[2], v0[3]); w.z = cvt_pk_bf16(v1[0], v1[1]); w.w = cvt_pk_bf16(v1[2], v1[3]);
                    *(u32x4*)(base + (size_t)row * ld + cc) = w;
                }
        }
    }
};

struct EpiProj {
    static constexpr bool PERM = true, AFTER_DRAIN = false;
    bf16_t *QR, *KA, *VA, *RK, *RV, *RG; float qscale;
    __device__ __forceinline__ void operator()(const f32x4 (&acc)[2][2][4][2], const Unit& u, int wr, int wc, int fr, int fq) const {
        const int pn = u.pn, row0 = u.pm * BM + wr * 64 + fr, c0 = wc * 32 + 8 * fq;
        const bool rope = (pn <= 3) || (pn == 4 && wc < 2) || (pn >= 5 && pn <= 12);
        if (rope) {
            const bool ret = pn >= 5; const int h = ret ? ((pn - 5) & 3) : 0;
            const float lg = __builtin_amdgcn_logf(1.0f - __builtin_amdgcn_exp2f(-5.0f - (float)h));
            float invrev[8];
#pragma unroll
            for (int i8 = 0; i8 < 8; ++i8) { const float ii = (float)((ret ? c0 : 8 * fq) + i8); invrev[i8] = 0.15915494309189535f * __builtin_amdgcn_exp2f(-ii * (ret ? 0.10381025296523008f : 0.4152410118609203f)); }
            bf16_t* base; int ld, cA, cB;
            if (pn <= 3)      { base = QR; ld = 2048; cA = pn * 256 + 64 * wc + 8 * fq; cB = cA + 32; }
            else if (pn == 4) { base = KA; ld = 128;  cA = 64 * wc + 8 * fq; cB = cA + 32; }
            else if (pn <= 8) { base = QR; ld = 2048; cA = 1024 + 256 * h + c0; cB = cA + 128; }
            else              { base = RK; ld = 1024; cA = 256 * h + c0; cB = cA + 128; }
#pragma unroll
            for (int ai = 0; ai < 2; ++ai)
#pragma unroll
                for (int m = 0; m < 4; ++m) {
                    const int row = row0 + ai * HALF + m * 16;
                    int pos, ipos;
                    if (row < 16384) { const int s = row & 4095; pos = 16 + s; ipos = s & 127; } else { int j = row - 16384; if (j > 15) j = 15; pos = j; ipos = 112 + j; }
                    float sc = qscale;
                    if (pn == 4) sc = 1.0f; else if (pn >= 9) sc = 0.0625f * __builtin_amdgcn_exp2f(-(float)(ipos + 1) * lg); else if (pn >= 5) sc = __builtin_amdgcn_exp2f((float)(ipos + 1) * lg);
                    const float pf = (float)pos;
                    float cs[8], sn[8];
#pragma unroll
                    for (int i8 = 0; i8 < 8; ++i8) { const float rev = __builtin_amdgcn_fractf(pf * invrev[i8]); cs[i8] = __builtin_amdgcn_cosf(rev); sn[i8] = __builtin_amdgcn_sinf(rev); }
                    const f32x4 a0 = acc[ai][0][m][0], a1 = acc[ai][0][m][1], b0 = acc[ai][1][m][0], b1 = acc[ai][1][m][1];
                    u32x4 wA, wB;
                    wA.x = cvt_pk_bf16((a0[0] * cs[0] - b0[0] * sn[0]) * sc, (a0[1] * cs[1] - b0[1] * sn[1]) * sc); wA.y = cvt_pk_bf16((a0[2] * cs[2] - b0[2] * sn[2]) * sc, (a0[3] * cs[3] - b0[3] * sn[3]) * sc);
                    wA.z = cvt_pk_bf16((a1[0] * cs[4] - b1[0] * sn[4]) * sc, (a1[1] * cs[5] - b1[1] * sn[5]) * sc); wA.w = cvt_pk_bf16((a1[2] * cs[6] - b1[2] * sn[6]) * sc, (a1[3] * cs[7] - b1[3] * sn[7]) * sc);
                    wB.x = cvt_pk_bf16((b0[0] * cs[0] + a0[0] * sn[0]) * sc, (b0[1] * cs[1] + a0[1] * sn[1]) * sc); wB.y = cvt_pk_bf16((b0[2] * cs[2] + a0[2] * sn[2]) * sc, (b0[3] * cs[3] + a0[3] * sn[3]) * sc);
                    wB.z = cvt_pk_bf16((b1[0] * cs[4] + a1[0] * sn[4]) * sc, (b1[1] * cs[5] + a1[1] * sn[5]) * sc); wB.w = cvt_pk_bf16((b1[2] * cs[6] + a1[2] * sn[6]) * sc, (b1[3] * cs[7] + a1[3] * sn[7]) * sc);
                    *(u32x4*)(base + (size_t)row * ld + cA) = wA; *(u32x4*)(base + (size_t)row * ld + cB) = wB;
                }
        } else {
            const bool silu = pn >= 17;
#pragma unroll
            for (int bj = 0; bj < 2; ++bj) {
                bf16_t* base; int ld, cc;
                if (pn == 4)       { base = VA; ld = 128;  cc = 64 * bj + 32 * (wc - 2) + 8 * fq; }
                else if (pn <= 16) { base = RV; ld = 1024; cc = 256 * (pn - 13) + 128 * bj + c0; }
                else               { base = RG; ld = 1024; cc = 256 * (pn - 17) + 128 * bj + c0; }
#pragma unroll
                for (int ai = 0; ai < 2; ++ai)
#pragma unroll
                    for (int m = 0; m < 4; ++m) {
                        const int row = row0 + ai * HALF + m * 16;
                        f32x4 v0 = acc[ai][bj][m][0], v1 = acc[ai][bj][m][1];
                        if (silu) {
#pragma unroll
                            for (int e = 0; e < 4; ++e) { v0[e] = v0[e] * __builtin_amdgcn_rcpf(1.0f + __builtin_amdgcn_exp2f(-1.4426950408889634f * v0[e])); v1[e] = v1[e] * __builtin_amdgcn_rcpf(1.0f + __builtin_amdgcn_exp2f(-1.4426950408889634f * v1[e])); } }
                        u32x4 w; w.x = cvt_pk_bf16(v0[0], v0[1]); w.y = cvt_pk_bf16(v0[2], v0[3]); w.z = cvt_pk_bf16(v1[0], v1[1]); w.w = cvt_pk_bf16(v1[2], v1[3]);
                        *(u32x4*)(base + (size_t)row * ld + cc) = w;
                    }
            }
        }
    }
};
template <class Epi, class Sched, bool ALIGN_EPI = false, bool SP2 = false>
__device__ __forceinline__ void gemm_phase(PG8_LAS unsigned char* lds, const Gemm g, const Sched& S, const Epi& E) {
    const int tid = threadIdx.x, wid = __builtin_amdgcn_readfirstlane(tid >> 6), lane = tid & 63, wr = wid >> 2, wc = wid & 3, fr = lane & 15, fq = lane >> 4;
    const int K = g.K, nt = K / BK;
    unsigned voffA[2], voffB[2];
#pragma unroll
    for (int i = 0; i < 2; ++i) { int R, C; stage_rc(tid * 16 + i * 8192, R, C); const int Rb = Epi::PERM ? ((R & ~31) + perm32(R & 31)) : R;
        voffA[i] = (unsigned)(R * K + C) * 2u; voffB[i] = (unsigned)(Rb * K + C) * 2u; }
    const size_t kstep = (size_t)(BK * 2);
    const size_t hstep = (size_t)HALF * K * 2;
    const size_t tstep = 2 * hstep;
    const unsigned ldsw = (unsigned)wid * 1024u;
    const int aoff = lds_byte(wr * 64 + fr, fq * 8), boff = lds_byte(wc * 32 + fr, fq * 8);
#define PG8_SA(b, h) (((b) * 2 + (h)) * HTB)
#define PG8_SB(b, h) ((4 + (b) * 2 + (h)) * HTB)
#define PG8_STAGE(bufoff, gbase, voff) do { _Pragma("unroll") for (int _i = 0; _i < 2; ++_i) \
        __builtin_amdgcn_global_load_lds((const unsigned*)((const char*)(gbase) + (voff)[_i]), (PG8_LAS unsigned*)(lds + (bufoff) + ldsw + _i * 8192), 16, 0, 0); } while (0)
#define PG8_LDA(dst, b, h) do { _Pragma("unroll") for (int m = 0; m < 4; ++m) _Pragma("unroll") for (int k = 0; k < 2; ++k) dst[m][k] = *(const PG8_LAS bf16x8*)(lds + PG8_SA(b, h) + aoff + m * 2048 + k * 1024); } while (0)
#define PG8_LDB(dst, b, h) do { _Pragma("unroll") for (int n = 0; n < 2; ++n) _Pragma("unroll") for (int k = 0; k < 2; ++k) dst[n][k] = *(const PG8_LAS bf16x8*)(lds + PG8_SB(b, h) + boff + n * 2048 + k * 1024); } while (0)
#define PG8_MMA(ai, bj, At, Bt) do { __builtin_amdgcn_s_setprio(1); _Pragma("unroll") for (int m = 0; m < 4; ++m) _Pragma("unroll") for (int n = 0; n < 2; ++n) _Pragma("unroll") for (int k = 0; k < 2; ++k) \
        acc[ai][bj][m][n] = __builtin_amdgcn_mfma_f32_16x16x32_bf16(Bt[n][k], At[m][k], acc[ai][bj][m][n], 0, 0, 0); __builtin_amdgcn_s_setprio(0); } while (0)
#define PG8_WAIT_V(n) asm volatile("s_waitcnt vmcnt(" #n ")" ::: "memory")
#define PG8_WAIT_L(n) asm volatile("s_waitcnt lgkmcnt(" #n ")" ::: "memory")
#define PG8_BAR __builtin_amdgcn_s_barrier()
#define PG8_SCHED __builtin_amdgcn_sched_barrier(0)
    Unit cur, nxt; int ui = 0;
    if (!S.next(0, cur)) return;
    f32x4 acc[2][2][4][2];
#pragma unroll
    for (int a = 0; a < 2; ++a)
#pragma unroll
        for (int b = 0; b < 2; ++b)
#pragma unroll
            for (int m = 0; m < 4; ++m)
#pragma unroll
                for (int n = 0; n < 2; ++n) acc[a][b][m][n] = (f32x4){0.f, 0.f, 0.f, 0.f};
    bf16x8 At[4][2], B0[2][2], B1[2][2];
    const char* cA = (const char*)g.A + (size_t)cur.pm * tstep; const char* cB = (const char*)g.Bt + (size_t)cur.pn * tstep;
    S.a_ready(cur);
    if constexpr (SP2) {
        PG8_STAGE(PG8_SB(0, 0), cB, voffB); PG8_STAGE(PG8_SB(0, 1), cB + hstep, voffB); PG8_STAGE(PG8_SA(0, 0), cA, voffA); PG8_STAGE(PG8_SA(0, 1), cA + hstep, voffA);
        if (wr == 1) PG8_BAR;
        PG8_WAIT_V(2); PG8_BAR;
        PG8_STAGE(PG8_SB(1, 0), cB + kstep, voffB); PG8_STAGE(PG8_SA(1, 0), cA + kstep, voffA); PG8_STAGE(PG8_SB(1, 1), cB + hstep + kstep, voffB);
        PG8_WAIT_V(6); PG8_BAR;
    } else {
        PG8_STAGE(PG8_SB(0, 0), cB, voffB); PG8_STAGE(PG8_SA(0, 0), cA, voffA); PG8_STAGE(PG8_SB(0, 1), cB + hstep, voffB); PG8_STAGE(PG8_SA(0, 1), cA + hstep, voffA);
        if (wr == 1) PG8_BAR;
        PG8_WAIT_V(4); PG8_BAR;
        PG8_STAGE(PG8_SB(1, 0), cB + kstep, voffB); PG8_STAGE(PG8_SA(1, 0), cA + kstep, voffA); PG8_STAGE(PG8_SB(1, 1), cB + hstep + kstep, voffB);
        PG8_WAIT_V(6); PG8_BAR;
    }
    for (;;) {
        const bool has_next = S.next(ui + 1, nxt);
        const char* nA = has_next ? (const char*)g.A + (size_t)nxt.pm * tstep : cA; const char* nB = has_next ? (const char*)g.Bt + (size_t)nxt.pn * tstep : cB;
        for (int t = 0; t < nt; t += 2) {
            const bool last = (t == nt - 2);
            const char* a1 = cA + (size_t)(t + 1) * kstep;
            const char* a2 = last ? nA : cA + (size_t)(t + 2) * kstep; const char* b2 = last ? nB : cB + (size_t)(t + 2) * kstep;
            const char* a3 = a2 + kstep; const char* b3 = b2 + kstep;
            if (last && has_next) S.a_ready(nxt);
            if constexpr (SP2) {
            PG8_LDB(B0, 0, 0); PG8_LDB(B1, 0, 1); PG8_SCHED; PG8_LDA(At, 0, 0); PG8_STAGE(PG8_SA(1, 1), a1 + hstep, voffA);
            PG8_WAIT_V(8); PG8_WAIT_L(0); PG8_BAR; PG8_MMA(0, 0, At, B0); PG8_MMA(0, 1, At, B1); PG8_BAR; PG8_SCHED;
            PG8_LDA(At, 0, 1); PG8_STAGE(PG8_SB(0, 0), b2, voffB); PG8_STAGE(PG8_SB(0, 1), b2 + hstep, voffB); PG8_STAGE(PG8_SA(0, 0), a2, voffA);
            PG8_WAIT_V(8); PG8_WAIT_L(0); PG8_BAR; PG8_MMA(1, 0, At, B0); PG8_MMA(1, 1, At, B1); PG8_BAR; PG8_SCHED;
            PG8_LDB(B0, 1, 0); PG8_LDB(B1, 1, 1); PG8_SCHED; PG8_LDA(At, 1, 0); PG8_STAGE(PG8_SA(0, 1), a2 + hstep, voffA);
            PG8_WAIT_V(8); PG8_WAIT_L(0); PG8_BAR; PG8_MMA(0, 0, At, B0); PG8_MMA(0, 1, At, B1); PG8_BAR; PG8_SCHED;
            PG8_LDA(At, 1, 1); PG8_STAGE(PG8_SB(1, 0), b3, voffB); PG8_STAGE(PG8_SB(1, 1), b3 + hstep, voffB); PG8_STAGE(PG8_SA(1, 0), a3, voffA);
            PG8_WAIT_V(8); PG8_WAIT_L(0); PG8_BAR; PG8_MMA(1, 0, At, B0); PG8_MMA(1, 1, At, B1); PG8_BAR; PG8_SCHED;
            } else {
            PG8_LDB(B0, 0, 0); PG8_SCHED; PG8_LDA(At, 0, 0); PG8_STAGE(PG8_SA(1, 1), a1 + hstep, voffA);
            PG8_WAIT_L(8); PG8_BAR; PG8_WAIT_L(0); PG8_MMA(0, 0, At, B0); PG8_BAR; PG8_SCHED;
            PG8_LDB(B1, 0, 1); PG8_STAGE(PG8_SB(0, 0), b2, voffB);
            PG8_BAR; PG8_WAIT_L(0); PG8_MMA(0, 1, At, B1); PG8_BAR;
            PG8_LDA(At, 0, 1); PG8_STAGE(PG8_SA(0, 0), a2, voffA);
            PG8_BAR; PG8_WAIT_L(0); PG8_MMA(1, 0, At, B0); PG8_BAR; PG8_SCHED;
            PG8_STAGE(PG8_SB(0, 1), b2 + hstep, voffB);
            PG8_WAIT_V(6); PG8_BAR; PG8_MMA(1, 1, At, B1); PG8_BAR;
            PG8_LDB(B0, 1, 0); PG8_SCHED; PG8_LDA(At, 1, 0); PG8_STAGE(PG8_SA(0, 1), a2 + hstep, voffA);
            PG8_WAIT_L(8); PG8_BAR; PG8_WAIT_L(0); PG8_MMA(0, 0, At, B0); PG8_BAR; PG8_SCHED;
            PG8_LDB(B1, 1, 1); PG8_STAGE(PG8_SB(1, 0), b3, voffB);
            PG8_BAR; PG8_WAIT_L(0); PG8_MMA(0, 1, At, B1); PG8_BAR;
            PG8_LDA(At, 1, 1); PG8_STAGE(PG8_SA(1, 0), a3, voffA);
            PG8_BAR; PG8_WAIT_L(0); PG8_MMA(1, 0, At, B0); PG8_BAR; PG8_SCHED;
            PG8_STAGE(PG8_SB(1, 1), b3 + hstep, voffB);
            PG8_WAIT_V(6); PG8_BAR; PG8_MMA(1, 1, At, B1); PG8_BAR;
            }
        }
        if constexpr (ALIGN_EPI) { if (wr == 0) PG8_BAR; }
        if constexpr (!Epi::AFTER_DRAIN) { E(acc, cur, wr, wc, fr, fq); S.done(cur); }
        if (!has_next) break;
#pragma unroll
        for (int a = 0; a < 2; ++a)
#pragma unroll
            for (int b = 0; b < 2; ++b)
#pragma unroll
                for (int m = 0; m < 4; ++m)
#pragma unroll
                    for (int n = 0; n < 2; ++n) acc[a][b][m][n] = (f32x4){0.f, 0.f, 0.f, 0.f};
        cur = nxt; cA = nA; cB = nB; ++ui;
        if constexpr (ALIGN_EPI) { if (wr == 1) PG8_BAR; }
    }
    PG8_WAIT_V(0);
    if constexpr (!ALIGN_EPI) { if (wr == 0) PG8_BAR; }
    PG8_BAR;
    if constexpr (Epi::AFTER_DRAIN) { E.fused(acc, cur, wr, wc, fr, fq, lds, wid, lane); S.done(cur); }
#undef PG8_SA
#undef PG8_SB
#undef PG8_STAGE
#undef PG8_LDA
#undef PG8_LDB
#undef PG8_MMA
#undef PG8_WAIT_V
#undef PG8_WAIT_L
#undef PG8_BAR
#undef PG8_SCHED
}
}

constexpr int NWAVES = 8;
constexpr int DM = 2048, NB = 4, SEQ = 4096, NTOK = NB * SEQ;
constexpr int NMETA = 16, NVALID = NTOK + NMETA, MROWS = 16640;
constexpr int IN_COLS = 5376;
constexpr float LN_EPS = 1e-5f, GN_EPS = 1e-5f;
constexpr float ALPHA = 1.189207115002721f;
constexpr float LOG2E = 1.4426950408889634f;
constexpr float QSCALE = 0.125f * LOG2E;
constexpr float U_SCALE = 64.0f, V_SCALE = 4.0f;
constexpr int NSL = 16;

constexpr size_t MiB = 1u << 20;
constexpr size_t WS_CTL = 0, CTL_ZERO_BYTES = 65536;
constexpr size_t SZ_SK = (size_t)16 * 128 * 128 * 2, SZ_ROPE_R = (size_t)4112 * 128 * 8, SZ_ROPE_A = (size_t)4112 * 32 * 8;
constexpr size_t SZ_W2T = (size_t)DM * DM * 2, SZ_W1T = (size_t)IN_COLS * DM * 2, SZ_TAB = (size_t)16384 * DM * 2;
constexpr size_t SZ_ROWS2K = (size_t)MROWS * 2048 * 2, SZ_ROWS1K = (size_t)MROWS * 1024 * 2, SZ_ROWS128 = (size_t)MROWS * 128 * 2;
constexpr size_t SZ_TOK2K = (size_t)NTOK * 2048 * 2, SZ_ST = (size_t)16 * 32 * 256 * 256 * 2, SZ_IDS = (size_t)NTOK * 128 * 4;
constexpr size_t al256(size_t x) { return (x + 255) & ~(size_t)255; }
constexpr size_t WS_SK = 1 * MiB;
constexpr size_t WS_ROPE_R = al256(WS_SK + SZ_SK);
constexpr size_t WS_ROPE_A = al256(WS_ROPE_R + SZ_ROPE_R);
constexpr size_t WS_W2T = al256(WS_ROPE_A + SZ_ROPE_A), WS_W3T = al256(WS_W2T + SZ_W2T), WS_W1T = al256(WS_W3T + SZ_W2T);
constexpr size_t WS_UT = al256(WS_W1T + SZ_W1T), WS_VT = al256(WS_UT + SZ_TAB);
constexpr size_t WS_H0 = al256(WS_VT + SZ_TAB);
constexpr size_t WS_QR = al256(WS_H0 + SZ_ROWS2K);
constexpr size_t WS_KA = al256(WS_QR + SZ_ROWS2K), WS_VA = al256(WS_KA + SZ_ROWS128);
constexpr size_t WS_RK = al256(WS_VA + SZ_ROWS128), WS_RV = al256(WS_RK + SZ_ROWS1K), WS_RG = al256(WS_RV + SZ_ROWS1K);
constexpr size_t WS_ST = al256(WS_RG + SZ_ROWS1K);
constexpr size_t WS_Y = WS_RK;
constexpr size_t WS_H1 = WS_ST;
constexpr size_t WS_IDS = al256(WS_ST + SZ_ST), WS_GATES = al256(WS_IDS + SZ_IDS);
constexpr size_t WS_END = al256(WS_GATES + SZ_IDS);
static_assert(WS_Y + SZ_TOK2K <= WS_RG, "Y overlays RK|RV only");
static_assert(SZ_TOK2K <= SZ_ST && (size_t)NTOK * 1024 * 4 <= SZ_ST, "H1 / RET_RAW fit the state region");
static_assert(WS_END <= (size_t)512 * MiB, "workspace map fits 4 x largest tensor");
static_assert(WS_RK + (size_t)8 * NTOK * 128 * 4 <= WS_ST && WS_KA + (size_t)NTOK * 128 * 4 <= WS_RK && WS_H0 + (size_t)NTOK * DM * 4 <= WS_KA, "expert-phase overlays (DOTX over RK|RV, CB over KA|VA, Y32 over H0|QR)");
constexpr int CW_TMO = 0, CW_TABQ = 64, CW_BAR = 4096;

constexpr int RING_OFF = 0, RING_BYTES = 131072;
constexpr int LDSCTL_OFF = RING_BYTES, MISC_OFF = LDSCTL_OFF + 320;
constexpr int LDS_BYTES = 147456;

#define GAS __attribute__((address_space(1)))
#define LAS __attribute__((address_space(3)))
typedef unsigned short bf16;
typedef unsigned v4u __attribute__((ext_vector_type(4)));
typedef unsigned v2u __attribute__((ext_vector_type(2)));
typedef float f32x4 __attribute__((ext_vector_type(4)));
typedef float f32x2 __attribute__((ext_vector_type(2)));
typedef GAS unsigned gu32;
typedef __bf16 bf16x2_t __attribute__((ext_vector_type(2)));
#define RLX_AGENT __ATOMIC_RELAXED, __HIP_MEMORY_SCOPE_AGENT
#define LDS_WAIT() asm volatile("s_waitcnt lgkmcnt(0)" ::: "memory")
#define VM_WAIT() asm volatile("s_waitcnt vmcnt(0)" ::: "memory")
#define LDS_BAR() do { asm volatile("s_waitcnt lgkmcnt(0)" ::: "memory"); __builtin_amdgcn_s_barrier(); asm volatile("" ::: "memory"); } while (0)
__device__ __forceinline__ unsigned f2bf(float f) { unsigned u = __builtin_bit_cast(unsigned, f); return (u + 0x7fffu + ((u >> 16) & 1u)) >> 16; }
__device__ __forceinline__ unsigned pk2(float lo, float hi) { return f2bf(lo) | (f2bf(hi) << 16); }
__device__ __forceinline__ float bflo(unsigned w) { return __uint_as_float(w << 16); }
__device__ __forceinline__ float bfhi(unsigned w) { return __uint_as_float(w & 0xffff0000u); }
__device__ __forceinline__ float bf2f(bf16 h) { return __uint_as_float((unsigned)h << 16); }

#define XB_TMO      128
#define XB_XCNT(j)  (256  + 64 * (j))
#define XB_XSUB(j)  (1280 + 64 * (j))
#define XB_XGEN(j)  (2304 + 64 * (j))
#define XB_TOP      3328
#define XB_TOPGEN   3392
#define XCD_BAR_WORDS 3456
#define XB_SPIN_CAP (1u << 18)

__device__ __forceinline__ unsigned xb_ld(unsigned* p)              { return __hip_atomic_load(p, __ATOMIC_RELAXED, __HIP_MEMORY_SCOPE_AGENT); }
__device__ __forceinline__ unsigned xb_add(unsigned* p, unsigned v) { return __hip_atomic_fetch_add(p, v, __ATOMIC_RELAXED, __HIP_MEMORY_SCOPE_AGENT); }
__device__ __forceinline__ unsigned xb_xcc_id() { return (unsigned)__builtin_amdgcn_s_getreg((3 << 11) | 20) & 0xFu; }
#define XB_SPIN(cond, bar) do { unsigned _sp = 0; while (cond) { __builtin_amdgcn_s_sleep(1); \
    if ((++_sp & 255u) == 0u) { if (xb_ld(&(bar)[XB_TMO])) break; if (_sp > XB_SPIN_CAP) { atomicAdd(&(bar)[XB_TMO], 1u); break; } } } } while (0)

struct XcdBarrier {
    unsigned* bar; unsigned x;
    volatile LAS unsigned* st;
};

__device__ __forceinline__ XcdBarrier xcd_barrier_post(unsigned* bar, volatile LAS unsigned* st) {
    XcdBarrier b; b.bar = bar; b.x = xb_xcc_id(); b.st = st;
    if (threadIdx.x == 0) (void)xb_add(&bar[XB_XCNT(b.x)], 1u);
    return b;
}
__device__ __forceinline__ void xcd_barrier_complete(unsigned* bar, unsigned x, unsigned& nloc, unsigned& nx) {
    const unsigned G = gridDim.x * gridDim.y * gridDim.z;
    unsigned sum, cnt, mine, sp = 0u;
    for (;;) {
        sum = 0u; cnt = 0u; mine = 0u;
#pragma unroll
        for (unsigned j = 0; j < 16; ++j) { const unsigned c = xb_ld(&bar[XB_XCNT(j)]); sum += c; cnt += (c > 0u) ? 1u : 0u; mine = (j == x) ? c : mine; }
        if (sum == G) break;
        __builtin_amdgcn_s_sleep(1);
        if ((++sp & 255u) == 0u) { if (xb_ld(&bar[XB_TMO])) break; if (sp > XB_SPIN_CAP) { atomicAdd(&bar[XB_TMO], 1u); break; } }
    }
    nloc = mine > 0u ? mine : 1u; nx = cnt > 0u ? cnt : 1u;
}

__device__ __forceinline__ void xcd_barrier(const XcdBarrier& b) {
    asm volatile("s_waitcnt vmcnt(0)" ::: "memory");
    __syncthreads();
    if (threadIdx.x == 0) {
        unsigned* bar = b.bar;
        __builtin_amdgcn_s_waitcnt(0);
        unsigned nloc = b.st[0], nx = b.st[1];
        if (nloc == 0u) { xcd_barrier_complete(bar, b.x, nloc, nx); b.st[0] = nloc; b.st[1] = nx; }
        const unsigned old = xb_add(&bar[XB_XSUB(b.x)], 1u);
        const unsigned gen = old / nloc;
        if (old + 1u == (gen + 1u) * nloc) {
            __builtin_amdgcn_fence(__ATOMIC_RELEASE, "agent");
            asm volatile("s_waitcnt vmcnt(0)" ::: "memory");
            const unsigned og = xb_add(&bar[XB_TOP], 1u);
            const unsigned tg = og / nx;
            if (og + 1u == (tg + 1u) * nx) xb_add(&bar[XB_TOPGEN], 1u);
            else XB_SPIN(xb_ld(&bar[XB_TOPGEN]) == tg, bar);
            __builtin_amdgcn_fence(__ATOMIC_ACQUIRE, "agent");
            xb_add(&bar[XB_XGEN(b.x)], 1u);
            asm volatile("s_waitcnt vmcnt(0)" ::: "memory");
        } else {
            XB_SPIN(xb_ld(&bar[XB_XGEN(b.x)]) == gen, bar);
            __builtin_amdgcn_fence(__ATOMIC_ACQUIRE, "agent");
            asm volatile("s_waitcnt vmcnt(0)" ::: "memory");
        }
    }
    __syncthreads();
}


__device__ __forceinline__ float dot2bf(unsigned a, unsigned b, float c) { asm("v_dot2c_f32_bf16 %0, %1, %2" : "+v"(c) : "v"(a), "v"(b)); return c; }
__device__ __forceinline__ float dot8bf_dpp(v4u a, v4u b) { float c = 0.f; asm("v_dot2c_f32_bf16 %0, %1, %5\n\tv_dot2c_f32_bf16 %0, %2, %6\n\tv_dot2c_f32_bf16 %0, %3, %7\n\tv_dot2c_f32_bf16 %0, %4, %8\n\ts_nop 1" : "+v"(c) : "v"(a.x), "v"(a.y), "v"(a.z), "v"(a.w), "v"(b.x), "v"(b.y), "v"(b.z), "v"(b.w)); return c; }
#define DPPF(v, ctrl) __int_as_float(__builtin_amdgcn_update_dpp(0, __float_as_int(v), (ctrl), 0xf, 0xf, true))
__device__ __forceinline__ float wave_sum(float v) {
#pragma unroll
    for (int o = 1; o < 64; o <<= 1) v += __shfl_xor(v, o);
    return v;
}
__device__ __forceinline__ float gelu_erf(float v) {
    const float av = fabsf(v), d = av * 0.2316418882f + 1.0f;
    const float t = __builtin_amdgcn_rcpf(d);
    float q = t * 0.5307027145f + (-0.7265760135f); q = q * t + 0.7107068705f; q = q * t + (-0.142248368f); q = q * t + 0.127414796f; q = q * t;
    const float e = __builtin_amdgcn_exp2f((v * v) * (-0.72134752044f));
    const float m = v * (q * e);
    return v < 0.f ? m : v - m;
}

struct Args { const float* in[15]; float* out; unsigned char* ws; };

__device__ __forceinline__ int w1_logical_col(int n0p) {
    const int pn = n0p >> 8, blk = (n0p & 255) >> 5, half = blk >> 2, a = blk & 3;
    if (pn <= 3) return pn * 256 + 64 * a + 32 * half;
    if (pn == 4) return (a < 2) ? (1024 + 64 * a + 32 * half) : (1152 + 64 * half + 32 * (a - 2));
    return n0p;
}
template <bool PERMW1> __device__ __forceinline__ void p0_transpose_item(const float* W, int K, int N, bf16* WT, LAS float* scr, int item, int lane) {
    const int nblk = N / 32, kb = item / nblk, nb = item % nblk, k0 = 64 * kb, n0 = 32 * nb; const int ns = PERMW1 ? w1_logical_col(n0) : n0;
    float tv[32];
#pragma unroll
    for (int i = 0; i < 32; ++i) { const int kk = 2 * i + (lane >> 5); tv[i] = W[(size_t)(k0 + kk) * N + ns + (lane & 31)]; }
#pragma unroll
    for (int i = 0; i < 32; ++i) { const int kk = 2 * i + (lane >> 5); scr[kk * 33 + (lane & 31)] = tv[i]; }
    LDS_WAIT(); asm volatile("" ::: "memory");
    const int c = lane & 7;
#pragma unroll
    for (int j = 0; j < 4; ++j) { const int n = (lane >> 3) + 8 * j; const LAS float* s = scr + (8 * c) * 33 + n;
        v4u o; o.x = pk2(s[0 * 33], s[1 * 33]); o.y = pk2(s[2 * 33], s[3 * 33]); o.z = pk2(s[4 * 33], s[5 * 33]); o.w = pk2(s[6 * 33], s[7 * 33]);
        *(GAS v4u*)(WT + (size_t)(n0 + n) * K + k0 + 8 * c) = o; }
    LDS_WAIT(); asm volatile("" ::: "memory");
}
__device__ __forceinline__ void ln_row_f32_to_bf16(const float* xrow, const float* g, const float* bta, bf16* orow, int lane) {
    const GAS f32x4* xr = (const GAS f32x4*)xrow + lane;
    f32x4 v[8]; float s = 0.f;
#pragma unroll
    for (int j = 0; j < 8; ++j) { v[j] = xr[64 * j]; s += (v[j].x + v[j].y) + (v[j].z + v[j].w); }
    const float mean = wave_sum(s) * (1.f / DM); float s2 = 0.f;
#pragma unroll
    for (int j = 0; j < 8; ++j) { v[j] = v[j] - mean; s2 += (v[j].x * v[j].x + v[j].y * v[j].y) + (v[j].z * v[j].z + v[j].w * v[j].w); }
    const float rstd = 1.f / sqrtf(wave_sum(s2) * (1.f / DM) + LN_EPS);
    GAS v2u* o8 = (GAS v2u*)orow + lane;
#pragma unroll
    for (int j = 0; j < 8; ++j) { const f32x4 gg = ((const GAS f32x4*)g)[lane + 64 * j], bb = ((const GAS f32x4*)bta)[lane + 64 * j];
        v2u o; o.x = pk2(v[j].x * rstd * gg.x + bb.x, v[j].y * rstd * gg.y + bb.y); o.y = pk2(v[j].z * rstd * gg.z + bb.z, v[j].w * rstd * gg.w + bb.w); o8[64 * j] = o; }
}
__device__ __forceinline__ void ln_row_bf16_to_bf16(const bf16* xrow, const float* g, const float* bta, bf16* orow, int lane) {
    const GAS v4u* xr = (const GAS v4u*)xrow + lane;
    float v[32]; float s = 0.f;
#pragma unroll
    for (int j = 0; j < 4; ++j) { const v4u w = xr[64 * j];
        v[8 * j + 0] = bflo(w.x); v[8 * j + 1] = bfhi(w.x); v[8 * j + 2] = bflo(w.y); v[8 * j + 3] = bfhi(w.y);
        v[8 * j + 4] = bflo(w.z); v[8 * j + 5] = bfhi(w.z); v[8 * j + 6] = bflo(w.w); v[8 * j + 7] = bfhi(w.w); }
#pragma unroll
    for (int i = 0; i < 32; ++i) s += v[i];
    const float mean = wave_sum(s) * (1.f / DM); float s2 = 0.f;
#pragma unroll
    for (int i = 0; i < 32; ++i) { v[i] -= mean; s2 += v[i] * v[i]; }
    const float rstd = 1.f / sqrtf(wave_sum(s2) * (1.f / DM) + LN_EPS);
    GAS v4u* o16 = (GAS v4u*)orow + lane;
#pragma unroll
    for (int j = 0; j < 4; ++j) {
        const GAS f32x4* gp = (const GAS f32x4*)g + 2 * (lane + 64 * j); const GAS f32x4* bp = (const GAS f32x4*)bta + 2 * (lane + 64 * j);
        const f32x4 g0 = gp[0], g1 = gp[1], b0 = bp[0], b1 = bp[1];
        v4u o; o.x = pk2(v[8 * j + 0] * rstd * g0.x + b0.x, v[8 * j + 1] * rstd * g0.y + b0.y); o.y = pk2(v[8 * j + 2] * rstd * g0.z + b0.z, v[8 * j + 3] * rstd * g0.w + b0.w);
        o.z = pk2(v[8 * j + 4] * rstd * g1.x + b1.x, v[8 * j + 5] * rstd * g1.y + b1.y); o.w = pk2(v[8 * j + 6] * rstd * g1.z + b1.z, v[8 * j + 7] * rstd * g1.w + b1.w);
        o16[64 * j] = o; }
}
__device__ __forceinline__ void row_pos(int r, int& pos, int& ipos) {
    if (r < NTOK) { const int s = r & (SEQ - 1); pos = NMETA + s; ipos = s & 127; }
    else { int j = r - NTOK; if (j > NMETA - 1) j = NMETA - 1; pos = j; ipos = 112 + j; }
}
__device__ __forceinline__ float log2_gamma(int h) { return log2f(1.0f - exp2f(-5.0f - (float)h)); }


typedef short bf16x8 __attribute__((ext_vector_type(8)));
typedef short s16x4 __attribute__((ext_vector_type(4)));
#define MFMA16(a, b, c) __builtin_amdgcn_mfma_f32_16x16x32_bf16((a), (b), (c), 0, 0, 0)
__device__ __forceinline__ s16x4 tr16(LAS const unsigned char* p) { return __builtin_bit_cast(s16x4, __builtin_amdgcn_ds_read_tr16_b64_v4i16((LAS s16x4*)p)); }
__device__ __forceinline__ bf16x8 cat8(s16x4 a, s16x4 b) { return __builtin_shufflevector(a, b, 0, 1, 2, 3, 4, 5, 6, 7); }
__device__ __forceinline__ unsigned cvtpk_s(float lo, float hi) { f32x2 v = {lo, hi}; bf16x2_t b = __builtin_convertvector(v, bf16x2_t); return __builtin_bit_cast(unsigned, b); }
__device__ __forceinline__ unsigned cvtpk(float lo, float hi) { unsigned r; asm("v_cvt_pk_bf16_f32 %0, %1, %2" : "=v"(r) : "v"(lo), "v"(hi)); return r; }

__device__ __forceinline__ void scan_unit(LAS unsigned char* L, int u, const bf16* RK, const bf16* RV, bf16* ST, int tid, int lane, int wave) {
    asm volatile("" : "+v"(tid)); lane = tid & 63;
    const int bh = u >> 4, di = (u >> 2) & 3, ei = u & 3, b = bh >> 2, h = bh & 3;
    const float g128 = exp2f(128.0f * log2_gamma(h));
    const int li = lane & 15, g = lane >> 4, q = li >> 2, p4 = li & 3;
    const int eb = wave >> 1, db0 = 2 * (wave & 1);
    f32x4 acc[2]; acc[0] = (f32x4){0.f, 0.f, 0.f, 0.f}; acc[1] = acc[0];
    const int sw = 2 * (((q >> 1) & 1) | ((g & 1) << 1));
    v4u kA[2], vA[2], kB[2], vB[2];
#define SCAN_LOAD(cc, kreg, vreg) do { _Pragma("unroll") for (int i_ = 0; i_ < 2; ++i_) { const int cid_ = tid + 512 * i_, row_ = cid_ >> 3, c16_ = cid_ & 7; \
        int srow_; bool ok_ = true; if ((cc) < 0) { ok_ = row_ >= 112; srow_ = NTOK + (ok_ ? row_ - 112 : 0); } else srow_ = b * SEQ + (cc) * 128 + row_; \
        const v4u kz_ = *(const GAS v4u*)(RK + (size_t)srow_ * 1024 + h * 256 + di * 64 + c16_ * 8), vz_ = *(const GAS v4u*)(RV + (size_t)srow_ * 1024 + h * 256 + ei * 64 + c16_ * 8); \
        kreg[i_] = ok_ ? kz_ : (v4u){0u, 0u, 0u, 0u}; vreg[i_] = ok_ ? vz_ : (v4u){0u, 0u, 0u, 0u}; } } while (0)
#define SCAN_WRITE(bufp, kreg, vreg) do { _Pragma("unroll") for (int i_ = 0; i_ < 2; ++i_) { const int cid_ = tid + 512 * i_, row_ = cid_ >> 3, c16_ = cid_ & 7; \
        const int sw_ = ((row_ >> 1) & 1) | ((row_ >> 2) & 2); const int off_ = row_ * 128 + ((c16_ ^ (2 * sw_)) << 4); \
        *(LAS v4u*)((bufp) + off_) = kreg[i_]; *(LAS v4u*)((bufp) + 16384 + off_) = vreg[i_]; } } while (0)
#define SCAN_FLUSH(c) do { if ((c) >= 0) { const v4u z_ = *(LAS const v4u*)(L + 65536 + ((c) & 1) * 8192 + (tid >> 3) * 128 + (tid & 7) * 16); \
        *(GAS v4u*)(ST + ((size_t)(bh * 32 + (c)) * 256 + 64 * ei + (tid >> 3)) * 256 + 64 * di + (tid & 7) * 8) = z_; } } while (0)
    SCAN_LOAD(-1, kA, vA); SCAN_WRITE(L, kA, vA); SCAN_LOAD(0, kA, vA); SCAN_LOAD(1, kB, vB); LDS_BAR();
    int cur = 0;
    for (int cc = -1; cc <= 29; cc += 2) {
        { LAS const unsigned char* Kt = L + cur * 32768; LAS const unsigned char* Vt = Kt + 16384;
#pragma unroll
          for (int ks = 0; ks < 4; ++ks) { const int r0 = (32 * ks + 8 * g + q) * 128 + 8 * (p4 & 1);
              const bf16x8 a = cat8(tr16(Vt + r0 + (((2 * eb + (p4 >> 1)) ^ sw) << 4)), tr16(Vt + r0 + 512 + (((2 * eb + (p4 >> 1)) ^ sw) << 4)));
#pragma unroll
              for (int n = 0; n < 2; ++n) { const int cn = ((2 * (db0 + n) + (p4 >> 1)) ^ sw) << 4; const bf16x8 bb = cat8(tr16(Kt + r0 + cn), tr16(Kt + r0 + 512 + cn)); acc[n] = MFMA16(a, bb, acc[n]); } }
          SCAN_FLUSH(cc);
#pragma unroll
          for (int n = 0; n < 2; ++n) { acc[n] = acc[n] * g128;
              LAS bf16* op = (LAS bf16*)(L + 65536 + ((cc + 1) & 1) * 8192) + (16 * eb + 4 * g) * 64 + 16 * (db0 + n) + li;
#pragma unroll
              for (int r = 0; r < 4; ++r) op[r * 64] = (bf16)f2bf(acc[n][r]); }
          SCAN_WRITE(L + (cur ^ 1) * 32768, kA, vA);
          if (cc + 3 <= 30) SCAN_LOAD(cc + 3, kA, vA);
          LDS_BAR(); cur ^= 1; }
        { LAS const unsigned char* Kt = L + cur * 32768; LAS const unsigned char* Vt = Kt + 16384;
#pragma unroll
          for (int ks = 0; ks < 4; ++ks) { const int r0 = (32 * ks + 8 * g + q) * 128 + 8 * (p4 & 1);
              const bf16x8 a = cat8(tr16(Vt + r0 + (((2 * eb + (p4 >> 1)) ^ sw) << 4)), tr16(Vt + r0 + 512 + (((2 * eb + (p4 >> 1)) ^ sw) << 4)));
#pragma unroll
              for (int n = 0; n < 2; ++n) { const int cn = ((2 * (db0 + n) + (p4 >> 1)) ^ sw) << 4; const bf16x8 bb = cat8(tr16(Kt + r0 + cn), tr16(Kt + r0 + 512 + cn)); acc[n] = MFMA16(a, bb, acc[n]); } }
          SCAN_FLUSH(cc + 1);
#pragma unroll
          for (int n = 0; n < 2; ++n) { acc[n] = acc[n] * g128;
              LAS bf16* op = (LAS bf16*)(L + 65536 + ((cc + 2) & 1) * 8192) + (16 * eb + 4 * g) * 64 + 16 * (db0 + n) + li;
#pragma unroll
              for (int r = 0; r < 4; ++r) op[r * 64] = (bf16)f2bf(acc[n][r]); }
          if (cc + 2 <= 30) SCAN_WRITE(L + (cur ^ 1) * 32768, kB, vB);
          if (cc + 4 <= 30) SCAN_LOAD(cc + 4, kB, vB);
          LDS_BAR(); cur ^= 1; }
    }
    SCAN_FLUSH(31);
    LDS_BAR();
#undef SCAN_LOAD
#undef SCAN_WRITE
#undef SCAN_FLUSH
}

__device__ __forceinline__ void retout_unit(LAS unsigned char* L, int u, bf16* QR, const bf16* RK, const bf16* RV, const bf16* RG, const bf16* ST, int tid, int lane, int wave) {
    asm volatile("" : "+v"(tid)); lane = tid & 63;
    const int bh = u >> 5, c = u & 31, b = bh >> 2, h = bh & 3;
    const int R0 = b * SEQ + c * 128;
    const int li = lane & 15, g = lane >> 4, q = li >> 2, p4 = li & 3;
    LAS unsigned char* RA = L; LAS unsigned char* RB = L + 65536;
#pragma unroll
    for (int i = 0; i < 8; ++i) { const int cid = tid + 512 * i, j = cid >> 5, ch = cid & 31;
        const v4u kz = *(const GAS v4u*)(RK + (size_t)(R0 + j) * 1024 + h * 256 + ch * 8), vz = *(const GAS v4u*)(RV + (size_t)(R0 + j) * 1024 + h * 256 + ch * 8);
        *(LAS v4u*)(RA + j * 512 + ((ch ^ (j & 15)) << 4)) = kz; *(LAS v4u*)(RB + j * 512 + ((ch ^ ((j & 7) << 1)) << 4)) = vz; }
    bf16x8 qf[8];
    { const GAS v4u* qp = (const GAS v4u*)(QR + (size_t)(R0 + 16 * wave + li) * 2048 + 1024 + h * 256 + 8 * g);
#pragma unroll
      for (int ks = 0; ks < 8; ++ks) qf[ks] = __builtin_bit_cast(bf16x8, qp[4 * ks]); }
#define RO_LOAD_ST(s0) do { _Pragma("unroll") for (int i_ = 0; i_ < 8; ++i_) { const int cid_ = tid + 512 * i_, sl_ = cid_ >> 11, e_ = (cid_ >> 3) & 255, ch_ = cid_ & 7; \
        stg[i_] = *(const GAS v4u*)(Sg + (size_t)e_ * 256 + 64 * ((s0) + sl_) + ch_ * 8); } } while (0)
#define RO_WRITE_ST(dst) do { _Pragma("unroll") for (int i_ = 0; i_ < 8; ++i_) { const int cid_ = tid + 512 * i_, sl_ = cid_ >> 11, e_ = (cid_ >> 3) & 255, ch_ = cid_ & 7; \
        *(LAS v4u*)((dst) + sl_ * 32768 + e_ * 128 + ((ch_ ^ (e_ & 7)) << 4)) = stg[i_]; } } while (0)
    const bf16* Sg = ST + (size_t)(bh * 32 + c) * 65536; v4u stg[8];
    __syncthreads();
    RO_LOAD_ST(0);
    f32x4 st[8];
#pragma unroll
    for (int jt = 0; jt < 8; ++jt) st[jt] = (f32x4){0.f, 0.f, 0.f, 0.f};
#pragma unroll
    for (int jt = 0; jt < 8; ++jt) if (jt <= wave) {
        const int j = 16 * jt + li;
#pragma unroll
        for (int ks = 0; ks < 8; ++ks) { const bf16x8 a = *(LAS const bf16x8*)(RA + j * 512 + (((4 * ks + g) ^ li) << 4)); st[jt] = MFMA16(a, qf[ks], st[jt]); }
        if (jt == wave) {
#pragma unroll
            for (int r = 0; r < 4; ++r) if (4 * g + r > li) st[jt][r] = 0.f; }
    }
    bf16x8 pf[4];
#pragma unroll
    for (int s = 0; s < 4; ++s) { v4u w; w.x = cvtpk_s(st[2 * s][0], st[2 * s][1]); w.y = cvtpk_s(st[2 * s][2], st[2 * s][3]); w.z = cvtpk_s(st[2 * s + 1][0], st[2 * s + 1][1]); w.w = cvtpk_s(st[2 * s + 1][2], st[2 * s + 1][3]); pf[s] = __builtin_bit_cast(bf16x8, w); }
    __syncthreads();
    RO_WRITE_ST(RA); RO_LOAD_ST(2);
    f32x4 o[16];
#pragma unroll
    for (int et = 0; et < 16; ++et) o[et] = (f32x4){0.f, 0.f, 0.f, 0.f};
#pragma unroll
    for (int s = 0; s < 4; ++s) if (2 * s <= wave) {
        const int r1 = 32 * s + 4 * g + q, r2 = r1 + 16;
#pragma unroll
        for (int et = 0; et < 16; ++et) {
            const int chn = 2 * et + (p4 >> 1);
            const bf16x8 a = cat8(tr16(RB + r1 * 512 + ((chn ^ ((r1 & 7) << 1)) << 4) + (p4 & 1) * 8), tr16(RB + r2 * 512 + ((chn ^ ((r2 & 7) << 1)) << 4) + (p4 & 1) * 8));
            o[et] = MFMA16(a, pf[s], o[et]);
        }
    }
    __syncthreads();
    RO_WRITE_ST(RB);
#define RO_STATE_MMA(src, s0) do { _Pragma("unroll") for (int sl_ = 0; sl_ < 2; ++sl_) _Pragma("unroll") for (int k2_ = 0; k2_ < 2; ++k2_) _Pragma("unroll") for (int et = 0; et < 16; ++et) { \
        const int e_ = 16 * et + li; const bf16x8 a_ = *(LAS const bf16x8*)((src) + sl_ * 32768 + e_ * 128 + (((4 * k2_ + g) ^ (e_ & 7)) << 4)); \
        o[et] = MFMA16(a_, qf[2 * ((s0) + sl_) + k2_], o[et]); } } while (0)
    RO_STATE_MMA(RA, 0);
    __syncthreads();
    RO_STATE_MMA(RB, 2);
#undef RO_LOAD_ST
#undef RO_WRITE_ST
#undef RO_STATE_MMA
    float s1 = 0.f;
#pragma unroll
    for (int et = 0; et < 16; ++et) s1 += (o[et][0] + o[et][1]) + (o[et][2] + o[et][3]);
    s1 += __shfl_xor(s1, 16); s1 += __shfl_xor(s1, 32);
    const float mu = s1 * (1.0f / 256.0f); float s2 = 0.f;
#pragma unroll
    for (int et = 0; et < 16; ++et) { o[et] = o[et] - mu; s2 += (o[et][0] * o[et][0] + o[et][1] * o[et][1]) + (o[et][2] * o[et][2] + o[et][3] * o[et][3]); }
    s2 += __shfl_xor(s2, 16); s2 += __shfl_xor(s2, 32);
    const float rstd = 1.0f / sqrtf(s2 * (1.0f / 256.0f) + GN_EPS);
    const int row = R0 + 16 * wave + li;
    const GAS v2u* gp = (const GAS v2u*)(RG + (size_t)row * 1024 + h * 256 + 4 * g); GAS v2u* op = (GAS v2u*)(QR + (size_t)row * 2048 + 1024 + h * 256 + 4 * g);
#pragma unroll
    for (int et = 0; et < 16; ++et) { const v2u gz = gp[4 * et]; v2u w;
        w.x = cvtpk(o[et][0] * rstd * bflo(gz.x), o[et][1] * rstd * bfhi(gz.x)); w.y = cvtpk(o[et][2] * rstd * bflo(gz.y), o[et][3] * rstd * bfhi(gz.y)); op[4 * et] = w; }
    __syncthreads();
}

typedef float f32x16 __attribute__((ext_vector_type(16)));
#define MFMA32(a, b, c) __builtin_amdgcn_mfma_f32_32x32x16_bf16((a), (b), (c), 0, 0, 0)
__device__ __forceinline__ int crow32(int reg, int hh) { return (reg & 3) + 8 * (reg >> 2) + 4 * hh; }

__device__ __forceinline__ void attn_unit(LAS unsigned char* L, int u, bf16* QR, const bf16* KA, const bf16* VA, const float* sinks, int tid, int lane, int wave) {
    asm volatile("" : "+v"(tid)); lane = tid & 63;
    const int b = u >> 6, j = (u >> 1) & 31, g2 = u & 1, hq = 8 * g2 + wave;
    const int R0 = b * SEQ + 128 * j;
    LAS unsigned char* Kt = L; LAS unsigned char* Vt = L + 32768;
#pragma unroll
    for (int i = 0; i < 4; ++i) { const int cid = tid + 512 * i, kk = cid >> 3, ch = cid & 7;
        int srow; bool ok = true;
        if (kk >= 128) srow = R0 + kk - 128; else if (j > 0) srow = R0 - 128 + kk; else { ok = kk >= 112; srow = NTOK + (ok ? kk - 112 : 0); }
        const v4u kz = *(const GAS v4u*)(KA + (size_t)srow * 128 + g2 * 64 + ch * 8), vz = *(const GAS v4u*)(VA + (size_t)srow * 128 + g2 * 64 + ch * 8);
        *(LAS v4u*)(Kt + kk * 128 + ((ch ^ (kk & 7)) << 4)) = ok ? kz : (v4u){0u, 0u, 0u, 0u};
        *(LAS v4u*)(Vt + kk * 128 + (ch << 4)) = ok ? vz : (v4u){0u, 0u, 0u, 0u}; }
    __syncthreads();
    const int r = lane & 31, hh = lane >> 5, blk = (lane >> 4) & 1, q = (lane & 15) >> 2, p4 = lane & 3;
    const float sk = sinks[hq] * LOG2E;
    v4u qn[4];
    { const GAS v4u* qp = (const GAS v4u*)(QR + (size_t)(R0 + r) * 2048 + hq * 64 + 8 * hh);
#pragma unroll
      for (int ks = 0; ks < 4; ++ks) qn[ks] = qp[2 * ks]; }
#pragma unroll 1
    for (int t = 0; t < 4; ++t) {
        const int i0 = 32 * t;
        bf16x8 qf[4];
#pragma unroll
        for (int ks = 0; ks < 4; ++ks) qf[ks] = __builtin_bit_cast(bf16x8, qn[ks]);
        if (t < 3) { const GAS v4u* qp = (const GAS v4u*)(QR + (size_t)(R0 + i0 + 32 + r) * 2048 + hq * 64 + 8 * hh);
#pragma unroll
          for (int ks = 0; ks < 4; ++ks) qn[ks] = qp[2 * ks]; }
        f32x16 s[5];
#pragma unroll
        for (int x = 0; x < 5; ++x) {
            const int krow_ = 32 * (t + x) + r;
            f32x16 acc;
#pragma unroll
            for (int e = 0; e < 16; ++e) acc[e] = 0.f;
#pragma unroll
            for (int ks = 0; ks < 4; ++ks) { const bf16x8 a = *(LAS const bf16x8*)(Kt + krow_ * 128 + (((2 * ks + hh) ^ (krow_ & 7)) << 4)); acc = MFMA32(a, qf[ks], acc); }
            s[x] = acc; __builtin_amdgcn_sched_barrier(0);
        }
        float m = sk;
#pragma unroll
        for (int e = 0; e < 16; ++e) { const int cr = crow32(e, hh);
            if (!(cr > r)) s[0][e] = -1.0e30f;
            if (!(cr <= r)) s[4][e] = -1.0e30f; }
        if (j == 0) {
#pragma unroll
            for (int x = 0; x < 4; ++x) if (t + x <= 3) {
#pragma unroll
                for (int e = 0; e < 16; ++e) if (32 * (t + x) + crow32(e, hh) < 112) s[x][e] = -1.0e30f; }
        }
#pragma unroll
        for (int x = 0; x < 5; ++x)
#pragma unroll
            for (int e = 0; e < 16; ++e) m = fmaxf(m, s[x][e]);
        m = fmaxf(m, __shfl_xor(m, 32));
        float l = 0.f;
#pragma unroll
        for (int x = 0; x < 5; ++x)
#pragma unroll
            for (int e = 0; e < 16; ++e) { const float pv = exp2f(s[x][e] - m); s[x][e] = pv; l += pv; }
        l += __shfl_xor(l, 32);
        l += exp2f(sk - m);
        f32x16 o[2];
#pragma unroll
        for (int e = 0; e < 16; ++e) { o[0][e] = 0.f; o[1][e] = 0.f; }
#pragma unroll
        for (int x = 0; x < 5; ++x)
#pragma unroll
            for (int st = 0; st < 2; ++st) {
                v4u w; w.x = cvtpk_s(s[x][8 * st + 0], s[x][8 * st + 1]); w.y = cvtpk_s(s[x][8 * st + 2], s[x][8 * st + 3]); w.z = cvtpk_s(s[x][8 * st + 4], s[x][8 * st + 5]); w.w = cvtpk_s(s[x][8 * st + 6], s[x][8 * st + 7]);
                const bf16x8 pb = __builtin_bit_cast(bf16x8, w);
                const int k1 = 32 * (t + x) + 16 * st + 4 * hh + q, k2 = k1 + 8;
#pragma unroll
                for (int dc = 0; dc < 2; ++dc) {
                    const int cb = ((4 * dc + 2 * blk + (p4 >> 1)) << 4) + 8 * (p4 & 1);
                    const bf16x8 a = cat8(tr16(Vt + k1 * 128 + cb), tr16(Vt + k2 * 128 + cb));
                    o[dc] = MFMA32(a, pb, o[dc]);
                }
                __builtin_amdgcn_sched_barrier(0);
            }
        const float il = 1.0f / l;
        GAS v2u* op = (GAS v2u*)(QR + (size_t)(R0 + i0 + r) * 2048 + hq * 64 + 4 * hh);
#pragma unroll
        for (int dc = 0; dc < 2; ++dc)
#pragma unroll
            for (int g4 = 0; g4 < 4; ++g4) { v2u w; w.x = cvtpk_s(o[dc][4 * g4 + 0] * il, o[dc][4 * g4 + 1] * il); w.y = cvtpk_s(o[dc][4 * g4 + 2] * il, o[dc][4 * g4 + 3] * il); op[8 * dc + 2 * g4] = w; }
    }
    __syncthreads();
}

__device__ __forceinline__ unsigned ord_key(float f) { const unsigned u = __float_as_uint(f); return u ^ ((unsigned)((int)u >> 31) | 0x80000000u); }
__device__ __forceinline__ float ord_val(unsigned k) { return __uint_as_float(k ^ (((int)k < 0) ? 0x80000000u : 0xffffffffu)); }
__device__ __forceinline__ unsigned umed3(unsigned a, unsigned b, unsigned c) { unsigned r; asm("v_med3_u32 %0, %1, %2, %3" : "=v"(r) : "v"(a), "v"(b), "v"(c)); return r; }
#define TK_INS(arr, val) do { const unsigned v_ = (val); _Pragma("unroll") for (int j_ = 15; j_ >= 1; --j_) arr[j_] = umed3(arr[j_ - 1], arr[j_], v_); arr[0] = arr[0] > v_ ? arr[0] : v_; } while (0)
__device__ __forceinline__ void topk_unit(LAS unsigned* Lw, LAS const unsigned char* Lsk, int tt, int hd, const bf16* Q3, unsigned short* IDS, float* GATES, int lane) {
    asm volatile("" : "+v"(lane));
    const int r = lane & 31, hh = lane >> 5, t0 = tt * 32;
    float sv[2][16];
#pragma unroll
    for (int p = 0; p < 2; ++p) {
        f32x16 acc[4];
#pragma unroll
        for (int nt = 0; nt < 4; ++nt)
#pragma unroll
            for (int e = 0; e < 16; ++e) acc[nt][e] = 0.f;
        const GAS v4u* qp = (const GAS v4u*)(Q3 + (size_t)(t0 + r) * DM + hd * 256 + p * 128 + 8 * hh);
        bf16x8 bq[8];
#pragma unroll
        for (int ks = 0; ks < 8; ++ks) bq[ks] = __builtin_bit_cast(bf16x8, qp[2 * ks]);
#pragma unroll
        for (int ks = 0; ks < 8; ++ks) {
#pragma unroll
            for (int nt = 0; nt < 4; ++nt) { const bf16x8 a = *(LAS const bf16x8*)(Lsk + p * 32768 + (32 * nt + r) * 256 + (((2 * ks + hh) ^ (r & 15)) << 4)); acc[nt] = MFMA32(a, bq[ks], acc[nt]); } }
        unsigned tk[16];
#pragma unroll
        for (int j2 = 0; j2 < 16; ++j2) tk[j2] = 0u;
#pragma unroll
        for (int nt = 0; nt < 4; ++nt)
#pragma unroll
            for (int e = 0; e < 16; ++e) { const int n = 32 * nt + crow32(e, hh); TK_INS(tk, (ord_key(acc[nt][e]) & 0xffffff80u) | (unsigned)(127 - n)); }
        unsigned pk[16];
#pragma unroll
        for (int j2 = 0; j2 < 16; ++j2) pk[j2] = (unsigned)__shfl_xor((int)tk[j2], 32);
#pragma unroll
        for (int j2 = 0; j2 < 16; ++j2) TK_INS(tk, pk[j2]);
#pragma unroll
        for (int j2 = 0; j2 < 16; ++j2) { sv[p][j2] = ord_val(tk[j2] & 0xffffff80u); Lw[(p * 16 + j2) * 64 + lane] = 127u - (tk[j2] & 0x7fu); }
    }
    unsigned fk[16];
#pragma unroll
    for (int j2 = 0; j2 < 16; ++j2) fk[j2] = 0u;
#pragma unroll
    for (int i = 0; i < 16; ++i)
#pragma unroll
        for (int j2 = 0; j2 < 16; ++j2) if ((i + 1) * (j2 + 1) <= 16) TK_INS(fk, (ord_key(sv[0][i] + sv[1][j2]) & 0xffffff00u) | (unsigned)(255 - (16 * i + j2)));
    float ev[16]; int idv[16]; float den = 0.f; const float f0 = ord_val(fk[0] & 0xffffff00u);
    LDS_WAIT();
#pragma unroll
    for (int k = 0; k < 16; ++k) { const unsigned idx = 255u - (fk[k] & 0xffu); const unsigned i1 = Lw[(idx >> 4) * 64 + lane], i2 = Lw[(16 + (idx & 15u)) * 64 + lane];
        idv[k] = (int)(i1 * 128u + i2); ev[k] = __expf(ord_val(fk[k] & 0xffffff00u) - f0); den += ev[k]; }
    const float iden = 1.0f / den;
    if (hh == 0) {
        GAS v4u* ip = (GAS v4u*)(IDS + (size_t)(t0 + r) * 128 + hd * 16); GAS f32x4* gp = (GAS f32x4*)(GATES + (size_t)(t0 + r) * 128 + hd * 16);
#pragma unroll
        for (int k8 = 0; k8 < 2; ++k8) ip[k8] = (v4u){(unsigned)idv[8 * k8] | ((unsigned)idv[8 * k8 + 1] << 16), (unsigned)idv[8 * k8 + 2] | ((unsigned)idv[8 * k8 + 3] << 16), (unsigned)idv[8 * k8 + 4] | ((unsigned)idv[8 * k8 + 5] << 16), (unsigned)idv[8 * k8 + 6] | ((unsigned)idv[8 * k8 + 7] << 16)};
#pragma unroll
        for (int k4 = 0; k4 < 4; ++k4) gp[k4] = (f32x4){ev[4 * k4] * iden, ev[4 * k4 + 1] * iden, ev[4 * k4 + 2] * iden, ev[4 * k4 + 3] * iden};
    }
    LDS_WAIT();
}

__global__ void __launch_bounds__(NWAVES * 64, 2) mk_fwd(Args args) {
    extern __shared__ __attribute__((aligned(16))) unsigned char lds[];
    LAS unsigned char* L = (LAS unsigned char*)lds;
    volatile LAS unsigned* MISC = (volatile LAS unsigned*)(L + MISC_OFF);
    const int tid = threadIdx.x, lane = tid & 63, wave = __builtin_amdgcn_readfirstlane(tid >> 6);
    const int G = gridDim.x, bx = blockIdx.x;
    const int vcu = (G % 8 == 0) ? (bx % 8) * (G / 8) + bx / 8 : bx;
    unsigned char* ws = args.ws;
    gu32* ctl = (gu32*)(ws + WS_CTL);
    const float* x = args.in[0]; const float* meta = args.in[1]; const float* ln_in_g = args.in[2]; const float* ln_in_b = args.in[3];
    const float* w_in = args.in[4]; const float* sinks = args.in[5]; const float* w_out = args.in[6]; const float* ln_mix_g = args.in[7]; const float* ln_mix_b = args.in[8];
    const float* wq = args.in[9]; const float* subkeys = args.in[10]; const float* u_tab = args.in[11]; const float* v_tab = args.in[12];
    const float* ln_ffn_g = args.in[13]; const float* ln_ffn_b = args.in[14];
    float* out = args.out;
    bf16* W1T = (bf16*)(ws + WS_W1T); bf16* W2T = (bf16*)(ws + WS_W2T); bf16* W3T = (bf16*)(ws + WS_W3T);
    bf16* H0 = (bf16*)(ws + WS_H0); bf16* QR = (bf16*)(ws + WS_QR); bf16* KA = (bf16*)(ws + WS_KA); bf16* VA = (bf16*)(ws + WS_VA);
    bf16* RK = (bf16*)(ws + WS_RK); bf16* RV = (bf16*)(ws + WS_RV); bf16* RG = (bf16*)(ws + WS_RG);
    bf16* Y = (bf16*)(ws + WS_Y); bf16* H1 = (bf16*)(ws + WS_H1); bf16* Q3 = (bf16*)(ws + WS_QR);
    bf16* STB = (bf16*)(ws + WS_ST);
    unsigned short* IDS = (unsigned short*)(ws + WS_IDS); float* GATES = (float*)(ws + WS_GATES);
    bf16* SKB = (bf16*)(ws + WS_SK);
    bf16* UT = (bf16*)(ws + WS_UT); bf16* VT = (bf16*)(ws + WS_VT);

    for (int u = tid; u < (LDS_BYTES - LDSCTL_OFF) / 4; u += NWAVES * 64) ((LAS unsigned*)(L + LDSCTL_OFF))[u] = 0u;
    __syncthreads();
    XcdBarrier bar; bar.bar = (unsigned*)(ctl + CW_BAR); bar.x = xb_xcc_id(); bar.st = MISC + 8;
    if (tid == 0) MISC[10] = xb_add(&bar.bar[XB_XCNT(bar.x)], 1u);
#define GRID_BAR() xcd_barrier(bar)
    const int gw = vcu * NWAVES + wave, NGW = G * NWAVES;
    const int gt = gw * 64 + lane, NGT = NGW * 64;

    {
        int lane = threadIdx.x; asm volatile("" : "+v"(lane)); lane &= 63; const int gt = gw * 64 + lane;
        LAS float* scr = (LAS float*)(L + RING_OFF + wave * 16384);
        constexpr int I_1 = (DM / 64) * (IN_COLS / 32), I_2 = (DM / 64) * (DM / 32), I_3 = I_2;
        for (int it = gw; it < I_1 + I_2 + I_3; it += NGW) {
            int r = it;
            if (r < I_1) { p0_transpose_item<true>(w_in, DM, IN_COLS, W1T, scr, r, lane); continue; } r -= I_1;
            if (r < I_2) { p0_transpose_item<false>(w_out, DM, DM, W2T, scr, r, lane); continue; } r -= I_2;
            p0_transpose_item<false>(wq, DM, DM, W3T, scr, r, lane);
        }
        for (int m = gw; m < MROWS; m += NGW) {
            if (m < NTOK) ln_row_f32_to_bf16(x + (size_t)m * DM, ln_in_g, ln_in_b, H0 + (size_t)m * DM, lane);
            else if (m < NVALID) ln_row_f32_to_bf16(meta + (size_t)(m - NTOK) * DM, ln_in_g, ln_in_b, H0 + (size_t)m * DM, lane);
            else { GAS v4u* o = (GAS v4u*)(H0 + (size_t)m * DM) + lane;
#pragma unroll
                for (int j = 0; j < 4; ++j) o[64 * j] = (v4u){0u, 0u, 0u, 0u}; }
        }
        for (int e = gt; e < 16 * 128 * 128 / 8; e += NGT) { const GAS f32x4* src = (const GAS f32x4*)subkeys + 2 * (size_t)e; const f32x4 a = src[0], b2 = src[1];
            v4u o; o.x = pk2(a.x, a.y); o.y = pk2(a.z, a.w); o.z = pk2(b2.x, b2.y); o.w = pk2(b2.z, b2.w); ((GAS v4u*)SKB)[e] = o; }
    }
    GRID_BAR();

    {
        pg8::Gemm g{H0, W1T, MROWS, IN_COLS, DM}; pg8::StaticOrder S; S.init(MROWS, IN_COLS, G, bx);
        pg8::EpiProj E{QR, KA, VA, RK, RV, RG, QSCALE};
        pg8::gemm_phase<pg8::EpiProj, pg8::StaticOrder, true, true>(L + RING_OFF, g, S, E);
    }
    {
        constexpr int NQ = 16384 * DM / 4, CHQ = 16384, NCH = 2 * NQ / CHQ;
        for (;;) {
            int ch = 0; if (lane == 0) ch = (int)__hip_atomic_fetch_add((unsigned*)(ctl + CW_TABQ), 1u, __ATOMIC_RELAXED, __HIP_MEMORY_SCOPE_AGENT);
            ch = __builtin_amdgcn_readfirstlane(ch); if (ch >= NCH) break;
            const int which = ch >= NCH / 2; const float sc = which ? V_SCALE : U_SCALE;
            const GAS f32x4* src = (const GAS f32x4*)(which ? v_tab : u_tab) + (size_t)(ch - which * (NCH / 2)) * CHQ + lane;
            GAS unsigned char* dstb = (GAS unsigned char*)(which ? (void*)VT : (void*)UT);
            const int i4b = (ch - which * (NCH / 2)) * CHQ + lane;
#pragma unroll 1
            for (int it = 0; it < CHQ / 64; it += 8) {
                f32x4 a[8];
#pragma unroll
                for (int u8 = 0; u8 < 8; ++u8) a[u8] = src[(it + u8) * 64];
#pragma unroll
                for (int u8 = 0; u8 < 8; ++u8) { const int i4 = i4b + (it + u8) * 64; const int row = i4 >> 9, q4 = i4 & 511;
                    int w = __builtin_amdgcn_cvt_pk_fp8_f32(a[u8].x * sc, a[u8].y * sc, 0, false); w = __builtin_amdgcn_cvt_pk_fp8_f32(a[u8].z * sc, a[u8].w * sc, w, true);
                    *(GAS unsigned*)(dstb + ((size_t)(q4 >> 5) * 16384 + row) * 128 + (q4 & 31) * 4) = (unsigned)w; }
            }
        }
    }
    GRID_BAR();

    for (int u = bx; u < 256; u += G) attn_unit(L + RING_OFF, u, QR, KA, VA, sinks, tid, lane, wave);

    for (int u = bx; u < 256; u += G) scan_unit(L + RING_OFF, u, RK, RV, STB, tid, lane, wave);
    GRID_BAR();

    for (int u = bx; u < 512; u += G) retout_unit(L + RING_OFF, u, QR, RK, RV, RG, STB, tid, lane, wave);
    GRID_BAR();

    {
        pg8::Gemm g{QR, W2T, NTOK, DM, DM}; pg8::StaticOrder S; S.init(NTOK, DM, G, bx);
        pg8::EpiGen<1> E{Y, DM, H0, ALPHA, nullptr, nullptr, nullptr, nullptr, nullptr, nullptr};
        pg8::gemm_phase<pg8::EpiGen<1>, pg8::StaticOrder, true, true>(L + RING_OFF, g, S, E);
    }
    GRID_BAR();

    for (int m = gw; m < NTOK; m += NGW) ln_row_bf16_to_bf16(Y + (size_t)m * DM, ln_mix_g, ln_mix_b, H1 + (size_t)m * DM, lane);
    GRID_BAR();

    {
        pg8::Gemm g{H1, W3T, NTOK, DM, DM}; pg8::StaticOrder S; S.init(NTOK, DM, G, bx);
        pg8::EpiGen<2> E{Q3, DM, nullptr, 0.f, nullptr, nullptr, nullptr, nullptr, nullptr, nullptr};
        pg8::gemm_phase<pg8::EpiGen<2>, pg8::StaticOrder, true, true>(L + RING_OFF, g, S, E);
    }
    GRID_BAR();

    const bool g8 = (G & 7) == 0; const int nbh = g8 ? (G >> 3) : G, hb = g8 ? (bx >> 3) : bx;
    for (int hd = g8 ? (bx & 7) : 0; hd < 8; hd += g8 ? 8 : 1) {
        __syncthreads();
#pragma unroll
        for (int i = 0; i < 8; ++i) { const int cid = tid + 512 * i, p = cid >> 11, n = (cid >> 4) & 127, ch = cid & 15;
            *(LAS v4u*)(L + RING_OFF + p * 32768 + n * 256 + ((ch ^ (n & 15)) << 4)) = *(const GAS v4u*)(SKB + ((size_t)((hd * 2 + p) * 128 + n)) * 128 + ch * 8); }
        __syncthreads();
        for (int tt = hb * NWAVES + wave; tt < NTOK / 32; tt += nbh * NWAVES) topk_unit((LAS unsigned*)(L + RING_OFF + 65536 + wave * 8192), L + RING_OFF, tt, hd, Q3, IDS, GATES, lane);
    }
    __syncthreads();
    GRID_BAR();

    int nx = 0, xr = 0, nloc = 1;
    { unsigned* bw = (unsigned*)(ctl + CW_BAR);
#pragma unroll
      for (unsigned j2 = 0; j2 < 16; ++j2) { const unsigned cnt = xb_ld(&bw[XB_XCNT(j2)]); nx += cnt > 0u; xr += (j2 < bar.x && cnt > 0u); if (j2 == bar.x) nloc = (int)cnt; }
      nx = __builtin_amdgcn_readfirstlane(nx); xr = __builtin_amdgcn_readfirstlane(xr); nloc = __builtin_amdgcn_readfirstlane(nloc); if (nx < 1) nx = 1; if (nloc < 1) nloc = 1; }
    const int lrank = __builtin_amdgcn_readfirstlane((int)MISC[10]);
    const int wv = lrank * NWAVES + wave, nwv = nloc * NWAVES;
    float* DOTX = (float*)(ws + WS_RK);
    bf16* CB = (bf16*)(ws + WS_KA);
    bf16* YB = (bf16*)(ws + WS_H0);
    {
        int tl = tid; asm volatile("" : "+v"(tl)); const int ln = tl & 63, k = ln >> 3, c8 = ln & 7;
        const unsigned char* UT8 = (const unsigned char*)UT;
        for (int s = xr; s < NSL; s += nx) {
            const unsigned char* Us = UT8 + (size_t)s * 16384 * 128;
            const bool first = (s == xr);
            v4u nid[2][2];
#pragma unroll
            for (int z = 0; z < 2; ++z) { const int tz = wv + z * nwv; const int tc = tz < NTOK ? tz : wv; const GAS v4u* ip = (const GAS v4u*)(IDS + (size_t)tc * 128 + 16 * k);
#pragma unroll
                for (int i = 0; i < 2; ++i) nid[z][i] = ip[i]; }
#pragma unroll 1
            for (int t = wv; t < NTOK; t += 2 * nwv) {
                const bool vB = (t + nwv) < NTOK; const int tt[2] = {t, vB ? t + nwv : t};
                v4u ub[2][16]; v4u hs[2][2]; f32x2 old[2];
#pragma unroll
                for (int z = 0; z < 2; ++z) {
#pragma unroll
                    for (int i = 0; i < 16; ++i) { const int pe = 2 * (i & 7) + (i >> 3); const unsigned eid = (nid[z][pe >> 3][(pe >> 1) & 3] >> (16 * (pe & 1))) & 0xffffu; ub[z][i] = *(const GAS v4u*)(Us + (size_t)eid * 128 + 16 * c8); }
                    { const GAS v4u* hp = (const GAS v4u*)(H1 + (size_t)tt[z] * DM + 128 * s + 16 * c8); hs[z][0] = hp[0]; hs[z][1] = hp[1]; } }
#pragma unroll
                for (int z = 0; z < 2; ++z) old[z] = first ? (f32x2){0.f, 0.f} : *(const GAS f32x2*)(DOTX + ((size_t)xr * NTOK + tt[z]) * 128 + 2 * ln);
#pragma unroll
                for (int z = 0; z < 2; ++z) { const int tz = t + (2 + z) * nwv; const int tc = tz < NTOK ? tz : t; const GAS v4u* ip = (const GAS v4u*)(IDS + (size_t)tc * 128 + 16 * k);
#pragma unroll
                    for (int i = 0; i < 2; ++i) nid[z][i] = ip[i]; }
#pragma unroll
                for (int z = 0; z < 2; ++z) {
                    float p[16]; f32x2 hp2[8];
#pragma unroll
                    for (int i = 0; i < 2; ++i)
#pragma unroll
                        for (int c4 = 0; c4 < 4; ++c4) hp2[4 * i + c4] = (f32x2){bflo(hs[z][i][c4]), bfhi(hs[z][i][c4])};
#pragma unroll
                    for (int i = 0; i < 16; ++i) { f32x2 d2 = {0.f, 0.f};
#pragma unroll
                        for (int dw = 0; dw < 4; ++dw) { const f32x2 fl = __builtin_amdgcn_cvt_pk_f32_fp8((int)ub[z][i][dw], false), fh = __builtin_amdgcn_cvt_pk_f32_fp8((int)ub[z][i][dw], true);
                            d2 = __builtin_elementwise_fma(fl, hp2[2 * dw], d2); d2 = __builtin_elementwise_fma(fh, hp2[2 * dw + 1], d2); }
                        p[i] = d2.x + d2.y; }
                    const bool b0 = (c8 & 1) != 0, b1 = (c8 & 2) != 0, b2 = (c8 & 4) != 0;
                    float r1[8], r2[4], q0, q1;
#pragma unroll
                    for (int m = 0; m < 8; ++m) { const float keep = b0 ? p[2 * m + 1] : p[2 * m], give = b0 ? p[2 * m] : p[2 * m + 1]; r1[m] = keep + DPPF(give, 0xB1); }
#pragma unroll
                    for (int m = 0; m < 4; ++m) { const float keep = b1 ? r1[2 * m + 1] : r1[2 * m], give = b1 ? r1[2 * m] : r1[2 * m + 1]; r2[m] = keep + DPPF(give, 0x4E); }
                    { const float keep = b2 ? r2[1] : r2[0], give = b2 ? r2[0] : r2[1]; const float gl = DPPF(give, 0x104), gr = DPPF(give, 0x114); q0 = keep + (b2 ? gr : gl); }
                    { const float keep = b2 ? r2[3] : r2[2], give = b2 ? r2[2] : r2[3]; const float gl = DPPF(give, 0x104), gr = DPPF(give, 0x114); q1 = keep + (b2 ? gr : gl); }
                    if (z == 0 || vB) *(GAS f32x2*)(DOTX + ((size_t)xr * NTOK + tt[z]) * 128 + 2 * ln) = (f32x2){q0 + old[z].x, q1 + old[z].y};
                }
            }
        }
    }
    GRID_BAR();
    for (int idx = gt; idx < NTOK * 128; idx += NGT) { float d = 0.f; for (int xx = 0; xx < nx; ++xx) d += DOTX[(size_t)xx * NTOK * 128 + idx]; CB[idx] = (bf16)f2bf((1.0f / V_SCALE) * GATES[idx] * gelu_erf(d * (1.0f / U_SCALE))); }
    GRID_BAR();
    {
        int tl = tid; asm volatile("" : "+v"(tl)); const int ln = tl & 63, k = ln >> 3, c8 = ln & 7;
        const unsigned char* VT8 = (const unsigned char*)VT;
        for (int s = xr; s < NSL; s += nx) {
            const unsigned char* Vs = VT8 + (size_t)s * 16384 * 128;
            v4u nid[2][2];
#pragma unroll
            for (int z = 0; z < 2; ++z) { const int tz = wv + z * nwv; const int tc = tz < NTOK ? tz : wv; const GAS v4u* ip = (const GAS v4u*)(IDS + (size_t)tc * 128 + 16 * k);
#pragma unroll
                for (int i = 0; i < 2; ++i) nid[z][i] = ip[i]; }
#pragma unroll 1
            for (int t = wv; t < NTOK; t += 2 * nwv) {
                const bool vB = (t + nwv) < NTOK; const int tt[2] = {t, vB ? t + nwv : t};
                v4u vb[2][16]; v4u cf[2][2]; unsigned hs[2];
#pragma unroll
                for (int z = 0; z < 2; ++z) {
#pragma unroll
                    for (int i = 0; i < 16; ++i) { const unsigned eid = (nid[z][i >> 3][(i >> 1) & 3] >> (16 * (i & 1))) & 0xffffu; vb[z][i] = *(const GAS v4u*)(Vs + (size_t)eid * 128 + 16 * c8); } }
#pragma unroll
                for (int z = 0; z < 2; ++z) { hs[z] = *(const GAS unsigned*)(H1 + (size_t)tt[z] * DM + 128 * s + 16 * c8 + 2 * k);
                    const GAS v4u* cp = (const GAS v4u*)(CB + (size_t)tt[z] * 128 + 16 * k); cf[z][0] = cp[0]; cf[z][1] = cp[1]; }
#pragma unroll
                for (int z = 0; z < 2; ++z) { const int tz = t + (2 + z) * nwv; const int tc = tz < NTOK ? tz : t; const GAS v4u* ip = (const GAS v4u*)(IDS + (size_t)tc * 128 + 16 * k);
#pragma unroll
                    for (int i = 0; i < 2; ++i) nid[z][i] = ip[i]; }
#pragma unroll
                for (int z = 0; z < 2; ++z) {
                    f32x2 accp[8];
#pragma unroll
                    for (int q2 = 0; q2 < 8; ++q2) accp[q2] = (f32x2){0.f, 0.f};
#pragma unroll
                    for (int i = 0; i < 16; ++i) { const unsigned cw = cf[z][i >> 3][(i >> 1) & 3]; const float c = (i & 1) ? bfhi(cw) : bflo(cw); const f32x2 c2 = {c, c};
#pragma unroll
                        for (int dw = 0; dw < 4; ++dw) { const f32x2 fl = __builtin_amdgcn_cvt_pk_f32_fp8((int)vb[z][i][dw], false), fh = __builtin_amdgcn_cvt_pk_f32_fp8((int)vb[z][i][dw], true);
                            accp[2 * dw] = __builtin_elementwise_fma(fl, c2, accp[2 * dw]); accp[2 * dw + 1] = __builtin_elementwise_fma(fh, c2, accp[2 * dw + 1]); } }
                    const bool kb0 = (k & 1) != 0, kb1 = (k & 2) != 0, kb2 = (k & 4) != 0;
                    f32x2 rA[4], rB[2], rC;
#pragma unroll
                    for (int m = 0; m < 4; ++m) { const f32x2 keep = kb0 ? accp[2 * m + 1] : accp[2 * m], give = kb0 ? accp[2 * m] : accp[2 * m + 1];
                        rA[m] = keep + (f32x2){DPPF(give.x, 0x128), DPPF(give.y, 0x128)}; }
#pragma unroll
                    for (int m = 0; m < 2; ++m) { const f32x2 keep = kb1 ? rA[2 * m + 1] : rA[2 * m], give = kb1 ? rA[2 * m] : rA[2 * m + 1];
                        const auto sx = __builtin_amdgcn_permlane16_swap(__float_as_uint(give.x), __float_as_uint(give.x), false, false), sy = __builtin_amdgcn_permlane16_swap(__float_as_uint(give.y), __float_as_uint(give.y), false, false);
                        rB[m] = keep + (f32x2){__uint_as_float(kb1 ? sx[0] : sx[1]), __uint_as_float(kb1 ? sy[0] : sy[1])}; }
                    { const f32x2 keep = kb2 ? rB[1] : rB[0], give = kb2 ? rB[0] : rB[1];
                        const auto sx = __builtin_amdgcn_permlane32_swap(__float_as_uint(give.x), __float_as_uint(give.x), false, false), sy = __builtin_amdgcn_permlane32_swap(__float_as_uint(give.y), __float_as_uint(give.y), false, false);
                        rC = keep + (f32x2){__uint_as_float(kb2 ? sx[0] : sx[1]), __uint_as_float(kb2 ? sy[0] : sy[1])}; }
                    if (z == 0 || vB) *(GAS unsigned*)(YB + (size_t)tt[z] * DM + 128 * s + 16 * c8 + 2 * k) = cvtpk_s(rC.x + ALPHA * bflo(hs[z]), rC.y + ALPHA * bfhi(hs[z]));
                }
            }
        }
    }
    GRID_BAR();
    for (int m = gw; m < NTOK; m += NGW) {
        const GAS v4u* xr4 = (const GAS v4u*)(YB + (size_t)m * DM) + lane;
        float v[32]; float sm = 0.f;
#pragma unroll
        for (int j2 = 0; j2 < 4; ++j2) { const v4u w = xr4[64 * j2];
            v[8 * j2 + 0] = bflo(w.x); v[8 * j2 + 1] = bfhi(w.x); v[8 * j2 + 2] = bflo(w.y); v[8 * j2 + 3] = bfhi(w.y); v[8 * j2 + 4] = bflo(w.z); v[8 * j2 + 5] = bfhi(w.z); v[8 * j2 + 6] = bflo(w.w); v[8 * j2 + 7] = bfhi(w.w); }
#pragma unroll
        for (int i = 0; i < 32; ++i) sm += v[i];
        const float mean = wave_sum(sm) * (1.f / DM); float s2 = 0.f;
#pragma unroll
        for (int i = 0; i < 32; ++i) { v[i] -= mean; s2 += v[i] * v[i]; }
        const float rstd = 1.f / sqrtf(wave_sum(s2) * (1.f / DM) + LN_EPS);
#pragma unroll
        for (int j2 = 0; j2 < 4; ++j2) {
            const GAS f32x4* gp = (const GAS f32x4*)ln_ffn_g + 2 * (lane + 64 * j2); const GAS f32x4* bp = (const GAS f32x4*)ln_ffn_b + 2 * (lane + 64 * j2);
            const f32x4 g0 = gp[0], g1 = gp[1], b0 = bp[0], b1 = bp[1];
            GAS f32x4* op = (GAS f32x4*)(out + (size_t)m * DM) + 2 * (lane + 64 * j2);
            op[0] = (f32x4){v[8 * j2 + 0] * rstd * g0.x + b0.x, v[8 * j2 + 1] * rstd * g0.y + b0.y, v[8 * j2 + 2] * rstd * g0.z + b0.z, v[8 * j2 + 3] * rstd * g0.w + b0.w};
            op[1] = (f32x4){v[8 * j2 + 4] * rstd * g1.x + b1.x, v[8 * j2 + 5] * rstd * g1.y + b1.y, v[8 * j2 + 6] * rstd * g1.z + b1.z, v[8 * j2 + 7] * rstd * g1.w + b1.w}; }
    }
}

extern "C" void kernel_launch(void* const* d_in, const int* in_sizes, int n_in, void* d_out, int out_size, void* d_ws, size_t ws_size, hipStream_t stream) {
    static int grid = 0;
    if (grid == 0) {
        if (n_in != 15 || out_size != NTOK * DM || ws_size < WS_END) { fprintf(stderr, "kernel_launch: unexpected shapes (n_in %d out %d ws %zu)\n", n_in, out_size, ws_size); grid = -1; return; }
        int dev = 0, cus = 0, per_cu = 0;
        if (hipGetDevice(&dev) != hipSuccess || hipDeviceGetAttribute(&cus, hipDeviceAttributeMultiprocessorCount, dev) != hipSuccess) { grid = -1; return; }
        if (hipFuncSetAttribute((const void*)mk_fwd, hipFuncAttributeMaxDynamicSharedMemorySize, LDS_BYTES) != hipSuccess) { fprintf(stderr, "kernel_launch: hipFuncSetAttribute failed\n"); grid = -1; return; }
        if (hipOccupancyMaxActiveBlocksPerMultiprocessor(&per_cu, (const void*)mk_fwd, NWAVES * 64, LDS_BYTES) != hipSuccess || per_cu < 1) { fprintf(stderr, "kernel_launch: occupancy query says %d\n", per_cu); }
        (void)hipGetLastError();
        grid = cus;
    }
    if (grid < 0) return;
    if (hipMemsetAsync((char*)d_ws + WS_CTL, 0, CTL_ZERO_BYTES, stream) != hipSuccess) return;
    Args a{};
    for (int i = 0; i < 15; ++i) a.in[i] = (const float*)d_in[i];
    a.out = (float*)d_out; a.ws = (unsigned char*)d_ws;
    hipLaunchKernelGGL(mk_fwd, dim3(grid), dim3(NWAVES * 64), LDS_BYTES, stream, a);
}
```

```cpp
#include <hip/hip_runtime.h>
#include <cstdio>
#include <cstdint>
#include <cmath>
namespace pg8 {
#define PG8_LAS __attribute__((address_space(3)))
typedef unsigned short bf16_t;
typedef short bf16x8 __attribute__((ext_vector_type(8)));
typedef float f32x4 __attribute__((ext_vector_type(4)));
typedef unsigned u32x4 __attribute__((ext_vector_type(4)));
constexpr int BM = 256, BK = 64, HALF = 128, HTB = HALF * BK * 2  , STAGE_BYTES = 8 * HTB, NXCD = 8, WGM = 8;

__host__ __device__ __forceinline__ int lds_byte(int r, int c) { const int st = (r >> 4) * 2 + (c >> 5), rr = r & 15, cc = c & 31, ob = rr * 64 + cc * 2; return st * 1024 + (ob ^ (((ob >> 9) & 1) << 5)); }
__host__ __device__ __forceinline__ void stage_rc(int b, int& R, int& C) { const int st = b / 1024, sb = b % 1024, swz = sb ^ (((sb >> 9) & 1) << 5); R = (st >> 1) * 16 + swz / 64; C = (st & 1) * 32 + (swz % 64) / 2; }
__host__ __device__ __forceinline__ int perm32(int rho) { const int n = rho >> 4, i = rho & 15; return 8 * (i >> 2) + 4 * n + (i & 3); }

struct Unit { int pm, pn; };
struct Gemm { const bf16_t* A; const bf16_t* Bt; int M, N, K; };

struct StaticOrder {
    int nM, nN, nwg, G, c;
    __host__ __device__ void init(int M, int N, int G_, int c_) { nM = M / BM; nN = N / BM; nwg = nM * nN; G = G_; c = c_; }
    __host__ __device__ bool next(int i, Unit& u) const {
        const long L = (long)i * G + c; if (L >= nwg) return false;
        int wgid = (int)L; { const int q = nwg / NXCD, r = nwg % NXCD, xcd = wgid % NXCD, off = wgid / NXCD; wgid = (xcd < r ? xcd * (q + 1) : r * (q + 1) + (xcd - r) * q) + off; }
        const int nig = WGM * nN, gid = wgid / nig, fm = gid * WGM, gsz = (nM - fm) < WGM ? (nM - fm) : WGM;
        u.pm = fm + ((wgid % nig) % gsz); u.pn = (wgid % nig) / gsz; return true;
    }
    __device__ __forceinline__ void a_ready(const Unit&) const {}
    __device__ __forceinline__ void done(const Unit&) const {}
};

__device__ __forceinline__ unsigned cvt_pk_bf16(float lo, float hi) { unsigned r; asm volatile("v_cvt_pk_bf16_f32 %0, %1, %2" : "=v"(r) : "v"(lo), "v"(hi)); return r; }
typedef float f32x2 __attribute__((ext_vector_type(2)));

template <int MODE> struct EpiGen {
    static constexpr bool PERM = true, AFTER_DRAIN = false;
    bf16_t* O; int ldc; const bf16_t* R; float alpha;
    bf16_t *QR, *KA, *VA, *RK, *RV, *RG;
    __device__ __forceinline__ void operator()(const f32x4 (&acc)[2][2][4][2], const Unit& u, int wr, int wc, int fr, int fq) const {
        const int row0 = u.pm * BM + wr * 64 + fr;
#pragma unroll
        for (int bj = 0; bj < 2; ++bj) {
            const int col = u.pn * BM + bj * HALF + wc * 32 + 8 * fq;
            bf16_t* base = O; int ld = ldc; int cc = col;
            if (MODE == 0) {
                if (col < 1024)      { base = QR; ld = 2048; cc = col; }
                else if (col < 1152) { base = KA; ld = 128;  cc = col - 1024; }
                else if (col < 1280) { base = VA; ld = 128;  cc = col - 1152; }
                else if (col < 2304) { base = QR; ld = 2048; cc = col - 1280 + 1024; }
                else if (col < 3328) { base = RK; ld = 1024; cc = col - 2304; }
                else if (col < 4352) { base = RV; ld = 1024; cc = col - 3328; }
                else                 { base = RG; ld = 1024; cc = col - 4352; }
            }
#pragma unroll
            for (int ai = 0; ai < 2; ++ai)
#pragma unroll
                for (int m = 0; m < 4; ++m) {
                    const int row = row0 + ai * HALF + m * 16;
                    f32x4 v0 = acc[ai][bj][m][0], v1 = acc[ai][bj][m][1];
                    if (MODE == 1) {
                        const u32x4 r = *(const u32x4*)(R + (size_t)row * ldc + col);
                        v0[0] += alpha * __uint_as_float(r.x << 16); v0[1] += alpha * __uint_as_float(r.x & 0xffff0000u);
                        v0[2] += alpha * __uint_as_float(r.y << 16); v0[3] += alpha * __uint_as_float(r.y & 0xffff0000u);
                        v1[0] += alpha * __uint_as_float(r.z << 16); v1[1] += alpha * __uint_as_float(r.z & 0xffff0000u);
                        v1[2] += alpha * __uint_as_float(r.w << 16); v1[3] += alpha * __uint_as_float(r.w & 0xffff0000u);
                    }
                    u32x4 w; w.x = cvt_pk_bf16(v0[0], v0[1]); w.y = cvt_pk_bf16(v0[2], v0[3]); w.z = cvt_pk_bf16(v1[0], v1[1]); w.w = cvt_pk_bf16(v1[2], v1[3]);
                    *(u32x4*)(base + (size_t)row * ld + cc) = w;
                }
        }
    }
};

struct EpiProj {
    static constexpr bool PERM = true, AFTER_DRAIN = false;
    bf16_t *QR, *KA, *VA, *RK, *RV, *RG; float qscale;
    __device__ __forceinline__ void operator()(const f32x4 (&acc)[2][2][4][2], const Unit& u, int wr, int wc, int fr, int fq) const {
        const int pn = u.pn, row0 = u.pm * BM + wr * 64 + fr, c0 = wc * 32 + 8 * fq;
        const bool rope = (pn <= 3) || (pn == 4 && wc < 2) || (pn >= 5 && pn <= 12);
        if (rope) {
            const bool ret = pn >= 5; const int h = ret ? ((pn - 5) & 3) : 0;
            const float lg = __builtin_amdgcn_logf(1.0f - __builtin_amdgcn_exp2f(-5.0f - (float)h));
            float invrev[8];
#pragma unroll
            for (int i8 = 0; i8 < 8; ++i8) { const float ii = (float)((ret ? c0 : 8 * fq) + i8); invrev[i8] = 0.15915494309189535f * __builtin_amdgcn_exp2f(-ii * (ret ? 0.10381025296523008f : 0.4152410118609203f)); }
            bf16_t* base; int ld, cA, cB;
            if (pn <= 3)      { base = QR; ld = 2048; cA = pn * 256 + 64 * wc + 8 * fq; cB = cA + 32; }
            else if (pn == 4) { base = KA; ld = 128;  cA = 64 * wc + 8 * fq; cB = cA + 32; }
            else if (pn <= 8) { base = QR; ld = 2048; cA = 1024 + 256 * h + c0; cB = cA + 128; }
            else              { base = RK; ld = 1024; cA = 256 * h + c0; cB = cA + 128; }
#pragma unroll
            for (int ai = 0; ai < 2; ++ai)
#pragma unroll
                for (int m = 0; m < 4; ++m) {
                    const int row = row0 + ai * HALF + m * 16;
                    int pos, ipos;
                    if (row < 16384) { const int s = row & 4095; pos = 16 + s; ipos = s & 127; } else { int j = row - 16384; if (j > 15) j = 15; pos = j; ipos = 112 + j; }
                    float sc = qscale;
                    if (pn == 4) sc = 1.0f; else if (pn >= 9) sc = 0.0625f * __builtin_amdgcn_exp2f(-(float)(ipos + 1) * lg); else if (pn >= 5) sc = __builtin_amdgcn_exp2f((float)(ipos + 1) * lg);
                    const float pf = (float)pos;
                    float cs[8], sn[8];
#pragma unroll
                    for (int i8 = 0; i8 < 8; ++i8) { const float rev = __builtin_amdgcn_fractf(pf * invrev[i8]); cs[i8] = __builtin_amdgcn_cosf(rev); sn[i8] = __builtin_amdgcn_sinf(rev); }
                    const f32x4 a0 = acc[ai][0][m][0], a1 = acc[ai][0][m][1], b0 = acc[ai][1][m][0], b1 = acc[ai][1][m][1];
                    u32x4 wA, wB;
                    wA.x = cvt_pk_bf16((a0[0] * cs[0] - b0[0] * sn[0]) * sc, (a0[1] * cs[1] - b0[1] * sn[1]) * sc); wA.y = cvt_pk_bf16((a0[2] * cs[2] - b0[2] * sn[2]) * sc, (a0[3] * cs[3] - b0[3] * sn[3]) * sc);
                    wA.z = cvt_pk_bf16((a1[0] * cs[4] - b1[0] * sn[4]) * sc, (a1[1] * cs[5] - b1[1] * sn[5]) * sc); wA.w = cvt_pk_bf16((a1[2] * cs[6] - b1[2] * sn[6]) * sc, (a1[3] * cs[7] - b1[3] * sn[7]) * sc);
                    wB.x = cvt_pk_bf16((b0[0] * cs[0] + a0[0] * sn[0]) * sc, (b0[1] * cs[1] + a0[1] * sn[1]) * sc); wB.y = cvt_pk_bf16((b0[2] * cs[2] + a0[2] * sn[2]) * sc, (b0[3] * cs[3] + a0[3] * sn[3]) * sc);
                    wB.z = cvt_pk_bf16((b1[0] * cs[4] + a1[0] * sn[4]) * sc, (b1[1] * cs[5] + a1[1] * sn[5]) * sc); wB.w = cvt_pk_bf16((b1[2] * cs[6] + a1[2] * sn[6]) * sc, (b1[3] * cs[7] + a1[3] * sn[7]) * sc);
                    *(u32x4*)(base + (size_t)row * ld + cA) = wA; *(u32x4*)(base + (size_t)row * ld + cB) = wB;
                }
        } else {
            const bool silu = pn >= 17;
#pragma unroll
            for (int bj = 0; bj < 2; ++bj) {
                bf16_t* base; int ld, cc;
                if (pn == 4)       { base = VA; ld = 128;  cc = 64 * bj + 32 * (wc - 2) + 8 * fq; }
                else if (pn <= 16) { base = RV; ld = 1024; cc = 256 * (pn - 13) + 128 * bj + c0; }
                else               { base = RG; ld = 1024; cc = 256 * (pn - 17) + 128 * bj + c0; }
#pragma unroll
                for (int ai = 0; ai < 2; ++ai)
#pragma unroll
                    for (int m = 0; m < 4; ++m) {
                        const int row = row0 + ai * HALF + m * 16;
                        f32x4 v0 = acc[ai][bj][m][0], v1 = acc[ai][bj][m][1];
                        if (silu) {
#pragma unroll
                            for (int e = 0; e < 4; ++e) { v0[e] = v0[e] * __builtin_amdgcn_rcpf(1.0f + __builtin_amdgcn_exp2f(-1.4426950408889634f * v0[e])); v1[e] = v1[e] * __builtin_amdgcn_rcpf(1.0f + __builtin_amdgcn_exp2f(-1.4426950408889634f * v1[e])); } }
                        u32x4 w; w.x = cvt_pk_bf16(v0[0], v0[1]); w.y = cvt_pk_bf16(v0[2], v0[3]); w.z = cvt_pk_bf16(v1[0], v1[1]); w.w = cvt_pk_bf16(v1[2], v1[3]);
                        *(u32x4*)(base + (size_t)row * ld + cc) = w;
                    }
            }
        }
    }
};
template <class Epi, class Sched, bool ALIGN_EPI = false, bool SP2 = false>
__device__ __forceinline__ void gemm_phase(PG8_LAS unsigned char* lds, const Gemm g, const Sched& S, const Epi& E) {
    const int tid = threadIdx.x, wid = __builtin_amdgcn_readfirstlane(tid >> 6), lane = tid & 63, wr = wid >> 2, wc = wid & 3, fr = lane & 15, fq = lane >> 4;
    const int K = g.K, nt = K / BK;
    unsigned voffA[2], voffB[2];
#pragma unroll
    for (int i = 0; i < 2; ++i) { int R, C; stage_rc(tid * 16 + i * 8192, R, C); const int Rb = Epi::PERM ? ((R & ~31) + perm32(R & 31)) : R;
        voffA[i] = (unsigned)(R * K + C) * 2u; voffB[i] = (unsigned)(Rb * K + C) * 2u; }
    const size_t kstep = (size_t)(BK * 2);
    const size_t hstep = (size_t)HALF * K * 2;
    const size_t tstep = 2 * hstep;
    const unsigned ldsw = (unsigned)wid * 1024u;
    const int aoff = lds_byte(wr * 64 + fr, fq * 8), boff = lds_byte(wc * 32 + fr, fq * 8);
#define PG8_SA(b, h) (((b) * 2 + (h)) * HTB)
#define PG8_SB(b, h) ((4 + (b) * 2 + (h)) * HTB)
#define PG8_STAGE(bufoff, gbase, voff) do { _Pragma("unroll") for (int _i = 0; _i < 2; ++_i) \
        __builtin_amdgcn_global_load_lds((const unsigned*)((const char*)(gbase) + (voff)[_i]), (PG8_LAS unsigned*)(lds + (bufoff) + ldsw + _i * 8192), 16, 0, 0); } while (0)
#define PG8_LDA(dst, b, h) do { _Pragma("unroll") for (int m = 0; m < 4; ++m) _Pragma("unroll") for (int k = 0; k < 2; ++k) dst[m][k] = *(const PG8_LAS bf16x8*)(lds + PG8_SA(b, h) + aoff + m * 2048 + k * 1024); } while (0)
#define PG8_LDB(dst, b, h) do { _Pragma("unroll") for (int n = 0; n < 2; ++n) _Pragma("unroll") for (int k = 0; k < 2; ++k) dst[n][k] = *(const PG8_LAS bf16x8*)(lds + PG8_SB(b, h) + boff + n * 2048 + k * 1024); } while (0)
#define PG8_MMA(ai, bj, At, Bt) do { __builtin_amdgcn_s_setprio(1); _Pragma("unroll") for (int m = 0; m < 4; ++m) _Pragma("unroll") for (int n = 0; n < 2; ++n) _Pragma("unroll") for (int k = 0; k < 2; ++k) \
        acc[ai][bj][m][n] = __builtin_amdgcn_mfma_f32_16x16x32_bf16(Bt[n][k], At[m][k], acc[ai][bj][m][n], 0, 0, 0); __builtin_amdgcn_s_setprio(0); } while (0)
#define PG8_WAIT_V(n) asm volatile("s_waitcnt vmcnt(" #n ")" ::: "memory")
#define PG8_WAIT_L(n) asm volatile("s_waitcnt lgkmcnt(" #n ")" ::: "memory")
#define PG8_BAR __builtin_amdgcn_s_barrier()
#define PG8_SCHED __builtin_amdgcn_sched_barrier(0)
    Unit cur, nxt; int ui = 0;
    if (!S.next(0, cur)) return;
    f32x4 acc[2][2][4][2];
#pragma unroll
    for (int a = 0; a < 2; ++a)
#pragma unroll
        for (int b = 0; b < 2; ++b)
#pragma unroll
            for (int m = 0; m < 4; ++m)
#pragma unroll
                for (int n = 0; n < 2; ++n) acc[a][b][m][n] = (f32x4){0.f, 0.f, 0.f, 0.f};
    bf16x8 At[4][2], B0[2][2], B1[2][2];
    const char* cA = (const char*)g.A + (size_t)cur.pm * tstep; const char* cB = (const char*)g.Bt + (size_t)cur.pn * tstep;
    S.a_ready(cur);
    if constexpr (SP2) {
        PG8_STAGE(PG8_SB(0, 0), cB, voffB); PG8_STAGE(PG8_SB(0, 1), cB + hstep, voffB); PG8_STAGE(PG8_SA(0, 0), cA, voffA); PG8_STAGE(PG8_SA(0, 1), cA + hstep, voffA);
        if (wr == 1) PG8_BAR;
        PG8_WAIT_V(2); PG8_BAR;
        PG8_STAGE(PG8_SB(1, 0), cB + kstep, voffB); PG8_STAGE(PG8_SA(1, 0), cA + kstep, voffA); PG8_STAGE(PG8_SB(1, 1), cB + hstep + kstep, voffB);
        PG8_WAIT_V(6); PG8_BAR;
    } else {
        PG8_STAGE(PG8_SB(0, 0), cB, voffB); PG8_STAGE(PG8_SA(0, 0), cA, voffA); PG8_STAGE(PG8_SB(0, 1), cB + hstep, voffB); PG8_STAGE(PG8_SA(0, 1), cA + hstep, voffA);
        if (wr == 1) PG8_BAR;
        PG8_WAIT_V(4); PG8_BAR;
        PG8_STAGE(PG8_SB(1, 0), cB + kstep, voffB); PG8_STAGE(PG8_SA(1, 0), cA + kstep, voffA); PG8_STAGE(PG8_SB(1, 1), cB + hstep + kstep, voffB);
        PG8_WAIT_V(6); PG8_BAR;
    }
    for (;;) {
        const bool has_next = S.next(ui + 1, nxt);
        const char* nA = has_next ? (const char*)g.A + (size_t)nxt.pm * tstep : cA; const char* nB = has_next ? (const char*)g.Bt + (size_t)nxt.pn * tstep : cB;
        for (int t = 0; t < nt; t += 2) {
            const bool last = (t == nt - 2);
            const char* a1 = cA + (size_t)(t + 1) * kstep;
            const char* a2 = last ? nA : cA + (size_t)(t + 2) * kstep; const char* b2 = last ? nB : cB + (size_t)(t + 2) * kstep;
            const char* a3 = a2 + kstep; const char* b3 = b2 + kstep;
            if (last && has_next) S.a_ready(nxt);
            if constexpr (SP2) {
            PG8_LDB(B0, 0, 0); PG8_LDB(B1, 0, 1); PG8_SCHED; PG8_LDA(At, 0, 0); PG8_STAGE(PG8_SA(1, 1), a1 + hstep, voffA);
            PG8_WAIT_V(8); PG8_WAIT_L(0); PG8_BAR; PG8_MMA(0, 0, At, B0); PG8_MMA(0, 1, At, B1); PG8_BAR; PG8_SCHED;
            PG8_LDA(At, 0, 1); PG8_STAGE(PG8_SB(0, 0), b2, voffB); PG8_STAGE(PG8_SB(0, 1), b2 + hstep, voffB); PG8_STAGE(PG8_SA(0, 0), a2, voffA);
            PG8_WAIT_V(8); PG8_WAIT_L(0); PG8_BAR; PG8_MMA(1, 0, At, B0); PG8_MMA(1, 1, At, B1); PG8_BAR; PG8_SCHED;
            PG8_LDB(B0, 1, 0); PG8_LDB(B1, 1, 1); PG8_SCHED; PG8_LDA(At, 1, 0); PG8_STAGE(PG8_SA(0, 1), a2 + hstep, voffA);
            PG8_WAIT_V(8); PG8_WAIT_L(0); PG8_BAR; PG8_MMA(0, 0, At, B0); PG8_MMA(0, 1, At, B1); PG8_BAR; PG8_SCHED;
            PG8_LDA(At, 1, 1); PG8_STAGE(PG8_SB(1, 0), b3, voffB); PG8_STAGE(PG8_SB(1, 1), b3 + hstep, voffB); PG8_STAGE(PG8_SA(1, 0), a3, voffA);
            PG8_WAIT_V(8); PG8_WAIT_L(0); PG8_BAR; PG8_MMA(1, 0, At, B0); PG8_MMA(1, 1, At, B1); PG8_BAR; PG8_SCHED;
            } else {
            PG8_LDB(B0, 0, 0); PG8_SCHED; PG8_LDA(At, 0, 0); PG8_STAGE(PG8_SA(1, 1), a1 + hstep, voffA);
            PG8_WAIT_L(8); PG8_BAR; PG8_WAIT_L(0); PG8_MMA(0, 0, At, B0); PG8_BAR; PG8_SCHED;
            PG8_LDB(B1, 0, 1); PG8_STAGE(PG8_SB(0, 0), b2, voffB);
            PG8_BAR; PG8_WAIT_L(0); PG8_MMA(0, 1, At, B1); PG8_BAR;
            PG8_LDA(At, 0, 1); PG8_STAGE(PG8_SA(0, 0), a2, voffA);
            PG8_BAR; PG8_WAIT_L(0); PG8_MMA(1, 0, At, B0); PG8_BAR; PG8_SCHED;
            PG8_STAGE(PG8_SB(0, 1), b2 + hstep, voffB);
            PG8_WAIT_V(6); PG8_BAR; PG8_MMA(1, 1, At, B1); PG8_BAR;
            PG8_LDB(B0, 1, 0); PG8_SCHED; PG8_LDA(At, 1, 0); PG8_STAGE(PG8_SA(0, 1), a2 + hstep, voffA);
            PG8_WAIT_L(8); PG8_BAR; PG8_WAIT_L(0); PG8_MMA(0, 0, At, B0); PG8_BAR; PG8_SCHED;
            PG8_LDB(B1, 1, 1); PG8_STAGE(PG8_SB(1, 0), b3, voffB);
            PG8_BAR; PG8_WAIT_L(0); PG8_MMA(0, 1, At, B1); PG8_BAR;
            PG8_LDA(At, 1, 1); PG8_STAGE(PG8_SA(1, 0), a3, voffA);
            PG8_BAR; PG8_WAIT_L(0); PG8_MMA(1, 0, At, B0); PG8_BAR; PG8_SCHED;
            PG8_STAGE(PG8_SB(1, 1), b3 + hstep, voffB);
            PG8_WAIT_V(6); PG8_BAR; PG8_MMA(1, 1, At, B1); PG8_BAR;
            }
        }
        if constexpr (ALIGN_EPI) { if (wr == 0) PG8_BAR; }
        if constexpr (!Epi::AFTER_DRAIN) { E(acc, cur, wr, wc, fr, fq); S.done(cur); }
        if (!has_next) break;
#pragma unroll
        for (int a = 0; a < 2; ++a)
#pragma unroll
            for (int b = 0; b < 2; ++b)
#pragma unroll
                for (int m = 0; m < 4; ++m)
#pragma unroll
                    for (int n = 0; n < 2; ++n) acc[a][b][m][n] = (f32x4){0.f, 0.f, 0.f, 0.f};
        cur = nxt; cA = nA; cB = nB; ++ui;
        if constexpr (ALIGN_EPI) { if (wr == 1) PG8_BAR; }
    }
    PG8_WAIT_V(0);
    if constexpr (!ALIGN_EPI) { if (wr == 0) PG8_BAR; }
    PG8_BAR;
    if constexpr (Epi::AFTER_DRAIN) { E.fused(acc, cur, wr, wc, fr, fq, lds, wid, lane); S.done(cur); }
#undef PG8_SA
#undef PG8_SB
#undef PG8_STAGE
#undef PG8_LDA
#undef PG8_LDB
#undef PG8_MMA
#undef PG8_WAIT_V
#undef PG8_WAIT_L
#undef PG8_BAR
#undef PG8_SCHED
}
}

constexpr int NWAVES = 8;
constexpr int DM = 2048, NB = 4, SEQ = 4096, NTOK = NB * SEQ;
constexpr int NMETA = 16, NVALID = NTOK + NMETA, MROWS = 16640;
constexpr int IN_COLS = 5376;
constexpr float LN_EPS = 1e-5f, GN_EPS = 1e-5f;
constexpr float ALPHA = 1.189207115002721f;
constexpr float LOG2E = 1.4426950408889634f;
constexpr float QSCALE = 0.125f * LOG2E;
constexpr float U_QSCALE = 958.0f;
constexpr float V_SCALE = 4.0f;
constexpr int NSL = 16;

constexpr size_t MiB = 1u << 20;
constexpr size_t WS_CTL = 0, CTL_ZERO_BYTES = 65536;
constexpr size_t SZ_SK = (size_t)16 * 128 * 128 * 2, SZ_ROPE_R = (size_t)4112 * 128 * 8, SZ_ROPE_A = (size_t)4112 * 32 * 8;
constexpr size_t SZ_W2T = (size_t)DM * DM * 2, SZ_W1T = (size_t)IN_COLS * DM * 2, SZ_TAB = (size_t)16384 * DM * 2;
constexpr size_t SZ_ROWS2K = (size_t)MROWS * 2048 * 2, SZ_ROWS1K = (size_t)MROWS * 1024 * 2, SZ_ROWS128 = (size_t)MROWS * 128 * 2;
constexpr size_t SZ_TOK2K = (size_t)NTOK * 2048 * 2, SZ_ST = (size_t)16 * 32 * 256 * 256 * 2, SZ_IDS = (size_t)NTOK * 128 * 4;
constexpr size_t al256(size_t x) { return (x + 255) & ~(size_t)255; }
constexpr size_t WS_SK = 1 * MiB;
constexpr size_t WS_ROPE_R = al256(WS_SK + SZ_SK);
constexpr size_t WS_ROPE_A = al256(WS_ROPE_R + SZ_ROPE_R);
constexpr size_t WS_W2T = al256(WS_ROPE_A + SZ_ROPE_A), WS_W3T = al256(WS_W2T + SZ_W2T), WS_W1T = al256(WS_W3T + SZ_W2T);
constexpr size_t WS_UT = al256(WS_W1T + SZ_W1T), WS_VT = al256(WS_UT + SZ_TAB);
constexpr size_t WS_H0 = al256(WS_VT + SZ_TAB);
constexpr size_t WS_QR = al256(WS_H0 + SZ_ROWS2K);
constexpr size_t WS_KA = al256(WS_QR + SZ_ROWS2K), WS_VA = al256(WS_KA + SZ_ROWS128);
constexpr size_t WS_RK = al256(WS_VA + SZ_ROWS128), WS_RV = al256(WS_RK + SZ_ROWS1K), WS_RG = al256(WS_RV + SZ_ROWS1K);
constexpr size_t WS_ST = al256(WS_RG + SZ_ROWS1K);
constexpr size_t WS_Y = WS_RK;
constexpr size_t WS_H1 = WS_ST;
constexpr size_t WS_IDS = al256(WS_ST + SZ_ST), WS_GATES = al256(WS_IDS + SZ_IDS);
constexpr size_t WS_HSC = al256(WS_GATES + SZ_IDS);
constexpr size_t WS_END = al256(WS_HSC + (size_t)NTOK * 4);
static_assert(WS_Y + SZ_TOK2K <= WS_RG, "Y overlays RK|RV only");
static_assert(SZ_TOK2K <= SZ_ST && (size_t)NTOK * 1024 * 4 <= SZ_ST, "H1 / RET_RAW fit the state region");
static_assert(WS_END <= (size_t)512 * MiB, "workspace map fits 4 x largest tensor");
static_assert(WS_RK + (size_t)8 * NTOK * 128 * 4 <= WS_ST && WS_KA + (size_t)NTOK * 128 * 4 <= WS_RK && WS_H0 + (size_t)NTOK * DM * 4 <= WS_KA, "expert-phase overlays (DOTX over RK|RV, CB over KA|VA, Y32 over H0|QR)");
constexpr int CW_TMO = 0, CW_TABQ = 64, CW_BAR = 4096;

constexpr int RING_OFF = 0, RING_BYTES = 131072;
constexpr int LDSCTL_OFF = RING_BYTES, MISC_OFF = LDSCTL_OFF + 320;
constexpr int LDS_BYTES = 147456;

#define GAS __attribute__((address_space(1)))
#define LAS __attribute__((address_space(3)))
typedef unsigned short bf16;
typedef unsigned v4u __attribute__((ext_vector_type(4)));
typedef unsigned v2u __attribute__((ext_vector_type(2)));
typedef float f32x4 __attribute__((ext_vector_type(4)));
typedef float f32x2 __attribute__((ext_vector_type(2)));
typedef GAS unsigned gu32;
typedef __bf16 bf16x2_t __attribute__((ext_vector_type(2)));
#define RLX_AGENT __ATOMIC_RELAXED, __HIP_MEMORY_SCOPE_AGENT
#define LDS_WAIT() asm volatile("s_waitcnt lgkmcnt(0)" ::: "memory")
#define VM_WAIT() asm volatile("s_waitcnt vmcnt(0)" ::: "memory")
#define LDS_BAR() do { asm volatile("s_waitcnt lgkmcnt(0)" ::: "memory"); __builtin_amdgcn_s_barrier(); asm volatile("" ::: "memory"); } while (0)
__device__ __forceinline__ unsigned f2bf(float f) { unsigned u = __builtin_bit_cast(unsigned, f); return (u + 0x7fffu + ((u >> 16) & 1u)) >> 16; }
__device__ __forceinline__ unsigned pk2(float lo, float hi) { return f2bf(lo) | (f2bf(hi) << 16); }
__device__ __forceinline__ float bflo(unsigned w) { return __uint_as_float(w << 16); }
__device__ __forceinline__ float bfhi(unsigned w) { return __uint_as_float(w & 0xffff0000u); }
__device__ __forceinline__ float bf2f(bf16 h) { return __uint_as_float((unsigned)h << 16); }

#define XB_TMO      128
#define XB_XCNT(j)  (256  + 64 * (j))
#define XB_XSUB(j)  (1280 + 64 * (j))
#define XB_XGEN(j)  (2304 + 64 * (j))
#define XB_TOP      3328
#define XB_TOPGEN   3392
#define XCD_BAR_WORDS 3456
#define XB_SPIN_CAP (1u << 18)

__device__ __forceinline__ unsigned xb_ld(unsigned* p)              { return __hip_atomic_load(p, __ATOMIC_RELAXED, __HIP_MEMORY_SCOPE_AGENT); }
__device__ __forceinline__ unsigned xb_add(unsigned* p, unsigned v) { return __hip_atomic_fetch_add(p, v, __ATOMIC_RELAXED, __HIP_MEMORY_SCOPE_AGENT); }
__device__ __forceinline__ unsigned xb_xcc_id() { return (unsigned)__builtin_amdgcn_s_getreg((3 << 11) | 20) & 0xFu; }
#define XB_SPIN(cond, bar) do { unsigned _sp = 0; while (cond) { __builtin_amdgcn_s_sleep(1); \
    if ((++_sp & 255u) == 0u) { if (xb_ld(&(bar)[XB_TMO])) break; if (_sp > XB_SPIN_CAP) { atomicAdd(&(bar)[XB_TMO], 1u); break; } } } } while (0)

struct XcdBarrier {
    unsigned* bar; unsigned x;
    volatile LAS unsigned* st;
};

__device__ __forceinline__ XcdBarrier xcd_barrier_post(unsigned* bar, volatile LAS unsigned* st) {
    XcdBarrier b; b.bar = bar; b.x = xb_xcc_id(); b.st = st;
    if (threadIdx.x == 0) (void)xb_add(&bar[XB_XCNT(b.x)], 1u);
    return b;
}
__device__ __forceinline__ void xcd_barrier_complete(unsigned* bar, unsigned x, unsigned& nloc, unsigned& nx) {
    const unsigned G = gridDim.x * gridDim.y * gridDim.z;
    unsigned sum, cnt, mine, sp = 0u;
    for (;;) {
        sum = 0u; cnt = 0u; mine = 0u;
#pragma unroll
        for (unsigned j = 0; j < 16; ++j) { const unsigned c = xb_ld(&bar[XB_XCNT(j)]); sum += c; cnt += (c > 0u) ? 1u : 0u; mine = (j == x) ? c : mine; }
        if (sum == G) break;
        __builtin_amdgcn_s_sleep(1);
        if ((++sp & 255u) == 0u) { if (xb_ld(&bar[XB_TMO])) break; if (sp > XB_SPIN_CAP) { atomicAdd(&bar[XB_TMO], 1u); break; } }
    }
    nloc = mine > 0u ? mine : 1u; nx = cnt > 0u ? cnt : 1u;
}

__device__ __forceinline__ void xcd_barrier(const XcdBarrier& b) {
    asm volatile("s_waitcnt vmcnt(0)" ::: "memory");
    __syncthreads();
    if (threadIdx.x == 0) {
        unsigned* bar = b.bar;
        __builtin_amdgcn_s_waitcnt(0);
        unsigned nloc = b.st[0], nx = b.st[1];
        if (nloc == 0u) { xcd_barrier_complete(bar, b.x, nloc, nx); b.st[0] = nloc; b.st[1] = nx; }
        const unsigned old = xb_add(&bar[XB_XSUB(b.x)], 1u);
        const unsigned gen = old / nloc;
        if (old + 1u == (gen + 1u) * nloc) {
            __builtin_amdgcn_fence(__ATOMIC_RELEASE, "agent");
            asm volatile("s_waitcnt vmcnt(0)" ::: "memory");
            const unsigned og = xb_add(&bar[XB_TOP], 1u);
            const unsigned tg = og / nx;
            if (og + 1u == (tg + 1u) * nx) xb_add(&bar[XB_TOPGEN], 1u);
            else XB_SPIN(xb_ld(&bar[XB_TOPGEN]) == tg, bar);
            __builtin_amdgcn_fence(__ATOMIC_ACQUIRE, "agent");
            xb_add(&bar[XB_XGEN(b.x)], 1u);
            asm volatile("s_waitcnt vmcnt(0)" ::: "memory");
        } else {
            XB_SPIN(xb_ld(&bar[XB_XGEN(b.x)]) == gen, bar);
            __builtin_amdgcn_fence(__ATOMIC_ACQUIRE, "agent");
            asm volatile("s_waitcnt vmcnt(0)" ::: "memory");
        }
    }
    __syncthreads();
}


__device__ __forceinline__ float dot2bf(unsigned a, unsigned b, float c) { asm("v_dot2c_f32_bf16 %0, %1, %2" : "+v"(c) : "v"(a), "v"(b)); return c; }
__device__ __forceinline__ float dot8bf_dpp(v4u a, v4u b) { float c = 0.f; asm("v_dot2c_f32_bf16 %0, %1, %5\n\tv_dot2c_f32_bf16 %0, %2, %6\n\tv_dot2c_f32_bf16 %0, %3, %7\n\tv_dot2c_f32_bf16 %0, %4, %8\n\ts_nop 1" : "+v"(c) : "v"(a.x), "v"(a.y), "v"(a.z), "v"(a.w), "v"(b.x), "v"(b.y), "v"(b.z), "v"(b.w)); return c; }
#define DPPF(v, ctrl) __int_as_float(__builtin_amdgcn_update_dpp(0, __float_as_int(v), (ctrl), 0xf, 0xf, true))
__device__ __forceinline__ int q8(float x) { int q = (int)__builtin_rintf(x); q = q < -127 ? -127 : (q > 127 ? 127 : q); return q & 0xff; }
__device__ __forceinline__ float wave_sum(float v) {
#pragma unroll
    for (int o = 1; o < 64; o <<= 1) v += __shfl_xor(v, o);
    return v;
}
__device__ __forceinline__ float gelu_erf(float v) {
    const float av = fabsf(v), d = av * 0.2316418882f + 1.0f;
    const float t = __builtin_amdgcn_rcpf(d);
    float q = t * 0.5307027145f + (-0.7265760135f); q = q * t + 0.7107068705f; q = q * t + (-0.142248368f); q = q * t + 0.127414796f; q = q * t;
    const float e = __builtin_amdgcn_exp2f((v * v) * (-0.72134752044f));
    const float m = v * (q * e);
    return v < 0.f ? m : v - m;
}

struct Args { const float* in[15]; float* out; unsigned char* ws; };

__device__ __forceinline__ int w1_logical_col(int n0p) {
    const int pn = n0p >> 8, blk = (n0p & 255) >> 5, half = blk >> 2, a = blk & 3;
    if (pn <= 3) return pn * 256 + 64 * a + 32 * half;
    if (pn == 4) return (a < 2) ? (1024 + 64 * a + 32 * half) : (1152 + 64 * half + 32 * (a - 2));
    return n0p;
}
template <bool PERMW1> __device__ __forceinline__ void p0_transpose_item(const float* W, int K, int N, bf16* WT, LAS float* scr, int item, int lane) {
    const int nblk = N / 32, kb = item / nblk, nb = item % nblk, k0 = 64 * kb, n0 = 32 * nb; const int ns = PERMW1 ? w1_logical_col(n0) : n0;
    float tv[32];
#pragma unroll
    for (int i = 0; i < 32; ++i) { const int kk = 2 * i + (lane >> 5); tv[i] = W[(size_t)(k0 + kk) * N + ns + (lane & 31)]; }
#pragma unroll
    for (int i = 0; i < 32; ++i) { const int kk = 2 * i + (lane >> 5); scr[kk * 33 + (lane & 31)] = tv[i]; }
    LDS_WAIT(); asm volatile("" ::: "memory");
    const int c = lane & 7;
#pragma unroll
    for (int j = 0; j < 4; ++j) { const int n = (lane >> 3) + 8 * j; const LAS float* s = scr + (8 * c) * 33 + n;
        v4u o; o.x = pk2(s[0 * 33], s[1 * 33]); o.y = pk2(s[2 * 33], s[3 * 33]); o.z = pk2(s[4 * 33], s[5 * 33]); o.w = pk2(s[6 * 33], s[7 * 33]);
        *(GAS v4u*)(WT + (size_t)(n0 + n) * K + k0 + 8 * c) = o; }
    LDS_WAIT(); asm volatile("" ::: "memory");
}
__device__ __forceinline__ void ln_row_f32_to_bf16(const float* xrow, const float* g, const float* bta, bf16* orow, int lane) {
    const GAS f32x4* xr = (const GAS f32x4*)xrow + lane;
    f32x4 v[8]; float s = 0.f;
#pragma unroll
    for (int j = 0; j < 8; ++j) { v[j] = xr[64 * j]; s += (v[j].x + v[j].y) + (v[j].z + v[j].w); }
    const float mean = wave_sum(s) * (1.f / DM); float s2 = 0.f;
#pragma unroll
    for (int j = 0; j < 8; ++j) { v[j] = v[j] - mean; s2 += (v[j].x * v[j].x + v[j].y * v[j].y) + (v[j].z * v[j].z + v[j].w * v[j].w); }
    const float rstd = 1.f / sqrtf(wave_sum(s2) * (1.f / DM) + LN_EPS);
    GAS v2u* o8 = (GAS v2u*)orow + lane;
#pragma unroll
    for (int j = 0; j < 8; ++j) { const f32x4 gg = ((const GAS f32x4*)g)[lane + 64 * j], bb = ((const GAS f32x4*)bta)[lane + 64 * j];
        v2u o; o.x = pk2(v[j].x * rstd * gg.x + bb.x, v[j].y * rstd * gg.y + bb.y); o.y = pk2(v[j].z * rstd * gg.z + bb.z, v[j].w * rstd * gg.w + bb.w); o8[64 * j] = o; }
}
__device__ __forceinline__ void ln_row_bf16_to_bf16(const bf16* xrow, const float* g, const float* bta, bf16* orow, signed char* qrow, float* qscale, int lane) {
    const GAS v4u* xr = (const GAS v4u*)xrow + lane;
    float v[32]; float s = 0.f;
#pragma unroll
    for (int j = 0; j < 4; ++j) { const v4u w = xr[64 * j];
        v[8 * j + 0] = bflo(w.x); v[8 * j + 1] = bfhi(w.x); v[8 * j + 2] = bflo(w.y); v[8 * j + 3] = bfhi(w.y);
        v[8 * j + 4] = bflo(w.z); v[8 * j + 5] = bfhi(w.z); v[8 * j + 6] = bflo(w.w); v[8 * j + 7] = bfhi(w.w); }
#pragma unroll
    for (int i = 0; i < 32; ++i) s += v[i];
    const float mean = wave_sum(s) * (1.f / DM); float s2 = 0.f;
#pragma unroll
    for (int i = 0; i < 32; ++i) { v[i] -= mean; s2 += v[i] * v[i]; }
    const float rstd = 1.f / sqrtf(wave_sum(s2) * (1.f / DM) + LN_EPS);
    GAS v4u* o16 = (GAS v4u*)orow + lane;
#pragma unroll
    for (int j = 0; j < 4; ++j) {
        const GAS f32x4* gp = (const GAS f32x4*)g + 2 * (lane + 64 * j); const GAS f32x4* bp = (const GAS f32x4*)bta + 2 * (lane + 64 * j);
        const f32x4 g0 = gp[0], g1 = gp[1], b0 = bp[0], b1 = bp[1];
        v4u o; o.x = pk2(v[8 * j + 0] * rstd * g0.x + b0.x, v[8 * j + 1] * rstd * g0.y + b0.y); o.y = pk2(v[8 * j + 2] * rstd * g0.z + b0.z, v[8 * j + 3] * rstd * g0.w + b0.w);
        o.z = pk2(v[8 * j + 4] * rstd * g1.x + b1.x, v[8 * j + 5] * rstd * g1.y + b1.y); o.w = pk2(v[8 * j + 6] * rstd * g1.z + b1.z, v[8 * j + 7] * rstd * g1.w + b1.w);
        o16[64 * j] = o;
        v[8 * j + 0] = v[8 * j + 0] * rstd * g0.x + b0.x; v[8 * j + 1] = v[8 * j + 1] * rstd * g0.y + b0.y; v[8 * j + 2] = v[8 * j + 2] * rstd * g0.z + b0.z; v[8 * j + 3] = v[8 * j + 3] * rstd * g0.w + b0.w;
        v[8 * j + 4] = v[8 * j + 4] * rstd * g1.x + b1.x; v[8 * j + 5] = v[8 * j + 5] * rstd * g1.y + b1.y; v[8 * j + 6] = v[8 * j + 6] * rstd * g1.z + b1.z; v[8 * j + 7] = v[8 * j + 7] * rstd * g1.w + b1.w; }
    float am = 0.f;
#pragma unroll
    for (int i = 0; i < 32; ++i) am = fmaxf(am, fabsf(v[i]));
#pragma unroll
    for (int o = 1; o < 64; o <<= 1) am = fmaxf(am, __shfl_xor(am, o));
    am = fmaxf(am, 1e-20f); const float iq = 127.0f / am;
    if (lane == 0) *qscale = am * (1.0f / 127.0f);
#pragma unroll
    for (int j = 0; j < 4; ++j) { v2u w; w.x = (unsigned)(q8(v[8 * j + 0] * iq) | (q8(v[8 * j + 1] * iq) << 8) | (q8(v[8 * j + 2] * iq) << 16) | (q8(v[8 * j + 3] * iq) << 24));
        w.y = (unsigned)(q8(v[8 * j + 4] * iq) | (q8(v[8 * j + 5] * iq) << 8) | (q8(v[8 * j + 6] * iq) << 16) | (q8(v[8 * j + 7] * iq) << 24)); ((GAS v2u*)qrow)[lane + 64 * j] = w; }
}
__device__ __forceinline__ void row_pos(int r, int& pos, int& ipos) {
    if (r < NTOK) { const int s = r & (SEQ - 1); pos = NMETA + s; ipos = s & 127; }
    else { int j = r - NTOK; if (j > NMETA - 1) j = NMETA - 1; pos = j; ipos = 112 + j; }
}
__device__ __forceinline__ float log2_gamma(int h) { return log2f(1.0f - exp2f(-5.0f - (float)h)); }


typedef short bf16x8 __attribute__((ext_vector_type(8)));
typedef short s16x4 __attribute__((ext_vector_type(4)));
#define MFMA16(a, b, c) __builtin_amdgcn_mfma_f32_16x16x32_bf16((a), (b), (c), 0, 0, 0)
__device__ __forceinline__ s16x4 tr16(LAS const unsigned char* p) { return __builtin_bit_cast(s16x4, __builtin_amdgcn_ds_read_tr16_b64_v4i16((LAS s16x4*)p)); }
__device__ __forceinline__ bf16x8 cat8(s16x4 a, s16x4 b) { return __builtin_shufflevector(a, b, 0, 1, 2, 3, 4, 5, 6, 7); }
__device__ __forceinline__ unsigned cvtpk_s(float lo, float hi) { f32x2 v = {lo, hi}; bf16x2_t b = __builtin_convertvector(v, bf16x2_t); return __builtin_bit_cast(unsigned, b); }
__device__ __forceinline__ unsigned cvtpk(float lo, float hi) { unsigned r; asm("v_cvt_pk_bf16_f32 %0, %1, %2" : "=v"(r) : "v"(lo), "v"(hi)); return r; }

__device__ __forceinline__ void scan_unit(LAS unsigned char* L, int u, const bf16* RK, const bf16* RV, bf16* ST, int tid, int lane, int wave) {
    asm volatile("" : "+v"(tid)); lane = tid & 63;
    const int bh = u >> 4, di = (u >> 2) & 3, ei = u & 3, b = bh >> 2, h = bh & 3;
    const float g128 = exp2f(128.0f * log2_gamma(h));
    const int li = lane & 15, g = lane >> 4, q = li >> 2, p4 = li & 3;
    const int eb = wave >> 1, db0 = 2 * (wave & 1);
    f32x4 acc[2]; acc[0] = (f32x4){0.f, 0.f, 0.f, 0.f}; acc[1] = acc[0];
    const int sw = 2 * (((q >> 1) & 1) | ((g & 1) << 1));
    v4u kA[2], vA[2], kB[2], vB[2];
#define SCAN_LOAD(cc, kreg, vreg) do { _Pragma("unroll") for (int i_ = 0; i_ < 2; ++i_) { const int cid_ = tid + 512 * i_, row_ = cid_ >> 3, c16_ = cid_ & 7; \
        int srow_; bool ok_ = true; if ((cc) < 0) { ok_ = row_ >= 112; srow_ = NTOK + (ok_ ? row_ - 112 : 0); } else srow_ = b * SEQ + (cc) * 128 + row_; \
        const v4u kz_ = *(const GAS v4u*)(RK + (size_t)srow_ * 1024 + h * 256 + di * 64 + c16_ * 8), vz_ = *(const GAS v4u*)(RV + (size_t)srow_ * 1024 + h * 256 + ei * 64 + c16_ * 8); \
        kreg[i_] = ok_ ? kz_ : (v4u){0u, 0u, 0u, 0u}; vreg[i_] = ok_ ? vz_ : (v4u){0u, 0u, 0u, 0u}; } } while (0)
#define SCAN_WRITE(bufp, kreg, vreg) do { _Pragma("unroll") for (int i_ = 0; i_ < 2; ++i_) { const int cid_ = tid + 512 * i_, row_ = cid_ >> 3, c16_ = cid_ & 7; \
        const int sw_ = ((row_ >> 1) & 1) | ((row_ >> 2) & 2); const int off_ = row_ * 128 + ((c16_ ^ (2 * sw_)) << 4); \
        *(LAS v4u*)((bufp) + off_) = kreg[i_]; *(LAS v4u*)((bufp) + 16384 + off_) = vreg[i_]; } } while (0)
#define SCAN_FLUSH(c) do { if ((c) >= 0) { const v4u z_ = *(LAS const v4u*)(L + 65536 + ((c) & 1) * 8192 + (tid >> 3) * 128 + (tid & 7) * 16); \
        *(GAS v4u*)(ST + ((size_t)(bh * 32 + (c)) * 256 + 64 * ei + (tid >> 3)) * 256 + 64 * di + (tid & 7) * 8) = z_; } } while (0)
    SCAN_LOAD(-1, kA, vA); SCAN_WRITE(L, kA, vA); SCAN_LOAD(0, kA, vA); SCAN_LOAD(1, kB, vB); LDS_BAR();
    int cur = 0;
    for (int cc = -1; cc <= 29; cc += 2) {
        { LAS const unsigned char* Kt = L + cur * 32768; LAS const unsigned char* Vt = Kt + 16384;
#pragma unroll
          for (int ks = 0; ks < 4; ++ks) { const int r0 = (32 * ks + 8 * g + q) * 128 + 8 * (p4 & 1);
              const bf16x8 a = cat8(tr16(Vt + r0 + (((2 * eb + (p4 >> 1)) ^ sw) << 4)), tr16(Vt + r0 + 512 + (((2 * eb + (p4 >> 1)) ^ sw) << 4)));
#pragma unroll
              for (int n = 0; n < 2; ++n) { const int cn = ((2 * (db0 + n) + (p4 >> 1)) ^ sw) << 4; const bf16x8 bb = cat8(tr16(Kt + r0 + cn), tr16(Kt + r0 + 512 + cn)); acc[n] = MFMA16(a, bb, acc[n]); } }
          SCAN_FLUSH(cc);
#pragma unroll
          for (int n = 0; n < 2; ++n) { acc[n] = acc[n] * g128;
              LAS bf16* op = (LAS bf16*)(L + 65536 + ((cc + 1) & 1) * 8192) + (16 * eb + 4 * g) * 64 + 16 * (db0 + n) + li;
#pragma unroll
              for (int r = 0; r < 4; ++r) op[r * 64] = (bf16)f2bf(acc[n][r]); }
          SCAN_WRITE(L + (cur ^ 1) * 32768, kA, vA);
          if (cc + 3 <= 30) SCAN_LOAD(cc + 3, kA, vA);
          LDS_BAR(); cur ^= 1; }
        { LAS const unsigned char* Kt = L + cur * 32768; LAS const unsigned char* Vt = Kt + 16384;
#pragma unroll
          for (int ks = 0; ks < 4; ++ks) { const int r0 = (32 * ks + 8 * g + q) * 128 + 8 * (p4 & 1);
              const bf16x8 a = cat8(tr16(Vt + r0 + (((2 * eb + (p4 >> 1)) ^ sw) << 4)), tr16(Vt + r0 + 512 + (((2 * eb + (p4 >> 1)) ^ sw) << 4)));
#pragma unroll
              for (int n = 0; n < 2; ++n) { const int cn = ((2 * (db0 + n) + (p4 >> 1)) ^ sw) << 4; const bf16x8 bb = cat8(tr16(Kt + r0 + cn), tr16(Kt + r0 + 512 + cn)); acc[n] = MFMA16(a, bb, acc[n]); } }
          SCAN_FLUSH(cc + 1);
#pragma unroll
          for (int n = 0; n < 2; ++n) { acc[n] = acc[n] * g128;
              LAS bf16* op = (LAS bf16*)(L + 65536 + ((cc + 2) & 1) * 8192) + (16 * eb + 4 * g) * 64 + 16 * (db0 + n) + li;
#pragma unroll
              for (int r = 0; r < 4; ++r) op[r * 64] = (bf16)f2bf(acc[n][r]); }
          if (cc + 2 <= 30) SCAN_WRITE(L + (cur ^ 1) * 32768, kB, vB);
          if (cc + 4 <= 30) SCAN_LOAD(cc + 4, kB, vB);
          LDS_BAR(); cur ^= 1; }
    }
    SCAN_FLUSH(31);
    LDS_BAR();
#undef SCAN_LOAD
#undef SCAN_WRITE
#undef SCAN_FLUSH
}

__device__ __forceinline__ void retout_unit(LAS unsigned char* L, int u, bf16* QR, const bf16* RK, const bf16* RV, const bf16* RG, const bf16* ST, int tid, int lane, int wave) {
    asm volatile("" : "+v"(tid)); lane = tid & 63;
    const int bh = u >> 5, c = u & 31, b = bh >> 2, h = bh & 3;
    const int R0 = b * SEQ + c * 128;
    const int li = lane & 15, g = lane >> 4, q = li >> 2, p4 = li & 3;
    LAS unsigned char* RA = L; LAS unsigned char* RB = L + 65536;
#pragma unroll
    for (int i = 0; i < 8; ++i) { const int cid = tid + 512 * i, j = cid >> 5, ch = cid & 31;
        const v4u kz = *(const GAS v4u*)(RK + (size_t)(R0 + j) * 1024 + h * 256 + ch * 8), vz = *(const GAS v4u*)(RV + (size_t)(R0 + j) * 1024 + h * 256 + ch * 8);
        *(LAS v4u*)(RA + j * 512 + ((ch ^ (j & 15)) << 4)) = kz; *(LAS v4u*)(RB + j * 512 + ((ch ^ ((j & 7) << 1)) << 4)) = vz; }
    bf16x8 qf[8];
    { const GAS v4u* qp = (const GAS v4u*)(QR + (size_t)(R0 + 16 * wave + li) * 2048 + 1024 + h * 256 + 8 * g);
#pragma unroll
      for (int ks = 0; ks < 8; ++ks) qf[ks] = __builtin_bit_cast(bf16x8, qp[4 * ks]); }
#define RO_LOAD_ST(s0) do { _Pragma("unroll") for (int i_ = 0; i_ < 8; ++i_) { const int cid_ = tid + 512 * i_, sl_ = cid_ >> 11, e_ = (cid_ >> 3) & 255, ch_ = cid_ & 7; \
        stg[i_] = *(const GAS v4u*)(Sg + (size_t)e_ * 256 + 64 * ((s0) + sl_) + ch_ * 8); } } while (0)
#define RO_WRITE_ST(dst) do { _Pragma("unroll") for (int i_ = 0; i_ < 8; ++i_) { const int cid_ = tid + 512 * i_, sl_ = cid_ >> 11, e_ = (cid_ >> 3) & 255, ch_ = cid_ & 7; \
        *(LAS v4u*)((dst) + sl_ * 32768 + e_ * 128 + ((ch_ ^ (e_ & 7)) << 4)) = stg[i_]; } } while (0)
    const bf16* Sg = ST + (size_t)(bh * 32 + c) * 65536; v4u stg[8];
    __syncthreads();
    RO_LOAD_ST(0);
    f32x4 st[8];
#pragma unroll
    for (int jt = 0; jt < 8; ++jt) st[jt] = (f32x4){0.f, 0.f, 0.f, 0.f};
#pragma unroll
    for (int jt = 0; jt < 8; ++jt) if (jt <= wave) {
        const int j = 16 * jt + li;
#pragma unroll
        for (int ks = 0; ks < 8; ++ks) { const bf16x8 a = *(LAS const bf16x8*)(RA + j * 512 + (((4 * ks + g) ^ li) << 4)); st[jt] = MFMA16(a, qf[ks], st[jt]); }
        if (jt == wave) {
#pragma unroll
            for (int r = 0; r < 4; ++r) if (4 * g + r > li) st[jt][r] = 0.f; }
    }
    bf16x8 pf[4];
#pragma unroll
    for (int s = 0; s < 4; ++s) { v4u w; w.x = cvtpk_s(st[2 * s][0], st[2 * s][1]); w.y = cvtpk_s(st[2 * s][2], st[2 * s][3]); w.z = cvtpk_s(st[2 * s + 1][0], st[2 * s + 1][1]); w.w = cvtpk_s(st[2 * s + 1][2], st[2 * s + 1][3]); pf[s] = __builtin_bit_cast(bf16x8, w); }
    __syncthreads();
    RO_WRITE_ST(RA); RO_LOAD_ST(2);
    f32x4 o[16];
#pragma unroll
    for (int et = 0; et < 16; ++et) o[et] = (f32x4){0.f, 0.f, 0.f, 0.f};
#pragma unroll
    for (int s = 0; s < 4; ++s) if (2 * s <= wave) {
        const int r1 = 32 * s + 4 * g + q, r2 = r1 + 16;
#pragma unroll
        for (int et = 0; et < 16; ++et) {
            const int chn = 2 * et + (p4 >> 1);
            const bf16x8 a = cat8(tr16(RB + r1 * 512 + ((chn ^ ((r1 & 7) << 1)) << 4) + (p4 & 1) * 8), tr16(RB + r2 * 512 + ((chn ^ ((r2 & 7) << 1)) << 4) + (p4 & 1) * 8));
            o[et] = MFMA16(a, pf[s], o[et]);
        }
    }
    __syncthreads();
    RO_WRITE_ST(RB);
#define RO_STATE_MMA(src, s0) do { _Pragma("unroll") for (int sl_ = 0; sl_ < 2; ++sl_) _Pragma("unroll") for (int k2_ = 0; k2_ < 2; ++k2_) _Pragma("unroll") for (int et = 0; et < 16; ++et) { \
        const int e_ = 16 * et + li; const bf16x8 a_ = *(LAS const bf16x8*)((src) + sl_ * 32768 + e_ * 128 + (((4 * k2_ + g) ^ (e_ & 7)) << 4)); \
        o[et] = MFMA16(a_, qf[2 * ((s0) + sl_) + k2_], o[et]); } } while (0)
    RO_STATE_MMA(RA, 0);
    __syncthreads();
    RO_STATE_MMA(RB, 2);
#undef RO_LOAD_ST
#undef RO_WRITE_ST
#undef RO_STATE_MMA
    float s1 = 0.f;
#pragma unroll
    for (int et = 0; et < 16; ++et) s1 += (o[et][0] + o[et][1]) + (o[et][2] + o[et][3]);
    s1 += __shfl_xor(s1, 16); s1 += __shfl_xor(s1, 32);
    const float mu = s1 * (1.0f / 256.0f); float s2 = 0.f;
#pragma unroll
    for (int et = 0; et < 16; ++et) { o[et] = o[et] - mu; s2 += (o[et][0] * o[et][0] + o[et][1] * o[et][1]) + (o[et][2] * o[et][2] + o[et][3] * o[et][3]); }
    s2 += __shfl_xor(s2, 16); s2 += __shfl_xor(s2, 32);
    const float rstd = 1.0f / sqrtf(s2 * (1.0f / 256.0f) + GN_EPS);
    const int row = R0 + 16 * wave + li;
    const GAS v2u* gp = (const GAS v2u*)(RG + (size_t)row * 1024 + h * 256 + 4 * g); GAS v2u* op = (GAS v2u*)(QR + (size_t)row * 2048 + 1024 + h * 256 + 4 * g);
#pragma unroll
    for (int et = 0; et < 16; ++et) { const v2u gz = gp[4 * et]; v2u w;
        w.x = cvtpk(o[et][0] * rstd * bflo(gz.x), o[et][1] * rstd * bfhi(gz.x)); w.y = cvtpk(o[et][2] * rstd * bflo(gz.y), o[et][3] * rstd * bfhi(gz.y)); op[4 * et] = w; }
    __syncthreads();
}

typedef float f32x16 __attribute__((ext_vector_type(16)));
#define MFMA32(a, b, c) __builtin_amdgcn_mfma_f32_32x32x16_bf16((a), (b), (c), 0, 0, 0)
__device__ __forceinline__ int crow32(int reg, int hh) { return (reg & 3) + 8 * (reg >> 2) + 4 * hh; }

__device__ __forceinline__ void attn_unit(LAS unsigned char* L, int u, bf16* QR, const bf16* KA, const bf16* VA, const float* sinks, int tid, int lane, int wave) {
    asm volatile("" : "+v"(tid)); lane = tid & 63;
    const int b = u >> 6, j = (u >> 1) & 31, g2 = u & 1, hq = 8 * g2 + wave;
    const int R0 = b * SEQ + 128 * j;
    LAS unsigned char* Kt = L; LAS unsigned char* Vt = L + 32768;
#pragma unroll
    for (int i = 0; i < 4; ++i) { const int cid = tid + 512 * i, kk = cid >> 3, ch = cid & 7;
        int srow; bool ok = true;
        if (kk >= 128) srow = R0 + kk - 128; else if (j > 0) srow = R0 - 128 + kk; else { ok = kk >= 112; srow = NTOK + (ok ? kk - 112 : 0); }
        const v4u kz = *(const GAS v4u*)(KA + (size_t)srow * 128 + g2 * 64 + ch * 8), vz = *(const GAS v4u*)(VA + (size_t)srow * 128 + g2 * 64 + ch * 8);
        *(LAS v4u*)(Kt + kk * 128 + ((ch ^ (kk & 7)) << 4)) = ok ? kz : (v4u){0u, 0u, 0u, 0u};
        *(LAS v4u*)(Vt + kk * 128 + (ch << 4)) = ok ? vz : (v4u){0u, 0u, 0u, 0u}; }
    __syncthreads();
    const int r = lane & 31, hh = lane >> 5, blk = (lane >> 4) & 1, q = (lane & 15) >> 2, p4 = lane & 3;
    const float sk = sinks[hq] * LOG2E;
    v4u qn[4];
    { const GAS v4u* qp = (const GAS v4u*)(QR + (size_t)(R0 + r) * 2048 + hq * 64 + 8 * hh);
#pragma unroll
      for (int ks = 0; ks < 4; ++ks) qn[ks] = qp[2 * ks]; }
#pragma unroll 1
    for (int t = 0; t < 4; ++t) {
        const int i0 = 32 * t;
        bf16x8 qf[4];
#pragma unroll
        for (int ks = 0; ks < 4; ++ks) qf[ks] = __builtin_bit_cast(bf16x8, qn[ks]);
        if (t < 3) { const GAS v4u* qp = (const GAS v4u*)(QR + (size_t)(R0 + i0 + 32 + r) * 2048 + hq * 64 + 8 * hh);
#pragma unroll
          for (int ks = 0; ks < 4; ++ks) qn[ks] = qp[2 * ks]; }
        f32x16 s[5];
#pragma unroll
        for (int x = 0; x < 5; ++x) {
            const int krow_ = 32 * (t + x) + r;
            f32x16 acc;
#pragma unroll
            for (int e = 0; e < 16; ++e) acc[e] = 0.f;
#pragma unroll
            for (int ks = 0; ks < 4; ++ks) { const bf16x8 a = *(LAS const bf16x8*)(Kt + krow_ * 128 + (((2 * ks + hh) ^ (krow_ & 7)) << 4)); acc = MFMA32(a, qf[ks], acc); }
            s[x] = acc; __builtin_amdgcn_sched_barrier(0);
        }
        float m = sk;
#pragma unroll
        for (int e = 0; e < 16; ++e) { const int cr = crow32(e, hh);
            if (!(cr > r)) s[0][e] = -1.0e30f;
            if (!(cr <= r)) s[4][e] = -1.0e30f; }
        if (j == 0) {
#pragma unroll
            for (int x = 0; x < 4; ++x) if (t + x <= 3) {
#pragma unroll
                for (int e = 0; e < 16; ++e) if (32 * (t + x) + crow32(e, hh) < 112) s[x][e] = -1.0e30f; }
        }
#pragma unroll
        for (int x = 0; x < 5; ++x)
#pragma unroll
            for (int e = 0; e < 16; ++e) m = fmaxf(m, s[x][e]);
        m = fmaxf(m, __shfl_xor(m, 32));
        float l = 0.f;
#pragma unroll
        for (int x = 0; x < 5; ++x)
#pragma unroll
            for (int e = 0; e < 16; ++e) { const float pv = exp2f(s[x][e] - m); s[x][e] = pv; l += pv; }
        l += __shfl_xor(l, 32);
        l += exp2f(sk - m);
        f32x16 o[2];
#pragma unroll
        for (int e = 0; e < 16; ++e) { o[0][e] = 0.f; o[1][e] = 0.f; }
#pragma unroll
        for (int x = 0; x < 5; ++x)
#pragma unroll
            for (int st = 0; st < 2; ++st) {
                v4u w; w.x = cvtpk_s(s[x][8 * st + 0], s[x][8 * st + 1]); w.y = cvtpk_s(s[x][8 * st + 2], s[x][8 * st + 3]); w.z = cvtpk_s(s[x][8 * st + 4], s[x][8 * st + 5]); w.w = cvtpk_s(s[x][8 * st + 6], s[x][8 * st + 7]);
                const bf16x8 pb = __builtin_bit_cast(bf16x8, w);
                const int k1 = 32 * (t + x) + 16 * st + 4 * hh + q, k2 = k1 + 8;
#pragma unroll
                for (int dc = 0; dc < 2; ++dc) {
                    const int cb = ((4 * dc + 2 * blk + (p4 >> 1)) << 4) + 8 * (p4 & 1);
                    const bf16x8 a = cat8(tr16(Vt + k1 * 128 + cb), tr16(Vt + k2 * 128 + cb));
                    o[dc] = MFMA32(a, pb, o[dc]);
                }
                __builtin_amdgcn_sched_barrier(0);
            }
        const float il = 1.0f / l;
        GAS v2u* op = (GAS v2u*)(QR + (size_t)(R0 + i0 + r) * 2048 + hq * 64 + 4 * hh);
#pragma unroll
        for (int dc = 0; dc < 2; ++dc)
#pragma unroll
            for (int g4 = 0; g4 < 4; ++g4) { v2u w; w.x = cvtpk_s(o[dc][4 * g4 + 0] * il, o[dc][4 * g4 + 1] * il); w.y = cvtpk_s(o[dc][4 * g4 + 2] * il, o[dc][4 * g4 + 3] * il); op[8 * dc + 2 * g4] = w; }
    }
    __syncthreads();
}

__device__ __forceinline__ unsigned ord_key(float f) { const unsigned u = __float_as_uint(f); return u ^ ((unsigned)((int)u >> 31) | 0x80000000u); }
__device__ __forceinline__ float ord_val(unsigned k) { return __uint_as_float(k ^ (((int)k < 0) ? 0x80000000u : 0xffffffffu)); }
__device__ __forceinline__ unsigned umed3(unsigned a, unsigned b, unsigned c) { unsigned r; asm("v_med3_u32 %0, %1, %2, %3" : "=v"(r) : "v"(a), "v"(b), "v"(c)); return r; }
#define TK_INS(arr, val) do { const unsigned v_ = (val); _Pragma("unroll") for (int j_ = 15; j_ >= 1; --j_) arr[j_] = umed3(arr[j_ - 1], arr[j_], v_); arr[0] = arr[0] > v_ ? arr[0] : v_; } while (0)
__device__ __forceinline__ void topk_unit(LAS unsigned* Lw, LAS const unsigned char* Lsk, int tt, int hd, const bf16* Q3, unsigned short* IDS, float* GATES, int lane) {
    asm volatile("" : "+v"(lane));
    const int r = lane & 31, hh = lane >> 5, t0 = tt * 32;
    float sv[2][16];
#pragma unroll
    for (int p = 0; p < 2; ++p) {
        f32x16 acc[4];
#pragma unroll
        for (int nt = 0; nt < 4; ++nt)
#pragma unroll
            for (int e = 0; e < 16; ++e) acc[nt][e] = 0.f;
        const GAS v4u* qp = (const GAS v4u*)(Q3 + (size_t)(t0 + r) * DM + hd * 256 + p * 128 + 8 * hh);
        bf16x8 bq[8];
#pragma unroll
        for (int ks = 0; ks < 8; ++ks) bq[ks] = __builtin_bit_cast(bf16x8, qp[2 * ks]);
#pragma unroll
        for (int ks = 0; ks < 8; ++ks) {
#pragma unroll
            for (int nt = 0; nt < 4; ++nt) { const bf16x8 a = *(LAS const bf16x8*)(Lsk + p * 32768 + (32 * nt + r) * 256 + (((2 * ks + hh) ^ (r & 15)) << 4)); acc[nt] = MFMA32(a, bq[ks], acc[nt]); } }
        unsigned tk[16];
#pragma unroll
        for (int j2 = 0; j2 < 16; ++j2) tk[j2] = 0u;
#pragma unroll
        for (int nt = 0; nt < 4; ++nt)
#pragma unroll
            for (int e = 0; e < 16; ++e) { const int n = 32 * nt + crow32(e, hh); TK_INS(tk, (ord_key(acc[nt][e]) & 0xffffff80u) | (unsigned)(127 - n)); }
        unsigned pk[16];
#pragma unroll
        for (int j2 = 0; j2 < 16; ++j2) pk[j2] = (unsigned)__shfl_xor((int)tk[j2], 32);
#pragma unroll
        for (int j2 = 0; j2 < 16; ++j2) TK_INS(tk, pk[j2]);
#pragma unroll
        for (int j2 = 0; j2 < 16; ++j2) { sv[p][j2] = ord_val(tk[j2] & 0xffffff80u); Lw[(p * 16 + j2) * 64 + lane] = 127u - (tk[j2] & 0x7fu); }
    }
    unsigned fk[16];
#pragma unroll
    for (int j2 = 0; j2 < 16; ++j2) fk[j2] = 0u;
#pragma unroll
    for (int i = 0; i < 16; ++i)
#pragma unroll
        for (int j2 = 0; j2 < 16; ++j2) if ((i + 1) * (j2 + 1) <= 16) TK_INS(fk, (ord_key(sv[0][i] + sv[1][j2]) & 0xffffff00u) | (unsigned)(255 - (16 * i + j2)));
    float ev[16]; int idv[16]; float den = 0.f; const float f0 = ord_val(fk[0] & 0xffffff00u);
    LDS_WAIT();
#pragma unroll
    for (int k = 0; k < 16; ++k) { const unsigned idx = 255u - (fk[k] & 0xffu); const unsigned i1 = Lw[(idx >> 4) * 64 + lane], i2 = Lw[(16 + (idx & 15u)) * 64 + lane];
        idv[k] = (int)(i1 * 128u + i2); ev[k] = __expf(ord_val(fk[k] & 0xffffff00u) - f0); den += ev[k]; }
    const float iden = 1.0f / den;
    if (hh == 0) {
        GAS v4u* ip = (GAS v4u*)(IDS + (size_t)(t0 + r) * 128 + hd * 16); GAS f32x4* gp = (GAS f32x4*)(GATES + (size_t)(t0 + r) * 128 + hd * 16);
#pragma unroll
        for (int k8 = 0; k8 < 2; ++k8) ip[k8] = (v4u){(unsigned)idv[8 * k8] | ((unsigned)idv[8 * k8 + 1] << 16), (unsigned)idv[8 * k8 + 2] | ((unsigned)idv[8 * k8 + 3] << 16), (unsigned)idv[8 * k8 + 4] | ((unsigned)idv[8 * k8 + 5] << 16), (unsigned)idv[8 * k8 + 6] | ((unsigned)idv[8 * k8 + 7] << 16)};
#pragma unroll
        for (int k4 = 0; k4 < 4; ++k4) gp[k4] = (f32x4){ev[4 * k4] * iden, ev[4 * k4 + 1] * iden, ev[4 * k4 + 2] * iden, ev[4 * k4 + 3] * iden};
    }
    LDS_WAIT();
}

__global__ void __launch_bounds__(NWAVES * 64, 2) mk_fwd(Args args) {
    extern __shared__ __attribute__((aligned(16))) unsigned char lds[];
    LAS unsigned char* L = (LAS unsigned char*)lds;
    volatile LAS unsigned* MISC = (volatile LAS unsigned*)(L + MISC_OFF);
    const int tid = threadIdx.x, lane = tid & 63, wave = __builtin_amdgcn_readfirstlane(tid >> 6);
    const int G = gridDim.x, bx = blockIdx.x;
    const int vcu = (G % 8 == 0) ? (bx % 8) * (G / 8) + bx / 8 : bx;
    unsigned char* ws = args.ws;
    gu32* ctl = (gu32*)(ws + WS_CTL);
    const float* x = args.in[0]; const float* meta = args.in[1]; const float* ln_in_g = args.in[2]; const float* ln_in_b = args.in[3];
    const float* w_in = args.in[4]; const float* sinks = args.in[5]; const float* w_out = args.in[6]; const float* ln_mix_g = args.in[7]; const float* ln_mix_b = args.in[8];
    const float* wq = args.in[9]; const float* subkeys = args.in[10]; const float* u_tab = args.in[11]; const float* v_tab = args.in[12];
    const float* ln_ffn_g = args.in[13]; const float* ln_ffn_b = args.in[14];
    float* out = args.out;
    bf16* W1T = (bf16*)(ws + WS_W1T); bf16* W2T = (bf16*)(ws + WS_W2T); bf16* W3T = (bf16*)(ws + WS_W3T);
    bf16* H0 = (bf16*)(ws + WS_H0); bf16* QR = (bf16*)(ws + WS_QR); bf16* KA = (bf16*)(ws + WS_KA); bf16* VA = (bf16*)(ws + WS_VA);
    bf16* RK = (bf16*)(ws + WS_RK); bf16* RV = (bf16*)(ws + WS_RV); bf16* RG = (bf16*)(ws + WS_RG);
    bf16* Y = (bf16*)(ws + WS_Y); bf16* H1 = (bf16*)(ws + WS_H1); bf16* Q3 = (bf16*)(ws + WS_QR);
    bf16* STB = (bf16*)(ws + WS_ST);
    unsigned short* IDS = (unsigned short*)(ws + WS_IDS); float* GATES = (float*)(ws + WS_GATES);
    bf16* SKB = (bf16*)(ws + WS_SK);
    signed char* H1Q = (signed char*)(ws + WS_RG); float* HSC = (float*)(ws + WS_HSC);
    bf16* UT = (bf16*)(ws + WS_UT); bf16* VT = (bf16*)(ws + WS_VT);

    for (int u = tid; u < (LDS_BYTES - LDSCTL_OFF) / 4; u += NWAVES * 64) ((LAS unsigned*)(L + LDSCTL_OFF))[u] = 0u;
    __syncthreads();
    XcdBarrier bar; bar.bar = (unsigned*)(ctl + CW_BAR); bar.x = xb_xcc_id(); bar.st = MISC + 8;
    if (tid == 0) MISC[10] = xb_add(&bar.bar[XB_XCNT(bar.x)], 1u);
#define GRID_BAR() xcd_barrier(bar)
    const int gw = vcu * NWAVES + wave, NGW = G * NWAVES;
    const int gt = gw * 64 + lane, NGT = NGW * 64;

    {
        int lane = threadIdx.x; asm volatile("" : "+v"(lane)); lane &= 63; const int gt = gw * 64 + lane;
        LAS float* scr = (LAS float*)(L + RING_OFF + wave * 16384);
        constexpr int I_1 = (DM / 64) * (IN_COLS / 32), I_2 = (DM / 64) * (DM / 32), I_3 = I_2;
        for (int it = gw; it < I_1 + I_2 + I_3; it += NGW) {
            int r = it;
            if (r < I_1) { p0_transpose_item<true>(w_in, DM, IN_COLS, W1T, scr, r, lane); continue; } r -= I_1;
            if (r < I_2) { p0_transpose_item<false>(w_out, DM, DM, W2T, scr, r, lane); continue; } r -= I_2;
            p0_transpose_item<false>(wq, DM, DM, W3T, scr, r, lane);
        }
        for (int m = gw; m < MROWS; m += NGW) {
            if (m < NTOK) ln_row_f32_to_bf16(x + (size_t)m * DM, ln_in_g, ln_in_b, H0 + (size_t)m * DM, lane);
            else if (m < NVALID) ln_row_f32_to_bf16(meta + (size_t)(m - NTOK) * DM, ln_in_g, ln_in_b, H0 + (size_t)m * DM, lane);
            else { GAS v4u* o = (GAS v4u*)(H0 + (size_t)m * DM) + lane;
#pragma unroll
                for (int j = 0; j < 4; ++j) o[64 * j] = (v4u){0u, 0u, 0u, 0u}; }
        }
        for (int e = gt; e < 16 * 128 * 128 / 8; e += NGT) { const GAS f32x4* src = (const GAS f32x4*)subkeys + 2 * (size_t)e; const f32x4 a = src[0], b2 = src[1];
            v4u o; o.x = pk2(a.x, a.y); o.y = pk2(a.z, a.w); o.z = pk2(b2.x, b2.y); o.w = pk2(b2.z, b2.w); ((GAS v4u*)SKB)[e] = o; }
    }
    GRID_BAR();

    {
        pg8::Gemm g{H0, W1T, MROWS, IN_COLS, DM}; pg8::StaticOrder S; S.init(MROWS, IN_COLS, G, bx);
        pg8::EpiProj E{QR, KA, VA, RK, RV, RG, QSCALE};
        pg8::gemm_phase<pg8::EpiProj, pg8::StaticOrder, true, true>(L + RING_OFF, g, S, E);
    }
    {
        constexpr int NQ = 16384 * DM / 4, CHQ = 16384, NCH = 2 * NQ / CHQ;
        for (;;) {
            int ch = 0; if (lane == 0) ch = (int)__hip_atomic_fetch_add((unsigned*)(ctl + CW_TABQ), 1u, __ATOMIC_RELAXED, __HIP_MEMORY_SCOPE_AGENT);
            ch = __builtin_amdgcn_readfirstlane(ch); if (ch >= NCH) break;
            const int which = ch >= NCH / 2; const float sc = which ? V_SCALE : U_QSCALE;
            const GAS f32x4* src = (const GAS f32x4*)(which ? v_tab : u_tab) + (size_t)(ch - which * (NCH / 2)) * CHQ + lane;
            GAS unsigned char* dstb = (GAS unsigned char*)(which ? (void*)VT : (void*)UT);
            const int i4b = (ch - which * (NCH / 2)) * CHQ + lane;
#pragma unroll 1
            for (int it = 0; it < CHQ / 64; it += 8) {
                f32x4 a[8];
#pragma unroll
                for (int u8 = 0; u8 < 8; ++u8) a[u8] = src[(it + u8) * 64];
#pragma unroll
                for (int u8 = 0; u8 < 8; ++u8) { const int i4 = i4b + (it + u8) * 64; const int row = i4 >> 9, q4 = i4 & 511;
                    int w;
                    if (which) { w = __builtin_amdgcn_cvt_pk_fp8_f32(a[u8].x * sc, a[u8].y * sc, 0, false); w = __builtin_amdgcn_cvt_pk_fp8_f32(a[u8].z * sc, a[u8].w * sc, w, true); }
                    else w = q8(a[u8].x * sc) | (q8(a[u8].y * sc) << 8) | (q8(a[u8].z * sc) << 16) | (q8(a[u8].w * sc) << 24);
                    *(GAS unsigned*)(dstb + ((size_t)(q4 >> 5) * 16384 + row) * 128 + (q4 & 31) * 4) = (unsigned)w; }
            }
        }
    }
    GRID_BAR();

    for (int u = bx; u < 256; u += G) attn_unit(L + RING_OFF, u, QR, KA, VA, sinks, tid, lane, wave);

    for (int u = bx; u < 256; u += G) scan_unit(L + RING_OFF, u, RK, RV, STB, tid, lane, wave);
    GRID_BAR();

    for (int u = bx; u < 512; u += G) retout_unit(L + RING_OFF, u, QR, RK, RV, RG, STB, tid, lane, wave);
    GRID_BAR();

    {
        pg8::Gemm g{QR, W2T, NTOK, DM, DM}; pg8::StaticOrder S; S.init(NTOK, DM, G, bx);
        pg8::EpiGen<1> E{Y, DM, H0, ALPHA, nullptr, nullptr, nullptr, nullptr, nullptr, nullptr};
        pg8::gemm_phase<pg8::EpiGen<1>, pg8::StaticOrder, true, true>(L + RING_OFF, g, S, E);
    }
    GRID_BAR();

    { int l5 = threadIdx.x; asm volatile("" : "+v"(l5)); l5 &= 63;
      for (int m = gw; m < NTOK; m += NGW) ln_row_bf16_to_bf16(Y + (size_t)m * DM, ln_mix_g, ln_mix_b, H1 + (size_t)m * DM, H1Q + (size_t)m * DM, HSC + m, l5); }
    GRID_BAR();

    {
        pg8::Gemm g{H1, W3T, NTOK, DM, DM}; pg8::StaticOrder S; S.init(NTOK, DM, G, bx);
        pg8::EpiGen<2> E{Q3, DM, nullptr, 0.f, nullptr, nullptr, nullptr, nullptr, nullptr, nullptr};
        pg8::gemm_phase<pg8::EpiGen<2>, pg8::StaticOrder, true, true>(L + RING_OFF, g, S, E);
    }
    GRID_BAR();

    const bool g8 = (G & 7) == 0; const int nbh = g8 ? (G >> 3) : G, hb = g8 ? (bx >> 3) : bx;
    for (int hd = g8 ? (bx & 7) : 0; hd < 8; hd += g8 ? 8 : 1) {
        __syncthreads();
#pragma unroll
        for (int i = 0; i < 8; ++i) { const int cid = tid + 512 * i, p = cid >> 11, n = (cid >> 4) & 127, ch = cid & 15;
            *(LAS v4u*)(L + RING_OFF + p * 32768 + n * 256 + ((ch ^ (n & 15)) << 4)) = *(const GAS v4u*)(SKB + ((size_t)((hd * 2 + p) * 128 + n)) * 128 + ch * 8); }
        __syncthreads();
        for (int tt = hb * NWAVES + wave; tt < NTOK / 32; tt += nbh * NWAVES) topk_unit((LAS unsigned*)(L + RING_OFF + 65536 + wave * 8192), L + RING_OFF, tt, hd, Q3, IDS, GATES, lane);
    }
    __syncthreads();
    GRID_BAR();

    int nx = 0, xr = 0, nloc = 1;
    { unsigned* bw = (unsigned*)(ctl + CW_BAR);
#pragma unroll
      for (unsigned j2 = 0; j2 < 16; ++j2) { const unsigned cnt = xb_ld(&bw[XB_XCNT(j2)]); nx += cnt > 0u; xr += (j2 < bar.x && cnt > 0u); if (j2 == bar.x) nloc = (int)cnt; }
      nx = __builtin_amdgcn_readfirstlane(nx); xr = __builtin_amdgcn_readfirstlane(xr); nloc = __builtin_amdgcn_readfirstlane(nloc); if (nx < 1) nx = 1; if (nloc < 1) nloc = 1; }
    const int lrank = __builtin_amdgcn_readfirstlane((int)MISC[10]);
    const int wv = lrank * NWAVES + wave, nwv = nloc * NWAVES;
    float* DOTX = (float*)(ws + WS_RK);
    bf16* CB = (bf16*)(ws + WS_KA);
    bf16* YB = (bf16*)(ws + WS_H0);
    {
        int tl = tid; asm volatile("" : "+v"(tl)); const int ln = tl & 63, k = ln >> 3, c8 = ln & 7;
        const unsigned char* UT8 = (const unsigned char*)UT;
        for (int s = xr; s < NSL; s += nx) {
            const unsigned char* Us = UT8 + (size_t)s * 16384 * 128;
            const bool first = (s == xr);
            v4u nid[2][2];
#pragma unroll
            for (int z = 0; z < 2; ++z) { const int tz = wv + z * nwv; const int tc = tz < NTOK ? tz : wv; const GAS v4u* ip = (const GAS v4u*)(IDS + (size_t)tc * 128 + 16 * k);
#pragma unroll
                for (int i = 0; i < 2; ++i) nid[z][i] = ip[i]; }
#pragma unroll 1
            for (int t = wv; t < NTOK; t += 2 * nwv) {
                const bool vB = (t + nwv) < NTOK; const int tt[2] = {t, vB ? t + nwv : t};
                v4u ub[2][16]; v4u hs[2]; int old[2][2];
#pragma unroll
                for (int z = 0; z < 2; ++z) {
#pragma unroll
                    for (int i = 0; i < 16; ++i) { const int pe = 2 * (i & 7) + (i >> 3); const unsigned eid = (nid[z][pe >> 3][(pe >> 1) & 3] >> (16 * (pe & 1))) & 0xffffu; ub[z][i] = *(const GAS v4u*)(Us + (size_t)eid * 128 + 16 * c8); }
                    hs[z] = *(const GAS v4u*)(H1Q + (size_t)tt[z] * DM + 128 * s + 16 * c8); }
#pragma unroll
                for (int z = 0; z < 2; ++z) { const v2u ov = first ? (v2u){0u, 0u} : *(const GAS v2u*)(DOTX + ((size_t)xr * NTOK + tt[z]) * 128 + 2 * ln); old[z][0] = (int)ov.x; old[z][1] = (int)ov.y; }
#pragma unroll
                for (int z = 0; z < 2; ++z) { const int tz = t + (2 + z) * nwv; const int tc = tz < NTOK ? tz : t; const GAS v4u* ip = (const GAS v4u*)(IDS + (size_t)tc * 128 + 16 * k);
#pragma unroll
                    for (int i = 0; i < 2; ++i) nid[z][i] = ip[i]; }
#pragma unroll
                for (int z = 0; z < 2; ++z) {
                    int p[16];
#pragma unroll
                    for (int i = 0; i < 16; ++i) { int d = 0;
                        d = __builtin_amdgcn_sdot4((int)ub[z][i].x, (int)hs[z].x, d, false); d = __builtin_amdgcn_sdot4((int)ub[z][i].y, (int)hs[z].y, d, false);
                        d = __builtin_amdgcn_sdot4((int)ub[z][i].z, (int)hs[z].z, d, false); d = __builtin_amdgcn_sdot4((int)ub[z][i].w, (int)hs[z].w, d, false); p[i] = d; }
                    const bool b0 = (c8 & 1) != 0, b1 = (c8 & 2) != 0, b2 = (c8 & 4) != 0;
                    int r1[8], r2[4], q0, q1;
#define DPPI(v, ctrl) __builtin_amdgcn_update_dpp(0, (v), (ctrl), 0xf, 0xf, true)
#pragma unroll
                    for (int m = 0; m < 8; ++m) { const int keep = b0 ? p[2 * m + 1] : p[2 * m], give = b0 ? p[2 * m] : p[2 * m + 1]; r1[m] = keep + DPPI(give, 0xB1); }
#pragma unroll
                    for (int m = 0; m < 4; ++m) { const int keep = b1 ? r1[2 * m + 1] : r1[2 * m], give = b1 ? r1[2 * m] : r1[2 * m + 1]; r2[m] = keep + DPPI(give, 0x4E); }
                    { const int keep = b2 ? r2[1] : r2[0], give = b2 ? r2[0] : r2[1]; const int gl = DPPI(give, 0x104), gr = DPPI(give, 0x114); q0 = keep + (b2 ? gr : gl); }
                    { const int keep = b2 ? r2[3] : r2[2], give = b2 ? r2[2] : r2[3]; const int gl = DPPI(give, 0x104), gr = DPPI(give, 0x114); q1 = keep + (b2 ? gr : gl); }
#undef DPPI
                    if (z == 0 || vB) *(GAS v2u*)(DOTX + ((size_t)xr * NTOK + tt[z]) * 128 + 2 * ln) = (v2u){(unsigned)(q0 + old[z][0]), (unsigned)(q1 + old[z][1])};
                }
            }
        }
    }
    GRID_BAR();
    for (int idx = gt; idx < NTOK * 128; idx += NGT) { int di = 0; for (int xx = 0; xx < nx; ++xx) di += ((const int*)DOTX)[(size_t)xx * NTOK * 128 + idx]; const float d = (float)di * (HSC[idx >> 7] * (1.0f / U_QSCALE)); CB[idx] = (bf16)f2bf((1.0f / V_SCALE) * GATES[idx] * gelu_erf(d)); }
    GRID_BAR();
    {
        int tl = tid; asm volatile("" : "+v"(tl)); const int ln = tl & 63, k = ln >> 3, c8 = ln & 7;
        const unsigned char* VT8 = (const unsigned char*)VT;
        for (int s = xr; s < NSL; s += nx) {
            const unsigned char* Vs = VT8 + (size_t)s * 16384 * 128;
            v4u nid[2][2];
#pragma unroll
            for (int z = 0; z < 2; ++z) { const int tz = wv + z * nwv; const int tc = tz < NTOK ? tz : wv; const GAS v4u* ip = (const GAS v4u*)(IDS + (size_t)tc * 128 + 16 * k);
#pragma unroll
                for (int i = 0; i < 2; ++i) nid[z][i] = ip[i]; }
#pragma unroll 1
            for (int t = wv; t < NTOK; t += 2 * nwv) {
                const bool vB = (t + nwv) < NTOK; const int tt[2] = {t, vB ? t + nwv : t};
                v4u vb[2][16]; v4u cf[2][2]; unsigned hs[2];
#pragma unroll
                for (int z = 0; z < 2; ++z) {
#pragma unroll
                    for (int i = 0; i < 16; ++i) { const unsigned eid = (nid[z][i >> 3][(i >> 1) & 3] >> (16 * (i & 1))) & 0xffffu; vb[z][i] = *(const GAS v4u*)(Vs + (size_t)eid * 128 + 16 * c8); } }
#pragma unroll
                for (int z = 0; z < 2; ++z) { hs[z] = *(const GAS unsigned*)(H1 + (size_t)tt[z] * DM + 128 * s + 16 * c8 + 2 * k);
                    const GAS v4u* cp = (const GAS v4u*)(CB + (size_t)tt[z] * 128 + 16 * k); cf[z][0] = cp[0]; cf[z][1] = cp[1]; }
#pragma unroll
                for (int z = 0; z < 2; ++z) { const int tz = t + (2 + z) * nwv; const int tc = tz < NTOK ? tz : t; const GAS v4u* ip = (const GAS v4u*)(IDS + (size_t)tc * 128 + 16 * k);
#pragma unroll
                    for (int i = 0; i < 2; ++i) nid[z][i] = ip[i]; }
#pragma unroll
                for (int z = 0; z < 2; ++z) {
                    f32x2 accp[8];
#pragma unroll
                    for (int q2 = 0; q2 < 8; ++q2) accp[q2] = (f32x2){0.f, 0.f};
#pragma unroll
                    for (int i = 0; i < 16; ++i) { const unsigned cw = cf[z][i >> 3][(i >> 1) & 3]; const float c = (i & 1) ? bfhi(cw) : bflo(cw); const f32x2 c2 = {c, c};
#pragma unroll
                        for (int dw = 0; dw < 4; ++dw) { const f32x2 fl = __builtin_amdgcn_cvt_pk_f32_fp8((int)vb[z][i][dw], false), fh = __builtin_amdgcn_cvt_pk_f32_fp8((int)vb[z][i][dw], true);
                            accp[2 * dw] = __builtin_elementwise_fma(fl, c2, accp[2 * dw]); accp[2 * dw + 1] = __builtin_elementwise_fma(fh, c2, accp[2 * dw + 1]); } }
                    const bool kb0 = (k & 1) != 0, kb1 = (k & 2) != 0, kb2 = (k & 4) != 0;
                    f32x2 rA[4], rB[2], rC;
#pragma unroll
                    for (int m = 0; m < 4; ++m) { const f32x2 keep = kb0 ? accp[2 * m + 1] : accp[2 * m], give = kb0 ? accp[2 * m] : accp[2 * m + 1];
                        rA[m] = keep + (f32x2){DPPF(give.x, 0x128), DPPF(give.y, 0x128)}; }
#pragma unroll
                    for (int m = 0; m < 2; ++m) { const f32x2 keep = kb1 ? rA[2 * m + 1] : rA[2 * m], give = kb1 ? rA[2 * m] : rA[2 * m + 1];
                        const auto sx = __builtin_amdgcn_permlane16_swap(__float_as_uint(give.x), __float_as_uint(give.x), false, false), sy = __builtin_amdgcn_permlane16_swap(__float_as_uint(give.y), __float_as_uint(give.y), false, false);
                        rB[m] = keep + (f32x2){__uint_as_float(kb1 ? sx[0] : sx[1]), __uint_as_float(kb1 ? sy[0] : sy[1])}; }
                    { const f32x2 keep = kb2 ? rB[1] : rB[0], give = kb2 ? rB[0] : rB[1];
                        const auto sx = __builtin_amdgcn_permlane32_swap(__float_as_uint(give.x), __float_as_uint(give.x), false, false), sy = __builtin_amdgcn_permlane32_swap(__float_as_uint(give.y), __float_as_uint(give.y), false, false);
                        rC = keep + (f32x2){__uint_as_float(kb2 ? sx[0] : sx[1]), __uint_as_float(kb2 ? sy[0] : sy[1])}; }
                    if (z == 0 || vB) *(GAS unsigned*)(YB + (size_t)tt[z] * DM + 128 * s + 16 * c8 + 2 * k) = cvtpk_s(rC.x + ALPHA * bflo(hs[z]), rC.y + ALPHA * bfhi(hs[z]));
                }
            }
        }
    }
    GRID_BAR();
    for (int m = gw; m < NTOK; m += NGW) {
        const GAS v4u* xr4 = (const GAS v4u*)(YB + (size_t)m * DM) + lane;
        float v[32]; float sm = 0.f;
#pragma unroll
        for (int j2 = 0; j2 < 4; ++j2) { const v4u w = xr4[64 * j2];
            v[8 * j2 + 0] = bflo(w.x); v[8 * j2 + 1] = bfhi(w.x); v[8 * j2 + 2] = bflo(w.y); v[8 * j2 + 3] = bfhi(w.y); v[8 * j2 + 4] = bflo(w.z); v[8 * j2 + 5] = bfhi(w.z); v[8 * j2 + 6] = bflo(w.w); v[8 * j2 + 7] = bfhi(w.w); }
#pragma unroll
        for (int i = 0; i < 32; ++i) sm += v[i];
        const float mean = wave_sum(sm) * (1.f / DM); float s2 = 0.f;
#pragma unroll
        for (int i = 0; i < 32; ++i) { v[i] -= mean; s2 += v[i] * v[i]; }
        const float rstd = 1.f / sqrtf(wave_sum(s2) * (1.f / DM) + LN_EPS);
#pragma unroll
        for (int j2 = 0; j2 < 4; ++j2) {
            const GAS f32x4* gp = (const GAS f32x4*)ln_ffn_g + 2 * (lane + 64 * j2); const GAS f32x4* bp = (const GAS f32x4*)ln_ffn_b + 2 * (lane + 64 * j2);
            const f32x4 g0 = gp[0], g1 = gp[1], b0 = bp[0], b1 = bp[1];
            GAS f32x4* op = (GAS f32x4*)(out + (size_t)m * DM) + 2 * (lane + 64 * j2);
            op[0] = (f32x4){v[8 * j2 + 0] * rstd * g0.x + b0.x, v[8 * j2 + 1] * rstd * g0.y + b0.y, v[8 * j2 + 2] * rstd * g0.z + b0.z, v[8 * j2 + 3] * rstd * g0.w + b0.w};
            op[1] = (f32x4){v[8 * j2 + 4] * rstd * g1.x + b1.x, v[8 * j2 + 5] * rstd * g1.y + b1.y, v[8 * j2 + 6] * rstd * g1.z + b1.z, v[8 * j2 + 7] * rstd * g1.w + b1.w}; }
    }
}

extern "C" void kernel_launch(void* const* d_in, const int* in_sizes, int n_in, void* d_out, int out_size, void* d_ws, size_t ws_size, hipStream_t stream) {
    static int grid = 0;
    if (grid == 0) {
        if (n_in != 15 || out_size != NTOK * DM || ws_size < WS_END) { fprintf(stderr, "kernel_launch: unexpected shapes (n_in %d out %d ws %zu)\n", n_in, out_size, ws_size); grid = -1; return; }
        int dev = 0, cus = 0, per_cu = 0;
        if (hipGetDevice(&dev) != hipSuccess || hipDeviceGetAttribute(&cus, hipDeviceAttributeMultiprocessorCount, dev) != hipSuccess) { grid = -1; return; }
        if (hipFuncSetAttribute((const void*)mk_fwd, hipFuncAttributeMaxDynamicSharedMemorySize, LDS_BYTES) != hipSuccess) { fprintf(stderr, "kernel_launch: hipFuncSetAttribute failed\n"); grid = -1; return; }
        if (hipOccupancyMaxActiveBlocksPerMultiprocessor(&per_cu, (const void*)mk_fwd, NWAVES * 64, LDS_BYTES) != hipSuccess || per_cu < 1) { fprintf(stderr, "kernel_launch: occupancy query says %d\n", per_cu); }
        (void)hipGetLastError();
        grid = cus;
    }
    if (grid < 0) return;
    if (hipMemsetAsync((char*)d_ws + WS_CTL, 0, CTL_ZERO_BYTES, stream) != hipSuccess) return;
    Args a{};
    for (int i = 0; i < 15; ++i) a.in[i] = (const float*)d_in[i];
    a.out = (float*)d_out; a.ws = (unsigned char*)d_ws;
    hipLaunchKernelGGL(mk_fwd, dim3(grid), dim3(NWAVES * 64), LDS_BYTES, stream, a);
}
```

```cpp
#include <hip/hip_runtime.h>
#include <cstdio>
#include <cstdint>
#include <cmath>
namespace pg8 {
#define PG8_LAS __attribute__((address_space(3)))
typedef unsigned short bf16_t;
typedef short bf16x8 __attribute__((ext_vector_type(8)));
typedef float f32x4 __attribute__((ext_vector_type(4)));
typedef unsigned u32x4 __attribute__((ext_vector_type(4)));
constexpr int BM = 256, BK = 64, HALF = 128, HTB = HALF * BK * 2  , STAGE_BYTES = 8 * HTB, NXCD = 8, WGM = 4;

__host__ __device__ __forceinline__ int lds_byte(int r, int c) { const int st = (r >> 4) * 2 + (c >> 5), rr = r & 15, cc = c & 31, ob = rr * 64 + cc * 2; return st * 1024 + (ob ^ (((ob >> 9) & 1) << 5)); }
__host__ __device__ __forceinline__ void stage_rc(int b, int& R, int& C) { const int st = b / 1024, sb = b % 1024, swz = sb ^ (((sb >> 9) & 1) << 5); R = (st >> 1) * 16 + swz / 64; C = (st & 1) * 32 + (swz % 64) / 2; }
__host__ __device__ __forceinline__ int perm32(int rho) { const int n = rho >> 4, i = rho & 15; return 8 * (i >> 2) + 4 * n + (i & 3); }

struct Unit { int pm, pn; };
struct Gemm { const bf16_t* A; const bf16_t* Bt; int M, N, K; };

struct StaticOrder {
    int nM, nN, nwg, G, c, wgm;
    __host__ __device__ void init(int M, int N, int G_, int c_, int wgm_ = WGM) { nM = M / BM; nN = N / BM; nwg = nM * nN; G = G_; c = c_; wgm = wgm_; }
    __host__ __device__ bool next(int i, Unit& u) const {
        const long L = (long)i * G + c; if (L >= nwg) return false;
        int wgid = (int)L; { const int q = nwg / NXCD, r = nwg % NXCD, xcd = wgid % NXCD, off = wgid / NXCD; wgid = (xcd < r ? xcd * (q + 1) : r * (q + 1) + (xcd - r) * q) + off; }
        const int nig = wgm * nN, gid = wgid / nig, fm = gid * wgm, gsz = (nM - fm) < wgm ? (nM - fm) : wgm;
        u.pm = fm + ((wgid % nig) % gsz); u.pn = (wgid % nig) / gsz; return true;
    }
    __device__ __forceinline__ void a_ready(const Unit&) const {}
    __device__ __forceinline__ void done(const Unit&) const {}
};

__device__ __forceinline__ unsigned cvt_pk_bf16(float lo, float hi) { unsigned r; asm volatile("v_cvt_pk_bf16_f32 %0, %1, %2" : "=v"(r) : "v"(lo), "v"(hi)); return r; }
typedef float f32x2 __attribute__((ext_vector_type(2)));

template <int MODE> struct EpiGen {
    static constexpr bool PERM = true, AFTER_DRAIN = false;
    bf16_t* O; int ldc; const bf16_t* R; float alpha;
    bf16_t *QR, *KA, *VA, *RK, *RV, *RG;
    __device__ __forceinline__ void operator()(const f32x4 (&acc)[2][2][4][2], const Unit& u, int wr, int wc, int fr, int fq) const {
        const int row0 = u.pm * BM + wr * 64 + fr;
#pragma unroll
        for (int bj = 0; bj < 2; ++bj) {
            const int col = u.pn * BM + bj * HALF + wc * 32 + 8 * fq;
            bf16_t* base = O; int ld = ldc; int cc = col;
            if (MODE == 0) {
                if (col < 1024)      { base = QR; ld = 2048; cc = col; }
                else if (col < 1152) { base = KA; ld = 128;  cc = col - 1024; }
                else if (col < 1280) { base = VA; ld = 128;  cc = col - 1152; }
                else if (col < 2304) { base = QR; ld = 2048; cc = col - 1280 + 1024; }
                else if (col < 3328) { base = RK; ld = 1024; cc = col - 2304; }
                else if (col < 4352) { base = RV; ld = 1024; cc = col - 3328; }
                else                 { base = RG; ld = 1024; cc = col - 4352; }
            }
#pragma unroll
            for (int ai = 0; ai < 2; ++ai)
#pragma unroll
                for (int m = 0; m < 4; ++m) {
                    const int row = row0 + ai * HALF + m * 16;
                    f32x4 v0 = acc[ai][bj][m][0], v1 = acc[ai][bj][m][1];
                    if (MODE == 1) {
                        const u32x4 r = *(const u32x4*)(R + (size_t)row * ldc + col);
                        v0[0] += alpha * __uint_as_float(r.x << 16); v0[1] += alpha * __uint_as_float(r.x & 0xffff0000u);
                        v0[2] += alpha * __uint_as_float(r.y << 16); v0[3] += alpha * __uint_as_float(r.y & 0xffff0000u);
                        v1[0] += alpha * __uint_as_float(r.z << 16); v1[1] += alpha * __uint_as_float(r.z & 0xffff0000u);
                        v1[2] += alpha * __uint_as_float(r.w << 16); v1[3] += alpha * __uint_as_float(r.w & 0xffff0000u);
                    }
                    u32x4 w; w.x = cvt_pk_bf16(v0[0], v0[1]); w.y = cvt_pk_bf16(v0[2], v0[3]); w.z = cvt_pk_bf16(v1[0], v1[1]); w.w = cvt_pk_bf16(v1[2], v1[3]);
                    *(u32x4*)(base + (size_t)row * ld + cc) = w;
                }
        }
    }
};

struct EpiProj {
    static constexpr bool PERM = true, AFTER_DRAIN = false;
    bf16_t *QR, *KA, *VA, *RK, *RV, *RG; float qscale;
    __device__ __forceinline__ void operator()(const f32x4 (&acc)[2][2][4][2], const Unit& u, int wr, int wc, int fr, int fq) const {
        const int pn = u.pn, row0 = u.pm * BM + wr * 64 + fr, c0 = wc * 32 + 8 * fq;
        const bool rope = (pn <= 3) || (pn == 4 && wc < 2) || (pn >= 5 && pn <= 12);
        if (rope) {
            const bool ret = pn >= 5; const int h = ret ? ((pn - 5) & 3) : 0;
            const float lg = __builtin_amdgcn_logf(1.0f - __builtin_amdgcn_exp2f(-5.0f - (float)h));
            float invrev[8];
#pragma unroll
            for (int i8 = 0; i8 < 8; ++i8) { const float ii = (float)((ret ? c0 : 8 * fq) + i8); invrev[i8] = 0.15915494309189535f * __builtin_amdgcn_exp2f(-ii * (ret ? 0.10381025296523008f : 0.4152410118609203f)); }
            bf16_t* base; int ld, cA, cB;
            if (pn <= 3)      { base = QR; ld = 2048; cA = pn * 256 + 64 * wc + 8 * fq; cB = cA + 32; }
            else if (pn == 4) { base = KA; ld = 128;  cA = 64 * wc + 8 * fq; cB = cA + 32; }
            else if (pn <= 8) { base = QR; ld = 2048; cA = 1024 + 256 * h + c0; cB = cA + 128; }
            else              { base = RK; ld = 1024; cA = 256 * h + c0; cB = cA + 128; }
#pragma unroll
            for (int ai = 0; ai < 2; ++ai)
#pragma unroll
                for (int m = 0; m < 4; ++m) {
                    const int row = row0 + ai * HALF + m * 16;
                    int pos, ipos;
                    if (row < 16384) { const int s = row & 4095; pos = 16 + s; ipos = s & 127; } else { int j = row - 16384; if (j > 15) j = 15; pos = j; ipos = 112 + j; }
                    float sc = qscale;
                    if (pn == 4) sc = 1.0f; else if (pn >= 9) sc = 0.0625f * __builtin_amdgcn_exp2f(-(float)(ipos + 1) * lg); else if (pn >= 5) sc = __builtin_amdgcn_exp2f((float)(ipos + 1) * lg);
                    const float pf = (float)pos;
                    float cs[8], sn[8];
#pragma unroll
                    for (int i8 = 0; i8 < 8; ++i8) { const float rev = __builtin_amdgcn_fractf(pf * invrev[i8]); cs[i8] = __builtin_amdgcn_cosf(rev); sn[i8] = __builtin_amdgcn_sinf(rev); }
                    const f32x4 a0 = acc[ai][0][m][0], a1 = acc[ai][0][m][1], b0 = acc[ai][1][m][0], b1 = acc[ai][1][m][1];
                    u32x4 wA, wB;
                    wA.x = cvt_pk_bf16((a0[0] * cs[0] - b0[0] * sn[0]) * sc, (a0[1] * cs[1] - b0[1] * sn[1]) * sc); wA.y = cvt_pk_bf16((a0[2] * cs[2] - b0[2] * sn[2]) * sc, (a0[3] * cs[3] - b0[3] * sn[3]) * sc);
                    wA.z = cvt_pk_bf16((a1[0] * cs[4] - b1[0] * sn[4]) * sc, (a1[1] * cs[5] - b1[1] * sn[5]) * sc); wA.w = cvt_pk_bf16((a1[2] * cs[6] - b1[2] * sn[6]) * sc, (a1[3] * cs[7] - b1[3] * sn[7]) * sc);
                    wB.x = cvt_pk_bf16((b0[0] * cs[0] + a0[0] * sn[0]) * sc, (b0[1] * cs[1] + a0[1] * sn[1]) * sc); wB.y = cvt_pk_bf16((b0[2] * cs[2] + a0[2] * sn[2]) * sc, (b0[3] * cs[3] + a0[3] * sn[3]) * sc);
                    wB.z = cvt_pk_bf16((b1[0] * cs[4] + a1[0] * sn[4]) * sc, (b1[1] * cs[5] + a1[1] * sn[5]) * sc); wB.w = cvt_pk_bf16((b1[2] * cs[6] + a1[2] * sn[6]) * sc, (b1[3] * cs[7] + a1[3] * sn[7]) * sc);
                    *(u32x4*)(base + (size_t)row * ld + cA) = wA; *(u32x4*)(base + (size_t)row * ld + cB) = wB;
                }
        } else {
            const bool silu = pn >= 17;
#pragma unroll
            for (int bj = 0; bj < 2; ++bj) {
                bf16_t* base; int ld, cc;
                if (pn == 4)       { base = VA; ld = 128;  cc = 64 * bj + 32 * (wc - 2) + 8 * fq; }
                else if (pn <= 16) { base = RV; ld = 1024; cc = 256 * (pn - 13) + 128 * bj + c0; }
                else               { base = RG; ld = 1024; cc = 256 * (pn - 17) + 128 * bj + c0; }
#pragma unroll
                for (int ai = 0; ai < 2; ++ai)
#pragma unroll
                    for (int m = 0; m < 4; ++m) {
                        const int row = row0 + ai * HALF + m * 16;
                        f32x4 v0 = acc[ai][bj][m][0], v1 = acc[ai][bj][m][1];
                        if (silu) {
#pragma unroll
                            for (int e = 0; e < 4; ++e) { v0[e] = v0[e] * __builtin_amdgcn_rcpf(1.0f + __builtin_amdgcn_exp2f(-1.4426950408889634f * v0[e])); v1[e] = v1[e] * __builtin_amdgcn_rcpf(1.0f + __builtin_amdgcn_exp2f(-1.4426950408889634f * v1[e])); } }
                        u32x4 w; w.x = cvt_pk_bf16(v0[0], v0[1]); w.y = cvt_pk_bf16(v0[2], v0[3]); w.z = cvt_pk_bf16(v1[0], v1[1]); w.w = cvt_pk_bf16(v1[2], v1[3]);
                        *(u32x4*)(base + (size_t)row * ld + cc) = w;
                    }
            }
        }
    }
};
struct NoHook { __device__ __forceinline__ void operator()(int) const {} };
template <class Epi, class Sched, bool ALIGN_EPI = false, bool SP2 = false, class Hook = NoHook>
__device__ __forceinline__ void gemm_phase(PG8_LAS unsigned char* lds, const Gemm g, const Sched& S, const Epi& E, const Hook& H = Hook()) {
    const int tid = threadIdx.x, wid = __builtin_amdgcn_readfirstlane(tid >> 6), lane = tid & 63, wr = wid >> 2, wc = wid & 3, fr = lane & 15, fq = lane >> 4;
    const int K = g.K, nt = K / BK;
    unsigned voffA[2], voffB[2];
#pragma unroll
    for (int i = 0; i < 2; ++i) { int R, C; stage_rc(tid * 16 + i * 8192, R, C); const int Rb = Epi::PERM ? ((R & ~31) + perm32(R & 31)) : R;
        voffA[i] = (unsigned)(R * K + C) * 2u; voffB[i] = (unsigned)(Rb * K + C) * 2u; }
    const size_t kstep = (size_t)(BK * 2);
    const size_t hstep = (size_t)HALF * K * 2;
    const size_t tstep = 2 * hstep;
    const unsigned ldsw = (unsigned)wid * 1024u;
    const int aoff = lds_byte(wr * 64 + fr, fq * 8), boff = lds_byte(wc * 32 + fr, fq * 8);
#define PG8_SA(b, h) (((b) * 2 + (h)) * HTB)
#define PG8_SB(b, h) ((4 + (b) * 2 + (h)) * HTB)
#define PG8_STAGE(bufoff, gbase, voff) do { _Pragma("unroll") for (int _i = 0; _i < 2; ++_i) \
        __builtin_amdgcn_global_load_lds((const unsigned*)((const char*)(gbase) + (voff)[_i]), (PG8_LAS unsigned*)(lds + (bufoff) + ldsw + _i * 8192), 16, 0, 0); } while (0)
#define PG8_LDA(dst, b, h) do { _Pragma("unroll") for (int m = 0; m < 4; ++m) _Pragma("unroll") for (int k = 0; k < 2; ++k) dst[m][k] = *(const PG8_LAS bf16x8*)(lds + PG8_SA(b, h) + aoff + m * 2048 + k * 1024); } while (0)
#define PG8_LDB(dst, b, h) do { _Pragma("unroll") for (int n = 0; n < 2; ++n) _Pragma("unroll") for (int k = 0; k < 2; ++k) dst[n][k] = *(const PG8_LAS bf16x8*)(lds + PG8_SB(b, h) + boff + n * 2048 + k * 1024); } while (0)
#define PG8_MMA(ai, bj, At, Bt) do { __builtin_amdgcn_s_setprio(1); _Pragma("unroll") for (int m = 0; m < 4; ++m) _Pragma("unroll") for (int n = 0; n < 2; ++n) _Pragma("unroll") for (int k = 0; k < 2; ++k) \
        acc[ai][bj][m][n] = __builtin_amdgcn_mfma_f32_16x16x32_bf16(Bt[n][k], At[m][k], acc[ai][bj][m][n], 0, 0, 0); __builtin_amdgcn_s_setprio(0); } while (0)
#define PG8_WAIT_V(n) asm volatile("s_waitcnt vmcnt(" #n ")" ::: "memory")
#define PG8_WAIT_L(n) asm volatile("s_waitcnt lgkmcnt(" #n ")" ::: "memory")
#define PG8_BAR __builtin_amdgcn_s_barrier()
#define PG8_SCHED __builtin_amdgcn_sched_barrier(0)
    Unit cur, nxt; int ui = 0;
    if (!S.next(0, cur)) return;
    f32x4 acc[2][2][4][2];
#pragma unroll
    for (int a = 0; a < 2; ++a)
#pragma unroll
        for (int b = 0; b < 2; ++b)
#pragma unroll
            for (int m = 0; m < 4; ++m)
#pragma unroll
                for (int n = 0; n < 2; ++n) acc[a][b][m][n] = (f32x4){0.f, 0.f, 0.f, 0.f};
    bf16x8 At[4][2], B0[2][2], B1[2][2];
    const char* cA = (const char*)g.A + (size_t)cur.pm * tstep; const char* cB = (const char*)g.Bt + (size_t)cur.pn * tstep;
    S.a_ready(cur);
    if constexpr (SP2) {
        PG8_STAGE(PG8_SB(0, 0), cB, voffB); PG8_STAGE(PG8_SB(0, 1), cB + hstep, voffB); PG8_STAGE(PG8_SA(0, 0), cA, voffA); PG8_STAGE(PG8_SA(0, 1), cA + hstep, voffA);
        if (wr == 1) PG8_BAR;
        PG8_WAIT_V(2); PG8_BAR;
        PG8_STAGE(PG8_SB(1, 0), cB + kstep, voffB); PG8_STAGE(PG8_SA(1, 0), cA + kstep, voffA); PG8_STAGE(PG8_SB(1, 1), cB + hstep + kstep, voffB);
        PG8_WAIT_V(6); PG8_BAR;
    } else {
        PG8_STAGE(PG8_SB(0, 0), cB, voffB); PG8_STAGE(PG8_SA(0, 0), cA, voffA); PG8_STAGE(PG8_SB(0, 1), cB + hstep, voffB); PG8_STAGE(PG8_SA(0, 1), cA + hstep, voffA);
        if (wr == 1) PG8_BAR;
        PG8_WAIT_V(4); PG8_BAR;
        PG8_STAGE(PG8_SB(1, 0), cB + kstep, voffB); PG8_STAGE(PG8_SA(1, 0), cA + kstep, voffA); PG8_STAGE(PG8_SB(1, 1), cB + hstep + kstep, voffB);
        PG8_WAIT_V(6); PG8_BAR;
    }
    for (;;) {
        const bool has_next = S.next(ui + 1, nxt);
        const char* nA = has_next ? (const char*)g.A + (size_t)nxt.pm * tstep : cA; const char* nB = has_next ? (const char*)g.Bt + (size_t)nxt.pn * tstep : cB;
        for (int t = 0; t < nt; t += 2) {
            const bool last = (t == nt - 2);
            const char* a1 = cA + (size_t)(t + 1) * kstep;
            const char* a2 = last ? nA : cA + (size_t)(t + 2) * kstep; const char* b2 = last ? nB : cB + (size_t)(t + 2) * kstep;
            const char* a3 = a2 + kstep; const char* b3 = b2 + kstep;
            if (last && has_next) S.a_ready(nxt);
            if constexpr (SP2) {
            PG8_LDB(B0, 0, 0); PG8_LDB(B1, 0, 1); PG8_SCHED; PG8_LDA(At, 0, 0); PG8_STAGE(PG8_SA(1, 1), a1 + hstep, voffA);
            PG8_WAIT_V(8); PG8_WAIT_L(0); PG8_BAR; PG8_MMA(0, 0, At, B0); PG8_MMA(0, 1, At, B1); PG8_BAR; PG8_SCHED;
            PG8_LDA(At, 0, 1); PG8_STAGE(PG8_SB(0, 0), b2, voffB); PG8_STAGE(PG8_SB(0, 1), b2 + hstep, voffB); PG8_STAGE(PG8_SA(0, 0), a2, voffA);
            PG8_WAIT_V(8); PG8_WAIT_L(0); PG8_BAR; PG8_MMA(1, 0, At, B0); PG8_MMA(1, 1, At, B1); PG8_BAR; PG8_SCHED;
            PG8_LDB(B0, 1, 0); PG8_LDB(B1, 1, 1); PG8_SCHED; PG8_LDA(At, 1, 0); PG8_STAGE(PG8_SA(0, 1), a2 + hstep, voffA);
            PG8_WAIT_V(8); PG8_WAIT_L(0); PG8_BAR; PG8_MMA(0, 0, At, B0); PG8_MMA(0, 1, At, B1); PG8_BAR; PG8_SCHED;
            PG8_LDA(At, 1, 1); PG8_STAGE(PG8_SB(1, 0), b3, voffB); PG8_STAGE(PG8_SB(1, 1), b3 + hstep, voffB); PG8_STAGE(PG8_SA(1, 0), a3, voffA);
            PG8_WAIT_V(8); PG8_WAIT_L(0); PG8_BAR; PG8_MMA(1, 0, At, B0); PG8_MMA(1, 1, At, B1); PG8_BAR; PG8_SCHED;
            } else {
            PG8_LDB(B0, 0, 0); PG8_SCHED; PG8_LDA(At, 0, 0); PG8_STAGE(PG8_SA(1, 1), a1 + hstep, voffA);
            PG8_WAIT_L(8); PG8_BAR; PG8_WAIT_L(0); PG8_MMA(0, 0, At, B0); PG8_BAR; PG8_SCHED;
            PG8_LDB(B1, 0, 1); PG8_STAGE(PG8_SB(0, 0), b2, voffB);
            PG8_BAR; PG8_WAIT_L(0); PG8_MMA(0, 1, At, B1); PG8_BAR;
            PG8_LDA(At, 0, 1); PG8_STAGE(PG8_SA(0, 0), a2, voffA);
            PG8_BAR; PG8_WAIT_L(0); PG8_MMA(1, 0, At, B0); PG8_BAR; PG8_SCHED;
            PG8_STAGE(PG8_SB(0, 1), b2 + hstep, voffB);
            PG8_WAIT_V(6); PG8_BAR; PG8_MMA(1, 1, At, B1); PG8_BAR;
            PG8_LDB(B0, 1, 0); PG8_SCHED; PG8_LDA(At, 1, 0); PG8_STAGE(PG8_SA(0, 1), a2 + hstep, voffA);
            PG8_WAIT_L(8); PG8_BAR; PG8_WAIT_L(0); PG8_MMA(0, 0, At, B0); PG8_BAR; PG8_SCHED;
            PG8_LDB(B1, 1, 1); PG8_STAGE(PG8_SB(1, 0), b3, voffB);
            PG8_BAR; PG8_WAIT_L(0); PG8_MMA(0, 1, At, B1); PG8_BAR;
            PG8_LDA(At, 1, 1); PG8_STAGE(PG8_SA(1, 0), a3, voffA);
            PG8_BAR; PG8_WAIT_L(0); PG8_MMA(1, 0, At, B0); PG8_BAR; PG8_SCHED;
            PG8_STAGE(PG8_SB(1, 1), b3 + hstep, voffB);
            PG8_WAIT_V(6); PG8_BAR; PG8_MMA(1, 1, At, B1); PG8_BAR;
            }
        }
        if constexpr (ALIGN_EPI) { if (wr == 0) PG8_BAR; }
        if constexpr (!Epi::AFTER_DRAIN) { E(acc, cur, wr, wc, fr, fq); S.done(cur); }
        if (!has_next) break;
        H(ui);
#pragma unroll
        for (int a = 0; a < 2; ++a)
#pragma unroll
            for (int b = 0; b < 2; ++b)
#pragma unroll
                for (int m = 0; m < 4; ++m)
#pragma unroll
                    for (int n = 0; n < 2; ++n) acc[a][b][m][n] = (f32x4){0.f, 0.f, 0.f, 0.f};
        cur = nxt; cA = nA; cB = nB; ++ui;
        if constexpr (ALIGN_EPI) { if (wr == 1) PG8_BAR; }
    }
    PG8_WAIT_V(0);
    if constexpr (!ALIGN_EPI) { if (wr == 0) PG8_BAR; }
    PG8_BAR;
    if constexpr (Epi::AFTER_DRAIN) { E.fused(acc, cur, wr, wc, fr, fq, lds, wid, lane); S.done(cur); }
#undef PG8_SA
#undef PG8_SB
#undef PG8_STAGE
#undef PG8_LDA
#undef PG8_LDB
#undef PG8_MMA
#undef PG8_WAIT_V
#undef PG8_WAIT_L
#undef PG8_BAR
#undef PG8_SCHED
}
}

constexpr int NWAVES = 8;
constexpr int DM = 2048, NB = 4, SEQ = 4096, NTOK = NB * SEQ;
constexpr int NMETA = 16, NVALID = NTOK + NMETA, MROWS = 16640;
constexpr int IN_COLS = 5376;
constexpr float LN_EPS = 1e-5f, GN_EPS = 1e-5f;
constexpr float ALPHA = 1.189207115002721f;
constexpr float LOG2E = 1.4426950408889634f;
constexpr float QSCALE = 0.125f * LOG2E;
constexpr float U_QSCALE = 958.0f;
constexpr float V_QSCALE = 35.6f;
constexpr int NSL = 16;

constexpr size_t MiB = 1u << 20;
constexpr size_t WS_CTL = 0, CTL_ZERO_BYTES = 65536;
constexpr size_t SZ_SK = (size_t)16 * 128 * 128 * 2, SZ_ROPE_R = (size_t)4112 * 128 * 8, SZ_ROPE_A = (size_t)4112 * 32 * 8;
constexpr size_t SZ_W2T = (size_t)DM * DM * 2, SZ_W1T = (size_t)IN_COLS * DM * 2, SZ_TAB = (size_t)16384 * DM * 2;
constexpr size_t SZ_ROWS2K = (size_t)MROWS * 2048 * 2, SZ_ROWS1K = (size_t)MROWS * 1024 * 2, SZ_ROWS128 = (size_t)MROWS * 128 * 2;
constexpr size_t SZ_TOK2K = (size_t)NTOK * 2048 * 2, SZ_ST = (size_t)16 * 32 * 256 * 256 * 2, SZ_IDS = (size_t)NTOK * 128 * 4;
constexpr size_t al256(size_t x) { return (x + 255) & ~(size_t)255; }
constexpr size_t WS_SK = 1 * MiB;
constexpr size_t WS_ROPE_R = al256(WS_SK + SZ_SK);
constexpr size_t WS_ROPE_A = al256(WS_ROPE_R + SZ_ROPE_R);
constexpr size_t WS_W2T = al256(WS_ROPE_A + SZ_ROPE_A), WS_W3T = al256(WS_W2T + SZ_W2T), WS_W1T = al256(WS_W3T + SZ_W2T);
constexpr size_t WS_UT = al256(WS_W1T + SZ_W1T), WS_VT = al256(WS_UT + SZ_TAB);
constexpr size_t WS_H0 = al256(WS_VT + SZ_TAB);
constexpr size_t WS_QR = al256(WS_H0 + SZ_ROWS2K);
constexpr size_t WS_KA = al256(WS_QR + SZ_ROWS2K), WS_VA = al256(WS_KA + SZ_ROWS128);
constexpr size_t WS_RK = al256(WS_VA + SZ_ROWS128), WS_RV = al256(WS_RK + SZ_ROWS1K), WS_RG = al256(WS_RV + SZ_ROWS1K);
constexpr size_t WS_ST = al256(WS_RG + SZ_ROWS1K);
constexpr size_t WS_Y = WS_RK;
constexpr size_t WS_H1 = WS_ST;
constexpr size_t WS_IDS = al256(WS_ST + SZ_ST), WS_GATES = al256(WS_IDS + SZ_IDS);
constexpr size_t WS_HSC = al256(WS_GATES + SZ_IDS);
constexpr size_t WS_CSC = al256(WS_HSC + (size_t)NTOK * 4);
constexpr size_t WS_END = al256(WS_CSC + (size_t)NTOK * 4);
static_assert(WS_Y + SZ_TOK2K <= WS_RG, "Y overlays RK|RV only");
static_assert(SZ_TOK2K <= SZ_ST && (size_t)NTOK * 1024 * 4 <= SZ_ST, "H1 / RET_RAW fit the state region");
static_assert(WS_END <= (size_t)512 * MiB, "workspace map fits 4 x largest tensor");
static_assert(WS_RK + (size_t)8 * NTOK * 128 * 4 <= WS_ST && WS_KA + (size_t)NTOK * 128 * 4 <= WS_RK && WS_H0 + (size_t)NTOK * DM * 4 <= WS_KA, "expert-phase overlays (DOTX over RK|RV, CB over KA|VA, Y32 over H0|QR)");
constexpr int CW_TMO = 0, CW_TABQ = 64, CW_BAR = 4096;

constexpr int RING_OFF = 0, RING_BYTES = 131072;
constexpr int LDSCTL_OFF = RING_BYTES, MISC_OFF = LDSCTL_OFF + 320;
constexpr int LDS_BYTES = 147456;

#define GAS __attribute__((address_space(1)))
#define LAS __attribute__((address_space(3)))
typedef unsigned short bf16;
typedef unsigned v4u __attribute__((ext_vector_type(4)));
typedef unsigned v2u __attribute__((ext_vector_type(2)));
typedef float f32x4 __attribute__((ext_vector_type(4)));
typedef float f32x2 __attribute__((ext_vector_type(2)));
typedef GAS unsigned gu32;
typedef __bf16 bf16x2_t __attribute__((ext_vector_type(2)));
#define RLX_AGENT __ATOMIC_RELAXED, __HIP_MEMORY_SCOPE_AGENT
#define LDS_WAIT() asm volatile("s_waitcnt lgkmcnt(0)" ::: "memory")
#define VM_WAIT() asm volatile("s_waitcnt vmcnt(0)" ::: "memory")
#define LDS_BAR() do { asm volatile("s_waitcnt lgkmcnt(0)" ::: "memory"); __builtin_amdgcn_s_barrier(); asm volatile("" ::: "memory"); } while (0)
__device__ __forceinline__ unsigned f2bf(float f) { unsigned u = __builtin_bit_cast(unsigned, f); return (u + 0x7fffu + ((u >> 16) & 1u)) >> 16; }
__device__ __forceinline__ unsigned pk2(float lo, float hi) { return f2bf(lo) | (f2bf(hi) << 16); }
__device__ __forceinline__ float bflo(unsigned w) { return __uint_as_float(w << 16); }
__device__ __forceinline__ float bfhi(unsigned w) { return __uint_as_float(w & 0xffff0000u); }
__device__ __forceinline__ float bf2f(bf16 h) { return __uint_as_float((unsigned)h << 16); }

#define XB_TMO      128
#define XB_XCNT(j)  (256  + 64 * (j))
#define XB_XSUB(j)  (1280 + 64 * (j))
#define XB_XGEN(j)  (2304 + 64 * (j))
#define XB_TOP      3328
#define XB_TOPGEN   3392
#define XCD_BAR_WORDS 3456
#define XB_SPIN_CAP (1u << 18)

__device__ __forceinline__ unsigned xb_ld(unsigned* p)              { return __hip_atomic_load(p, __ATOMIC_RELAXED, __HIP_MEMORY_SCOPE_AGENT); }
__device__ __forceinline__ unsigned xb_add(unsigned* p, unsigned v) { return __hip_atomic_fetch_add(p, v, __ATOMIC_RELAXED, __HIP_MEMORY_SCOPE_AGENT); }
__device__ __forceinline__ unsigned xb_xcc_id() { return (unsigned)__builtin_amdgcn_s_getreg((3 << 11) | 20) & 0xFu; }
#define XB_SPIN(cond, bar) do { unsigned _sp = 0; while (cond) { __builtin_amdgcn_s_sleep(1); \
    if ((++_sp & 255u) == 0u) { if (xb_ld(&(bar)[XB_TMO])) break; if (_sp > XB_SPIN_CAP) { atomicAdd(&(bar)[XB_TMO], 1u); break; } } } } while (0)

struct XcdBarrier {
    unsigned* bar; unsigned x;
    volatile LAS unsigned* st;
};

__device__ __forceinline__ XcdBarrier xcd_barrier_post(unsigned* bar, volatile LAS unsigned* st) {
    XcdBarrier b; b.bar = bar; b.x = xb_xcc_id(); b.st = st;
    if (threadIdx.x == 0) (void)xb_add(&bar[XB_XCNT(b.x)], 1u);
    return b;
}
__device__ __forceinline__ void xcd_barrier_complete(unsigned* bar, unsigned x, unsigned& nloc, unsigned& nx) {
    const unsigned G = gridDim.x * gridDim.y * gridDim.z;
    unsigned sum, cnt, mine, sp = 0u;
    for (;;) {
        sum = 0u; cnt = 0u; mine = 0u;
#pragma unroll
        for (unsigned j = 0; j < 16; ++j) { const unsigned c = xb_ld(&bar[XB_XCNT(j)]); sum += c; cnt += (c > 0u) ? 1u : 0u; mine = (j == x) ? c : mine; }
        if (sum == G) break;
        __builtin_amdgcn_s_sleep(1);
        if ((++sp & 255u) == 0u) { if (xb_ld(&bar[XB_TMO])) break; if (sp > XB_SPIN_CAP) { atomicAdd(&bar[XB_TMO], 1u); break; } }
    }
    nloc = mine > 0u ? mine : 1u; nx = cnt > 0u ? cnt : 1u;
}

__device__ __forceinline__ void xcd_barrier(const XcdBarrier& b) {
    asm volatile("s_waitcnt vmcnt(0)" ::: "memory");
    __syncthreads();
    if (threadIdx.x == 0) {
        unsigned* bar = b.bar;
        __builtin_amdgcn_s_waitcnt(0);
        unsigned nloc = b.st[0], nx = b.st[1];
        if (nloc == 0u) { xcd_barrier_complete(bar, b.x, nloc, nx); b.st[0] = nloc; b.st[1] = nx; }
        const unsigned old = xb_add(&bar[XB_XSUB(b.x)], 1u);
        const unsigned gen = old / nloc;
        if (old + 1u == (gen + 1u) * nloc) {
            __builtin_amdgcn_fence(__ATOMIC_RELEASE, "agent");
            asm volatile("s_waitcnt vmcnt(0)" ::: "memory");
            const unsigned og = xb_add(&bar[XB_TOP], 1u);
            const unsigned tg = og / nx;
            if (og + 1u == (tg + 1u) * nx) xb_add(&bar[XB_TOPGEN], 1u);
            else XB_SPIN(xb_ld(&bar[XB_TOPGEN]) == tg, bar);
            __builtin_amdgcn_fence(__ATOMIC_ACQUIRE, "agent");
            xb_add(&bar[XB_XGEN(b.x)], 1u);
            asm volatile("s_waitcnt vmcnt(0)" ::: "memory");
        } else {
            XB_SPIN(xb_ld(&bar[XB_XGEN(b.x)]) == gen, bar);
            __builtin_amdgcn_fence(__ATOMIC_ACQUIRE, "agent");
            asm volatile("s_waitcnt vmcnt(0)" ::: "memory");
        }
    }
    __syncthreads();
}


__device__ __forceinline__ float dot2bf(unsigned a, unsigned b, float c) { asm("v_dot2c_f32_bf16 %0, %1, %2" : "+v"(c) : "v"(a), "v"(b)); return c; }
__device__ __forceinline__ float dot8bf_dpp(v4u a, v4u b) { float c = 0.f; asm("v_dot2c_f32_bf16 %0, %1, %5\n\tv_dot2c_f32_bf16 %0, %2, %6\n\tv_dot2c_f32_bf16 %0, %3, %7\n\tv_dot2c_f32_bf16 %0, %4, %8\n\ts_nop 1" : "+v"(c) : "v"(a.x), "v"(a.y), "v"(a.z), "v"(a.w), "v"(b.x), "v"(b.y), "v"(b.z), "v"(b.w)); return c; }
#define DPPF(v, ctrl) __int_as_float(__builtin_amdgcn_update_dpp(0, __float_as_int(v), (ctrl), 0xf, 0xf, true))
__device__ __forceinline__ int q8(float x) { int q = (int)__builtin_rintf(x); q = q < -127 ? -127 : (q > 127 ? 127 : q); return q & 0xff; }
__device__ __forceinline__ float wave_sum(float v) {
    v += DPPF(v, 0xB1); v += DPPF(v, 0x4E); v += DPPF(v, 0x141); v += DPPF(v, 0x128);
    { const auto r16 = __builtin_amdgcn_permlane16_swap(__float_as_uint(v), __float_as_uint(v), false, false); v = __uint_as_float(r16[0]) + __uint_as_float(r16[1]); }
    { const auto r32 = __builtin_amdgcn_permlane32_swap(__float_as_uint(v), __float_as_uint(v), false, false); v = __uint_as_float(r32[0]) + __uint_as_float(r32[1]); }
    return v;
}
__device__ __forceinline__ float wave_max(float v) {
    v = fmaxf(v, DPPF(v, 0xB1)); v = fmaxf(v, DPPF(v, 0x4E)); v = fmaxf(v, DPPF(v, 0x141)); v = fmaxf(v, DPPF(v, 0x128));
    { const auto r16 = __builtin_amdgcn_permlane16_swap(__float_as_uint(v), __float_as_uint(v), false, false); v = fmaxf(__uint_as_float(r16[0]), __uint_as_float(r16[1])); }
    { const auto r32 = __builtin_amdgcn_permlane32_swap(__float_as_uint(v), __float_as_uint(v), false, false); v = fmaxf(__uint_as_float(r32[0]), __uint_as_float(r32[1])); }
    return v;
}
__device__ __forceinline__ float gelu_erf(float v) {
    const float av = fabsf(v), d = av * 0.2316418882f + 1.0f;
    const float t = __builtin_amdgcn_rcpf(d);
    float q = t * 0.5307027145f + (-0.7265760135f); q = q * t + 0.7107068705f; q = q * t + (-0.142248368f); q = q * t + 0.127414796f; q = q * t;
    const float e = __builtin_amdgcn_exp2f((v * v) * (-0.72134752044f));
    const float m = v * (q * e);
    return v < 0.f ? m : v - m;
}

struct Args { const float* in[15]; float* out; unsigned char* ws; };

__device__ __forceinline__ int w1_logical_col(int n0p) {
    const int pn = n0p >> 8, blk = (n0p & 255) >> 5, half = blk >> 2, a = blk & 3;
    if (pn <= 3) return pn * 256 + 64 * a + 32 * half;
    if (pn == 4) return (a < 2) ? (1024 + 64 * a + 32 * half) : (1152 + 64 * half + 32 * (a - 2));
    return n0p;
}
template <bool PERMW1> __device__ __forceinline__ void p0_transpose_item(const float* W, int K, int N, bf16* WT, LAS float* scr, int item, int lane) {
    const int nblk = N / 32, kb = item / nblk, nb = item % nblk, k0 = 64 * kb, n0 = 32 * nb; const int ns = PERMW1 ? w1_logical_col(n0) : n0;
    float tv[32];
#pragma unroll
    for (int i = 0; i < 32; ++i) { const int kk = 2 * i + (lane >> 5); tv[i] = W[(size_t)(k0 + kk) * N + ns + (lane & 31)]; }
#pragma unroll
    for (int i = 0; i < 32; ++i) { const int kk = 2 * i + (lane >> 5); scr[kk * 33 + (lane & 31)] = tv[i]; }
    LDS_WAIT(); asm volatile("" ::: "memory");
    const int c = lane & 7;
#pragma unroll
    for (int j = 0; j < 4; ++j) { const int n = (lane >> 3) + 8 * j; const LAS float* s = scr + (8 * c) * 33 + n;
        v4u o; o.x = pk2(s[0 * 33], s[1 * 33]); o.y = pk2(s[2 * 33], s[3 * 33]); o.z = pk2(s[4 * 33], s[5 * 33]); o.w = pk2(s[6 * 33], s[7 * 33]);
        *(GAS v4u*)(WT + (size_t)(n0 + n) * K + k0 + 8 * c) = o; }
    LDS_WAIT(); asm volatile("" ::: "memory");
}
__device__ __forceinline__ void ln_load_f32(f32x4 (&v)[8], const float* xrow, int lane) {
    const GAS f32x4* xr = (const GAS f32x4*)xrow + lane;
#pragma unroll
    for (int j = 0; j < 8; ++j) v[j] = xr[64 * j];
}
__device__ __forceinline__ void ln_row_f32_to_bf16(f32x4 (&v)[8], const float* g, const float* bta, bf16* orow, int lane) {
    float s = 0.f;
#pragma unroll
    for (int j = 0; j < 8; ++j) s += (v[j].x + v[j].y) + (v[j].z + v[j].w);
    const float mean = wave_sum(s) * (1.f / DM); float s2 = 0.f;
#pragma unroll
    for (int j = 0; j < 8; ++j) { v[j] = v[j] - mean; s2 += (v[j].x * v[j].x + v[j].y * v[j].y) + (v[j].z * v[j].z + v[j].w * v[j].w); }
    const float rstd = 1.f / sqrtf(wave_sum(s2) * (1.f / DM) + LN_EPS);
    GAS v2u* o8 = (GAS v2u*)orow + lane;
#pragma unroll
    for (int j = 0; j < 8; ++j) { const f32x4 gg = ((const GAS f32x4*)g)[lane + 64 * j], bb = ((const GAS f32x4*)bta)[lane + 64 * j];
        v2u o; o.x = pk2(v[j].x * rstd * gg.x + bb.x, v[j].y * rstd * gg.y + bb.y); o.y = pk2(v[j].z * rstd * gg.z + bb.z, v[j].w * rstd * gg.w + bb.w); o8[64 * j] = o; }
}
__device__ __forceinline__ void ln_load_bf16(v4u (&w4)[4], const bf16* xrow, int lane) {
    const GAS v4u* xr = (const GAS v4u*)xrow + lane;
#pragma unroll
    for (int j = 0; j < 4; ++j) w4[j] = xr[64 * j];
}
__device__ __forceinline__ void ln_row_bf16_to_bf16(const v4u (&w4)[4], const float* g, const float* bta, bf16* orow, signed char* qrow, float* qscale, int lane) {
    float v[32]; float s = 0.f;
#pragma unroll
    for (int j = 0; j < 4; ++j) { const v4u w = w4[j];
        v[8 * j + 0] = bflo(w.x); v[8 * j + 1] = bfhi(w.x); v[8 * j + 2] = bflo(w.y); v[8 * j + 3] = bfhi(w.y);
        v[8 * j + 4] = bflo(w.z); v[8 * j + 5] = bfhi(w.z); v[8 * j + 6] = bflo(w.w); v[8 * j + 7] = bfhi(w.w); }
#pragma unroll
    for (int i = 0; i < 32; ++i) s += v[i];
    const float mean = wave_sum(s) * (1.f / DM); float s2 = 0.f;
#pragma unroll
    for (int i = 0; i < 32; ++i) { v[i] -= mean; s2 += v[i] * v[i]; }
    const float rstd = 1.f / sqrtf(wave_sum(s2) * (1.f / DM) + LN_EPS);
    GAS v4u* o16 = (GAS v4u*)orow + lane;
#pragma unroll
    for (int j = 0; j < 4; ++j) {
        const GAS f32x4* gp = (const GAS f32x4*)g + 2 * (lane + 64 * j); const GAS f32x4* bp = (const GAS f32x4*)bta + 2 * (lane + 64 * j);
        const f32x4 g0 = gp[0], g1 = gp[1], b0 = bp[0], b1 = bp[1];
        v4u o; o.x = pk2(v[8 * j + 0] * rstd * g0.x + b0.x, v[8 * j + 1] * rstd * g0.y + b0.y); o.y = pk2(v[8 * j + 2] * rstd * g0.z + b0.z, v[8 * j + 3] * rstd * g0.w + b0.w);
        o.z = pk2(v[8 * j + 4] * rstd * g1.x + b1.x, v[8 * j + 5] * rstd * g1.y + b1.y); o.w = pk2(v[8 * j + 6] * rstd * g1.z + b1.z, v[8 * j + 7] * rstd * g1.w + b1.w);
        o16[64 * j] = o;
        v[8 * j + 0] = v[8 * j + 0] * rstd * g0.x + b0.x; v[8 * j + 1] = v[8 * j + 1] * rstd * g0.y + b0.y; v[8 * j + 2] = v[8 * j + 2] * rstd * g0.z + b0.z; v[8 * j + 3] = v[8 * j + 3] * rstd * g0.w + b0.w;
        v[8 * j + 4] = v[8 * j + 4] * rstd * g1.x + b1.x; v[8 * j + 5] = v[8 * j + 5] * rstd * g1.y + b1.y; v[8 * j + 6] = v[8 * j + 6] * rstd * g1.z + b1.z; v[8 * j + 7] = v[8 * j + 7] * rstd * g1.w + b1.w; }
    float am = 0.f;
#pragma unroll
    for (int i = 0; i < 32; ++i) am = fmaxf(am, fabsf(v[i]));
    am = wave_max(am);
    am = fmaxf(am, 1e-20f); const float iq = 127.0f / am;
    if (lane == 0) *qscale = am * (1.0f / 127.0f);
#pragma unroll
    for (int j = 0; j < 4; ++j) { v2u w; w.x = (unsigned)(q8(v[8 * j + 0] * iq) | (q8(v[8 * j + 1] * iq) << 8) | (q8(v[8 * j + 2] * iq) << 16) | (q8(v[8 * j + 3] * iq) << 24));
        w.y = (unsigned)(q8(v[8 * j + 4] * iq) | (q8(v[8 * j + 5] * iq) << 8) | (q8(v[8 * j + 6] * iq) << 16) | (q8(v[8 * j + 7] * iq) << 24)); ((GAS v2u*)qrow)[lane + 64 * j] = w; }
}
__device__ __forceinline__ void row_pos(int r, int& pos, int& ipos) {
    if (r < NTOK) { const int s = r & (SEQ - 1); pos = NMETA + s; ipos = s & 127; }
    else { int j = r - NTOK; if (j > NMETA - 1) j = NMETA - 1; pos = j; ipos = 112 + j; }
}
__device__ __forceinline__ float log2_gamma(int h) { return log2f(1.0f - exp2f(-5.0f - (float)h)); }


typedef short bf16x8 __attribute__((ext_vector_type(8)));
typedef short s16x4 __attribute__((ext_vector_type(4)));
#define MFMA16(a, b, c) __builtin_amdgcn_mfma_f32_16x16x32_bf16((a), (b), (c), 0, 0, 0)
__device__ __forceinline__ s16x4 tr16(LAS const unsigned char* p) { return __builtin_bit_cast(s16x4, __builtin_amdgcn_ds_read_tr16_b64_v4i16((LAS s16x4*)p)); }
__device__ __forceinline__ bf16x8 cat8(s16x4 a, s16x4 b) { return __builtin_shufflevector(a, b, 0, 1, 2, 3, 4, 5, 6, 7); }
__device__ __forceinline__ unsigned cvtpk_s(float lo, float hi) { f32x2 v = {lo, hi}; bf16x2_t b = __builtin_convertvector(v, bf16x2_t); return __builtin_bit_cast(unsigned, b); }
__device__ __forceinline__ unsigned cvtpk(float lo, float hi) { unsigned r; asm("v_cvt_pk_bf16_f32 %0, %1, %2" : "=v"(r) : "v"(lo), "v"(hi)); return r; }

__device__ __forceinline__ void scan_unit(LAS unsigned char* L, int u, const bf16* RK, const bf16* RV, bf16* ST, int tid, int lane, int wave) {
    asm volatile("" : "+v"(tid)); lane = tid & 63;
    const int bh = u >> 4, di = (u >> 2) & 3, ei = u & 3, b = bh >> 2, h = bh & 3;
    const float g128 = exp2f(128.0f * log2_gamma(h));
    const int li = lane & 15, g = lane >> 4, q = li >> 2, p4 = li & 3;
    const int eb = wave >> 1, db0 = 2 * (wave & 1);
    f32x4 acc[2]; acc[0] = (f32x4){0.f, 0.f, 0.f, 0.f}; acc[1] = acc[0];
    const int sw = 2 * (((q >> 1) & 1) | ((g & 1) << 1));
    v4u kA[2], vA[2], kB[2], vB[2];
#define SCAN_LOAD(cc, kreg, vreg) do { _Pragma("unroll") for (int i_ = 0; i_ < 2; ++i_) { const int cid_ = tid + 512 * i_, row_ = cid_ >> 3, c16_ = cid_ & 7; \
        int srow_; bool ok_ = true; if ((cc) < 0) { ok_ = row_ >= 112; srow_ = NTOK + (ok_ ? row_ - 112 : 0); } else srow_ = b * SEQ + (cc) * 128 + row_; \
        const v4u kz_ = *(const GAS v4u*)(RK + (size_t)srow_ * 1024 + h * 256 + di * 64 + c16_ * 8), vz_ = *(const GAS v4u*)(RV + (size_t)srow_ * 1024 + h * 256 + ei * 64 + c16_ * 8); \
        kreg[i_] = ok_ ? kz_ : (v4u){0u, 0u, 0u, 0u}; vreg[i_] = ok_ ? vz_ : (v4u){0u, 0u, 0u, 0u}; } } while (0)
#define SCAN_WRITE(bufp, kreg, vreg) do { _Pragma("unroll") for (int i_ = 0; i_ < 2; ++i_) { const int cid_ = tid + 512 * i_, row_ = cid_ >> 3, c16_ = cid_ & 7; \
        const int sw_ = ((row_ >> 1) & 1) | ((row_ >> 2) & 2); const int off_ = row_ * 128 + ((c16_ ^ (2 * sw_)) << 4); \
        *(LAS v4u*)((bufp) + off_) = kreg[i_]; *(LAS v4u*)((bufp) + 16384 + off_) = vreg[i_]; } } while (0)
#define SCAN_FLUSH(c) do { if ((c) >= 0) { const v4u z_ = *(LAS const v4u*)(L + 65536 + ((c) & 1) * 8192 + (tid >> 3) * 128 + (tid & 7) * 16); \
        *(GAS v4u*)(ST + ((size_t)(bh * 32 + (c)) * 256 + 64 * ei + (tid >> 3)) * 256 + 64 * di + (tid & 7) * 8) = z_; } } while (0)
    SCAN_LOAD(-1, kA, vA); SCAN_WRITE(L, kA, vA); SCAN_LOAD(0, kA, vA); SCAN_LOAD(1, kB, vB); LDS_BAR();
    int cur = 0;
    for (int cc = -1; cc <= 29; cc += 2) {
        { LAS const unsigned char* Kt = L + cur * 32768; LAS const unsigned char* Vt = Kt + 16384;
#pragma unroll
          for (int ks = 0; ks < 4; ++ks) { const int r0 = (32 * ks + 8 * g + q) * 128 + 8 * (p4 & 1);
              const bf16x8 a = cat8(tr16(Vt + r0 + (((2 * eb + (p4 >> 1)) ^ sw) << 4)), tr16(Vt + r0 + 512 + (((2 * eb + (p4 >> 1)) ^ sw) << 4)));
#pragma unroll
              for (int n = 0; n < 2; ++n) { const int cn = ((2 * (db0 + n) + (p4 >> 1)) ^ sw) << 4; const bf16x8 bb = cat8(tr16(Kt + r0 + cn), tr16(Kt + r0 + 512 + cn)); acc[n] = MFMA16(a, bb, acc[n]); } }
          SCAN_FLUSH(cc);
#pragma unroll
          for (int n = 0; n < 2; ++n) { acc[n] = acc[n] * g128;
              LAS bf16* op = (LAS bf16*)(L + 65536 + ((cc + 1) & 1) * 8192) + (16 * eb + 4 * g) * 64 + 16 * (db0 + n) + li;
#pragma unroll
              for (int r = 0; r < 4; ++r) op[r * 64] = (bf16)f2bf(acc[n][r]); }
          SCAN_WRITE(L + (cur ^ 1) * 32768, kA, vA);
          if (cc + 3 <= 30) SCAN_LOAD(cc + 3, kA, vA);
          LDS_BAR(); cur ^= 1; }
        { LAS const unsigned char* Kt = L + cur * 32768; LAS const unsigned char* Vt = Kt + 16384;
#pragma unroll
          for (int ks = 0; ks < 4; ++ks) { const int r0 = (32 * ks + 8 * g + q) * 128 + 8 * (p4 & 1);
              const bf16x8 a = cat8(tr16(Vt + r0 + (((2 * eb + (p4 >> 1)) ^ sw) << 4)), tr16(Vt + r0 + 512 + (((2 * eb + (p4 >> 1)) ^ sw) << 4)));
#pragma unroll
              for (int n = 0; n < 2; ++n) { const int cn = ((2 * (db0 + n) + (p4 >> 1)) ^ sw) << 4; const bf16x8 bb = cat8(tr16(Kt + r0 + cn), tr16(Kt + r0 + 512 + cn)); acc[n] = MFMA16(a, bb, acc[n]); } }
          SCAN_FLUSH(cc + 1);
#pragma unroll
          for (int n = 0; n < 2; ++n) { acc[n] = acc[n] * g128;
              LAS bf16* op = (LAS bf16*)(L + 65536 + ((cc + 2) & 1) * 8192) + (16 * eb + 4 * g) * 64 + 16 * (db0 + n) + li;
#pragma unroll
              for (int r = 0; r < 4; ++r) op[r * 64] = (bf16)f2bf(acc[n][r]); }
          if (cc + 2 <= 30) SCAN_WRITE(L + (cur ^ 1) * 32768, kB, vB);
          if (cc + 4 <= 30) SCAN_LOAD(cc + 4, kB, vB);
          LDS_BAR(); cur ^= 1; }
    }
    SCAN_FLUSH(31);
    LDS_BAR();
#undef SCAN_LOAD
#undef SCAN_WRITE
#undef SCAN_FLUSH
}

__device__ __forceinline__ void retout_unit(LAS unsigned char* L, int u, bf16* QR, const bf16* RK, const bf16* RV, const bf16* RG, const bf16* ST, int tid, int lane, int wave) {
    asm volatile("" : "+v"(tid)); lane = tid & 63;
    const int bh = u >> 5, c = u & 31, b = bh >> 2, h = bh & 3;
    const int R0 = b * SEQ + c * 128;
    const int li = lane & 15, g = lane >> 4, q = li >> 2, p4 = li & 3;
    LAS unsigned char* RA = L; LAS unsigned char* RB = L + 65536;
#pragma unroll
    for (int i = 0; i < 8; ++i) { const int cid = tid + 512 * i, j = cid >> 5, ch = cid & 31;
        const v4u kz = *(const GAS v4u*)(RK + (size_t)(R0 + j) * 1024 + h * 256 + ch * 8), vz = *(const GAS v4u*)(RV + (size_t)(R0 + j) * 1024 + h * 256 + ch * 8);
        *(LAS v4u*)(RA + j * 512 + ((ch ^ (j & 15)) << 4)) = kz; *(LAS v4u*)(RB + j * 512 + ((ch ^ ((j & 7) << 1)) << 4)) = vz; }
    bf16x8 qf[8];
    { const GAS v4u* qp = (const GAS v4u*)(QR + (size_t)(R0 + 16 * wave + li) * 2048 + 1024 + h * 256 + 8 * g);
#pragma unroll
      for (int ks = 0; ks < 8; ++ks) qf[ks] = __builtin_bit_cast(bf16x8, qp[4 * ks]); }
#define RO_LOAD_ST(s0) do { _Pragma("unroll") for (int i_ = 0; i_ < 8; ++i_) { const int cid_ = tid + 512 * i_, sl_ = cid_ >> 11, e_ = (cid_ >> 3) & 255, ch_ = cid_ & 7; \
        stg[i_] = *(const GAS v4u*)(Sg + (size_t)e_ * 256 + 64 * ((s0) + sl_) + ch_ * 8); } } while (0)
#define RO_WRITE_ST(dst) do { _Pragma("unroll") for (int i_ = 0; i_ < 8; ++i_) { const int cid_ = tid + 512 * i_, sl_ = cid_ >> 11, e_ = (cid_ >> 3) & 255, ch_ = cid_ & 7; \
        *(LAS v4u*)((dst) + sl_ * 32768 + e_ * 128 + ((ch_ ^ (e_ & 7)) << 4)) = stg[i_]; } } while (0)
    const bf16* Sg = ST + (size_t)(bh * 32 + c) * 65536; v4u stg[8];
    __syncthreads();
    RO_LOAD_ST(0);
    f32x4 st[8];
#pragma unroll
    for (int jt = 0; jt < 8; ++jt) st[jt] = (f32x4){0.f, 0.f, 0.f, 0.f};
#pragma unroll
    for (int jt = 0; jt < 8; ++jt) if (jt <= wave) {
        const int j = 16 * jt + li;
#pragma unroll
        for (int ks = 0; ks < 8; ++ks) { const bf16x8 a = *(LAS const bf16x8*)(RA + j * 512 + (((4 * ks + g) ^ li) << 4)); st[jt] = MFMA16(a, qf[ks], st[jt]); }
        if (jt == wave) {
#pragma unroll
            for (int r = 0; r < 4; ++r) if (4 * g + r > li) st[jt][r] = 0.f; }
    }
    bf16x8 pf[4];
#pragma unroll
    for (int s = 0; s < 4; ++s) { v4u w; w.x = cvtpk_s(st[2 * s][0], st[2 * s][1]); w.y = cvtpk_s(st[2 * s][2], st[2 * s][3]); w.z = cvtpk_s(st[2 * s + 1][0], st[2 * s + 1][1]); w.w = cvtpk_s(st[2 * s + 1][2], st[2 * s + 1][3]); pf[s] = __builtin_bit_cast(bf16x8, w); }
    __syncthreads();
    RO_WRITE_ST(RA); RO_LOAD_ST(2);
    f32x4 o[16];
#pragma unroll
    for (int et = 0; et < 16; ++et) o[et] = (f32x4){0.f, 0.f, 0.f, 0.f};
#pragma unroll
    for (int s = 0; s < 4; ++s) if (2 * s <= wave) {
        const int r1 = 32 * s + 4 * g + q, r2 = r1 + 16;
#pragma unroll
        for (int et = 0; et < 16; ++et) {
            const int chn = 2 * et + (p4 >> 1);
            const bf16x8 a = cat8(tr16(RB + r1 * 512 + ((chn ^ ((r1 & 7) << 1)) << 4) + (p4 & 1) * 8), tr16(RB + r2 * 512 + ((chn ^ ((r2 & 7) << 1)) << 4) + (p4 & 1) * 8));
            o[et] = MFMA16(a, pf[s], o[et]);
        }
    }
    __syncthreads();
    RO_WRITE_ST(RB);
#define RO_STATE_MMA(src, s0) do { _Pragma("unroll") for (int sl_ = 0; sl_ < 2; ++sl_) _Pragma("unroll") for (int k2_ = 0; k2_ < 2; ++k2_) _Pragma("unroll") for (int et = 0; et < 16; ++et) { \
        const int e_ = 16 * et + li; const bf16x8 a_ = *(LAS const bf16x8*)((src) + sl_ * 32768 + e_ * 128 + (((4 * k2_ + g) ^ (e_ & 7)) << 4)); \
        o[et] = MFMA16(a_, qf[2 * ((s0) + sl_) + k2_], o[et]); } } while (0)
    RO_STATE_MMA(RA, 0);
    __syncthreads();
    RO_STATE_MMA(RB, 2);
#undef RO_LOAD_ST
#undef RO_WRITE_ST
#undef RO_STATE_MMA
    float s1 = 0.f;
#pragma unroll
    for (int et = 0; et < 16; ++et) s1 += (o[et][0] + o[et][1]) + (o[et][2] + o[et][3]);
    s1 += __shfl_xor(s1, 16); s1 += __shfl_xor(s1, 32);
    const float mu = s1 * (1.0f / 256.0f); float s2 = 0.f;
#pragma unroll
    for (int et = 0; et < 16; ++et) { o[et] = o[et] - mu; s2 += (o[et][0] * o[et][0] + o[et][1] * o[et][1]) + (o[et][2] * o[et][2] + o[et][3] * o[et][3]); }
    s2 += __shfl_xor(s2, 16); s2 += __shfl_xor(s2, 32);
    const float rstd = 1.0f / sqrtf(s2 * (1.0f / 256.0f) + GN_EPS);
    const int row = R0 + 16 * wave + li;
    const GAS v2u* gp = (const GAS v2u*)(RG + (size_t)row * 1024 + h * 256 + 4 * g); GAS v2u* op = (GAS v2u*)(QR + (size_t)row * 2048 + 1024 + h * 256 + 4 * g);
#pragma unroll
    for (int et = 0; et < 16; ++et) { const v2u gz = gp[4 * et]; v2u w;
        w.x = cvtpk(o[et][0] * rstd * bflo(gz.x), o[et][1] * rstd * bfhi(gz.x)); w.y = cvtpk(o[et][2] * rstd * bflo(gz.y), o[et][3] * rstd * bfhi(gz.y)); op[4 * et] = w; }
    __syncthreads();
}

typedef float f32x16 __attribute__((ext_vector_type(16)));
#define MFMA32(a, b, c) __builtin_amdgcn_mfma_f32_32x32x16_bf16((a), (b), (c), 0, 0, 0)
__device__ __forceinline__ int crow32(int reg, int hh) { return (reg & 3) + 8 * (reg >> 2) + 4 * hh; }

__device__ __forceinline__ void attn_unit(LAS unsigned char* L, int u, bf16* QR, const bf16* KA, const bf16* VA, const float* sinks, int tid, int lane, int wave) {
    asm volatile("" : "+v"(tid)); lane = tid & 63;
    const int b = u >> 6, j = (u >> 1) & 31, g2 = u & 1, hq = 8 * g2 + wave;
    const int R0 = b * SEQ + 128 * j;
    LAS unsigned char* Kt = L; LAS unsigned char* Vt = L + 32768;
#pragma unroll
    for (int i = 0; i < 4; ++i) { const int cid = tid + 512 * i, kk = cid >> 3, ch = cid & 7;
        int srow; bool ok = true;
        if (kk >= 128) srow = R0 + kk - 128; else if (j > 0) srow = R0 - 128 + kk; else { ok = kk >= 112; srow = NTOK + (ok ? kk - 112 : 0); }
        const v4u kz = *(const GAS v4u*)(KA + (size_t)srow * 128 + g2 * 64 + ch * 8), vz = *(const GAS v4u*)(VA + (size_t)srow * 128 + g2 * 64 + ch * 8);
        *(LAS v4u*)(Kt + kk * 128 + ((ch ^ (kk & 7)) << 4)) = ok ? kz : (v4u){0u, 0u, 0u, 0u};
        *(LAS v4u*)(Vt + kk * 128 + (ch << 4)) = ok ? vz : (v4u){0u, 0u, 0u, 0u}; }
    __syncthreads();
    const int r = lane & 31, hh = lane >> 5, blk = (lane >> 4) & 1, q = (lane & 15) >> 2, p4 = lane & 3;
    const float sk = sinks[hq] * LOG2E;
    v4u qn[4];
    { const GAS v4u* qp = (const GAS v4u*)(QR + (size_t)(R0 + r) * 2048 + hq * 64 + 8 * hh);
#pragma unroll
      for (int ks = 0; ks < 4; ++ks) qn[ks] = qp[2 * ks]; }
#pragma unroll 1
    for (int t = 0; t < 4; ++t) {
        const int i0 = 32 * t;
        bf16x8 qf[4];
#pragma unroll
        for (int ks = 0; ks < 4; ++ks) qf[ks] = __builtin_bit_cast(bf16x8, qn[ks]);
        if (t < 3) { const GAS v4u* qp = (const GAS v4u*)(QR + (size_t)(R0 + i0 + 32 + r) * 2048 + hq * 64 + 8 * hh);
#pragma unroll
          for (int ks = 0; ks < 4; ++ks) qn[ks] = qp[2 * ks]; }
        f32x16 s[5];
#pragma unroll
        for (int x = 0; x < 5; ++x) {
            const int krow_ = 32 * (t + x) + r;
            f32x16 acc;
#pragma unroll
            for (int e = 0; e < 16; ++e) acc[e] = 0.f;
#pragma unroll
            for (int ks = 0; ks < 4; ++ks) { const bf16x8 a = *(LAS const bf16x8*)(Kt + krow_ * 128 + (((2 * ks + hh) ^ (krow_ & 7)) << 4)); acc = MFMA32(a, qf[ks], acc); }
            s[x] = acc; __builtin_amdgcn_sched_barrier(0);
        }
        float m = sk;
#pragma unroll
        for (int e = 0; e < 16; ++e) { const int cr = crow32(e, hh);
            if (!(cr > r)) s[0][e] = -1.0e30f;
            if (!(cr <= r)) s[4][e] = -1.0e30f; }
        if (j == 0) {
#pragma unroll
            for (int x = 0; x < 4; ++x) if (t + x <= 3) {
#pragma unroll
                for (int e = 0; e < 16; ++e) if (32 * (t + x) + crow32(e, hh) < 112) s[x][e] = -1.0e30f; }
        }
#pragma unroll
        for (int x = 0; x < 5; ++x)
#pragma unroll
            for (int e = 0; e < 16; ++e) m = fmaxf(m, s[x][e]);
        m = fmaxf(m, __shfl_xor(m, 32));
        float l = 0.f;
#pragma unroll
        for (int x = 0; x < 5; ++x)
#pragma unroll
            for (int e = 0; e < 16; ++e) { const float pv = exp2f(s[x][e] - m); s[x][e] = pv; l += pv; }
        l += __shfl_xor(l, 32);
        l += exp2f(sk - m);
        f32x16 o[2];
#pragma unroll
        for (int e = 0; e < 16; ++e) { o[0][e] = 0.f; o[1][e] = 0.f; }
#pragma unroll
        for (int x = 0; x < 5; ++x)
#pragma unroll
            for (int st = 0; st < 2; ++st) {
                v4u w; w.x = cvtpk_s(s[x][8 * st + 0], s[x][8 * st + 1]); w.y = cvtpk_s(s[x][8 * st + 2], s[x][8 * st + 3]); w.z = cvtpk_s(s[x][8 * st + 4], s[x][8 * st + 5]); w.w = cvtpk_s(s[x][8 * st + 6], s[x][8 * st + 7]);
                const bf16x8 pb = __builtin_bit_cast(bf16x8, w);
                const int k1 = 32 * (t + x) + 16 * st + 4 * hh + q, k2 = k1 + 8;
#pragma unroll
                for (int dc = 0; dc < 2; ++dc) {
                    const int cb = ((4 * dc + 2 * blk + (p4 >> 1)) << 4) + 8 * (p4 & 1);
                    const bf16x8 a = cat8(tr16(Vt + k1 * 128 + cb), tr16(Vt + k2 * 128 + cb));
                    o[dc] = MFMA32(a, pb, o[dc]);
                }
                __builtin_amdgcn_sched_barrier(0);
            }
        const float il = 1.0f / l;
        GAS v2u* op = (GAS v2u*)(QR + (size_t)(R0 + i0 + r) * 2048 + hq * 64 + 4 * hh);
#pragma unroll
        for (int dc = 0; dc < 2; ++dc)
#pragma unroll
            for (int g4 = 0; g4 < 4; ++g4) { v2u w; w.x = cvtpk_s(o[dc][4 * g4 + 0] * il, o[dc][4 * g4 + 1] * il); w.y = cvtpk_s(o[dc][4 * g4 + 2] * il, o[dc][4 * g4 + 3] * il); op[8 * dc + 2 * g4] = w; }
    }
    __syncthreads();
}

__device__ __forceinline__ unsigned ord_key(float f) { const unsigned u = __float_as_uint(f); return u ^ ((unsigned)((int)u >> 31) | 0x80000000u); }
__device__ __forceinline__ float ord_val(unsigned k) { return __uint_as_float(k ^ (((int)k < 0) ? 0x80000000u : 0xffffffffu)); }
__device__ __forceinline__ unsigned umed3(unsigned a, unsigned b, unsigned c) { unsigned r; asm("v_med3_u32 %0, %1, %2, %3" : "=v"(r) : "v"(a), "v"(b), "v"(c)); return r; }
#define TK_INS(arr, val) do { const unsigned v_ = (val); _Pragma("unroll") for (int j_ = 15; j_ >= 1; --j_) arr[j_] = umed3(arr[j_ - 1], arr[j_], v_); arr[0] = arr[0] > v_ ? arr[0] : v_; } while (0)
__device__ __forceinline__ void topk_unit(LAS unsigned* Lw, LAS const unsigned char* Lsk, int tt, int hd, const bf16* Q3, unsigned short* IDS, float* GATES, int lane) {
    asm volatile("" : "+v"(lane));
    const int r = lane & 31, hh = lane >> 5, t0 = tt * 32;
    float sv[2][16];
#pragma unroll
    for (int p = 0; p < 2; ++p) {
        f32x16 acc[4];
#pragma unroll
        for (int nt = 0; nt < 4; ++nt)
#pragma unroll
            for (int e = 0; e < 16; ++e) acc[nt][e] = 0.f;
        const GAS v4u* qp = (const GAS v4u*)(Q3 + (size_t)(t0 + r) * DM + hd * 256 + p * 128 + 8 * hh);
        bf16x8 bq[8];
#pragma unroll
        for (int ks = 0; ks < 8; ++ks) bq[ks] = __builtin_bit_cast(bf16x8, qp[2 * ks]);
#pragma unroll
        for (int ks = 0; ks < 8; ++ks) {
#pragma unroll
            for (int nt = 0; nt < 4; ++nt) { const bf16x8 a = *(LAS const bf16x8*)(Lsk + p * 32768 + (32 * nt + r) * 256 + (((2 * ks + hh) ^ (r & 15)) << 4)); acc[nt] = MFMA32(a, bq[ks], acc[nt]); } }
        unsigned tk[16];
#pragma unroll
        for (int j2 = 0; j2 < 16; ++j2) tk[j2] = 0u;
#pragma unroll
        for (int nt = 0; nt < 4; ++nt)
#pragma unroll
            for (int e = 0; e < 16; ++e) { const int n = 32 * nt + crow32(e, hh); TK_INS(tk, (ord_key(acc[nt][e]) & 0xffffff80u) | (unsigned)(127 - n)); }
        unsigned pk[16];
#pragma unroll
        for (int j2 = 0; j2 < 16; ++j2) pk[j2] = (unsigned)__shfl_xor((int)tk[j2], 32);
#pragma unroll
        for (int j2 = 0; j2 < 16; ++j2) TK_INS(tk, pk[j2]);
#pragma unroll
        for (int j2 = 0; j2 < 16; ++j2) { sv[p][j2] = ord_val(tk[j2] & 0xffffff80u); Lw[(p * 16 + j2) * 64 + lane] = 127u - (tk[j2] & 0x7fu); }
    }
    unsigned fk[16];
#pragma unroll
    for (int j2 = 0; j2 < 16; ++j2) fk[j2] = 0u;
#pragma unroll
    for (int i = 0; i < 16; ++i)
#pragma unroll
        for (int j2 = 0; j2 < 16; ++j2) if ((i + 1) * (j2 + 1) <= 16) TK_INS(fk, (ord_key(sv[0][i] + sv[1][j2]) & 0xffffff00u) | (unsigned)(255 - (16 * i + j2)));
    float ev[16]; int idv[16]; float den = 0.f; const float f0 = ord_val(fk[0] & 0xffffff00u);
    LDS_WAIT();
#pragma unroll
    for (int k = 0; k < 16; ++k) { const unsigned idx = 255u - (fk[k] & 0xffu); const unsigned i1 = Lw[(idx >> 4) * 64 + lane], i2 = Lw[(16 + (idx & 15u)) * 64 + lane];
        idv[k] = (int)(i1 * 128u + i2); ev[k] = __expf(ord_val(fk[k] & 0xffffff00u) - f0); den += ev[k]; }
    const float iden = 1.0f / den;
    if (hh == 0) {
        GAS v4u* ip = (GAS v4u*)(IDS + (size_t)(t0 + r) * 128 + hd * 16); GAS f32x4* gp = (GAS f32x4*)(GATES + (size_t)(t0 + r) * 128 + hd * 16);
#pragma unroll
        for (int k8 = 0; k8 < 2; ++k8) ip[k8] = (v4u){(unsigned)idv[8 * k8] | ((unsigned)idv[8 * k8 + 1] << 16), (unsigned)idv[8 * k8 + 2] | ((unsigned)idv[8 * k8 + 3] << 16), (unsigned)idv[8 * k8 + 4] | ((unsigned)idv[8 * k8 + 5] << 16), (unsigned)idv[8 * k8 + 6] | ((unsigned)idv[8 * k8 + 7] << 16)};
#pragma unroll
        for (int k4 = 0; k4 < 4; ++k4) gp[k4] = (f32x4){ev[4 * k4] * iden, ev[4 * k4 + 1] * iden, ev[4 * k4 + 2] * iden, ev[4 * k4 + 3] * iden};
    }
    LDS_WAIT();
}

constexpr int TAB_NQ = 16384 * DM / 4, TAB_CHQ = 4096, TAB_NCH = 2 * TAB_NQ / TAB_CHQ, TAB_SLOT_CHUNKS = 3;
template <int UNR> __device__ __forceinline__ void tab_chunk(int ch, const float* u_tab, const float* v_tab, void* UT, void* VT, int lane) {
    const int which = ch >= TAB_NCH / 2; const float sc = which ? V_QSCALE : U_QSCALE;
    const GAS f32x4* src = (const GAS f32x4*)(which ? v_tab : u_tab) + (size_t)(ch - which * (TAB_NCH / 2)) * TAB_CHQ + lane;
    GAS unsigned char* dstb = (GAS unsigned char*)(which ? VT : UT);
    const int i4b = (ch - which * (TAB_NCH / 2)) * TAB_CHQ + lane;
#pragma unroll 1
    for (int it = 0; it < TAB_CHQ / 64; it += UNR) {
        f32x4 a[UNR];
#pragma unroll
        for (int u8 = 0; u8 < UNR; ++u8) a[u8] = src[(it + u8) * 64];
#pragma unroll
        for (int u8 = 0; u8 < UNR; ++u8) { const int i4 = i4b + (it + u8) * 64; const int row = i4 >> 9, q4 = i4 & 511;
            const int w = q8(a[u8].x * sc) | (q8(a[u8].y * sc) << 8) | (q8(a[u8].z * sc) << 16) | (q8(a[u8].w * sc) << 24);
            *(GAS unsigned*)(dstb + ((size_t)(q4 >> 5) * 16384 + row) * 128 + (q4 & 31) * 4) = (unsigned)w; }
    }
}
struct TabHook {
    gu32* q; const float* u_tab; const float* v_tab; void* UT; void* VT; int slot;
    __device__ __forceinline__ void operator()(int ui) const {
        if (ui != slot) return;
        int lane = threadIdx.x; asm volatile("" : "+v"(lane)); lane &= 63;
#pragma unroll 1
        for (int n = 0; n < TAB_SLOT_CHUNKS; ++n) {
            int ch = 0; if (lane == 0) ch = (int)__hip_atomic_fetch_add((unsigned*)q, 1u, __ATOMIC_RELAXED, __HIP_MEMORY_SCOPE_AGENT);
            ch = __builtin_amdgcn_readfirstlane(ch); if (ch >= TAB_NCH) return;
            tab_chunk<16>(ch, u_tab, v_tab, UT, VT, lane);
        }
    }
};

__global__ void __launch_bounds__(NWAVES * 64, 2) mk_fwd(Args args) {
    extern __shared__ __attribute__((aligned(16))) unsigned char lds[];
    LAS unsigned char* L = (LAS unsigned char*)lds;
    volatile LAS unsigned* MISC = (volatile LAS unsigned*)(L + MISC_OFF);
    const int tid = threadIdx.x, lane = tid & 63, wave = __builtin_amdgcn_readfirstlane(tid >> 6);
    const int G = gridDim.x, bx = blockIdx.x;
    const int vcu = (G % 8 == 0) ? (bx % 8) * (G / 8) + bx / 8 : bx;
    unsigned char* ws = args.ws;
    gu32* ctl = (gu32*)(ws + WS_CTL);
    const float* x = args.in[0]; const float* meta = args.in[1]; const float* ln_in_g = args.in[2]; const float* ln_in_b = args.in[3];
    const float* w_in = args.in[4]; const float* sinks = args.in[5]; const float* w_out = args.in[6]; const float* ln_mix_g = args.in[7]; const float* ln_mix_b = args.in[8];
    const float* wq = args.in[9]; const float* subkeys = args.in[10]; const float* u_tab = args.in[11]; const float* v_tab = args.in[12];
    const float* ln_ffn_g = args.in[13]; const float* ln_ffn_b = args.in[14];
    float* out = args.out;
    bf16* W1T = (bf16*)(ws + WS_W1T); bf16* W2T = (bf16*)(ws + WS_W2T); bf16* W3T = (bf16*)(ws + WS_W3T);
    bf16* H0 = (bf16*)(ws + WS_H0); bf16* QR = (bf16*)(ws + WS_QR); bf16* KA = (bf16*)(ws + WS_KA); bf16* VA = (bf16*)(ws + WS_VA);
    bf16* RK = (bf16*)(ws + WS_RK); bf16* RV = (bf16*)(ws + WS_RV); bf16* RG = (bf16*)(ws + WS_RG);
    bf16* Y = (bf16*)(ws + WS_Y); bf16* H1 = (bf16*)(ws + WS_H1); bf16* Q3 = (bf16*)(ws + WS_QR);
    bf16* STB = (bf16*)(ws + WS_ST);
    unsigned short* IDS = (unsigned short*)(ws + WS_IDS); float* GATES = (float*)(ws + WS_GATES);
    bf16* SKB = (bf16*)(ws + WS_SK);
    signed char* H1Q = (signed char*)(ws + WS_RG); float* HSC = (float*)(ws + WS_HSC);
    bf16* UT = (bf16*)(ws + WS_UT); bf16* VT = (bf16*)(ws + WS_VT);

    for (int u = tid; u < (LDS_BYTES - LDSCTL_OFF) / 4; u += NWAVES * 64) ((LAS unsigned*)(L + LDSCTL_OFF))[u] = 0u;
    __syncthreads();
    XcdBarrier bar; bar.bar = (unsigned*)(ctl + CW_BAR); bar.x = xb_xcc_id(); bar.st = MISC + 8;
    if (tid == 0) MISC[10] = xb_add(&bar.bar[XB_XCNT(bar.x)], 1u);
#define GRID_BAR() xcd_barrier(bar)
    const int gw = vcu * NWAVES + wave, NGW = G * NWAVES;
    const int gt = gw * 64 + lane, NGT = NGW * 64;

    {
        int lane = threadIdx.x; asm volatile("" : "+v"(lane)); lane &= 63; const int gt = gw * 64 + lane;
        LAS float* scr = (LAS float*)(L + RING_OFF + wave * 16384);
        constexpr int I_1 = (DM / 64) * (IN_COLS / 32), I_2 = (DM / 64) * (DM / 32), I_3 = I_2;
#pragma unroll 1
        for (int pass = 0; pass < 2; ++pass) {
          if ((pass ^ (wave & 1)) == 0) {
        for (int it = gw; it < I_1 + I_2 + I_3; it += NGW) {
            int r = it;
            if (r < I_1) { p0_transpose_item<true>(w_in, DM, IN_COLS, W1T, scr, r, lane); continue; } r -= I_1;
            if (r < I_2) { p0_transpose_item<false>(w_out, DM, DM, W2T, scr, r, lane); continue; } r -= I_2;
            p0_transpose_item<false>(wq, DM, DM, W3T, scr, r, lane);
        }
          } else {
        {
            f32x4 va[8], vn[8];
            int m = gw; if (m < NVALID) ln_load_f32(va, m < NTOK ? x + (size_t)m * DM : meta + (size_t)(m - NTOK) * DM, lane);
            for (; m < MROWS; m += NGW) {
                const int mn = m + NGW; if (mn < NVALID) ln_load_f32(vn, mn < NTOK ? x + (size_t)mn * DM : meta + (size_t)(mn - NTOK) * DM, lane);
                if (m < NVALID) ln_row_f32_to_bf16(va, ln_in_g, ln_in_b, H0 + (size_t)m * DM, lane);
                else { GAS v4u* o = (GAS v4u*)(H0 + (size_t)m * DM) + lane;
#pragma unroll
                    for (int j = 0; j < 4; ++j) o[64 * j] = (v4u){0u, 0u, 0u, 0u}; }
#pragma unroll
                for (int j = 0; j < 8; ++j) va[j] = vn[j];
            }
        }
          }
        }
        for (int e = gt; e < 16 * 128 * 128 / 8; e += NGT) { const GAS f32x4* src = (const GAS f32x4*)subkeys + 2 * (size_t)e; const f32x4 a = src[0], b2 = src[1];
            v4u o; o.x = pk2(a.x, a.y); o.y = pk2(a.z, a.w); o.z = pk2(b2.x, b2.y); o.w = pk2(b2.z, b2.w); ((GAS v4u*)SKB)[e] = o; }
    }
    GRID_BAR();

    {
        pg8::Gemm g{H0, W1T, MROWS, IN_COLS, DM}; pg8::StaticOrder S; S.init(MROWS, IN_COLS, G, bx, 5);
        pg8::EpiProj E{QR, KA, VA, RK, RV, RG, QSCALE};
        const int nwg1 = (MROWS / 256) * (IN_COLS / 256), T1 = (nwg1 + G - 1) / G, c0 = nwg1 - (T1 - 1) * G;
        TabHook Hk{ctl + CW_TABQ, u_tab, v_tab, (void*)UT, (void*)VT, (bx >= c0 && T1 > 2) ? (bx - c0) % (T1 - 2) : -1};
        pg8::gemm_phase<pg8::EpiProj, pg8::StaticOrder, true, true, TabHook>(L + RING_OFF, g, S, E, Hk);
    }
    {
        for (;;) {
            int ch = 0; if (lane == 0) ch = (int)__hip_atomic_fetch_add((unsigned*)(ctl + CW_TABQ), 1u, __ATOMIC_RELAXED, __HIP_MEMORY_SCOPE_AGENT);
            ch = __builtin_amdgcn_readfirstlane(ch); if (ch >= TAB_NCH) break;
            tab_chunk<8>(ch, u_tab, v_tab, (void*)UT, (void*)VT, lane);
        }
    }
    GRID_BAR();

    for (int u = bx; u < 256; u += G) attn_unit(L + RING_OFF, u, QR, KA, VA, sinks, tid, lane, wave);

    for (int u = bx; u < 256; u += G) scan_unit(L + RING_OFF, u, RK, RV, STB, tid, lane, wave);
    GRID_BAR();

    for (int u = bx; u < 512; u += G) retout_unit(L + RING_OFF, u, QR, RK, RV, RG, STB, tid, lane, wave);
    GRID_BAR();

    {
        pg8::Gemm g{QR, W2T, NTOK, DM, DM}; pg8::StaticOrder S; S.init(NTOK, DM, G, bx);
        pg8::EpiGen<1> E{Y, DM, H0, ALPHA, nullptr, nullptr, nullptr, nullptr, nullptr, nullptr};
        pg8::gemm_phase<pg8::EpiGen<1>, pg8::StaticOrder, true, true>(L + RING_OFF, g, S, E);
    }
    GRID_BAR();

    { int l5 = threadIdx.x; asm volatile("" : "+v"(l5)); l5 &= 63;
      v4u wa[4], wn[4]; int m = gw; if (m < NTOK) ln_load_bf16(wa, Y + (size_t)m * DM, l5);
      for (; m < NTOK; m += NGW) { const int mn = m + NGW; if (mn < NTOK) ln_load_bf16(wn, Y + (size_t)mn * DM, l5);
          ln_row_bf16_to_bf16(wa, ln_mix_g, ln_mix_b, H1 + (size_t)m * DM, H1Q + (size_t)m * DM, HSC + m, l5);
#pragma unroll
          for (int j = 0; j < 4; ++j) wa[j] = wn[j]; } }
    GRID_BAR();

    {
        pg8::Gemm g{H1, W3T, NTOK, DM, DM}; pg8::StaticOrder S; S.init(NTOK, DM, G, bx);
        pg8::EpiGen<2> E{Q3, DM, nullptr, 0.f, nullptr, nullptr, nullptr, nullptr, nullptr, nullptr};
        pg8::gemm_phase<pg8::EpiGen<2>, pg8::StaticOrder, true, true>(L + RING_OFF, g, S, E);
    }
    GRID_BAR();

    const bool g8 = (G & 7) == 0; const int nbh = g8 ? (G >> 3) : G, hb = g8 ? (bx >> 3) : bx;
    for (int hd = g8 ? (bx & 7) : 0; hd < 8; hd += g8 ? 8 : 1) {
        __syncthreads();
#pragma unroll
        for (int i = 0; i < 8; ++i) { const int cid = tid + 512 * i, p = cid >> 11, n = (cid >> 4) & 127, ch = cid & 15;
            *(LAS v4u*)(L + RING_OFF + p * 32768 + n * 256 + ((ch ^ (n & 15)) << 4)) = *(const GAS v4u*)(SKB + ((size_t)((hd * 2 + p) * 128 + n)) * 128 + ch * 8); }
        __syncthreads();
        for (int tt = hb * NWAVES + wave; tt < NTOK / 32; tt += nbh * NWAVES) topk_unit((LAS unsigned*)(L + RING_OFF + 65536 + wave * 8192), L + RING_OFF, tt, hd, Q3, IDS, GATES, lane);
    }
    __syncthreads();
    GRID_BAR();

    int nx = 0, xr = 0, nloc = 1;
    { unsigned* bw = (unsigned*)(ctl + CW_BAR);
#pragma unroll
      for (unsigned j2 = 0; j2 < 16; ++j2) { const unsigned cnt = xb_ld(&bw[XB_XCNT(j2)]); nx += cnt > 0u; xr += (j2 < bar.x && cnt > 0u); if (j2 == bar.x) nloc = (int)cnt; }
      nx = __builtin_amdgcn_readfirstlane(nx); xr = __builtin_amdgcn_readfirstlane(xr); nloc = __builtin_amdgcn_readfirstlane(nloc); if (nx < 1) nx = 1; if (nloc < 1) nloc = 1; }
    const int lrank = __builtin_amdgcn_readfirstlane((int)MISC[10]);
    const int wv = lrank * NWAVES + wave, nwv = nloc * NWAVES;
    float* DOTX = (float*)(ws + WS_RK);
    signed char* CB8 = (signed char*)(ws + WS_KA); float* CSC = (float*)(ws + WS_CSC);
    bf16* YB = (bf16*)(ws + WS_H0);
    {
        int tl = tid; asm volatile("" : "+v"(tl)); const int ln = tl & 63, k = ln >> 3, c8 = ln & 7;
        const unsigned char* UT8 = (const unsigned char*)UT;
        for (int s = xr; s < NSL; s += nx) {
            const unsigned char* Us = UT8 + (size_t)s * 16384 * 128;
            const bool first = (s == xr);
            v4u nid[2][2];
#pragma unroll
            for (int z = 0; z < 2; ++z) { const int tz = wv + z * nwv; const int tc = tz < NTOK ? tz : wv; const GAS v4u* ip = (const GAS v4u*)(IDS + (size_t)tc * 128 + 16 * k);
#pragma unroll
                for (int i = 0; i < 2; ++i) nid[z][i] = ip[i]; }
#pragma unroll 1
            for (int t = wv; t < NTOK; t += 2 * nwv) {
                const bool vB = (t + nwv) < NTOK; const int tt[2] = {t, vB ? t + nwv : t};
                v4u ub[2][16]; v4u hs[2]; int old[2][2];
#pragma unroll
                for (int z = 0; z < 2; ++z) {
#pragma unroll
                    for (int i = 0; i < 16; ++i) { const int pe = 2 * (i & 7) + (i >> 3); const unsigned eid = (nid[z][pe >> 3][(pe >> 1) & 3] >> (16 * (pe & 1))) & 0xffffu; ub[z][i] = *(const GAS v4u*)(Us + (size_t)eid * 128 + 16 * c8); }
                    hs[z] = *(const GAS v4u*)(H1Q + (size_t)tt[z] * DM + 128 * s + 16 * c8); }
#pragma unroll
                for (int z = 0; z < 2; ++z) { const v2u ov = first ? (v2u){0u, 0u} : *(const GAS v2u*)(DOTX + ((size_t)xr * NTOK + tt[z]) * 128 + 2 * ln); old[z][0] = (int)ov.x; old[z][1] = (int)ov.y; }
#pragma unroll
                for (int z = 0; z < 2; ++z) { const int tz = t + (2 + z) * nwv; const int tc = tz < NTOK ? tz : t; const GAS v4u* ip = (const GAS v4u*)(IDS + (size_t)tc * 128 + 16 * k);
#pragma unroll
                    for (int i = 0; i < 2; ++i) nid[z][i] = ip[i]; }
#pragma unroll
                for (int z = 0; z < 2; ++z) {
                    int p[16];
#pragma unroll
                    for (int i = 0; i < 16; ++i) { int d = 0;
                        d = __builtin_amdgcn_sdot4((int)ub[z][i].x, (int)hs[z].x, d, false); d = __builtin_amdgcn_sdot4((int)ub[z][i].y, (int)hs[z].y, d, false);
                        d = __builtin_amdgcn_sdot4((int)ub[z][i].z, (int)hs[z].z, d, false); d = __builtin_amdgcn_sdot4((int)ub[z][i].w, (int)hs[z].w, d, false); p[i] = d; }
                    const bool b0 = (c8 & 1) != 0, b1 = (c8 & 2) != 0, b2 = (c8 & 4) != 0;
                    int r1[8], r2[4], q0, q1;
#define DPPI(v, ctrl) __builtin_amdgcn_update_dpp(0, (v), (ctrl), 0xf, 0xf, true)
#pragma unroll
                    for (int m = 0; m < 8; ++m) { const int keep = b0 ? p[2 * m + 1] : p[2 * m], give = b0 ? p[2 * m] : p[2 * m + 1]; r1[m] = keep + DPPI(give, 0xB1); }
#pragma unroll
                    for (int m = 0; m < 4; ++m) { const int keep = b1 ? r1[2 * m + 1] : r1[2 * m], give = b1 ? r1[2 * m] : r1[2 * m + 1]; r2[m] = keep + DPPI(give, 0x4E); }
                    { const int keep = b2 ? r2[1] : r2[0], give = b2 ? r2[0] : r2[1]; const int gl = DPPI(give, 0x104), gr = DPPI(give, 0x114); q0 = keep + (b2 ? gr : gl); }
                    { const int keep = b2 ? r2[3] : r2[2], give = b2 ? r2[2] : r2[3]; const int gl = DPPI(give, 0x104), gr = DPPI(give, 0x114); q1 = keep + (b2 ? gr : gl); }
#undef DPPI
                    if (z == 0 || vB) *(GAS v2u*)(DOTX + ((size_t)xr * NTOK + tt[z]) * 128 + 2 * ln) = (v2u){(unsigned)(q0 + old[z][0]), (unsigned)(q1 + old[z][1])};
                }
            }
        }
    }
    GRID_BAR();
    for (int i8 = gt; i8 < NTOK * 16; i8 += NGT) {
        const size_t gi = (size_t)i8 * 8; v4u a0 = {0u, 0u, 0u, 0u}, a1 = a0;
        for (int xx = 0; xx < nx; ++xx) { const GAS v4u* dp = (const GAS v4u*)((const int*)DOTX + (size_t)xx * NTOK * 128 + gi); const v4u p0 = dp[0], p1 = dp[1]; a0 += p0; a1 += p1; }
        const GAS f32x4* gp = (const GAS f32x4*)(GATES + gi); const f32x4 g0 = gp[0], g1 = gp[1];
        const float sc = HSC[i8 >> 4] * (1.0f / U_QSCALE);
        float c[8];
        c[0] = g0.x * gelu_erf((float)(int)a0.x * sc); c[1] = g0.y * gelu_erf((float)(int)a0.y * sc); c[2] = g0.z * gelu_erf((float)(int)a0.z * sc); c[3] = g0.w * gelu_erf((float)(int)a0.w * sc);
        c[4] = g1.x * gelu_erf((float)(int)a1.x * sc); c[5] = g1.y * gelu_erf((float)(int)a1.y * sc); c[6] = g1.z * gelu_erf((float)(int)a1.z * sc); c[7] = g1.w * gelu_erf((float)(int)a1.w * sc);
        float am = 0.f;
#pragma unroll
        for (int j2 = 0; j2 < 8; ++j2) am = fmaxf(am, fabsf(c[j2]));
        am = fmaxf(am, DPPF(am, 0xB1)); am = fmaxf(am, DPPF(am, 0x4E)); am = fmaxf(am, DPPF(am, 0x141)); am = fmaxf(am, DPPF(am, 0x128));
        am = fmaxf(am, 1e-30f); const float iq = 127.0f / am;
        v2u o; o.x = (unsigned)(q8(c[0] * iq) | (q8(c[1] * iq) << 8) | (q8(c[2] * iq) << 16) | (q8(c[3] * iq) << 24)); o.y = (unsigned)(q8(c[4] * iq) | (q8(c[5] * iq) << 8) | (q8(c[6] * iq) << 16) | (q8(c[7] * iq) << 24));
        *(GAS v2u*)(CB8 + gi) = o;
        if ((i8 & 15) == 0) CSC[i8 >> 4] = am * (1.0f / (127.0f * V_QSCALE));
    }
    GRID_BAR();
    {
        int tl = tid; asm volatile("" : "+v"(tl)); const int ln = tl & 63, k = ln >> 3, c8 = ln & 7;
        const unsigned char* VT8 = (const unsigned char*)VT;
        for (int s = xr; s < NSL; s += nx) {
            const unsigned char* Vs = VT8 + (size_t)s * 16384 * 128;
            v4u nid[2][2];
#pragma unroll
            for (int z = 0; z < 2; ++z) { const int tz = wv + z * nwv; const int tc = tz < NTOK ? tz : wv; const GAS v4u* ip = (const GAS v4u*)(IDS + (size_t)tc * 128 + 16 * k);
#pragma unroll
                for (int i = 0; i < 2; ++i) nid[z][i] = ip[i]; }
#pragma unroll 1
            for (int t = wv; t < NTOK; t += 2 * nwv) {
                const bool vB = (t + nwv) < NTOK; const int tt[2] = {t, vB ? t + nwv : t};
                v4u vb[2][16]; v4u cf[2]; unsigned hs[2]; float scl[2];
#pragma unroll
                for (int z = 0; z < 2; ++z) {
#pragma unroll
                    for (int i = 0; i < 16; ++i) { const unsigned eid = (nid[z][i >> 3][(i >> 1) & 3] >> (16 * (i & 1))) & 0xffffu; vb[z][i] = *(const GAS v4u*)(Vs + (size_t)eid * 128 + 16 * c8); } }
#pragma unroll
                for (int z = 0; z < 2; ++z) { hs[z] = *(const GAS unsigned*)(H1 + (size_t)tt[z] * DM + 128 * s + 16 * c8 + 2 * k);
                    cf[z] = *(const GAS v4u*)(CB8 + (size_t)tt[z] * 128 + 16 * k); scl[z] = CSC[tt[z]]; }
#pragma unroll
                for (int z = 0; z < 2; ++z) { const int tz = t + (2 + z) * nwv; const int tc = tz < NTOK ? tz : t; const GAS v4u* ip = (const GAS v4u*)(IDS + (size_t)tc * 128 + 16 * k);
#pragma unroll
                    for (int i = 0; i < 2; ++i) nid[z][i] = ip[i]; }
#pragma unroll
                for (int z = 0; z < 2; ++z) {
                    int ai[16];
#pragma unroll
                    for (int q2 = 0; q2 < 16; ++q2) ai[q2] = 0;
#pragma unroll
                    for (int ig = 0; ig < 4; ++ig) { const int cq = (int)cf[z][ig];
#pragma unroll
                        for (int dw = 0; dw < 4; ++dw) {
                            const unsigned d0 = vb[z][4 * ig][dw], d1 = vb[z][4 * ig + 1][dw], d2 = vb[z][4 * ig + 2][dw], d3 = vb[z][4 * ig + 3][dw];
                            const unsigned p0 = __builtin_amdgcn_perm(d1, d0, 0x05010400u), p1 = __builtin_amdgcn_perm(d1, d0, 0x07030602u), p2 = __builtin_amdgcn_perm(d3, d2, 0x05010400u), p3 = __builtin_amdgcn_perm(d3, d2, 0x07030602u);
                            ai[4 * dw + 0] = __builtin_amdgcn_sdot4((int)__builtin_amdgcn_perm(p2, p0, 0x05040100u), cq, ai[4 * dw + 0], false);
                            ai[4 * dw + 1] = __builtin_amdgcn_sdot4((int)__builtin_amdgcn_perm(p2, p0, 0x07060302u), cq, ai[4 * dw + 1], false);
                            ai[4 * dw + 2] = __builtin_amdgcn_sdot4((int)__builtin_amdgcn_perm(p3, p1, 0x05040100u), cq, ai[4 * dw + 2], false);
                            ai[4 * dw + 3] = __builtin_amdgcn_sdot4((int)__builtin_amdgcn_perm(p3, p1, 0x07060302u), cq, ai[4 * dw + 3], false); } }
                    const bool kb0 = (k & 1) != 0, kb1 = (k & 2) != 0, kb2 = (k & 4) != 0;
                    int rAx[4], rAy[4], rBx[2], rBy[2], rCx, rCy;
#define DPPI(v, ctrl) __builtin_amdgcn_update_dpp(0, (v), (ctrl), 0xf, 0xf, true)
#pragma unroll
                    for (int m = 0; m < 4; ++m) { const int kx = kb0 ? ai[4 * m + 2] : ai[4 * m], ky = kb0 ? ai[4 * m + 3] : ai[4 * m + 1], gx = kb0 ? ai[4 * m] : ai[4 * m + 2], gy = kb0 ? ai[4 * m + 1] : ai[4 * m + 3];
                        rAx[m] = kx + DPPI(gx, 0x128); rAy[m] = ky + DPPI(gy, 0x128); }
#pragma unroll
                    for (int m = 0; m < 2; ++m) { const int kx = kb1 ? rAx[2 * m + 1] : rAx[2 * m], ky = kb1 ? rAy[2 * m + 1] : rAy[2 * m], gx = kb1 ? rAx[2 * m] : rAx[2 * m + 1], gy = kb1 ? rAy[2 * m] : rAy[2 * m + 1];
                        const auto sx = __builtin_amdgcn_permlane16_swap((unsigned)gx, (unsigned)gx, false, false), sy = __builtin_amdgcn_permlane16_swap((unsigned)gy, (unsigned)gy, false, false);
                        rBx[m] = kx + (int)(kb1 ? sx[0] : sx[1]); rBy[m] = ky + (int)(kb1 ? sy[0] : sy[1]); }
                    { const int kx = kb2 ? rBx[1] : rBx[0], ky = kb2 ? rBy[1] : rBy[0], gx = kb2 ? rBx[0] : rBx[1], gy = kb2 ? rBy[0] : rBy[1];
                        const auto sx = __builtin_amdgcn_permlane32_swap((unsigned)gx, (unsigned)gx, false, false), sy = __builtin_amdgcn_permlane32_swap((unsigned)gy, (unsigned)gy, false, false);
                        rCx = kx + (int)(kb2 ? sx[0] : sx[1]); rCy = ky + (int)(kb2 ? sy[0] : sy[1]); }
#undef DPPI
                    if (z == 0 || vB) *(GAS unsigned*)(YB + (size_t)tt[z] * DM + 128 * s + 16 * c8 + 2 * k) = cvtpk_s((float)rCx * scl[z] + ALPHA * bflo(hs[z]), (float)rCy * scl[z] + ALPHA * bfhi(hs[z]));
                }
            }
        }
    }
    GRID_BAR();
    v4u wa[4], wn[4]; if (gw < NTOK) ln_load_bf16(wa, YB + (size_t)gw * DM, lane);
    for (int m = gw; m < NTOK; m += NGW) {
        { const int mn = m + NGW; if (mn < NTOK) ln_load_bf16(wn, YB + (size_t)mn * DM, lane); }
        float v[32]; float sm = 0.f;
#pragma unroll
        for (int j2 = 0; j2 < 4; ++j2) { const v4u w = wa[j2];
            v[8 * j2 + 0] = bflo(w.x); v[8 * j2 + 1] = bfhi(w.x); v[8 * j2 + 2] = bflo(w.y); v[8 * j2 + 3] = bfhi(w.y); v[8 * j2 + 4] = bflo(w.z); v[8 * j2 + 5] = bfhi(w.z); v[8 * j2 + 6] = bflo(w.w); v[8 * j2 + 7] = bfhi(w.w); }
#pragma unroll
        for (int i = 0; i < 32; ++i) sm += v[i];
        const float mean = wave_sum(sm) * (1.f / DM); float s2 = 0.f;
#pragma unroll
        for (int i = 0; i < 32; ++i) { v[i] -= mean; s2 += v[i] * v[i]; }
        const float rstd = 1.f / sqrtf(wave_sum(s2) * (1.f / DM) + LN_EPS);
#pragma unroll
        for (int j2 = 0; j2 < 4; ++j2) {
            const GAS f32x4* gp = (const GAS f32x4*)ln_ffn_g + 2 * (lane + 64 * j2); const GAS f32x4* bp = (const GAS f32x4*)ln_ffn_b + 2 * (lane + 64 * j2);
            const f32x4 g0 = gp[0], g1 = gp[1], b0 = bp[0], b1 = bp[1];
            GAS f32x4* op = (GAS f32x4*)(out + (size_t)m * DM) + 2 * (lane + 64 * j2);
            op[0] = (f32x4){v[8 * j2 + 0] * rstd * g0.x + b0.x, v[8 * j2 + 1] * rstd * g0.y + b0.y, v[8 * j2 + 2] * rstd * g0.z + b0.z, v[8 * j2 + 3] * rstd * g0.w + b0.w};
            op[1] = (f32x4){v[8 * j2 + 4] * rstd * g1.x + b1.x, v[8 * j2 + 5] * rstd * g1.y + b1.y, v[8 * j2 + 6] * rstd * g1.z + b1.z, v[8 * j2 + 7] * rstd * g1.w + b1.w}; }
#pragma unroll
        for (int j2 = 0; j2 < 4; ++j2) wa[j2] = wn[j2];
    }
}

extern "C" void kernel_launch(void* const* d_in, const int* in_sizes, int n_in, void* d_out, int out_size, void* d_ws, size_t ws_size, hipStream_t stream) {
    static int grid = 0;
    if (grid == 0) {
        if (n_in != 15 || out_size != NTOK * DM || ws_size < WS_END) { fprintf(stderr, "kernel_launch: unexpected shapes (n_in %d out %d ws %zu)\n", n_in, out_size, ws_size); grid = -1; return; }
        int dev = 0, cus = 0, per_cu = 0;
        if (hipGetDevice(&dev) != hipSuccess || hipDeviceGetAttribute(&cus, hipDeviceAttributeMultiprocessorCount, dev) != hipSuccess) { grid = -1; return; }
        if (hipFuncSetAttribute((const void*)mk_fwd, hipFuncAttributeMaxDynamicSharedMemorySize, LDS_BYTES) != hipSuccess) { fprintf(stderr, "kernel_launch: hipFuncSetAttribute failed\n"); grid = -1; return; }
        if (hipOccupancyMaxActiveBlocksPerMultiprocessor(&per_cu, (const void*)mk_fwd, NWAVES * 64, LDS_BYTES) != hipSuccess || per_cu < 1) { fprintf(stderr, "kernel_launch: occupancy query says %d\n", per_cu); }
        (void)hipGetLastError();
        grid = cus;
    }
    if (grid < 0) return;
    if (hipMemsetAsync((char*)d_ws + WS_CTL, 0, CTL_ZERO_BYTES, stream) != hipSuccess) return;
    Args a{};
    for (int i = 0; i < 15; ++i) a.in[i] = (const float*)d_in[i];
    a.out = (float*)d_out; a.ws = (unsigned char*)d_ws;
    hipLaunchKernelGGL(mk_fwd, dim3(grid), dim3(NWAVES * 64), LDS_BYTES, stream, a);
}
```

```cpp
#include <hip/hip_runtime.h>
#include <cstdio>
#include <cstdint>
#include <cmath>
namespace pg8 {
#define PG8_LAS __attribute__((address_space(3)))
typedef unsigned short bf16_t;
typedef short bf16x8 __attribute__((ext_vector_type(8)));
typedef float f32x4 __attribute__((ext_vector_type(4)));
typedef unsigned u32x4 __attribute__((ext_vector_type(4)));
constexpr int BM = 256, BK = 64, HALF = 128, HTB = HALF * BK * 2  , STAGE_BYTES = 8 * HTB, NXCD = 8, WGM = 4;

__host__ __device__ __forceinline__ int lds_byte(int r, int c) { const int st = (r >> 4) * 2 + (c >> 5), rr = r & 15, cc = c & 31, ob = rr * 64 + cc * 2; return st * 1024 + (ob ^ (((ob >> 9) & 1) << 5)); }
__host__ __device__ __forceinline__ void stage_rc(int b, int& R, int& C) { const int st = b / 1024, sb = b % 1024, swz = sb ^ (((sb >> 9) & 1) << 5); R = (st >> 1) * 16 + swz / 64; C = (st & 1) * 32 + (swz % 64) / 2; }
__host__ __device__ __forceinline__ int perm32(int rho) { const int n = rho >> 4, i = rho & 15; return 8 * (i >> 2) + 4 * n + (i & 3); }

struct Unit { int pm, pn; };
struct Gemm { const bf16_t* A; const bf16_t* Bt; int M, N, K; const float* rs; const float* cs; };
typedef int i32x4 __attribute__((ext_vector_type(4)));

struct StaticOrder {
    int nM, nN, nwg, G, c, wgm;
    __host__ __device__ void init(int M, int N, int G_, int c_, int wgm_ = WGM) { nM = M / BM; nN = N / BM; nwg = nM * nN; G = G_; c = c_; wgm = wgm_; }
    __host__ __device__ bool next(int i, Unit& u) const {
        const long L = (long)i * G + c; if (L >= nwg) return false;
        int wgid = (int)L; { const int q = nwg / NXCD, r = nwg % NXCD, xcd = wgid % NXCD, off = wgid / NXCD; wgid = (xcd < r ? xcd * (q + 1) : r * (q + 1) + (xcd - r) * q) + off; }
        const int nig = wgm * nN, gid = wgid / nig, fm = gid * wgm, gsz = (nM - fm) < wgm ? (nM - fm) : wgm;
        u.pm = fm + ((wgid % nig) % gsz); u.pn = (wgid % nig) / gsz; return true;
    }
    __device__ __forceinline__ void a_ready(const Unit&) const {}
    __device__ __forceinline__ void done(const Unit&) const {}
};

__device__ __forceinline__ unsigned cvt_pk_bf16(float lo, float hi) { unsigned r; asm volatile("v_cvt_pk_bf16_f32 %0, %1, %2" : "=v"(r) : "v"(lo), "v"(hi)); return r; }
typedef float f32x2 __attribute__((ext_vector_type(2)));

template <int MODE> struct EpiGen {
    static constexpr bool PERM = true, AFTER_DRAIN = false;
    bf16_t* O; int ldc; const bf16_t* R; float alpha;
    bf16_t *QR, *KA, *VA, *RK, *RV, *RG;
    __device__ __forceinline__ void operator()(const f32x4 (&acc)[2][2][4][2], const Unit& u, int wr, int wc, int fr, int fq) const {
        const int row0 = u.pm * BM + wr * 64 + fr;
#pragma unroll
        for (int bj = 0; bj < 2; ++bj) {
            const int col = u.pn * BM + bj * HALF + wc * 32 + 8 * fq;
            bf16_t* base = O; int ld = ldc; int cc = col;
            if (MODE == 0) {
                if (col < 1024)      { base = QR; ld = 2048; cc = col; }
                else if (col < 1152) { base = KA; ld = 128;  cc = col - 1024; }
                else if (col < 1280) { base = VA; ld = 128;  cc = col - 1152; }
                else if (col < 2304) { base = QR; ld = 2048; cc = col - 1280 + 1024; }
                else if (col < 3328) { base = RK; ld = 1024; cc = col - 2304; }
                else if (col < 4352) { base = RV; ld = 1024; cc = col - 3328; }
                else                 { base = RG; ld = 1024; cc = col - 4352; }
            }
#pragma unroll
            for (int ai = 0; ai < 2; ++ai)
#pragma unroll
                for (int m = 0; m < 4; ++m) {
                    const int row = row0 + ai * HALF + m * 16;
                    f32x4 v0 = acc[ai][bj][m][0], v1 = acc[ai][bj][m][1];
                    if (MODE == 1) {
                        const u32x4 r = *(const u32x4*)(R + (size_t)row * ldc + col);
                        v0[0] += alpha * __uint_as_float(r.x << 16); v0[1] += alpha * __uint_as_float(r.x & 0xffff0000u);
                        v0[2] += alpha * __uint_as_float(r.y << 16); v0[3] += alpha * __uint_as_float(r.y & 0xffff0000u);
                        v1[0] += alpha * __uint_as_float(r.z << 16); v1[1] += alpha * __uint_as_float(r.z & 0xffff0000u);
                        v1[2] += alpha * __uint_as_float(r.w << 16); v1[3] += alpha * __uint_as_float(r.w & 0xffff0000u);
                    }
                    u32x4 w; w.x = cvt_pk_bf16(v0[0], v0[1]); w.y = cvt_pk_bf16(v0[2], v0[3]); w.z = cvt_pk_bf16(v1[0], v1[1]); w.w = cvt_pk_bf16(v1[2], v1[3]);
                    *(u32x4*)(base + (size_t)row * ld + cc) = w;
                }
        }
    }
};

struct EpiProj {
    static constexpr bool PERM = true, AFTER_DRAIN = false;
    bf16_t *QR, *KA, *VA, *RK, *RV, *RG; float qscale;
    __device__ __forceinline__ void operator()(const f32x4 (&acc)[2][2][4][2], const Unit& u, int wr, int wc, int fr, int fq) const {
        const int pn = u.pn, row0 = u.pm * BM + wr * 64 + fr, c0 = wc * 32 + 8 * fq;
        const bool rope = (pn <= 3) || (pn == 4 && wc < 2) || (pn >= 5 && pn <= 12);
        if (rope) {
            const bool ret = pn >= 5; const int h = ret ? ((pn - 5) & 3) : 0;
            const float lg = __builtin_amdgcn_logf(1.0f - __builtin_amdgcn_exp2f(-5.0f - (float)h));
            float invrev[8];
#pragma unroll
            for (int i8 = 0; i8 < 8; ++i8) { const float ii = (float)((ret ? c0 : 8 * fq) + i8); invrev[i8] = 0.15915494309189535f * __builtin_amdgcn_exp2f(-ii * (ret ? 0.10381025296523008f : 0.4152410118609203f)); }
            bf16_t* base; int ld, cA, cB;
            if (pn <= 3)      { base = QR; ld = 2048; cA = pn * 256 + 64 * wc + 8 * fq; cB = cA + 32; }
            else if (pn == 4) { base = KA; ld = 128;  cA = 64 * wc + 8 * fq; cB = cA + 32; }
            else if (pn <= 8) { base = QR; ld = 2048; cA = 1024 + 256 * h + c0; cB = cA + 128; }
            else              { base = RK; ld = 1024; cA = 256 * h + c0; cB = cA + 128; }
#pragma unroll
            for (int ai = 0; ai < 2; ++ai)
#pragma unroll
                for (int m = 0; m < 4; ++m) {
                    const int row = row0 + ai * HALF + m * 16;
                    int pos, ipos;
                    if (row < 16384) { const int s = row & 4095; pos = 16 + s; ipos = s & 127; } else { int j = row - 16384; if (j > 15) j = 15; pos = j; ipos = 112 + j; }
                    float sc = qscale;
                    if (pn == 4) sc = 1.0f; else if (pn >= 9) sc = 0.0625f * __builtin_amdgcn_exp2f(-(float)(ipos + 1) * lg); else if (pn >= 5) sc = __builtin_amdgcn_exp2f((float)(ipos + 1) * lg);
                    const float pf = (float)pos;
                    float cs[8], sn[8];
#pragma unroll
                    for (int i8 = 0; i8 < 8; ++i8) { const float rev = __builtin_amdgcn_fractf(pf * invrev[i8]); cs[i8] = __builtin_amdgcn_cosf(rev); sn[i8] = __builtin_amdgcn_sinf(rev); }
                    const f32x4 a0 = acc[ai][0][m][0], a1 = acc[ai][0][m][1], b0 = acc[ai][1][m][0], b1 = acc[ai][1][m][1];
                    u32x4 wA, wB;
                    wA.x = cvt_pk_bf16((a0[0] * cs[0] - b0[0] * sn[0]) * sc, (a0[1] * cs[1] - b0[1] * sn[1]) * sc); wA.y = cvt_pk_bf16((a0[2] * cs[2] - b0[2] * sn[2]) * sc, (a0[3] * cs[3] - b0[3] * sn[3]) * sc);
                    wA.z = cvt_pk_bf16((a1[0] * cs[4] - b1[0] * sn[4]) * sc, (a1[1] * cs[5] - b1[1] * sn[5]) * sc); wA.w = cvt_pk_bf16((a1[2] * cs[6] - b1[2] * sn[6]) * sc, (a1[3] * cs[7] - b1[3] * sn[7]) * sc);
                    wB.x = cvt_pk_bf16((b0[0] * cs[0] + a0[0] * sn[0]) * sc, (b0[1] * cs[1] + a0[1] * sn[1]) * sc); wB.y = cvt_pk_bf16((b0[2] * cs[2] + a0[2] * sn[2]) * sc, (b0[3] * cs[3] + a0[3] * sn[3]) * sc);
                    wB.z = cvt_pk_bf16((b1[0] * cs[4] + a1[0] * sn[4]) * sc, (b1[1] * cs[5] + a1[1] * sn[5]) * sc); wB.w = cvt_pk_bf16((b1[2] * cs[6] + a1[2] * sn[6]) * sc, (b1[3] * cs[7] + a1[3] * sn[7]) * sc);
                    *(u32x4*)(base + (size_t)row * ld + cA) = wA; *(u32x4*)(base + (size_t)row * ld + cB) = wB;
                }
        } else {
            const bool silu = pn >= 17;
#pragma unroll
            for (int bj = 0; bj < 2; ++bj) {
                bf16_t* base; int ld, cc;
                if (pn == 4)       { base = VA; ld = 128;  cc = 64 * bj + 32 * (wc - 2) + 8 * fq; }
                else if (pn <= 16) { base = RV; ld = 1024; cc = 256 * (pn - 13) + 128 * bj + c0; }
                else               { base = RG; ld = 1024; cc = 256 * (pn - 17) + 128 * bj + c0; }
#pragma unroll
                for (int ai = 0; ai < 2; ++ai)
#pragma unroll
                    for (int m = 0; m < 4; ++m) {
                        const int row = row0 + ai * HALF + m * 16;
                        f32x4 v0 = acc[ai][bj][m][0], v1 = acc[ai][bj][m][1];
                        if (silu) {
#pragma unroll
                            for (int e = 0; e < 4; ++e) { v0[e] = v0[e] * __builtin_amdgcn_rcpf(1.0f + __builtin_amdgcn_exp2f(-1.4426950408889634f * v0[e])); v1[e] = v1[e] * __builtin_amdgcn_rcpf(1.0f + __builtin_amdgcn_exp2f(-1.4426950408889634f * v1[e])); } }
                        u32x4 w; w.x = cvt_pk_bf16(v0[0], v0[1]); w.y = cvt_pk_bf16(v0[2], v0[3]); w.z = cvt_pk_bf16(v1[0], v1[1]); w.w = cvt_pk_bf16(v1[2], v1[3]);
                        *(u32x4*)(base + (size_t)row * ld + cc) = w;
                    }
            }
        }
    }
};
struct NoHook { __device__ __forceinline__ void operator()(int) const {} };
template <class Epi, class Sched, bool ALIGN_EPI = false, bool SP2 = false, class Hook = NoHook, bool I8 = false>
__device__ __forceinline__ void gemm_phase(PG8_LAS unsigned char* lds, const Gemm g, const Sched& S, const Epi& E, const Hook& H = Hook()) {
    const int tid = threadIdx.x, wid = __builtin_amdgcn_readfirstlane(tid >> 6), lane = tid & 63, wr = wid >> 2, wc = wid & 3, fr = lane & 15, fq = lane >> 4;
    const int K = g.K, nt = K / BK;
    unsigned voffA[2], voffB[2];
#pragma unroll
    for (int i = 0; i < 2; ++i) { int R, C; stage_rc(tid * 16 + i * 8192, R, C); const int Rb = Epi::PERM ? ((R & ~31) + perm32(R & 31)) : R;
        voffA[i] = (unsigned)(R * K + C) * 2u; voffB[i] = (unsigned)(Rb * K + C) * 2u; }
    const size_t kstep = (size_t)(BK * 2);
    const size_t hstep = (size_t)HALF * K * 2;
    const size_t tstep = 2 * hstep;
    const unsigned ldsw = (unsigned)wid * 1024u;
    const int aoff = lds_byte(wr * 64 + fr, fq * 8), boff = lds_byte(wc * 32 + fr, fq * 8);
#define PG8_SA(b, h) (((b) * 2 + (h)) * HTB)
#define PG8_SB(b, h) ((4 + (b) * 2 + (h)) * HTB)
#define PG8_STAGE(bufoff, gbase, voff) do { _Pragma("unroll") for (int _i = 0; _i < 2; ++_i) \
        __builtin_amdgcn_global_load_lds((const unsigned*)((const char*)(gbase) + (voff)[_i]), (PG8_LAS unsigned*)(lds + (bufoff) + ldsw + _i * 8192), 16, 0, 0); } while (0)
#define PG8_LDA(dst, b, h) do { _Pragma("unroll") for (int m = 0; m < 4; ++m) _Pragma("unroll") for (int k = 0; k < 2; ++k) dst[m][k] = *(const PG8_LAS bf16x8*)(lds + PG8_SA(b, h) + aoff + m * 2048 + k * 1024); } while (0)
#define PG8_LDB(dst, b, h) do { _Pragma("unroll") for (int n = 0; n < 2; ++n) _Pragma("unroll") for (int k = 0; k < 2; ++k) dst[n][k] = *(const PG8_LAS bf16x8*)(lds + PG8_SB(b, h) + boff + n * 2048 + k * 1024); } while (0)
#define PG8_MMA(ai, bj, At, Bt) do { __builtin_amdgcn_s_setprio(1); _Pragma("unroll") for (int m = 0; m < 4; ++m) _Pragma("unroll") for (int n = 0; n < 2; ++n) _Pragma("unroll") for (int k = 0; k < 2; ++k) \
        { if constexpr (I8) acc[ai][bj][m][n] = __builtin_bit_cast(f32x4, __builtin_amdgcn_mfma_i32_16x16x64_i8(__builtin_bit_cast(i32x4, Bt[n][k]), __builtin_bit_cast(i32x4, At[m][k]), __builtin_bit_cast(i32x4, acc[ai][bj][m][n]), 0, 0, 0)); \
          else acc[ai][bj][m][n] = __builtin_amdgcn_mfma_f32_16x16x32_bf16(Bt[n][k], At[m][k], acc[ai][bj][m][n], 0, 0, 0); } __builtin_amdgcn_s_setprio(0); } while (0)
#define PG8_WAIT_V(n) asm volatile("s_waitcnt vmcnt(" #n ")" ::: "memory")
#define PG8_WAIT_L(n) asm volatile("s_waitcnt lgkmcnt(" #n ")" ::: "memory")
#define PG8_BAR __builtin_amdgcn_s_barrier()
#define PG8_SCHED __builtin_amdgcn_sched_barrier(0)
    Unit cur, nxt; int ui = 0;
    if (!S.next(0, cur)) return;
    f32x4 acc[2][2][4][2];
#pragma unroll
    for (int a = 0; a < 2; ++a)
#pragma unroll
        for (int b = 0; b < 2; ++b)
#pragma unroll
            for (int m = 0; m < 4; ++m)
#pragma unroll
                for (int n = 0; n < 2; ++n) acc[a][b][m][n] = (f32x4){0.f, 0.f, 0.f, 0.f};
    bf16x8 At[4][2], B0[2][2], B1[2][2];
    const char* cA = (const char*)g.A + (size_t)cur.pm * tstep; const char* cB = (const char*)g.Bt + (size_t)cur.pn * tstep;
    S.a_ready(cur);
    if constexpr (SP2) {
        PG8_STAGE(PG8_SB(0, 0), cB, voffB); PG8_STAGE(PG8_SB(0, 1), cB + hstep, voffB); PG8_STAGE(PG8_SA(0, 0), cA, voffA); PG8_STAGE(PG8_SA(0, 1), cA + hstep, voffA);
        if (wr == 1) PG8_BAR;
        PG8_WAIT_V(2); PG8_BAR;
        PG8_STAGE(PG8_SB(1, 0), cB + kstep, voffB); PG8_STAGE(PG8_SA(1, 0), cA + kstep, voffA); PG8_STAGE(PG8_SB(1, 1), cB + hstep + kstep, voffB);
        PG8_WAIT_V(6); PG8_BAR;
    } else {
        PG8_STAGE(PG8_SB(0, 0), cB, voffB); PG8_STAGE(PG8_SA(0, 0), cA, voffA); PG8_STAGE(PG8_SB(0, 1), cB + hstep, voffB); PG8_STAGE(PG8_SA(0, 1), cA + hstep, voffA);
        if (wr == 1) PG8_BAR;
        PG8_WAIT_V(4); PG8_BAR;
        PG8_STAGE(PG8_SB(1, 0), cB + kstep, voffB); PG8_STAGE(PG8_SA(1, 0), cA + kstep, voffA); PG8_STAGE(PG8_SB(1, 1), cB + hstep + kstep, voffB);
        PG8_WAIT_V(6); PG8_BAR;
    }
    for (;;) {
        const bool has_next = S.next(ui + 1, nxt);
        const char* nA = has_next ? (const char*)g.A + (size_t)nxt.pm * tstep : cA; const char* nB = has_next ? (const char*)g.Bt + (size_t)nxt.pn * tstep : cB;
        for (int t = 0; t < nt; t += 2) {
            const bool last = (t == nt - 2);
            const char* a1 = cA + (size_t)(t + 1) * kstep;
            const char* a2 = last ? nA : cA + (size_t)(t + 2) * kstep; const char* b2 = last ? nB : cB + (size_t)(t + 2) * kstep;
            const char* a3 = a2 + kstep; const char* b3 = b2 + kstep;
            if (last && has_next) S.a_ready(nxt);
            if constexpr (SP2) {
            PG8_LDB(B0, 0, 0); PG8_LDB(B1, 0, 1); PG8_SCHED; PG8_LDA(At, 0, 0); PG8_STAGE(PG8_SA(1, 1), a1 + hstep, voffA);
            PG8_WAIT_V(8); PG8_WAIT_L(0); PG8_BAR; PG8_MMA(0, 0, At, B0); PG8_MMA(0, 1, At, B1); PG8_BAR; PG8_SCHED;
            PG8_LDA(At, 0, 1); PG8_STAGE(PG8_SB(0, 0), b2, voffB); PG8_STAGE(PG8_SB(0, 1), b2 + hstep, voffB); PG8_STAGE(PG8_SA(0, 0), a2, voffA);
            PG8_WAIT_V(8); PG8_WAIT_L(0); PG8_BAR; PG8_MMA(1, 0, At, B0); PG8_MMA(1, 1, At, B1); PG8_BAR; PG8_SCHED;
            PG8_LDB(B0, 1, 0); PG8_LDB(B1, 1, 1); PG8_SCHED; PG8_LDA(At, 1, 0); PG8_STAGE(PG8_SA(0, 1), a2 + hstep, voffA);
            PG8_WAIT_V(8); PG8_WAIT_L(0); PG8_BAR; PG8_MMA(0, 0, At, B0); PG8_MMA(0, 1, At, B1); PG8_BAR; PG8_SCHED;
            PG8_LDA(At, 1, 1); PG8_STAGE(PG8_SB(1, 0), b3, voffB); PG8_STAGE(PG8_SB(1, 1), b3 + hstep, voffB); PG8_STAGE(PG8_SA(1, 0), a3, voffA);
            PG8_WAIT_V(8); PG8_WAIT_L(0); PG8_BAR; PG8_MMA(1, 0, At, B0); PG8_MMA(1, 1, At, B1); PG8_BAR; PG8_SCHED;
            } else {
            PG8_LDB(B0, 0, 0); PG8_SCHED; PG8_LDA(At, 0, 0); PG8_STAGE(PG8_SA(1, 1), a1 + hstep, voffA);
            PG8_WAIT_L(8); PG8_BAR; PG8_WAIT_L(0); PG8_MMA(0, 0, At, B0); PG8_BAR; PG8_SCHED;
            PG8_LDB(B1, 0, 1); PG8_STAGE(PG8_SB(0, 0), b2, voffB);
            PG8_BAR; PG8_WAIT_L(0); PG8_MMA(0, 1, At, B1); PG8_BAR;
            PG8_LDA(At, 0, 1); PG8_STAGE(PG8_SA(0, 0), a2, voffA);
            PG8_BAR; PG8_WAIT_L(0); PG8_MMA(1, 0, At, B0); PG8_BAR; PG8_SCHED;
            PG8_STAGE(PG8_SB(0, 1), b2 + hstep, voffB);
            PG8_WAIT_V(6); PG8_BAR; PG8_MMA(1, 1, At, B1); PG8_BAR;
            PG8_LDB(B0, 1, 0); PG8_SCHED; PG8_LDA(At, 1, 0); PG8_STAGE(PG8_SA(0, 1), a2 + hstep, voffA);
            PG8_WAIT_L(8); PG8_BAR; PG8_WAIT_L(0); PG8_MMA(0, 0, At, B0); PG8_BAR; PG8_SCHED;
            PG8_LDB(B1, 1, 1); PG8_STAGE(PG8_SB(1, 0), b3, voffB);
            PG8_BAR; PG8_WAIT_L(0); PG8_MMA(0, 1, At, B1); PG8_BAR;
            PG8_LDA(At, 1, 1); PG8_STAGE(PG8_SA(1, 0), a3, voffA);
            PG8_BAR; PG8_WAIT_L(0); PG8_MMA(1, 0, At, B0); PG8_BAR; PG8_SCHED;
            PG8_STAGE(PG8_SB(1, 1), b3 + hstep, voffB);
            PG8_WAIT_V(6); PG8_BAR; PG8_MMA(1, 1, At, B1); PG8_BAR;
            }
        }
        if constexpr (ALIGN_EPI) { if (wr == 0) PG8_BAR; }
        if constexpr (I8) {
            const int row0 = cur.pm * BM + wr * 64 + fr;
            float rsv[2][4];
#pragma unroll
            for (int ai = 0; ai < 2; ++ai)
#pragma unroll
                for (int m = 0; m < 4; ++m) rsv[ai][m] = g.rs[row0 + ai * HALF + m * 16];
#pragma unroll
            for (int bj = 0; bj < 2; ++bj) {
                const int col = cur.pn * BM + bj * HALF + wc * 32 + 8 * fq;
                const f32x4 c0 = *(const f32x4*)(g.cs + col), c1 = *(const f32x4*)(g.cs + col + 4);
#pragma unroll
                for (int ai = 0; ai < 2; ++ai)
#pragma unroll
                    for (int m = 0; m < 4; ++m)
                    {
                        const i32x4 i0 = __builtin_bit_cast(i32x4, acc[ai][bj][m][0]), i1 = __builtin_bit_cast(i32x4, acc[ai][bj][m][1]);
                        f32x4 f0, f1;
#pragma unroll
                        for (int e = 0; e < 4; ++e) { f0[e] = (float)i0[e] * (rsv[ai][m] * c0[e]); f1[e] = (float)i1[e] * (rsv[ai][m] * c1[e]); }
                        acc[ai][bj][m][0] = f0; acc[ai][bj][m][1] = f1; }
            }
        }
        if constexpr (!Epi::AFTER_DRAIN) { E(acc, cur, wr, wc, fr, fq); S.done(cur); }
        if (!has_next) break;
        H(ui);
#pragma unroll
        for (int a = 0; a < 2; ++a)
#pragma unroll
            for (int b = 0; b < 2; ++b)
#pragma unroll
                for (int m = 0; m < 4; ++m)
#pragma unroll
                    for (int n = 0; n < 2; ++n) acc[a][b][m][n] = (f32x4){0.f, 0.f, 0.f, 0.f};
        cur = nxt; cA = nA; cB = nB; ++ui;
        if constexpr (ALIGN_EPI) { if (wr == 1) PG8_BAR; }
    }
    PG8_WAIT_V(0);
    if constexpr (!ALIGN_EPI) { if (wr == 0) PG8_BAR; }
    PG8_BAR;
    if constexpr (Epi::AFTER_DRAIN) { E.fused(acc, cur, wr, wc, fr, fq, lds, wid, lane); S.done(cur); }
#undef PG8_SA
#undef PG8_SB
#undef PG8_STAGE
#undef PG8_LDA
#undef PG8_LDB
#undef PG8_MMA
#undef PG8_WAIT_V
#undef PG8_WAIT_L
#undef PG8_BAR
#undef PG8_SCHED
}
}

constexpr int NWAVES = 8;
constexpr int DM = 2048, NB = 4, SEQ = 4096, NTOK = NB * SEQ;
constexpr int NMETA = 16, NVALID = NTOK + NMETA, MROWS = 16640;
constexpr int IN_COLS = 5376;
constexpr float LN_EPS = 1e-5f, GN_EPS = 1e-5f;
constexpr float ALPHA = 1.189207115002721f;
constexpr float LOG2E = 1.4426950408889634f;
constexpr float QSCALE = 0.125f * LOG2E;
constexpr float U_QSCALE = 958.0f;
constexpr float V_QSCALE = 35.6f;
constexpr int NSL = 16;

constexpr size_t MiB = 1u << 20;
constexpr size_t WS_CTL = 0, CTL_ZERO_BYTES = 65536;
constexpr size_t SZ_SK = (size_t)16 * 128 * 128 * 2, SZ_ROPE_R = (size_t)4112 * 128 * 8, SZ_ROPE_A = (size_t)4112 * 32 * 8;
constexpr size_t SZ_W2T = (size_t)DM * DM * 2, SZ_W1T = (size_t)IN_COLS * DM * 2, SZ_TAB = (size_t)16384 * DM;
constexpr size_t SZ_ROWS2K = (size_t)MROWS * 2048 * 2, SZ_ROWS1K = (size_t)MROWS * 1024 * 2, SZ_ROWS128 = (size_t)MROWS * 128 * 2;
constexpr size_t SZ_TOK2K = (size_t)NTOK * 2048 * 2, SZ_ST = (size_t)16 * 32 * 256 * 256 * 2, SZ_IDS = (size_t)NTOK * 128 * 4;
constexpr size_t al256(size_t x) { return (x + 255) & ~(size_t)255; }
constexpr size_t WS_SK = 1 * MiB;
constexpr size_t WS_ROPE_R = al256(WS_SK + SZ_SK);
constexpr size_t WS_ROPE_A = al256(WS_ROPE_R + SZ_ROPE_R);
constexpr size_t WS_W2T = al256(WS_ROPE_A + SZ_ROPE_A), WS_W3T = al256(WS_W2T + SZ_W2T), WS_W1T = al256(WS_W3T + SZ_W2T);
constexpr size_t WS_UT = al256(WS_W1T + SZ_W1T), WS_VT = al256(WS_UT + SZ_TAB);
constexpr size_t WS_H0 = al256(WS_VT + SZ_TAB);
constexpr size_t WS_QR = al256(WS_H0 + SZ_ROWS2K);
constexpr size_t WS_KA = al256(WS_QR + SZ_ROWS2K), WS_VA = al256(WS_KA + SZ_ROWS128);
constexpr size_t WS_RK = al256(WS_VA + SZ_ROWS128), WS_RV = al256(WS_RK + SZ_ROWS1K), WS_RG = al256(WS_RV + SZ_ROWS1K);
constexpr size_t WS_ST = al256(WS_RG + SZ_ROWS1K);
constexpr size_t WS_Y = WS_RK;
constexpr size_t WS_H1 = WS_ST;
constexpr size_t WS_IDS = al256(WS_ST + SZ_ST), WS_GATES = al256(WS_IDS + SZ_IDS);
constexpr size_t WS_HSC = al256(WS_GATES + SZ_IDS);
constexpr size_t WS_CSC = al256(WS_HSC + (size_t)NTOK * 4);
constexpr size_t WS_H0Q = al256(WS_CSC + (size_t)NTOK * 4);
constexpr size_t WS_W1Q = al256(WS_H0Q + (size_t)MROWS * DM);
constexpr size_t WS_W3Q = al256(WS_W1Q + (size_t)IN_COLS * DM);
constexpr size_t WS_H0S = al256(WS_W3Q + (size_t)DM * DM);
constexpr size_t WS_WS1 = al256(WS_H0S + (size_t)MROWS * 4);
constexpr size_t WS_WS3 = al256(WS_WS1 + (size_t)IN_COLS * 4);
constexpr size_t WS_END = al256(WS_WS3 + (size_t)DM * 4);
static_assert(WS_Y + SZ_TOK2K <= WS_RG, "Y overlays RK|RV only");
static_assert(SZ_TOK2K <= SZ_ST && (size_t)NTOK * 1024 * 4 <= SZ_ST, "H1 / RET_RAW fit the state region");
static_assert(WS_END <= (size_t)512 * MiB, "workspace map fits 4 x largest tensor");
static_assert(WS_RK + (size_t)8 * NTOK * 128 * 4 <= WS_ST && WS_KA + (size_t)NTOK * 128 * 4 <= WS_RK && WS_H0 + (size_t)NTOK * DM * 4 <= WS_KA, "expert-phase overlays (DOTX over RK|RV, CB over KA|VA, Y32 over H0|QR)");
constexpr int CW_TMO = 0, CW_TABQ = 64, CW_BAR = 4096;

constexpr int RING_OFF = 0, RING_BYTES = 131072;
constexpr int LDSCTL_OFF = RING_BYTES, MISC_OFF = LDSCTL_OFF + 320;
constexpr int LDS_BYTES = 147456;

#define GAS __attribute__((address_space(1)))
#define LAS __attribute__((address_space(3)))
typedef unsigned short bf16;
typedef unsigned v4u __attribute__((ext_vector_type(4)));
typedef unsigned v2u __attribute__((ext_vector_type(2)));
typedef float f32x4 __attribute__((ext_vector_type(4)));
typedef float f32x2 __attribute__((ext_vector_type(2)));
typedef GAS unsigned gu32;
typedef __bf16 bf16x2_t __attribute__((ext_vector_type(2)));
#define RLX_AGENT __ATOMIC_RELAXED, __HIP_MEMORY_SCOPE_AGENT
#define LDS_WAIT() asm volatile("s_waitcnt lgkmcnt(0)" ::: "memory")
#define VM_WAIT() asm volatile("s_waitcnt vmcnt(0)" ::: "memory")
#define LDS_BAR() do { asm volatile("s_waitcnt lgkmcnt(0)" ::: "memory"); __builtin_amdgcn_s_barrier(); asm volatile("" ::: "memory"); } while (0)
__device__ __forceinline__ unsigned f2bf(float f) { unsigned u = __builtin_bit_cast(unsigned, f); return (u + 0x7fffu + ((u >> 16) & 1u)) >> 16; }
__device__ __forceinline__ unsigned pk2(float lo, float hi) { return f2bf(lo) | (f2bf(hi) << 16); }
__device__ __forceinline__ float bflo(unsigned w) { return __uint_as_float(w << 16); }
__device__ __forceinline__ float bfhi(unsigned w) { return __uint_as_float(w & 0xffff0000u); }
__device__ __forceinline__ float bf2f(bf16 h) { return __uint_as_float((unsigned)h << 16); }

#define XB_TMO      128
#define XB_XCNT(j)  (256  + 64 * (j))
#define XB_XSUB(j)  (1280 + 64 * (j))
#define XB_XGEN(j)  (2304 + 64 * (j))
#define XB_TOP      3328
#define XB_TOPGEN   3392
#define XCD_BAR_WORDS 3456
#define XB_SPIN_CAP (1u << 18)

__device__ __forceinline__ unsigned xb_ld(unsigned* p)              { return __hip_atomic_load(p, __ATOMIC_RELAXED, __HIP_MEMORY_SCOPE_AGENT); }
__device__ __forceinline__ unsigned xb_add(unsigned* p, unsigned v) { return __hip_atomic_fetch_add(p, v, __ATOMIC_RELAXED, __HIP_MEMORY_SCOPE_AGENT); }
__device__ __forceinline__ unsigned xb_xcc_id() { return (unsigned)__builtin_amdgcn_s_getreg((3 << 11) | 20) & 0xFu; }
#define XB_SPIN(cond, bar) do { unsigned _sp = 0; while (cond) { __builtin_amdgcn_s_sleep(1); \
    if ((++_sp & 255u) == 0u) { if (xb_ld(&(bar)[XB_TMO])) break; if (_sp > XB_SPIN_CAP) { atomicAdd(&(bar)[XB_TMO], 1u); break; } } } } while (0)

struct XcdBarrier {
    unsigned* bar; unsigned x;
    volatile LAS unsigned* st;
};

__device__ __forceinline__ XcdBarrier xcd_barrier_post(unsigned* bar, volatile LAS unsigned* st) {
    XcdBarrier b; b.bar = bar; b.x = xb_xcc_id(); b.st = st;
    if (threadIdx.x == 0) (void)xb_add(&bar[XB_XCNT(b.x)], 1u);
    return b;
}
__device__ __forceinline__ void xcd_barrier_complete(unsigned* bar, unsigned x, unsigned& nloc, unsigned& nx) {
    const unsigned G = gridDim.x * gridDim.y * gridDim.z;
    unsigned sum, cnt, mine, sp = 0u;
    for (;;) {
        sum = 0u; cnt = 0u; mine = 0u;
#pragma unroll
        for (unsigned j = 0; j < 16; ++j) { const unsigned c = xb_ld(&bar[XB_XCNT(j)]); sum += c; cnt += (c > 0u) ? 1u : 0u; mine = (j == x) ? c : mine; }
        if (sum == G) break;
        __builtin_amdgcn_s_sleep(1);
        if ((++sp & 255u) == 0u) { if (xb_ld(&bar[XB_TMO])) break; if (sp > XB_SPIN_CAP) { atomicAdd(&bar[XB_TMO], 1u); break; } }
    }
    nloc = mine > 0u ? mine : 1u; nx = cnt > 0u ? cnt : 1u;
}

__device__ __forceinline__ void xcd_barrier(const XcdBarrier& b) {
    asm volatile("s_waitcnt vmcnt(0)" ::: "memory");
    __syncthreads();
    if (threadIdx.x == 0) {
        unsigned* bar = b.bar;
        __builtin_amdgcn_s_waitcnt(0);
        unsigned nloc = b.st[0], nx = b.st[1];
        if (nloc == 0u) { xcd_barrier_complete(bar, b.x, nloc, nx); b.st[0] = nloc; b.st[1] = nx; }
        const unsigned old = xb_add(&bar[XB_XSUB(b.x)], 1u);
        const unsigned gen = old / nloc;
        if (old + 1u == (gen + 1u) * nloc) {
            __builtin_amdgcn_fence(__ATOMIC_RELEASE, "agent");
            asm volatile("s_waitcnt vmcnt(0)" ::: "memory");
            const unsigned og = xb_add(&bar[XB_TOP], 1u);
            const unsigned tg = og / nx;
            if (og + 1u == (tg + 1u) * nx) xb_add(&bar[XB_TOPGEN], 1u);
            else XB_SPIN(xb_ld(&bar[XB_TOPGEN]) == tg, bar);
            __builtin_amdgcn_fence(__ATOMIC_ACQUIRE, "agent");
            xb_add(&bar[XB_XGEN(b.x)], 1u);
            asm volatile("s_waitcnt vmcnt(0)" ::: "memory");
        } else {
            XB_SPIN(xb_ld(&bar[XB_XGEN(b.x)]) == gen, bar);
            __builtin_amdgcn_fence(__ATOMIC_ACQUIRE, "agent");
            asm volatile("s_waitcnt vmcnt(0)" ::: "memory");
        }
    }
    __syncthreads();
}


__device__ __forceinline__ float dot2bf(unsigned a, unsigned b, float c) { asm("v_dot2c_f32_bf16 %0, %1, %2" : "+v"(c) : "v"(a), "v"(b)); return c; }
__device__ __forceinline__ float dot8bf_dpp(v4u a, v4u b) { float c = 0.f; asm("v_dot2c_f32_bf16 %0, %1, %5\n\tv_dot2c_f32_bf16 %0, %2, %6\n\tv_dot2c_f32_bf16 %0, %3, %7\n\tv_dot2c_f32_bf16 %0, %4, %8\n\ts_nop 1" : "+v"(c) : "v"(a.x), "v"(a.y), "v"(a.z), "v"(a.w), "v"(b.x), "v"(b.y), "v"(b.z), "v"(b.w)); return c; }
#define DPPF(v, ctrl) __int_as_float(__builtin_amdgcn_update_dpp(0, __float_as_int(v), (ctrl), 0xf, 0xf, true))
__device__ __forceinline__ int q8(float x) { int q = (int)__builtin_rintf(x); q = q < -127 ? -127 : (q > 127 ? 127 : q); return q & 0xff; }
__device__ __forceinline__ float wave_sum(float v) {
    v += DPPF(v, 0xB1); v += DPPF(v, 0x4E); v += DPPF(v, 0x141); v += DPPF(v, 0x128);
    { const auto r16 = __builtin_amdgcn_permlane16_swap(__float_as_uint(v), __float_as_uint(v), false, false); v = __uint_as_float(r16[0]) + __uint_as_float(r16[1]); }
    { const auto r32 = __builtin_amdgcn_permlane32_swap(__float_as_uint(v), __float_as_uint(v), false, false); v = __uint_as_float(r32[0]) + __uint_as_float(r32[1]); }
    return v;
}
__device__ __forceinline__ float wave_max(float v) {
    v = fmaxf(v, DPPF(v, 0xB1)); v = fmaxf(v, DPPF(v, 0x4E)); v = fmaxf(v, DPPF(v, 0x141)); v = fmaxf(v, DPPF(v, 0x128));
    { const auto r16 = __builtin_amdgcn_permlane16_swap(__float_as_uint(v), __float_as_uint(v), false, false); v = fmaxf(__uint_as_float(r16[0]), __uint_as_float(r16[1])); }
    { const auto r32 = __builtin_amdgcn_permlane32_swap(__float_as_uint(v), __float_as_uint(v), false, false); v = fmaxf(__uint_as_float(r32[0]), __uint_as_float(r32[1])); }
    return v;
}
__device__ __forceinline__ float gelu_erf(float v) {
    const float av = fabsf(v), d = av * 0.2316418882f + 1.0f;
    const float t = __builtin_amdgcn_rcpf(d);
    float q = t * 0.5307027145f + (-0.7265760135f); q = q * t + 0.7107068705f; q = q * t + (-0.142248368f); q = q * t + 0.127414796f; q = q * t;
    const float e = __builtin_amdgcn_exp2f((v * v) * (-0.72134752044f));
    const float m = v * (q * e);
    return v < 0.f ? m : v - m;
}

struct Args { const float* in[15]; float* out; unsigned char* ws; };

__device__ __forceinline__ int w1_logical_col(int n0p) {
    const int pn = n0p >> 8, blk = (n0p & 255) >> 5, half = blk >> 2, a = blk & 3;
    if (pn <= 3) return pn * 256 + 64 * a + 32 * half;
    if (pn == 4) return (a < 2) ? (1024 + 64 * a + 32 * half) : (1152 + 64 * half + 32 * (a - 2));
    return n0p;
}
template <bool PERMW1> __device__ __forceinline__ void p0_transpose_item(const float* W, int K, int N, bf16* WT, LAS float* scr, int item, int lane) {
    const int nblk = N / 32, kb = item / nblk, nb = item % nblk, k0 = 64 * kb, n0 = 32 * nb; const int ns = PERMW1 ? w1_logical_col(n0) : n0;
    float tv[32];
#pragma unroll
    for (int i = 0; i < 32; ++i) { const int kk = 2 * i + (lane >> 5); tv[i] = W[(size_t)(k0 + kk) * N + ns + (lane & 31)]; }
#pragma unroll
    for (int i = 0; i < 32; ++i) { const int kk = 2 * i + (lane >> 5); scr[kk * 33 + (lane & 31)] = tv[i]; }
    LDS_WAIT(); asm volatile("" ::: "memory");
    const int c = lane & 7;
#pragma unroll
    for (int j = 0; j < 4; ++j) { const int n = (lane >> 3) + 8 * j; const LAS float* s = scr + (8 * c) * 33 + n;
        v4u o; o.x = pk2(s[0 * 33], s[1 * 33]); o.y = pk2(s[2 * 33], s[3 * 33]); o.z = pk2(s[4 * 33], s[5 * 33]); o.w = pk2(s[6 * 33], s[7 * 33]);
        *(GAS v4u*)(WT + (size_t)(n0 + n) * K + k0 + 8 * c) = o; }
    LDS_WAIT(); asm volatile("" ::: "memory");
}
__device__ __forceinline__ void ln_load_f32(f32x4 (&v)[8], const float* xrow, int lane) {
    const GAS f32x4* xr = (const GAS f32x4*)xrow + lane;
#pragma unroll
    for (int j = 0; j < 8; ++j) v[j] = xr[64 * j];
}
__device__ __forceinline__ void ln_row_f32_to_bf16(f32x4 (&v)[8], const float* g, const float* bta, bf16* orow, int lane) {
    float s = 0.f;
#pragma unroll
    for (int j = 0; j < 8; ++j) s += (v[j].x + v[j].y) + (v[j].z + v[j].w);
    const float mean = wave_sum(s) * (1.f / DM); float s2 = 0.f;
#pragma unroll
    for (int j = 0; j < 8; ++j) { v[j] = v[j] - mean; s2 += (v[j].x * v[j].x + v[j].y * v[j].y) + (v[j].z * v[j].z + v[j].w * v[j].w); }
    const float rstd = 1.f / sqrtf(wave_sum(s2) * (1.f / DM) + LN_EPS);
    GAS v2u* o8 = (GAS v2u*)orow + lane;
#pragma unroll
    for (int j = 0; j < 8; ++j) { const f32x4 gg = ((const GAS f32x4*)g)[lane + 64 * j], bb = ((const GAS f32x4*)bta)[lane + 64 * j];
        v2u o; o.x = pk2(v[j].x * rstd * gg.x + bb.x, v[j].y * rstd * gg.y + bb.y); o.y = pk2(v[j].z * rstd * gg.z + bb.z, v[j].w * rstd * gg.w + bb.w); o8[64 * j] = o; }
}
__device__ __forceinline__ void ln_row_f32_to_bf16_q(f32x4 (&v)[8], const float* g, const float* bta, bf16* orow, signed char* qrow, float* qscale, int lane) {
    float s = 0.f;
#pragma unroll
    for (int j = 0; j < 8; ++j) s += (v[j].x + v[j].y) + (v[j].z + v[j].w);
    const float mean = wave_sum(s) * (1.f / DM); float s2 = 0.f;
#pragma unroll
    for (int j = 0; j < 8; ++j) { v[j] = v[j] - mean; s2 += (v[j].x * v[j].x + v[j].y * v[j].y) + (v[j].z * v[j].z + v[j].w * v[j].w); }
    const float rstd = 1.f / sqrtf(wave_sum(s2) * (1.f / DM) + LN_EPS);
    GAS v2u* o8 = (GAS v2u*)orow + lane; float am = 0.f;
#pragma unroll
    for (int j = 0; j < 8; ++j) { const f32x4 gg = ((const GAS f32x4*)g)[lane + 64 * j], bb = ((const GAS f32x4*)bta)[lane + 64 * j];
        v[j].x = v[j].x * rstd * gg.x + bb.x; v[j].y = v[j].y * rstd * gg.y + bb.y; v[j].z = v[j].z * rstd * gg.z + bb.z; v[j].w = v[j].w * rstd * gg.w + bb.w;
        am = fmaxf(am, fmaxf(fmaxf(fabsf(v[j].x), fabsf(v[j].y)), fmaxf(fabsf(v[j].z), fabsf(v[j].w))));
        v2u o; o.x = pk2(v[j].x, v[j].y); o.y = pk2(v[j].z, v[j].w); o8[64 * j] = o; }
    am = fmaxf(wave_max(am), 1e-20f); const float iq = 127.0f / am;
    if (lane == 0) *qscale = am * (1.0f / 127.0f);
#pragma unroll
    for (int j = 0; j < 8; ++j) ((GAS unsigned*)qrow)[lane + 64 * j] = (unsigned)(q8(v[j].x * iq) | (q8(v[j].y * iq) << 8) | (q8(v[j].z * iq) << 16) | (q8(v[j].w * iq) << 24));
}
__device__ __forceinline__ void w_strip(LAS unsigned char* L, LAS float* red, const float* W, int ld, int ns, signed char* dst, float* sc, int tid) {
    asm volatile("" : "+v"(tid));
    const int kr = tid >> 3, c4 = tid & 7, lane = tid & 63, wave = __builtin_amdgcn_readfirstlane(tid >> 6);
    float mx[4] = {0.f, 0.f, 0.f, 0.f};
    const GAS f32x4* src = (const GAS f32x4*)(W + (size_t)kr * ld + ns) + c4;
#pragma unroll 1
    for (int r0 = 0; r0 < 32; r0 += 16) {
        f32x4 a[16];
#pragma unroll
        for (int i = 0; i < 16; ++i) a[i] = src[(size_t)(64 * (r0 + i)) * (ld / 4)];
#pragma unroll
        for (int i = 0; i < 16; ++i) { const int k = 64 * (r0 + i) + kr; const int so = ((((k >> 3) ^ c4)) << 4) + (k & 7) * 2;
#pragma unroll
            for (int j = 0; j < 4; ++j) { mx[j] = fmaxf(mx[j], fabsf(a[i][j])); *(LAS unsigned short*)(L + (4 * c4 + j) * 4096 + so) = (unsigned short)f2bf(a[i][j]); } }
    }
#pragma unroll
    for (int j = 0; j < 4; ++j) { mx[j] = fmaxf(mx[j], __shfl_xor(mx[j], 8)); mx[j] = fmaxf(mx[j], __shfl_xor(mx[j], 16)); mx[j] = fmaxf(mx[j], __shfl_xor(mx[j], 32)); }
    if (lane < 8) {
#pragma unroll
        for (int j = 0; j < 4; ++j) red[wave * 32 + 4 * c4 + j] = mx[j]; }
    LDS_BAR();
#pragma unroll 1
    for (int nn = 0; nn < 4; ++nn) {
        const int n = 4 * wave + nn; float am = 0.f;
#pragma unroll
        for (int w8 = 0; w8 < 8; ++w8) am = fmaxf(am, red[w8 * 32 + n]);
        am = fmaxf(am, 1e-30f); const float iq = 127.0f / am;
        if (lane == 0) sc[n] = am * (1.0f / 127.0f);
#pragma unroll
        for (int h = 0; h < 2; ++h) { const int run = h * 64 + lane;
            const v4u w0 = *(LAS const v4u*)(L + n * 4096 + (((2 * run) ^ (wave & 7)) << 4)), w1 = *(LAS const v4u*)(L + n * 4096 + (((2 * run + 1) ^ (wave & 7)) << 4));
            v4u o;
            o.x = (unsigned)(q8(bflo(w0.x) * iq) | (q8(bfhi(w0.x) * iq) << 8) | (q8(bflo(w0.y) * iq) << 16) | (q8(bfhi(w0.y) * iq) << 24));
            o.y = (unsigned)(q8(bflo(w0.z) * iq) | (q8(bfhi(w0.z) * iq) << 8) | (q8(bflo(w0.w) * iq) << 16) | (q8(bfhi(w0.w) * iq) << 24));
            o.z = (unsigned)(q8(bflo(w1.x) * iq) | (q8(bfhi(w1.x) * iq) << 8) | (q8(bflo(w1.y) * iq) << 16) | (q8(bfhi(w1.y) * iq) << 24));
            o.w = (unsigned)(q8(bflo(w1.z) * iq) | (q8(bfhi(w1.z) * iq) << 8) | (q8(bflo(w1.w) * iq) << 16) | (q8(bfhi(w1.w) * iq) << 24));
            *(GAS v4u*)(dst + (size_t)n * DM + 16 * run) = o; }
    }
    LDS_BAR();
}
__device__ __forceinline__ void ln_load_bf16(v4u (&w4)[4], const bf16* xrow, int lane) {
    const GAS v4u* xr = (const GAS v4u*)xrow + lane;
#pragma unroll
    for (int j = 0; j < 4; ++j) w4[j] = xr[64 * j];
}
__device__ __forceinline__ void ln_row_bf16_to_bf16(const v4u (&w4)[4], const float* g, const float* bta, bf16* orow, signed char* qrow, float* qscale, int lane) {
    float v[32]; float s = 0.f;
#pragma unroll
    for (int j = 0; j < 4; ++j) { const v4u w = w4[j];
        v[8 * j + 0] = bflo(w.x); v[8 * j + 1] = bfhi(w.x); v[8 * j + 2] = bflo(w.y); v[8 * j + 3] = bfhi(w.y);
        v[8 * j + 4] = bflo(w.z); v[8 * j + 5] = bfhi(w.z); v[8 * j + 6] = bflo(w.w); v[8 * j + 7] = bfhi(w.w); }
#pragma unroll
    for (int i = 0; i < 32; ++i) s += v[i];
    const float mean = wave_sum(s) * (1.f / DM); float s2 = 0.f;
#pragma unroll
    for (int i = 0; i < 32; ++i) { v[i] -= mean; s2 += v[i] * v[i]; }
    const float rstd = 1.f / sqrtf(wave_sum(s2) * (1.f / DM) + LN_EPS);
    GAS v4u* o16 = (GAS v4u*)orow + lane;
#pragma unroll
    for (int j = 0; j < 4; ++j) {
        const GAS f32x4* gp = (const GAS f32x4*)g + 2 * (lane + 64 * j); const GAS f32x4* bp = (const GAS f32x4*)bta + 2 * (lane + 64 * j);
        const f32x4 g0 = gp[0], g1 = gp[1], b0 = bp[0], b1 = bp[1];
        v4u o; o.x = pk2(v[8 * j + 0] * rstd * g0.x + b0.x, v[8 * j + 1] * rstd * g0.y + b0.y); o.y = pk2(v[8 * j + 2] * rstd * g0.z + b0.z, v[8 * j + 3] * rstd * g0.w + b0.w);
        o.z = pk2(v[8 * j + 4] * rstd * g1.x + b1.x, v[8 * j + 5] * rstd * g1.y + b1.y); o.w = pk2(v[8 * j + 6] * rstd * g1.z + b1.z, v[8 * j + 7] * rstd * g1.w + b1.w);
        o16[64 * j] = o;
        v[8 * j + 0] = v[8 * j + 0] * rstd * g0.x + b0.x; v[8 * j + 1] = v[8 * j + 1] * rstd * g0.y + b0.y; v[8 * j + 2] = v[8 * j + 2] * rstd * g0.z + b0.z; v[8 * j + 3] = v[8 * j + 3] * rstd * g0.w + b0.w;
        v[8 * j + 4] = v[8 * j + 4] * rstd * g1.x + b1.x; v[8 * j + 5] = v[8 * j + 5] * rstd * g1.y + b1.y; v[8 * j + 6] = v[8 * j + 6] * rstd * g1.z + b1.z; v[8 * j + 7] = v[8 * j + 7] * rstd * g1.w + b1.w; }
    float am = 0.f;
#pragma unroll
    for (int i = 0; i < 32; ++i) am = fmaxf(am, fabsf(v[i]));
    am = wave_max(am);
    am = fmaxf(am, 1e-20f); const float iq = 127.0f / am;
    if (lane == 0) *qscale = am * (1.0f / 127.0f);
#pragma unroll
    for (int j = 0; j < 4; ++j) { v2u w; w.x = (unsigned)(q8(v[8 * j + 0] * iq) | (q8(v[8 * j + 1] * iq) << 8) | (q8(v[8 * j + 2] * iq) << 16) | (q8(v[8 * j + 3] * iq) << 24));
        w.y = (unsigned)(q8(v[8 * j + 4] * iq) | (q8(v[8 * j + 5] * iq) << 8) | (q8(v[8 * j + 6] * iq) << 16) | (q8(v[8 * j + 7] * iq) << 24)); ((GAS v2u*)qrow)[lane + 64 * j] = w; }
}
__device__ __forceinline__ void row_pos(int r, int& pos, int& ipos) {
    if (r < NTOK) { const int s = r & (SEQ - 1); pos = NMETA + s; ipos = s & 127; }
    else { int j = r - NTOK; if (j > NMETA - 1) j = NMETA - 1; pos = j; ipos = 112 + j; }
}
__device__ __forceinline__ float log2_gamma(int h) { return log2f(1.0f - exp2f(-5.0f - (float)h)); }


typedef short bf16x8 __attribute__((ext_vector_type(8)));
typedef short s16x4 __attribute__((ext_vector_type(4)));
#define MFMA16(a, b, c) __builtin_amdgcn_mfma_f32_16x16x32_bf16((a), (b), (c), 0, 0, 0)
__device__ __forceinline__ s16x4 tr16(LAS const unsigned char* p) { return __builtin_bit_cast(s16x4, __builtin_amdgcn_ds_read_tr16_b64_v4i16((LAS s16x4*)p)); }
__device__ __forceinline__ bf16x8 cat8(s16x4 a, s16x4 b) { return __builtin_shufflevector(a, b, 0, 1, 2, 3, 4, 5, 6, 7); }
__device__ __forceinline__ unsigned cvtpk_s(float lo, float hi) { f32x2 v = {lo, hi}; bf16x2_t b = __builtin_convertvector(v, bf16x2_t); return __builtin_bit_cast(unsigned, b); }
__device__ __forceinline__ unsigned cvtpk(float lo, float hi) { unsigned r; asm("v_cvt_pk_bf16_f32 %0, %1, %2" : "=v"(r) : "v"(lo), "v"(hi)); return r; }

__device__ __forceinline__ void scan_unit(LAS unsigned char* L, int u, const bf16* RK, const bf16* RV, bf16* ST, int tid, int lane, int wave) {
    asm volatile("" : "+v"(tid)); lane = tid & 63;
    const int bh = u >> 4, di = (u >> 2) & 3, ei = u & 3, b = bh >> 2, h = bh & 3;
    const float g128 = exp2f(128.0f * log2_gamma(h));
    const int li = lane & 15, g = lane >> 4, q = li >> 2, p4 = li & 3;
    const int eb = wave >> 1, db0 = 2 * (wave & 1);
    f32x4 acc[2]; acc[0] = (f32x4){0.f, 0.f, 0.f, 0.f}; acc[1] = acc[0];
    const int sw = 2 * (((q >> 1) & 1) | ((g & 1) << 1));
    v4u kA[2], vA[2], kB[2], vB[2];
#define SCAN_LOAD(cc, kreg, vreg) do { _Pragma("unroll") for (int i_ = 0; i_ < 2; ++i_) { const int cid_ = tid + 512 * i_, row_ = cid_ >> 3, c16_ = cid_ & 7; \
        int srow_; bool ok_ = true; if ((cc) < 0) { ok_ = row_ >= 112; srow_ = NTOK + (ok_ ? row_ - 112 : 0); } else srow_ = b * SEQ + (cc) * 128 + row_; \
        const v4u kz_ = *(const GAS v4u*)(RK + (size_t)srow_ * 1024 + h * 256 + di * 64 + c16_ * 8), vz_ = *(const GAS v4u*)(RV + (size_t)srow_ * 1024 + h * 256 + ei * 64 + c16_ * 8); \
        kreg[i_] = ok_ ? kz_ : (v4u){0u, 0u, 0u, 0u}; vreg[i_] = ok_ ? vz_ : (v4u){0u, 0u, 0u, 0u}; } } while (0)
#define SCAN_WRITE(bufp, kreg, vreg) do { _Pragma("unroll") for (int i_ = 0; i_ < 2; ++i_) { const int cid_ = tid + 512 * i_, row_ = cid_ >> 3, c16_ = cid_ & 7; \
        const int sw_ = ((row_ >> 1) & 1) | ((row_ >> 2) & 2); const int off_ = row_ * 128 + ((c16_ ^ (2 * sw_)) << 4); \
        *(LAS v4u*)((bufp) + off_) = kreg[i_]; *(LAS v4u*)((bufp) + 16384 + off_) = vreg[i_]; } } while (0)
#define SCAN_FLUSH(c) do { if ((c) >= 0) { const v4u z_ = *(LAS const v4u*)(L + 65536 + ((c) & 1) * 8192 + (tid >> 3) * 128 + (tid & 7) * 16); \
        *(GAS v4u*)(ST + ((size_t)(bh * 32 + (c)) * 256 + 64 * ei + (tid >> 3)) * 256 + 64 * di + (tid & 7) * 8) = z_; } } while (0)
    SCAN_LOAD(-1, kA, vA); SCAN_WRITE(L, kA, vA); SCAN_LOAD(0, kA, vA); SCAN_LOAD(1, kB, vB); LDS_BAR();
    int cur = 0;
    for (int cc = -1; cc <= 29; cc += 2) {
        { LAS const unsigned char* Kt = L + cur * 32768; LAS const unsigned char* Vt = Kt + 16384;
#pragma unroll
          for (int ks = 0; ks < 4; ++ks) { const int r0 = (32 * ks + 8 * g + q) * 128 + 8 * (p4 & 1);
              const bf16x8 a = cat8(tr16(Vt + r0 + (((2 * eb + (p4 >> 1)) ^ sw) << 4)), tr16(Vt + r0 + 512 + (((2 * eb + (p4 >> 1)) ^ sw) << 4)));
#pragma unroll
              for (int n = 0; n < 2; ++n) { const int cn = ((2 * (db0 + n) + (p4 >> 1)) ^ sw) << 4; const bf16x8 bb = cat8(tr16(Kt + r0 + cn), tr16(Kt + r0 + 512 + cn)); acc[n] = MFMA16(a, bb, acc[n]); } }
          SCAN_FLUSH(cc);
#pragma unroll
          for (int n = 0; n < 2; ++n) { acc[n] = acc[n] * g128;
              LAS bf16* op = (LAS bf16*)(L + 65536 + ((cc + 1) & 1) * 8192) + (16 * eb + 4 * g) * 64 + 16 * (db0 + n) + li;
#pragma unroll
              for (int r = 0; r < 4; ++r) op[r * 64] = (bf16)f2bf(acc[n][r]); }
          SCAN_WRITE(L + (cur ^ 1) * 32768, kA, vA);
          if (cc + 3 <= 30) SCAN_LOAD(cc + 3, kA, vA);
          LDS_BAR(); cur ^= 1; }
        { LAS const unsigned char* Kt = L + cur * 32768; LAS const unsigned char* Vt = Kt + 16384;
#pragma unroll
          for (int ks = 0; ks < 4; ++ks) { const int r0 = (32 * ks + 8 * g + q) * 128 + 8 * (p4 & 1);
              const bf16x8 a = cat8(tr16(Vt + r0 + (((2 * eb + (p4 >> 1)) ^ sw) << 4)), tr16(Vt + r0 + 512 + (((2 * eb + (p4 >> 1)) ^ sw) << 4)));
#pragma unroll
              for (int n = 0; n < 2; ++n) { const int cn = ((2 * (db0 + n) + (p4 >> 1)) ^ sw) << 4; const bf16x8 bb = cat8(tr16(Kt + r0 + cn), tr16(Kt + r0 + 512 + cn)); acc[n] = MFMA16(a, bb, acc[n]); } }
          SCAN_FLUSH(cc + 1);
#pragma unroll
          for (int n = 0; n < 2; ++n) { acc[n] = acc[n] * g128;
              LAS bf16* op = (LAS bf16*)(L + 65536 + ((cc + 2) & 1) * 8192) + (16 * eb + 4 * g) * 64 + 16 * (db0 + n) + li;
#pragma unroll
              for (int r = 0; r < 4; ++r) op[r * 64] = (bf16)f2bf(acc[n][r]); }
          if (cc + 2 <= 30) SCAN_WRITE(L + (cur ^ 1) * 32768, kB, vB);
          if (cc + 4 <= 30) SCAN_LOAD(cc + 4, kB, vB);
          LDS_BAR(); cur ^= 1; }
    }
    SCAN_FLUSH(31);
    LDS_BAR();
#undef SCAN_LOAD
#undef SCAN_WRITE
#undef SCAN_FLUSH
}

__device__ __forceinline__ void retout_unit(LAS unsigned char* L, int u, bf16* QR, const bf16* RK, const bf16* RV, const bf16* RG, const bf16* ST, int tid, int lane, int wave) {
    asm volatile("" : "+v"(tid)); lane = tid & 63;
    const int bh = u >> 5, c = u & 31, b = bh >> 2, h = bh & 3;
    const int R0 = b * SEQ + c * 128;
    const int li = lane & 15, g = lane >> 4, q = li >> 2, p4 = li & 3;
    LAS unsigned char* RA = L; LAS unsigned char* RB = L + 65536;
#pragma unroll
    for (int i = 0; i < 8; ++i) { const int cid = tid + 512 * i, j = cid >> 5, ch = cid & 31;
        const v4u kz = *(const GAS v4u*)(RK + (size_t)(R0 + j) * 1024 + h * 256 + ch * 8), vz = *(const GAS v4u*)(RV + (size_t)(R0 + j) * 1024 + h * 256 + ch * 8);
        *(LAS v4u*)(RA + j * 512 + ((ch ^ (j & 15)) << 4)) = kz; *(LAS v4u*)(RB + j * 512 + ((ch ^ ((j & 7) << 1)) << 4)) = vz; }
    bf16x8 qf[8];
    { const GAS v4u* qp = (const GAS v4u*)(QR + (size_t)(R0 + 16 * wave + li) * 2048 + 1024 + h * 256 + 8 * g);
#pragma unroll
      for (int ks = 0; ks < 8; ++ks) qf[ks] = __builtin_bit_cast(bf16x8, qp[4 * ks]); }
#define RO_LOAD_ST(s0) do { _Pragma("unroll") for (int i_ = 0; i_ < 8; ++i_) { const int cid_ = tid + 512 * i_, sl_ = cid_ >> 11, e_ = (cid_ >> 3) & 255, ch_ = cid_ & 7; \
        stg[i_] = *(const GAS v4u*)(Sg + (size_t)e_ * 256 + 64 * ((s0) + sl_) + ch_ * 8); } } while (0)
#define RO_WRITE_ST(dst) do { _Pragma("unroll") for (int i_ = 0; i_ < 8; ++i_) { const int cid_ = tid + 512 * i_, sl_ = cid_ >> 11, e_ = (cid_ >> 3) & 255, ch_ = cid_ & 7; \
        *(LAS v4u*)((dst) + sl_ * 32768 + e_ * 128 + ((ch_ ^ (e_ & 7)) << 4)) = stg[i_]; } } while (0)
    const bf16* Sg = ST + (size_t)(bh * 32 + c) * 65536; v4u stg[8];
    __syncthreads();
    RO_LOAD_ST(0);
    f32x4 st[8];
#pragma unroll
    for (int jt = 0; jt < 8; ++jt) st[jt] = (f32x4){0.f, 0.f, 0.f, 0.f};
#pragma unroll
    for (int jt = 0; jt < 8; ++jt) if (jt <= wave) {
        const int j = 16 * jt + li;
#pragma unroll
        for (int ks = 0; ks < 8; ++ks) { const bf16x8 a = *(LAS const bf16x8*)(RA + j * 512 + (((4 * ks + g) ^ li) << 4)); st[jt] = MFMA16(a, qf[ks], st[jt]); }
        if (jt == wave) {
#pragma unroll
            for (int r = 0; r < 4; ++r) if (4 * g + r > li) st[jt][r] = 0.f; }
    }
    bf16x8 pf[4];
#pragma unroll
    for (int s = 0; s < 4; ++s) { v4u w; w.x = cvtpk_s(st[2 * s][0], st[2 * s][1]); w.y = cvtpk_s(st[2 * s][2], st[2 * s][3]); w.z = cvtpk_s(st[2 * s + 1][0], st[2 * s + 1][1]); w.w = cvtpk_s(st[2 * s + 1][2], st[2 * s + 1][3]); pf[s] = __builtin_bit_cast(bf16x8, w); }
    __syncthreads();
    RO_WRITE_ST(RA); RO_LOAD_ST(2);
    f32x4 o[16];
#pragma unroll
    for (int et = 0; et < 16; ++et) o[et] = (f32x4){0.f, 0.f, 0.f, 0.f};
#pragma unroll
    for (int s = 0; s < 4; ++s) if (2 * s <= wave) {
        const int r1 = 32 * s + 4 * g + q, r2 = r1 + 16;
#pragma unroll
        for (int et = 0; et < 16; ++et) {
            const int chn = 2 * et + (p4 >> 1);
            const bf16x8 a = cat8(tr16(RB + r1 * 512 + ((chn ^ ((r1 & 7) << 1)) << 4) + (p4 & 1) * 8), tr16(RB + r2 * 512 + ((chn ^ ((r2 & 7) << 1)) << 4) + (p4 & 1) * 8));
            o[et] = MFMA16(a, pf[s], o[et]);
        }
    }
    __syncthreads();
    RO_WRITE_ST(RB);
#define RO_STATE_MMA(src, s0) do { _Pragma("unroll") for (int sl_ = 0; sl_ < 2; ++sl_) _Pragma("unroll") for (int k2_ = 0; k2_ < 2; ++k2_) _Pragma("unroll") for (int et = 0; et < 16; ++et) { \
        const int e_ = 16 * et + li; const bf16x8 a_ = *(LAS const bf16x8*)((src) + sl_ * 32768 + e_ * 128 + (((4 * k2_ + g) ^ (e_ & 7)) << 4)); \
        o[et] = MFMA16(a_, qf[2 * ((s0) + sl_) + k2_], o[et]); } } while (0)
    RO_STATE_MMA(RA, 0);
    __syncthreads();
    RO_STATE_MMA(RB, 2);
#undef RO_LOAD_ST
#undef RO_WRITE_ST
#undef RO_STATE_MMA
    float s1 = 0.f;
#pragma unroll
    for (int et = 0; et < 16; ++et) s1 += (o[et][0] + o[et][1]) + (o[et][2] + o[et][3]);
    s1 += __shfl_xor(s1, 16); s1 += __shfl_xor(s1, 32);
    const float mu = s1 * (1.0f / 256.0f); float s2 = 0.f;
#pragma unroll
    for (int et = 0; et < 16; ++et) { o[et] = o[et] - mu; s2 += (o[et][0] * o[et][0] + o[et][1] * o[et][1]) + (o[et][2] * o[et][2] + o[et][3] * o[et][3]); }
    s2 += __shfl_xor(s2, 16); s2 += __shfl_xor(s2, 32);
    const float rstd = 1.0f / sqrtf(s2 * (1.0f / 256.0f) + GN_EPS);
    const int row = R0 + 16 * wave + li;
    const GAS v2u* gp = (const GAS v2u*)(RG + (size_t)row * 1024 + h * 256 + 4 * g); GAS v2u* op = (GAS v2u*)(QR + (size_t)row * 2048 + 1024 + h * 256 + 4 * g);
#pragma unroll
    for (int et = 0; et < 16; ++et) { const v2u gz = gp[4 * et]; v2u w;
        w.x = cvtpk(o[et][0] * rstd * bflo(gz.x), o[et][1] * rstd * bfhi(gz.x)); w.y = cvtpk(o[et][2] * rstd * bflo(gz.y), o[et][3] * rstd * bfhi(gz.y)); op[4 * et] = w; }
    __syncthreads();
}

typedef float f32x16 __attribute__((ext_vector_type(16)));
#define MFMA32(a, b, c) __builtin_amdgcn_mfma_f32_32x32x16_bf16((a), (b), (c), 0, 0, 0)
__device__ __forceinline__ int crow32(int reg, int hh) { return (reg & 3) + 8 * (reg >> 2) + 4 * hh; }

__device__ __forceinline__ void attn_unit(LAS unsigned char* L, int u, bf16* QR, const bf16* KA, const bf16* VA, const float* sinks, int tid, int lane, int wave) {
    asm volatile("" : "+v"(tid)); lane = tid & 63;
    const int b = u >> 6, j = (u >> 1) & 31, g2 = u & 1, hq = 8 * g2 + wave;
    const int R0 = b * SEQ + 128 * j;
    LAS unsigned char* Kt = L; LAS unsigned char* Vt = L + 32768;
#pragma unroll
    for (int i = 0; i < 4; ++i) { const int cid = tid + 512 * i, kk = cid >> 3, ch = cid & 7;
        int srow; bool ok = true;
        if (kk >= 128) srow = R0 + kk - 128; else if (j > 0) srow = R0 - 128 + kk; else { ok = kk >= 112; srow = NTOK + (ok ? kk - 112 : 0); }
        const v4u kz = *(const GAS v4u*)(KA + (size_t)srow * 128 + g2 * 64 + ch * 8), vz = *(const GAS v4u*)(VA + (size_t)srow * 128 + g2 * 64 + ch * 8);
        *(LAS v4u*)(Kt + kk * 128 + ((ch ^ (kk & 7)) << 4)) = ok ? kz : (v4u){0u, 0u, 0u, 0u};
        *(LAS v4u*)(Vt + kk * 128 + (ch << 4)) = ok ? vz : (v4u){0u, 0u, 0u, 0u}; }
    __syncthreads();
    const int r = lane & 31, hh = lane >> 5, blk = (lane >> 4) & 1, q = (lane & 15) >> 2, p4 = lane & 3;
    const float sk = sinks[hq] * LOG2E;
    v4u qn[4];
    { const GAS v4u* qp = (const GAS v4u*)(QR + (size_t)(R0 + r) * 2048 + hq * 64 + 8 * hh);
#pragma unroll
      for (int ks = 0; ks < 4; ++ks) qn[ks] = qp[2 * ks]; }
#pragma unroll 1
    for (int t = 0; t < 4; ++t) {
        const int i0 = 32 * t;
        bf16x8 qf[4];
#pragma unroll
        for (int ks = 0; ks < 4; ++ks) qf[ks] = __builtin_bit_cast(bf16x8, qn[ks]);
        if (t < 3) { const GAS v4u* qp = (const GAS v4u*)(QR + (size_t)(R0 + i0 + 32 + r) * 2048 + hq * 64 + 8 * hh);
#pragma unroll
          for (int ks = 0; ks < 4; ++ks) qn[ks] = qp[2 * ks]; }
        f32x16 s[5];
#pragma unroll
        for (int x = 0; x < 5; ++x) {
            const int krow_ = 32 * (t + x) + r;
            f32x16 acc;
#pragma unroll
            for (int e = 0; e < 16; ++e) acc[e] = 0.f;
#pragma unroll
            for (int ks = 0; ks < 4; ++ks) { const bf16x8 a = *(LAS const bf16x8*)(Kt + krow_ * 128 + (((2 * ks + hh) ^ (krow_ & 7)) << 4)); acc = MFMA32(a, qf[ks], acc); }
            s[x] = acc; __builtin_amdgcn_sched_barrier(0);
        }
        float m = sk;
#pragma unroll
        for (int e = 0; e < 16; ++e) { const int cr = crow32(e, hh);
            if (!(cr > r)) s[0][e] = -1.0e30f;
            if (!(cr <= r)) s[4][e] = -1.0e30f; }
        if (j == 0) {
#pragma unroll
            for (int x = 0; x < 4; ++x) if (t + x <= 3) {
#pragma unroll
                for (int e = 0; e < 16; ++e) if (32 * (t + x) + crow32(e, hh) < 112) s[x][e] = -1.0e30f; }
        }
#pragma unroll
        for (int x = 0; x < 5; ++x)
#pragma unroll
            for (int e = 0; e < 16; ++e) m = fmaxf(m, s[x][e]);
        m = fmaxf(m, __shfl_xor(m, 32));
        float l = 0.f;
#pragma unroll
        for (int x = 0; x < 5; ++x)
#pragma unroll
            for (int e = 0; e < 16; ++e) { const float pv = exp2f(s[x][e] - m); s[x][e] = pv; l += pv; }
        l += __shfl_xor(l, 32);
        l += exp2f(sk - m);
        f32x16 o[2];
#pragma unroll
        for (int e = 0; e < 16; ++e) { o[0][e] = 0.f; o[1][e] = 0.f; }
#pragma unroll
        for (int x = 0; x < 5; ++x)
#pragma unroll
            for (int st = 0; st < 2; ++st) {
                v4u w; w.x = cvtpk_s(s[x][8 * st + 0], s[x][8 * st + 1]); w.y = cvtpk_s(s[x][8 * st + 2], s[x][8 * st + 3]); w.z = cvtpk_s(s[x][8 * st + 4], s[x][8 * st + 5]); w.w = cvtpk_s(s[x][8 * st + 6], s[x][8 * st + 7]);
                const bf16x8 pb = __builtin_bit_cast(bf16x8, w);
                const int k1 = 32 * (t + x) + 16 * st + 4 * hh + q, k2 = k1 + 8;
#pragma unroll
                for (int dc = 0; dc < 2; ++dc) {
                    const int cb = ((4 * dc + 2 * blk + (p4 >> 1)) << 4) + 8 * (p4 & 1);
                    const bf16x8 a = cat8(tr16(Vt + k1 * 128 + cb), tr16(Vt + k2 * 128 + cb));
                    o[dc] = MFMA32(a, pb, o[dc]);
                }
                __builtin_amdgcn_sched_barrier(0);
            }
        const float il = 1.0f / l;
        GAS v2u* op = (GAS v2u*)(QR + (size_t)(R0 + i0 + r) * 2048 + hq * 64 + 4 * hh);
#pragma unroll
        for (int dc = 0; dc < 2; ++dc)
#pragma unroll
            for (int g4 = 0; g4 < 4; ++g4) { v2u w; w.x = cvtpk_s(o[dc][4 * g4 + 0] * il, o[dc][4 * g4 + 1] * il); w.y = cvtpk_s(o[dc][4 * g4 + 2] * il, o[dc][4 * g4 + 3] * il); op[8 * dc + 2 * g4] = w; }
    }
    __syncthreads();
}

__device__ __forceinline__ unsigned ord_key(float f) { const unsigned u = __float_as_uint(f); return u ^ ((unsigned)((int)u >> 31) | 0x80000000u); }
__device__ __forceinline__ float ord_val(unsigned k) { return __uint_as_float(k ^ (((int)k < 0) ? 0x80000000u : 0xffffffffu)); }
__device__ __forceinline__ unsigned umed3(unsigned a, unsigned b, unsigned c) { unsigned r; asm("v_med3_u32 %0, %1, %2, %3" : "=v"(r) : "v"(a), "v"(b), "v"(c)); return r; }
#define TK_INS(arr, val) do { const unsigned v_ = (val); _Pragma("unroll") for (int j_ = 15; j_ >= 1; --j_) arr[j_] = umed3(arr[j_ - 1], arr[j_], v_); arr[0] = arr[0] > v_ ? arr[0] : v_; } while (0)
__device__ __forceinline__ void topk_unit(LAS unsigned* Lw, LAS const unsigned char* Lsk, int tt, int hd, const bf16* Q3, unsigned short* IDS, float* GATES, int lane) {
    asm volatile("" : "+v"(lane));
    const int r = lane & 31, hh = lane >> 5, t0 = tt * 32;
    float sv[2][16];
#pragma unroll
    for (int p = 0; p < 2; ++p) {
        f32x16 acc[4];
#pragma unroll
        for (int nt = 0; nt < 4; ++nt)
#pragma unroll
            for (int e = 0; e < 16; ++e) acc[nt][e] = 0.f;
        const GAS v4u* qp = (const GAS v4u*)(Q3 + (size_t)(t0 + r) * DM + hd * 256 + p * 128 + 8 * hh);
        bf16x8 bq[8];
#pragma unroll
        for (int ks = 0; ks < 8; ++ks) bq[ks] = __builtin_bit_cast(bf16x8, qp[2 * ks]);
#pragma unroll
        for (int ks = 0; ks < 8; ++ks) {
#pragma unroll
            for (int nt = 0; nt < 4; ++nt) { const bf16x8 a = *(LAS const bf16x8*)(Lsk + p * 32768 + (32 * nt + r) * 256 + (((2 * ks + hh) ^ (r & 15)) << 4)); acc[nt] = MFMA32(a, bq[ks], acc[nt]); } }
        unsigned tk[16];
#pragma unroll
        for (int j2 = 0; j2 < 16; ++j2) tk[j2] = 0u;
#pragma unroll
        for (int nt = 0; nt < 4; ++nt)
#pragma unroll
            for (int e = 0; e < 16; ++e) { const int n = 32 * nt + crow32(e, hh); TK_INS(tk, (ord_key(acc[nt][e]) & 0xffffff80u) | (unsigned)(127 - n)); }
        unsigned pk[16];
#pragma unroll
        for (int j2 = 0; j2 < 16; ++j2) pk[j2] = (unsigned)__shfl_xor((int)tk[j2], 32);
#pragma unroll
        for (int j2 = 0; j2 < 16; ++j2) TK_INS(tk, pk[j2]);
#pragma unroll
        for (int j2 = 0; j2 < 16; ++j2) { sv[p][j2] = ord_val(tk[j2] & 0xffffff80u); Lw[(p * 16 + j2) * 64 + lane] = 127u - (tk[j2] & 0x7fu); }
    }
    unsigned fk[16];
#pragma unroll
    for (int j2 = 0; j2 < 16; ++j2) fk[j2] = 0u;
#pragma unroll
    for (int i = 0; i < 16; ++i)
#pragma unroll
        for (int j2 = 0; j2 < 16; ++j2) if ((i + 1) * (j2 + 1) <= 16) TK_INS(fk, (ord_key(sv[0][i] + sv[1][j2]) & 0xffffff00u) | (unsigned)(255 - (16 * i + j2)));
    float ev[16]; int idv[16]; float den = 0.f; const float f0 = ord_val(fk[0] & 0xffffff00u);
    LDS_WAIT();
#pragma unroll
    for (int k = 0; k < 16; ++k) { const unsigned idx = 255u - (fk[k] & 0xffu); const unsigned i1 = Lw[(idx >> 4) * 64 + lane], i2 = Lw[(16 + (idx & 15u)) * 64 + lane];
        idv[k] = (int)(i1 * 128u + i2); ev[k] = __expf(ord_val(fk[k] & 0xffffff00u) - f0); den += ev[k]; }
    const float iden = 1.0f / den;
    if (hh == 0) {
        GAS v4u* ip = (GAS v4u*)(IDS + (size_t)(t0 + r) * 128 + hd * 16); GAS f32x4* gp = (GAS f32x4*)(GATES + (size_t)(t0 + r) * 128 + hd * 16);
#pragma unroll
        for (int k8 = 0; k8 < 2; ++k8) ip[k8] = (v4u){(unsigned)idv[8 * k8] | ((unsigned)idv[8 * k8 + 1] << 16), (unsigned)idv[8 * k8 + 2] | ((unsigned)idv[8 * k8 + 3] << 16), (unsigned)idv[8 * k8 + 4] | ((unsigned)idv[8 * k8 + 5] << 16), (unsigned)idv[8 * k8 + 6] | ((unsigned)idv[8 * k8 + 7] << 16)};
#pragma unroll
        for (int k4 = 0; k4 < 4; ++k4) gp[k4] = (f32x4){ev[4 * k4] * iden, ev[4 * k4 + 1] * iden, ev[4 * k4 + 2] * iden, ev[4 * k4 + 3] * iden};
    }
    LDS_WAIT();
}

constexpr int TAB_NQ = 16384 * DM / 4, TAB_CHQ = 4096, TAB_NCH = 2 * TAB_NQ / TAB_CHQ, TAB_SLOT_CHUNKS = 3;
template <int UNR> __device__ __forceinline__ void tab_chunk(int ch, const float* u_tab, const float* v_tab, void* UT, void* VT, int lane) {
    const int which = ch >= TAB_NCH / 2; const float sc = which ? V_QSCALE : U_QSCALE;
    const GAS f32x4* src = (const GAS f32x4*)(which ? v_tab : u_tab) + (size_t)(ch - which * (TAB_NCH / 2)) * TAB_CHQ + lane;
    GAS unsigned char* dstb = (GAS unsigned char*)(which ? VT : UT);
    const int i4b = (ch - which * (TAB_NCH / 2)) * TAB_CHQ + lane;
#pragma unroll 1
    for (int it = 0; it < TAB_CHQ / 64; it += UNR) {
        f32x4 a[UNR];
#pragma unroll
        for (int u8 = 0; u8 < UNR; ++u8) a[u8] = src[(it + u8) * 64];
#pragma unroll
        for (int u8 = 0; u8 < UNR; ++u8) { const int i4 = i4b + (it + u8) * 64; const int row = i4 >> 9, q4 = i4 & 511;
            const int w = q8(a[u8].x * sc) | (q8(a[u8].y * sc) << 8) | (q8(a[u8].z * sc) << 16) | (q8(a[u8].w * sc) << 24);
            *(GAS unsigned*)(dstb + ((size_t)(q4 >> 5) * 16384 + row) * 128 + (q4 & 31) * 4) = (unsigned)w; }
    }
}
struct TabHook {
    gu32* q; const float* u_tab; const float* v_tab; void* UT; void* VT; int slot;
    __device__ __forceinline__ void operator()(int ui) const {
        if (ui != slot) return;
        int lane = threadIdx.x; asm volatile("" : "+v"(lane)); lane &= 63;
#pragma unroll 1
        for (int n = 0; n < TAB_SLOT_CHUNKS; ++n) {
            int ch = 0; if (lane == 0) ch = (int)__hip_atomic_fetch_add((unsigned*)q, 1u, __ATOMIC_RELAXED, __HIP_MEMORY_SCOPE_AGENT);
            ch = __builtin_amdgcn_readfirstlane(ch); if (ch >= TAB_NCH) return;
            tab_chunk<16>(ch, u_tab, v_tab, UT, VT, lane);
        }
    }
};

__global__ void __launch_bounds__(NWAVES * 64, 2) mk_fwd(Args args) {
    extern __shared__ __attribute__((aligned(16))) unsigned char lds[];
    LAS unsigned char* L = (LAS unsigned char*)lds;
    volatile LAS unsigned* MISC = (volatile LAS unsigned*)(L + MISC_OFF);
    const int tid = threadIdx.x, lane = tid & 63, wave = __builtin_amdgcn_readfirstlane(tid >> 6);
    const int G = gridDim.x, bx = blockIdx.x;
    const int vcu = (G % 8 == 0) ? (bx % 8) * (G / 8) + bx / 8 : bx;
    unsigned char* ws = args.ws;
    gu32* ctl = (gu32*)(ws + WS_CTL);
    const float* x = args.in[0]; const float* meta = args.in[1]; const float* ln_in_g = args.in[2]; const float* ln_in_b = args.in[3];
    const float* w_in = args.in[4]; const float* sinks = args.in[5]; const float* w_out = args.in[6]; const float* ln_mix_g = args.in[7]; const float* ln_mix_b = args.in[8];
    const float* wq = args.in[9]; const float* subkeys = args.in[10]; const float* u_tab = args.in[11]; const float* v_tab = args.in[12];
    const float* ln_ffn_g = args.in[13]; const float* ln_ffn_b = args.in[14];
    float* out = args.out;
    bf16* W1T = (bf16*)(ws + WS_W1T); bf16* W2T = (bf16*)(ws + WS_W2T); bf16* W3T = (bf16*)(ws + WS_W3T);
    bf16* H0 = (bf16*)(ws + WS_H0); bf16* QR = (bf16*)(ws + WS_QR); bf16* KA = (bf16*)(ws + WS_KA); bf16* VA = (bf16*)(ws + WS_VA);
    bf16* RK = (bf16*)(ws + WS_RK); bf16* RV = (bf16*)(ws + WS_RV); bf16* RG = (bf16*)(ws + WS_RG);
    bf16* Y = (bf16*)(ws + WS_Y); bf16* H1 = (bf16*)(ws + WS_H1); bf16* Q3 = (bf16*)(ws + WS_QR);
    bf16* STB = (bf16*)(ws + WS_ST);
    unsigned short* IDS = (unsigned short*)(ws + WS_IDS); float* GATES = (float*)(ws + WS_GATES);
    bf16* SKB = (bf16*)(ws + WS_SK);
    signed char* H1Q = (signed char*)(ws + WS_RG); float* HSC = (float*)(ws + WS_HSC);
    bf16* UT = (bf16*)(ws + WS_UT); bf16* VT = (bf16*)(ws + WS_VT);
    signed char* H0Q = (signed char*)(ws + WS_H0Q); signed char* W1Q = (signed char*)(ws + WS_W1Q); signed char* W3Q = (signed char*)(ws + WS_W3Q);
    float* H0S = (float*)(ws + WS_H0S); float* WS1 = (float*)(ws + WS_WS1); float* WS3 = (float*)(ws + WS_WS3);

    for (int u = tid; u < (LDS_BYTES - LDSCTL_OFF) / 4; u += NWAVES * 64) ((LAS unsigned*)(L + LDSCTL_OFF))[u] = 0u;
    __syncthreads();
    XcdBarrier bar; bar.bar = (unsigned*)(ctl + CW_BAR); bar.x = xb_xcc_id(); bar.st = MISC + 8;
    if (tid == 0) MISC[10] = xb_add(&bar.bar[XB_XCNT(bar.x)], 1u);
#define GRID_BAR() xcd_barrier(bar)
    const int gw = vcu * NWAVES + wave, NGW = G * NWAVES;
    const int gt = gw * 64 + lane, NGT = NGW * 64;

    {
        int lane = threadIdx.x; asm volatile("" : "+v"(lane)); lane &= 63; const int gt = gw * 64 + lane;
        LAS float* scr = (LAS float*)(L + RING_OFF + wave * 16384);
        constexpr int I_2 = (DM / 64) * (DM / 32);
        for (int sx = bx; sx < IN_COLS / 32 + DM / 32; sx += G) {
            if (sx < IN_COLS / 32) w_strip(L + RING_OFF, (LAS float*)(L + LDSCTL_OFF + 4096), w_in, IN_COLS, w1_logical_col(32 * sx), W1Q + (size_t)32 * sx * DM, WS1 + 32 * sx, tid);
            else { const int s3 = sx - IN_COLS / 32; w_strip(L + RING_OFF, (LAS float*)(L + LDSCTL_OFF + 4096), wq, DM, 32 * s3, W3Q + (size_t)32 * s3 * DM, WS3 + 32 * s3, tid); }
        }
#pragma unroll 1
        for (int pass = 0; pass < 2; ++pass) {
          if ((pass ^ (wave & 1)) == 0) {
        for (int it = gw; it < I_2; it += NGW) p0_transpose_item<false>(w_out, DM, DM, W2T, scr, it, lane);
          } else {
        {
            f32x4 va[8], vn[8];
            int m = gw; if (m < NVALID) ln_load_f32(va, m < NTOK ? x + (size_t)m * DM : meta + (size_t)(m - NTOK) * DM, lane);
            for (; m < MROWS; m += NGW) {
                const int mn = m + NGW; if (mn < NVALID) ln_load_f32(vn, mn < NTOK ? x + (size_t)mn * DM : meta + (size_t)(mn - NTOK) * DM, lane);
                if (m < NVALID) ln_row_f32_to_bf16_q(va, ln_in_g, ln_in_b, H0 + (size_t)m * DM, H0Q + (size_t)m * DM, H0S + m, lane);
                else { GAS v4u* o = (GAS v4u*)(H0 + (size_t)m * DM) + lane; GAS v4u* oq = (GAS v4u*)(H0Q + (size_t)m * DM) + lane;
#pragma unroll
                    for (int j = 0; j < 4; ++j) o[64 * j] = (v4u){0u, 0u, 0u, 0u};
                    oq[0] = (v4u){0u, 0u, 0u, 0u}; oq[64] = (v4u){0u, 0u, 0u, 0u}; if (lane == 0) H0S[m] = 0.f; }
#pragma unroll
                for (int j = 0; j < 8; ++j) va[j] = vn[j];
            }
        }
          }
        }
        for (int e = gt; e < 16 * 128 * 128 / 8; e += NGT) { const GAS f32x4* src = (const GAS f32x4*)subkeys + 2 * (size_t)e; const f32x4 a = src[0], b2 = src[1];
            v4u o; o.x = pk2(a.x, a.y); o.y = pk2(a.z, a.w); o.z = pk2(b2.x, b2.y); o.w = pk2(b2.z, b2.w); ((GAS v4u*)SKB)[e] = o; }
    }
    GRID_BAR();

    {
        pg8::Gemm g{(const bf16*)H0Q, (const bf16*)W1Q, MROWS, IN_COLS, DM / 2, H0S, WS1}; pg8::StaticOrder S; S.init(MROWS, IN_COLS, G, bx, 5);
        pg8::EpiProj E{QR, KA, VA, RK, RV, RG, QSCALE};
        const int nwg1 = (MROWS / 256) * (IN_COLS / 256), T1 = (nwg1 + G - 1) / G, c0 = nwg1 - (T1 - 1) * G;
        TabHook Hk{ctl + CW_TABQ, u_tab, v_tab, (void*)UT, (void*)VT, (bx >= c0 && T1 > 2) ? (bx - c0) % (T1 - 2) : -1};
        pg8::gemm_phase<pg8::EpiProj, pg8::StaticOrder, true, true, TabHook, true>(L + RING_OFF, g, S, E, Hk);
    }
    {
        for (;;) {
            int ch = 0; if (lane == 0) ch = (int)__hip_atomic_fetch_add((unsigned*)(ctl + CW_TABQ), 1u, __ATOMIC_RELAXED, __HIP_MEMORY_SCOPE_AGENT);
            ch = __builtin_amdgcn_readfirstlane(ch); if (ch >= TAB_NCH) break;
            tab_chunk<8>(ch, u_tab, v_tab, (void*)UT, (void*)VT, lane);
        }
    }
    GRID_BAR();

    for (int u = bx; u < 256; u += G) attn_unit(L + RING_OFF, u, QR, KA, VA, sinks, tid, lane, wave);

    for (int u = bx; u < 256; u += G) scan_unit(L + RING_OFF, u, RK, RV, STB, tid, lane, wave);
    GRID_BAR();

    for (int u = bx; u < 512; u += G) retout_unit(L + RING_OFF, u, QR, RK, RV, RG, STB, tid, lane, wave);
    GRID_BAR();

    {
        pg8::Gemm g{QR, W2T, NTOK, DM, DM}; pg8::StaticOrder S; S.init(NTOK, DM, G, bx);
        pg8::EpiGen<1> E{Y, DM, H0, ALPHA, nullptr, nullptr, nullptr, nullptr, nullptr, nullptr};
        pg8::gemm_phase<pg8::EpiGen<1>, pg8::StaticOrder, true, true>(L + RING_OFF, g, S, E);
    }
    GRID_BAR();

    { int l5 = threadIdx.x; asm volatile("" : "+v"(l5)); l5 &= 63;
      v4u wa[4], wn[4]; int m = gw; if (m < NTOK) ln_load_bf16(wa, Y + (size_t)m * DM, l5);
      for (; m < NTOK; m += NGW) { const int mn = m + NGW; if (mn < NTOK) ln_load_bf16(wn, Y + (size_t)mn * DM, l5);
          ln_row_bf16_to_bf16(wa, ln_mix_g, ln_mix_b, H1 + (size_t)m * DM, H1Q + (size_t)m * DM, HSC + m, l5);
#pragma unroll
          for (int j = 0; j < 4; ++j) wa[j] = wn[j]; } }
    GRID_BAR();

    {
        pg8::Gemm g{(const bf16*)H1Q, (const bf16*)W3Q, NTOK, DM, DM / 2, HSC, WS3}; pg8::StaticOrder S; S.init(NTOK, DM, G, bx);
        pg8::EpiGen<2> E{Q3, DM, nullptr, 0.f, nullptr, nullptr, nullptr, nullptr, nullptr, nullptr};
        pg8::gemm_phase<pg8::EpiGen<2>, pg8::StaticOrder, true, true, pg8::NoHook, true>(L + RING_OFF, g, S, E);
    }
    GRID_BAR();

    const bool g8 = (G & 7) == 0; const int nbh = g8 ? (G >> 3) : G, hb = g8 ? (bx >> 3) : bx;
    for (int hd = g8 ? (bx & 7) : 0; hd < 8; hd += g8 ? 8 : 1) {
        __syncthreads();
#pragma unroll
        for (int i = 0; i < 8; ++i) { const int cid = tid + 512 * i, p = cid >> 11, n = (cid >> 4) & 127, ch = cid & 15;
            *(LAS v4u*)(L + RING_OFF + p * 32768 + n * 256 + ((ch ^ (n & 15)) << 4)) = *(const GAS v4u*)(SKB + ((size_t)((hd * 2 + p) * 128 + n)) * 128 + ch * 8); }
        __syncthreads();
        for (int tt = hb * NWAVES + wave; tt < NTOK / 32; tt += nbh * NWAVES) topk_unit((LAS unsigned*)(L + RING_OFF + 65536 + wave * 8192), L + RING_OFF, tt, hd, Q3, IDS, GATES, lane);
    }
    __syncthreads();
    GRID_BAR();

    int nx = 0, xr = 0, nloc = 1;
    { unsigned* bw = (unsigned*)(ctl + CW_BAR);
#pragma unroll
      for (unsigned j2 = 0; j2 < 16; ++j2) { const unsigned cnt = xb_ld(&bw[XB_XCNT(j2)]); nx += cnt > 0u; xr += (j2 < bar.x && cnt > 0u); if (j2 == bar.x) nloc = (int)cnt; }
      nx = __builtin_amdgcn_readfirstlane(nx); xr = __builtin_amdgcn_readfirstlane(xr); nloc = __builtin_amdgcn_readfirstlane(nloc); if (nx < 1) nx = 1; if (nloc < 1) nloc = 1; }
    const int lrank = __builtin_amdgcn_readfirstlane((int)MISC[10]);
    const int wv = lrank * NWAVES + wave, nwv = nloc * NWAVES;
    float* DOTX = (float*)(ws + WS_RK);
    signed char* CB8 = (signed char*)(ws + WS_KA); float* CSC = (float*)(ws + WS_CSC);
    bf16* YB = (bf16*)(ws + WS_H0);
    {
        int tl = tid; asm volatile("" : "+v"(tl)); const int ln = tl & 63, k = ln >> 3, c8 = ln & 7;
        const unsigned char* UT8 = (const unsigned char*)UT;
        for (int s = xr; s < NSL; s += nx) {
            const unsigned char* Us = UT8 + (size_t)s * 16384 * 128;
            const bool first = (s == xr);
            v4u nid[2][2];
#pragma unroll
            for (int z = 0; z < 2; ++z) { const int tz = wv + z * nwv; const int tc = tz < NTOK ? tz : wv; const GAS v4u* ip = (const GAS v4u*)(IDS + (size_t)tc * 128 + 16 * k);
#pragma unroll
                for (int i = 0; i < 2; ++i) nid[z][i] = ip[i]; }
#pragma unroll 1
            for (int t = wv; t < NTOK; t += 2 * nwv) {
                const bool vB = (t + nwv) < NTOK; const int tt[2] = {t, vB ? t + nwv : t};
                v4u ub[2][16]; v4u hs[2]; int old[2][2];
#pragma unroll
                for (int z = 0; z < 2; ++z) {
#pragma unroll
                    for (int i = 0; i < 16; ++i) { const int pe = 2 * (i & 7) + (i >> 3); const unsigned eid = (nid[z][pe >> 3][(pe >> 1) & 3] >> (16 * (pe & 1))) & 0xffffu; ub[z][i] = *(const GAS v4u*)(Us + (size_t)eid * 128 + 16 * c8); }
                    hs[z] = *(const GAS v4u*)(H1Q + (size_t)tt[z] * DM + 128 * s + 16 * c8); }
#pragma unroll
                for (int z = 0; z < 2; ++z) { const v2u ov = first ? (v2u){0u, 0u} : *(const GAS v2u*)(DOTX + ((size_t)xr * NTOK + tt[z]) * 128 + 2 * ln); old[z][0] = (int)ov.x; old[z][1] = (int)ov.y; }
#pragma unroll
                for (int z = 0; z < 2; ++z) { const int tz = t + (2 + z) * nwv; const int tc = tz < NTOK ? tz : t; const GAS v4u* ip = (const GAS v4u*)(IDS + (size_t)tc * 128 + 16 * k);
#pragma unroll
                    for (int i = 0; i < 2; ++i) nid[z][i] = ip[i]; }
#pragma unroll
                for (int z = 0; z < 2; ++z) {
                    int p[16];
#pragma unroll
                    for (int i = 0; i < 16; ++i) { int d = 0;
                        d = __builtin_amdgcn_sdot4((int)ub[z][i].x, (int)hs[z].x, d, false); d = __builtin_amdgcn_sdot4((int)ub[z][i].y, (int)hs[z].y, d, false);
                        d = __builtin_amdgcn_sdot4((int)ub[z][i].z, (int)hs[z].z, d, false); d = __builtin_amdgcn_sdot4((int)ub[z][i].w, (int)hs[z].w, d, false); p[i] = d; }
                    const bool b0 = (c8 & 1) != 0, b1 = (c8 & 2) != 0, b2 = (c8 & 4) != 0;
                    int r1[8], r2[4], q0, q1;
#define DPPI(v, ctrl) __builtin_amdgcn_update_dpp(0, (v), (ctrl), 0xf, 0xf, true)
#pragma unroll
                    for (int m = 0; m < 8; ++m) { const int keep = b0 ? p[2 * m + 1] : p[2 * m], give = b0 ? p[2 * m] : p[2 * m + 1]; r1[m] = keep + DPPI(give, 0xB1); }
#pragma unroll
                    for (int m = 0; m < 4; ++m) { const int keep = b1 ? r1[2 * m + 1] : r1[2 * m], give = b1 ? r1[2 * m] : r1[2 * m + 1]; r2[m] = keep + DPPI(give, 0x4E); }
                    { const int keep = b2 ? r2[1] : r2[0], give = b2 ? r2[0] : r2[1]; const int gl = DPPI(give, 0x104), gr = DPPI(give, 0x114); q0 = keep + (b2 ? gr : gl); }
                    { const int keep = b2 ? r2[3] : r2[2], give = b2 ? r2[2] : r2[3]; const int gl = DPPI(give, 0x104), gr = DPPI(give, 0x114); q1 = keep + (b2 ? gr : gl); }
#undef DPPI
                    if (z == 0 || vB) *(GAS v2u*)(DOTX + ((size_t)xr * NTOK + tt[z]) * 128 + 2 * ln) = (v2u){(unsigned)(q0 + old[z][0]), (unsigned)(q1 + old[z][1])};
                }
            }
        }
    }
    GRID_BAR();
    for (int i8 = gt; i8 < NTOK * 16; i8 += NGT) {
        const size_t gi = (size_t)i8 * 8; v4u a0 = {0u, 0u, 0u, 0u}, a1 = a0;
        for (int xx = 0; xx < nx; ++xx) { const GAS v4u* dp = (const GAS v4u*)((const int*)DOTX + (size_t)xx * NTOK * 128 + gi); const v4u p0 = dp[0], p1 = dp[1]; a0 += p0; a1 += p1; }
        const GAS f32x4* gp = (const GAS f32x4*)(GATES + gi); const f32x4 g0 = gp[0], g1 = gp[1];
        const float sc = HSC[i8 >> 4] * (1.0f / U_QSCALE);
        float c[8];
        c[0] = g0.x * gelu_erf((float)(int)a0.x * sc); c[1] = g0.y * gelu_erf((float)(int)a0.y * sc); c[2] = g0.z * gelu_erf((float)(int)a0.z * sc); c[3] = g0.w * gelu_erf((float)(int)a0.w * sc);
        c[4] = g1.x * gelu_erf((float)(int)a1.x * sc); c[5] = g1.y * gelu_erf((float)(int)a1.y * sc); c[6] = g1.z * gelu_erf((float)(int)a1.z * sc); c[7] = g1.w * gelu_erf((float)(int)a1.w * sc);
        float am = 0.f;
#pragma unroll
        for (int j2 = 0; j2 < 8; ++j2) am = fmaxf(am, fabsf(c[j2]));
        am = fmaxf(am, DPPF(am, 0xB1)); am = fmaxf(am, DPPF(am, 0x4E)); am = fmaxf(am, DPPF(am, 0x141)); am = fmaxf(am, DPPF(am, 0x128));
        am = fmaxf(am, 1e-30f); const float iq = 127.0f / am;
        v2u o; o.x = (unsigned)(q8(c[0] * iq) | (q8(c[1] * iq) << 8) | (q8(c[2] * iq) << 16) | (q8(c[3] * iq) << 24)); o.y = (unsigned)(q8(c[4] * iq) | (q8(c[5] * iq) << 8) | (q8(c[6] * iq) << 16) | (q8(c[7] * iq) << 24));
        *(GAS v2u*)(CB8 + gi) = o;
        if ((i8 & 15) == 0) CSC[i8 >> 4] = am * (1.0f / (127.0f * V_QSCALE));
    }
    GRID_BAR();
    {
        int tl = tid; asm volatile("" : "+v"(tl)); const int ln = tl & 63, k = ln >> 3, c8 = ln & 7;
        const unsigned char* VT8 = (const unsigned char*)VT;
        for (int s = xr; s < NSL; s += nx) {
            const unsigned char* Vs = VT8 + (size_t)s * 16384 * 128;
            v4u nid[2][2];
#pragma unroll
            for (int z = 0; z < 2; ++z) { const int tz = wv + z * nwv; const int tc = tz < NTOK ? tz : wv; const GAS v4u* ip = (const GAS v4u*)(IDS + (size_t)tc * 128 + 16 * k);
#pragma unroll
                for (int i = 0; i < 2; ++i) nid[z][i] = ip[i]; }
#pragma unroll 1
            for (int t = wv; t < NTOK; t += 2 * nwv) {
                const bool vB = (t + nwv) < NTOK; const int tt[2] = {t, vB ? t + nwv : t};
                v4u vb[2][16]; v4u cf[2]; unsigned hs[2]; float scl[2];
#pragma unroll
                for (int z = 0; z < 2; ++z) {
#pragma unroll
                    for (int i = 0; i < 16; ++i) { const unsigned eid = (nid[z][i >> 3][(i >> 1) & 3] >> (16 * (i & 1))) & 0xffffu; vb[z][i] = *(const GAS v4u*)(Vs + (size_t)eid * 128 + 16 * c8); } }
#pragma unroll
                for (int z = 0; z < 2; ++z) { hs[z] = *(const GAS unsigned*)(H1 + (size_t)tt[z] * DM + 128 * s + 16 * c8 + 2 * k);
                    cf[z] = *(const GAS v4u*)(CB8 + (size_t)tt[z] * 128 + 16 * k); scl[z] = CSC[tt[z]]; }
#pragma unroll
                for (int z = 0; z < 2; ++z) { const int tz = t + (2 + z) * nwv; const int tc = tz < NTOK ? tz : t; const GAS v4u* ip = (const GAS v4u*)(IDS + (size_t)tc * 128 + 16 * k);
#pragma unroll
                    for (int i = 0; i < 2; ++i) nid[z][i] = ip[i]; }
#pragma unroll
                for (int z = 0; z < 2; ++z) {
                    int ai[16];
#pragma unroll
                    for (int q2 = 0; q2 < 16; ++q2) ai[q2] = 0;
#pragma unroll
                    for (int ig = 0; ig < 4; ++ig) { const int cq = (int)cf[z][ig];
#pragma unroll
                        for (int dw = 0; dw < 4; ++dw) {
                            const unsigned d0 = vb[z][4 * ig][dw], d1 = vb[z][4 * ig + 1][dw], d2 = vb[z][4 * ig + 2][dw], d3 = vb[z][4 * ig + 3][dw];
                            const unsigned p0 = __builtin_amdgcn_perm(d1, d0, 0x05010400u), p1 = __builtin_amdgcn_perm(d1, d0, 0x07030602u), p2 = __builtin_amdgcn_perm(d3, d2, 0x05010400u), p3 = __builtin_amdgcn_perm(d3, d2, 0x07030602u);
                            ai[4 * dw + 0] = __builtin_amdgcn_sdot4((int)__builtin_amdgcn_perm(p2, p0, 0x05040100u), cq, ai[4 * dw + 0], false);
                            ai[4 * dw + 1] = __builtin_amdgcn_sdot4((int)__builtin_amdgcn_perm(p2, p0, 0x07060302u), cq, ai[4 * dw + 1], false);
                            ai[4 * dw + 2] = __builtin_amdgcn_sdot4((int)__builtin_amdgcn_perm(p3, p1, 0x05040100u), cq, ai[4 * dw + 2], false);
                            ai[4 * dw + 3] = __builtin_amdgcn_sdot4((int)__builtin_amdgcn_perm(p3, p1, 0x07060302u), cq, ai[4 * dw + 3], false); } }
                    const bool kb0 = (k & 1) != 0, kb1 = (k & 2) != 0, kb2 = (k & 4) != 0;
                    int rAx[4], rAy[4], rBx[2], rBy[2], rCx, rCy;
#define DPPI(v, ctrl) __builtin_amdgcn_update_dpp(0, (v), (ctrl), 0xf, 0xf, true)
#pragma unroll
                    for (int m = 0; m < 4; ++m) { const int kx = kb0 ? ai[4 * m + 2] : ai[4 * m], ky = kb0 ? ai[4 * m + 3] : ai[4 * m + 1], gx = kb0 ? ai[4 * m] : ai[4 * m + 2], gy = kb0 ? ai[4 * m + 1] : ai[4 * m + 3];
                        rAx[m] = kx + DPPI(gx, 0x128); rAy[m] = ky + DPPI(gy, 0x128); }
#pragma unroll
                    for (int m = 0; m < 2; ++m) { const int kx = kb1 ? rAx[2 * m + 1] : rAx[2 * m], ky = kb1 ? rAy[2 * m + 1] : rAy[2 * m], gx = kb1 ? rAx[2 * m] : rAx[2 * m + 1], gy = kb1 ? rAy[2 * m] : rAy[2 * m + 1];
                        const auto sx = __builtin_amdgcn_permlane16_swap((unsigned)gx, (unsigned)gx, false, false), sy = __builtin_amdgcn_permlane16_swap((unsigned)gy, (unsigned)gy, false, false);
                        rBx[m] = kx + (int)(kb1 ? sx[0] : sx[1]); rBy[m] = ky + (int)(kb1 ? sy[0] : sy[1]); }
                    { const int kx = kb2 ? rBx[1] : rBx[0], ky = kb2 ? rBy[1] : rBy[0], gx = kb2 ? rBx[0] : rBx[1], gy = kb2 ? rBy[0] : rBy[1];
                        const auto sx = __builtin_amdgcn_permlane32_swap((unsigned)gx, (unsigned)gx, false, false), sy = __builtin_amdgcn_permlane32_swap((unsigned)gy, (unsigned)gy, false, false);
                        rCx = kx + (int)(kb2 ? sx[0] : sx[1]); rCy = ky + (int)(kb2 ? sy[0] : sy[1]); }
#undef DPPI
                    if (z == 0 || vB) *(GAS unsigned*)(YB + (size_t)tt[z] * DM + 128 * s + 16 * c8 + 2 * k) = cvtpk_s((float)rCx * scl[z] + ALPHA * bflo(hs[z]), (float)rCy * scl[z] + ALPHA * bfhi(hs[z]));
                }
            }
        }
    }
    GRID_BAR();
    v4u wa[4], wn[4]; if (gw < NTOK) ln_load_bf16(wa, YB + (size_t)gw * DM, lane);
    for (int m = gw; m < NTOK; m += NGW) {
        { const int mn = m + NGW; if (mn < NTOK) ln_load_bf16(wn, YB + (size_t)mn * DM, lane); }
        float v[32]; float sm = 0.f;
#pragma unroll
        for (int j2 = 0; j2 < 4; ++j2) { const v4u w = wa[j2];
            v[8 * j2 + 0] = bflo(w.x); v[8 * j2 + 1] = bfhi(w.x); v[8 * j2 + 2] = bflo(w.y); v[8 * j2 + 3] = bfhi(w.y); v[8 * j2 + 4] = bflo(w.z); v[8 * j2 + 5] = bfhi(w.z); v[8 * j2 + 6] = bflo(w.w); v[8 * j2 + 7] = bfhi(w.w); }
#pragma unroll
        for (int i = 0; i < 32; ++i) sm += v[i];
        const float mean = wave_sum(sm) * (1.f / DM); float s2 = 0.f;
#pragma unroll
        for (int i = 0; i < 32; ++i) { v[i] -= mean; s2 += v[i] * v[i]; }
        const float rstd = 1.f / sqrtf(wave_sum(s2) * (1.f / DM) + LN_EPS);
#pragma unroll
        for (int j2 = 0; j2 < 4; ++j2) {
            const GAS f32x4* gp = (const GAS f32x4*)ln_ffn_g + 2 * (lane + 64 * j2); const GAS f32x4* bp = (const GAS f32x4*)ln_ffn_b + 2 * (lane + 64 * j2);
            const f32x4 g0 = gp[0], g1 = gp[1], b0 = bp[0], b1 = bp[1];
            GAS f32x4* op = (GAS f32x4*)(out + (size_t)m * DM) + 2 * (lane + 64 * j2);
            op[0] = (f32x4){v[8 * j2 + 0] * rstd * g0.x + b0.x, v[8 * j2 + 1] * rstd * g0.y + b0.y, v[8 * j2 + 2] * rstd * g0.z + b0.z, v[8 * j2 + 3] * rstd * g0.w + b0.w};
            op[1] = (f32x4){v[8 * j2 + 4] * rstd * g1.x + b1.x, v[8 * j2 + 5] * rstd * g1.y + b1.y, v[8 * j2 + 6] * rstd * g1.z + b1.z, v[8 * j2 + 7] * rstd * g1.w + b1.w}; }
#pragma unroll
        for (int j2 = 0; j2 < 4; ++j2) wa[j2] = wn[j2];
    }
}

extern "C" void kernel_launch(void* const* d_in, const int* in_sizes, int n_in, void* d_out, int out_size, void* d_ws, size_t ws_size, hipStream_t stream) {
    static int grid = 0;
    if (grid == 0) {
        if (n_in != 15 || out_size != NTOK * DM || ws_size < WS_END) { fprintf(stderr, "kernel_launch: unexpected shapes (n_in %d out %d ws %zu)\n", n_in, out_size, ws_size); grid = -1; return; }
        int dev = 0, cus = 0, per_cu = 0;
        if (hipGetDevice(&dev) != hipSuccess || hipDeviceGetAttribute(&cus, hipDeviceAttributeMultiprocessorCount, dev) != hipSuccess) { grid = -1; return; }
        if (hipFuncSetAttribute((const void*)mk_fwd, hipFuncAttributeMaxDynamicSharedMemorySize, LDS_BYTES) != hipSuccess) { fprintf(stderr, "kernel_launch: hipFuncSetAttribute failed\n"); grid = -1; return; }
        if (hipOccupancyMaxActiveBlocksPerMultiprocessor(&per_cu, (const void*)mk_fwd, NWAVES * 64, LDS_BYTES) != hipSuccess || per_cu < 1) { fprintf(stderr, "kernel_launch: occupancy query says %d\n", per_cu); }
        (void)hipGetLastError();
        grid = cus;
    }
    if (grid < 0) return;
    if (hipMemsetAsync((char*)d_ws + WS_CTL, 0, CTL_ZERO_BYTES, stream) != hipSuccess) return;
    Args a{};
    for (int i = 0; i < 15; ++i) a.in[i] = (const float*)d_in[i];
    a.out = (float*)d_out; a.ws = (unsigned char*)d_ws;
    hipLaunchKernelGGL(mk_fwd, dim3(grid), dim3(NWAVES * 64), LDS_BYTES, stream, a);
}
```

```cpp
#include <hip/hip_runtime.h>
#include <cstdio>
#include <cstdint>
#include <cmath>
namespace pg8 {
#define PG8_LAS __attribute__((address_space(3)))
typedef unsigned short bf16_t;
typedef short bf16x8 __attribute__((ext_vector_type(8)));
typedef float f32x4 __attribute__((ext_vector_type(4)));
typedef unsigned u32x4 __attribute__((ext_vector_type(4)));
constexpr int BM = 256, BK = 64, HALF = 128, HTB = HALF * BK * 2  , STAGE_BYTES = 8 * HTB, NXCD = 8, WGM = 4;

__host__ __device__ __forceinline__ int lds_byte(int r, int c) { const int st = (r >> 4) * 2 + (c >> 5), rr = r & 15, cc = c & 31, ob = rr * 64 + cc * 2; return st * 1024 + (ob ^ (((ob >> 9) & 1) << 5)); }
__host__ __device__ __forceinline__ void stage_rc(int b, int& R, int& C) { const int st = b / 1024, sb = b % 1024, swz = sb ^ (((sb >> 9) & 1) << 5); R = (st >> 1) * 16 + swz / 64; C = (st & 1) * 32 + (swz % 64) / 2; }
__host__ __device__ __forceinline__ int perm32(int rho) { const int n = rho >> 4, i = rho & 15; return 8 * (i >> 2) + 4 * n + (i & 3); }

struct Unit { int pm, pn; };
struct Gemm { const bf16_t* A; const bf16_t* Bt; int M, N, K; const float* rs; const float* cs; };
typedef int i32x4 __attribute__((ext_vector_type(4)));

struct StaticOrder {
    int nM, nN, nwg, G, c, wgm;
    __host__ __device__ void init(int M, int N, int G_, int c_, int wgm_ = WGM) { nM = M / BM; nN = N / BM; nwg = nM * nN; G = G_; c = c_; wgm = wgm_; }
    __host__ __device__ bool next(int i, Unit& u) const {
        const long L = (long)i * G + c; if (L >= nwg) return false;
        int wgid = (int)L; { const int q = nwg / NXCD, r = nwg % NXCD, xcd = wgid % NXCD, off = wgid / NXCD; wgid = (xcd < r ? xcd * (q + 1) : r * (q + 1) + (xcd - r) * q) + off; }
        const int nig = wgm * nN, gid = wgid / nig, fm = gid * wgm, gsz = (nM - fm) < wgm ? (nM - fm) : wgm;
        u.pm = fm + ((wgid % nig) % gsz); u.pn = (wgid % nig) / gsz; return true;
    }
    __device__ __forceinline__ void a_ready(const Unit&) const {}
    __device__ __forceinline__ void done(const Unit&) const {}
};

__device__ __forceinline__ unsigned cvt_pk_bf16(float lo, float hi) { unsigned r; asm volatile("v_cvt_pk_bf16_f32 %0, %1, %2" : "=v"(r) : "v"(lo), "v"(hi)); return r; }
typedef float f32x2 __attribute__((ext_vector_type(2)));

template <int MODE> struct EpiGen {
    static constexpr bool PERM = true, AFTER_DRAIN = false;
    bf16_t* O; int ldc; const bf16_t* R; float alpha;
    const signed char* R8 = nullptr; const float* RS = nullptr;
    bf16_t *QR, *KA, *VA, *RK, *RV, *RG;
    __device__ __forceinline__ void operator()(const f32x4 (&acc)[2][2][4][2], const Unit& u, int wr, int wc, int fr, int fq) const {
        const int row0 = u.pm * BM + wr * 64 + fr;
#pragma unroll
        for (int bj = 0; bj < 2; ++bj) {
            const int col = u.pn * BM + bj * HALF + wc * 32 + 8 * fq;
            bf16_t* base = O; int ld = ldc; int cc = col;
            if (MODE == 0) {
                if (col < 1024)      { base = QR; ld = 2048; cc = col; }
                else if (col < 1152) { base = KA; ld = 128;  cc = col - 1024; }
                else if (col < 1280) { base = VA; ld = 128;  cc = col - 1152; }
                else if (col < 2304) { base = QR; ld = 2048; cc = col - 1280 + 1024; }
                else if (col < 3328) { base = RK; ld = 1024; cc = col - 2304; }
                else if (col < 4352) { base = RV; ld = 1024; cc = col - 3328; }
                else                 { base = RG; ld = 1024; cc = col - 4352; }
            }
#pragma unroll
            for (int ai = 0; ai < 2; ++ai)
#pragma unroll
                for (int m = 0; m < 4; ++m) {
                    const int row = row0 + ai * HALF + m * 16;
                    f32x4 v0 = acc[ai][bj][m][0], v1 = acc[ai][bj][m][1];
                    if (MODE == 1) {
                        const unsigned long long rr = *(const unsigned long long*)(R8 + (size_t)row * ldc + col);
                        const unsigned r0 = (unsigned)rr ^ 0x80808080u, r1 = (unsigned)(rr >> 32) ^ 0x80808080u;
                        const float as = alpha * RS[row], ab = -128.0f * as;
                        v0[0] += (float)(r0 & 0xffu) * as + ab; v0[1] += (float)((r0 >> 8) & 0xffu) * as + ab; v0[2] += (float)((r0 >> 16) & 0xffu) * as + ab; v0[3] += (float)(r0 >> 24) * as + ab;
                        v1[0] += (float)(r1 & 0xffu) * as + ab; v1[1] += (float)((r1 >> 8) & 0xffu) * as + ab; v1[2] += (float)((r1 >> 16) & 0xffu) * as + ab; v1[3] += (float)(r1 >> 24) * as + ab;
                    }
                    u32x4 w; w.x = cvt_pk_bf16(v0[0], v0[1]); w.y = cvt_pk_bf16(v0[2], v0[3]); w.z = cvt_pk_bf16(v1[0], v1[1]); w.w = cvt_pk_bf16(v1[2], v1[3]);
                    *(u32x4*)(base + (size_t)row * ld + cc) = w;
                }
        }
    }
};

struct EpiProj {
    static constexpr bool PERM = true, AFTER_DRAIN = false;
    bf16_t *QR, *KA, *VA, *RK, *RV, *RG; float qscale;
    __device__ __forceinline__ void operator()(const f32x4 (&acc)[2][2][4][2], const Unit& u, int wr, int wc, int fr, int fq) const {
        const int pn = u.pn, row0 = u.pm * BM + wr * 64 + fr, c0 = wc * 32 + 8 * fq;
        const bool rope = (pn <= 3) || (pn == 4 && wc < 2) || (pn >= 5 && pn <= 12);
        if (rope) {
            const bool ret = pn >= 5; const int h = ret ? ((pn - 5) & 3) : 0;
            const float lg = __builtin_amdgcn_logf(1.0f - __builtin_amdgcn_exp2f(-5.0f - (float)h));
            float invrev[8];
#pragma unroll
            for (int i8 = 0; i8 < 8; ++i8) { const float ii = (float)((ret ? c0 : 8 * fq) + i8); invrev[i8] = 0.15915494309189535f * __builtin_amdgcn_exp2f(-ii * (ret ? 0.10381025296523008f : 0.4152410118609203f)); }
            bf16_t* base; int ld, cA, cB;
            if (pn <= 3)      { base = QR; ld = 2048; cA = pn * 256 + 64 * wc + 8 * fq; cB = cA + 32; }
            else if (pn == 4) { base = KA; ld = 128;  cA = 64 * wc + 8 * fq; cB = cA + 32; }
            else if (pn <= 8) { base = QR; ld = 2048; cA = 1024 + 256 * h + c0; cB = cA + 128; }
            else              { base = RK; ld = 1024; cA = 256 * h + c0; cB = cA + 128; }
#pragma unroll
            for (int ai = 0; ai < 2; ++ai)
#pragma unroll
                for (int m = 0; m < 4; ++m) {
                    const int row = row0 + ai * HALF + m * 16;
                    int pos, ipos;
                    if (row < 16384) { const int s = row & 4095; pos = 16 + s; ipos = s & 127; } else { int j = row - 16384; if (j > 15) j = 15; pos = j; ipos = 112 + j; }
                    float sc = qscale;
                    if (pn == 4) sc = 1.0f; else if (pn >= 9) sc = 0.0625f * __builtin_amdgcn_exp2f(-(float)(ipos + 1) * lg); else if (pn >= 5) sc = __builtin_amdgcn_exp2f((float)(ipos + 1) * lg);
                    const float pf = (float)pos;
                    float cs[8], sn[8];
#pragma unroll
                    for (int i8 = 0; i8 < 8; ++i8) { const float rev = __builtin_amdgcn_fractf(pf * invrev[i8]); cs[i8] = __builtin_amdgcn_cosf(rev); sn[i8] = __builtin_amdgcn_sinf(rev); }
                    const f32x4 a0 = acc[ai][0][m][0], a1 = acc[ai][0][m][1], b0 = acc[ai][1][m][0], b1 = acc[ai][1][m][1];
                    u32x4 wA, wB;
                    wA.x = cvt_pk_bf16((a0[0] * cs[0] - b0[0] * sn[0]) * sc, (a0[1] * cs[1] - b0[1] * sn[1]) * sc); wA.y = cvt_pk_bf16((a0[2] * cs[2] - b0[2] * sn[2]) * sc, (a0[3] * cs[3] - b0[3] * sn[3]) * sc);
                    wA.z = cvt_pk_bf16((a1[0] * cs[4] - b1[0] * sn[4]) * sc, (a1[1] * cs[5] - b1[1] * sn[5]) * sc); wA.w = cvt_pk_bf16((a1[2] * cs[6] - b1[2] * sn[6]) * sc, (a1[3] * cs[7] - b1[3] * sn[7]) * sc);
                    wB.x = cvt_pk_bf16((b0[0] * cs[0] + a0[0] * sn[0]) * sc, (b0[1] * cs[1] + a0[1] * sn[1]) * sc); wB.y = cvt_pk_bf16((b0[2] * cs[2] + a0[2] * sn[2]) * sc, (b0[3] * cs[3] + a0[3] * sn[3]) * sc);
                    wB.z = cvt_pk_bf16((b1[0] * cs[4] + a1[0] * sn[4]) * sc, (b1[1] * cs[5] + a1[1] * sn[5]) * sc); wB.w = cvt_pk_bf16((b1[2] * cs[6] + a1[2] * sn[6]) * sc, (b1[3] * cs[7] + a1[3] * sn[7]) * sc);
                    *(u32x4*)(base + (size_t)row * ld + cA) = wA; *(u32x4*)(base + (size_t)row * ld + cB) = wB;
                }
        } else {
            const bool silu = pn >= 17;
#pragma unroll
            for (int bj = 0; bj < 2; ++bj) {
                bf16_t* base; int ld, cc;
                if (pn == 4)       { base = VA; ld = 128;  cc = 64 * bj + 32 * (wc - 2) + 8 * fq; }
                else if (pn <= 16) { base = RV; ld = 1024; cc = 256 * (pn - 13) + 128 * bj + c0; }
                else               { base = RG; ld = 1024; cc = 256 * (pn - 17) + 128 * bj + c0; }
#pragma unroll
                for (int ai = 0; ai < 2; ++ai)
#pragma unroll
                    for (int m = 0; m < 4; ++m) {
                        const int row = row0 + ai * HALF + m * 16;
                        f32x4 v0 = acc[ai][bj][m][0], v1 = acc[ai][bj][m][1];
                        if (silu) {
#pragma unroll
                            for (int e = 0; e < 4; ++e) { v0[e] = v0[e] * __builtin_amdgcn_rcpf(1.0f + __builtin_amdgcn_exp2f(-1.4426950408889634f * v0[e])); v1[e] = v1[e] * __builtin_amdgcn_rcpf(1.0f + __builtin_amdgcn_exp2f(-1.4426950408889634f * v1[e])); } }
                        u32x4 w; w.x = cvt_pk_bf16(v0[0], v0[1]); w.y = cvt_pk_bf16(v0[2], v0[3]); w.z = cvt_pk_bf16(v1[0], v1[1]); w.w = cvt_pk_bf16(v1[2], v1[3]);
                        *(u32x4*)(base + (size_t)row * ld + cc) = w;
                    }
            }
        }
    }
};
struct NoHook { __device__ __forceinline__ void operator()(int) const {} };
template <class Epi, class Sched, bool ALIGN_EPI = false, bool SP2 = false, class Hook = NoHook, bool I8 = false>
__device__ __forceinline__ void gemm_phase(PG8_LAS unsigned char* lds, const Gemm g, const Sched& S, const Epi& E, const Hook& H = Hook()) {
    const int tid = threadIdx.x, wid = __builtin_amdgcn_readfirstlane(tid >> 6), lane = tid & 63, wr = wid >> 2, wc = wid & 3, fr = lane & 15, fq = lane >> 4;
    const int K = g.K, nt = K / BK;
    unsigned voffA[2], voffB[2];
#pragma unroll
    for (int i = 0; i < 2; ++i) { int R, C; stage_rc(tid * 16 + i * 8192, R, C); const int Rb = Epi::PERM ? ((R & ~31) + perm32(R & 31)) : R;
        voffA[i] = (unsigned)(R * K + C) * 2u; voffB[i] = (unsigned)(Rb * K + C) * 2u; }
    const size_t kstep = (size_t)(BK * 2);
    const size_t hstep = (size_t)HALF * K * 2;
    const size_t tstep = 2 * hstep;
    const unsigned ldsw = (unsigned)wid * 1024u;
    const int aoff = lds_byte(wr * 64 + fr, fq * 8), boff = lds_byte(wc * 32 + fr, fq * 8);
#define PG8_SA(b, h) (((b) * 2 + (h)) * HTB)
#define PG8_SB(b, h) ((4 + (b) * 2 + (h)) * HTB)
#define PG8_STAGE(bufoff, gbase, voff) do { _Pragma("unroll") for (int _i = 0; _i < 2; ++_i) \
        __builtin_amdgcn_global_load_lds((const unsigned*)((const char*)(gbase) + (voff)[_i]), (PG8_LAS unsigned*)(lds + (bufoff) + ldsw + _i * 8192), 16, 0, 0); } while (0)
#define PG8_LDA(dst, b, h) do { _Pragma("unroll") for (int m = 0; m < 4; ++m) _Pragma("unroll") for (int k = 0; k < 2; ++k) dst[m][k] = *(const PG8_LAS bf16x8*)(lds + PG8_SA(b, h) + aoff + m * 2048 + k * 1024); } while (0)
#define PG8_LDB(dst, b, h) do { _Pragma("unroll") for (int n = 0; n < 2; ++n) _Pragma("unroll") for (int k = 0; k < 2; ++k) dst[n][k] = *(const PG8_LAS bf16x8*)(lds + PG8_SB(b, h) + boff + n * 2048 + k * 1024); } while (0)
#define PG8_MMA(ai, bj, At, Bt) do { __builtin_amdgcn_s_setprio(1); _Pragma("unroll") for (int m = 0; m < 4; ++m) _Pragma("unroll") for (int n = 0; n < 2; ++n) _Pragma("unroll") for (int k = 0; k < 2; ++k) \
        { if constexpr (I8) acc[ai][bj][m][n] = __builtin_bit_cast(f32x4, __builtin_amdgcn_mfma_i32_16x16x64_i8(__builtin_bit_cast(i32x4, Bt[n][k]), __builtin_bit_cast(i32x4, At[m][k]), __builtin_bit_cast(i32x4, acc[ai][bj][m][n]), 0, 0, 0)); \
          else acc[ai][bj][m][n] = __builtin_amdgcn_mfma_f32_16x16x32_bf16(Bt[n][k], At[m][k], acc[ai][bj][m][n], 0, 0, 0); } __builtin_amdgcn_s_setprio(0); } while (0)
#define PG8_WAIT_V(n) asm volatile("s_waitcnt vmcnt(" #n ")" ::: "memory")
#define PG8_WAIT_L(n) asm volatile("s_waitcnt lgkmcnt(" #n ")" ::: "memory")
#define PG8_BAR __builtin_amdgcn_s_barrier()
#define PG8_SCHED __builtin_amdgcn_sched_barrier(0)
    Unit cur, nxt; int ui = 0;
    if (!S.next(0, cur)) return;
    f32x4 acc[2][2][4][2];
#pragma unroll
    for (int a = 0; a < 2; ++a)
#pragma unroll
        for (int b = 0; b < 2; ++b)
#pragma unroll
            for (int m = 0; m < 4; ++m)
#pragma unroll
                for (int n = 0; n < 2; ++n) acc[a][b][m][n] = (f32x4){0.f, 0.f, 0.f, 0.f};
    bf16x8 At[4][2], B0[2][2], B1[2][2];
    const char* cA = (const char*)g.A + (size_t)cur.pm * tstep; const char* cB = (const char*)g.Bt + (size_t)cur.pn * tstep;
    S.a_ready(cur);
    if constexpr (SP2) {
        PG8_STAGE(PG8_SB(0, 0), cB, voffB); PG8_STAGE(PG8_SB(0, 1), cB + hstep, voffB); PG8_STAGE(PG8_SA(0, 0), cA, voffA); PG8_STAGE(PG8_SA(0, 1), cA + hstep, voffA);
        if (wr == 1) PG8_BAR;
        PG8_WAIT_V(2); PG8_BAR;
        PG8_STAGE(PG8_SB(1, 0), cB + kstep, voffB); PG8_STAGE(PG8_SA(1, 0), cA + kstep, voffA); PG8_STAGE(PG8_SB(1, 1), cB + hstep + kstep, voffB);
        PG8_WAIT_V(6); PG8_BAR;
    } else {
        PG8_STAGE(PG8_SB(0, 0), cB, voffB); PG8_STAGE(PG8_SA(0, 0), cA, voffA); PG8_STAGE(PG8_SB(0, 1), cB + hstep, voffB); PG8_STAGE(PG8_SA(0, 1), cA + hstep, voffA);
        if (wr == 1) PG8_BAR;
        PG8_WAIT_V(4); PG8_BAR;
        PG8_STAGE(PG8_SB(1, 0), cB + kstep, voffB); PG8_STAGE(PG8_SA(1, 0), cA + kstep, voffA); PG8_STAGE(PG8_SB(1, 1), cB + hstep + kstep, voffB);
        PG8_WAIT_V(6); PG8_BAR;
    }
    for (;;) {
        const bool has_next = S.next(ui + 1, nxt);
        const char* nA = has_next ? (const char*)g.A + (size_t)nxt.pm * tstep : cA; const char* nB = has_next ? (const char*)g.Bt + (size_t)nxt.pn * tstep : cB;
        for (int t = 0; t < nt; t += 2) {
            const bool last = (t == nt - 2);
            const char* a1 = cA + (size_t)(t + 1) * kstep;
            const char* a2 = last ? nA : cA + (size_t)(t + 2) * kstep; const char* b2 = last ? nB : cB + (size_t)(t + 2) * kstep;
            const char* a3 = a2 + kstep; const char* b3 = b2 + kstep;
            if (last && has_next) S.a_ready(nxt);
            if constexpr (SP2) {
            PG8_LDB(B0, 0, 0); PG8_LDB(B1, 0, 1); PG8_SCHED; PG8_LDA(At, 0, 0); PG8_STAGE(PG8_SA(1, 1), a1 + hstep, voffA);
            PG8_WAIT_V(8); PG8_WAIT_L(0); PG8_BAR; PG8_MMA(0, 0, At, B0); PG8_MMA(0, 1, At, B1); PG8_BAR; PG8_SCHED;
            PG8_LDA(At, 0, 1); PG8_STAGE(PG8_SB(0, 0), b2, voffB); PG8_STAGE(PG8_SB(0, 1), b2 + hstep, voffB); PG8_STAGE(PG8_SA(0, 0), a2, voffA);
            PG8_WAIT_V(8); PG8_WAIT_L(0); PG8_BAR; PG8_MMA(1, 0, At, B0); PG8_MMA(1, 1, At, B1); PG8_BAR; PG8_SCHED;
            PG8_LDB(B0, 1, 0); PG8_LDB(B1, 1, 1); PG8_SCHED; PG8_LDA(At, 1, 0); PG8_STAGE(PG8_SA(0, 1), a2 + hstep, voffA);
            PG8_WAIT_V(8); PG8_WAIT_L(0); PG8_BAR; PG8_MMA(0, 0, At, B0); PG8_MMA(0, 1, At, B1); PG8_BAR; PG8_SCHED;
            PG8_LDA(At, 1, 1); PG8_STAGE(PG8_SB(1, 0), b3, voffB); PG8_STAGE(PG8_SB(1, 1), b3 + hstep, voffB); PG8_STAGE(PG8_SA(1, 0), a3, voffA);
            PG8_WAIT_V(8); PG8_WAIT_L(0); PG8_BAR; PG8_MMA(1, 0, At, B0); PG8_MMA(1, 1, At, B1); PG8_BAR; PG8_SCHED;
            } else {
            PG8_LDB(B0, 0, 0); PG8_SCHED; PG8_LDA(At, 0, 0); PG8_STAGE(PG8_SA(1, 1), a1 + hstep, voffA);
            PG8_WAIT_L(8); PG8_BAR; PG8_WAIT_L(0); PG8_MMA(0, 0, At, B0); PG8_BAR; PG8_SCHED;
            PG8_LDB(B1, 0, 1); PG8_STAGE(PG8_SB(0, 0), b2, voffB);
            PG8_BAR; PG8_WAIT_L(0); PG8_MMA(0, 1, At, B1); PG8_BAR;
            PG8_LDA(At, 0, 1); PG8_STAGE(PG8_SA(0, 0), a2, voffA);
            PG8_BAR; PG8_WAIT_L(0); PG8_MMA(1, 0, At, B0); PG8_BAR; PG8_SCHED;
            PG8_STAGE(PG8_SB(0, 1), b2 + hstep, voffB);
            PG8_WAIT_V(6); PG8_BAR; PG8_MMA(1, 1, At, B1); PG8_BAR;
            PG8_LDB(B0, 1, 0); PG8_SCHED; PG8_LDA(At, 1, 0); PG8_STAGE(PG8_SA(0, 1), a2 + hstep, voffA);
            PG8_WAIT_L(8); PG8_BAR; PG8_WAIT_L(0); PG8_MMA(0, 0, At, B0); PG8_BAR; PG8_SCHED;
            PG8_LDB(B1, 1, 1); PG8_STAGE(PG8_SB(1, 0), b3, voffB);
            PG8_BAR; PG8_WAIT_L(0); PG8_MMA(0, 1, At, B1); PG8_BAR;
            PG8_LDA(At, 1, 1); PG8_STAGE(PG8_SA(1, 0), a3, voffA);
            PG8_BAR; PG8_WAIT_L(0); PG8_MMA(1, 0, At, B0); PG8_BAR; PG8_SCHED;
            PG8_STAGE(PG8_SB(1, 1), b3 + hstep, voffB);
            PG8_WAIT_V(6); PG8_BAR; PG8_MMA(1, 1, At, B1); PG8_BAR;
            }
        }
        if constexpr (ALIGN_EPI) { if (wr == 0) PG8_BAR; }
        if constexpr (I8) {
            const int row0 = cur.pm * BM + wr * 64 + fr;
            float rsv[2][4];
#pragma unroll
            for (int ai = 0; ai < 2; ++ai)
#pragma unroll
                for (int m = 0; m < 4; ++m) rsv[ai][m] = g.rs[row0 + ai * HALF + m * 16];
#pragma unroll
            for (int bj = 0; bj < 2; ++bj) {
                const int col = cur.pn * BM + bj * HALF + wc * 32 + 8 * fq;
                const f32x4 c0 = *(const f32x4*)(g.cs + col), c1 = *(const f32x4*)(g.cs + col + 4);
#pragma unroll
                for (int ai = 0; ai < 2; ++ai)
#pragma unroll
                    for (int m = 0; m < 4; ++m)
                    {
                        const i32x4 i0 = __builtin_bit_cast(i32x4, acc[ai][bj][m][0]), i1 = __builtin_bit_cast(i32x4, acc[ai][bj][m][1]);
                        f32x4 f0, f1;
#pragma unroll
                        for (int e = 0; e < 4; ++e) { f0[e] = (float)i0[e] * (rsv[ai][m] * c0[e]); f1[e] = (float)i1[e] * (rsv[ai][m] * c1[e]); }
                        acc[ai][bj][m][0] = f0; acc[ai][bj][m][1] = f1; }
            }
        }
        if constexpr (!Epi::AFTER_DRAIN) { E(acc, cur, wr, wc, fr, fq); S.done(cur); }
        if (!has_next) break;
        H(ui);
#pragma unroll
        for (int a = 0; a < 2; ++a)
#pragma unroll
            for (int b = 0; b < 2; ++b)
#pragma unroll
                for (int m = 0; m < 4; ++m)
#pragma unroll
                    for (int n = 0; n < 2; ++n) acc[a][b][m][n] = (f32x4){0.f, 0.f, 0.f, 0.f};
        cur = nxt; cA = nA; cB = nB; ++ui;
        if constexpr (ALIGN_EPI) { if (wr == 1) PG8_BAR; }
    }
    PG8_WAIT_V(0);
    if constexpr (!ALIGN_EPI) { if (wr == 0) PG8_BAR; }
    PG8_BAR;
    if constexpr (Epi::AFTER_DRAIN) { E.fused(acc, cur, wr, wc, fr, fq, lds, wid, lane); S.done(cur); }
#undef PG8_SA
#undef PG8_SB
#undef PG8_STAGE
#undef PG8_LDA
#undef PG8_LDB
#undef PG8_MMA
#undef PG8_WAIT_V
#undef PG8_WAIT_L
#undef PG8_BAR
#undef PG8_SCHED
}
}

constexpr int NWAVES = 8;
constexpr int DM = 2048, NB = 4, SEQ = 4096, NTOK = NB * SEQ;
constexpr int NMETA = 16, NVALID = NTOK + NMETA, MROWS = 16640;
constexpr int IN_COLS = 5376;
constexpr float LN_EPS = 1e-5f, GN_EPS = 1e-5f;
constexpr float ALPHA = 1.189207115002721f;
constexpr float LOG2E = 1.4426950408889634f;
constexpr float QSCALE = 0.125f * LOG2E;
constexpr float U_QSCALE = 958.0f;
constexpr float V_QSCALE = 35.6f;
constexpr int NSL = 16;

constexpr size_t MiB = 1u << 20;
constexpr size_t WS_CTL = 0, CTL_ZERO_BYTES = 65536;
constexpr size_t SZ_SK = (size_t)16 * 128 * 128 * 2, SZ_ROPE_R = (size_t)4112 * 128 * 8, SZ_ROPE_A = (size_t)4112 * 32 * 8;
constexpr size_t SZ_W2T = (size_t)DM * DM * 2, SZ_W1T = (size_t)IN_COLS * DM * 2, SZ_TAB = (size_t)16384 * DM;
constexpr size_t SZ_ROWS2K = (size_t)MROWS * 2048 * 2, SZ_ROWS1K = (size_t)MROWS * 1024 * 2, SZ_ROWS128 = (size_t)MROWS * 128 * 2;
constexpr size_t SZ_TOK2K = (size_t)NTOK * 2048 * 2, SZ_ST = (size_t)16 * 32 * 256 * 256 * 2, SZ_IDS = (size_t)NTOK * 128 * 4;
constexpr size_t al256(size_t x) { return (x + 255) & ~(size_t)255; }
constexpr size_t WS_SK = 1 * MiB;
constexpr size_t WS_ROPE_R = al256(WS_SK + SZ_SK);
constexpr size_t WS_ROPE_A = al256(WS_ROPE_R + SZ_ROPE_R);
constexpr size_t WS_W2T = al256(WS_ROPE_A + SZ_ROPE_A), WS_W3T = al256(WS_W2T + SZ_W2T), WS_W1T = al256(WS_W3T + SZ_W2T);
constexpr size_t WS_UT = al256(WS_W1T + SZ_W1T), WS_VT = al256(WS_UT + SZ_TAB);
constexpr size_t WS_H0 = al256(WS_VT + SZ_TAB);
constexpr size_t WS_QR = al256(WS_H0 + SZ_ROWS2K);
constexpr size_t WS_KA = al256(WS_QR + SZ_ROWS2K), WS_VA = al256(WS_KA + SZ_ROWS128);
constexpr size_t WS_RK = al256(WS_VA + SZ_ROWS128), WS_RV = al256(WS_RK + SZ_ROWS1K), WS_RG = al256(WS_RV + SZ_ROWS1K);
constexpr size_t WS_ST = al256(WS_RG + SZ_ROWS1K);
constexpr size_t WS_Y = WS_RK;
constexpr size_t WS_H1 = WS_ST;
constexpr size_t WS_IDS = al256(WS_ST + SZ_ST), WS_GATES = al256(WS_IDS + SZ_IDS);
constexpr size_t WS_HSC = al256(WS_GATES + SZ_IDS);
constexpr size_t WS_CSC = al256(WS_HSC + (size_t)NTOK * 4);
constexpr size_t WS_H0Q = al256(WS_CSC + (size_t)NTOK * 4);
constexpr size_t WS_W1Q = al256(WS_H0Q + (size_t)MROWS * DM);
constexpr size_t WS_W3Q = al256(WS_W1Q + (size_t)IN_COLS * DM);
constexpr size_t WS_H0S = al256(WS_W3Q + (size_t)DM * DM);
constexpr size_t WS_WS1 = al256(WS_H0S + (size_t)MROWS * 4);
constexpr size_t WS_WS3 = al256(WS_WS1 + (size_t)IN_COLS * 4);
constexpr size_t WS_END = al256(WS_WS3 + (size_t)DM * 4);
static_assert(WS_Y + SZ_TOK2K <= WS_RG, "Y overlays RK|RV only");
static_assert(SZ_TOK2K <= SZ_ST && (size_t)NTOK * 1024 * 4 <= SZ_ST, "H1 / RET_RAW fit the state region");
static_assert(WS_END <= (size_t)512 * MiB, "workspace map fits 4 x largest tensor");
static_assert(WS_RK + (size_t)8 * NTOK * 128 * 4 <= WS_ST && WS_KA + (size_t)NTOK * 128 * 4 <= WS_RK && WS_H0 + (size_t)NTOK * DM * 4 <= WS_KA, "expert-phase overlays (DOTX over RK|RV, CB over KA|VA, Y32 over H0|QR)");
constexpr int CW_TMO = 0, CW_TABQ = 64, CW_BAR = 4096;

constexpr int RING_OFF = 0, RING_BYTES = 131072;
constexpr int LDSCTL_OFF = RING_BYTES, MISC_OFF = LDSCTL_OFF + 320;
constexpr int LDS_BYTES = 147456;

#define GAS __attribute__((address_space(1)))
#define LAS __attribute__((address_space(3)))
typedef unsigned short bf16;
typedef unsigned v4u __attribute__((ext_vector_type(4)));
typedef unsigned v2u __attribute__((ext_vector_type(2)));
typedef float f32x4 __attribute__((ext_vector_type(4)));
typedef float f32x2 __attribute__((ext_vector_type(2)));
typedef GAS unsigned gu32;
typedef __bf16 bf16x2_t __attribute__((ext_vector_type(2)));
#define RLX_AGENT __ATOMIC_RELAXED, __HIP_MEMORY_SCOPE_AGENT
#define LDS_WAIT() asm volatile("s_waitcnt lgkmcnt(0)" ::: "memory")
#define VM_WAIT() asm volatile("s_waitcnt vmcnt(0)" ::: "memory")
#define LDS_BAR() do { asm volatile("s_waitcnt lgkmcnt(0)" ::: "memory"); __builtin_amdgcn_s_barrier(); asm volatile("" ::: "memory"); } while (0)
__device__ __forceinline__ unsigned f2bf(float f) { unsigned u = __builtin_bit_cast(unsigned, f); return (u + 0x7fffu + ((u >> 16) & 1u)) >> 16; }
__device__ __forceinline__ unsigned pk2(float lo, float hi) { return f2bf(lo) | (f2bf(hi) << 16); }
__device__ __forceinline__ float bflo(unsigned w) { return __uint_as_float(w << 16); }
__device__ __forceinline__ float bfhi(unsigned w) { return __uint_as_float(w & 0xffff0000u); }
__device__ __forceinline__ float bf2f(bf16 h) { return __uint_as_float((unsigned)h << 16); }

#define XB_TMO      128
#define XB_XCNT(j)  (256  + 64 * (j))
#define XB_XSUB(j)  (1280 + 64 * (j))
#define XB_XGEN(j)  (2304 + 64 * (j))
#define XB_TOP      3328
#define XB_TOPGEN   3392
#define XCD_BAR_WORDS 3456
#define XB_SPIN_CAP (1u << 18)

__device__ __forceinline__ unsigned xb_ld(unsigned* p)              { return __hip_atomic_load(p, __ATOMIC_RELAXED, __HIP_MEMORY_SCOPE_AGENT); }
__device__ __forceinline__ unsigned xb_add(unsigned* p, unsigned v) { return __hip_atomic_fetch_add(p, v, __ATOMIC_RELAXED, __HIP_MEMORY_SCOPE_AGENT); }
__device__ __forceinline__ unsigned xb_xcc_id() { return (unsigned)__builtin_amdgcn_s_getreg((3 << 11) | 20) & 0xFu; }
#define XB_SPIN(cond, bar) do { unsigned _sp = 0; while (cond) { __builtin_amdgcn_s_sleep(1); \
    if ((++_sp & 255u) == 0u) { if (xb_ld(&(bar)[XB_TMO])) break; if (_sp > XB_SPIN_CAP) { atomicAdd(&(bar)[XB_TMO], 1u); break; } } } } while (0)

struct XcdBarrier {
    unsigned* bar; unsigned x;
    volatile LAS unsigned* st;
};

__device__ __forceinline__ XcdBarrier xcd_barrier_post(unsigned* bar, volatile LAS unsigned* st) {
    XcdBarrier b; b.bar = bar; b.x = xb_xcc_id(); b.st = st;
    if (threadIdx.x == 0) (void)xb_add(&bar[XB_XCNT(b.x)], 1u);
    return b;
}
__device__ __forceinline__ void xcd_barrier_complete(unsigned* bar, unsigned x, unsigned& nloc, unsigned& nx) {
    const unsigned G = gridDim.x * gridDim.y * gridDim.z;
    unsigned sum, cnt, mine, sp = 0u;
    for (;;) {
        sum = 0u; cnt = 0u; mine = 0u;
#pragma unroll
        for (unsigned j = 0; j < 16; ++j) { const unsigned c = xb_ld(&bar[XB_XCNT(j)]); sum += c; cnt += (c > 0u) ? 1u : 0u; mine = (j == x) ? c : mine; }
        if (sum == G) break;
        __builtin_amdgcn_s_sleep(1);
        if ((++sp & 255u) == 0u) { if (xb_ld(&bar[XB_TMO])) break; if (sp > XB_SPIN_CAP) { atomicAdd(&bar[XB_TMO], 1u); break; } }
    }
    nloc = mine > 0u ? mine : 1u; nx = cnt > 0u ? cnt : 1u;
}

__device__ __forceinline__ void xcd_barrier(const XcdBarrier& b) {
    asm volatile("s_waitcnt vmcnt(0)" ::: "memory");
    __syncthreads();
    if (threadIdx.x == 0) {
        unsigned* bar = b.bar;
        __builtin_amdgcn_s_waitcnt(0);
        unsigned nloc = b.st[0], nx = b.st[1];
        if (nloc == 0u) { xcd_barrier_complete(bar, b.x, nloc, nx); b.st[0] = nloc; b.st[1] = nx; }
        const unsigned old = xb_add(&bar[XB_XSUB(b.x)], 1u);
        const unsigned gen = old / nloc;
        if (old + 1u == (gen + 1u) * nloc) {
            __builtin_amdgcn_fence(__ATOMIC_RELEASE, "agent");
            asm volatile("s_waitcnt vmcnt(0)" ::: "memory");
            const unsigned og = xb_add(&bar[XB_TOP], 1u);
            const unsigned tg = og / nx;
            if (og + 1u == (tg + 1u) * nx) xb_add(&bar[XB_TOPGEN], 1u);
            else XB_SPIN(xb_ld(&bar[XB_TOPGEN]) == tg, bar);
            __builtin_amdgcn_fence(__ATOMIC_ACQUIRE, "agent");
            xb_add(&bar[XB_XGEN(b.x)], 1u);
            asm volatile("s_waitcnt vmcnt(0)" ::: "memory");
        } else {
            XB_SPIN(xb_ld(&bar[XB_XGEN(b.x)]) == gen, bar);
            __builtin_amdgcn_fence(__ATOMIC_ACQUIRE, "agent");
            asm volatile("s_waitcnt vmcnt(0)" ::: "memory");
        }
    }
    __syncthreads();
}


__device__ __forceinline__ float dot2bf(unsigned a, unsigned b, float c) { asm("v_dot2c_f32_bf16 %0, %1, %2" : "+v"(c) : "v"(a), "v"(b)); return c; }
__device__ __forceinline__ float dot8bf_dpp(v4u a, v4u b) { float c = 0.f; asm("v_dot2c_f32_bf16 %0, %1, %5\n\tv_dot2c_f32_bf16 %0, %2, %6\n\tv_dot2c_f32_bf16 %0, %3, %7\n\tv_dot2c_f32_bf16 %0, %4, %8\n\ts_nop 1" : "+v"(c) : "v"(a.x), "v"(a.y), "v"(a.z), "v"(a.w), "v"(b.x), "v"(b.y), "v"(b.z), "v"(b.w)); return c; }
#define DPPF(v, ctrl) __int_as_float(__builtin_amdgcn_update_dpp(0, __float_as_int(v), (ctrl), 0xf, 0xf, true))
__device__ __forceinline__ int q8(float x) { int q = (int)__builtin_rintf(x); q = q < -127 ? -127 : (q > 127 ? 127 : q); return q & 0xff; }
__device__ __forceinline__ float wave_sum(float v) {
    v += DPPF(v, 0xB1); v += DPPF(v, 0x4E); v += DPPF(v, 0x141); v += DPPF(v, 0x128);
    { const auto r16 = __builtin_amdgcn_permlane16_swap(__float_as_uint(v), __float_as_uint(v), false, false); v = __uint_as_float(r16[0]) + __uint_as_float(r16[1]); }
    { const auto r32 = __builtin_amdgcn_permlane32_swap(__float_as_uint(v), __float_as_uint(v), false, false); v = __uint_as_float(r32[0]) + __uint_as_float(r32[1]); }
    return v;
}
__device__ __forceinline__ float wave_max(float v) {
    v = fmaxf(v, DPPF(v, 0xB1)); v = fmaxf(v, DPPF(v, 0x4E)); v = fmaxf(v, DPPF(v, 0x141)); v = fmaxf(v, DPPF(v, 0x128));
    { const auto r16 = __builtin_amdgcn_permlane16_swap(__float_as_uint(v), __float_as_uint(v), false, false); v = fmaxf(__uint_as_float(r16[0]), __uint_as_float(r16[1])); }
    { const auto r32 = __builtin_amdgcn_permlane32_swap(__float_as_uint(v), __float_as_uint(v), false, false); v = fmaxf(__uint_as_float(r32[0]), __uint_as_float(r32[1])); }
    return v;
}
__device__ __forceinline__ float gelu_erf(float v) {
    const float av = fabsf(v), d = av * 0.2316418882f + 1.0f;
    const float t = __builtin_amdgcn_rcpf(d);
    float q = t * 0.5307027145f + (-0.7265760135f); q = q * t + 0.7107068705f; q = q * t + (-0.142248368f); q = q * t + 0.127414796f; q = q * t;
    const float e = __builtin_amdgcn_exp2f((v * v) * (-0.72134752044f));
    const float m = v * (q * e);
    return v < 0.f ? m : v - m;
}

struct Args { const float* in[15]; float* out; unsigned char* ws; };

__device__ __forceinline__ int w1_logical_col(int n0p) {
    const int pn = n0p >> 8, blk = (n0p & 255) >> 5, half = blk >> 2, a = blk & 3;
    if (pn <= 3) return pn * 256 + 64 * a + 32 * half;
    if (pn == 4) return (a < 2) ? (1024 + 64 * a + 32 * half) : (1152 + 64 * half + 32 * (a - 2));
    return n0p;
}
template <bool PERMW1> __device__ __forceinline__ void p0_transpose_item(const float* W, int K, int N, bf16* WT, LAS float* scr, int item, int lane) {
    const int nblk = N / 32, kb = item / nblk, nb = item % nblk, k0 = 64 * kb, n0 = 32 * nb; const int ns = PERMW1 ? w1_logical_col(n0) : n0;
    float tv[32];
#pragma unroll
    for (int i = 0; i < 32; ++i) { const int kk = 2 * i + (lane >> 5); tv[i] = W[(size_t)(k0 + kk) * N + ns + (lane & 31)]; }
#pragma unroll
    for (int i = 0; i < 32; ++i) { const int kk = 2 * i + (lane >> 5); scr[kk * 33 + (lane & 31)] = tv[i]; }
    LDS_WAIT(); asm volatile("" ::: "memory");
    const int c = lane & 7;
#pragma unroll
    for (int j = 0; j < 4; ++j) { const int n = (lane >> 3) + 8 * j; const LAS float* s = scr + (8 * c) * 33 + n;
        v4u o; o.x = pk2(s[0 * 33], s[1 * 33]); o.y = pk2(s[2 * 33], s[3 * 33]); o.z = pk2(s[4 * 33], s[5 * 33]); o.w = pk2(s[6 * 33], s[7 * 33]);
        *(GAS v4u*)(WT + (size_t)(n0 + n) * K + k0 + 8 * c) = o; }
    LDS_WAIT(); asm volatile("" ::: "memory");
}
__device__ __forceinline__ void ln_load_f32(f32x4 (&v)[8], const float* xrow, int lane) {
    const GAS f32x4* xr = (const GAS f32x4*)xrow + lane;
#pragma unroll
    for (int j = 0; j < 8; ++j) v[j] = xr[64 * j];
}
__device__ __forceinline__ void ln_row_f32_to_bf16(f32x4 (&v)[8], const float* g, const float* bta, bf16* orow, int lane) {
    float s = 0.f;
#pragma unroll
    for (int j = 0; j < 8; ++j) s += (v[j].x + v[j].y) + (v[j].z + v[j].w);
    const float mean = wave_sum(s) * (1.f / DM); float s2 = 0.f;
#pragma unroll
    for (int j = 0; j < 8; ++j) { v[j] = v[j] - mean; s2 += (v[j].x * v[j].x + v[j].y * v[j].y) + (v[j].z * v[j].z + v[j].w * v[j].w); }
    const float rstd = 1.f / sqrtf(wave_sum(s2) * (1.f / DM) + LN_EPS);
    GAS v2u* o8 = (GAS v2u*)orow + lane;
#pragma unroll
    for (int j = 0; j < 8; ++j) { const f32x4 gg = ((const GAS f32x4*)g)[lane + 64 * j], bb = ((const GAS f32x4*)bta)[lane + 64 * j];
        v2u o; o.x = pk2(v[j].x * rstd * gg.x + bb.x, v[j].y * rstd * gg.y + bb.y); o.y = pk2(v[j].z * rstd * gg.z + bb.z, v[j].w * rstd * gg.w + bb.w); o8[64 * j] = o; }
}
__device__ __forceinline__ void ln_row_f32_to_bf16_q(f32x4 (&v)[8], const float* g, const float* bta, bf16* orow, signed char* qrow, float* qscale, int lane) {
    float s = 0.f;
#pragma unroll
    for (int j = 0; j < 8; ++j) s += (v[j].x + v[j].y) + (v[j].z + v[j].w);
    const float mean = wave_sum(s) * (1.f / DM); float s2 = 0.f;
#pragma unroll
    for (int j = 0; j < 8; ++j) { v[j] = v[j] - mean; s2 += (v[j].x * v[j].x + v[j].y * v[j].y) + (v[j].z * v[j].z + v[j].w * v[j].w); }
    const float rstd = 1.f / sqrtf(wave_sum(s2) * (1.f / DM) + LN_EPS);
    GAS v2u* o8 = (GAS v2u*)orow + lane; float am = 0.f;
#pragma unroll
    for (int j = 0; j < 8; ++j) { const f32x4 gg = ((const GAS f32x4*)g)[lane + 64 * j], bb = ((const GAS f32x4*)bta)[lane + 64 * j];
        v[j].x = v[j].x * rstd * gg.x + bb.x; v[j].y = v[j].y * rstd * gg.y + bb.y; v[j].z = v[j].z * rstd * gg.z + bb.z; v[j].w = v[j].w * rstd * gg.w + bb.w;
        am = fmaxf(am, fmaxf(fmaxf(fabsf(v[j].x), fabsf(v[j].y)), fmaxf(fabsf(v[j].z), fabsf(v[j].w))));
        if (orow) { v2u o; o.x = pk2(v[j].x, v[j].y); o.y = pk2(v[j].z, v[j].w); o8[64 * j] = o; } }
    am = fmaxf(wave_max(am), 1e-20f); const float iq = 127.0f / am;
    if (lane == 0) *qscale = am * (1.0f / 127.0f);
#pragma unroll
    for (int j = 0; j < 8; ++j) ((GAS unsigned*)qrow)[lane + 64 * j] = (unsigned)(q8(v[j].x * iq) | (q8(v[j].y * iq) << 8) | (q8(v[j].z * iq) << 16) | (q8(v[j].w * iq) << 24));
}
__device__ __forceinline__ void w_strip(LAS unsigned char* L, LAS float* red, const float* W, int ld, int ns, signed char* dst, float* sc, int tid) {
    asm volatile("" : "+v"(tid));
    const int kr = tid >> 3, c4 = tid & 7, lane = tid & 63, wave = __builtin_amdgcn_readfirstlane(tid >> 6);
    float mx[4] = {0.f, 0.f, 0.f, 0.f};
    const GAS f32x4* src = (const GAS f32x4*)(W + (size_t)kr * ld + ns) + c4;
#pragma unroll 1
    for (int r0 = 0; r0 < 32; r0 += 16) {
        f32x4 a[16];
#pragma unroll
        for (int i = 0; i < 16; ++i) a[i] = src[(size_t)(64 * (r0 + i)) * (ld / 4)];
#pragma unroll
        for (int i = 0; i < 16; ++i) { const int k = 64 * (r0 + i) + kr; const int so = ((((k >> 3) ^ c4)) << 4) + (k & 7) * 2;
#pragma unroll
            for (int j = 0; j < 4; ++j) { mx[j] = fmaxf(mx[j], fabsf(a[i][j])); *(LAS unsigned short*)(L + (4 * c4 + j) * 4096 + so) = (unsigned short)f2bf(a[i][j]); } }
    }
#pragma unroll
    for (int j = 0; j < 4; ++j) { mx[j] = fmaxf(mx[j], __shfl_xor(mx[j], 8)); mx[j] = fmaxf(mx[j], __shfl_xor(mx[j], 16)); mx[j] = fmaxf(mx[j], __shfl_xor(mx[j], 32)); }
    if (lane < 8) {
#pragma unroll
        for (int j = 0; j < 4; ++j) red[wave * 32 + 4 * c4 + j] = mx[j]; }
    LDS_BAR();
#pragma unroll 1
    for (int nn = 0; nn < 4; ++nn) {
        const int n = 4 * wave + nn; float am = 0.f;
#pragma unroll
        for (int w8 = 0; w8 < 8; ++w8) am = fmaxf(am, red[w8 * 32 + n]);
        am = fmaxf(am, 1e-30f); const float iq = 127.0f / am;
        if (lane == 0) sc[n] = am * (1.0f / 127.0f);
#pragma unroll
        for (int h = 0; h < 2; ++h) { const int run = h * 64 + lane;
            const v4u w0 = *(LAS const v4u*)(L + n * 4096 + (((2 * run) ^ (wave & 7)) << 4)), w1 = *(LAS const v4u*)(L + n * 4096 + (((2 * run + 1) ^ (wave & 7)) << 4));
            v4u o;
            o.x = (unsigned)(q8(bflo(w0.x) * iq) | (q8(bfhi(w0.x) * iq) << 8) | (q8(bflo(w0.y) * iq) << 16) | (q8(bfhi(w0.y) * iq) << 24));
            o.y = (unsigned)(q8(bflo(w0.z) * iq) | (q8(bfhi(w0.z) * iq) << 8) | (q8(bflo(w0.w) * iq) << 16) | (q8(bfhi(w0.w) * iq) << 24));
            o.z = (unsigned)(q8(bflo(w1.x) * iq) | (q8(bfhi(w1.x) * iq) << 8) | (q8(bflo(w1.y) * iq) << 16) | (q8(bfhi(w1.y) * iq) << 24));
            o.w = (unsigned)(q8(bflo(w1.z) * iq) | (q8(bfhi(w1.z) * iq) << 8) | (q8(bflo(w1.w) * iq) << 16) | (q8(bfhi(w1.w) * iq) << 24));
            *(GAS v4u*)(dst + (size_t)n * DM + 16 * run) = o; }
    }
    LDS_BAR();
}
__device__ __forceinline__ void ln_load_bf16(v4u (&w4)[4], const bf16* xrow, int lane) {
    const GAS v4u* xr = (const GAS v4u*)xrow + lane;
#pragma unroll
    for (int j = 0; j < 4; ++j) w4[j] = xr[64 * j];
}
__device__ __forceinline__ void ln_row_bf16_to_bf16(const v4u (&w4)[4], const float* g, const float* bta, bf16* orow, signed char* qrow, float* qscale, int lane) {
    float v[32]; float s = 0.f;
#pragma unroll
    for (int j = 0; j < 4; ++j) { const v4u w = w4[j];
        v[8 * j + 0] = bflo(w.x); v[8 * j + 1] = bfhi(w.x); v[8 * j + 2] = bflo(w.y); v[8 * j + 3] = bfhi(w.y);
        v[8 * j + 4] = bflo(w.z); v[8 * j + 5] = bfhi(w.z); v[8 * j + 6] = bflo(w.w); v[8 * j + 7] = bfhi(w.w); }
#pragma unroll
    for (int i = 0; i < 32; ++i) s += v[i];
    const float mean = wave_sum(s) * (1.f / DM); float s2 = 0.f;
#pragma unroll
    for (int i = 0; i < 32; ++i) { v[i] -= mean; s2 += v[i] * v[i]; }
    const float rstd = 1.f / sqrtf(wave_sum(s2) * (1.f / DM) + LN_EPS);
    GAS v4u* o16 = (GAS v4u*)orow + lane;
#pragma unroll
    for (int j = 0; j < 4; ++j) {
        const GAS f32x4* gp = (const GAS f32x4*)g + 2 * (lane + 64 * j); const GAS f32x4* bp = (const GAS f32x4*)bta + 2 * (lane + 64 * j);
        const f32x4 g0 = gp[0], g1 = gp[1], b0 = bp[0], b1 = bp[1];
        v4u o; o.x = pk2(v[8 * j + 0] * rstd * g0.x + b0.x, v[8 * j + 1] * rstd * g0.y + b0.y); o.y = pk2(v[8 * j + 2] * rstd * g0.z + b0.z, v[8 * j + 3] * rstd * g0.w + b0.w);
        o.z = pk2(v[8 * j + 4] * rstd * g1.x + b1.x, v[8 * j + 5] * rstd * g1.y + b1.y); o.w = pk2(v[8 * j + 6] * rstd * g1.z + b1.z, v[8 * j + 7] * rstd * g1.w + b1.w);
        if (orow) o16[64 * j] = o;
        v[8 * j + 0] = v[8 * j + 0] * rstd * g0.x + b0.x; v[8 * j + 1] = v[8 * j + 1] * rstd * g0.y + b0.y; v[8 * j + 2] = v[8 * j + 2] * rstd * g0.z + b0.z; v[8 * j + 3] = v[8 * j + 3] * rstd * g0.w + b0.w;
        v[8 * j + 4] = v[8 * j + 4] * rstd * g1.x + b1.x; v[8 * j + 5] = v[8 * j + 5] * rstd * g1.y + b1.y; v[8 * j + 6] = v[8 * j + 6] * rstd * g1.z + b1.z; v[8 * j + 7] = v[8 * j + 7] * rstd * g1.w + b1.w; }
    float am = 0.f;
#pragma unroll
    for (int i = 0; i < 32; ++i) am = fmaxf(am, fabsf(v[i]));
    am = wave_max(am);
    am = fmaxf(am, 1e-20f); const float iq = 127.0f / am;
    if (lane == 0) *qscale = am * (1.0f / 127.0f);
#pragma unroll
    for (int j = 0; j < 4; ++j) { v2u w; w.x = (unsigned)(q8(v[8 * j + 0] * iq) | (q8(v[8 * j + 1] * iq) << 8) | (q8(v[8 * j + 2] * iq) << 16) | (q8(v[8 * j + 3] * iq) << 24));
        w.y = (unsigned)(q8(v[8 * j + 4] * iq) | (q8(v[8 * j + 5] * iq) << 8) | (q8(v[8 * j + 6] * iq) << 16) | (q8(v[8 * j + 7] * iq) << 24)); ((GAS v2u*)qrow)[lane + 64 * j] = w; }
}
__device__ __forceinline__ void row_pos(int r, int& pos, int& ipos) {
    if (r < NTOK) { const int s = r & (SEQ - 1); pos = NMETA + s; ipos = s & 127; }
    else { int j = r - NTOK; if (j > NMETA - 1) j = NMETA - 1; pos = j; ipos = 112 + j; }
}
__device__ __forceinline__ float log2_gamma(int h) { return log2f(1.0f - exp2f(-5.0f - (float)h)); }


typedef short bf16x8 __attribute__((ext_vector_type(8)));
typedef short s16x4 __attribute__((ext_vector_type(4)));
#define MFMA16(a, b, c) __builtin_amdgcn_mfma_f32_16x16x32_bf16((a), (b), (c), 0, 0, 0)
__device__ __forceinline__ s16x4 tr16(LAS const unsigned char* p) { return __builtin_bit_cast(s16x4, __builtin_amdgcn_ds_read_tr16_b64_v4i16((LAS s16x4*)p)); }
__device__ __forceinline__ bf16x8 cat8(s16x4 a, s16x4 b) { return __builtin_shufflevector(a, b, 0, 1, 2, 3, 4, 5, 6, 7); }
__device__ __forceinline__ unsigned cvtpk_s(float lo, float hi) { f32x2 v = {lo, hi}; bf16x2_t b = __builtin_convertvector(v, bf16x2_t); return __builtin_bit_cast(unsigned, b); }
__device__ __forceinline__ unsigned cvtpk(float lo, float hi) { unsigned r; asm("v_cvt_pk_bf16_f32 %0, %1, %2" : "=v"(r) : "v"(lo), "v"(hi)); return r; }

__device__ __forceinline__ void scan_unit(LAS unsigned char* L, int u, const bf16* RK, const bf16* RV, bf16* ST, int tid, int lane, int wave) {
    asm volatile("" : "+v"(tid)); lane = tid & 63;
    const int bh = u >> 4, di = (u >> 2) & 3, ei = u & 3, b = bh >> 2, h = bh & 3;
    const float g128 = exp2f(128.0f * log2_gamma(h));
    const int li = lane & 15, g = lane >> 4, q = li >> 2, p4 = li & 3;
    const int eb = wave >> 1, db0 = 2 * (wave & 1);
    f32x4 acc[2]; acc[0] = (f32x4){0.f, 0.f, 0.f, 0.f}; acc[1] = acc[0];
    const int sw = 2 * (((q >> 1) & 1) | ((g & 1) << 1));
    v4u kA[2], vA[2], kB[2], vB[2];
#define SCAN_LOAD(cc, kreg, vreg) do { _Pragma("unroll") for (int i_ = 0; i_ < 2; ++i_) { const int cid_ = tid + 512 * i_, row_ = cid_ >> 3, c16_ = cid_ & 7; \
        int srow_; bool ok_ = true; if ((cc) < 0) { ok_ = row_ >= 112; srow_ = NTOK + (ok_ ? row_ - 112 : 0); } else srow_ = b * SEQ + (cc) * 128 + row_; \
        const v4u kz_ = *(const GAS v4u*)(RK + (size_t)srow_ * 1024 + h * 256 + di * 64 + c16_ * 8), vz_ = *(const GAS v4u*)(RV + (size_t)srow_ * 1024 + h * 256 + ei * 64 + c16_ * 8); \
        kreg[i_] = ok_ ? kz_ : (v4u){0u, 0u, 0u, 0u}; vreg[i_] = ok_ ? vz_ : (v4u){0u, 0u, 0u, 0u}; } } while (0)
#define SCAN_WRITE(bufp, kreg, vreg) do { _Pragma("unroll") for (int i_ = 0; i_ < 2; ++i_) { const int cid_ = tid + 512 * i_, row_ = cid_ >> 3, c16_ = cid_ & 7; \
        const int sw_ = ((row_ >> 1) & 1) | ((row_ >> 2) & 2); const int off_ = row_ * 128 + ((c16_ ^ (2 * sw_)) << 4); \
        *(LAS v4u*)((bufp) + off_) = kreg[i_]; *(LAS v4u*)((bufp) + 16384 + off_) = vreg[i_]; } } while (0)
#define SCAN_FLUSH(c) do { if ((c) >= 0) { const v4u z_ = *(LAS const v4u*)(L + 65536 + ((c) & 1) * 8192 + (tid >> 3) * 128 + (tid & 7) * 16); \
        *(GAS v4u*)(ST + ((size_t)(bh * 32 + (c)) * 256 + 64 * ei + (tid >> 3)) * 256 + 64 * di + (tid & 7) * 8) = z_; } } while (0)
    SCAN_LOAD(-1, kA, vA); SCAN_WRITE(L, kA, vA); SCAN_LOAD(0, kA, vA); SCAN_LOAD(1, kB, vB); LDS_BAR();
    int cur = 0;
    for (int cc = -1; cc <= 29; cc += 2) {
        { LAS const unsigned char* Kt = L + cur * 32768; LAS const unsigned char* Vt = Kt + 16384;
#pragma unroll
          for (int ks = 0; ks < 4; ++ks) { const int r0 = (32 * ks + 8 * g + q) * 128 + 8 * (p4 & 1);
              const bf16x8 a = cat8(tr16(Vt + r0 + (((2 * eb + (p4 >> 1)) ^ sw) << 4)), tr16(Vt + r0 + 512 + (((2 * eb + (p4 >> 1)) ^ sw) << 4)));
#pragma unroll
              for (int n = 0; n < 2; ++n) { const int cn = ((2 * (db0 + n) + (p4 >> 1)) ^ sw) << 4; const bf16x8 bb = cat8(tr16(Kt + r0 + cn), tr16(Kt + r0 + 512 + cn)); acc[n] = MFMA16(a, bb, acc[n]); } }
          SCAN_FLUSH(cc);
#pragma unroll
          for (int n = 0; n < 2; ++n) { acc[n] = acc[n] * g128;
              LAS bf16* op = (LAS bf16*)(L + 65536 + ((cc + 1) & 1) * 8192) + (16 * eb + 4 * g) * 64 + 16 * (db0 + n) + li;
#pragma unroll
              for (int r = 0; r < 4; ++r) op[r * 64] = (bf16)f2bf(acc[n][r]); }
          SCAN_WRITE(L + (cur ^ 1) * 32768, kA, vA);
          if (cc + 3 <= 30) SCAN_LOAD(cc + 3, kA, vA);
          LDS_BAR(); cur ^= 1; }
        { LAS const unsigned char* Kt = L + cur * 32768; LAS const unsigned char* Vt = Kt + 16384;
#pragma unroll
          for (int ks = 0; ks < 4; ++ks) { const int r0 = (32 * ks + 8 * g + q) * 128 + 8 * (p4 & 1);
              const bf16x8 a = cat8(tr16(Vt + r0 + (((2 * eb + (p4 >> 1)) ^ sw) << 4)), tr16(Vt + r0 + 512 + (((2 * eb + (p4 >> 1)) ^ sw) << 4)));
#pragma unroll
              for (int n = 0; n < 2; ++n) { const int cn = ((2 * (db0 + n) + (p4 >> 1)) ^ sw) << 4; const bf16x8 bb = cat8(tr16(Kt + r0 + cn), tr16(Kt + r0 + 512 + cn)); acc[n] = MFMA16(a, bb, acc[n]); } }
          SCAN_FLUSH(cc + 1);
#pragma unroll
          for (int n = 0; n < 2; ++n) { acc[n] = acc[n] * g128;
              LAS bf16* op = (LAS bf16*)(L + 65536 + ((cc + 2) & 1) * 8192) + (16 * eb + 4 * g) * 64 + 16 * (db0 + n) + li;
#pragma unroll
              for (int r = 0; r < 4; ++r) op[r * 64] = (bf16)f2bf(acc[n][r]); }
          if (cc + 2 <= 30) SCAN_WRITE(L + (cur ^ 1) * 32768, kB, vB);
          if (cc + 4 <= 30) SCAN_LOAD(cc + 4, kB, vB);
          LDS_BAR(); cur ^= 1; }
    }
    SCAN_FLUSH(31);
    LDS_BAR();
#undef SCAN_LOAD
#undef SCAN_WRITE
#undef SCAN_FLUSH
}

__device__ __forceinline__ void retout_unit(LAS unsigned char* L, int u, bf16* QR, const bf16* RK, const bf16* RV, const bf16* RG, const bf16* ST, int tid, int lane, int wave) {
    asm volatile("" : "+v"(tid)); lane = tid & 63;
    const int bh = u >> 5, c = u & 31, b = bh >> 2, h = bh & 3;
    const int R0 = b * SEQ + c * 128;
    const int li = lane & 15, g = lane >> 4, q = li >> 2, p4 = li & 3;
    LAS unsigned char* RA = L; LAS unsigned char* RB = L + 65536;
#pragma unroll
    for (int i = 0; i < 8; ++i) { const int cid = tid + 512 * i, j = cid >> 5, ch = cid & 31;
        const v4u kz = *(const GAS v4u*)(RK + (size_t)(R0 + j) * 1024 + h * 256 + ch * 8), vz = *(const GAS v4u*)(RV + (size_t)(R0 + j) * 1024 + h * 256 + ch * 8);
        *(LAS v4u*)(RA + j * 512 + ((ch ^ (j & 15)) << 4)) = kz; *(LAS v4u*)(RB + j * 512 + ((ch ^ ((j & 7) << 1)) << 4)) = vz; }
    bf16x8 qf[8];
    { const GAS v4u* qp = (const GAS v4u*)(QR + (size_t)(R0 + 16 * wave + li) * 2048 + 1024 + h * 256 + 8 * g);
#pragma unroll
      for (int ks = 0; ks < 8; ++ks) qf[ks] = __builtin_bit_cast(bf16x8, qp[4 * ks]); }
#define RO_LOAD_ST(s0) do { _Pragma("unroll") for (int i_ = 0; i_ < 8; ++i_) { const int cid_ = tid + 512 * i_, sl_ = cid_ >> 11, e_ = (cid_ >> 3) & 255, ch_ = cid_ & 7; \
        stg[i_] = *(const GAS v4u*)(Sg + (size_t)e_ * 256 + 64 * ((s0) + sl_) + ch_ * 8); } } while (0)
#define RO_WRITE_ST(dst) do { _Pragma("unroll") for (int i_ = 0; i_ < 8; ++i_) { const int cid_ = tid + 512 * i_, sl_ = cid_ >> 11, e_ = (cid_ >> 3) & 255, ch_ = cid_ & 7; \
        *(LAS v4u*)((dst) + sl_ * 32768 + e_ * 128 + ((ch_ ^ (e_ & 7)) << 4)) = stg[i_]; } } while (0)
    const bf16* Sg = ST + (size_t)(bh * 32 + c) * 65536; v4u stg[8];
    __syncthreads();
    RO_LOAD_ST(0);
    f32x4 st[8];
#pragma unroll
    for (int jt = 0; jt < 8; ++jt) st[jt] = (f32x4){0.f, 0.f, 0.f, 0.f};
#pragma unroll
    for (int jt = 0; jt < 8; ++jt) if (jt <= wave) {
        const int j = 16 * jt + li;
#pragma unroll
        for (int ks = 0; ks < 8; ++ks) { const bf16x8 a = *(LAS const bf16x8*)(RA + j * 512 + (((4 * ks + g) ^ li) << 4)); st[jt] = MFMA16(a, qf[ks], st[jt]); }
        if (jt == wave) {
#pragma unroll
            for (int r = 0; r < 4; ++r) if (4 * g + r > li) st[jt][r] = 0.f; }
    }
    bf16x8 pf[4];
#pragma unroll
    for (int s = 0; s < 4; ++s) { v4u w; w.x = cvtpk_s(st[2 * s][0], st[2 * s][1]); w.y = cvtpk_s(st[2 * s][2], st[2 * s][3]); w.z = cvtpk_s(st[2 * s + 1][0], st[2 * s + 1][1]); w.w = cvtpk_s(st[2 * s + 1][2], st[2 * s + 1][3]); pf[s] = __builtin_bit_cast(bf16x8, w); }
    __syncthreads();
    RO_WRITE_ST(RA); RO_LOAD_ST(2);
    f32x4 o[16];
#pragma unroll
    for (int et = 0; et < 16; ++et) o[et] = (f32x4){0.f, 0.f, 0.f, 0.f};
#pragma unroll
    for (int s = 0; s < 4; ++s) if (2 * s <= wave) {
        const int r1 = 32 * s + 4 * g + q, r2 = r1 + 16;
#pragma unroll
        for (int et = 0; et < 16; ++et) {
            const int chn = 2 * et + (p4 >> 1);
            const bf16x8 a = cat8(tr16(RB + r1 * 512 + ((chn ^ ((r1 & 7) << 1)) << 4) + (p4 & 1) * 8), tr16(RB + r2 * 512 + ((chn ^ ((r2 & 7) << 1)) << 4) + (p4 & 1) * 8));
            o[et] = MFMA16(a, pf[s], o[et]);
        }
    }
    __syncthreads();
    RO_WRITE_ST(RB);
#define RO_STATE_MMA(src, s0) do { _Pragma("unroll") for (int sl_ = 0; sl_ < 2; ++sl_) _Pragma("unroll") for (int k2_ = 0; k2_ < 2; ++k2_) _Pragma("unroll") for (int et = 0; et < 16; ++et) { \
        const int e_ = 16 * et + li; const bf16x8 a_ = *(LAS const bf16x8*)((src) + sl_ * 32768 + e_ * 128 + (((4 * k2_ + g) ^ (e_ & 7)) << 4)); \
        o[et] = MFMA16(a_, qf[2 * ((s0) + sl_) + k2_], o[et]); } } while (0)
    RO_STATE_MMA(RA, 0);
    __syncthreads();
    RO_STATE_MMA(RB, 2);
#undef RO_LOAD_ST
#undef RO_WRITE_ST
#undef RO_STATE_MMA
    float s1 = 0.f;
#pragma unroll
    for (int et = 0; et < 16; ++et) s1 += (o[et][0] + o[et][1]) + (o[et][2] + o[et][3]);
    s1 += __shfl_xor(s1, 16); s1 += __shfl_xor(s1, 32);
    const float mu = s1 * (1.0f / 256.0f); float s2 = 0.f;
#pragma unroll
    for (int et = 0; et < 16; ++et) { o[et] = o[et] - mu; s2 += (o[et][0] * o[et][0] + o[et][1] * o[et][1]) + (o[et][2] * o[et][2] + o[et][3] * o[et][3]); }
    s2 += __shfl_xor(s2, 16); s2 += __shfl_xor(s2, 32);
    const float rstd = 1.0f / sqrtf(s2 * (1.0f / 256.0f) + GN_EPS);
    const int row = R0 + 16 * wave + li;
    const GAS v2u* gp = (const GAS v2u*)(RG + (size_t)row * 1024 + h * 256 + 4 * g); GAS v2u* op = (GAS v2u*)(QR + (size_t)row * 2048 + 1024 + h * 256 + 4 * g);
#pragma unroll
    for (int et = 0; et < 16; ++et) { const v2u gz = gp[4 * et]; v2u w;
        w.x = cvtpk(o[et][0] * rstd * bflo(gz.x), o[et][1] * rstd * bfhi(gz.x)); w.y = cvtpk(o[et][2] * rstd * bflo(gz.y), o[et][3] * rstd * bfhi(gz.y)); op[4 * et] = w; }
    __syncthreads();
}

typedef float f32x16 __attribute__((ext_vector_type(16)));
#define MFMA32(a, b, c) __builtin_amdgcn_mfma_f32_32x32x16_bf16((a), (b), (c), 0, 0, 0)
__device__ __forceinline__ int crow32(int reg, int hh) { return (reg & 3) + 8 * (reg >> 2) + 4 * hh; }

__device__ __forceinline__ void attn_unit(LAS unsigned char* L, int u, bf16* QR, const bf16* KA, const bf16* VA, const float* sinks, int tid, int lane, int wave) {
    asm volatile("" : "+v"(tid)); lane = tid & 63;
    const int b = u >> 6, j = (u >> 1) & 31, g2 = u & 1, hq = 8 * g2 + wave;
    const int R0 = b * SEQ + 128 * j;
    LAS unsigned char* Kt = L; LAS unsigned char* Vt = L + 32768;
#pragma unroll
    for (int i = 0; i < 4; ++i) { const int cid = tid + 512 * i, kk = cid >> 3, ch = cid & 7;
        int srow; bool ok = true;
        if (kk >= 128) srow = R0 + kk - 128; else if (j > 0) srow = R0 - 128 + kk; else { ok = kk >= 112; srow = NTOK + (ok ? kk - 112 : 0); }
        const v4u kz = *(const GAS v4u*)(KA + (size_t)srow * 128 + g2 * 64 + ch * 8), vz = *(const GAS v4u*)(VA + (size_t)srow * 128 + g2 * 64 + ch * 8);
        *(LAS v4u*)(Kt + kk * 128 + ((ch ^ (kk & 7)) << 4)) = ok ? kz : (v4u){0u, 0u, 0u, 0u};
        *(LAS v4u*)(Vt + kk * 128 + (ch << 4)) = ok ? vz : (v4u){0u, 0u, 0u, 0u}; }
    __syncthreads();
    const int r = lane & 31, hh = lane >> 5, blk = (lane >> 4) & 1, q = (lane & 15) >> 2, p4 = lane & 3;
    const float sk = sinks[hq] * LOG2E;
    v4u qn[4];
    { const GAS v4u* qp = (const GAS v4u*)(QR + (size_t)(R0 + r) * 2048 + hq * 64 + 8 * hh);
#pragma unroll
      for (int ks = 0; ks < 4; ++ks) qn[ks] = qp[2 * ks]; }
#pragma unroll 1
    for (int t = 0; t < 4; ++t) {
        const int i0 = 32 * t;
        bf16x8 qf[4];
#pragma unroll
        for (int ks = 0; ks < 4; ++ks) qf[ks] = __builtin_bit_cast(bf16x8, qn[ks]);
        if (t < 3) { const GAS v4u* qp = (const GAS v4u*)(QR + (size_t)(R0 + i0 + 32 + r) * 2048 + hq * 64 + 8 * hh);
#pragma unroll
          for (int ks = 0; ks < 4; ++ks) qn[ks] = qp[2 * ks]; }
        f32x16 s[5];
#pragma unroll
        for (int x = 0; x < 5; ++x) {
            const int krow_ = 32 * (t + x) + r;
            f32x16 acc;
#pragma unroll
            for (int e = 0; e < 16; ++e) acc[e] = 0.f;
#pragma unroll
            for (int ks = 0; ks < 4; ++ks) { const bf16x8 a = *(LAS const bf16x8*)(Kt + krow_ * 128 + (((2 * ks + hh) ^ (krow_ & 7)) << 4)); acc = MFMA32(a, qf[ks], acc); }
            s[x] = acc; __builtin_amdgcn_sched_barrier(0);
        }
        float m = sk;
#pragma unroll
        for (int e = 0; e < 16; ++e) { const int cr = crow32(e, hh);
            if (!(cr > r)) s[0][e] = -1.0e30f;
            if (!(cr <= r)) s[4][e] = -1.0e30f; }
        if (j == 0) {
#pragma unroll
            for (int x = 0; x < 4; ++x) if (t + x <= 3) {
#pragma unroll
                for (int e = 0; e < 16; ++e) if (32 * (t + x) + crow32(e, hh) < 112) s[x][e] = -1.0e30f; }
        }
#pragma unroll
        for (int x = 0; x < 5; ++x)
#pragma unroll
            for (int e = 0; e < 16; ++e) m = fmaxf(m, s[x][e]);
        m = fmaxf(m, __shfl_xor(m, 32));
        float l = 0.f;
#pragma unroll
        for (int x = 0; x < 5; ++x)
#pragma unroll
            for (int e = 0; e < 16; ++e) { const float pv = exp2f(s[x][e] - m); s[x][e] = pv; l += pv; }
        l += __shfl_xor(l, 32);
        l += exp2f(sk - m);
        f32x16 o[2];
#pragma unroll
        for (int e = 0; e < 16; ++e) { o[0][e] = 0.f; o[1][e] = 0.f; }
#pragma unroll
        for (int x = 0; x < 5; ++x)
#pragma unroll
            for (int st = 0; st < 2; ++st) {
                v4u w; w.x = cvtpk_s(s[x][8 * st + 0], s[x][8 * st + 1]); w.y = cvtpk_s(s[x][8 * st + 2], s[x][8 * st + 3]); w.z = cvtpk_s(s[x][8 * st + 4], s[x][8 * st + 5]); w.w = cvtpk_s(s[x][8 * st + 6], s[x][8 * st + 7]);
                const bf16x8 pb = __builtin_bit_cast(bf16x8, w);
                const int k1 = 32 * (t + x) + 16 * st + 4 * hh + q, k2 = k1 + 8;
#pragma unroll
                for (int dc = 0; dc < 2; ++dc) {
                    const int cb = ((4 * dc + 2 * blk + (p4 >> 1)) << 4) + 8 * (p4 & 1);
                    const bf16x8 a = cat8(tr16(Vt + k1 * 128 + cb), tr16(Vt + k2 * 128 + cb));
                    o[dc] = MFMA32(a, pb, o[dc]);
                }
                __builtin_amdgcn_sched_barrier(0);
            }
        const float il = 1.0f / l;
        GAS v2u* op = (GAS v2u*)(QR + (size_t)(R0 + i0 + r) * 2048 + hq * 64 + 4 * hh);
#pragma unroll
        for (int dc = 0; dc < 2; ++dc)
#pragma unroll
            for (int g4 = 0; g4 < 4; ++g4) { v2u w; w.x = cvtpk_s(o[dc][4 * g4 + 0] * il, o[dc][4 * g4 + 1] * il); w.y = cvtpk_s(o[dc][4 * g4 + 2] * il, o[dc][4 * g4 + 3] * il); op[8 * dc + 2 * g4] = w; }
    }
    __syncthreads();
}

__device__ __forceinline__ unsigned ord_key(float f) { const unsigned u = __float_as_uint(f); return u ^ ((unsigned)((int)u >> 31) | 0x80000000u); }
__device__ __forceinline__ float ord_val(unsigned k) { return __uint_as_float(k ^ (((int)k < 0) ? 0x80000000u : 0xffffffffu)); }
__device__ __forceinline__ unsigned umed3(unsigned a, unsigned b, unsigned c) { unsigned r; asm("v_med3_u32 %0, %1, %2, %3" : "=v"(r) : "v"(a), "v"(b), "v"(c)); return r; }
#define TK_INS(arr, val) do { const unsigned v_ = (val); _Pragma("unroll") for (int j_ = 15; j_ >= 1; --j_) arr[j_] = umed3(arr[j_ - 1], arr[j_], v_); arr[0] = arr[0] > v_ ? arr[0] : v_; } while (0)
__device__ __forceinline__ void topk_unit(LAS unsigned* Lw, LAS const unsigned char* Lsk, int tt, int hd, const bf16* Q3, unsigned short* IDS, float* GATES, int lane) {
    asm volatile("" : "+v"(lane));
    const int r = lane & 31, hh = lane >> 5, t0 = tt * 32;
    float sv[2][16];
#pragma unroll
    for (int p = 0; p < 2; ++p) {
        f32x16 acc[4];
#pragma unroll
        for (int nt = 0; nt < 4; ++nt)
#pragma unroll
            for (int e = 0; e < 16; ++e) acc[nt][e] = 0.f;
        const GAS v4u* qp = (const GAS v4u*)(Q3 + (size_t)(t0 + r) * DM + hd * 256 + p * 128 + 8 * hh);
        bf16x8 bq[8];
#pragma unroll
        for (int ks = 0; ks < 8; ++ks) bq[ks] = __builtin_bit_cast(bf16x8, qp[2 * ks]);
#pragma unroll
        for (int ks = 0; ks < 8; ++ks) {
#pragma unroll
            for (int nt = 0; nt < 4; ++nt) { const bf16x8 a = *(LAS const bf16x8*)(Lsk + p * 32768 + (32 * nt + r) * 256 + (((2 * ks + hh) ^ (r & 15)) << 4)); acc[nt] = MFMA32(a, bq[ks], acc[nt]); } }
        unsigned tk[16];
#pragma unroll
        for (int j2 = 0; j2 < 16; ++j2) tk[j2] = 0u;
#pragma unroll
        for (int nt = 0; nt < 4; ++nt)
#pragma unroll
            for (int e = 0; e < 16; ++e) { const int n = 32 * nt + crow32(e, hh); TK_INS(tk, (ord_key(acc[nt][e]) & 0xffffff80u) | (unsigned)(127 - n)); }
        unsigned pk[16];
#pragma unroll
        for (int j2 = 0; j2 < 16; ++j2) pk[j2] = (unsigned)__shfl_xor((int)tk[j2], 32);
#pragma unroll
        for (int j2 = 0; j2 < 16; ++j2) TK_INS(tk, pk[j2]);
#pragma unroll
        for (int j2 = 0; j2 < 16; ++j2) { sv[p][j2] = ord_val(tk[j2] & 0xffffff80u); Lw[(p * 16 + j2) * 64 + lane] = 127u - (tk[j2] & 0x7fu); }
    }
    unsigned fk[16];
#pragma unroll
    for (int j2 = 0; j2 < 16; ++j2) fk[j2] = 0u;
#pragma unroll
    for (int i = 0; i < 16; ++i)
#pragma unroll
        for (int j2 = 0; j2 < 16; ++j2) if ((i + 1) * (j2 + 1) <= 16) TK_INS(fk, (ord_key(sv[0][i] + sv[1][j2]) & 0xffffff00u) | (unsigned)(255 - (16 * i + j2)));
    float ev[16]; int idv[16]; float den = 0.f; const float f0 = ord_val(fk[0] & 0xffffff00u);
    LDS_WAIT();
#pragma unroll
    for (int k = 0; k < 16; ++k) { const unsigned idx = 255u - (fk[k] & 0xffu); const unsigned i1 = Lw[(idx >> 4) * 64 + lane], i2 = Lw[(16 + (idx & 15u)) * 64 + lane];
        idv[k] = (int)(i1 * 128u + i2); ev[k] = __expf(ord_val(fk[k] & 0xffffff00u) - f0); den += ev[k]; }
    const float iden = 1.0f / den;
    if (hh == 0) {
        GAS v4u* ip = (GAS v4u*)(IDS + (size_t)(t0 + r) * 128 + hd * 16); GAS f32x4* gp = (GAS f32x4*)(GATES + (size_t)(t0 + r) * 128 + hd * 16);
#pragma unroll
        for (int k8 = 0; k8 < 2; ++k8) ip[k8] = (v4u){(unsigned)idv[8 * k8] | ((unsigned)idv[8 * k8 + 1] << 16), (unsigned)idv[8 * k8 + 2] | ((unsigned)idv[8 * k8 + 3] << 16), (unsigned)idv[8 * k8 + 4] | ((unsigned)idv[8 * k8 + 5] << 16), (unsigned)idv[8 * k8 + 6] | ((unsigned)idv[8 * k8 + 7] << 16)};
#pragma unroll
        for (int k4 = 0; k4 < 4; ++k4) gp[k4] = (f32x4){ev[4 * k4] * iden, ev[4 * k4 + 1] * iden, ev[4 * k4 + 2] * iden, ev[4 * k4 + 3] * iden};
    }
    LDS_WAIT();
}

constexpr int TAB_NQ = 16384 * DM / 4, TAB_CHQ = 4096, TAB_NCH = 2 * TAB_NQ / TAB_CHQ, TAB_SLOT_CHUNKS = 3;
template <int UNR> __device__ __forceinline__ void tab_chunk(int ch, const float* u_tab, const float* v_tab, void* UT, void* VT, int lane) {
    const int which = ch >= TAB_NCH / 2; const float sc = which ? V_QSCALE : U_QSCALE;
    const GAS f32x4* src = (const GAS f32x4*)(which ? v_tab : u_tab) + (size_t)(ch - which * (TAB_NCH / 2)) * TAB_CHQ + lane;
    GAS unsigned char* dstb = (GAS unsigned char*)(which ? VT : UT);
    const int i4b = (ch - which * (TAB_NCH / 2)) * TAB_CHQ + lane;
#pragma unroll 1
    for (int it = 0; it < TAB_CHQ / 64; it += UNR) {
        f32x4 a[UNR];
#pragma unroll
        for (int u8 = 0; u8 < UNR; ++u8) a[u8] = src[(it + u8) * 64];
#pragma unroll
        for (int u8 = 0; u8 < UNR; ++u8) { const int i4 = i4b + (it + u8) * 64; const int row = i4 >> 9, q4 = i4 & 511;
            const int w = q8(a[u8].x * sc) | (q8(a[u8].y * sc) << 8) | (q8(a[u8].z * sc) << 16) | (q8(a[u8].w * sc) << 24);
            *(GAS unsigned*)(dstb + ((size_t)(q4 >> 5) * 16384 + row) * 128 + (q4 & 31) * 4) = (unsigned)w; }
    }
}
struct TabHook {
    gu32* q; const float* u_tab; const float* v_tab; void* UT; void* VT; int slot;
    __device__ __forceinline__ void operator()(int ui) const {
        if (ui != slot) return;
        int lane = threadIdx.x; asm volatile("" : "+v"(lane)); lane &= 63;
#pragma unroll 1
        for (int n = 0; n < TAB_SLOT_CHUNKS; ++n) {
            int ch = 0; if (lane == 0) ch = (int)__hip_atomic_fetch_add((unsigned*)q, 1u, __ATOMIC_RELAXED, __HIP_MEMORY_SCOPE_AGENT);
            ch = __builtin_amdgcn_readfirstlane(ch); if (ch >= TAB_NCH) return;
            tab_chunk<16>(ch, u_tab, v_tab, UT, VT, lane);
        }
    }
};

__global__ void __launch_bounds__(NWAVES * 64, 2) mk_fwd(Args args) {
    extern __shared__ __attribute__((aligned(16))) unsigned char lds[];
    LAS unsigned char* L = (LAS unsigned char*)lds;
    volatile LAS unsigned* MISC = (volatile LAS unsigned*)(L + MISC_OFF);
    const int tid = threadIdx.x, lane = tid & 63, wave = __builtin_amdgcn_readfirstlane(tid >> 6);
    const int G = gridDim.x, bx = blockIdx.x;
    const int vcu = (G % 8 == 0) ? (bx % 8) * (G / 8) + bx / 8 : bx;
    unsigned char* ws = args.ws;
    gu32* ctl = (gu32*)(ws + WS_CTL);
    const float* x = args.in[0]; const float* meta = args.in[1]; const float* ln_in_g = args.in[2]; const float* ln_in_b = args.in[3];
    const float* w_in = args.in[4]; const float* sinks = args.in[5]; const float* w_out = args.in[6]; const float* ln_mix_g = args.in[7]; const float* ln_mix_b = args.in[8];
    const float* wq = args.in[9]; const float* subkeys = args.in[10]; const float* u_tab = args.in[11]; const float* v_tab = args.in[12];
    const float* ln_ffn_g = args.in[13]; const float* ln_ffn_b = args.in[14];
    float* out = args.out;
    bf16* W1T = (bf16*)(ws + WS_W1T); bf16* W2T = (bf16*)(ws + WS_W2T); bf16* W3T = (bf16*)(ws + WS_W3T);
    bf16* H0 = (bf16*)(ws + WS_H0); bf16* QR = (bf16*)(ws + WS_QR); bf16* KA = (bf16*)(ws + WS_KA); bf16* VA = (bf16*)(ws + WS_VA);
    bf16* RK = (bf16*)(ws + WS_RK); bf16* RV = (bf16*)(ws + WS_RV); bf16* RG = (bf16*)(ws + WS_RG);
    bf16* Y = (bf16*)(ws + WS_Y); bf16* H1 = (bf16*)(ws + WS_H1); bf16* Q3 = (bf16*)(ws + WS_QR);
    bf16* STB = (bf16*)(ws + WS_ST);
    unsigned short* IDS = (unsigned short*)(ws + WS_IDS); float* GATES = (float*)(ws + WS_GATES);
    bf16* SKB = (bf16*)(ws + WS_SK);
    signed char* H1Q = (signed char*)(ws + WS_RG); float* HSC = (float*)(ws + WS_HSC);
    bf16* UT = (bf16*)(ws + WS_UT); bf16* VT = (bf16*)(ws + WS_VT);
    signed char* H0Q = (signed char*)(ws + WS_H0Q); signed char* W1Q = (signed char*)(ws + WS_W1Q); signed char* W3Q = (signed char*)(ws + WS_W3Q);
    float* H0S = (float*)(ws + WS_H0S); float* WS1 = (float*)(ws + WS_WS1); float* WS3 = (float*)(ws + WS_WS3);

    for (int u = tid; u < (LDS_BYTES - LDSCTL_OFF) / 4; u += NWAVES * 64) ((LAS unsigned*)(L + LDSCTL_OFF))[u] = 0u;
    __syncthreads();
    XcdBarrier bar; bar.bar = (unsigned*)(ctl + CW_BAR); bar.x = xb_xcc_id(); bar.st = MISC + 8;
    if (tid == 0) MISC[10] = xb_add(&bar.bar[XB_XCNT(bar.x)], 1u);
#define GRID_BAR() xcd_barrier(bar)
    const int gw = vcu * NWAVES + wave, NGW = G * NWAVES;
    const int gt = gw * 64 + lane, NGT = NGW * 64;

    {
        int lane = threadIdx.x; asm volatile("" : "+v"(lane)); lane &= 63; const int gt = gw * 64 + lane;
        LAS float* scr = (LAS float*)(L + RING_OFF + wave * 16384);
        constexpr int I_2 = (DM / 64) * (DM / 32);
        for (int sx = bx; sx < IN_COLS / 32 + DM / 32; sx += G) {
            if (sx < IN_COLS / 32) w_strip(L + RING_OFF, (LAS float*)(L + LDSCTL_OFF + 4096), w_in, IN_COLS, w1_logical_col(32 * sx), W1Q + (size_t)32 * sx * DM, WS1 + 32 * sx, tid);
            else { const int s3 = sx - IN_COLS / 32; w_strip(L + RING_OFF, (LAS float*)(L + LDSCTL_OFF + 4096), wq, DM, 32 * s3, W3Q + (size_t)32 * s3 * DM, WS3 + 32 * s3, tid); }
        }
#pragma unroll 1
        for (int pass = 0; pass < 2; ++pass) {
          if ((pass ^ (wave & 1)) == 0) {
        for (int it = gw; it < I_2; it += NGW) p0_transpose_item<false>(w_out, DM, DM, W2T, scr, it, lane);
          } else {
        {
            f32x4 va[8], vn[8];
            int m = gw; if (m < NVALID) ln_load_f32(va, m < NTOK ? x + (size_t)m * DM : meta + (size_t)(m - NTOK) * DM, lane);
            for (; m < MROWS; m += NGW) {
                const int mn = m + NGW; if (mn < NVALID) ln_load_f32(vn, mn < NTOK ? x + (size_t)mn * DM : meta + (size_t)(mn - NTOK) * DM, lane);
                if (m < NVALID) ln_row_f32_to_bf16_q(va, ln_in_g, ln_in_b, nullptr, H0Q + (size_t)m * DM, H0S + m, lane);
                else { GAS v4u* oq = (GAS v4u*)(H0Q + (size_t)m * DM) + lane;
                    oq[0] = (v4u){0u, 0u, 0u, 0u}; oq[64] = (v4u){0u, 0u, 0u, 0u}; if (lane == 0) H0S[m] = 0.f; }
#pragma unroll
                for (int j = 0; j < 8; ++j) va[j] = vn[j];
            }
        }
          }
        }
        for (int e = gt; e < 16 * 128 * 128 / 8; e += NGT) { const GAS f32x4* src = (const GAS f32x4*)subkeys + 2 * (size_t)e; const f32x4 a = src[0], b2 = src[1];
            v4u o; o.x = pk2(a.x, a.y); o.y = pk2(a.z, a.w); o.z = pk2(b2.x, b2.y); o.w = pk2(b2.z, b2.w); ((GAS v4u*)SKB)[e] = o; }
    }
    GRID_BAR();

    {
        pg8::Gemm g{(const bf16*)H0Q, (const bf16*)W1Q, MROWS, IN_COLS, DM / 2, H0S, WS1}; pg8::StaticOrder S; S.init(MROWS, IN_COLS, G, bx, 5);
        pg8::EpiProj E{QR, KA, VA, RK, RV, RG, QSCALE};
        const int nwg1 = (MROWS / 256) * (IN_COLS / 256), T1 = (nwg1 + G - 1) / G, c0 = nwg1 - (T1 - 1) * G;
        TabHook Hk{ctl + CW_TABQ, u_tab, v_tab, (void*)UT, (void*)VT, (bx >= c0 && T1 > 2) ? (bx - c0) % (T1 - 2) : -1};
        pg8::gemm_phase<pg8::EpiProj, pg8::StaticOrder, true, true, TabHook, true>(L + RING_OFF, g, S, E, Hk);
    }
    {
        for (;;) {
            int ch = 0; if (lane == 0) ch = (int)__hip_atomic_fetch_add((unsigned*)(ctl + CW_TABQ), 1u, __ATOMIC_RELAXED, __HIP_MEMORY_SCOPE_AGENT);
            ch = __builtin_amdgcn_readfirstlane(ch); if (ch >= TAB_NCH) break;
            tab_chunk<8>(ch, u_tab, v_tab, (void*)UT, (void*)VT, lane);
        }
    }
    GRID_BAR();

    for (int u = bx; u < 256; u += G) attn_unit(L + RING_OFF, u, QR, KA, VA, sinks, tid, lane, wave);

    for (int u = bx; u < 256; u += G) scan_unit(L + RING_OFF, u, RK, RV, STB, tid, lane, wave);
    GRID_BAR();

    for (int u = bx; u < 512; u += G) retout_unit(L + RING_OFF, u, QR, RK, RV, RG, STB, tid, lane, wave);
    GRID_BAR();

    {
        pg8::Gemm g{QR, W2T, NTOK, DM, DM}; pg8::StaticOrder S; S.init(NTOK, DM, G, bx);
        pg8::EpiGen<1> E{Y, DM, nullptr, ALPHA, H0Q, H0S, nullptr, nullptr, nullptr, nullptr, nullptr, nullptr};
        pg8::gemm_phase<pg8::EpiGen<1>, pg8::StaticOrder, true, true>(L + RING_OFF, g, S, E);
    }
    GRID_BAR();

    { int l5 = threadIdx.x; asm volatile("" : "+v"(l5)); l5 &= 63;
      v4u wa[4], wn[4]; int m = gw; if (m < NTOK) ln_load_bf16(wa, Y + (size_t)m * DM, l5);
      for (; m < NTOK; m += NGW) { const int mn = m + NGW; if (mn < NTOK) ln_load_bf16(wn, Y + (size_t)mn * DM, l5);
          ln_row_bf16_to_bf16(wa, ln_mix_g, ln_mix_b, nullptr, H1Q + (size_t)m * DM, HSC + m, l5);
#pragma unroll
          for (int j = 0; j < 4; ++j) wa[j] = wn[j]; } }
    GRID_BAR();

    {
        pg8::Gemm g{(const bf16*)H1Q, (const bf16*)W3Q, NTOK, DM, DM / 2, HSC, WS3}; pg8::StaticOrder S; S.init(NTOK, DM, G, bx);
        pg8::EpiGen<2> E{Q3, DM, nullptr, 0.f, nullptr, nullptr, nullptr, nullptr, nullptr, nullptr};
        pg8::gemm_phase<pg8::EpiGen<2>, pg8::StaticOrder, true, true, pg8::NoHook, true>(L + RING_OFF, g, S, E);
    }
    GRID_BAR();

    const bool g8 = (G & 7) == 0; const int nbh = g8 ? (G >> 3) : G, hb = g8 ? (bx >> 3) : bx;
    for (int hd = g8 ? (bx & 7) : 0; hd < 8; hd += g8 ? 8 : 1) {
        __syncthreads();
#pragma unroll
        for (int i = 0; i < 8; ++i) { const int cid = tid + 512 * i, p = cid >> 11, n = (cid >> 4) & 127, ch = cid & 15;
            *(LAS v4u*)(L + RING_OFF + p * 32768 + n * 256 + ((ch ^ (n & 15)) << 4)) = *(const GAS v4u*)(SKB + ((size_t)((hd * 2 + p) * 128 + n)) * 128 + ch * 8); }
        __syncthreads();
        for (int tt = hb * NWAVES + wave; tt < NTOK / 32; tt += nbh * NWAVES) topk_unit((LAS unsigned*)(L + RING_OFF + 65536 + wave * 8192), L + RING_OFF, tt, hd, Q3, IDS, GATES, lane);
    }
    __syncthreads();
    GRID_BAR();

    int nx = 0, xr = 0, nloc = 1;
    { unsigned* bw = (unsigned*)(ctl + CW_BAR);
#pragma unroll
      for (unsigned j2 = 0; j2 < 16; ++j2) { const unsigned cnt = xb_ld(&bw[XB_XCNT(j2)]); nx += cnt > 0u; xr += (j2 < bar.x && cnt > 0u); if (j2 == bar.x) nloc = (int)cnt; }
      nx = __builtin_amdgcn_readfirstlane(nx); xr = __builtin_amdgcn_readfirstlane(xr); nloc = __builtin_amdgcn_readfirstlane(nloc); if (nx < 1) nx = 1; if (nloc < 1) nloc = 1; }
    const int lrank = __builtin_amdgcn_readfirstlane((int)MISC[10]);
    const int wv = lrank * NWAVES + wave, nwv = nloc * NWAVES;
    float* DOTX = (float*)(ws + WS_RK);
    signed char* CB8 = (signed char*)(ws + WS_KA); float* CSC = (float*)(ws + WS_CSC);
    bf16* YB = (bf16*)(ws + WS_H0);
    {
        int tl = tid; asm volatile("" : "+v"(tl)); const int ln = tl & 63, k = ln >> 3, c8 = ln & 7;
        const unsigned char* UT8 = (const unsigned char*)UT;
        for (int s = xr; s < NSL; s += nx) {
            const unsigned char* Us = UT8 + (size_t)s * 16384 * 128;
            const bool first = (s == xr);
            v4u nid[2][2];
#pragma unroll
            for (int z = 0; z < 2; ++z) { const int tz = wv + z * nwv; const int tc = tz < NTOK ? tz : wv; const GAS v4u* ip = (const GAS v4u*)(IDS + (size_t)tc * 128 + 16 * k);
#pragma unroll
                for (int i = 0; i < 2; ++i) nid[z][i] = ip[i]; }
#pragma unroll 1
            for (int t = wv; t < NTOK; t += 2 * nwv) {
                const bool vB = (t + nwv) < NTOK; const int tt[2] = {t, vB ? t + nwv : t};
                v4u ub[2][16]; v4u hs[2]; int old[2][2];
#pragma unroll
                for (int z = 0; z < 2; ++z) {
#pragma unroll
                    for (int i = 0; i < 16; ++i) { const int pe = 2 * (i & 7) + (i >> 3); const unsigned eid = (nid[z][pe >> 3][(pe >> 1) & 3] >> (16 * (pe & 1))) & 0xffffu; ub[z][i] = *(const GAS v4u*)(Us + (size_t)eid * 128 + 16 * c8); }
                    hs[z] = *(const GAS v4u*)(H1Q + (size_t)tt[z] * DM + 128 * s + 16 * c8); }
#pragma unroll
                for (int z = 0; z < 2; ++z) { const v2u ov = first ? (v2u){0u, 0u} : *(const GAS v2u*)(DOTX + ((size_t)xr * NTOK + tt[z]) * 128 + 2 * ln); old[z][0] = (int)ov.x; old[z][1] = (int)ov.y; }
#pragma unroll
                for (int z = 0; z < 2; ++z) { const int tz = t + (2 + z) * nwv; const int tc = tz < NTOK ? tz : t; const GAS v4u* ip = (const GAS v4u*)(IDS + (size_t)tc * 128 + 16 * k);
#pragma unroll
                    for (int i = 0; i < 2; ++i) nid[z][i] = ip[i]; }
#pragma unroll
                for (int z = 0; z < 2; ++z) {
                    int p[16];
#pragma unroll
                    for (int i = 0; i < 16; ++i) { int d = 0;
                        d = __builtin_amdgcn_sdot4((int)ub[z][i].x, (int)hs[z].x, d, false); d = __builtin_amdgcn_sdot4((int)ub[z][i].y, (int)hs[z].y, d, false);
                        d = __builtin_amdgcn_sdot4((int)ub[z][i].z, (int)hs[z].z, d, false); d = __builtin_amdgcn_sdot4((int)ub[z][i].w, (int)hs[z].w, d, false); p[i] = d; }
                    const bool b0 = (c8 & 1) != 0, b1 = (c8 & 2) != 0, b2 = (c8 & 4) != 0;
                    int r1[8], r2[4], q0, q1;
#define DPPI(v, ctrl) __builtin_amdgcn_update_dpp(0, (v), (ctrl), 0xf, 0xf, true)
#pragma unroll
                    for (int m = 0; m < 8; ++m) { const int keep = b0 ? p[2 * m + 1] : p[2 * m], give = b0 ? p[2 * m] : p[2 * m + 1]; r1[m] = keep + DPPI(give, 0xB1); }
#pragma unroll
                    for (int m = 0; m < 4; ++m) { const int keep = b1 ? r1[2 * m + 1] : r1[2 * m], give = b1 ? r1[2 * m] : r1[2 * m + 1]; r2[m] = keep + DPPI(give, 0x4E); }
                    { const int keep = b2 ? r2[1] : r2[0], give = b2 ? r2[0] : r2[1]; const int gl = DPPI(give, 0x104), gr = DPPI(give, 0x114); q0 = keep + (b2 ? gr : gl); }
                    { const int keep = b2 ? r2[3] : r2[2], give = b2 ? r2[2] : r2[3]; const int gl = DPPI(give, 0x104), gr = DPPI(give, 0x114); q1 = keep + (b2 ? gr : gl); }
#undef DPPI
                    if (z == 0 || vB) *(GAS v2u*)(DOTX + ((size_t)xr * NTOK + tt[z]) * 128 + 2 * ln) = (v2u){(unsigned)(q0 + old[z][0]), (unsigned)(q1 + old[z][1])};
                }
            }
        }
    }
    GRID_BAR();
    for (int i8 = gt; i8 < NTOK * 16; i8 += NGT) {
        const size_t gi = (size_t)i8 * 8; v4u a0 = {0u, 0u, 0u, 0u}, a1 = a0;
        for (int xx = 0; xx < nx; ++xx) { const GAS v4u* dp = (const GAS v4u*)((const int*)DOTX + (size_t)xx * NTOK * 128 + gi); const v4u p0 = dp[0], p1 = dp[1]; a0 += p0; a1 += p1; }
        const GAS f32x4* gp = (const GAS f32x4*)(GATES + gi); const f32x4 g0 = gp[0], g1 = gp[1];
        const float sc = HSC[i8 >> 4] * (1.0f / U_QSCALE);
        float c[8];
        c[0] = g0.x * gelu_erf((float)(int)a0.x * sc); c[1] = g0.y * gelu_erf((float)(int)a0.y * sc); c[2] = g0.z * gelu_erf((float)(int)a0.z * sc); c[3] = g0.w * gelu_erf((float)(int)a0.w * sc);
        c[4] = g1.x * gelu_erf((float)(int)a1.x * sc); c[5] = g1.y * gelu_erf((float)(int)a1.y * sc); c[6] = g1.z * gelu_erf((float)(int)a1.z * sc); c[7] = g1.w * gelu_erf((float)(int)a1.w * sc);
        float am = 0.f;
#pragma unroll
        for (int j2 = 0; j2 < 8; ++j2) am = fmaxf(am, fabsf(c[j2]));
        am = fmaxf(am, DPPF(am, 0xB1)); am = fmaxf(am, DPPF(am, 0x4E)); am = fmaxf(am, DPPF(am, 0x141)); am = fmaxf(am, DPPF(am, 0x128));
        am = fmaxf(am, 1e-30f); const float iq = 127.0f / am;
        v2u o; o.x = (unsigned)(q8(c[0] * iq) | (q8(c[1] * iq) << 8) | (q8(c[2] * iq) << 16) | (q8(c[3] * iq) << 24)); o.y = (unsigned)(q8(c[4] * iq) | (q8(c[5] * iq) << 8) | (q8(c[6] * iq) << 16) | (q8(c[7] * iq) << 24));
        *(GAS v2u*)(CB8 + gi) = o;
        if ((i8 & 15) == 0) CSC[i8 >> 4] = am * (1.0f / (127.0f * V_QSCALE));
    }
    GRID_BAR();
    {
        int tl = tid; asm volatile("" : "+v"(tl)); const int ln = tl & 63, k = ln >> 3, c8 = ln & 7;
        const unsigned char* VT8 = (const unsigned char*)VT;
        for (int s = xr; s < NSL; s += nx) {
            const unsigned char* Vs = VT8 + (size_t)s * 16384 * 128;
            v4u nid[2][2];
#pragma unroll
            for (int z = 0; z < 2; ++z) { const int tz = wv + z * nwv; const int tc = tz < NTOK ? tz : wv; const GAS v4u* ip = (const GAS v4u*)(IDS + (size_t)tc * 128 + 16 * k);
#pragma unroll
                for (int i = 0; i < 2; ++i) nid[z][i] = ip[i]; }
#pragma unroll 1
            for (int t = wv; t < NTOK; t += 2 * nwv) {
                const bool vB = (t + nwv) < NTOK; const int tt[2] = {t, vB ? t + nwv : t};
                v4u vb[2][16]; v4u cf[2]; unsigned hs[2]; float scl[2], hsc[2];
#pragma unroll
                for (int z = 0; z < 2; ++z) {
#pragma unroll
                    for (int i = 0; i < 16; ++i) { const unsigned eid = (nid[z][i >> 3][(i >> 1) & 3] >> (16 * (i & 1))) & 0xffffu; vb[z][i] = *(const GAS v4u*)(Vs + (size_t)eid * 128 + 16 * c8); } }
#pragma unroll
                for (int z = 0; z < 2; ++z) { hs[z] = *(const GAS unsigned short*)(H1Q + (size_t)tt[z] * DM + 128 * s + 16 * c8 + 2 * k); hsc[z] = ALPHA * HSC[tt[z]];
                    cf[z] = *(const GAS v4u*)(CB8 + (size_t)tt[z] * 128 + 16 * k); scl[z] = CSC[tt[z]]; }
#pragma unroll
                for (int z = 0; z < 2; ++z) { const int tz = t + (2 + z) * nwv; const int tc = tz < NTOK ? tz : t; const GAS v4u* ip = (const GAS v4u*)(IDS + (size_t)tc * 128 + 16 * k);
#pragma unroll
                    for (int i = 0; i < 2; ++i) nid[z][i] = ip[i]; }
#pragma unroll
                for (int z = 0; z < 2; ++z) {
                    int ai[16];
#pragma unroll
                    for (int q2 = 0; q2 < 16; ++q2) ai[q2] = 0;
#pragma unroll
                    for (int ig = 0; ig < 4; ++ig) { const int cq = (int)cf[z][ig];
#pragma unroll
                        for (int dw = 0; dw < 4; ++dw) {
                            const unsigned d0 = vb[z][4 * ig][dw], d1 = vb[z][4 * ig + 1][dw], d2 = vb[z][4 * ig + 2][dw], d3 = vb[z][4 * ig + 3][dw];
                            const unsigned p0 = __builtin_amdgcn_perm(d1, d0, 0x05010400u), p1 = __builtin_amdgcn_perm(d1, d0, 0x07030602u), p2 = __builtin_amdgcn_perm(d3, d2, 0x05010400u), p3 = __builtin_amdgcn_perm(d3, d2, 0x07030602u);
                            ai[4 * dw + 0] = __builtin_amdgcn_sdot4((int)__builtin_amdgcn_perm(p2, p0, 0x05040100u), cq, ai[4 * dw + 0], false);
                            ai[4 * dw + 1] = __builtin_amdgcn_sdot4((int)__builtin_amdgcn_perm(p2, p0, 0x07060302u), cq, ai[4 * dw + 1], false);
                            ai[4 * dw + 2] = __builtin_amdgcn_sdot4((int)__builtin_amdgcn_perm(p3, p1, 0x05040100u), cq, ai[4 * dw + 2], false);
                            ai[4 * dw + 3] = __builtin_amdgcn_sdot4((int)__builtin_amdgcn_perm(p3, p1, 0x07060302u), cq, ai[4 * dw + 3], false); } }
                    const bool kb0 = (k & 1) != 0, kb1 = (k & 2) != 0, kb2 = (k & 4) != 0;
                    int rAx[4], rAy[4], rBx[2], rBy[2], rCx, rCy;
#define DPPI(v, ctrl) __builtin_amdgcn_update_dpp(0, (v), (ctrl), 0xf, 0xf, true)
#pragma unroll
                    for (int m = 0; m < 4; ++m) { const int kx = kb0 ? ai[4 * m + 2] : ai[4 * m], ky = kb0 ? ai[4 * m + 3] : ai[4 * m + 1], gx = kb0 ? ai[4 * m] : ai[4 * m + 2], gy = kb0 ? ai[4 * m + 1] : ai[4 * m + 3];
                        rAx[m] = kx + DPPI(gx, 0x128); rAy[m] = ky + DPPI(gy, 0x128); }
#pragma unroll
                    for (int m = 0; m < 2; ++m) { const int kx = kb1 ? rAx[2 * m + 1] : rAx[2 * m], ky = kb1 ? rAy[2 * m + 1] : rAy[2 * m], gx = kb1 ? rAx[2 * m] : rAx[2 * m + 1], gy = kb1 ? rAy[2 * m] : rAy[2 * m + 1];
                        const auto sx = __builtin_amdgcn_permlane16_swap((unsigned)gx, (unsigned)gx, false, false), sy = __builtin_amdgcn_permlane16_swap((unsigned)gy, (unsigned)gy, false, false);
                        rBx[m] = kx + (int)(kb1 ? sx[0] : sx[1]); rBy[m] = ky + (int)(kb1 ? sy[0] : sy[1]); }
                    { const int kx = kb2 ? rBx[1] : rBx[0], ky = kb2 ? rBy[1] : rBy[0], gx = kb2 ? rBx[0] : rBx[1], gy = kb2 ? rBy[0] : rBy[1];
                        const auto sx = __builtin_amdgcn_permlane32_swap((unsigned)gx, (unsigned)gx, false, false), sy = __builtin_amdgcn_permlane32_swap((unsigned)gy, (unsigned)gy, false, false);
                        rCx = kx + (int)(kb2 ? sx[0] : sx[1]); rCy = ky + (int)(kb2 ? sy[0] : sy[1]); }
#undef DPPI
                    if (z == 0 || vB) *(GAS unsigned*)(YB + (size_t)tt[z] * DM + 128 * s + 16 * c8 + 2 * k) = cvtpk_s((float)rCx * scl[z] + hsc[z] * (float)(int)(signed char)(hs[z] & 0xffu), (float)rCy * scl[z] + hsc[z] * (float)(int)(signed char)(hs[z] >> 8));
                }
            }
        }
    }
    GRID_BAR();
    v4u wa[4], wn[4]; if (gw < NTOK) ln_load_bf16(wa, YB + (size_t)gw * DM, lane);
    for (int m = gw; m < NTOK; m += NGW) {
        { const int mn = m + NGW; if (mn < NTOK) ln_load_bf16(wn, YB + (size_t)mn * DM, lane); }
        float v[32]; float sm = 0.f;
#pragma unroll
        for (int j2 = 0; j2 < 4; ++j2) { const v4u w = wa[j2];
            v[8 * j2 + 0] = bflo(w.x); v[8 * j2 + 1] = bfhi(w.x); v[8 * j2 + 2] = bflo(w.y); v[8 * j2 + 3] = bfhi(w.y); v[8 * j2 + 4] = bflo(w.z); v[8 * j2 + 5] = bfhi(w.z); v[8 * j2 + 6] = bflo(w.w); v[8 * j2 + 7] = bfhi(w.w); }
#pragma unroll
        for (int i = 0; i < 32; ++i) sm += v[i];
        const float mean = wave_sum(sm) * (1.f / DM); float s2 = 0.f;
#pragma unroll
        for (int i = 0; i < 32; ++i) { v[i] -= mean; s2 += v[i] * v[i]; }
        const float rstd = 1.f / sqrtf(wave_sum(s2) * (1.f / DM) + LN_EPS);
#pragma unroll
        for (int j2 = 0; j2 < 4; ++j2) {
            const GAS f32x4* gp = (const GAS f32x4*)ln_ffn_g + 2 * (lane + 64 * j2); const GAS f32x4* bp = (const GAS f32x4*)ln_ffn_b + 2 * (lane + 64 * j2);
            const f32x4 g0 = gp[0], g1 = gp[1], b0 = bp[0], b1 = bp[1];
            GAS f32x4* op = (GAS f32x4*)(out + (size_t)m * DM) + 2 * (lane + 64 * j2);
            op[0] = (f32x4){v[8 * j2 + 0] * rstd * g0.x + b0.x, v[8 * j2 + 1] * rstd * g0.y + b0.y, v[8 * j2 + 2] * rstd * g0.z + b0.z, v[8 * j2 + 3] * rstd * g0.w + b0.w};
            op[1] = (f32x4){v[8 * j2 + 4] * rstd * g1.x + b1.x, v[8 * j2 + 5] * rstd * g1.y + b1.y, v[8 * j2 + 6] * rstd * g1.z + b1.z, v[8 * j2 + 7] * rstd * g1.w + b1.w}; }
#pragma unroll
        for (int j2 = 0; j2 < 4; ++j2) wa[j2] = wn[j2];
    }
}

extern "C" void kernel_launch(void* const* d_in, const int* in_sizes, int n_in, void* d_out, int out_size, void* d_ws, size_t ws_size, hipStream_t stream) {
    static int grid = 0;
    if (grid == 0) {
        if (n_in != 15 || out_size != NTOK * DM || ws_size < WS_END) { fprintf(stderr, "kernel_launch: unexpected shapes (n_in %d out %d ws %zu)\n", n_in, out_size, ws_size); grid = -1; return; }
        int dev = 0, cus = 0, per_cu = 0;
        if (hipGetDevice(&dev) != hipSuccess || hipDeviceGetAttribute(&cus, hipDeviceAttributeMultiprocessorCount, dev) != hipSuccess) { grid = -1; return; }
        if (hipFuncSetAttribute((const void*)mk_fwd, hipFuncAttributeMaxDynamicSharedMemorySize, LDS_BYTES) != hipSuccess) { fprintf(stderr, "kernel_launch: hipFuncSetAttribute failed\n"); grid = -1; return; }
        if (hipOccupancyMaxActiveBlocksPerMultiprocessor(&per_cu, (const void*)mk_fwd, NWAVES * 64, LDS_BYTES) != hipSuccess || per_cu < 1) { fprintf(stderr, "kernel_launch: occupancy query says %d\n", per_cu); }
        (void)hipGetLastError();
        grid = cus;
    }
    if (grid < 0) return;
    if (hipMemsetAsync((char*)d_ws + WS_CTL, 0, CTL_ZERO_BYTES, stream) != hipSuccess) return;
    Args a{};
    for (int i = 0; i < 15; ++i) a.in[i] = (const float*)d_in[i];
    a.out = (float*)d_out; a.ws = (unsigned char*)d_ws;
    hipLaunchKernelGGL(mk_fwd, dim3(grid), dim3(NWAVES * 64), LDS_BYTES, stream, a);
}
```

```cpp
#include <hip/hip_runtime.h>
#include <cstdio>
#include <cstdint>
#include <cmath>
namespace pg8 {
#define PG8_LAS __attribute__((address_space(3)))
typedef unsigned short bf16_t;
typedef short bf16x8 __attribute__((ext_vector_type(8)));
typedef float f32x4 __attribute__((ext_vector_type(4)));
typedef unsigned u32x4 __attribute__((ext_vector_type(4)));
constexpr int BM = 256, BK = 64, HALF = 128, HTB = HALF * BK * 2  , STAGE_BYTES = 8 * HTB, NXCD = 8, WGM = 4;

__host__ __device__ __forceinline__ int lds_byte(int r, int c) { const int st = (r >> 4) * 2 + (c >> 5), rr = r & 15, cc = c & 31, ob = rr * 64 + cc * 2; return st * 1024 + (ob ^ (((ob >> 9) & 1) << 5)); }
__host__ __device__ __forceinline__ void stage_rc(int b, int& R, int& C) { const int st = b / 1024, sb = b % 1024, swz = sb ^ (((sb >> 9) & 1) << 5); R = (st >> 1) * 16 + swz / 64; C = (st & 1) * 32 + (swz % 64) / 2; }
__host__ __device__ __forceinline__ int perm32(int rho) { const int n = rho >> 4, i = rho & 15; return 8 * (i >> 2) + 4 * n + (i & 3); }

struct Unit { int pm, pn; };
struct Gemm { const bf16_t* A; const bf16_t* Bt; int M, N, K; const float* rs; const float* cs; float ascale = 1.0f; };
typedef int i32x4 __attribute__((ext_vector_type(4)));
typedef int i32x8 __attribute__((ext_vector_type(8)));

struct StaticOrder {
    int nM, nN, nwg, G, c, wgm;
    __host__ __device__ void init(int M, int N, int G_, int c_, int wgm_ = WGM) { nM = M / BM; nN = N / BM; nwg = nM * nN; G = G_; c = c_; wgm = wgm_; }
    __host__ __device__ bool next(int i, Unit& u) const {
        const long L = (long)i * G + c; if (L >= nwg) return false;
        int wgid = (int)L; { const int q = nwg / NXCD, r = nwg % NXCD, xcd = wgid % NXCD, off = wgid / NXCD; wgid = (xcd < r ? xcd * (q + 1) : r * (q + 1) + (xcd - r) * q) + off; }
        const int nig = wgm * nN, gid = wgid / nig, fm = gid * wgm, gsz = (nM - fm) < wgm ? (nM - fm) : wgm;
        u.pm = fm + ((wgid % nig) % gsz); u.pn = (wgid % nig) / gsz; return true;
    }
    __device__ __forceinline__ void a_ready(const Unit&) const {}
    __device__ __forceinline__ void done(const Unit&) const {}
};

__device__ __forceinline__ unsigned cvt_pk_bf16(float lo, float hi) { unsigned r; asm volatile("v_cvt_pk_bf16_f32 %0, %1, %2" : "=v"(r) : "v"(lo), "v"(hi)); return r; }
typedef float f32x2 __attribute__((ext_vector_type(2)));

template <int MODE> struct EpiGen {
    static constexpr bool PERM = true, AFTER_DRAIN = false;
    bf16_t* O; int ldc; const bf16_t* R; float alpha;
    const signed char* R8 = nullptr; const float* RS = nullptr;
    bf16_t *QR, *KA, *VA, *RK, *RV, *RG;
    __device__ __forceinline__ void operator()(const f32x4 (&acc)[2][2][4][2], const Unit& u, int wr, int wc, int fr, int fq) const {
        const int row0 = u.pm * BM + wr * 64 + fr;
#pragma unroll
        for (int bj = 0; bj < 2; ++bj) {
            const int col = u.pn * BM + bj * HALF + wc * 32 + 8 * fq;
            bf16_t* base = O; int ld = ldc; int cc = col;
            if (MODE == 0) {
                if (col < 1024)      { base = QR; ld = 2048; cc = col; }
                else if (col < 1152) { base = KA; ld = 128;  cc = col - 1024; }
                else if (col < 1280) { base = VA; ld = 128;  cc = col - 1152; }
                else if (col < 2304) { base = QR; ld = 2048; cc = col - 1280 + 1024; }
                else if (col < 3328) { base = RK; ld = 1024; cc = col - 2304; }
                else if (col < 4352) { base = RV; ld = 1024; cc = col - 3328; }
                else                 { base = RG; ld = 1024; cc = col - 4352; }
            }
#pragma unroll
            for (int ai = 0; ai < 2; ++ai)
#pragma unroll
                for (int m = 0; m < 4; ++m) {
                    const int row = row0 + ai * HALF + m * 16;
                    f32x4 v0 = acc[ai][bj][m][0], v1 = acc[ai][bj][m][1];
                    if (MODE == 1) {
                        const unsigned long long rr = *(const unsigned long long*)(R8 + (size_t)row * ldc + col);
                        const unsigned r0 = (unsigned)rr ^ 0x80808080u, r1 = (unsigned)(rr >> 32) ^ 0x80808080u;
                        const float as = alpha * RS[row], ab = -128.0f * as;
                        v0[0] += (float)(r0 & 0xffu) * as + ab; v0[1] += (float)((r0 >> 8) & 0xffu) * as + ab; v0[2] += (float)((r0 >> 16) & 0xffu) * as + ab; v0[3] += (float)(r0 >> 24) * as + ab;
                        v1[0] += (float)(r1 & 0xffu) * as + ab; v1[1] += (float)((r1 >> 8) & 0xffu) * as + ab; v1[2] += (float)((r1 >> 16) & 0xffu) * as + ab; v1[3] += (float)(r1 >> 24) * as + ab;
                    }
                    u32x4 w; w.x = cvt_pk_bf16(v0[0], v0[1]); w.y = cvt_pk_bf16(v0[2], v0[3]); w.z = cvt_pk_bf16(v1[0], v1[1]); w.w = cvt_pk_bf16(v1[2], v1[3]);
                    *(u32x4*)(base + (size_t)row * ld + cc) = w;
                }
        }
    }
};

struct EpiProj {
    static constexpr bool PERM = true, AFTER_DRAIN = false;
    bf16_t *QR, *KA, *VA, *RK, *RV, *RG; float qscale;
    __device__ __forceinline__ void operator()(const f32x4 (&acc)[2][2][4][2], const Unit& u, int wr, int wc, int fr, int fq) const {
        const int pn = u.pn, row0 = u.pm * BM + wr * 64 + fr, c0 = wc * 32 + 8 * fq;
        const bool rope = (pn <= 3) || (pn == 4 && wc < 2) || (pn >= 5 && pn <= 12);
        if (rope) {
            const bool ret = pn >= 5; const int h = ret ? ((pn - 5) & 3) : 0;
            const float lg = __builtin_amdgcn_logf(1.0f - __builtin_amdgcn_exp2f(-5.0f - (float)h));
            float invrev[8];
#pragma unroll
            for (int i8 = 0; i8 < 8; ++i8) { const float ii = (float)((ret ? c0 : 8 * fq) + i8); invrev[i8] = 0.15915494309189535f * __builtin_amdgcn_exp2f(-ii * (ret ? 0.10381025296523008f : 0.4152410118609203f)); }
            bf16_t* base; int ld, cA, cB;
            if (pn <= 3)      { base = QR; ld = 2048; cA = pn * 256 + 64 * wc + 8 * fq; cB = cA + 32; }
            else if (pn == 4) { base = KA; ld = 128;  cA = 64 * wc + 8 * fq; cB = cA + 32; }
            else if (pn <= 8) { base = QR; ld = 2048; cA = 1024 + 256 * h + c0; cB = cA + 128; }
            else              { base = RK; ld = 1024; cA = 256 * h + c0; cB = cA + 128; }
#pragma unroll
            for (int ai = 0; ai < 2; ++ai)
#pragma unroll
                for (int m = 0; m < 4; ++m) {
                    const int row = row0 + ai * HALF + m * 16;
                    int pos, ipos;
                    if (row < 16384) { const int s = row & 4095; pos = 16 + s; ipos = s & 127; } else { int j = row - 16384; if (j > 15) j = 15; pos = j; ipos = 112 + j; }
                    float sc = qscale;
                    if (pn == 4) sc = 1.0f; else if (pn >= 9) sc = 0.0625f * __builtin_amdgcn_exp2f(-(float)(ipos + 1) * lg); else if (pn >= 5) sc = __builtin_amdgcn_exp2f((float)(ipos + 1) * lg);
                    const float pf = (float)pos;
                    float cs[8], sn[8];
#pragma unroll
                    for (int i8 = 0; i8 < 8; ++i8) { const float rev = __builtin_amdgcn_fractf(pf * invrev[i8]); cs[i8] = __builtin_amdgcn_cosf(rev); sn[i8] = __builtin_amdgcn_sinf(rev); }
                    const f32x4 a0 = acc[ai][0][m][0], a1 = acc[ai][0][m][1], b0 = acc[ai][1][m][0], b1 = acc[ai][1][m][1];
                    u32x4 wA, wB;
                    wA.x = cvt_pk_bf16((a0[0] * cs[0] - b0[0] * sn[0]) * sc, (a0[1] * cs[1] - b0[1] * sn[1]) * sc); wA.y = cvt_pk_bf16((a0[2] * cs[2] - b0[2] * sn[2]) * sc, (a0[3] * cs[3] - b0[3] * sn[3]) * sc);
                    wA.z = cvt_pk_bf16((a1[0] * cs[4] - b1[0] * sn[4]) * sc, (a1[1] * cs[5] - b1[1] * sn[5]) * sc); wA.w = cvt_pk_bf16((a1[2] * cs[6] - b1[2] * sn[6]) * sc, (a1[3] * cs[7] - b1[3] * sn[7]) * sc);
                    wB.x = cvt_pk_bf16((b0[0] * cs[0] + a0[0] * sn[0]) * sc, (b0[1] * cs[1] + a0[1] * sn[1]) * sc); wB.y = cvt_pk_bf16((b0[2] * cs[2] + a0[2] * sn[2]) * sc, (b0[3] * cs[3] + a0[3] * sn[3]) * sc);
                    wB.z = cvt_pk_bf16((b1[0] * cs[4] + a1[0] * sn[4]) * sc, (b1[1] * cs[5] + a1[1] * sn[5]) * sc); wB.w = cvt_pk_bf16((b1[2] * cs[6] + a1[2] * sn[6]) * sc, (b1[3] * cs[7] + a1[3] * sn[7]) * sc);
                    *(u32x4*)(base + (size_t)row * ld + cA) = wA; *(u32x4*)(base + (size_t)row * ld + cB) = wB;
                }
        } else {
            const bool silu = pn >= 17;
#pragma unroll
            for (int bj = 0; bj < 2; ++bj) {
                bf16_t* base; int ld, cc;
                if (pn == 4)       { base = VA; ld = 128;  cc = 64 * bj + 32 * (wc - 2) + 8 * fq; }
                else if (pn <= 16) { base = RV; ld = 1024; cc = 256 * (pn - 13) + 128 * bj + c0; }
                else               { base = RG; ld = 1024; cc = 256 * (pn - 17) + 128 * bj + c0; }
#pragma unroll
                for (int ai = 0; ai < 2; ++ai)
#pragma unroll
                    for (int m = 0; m < 4; ++m) {
                        const int row = row0 + ai * HALF + m * 16;
                        f32x4 v0 = acc[ai][bj][m][0], v1 = acc[ai][bj][m][1];
                        if (silu) {
#pragma unroll
                            for (int e = 0; e < 4; ++e) { v0[e] = v0[e] * __builtin_amdgcn_rcpf(1.0f + __builtin_amdgcn_exp2f(-1.4426950408889634f * v0[e])); v1[e] = v1[e] * __builtin_amdgcn_rcpf(1.0f + __builtin_amdgcn_exp2f(-1.4426950408889634f * v1[e])); } }
                        u32x4 w; w.x = cvt_pk_bf16(v0[0], v0[1]); w.y = cvt_pk_bf16(v0[2], v0[3]); w.z = cvt_pk_bf16(v1[0], v1[1]); w.w = cvt_pk_bf16(v1[2], v1[3]);
                        *(u32x4*)(base + (size_t)row * ld + cc) = w;
                    }
            }
        }
    }
};
struct NoHook { __device__ __forceinline__ void operator()(int) const {} };
template <class Epi, class Sched, bool ALIGN_EPI = false, bool SP2 = false, class Hook = NoHook, bool I8 = false, bool F8 = false>
__device__ __forceinline__ void gemm_phase(PG8_LAS unsigned char* lds, const Gemm g, const Sched& S, const Epi& E, const Hook& H = Hook()) {
    int tid_ = threadIdx.x; asm volatile("" : "+v"(tid_));
    const int tid = tid_, wid = __builtin_amdgcn_readfirstlane(tid >> 6), lane = tid & 63, wr = wid >> 2, wc = wid & 3, fr = lane & 15, fq = lane >> 4;
    const int K = g.K, nt = K / BK;
    unsigned voffA[2], voffB[2];
#pragma unroll
    for (int i = 0; i < 2; ++i) { int R, C; stage_rc(tid * 16 + i * 8192, R, C); const int Rb = Epi::PERM ? ((R & ~31) + perm32(R & 31)) : R;
        voffA[i] = (unsigned)(R * K + C) * 2u; voffB[i] = (unsigned)(Rb * K + C) * 2u; }
    const size_t kstep = (size_t)(BK * 2);
    const size_t hstep = (size_t)HALF * K * 2;
    const size_t tstep = 2 * hstep;
    const unsigned ldsw = (unsigned)wid * 1024u;
    const int aoff = lds_byte(wr * 64 + fr, fq * 8), boff = lds_byte(wc * 32 + fr, fq * 8);
#define PG8_SA(b, h) (((b) * 2 + (h)) * HTB)
#define PG8_SB(b, h) ((4 + (b) * 2 + (h)) * HTB)
#define PG8_STAGE(bufoff, gbase, voff) do { _Pragma("unroll") for (int _i = 0; _i < 2; ++_i) { unsigned vo_ = (voff)[_i]; if constexpr (F8) asm volatile("" : "+v"(vo_)); \
        __builtin_amdgcn_global_load_lds((const unsigned*)((const char*)(gbase) + vo_), (PG8_LAS unsigned*)(lds + (bufoff) + ldsw + _i * 8192), 16, 0, 0); } } while (0)
#define PG8_LDA(dst, b, h) do { _Pragma("unroll") for (int m = 0; m < 4; ++m) _Pragma("unroll") for (int k = 0; k < 2; ++k) dst[m][k] = *(const PG8_LAS bf16x8*)(lds + PG8_SA(b, h) + aoff + m * 2048 + k * 1024); } while (0)
#define PG8_LDB(dst, b, h) do { _Pragma("unroll") for (int n = 0; n < 2; ++n) _Pragma("unroll") for (int k = 0; k < 2; ++k) dst[n][k] = *(const PG8_LAS bf16x8*)(lds + PG8_SB(b, h) + boff + n * 2048 + k * 1024); } while (0)
#define PG8_CAT8(x) __builtin_shufflevector(__builtin_bit_cast(i32x4, (x)[0]), __builtin_bit_cast(i32x4, (x)[1]), 0, 1, 2, 3, 4, 5, 6, 7)
#define PG8_MMA(ai, bj, At, Bt) do { __builtin_amdgcn_s_setprio(1); if constexpr (F8) { _Pragma("unroll") for (int m = 0; m < 4; ++m) _Pragma("unroll") for (int n = 0; n < 2; ++n) \
        acc[ai][bj][m][n] = __builtin_amdgcn_mfma_scale_f32_16x16x128_f8f6f4(PG8_CAT8(Bt[n]), PG8_CAT8(At[m]), acc[ai][bj][m][n], 0, 0, 0, 0x7f7f7f7f, 0, 0x7f7f7f7f); } else \
    _Pragma("unroll") for (int m = 0; m < 4; ++m) _Pragma("unroll") for (int n = 0; n < 2; ++n) _Pragma("unroll") for (int k = 0; k < 2; ++k) \
        { if constexpr (I8) acc[ai][bj][m][n] = __builtin_bit_cast(f32x4, __builtin_amdgcn_mfma_i32_16x16x64_i8(__builtin_bit_cast(i32x4, Bt[n][k]), __builtin_bit_cast(i32x4, At[m][k]), __builtin_bit_cast(i32x4, acc[ai][bj][m][n]), 0, 0, 0)); \
          else acc[ai][bj][m][n] = __builtin_amdgcn_mfma_f32_16x16x32_bf16(Bt[n][k], At[m][k], acc[ai][bj][m][n], 0, 0, 0); } __builtin_amdgcn_s_setprio(0); } while (0)
#define PG8_WAIT_V(n) asm volatile("s_waitcnt vmcnt(" #n ")" ::: "memory")
#define PG8_WAIT_L(n) asm volatile("s_waitcnt lgkmcnt(" #n ")" ::: "memory")
#define PG8_BAR __builtin_amdgcn_s_barrier()
#define PG8_SCHED __builtin_amdgcn_sched_barrier(0)
    Unit cur, nxt; int ui = 0;
    if (!S.next(0, cur)) return;
    f32x4 acc[2][2][4][2];
#pragma unroll
    for (int a = 0; a < 2; ++a)
#pragma unroll
        for (int b = 0; b < 2; ++b)
#pragma unroll
            for (int m = 0; m < 4; ++m)
#pragma unroll
                for (int n = 0; n < 2; ++n) acc[a][b][m][n] = (f32x4){0.f, 0.f, 0.f, 0.f};
    bf16x8 At[4][2], B0[2][2], B1[2][2];
    const char* cA = (const char*)g.A + (size_t)cur.pm * tstep; const char* cB = (const char*)g.Bt + (size_t)cur.pn * tstep;
    S.a_ready(cur);
    if constexpr (SP2) {
        PG8_STAGE(PG8_SB(0, 0), cB, voffB); PG8_STAGE(PG8_SB(0, 1), cB + hstep, voffB); PG8_STAGE(PG8_SA(0, 0), cA, voffA); PG8_STAGE(PG8_SA(0, 1), cA + hstep, voffA);
        if (wr == 1) PG8_BAR;
        PG8_WAIT_V(2); PG8_BAR;
        PG8_STAGE(PG8_SB(1, 0), cB + kstep, voffB); PG8_STAGE(PG8_SA(1, 0), cA + kstep, voffA); PG8_STAGE(PG8_SB(1, 1), cB + hstep + kstep, voffB);
        PG8_WAIT_V(6); PG8_BAR;
    } else {
        PG8_STAGE(PG8_SB(0, 0), cB, voffB); PG8_STAGE(PG8_SA(0, 0), cA, voffA); PG8_STAGE(PG8_SB(0, 1), cB + hstep, voffB); PG8_STAGE(PG8_SA(0, 1), cA + hstep, voffA);
        if (wr == 1) PG8_BAR;
        PG8_WAIT_V(4); PG8_BAR;
        PG8_STAGE(PG8_SB(1, 0), cB + kstep, voffB); PG8_STAGE(PG8_SA(1, 0), cA + kstep, voffA); PG8_STAGE(PG8_SB(1, 1), cB + hstep + kstep, voffB);
        PG8_WAIT_V(6); PG8_BAR;
    }
    for (;;) {
        const bool has_next = S.next(ui + 1, nxt);
        const char* nA = has_next ? (const char*)g.A + (size_t)nxt.pm * tstep : cA; const char* nB = has_next ? (const char*)g.Bt + (size_t)nxt.pn * tstep : cB;
        for (int t = 0; t < nt; t += 2) {
            const bool last = (t == nt - 2);
            const char* a1 = cA + (size_t)(t + 1) * kstep;
            const char* a2 = last ? nA : cA + (size_t)(t + 2) * kstep; const char* b2 = last ? nB : cB + (size_t)(t + 2) * kstep;
            const char* a3 = a2 + kstep; const char* b3 = b2 + kstep;
            if (last && has_next) S.a_ready(nxt);
            if constexpr (SP2) {
            PG8_LDB(B0, 0, 0); PG8_LDB(B1, 0, 1); PG8_SCHED; PG8_LDA(At, 0, 0); PG8_STAGE(PG8_SA(1, 1), a1 + hstep, voffA);
            PG8_WAIT_V(8); PG8_WAIT_L(0); PG8_BAR; PG8_MMA(0, 0, At, B0); PG8_MMA(0, 1, At, B1); PG8_BAR; PG8_SCHED;
            PG8_LDA(At, 0, 1); PG8_STAGE(PG8_SB(0, 0), b2, voffB); PG8_STAGE(PG8_SB(0, 1), b2 + hstep, voffB); PG8_STAGE(PG8_SA(0, 0), a2, voffA);
            PG8_WAIT_V(8); PG8_WAIT_L(0); PG8_BAR; PG8_MMA(1, 0, At, B0); PG8_MMA(1, 1, At, B1); PG8_BAR; PG8_SCHED;
            PG8_LDB(B0, 1, 0); PG8_LDB(B1, 1, 1); PG8_SCHED; PG8_LDA(At, 1, 0); PG8_STAGE(PG8_SA(0, 1), a2 + hstep, voffA);
            PG8_WAIT_V(8); PG8_WAIT_L(0); PG8_BAR; PG8_MMA(0, 0, At, B0); PG8_MMA(0, 1, At, B1); PG8_BAR; PG8_SCHED;
            PG8_LDA(At, 1, 1); PG8_STAGE(PG8_SB(1, 0), b3, voffB); PG8_STAGE(PG8_SB(1, 1), b3 + hstep, voffB); PG8_STAGE(PG8_SA(1, 0), a3, voffA);
            PG8_WAIT_V(8); PG8_WAIT_L(0); PG8_BAR; PG8_MMA(1, 0, At, B0); PG8_MMA(1, 1, At, B1); PG8_BAR; PG8_SCHED;
            } else {
            PG8_LDB(B0, 0, 0); PG8_SCHED; PG8_LDA(At, 0, 0); PG8_STAGE(PG8_SA(1, 1), a1 + hstep, voffA);
            PG8_WAIT_L(8); PG8_BAR; PG8_WAIT_L(0); PG8_MMA(0, 0, At, B0); PG8_BAR; PG8_SCHED;
            PG8_LDB(B1, 0, 1); PG8_STAGE(PG8_SB(0, 0), b2, voffB);
            PG8_BAR; PG8_WAIT_L(0); PG8_MMA(0, 1, At, B1); PG8_BAR;
            PG8_LDA(At, 0, 1); PG8_STAGE(PG8_SA(0, 0), a2, voffA);
            PG8_BAR; PG8_WAIT_L(0); PG8_MMA(1, 0, At, B0); PG8_BAR; PG8_SCHED;
            PG8_STAGE(PG8_SB(0, 1), b2 + hstep, voffB);
            PG8_WAIT_V(6); PG8_BAR; PG8_MMA(1, 1, At, B1); PG8_BAR;
            PG8_LDB(B0, 1, 0); PG8_SCHED; PG8_LDA(At, 1, 0); PG8_STAGE(PG8_SA(0, 1), a2 + hstep, voffA);
            PG8_WAIT_L(8); PG8_BAR; PG8_WAIT_L(0); PG8_MMA(0, 0, At, B0); PG8_BAR; PG8_SCHED;
            PG8_LDB(B1, 1, 1); PG8_STAGE(PG8_SB(1, 0), b3, voffB);
            PG8_BAR; PG8_WAIT_L(0); PG8_MMA(0, 1, At, B1); PG8_BAR;
            PG8_LDA(At, 1, 1); PG8_STAGE(PG8_SA(1, 0), a3, voffA);
            PG8_BAR; PG8_WAIT_L(0); PG8_MMA(1, 0, At, B0); PG8_BAR; PG8_SCHED;
            PG8_STAGE(PG8_SB(1, 1), b3 + hstep, voffB);
            PG8_WAIT_V(6); PG8_BAR; PG8_MMA(1, 1, At, B1); PG8_BAR;
            }
        }
        if constexpr (ALIGN_EPI) { if (wr == 0) PG8_BAR; }
        int frl = fr, fql = fq; asm volatile("" : "+v"(frl), "+v"(fql));
        if constexpr (I8 || F8) {
            const int row0 = cur.pm * BM + wr * 64 + frl;
            float rsv[2][4];
#pragma unroll
            for (int ai = 0; ai < 2; ++ai)
#pragma unroll
                for (int m = 0; m < 4; ++m) rsv[ai][m] = F8 ? g.ascale : g.rs[row0 + ai * HALF + m * 16];
#pragma unroll
            for (int bj = 0; bj < 2; ++bj) {
                const int col = cur.pn * BM + bj * HALF + wc * 32 + 8 * fql;
                const f32x4 c0 = *(const f32x4*)(g.cs + col), c1 = *(const f32x4*)(g.cs + col + 4);
#pragma unroll
                for (int ai = 0; ai < 2; ++ai)
#pragma unroll
                    for (int m = 0; m < 4; ++m)
                    {
                        const i32x4 i0 = __builtin_bit_cast(i32x4, acc[ai][bj][m][0]), i1 = __builtin_bit_cast(i32x4, acc[ai][bj][m][1]);
                        f32x4 f0, f1;
#pragma unroll
                        for (int e = 0; e < 4; ++e) { f0[e] = (F8 ? acc[ai][bj][m][0][e] : (float)i0[e]) * (rsv[ai][m] * c0[e]); f1[e] = (F8 ? acc[ai][bj][m][1][e] : (float)i1[e]) * (rsv[ai][m] * c1[e]); }
                        acc[ai][bj][m][0] = f0; acc[ai][bj][m][1] = f1; }
            }
        }
        if constexpr (!Epi::AFTER_DRAIN) { E(acc, cur, wr, wc, frl, fql); S.done(cur); }
        if (!has_next) break;
        H(ui);
#pragma unroll
        for (int a = 0; a < 2; ++a)
#pragma unroll
            for (int b = 0; b < 2; ++b)
#pragma unroll
                for (int m = 0; m < 4; ++m)
#pragma unroll
                    for (int n = 0; n < 2; ++n) acc[a][b][m][n] = (f32x4){0.f, 0.f, 0.f, 0.f};
        cur = nxt; cA = nA; cB = nB; ++ui;
        if constexpr (ALIGN_EPI) { if (wr == 1) PG8_BAR; }
    }
    PG8_WAIT_V(0);
    if constexpr (!ALIGN_EPI) { if (wr == 0) PG8_BAR; }
    PG8_BAR;
    if constexpr (Epi::AFTER_DRAIN) { E.fused(acc, cur, wr, wc, fr, fq, lds, wid, lane); S.done(cur); }
#undef PG8_SA
#undef PG8_SB
#undef PG8_STAGE
#undef PG8_LDA
#undef PG8_LDB
#undef PG8_MMA
#undef PG8_WAIT_V
#undef PG8_WAIT_L
#undef PG8_BAR
#undef PG8_SCHED
}
}

constexpr int NWAVES = 8;
constexpr int DM = 2048, NB = 4, SEQ = 4096, NTOK = NB * SEQ;
constexpr int NMETA = 16, NVALID = NTOK + NMETA, MROWS = 16640;
constexpr int IN_COLS = 5376;
constexpr float LN_EPS = 1e-5f, GN_EPS = 1e-5f;
constexpr float ALPHA = 1.189207115002721f;
constexpr float LOG2E = 1.4426950408889634f;
constexpr float QSCALE = 0.125f * LOG2E;
constexpr float U_QSCALE = 958.0f;
constexpr float V_QSCALE = 35.6f;
constexpr int NSL = 16;

constexpr size_t MiB = 1u << 20;
constexpr size_t WS_CTL = 0, CTL_ZERO_BYTES = 65536;
constexpr size_t SZ_SK = (size_t)16 * 128 * 128 * 2, SZ_ROPE_R = (size_t)4112 * 128 * 8, SZ_ROPE_A = (size_t)4112 * 32 * 8;
constexpr size_t SZ_W2T = (size_t)DM * DM * 2, SZ_W1T = (size_t)IN_COLS * DM * 2, SZ_TAB = (size_t)16384 * DM;
constexpr size_t SZ_ROWS2K = (size_t)MROWS * 2048 * 2, SZ_ROWS1K = (size_t)MROWS * 1024 * 2, SZ_ROWS128 = (size_t)MROWS * 128 * 2;
constexpr size_t SZ_TOK2K = (size_t)NTOK * 2048 * 2, SZ_ST = (size_t)16 * 32 * 256 * 256 * 2, SZ_IDS = (size_t)NTOK * 128 * 4;
constexpr size_t al256(size_t x) { return (x + 255) & ~(size_t)255; }
constexpr size_t WS_SK = 1 * MiB;
constexpr size_t WS_ROPE_R = al256(WS_SK + SZ_SK);
constexpr size_t WS_ROPE_A = al256(WS_ROPE_R + SZ_ROPE_R);
constexpr size_t WS_W2T = al256(WS_ROPE_A + SZ_ROPE_A), WS_W3T = al256(WS_W2T + SZ_W2T), WS_W1T = al256(WS_W3T + SZ_W2T);
constexpr size_t WS_UT = al256(WS_W1T + SZ_W1T), WS_VT = al256(WS_UT + SZ_TAB);
constexpr size_t WS_H0 = al256(WS_VT + SZ_TAB);
constexpr size_t WS_QR = al256(WS_H0 + SZ_ROWS2K);
constexpr size_t WS_KA = al256(WS_QR + SZ_ROWS2K), WS_VA = al256(WS_KA + SZ_ROWS128);
constexpr size_t WS_RK = al256(WS_VA + SZ_ROWS128), WS_RV = al256(WS_RK + SZ_ROWS1K), WS_RG = al256(WS_RV + SZ_ROWS1K);
constexpr size_t WS_ST = al256(WS_RG + SZ_ROWS1K);
constexpr size_t WS_Y = WS_RK;
constexpr size_t WS_H1 = WS_ST;
constexpr size_t WS_IDS = al256(WS_ST + SZ_ST), WS_GATES = al256(WS_IDS + SZ_IDS);
constexpr size_t WS_HSC = al256(WS_GATES + SZ_IDS);
constexpr size_t WS_CSC = al256(WS_HSC + (size_t)NTOK * 4);
constexpr size_t WS_H0Q = al256(WS_CSC + (size_t)NTOK * 4);
constexpr size_t WS_W1Q = al256(WS_H0Q + (size_t)MROWS * DM);
constexpr size_t WS_W3Q = al256(WS_W1Q + (size_t)IN_COLS * DM);
constexpr size_t WS_H0S = al256(WS_W3Q + (size_t)DM * DM);
constexpr size_t WS_WS1 = al256(WS_H0S + (size_t)MROWS * 4);
constexpr size_t WS_WS3 = al256(WS_WS1 + (size_t)IN_COLS * 4);
constexpr size_t WS_END = al256(WS_WS3 + (size_t)DM * 4);
static_assert(WS_Y + SZ_TOK2K <= WS_RG, "Y overlays RK|RV only");
static_assert(SZ_TOK2K <= SZ_ST && (size_t)NTOK * 1024 * 4 <= SZ_ST, "H1 / RET_RAW fit the state region");
static_assert(WS_END <= (size_t)512 * MiB, "workspace map fits 4 x largest tensor");
static_assert(WS_RK + (size_t)8 * NTOK * 128 * 4 <= WS_ST && WS_KA + (size_t)NTOK * 128 * 4 <= WS_RK && WS_H0 + (size_t)NTOK * DM * 4 <= WS_KA, "expert-phase overlays (DOTX over RK|RV, CB over KA|VA, Y32 over H0|QR)");
constexpr int CW_TMO = 0, CW_TABQ = 64, CW_BAR = 4096;

constexpr int RING_OFF = 0, RING_BYTES = 131072;
constexpr int LDSCTL_OFF = RING_BYTES, MISC_OFF = LDSCTL_OFF + 320;
constexpr int LDS_BYTES = 147456;

#define GAS __attribute__((address_space(1)))
#define LAS __attribute__((address_space(3)))
typedef unsigned short bf16;
typedef unsigned v4u __attribute__((ext_vector_type(4)));
typedef unsigned v2u __attribute__((ext_vector_type(2)));
typedef float f32x4 __attribute__((ext_vector_type(4)));
typedef float f32x2 __attribute__((ext_vector_type(2)));
typedef GAS unsigned gu32;
typedef __bf16 bf16x2_t __attribute__((ext_vector_type(2)));
#define RLX_AGENT __ATOMIC_RELAXED, __HIP_MEMORY_SCOPE_AGENT
#define LDS_WAIT() asm volatile("s_waitcnt lgkmcnt(0)" ::: "memory")
#define VM_WAIT() asm volatile("s_waitcnt vmcnt(0)" ::: "memory")
#define LDS_BAR() do { asm volatile("s_waitcnt lgkmcnt(0)" ::: "memory"); __builtin_amdgcn_s_barrier(); asm volatile("" ::: "memory"); } while (0)
__device__ __forceinline__ unsigned f2bf(float f) { unsigned u = __builtin_bit_cast(unsigned, f); return (u + 0x7fffu + ((u >> 16) & 1u)) >> 16; }
__device__ __forceinline__ unsigned pk2(float lo, float hi) { return f2bf(lo) | (f2bf(hi) << 16); }
__device__ __forceinline__ float bflo(unsigned w) { return __uint_as_float(w << 16); }
__device__ __forceinline__ float bfhi(unsigned w) { return __uint_as_float(w & 0xffff0000u); }
__device__ __forceinline__ float bf2f(bf16 h) { return __uint_as_float((unsigned)h << 16); }

#define XB_TMO      128
#define XB_XCNT(j)  (256  + 64 * (j))
#define XB_XSUB(j)  (1280 + 64 * (j))
#define XB_XGEN(j)  (2304 + 64 * (j))
#define XB_TOP      3328
#define XB_TOPGEN   3392
#define XCD_BAR_WORDS 3456
#define XB_SPIN_CAP (1u << 18)

__device__ __forceinline__ unsigned xb_ld(unsigned* p)              { return __hip_atomic_load(p, __ATOMIC_RELAXED, __HIP_MEMORY_SCOPE_AGENT); }
__device__ __forceinline__ unsigned xb_add(unsigned* p, unsigned v) { return __hip_atomic_fetch_add(p, v, __ATOMIC_RELAXED, __HIP_MEMORY_SCOPE_AGENT); }
__device__ __forceinline__ unsigned xb_xcc_id() { return (unsigned)__builtin_amdgcn_s_getreg((3 << 11) | 20) & 0xFu; }
#define XB_SPIN(cond, bar) do { unsigned _sp = 0; while (cond) { __builtin_amdgcn_s_sleep(1); \
    if ((++_sp & 255u) == 0u) { if (xb_ld(&(bar)[XB_TMO])) break; if (_sp > XB_SPIN_CAP) { atomicAdd(&(bar)[XB_TMO], 1u); break; } } } } while (0)

struct XcdBarrier {
    unsigned* bar; unsigned x;
    volatile LAS unsigned* st;
};

__device__ __forceinline__ XcdBarrier xcd_barrier_post(unsigned* bar, volatile LAS unsigned* st) {
    XcdBarrier b; b.bar = bar; b.x = xb_xcc_id(); b.st = st;
    if (threadIdx.x == 0) (void)xb_add(&bar[XB_XCNT(b.x)], 1u);
    return b;
}
__device__ __forceinline__ void xcd_barrier_complete(unsigned* bar, unsigned x, unsigned& nloc, unsigned& nx) {
    const unsigned G = gridDim.x * gridDim.y * gridDim.z;
    unsigned sum, cnt, mine, sp = 0u;
    for (;;) {
        sum = 0u; cnt = 0u; mine = 0u;
#pragma unroll
        for (unsigned j = 0; j < 16; ++j) { const unsigned c = xb_ld(&bar[XB_XCNT(j)]); sum += c; cnt += (c > 0u) ? 1u : 0u; mine = (j == x) ? c : mine; }
        if (sum == G) break;
        __builtin_amdgcn_s_sleep(1);
        if ((++sp & 255u) == 0u) { if (xb_ld(&bar[XB_TMO])) break; if (sp > XB_SPIN_CAP) { atomicAdd(&bar[XB_TMO], 1u); break; } }
    }
    nloc = mine > 0u ? mine : 1u; nx = cnt > 0u ? cnt : 1u;
}

__device__ __forceinline__ void xcd_barrier(const XcdBarrier& b) {
    asm volatile("s_waitcnt vmcnt(0)" ::: "memory");
    __syncthreads();
    if (threadIdx.x == 0) {
        unsigned* bar = b.bar;
        __builtin_amdgcn_s_waitcnt(0);
        unsigned nloc = b.st[0], nx = b.st[1];
        if (nloc == 0u) { xcd_barrier_complete(bar, b.x, nloc, nx); b.st[0] = nloc; b.st[1] = nx; }
        const unsigned old = xb_add(&bar[XB_XSUB(b.x)], 1u);
        const unsigned gen = old / nloc;
        if (old + 1u == (gen + 1u) * nloc) {
            __builtin_amdgcn_fence(__ATOMIC_RELEASE, "agent");
            asm volatile("s_waitcnt vmcnt(0)" ::: "memory");
            const unsigned og = xb_add(&bar[XB_TOP], 1u);
            const unsigned tg = og / nx;
            if (og + 1u == (tg + 1u) * nx) xb_add(&bar[XB_TOPGEN], 1u);
            else XB_SPIN(xb_ld(&bar[XB_TOPGEN]) == tg, bar);
            __builtin_amdgcn_fence(__ATOMIC_ACQUIRE, "agent");
            xb_add(&bar[XB_XGEN(b.x)], 1u);
            asm volatile("s_waitcnt vmcnt(0)" ::: "memory");
        } else {
            XB_SPIN(xb_ld(&bar[XB_XGEN(b.x)]) == gen, bar);
            __builtin_amdgcn_fence(__ATOMIC_ACQUIRE, "agent");
            asm volatile("s_waitcnt vmcnt(0)" ::: "memory");
        }
    }
    __syncthreads();
}


__device__ __forceinline__ float dot2bf(unsigned a, unsigned b, float c) { asm("v_dot2c_f32_bf16 %0, %1, %2" : "+v"(c) : "v"(a), "v"(b)); return c; }
__device__ __forceinline__ float dot8bf_dpp(v4u a, v4u b) { float c = 0.f; asm("v_dot2c_f32_bf16 %0, %1, %5\n\tv_dot2c_f32_bf16 %0, %2, %6\n\tv_dot2c_f32_bf16 %0, %3, %7\n\tv_dot2c_f32_bf16 %0, %4, %8\n\ts_nop 1" : "+v"(c) : "v"(a.x), "v"(a.y), "v"(a.z), "v"(a.w), "v"(b.x), "v"(b.y), "v"(b.z), "v"(b.w)); return c; }
#define DPPF(v, ctrl) __int_as_float(__builtin_amdgcn_update_dpp(0, __float_as_int(v), (ctrl), 0xf, 0xf, true))
__device__ __forceinline__ int q8(float x) { int q = (int)__builtin_rintf(x); q = q < -127 ? -127 : (q > 127 ? 127 : q); return q & 0xff; }
__device__ __forceinline__ unsigned fp8x4(float a, float b, float c, float d) {
    a = __builtin_amdgcn_fmed3f(a, -440.f, 440.f); b = __builtin_amdgcn_fmed3f(b, -440.f, 440.f); c = __builtin_amdgcn_fmed3f(c, -440.f, 440.f); d = __builtin_amdgcn_fmed3f(d, -440.f, 440.f);
    int w = 0; w = __builtin_amdgcn_cvt_pk_fp8_f32(a, b, w, false); w = __builtin_amdgcn_cvt_pk_fp8_f32(c, d, w, true); return (unsigned)w; }
constexpr float MIX_F8_SCALE = 8.0f;
__device__ __forceinline__ float wave_sum(float v) {
    v += DPPF(v, 0xB1); v += DPPF(v, 0x4E); v += DPPF(v, 0x141); v += DPPF(v, 0x128);
    { const auto r16 = __builtin_amdgcn_permlane16_swap(__float_as_uint(v), __float_as_uint(v), false, false); v = __uint_as_float(r16[0]) + __uint_as_float(r16[1]); }
    { const auto r32 = __builtin_amdgcn_permlane32_swap(__float_as_uint(v), __float_as_uint(v), false, false); v = __uint_as_float(r32[0]) + __uint_as_float(r32[1]); }
    return v;
}
__device__ __forceinline__ float wave_max(float v) {
    v = fmaxf(v, DPPF(v, 0xB1)); v = fmaxf(v, DPPF(v, 0x4E)); v = fmaxf(v, DPPF(v, 0x141)); v = fmaxf(v, DPPF(v, 0x128));
    { const auto r16 = __builtin_amdgcn_permlane16_swap(__float_as_uint(v), __float_as_uint(v), false, false); v = fmaxf(__uint_as_float(r16[0]), __uint_as_float(r16[1])); }
    { const auto r32 = __builtin_amdgcn_permlane32_swap(__float_as_uint(v), __float_as_uint(v), false, false); v = fmaxf(__uint_as_float(r32[0]), __uint_as_float(r32[1])); }
    return v;
}
__device__ __forceinline__ float gelu_erf(float v) {
    const float av = fabsf(v), d = av * 0.2316418882f + 1.0f;
    const float t = __builtin_amdgcn_rcpf(d);
    float q = t * 0.5307027145f + (-0.7265760135f); q = q * t + 0.7107068705f; q = q * t + (-0.142248368f); q = q * t + 0.127414796f; q = q * t;
    const float e = __builtin_amdgcn_exp2f((v * v) * (-0.72134752044f));
    const float m = v * (q * e);
    return v < 0.f ? m : v - m;
}

struct Args { const float* in[15]; float* out; unsigned char* ws; };

__device__ __forceinline__ int w1_logical_col(int n0p) {
    const int pn = n0p >> 8, blk = (n0p & 255) >> 5, half = blk >> 2, a = blk & 3;
    if (pn <= 3) return pn * 256 + 64 * a + 32 * half;
    if (pn == 4) return (a < 2) ? (1024 + 64 * a + 32 * half) : (1152 + 64 * half + 32 * (a - 2));
    return n0p;
}
template <bool PERMW1> __device__ __forceinline__ void p0_transpose_item(const float* W, int K, int N, bf16* WT, LAS float* scr, int item, int lane) {
    const int nblk = N / 32, kb = item / nblk, nb = item % nblk, k0 = 64 * kb, n0 = 32 * nb; const int ns = PERMW1 ? w1_logical_col(n0) : n0;
    float tv[32];
#pragma unroll
    for (int i = 0; i < 32; ++i) { const int kk = 2 * i + (lane >> 5); tv[i] = W[(size_t)(k0 + kk) * N + ns + (lane & 31)]; }
#pragma unroll
    for (int i = 0; i < 32; ++i) { const int kk = 2 * i + (lane >> 5); scr[kk * 33 + (lane & 31)] = tv[i]; }
    LDS_WAIT(); asm volatile("" ::: "memory");
    const int c = lane & 7;
#pragma unroll
    for (int j = 0; j < 4; ++j) { const int n = (lane >> 3) + 8 * j; const LAS float* s = scr + (8 * c) * 33 + n;
        v4u o; o.x = pk2(s[0 * 33], s[1 * 33]); o.y = pk2(s[2 * 33], s[3 * 33]); o.z = pk2(s[4 * 33], s[5 * 33]); o.w = pk2(s[6 * 33], s[7 * 33]);
        *(GAS v4u*)(WT + (size_t)(n0 + n) * K + k0 + 8 * c) = o; }
    LDS_WAIT(); asm volatile("" ::: "memory");
}
__device__ __forceinline__ void ln_load_f32(f32x4 (&v)[8], const float* xrow, int lane) {
    const GAS f32x4* xr = (const GAS f32x4*)xrow + lane;
#pragma unroll
    for (int j = 0; j < 8; ++j) v[j] = xr[64 * j];
}
__device__ __forceinline__ void ln_row_f32_to_bf16(f32x4 (&v)[8], const float* g, const float* bta, bf16* orow, int lane) {
    float s = 0.f;
#pragma unroll
    for (int j = 0; j < 8; ++j) s += (v[j].x + v[j].y) + (v[j].z + v[j].w);
    const float mean = wave_sum(s) * (1.f / DM); float s2 = 0.f;
#pragma unroll
    for (int j = 0; j < 8; ++j) { v[j] = v[j] - mean; s2 += (v[j].x * v[j].x + v[j].y * v[j].y) + (v[j].z * v[j].z + v[j].w * v[j].w); }
    const float rstd = 1.f / sqrtf(wave_sum(s2) * (1.f / DM) + LN_EPS);
    GAS v2u* o8 = (GAS v2u*)orow + lane;
#pragma unroll
    for (int j = 0; j < 8; ++j) { const f32x4 gg = ((const GAS f32x4*)g)[lane + 64 * j], bb = ((const GAS f32x4*)bta)[lane + 64 * j];
        v2u o; o.x = pk2(v[j].x * rstd * gg.x + bb.x, v[j].y * rstd * gg.y + bb.y); o.y = pk2(v[j].z * rstd * gg.z + bb.z, v[j].w * rstd * gg.w + bb.w); o8[64 * j] = o; }
}
__device__ __forceinline__ void ln_row_f32_to_bf16_q(f32x4 (&v)[8], const float* g, const float* bta, bf16* orow, signed char* qrow, float* qscale, int lane) {
    float s = 0.f;
#pragma unroll
    for (int j = 0; j < 8; ++j) s += (v[j].x + v[j].y) + (v[j].z + v[j].w);
    const float mean = wave_sum(s) * (1.f / DM); float s2 = 0.f;
#pragma unroll
    for (int j = 0; j < 8; ++j) { v[j] = v[j] - mean; s2 += (v[j].x * v[j].x + v[j].y * v[j].y) + (v[j].z * v[j].z + v[j].w * v[j].w); }
    const float rstd = 1.f / sqrtf(wave_sum(s2) * (1.f / DM) + LN_EPS);
    GAS v2u* o8 = (GAS v2u*)orow + lane; float am = 0.f;
#pragma unroll
    for (int j = 0; j < 8; ++j) { const f32x4 gg = ((const GAS f32x4*)g)[lane + 64 * j], bb = ((const GAS f32x4*)bta)[lane + 64 * j];
        v[j].x = v[j].x * rstd * gg.x + bb.x; v[j].y = v[j].y * rstd * gg.y + bb.y; v[j].z = v[j].z * rstd * gg.z + bb.z; v[j].w = v[j].w * rstd * gg.w + bb.w;
        am = fmaxf(am, fmaxf(fmaxf(fabsf(v[j].x), fabsf(v[j].y)), fmaxf(fabsf(v[j].z), fabsf(v[j].w))));
        if (orow) { v2u o; o.x = pk2(v[j].x, v[j].y); o.y = pk2(v[j].z, v[j].w); o8[64 * j] = o; } }
    am = fmaxf(wave_max(am), 1e-20f); const float iq = 127.0f / am;
    if (lane == 0) *qscale = am * (1.0f / 127.0f);
#pragma unroll
    for (int j = 0; j < 8; ++j) ((GAS unsigned*)qrow)[lane + 64 * j] = (unsigned)(q8(v[j].x * iq) | (q8(v[j].y * iq) << 8) | (q8(v[j].z * iq) << 16) | (q8(v[j].w * iq) << 24));
}
template <bool F8> __device__ __forceinline__ void w_strip(LAS unsigned char* L, LAS float* red, const float* W, int ld, int ns, signed char* dst, float* sc, int tid) {
    asm volatile("" : "+v"(tid));
    const int kr = tid >> 3, c4 = tid & 7, lane = tid & 63, wave = __builtin_amdgcn_readfirstlane(tid >> 6);
    float mx[4] = {0.f, 0.f, 0.f, 0.f};
    const GAS f32x4* src = (const GAS f32x4*)(W + (size_t)kr * ld + ns) + c4;
#pragma unroll 1
    for (int r0 = 0; r0 < 32; r0 += 16) {
        f32x4 a[16];
#pragma unroll
        for (int i = 0; i < 16; ++i) a[i] = src[(size_t)(64 * (r0 + i)) * (ld / 4)];
#pragma unroll
        for (int i = 0; i < 16; ++i) { const int k = 64 * (r0 + i) + kr; const int so = ((((k >> 3) ^ c4)) << 4) + (k & 7) * 2;
#pragma unroll
            for (int j = 0; j < 4; ++j) { mx[j] = fmaxf(mx[j], fabsf(a[i][j])); *(LAS unsigned short*)(L + (4 * c4 + j) * 4096 + so) = (unsigned short)f2bf(a[i][j]); } }
    }
#pragma unroll
    for (int j = 0; j < 4; ++j) { mx[j] = fmaxf(mx[j], __shfl_xor(mx[j], 8)); mx[j] = fmaxf(mx[j], __shfl_xor(mx[j], 16)); mx[j] = fmaxf(mx[j], __shfl_xor(mx[j], 32)); }
    if (lane < 8) {
#pragma unroll
        for (int j = 0; j < 4; ++j) red[wave * 32 + 4 * c4 + j] = mx[j]; }
    LDS_BAR();
#pragma unroll 1
    for (int nn = 0; nn < 4; ++nn) {
        const int n = 4 * wave + nn; float am = 0.f;
#pragma unroll
        for (int w8 = 0; w8 < 8; ++w8) am = fmaxf(am, red[w8 * 32 + n]);
        am = fmaxf(am, 1e-30f); const float iq = (F8 ? 384.0f : 127.0f) / am;
        if (lane == 0) sc[n] = am * (F8 ? 1.0f / 384.0f : 1.0f / 127.0f);
#pragma unroll
        for (int h = 0; h < 2; ++h) { const int run = h * 64 + lane;
            const v4u w0 = *(LAS const v4u*)(L + n * 4096 + (((2 * run) ^ (wave & 7)) << 4)), w1 = *(LAS const v4u*)(L + n * 4096 + (((2 * run + 1) ^ (wave & 7)) << 4));
            v4u o;
            if constexpr (F8) {
                o.x = fp8x4(bflo(w0.x) * iq, bfhi(w0.x) * iq, bflo(w0.y) * iq, bfhi(w0.y) * iq); o.y = fp8x4(bflo(w0.z) * iq, bfhi(w0.z) * iq, bflo(w0.w) * iq, bfhi(w0.w) * iq);
                o.z = fp8x4(bflo(w1.x) * iq, bfhi(w1.x) * iq, bflo(w1.y) * iq, bfhi(w1.y) * iq); o.w = fp8x4(bflo(w1.z) * iq, bfhi(w1.z) * iq, bflo(w1.w) * iq, bfhi(w1.w) * iq);
            } else {
            o.x = (unsigned)(q8(bflo(w0.x) * iq) | (q8(bfhi(w0.x) * iq) << 8) | (q8(bflo(w0.y) * iq) << 16) | (q8(bfhi(w0.y) * iq) << 24));
            o.y = (unsigned)(q8(bflo(w0.z) * iq) | (q8(bfhi(w0.z) * iq) << 8) | (q8(bflo(w0.w) * iq) << 16) | (q8(bfhi(w0.w) * iq) << 24));
            o.z = (unsigned)(q8(bflo(w1.x) * iq) | (q8(bfhi(w1.x) * iq) << 8) | (q8(bflo(w1.y) * iq) << 16) | (q8(bfhi(w1.y) * iq) << 24));
            o.w = (unsigned)(q8(bflo(w1.z) * iq) | (q8(bfhi(w1.z) * iq) << 8) | (q8(bflo(w1.w) * iq) << 16) | (q8(bfhi(w1.w) * iq) << 24)); }
            *(GAS v4u*)(dst + (size_t)n * DM + 16 * run) = o; }
    }
    LDS_BAR();
}
__device__ __forceinline__ void ln_load_bf16(v4u (&w4)[4], const bf16* xrow, int lane) {
    const GAS v4u* xr = (const GAS v4u*)xrow + lane;
#pragma unroll
    for (int j = 0; j < 4; ++j) w4[j] = xr[64 * j];
}
__device__ __forceinline__ void ln_row_bf16_to_bf16(const v4u (&w4)[4], const float* g, const float* bta, bf16* orow, signed char* qrow, float* qscale, int lane) {
    float v[32]; float s = 0.f;
#pragma unroll
    for (int j = 0; j < 4; ++j) { const v4u w = w4[j];
        v[8 * j + 0] = bflo(w.x); v[8 * j + 1] = bfhi(w.x); v[8 * j + 2] = bflo(w.y); v[8 * j + 3] = bfhi(w.y);
        v[8 * j + 4] = bflo(w.z); v[8 * j + 5] = bfhi(w.z); v[8 * j + 6] = bflo(w.w); v[8 * j + 7] = bfhi(w.w); }
#pragma unroll
    for (int i = 0; i < 32; ++i) s += v[i];
    const float mean = wave_sum(s) * (1.f / DM); float s2 = 0.f;
#pragma unroll
    for (int i = 0; i < 32; ++i) { v[i] -= mean; s2 += v[i] * v[i]; }
    const float rstd = 1.f / sqrtf(wave_sum(s2) * (1.f / DM) + LN_EPS);
    GAS v4u* o16 = (GAS v4u*)orow + lane;
#pragma unroll
    for (int j = 0; j < 4; ++j) {
        const GAS f32x4* gp = (const GAS f32x4*)g + 2 * (lane + 64 * j); const GAS f32x4* bp = (const GAS f32x4*)bta + 2 * (lane + 64 * j);
        const f32x4 g0 = gp[0], g1 = gp[1], b0 = bp[0], b1 = bp[1];
        v4u o; o.x = pk2(v[8 * j + 0] * rstd * g0.x + b0.x, v[8 * j + 1] * rstd * g0.y + b0.y); o.y = pk2(v[8 * j + 2] * rstd * g0.z + b0.z, v[8 * j + 3] * rstd * g0.w + b0.w);
        o.z = pk2(v[8 * j + 4] * rstd * g1.x + b1.x, v[8 * j + 5] * rstd * g1.y + b1.y); o.w = pk2(v[8 * j + 6] * rstd * g1.z + b1.z, v[8 * j + 7] * rstd * g1.w + b1.w);
        if (orow) o16[64 * j] = o;
        v[8 * j + 0] = v[8 * j + 0] * rstd * g0.x + b0.x; v[8 * j + 1] = v[8 * j + 1] * rstd * g0.y + b0.y; v[8 * j + 2] = v[8 * j + 2] * rstd * g0.z + b0.z; v[8 * j + 3] = v[8 * j + 3] * rstd * g0.w + b0.w;
        v[8 * j + 4] = v[8 * j + 4] * rstd * g1.x + b1.x; v[8 * j + 5] = v[8 * j + 5] * rstd * g1.y + b1.y; v[8 * j + 6] = v[8 * j + 6] * rstd * g1.z + b1.z; v[8 * j + 7] = v[8 * j + 7] * rstd * g1.w + b1.w; }
    float am = 0.f;
#pragma unroll
    for (int i = 0; i < 32; ++i) am = fmaxf(am, fabsf(v[i]));
    am = wave_max(am);
    am = fmaxf(am, 1e-20f); const float iq = 127.0f / am;
    if (lane == 0) *qscale = am * (1.0f / 127.0f);
#pragma unroll
    for (int j = 0; j < 4; ++j) { v2u w; w.x = (unsigned)(q8(v[8 * j + 0] * iq) | (q8(v[8 * j + 1] * iq) << 8) | (q8(v[8 * j + 2] * iq) << 16) | (q8(v[8 * j + 3] * iq) << 24));
        w.y = (unsigned)(q8(v[8 * j + 4] * iq) | (q8(v[8 * j + 5] * iq) << 8) | (q8(v[8 * j + 6] * iq) << 16) | (q8(v[8 * j + 7] * iq) << 24)); ((GAS v2u*)qrow)[lane + 64 * j] = w; }
}
__device__ __forceinline__ void row_pos(int r, int& pos, int& ipos) {
    if (r < NTOK) { const int s = r & (SEQ - 1); pos = NMETA + s; ipos = s & 127; }
    else { int j = r - NTOK; if (j > NMETA - 1) j = NMETA - 1; pos = j; ipos = 112 + j; }
}
__device__ __forceinline__ float log2_gamma(int h) { return log2f(1.0f - exp2f(-5.0f - (float)h)); }


typedef short bf16x8 __attribute__((ext_vector_type(8)));
typedef short s16x4 __attribute__((ext_vector_type(4)));
#define MFMA16(a, b, c) __builtin_amdgcn_mfma_f32_16x16x32_bf16((a), (b), (c), 0, 0, 0)
__device__ __forceinline__ s16x4 tr16(LAS const unsigned char* p) { return __builtin_bit_cast(s16x4, __builtin_amdgcn_ds_read_tr16_b64_v4i16((LAS s16x4*)p)); }
__device__ __forceinline__ bf16x8 cat8(s16x4 a, s16x4 b) { return __builtin_shufflevector(a, b, 0, 1, 2, 3, 4, 5, 6, 7); }
__device__ __forceinline__ unsigned cvtpk_s(float lo, float hi) { f32x2 v = {lo, hi}; bf16x2_t b = __builtin_convertvector(v, bf16x2_t); return __builtin_bit_cast(unsigned, b); }
__device__ __forceinline__ unsigned cvtpk(float lo, float hi) { unsigned r; asm("v_cvt_pk_bf16_f32 %0, %1, %2" : "=v"(r) : "v"(lo), "v"(hi)); return r; }

__device__ __forceinline__ void scan_unit(LAS unsigned char* L, int u, const bf16* RK, const bf16* RV, bf16* ST, int tid, int lane, int wave) {
    asm volatile("" : "+v"(tid)); lane = tid & 63;
    const int bh = u >> 4, di = (u >> 2) & 3, ei = u & 3, b = bh >> 2, h = bh & 3;
    const float g128 = exp2f(128.0f * log2_gamma(h));
    const int li = lane & 15, g = lane >> 4, q = li >> 2, p4 = li & 3;
    const int eb = wave >> 1, db0 = 2 * (wave & 1);
    f32x4 acc[2]; acc[0] = (f32x4){0.f, 0.f, 0.f, 0.f}; acc[1] = acc[0];
    const int sw = 2 * (((q >> 1) & 1) | ((g & 1) << 1));
    v4u kA[2], vA[2], kB[2], vB[2];
#define SCAN_LOAD(cc, kreg, vreg) do { _Pragma("unroll") for (int i_ = 0; i_ < 2; ++i_) { const int cid_ = tid + 512 * i_, row_ = cid_ >> 3, c16_ = cid_ & 7; \
        int srow_; bool ok_ = true; if ((cc) < 0) { ok_ = row_ >= 112; srow_ = NTOK + (ok_ ? row_ - 112 : 0); } else srow_ = b * SEQ + (cc) * 128 + row_; \
        const v4u kz_ = *(const GAS v4u*)(RK + (size_t)srow_ * 1024 + h * 256 + di * 64 + c16_ * 8), vz_ = *(const GAS v4u*)(RV + (size_t)srow_ * 1024 + h * 256 + ei * 64 + c16_ * 8); \
        kreg[i_] = ok_ ? kz_ : (v4u){0u, 0u, 0u, 0u}; vreg[i_] = ok_ ? vz_ : (v4u){0u, 0u, 0u, 0u}; } } while (0)
#define SCAN_WRITE(bufp, kreg, vreg) do { _Pragma("unroll") for (int i_ = 0; i_ < 2; ++i_) { const int cid_ = tid + 512 * i_, row_ = cid_ >> 3, c16_ = cid_ & 7; \
        const int sw_ = ((row_ >> 1) & 1) | ((row_ >> 2) & 2); const int off_ = row_ * 128 + ((c16_ ^ (2 * sw_)) << 4); \
        *(LAS v4u*)((bufp) + off_) = kreg[i_]; *(LAS v4u*)((bufp) + 16384 + off_) = vreg[i_]; } } while (0)
#define SCAN_FLUSH(c) do { if ((c) >= 0) { const v4u z_ = *(LAS const v4u*)(L + 65536 + ((c) & 1) * 8192 + (tid >> 3) * 128 + (tid & 7) * 16); \
        *(GAS v4u*)(ST + ((size_t)(bh * 32 + (c)) * 256 + 64 * ei + (tid >> 3)) * 256 + 64 * di + (tid & 7) * 8) = z_; } } while (0)
    SCAN_LOAD(-1, kA, vA); SCAN_WRITE(L, kA, vA); SCAN_LOAD(0, kA, vA); SCAN_LOAD(1, kB, vB); LDS_BAR();
    int cur = 0;
    for (int cc = -1; cc <= 29; cc += 2) {
        { LAS const unsigned char* Kt = L + cur * 32768; LAS const unsigned char* Vt = Kt + 16384;
#pragma unroll
          for (int ks = 0; ks < 4; ++ks) { const int r0 = (32 * ks + 8 * g + q) * 128 + 8 * (p4 & 1);
              const bf16x8 a = cat8(tr16(Vt + r0 + (((2 * eb + (p4 >> 1)) ^ sw) << 4)), tr16(Vt + r0 + 512 + (((2 * eb + (p4 >> 1)) ^ sw) << 4)));
#pragma unroll
              for (int n = 0; n < 2; ++n) { const int cn = ((2 * (db0 + n) + (p4 >> 1)) ^ sw) << 4; const bf16x8 bb = cat8(tr16(Kt + r0 + cn), tr16(Kt + r0 + 512 + cn)); acc[n] = MFMA16(a, bb, acc[n]); } }
          SCAN_FLUSH(cc);
#pragma unroll
          for (int n = 0; n < 2; ++n) { acc[n] = acc[n] * g128;
              LAS bf16* op = (LAS bf16*)(L + 65536 + ((cc + 1) & 1) * 8192) + (16 * eb + 4 * g) * 64 + 16 * (db0 + n) + li;
#pragma unroll
              for (int r = 0; r < 4; ++r) op[r * 64] = (bf16)f2bf(acc[n][r]); }
          SCAN_WRITE(L + (cur ^ 1) * 32768, kA, vA);
          if (cc + 3 <= 30) SCAN_LOAD(cc + 3, kA, vA);
          LDS_BAR(); cur ^= 1; }
        { LAS const unsigned char* Kt = L + cur * 32768; LAS const unsigned char* Vt = Kt + 16384;
#pragma unroll
          for (int ks = 0; ks < 4; ++ks) { const int r0 = (32 * ks + 8 * g + q) * 128 + 8 * (p4 & 1);
              const bf16x8 a = cat8(tr16(Vt + r0 + (((2 * eb + (p4 >> 1)) ^ sw) << 4)), tr16(Vt + r0 + 512 + (((2 * eb + (p4 >> 1)) ^ sw) << 4)));
#pragma unroll
              for (int n = 0; n < 2; ++n) { const int cn = ((2 * (db0 + n) + (p4 >> 1)) ^ sw) << 4; const bf16x8 bb = cat8(tr16(Kt + r0 + cn), tr16(Kt + r0 + 512 + cn)); acc[n] = MFMA16(a, bb, acc[n]); } }
          SCAN_FLUSH(cc + 1);
#pragma unroll
          for (int n = 0; n < 2; ++n) { acc[n] = acc[n] * g128;
              LAS bf16* op = (LAS bf16*)(L + 65536 + ((cc + 2) & 1) * 8192) + (16 * eb + 4 * g) * 64 + 16 * (db0 + n) + li;
#pragma unroll
              for (int r = 0; r < 4; ++r) op[r * 64] = (bf16)f2bf(acc[n][r]); }
          if (cc + 2 <= 30) SCAN_WRITE(L + (cur ^ 1) * 32768, kB, vB);
          if (cc + 4 <= 30) SCAN_LOAD(cc + 4, kB, vB);
          LDS_BAR(); cur ^= 1; }
    }
    SCAN_FLUSH(31);
    LDS_BAR();
#undef SCAN_LOAD
#undef SCAN_WRITE
#undef SCAN_FLUSH
}

__device__ __forceinline__ void retout_unit(LAS unsigned char* L, int u, const bf16* QR, unsigned char* MIX8, const bf16* RK, const bf16* RV, const bf16* RG, const bf16* ST, int tid, int lane, int wave) {
    asm volatile("" : "+v"(tid)); lane = tid & 63;
    const int bh = u >> 5, c = u & 31, b = bh >> 2, h = bh & 3;
    const int R0 = b * SEQ + c * 128;
    const int li = lane & 15, g = lane >> 4, q = li >> 2, p4 = li & 3;
    LAS unsigned char* RA = L; LAS unsigned char* RB = L + 65536;
#pragma unroll
    for (int i = 0; i < 8; ++i) { const int cid = tid + 512 * i, j = cid >> 5, ch = cid & 31;
        const v4u kz = *(const GAS v4u*)(RK + (size_t)(R0 + j) * 1024 + h * 256 + ch * 8), vz = *(const GAS v4u*)(RV + (size_t)(R0 + j) * 1024 + h * 256 + ch * 8);
        *(LAS v4u*)(RA + j * 512 + ((ch ^ (j & 15)) << 4)) = kz; *(LAS v4u*)(RB + j * 512 + ((ch ^ ((j & 7) << 1)) << 4)) = vz; }
    bf16x8 qf[8];
    { const GAS v4u* qp = (const GAS v4u*)(QR + (size_t)(R0 + 16 * wave + li) * 2048 + 1024 + h * 256 + 8 * g);
#pragma unroll
      for (int ks = 0; ks < 8; ++ks) qf[ks] = __builtin_bit_cast(bf16x8, qp[4 * ks]); }
#define RO_LOAD_ST(s0) do { _Pragma("unroll") for (int i_ = 0; i_ < 8; ++i_) { const int cid_ = tid + 512 * i_, sl_ = cid_ >> 11, e_ = (cid_ >> 3) & 255, ch_ = cid_ & 7; \
        stg[i_] = *(const GAS v4u*)(Sg + (size_t)e_ * 256 + 64 * ((s0) + sl_) + ch_ * 8); } } while (0)
#define RO_WRITE_ST(dst) do { _Pragma("unroll") for (int i_ = 0; i_ < 8; ++i_) { const int cid_ = tid + 512 * i_, sl_ = cid_ >> 11, e_ = (cid_ >> 3) & 255, ch_ = cid_ & 7; \
        *(LAS v4u*)((dst) + sl_ * 32768 + e_ * 128 + ((ch_ ^ (e_ & 7)) << 4)) = stg[i_]; } } while (0)
    const bf16* Sg = ST + (size_t)(bh * 32 + c) * 65536; v4u stg[8];
    __syncthreads();
    RO_LOAD_ST(0);
    f32x4 st[8];
#pragma unroll
    for (int jt = 0; jt < 8; ++jt) st[jt] = (f32x4){0.f, 0.f, 0.f, 0.f};
#pragma unroll
    for (int jt = 0; jt < 8; ++jt) if (jt <= wave) {
        const int j = 16 * jt + li;
#pragma unroll
        for (int ks = 0; ks < 8; ++ks) { const bf16x8 a = *(LAS const bf16x8*)(RA + j * 512 + (((4 * ks + g) ^ li) << 4)); st[jt] = MFMA16(a, qf[ks], st[jt]); }
        if (jt == wave) {
#pragma unroll
            for (int r = 0; r < 4; ++r) if (4 * g + r > li) st[jt][r] = 0.f; }
    }
    bf16x8 pf[4];
#pragma unroll
    for (int s = 0; s < 4; ++s) { v4u w; w.x = cvtpk_s(st[2 * s][0], st[2 * s][1]); w.y = cvtpk_s(st[2 * s][2], st[2 * s][3]); w.z = cvtpk_s(st[2 * s + 1][0], st[2 * s + 1][1]); w.w = cvtpk_s(st[2 * s + 1][2], st[2 * s + 1][3]); pf[s] = __builtin_bit_cast(bf16x8, w); }
    __syncthreads();
    RO_WRITE_ST(RA); RO_LOAD_ST(2);
    f32x4 o[16];
#pragma unroll
    for (int et = 0; et < 16; ++et) o[et] = (f32x4){0.f, 0.f, 0.f, 0.f};
#pragma unroll
    for (int s = 0; s < 4; ++s) if (2 * s <= wave) {
        const int r1 = 32 * s + 4 * g + q, r2 = r1 + 16;
#pragma unroll
        for (int et = 0; et < 16; ++et) {
            const int chn = 2 * et + (p4 >> 1);
            const bf16x8 a = cat8(tr16(RB + r1 * 512 + ((chn ^ ((r1 & 7) << 1)) << 4) + (p4 & 1) * 8), tr16(RB + r2 * 512 + ((chn ^ ((r2 & 7) << 1)) << 4) + (p4 & 1) * 8));
            o[et] = MFMA16(a, pf[s], o[et]);
        }
    }
    __syncthreads();
    RO_WRITE_ST(RB);
#define RO_STATE_MMA(src, s0) do { _Pragma("unroll") for (int sl_ = 0; sl_ < 2; ++sl_) _Pragma("unroll") for (int k2_ = 0; k2_ < 2; ++k2_) _Pragma("unroll") for (int et = 0; et < 16; ++et) { \
        const int e_ = 16 * et + li; const bf16x8 a_ = *(LAS const bf16x8*)((src) + sl_ * 32768 + e_ * 128 + (((4 * k2_ + g) ^ (e_ & 7)) << 4)); \
        o[et] = MFMA16(a_, qf[2 * ((s0) + sl_) + k2_], o[et]); } } while (0)
    RO_STATE_MMA(RA, 0);
    __syncthreads();
    RO_STATE_MMA(RB, 2);
#undef RO_LOAD_ST
#undef RO_WRITE_ST
#undef RO_STATE_MMA
    float s1 = 0.f;
#pragma unroll
    for (int et = 0; et < 16; ++et) s1 += (o[et][0] + o[et][1]) + (o[et][2] + o[et][3]);
    s1 += __shfl_xor(s1, 16); s1 += __shfl_xor(s1, 32);
    const float mu = s1 * (1.0f / 256.0f); float s2 = 0.f;
#pragma unroll
    for (int et = 0; et < 16; ++et) { o[et] = o[et] - mu; s2 += (o[et][0] * o[et][0] + o[et][1] * o[et][1]) + (o[et][2] * o[et][2] + o[et][3] * o[et][3]); }
    s2 += __shfl_xor(s2, 16); s2 += __shfl_xor(s2, 32);
    const float rstd = 1.0f / sqrtf(s2 * (1.0f / 256.0f) + GN_EPS);
    const int row = R0 + 16 * wave + li;
    const GAS v2u* gp = (const GAS v2u*)(RG + (size_t)row * 1024 + h * 256 + 4 * g); GAS unsigned* op = (GAS unsigned*)(MIX8 + (size_t)row * 2048 + 1024 + h * 256 + 4 * g);
    const float rstd8 = rstd * MIX_F8_SCALE;
#pragma unroll
    for (int et = 0; et < 16; ++et) { const v2u gz = gp[4 * et];
        op[4 * et] = fp8x4(o[et][0] * rstd8 * bflo(gz.x), o[et][1] * rstd8 * bfhi(gz.x), o[et][2] * rstd8 * bflo(gz.y), o[et][3] * rstd8 * bfhi(gz.y)); }
    __syncthreads();
}

typedef float f32x16 __attribute__((ext_vector_type(16)));
#define MFMA32(a, b, c) __builtin_amdgcn_mfma_f32_32x32x16_bf16((a), (b), (c), 0, 0, 0)
__device__ __forceinline__ int crow32(int reg, int hh) { return (reg & 3) + 8 * (reg >> 2) + 4 * hh; }

__device__ __forceinline__ void attn_unit(LAS unsigned char* L, int u, const bf16* QR, unsigned char* MIX8, const bf16* KA, const bf16* VA, const float* sinks, int tid, int lane, int wave) {
    asm volatile("" : "+v"(tid)); lane = tid & 63;
    const int b = u >> 6, j = (u >> 1) & 31, g2 = u & 1, hq = 8 * g2 + wave;
    const int R0 = b * SEQ + 128 * j;
    LAS unsigned char* Kt = L; LAS unsigned char* Vt = L + 32768;
#pragma unroll
    for (int i = 0; i < 4; ++i) { const int cid = tid + 512 * i, kk = cid >> 3, ch = cid & 7;
        int srow; bool ok = true;
        if (kk >= 128) srow = R0 + kk - 128; else if (j > 0) srow = R0 - 128 + kk; else { ok = kk >= 112; srow = NTOK + (ok ? kk - 112 : 0); }
        const v4u kz = *(const GAS v4u*)(KA + (size_t)srow * 128 + g2 * 64 + ch * 8), vz = *(const GAS v4u*)(VA + (size_t)srow * 128 + g2 * 64 + ch * 8);
        *(LAS v4u*)(Kt + kk * 128 + ((ch ^ (kk & 7)) << 4)) = ok ? kz : (v4u){0u, 0u, 0u, 0u};
        *(LAS v4u*)(Vt + kk * 128 + (ch << 4)) = ok ? vz : (v4u){0u, 0u, 0u, 0u}; }
    __syncthreads();
    const int r = lane & 31, hh = lane >> 5, blk = (lane >> 4) & 1, q = (lane & 15) >> 2, p4 = lane & 3;
    const float sk = sinks[hq] * LOG2E;
    v4u qn[4];
    { const GAS v4u* qp = (const GAS v4u*)(QR + (size_t)(R0 + r) * 2048 + hq * 64 + 8 * hh);
#pragma unroll
      for (int ks = 0; ks < 4; ++ks) qn[ks] = qp[2 * ks]; }
#pragma unroll 1
    for (int t = 0; t < 4; ++t) {
        const int i0 = 32 * t;
        bf16x8 qf[4];
#pragma unroll
        for (int ks = 0; ks < 4; ++ks) qf[ks] = __builtin_bit_cast(bf16x8, qn[ks]);
        if (t < 3) { const GAS v4u* qp = (const GAS v4u*)(QR + (size_t)(R0 + i0 + 32 + r) * 2048 + hq * 64 + 8 * hh);
#pragma unroll
          for (int ks = 0; ks < 4; ++ks) qn[ks] = qp[2 * ks]; }
        f32x16 s[5];
#pragma unroll
        for (int x = 0; x < 5; ++x) {
            const int krow_ = 32 * (t + x) + r;
            f32x16 acc;
#pragma unroll
            for (int e = 0; e < 16; ++e) acc[e] = 0.f;
#pragma unroll
            for (int ks = 0; ks < 4; ++ks) { const bf16x8 a = *(LAS const bf16x8*)(Kt + krow_ * 128 + (((2 * ks + hh) ^ (krow_ & 7)) << 4)); acc = MFMA32(a, qf[ks], acc); }
            s[x] = acc; __builtin_amdgcn_sched_barrier(0);
        }
        float m = sk;
#pragma unroll
        for (int e = 0; e < 16; ++e) { const int cr = crow32(e, hh);
            if (!(cr > r)) s[0][e] = -1.0e30f;
            if (!(cr <= r)) s[4][e] = -1.0e30f; }
        if (j == 0) {
#pragma unroll
            for (int x = 0; x < 4; ++x) if (t + x <= 3) {
#pragma unroll
                for (int e = 0; e < 16; ++e) if (32 * (t + x) + crow32(e, hh) < 112) s[x][e] = -1.0e30f; }
        }
#pragma unroll
        for (int x = 0; x < 5; ++x)
#pragma unroll
            for (int e = 0; e < 16; ++e) m = fmaxf(m, s[x][e]);
        m = fmaxf(m, __shfl_xor(m, 32));
        float l = 0.f;
#pragma unroll
        for (int x = 0; x < 5; ++x)
#pragma unroll
            for (int e = 0; e < 16; ++e) { const float pv = exp2f(s[x][e] - m); s[x][e] = pv; l += pv; }
        l += __shfl_xor(l, 32);
        l += exp2f(sk - m);
        f32x16 o[2];
#pragma unroll
        for (int e = 0; e < 16; ++e) { o[0][e] = 0.f; o[1][e] = 0.f; }
#pragma unroll
        for (int x = 0; x < 5; ++x)
#pragma unroll
            for (int st = 0; st < 2; ++st) {
                v4u w; w.x = cvtpk_s(s[x][8 * st + 0], s[x][8 * st + 1]); w.y = cvtpk_s(s[x][8 * st + 2], s[x][8 * st + 3]); w.z = cvtpk_s(s[x][8 * st + 4], s[x][8 * st + 5]); w.w = cvtpk_s(s[x][8 * st + 6], s[x][8 * st + 7]);
                const bf16x8 pb = __builtin_bit_cast(bf16x8, w);
                const int k1 = 32 * (t + x) + 16 * st + 4 * hh + q, k2 = k1 + 8;
#pragma unroll
                for (int dc = 0; dc < 2; ++dc) {
                    const int cb = ((4 * dc + 2 * blk + (p4 >> 1)) << 4) + 8 * (p4 & 1);
                    const bf16x8 a = cat8(tr16(Vt + k1 * 128 + cb), tr16(Vt + k2 * 128 + cb));
                    o[dc] = MFMA32(a, pb, o[dc]);
                }
                __builtin_amdgcn_sched_barrier(0);
            }
        const float il = 1.0f / l;
        const float il8 = il * MIX_F8_SCALE;
        GAS unsigned* op = (GAS unsigned*)(MIX8 + (size_t)(R0 + i0 + r) * 2048 + hq * 64 + 4 * hh);
#pragma unroll
        for (int dc = 0; dc < 2; ++dc)
#pragma unroll
            for (int g4 = 0; g4 < 4; ++g4) op[8 * dc + 2 * g4] = fp8x4(o[dc][4 * g4 + 0] * il8, o[dc][4 * g4 + 1] * il8, o[dc][4 * g4 + 2] * il8, o[dc][4 * g4 + 3] * il8);
    }
    __syncthreads();
}

__device__ __forceinline__ unsigned ord_key(float f) { const unsigned u = __float_as_uint(f); return u ^ ((unsigned)((int)u >> 31) | 0x80000000u); }
__device__ __forceinline__ float ord_val(unsigned k) { return __uint_as_float(k ^ (((int)k < 0) ? 0x80000000u : 0xffffffffu)); }
__device__ __forceinline__ unsigned umed3(unsigned a, unsigned b, unsigned c) { unsigned r; asm("v_med3_u32 %0, %1, %2, %3" : "=v"(r) : "v"(a), "v"(b), "v"(c)); return r; }
#define TK_INS(arr, val) do { const unsigned v_ = (val); _Pragma("unroll") for (int j_ = 15; j_ >= 1; --j_) arr[j_] = umed3(arr[j_ - 1], arr[j_], v_); arr[0] = arr[0] > v_ ? arr[0] : v_; } while (0)
__device__ __forceinline__ void topk_unit(LAS unsigned* Lw, LAS const unsigned char* Lsk, int tt, int hd, const bf16* Q3, unsigned short* IDS, float* GATES, int lane) {
    asm volatile("" : "+v"(lane));
    const int r = lane & 31, hh = lane >> 5, t0 = tt * 32;
    float sv[2][16];
#pragma unroll
    for (int p = 0; p < 2; ++p) {
        f32x16 acc[4];
#pragma unroll
        for (int nt = 0; nt < 4; ++nt)
#pragma unroll
            for (int e = 0; e < 16; ++e) acc[nt][e] = 0.f;
        const GAS v4u* qp = (const GAS v4u*)(Q3 + (size_t)(t0 + r) * DM + hd * 256 + p * 128 + 8 * hh);
        bf16x8 bq[8];
#pragma unroll
        for (int ks = 0; ks < 8; ++ks) bq[ks] = __builtin_bit_cast(bf16x8, qp[2 * ks]);
#pragma unroll
        for (int ks = 0; ks < 8; ++ks) {
#pragma unroll
            for (int nt = 0; nt < 4; ++nt) { const bf16x8 a = *(LAS const bf16x8*)(Lsk + p * 32768 + (32 * nt + r) * 256 + (((2 * ks + hh) ^ (r & 15)) << 4)); acc[nt] = MFMA32(a, bq[ks], acc[nt]); } }
        unsigned tk[16];
#pragma unroll
        for (int j2 = 0; j2 < 16; ++j2) tk[j2] = 0u;
#pragma unroll
        for (int nt = 0; nt < 4; ++nt)
#pragma unroll
            for (int e = 0; e < 16; ++e) { const int n = 32 * nt + crow32(e, hh); TK_INS(tk, (ord_key(acc[nt][e]) & 0xffffff80u) | (unsigned)(127 - n)); }
        unsigned pk[16];
#pragma unroll
        for (int j2 = 0; j2 < 16; ++j2) pk[j2] = (unsigned)__shfl_xor((int)tk[j2], 32);
#pragma unroll
        for (int j2 = 0; j2 < 16; ++j2) TK_INS(tk, pk[j2]);
#pragma unroll
        for (int j2 = 0; j2 < 16; ++j2) { sv[p][j2] = ord_val(tk[j2] & 0xffffff80u); Lw[(p * 16 + j2) * 64 + lane] = 127u - (tk[j2] & 0x7fu); }
    }
    unsigned fk[16];
#pragma unroll
    for (int j2 = 0; j2 < 16; ++j2) fk[j2] = 0u;
#pragma unroll
    for (int i = 0; i < 16; ++i)
#pragma unroll
        for (int j2 = 0; j2 < 16; ++j2) if ((i + 1) * (j2 + 1) <= 16) TK_INS(fk, (ord_key(sv[0][i] + sv[1][j2]) & 0xffffff00u) | (unsigned)(255 - (16 * i + j2)));
    float ev[16]; int idv[16]; float den = 0.f; const float f0 = ord_val(fk[0] & 0xffffff00u);
    LDS_WAIT();
#pragma unroll
    for (int k = 0; k < 16; ++k) { const unsigned idx = 255u - (fk[k] & 0xffu); const unsigned i1 = Lw[(idx >> 4) * 64 + lane], i2 = Lw[(16 + (idx & 15u)) * 64 + lane];
        idv[k] = (int)(i1 * 128u + i2); ev[k] = __expf(ord_val(fk[k] & 0xffffff00u) - f0); den += ev[k]; }
    const float iden = 1.0f / den;
    if (hh == 0) {
        GAS v4u* ip = (GAS v4u*)(IDS + (size_t)(t0 + r) * 128 + hd * 16); GAS f32x4* gp = (GAS f32x4*)(GATES + (size_t)(t0 + r) * 128 + hd * 16);
#pragma unroll
        for (int k8 = 0; k8 < 2; ++k8) ip[k8] = (v4u){(unsigned)idv[8 * k8] | ((unsigned)idv[8 * k8 + 1] << 16), (unsigned)idv[8 * k8 + 2] | ((unsigned)idv[8 * k8 + 3] << 16), (unsigned)idv[8 * k8 + 4] | ((unsigned)idv[8 * k8 + 5] << 16), (unsigned)idv[8 * k8 + 6] | ((unsigned)idv[8 * k8 + 7] << 16)};
#pragma unroll
        for (int k4 = 0; k4 < 4; ++k4) gp[k4] = (f32x4){ev[4 * k4] * iden, ev[4 * k4 + 1] * iden, ev[4 * k4 + 2] * iden, ev[4 * k4 + 3] * iden};
    }
    LDS_WAIT();
}

constexpr int TAB_NQ = 16384 * DM / 4, TAB_CHQ = 4096, TAB_NCH = 2 * TAB_NQ / TAB_CHQ, TAB_SLOT_CHUNKS = 3;
template <int UNR> __device__ __forceinline__ void tab_chunk(int ch, const float* u_tab, const float* v_tab, void* UT, void* VT, int lane) {
    const int which = ch >= TAB_NCH / 2; const float sc = which ? V_QSCALE : U_QSCALE;
    const GAS f32x4* src = (const GAS f32x4*)(which ? v_tab : u_tab) + (size_t)(ch - which * (TAB_NCH / 2)) * TAB_CHQ + lane;
    GAS unsigned char* dstb = (GAS unsigned char*)(which ? VT : UT);
    const int i4b = (ch - which * (TAB_NCH / 2)) * TAB_CHQ + lane;
#pragma unroll 1
    for (int it = 0; it < TAB_CHQ / 64; it += UNR) {
        f32x4 a[UNR];
#pragma unroll
        for (int u8 = 0; u8 < UNR; ++u8) a[u8] = src[(it + u8) * 64];
#pragma unroll
        for (int u8 = 0; u8 < UNR; ++u8) { const int i4 = i4b + (it + u8) * 64; const int row = i4 >> 9, q4 = i4 & 511;
            const int w = q8(a[u8].x * sc) | (q8(a[u8].y * sc) << 8) | (q8(a[u8].z * sc) << 16) | (q8(a[u8].w * sc) << 24);
            *(GAS unsigned*)(dstb + ((size_t)(q4 >> 5) * 16384 + row) * 128 + (q4 & 31) * 4) = (unsigned)w; }
    }
}
struct TabHook {
    gu32* q; const float* u_tab; const float* v_tab; void* UT; void* VT; int slot;
    __device__ __forceinline__ void operator()(int ui) const {
        if (ui != slot) return;
        int lane = threadIdx.x; asm volatile("" : "+v"(lane)); lane &= 63;
#pragma unroll 1
        for (int n = 0; n < TAB_SLOT_CHUNKS; ++n) {
            int ch = 0; if (lane == 0) ch = (int)__hip_atomic_fetch_add((unsigned*)q, 1u, __ATOMIC_RELAXED, __HIP_MEMORY_SCOPE_AGENT);
            ch = __builtin_amdgcn_readfirstlane(ch); if (ch >= TAB_NCH) return;
            tab_chunk<16>(ch, u_tab, v_tab, UT, VT, lane);
        }
    }
};

__global__ void __launch_bounds__(NWAVES * 64, 2) mk_fwd(Args args) {
    extern __shared__ __attribute__((aligned(16))) unsigned char lds[];
    LAS unsigned char* L = (LAS unsigned char*)lds;
    volatile LAS unsigned* MISC = (volatile LAS unsigned*)(L + MISC_OFF);
    const int tid = threadIdx.x, lane = tid & 63, wave = __builtin_amdgcn_readfirstlane(tid >> 6);
    const int G = gridDim.x, bx = blockIdx.x;
    const int vcu = (G % 8 == 0) ? (bx % 8) * (G / 8) + bx / 8 : bx;
    unsigned char* ws = args.ws;
    gu32* ctl = (gu32*)(ws + WS_CTL);
    const float* x = args.in[0]; const float* meta = args.in[1]; const float* ln_in_g = args.in[2]; const float* ln_in_b = args.in[3];
    const float* w_in = args.in[4]; const float* sinks = args.in[5]; const float* w_out = args.in[6]; const float* ln_mix_g = args.in[7]; const float* ln_mix_b = args.in[8];
    const float* wq = args.in[9]; const float* subkeys = args.in[10]; const float* u_tab = args.in[11]; const float* v_tab = args.in[12];
    const float* ln_ffn_g = args.in[13]; const float* ln_ffn_b = args.in[14];
    float* out = args.out;
    bf16* W1T = (bf16*)(ws + WS_W1T); bf16* W2T = (bf16*)(ws + WS_W2T); bf16* W3T = (bf16*)(ws + WS_W3T);
    bf16* H0 = (bf16*)(ws + WS_H0); bf16* QR = (bf16*)(ws + WS_QR); bf16* KA = (bf16*)(ws + WS_KA); bf16* VA = (bf16*)(ws + WS_VA);
    bf16* RK = (bf16*)(ws + WS_RK); bf16* RV = (bf16*)(ws + WS_RV); bf16* RG = (bf16*)(ws + WS_RG);
    bf16* Y = (bf16*)(ws + WS_Y); bf16* H1 = (bf16*)(ws + WS_H1); bf16* Q3 = (bf16*)(ws + WS_QR);
    bf16* STB = (bf16*)(ws + WS_ST);
    unsigned short* IDS = (unsigned short*)(ws + WS_IDS); float* GATES = (float*)(ws + WS_GATES);
    bf16* SKB = (bf16*)(ws + WS_SK);
    signed char* H1Q = (signed char*)(ws + WS_RG); float* HSC = (float*)(ws + WS_HSC);
    bf16* UT = (bf16*)(ws + WS_UT); bf16* VT = (bf16*)(ws + WS_VT);
    signed char* H0Q = (signed char*)(ws + WS_H0Q); signed char* W1Q = (signed char*)(ws + WS_W1Q); signed char* W3Q = (signed char*)(ws + WS_W3Q);
    float* H0S = (float*)(ws + WS_H0S); float* WS1 = (float*)(ws + WS_WS1); float* WS3 = (float*)(ws + WS_WS3);
    unsigned char* MIX8 = (unsigned char*)(ws + WS_H0);
    signed char* W2Q = (signed char*)(ws + WS_W3T); float* WS2 = (float*)(ws + WS_W1T);

    for (int u = tid; u < (LDS_BYTES - LDSCTL_OFF) / 4; u += NWAVES * 64) ((LAS unsigned*)(L + LDSCTL_OFF))[u] = 0u;
    __syncthreads();
    XcdBarrier bar; bar.bar = (unsigned*)(ctl + CW_BAR); bar.x = xb_xcc_id(); bar.st = MISC + 8;
    if (tid == 0) MISC[10] = xb_add(&bar.bar[XB_XCNT(bar.x)], 1u);
#define GRID_BAR() xcd_barrier(bar)
    const int gw = vcu * NWAVES + wave, NGW = G * NWAVES;
    const int gt = gw * 64 + lane, NGT = NGW * 64;

    {
        int lane = threadIdx.x; asm volatile("" : "+v"(lane)); lane &= 63; const int gt = gw * 64 + lane;
        LAS float* scr = (LAS float*)(L + RING_OFF + wave * 16384);
        constexpr int I_2 = (DM / 64) * (DM / 32);
        for (int sx = bx; sx < IN_COLS / 32 + 2 * (DM / 32); sx += G) {
            LAS float* red = (LAS float*)(L + LDSCTL_OFF + 4096);
            if (sx < IN_COLS / 32) w_strip<false>(L + RING_OFF, red, w_in, IN_COLS, w1_logical_col(32 * sx), W1Q + (size_t)32 * sx * DM, WS1 + 32 * sx, tid);
            else if (sx < IN_COLS / 32 + DM / 32) { const int s3 = sx - IN_COLS / 32; w_strip<false>(L + RING_OFF, red, wq, DM, 32 * s3, W3Q + (size_t)32 * s3 * DM, WS3 + 32 * s3, tid); }
            else { const int s2 = sx - IN_COLS / 32 - DM / 32; w_strip<true>(L + RING_OFF, red, w_out, DM, 32 * s2, W2Q + (size_t)32 * s2 * DM, WS2 + 32 * s2, tid); }
        }
#pragma unroll 1
        for (int pass = 0; pass < 2; ++pass) {
          if ((pass ^ (wave & 1)) == 0) {
          } else {
        {
            f32x4 va[8], vn[8];
            int m = gw; if (m < NVALID) ln_load_f32(va, m < NTOK ? x + (size_t)m * DM : meta + (size_t)(m - NTOK) * DM, lane);
            for (; m < MROWS; m += NGW) {
                const int mn = m + NGW; if (mn < NVALID) ln_load_f32(vn, mn < NTOK ? x + (size_t)mn * DM : meta + (size_t)(mn - NTOK) * DM, lane);
                if (m < NVALID) ln_row_f32_to_bf16_q(va, ln_in_g, ln_in_b, nullptr, H0Q + (size_t)m * DM, H0S + m, lane);
                else { GAS v4u* oq = (GAS v4u*)(H0Q + (size_t)m * DM) + lane;
                    oq[0] = (v4u){0u, 0u, 0u, 0u}; oq[64] = (v4u){0u, 0u, 0u, 0u}; if (lane == 0) H0S[m] = 0.f; }
#pragma unroll
                for (int j = 0; j < 8; ++j) va[j] = vn[j];
            }
        }
          }
        }
        for (int e = gt; e < 16 * 128 * 128 / 8; e += NGT) { const GAS f32x4* src = (const GAS f32x4*)subkeys + 2 * (size_t)e; const f32x4 a = src[0], b2 = src[1];
            v4u o; o.x = pk2(a.x, a.y); o.y = pk2(a.z, a.w); o.z = pk2(b2.x, b2.y); o.w = pk2(b2.z, b2.w); ((GAS v4u*)SKB)[e] = o; }
    }
    GRID_BAR();

    {
        pg8::Gemm g{(const bf16*)H0Q, (const bf16*)W1Q, MROWS, IN_COLS, DM / 2, H0S, WS1}; pg8::StaticOrder S; S.init(MROWS, IN_COLS, G, bx, 5);
        pg8::EpiProj E{QR, KA, VA, RK, RV, RG, QSCALE};
        const int nwg1 = (MROWS / 256) * (IN_COLS / 256), T1 = (nwg1 + G - 1) / G, c0 = nwg1 - (T1 - 1) * G;
        TabHook Hk{ctl + CW_TABQ, u_tab, v_tab, (void*)UT, (void*)VT, (bx >= c0 && T1 > 2) ? (bx - c0) % (T1 - 2) : -1};
        pg8::gemm_phase<pg8::EpiProj, pg8::StaticOrder, true, true, TabHook, true>(L + RING_OFF, g, S, E, Hk);
    }
    {
        for (;;) {
            int ch = 0; if (lane == 0) ch = (int)__hip_atomic_fetch_add((unsigned*)(ctl + CW_TABQ), 1u, __ATOMIC_RELAXED, __HIP_MEMORY_SCOPE_AGENT);
            ch = __builtin_amdgcn_readfirstlane(ch); if (ch >= TAB_NCH) break;
            tab_chunk<8>(ch, u_tab, v_tab, (void*)UT, (void*)VT, lane);
        }
    }
    GRID_BAR();

    for (int u = bx; u < 256; u += G) attn_unit(L + RING_OFF, u, QR, MIX8, KA, VA, sinks, tid, lane, wave);

    for (int u = bx; u < 256; u += G) scan_unit(L + RING_OFF, u, RK, RV, STB, tid, lane, wave);
    GRID_BAR();

    for (int u = bx; u < 512; u += G) retout_unit(L + RING_OFF, u, QR, MIX8, RK, RV, RG, STB, tid, lane, wave);
    GRID_BAR();

    {
        pg8::Gemm g{(const bf16*)MIX8, (const bf16*)W2Q, NTOK, DM, DM / 2, nullptr, WS2, 1.0f / MIX_F8_SCALE}; pg8::StaticOrder S; S.init(NTOK, DM, G, bx);
        pg8::EpiGen<1> E{Y, DM, nullptr, ALPHA, H0Q, H0S, nullptr, nullptr, nullptr, nullptr, nullptr, nullptr};
        pg8::gemm_phase<pg8::EpiGen<1>, pg8::StaticOrder, true, true, pg8::NoHook, false, true>(L + RING_OFF, g, S, E);
    }
    GRID_BAR();

    { int l5 = threadIdx.x; asm volatile("" : "+v"(l5)); l5 &= 63;
      v4u wa[4], wn[4]; int m = gw; if (m < NTOK) ln_load_bf16(wa, Y + (size_t)m * DM, l5);
      for (; m < NTOK; m += NGW) { const int mn = m + NGW; if (mn < NTOK) ln_load_bf16(wn, Y + (size_t)mn * DM, l5);
          ln_row_bf16_to_bf16(wa, ln_mix_g, ln_mix_b, nullptr, H1Q + (size_t)m * DM, HSC + m, l5);
#pragma unroll
          for (int j = 0; j < 4; ++j) wa[j] = wn[j]; } }
    GRID_BAR();

    {
        pg8::Gemm g{(const bf16*)H1Q, (const bf16*)W3Q, NTOK, DM, DM / 2, HSC, WS3}; pg8::StaticOrder S; S.init(NTOK, DM, G, bx);
        pg8::EpiGen<2> E{Q3, DM, nullptr, 0.f, nullptr, nullptr, nullptr, nullptr, nullptr, nullptr};
        pg8::gemm_phase<pg8::EpiGen<2>, pg8::StaticOrder, true, true, pg8::NoHook, true>(L + RING_OFF, g, S, E);
    }
    GRID_BAR();

    const bool g8 = (G & 7) == 0; const int nbh = g8 ? (G >> 3) : G, hb = g8 ? (bx >> 3) : bx;
    for (int hd = g8 ? (bx & 7) : 0; hd < 8; hd += g8 ? 8 : 1) {
        __syncthreads();
#pragma unroll
        for (int i = 0; i < 8; ++i) { const int cid = tid + 512 * i, p = cid >> 11, n = (cid >> 4) & 127, ch = cid & 15;
            *(LAS v4u*)(L + RING_OFF + p * 32768 + n * 256 + ((ch ^ (n & 15)) << 4)) = *(const GAS v4u*)(SKB + ((size_t)((hd * 2 + p) * 128 + n)) * 128 + ch * 8); }
        __syncthreads();
        int l7 = threadIdx.x; asm volatile("" : "+v"(l7)); l7 &= 63;
        for (int tt = hb * NWAVES + wave; tt < NTOK / 32; tt += nbh * NWAVES) topk_unit((LAS unsigned*)(L + RING_OFF + 65536 + wave * 8192), L + RING_OFF, tt, hd, Q3, IDS, GATES, l7);
    }
    __syncthreads();
    GRID_BAR();

    int nx = 0, xr = 0, nloc = 1;
    { unsigned* bw = (unsigned*)(ctl + CW_BAR);
#pragma unroll
      for (unsigned j2 = 0; j2 < 16; ++j2) { const unsigned cnt = xb_ld(&bw[XB_XCNT(j2)]); nx += cnt > 0u; xr += (j2 < bar.x && cnt > 0u); if (j2 == bar.x) nloc = (int)cnt; }
      nx = __builtin_amdgcn_readfirstlane(nx); xr = __builtin_amdgcn_readfirstlane(xr); nloc = __builtin_amdgcn_readfirstlane(nloc); if (nx < 1) nx = 1; if (nloc < 1) nloc = 1; }
    const int lrank = __builtin_amdgcn_readfirstlane((int)MISC[10]);
    const int wv = lrank * NWAVES + wave, nwv = nloc * NWAVES;
    float* DOTX = (float*)(ws + WS_RK);
    signed char* CB8 = (signed char*)(ws + WS_KA); float* CSC = (float*)(ws + WS_CSC);
    bf16* YB = (bf16*)(ws + WS_H0);
    {
        int tl = tid; asm volatile("" : "+v"(tl)); const int ln = tl & 63, k = ln >> 3, c8 = ln & 7;
        const unsigned char* UT8 = (const unsigned char*)UT;
        for (int s = xr; s < NSL; s += nx) {
            const unsigned char* Us = UT8 + (size_t)s * 16384 * 128;
            const bool first = (s == xr);
            v4u nid[2][2];
#pragma unroll
            for (int z = 0; z < 2; ++z) { const int tz = wv + z * nwv; const int tc = tz < NTOK ? tz : wv; const GAS v4u* ip = (const GAS v4u*)(IDS + (size_t)tc * 128 + 16 * k);
#pragma unroll
                for (int i = 0; i < 2; ++i) nid[z][i] = ip[i]; }
#pragma unroll 1
            for (int t = wv; t < NTOK; t += 2 * nwv) {
                const bool vB = (t + nwv) < NTOK; const int tt[2] = {t, vB ? t + nwv : t};
                v4u ub[2][16]; v4u hs[2]; int old[2][2];
#pragma unroll
                for (int z = 0; z < 2; ++z) {
#pragma unroll
                    for (int i = 0; i < 16; ++i) { const int pe = 2 * (i & 7) + (i >> 3); const unsigned eid = (nid[z][pe >> 3][(pe >> 1) & 3] >> (16 * (pe & 1))) & 0xffffu; ub[z][i] = *(const GAS v4u*)(Us + (size_t)eid * 128 + 16 * c8); }
                    hs[z] = *(const GAS v4u*)(H1Q + (size_t)tt[z] * DM + 128 * s + 16 * c8); }
#pragma unroll
                for (int z = 0; z < 2; ++z) { const v2u ov = first ? (v2u){0u, 0u} : *(const GAS v2u*)(DOTX + ((size_t)xr * NTOK + tt[z]) * 128 + 2 * ln); old[z][0] = (int)ov.x; old[z][1] = (int)ov.y; }
#pragma unroll
                for (int z = 0; z < 2; ++z) { const int tz = t + (2 + z) * nwv; const int tc = tz < NTOK ? tz : t; const GAS v4u* ip = (const GAS v4u*)(IDS + (size_t)tc * 128 + 16 * k);
#pragma unroll
                    for (int i = 0; i < 2; ++i) nid[z][i] = ip[i]; }
#pragma unroll
                for (int z = 0; z < 2; ++z) {
                    int p[16];
#pragma unroll
                    for (int i = 0; i < 16; ++i) { int d = 0;
                        d = __builtin_amdgcn_sdot4((int)ub[z][i].x, (int)hs[z].x, d, false); d = __builtin_amdgcn_sdot4((int)ub[z][i].y, (int)hs[z].y, d, false);
                        d = __builtin_amdgcn_sdot4((int)ub[z][i].z, (int)hs[z].z, d, false); d = __builtin_amdgcn_sdot4((int)ub[z][i].w, (int)hs[z].w, d, false); p[i] = d; }
                    const bool b0 = (c8 & 1) != 0, b1 = (c8 & 2) != 0, b2 = (c8 & 4) != 0;
                    int r1[8], r2[4], q0, q1;
#define DPPI(v, ctrl) __builtin_amdgcn_update_dpp(0, (v), (ctrl), 0xf, 0xf, true)
#pragma unroll
                    for (int m = 0; m < 8; ++m) { const int keep = b0 ? p[2 * m + 1] : p[2 * m], give = b0 ? p[2 * m] : p[2 * m + 1]; r1[m] = keep + DPPI(give, 0xB1); }
#pragma unroll
                    for (int m = 0; m < 4; ++m) { const int keep = b1 ? r1[2 * m + 1] : r1[2 * m], give = b1 ? r1[2 * m] : r1[2 * m + 1]; r2[m] = keep + DPPI(give, 0x4E); }
                    { const int keep = b2 ? r2[1] : r2[0], give = b2 ? r2[0] : r2[1]; const int gl = DPPI(give, 0x104), gr = DPPI(give, 0x114); q0 = keep + (b2 ? gr : gl); }
                    { const int keep = b2 ? r2[3] : r2[2], give = b2 ? r2[2] : r2[3]; const int gl = DPPI(give, 0x104), gr = DPPI(give, 0x114); q1 = keep + (b2 ? gr : gl); }
#undef DPPI
                    if (z == 0 || vB) *(GAS v2u*)(DOTX + ((size_t)xr * NTOK + tt[z]) * 128 + 2 * ln) = (v2u){(unsigned)(q0 + old[z][0]), (unsigned)(q1 + old[z][1])};
                }
            }
        }
    }
    GRID_BAR();
    int lc = threadIdx.x; asm volatile("" : "+v"(lc)); lc &= 63;
    for (int i8 = gw * 64 + lc; i8 < NTOK * 16; i8 += NGT) {
        const size_t gi = (size_t)i8 * 8; v4u a0 = {0u, 0u, 0u, 0u}, a1 = a0;
        for (int xx = 0; xx < nx; ++xx) { const GAS v4u* dp = (const GAS v4u*)((const int*)DOTX + (size_t)xx * NTOK * 128 + gi); const v4u p0 = dp[0], p1 = dp[1]; a0 += p0; a1 += p1; }
        const GAS f32x4* gp = (const GAS f32x4*)(GATES + gi); const f32x4 g0 = gp[0], g1 = gp[1];
        const float sc = HSC[i8 >> 4] * (1.0f / U_QSCALE);
        float c[8];
        c[0] = g0.x * gelu_erf((float)(int)a0.x * sc); c[1] = g0.y * gelu_erf((float)(int)a0.y * sc); c[2] = g0.z * gelu_erf((float)(int)a0.z * sc); c[3] = g0.w * gelu_erf((float)(int)a0.w * sc);
        c[4] = g1.x * gelu_erf((float)(int)a1.x * sc); c[5] = g1.y * gelu_erf((float)(int)a1.y * sc); c[6] = g1.z * gelu_erf((float)(int)a1.z * sc); c[7] = g1.w * gelu_erf((float)(int)a1.w * sc);
        float am = 0.f;
#pragma unroll
        for (int j2 = 0; j2 < 8; ++j2) am = fmaxf(am, fabsf(c[j2]));
        am = fmaxf(am, DPPF(am, 0xB1)); am = fmaxf(am, DPPF(am, 0x4E)); am = fmaxf(am, DPPF(am, 0x141)); am = fmaxf(am, DPPF(am, 0x128));
        am = fmaxf(am, 1e-30f); const float iq = 127.0f / am;
        v2u o; o.x = (unsigned)(q8(c[0] * iq) | (q8(c[1] * iq) << 8) | (q8(c[2] * iq) << 16) | (q8(c[3] * iq) << 24)); o.y = (unsigned)(q8(c[4] * iq) | (q8(c[5] * iq) << 8) | (q8(c[6] * iq) << 16) | (q8(c[7] * iq) << 24));
        *(GAS v2u*)(CB8 + gi) = o;
        if ((i8 & 15) == 0) CSC[i8 >> 4] = am * (1.0f / (127.0f * V_QSCALE));
    }
    GRID_BAR();
    {
        int tl = tid; asm volatile("" : "+v"(tl)); const int ln = tl & 63, k = ln >> 3, c8 = ln & 7;
        const unsigned char* VT8 = (const unsigned char*)VT;
        for (int s = xr; s < NSL; s += nx) {
            const unsigned char* Vs = VT8 + (size_t)s * 16384 * 128;
            v4u nid[2][2];
#pragma unroll
            for (int z = 0; z < 2; ++z) { const int tz = wv + z * nwv; const int tc = tz < NTOK ? tz : wv; const GAS v4u* ip = (const GAS v4u*)(IDS + (size_t)tc * 128 + 16 * k);
#pragma unroll
                for (int i = 0; i < 2; ++i) nid[z][i] = ip[i]; }
#pragma unroll 1
            for (int t = wv; t < NTOK; t += 2 * nwv) {
                const bool vB = (t + nwv) < NTOK; const int tt[2] = {t, vB ? t + nwv : t};
                v4u vb[2][16]; v4u cf[2]; unsigned hs[2]; float scl[2], hsc[2];
#pragma unroll
                for (int z = 0; z < 2; ++z) {
#pragma unroll
                    for (int i = 0; i < 16; ++i) { const unsigned eid = (nid[z][i >> 3][(i >> 1) & 3] >> (16 * (i & 1))) & 0xffffu; vb[z][i] = *(const GAS v4u*)(Vs + (size_t)eid * 128 + 16 * c8); } }
#pragma unroll
                for (int z = 0; z < 2; ++z) { hs[z] = *(const GAS unsigned short*)(H1Q + (size_t)tt[z] * DM + 128 * s + 16 * c8 + 2 * k); hsc[z] = ALPHA * HSC[tt[z]];
                    cf[z] = *(const GAS v4u*)(CB8 + (size_t)tt[z] * 128 + 16 * k); scl[z] = CSC[tt[z]]; }
#pragma unroll
                for (int z = 0; z < 2; ++z) { const int tz = t + (2 + z) * nwv; const int tc = tz < NTOK ? tz : t; const GAS v4u* ip = (const GAS v4u*)(IDS + (size_t)tc * 128 + 16 * k);
#pragma unroll
                    for (int i = 0; i < 2; ++i) nid[z][i] = ip[i]; }
#pragma unroll
                for (int z = 0; z < 2; ++z) {
                    int ai[16];
#pragma unroll
                    for (int q2 = 0; q2 < 16; ++q2) ai[q2] = 0;
#pragma unroll
                    for (int ig = 0; ig < 4; ++ig) { const int cq = (int)cf[z][ig];
#pragma unroll
                        for (int dw = 0; dw < 4; ++dw) {
                            const unsigned d0 = vb[z][4 * ig][dw], d1 = vb[z][4 * ig + 1][dw], d2 = vb[z][4 * ig + 2][dw], d3 = vb[z][4 * ig + 3][dw];
                            const unsigned p0 = __builtin_amdgcn_perm(d1, d0, 0x05010400u), p1 = __builtin_amdgcn_perm(d1, d0, 0x07030602u), p2 = __builtin_amdgcn_perm(d3, d2, 0x05010400u), p3 = __builtin_amdgcn_perm(d3, d2, 0x07030602u);
                            ai[4 * dw + 0] = __builtin_amdgcn_sdot4((int)__builtin_amdgcn_perm(p2, p0, 0x05040100u), cq, ai[4 * dw + 0], false);
                            ai[4 * dw + 1] = __builtin_amdgcn_sdot4((int)__builtin_amdgcn_perm(p2, p0, 0x07060302u), cq, ai[4 * dw + 1], false);
                            ai[4 * dw + 2] = __builtin_amdgcn_sdot4((int)__builtin_amdgcn_perm(p3, p1, 0x05040100u), cq, ai[4 * dw + 2], false);
                            ai[4 * dw + 3] = __builtin_amdgcn_sdot4((int)__builtin_amdgcn_perm(p3, p1, 0x07060302u), cq, ai[4 * dw + 3], false); } }
                    const bool kb0 = (k & 1) != 0, kb1 = (k & 2) != 0, kb2 = (k & 4) != 0;
                    int rAx[4], rAy[4], rBx[2], rBy[2], rCx, rCy;
#define DPPI(v, ctrl) __builtin_amdgcn_update_dpp(0, (v), (ctrl), 0xf, 0xf, true)
#pragma unroll
                    for (int m = 0; m < 4; ++m) { const int kx = kb0 ? ai[4 * m + 2] : ai[4 * m], ky = kb0 ? ai[4 * m + 3] : ai[4 * m + 1], gx = kb0 ? ai[4 * m] : ai[4 * m + 2], gy = kb0 ? ai[4 * m + 1] : ai[4 * m + 3];
                        rAx[m] = kx + DPPI(gx, 0x128); rAy[m] = ky + DPPI(gy, 0x128); }
#pragma unroll
                    for (int m = 0; m < 2; ++m) { const int kx = kb1 ? rAx[2 * m + 1] : rAx[2 * m], ky = kb1 ? rAy[2 * m + 1] : rAy[2 * m], gx = kb1 ? rAx[2 * m] : rAx[2 * m + 1], gy = kb1 ? rAy[2 * m] : rAy[2 * m + 1];
                        const auto sx = __builtin_amdgcn_permlane16_swap((unsigned)gx, (unsigned)gx, false, false), sy = __builtin_amdgcn_permlane16_swap((unsigned)gy, (unsigned)gy, false, false);
                        rBx[m] = kx + (int)(kb1 ? sx[0] : sx[1]); rBy[m] = ky + (int)(kb1 ? sy[0] : sy[1]); }
                    { const int kx = kb2 ? rBx[1] : rBx[0], ky = kb2 ? rBy[1] : rBy[0], gx = kb2 ? rBx[0] : rBx[1], gy = kb2 ? rBy[0] : rBy[1];
                        const auto sx = __builtin_amdgcn_permlane32_swap((unsigned)gx, (unsigned)gx, false, false), sy = __builtin_amdgcn_permlane32_swap((unsigned)gy, (unsigned)gy, false, false);
                        rCx = kx + (int)(kb2 ? sx[0] : sx[1]); rCy = ky + (int)(kb2 ? sy[0] : sy[1]); }
#undef DPPI
                    if (z == 0 || vB) *(GAS unsigned*)(YB + (size_t)tt[z] * DM + 128 * s + 16 * c8 + 2 * k) = cvtpk_s((float)rCx * scl[z] + hsc[z] * (float)(int)(signed char)(hs[z] & 0xffu), (float)rCy * scl[z] + hsc[z] * (float)(int)(signed char)(hs[z] >> 8));
                }
            }
        }
    }
    GRID_BAR();
    { int lane = threadIdx.x; asm volatile("" : "+v"(lane)); lane &= 63;
    v4u wa[4], wn[4]; if (gw < NTOK) ln_load_bf16(wa, YB + (size_t)gw * DM, lane);
    for (int m = gw; m < NTOK; m += NGW) {
        { const int mn = m + NGW; if (mn < NTOK) ln_load_bf16(wn, YB + (size_t)mn * DM, lane); }
        float v[32]; float sm = 0.f;
#pragma unroll
        for (int j2 = 0; j2 < 4; ++j2) { const v4u w = wa[j2];
            v[8 * j2 + 0] = bflo(w.x); v[8 * j2 + 1] = bfhi(w.x); v[8 * j2 + 2] = bflo(w.y); v[8 * j2 + 3] = bfhi(w.y); v[8 * j2 + 4] = bflo(w.z); v[8 * j2 + 5] = bfhi(w.z); v[8 * j2 + 6] = bflo(w.w); v[8 * j2 + 7] = bfhi(w.w); }
#pragma unroll
        for (int i = 0; i < 32; ++i) sm += v[i];
        const float mean = wave_sum(sm) * (1.f / DM); float s2 = 0.f;
#pragma unroll
        for (int i = 0; i < 32; ++i) { v[i] -= mean; s2 += v[i] * v[i]; }
        const float rstd = 1.f / sqrtf(wave_sum(s2) * (1.f / DM) + LN_EPS);
#pragma unroll
        for (int j2 = 0; j2 < 4; ++j2) {
            const GAS f32x4* gp = (const GAS f32x4*)ln_ffn_g + 2 * (lane + 64 * j2); const GAS f32x4* bp = (const GAS f32x4*)ln_ffn_b + 2 * (lane + 64 * j2);
            const f32x4 g0 = gp[0], g1 = gp[1], b0 = bp[0], b1 = bp[1];
            GAS f32x4* op = (GAS f32x4*)(out + (size_t)m * DM) + 2 * (lane + 64 * j2);
            op[0] = (f32x4){v[8 * j2 + 0] * rstd * g0.x + b0.x, v[8 * j2 + 1] * rstd * g0.y + b0.y, v[8 * j2 + 2] * rstd * g0.z + b0.z, v[8 * j2 + 3] * rstd * g0.w + b0.w};
            op[1] = (f32x4){v[8 * j2 + 4] * rstd * g1.x + b1.x, v[8 * j2 + 5] * rstd * g1.y + b1.y, v[8 * j2 + 6] * rstd * g1.z + b1.z, v[8 * j2 + 7] * rstd * g1.w + b1.w}; }
#pragma unroll
        for (int j2 = 0; j2 < 4; ++j2) wa[j2] = wn[j2];
    }
    }
}

extern "C" void kernel_launch(void* const* d_in, const int* in_sizes, int n_in, void* d_out, int out_size, void* d_ws, size_t ws_size, hipStream_t stream) {
    static int grid = 0;
    if (grid == 0) {
        if (n_in != 15 || out_size != NTOK * DM || ws_size < WS_END) { fprintf(stderr, "kernel_launch: unexpected shapes (n_in %d out %d ws %zu)\n", n_in, out_size, ws_size); grid = -1; return; }
        int dev = 0, cus = 0, per_cu = 0;
        if (hipGetDevice(&dev) != hipSuccess || hipDeviceGetAttribute(&cus, hipDeviceAttributeMultiprocessorCount, dev) != hipSuccess) { grid = -1; return; }
        if (hipFuncSetAttribute((const void*)mk_fwd, hipFuncAttributeMaxDynamicSharedMemorySize, LDS_BYTES) != hipSuccess) { fprintf(stderr, "kernel_launch: hipFuncSetAttribute failed\n"); grid = -1; return; }
        if (hipOccupancyMaxActiveBlocksPerMultiprocessor(&per_cu, (const void*)mk_fwd, NWAVES * 64, LDS_BYTES) != hipSuccess || per_cu < 1) { fprintf(stderr, "kernel_launch: occupancy query says %d\n", per_cu); }
        (void)hipGetLastError();
        grid = cus;
    }
    if (grid < 0) return;
    if (hipMemsetAsync((char*)d_ws + WS_CTL, 0, CTL_ZERO_BYTES, stream) != hipSuccess) return;
    Args a{};
    for (int i = 0; i < 15; ++i) a.in[i] = (const float*)d_in[i];
    a.out = (float*)d_out; a.ws = (unsigned char*)d_ws;
    hipLaunchKernelGGL(mk_fwd, dim3(grid), dim3(NWAVES * 64), LDS_BYTES, stream, a);
}
```

```cpp
#include <hip/hip_runtime.h>
#include <cstdio>
#include <cstdint>
#include <cmath>
namespace pg8 {
#define PG8_LAS __attribute__((address_space(3)))
typedef unsigned short bf16_t;
typedef short bf16x8 __attribute__((ext_vector_type(8)));
typedef float f32x4 __attribute__((ext_vector_type(4)));
typedef unsigned u32x4 __attribute__((ext_vector_type(4)));
constexpr int BM = 256, BK = 64, HALF = 128, HTB = HALF * BK * 2  , STAGE_BYTES = 8 * HTB, NXCD = 8, WGM = 4;

__host__ __device__ __forceinline__ int lds_byte(int r, int c) { const int st = (r >> 4) * 2 + (c >> 5), rr = r & 15, cc = c & 31, ob = rr * 64 + cc * 2; return st * 1024 + (ob ^ (((ob >> 9) & 1) << 5)); }
__host__ __device__ __forceinline__ void stage_rc(int b, int& R, int& C) { const int st = b / 1024, sb = b % 1024, swz = sb ^ (((sb >> 9) & 1) << 5); R = (st >> 1) * 16 + swz / 64; C = (st & 1) * 32 + (swz % 64) / 2; }
__host__ __device__ __forceinline__ int perm32(int rho) { const int n = rho >> 4, i = rho & 15; return 8 * (i >> 2) + 4 * n + (i & 3); }

struct Unit { int pm, pn; };
struct Gemm { const bf16_t* A; const bf16_t* Bt; int M, N, K; const float* rs; const float* cs; float ascale = 1.0f; };
typedef int i32x4 __attribute__((ext_vector_type(4)));
typedef int i32x8 __attribute__((ext_vector_type(8)));

struct StaticOrder {
    int nM, nN, nwg, G, c, wgm;
    __host__ __device__ void init(int M, int N, int G_, int c_, int wgm_ = WGM) { nM = M / BM; nN = N / BM; nwg = nM * nN; G = G_; c = c_; wgm = wgm_; }
    __host__ __device__ bool next(int i, Unit& u) const {
        const long L = (long)i * G + c; if (L >= nwg) return false;
        int wgid = (int)L; { const int q = nwg / NXCD, r = nwg % NXCD, xcd = wgid % NXCD, off = wgid / NXCD; wgid = (xcd < r ? xcd * (q + 1) : r * (q + 1) + (xcd - r) * q) + off; }
        const int nig = wgm * nN, gid = wgid / nig, fm = gid * wgm, gsz = (nM - fm) < wgm ? (nM - fm) : wgm;
        u.pm = fm + ((wgid % nig) % gsz); u.pn = (wgid % nig) / gsz; return true;
    }
    __device__ __forceinline__ void a_ready(const Unit&) const {}
    __device__ __forceinline__ void done(const Unit&) const {}
};

__device__ __forceinline__ unsigned cvt_pk_bf16(float lo, float hi) { unsigned r; asm volatile("v_cvt_pk_bf16_f32 %0, %1, %2" : "=v"(r) : "v"(lo), "v"(hi)); return r; }
typedef float f32x2 __attribute__((ext_vector_type(2)));

template <int MODE> struct EpiGen {
    static constexpr bool PERM = true, AFTER_DRAIN = false;
    bf16_t* O; int ldc; const bf16_t* R; float alpha;
    const signed char* R8 = nullptr; const float* RS = nullptr;
    bf16_t *QR, *KA, *VA, *RK, *RV, *RG;
    __device__ __forceinline__ void operator()(const f32x4 (&acc)[2][2][4][2], const Unit& u, int wr, int wc, int fr, int fq) const {
        const int row0 = u.pm * BM + wr * 64 + fr;
#pragma unroll
        for (int bj = 0; bj < 2; ++bj) {
            const int col = u.pn * BM + bj * HALF + wc * 32 + 8 * fq;
            bf16_t* base = O; int ld = ldc; int cc = col;
            if (MODE == 0) {
                if (col < 1024)      { base = QR; ld = 2048; cc = col; }
                else if (col < 1152) { base = KA; ld = 128;  cc = col - 1024; }
                else if (col < 1280) { base = VA; ld = 128;  cc = col - 1152; }
                else if (col < 2304) { base = QR; ld = 2048; cc = col - 1280 + 1024; }
                else if (col < 3328) { base = RK; ld = 1024; cc = col - 2304; }
                else if (col < 4352) { base = RV; ld = 1024; cc = col - 3328; }
                else                 { base = RG; ld = 1024; cc = col - 4352; }
            }
#pragma unroll
            for (int ai = 0; ai < 2; ++ai)
#pragma unroll
                for (int m = 0; m < 4; ++m) {
                    const int row = row0 + ai * HALF + m * 16;
                    f32x4 v0 = acc[ai][bj][m][0], v1 = acc[ai][bj][m][1];
                    if (MODE == 1) {
                        const unsigned long long rr = *(const unsigned long long*)(R8 + (size_t)row * ldc + col);
                        const unsigned r0 = (unsigned)rr ^ 0x80808080u, r1 = (unsigned)(rr >> 32) ^ 0x80808080u;
                        const float as = alpha * RS[row], ab = -128.0f * as;
                        v0[0] += (float)(r0 & 0xffu) * as + ab; v0[1] += (float)((r0 >> 8) & 0xffu) * as + ab; v0[2] += (float)((r0 >> 16) & 0xffu) * as + ab; v0[3] += (float)(r0 >> 24) * as + ab;
                        v1[0] += (float)(r1 & 0xffu) * as + ab; v1[1] += (float)((r1 >> 8) & 0xffu) * as + ab; v1[2] += (float)((r1 >> 16) & 0xffu) * as + ab; v1[3] += (float)(r1 >> 24) * as + ab;
                    }
                    u32x4 w; w.x = cvt_pk_bf16(v0[0], v0[1]); w.y = cvt_pk_bf16(v0[2], v0[3]); w.z = cvt_pk_bf16(v1[0], v1[1]); w.w = cvt_pk_bf16(v1[2], v1[3]);
                    *(u32x4*)(base + (size_t)row * ld + cc) = w;
                }
        }
    }
};

struct EpiProj {
    static constexpr bool PERM = true, AFTER_DRAIN = false;
    bf16_t *QR, *KA, *VA, *RK, *RV, *RG; float qscale;
    __device__ __forceinline__ void operator()(const f32x4 (&acc)[2][2][4][2], const Unit& u, int wr, int wc, int fr, int fq) const {
        const int pn = u.pn, row0 = u.pm * BM + wr * 64 + fr, c0 = wc * 32 + 8 * fq;
        const bool rope = (pn <= 3) || (pn == 4 && wc < 2) || (pn >= 5 && pn <= 12);
        if (rope) {
            const bool ret = pn >= 5; const int h = ret ? ((pn - 5) & 3) : 0;
            const float lg = __builtin_amdgcn_logf(1.0f - __builtin_amdgcn_exp2f(-5.0f - (float)h));
            float invrev[8];
#pragma unroll
            for (int i8 = 0; i8 < 8; ++i8) { const float ii = (float)((ret ? c0 : 8 * fq) + i8); invrev[i8] = 0.15915494309189535f * __builtin_amdgcn_exp2f(-ii * (ret ? 0.10381025296523008f : 0.4152410118609203f)); }
            bf16_t* base; int ld, cA, cB;
            if (pn <= 3)      { base = QR; ld = 2048; cA = pn * 256 + 64 * wc + 8 * fq; cB = cA + 32; }
            else if (pn == 4) { base = KA; ld = 128;  cA = 64 * wc + 8 * fq; cB = cA + 32; }
            else if (pn <= 8) { base = QR; ld = 2048; cA = 1024 + 256 * h + c0; cB = cA + 128; }
            else              { base = RK; ld = 1024; cA = 256 * h + c0; cB = cA + 128; }
#pragma unroll
            for (int ai = 0; ai < 2; ++ai)
#pragma unroll
                for (int m = 0; m < 4; ++m) {
                    const int row = row0 + ai * HALF + m * 16;
                    int pos, ipos;
                    if (row < 16384) { const int s = row & 4095; pos = 16 + s; ipos = s & 127; } else { int j = row - 16384; if (j > 15) j = 15; pos = j; ipos = 112 + j; }
                    float sc = qscale;
                    if (pn == 4) sc = 1.0f; else if (pn >= 9) sc = 0.0625f * __builtin_amdgcn_exp2f(-(float)(ipos + 1) * lg); else if (pn >= 5) sc = __builtin_amdgcn_exp2f((float)(ipos + 1) * lg);
                    const float pf = (float)pos;
                    float cs[8], sn[8];
#pragma unroll
                    for (int i8 = 0; i8 < 8; ++i8) { const float rev = __builtin_amdgcn_fractf(pf * invrev[i8]); cs[i8] = __builtin_amdgcn_cosf(rev); sn[i8] = __builtin_amdgcn_sinf(rev); }
                    const f32x4 a0 = acc[ai][0][m][0], a1 = acc[ai][0][m][1], b0 = acc[ai][1][m][0], b1 = acc[ai][1][m][1];
                    u32x4 wA, wB;
                    wA.x = cvt_pk_bf16((a0[0] * cs[0] - b0[0] * sn[0]) * sc, (a0[1] * cs[1] - b0[1] * sn[1]) * sc); wA.y = cvt_pk_bf16((a0[2] * cs[2] - b0[2] * sn[2]) * sc, (a0[3] * cs[3] - b0[3] * sn[3]) * sc);
                    wA.z = cvt_pk_bf16((a1[0] * cs[4] - b1[0] * sn[4]) * sc, (a1[1] * cs[5] - b1[1] * sn[5]) * sc); wA.w = cvt_pk_bf16((a1[2] * cs[6] - b1[2] * sn[6]) * sc, (a1[3] * cs[7] - b1[3] * sn[7]) * sc);
                    wB.x = cvt_pk_bf16((b0[0] * cs[0] + a0[0] * sn[0]) * sc, (b0[1] * cs[1] + a0[1] * sn[1]) * sc); wB.y = cvt_pk_bf16((b0[2] * cs[2] + a0[2] * sn[2]) * sc, (b0[3] * cs[3] + a0[3] * sn[3]) * sc);
                    wB.z = cvt_pk_bf16((b1[0] * cs[4] + a1[0] * sn[4]) * sc, (b1[1] * cs[5] + a1[1] * sn[5]) * sc); wB.w = cvt_pk_bf16((b1[2] * cs[6] + a1[2] * sn[6]) * sc, (b1[3] * cs[7] + a1[3] * sn[7]) * sc);
                    *(u32x4*)(base + (size_t)row * ld + cA) = wA; *(u32x4*)(base + (size_t)row * ld + cB) = wB;
                }
        } else {
            const bool silu = pn >= 17;
#pragma unroll
            for (int bj = 0; bj < 2; ++bj) {
                bf16_t* base; int ld, cc;
                if (pn == 4)       { base = VA; ld = 128;  cc = 64 * bj + 32 * (wc - 2) + 8 * fq; }
                else if (pn <= 16) { base = RV; ld = 1024; cc = 256 * (pn - 13) + 128 * bj + c0; }
                else               { base = RG; ld = 1024; cc = 256 * (pn - 17) + 128 * bj + c0; }
#pragma unroll
                for (int ai = 0; ai < 2; ++ai)
#pragma unroll
                    for (int m = 0; m < 4; ++m) {
                        const int row = row0 + ai * HALF + m * 16;
                        f32x4 v0 = acc[ai][bj][m][0], v1 = acc[ai][bj][m][1];
                        if (silu) {
#pragma unroll
                            for (int e = 0; e < 4; ++e) { v0[e] = v0[e] * __builtin_amdgcn_rcpf(1.0f + __builtin_amdgcn_exp2f(-1.4426950408889634f * v0[e])); v1[e] = v1[e] * __builtin_amdgcn_rcpf(1.0f + __builtin_amdgcn_exp2f(-1.4426950408889634f * v1[e])); } }
                        u32x4 w; w.x = cvt_pk_bf16(v0[0], v0[1]); w.y = cvt_pk_bf16(v0[2], v0[3]); w.z = cvt_pk_bf16(v1[0], v1[1]); w.w = cvt_pk_bf16(v1[2], v1[3]);
                        *(u32x4*)(base + (size_t)row * ld + cc) = w;
                    }
            }
        }
    }
};
struct NoHook { __device__ __forceinline__ void operator()(int) const {} };
template <class Epi, class Sched, bool ALIGN_EPI = false, bool SP2 = false, class Hook = NoHook, bool I8 = false, bool F8 = false>
__device__ __forceinline__ void gemm_phase(PG8_LAS unsigned char* lds, const Gemm g, const Sched& S, const Epi& E, const Hook& H = Hook()) {
    int tid_ = threadIdx.x; asm volatile("" : "+v"(tid_));
    const int tid = tid_, wid = __builtin_amdgcn_readfirstlane(tid >> 6), lane = tid & 63, wr = wid >> 2, wc = wid & 3, fr = lane & 15, fq = lane >> 4;
    const int K = g.K, nt = K / BK;
    unsigned voffA[2], voffB[2];
#pragma unroll
    for (int i = 0; i < 2; ++i) { int R, C; stage_rc(tid * 16 + i * 8192, R, C); const int Rb = Epi::PERM ? ((R & ~31) + perm32(R & 31)) : R;
        voffA[i] = (unsigned)(R * K + C) * 2u; voffB[i] = (unsigned)(Rb * K + C) * 2u; }
    const size_t kstep = (size_t)(BK * 2);
    const size_t hstep = (size_t)HALF * K * 2;
    const size_t tstep = 2 * hstep;
    const unsigned ldsw = (unsigned)wid * 1024u;
    const int aoff = lds_byte(wr * 64 + fr, fq * 8), boff = lds_byte(wc * 32 + fr, fq * 8);
#define PG8_SA(b, h) (((b) * 2 + (h)) * HTB)
#define PG8_SB(b, h) ((4 + (b) * 2 + (h)) * HTB)
#define PG8_STAGE(bufoff, gbase, voff) do { _Pragma("unroll") for (int _i = 0; _i < 2; ++_i) { unsigned vo_ = (voff)[_i]; if constexpr (F8) asm volatile("" : "+v"(vo_)); \
        __builtin_amdgcn_global_load_lds((const unsigned*)((const char*)(gbase) + vo_), (PG8_LAS unsigned*)(lds + (bufoff) + ldsw + _i * 8192), 16, 0, 0); } } while (0)
#define PG8_LDA(dst, b, h) do { _Pragma("unroll") for (int m = 0; m < 4; ++m) _Pragma("unroll") for (int k = 0; k < 2; ++k) dst[m][k] = *(const PG8_LAS bf16x8*)(lds + PG8_SA(b, h) + aoff + m * 2048 + k * 1024); } while (0)
#define PG8_LDB(dst, b, h) do { _Pragma("unroll") for (int n = 0; n < 2; ++n) _Pragma("unroll") for (int k = 0; k < 2; ++k) dst[n][k] = *(const PG8_LAS bf16x8*)(lds + PG8_SB(b, h) + boff + n * 2048 + k * 1024); } while (0)
#define PG8_CAT8(x) __builtin_shufflevector(__builtin_bit_cast(i32x4, (x)[0]), __builtin_bit_cast(i32x4, (x)[1]), 0, 1, 2, 3, 4, 5, 6, 7)
#define PG8_MMA(ai, bj, At, Bt) do { __builtin_amdgcn_s_setprio(1); if constexpr (F8) { _Pragma("unroll") for (int m = 0; m < 4; ++m) _Pragma("unroll") for (int n = 0; n < 2; ++n) \
        acc[ai][bj][m][n] = __builtin_amdgcn_mfma_scale_f32_16x16x128_f8f6f4(PG8_CAT8(Bt[n]), PG8_CAT8(At[m]), acc[ai][bj][m][n], 0, 0, 0, 0x7f7f7f7f, 0, 0x7f7f7f7f); } else \
    _Pragma("unroll") for (int m = 0; m < 4; ++m) _Pragma("unroll") for (int n = 0; n < 2; ++n) _Pragma("unroll") for (int k = 0; k < 2; ++k) \
        { if constexpr (I8) acc[ai][bj][m][n] = __builtin_bit_cast(f32x4, __builtin_amdgcn_mfma_i32_16x16x64_i8(__builtin_bit_cast(i32x4, Bt[n][k]), __builtin_bit_cast(i32x4, At[m][k]), __builtin_bit_cast(i32x4, acc[ai][bj][m][n]), 0, 0, 0)); \
          else acc[ai][bj][m][n] = __builtin_amdgcn_mfma_f32_16x16x32_bf16(Bt[n][k], At[m][k], acc[ai][bj][m][n], 0, 0, 0); } __builtin_amdgcn_s_setprio(0); } while (0)
#define PG8_WAIT_V(n) asm volatile("s_waitcnt vmcnt(" #n ")" ::: "memory")
#define PG8_WAIT_L(n) asm volatile("s_waitcnt lgkmcnt(" #n ")" ::: "memory")
#define PG8_BAR __builtin_amdgcn_s_barrier()
#define PG8_SCHED __builtin_amdgcn_sched_barrier(0)
    Unit cur, nxt; int ui = 0;
    if (!S.next(0, cur)) return;
    f32x4 acc[2][2][4][2];
#pragma unroll
    for (int a = 0; a < 2; ++a)
#pragma unroll
        for (int b = 0; b < 2; ++b)
#pragma unroll
            for (int m = 0; m < 4; ++m)
#pragma unroll
                for (int n = 0; n < 2; ++n) acc[a][b][m][n] = (f32x4){0.f, 0.f, 0.f, 0.f};
    bf16x8 At[4][2], B0[2][2], B1[2][2];
    const char* cA = (const char*)g.A + (size_t)cur.pm * tstep; const char* cB = (const char*)g.Bt + (size_t)cur.pn * tstep;
    S.a_ready(cur);
    if constexpr (SP2) {
        PG8_STAGE(PG8_SB(0, 0), cB, voffB); PG8_STAGE(PG8_SB(0, 1), cB + hstep, voffB); PG8_STAGE(PG8_SA(0, 0), cA, voffA); PG8_STAGE(PG8_SA(0, 1), cA + hstep, voffA);
        if (wr == 1) PG8_BAR;
        PG8_WAIT_V(2); PG8_BAR;
        PG8_STAGE(PG8_SB(1, 0), cB + kstep, voffB); PG8_STAGE(PG8_SA(1, 0), cA + kstep, voffA); PG8_STAGE(PG8_SB(1, 1), cB + hstep + kstep, voffB);
        PG8_WAIT_V(6); PG8_BAR;
    } else {
        PG8_STAGE(PG8_SB(0, 0), cB, voffB); PG8_STAGE(PG8_SA(0, 0), cA, voffA); PG8_STAGE(PG8_SB(0, 1), cB + hstep, voffB); PG8_STAGE(PG8_SA(0, 1), cA + hstep, voffA);
        if (wr == 1) PG8_BAR;
        PG8_WAIT_V(4); PG8_BAR;
        PG8_STAGE(PG8_SB(1, 0), cB + kstep, voffB); PG8_STAGE(PG8_SA(1, 0), cA + kstep, voffA); PG8_STAGE(PG8_SB(1, 1), cB + hstep + kstep, voffB);
        PG8_WAIT_V(6); PG8_BAR;
    }
    for (;;) {
        const bool has_next = S.next(ui + 1, nxt);
        const char* nA = has_next ? (const char*)g.A + (size_t)nxt.pm * tstep : cA; const char* nB = has_next ? (const char*)g.Bt + (size_t)nxt.pn * tstep : cB;
        for (int t = 0; t < nt; t += 2) {
            const bool last = (t == nt - 2);
            const char* a1 = cA + (size_t)(t + 1) * kstep;
            const char* a2 = last ? nA : cA + (size_t)(t + 2) * kstep; const char* b2 = last ? nB : cB + (size_t)(t + 2) * kstep;
            const char* a3 = a2 + kstep; const char* b3 = b2 + kstep;
            if (last && has_next) S.a_ready(nxt);
            if constexpr (SP2) {
            PG8_LDB(B0, 0, 0); PG8_LDB(B1, 0, 1); PG8_SCHED; PG8_LDA(At, 0, 0); PG8_STAGE(PG8_SA(1, 1), a1 + hstep, voffA);
            PG8_WAIT_V(8); PG8_WAIT_L(0); PG8_BAR; PG8_MMA(0, 0, At, B0); PG8_MMA(0, 1, At, B1); PG8_BAR; PG8_SCHED;
            PG8_LDA(At, 0, 1); PG8_STAGE(PG8_SB(0, 0), b2, voffB); PG8_STAGE(PG8_SB(0, 1), b2 + hstep, voffB); PG8_STAGE(PG8_SA(0, 0), a2, voffA);
            PG8_WAIT_V(8); PG8_WAIT_L(0); PG8_BAR; PG8_MMA(1, 0, At, B0); PG8_MMA(1, 1, At, B1); PG8_BAR; PG8_SCHED;
            PG8_LDB(B0, 1, 0); PG8_LDB(B1, 1, 1); PG8_SCHED; PG8_LDA(At, 1, 0); PG8_STAGE(PG8_SA(0, 1), a2 + hstep, voffA);
            PG8_WAIT_V(8); PG8_WAIT_L(0); PG8_BAR; PG8_MMA(0, 0, At, B0); PG8_MMA(0, 1, At, B1); PG8_BAR; PG8_SCHED;
            PG8_LDA(At, 1, 1); PG8_STAGE(PG8_SB(1, 0), b3, voffB); PG8_STAGE(PG8_SB(1, 1), b3 + hstep, voffB); PG8_STAGE(PG8_SA(1, 0), a3, voffA);
            PG8_WAIT_V(8); PG8_WAIT_L(0); PG8_BAR; PG8_MMA(1, 0, At, B0); PG8_MMA(1, 1, At, B1); PG8_BAR; PG8_SCHED;
            } else {
            PG8_LDB(B0, 0, 0); PG8_SCHED; PG8_LDA(At, 0, 0); PG8_STAGE(PG8_SA(1, 1), a1 + hstep, voffA);
            PG8_WAIT_L(8); PG8_BAR; PG8_WAIT_L(0); PG8_MMA(0, 0, At, B0); PG8_BAR; PG8_SCHED;
            PG8_LDB(B1, 0, 1); PG8_STAGE(PG8_SB(0, 0), b2, voffB);
            PG8_BAR; PG8_WAIT_L(0); PG8_MMA(0, 1, At, B1); PG8_BAR;
            PG8_LDA(At, 0, 1); PG8_STAGE(PG8_SA(0, 0), a2, voffA);
            PG8_BAR; PG8_WAIT_L(0); PG8_MMA(1, 0, At, B0); PG8_BAR; PG8_SCHED;
            PG8_STAGE(PG8_SB(0, 1), b2 + hstep, voffB);
            PG8_WAIT_V(6); PG8_BAR; PG8_MMA(1, 1, At, B1); PG8_BAR;
            PG8_LDB(B0, 1, 0); PG8_SCHED; PG8_LDA(At, 1, 0); PG8_STAGE(PG8_SA(0, 1), a2 + hstep, voffA);
            PG8_WAIT_L(8); PG8_BAR; PG8_WAIT_L(0); PG8_MMA(0, 0, At, B0); PG8_BAR; PG8_SCHED;
            PG8_LDB(B1, 1, 1); PG8_STAGE(PG8_SB(1, 0), b3, voffB);
            PG8_BAR; PG8_WAIT_L(0); PG8_MMA(0, 1, At, B1); PG8_BAR;
            PG8_LDA(At, 1, 1); PG8_STAGE(PG8_SA(1, 0), a3, voffA);
            PG8_BAR; PG8_WAIT_L(0); PG8_MMA(1, 0, At, B0); PG8_BAR; PG8_SCHED;
            PG8_STAGE(PG8_SB(1, 1), b3 + hstep, voffB);
            PG8_WAIT_V(6); PG8_BAR; PG8_MMA(1, 1, At, B1); PG8_BAR;
            }
        }
        if constexpr (ALIGN_EPI) { if (wr == 0) PG8_BAR; }
        int frl = fr, fql = fq; asm volatile("" : "+v"(frl), "+v"(fql));
        if constexpr (I8 || F8) {
            const int row0 = cur.pm * BM + wr * 64 + frl;
            float rsv[2][4];
#pragma unroll
            for (int ai = 0; ai < 2; ++ai)
#pragma unroll
                for (int m = 0; m < 4; ++m) rsv[ai][m] = F8 ? g.ascale : g.rs[row0 + ai * HALF + m * 16];
#pragma unroll
            for (int bj = 0; bj < 2; ++bj) {
                const int col = cur.pn * BM + bj * HALF + wc * 32 + 8 * fql;
                const f32x4 c0 = *(const f32x4*)(g.cs + col), c1 = *(const f32x4*)(g.cs + col + 4);
#pragma unroll
                for (int ai = 0; ai < 2; ++ai)
#pragma unroll
                    for (int m = 0; m < 4; ++m)
                    {
                        const i32x4 i0 = __builtin_bit_cast(i32x4, acc[ai][bj][m][0]), i1 = __builtin_bit_cast(i32x4, acc[ai][bj][m][1]);
                        f32x4 f0, f1;
#pragma unroll
                        for (int e = 0; e < 4; ++e) { f0[e] = (F8 ? acc[ai][bj][m][0][e] : (float)i0[e]) * (rsv[ai][m] * c0[e]); f1[e] = (F8 ? acc[ai][bj][m][1][e] : (float)i1[e]) * (rsv[ai][m] * c1[e]); }
                        acc[ai][bj][m][0] = f0; acc[ai][bj][m][1] = f1; }
            }
        }
        if constexpr (!Epi::AFTER_DRAIN) { E(acc, cur, wr, wc, frl, fql); S.done(cur); }
        if (!has_next) break;
        H(ui);
#pragma unroll
        for (int a = 0; a < 2; ++a)
#pragma unroll
            for (int b = 0; b < 2; ++b)
#pragma unroll
                for (int m = 0; m < 4; ++m)
#pragma unroll
                    for (int n = 0; n < 2; ++n) acc[a][b][m][n] = (f32x4){0.f, 0.f, 0.f, 0.f};
        cur = nxt; cA = nA; cB = nB; ++ui;
        if constexpr (ALIGN_EPI) { if (wr == 1) PG8_BAR; }
    }
    PG8_WAIT_V(0);
    if constexpr (!ALIGN_EPI) { if (wr == 0) PG8_BAR; }
    PG8_BAR;
    if constexpr (Epi::AFTER_DRAIN) { E.fused(acc, cur, wr, wc, fr, fq, lds, wid, lane); S.done(cur); }
#undef PG8_SA
#undef PG8_SB
#undef PG8_STAGE
#undef PG8_LDA
#undef PG8_LDB
#undef PG8_MMA
#undef PG8_WAIT_V
#undef PG8_WAIT_L
#undef PG8_BAR
#undef PG8_SCHED
}
}

constexpr int NWAVES = 8;
constexpr int DM = 2048, NB = 4, SEQ = 4096, NTOK = NB * SEQ;
constexpr int NMETA = 16, NVALID = NTOK + NMETA, MROWS = 16640;
constexpr int IN_COLS = 5376;
constexpr float LN_EPS = 1e-5f, GN_EPS = 1e-5f;
constexpr float ALPHA = 1.189207115002721f;
constexpr float LOG2E = 1.4426950408889634f;
constexpr float QSCALE = 0.125f * LOG2E;
constexpr float U_QSCALE = 958.0f;
constexpr float V_QSCALE = 35.6f;
constexpr int NSL = 16;

constexpr size_t MiB = 1u << 20;
constexpr size_t WS_CTL = 0, CTL_ZERO_BYTES = 65536;
constexpr size_t SZ_SK = (size_t)16 * 128 * 128 * 2, SZ_ROPE_R = (size_t)4112 * 128 * 8, SZ_ROPE_A = (size_t)4112 * 32 * 8;
constexpr size_t SZ_W2T = (size_t)DM * DM * 2, SZ_W1T = (size_t)IN_COLS * DM * 2, SZ_TAB = (size_t)16384 * DM;
constexpr size_t SZ_ROWS2K = (size_t)MROWS * 2048 * 2, SZ_ROWS1K = (size_t)MROWS * 1024 * 2, SZ_ROWS128 = (size_t)MROWS * 128 * 2;
constexpr size_t SZ_TOK2K = (size_t)NTOK * 2048 * 2, SZ_ST = (size_t)16 * 32 * 256 * 256 * 2, SZ_IDS = (size_t)NTOK * 128 * 4;
constexpr size_t al256(size_t x) { return (x + 255) & ~(size_t)255; }
constexpr size_t WS_SK = 1 * MiB;
constexpr size_t WS_ROPE_R = al256(WS_SK + SZ_SK);
constexpr size_t WS_ROPE_A = al256(WS_ROPE_R + SZ_ROPE_R);
constexpr size_t WS_W2T = al256(WS_ROPE_A + SZ_ROPE_A), WS_W3T = al256(WS_W2T + SZ_W2T), WS_W1T = al256(WS_W3T + SZ_W2T);
constexpr size_t WS_UT = al256(WS_W1T + SZ_W1T), WS_VT = al256(WS_UT + SZ_TAB);
constexpr size_t WS_H0 = al256(WS_VT + SZ_TAB);
constexpr size_t WS_QR = al256(WS_H0 + SZ_ROWS2K);
constexpr size_t WS_KA = al256(WS_QR + SZ_ROWS2K), WS_VA = al256(WS_KA + SZ_ROWS128);
constexpr size_t WS_RK = al256(WS_VA + SZ_ROWS128), WS_RV = al256(WS_RK + SZ_ROWS1K), WS_RG = al256(WS_RV + SZ_ROWS1K);
constexpr size_t WS_ST = al256(WS_RG + SZ_ROWS1K);
constexpr size_t WS_Y = WS_RK;
constexpr size_t WS_H1 = WS_ST;
constexpr size_t WS_IDS = al256(WS_ST + SZ_ST), WS_GATES = al256(WS_IDS + SZ_IDS);
constexpr size_t WS_HSC = al256(WS_GATES + SZ_IDS);
constexpr size_t WS_CSC = al256(WS_HSC + (size_t)NTOK * 4);
constexpr size_t WS_H0Q = al256(WS_CSC + (size_t)NTOK * 4);
constexpr size_t WS_W1Q = al256(WS_H0Q + (size_t)MROWS * DM);
constexpr size_t WS_W3Q = al256(WS_W1Q + (size_t)IN_COLS * DM);
constexpr size_t WS_H0S = al256(WS_W3Q + (size_t)DM * DM);
constexpr size_t WS_WS1 = al256(WS_H0S + (size_t)MROWS * 4);
constexpr size_t WS_WS3 = al256(WS_WS1 + (size_t)IN_COLS * 4);
constexpr size_t WS_END = al256(WS_WS3 + (size_t)DM * 4);
static_assert(WS_Y + SZ_TOK2K <= WS_RG, "Y overlays RK|RV only");
static_assert(SZ_TOK2K <= SZ_ST && (size_t)NTOK * 1024 * 4 <= SZ_ST, "H1 / RET_RAW fit the state region");
static_assert(WS_END <= (size_t)512 * MiB, "workspace map fits 4 x largest tensor");
static_assert(WS_RK + (size_t)8 * NTOK * 128 * 4 <= WS_ST && WS_KA + (size_t)NTOK * 128 * 4 <= WS_RK && WS_H0 + (size_t)NTOK * DM * 4 <= WS_KA, "expert-phase overlays (DOTX over RK|RV, CB over KA|VA, Y32 over H0|QR)");
constexpr int CW_TMO = 0, CW_TABQ = 64, CW_BAR = 4096;

constexpr int RING_OFF = 0, RING_BYTES = 131072;
constexpr int LDSCTL_OFF = RING_BYTES, MISC_OFF = LDSCTL_OFF + 320;
constexpr int LDS_BYTES = 147456;

#define GAS __attribute__((address_space(1)))
#define LAS __attribute__((address_space(3)))
typedef unsigned short bf16;
typedef unsigned v4u __attribute__((ext_vector_type(4)));
typedef unsigned v2u __attribute__((ext_vector_type(2)));
typedef float f32x4 __attribute__((ext_vector_type(4)));
typedef float f32x2 __attribute__((ext_vector_type(2)));
typedef GAS unsigned gu32;
typedef __bf16 bf16x2_t __attribute__((ext_vector_type(2)));
#define RLX_AGENT __ATOMIC_RELAXED, __HIP_MEMORY_SCOPE_AGENT
#define LDS_WAIT() asm volatile("s_waitcnt lgkmcnt(0)" ::: "memory")
#define VM_WAIT() asm volatile("s_waitcnt vmcnt(0)" ::: "memory")
#define LDS_BAR() do { asm volatile("s_waitcnt lgkmcnt(0)" ::: "memory"); __builtin_amdgcn_s_barrier(); asm volatile("" ::: "memory"); } while (0)
__device__ __forceinline__ unsigned f2bf(float f) { unsigned u = __builtin_bit_cast(unsigned, f); return (u + 0x7fffu + ((u >> 16) & 1u)) >> 16; }
__device__ __forceinline__ unsigned pk2(float lo, float hi) { return f2bf(lo) | (f2bf(hi) << 16); }
__device__ __forceinline__ float bflo(unsigned w) { return __uint_as_float(w << 16); }
__device__ __forceinline__ float bfhi(unsigned w) { return __uint_as_float(w & 0xffff0000u); }
__device__ __forceinline__ float bf2f(bf16 h) { return __uint_as_float((unsigned)h << 16); }

#define XB_TMO      128
#define XB_XCNT(j)  (256  + 64 * (j))
#define XB_XSUB(j)  (1280 + 64 * (j))
#define XB_XGEN(j)  (2304 + 64 * (j))
#define XB_TOP      3328
#define XB_TOPGEN   3392
#define XCD_BAR_WORDS 3456
#define XB_SPIN_CAP (1u << 18)

__device__ __forceinline__ unsigned xb_ld(unsigned* p)              { return __hip_atomic_load(p, __ATOMIC_RELAXED, __HIP_MEMORY_SCOPE_AGENT); }
__device__ __forceinline__ unsigned xb_add(unsigned* p, unsigned v) { return __hip_atomic_fetch_add(p, v, __ATOMIC_RELAXED, __HIP_MEMORY_SCOPE_AGENT); }
__device__ __forceinline__ unsigned xb_xcc_id() { return (unsigned)__builtin_amdgcn_s_getreg((3 << 11) | 20) & 0xFu; }
#define XB_SPIN(cond, bar) do { unsigned _sp = 0; while (cond) { __builtin_amdgcn_s_sleep(1); \
    if ((++_sp & 255u) == 0u) { if (xb_ld(&(bar)[XB_TMO])) break; if (_sp > XB_SPIN_CAP) { atomicAdd(&(bar)[XB_TMO], 1u); break; } } } } while (0)

struct XcdBarrier {
    unsigned* bar; unsigned x;
    volatile LAS unsigned* st;
};

__device__ __forceinline__ XcdBarrier xcd_barrier_post(unsigned* bar, volatile LAS unsigned* st) {
    XcdBarrier b; b.bar = bar; b.x = xb_xcc_id(); b.st = st;
    if (threadIdx.x == 0) (void)xb_add(&bar[XB_XCNT(b.x)], 1u);
    return b;
}
__device__ __forceinline__ void xcd_barrier_complete(unsigned* bar, unsigned x, unsigned& nloc, unsigned& nx) {
    const unsigned G = gridDim.x * gridDim.y * gridDim.z;
    unsigned sum, cnt, mine, sp = 0u;
    for (;;) {
        sum = 0u; cnt = 0u; mine = 0u;
#pragma unroll
        for (unsigned j = 0; j < 16; ++j) { const unsigned c = xb_ld(&bar[XB_XCNT(j)]); sum += c; cnt += (c > 0u) ? 1u : 0u; mine = (j == x) ? c : mine; }
        if (sum == G) break;
        __builtin_amdgcn_s_sleep(1);
        if ((++sp & 255u) == 0u) { if (xb_ld(&bar[XB_TMO])) break; if (sp > XB_SPIN_CAP) { atomicAdd(&bar[XB_TMO], 1u); break; } }
    }
    nloc = mine > 0u ? mine : 1u; nx = cnt > 0u ? cnt : 1u;
}

__device__ __forceinline__ void xcd_barrier(const XcdBarrier& b) {
    asm volatile("s_waitcnt vmcnt(0)" ::: "memory");
    __syncthreads();
    if (threadIdx.x == 0) {
        unsigned* bar = b.bar;
        __builtin_amdgcn_s_waitcnt(0);
        unsigned nloc = b.st[0], nx = b.st[1];
        if (nloc == 0u) { xcd_barrier_complete(bar, b.x, nloc, nx); b.st[0] = nloc; b.st[1] = nx; }
        const unsigned old = xb_add(&bar[XB_XSUB(b.x)], 1u);
        const unsigned gen = old / nloc;
        if (old + 1u == (gen + 1u) * nloc) {
            __builtin_amdgcn_fence(__ATOMIC_RELEASE, "agent");
            asm volatile("s_waitcnt vmcnt(0)" ::: "memory");
            const unsigned og = xb_add(&bar[XB_TOP], 1u);
            const unsigned tg = og / nx;
            if (og + 1u == (tg + 1u) * nx) xb_add(&bar[XB_TOPGEN], 1u);
            else XB_SPIN(xb_ld(&bar[XB_TOPGEN]) == tg, bar);
            __builtin_amdgcn_fence(__ATOMIC_ACQUIRE, "agent");
            xb_add(&bar[XB_XGEN(b.x)], 1u);
            asm volatile("s_waitcnt vmcnt(0)" ::: "memory");
        } else {
            XB_SPIN(xb_ld(&bar[XB_XGEN(b.x)]) == gen, bar);
            __builtin_amdgcn_fence(__ATOMIC_ACQUIRE, "agent");
            asm volatile("s_waitcnt vmcnt(0)" ::: "memory");
        }
    }
    __syncthreads();
}


__device__ __forceinline__ float dot2bf(unsigned a, unsigned b, float c) { asm("v_dot2c_f32_bf16 %0, %1, %2" : "+v"(c) : "v"(a), "v"(b)); return c; }
__device__ __forceinline__ float dot8bf_dpp(v4u a, v4u b) { float c = 0.f; asm("v_dot2c_f32_bf16 %0, %1, %5\n\tv_dot2c_f32_bf16 %0, %2, %6\n\tv_dot2c_f32_bf16 %0, %3, %7\n\tv_dot2c_f32_bf16 %0, %4, %8\n\ts_nop 1" : "+v"(c) : "v"(a.x), "v"(a.y), "v"(a.z), "v"(a.w), "v"(b.x), "v"(b.y), "v"(b.z), "v"(b.w)); return c; }
#define DPPF(v, ctrl) __int_as_float(__builtin_amdgcn_update_dpp(0, __float_as_int(v), (ctrl), 0xf, 0xf, true))
__device__ __forceinline__ int q8(float x) { int q = (int)__builtin_rintf(x); q = q < -127 ? -127 : (q > 127 ? 127 : q); return q & 0xff; }
__device__ __forceinline__ unsigned fp8x4(float a, float b, float c, float d) {
    a = __builtin_amdgcn_fmed3f(a, -440.f, 440.f); b = __builtin_amdgcn_fmed3f(b, -440.f, 440.f); c = __builtin_amdgcn_fmed3f(c, -440.f, 440.f); d = __builtin_amdgcn_fmed3f(d, -440.f, 440.f);
    int w = 0; w = __builtin_amdgcn_cvt_pk_fp8_f32(a, b, w, false); w = __builtin_amdgcn_cvt_pk_fp8_f32(c, d, w, true); return (unsigned)w; }
constexpr float MIX_F8_SCALE = 8.0f;
__device__ __forceinline__ float wave_sum(float v) {
    v += DPPF(v, 0xB1); v += DPPF(v, 0x4E); v += DPPF(v, 0x141); v += DPPF(v, 0x128);
    { const auto r16 = __builtin_amdgcn_permlane16_swap(__float_as_uint(v), __float_as_uint(v), false, false); v = __uint_as_float(r16[0]) + __uint_as_float(r16[1]); }
    { const auto r32 = __builtin_amdgcn_permlane32_swap(__float_as_uint(v), __float_as_uint(v), false, false); v = __uint_as_float(r32[0]) + __uint_as_float(r32[1]); }
    return v;
}
__device__ __forceinline__ float wave_max(float v) {
    v = fmaxf(v, DPPF(v, 0xB1)); v = fmaxf(v, DPPF(v, 0x4E)); v = fmaxf(v, DPPF(v, 0x141)); v = fmaxf(v, DPPF(v, 0x128));
    { const auto r16 = __builtin_amdgcn_permlane16_swap(__float_as_uint(v), __float_as_uint(v), false, false); v = fmaxf(__uint_as_float(r16[0]), __uint_as_float(r16[1])); }
    { const auto r32 = __builtin_amdgcn_permlane32_swap(__float_as_uint(v), __float_as_uint(v), false, false); v = fmaxf(__uint_as_float(r32[0]), __uint_as_float(r32[1])); }
    return v;
}
__device__ __forceinline__ float gelu_erf(float v) {
    const float av = fabsf(v), d = av * 0.2316418882f + 1.0f;
    const float t = __builtin_amdgcn_rcpf(d);
    float q = t * 0.5307027145f + (-0.7265760135f); q = q * t + 0.7107068705f; q = q * t + (-0.142248368f); q = q * t + 0.127414796f; q = q * t;
    const float e = __builtin_amdgcn_exp2f((v * v) * (-0.72134752044f));
    const float m = v * (q * e);
    return v < 0.f ? m : v - m;
}

struct Args { const float* in[15]; float* out; unsigned char* ws; };

__device__ __forceinline__ int w1_logical_col(int n0p) {
    const int pn = n0p >> 8, blk = (n0p & 255) >> 5, half = blk >> 2, a = blk & 3;
    if (pn <= 3) return pn * 256 + 64 * a + 32 * half;
    if (pn == 4) return (a < 2) ? (1024 + 64 * a + 32 * half) : (1152 + 64 * half + 32 * (a - 2));
    return n0p;
}
template <bool PERMW1> __device__ __forceinline__ void p0_transpose_item(const float* W, int K, int N, bf16* WT, LAS float* scr, int item, int lane) {
    const int nblk = N / 32, kb = item / nblk, nb = item % nblk, k0 = 64 * kb, n0 = 32 * nb; const int ns = PERMW1 ? w1_logical_col(n0) : n0;
    float tv[32];
#pragma unroll
    for (int i = 0; i < 32; ++i) { const int kk = 2 * i + (lane >> 5); tv[i] = W[(size_t)(k0 + kk) * N + ns + (lane & 31)]; }
#pragma unroll
    for (int i = 0; i < 32; ++i) { const int kk = 2 * i + (lane >> 5); scr[kk * 33 + (lane & 31)] = tv[i]; }
    LDS_WAIT(); asm volatile("" ::: "memory");
    const int c = lane & 7;
#pragma unroll
    for (int j = 0; j < 4; ++j) { const int n = (lane >> 3) + 8 * j; const LAS float* s = scr + (8 * c) * 33 + n;
        v4u o; o.x = pk2(s[0 * 33], s[1 * 33]); o.y = pk2(s[2 * 33], s[3 * 33]); o.z = pk2(s[4 * 33], s[5 * 33]); o.w = pk2(s[6 * 33], s[7 * 33]);
        *(GAS v4u*)(WT + (size_t)(n0 + n) * K + k0 + 8 * c) = o; }
    LDS_WAIT(); asm volatile("" ::: "memory");
}
__device__ __forceinline__ void ln_load_f32(f32x4 (&v)[8], const float* xrow, int lane) {
    const GAS f32x4* xr = (const GAS f32x4*)xrow + lane;
#pragma unroll
    for (int j = 0; j < 8; ++j) v[j] = xr[64 * j];
}
__device__ __forceinline__ void ln_row_f32_to_bf16(f32x4 (&v)[8], const float* g, const float* bta, bf16* orow, int lane) {
    float s = 0.f;
#pragma unroll
    for (int j = 0; j < 8; ++j) s += (v[j].x + v[j].y) + (v[j].z + v[j].w);
    const float mean = wave_sum(s) * (1.f / DM); float s2 = 0.f;
#pragma unroll
    for (int j = 0; j < 8; ++j) { v[j] = v[j] - mean; s2 += (v[j].x * v[j].x + v[j].y * v[j].y) + (v[j].z * v[j].z + v[j].w * v[j].w); }
    const float rstd = 1.f / sqrtf(wave_sum(s2) * (1.f / DM) + LN_EPS);
    GAS v2u* o8 = (GAS v2u*)orow + lane;
#pragma unroll
    for (int j = 0; j < 8; ++j) { const f32x4 gg = ((const GAS f32x4*)g)[lane + 64 * j], bb = ((const GAS f32x4*)bta)[lane + 64 * j];
        v2u o; o.x = pk2(v[j].x * rstd * gg.x + bb.x, v[j].y * rstd * gg.y + bb.y); o.y = pk2(v[j].z * rstd * gg.z + bb.z, v[j].w * rstd * gg.w + bb.w); o8[64 * j] = o; }
}
__device__ __forceinline__ void ln_row_f32_to_bf16_q(f32x4 (&v)[8], const float* g, const float* bta, bf16* orow, signed char* qrow, float* qscale, int lane) {
    float s = 0.f;
#pragma unroll
    for (int j = 0; j < 8; ++j) s += (v[j].x + v[j].y) + (v[j].z + v[j].w);
    const float mean = wave_sum(s) * (1.f / DM); float s2 = 0.f;
#pragma unroll
    for (int j = 0; j < 8; ++j) { v[j] = v[j] - mean; s2 += (v[j].x * v[j].x + v[j].y * v[j].y) + (v[j].z * v[j].z + v[j].w * v[j].w); }
    const float rstd = 1.f / sqrtf(wave_sum(s2) * (1.f / DM) + LN_EPS);
    GAS v2u* o8 = (GAS v2u*)orow + lane; float am = 0.f;
#pragma unroll
    for (int j = 0; j < 8; ++j) { const f32x4 gg = ((const GAS f32x4*)g)[lane + 64 * j], bb = ((const GAS f32x4*)bta)[lane + 64 * j];
        v[j].x = v[j].x * rstd * gg.x + bb.x; v[j].y = v[j].y * rstd * gg.y + bb.y; v[j].z = v[j].z * rstd * gg.z + bb.z; v[j].w = v[j].w * rstd * gg.w + bb.w;
        am = fmaxf(am, fmaxf(fmaxf(fabsf(v[j].x), fabsf(v[j].y)), fmaxf(fabsf(v[j].z), fabsf(v[j].w))));
        if (orow) { v2u o; o.x = pk2(v[j].x, v[j].y); o.y = pk2(v[j].z, v[j].w); o8[64 * j] = o; } }
    am = fmaxf(wave_max(am), 1e-20f); const float iq = 127.0f / am;
    if (lane == 0) *qscale = am * (1.0f / 127.0f);
#pragma unroll
    for (int j = 0; j < 8; ++j) ((GAS unsigned*)qrow)[lane + 64 * j] = (unsigned)(q8(v[j].x * iq) | (q8(v[j].y * iq) << 8) | (q8(v[j].z * iq) << 16) | (q8(v[j].w * iq) << 24));
}
template <bool F8> __device__ __forceinline__ void w_strip(LAS unsigned char* L, LAS float* red, const float* W, int ld, int ns, signed char* dst, float* sc, int tid) {
    asm volatile("" : "+v"(tid));
    const int kr = tid >> 3, c4 = tid & 7, lane = tid & 63, wave = __builtin_amdgcn_readfirstlane(tid >> 6);
    float mx[4] = {0.f, 0.f, 0.f, 0.f};
    const GAS f32x4* src = (const GAS f32x4*)(W + (size_t)kr * ld + ns) + c4;
#pragma unroll 1
    for (int r0 = 0; r0 < 32; r0 += 16) {
        f32x4 a[16];
#pragma unroll
        for (int i = 0; i < 16; ++i) a[i] = src[(size_t)(64 * (r0 + i)) * (ld / 4)];
#pragma unroll
        for (int i = 0; i < 16; ++i) { const int k = 64 * (r0 + i) + kr; const int so = ((((k >> 3) ^ c4)) << 4) + (k & 7) * 2;
#pragma unroll
            for (int j = 0; j < 4; ++j) { mx[j] = fmaxf(mx[j], fabsf(a[i][j])); *(LAS unsigned short*)(L + (4 * c4 + j) * 4096 + so) = (unsigned short)f2bf(a[i][j]); } }
    }
#pragma unroll
    for (int j = 0; j < 4; ++j) { mx[j] = fmaxf(mx[j], __shfl_xor(mx[j], 8)); mx[j] = fmaxf(mx[j], __shfl_xor(mx[j], 16)); mx[j] = fmaxf(mx[j], __shfl_xor(mx[j], 32)); }
    if (lane < 8) {
#pragma unroll
        for (int j = 0; j < 4; ++j) red[wave * 32 + 4 * c4 + j] = mx[j]; }
    LDS_BAR();
#pragma unroll 1
    for (int nn = 0; nn < 4; ++nn) {
        const int n = 4 * wave + nn; float am = 0.f;
#pragma unroll
        for (int w8 = 0; w8 < 8; ++w8) am = fmaxf(am, red[w8 * 32 + n]);
        am = fmaxf(am, 1e-30f); const float iq = (F8 ? 384.0f : 127.0f) / am;
        if (lane == 0) sc[n] = am * (F8 ? 1.0f / 384.0f : 1.0f / 127.0f);
#pragma unroll
        for (int h = 0; h < 2; ++h) { const int run = h * 64 + lane;
            const v4u w0 = *(LAS const v4u*)(L + n * 4096 + (((2 * run) ^ (wave & 7)) << 4)), w1 = *(LAS const v4u*)(L + n * 4096 + (((2 * run + 1) ^ (wave & 7)) << 4));
            v4u o;
            if constexpr (F8) {
                o.x = fp8x4(bflo(w0.x) * iq, bfhi(w0.x) * iq, bflo(w0.y) * iq, bfhi(w0.y) * iq); o.y = fp8x4(bflo(w0.z) * iq, bfhi(w0.z) * iq, bflo(w0.w) * iq, bfhi(w0.w) * iq);
                o.z = fp8x4(bflo(w1.x) * iq, bfhi(w1.x) * iq, bflo(w1.y) * iq, bfhi(w1.y) * iq); o.w = fp8x4(bflo(w1.z) * iq, bfhi(w1.z) * iq, bflo(w1.w) * iq, bfhi(w1.w) * iq);
            } else {
            o.x = (unsigned)(q8(bflo(w0.x) * iq) | (q8(bfhi(w0.x) * iq) << 8) | (q8(bflo(w0.y) * iq) << 16) | (q8(bfhi(w0.y) * iq) << 24));
            o.y = (unsigned)(q8(bflo(w0.z) * iq) | (q8(bfhi(w0.z) * iq) << 8) | (q8(bflo(w0.w) * iq) << 16) | (q8(bfhi(w0.w) * iq) << 24));
            o.z = (unsigned)(q8(bflo(w1.x) * iq) | (q8(bfhi(w1.x) * iq) << 8) | (q8(bflo(w1.y) * iq) << 16) | (q8(bfhi(w1.y) * iq) << 24));
            o.w = (unsigned)(q8(bflo(w1.z) * iq) | (q8(bfhi(w1.z) * iq) << 8) | (q8(bflo(w1.w) * iq) << 16) | (q8(bfhi(w1.w) * iq) << 24)); }
            *(GAS v4u*)(dst + (size_t)n * DM + 16 * run) = o; }
    }
    LDS_BAR();
}
__device__ __forceinline__ void ln_load_bf16(v4u (&w4)[4], const bf16* xrow, int lane) {
    const GAS v4u* xr = (const GAS v4u*)xrow + lane;
#pragma unroll
    for (int j = 0; j < 4; ++j) w4[j] = xr[64 * j];
}
__device__ __forceinline__ void ln_row_bf16_to_bf16(const v4u (&w4)[4], const float* g, const float* bta, bf16* orow, signed char* qrow, float* qscale, int lane) {
    float v[32]; float s = 0.f;
#pragma unroll
    for (int j = 0; j < 4; ++j) { const v4u w = w4[j];
        v[8 * j + 0] = bflo(w.x); v[8 * j + 1] = bfhi(w.x); v[8 * j + 2] = bflo(w.y); v[8 * j + 3] = bfhi(w.y);
        v[8 * j + 4] = bflo(w.z); v[8 * j + 5] = bfhi(w.z); v[8 * j + 6] = bflo(w.w); v[8 * j + 7] = bfhi(w.w); }
#pragma unroll
    for (int i = 0; i < 32; ++i) s += v[i];
    const float mean = wave_sum(s) * (1.f / DM); float s2 = 0.f;
#pragma unroll
    for (int i = 0; i < 32; ++i) { v[i] -= mean; s2 += v[i] * v[i]; }
    const float rstd = 1.f / sqrtf(wave_sum(s2) * (1.f / DM) + LN_EPS);
    GAS v4u* o16 = (GAS v4u*)orow + lane;
#pragma unroll
    for (int j = 0; j < 4; ++j) {
        const GAS f32x4* gp = (const GAS f32x4*)g + 2 * (lane + 64 * j); const GAS f32x4* bp = (const GAS f32x4*)bta + 2 * (lane + 64 * j);
        const f32x4 g0 = gp[0], g1 = gp[1], b0 = bp[0], b1 = bp[1];
        v4u o; o.x = pk2(v[8 * j + 0] * rstd * g0.x + b0.x, v[8 * j + 1] * rstd * g0.y + b0.y); o.y = pk2(v[8 * j + 2] * rstd * g0.z + b0.z, v[8 * j + 3] * rstd * g0.w + b0.w);
        o.z = pk2(v[8 * j + 4] * rstd * g1.x + b1.x, v[8 * j + 5] * rstd * g1.y + b1.y); o.w = pk2(v[8 * j + 6] * rstd * g1.z + b1.z, v[8 * j + 7] * rstd * g1.w + b1.w);
        if (orow) o16[64 * j] = o;
        v[8 * j + 0] = v[8 * j + 0] * rstd * g0.x + b0.x; v[8 * j + 1] = v[8 * j + 1] * rstd * g0.y + b0.y; v[8 * j + 2] = v[8 * j + 2] * rstd * g0.z + b0.z; v[8 * j + 3] = v[8 * j + 3] * rstd * g0.w + b0.w;
        v[8 * j + 4] = v[8 * j + 4] * rstd * g1.x + b1.x; v[8 * j + 5] = v[8 * j + 5] * rstd * g1.y + b1.y; v[8 * j + 6] = v[8 * j + 6] * rstd * g1.z + b1.z; v[8 * j + 7] = v[8 * j + 7] * rstd * g1.w + b1.w; }
    float am = 0.f;
#pragma unroll
    for (int i = 0; i < 32; ++i) am = fmaxf(am, fabsf(v[i]));
    am = wave_max(am);
    am = fmaxf(am, 1e-20f); const float iq = 127.0f / am;
    if (lane == 0) *qscale = am * (1.0f / 127.0f);
#pragma unroll
    for (int j = 0; j < 4; ++j) { v2u w; w.x = (unsigned)(q8(v[8 * j + 0] * iq) | (q8(v[8 * j + 1] * iq) << 8) | (q8(v[8 * j + 2] * iq) << 16) | (q8(v[8 * j + 3] * iq) << 24));
        w.y = (unsigned)(q8(v[8 * j + 4] * iq) | (q8(v[8 * j + 5] * iq) << 8) | (q8(v[8 * j + 6] * iq) << 16) | (q8(v[8 * j + 7] * iq) << 24)); ((GAS v2u*)qrow)[lane + 64 * j] = w; }
}
__device__ __forceinline__ void row_pos(int r, int& pos, int& ipos) {
    if (r < NTOK) { const int s = r & (SEQ - 1); pos = NMETA + s; ipos = s & 127; }
    else { int j = r - NTOK; if (j > NMETA - 1) j = NMETA - 1; pos = j; ipos = 112 + j; }
}
__device__ __forceinline__ float log2_gamma(int h) { return log2f(1.0f - exp2f(-5.0f - (float)h)); }


typedef short bf16x8 __attribute__((ext_vector_type(8)));
typedef short s16x4 __attribute__((ext_vector_type(4)));
#define MFMA16(a, b, c) __builtin_amdgcn_mfma_f32_16x16x32_bf16((a), (b), (c), 0, 0, 0)
__device__ __forceinline__ s16x4 tr16(LAS const unsigned char* p) { return __builtin_bit_cast(s16x4, __builtin_amdgcn_ds_read_tr16_b64_v4i16((LAS s16x4*)p)); }
__device__ __forceinline__ bf16x8 cat8(s16x4 a, s16x4 b) { return __builtin_shufflevector(a, b, 0, 1, 2, 3, 4, 5, 6, 7); }
__device__ __forceinline__ unsigned cvtpk_s(float lo, float hi) { f32x2 v = {lo, hi}; bf16x2_t b = __builtin_convertvector(v, bf16x2_t); return __builtin_bit_cast(unsigned, b); }
__device__ __forceinline__ unsigned cvtpk(float lo, float hi) { unsigned r; asm("v_cvt_pk_bf16_f32 %0, %1, %2" : "=v"(r) : "v"(lo), "v"(hi)); return r; }

__device__ __forceinline__ void scan_unit(LAS unsigned char* L, int u, const bf16* RK, const bf16* RV, bf16* ST, int tid, int lane, int wave) {
    asm volatile("" : "+v"(tid)); lane = tid & 63;
    const int bh = u >> 4, di = (u >> 2) & 3, ei = u & 3, b = bh >> 2, h = bh & 3;
    const float g128 = exp2f(128.0f * log2_gamma(h));
    const int li = lane & 15, g = lane >> 4, q = li >> 2, p4 = li & 3;
    const int eb = wave >> 1, db0 = 2 * (wave & 1);
    f32x4 acc[2]; acc[0] = (f32x4){0.f, 0.f, 0.f, 0.f}; acc[1] = acc[0];
    const int sw = 2 * (((q >> 1) & 1) | ((g & 1) << 1));
    v4u kA[2], vA[2], kB[2], vB[2];
#define SCAN_LOAD(cc, kreg, vreg) do { _Pragma("unroll") for (int i_ = 0; i_ < 2; ++i_) { const int cid_ = tid + 512 * i_, row_ = cid_ >> 3, c16_ = cid_ & 7; \
        int srow_; bool ok_ = true; if ((cc) < 0) { ok_ = row_ >= 112; srow_ = NTOK + (ok_ ? row_ - 112 : 0); } else srow_ = b * SEQ + (cc) * 128 + row_; \
        const v4u kz_ = *(const GAS v4u*)(RK + (size_t)srow_ * 1024 + h * 256 + di * 64 + c16_ * 8), vz_ = *(const GAS v4u*)(RV + (size_t)srow_ * 1024 + h * 256 + ei * 64 + c16_ * 8); \
        kreg[i_] = ok_ ? kz_ : (v4u){0u, 0u, 0u, 0u}; vreg[i_] = ok_ ? vz_ : (v4u){0u, 0u, 0u, 0u}; } } while (0)
#define SCAN_WRITE(bufp, kreg, vreg) do { _Pragma("unroll") for (int i_ = 0; i_ < 2; ++i_) { const int cid_ = tid + 512 * i_, row_ = cid_ >> 3, c16_ = cid_ & 7; \
        const int sw_ = ((row_ >> 1) & 1) | ((row_ >> 2) & 2); const int off_ = row_ * 128 + ((c16_ ^ (2 * sw_)) << 4); \
        *(LAS v4u*)((bufp) + off_) = kreg[i_]; *(LAS v4u*)((bufp) + 16384 + off_) = vreg[i_]; } } while (0)
#define SCAN_FLUSH(c) do { if ((c) >= 0) { const v4u z_ = *(LAS const v4u*)(L + 65536 + ((c) & 1) * 8192 + (tid >> 3) * 128 + (tid & 7) * 16); \
        *(GAS v4u*)(ST + ((size_t)(bh * 32 + (c)) * 256 + 64 * ei + (tid >> 3)) * 256 + 64 * di + (tid & 7) * 8) = z_; } } while (0)
    SCAN_LOAD(-1, kA, vA); SCAN_WRITE(L, kA, vA); SCAN_LOAD(0, kA, vA); SCAN_LOAD(1, kB, vB); LDS_BAR();
    int cur = 0;
    for (int cc = -1; cc <= 29; cc += 2) {
        { LAS const unsigned char* Kt = L + cur * 32768; LAS const unsigned char* Vt = Kt + 16384;
#pragma unroll
          for (int ks = 0; ks < 4; ++ks) { const int r0 = (32 * ks + 8 * g + q) * 128 + 8 * (p4 & 1);
              const bf16x8 a = cat8(tr16(Vt + r0 + (((2 * eb + (p4 >> 1)) ^ sw) << 4)), tr16(Vt + r0 + 512 + (((2 * eb + (p4 >> 1)) ^ sw) << 4)));
#pragma unroll
              for (int n = 0; n < 2; ++n) { const int cn = ((2 * (db0 + n) + (p4 >> 1)) ^ sw) << 4; const bf16x8 bb = cat8(tr16(Kt + r0 + cn), tr16(Kt + r0 + 512 + cn)); acc[n] = MFMA16(a, bb, acc[n]); } }
          SCAN_FLUSH(cc);
#pragma unroll
          for (int n = 0; n < 2; ++n) { acc[n] = acc[n] * g128;
              LAS bf16* op = (LAS bf16*)(L + 65536 + ((cc + 1) & 1) * 8192) + (16 * eb + 4 * g) * 64 + 16 * (db0 + n) + li;
#pragma unroll
              for (int r = 0; r < 4; ++r) op[r * 64] = (bf16)f2bf(acc[n][r]); }
          SCAN_WRITE(L + (cur ^ 1) * 32768, kA, vA);
          if (cc + 3 <= 30) SCAN_LOAD(cc + 3, kA, vA);
          LDS_BAR(); cur ^= 1; }
        { LAS const unsigned char* Kt = L + cur * 32768; LAS const unsigned char* Vt = Kt + 16384;
#pragma unroll
          for (int ks = 0; ks < 4; ++ks) { const int r0 = (32 * ks + 8 * g + q) * 128 + 8 * (p4 & 1);
              const bf16x8 a = cat8(tr16(Vt + r0 + (((2 * eb + (p4 >> 1)) ^ sw) << 4)), tr16(Vt + r0 + 512 + (((2 * eb + (p4 >> 1)) ^ sw) << 4)));
#pragma unroll
              for (int n = 0; n < 2; ++n) { const int cn = ((2 * (db0 + n) + (p4 >> 1)) ^ sw) << 4; const bf16x8 bb = cat8(tr16(Kt + r0 + cn), tr16(Kt + r0 + 512 + cn)); acc[n] = MFMA16(a, bb, acc[n]); } }
          SCAN_FLUSH(cc + 1);
#pragma unroll
          for (int n = 0; n < 2; ++n) { acc[n] = acc[n] * g128;
              LAS bf16* op = (LAS bf16*)(L + 65536 + ((cc + 2) & 1) * 8192) + (16 * eb + 4 * g) * 64 + 16 * (db0 + n) + li;
#pragma unroll
              for (int r = 0; r < 4; ++r) op[r * 64] = (bf16)f2bf(acc[n][r]); }
          if (cc + 2 <= 30) SCAN_WRITE(L + (cur ^ 1) * 32768, kB, vB);
          if (cc + 4 <= 30) SCAN_LOAD(cc + 4, kB, vB);
          LDS_BAR(); cur ^= 1; }
    }
    SCAN_FLUSH(31);
    LDS_BAR();
#undef SCAN_LOAD
#undef SCAN_WRITE
#undef SCAN_FLUSH
}

__device__ __forceinline__ void retout_unit(LAS unsigned char* L, int u, const bf16* QR, unsigned char* MIX8, const bf16* RK, const bf16* RV, const bf16* RG, const bf16* ST, int tid, int lane, int wave) {
    asm volatile("" : "+v"(tid)); lane = tid & 63;
    const int bh = u >> 5, c = u & 31, b = bh >> 2, h = bh & 3;
    const int R0 = b * SEQ + c * 128;
    const int li = lane & 15, g = lane >> 4, q = li >> 2, p4 = li & 3;
    LAS unsigned char* RA = L; LAS unsigned char* RB = L + 65536;
#pragma unroll
    for (int i = 0; i < 8; ++i) { const int cid = tid + 512 * i, j = cid >> 5, ch = cid & 31;
        const v4u kz = *(const GAS v4u*)(RK + (size_t)(R0 + j) * 1024 + h * 256 + ch * 8), vz = *(const GAS v4u*)(RV + (size_t)(R0 + j) * 1024 + h * 256 + ch * 8);
        *(LAS v4u*)(RA + j * 512 + ((ch ^ (j & 15)) << 4)) = kz; *(LAS v4u*)(RB + j * 512 + ((ch ^ ((j & 7) << 1)) << 4)) = vz; }
    bf16x8 qf[8];
    { const GAS v4u* qp = (const GAS v4u*)(QR + (size_t)(R0 + 16 * wave + li) * 2048 + 1024 + h * 256 + 8 * g);
#pragma unroll
      for (int ks = 0; ks < 8; ++ks) qf[ks] = __builtin_bit_cast(bf16x8, qp[4 * ks]); }
#define RO_LOAD_ST(s0) do { _Pragma("unroll") for (int i_ = 0; i_ < 8; ++i_) { const int cid_ = tid + 512 * i_, sl_ = cid_ >> 11, e_ = (cid_ >> 3) & 255, ch_ = cid_ & 7; \
        stg[i_] = *(const GAS v4u*)(Sg + (size_t)e_ * 256 + 64 * ((s0) + sl_) + ch_ * 8); } } while (0)
#define RO_WRITE_ST(dst) do { _Pragma("unroll") for (int i_ = 0; i_ < 8; ++i_) { const int cid_ = tid + 512 * i_, sl_ = cid_ >> 11, e_ = (cid_ >> 3) & 255, ch_ = cid_ & 7; \
        *(LAS v4u*)((dst) + sl_ * 32768 + e_ * 128 + ((ch_ ^ (e_ & 7)) << 4)) = stg[i_]; } } while (0)
    const bf16* Sg = ST + (size_t)(bh * 32 + c) * 65536; v4u stg[8];
    __syncthreads();
    RO_LOAD_ST(0);
    f32x4 st[8];
#pragma unroll
    for (int jt = 0; jt < 8; ++jt) st[jt] = (f32x4){0.f, 0.f, 0.f, 0.f};
#pragma unroll
    for (int jt = 0; jt < 8; ++jt) if (jt <= wave) {
        const int j = 16 * jt + li;
#pragma unroll
        for (int ks = 0; ks < 8; ++ks) { const bf16x8 a = *(LAS const bf16x8*)(RA + j * 512 + (((4 * ks + g) ^ li) << 4)); st[jt] = MFMA16(a, qf[ks], st[jt]); }
        if (jt == wave) {
#pragma unroll
            for (int r = 0; r < 4; ++r) if (4 * g + r > li) st[jt][r] = 0.f; }
    }
    bf16x8 pf[4];
#pragma unroll
    for (int s = 0; s < 4; ++s) { v4u w; w.x = cvtpk_s(st[2 * s][0], st[2 * s][1]); w.y = cvtpk_s(st[2 * s][2], st[2 * s][3]); w.z = cvtpk_s(st[2 * s + 1][0], st[2 * s + 1][1]); w.w = cvtpk_s(st[2 * s + 1][2], st[2 * s + 1][3]); pf[s] = __builtin_bit_cast(bf16x8, w); }
    __syncthreads();
    RO_WRITE_ST(RA); RO_LOAD_ST(2);
    f32x4 o[16];
#pragma unroll
    for (int et = 0; et < 16; ++et) o[et] = (f32x4){0.f, 0.f, 0.f, 0.f};
#pragma unroll
    for (int s = 0; s < 4; ++s) if (2 * s <= wave) {
        const int r1 = 32 * s + 4 * g + q, r2 = r1 + 16;
#pragma unroll
        for (int et = 0; et < 16; ++et) {
            const int chn = 2 * et + (p4 >> 1);
            const bf16x8 a = cat8(tr16(RB + r1 * 512 + ((chn ^ ((r1 & 7) << 1)) << 4) + (p4 & 1) * 8), tr16(RB + r2 * 512 + ((chn ^ ((r2 & 7) << 1)) << 4) + (p4 & 1) * 8));
            o[et] = MFMA16(a, pf[s], o[et]);
        }
    }
    __syncthreads();
    RO_WRITE_ST(RB);
#define RO_STATE_MMA(src, s0) do { _Pragma("unroll") for (int sl_ = 0; sl_ < 2; ++sl_) _Pragma("unroll") for (int k2_ = 0; k2_ < 2; ++k2_) _Pragma("unroll") for (int et = 0; et < 16; ++et) { \
        const int e_ = 16 * et + li; const bf16x8 a_ = *(LAS const bf16x8*)((src) + sl_ * 32768 + e_ * 128 + (((4 * k2_ + g) ^ (e_ & 7)) << 4)); \
        o[et] = MFMA16(a_, qf[2 * ((s0) + sl_) + k2_], o[et]); } } while (0)
    RO_STATE_MMA(RA, 0);
    __syncthreads();
    RO_STATE_MMA(RB, 2);
#undef RO_LOAD_ST
#undef RO_WRITE_ST
#undef RO_STATE_MMA
    float s1 = 0.f;
#pragma unroll
    for (int et = 0; et < 16; ++et) s1 += (o[et][0] + o[et][1]) + (o[et][2] + o[et][3]);
    s1 += __shfl_xor(s1, 16); s1 += __shfl_xor(s1, 32);
    const float mu = s1 * (1.0f / 256.0f); float s2 = 0.f;
#pragma unroll
    for (int et = 0; et < 16; ++et) { o[et] = o[et] - mu; s2 += (o[et][0] * o[et][0] + o[et][1] * o[et][1]) + (o[et][2] * o[et][2] + o[et][3] * o[et][3]); }
    s2 += __shfl_xor(s2, 16); s2 += __shfl_xor(s2, 32);
    const float rstd = 1.0f / sqrtf(s2 * (1.0f / 256.0f) + GN_EPS);
    const int row = R0 + 16 * wave + li;
    const GAS v2u* gp = (const GAS v2u*)(RG + (size_t)row * 1024 + h * 256 + 4 * g); GAS unsigned* op = (GAS unsigned*)(MIX8 + (size_t)row * 2048 + 1024 + h * 256 + 4 * g);
    const float rstd8 = rstd * MIX_F8_SCALE;
#pragma unroll
    for (int et = 0; et < 16; ++et) { const v2u gz = gp[4 * et];
        op[4 * et] = fp8x4(o[et][0] * rstd8 * bflo(gz.x), o[et][1] * rstd8 * bfhi(gz.x), o[et][2] * rstd8 * bflo(gz.y), o[et][3] * rstd8 * bfhi(gz.y)); }
    __syncthreads();
}

typedef float f32x16 __attribute__((ext_vector_type(16)));
#define MFMA32(a, b, c) __builtin_amdgcn_mfma_f32_32x32x16_bf16((a), (b), (c), 0, 0, 0)
__device__ __forceinline__ int crow32(int reg, int hh) { return (reg & 3) + 8 * (reg >> 2) + 4 * hh; }

__device__ __forceinline__ void attn_unit(LAS unsigned char* L, int u, const bf16* QR, unsigned char* MIX8, const bf16* KA, const bf16* VA, const float* sinks, int tid, int lane, int wave) {
    asm volatile("" : "+v"(tid)); lane = tid & 63;
    const int b = u >> 6, j = (u >> 1) & 31, g2 = u & 1, hq = 8 * g2 + wave;
    const int R0 = b * SEQ + 128 * j;
    LAS unsigned char* Kt = L; LAS unsigned char* Vt = L + 32768;
#pragma unroll
    for (int i = 0; i < 4; ++i) { const int cid = tid + 512 * i, kk = cid >> 3, ch = cid & 7;
        int srow; bool ok = true;
        if (kk >= 128) srow = R0 + kk - 128; else if (j > 0) srow = R0 - 128 + kk; else { ok = kk >= 112; srow = NTOK + (ok ? kk - 112 : 0); }
        const v4u kz = *(const GAS v4u*)(KA + (size_t)srow * 128 + g2 * 64 + ch * 8), vz = *(const GAS v4u*)(VA + (size_t)srow * 128 + g2 * 64 + ch * 8);
        *(LAS v4u*)(Kt + kk * 128 + ((ch ^ (kk & 7)) << 4)) = ok ? kz : (v4u){0u, 0u, 0u, 0u};
        *(LAS v4u*)(Vt + kk * 128 + (ch << 4)) = ok ? vz : (v4u){0u, 0u, 0u, 0u}; }
    __syncthreads();
    const int r = lane & 31, hh = lane >> 5, blk = (lane >> 4) & 1, q = (lane & 15) >> 2, p4 = lane & 3;
    const float sk = sinks[hq] * LOG2E;
    v4u qn[4];
    { const GAS v4u* qp = (const GAS v4u*)(QR + (size_t)(R0 + r) * 2048 + hq * 64 + 8 * hh);
#pragma unroll
      for (int ks = 0; ks < 4; ++ks) qn[ks] = qp[2 * ks]; }
#pragma unroll 1
    for (int t = 0; t < 4; ++t) {
        const int i0 = 32 * t;
        bf16x8 qf[4];
#pragma unroll
        for (int ks = 0; ks < 4; ++ks) qf[ks] = __builtin_bit_cast(bf16x8, qn[ks]);
        if (t < 3) { const GAS v4u* qp = (const GAS v4u*)(QR + (size_t)(R0 + i0 + 32 + r) * 2048 + hq * 64 + 8 * hh);
#pragma unroll
          for (int ks = 0; ks < 4; ++ks) qn[ks] = qp[2 * ks]; }
        f32x16 s[5];
#pragma unroll
        for (int x = 0; x < 5; ++x) {
            const int krow_ = 32 * (t + x) + r;
            f32x16 acc;
#pragma unroll
            for (int e = 0; e < 16; ++e) acc[e] = 0.f;
#pragma unroll
            for (int ks = 0; ks < 4; ++ks) { const bf16x8 a = *(LAS const bf16x8*)(Kt + krow_ * 128 + (((2 * ks + hh) ^ (krow_ & 7)) << 4)); acc = MFMA32(a, qf[ks], acc); }
            s[x] = acc; __builtin_amdgcn_sched_barrier(0);
        }
        float m = sk;
#pragma unroll
        for (int e = 0; e < 16; ++e) { const int cr = crow32(e, hh);
            if (!(cr > r)) s[0][e] = -1.0e30f;
            if (!(cr <= r)) s[4][e] = -1.0e30f; }
        if (j == 0) {
#pragma unroll
            for (int x = 0; x < 4; ++x) if (t + x <= 3) {
#pragma unroll
                for (int e = 0; e < 16; ++e) if (32 * (t + x) + crow32(e, hh) < 112) s[x][e] = -1.0e30f; }
        }
#pragma unroll
        for (int x = 0; x < 5; ++x)
#pragma unroll
            for (int e = 0; e < 16; ++e) m = fmaxf(m, s[x][e]);
        m = fmaxf(m, __shfl_xor(m, 32));
        float l = 0.f;
#pragma unroll
        for (int x = 0; x < 5; ++x)
#pragma unroll
            for (int e = 0; e < 16; ++e) { const float pv = exp2f(s[x][e] - m); s[x][e] = pv; l += pv; }
        l += __shfl_xor(l, 32);
        l += exp2f(sk - m);
        f32x16 o[2];
#pragma unroll
        for (int e = 0; e < 16; ++e) { o[0][e] = 0.f; o[1][e] = 0.f; }
#pragma unroll
        for (int x = 0; x < 5; ++x)
#pragma unroll
            for (int st = 0; st < 2; ++st) {
                v4u w; w.x = cvtpk_s(s[x][8 * st + 0], s[x][8 * st + 1]); w.y = cvtpk_s(s[x][8 * st + 2], s[x][8 * st + 3]); w.z = cvtpk_s(s[x][8 * st + 4], s[x][8 * st + 5]); w.w = cvtpk_s(s[x][8 * st + 6], s[x][8 * st + 7]);
                const bf16x8 pb = __builtin_bit_cast(bf16x8, w);
                const int k1 = 32 * (t + x) + 16 * st + 4 * hh + q, k2 = k1 + 8;
#pragma unroll
                for (int dc = 0; dc < 2; ++dc) {
                    const int cb = ((4 * dc + 2 * blk + (p4 >> 1)) << 4) + 8 * (p4 & 1);
                    const bf16x8 a = cat8(tr16(Vt + k1 * 128 + cb), tr16(Vt + k2 * 128 + cb));
                    o[dc] = MFMA32(a, pb, o[dc]);
                }
                __builtin_amdgcn_sched_barrier(0);
            }
        const float il = 1.0f / l;
        const float il8 = il * MIX_F8_SCALE;
        GAS unsigned* op = (GAS unsigned*)(MIX8 + (size_t)(R0 + i0 + r) * 2048 + hq * 64 + 4 * hh);
#pragma unroll
        for (int dc = 0; dc < 2; ++dc)
#pragma unroll
            for (int g4 = 0; g4 < 4; ++g4) op[8 * dc + 2 * g4] = fp8x4(o[dc][4 * g4 + 0] * il8, o[dc][4 * g4 + 1] * il8, o[dc][4 * g4 + 2] * il8, o[dc][4 * g4 + 3] * il8);
    }
    __syncthreads();
}

__device__ __forceinline__ unsigned ord_key(float f) { const unsigned u = __float_as_uint(f); return u ^ ((unsigned)((int)u >> 31) | 0x80000000u); }
__device__ __forceinline__ float ord_val(unsigned k) { return __uint_as_float(k ^ (((int)k < 0) ? 0x80000000u : 0xffffffffu)); }
__device__ __forceinline__ unsigned umed3(unsigned a, unsigned b, unsigned c) { unsigned r; asm("v_med3_u32 %0, %1, %2, %3" : "=v"(r) : "v"(a), "v"(b), "v"(c)); return r; }
#define TK_INS(arr, val) do { const unsigned v_ = (val); _Pragma("unroll") for (int j_ = 15; j_ >= 1; --j_) arr[j_] = umed3(arr[j_ - 1], arr[j_], v_); arr[0] = arr[0] > v_ ? arr[0] : v_; } while (0)
__device__ __forceinline__ void topk_unit(LAS unsigned* Lw, LAS const unsigned char* Lsk, int tt, int hd, const bf16* Q3, unsigned short* IDS, float* GATES, int lane) {
    asm volatile("" : "+v"(lane));
    const int r = lane & 31, hh = lane >> 5, t0 = tt * 32;
    float sv[2][16];
#pragma unroll
    for (int p = 0; p < 2; ++p) {
        f32x16 acc[4];
#pragma unroll
        for (int nt = 0; nt < 4; ++nt)
#pragma unroll
            for (int e = 0; e < 16; ++e) acc[nt][e] = 0.f;
        const GAS v4u* qp = (const GAS v4u*)(Q3 + (size_t)(t0 + r) * DM + hd * 256 + p * 128 + 8 * hh);
        bf16x8 bq[8];
#pragma unroll
        for (int ks = 0; ks < 8; ++ks) bq[ks] = __builtin_bit_cast(bf16x8, qp[2 * ks]);
#pragma unroll
        for (int ks = 0; ks < 8; ++ks) {
#pragma unroll
            for (int nt = 0; nt < 4; ++nt) { const bf16x8 a = *(LAS const bf16x8*)(Lsk + p * 32768 + (32 * nt + r) * 256 + (((2 * ks + hh) ^ (r & 15)) << 4)); acc[nt] = MFMA32(a, bq[ks], acc[nt]); } }
        unsigned tk[16];
#pragma unroll
        for (int j2 = 0; j2 < 16; ++j2) tk[j2] = 0u;
#pragma unroll
        for (int nt = 0; nt < 4; ++nt)
#pragma unroll
            for (int e = 0; e < 16; ++e) { const int n = 32 * nt + crow32(e, hh); TK_INS(tk, (ord_key(acc[nt][e]) & 0xffffff80u) | (unsigned)(127 - n)); }
        unsigned pk[16];
#pragma unroll
        for (int j2 = 0; j2 < 16; ++j2) pk[j2] = (unsigned)__shfl_xor((int)tk[j2], 32);
#pragma unroll
        for (int j2 = 0; j2 < 16; ++j2) TK_INS(tk, pk[j2]);
#pragma unroll
        for (int j2 = 0; j2 < 16; ++j2) { sv[p][j2] = ord_val(tk[j2] & 0xffffff80u); Lw[(p * 16 + j2) * 64 + lane] = 127u - (tk[j2] & 0x7fu); }
    }
    unsigned fk[16];
#pragma unroll
    for (int j2 = 0; j2 < 16; ++j2) fk[j2] = 0u;
#pragma unroll
    for (int i = 0; i < 16; ++i)
#pragma unroll
        for (int j2 = 0; j2 < 16; ++j2) if ((i + 1) * (j2 + 1) <= 16) TK_INS(fk, (ord_key(sv[0][i] + sv[1][j2]) & 0xffffff00u) | (unsigned)(255 - (16 * i + j2)));
    float ev[16]; int idv[16]; float den = 0.f; const float f0 = ord_val(fk[0] & 0xffffff00u);
    LDS_WAIT();
#pragma unroll
    for (int k = 0; k < 16; ++k) { const unsigned idx = 255u - (fk[k] & 0xffu); const unsigned i1 = Lw[(idx >> 4) * 64 + lane], i2 = Lw[(16 + (idx & 15u)) * 64 + lane];
        idv[k] = (int)(i1 * 128u + i2); ev[k] = __expf(ord_val(fk[k] & 0xffffff00u) - f0); den += ev[k]; }
    const float iden = 1.0f / den;
    if (hh == 0) {
        GAS v4u* ip = (GAS v4u*)(IDS + (size_t)(t0 + r) * 128 + hd * 16); GAS f32x4* gp = (GAS f32x4*)(GATES + (size_t)(t0 + r) * 128 + hd * 16);
#pragma unroll
        for (int k8 = 0; k8 < 2; ++k8) ip[k8] = (v4u){(unsigned)idv[8 * k8] | ((unsigned)idv[8 * k8 + 1] << 16), (unsigned)idv[8 * k8 + 2] | ((unsigned)idv[8 * k8 + 3] << 16), (unsigned)idv[8 * k8 + 4] | ((unsigned)idv[8 * k8 + 5] << 16), (unsigned)idv[8 * k8 + 6] | ((unsigned)idv[8 * k8 + 7] << 16)};
#pragma unroll
        for (int k4 = 0; k4 < 4; ++k4) gp[k4] = (f32x4){ev[4 * k4] * iden, ev[4 * k4 + 1] * iden, ev[4 * k4 + 2] * iden, ev[4 * k4 + 3] * iden};
    }
    LDS_WAIT();
}

template <bool F8, bool PERMW1> __device__ __forceinline__ void w_tile(LAS unsigned char* T, const float* W, int ld, int k0, int n0, signed char* dst, float qs, int tid) {
    asm volatile("" : "+v"(tid));
    const int kq = tid >> 5, c4 = tid & 31;
    const int ncol = PERMW1 ? w1_logical_col(n0 + ((4 * c4) & ~31)) + ((4 * c4) & 31) : n0 + 4 * c4;
    const GAS f32x4* src = (const GAS f32x4*)(W + (size_t)(k0 + 8 * kq) * ld + ncol);
    f32x4 a[8];
#pragma unroll
    for (int i = 0; i < 8; ++i) a[i] = src[(size_t)i * (ld / 4)];
#pragma unroll
    for (int j = 0; j < 4; ++j) { v2u w;
        if constexpr (F8) { w.x = fp8x4(a[0][j] * qs, a[1][j] * qs, a[2][j] * qs, a[3][j] * qs); w.y = fp8x4(a[4][j] * qs, a[5][j] * qs, a[6][j] * qs, a[7][j] * qs); }
        else { w.x = (unsigned)(q8(a[0][j] * qs) | (q8(a[1][j] * qs) << 8) | (q8(a[2][j] * qs) << 16) | (q8(a[3][j] * qs) << 24)); w.y = (unsigned)(q8(a[4][j] * qs) | (q8(a[5][j] * qs) << 8) | (q8(a[6][j] * qs) << 16) | (q8(a[7][j] * qs) << 24)); }
        *(LAS v2u*)(T + (4 * c4 + j) * 128 + ((kq ^ (c4 & 15)) << 3)) = w; }
    LDS_BAR();
    { const int n = tid >> 2, q = tid & 3, sw = (n >> 2) & 15; v2u p[4];
#pragma unroll
      for (int r = 0; r < 4; ++r) p[r] = *(LAS const v2u*)(T + n * 128 + (((4 * q + r) ^ sw) << 3));
      GAS v4u* o = (GAS v4u*)(dst + (size_t)(n0 + n) * DM + k0 + 32 * q);
      o[0] = (v4u){p[0].x, p[0].y, p[1].x, p[1].y}; o[1] = (v4u){p[2].x, p[2].y, p[3].x, p[3].y}; }
    LDS_BAR();
}
constexpr int TAB_NQ = 16384 * DM / 4, TAB_CHQ = 4096, TAB_NCH = 2 * TAB_NQ / TAB_CHQ, TAB_SLOT_CHUNKS = 3;
template <int UNR> __device__ __forceinline__ void tab_chunk(int ch, const float* u_tab, const float* v_tab, void* UT, void* VT, int lane) {
    const int which = ch >= TAB_NCH / 2; const float sc = which ? V_QSCALE : U_QSCALE;
    const GAS f32x4* src = (const GAS f32x4*)(which ? v_tab : u_tab) + (size_t)(ch - which * (TAB_NCH / 2)) * TAB_CHQ + lane;
    GAS unsigned char* dstb = (GAS unsigned char*)(which ? VT : UT);
    const int i4b = (ch - which * (TAB_NCH / 2)) * TAB_CHQ + lane;
#pragma unroll 1
    for (int it = 0; it < TAB_CHQ / 64; it += UNR) {
        f32x4 a[UNR];
#pragma unroll
        for (int u8 = 0; u8 < UNR; ++u8) a[u8] = src[(it + u8) * 64];
#pragma unroll
        for (int u8 = 0; u8 < UNR; ++u8) { const int i4 = i4b + (it + u8) * 64; const int row = i4 >> 9, q4 = i4 & 511;
            const int w = q8(a[u8].x * sc) | (q8(a[u8].y * sc) << 8) | (q8(a[u8].z * sc) << 16) | (q8(a[u8].w * sc) << 24);
            *(GAS unsigned*)(dstb + ((size_t)(q4 >> 5) * 16384 + row) * 128 + (q4 & 31) * 4) = (unsigned)w; }
    }
}
struct TabHook {
    gu32* q; const float* u_tab; const float* v_tab; void* UT; void* VT; int slot;
    __device__ __forceinline__ void operator()(int ui) const {
        if (ui != slot) return;
        int lane = threadIdx.x; asm volatile("" : "+v"(lane)); lane &= 63;
#pragma unroll 1
        for (int n = 0; n < TAB_SLOT_CHUNKS; ++n) {
            int ch = 0; if (lane == 0) ch = (int)__hip_atomic_fetch_add((unsigned*)q, 1u, __ATOMIC_RELAXED, __HIP_MEMORY_SCOPE_AGENT);
            ch = __builtin_amdgcn_readfirstlane(ch); if (ch >= TAB_NCH) return;
            tab_chunk<16>(ch, u_tab, v_tab, UT, VT, lane);
        }
    }
};

__global__ void __launch_bounds__(NWAVES * 64, 2) mk_fwd(Args args) {
    extern __shared__ __attribute__((aligned(16))) unsigned char lds[];
    LAS unsigned char* L = (LAS unsigned char*)lds;
    volatile LAS unsigned* MISC = (volatile LAS unsigned*)(L + MISC_OFF);
    const int tid = threadIdx.x, lane = tid & 63, wave = __builtin_amdgcn_readfirstlane(tid >> 6);
    const int G = gridDim.x, bx = blockIdx.x;
    const int vcu = (G % 8 == 0) ? (bx % 8) * (G / 8) + bx / 8 : bx;
    unsigned char* ws = args.ws;
    gu32* ctl = (gu32*)(ws + WS_CTL);
    const float* x = args.in[0]; const float* meta = args.in[1]; const float* ln_in_g = args.in[2]; const float* ln_in_b = args.in[3];
    const float* w_in = args.in[4]; const float* sinks = args.in[5]; const float* w_out = args.in[6]; const float* ln_mix_g = args.in[7]; const float* ln_mix_b = args.in[8];
    const float* wq = args.in[9]; const float* subkeys = args.in[10]; const float* u_tab = args.in[11]; const float* v_tab = args.in[12];
    const float* ln_ffn_g = args.in[13]; const float* ln_ffn_b = args.in[14];
    float* out = args.out;
    bf16* W1T = (bf16*)(ws + WS_W1T); bf16* W2T = (bf16*)(ws + WS_W2T); bf16* W3T = (bf16*)(ws + WS_W3T);
    bf16* H0 = (bf16*)(ws + WS_H0); bf16* QR = (bf16*)(ws + WS_QR); bf16* KA = (bf16*)(ws + WS_KA); bf16* VA = (bf16*)(ws + WS_VA);
    bf16* RK = (bf16*)(ws + WS_RK); bf16* RV = (bf16*)(ws + WS_RV); bf16* RG = (bf16*)(ws + WS_RG);
    bf16* Y = (bf16*)(ws + WS_Y); bf16* H1 = (bf16*)(ws + WS_H1); bf16* Q3 = (bf16*)(ws + WS_QR);
    bf16* STB = (bf16*)(ws + WS_ST);
    unsigned short* IDS = (unsigned short*)(ws + WS_IDS); float* GATES = (float*)(ws + WS_GATES);
    bf16* SKB = (bf16*)(ws + WS_SK);
    signed char* H1Q = (signed char*)(ws + WS_RG); float* HSC = (float*)(ws + WS_HSC);
    bf16* UT = (bf16*)(ws + WS_UT); bf16* VT = (bf16*)(ws + WS_VT);
    signed char* H0Q = (signed char*)(ws + WS_H0Q); signed char* W1Q = (signed char*)(ws + WS_W1Q); signed char* W3Q = (signed char*)(ws + WS_W3Q);
    float* H0S = (float*)(ws + WS_H0S); float* WS1 = (float*)(ws + WS_WS1); float* WS3 = (float*)(ws + WS_WS3);
    unsigned char* MIX8 = (unsigned char*)(ws + WS_H0);
    signed char* W2Q = (signed char*)(ws + WS_W3T); float* WS2 = (float*)(ws + WS_W1T);

    for (int u = tid; u < (LDS_BYTES - LDSCTL_OFF) / 4; u += NWAVES * 64) ((LAS unsigned*)(L + LDSCTL_OFF))[u] = 0u;
    __syncthreads();
    XcdBarrier bar; bar.bar = (unsigned*)(ctl + CW_BAR); bar.x = xb_xcc_id(); bar.st = MISC + 8;
    if (tid == 0) MISC[10] = xb_add(&bar.bar[XB_XCNT(bar.x)], 1u);
#define GRID_BAR() xcd_barrier(bar)
    const int gw = vcu * NWAVES + wave, NGW = G * NWAVES;
    const int gt = gw * 64 + lane, NGT = NGW * 64;

    {
        int lane = threadIdx.x; asm volatile("" : "+v"(lane)); lane &= 63; const int gt = gw * 64 + lane;
        LAS float* scr = (LAS float*)(L + RING_OFF + wave * 16384);
        float qs1, qs3, qs2;
        { LAS float* red = (LAS float*)(L + LDSCTL_OFF + 4096); float ss[3];
          const float* wp[3] = {w_in, wq, w_out};
          int t0l = threadIdx.x; asm volatile("" : "+v"(t0l));
#pragma unroll
          for (int w3 = 0; w3 < 3; ++w3) { const GAS f32x4* p = (const GAS f32x4*)wp[w3] + t0l; float acc = 0.f;
#pragma unroll
              for (int i = 0; i < 8; ++i) { const f32x4 v = p[512 * i]; acc += (v.x * v.x + v.y * v.y) + (v.z * v.z + v.w * v.w); }
              ss[w3] = wave_sum(acc); }
          if (lane == 0) { red[wave * 4 + 0] = ss[0]; red[wave * 4 + 1] = ss[1]; red[wave * 4 + 2] = ss[2]; }
          LDS_BAR();
          float t0 = 0.f, t1 = 0.f, t2 = 0.f;
#pragma unroll
          for (int w8 = 0; w8 < 8; ++w8) { t0 += red[w8 * 4 + 0]; t1 += red[w8 * 4 + 1]; t2 += red[w8 * 4 + 2]; }
          const float r1 = fmaxf(sqrtf(t0 * (1.0f / 16384.0f)), 1e-30f), r3 = fmaxf(sqrtf(t1 * (1.0f / 16384.0f)), 1e-30f), r2 = fmaxf(sqrtf(t2 * (1.0f / 16384.0f)), 1e-30f);
          qs1 = 127.0f / (5.5f * r1); qs3 = 127.0f / (5.5f * r3); qs2 = 384.0f / (6.0f * r2);
          for (int i = gt; i < IN_COLS + 2 * DM; i += NGT) { if (i < IN_COLS) WS1[i] = 1.0f / qs1; else if (i < IN_COLS + DM) WS3[i - IN_COLS] = 1.0f / qs3; else WS2[i - IN_COLS - DM] = 1.0f / qs2; }
          LDS_BAR(); }
        constexpr int NB1 = IN_COLS / 128, NB3 = DM / 128, IT1 = 16 * NB1, IT3 = 16 * NB3;
        for (int it = bx; it < IT1 + 2 * IT3; it += G) {
            if (it < IT1) w_tile<false, true>(L + RING_OFF, w_in, IN_COLS, 128 * (it / NB1), 128 * (it % NB1), W1Q, qs1, tid);
            else if (it < IT1 + IT3) { const int r = it - IT1; w_tile<false, false>(L + RING_OFF, wq, DM, 128 * (r / NB3), 128 * (r % NB3), W3Q, qs3, tid); }
            else { const int r = it - IT1 - IT3; w_tile<true, false>(L + RING_OFF, w_out, DM, 128 * (r / NB3), 128 * (r % NB3), W2Q, qs2, tid); }
        }
        {
            f32x4 va[8], vn[8];
            int m = gw; if (m < NVALID) ln_load_f32(va, m < NTOK ? x + (size_t)m * DM : meta + (size_t)(m - NTOK) * DM, lane);
            for (; m < MROWS; m += NGW) {
                const int mn = m + NGW; if (mn < NVALID) ln_load_f32(vn, mn < NTOK ? x + (size_t)mn * DM : meta + (size_t)(mn - NTOK) * DM, lane);
                if (m < NVALID) ln_row_f32_to_bf16_q(va, ln_in_g, ln_in_b, nullptr, H0Q + (size_t)m * DM, H0S + m, lane);
                else { GAS v4u* oq = (GAS v4u*)(H0Q + (size_t)m * DM) + lane;
                    oq[0] = (v4u){0u, 0u, 0u, 0u}; oq[64] = (v4u){0u, 0u, 0u, 0u}; if (lane == 0) H0S[m] = 0.f; }
#pragma unroll
                for (int j = 0; j < 8; ++j) va[j] = vn[j];
            }
        }
        for (int e = gt; e < 16 * 128 * 128 / 8; e += NGT) { const GAS f32x4* src = (const GAS f32x4*)subkeys + 2 * (size_t)e; const f32x4 a = src[0], b2 = src[1];
            v4u o; o.x = pk2(a.x, a.y); o.y = pk2(a.z, a.w); o.z = pk2(b2.x, b2.y); o.w = pk2(b2.z, b2.w); ((GAS v4u*)SKB)[e] = o; }
    }
    GRID_BAR();

    {
        pg8::Gemm g{(const bf16*)H0Q, (const bf16*)W1Q, MROWS, IN_COLS, DM / 2, H0S, WS1}; pg8::StaticOrder S; S.init(MROWS, IN_COLS, G, bx, 5);
        pg8::EpiProj E{QR, KA, VA, RK, RV, RG, QSCALE};
        const int nwg1 = (MROWS / 256) * (IN_COLS / 256), T1 = (nwg1 + G - 1) / G, c0 = nwg1 - (T1 - 1) * G;
        TabHook Hk{ctl + CW_TABQ, u_tab, v_tab, (void*)UT, (void*)VT, (bx >= c0 && T1 > 2) ? (bx - c0) % (T1 - 2) : -1};
        pg8::gemm_phase<pg8::EpiProj, pg8::StaticOrder, true, true, TabHook, true>(L + RING_OFF, g, S, E, Hk);
    }
    {
        for (;;) {
            int ch = 0; if (lane == 0) ch = (int)__hip_atomic_fetch_add((unsigned*)(ctl + CW_TABQ), 1u, __ATOMIC_RELAXED, __HIP_MEMORY_SCOPE_AGENT);
            ch = __builtin_amdgcn_readfirstlane(ch); if (ch >= TAB_NCH) break;
            tab_chunk<8>(ch, u_tab, v_tab, (void*)UT, (void*)VT, lane);
        }
    }
    GRID_BAR();

    for (int u = bx; u < 256; u += G) attn_unit(L + RING_OFF, u, QR, MIX8, KA, VA, sinks, tid, lane, wave);

    for (int u = bx; u < 256; u += G) scan_unit(L + RING_OFF, u, RK, RV, STB, tid, lane, wave);
    GRID_BAR();

    for (int u = bx; u < 512; u += G) retout_unit(L + RING_OFF, u, QR, MIX8, RK, RV, RG, STB, tid, lane, wave);
    GRID_BAR();

    {
        pg8::Gemm g{(const bf16*)MIX8, (const bf16*)W2Q, NTOK, DM, DM / 2, nullptr, WS2, 1.0f / MIX_F8_SCALE}; pg8::StaticOrder S; S.init(NTOK, DM, G, bx);
        pg8::EpiGen<1> E{Y, DM, nullptr, ALPHA, H0Q, H0S, nullptr, nullptr, nullptr, nullptr, nullptr, nullptr};
        pg8::gemm_phase<pg8::EpiGen<1>, pg8::StaticOrder, true, true, pg8::NoHook, false, true>(L + RING_OFF, g, S, E);
    }
    GRID_BAR();

    { int l5 = threadIdx.x; asm volatile("" : "+v"(l5)); l5 &= 63;
      v4u wa[4], wn[4]; int m = gw; if (m < NTOK) ln_load_bf16(wa, Y + (size_t)m * DM, l5);
      for (; m < NTOK; m += NGW) { const int mn = m + NGW; if (mn < NTOK) ln_load_bf16(wn, Y + (size_t)mn * DM, l5);
          ln_row_bf16_to_bf16(wa, ln_mix_g, ln_mix_b, nullptr, H1Q + (size_t)m * DM, HSC + m, l5);
#pragma unroll
          for (int j = 0; j < 4; ++j) wa[j] = wn[j]; } }
    GRID_BAR();

    {
        pg8::Gemm g{(const bf16*)H1Q, (const bf16*)W3Q, NTOK, DM, DM / 2, HSC, WS3}; pg8::StaticOrder S; S.init(NTOK, DM, G, bx);
        pg8::EpiGen<2> E{Q3, DM, nullptr, 0.f, nullptr, nullptr, nullptr, nullptr, nullptr, nullptr};
        pg8::gemm_phase<pg8::EpiGen<2>, pg8::StaticOrder, true, true, pg8::NoHook, true>(L + RING_OFF, g, S, E);
    }
    GRID_BAR();

    const bool g8 = (G & 7) == 0; const int nbh = g8 ? (G >> 3) : G, hb = g8 ? (bx >> 3) : bx;
    int t7 = threadIdx.x; asm volatile("" : "+v"(t7));
    for (int hd = g8 ? (bx & 7) : 0; hd < 8; hd += g8 ? 8 : 1) {
        __syncthreads();
#pragma unroll
        for (int i = 0; i < 8; ++i) { const int cid = t7 + 512 * i, p = cid >> 11, n = (cid >> 4) & 127, ch = cid & 15;
            *(LAS v4u*)(L + RING_OFF + p * 32768 + n * 256 + ((ch ^ (n & 15)) << 4)) = *(const GAS v4u*)(SKB + ((size_t)((hd * 2 + p) * 128 + n)) * 128 + ch * 8); }
        __syncthreads();
        int l7 = threadIdx.x; asm volatile("" : "+v"(l7)); l7 &= 63;
        for (int tt = hb * NWAVES + wave; tt < NTOK / 32; tt += nbh * NWAVES) topk_unit((LAS unsigned*)(L + RING_OFF + 65536 + wave * 8192), L + RING_OFF, tt, hd, Q3, IDS, GATES, l7);
    }
    __syncthreads();
    GRID_BAR();

    int nx = 0, xr = 0, nloc = 1;
    { unsigned* bw = (unsigned*)(ctl + CW_BAR);
#pragma unroll
      for (unsigned j2 = 0; j2 < 16; ++j2) { const unsigned cnt = xb_ld(&bw[XB_XCNT(j2)]); nx += cnt > 0u; xr += (j2 < bar.x && cnt > 0u); if (j2 == bar.x) nloc = (int)cnt; }
      nx = __builtin_amdgcn_readfirstlane(nx); xr = __builtin_amdgcn_readfirstlane(xr); nloc = __builtin_amdgcn_readfirstlane(nloc); if (nx < 1) nx = 1; if (nloc < 1) nloc = 1; }
    const int lrank = __builtin_amdgcn_readfirstlane((int)MISC[10]);
    const int wv = lrank * NWAVES + wave, nwv = nloc * NWAVES;
    float* DOTX = (float*)(ws + WS_RK);
    signed char* CB8 = (signed char*)(ws + WS_KA); float* CSC = (float*)(ws + WS_CSC);
    bf16* YB = (bf16*)(ws + WS_H0);
    {
        int tl = tid; asm volatile("" : "+v"(tl)); const int ln = tl & 63, k = ln >> 3, c8 = ln & 7;
        const unsigned char* UT8 = (const unsigned char*)UT;
        for (int s = xr; s < NSL; s += nx) {
            const unsigned char* Us = UT8 + (size_t)s * 16384 * 128;
            const bool first = (s == xr);
            v4u nid[2][2];
#pragma unroll
            for (int z = 0; z < 2; ++z) { const int tz = wv + z * nwv; const int tc = tz < NTOK ? tz : wv; const GAS v4u* ip = (const GAS v4u*)(IDS + (size_t)tc * 128 + 16 * k);
#pragma unroll
                for (int i = 0; i < 2; ++i) nid[z][i] = ip[i]; }
#pragma unroll 1
            for (int t = wv; t < NTOK; t += 2 * nwv) {
                const bool vB = (t + nwv) < NTOK; const int tt[2] = {t, vB ? t + nwv : t};
                v4u ub[2][16]; v4u hs[2]; int old[2][2];
#pragma unroll
                for (int z = 0; z < 2; ++z) {
#pragma unroll
                    for (int i = 0; i < 16; ++i) { const int pe = 2 * (i & 7) + (i >> 3); const unsigned eid = (nid[z][pe >> 3][(pe >> 1) & 3] >> (16 * (pe & 1))) & 0xffffu; ub[z][i] = *(const GAS v4u*)(Us + (size_t)eid * 128 + 16 * c8); }
                    hs[z] = *(const GAS v4u*)(H1Q + (size_t)tt[z] * DM + 128 * s + 16 * c8); }
#pragma unroll
                for (int z = 0; z < 2; ++z) { const v2u ov = first ? (v2u){0u, 0u} : *(const GAS v2u*)(DOTX + ((size_t)xr * NTOK + tt[z]) * 128 + 2 * ln); old[z][0] = (int)ov.x; old[z][1] = (int)ov.y; }
#pragma unroll
                for (int z = 0; z < 2; ++z) { const int tz = t + (2 + z) * nwv; const int tc = tz < NTOK ? tz : t; const GAS v4u* ip = (const GAS v4u*)(IDS + (size_t)tc * 128 + 16 * k);
#pragma unroll
                    for (int i = 0; i < 2; ++i) nid[z][i] = ip[i]; }
#pragma unroll
                for (int z = 0; z < 2; ++z) {
                    int p[16];
#pragma unroll
                    for (int i = 0; i < 16; ++i) { int d = 0;
                        d = __builtin_amdgcn_sdot4((int)ub[z][i].x, (int)hs[z].x, d, false); d = __builtin_amdgcn_sdot4((int)ub[z][i].y, (int)hs[z].y, d, false);
                        d = __builtin_amdgcn_sdot4((int)ub[z][i].z, (int)hs[z].z, d, false); d = __builtin_amdgcn_sdot4((int)ub[z][i].w, (int)hs[z].w, d, false); p[i] = d; }
                    const bool b0 = (c8 & 1) != 0, b1 = (c8 & 2) != 0, b2 = (c8 & 4) != 0;
                    int r1[8], r2[4], q0, q1;
#define DPPI(v, ctrl) __builtin_amdgcn_update_dpp(0, (v), (ctrl), 0xf, 0xf, true)
#pragma unroll
                    for (int m = 0; m < 8; ++m) { const int keep = b0 ? p[2 * m + 1] : p[2 * m], give = b0 ? p[2 * m] : p[2 * m + 1]; r1[m] = keep + DPPI(give, 0xB1); }
#pragma unroll
                    for (int m = 0; m < 4; ++m) { const int keep = b1 ? r1[2 * m + 1] : r1[2 * m], give = b1 ? r1[2 * m] : r1[2 * m + 1]; r2[m] = keep + DPPI(give, 0x4E); }
                    { const int keep = b2 ? r2[1] : r2[0], give = b2 ? r2[0] : r2[1]; const int gl = DPPI(give, 0x104), gr = DPPI(give, 0x114); q0 = keep + (b2 ? gr : gl); }
                    { const int keep = b2 ? r2[3] : r2[2], give = b2 ? r2[2] : r2[3]; const int gl = DPPI(give, 0x104), gr = DPPI(give, 0x114); q1 = keep + (b2 ? gr : gl); }
#undef DPPI
                    if (z == 0 || vB) *(GAS v2u*)(DOTX + ((size_t)xr * NTOK + tt[z]) * 128 + 2 * ln) = (v2u){(unsigned)(q0 + old[z][0]), (unsigned)(q1 + old[z][1])};
                }
            }
        }
    }
    GRID_BAR();
    int lc = threadIdx.x; asm volatile("" : "+v"(lc)); lc &= 63;
    for (int i8 = gw * 64 + lc; i8 < NTOK * 16; i8 += NGT) {
        const size_t gi = (size_t)i8 * 8; v4u a0 = {0u, 0u, 0u, 0u}, a1 = a0;
        for (int xx = 0; xx < nx; ++xx) { const GAS v4u* dp = (const GAS v4u*)((const int*)DOTX + (size_t)xx * NTOK * 128 + gi); const v4u p0 = dp[0], p1 = dp[1]; a0 += p0; a1 += p1; }
        const GAS f32x4* gp = (const GAS f32x4*)(GATES + gi); const f32x4 g0 = gp[0], g1 = gp[1];
        const float sc = HSC[i8 >> 4] * (1.0f / U_QSCALE);
        float c[8];
        c[0] = g0.x * gelu_erf((float)(int)a0.x * sc); c[1] = g0.y * gelu_erf((float)(int)a0.y * sc); c[2] = g0.z * gelu_erf((float)(int)a0.z * sc); c[3] = g0.w * gelu_erf((float)(int)a0.w * sc);
        c[4] = g1.x * gelu_erf((float)(int)a1.x * sc); c[5] = g1.y * gelu_erf((float)(int)a1.y * sc); c[6] = g1.z * gelu_erf((float)(int)a1.z * sc); c[7] = g1.w * gelu_erf((float)(int)a1.w * sc);
        float am = 0.f;
#pragma unroll
        for (int j2 = 0; j2 < 8; ++j2) am = fmaxf(am, fabsf(c[j2]));
        am = fmaxf(am, DPPF(am, 0xB1)); am = fmaxf(am, DPPF(am, 0x4E)); am = fmaxf(am, DPPF(am, 0x141)); am = fmaxf(am, DPPF(am, 0x128));
        am = fmaxf(am, 1e-30f); const float iq = 127.0f / am;
        v2u o; o.x = (unsigned)(q8(c[0] * iq) | (q8(c[1] * iq) << 8) | (q8(c[2] * iq) << 16) | (q8(c[3] * iq) << 24)); o.y = (unsigned)(q8(c[4] * iq) | (q8(c[5] * iq) << 8) | (q8(c[6] * iq) << 16) | (q8(c[7] * iq) << 24));
        *(GAS v2u*)(CB8 + gi) = o;
        if ((i8 & 15) == 0) CSC[i8 >> 4] = am * (1.0f / (127.0f * V_QSCALE));
    }
    GRID_BAR();
    {
        int tl = tid; asm volatile("" : "+v"(tl)); const int ln = tl & 63, k = ln >> 3, c8 = ln & 7;
        const unsigned char* VT8 = (const unsigned char*)VT;
        for (int s = xr; s < NSL; s += nx) {
            const unsigned char* Vs = VT8 + (size_t)s * 16384 * 128;
            v4u nid[2][2];
#pragma unroll
            for (int z = 0; z < 2; ++z) { const int tz = wv + z * nwv; const int tc = tz < NTOK ? tz : wv; const GAS v4u* ip = (const GAS v4u*)(IDS + (size_t)tc * 128 + 16 * k);
#pragma unroll
                for (int i = 0; i < 2; ++i) nid[z][i] = ip[i]; }
#pragma unroll 1
            for (int t = wv; t < NTOK; t += 2 * nwv) {
                const bool vB = (t + nwv) < NTOK; const int tt[2] = {t, vB ? t + nwv : t};
                v4u vb[2][16]; v4u cf[2]; unsigned hs[2]; float scl[2], hsc[2];
#pragma unroll
                for (int z = 0; z < 2; ++z) {
#pragma unroll
                    for (int i = 0; i < 16; ++i) { const unsigned eid = (nid[z][i >> 3][(i >> 1) & 3] >> (16 * (i & 1))) & 0xffffu; vb[z][i] = *(const GAS v4u*)(Vs + (size_t)eid * 128 + 16 * c8); } }
#pragma unroll
                for (int z = 0; z < 2; ++z) { hs[z] = *(const GAS unsigned short*)(H1Q + (size_t)tt[z] * DM + 128 * s + 16 * c8 + 2 * k); hsc[z] = ALPHA * HSC[tt[z]];
                    cf[z] = *(const GAS v4u*)(CB8 + (size_t)tt[z] * 128 + 16 * k); scl[z] = CSC[tt[z]]; }
#pragma unroll
                for (int z = 0; z < 2; ++z) { const int tz = t + (2 + z) * nwv; const int tc = tz < NTOK ? tz : t; const GAS v4u* ip = (const GAS v4u*)(IDS + (size_t)tc * 128 + 16 * k);
#pragma unroll
                    for (int i = 0; i < 2; ++i) nid[z][i] = ip[i]; }
#pragma unroll
                for (int z = 0; z < 2; ++z) {
                    int ai[16];
#pragma unroll
                    for (int q2 = 0; q2 < 16; ++q2) ai[q2] = 0;
#pragma unroll
                    for (int ig = 0; ig < 4; ++ig) { const int cq = (int)cf[z][ig];
#pragma unroll
                        for (int dw = 0; dw < 4; ++dw) {
                            const unsigned d0 = vb[z][4 * ig][dw], d1 = vb[z][4 * ig + 1][dw], d2 = vb[z][4 * ig + 2][dw], d3 = vb[z][4 * ig + 3][dw];
                            const unsigned p0 = __builtin_amdgcn_perm(d1, d0, 0x05010400u), p1 = __builtin_amdgcn_perm(d1, d0, 0x07030602u), p2 = __builtin_amdgcn_perm(d3, d2, 0x05010400u), p3 = __builtin_amdgcn_perm(d3, d2, 0x07030602u);
                            ai[4 * dw + 0] = __builtin_amdgcn_sdot4((int)__builtin_amdgcn_perm(p2, p0, 0x05040100u), cq, ai[4 * dw + 0], false);
                            ai[4 * dw + 1] = __builtin_amdgcn_sdot4((int)__builtin_amdgcn_perm(p2, p0, 0x07060302u), cq, ai[4 * dw + 1], false);
                            ai[4 * dw + 2] = __builtin_amdgcn_sdot4((int)__builtin_amdgcn_perm(p3, p1, 0x05040100u), cq, ai[4 * dw + 2], false);
                            ai[4 * dw + 3] = __builtin_amdgcn_sdot4((int)__builtin_amdgcn_perm(p3, p1, 0x07060302u), cq, ai[4 * dw + 3], false); } }
                    const bool kb0 = (k & 1) != 0, kb1 = (k & 2) != 0, kb2 = (k & 4) != 0;
                    int rAx[4], rAy[4], rBx[2], rBy[2], rCx, rCy;
#define DPPI(v, ctrl) __builtin_amdgcn_update_dpp(0, (v), (ctrl), 0xf, 0xf, true)
#pragma unroll
                    for (int m = 0; m < 4; ++m) { const int kx = kb0 ? ai[4 * m + 2] : ai[4 * m], ky = kb0 ? ai[4 * m + 3] : ai[4 * m + 1], gx = kb0 ? ai[4 * m] : ai[4 * m + 2], gy = kb0 ? ai[4 * m + 1] : ai[4 * m + 3];
                        rAx[m] = kx + DPPI(gx, 0x128); rAy[m] = ky + DPPI(gy, 0x128); }
#pragma unroll
                    for (int m = 0; m < 2; ++m) { const int kx = kb1 ? rAx[2 * m + 1] : rAx[2 * m], ky = kb1 ? rAy[2 * m + 1] : rAy[2 * m], gx = kb1 ? rAx[2 * m] : rAx[2 * m + 1], gy = kb1 ? rAy[2 * m] : rAy[2 * m + 1];
                        const auto sx = __builtin_amdgcn_permlane16_swap((unsigned)gx, (unsigned)gx, false, false), sy = __builtin_amdgcn_permlane16_swap((unsigned)gy, (unsigned)gy, false, false);
                        rBx[m] = kx + (int)(kb1 ? sx[0] : sx[1]); rBy[m] = ky + (int)(kb1 ? sy[0] : sy[1]); }
                    { const int kx = kb2 ? rBx[1] : rBx[0], ky = kb2 ? rBy[1] : rBy[0], gx = kb2 ? rBx[0] : rBx[1], gy = kb2 ? rBy[0] : rBy[1];
                        const auto sx = __builtin_amdgcn_permlane32_swap((unsigned)gx, (unsigned)gx, false, false), sy = __builtin_amdgcn_permlane32_swap((unsigned)gy, (unsigned)gy, false, false);
                        rCx = kx + (int)(kb2 ? sx[0] : sx[1]); rCy = ky + (int)(kb2 ? sy[0] : sy[1]); }
#undef DPPI
                    if (z == 0 || vB) *(GAS unsigned*)(YB + (size_t)tt[z] * DM + 128 * s + 16 * c8 + 2 * k) = cvtpk_s((float)rCx * scl[z] + hsc[z] * (float)(int)(signed char)(hs[z] & 0xffu), (float)rCy * scl[z] + hsc[z] * (float)(int)(signed char)(hs[z] >> 8));
                }
            }
        }
    }
    GRID_BAR();
    { int lane = threadIdx.x; asm volatile("" : "+v"(lane)); lane &= 63;
    v4u wa[4], wn[4]; if (gw < NTOK) ln_load_bf16(wa, YB + (size_t)gw * DM, lane);
    for (int m = gw; m < NTOK; m += NGW) {
        { const int mn = m + NGW; if (mn < NTOK) ln_load_bf16(wn, YB + (size_t)mn * DM, lane); }
        float v[32]; float sm = 0.f;
#pragma unroll
        for (int j2 = 0; j2 < 4; ++j2) { const v4u w = wa[j2];
            v[8 * j2 + 0] = bflo(w.x); v[8 * j2 + 1] = bfhi(w.x); v[8 * j2 + 2] = bflo(w.y); v[8 * j2 + 3] = bfhi(w.y); v[8 * j2 + 4] = bflo(w.z); v[8 * j2 + 5] = bfhi(w.z); v[8 * j2 + 6] = bflo(w.w); v[8 * j2 + 7] = bfhi(w.w); }
#pragma unroll
        for (int i = 0; i < 32; ++i) sm += v[i];
        const float mean = wave_sum(sm) * (1.f / DM); float s2 = 0.f;
#pragma unroll
        for (int i = 0; i < 32; ++i) { v[i] -= mean; s2 += v[i] * v[i]; }
        const float rstd = 1.f / sqrtf(wave_sum(s2) * (1.f / DM) + LN_EPS);
#pragma unroll
        for (int j2 = 0; j2 < 4; ++j2) {
            const GAS f32x4* gp = (const GAS f32x4*)ln_ffn_g + 2 * (lane + 64 * j2); const GAS f32x4* bp = (const GAS f32x4*)ln_ffn_b + 2 * (lane + 64 * j2);
            const f32x4 g0 = gp[0], g1 = gp[1], b0 = bp[0], b1 = bp[1];
            GAS f32x4* op = (GAS f32x4*)(out + (size_t)m * DM) + 2 * (lane + 64 * j2);
            op[0] = (f32x4){v[8 * j2 + 0] * rstd * g0.x + b0.x, v[8 * j2 + 1] * rstd * g0.y + b0.y, v[8 * j2 + 2] * rstd * g0.z + b0.z, v[8 * j2 + 3] * rstd * g0.w + b0.w};
            op[1] = (f32x4){v[8 * j2 + 4] * rstd * g1.x + b1.x, v[8 * j2 + 5] * rstd * g1.y + b1.y, v[8 * j2 + 6] * rstd * g1.z + b1.z, v[8 * j2 + 7] * rstd * g1.w + b1.w}; }
#pragma unroll
        for (int j2 = 0; j2 < 4; ++j2) wa[j2] = wn[j2];
    }
    }
}

extern "C" void kernel_launch(void* const* d_in, const int* in_sizes, int n_in, void* d_out, int out_size, void* d_ws, size_t ws_size, hipStream_t stream) {
    static int grid = 0;
    if (grid == 0) {
        if (n_in != 15 || out_size != NTOK * DM || ws_size < WS_END) { fprintf(stderr, "kernel_launch: unexpected shapes (n_in %d out %d ws %zu)\n", n_in, out_size, ws_size); grid = -1; return; }
        int dev = 0, cus = 0, per_cu = 0;
        if (hipGetDevice(&dev) != hipSuccess || hipDeviceGetAttribute(&cus, hipDeviceAttributeMultiprocessorCount, dev) != hipSuccess) { grid = -1; return; }
        if (hipFuncSetAttribute((const void*)mk_fwd, hipFuncAttributeMaxDynamicSharedMemorySize, LDS_BYTES) != hipSuccess) { fprintf(stderr, "kernel_launch: hipFuncSetAttribute failed\n"); grid = -1; return; }
        if (hipOccupancyMaxActiveBlocksPerMultiprocessor(&per_cu, (const void*)mk_fwd, NWAVES * 64, LDS_BYTES) != hipSuccess || per_cu < 1) { fprintf(stderr, "kernel_launch: occupancy query says %d\n", per_cu); }
        (void)hipGetLastError();
        grid = cus;
    }
    if (grid < 0) return;
    if (hipMemsetAsync((char*)d_ws + WS_CTL, 0, CTL_ZERO_BYTES, stream) != hipSuccess) return;
    Args a{};
    for (int i = 0; i < 15; ++i) a.in[i] = (const float*)d_in[i];
    a.out = (float*)d_out; a.ws = (unsigned char*)d_ws;
    hipLaunchKernelGGL(mk_fwd, dim3(grid), dim3(NWAVES * 64), LDS_BYTES, stream, a);
}
```

```cpp
#include <hip/hip_runtime.h>
#include <cstdio>
#include <cstdint>
#include <cmath>
namespace pg8 {
#define PG8_LAS __attribute__((address_space(3)))
typedef unsigned short bf16_t;
typedef short bf16x8 __attribute__((ext_vector_type(8)));
typedef float f32x4 __attribute__((ext_vector_type(4)));
typedef unsigned u32x4 __attribute__((ext_vector_type(4)));
constexpr int BM = 256, BK = 64, HALF = 128, HTB = HALF * BK * 2  , STAGE_BYTES = 8 * HTB, NXCD = 8, WGM = 4;

__host__ __device__ __forceinline__ int lds_byte(int r, int c) { const int st = (r >> 4) * 2 + (c >> 5), rr = r & 15, cc = c & 31, ob = rr * 64 + cc * 2; return st * 1024 + (ob ^ (((ob >> 9) & 1) << 5)); }
__host__ __device__ __forceinline__ void stage_rc(int b, int& R, int& C) { const int st = b / 1024, sb = b % 1024, swz = sb ^ (((sb >> 9) & 1) << 5); R = (st >> 1) * 16 + swz / 64; C = (st & 1) * 32 + (swz % 64) / 2; }
__host__ __device__ __forceinline__ int perm32(int rho) { const int n = rho >> 4, i = rho & 15; return 8 * (i >> 2) + 4 * n + (i & 3); }

struct Unit { int pm, pn; };
struct Gemm { const bf16_t* A; const bf16_t* Bt; int M, N, K; const float* rs; const float* cs; float ascale = 1.0f; };
typedef int i32x4 __attribute__((ext_vector_type(4)));
typedef int i32x8 __attribute__((ext_vector_type(8)));

struct StaticOrder {
    int nM, nN, nwg, G, c, wgm;
    __host__ __device__ void init(int M, int N, int G_, int c_, int wgm_ = WGM) { nM = M / BM; nN = N / BM; nwg = nM * nN; G = G_; c = c_; wgm = wgm_; }
    __host__ __device__ bool next(int i, Unit& u) const {
        const long L = (long)i * G + c; if (L >= nwg) return false;
        int wgid = (int)L; { const int q = nwg / NXCD, r = nwg % NXCD, xcd = wgid % NXCD, off = wgid / NXCD; wgid = (xcd < r ? xcd * (q + 1) : r * (q + 1) + (xcd - r) * q) + off; }
        const int nig = wgm * nN, gid = wgid / nig, fm = gid * wgm, gsz = (nM - fm) < wgm ? (nM - fm) : wgm;
        u.pm = fm + ((wgid % nig) % gsz); u.pn = (wgid % nig) / gsz; return true;
    }
    __device__ __forceinline__ void a_ready(const Unit&) const {}
    __device__ __forceinline__ void done(const Unit&) const {}
};

__device__ __forceinline__ unsigned cvt_pk_bf16(float lo, float hi) { unsigned r; asm volatile("v_cvt_pk_bf16_f32 %0, %1, %2" : "=v"(r) : "v"(lo), "v"(hi)); return r; }
typedef float f32x2 __attribute__((ext_vector_type(2)));

template <int MODE> struct EpiGen {
    static constexpr bool PERM = true, AFTER_DRAIN = false;
    bf16_t* O; int ldc; const bf16_t* R; float alpha;
    const signed char* R8 = nullptr; const float* RS = nullptr;
    bf16_t *QR, *KA, *VA, *RK, *RV, *RG;
    __device__ __forceinline__ void operator()(const f32x4 (&acc)[2][2][4][2], const Unit& u, int wr, int wc, int fr, int fq) const {
        const int row0 = u.pm * BM + wr * 64 + fr;
#pragma unroll
        for (int bj = 0; bj < 2; ++bj) {
            const int col = u.pn * BM + bj * HALF + wc * 32 + 8 * fq;
            bf16_t* base = O; int ld = ldc; int cc = col;
            if (MODE == 0) {
                if (col < 1024)      { base = QR; ld = 2048; cc = col; }
                else if (col < 1152) { base = KA; ld = 128;  cc = col - 1024; }
                else if (col < 1280) { base = VA; ld = 128;  cc = col - 1152; }
                else if (col < 2304) { base = QR; ld = 2048; cc = col - 1280 + 1024; }
                else if (col < 3328) { base = RK; ld = 1024; cc = col - 2304; }
                else if (col < 4352) { base = RV; ld = 1024; cc = col - 3328; }
                else                 { base = RG; ld = 1024; cc = col - 4352; }
            }
#pragma unroll
            for (int ai = 0; ai < 2; ++ai)
#pragma unroll
                for (int m = 0; m < 4; ++m) {
                    const int row = row0 + ai * HALF + m * 16;
                    f32x4 v0 = acc[ai][bj][m][0], v1 = acc[ai][bj][m][1];
                    if (MODE == 1) {
                        const unsigned long long rr = *(const unsigned long long*)(R8 + (size_t)row * ldc + col);
                        const unsigned r0 = (unsigned)rr ^ 0x80808080u, r1 = (unsigned)(rr >> 32) ^ 0x80808080u;
                        const float as = alpha * RS[row], ab = -128.0f * as;
                        v0[0] += (float)(r0 & 0xffu) * as + ab; v0[1] += (float)((r0 >> 8) & 0xffu) * as + ab; v0[2] += (float)((r0 >> 16) & 0xffu) * as + ab; v0[3] += (float)(r0 >> 24) * as + ab;
                        v1[0] += (float)(r1 & 0xffu) * as + ab; v1[1] += (float)((r1 >> 8) & 0xffu) * as + ab; v1[2] += (float)((r1 >> 16) & 0xffu) * as + ab; v1[3] += (float)(r1 >> 24) * as + ab;
                    }
                    u32x4 w; w.x = cvt_pk_bf16(v0[0], v0[1]); w.y = cvt_pk_bf16(v0[2], v0[3]); w.z = cvt_pk_bf16(v1[0], v1[1]); w.w = cvt_pk_bf16(v1[2], v1[3]);
                    *(u32x4*)(base + (size_t)row * ld + cc) = w;
                }
        }
    }
};

struct EpiProj {
    static constexpr bool PERM = true, AFTER_DRAIN = false;
    bf16_t *QR, *KA, *VA, *RK, *RV, *RG; float qscale;
    __device__ __forceinline__ void operator()(const f32x4 (&acc)[2][2][4][2], const Unit& u, int wr, int wc, int fr, int fq) const {
        const int pn = u.pn, row0 = u.pm * BM + wr * 64 + fr, c0 = wc * 32 + 8 * fq;
        const bool rope = (pn <= 3) || (pn == 4 && wc < 2) || (pn >= 5 && pn <= 12);
        if (rope) {
            const bool ret = pn >= 5; const int h = ret ? ((pn - 5) & 3) : 0;
            const float lg = __builtin_amdgcn_logf(1.0f - __builtin_amdgcn_exp2f(-5.0f - (float)h));
            float invrev[8];
#pragma unroll
            for (int i8 = 0; i8 < 8; ++i8) { const float ii = (float)((ret ? c0 : 8 * fq) + i8); invrev[i8] = 0.15915494309189535f * __builtin_amdgcn_exp2f(-ii * (ret ? 0.10381025296523008f : 0.4152410118609203f)); }
            bf16_t* base; int ld, cA, cB;
            if (pn <= 3)      { base = QR; ld = 2048; cA = pn * 256 + 64 * wc + 8 * fq; cB = cA + 32; }
            else if (pn == 4) { base = KA; ld = 128;  cA = 64 * wc + 8 * fq; cB = cA + 32; }
            else if (pn <= 8) { base = QR; ld = 2048; cA = 1024 + 256 * h + c0; cB = cA + 128; }
            else              { base = RK; ld = 1024; cA = 256 * h + c0; cB = cA + 128; }
#pragma unroll
            for (int ai = 0; ai < 2; ++ai)
#pragma unroll
                for (int m = 0; m < 4; ++m) {
                    const int row = row0 + ai * HALF + m * 16;
                    int pos, ipos;
                    if (row < 16384) { const int s = row & 4095; pos = 16 + s; ipos = s & 127; } else { int j = row - 16384; if (j > 15) j = 15; pos = j; ipos = 112 + j; }
                    float sc = qscale;
                    if (pn == 4) sc = 1.0f; else if (pn >= 9) sc = 0.0625f * __builtin_amdgcn_exp2f(-(float)(ipos + 1) * lg); else if (pn >= 5) sc = __builtin_amdgcn_exp2f((float)(ipos + 1) * lg);
                    const float pf = (float)pos;
                    float cs[8], sn[8];
#pragma unroll
                    for (int i8 = 0; i8 < 8; ++i8) { const float rev = __builtin_amdgcn_fractf(pf * invrev[i8]); cs[i8] = __builtin_amdgcn_cosf(rev); sn[i8] = __builtin_amdgcn_sinf(rev); }
                    const f32x4 a0 = acc[ai][0][m][0], a1 = acc[ai][0][m][1], b0 = acc[ai][1][m][0], b1 = acc[ai][1][m][1];
                    u32x4 wA, wB;
                    wA.x = cvt_pk_bf16((a0[0] * cs[0] - b0[0] * sn[0]) * sc, (a0[1] * cs[1] - b0[1] * sn[1]) * sc); wA.y = cvt_pk_bf16((a0[2] * cs[2] - b0[2] * sn[2]) * sc, (a0[3] * cs[3] - b0[3] * sn[3]) * sc);
                    wA.z = cvt_pk_bf16((a1[0] * cs[4] - b1[0] * sn[4]) * sc, (a1[1] * cs[5] - b1[1] * sn[5]) * sc); wA.w = cvt_pk_bf16((a1[2] * cs[6] - b1[2] * sn[6]) * sc, (a1[3] * cs[7] - b1[3] * sn[7]) * sc);
                    wB.x = cvt_pk_bf16((b0[0] * cs[0] + a0[0] * sn[0]) * sc, (b0[1] * cs[1] + a0[1] * sn[1]) * sc); wB.y = cvt_pk_bf16((b0[2] * cs[2] + a0[2] * sn[2]) * sc, (b0[3] * cs[3] + a0[3] * sn[3]) * sc);
                    wB.z = cvt_pk_bf16((b1[0] * cs[4] + a1[0] * sn[4]) * sc, (b1[1] * cs[5] + a1[1] * sn[5]) * sc); wB.w = cvt_pk_bf16((b1[2] * cs[6] + a1[2] * sn[6]) * sc, (b1[3] * cs[7] + a1[3] * sn[7]) * sc);
                    *(u32x4*)(base + (size_t)row * ld + cA) = wA; *(u32x4*)(base + (size_t)row * ld + cB) = wB;
                }
        } else {
            const bool silu = pn >= 17;
#pragma unroll
            for (int bj = 0; bj < 2; ++bj) {
                bf16_t* base; int ld, cc;
                if (pn == 4)       { base = VA; ld = 128;  cc = 64 * bj + 32 * (wc - 2) + 8 * fq; }
                else if (pn <= 16) { base = RV; ld = 1024; cc = 256 * (pn - 13) + 128 * bj + c0; }
                else               { base = RG; ld = 1024; cc = 256 * (pn - 17) + 128 * bj + c0; }
#pragma unroll
                for (int ai = 0; ai < 2; ++ai)
#pragma unroll
                    for (int m = 0; m < 4; ++m) {
                        const int row = row0 + ai * HALF + m * 16;
                        f32x4 v0 = acc[ai][bj][m][0], v1 = acc[ai][bj][m][1];
                        if (silu) {
#pragma unroll
                            for (int e = 0; e < 4; ++e) { v0[e] = v0[e] * __builtin_amdgcn_rcpf(1.0f + __builtin_amdgcn_exp2f(-1.4426950408889634f * v0[e])); v1[e] = v1[e] * __builtin_amdgcn_rcpf(1.0f + __builtin_amdgcn_exp2f(-1.4426950408889634f * v1[e])); } }
                        u32x4 w; w.x = cvt_pk_bf16(v0[0], v0[1]); w.y = cvt_pk_bf16(v0[2], v0[3]); w.z = cvt_pk_bf16(v1[0], v1[1]); w.w = cvt_pk_bf16(v1[2], v1[3]);
                        *(u32x4*)(base + (size_t)row * ld + cc) = w;
                    }
            }
        }
    }
};
struct NoHook { __device__ __forceinline__ void operator()(int) const {} };
template <class Epi, class Sched, bool ALIGN_EPI = false, bool SP2 = false, class Hook = NoHook, bool I8 = false, bool F8 = false>
__device__ __forceinline__ void gemm_phase(PG8_LAS unsigned char* lds, const Gemm g, const Sched& S, const Epi& E, const Hook& H = Hook()) {
    int tid_ = threadIdx.x; asm volatile("" : "+v"(tid_));
    const int tid = tid_, wid = __builtin_amdgcn_readfirstlane(tid >> 6), lane = tid & 63, wr = wid >> 2, wc = wid & 3, fr = lane & 15, fq = lane >> 4;
    const int K = g.K, nt = K / BK;
    unsigned voffA[2], voffB[2];
#pragma unroll
    for (int i = 0; i < 2; ++i) { int R, C; stage_rc(tid * 16 + i * 8192, R, C); const int Rb = Epi::PERM ? ((R & ~31) + perm32(R & 31)) : R;
        voffA[i] = (unsigned)(R * K + C) * 2u; voffB[i] = (unsigned)(Rb * K + C) * 2u; }
    const size_t kstep = (size_t)(BK * 2);
    const size_t hstep = (size_t)HALF * K * 2;
    const size_t tstep = 2 * hstep;
    const unsigned ldsw = (unsigned)wid * 1024u;
    const int aoff = lds_byte(wr * 64 + fr, fq * 8), boff = lds_byte(wc * 32 + fr, fq * 8);
#define PG8_SA(b, h) (((b) * 2 + (h)) * HTB)
#define PG8_SB(b, h) ((4 + (b) * 2 + (h)) * HTB)
#define PG8_STAGE(bufoff, gbase, voff) do { _Pragma("unroll") for (int _i = 0; _i < 2; ++_i) { unsigned vo_ = (voff)[_i]; if constexpr (F8) asm volatile("" : "+v"(vo_)); \
        __builtin_amdgcn_global_load_lds((const unsigned*)((const char*)(gbase) + vo_), (PG8_LAS unsigned*)(lds + (bufoff) + ldsw + _i * 8192), 16, 0, 0); } } while (0)
#define PG8_LDA(dst, b, h) do { _Pragma("unroll") for (int m = 0; m < 4; ++m) _Pragma("unroll") for (int k = 0; k < 2; ++k) dst[m][k] = *(const PG8_LAS bf16x8*)(lds + PG8_SA(b, h) + aoff + m * 2048 + k * 1024); } while (0)
#define PG8_LDB(dst, b, h) do { _Pragma("unroll") for (int n = 0; n < 2; ++n) _Pragma("unroll") for (int k = 0; k < 2; ++k) dst[n][k] = *(const PG8_LAS bf16x8*)(lds + PG8_SB(b, h) + boff + n * 2048 + k * 1024); } while (0)
#define PG8_CAT8(x) __builtin_shufflevector(__builtin_bit_cast(i32x4, (x)[0]), __builtin_bit_cast(i32x4, (x)[1]), 0, 1, 2, 3, 4, 5, 6, 7)
#define PG8_MMA(ai, bj, At, Bt) do { __builtin_amdgcn_s_setprio(1); if constexpr (F8) { _Pragma("unroll") for (int m = 0; m < 4; ++m) _Pragma("unroll") for (int n = 0; n < 2; ++n) \
        acc[ai][bj][m][n] = __builtin_amdgcn_mfma_scale_f32_16x16x128_f8f6f4(PG8_CAT8(Bt[n]), PG8_CAT8(At[m]), acc[ai][bj][m][n], 0, 0, 0, 0x7f7f7f7f, 0, 0x7f7f7f7f); } else \
    _Pragma("unroll") for (int m = 0; m < 4; ++m) _Pragma("unroll") for (int n = 0; n < 2; ++n) _Pragma("unroll") for (int k = 0; k < 2; ++k) \
        { if constexpr (I8) acc[ai][bj][m][n] = __builtin_bit_cast(f32x4, __builtin_amdgcn_mfma_i32_16x16x64_i8(__builtin_bit_cast(i32x4, Bt[n][k]), __builtin_bit_cast(i32x4, At[m][k]), __builtin_bit_cast(i32x4, acc[ai][bj][m][n]), 0, 0, 0)); \
          else acc[ai][bj][m][n] = __builtin_amdgcn_mfma_f32_16x16x32_bf16(Bt[n][k], At[m][k], acc[ai][bj][m][n], 0, 0, 0); } __builtin_amdgcn_s_setprio(0); } while (0)
#define PG8_WAIT_V(n) asm volatile("s_waitcnt vmcnt(" #n ")" ::: "memory")
#define PG8_WAIT_L(n) asm volatile("s_waitcnt lgkmcnt(" #n ")" ::: "memory")
#define PG8_BAR __builtin_amdgcn_s_barrier()
#define PG8_SCHED __builtin_amdgcn_sched_barrier(0)
    Unit cur, nxt; int ui = 0;
    if (!S.next(0, cur)) return;
    f32x4 acc[2][2][4][2];
#pragma unroll
    for (int a = 0; a < 2; ++a)
#pragma unroll
        for (int b = 0; b < 2; ++b)
#pragma unroll
            for (int m = 0; m < 4; ++m)
#pragma unroll
                for (int n = 0; n < 2; ++n) acc[a][b][m][n] = (f32x4){0.f, 0.f, 0.f, 0.f};
    bf16x8 At[4][2], B0[2][2], B1[2][2];
    const char* cA = (const char*)g.A + (size_t)cur.pm * tstep; const char* cB = (const char*)g.Bt + (size_t)cur.pn * tstep;
    S.a_ready(cur);
    if constexpr (SP2) {
        PG8_STAGE(PG8_SB(0, 0), cB, voffB); PG8_STAGE(PG8_SB(0, 1), cB + hstep, voffB); PG8_STAGE(PG8_SA(0, 0), cA, voffA); PG8_STAGE(PG8_SA(0, 1), cA + hstep, voffA);
        if (wr == 1) PG8_BAR;
        PG8_WAIT_V(2); PG8_BAR;
        PG8_STAGE(PG8_SB(1, 0), cB + kstep, voffB); PG8_STAGE(PG8_SA(1, 0), cA + kstep, voffA); PG8_STAGE(PG8_SB(1, 1), cB + hstep + kstep, voffB);
        PG8_WAIT_V(6); PG8_BAR;
    } else {
        PG8_STAGE(PG8_SB(0, 0), cB, voffB); PG8_STAGE(PG8_SA(0, 0), cA, voffA); PG8_STAGE(PG8_SB(0, 1), cB + hstep, voffB); PG8_STAGE(PG8_SA(0, 1), cA + hstep, voffA);
        if (wr == 1) PG8_BAR;
        PG8_WAIT_V(4); PG8_BAR;
        PG8_STAGE(PG8_SB(1, 0), cB + kstep, voffB); PG8_STAGE(PG8_SA(1, 0), cA + kstep, voffA); PG8_STAGE(PG8_SB(1, 1), cB + hstep + kstep, voffB);
        PG8_WAIT_V(6); PG8_BAR;
    }
    for (;;) {
        const bool has_next = S.next(ui + 1, nxt);
        const char* nA = has_next ? (const char*)g.A + (size_t)nxt.pm * tstep : cA; const char* nB = has_next ? (const char*)g.Bt + (size_t)nxt.pn * tstep : cB;
        for (int t = 0; t < nt; t += 2) {
            const bool last = (t == nt - 2);
            const char* a1 = cA + (size_t)(t + 1) * kstep;
            const char* a2 = last ? nA : cA + (size_t)(t + 2) * kstep; const char* b2 = last ? nB : cB + (size_t)(t + 2) * kstep;
            const char* a3 = a2 + kstep; const char* b3 = b2 + kstep;
            if (last && has_next) S.a_ready(nxt);
            if constexpr (SP2) {
            PG8_LDB(B0, 0, 0); PG8_LDB(B1, 0, 1); PG8_SCHED; PG8_LDA(At, 0, 0); PG8_STAGE(PG8_SA(1, 1), a1 + hstep, voffA);
            PG8_WAIT_V(8); PG8_WAIT_L(0); PG8_BAR; PG8_MMA(0, 0, At, B0); PG8_MMA(0, 1, At, B1); PG8_BAR; PG8_SCHED;
            PG8_LDA(At, 0, 1); PG8_STAGE(PG8_SB(0, 0), b2, voffB); PG8_STAGE(PG8_SB(0, 1), b2 + hstep, voffB); PG8_STAGE(PG8_SA(0, 0), a2, voffA);
            PG8_WAIT_V(8); PG8_WAIT_L(0); PG8_BAR; PG8_MMA(1, 0, At, B0); PG8_MMA(1, 1, At, B1); PG8_BAR; PG8_SCHED;
            PG8_LDB(B0, 1, 0); PG8_LDB(B1, 1, 1); PG8_SCHED; PG8_LDA(At, 1, 0); PG8_STAGE(PG8_SA(0, 1), a2 + hstep, voffA);
            PG8_WAIT_V(8); PG8_WAIT_L(0); PG8_BAR; PG8_MMA(0, 0, At, B0); PG8_MMA(0, 1, At, B1); PG8_BAR; PG8_SCHED;
            PG8_LDA(At, 1, 1); PG8_STAGE(PG8_SB(1, 0), b3, voffB); PG8_STAGE(PG8_SB(1, 1), b3 + hstep, voffB); PG8_STAGE(PG8_SA(1, 0), a3, voffA);
            PG8_WAIT_V(8); PG8_WAIT_L(0); PG8_BAR; PG8_MMA(1, 0, At, B0); PG8_MMA(1, 1, At, B1); PG8_BAR; PG8_SCHED;
            } else {
            PG8_LDB(B0, 0, 0); PG8_SCHED; PG8_LDA(At, 0, 0); PG8_STAGE(PG8_SA(1, 1), a1 + hstep, voffA);
            PG8_WAIT_L(8); PG8_BAR; PG8_WAIT_L(0); PG8_MMA(0, 0, At, B0); PG8_BAR; PG8_SCHED;
            PG8_LDB(B1, 0, 1); PG8_STAGE(PG8_SB(0, 0), b2, voffB);
            PG8_BAR; PG8_WAIT_L(0); PG8_MMA(0, 1, At, B1); PG8_BAR;
            PG8_LDA(At, 0, 1); PG8_STAGE(PG8_SA(0, 0), a2, voffA);
            PG8_BAR; PG8_WAIT_L(0); PG8_MMA(1, 0, At, B0); PG8_BAR; PG8_SCHED;
            PG8_STAGE(PG8_SB(0, 1), b2 + hstep, voffB);
            PG8_WAIT_V(6); PG8_BAR; PG8_MMA(1, 1, At, B1); PG8_BAR;
            PG8_LDB(B0, 1, 0); PG8_SCHED; PG8_LDA(At, 1, 0); PG8_STAGE(PG8_SA(0, 1), a2 + hstep, voffA);
            PG8_WAIT_L(8); PG8_BAR; PG8_WAIT_L(0); PG8_MMA(0, 0, At, B0); PG8_BAR; PG8_SCHED;
            PG8_LDB(B1, 1, 1); PG8_STAGE(PG8_SB(1, 0), b3, voffB);
            PG8_BAR; PG8_WAIT_L(0); PG8_MMA(0, 1, At, B1); PG8_BAR;
            PG8_LDA(At, 1, 1); PG8_STAGE(PG8_SA(1, 0), a3, voffA);
            PG8_BAR; PG8_WAIT_L(0); PG8_MMA(1, 0, At, B0); PG8_BAR; PG8_SCHED;
            PG8_STAGE(PG8_SB(1, 1), b3 + hstep, voffB);
            PG8_WAIT_V(6); PG8_BAR; PG8_MMA(1, 1, At, B1); PG8_BAR;
            }
        }
        if constexpr (ALIGN_EPI) { if (wr == 0) PG8_BAR; }
        int frl = fr, fql = fq; asm volatile("" : "+v"(frl), "+v"(fql));
        if constexpr (I8 || F8) {
            const int row0 = cur.pm * BM + wr * 64 + frl;
            float rsv[2][4];
#pragma unroll
            for (int ai = 0; ai < 2; ++ai)
#pragma unroll
                for (int m = 0; m < 4; ++m) rsv[ai][m] = F8 ? g.ascale : g.rs[row0 + ai * HALF + m * 16];
#pragma unroll
            for (int bj = 0; bj < 2; ++bj) {
                const int col = cur.pn * BM + bj * HALF + wc * 32 + 8 * fql;
                const f32x4 c0 = *(const f32x4*)(g.cs + col), c1 = *(const f32x4*)(g.cs + col + 4);
#pragma unroll
                for (int ai = 0; ai < 2; ++ai)
#pragma unroll
                    for (int m = 0; m < 4; ++m)
                    {
                        const i32x4 i0 = __builtin_bit_cast(i32x4, acc[ai][bj][m][0]), i1 = __builtin_bit_cast(i32x4, acc[ai][bj][m][1]);
                        f32x4 f0, f1;
#pragma unroll
                        for (int e = 0; e < 4; ++e) { f0[e] = (F8 ? acc[ai][bj][m][0][e] : (float)i0[e]) * (rsv[ai][m] * c0[e]); f1[e] = (F8 ? acc[ai][bj][m][1][e] : (float)i1[e]) * (rsv[ai][m] * c1[e]); }
                        acc[ai][bj][m][0] = f0; acc[ai][bj][m][1] = f1; }
            }
        }
        if constexpr (!Epi::AFTER_DRAIN) { E(acc, cur, wr, wc, frl, fql); S.done(cur); }
        if (!has_next) break;
        H(ui);
#pragma unroll
        for (int a = 0; a < 2; ++a)
#pragma unroll
            for (int b = 0; b < 2; ++b)
#pragma unroll
                for (int m = 0; m < 4; ++m)
#pragma unroll
                    for (int n = 0; n < 2; ++n) acc[a][b][m][n] = (f32x4){0.f, 0.f, 0.f, 0.f};
        cur = nxt; cA = nA; cB = nB; ++ui;
        if constexpr (ALIGN_EPI) { if (wr == 1) PG8_BAR; }
    }
    PG8_WAIT_V(0);
    if constexpr (!ALIGN_EPI) { if (wr == 0) PG8_BAR; }
    PG8_BAR;
    if constexpr (Epi::AFTER_DRAIN) { E.fused(acc, cur, wr, wc, fr, fq, lds, wid, lane); S.done(cur); }
#undef PG8_SA
#undef PG8_SB
#undef PG8_STAGE
#undef PG8_LDA
#undef PG8_LDB
#undef PG8_MMA
#undef PG8_WAIT_V
#undef PG8_WAIT_L
#undef PG8_BAR
#undef PG8_SCHED
}
}

constexpr int NWAVES = 8;
constexpr int DM = 2048, NB = 4, SEQ = 4096, NTOK = NB * SEQ;
constexpr int NMETA = 16, NVALID = NTOK + NMETA, MROWS = 16640;
constexpr int IN_COLS = 5376;
constexpr float LN_EPS = 1e-5f, GN_EPS = 1e-5f;
constexpr float ALPHA = 1.189207115002721f;
constexpr float LOG2E = 1.4426950408889634f;
constexpr float QSCALE = 0.125f * LOG2E;
constexpr float U_QSCALE = 958.0f;
constexpr float V_QSCALE = 35.6f;
constexpr int NSL = 16;

constexpr size_t MiB = 1u << 20;
constexpr size_t WS_CTL = 0, CTL_ZERO_BYTES = 65536;
constexpr size_t SZ_SK = (size_t)16 * 128 * 128 * 2, SZ_ROPE_R = (size_t)4112 * 128 * 8, SZ_ROPE_A = (size_t)4112 * 32 * 8;
constexpr size_t SZ_W2T = (size_t)DM * DM * 2, SZ_W1T = (size_t)IN_COLS * DM * 2, SZ_TAB = (size_t)16384 * DM;
constexpr size_t SZ_ROWS2K = (size_t)MROWS * 2048 * 2, SZ_ROWS1K = (size_t)MROWS * 1024 * 2, SZ_ROWS128 = (size_t)MROWS * 128 * 2;
constexpr size_t SZ_TOK2K = (size_t)NTOK * 2048 * 2, SZ_ST = (size_t)16 * 32 * 256 * 256 * 2, SZ_IDS = (size_t)NTOK * 128 * 4;
constexpr size_t al256(size_t x) { return (x + 255) & ~(size_t)255; }
constexpr size_t WS_SK = 1 * MiB;
constexpr size_t WS_ROPE_R = al256(WS_SK + SZ_SK);
constexpr size_t WS_ROPE_A = al256(WS_ROPE_R + SZ_ROPE_R);
constexpr size_t WS_W2T = al256(WS_ROPE_A + SZ_ROPE_A), WS_W3T = al256(WS_W2T + SZ_W2T), WS_W1T = al256(WS_W3T + SZ_W2T);
constexpr size_t WS_UT = al256(WS_W1T + SZ_W1T), WS_VT = al256(WS_UT + SZ_TAB);
constexpr size_t WS_H0 = al256(WS_VT + SZ_TAB);
constexpr size_t WS_QR = al256(WS_H0 + SZ_ROWS2K);
constexpr size_t WS_KA = al256(WS_QR + SZ_ROWS2K), WS_VA = al256(WS_KA + SZ_ROWS128);
constexpr size_t WS_RK = al256(WS_VA + SZ_ROWS128), WS_RV = al256(WS_RK + SZ_ROWS1K), WS_RG = al256(WS_RV + SZ_ROWS1K);
constexpr size_t WS_ST = al256(WS_RG + SZ_ROWS1K);
constexpr size_t WS_Y = WS_RK;
constexpr size_t WS_H1 = WS_ST;
constexpr size_t WS_IDS = al256(WS_ST + SZ_ST), WS_GATES = al256(WS_IDS + SZ_IDS);
constexpr size_t WS_HSC = al256(WS_GATES + SZ_IDS);
constexpr size_t WS_CSC = al256(WS_HSC + (size_t)NTOK * 4);
constexpr size_t WS_H0Q = al256(WS_CSC + (size_t)NTOK * 4);
constexpr size_t WS_W1Q = al256(WS_H0Q + (size_t)MROWS * DM);
constexpr size_t WS_W3Q = al256(WS_W1Q + (size_t)IN_COLS * DM);
constexpr size_t WS_H0S = al256(WS_W3Q + (size_t)DM * DM);
constexpr size_t WS_WS1 = al256(WS_H0S + (size_t)MROWS * 4);
constexpr size_t WS_WS3 = al256(WS_WS1 + (size_t)IN_COLS * 4);
constexpr size_t WS_END = al256(WS_WS3 + (size_t)DM * 4);
static_assert(WS_Y + SZ_TOK2K <= WS_RG, "Y overlays RK|RV only");
static_assert(SZ_TOK2K <= SZ_ST && (size_t)NTOK * 1024 * 4 <= SZ_ST, "H1 / RET_RAW fit the state region");
static_assert(WS_END <= (size_t)512 * MiB, "workspace map fits 4 x largest tensor");
static_assert(WS_RK + (size_t)8 * NTOK * 128 * 4 <= WS_ST && WS_KA + (size_t)NTOK * 128 * 4 <= WS_RK && WS_H0 + (size_t)NTOK * DM * 4 <= WS_KA, "expert-phase overlays (DOTX over RK|RV, CB over KA|VA, Y32 over H0|QR)");
constexpr int CW_TMO = 0, CW_TABQ = 64, CW_BAR = 4096;

constexpr int RING_OFF = 0, RING_BYTES = 131072;
constexpr int LDSCTL_OFF = RING_BYTES, MISC_OFF = LDSCTL_OFF + 320;
constexpr int LDS_BYTES = 147456;

#define GAS __attribute__((address_space(1)))
#define LAS __attribute__((address_space(3)))
typedef unsigned short bf16;
typedef unsigned v4u __attribute__((ext_vector_type(4)));
typedef unsigned v2u __attribute__((ext_vector_type(2)));
typedef float f32x4 __attribute__((ext_vector_type(4)));
typedef float f32x2 __attribute__((ext_vector_type(2)));
typedef GAS unsigned gu32;
typedef __bf16 bf16x2_t __attribute__((ext_vector_type(2)));
#define RLX_AGENT __ATOMIC_RELAXED, __HIP_MEMORY_SCOPE_AGENT
#define LDS_WAIT() asm volatile("s_waitcnt lgkmcnt(0)" ::: "memory")
#define VM_WAIT() asm volatile("s_waitcnt vmcnt(0)" ::: "memory")
#define LDS_BAR() do { asm volatile("s_waitcnt lgkmcnt(0)" ::: "memory"); __builtin_amdgcn_s_barrier(); asm volatile("" ::: "memory"); } while (0)
__device__ __forceinline__ unsigned f2bf(float f) { unsigned u = __builtin_bit_cast(unsigned, f); return (u + 0x7fffu + ((u >> 16) & 1u)) >> 16; }
__device__ __forceinline__ unsigned pk2(float lo, float hi) { return f2bf(lo) | (f2bf(hi) << 16); }
__device__ __forceinline__ float bflo(unsigned w) { return __uint_as_float(w << 16); }
__device__ __forceinline__ float bfhi(unsigned w) { return __uint_as_float(w & 0xffff0000u); }
__device__ __forceinline__ float bf2f(bf16 h) { return __uint_as_float((unsigned)h << 16); }

#define XB_TMO      128
#define XB_XCNT(j)  (256  + 64 * (j))
#define XB_XSUB(j)  (1280 + 64 * (j))
#define XB_XGEN(j)  (2304 + 64 * (j))
#define XB_TOP      3328
#define XB_TOPGEN   3392
#define XCD_BAR_WORDS 3456
#define XB_SPIN_CAP (1u << 18)

__device__ __forceinline__ unsigned xb_ld(unsigned* p)              { return __hip_atomic_load(p, __ATOMIC_RELAXED, __HIP_MEMORY_SCOPE_AGENT); }
__device__ __forceinline__ unsigned xb_add(unsigned* p, unsigned v) { return __hip_atomic_fetch_add(p, v, __ATOMIC_RELAXED, __HIP_MEMORY_SCOPE_AGENT); }
__device__ __forceinline__ unsigned xb_xcc_id() { return (unsigned)__builtin_amdgcn_s_getreg((3 << 11) | 20) & 0xFu; }
#define XB_SPIN(cond, bar) do { unsigned _sp = 0; while (cond) { __builtin_amdgcn_s_sleep(1); \
    if ((++_sp & 255u) == 0u) { if (xb_ld(&(bar)[XB_TMO])) break; if (_sp > XB_SPIN_CAP) { atomicAdd(&(bar)[XB_TMO], 1u); break; } } } } while (0)

struct XcdBarrier {
    unsigned* bar; unsigned x;
    volatile LAS unsigned* st;
};

__device__ __forceinline__ XcdBarrier xcd_barrier_post(unsigned* bar, volatile LAS unsigned* st) {
    XcdBarrier b; b.bar = bar; b.x = xb_xcc_id(); b.st = st;
    if (threadIdx.x == 0) (void)xb_add(&bar[XB_XCNT(b.x)], 1u);
    return b;
}
__device__ __forceinline__ void xcd_barrier_complete(unsigned* bar, unsigned x, unsigned& nloc, unsigned& nx) {
    const unsigned G = gridDim.x * gridDim.y * gridDim.z;
    unsigned sum, cnt, mine, sp = 0u;
    for (;;) {
        sum = 0u; cnt = 0u; mine = 0u;
#pragma unroll
        for (unsigned j = 0; j < 16; ++j) { const unsigned c = xb_ld(&bar[XB_XCNT(j)]); sum += c; cnt += (c > 0u) ? 1u : 0u; mine = (j == x) ? c : mine; }
        if (sum == G) break;
        __builtin_amdgcn_s_sleep(1);
        if ((++sp & 255u) == 0u) { if (xb_ld(&bar[XB_TMO])) break; if (sp > XB_SPIN_CAP) { atomicAdd(&bar[XB_TMO], 1u); break; } }
    }
    nloc = mine > 0u ? mine : 1u; nx = cnt > 0u ? cnt : 1u;
}

__device__ __forceinline__ void xcd_barrier(const XcdBarrier& b) {
    asm volatile("s_waitcnt vmcnt(0)" ::: "memory");
    __syncthreads();
    if (threadIdx.x == 0) {
        unsigned* bar = b.bar;
        __builtin_amdgcn_s_waitcnt(0);
        unsigned nloc = b.st[0], nx = b.st[1];
        if (nloc == 0u) { xcd_barrier_complete(bar, b.x, nloc, nx); b.st[0] = nloc; b.st[1] = nx; }
        const unsigned old = xb_add(&bar[XB_XSUB(b.x)], 1u);
        const unsigned gen = old / nloc;
        if (old + 1u == (gen + 1u) * nloc) {
            __builtin_amdgcn_fence(__ATOMIC_RELEASE, "agent");
            asm volatile("s_waitcnt vmcnt(0)" ::: "memory");
            const unsigned og = xb_add(&bar[XB_TOP], 1u);
            const unsigned tg = og / nx;
            if (og + 1u == (tg + 1u) * nx) xb_add(&bar[XB_TOPGEN], 1u);
            else XB_SPIN(xb_ld(&bar[XB_TOPGEN]) == tg, bar);
            __builtin_amdgcn_fence(__ATOMIC_ACQUIRE, "agent");
            xb_add(&bar[XB_XGEN(b.x)], 1u);
            asm volatile("s_waitcnt vmcnt(0)" ::: "memory");
        } else {
            XB_SPIN(xb_ld(&bar[XB_XGEN(b.x)]) == gen, bar);
            __builtin_amdgcn_fence(__ATOMIC_ACQUIRE, "agent");
            asm volatile("s_waitcnt vmcnt(0)" ::: "memory");
        }
    }
    __syncthreads();
}


__device__ __forceinline__ float dot2bf(unsigned a, unsigned b, float c) { asm("v_dot2c_f32_bf16 %0, %1, %2" : "+v"(c) : "v"(a), "v"(b)); return c; }
__device__ __forceinline__ float dot8bf_dpp(v4u a, v4u b) { float c = 0.f; asm("v_dot2c_f32_bf16 %0, %1, %5\n\tv_dot2c_f32_bf16 %0, %2, %6\n\tv_dot2c_f32_bf16 %0, %3, %7\n\tv_dot2c_f32_bf16 %0, %4, %8\n\ts_nop 1" : "+v"(c) : "v"(a.x), "v"(a.y), "v"(a.z), "v"(a.w), "v"(b.x), "v"(b.y), "v"(b.z), "v"(b.w)); return c; }
#define DPPF(v, ctrl) __int_as_float(__builtin_amdgcn_update_dpp(0, __float_as_int(v), (ctrl), 0xf, 0xf, true))
__device__ __forceinline__ int q8(float x) { int q = (int)__builtin_rintf(x); q = q < -127 ? -127 : (q > 127 ? 127 : q); return q & 0xff; }
__device__ __forceinline__ unsigned fp8x4(float a, float b, float c, float d) {
    a = __builtin_amdgcn_fmed3f(a, -440.f, 440.f); b = __builtin_amdgcn_fmed3f(b, -440.f, 440.f); c = __builtin_amdgcn_fmed3f(c, -440.f, 440.f); d = __builtin_amdgcn_fmed3f(d, -440.f, 440.f);
    int w = 0; w = __builtin_amdgcn_cvt_pk_fp8_f32(a, b, w, false); w = __builtin_amdgcn_cvt_pk_fp8_f32(c, d, w, true); return (unsigned)w; }
constexpr float MIX_F8_SCALE = 8.0f;
__device__ __forceinline__ float wave_sum(float v) {
    v += DPPF(v, 0xB1); v += DPPF(v, 0x4E); v += DPPF(v, 0x141); v += DPPF(v, 0x128);
    { const auto r16 = __builtin_amdgcn_permlane16_swap(__float_as_uint(v), __float_as_uint(v), false, false); v = __uint_as_float(r16[0]) + __uint_as_float(r16[1]); }
    { const auto r32 = __builtin_amdgcn_permlane32_swap(__float_as_uint(v), __float_as_uint(v), false, false); v = __uint_as_float(r32[0]) + __uint_as_float(r32[1]); }
    return v;
}
__device__ __forceinline__ float wave_max(float v) {
    v = fmaxf(v, DPPF(v, 0xB1)); v = fmaxf(v, DPPF(v, 0x4E)); v = fmaxf(v, DPPF(v, 0x141)); v = fmaxf(v, DPPF(v, 0x128));
    { const auto r16 = __builtin_amdgcn_permlane16_swap(__float_as_uint(v), __float_as_uint(v), false, false); v = fmaxf(__uint_as_float(r16[0]), __uint_as_float(r16[1])); }
    { const auto r32 = __builtin_amdgcn_permlane32_swap(__float_as_uint(v), __float_as_uint(v), false, false); v = fmaxf(__uint_as_float(r32[0]), __uint_as_float(r32[1])); }
    return v;
}
__device__ __forceinline__ float gelu_erf(float v) {
    const float av = fabsf(v), d = av * 0.2316418882f + 1.0f;
    const float t = __builtin_amdgcn_rcpf(d);
    float q = t * 0.5307027145f + (-0.7265760135f); q = q * t + 0.7107068705f; q = q * t + (-0.142248368f); q = q * t + 0.127414796f; q = q * t;
    const float e = __builtin_amdgcn_exp2f((v * v) * (-0.72134752044f));
    const float m = v * (q * e);
    return v < 0.f ? m : v - m;
}

struct Args { const float* in[15]; float* out; unsigned char* ws; };

__device__ __forceinline__ int w1_logical_col(int n0p) {
    const int pn = n0p >> 8, blk = (n0p & 255) >> 5, half = blk >> 2, a = blk & 3;
    if (pn <= 3) return pn * 256 + 64 * a + 32 * half;
    if (pn == 4) return (a < 2) ? (1024 + 64 * a + 32 * half) : (1152 + 64 * half + 32 * (a - 2));
    return n0p;
}
template <bool PERMW1> __device__ __forceinline__ void p0_transpose_item(const float* W, int K, int N, bf16* WT, LAS float* scr, int item, int lane) {
    const int nblk = N / 32, kb = item / nblk, nb = item % nblk, k0 = 64 * kb, n0 = 32 * nb; const int ns = PERMW1 ? w1_logical_col(n0) : n0;
    float tv[32];
#pragma unroll
    for (int i = 0; i < 32; ++i) { const int kk = 2 * i + (lane >> 5); tv[i] = W[(size_t)(k0 + kk) * N + ns + (lane & 31)]; }
#pragma unroll
    for (int i = 0; i < 32; ++i) { const int kk = 2 * i + (lane >> 5); scr[kk * 33 + (lane & 31)] = tv[i]; }
    LDS_WAIT(); asm volatile("" ::: "memory");
    const int c = lane & 7;
#pragma unroll
    for (int j = 0; j < 4; ++j) { const int n = (lane >> 3) + 8 * j; const LAS float* s = scr + (8 * c) * 33 + n;
        v4u o; o.x = pk2(s[0 * 33], s[1 * 33]); o.y = pk2(s[2 * 33], s[3 * 33]); o.z = pk2(s[4 * 33], s[5 * 33]); o.w = pk2(s[6 * 33], s[7 * 33]);
        *(GAS v4u*)(WT + (size_t)(n0 + n) * K + k0 + 8 * c) = o; }
    LDS_WAIT(); asm volatile("" ::: "memory");
}
__device__ __forceinline__ void ln_load_f32(f32x4 (&v)[8], const float* xrow, int lane) {
    const GAS f32x4* xr = (const GAS f32x4*)xrow + lane;
#pragma unroll
    for (int j = 0; j < 8; ++j) v[j] = xr[64 * j];
}
__device__ __forceinline__ void ln_row_f32_to_bf16(f32x4 (&v)[8], const float* g, const float* bta, bf16* orow, int lane) {
    float s = 0.f;
#pragma unroll
    for (int j = 0; j < 8; ++j) s += (v[j].x + v[j].y) + (v[j].z + v[j].w);
    const float mean = wave_sum(s) * (1.f / DM); float s2 = 0.f;
#pragma unroll
    for (int j = 0; j < 8; ++j) { v[j] = v[j] - mean; s2 += (v[j].x * v[j].x + v[j].y * v[j].y) + (v[j].z * v[j].z + v[j].w * v[j].w); }
    const float rstd = 1.f / sqrtf(wave_sum(s2) * (1.f / DM) + LN_EPS);
    GAS v2u* o8 = (GAS v2u*)orow + lane;
#pragma unroll
    for (int j = 0; j < 8; ++j) { const f32x4 gg = ((const GAS f32x4*)g)[lane + 64 * j], bb = ((const GAS f32x4*)bta)[lane + 64 * j];
        v2u o; o.x = pk2(v[j].x * rstd * gg.x + bb.x, v[j].y * rstd * gg.y + bb.y); o.y = pk2(v[j].z * rstd * gg.z + bb.z, v[j].w * rstd * gg.w + bb.w); o8[64 * j] = o; }
}
__device__ __forceinline__ void stage_gb(LAS unsigned char* Lgb, const float* g, const float* b, int tid) {
    asm volatile("" : "+v"(tid));
    *(LAS f32x4*)(Lgb + 16 * tid) = ((const GAS f32x4*)g)[tid]; *(LAS f32x4*)(Lgb + 8192 + 16 * tid) = ((const GAS f32x4*)b)[tid];
    __syncthreads();
}
__device__ __forceinline__ void ln_row_f32_to_bf16_q(f32x4 (&v)[8], LAS const unsigned char* Lgb, bf16* orow, signed char* qrow, float* qscale, int lane) {
    float s = 0.f;
#pragma unroll
    for (int j = 0; j < 8; ++j) s += (v[j].x + v[j].y) + (v[j].z + v[j].w);
    const float mean = wave_sum(s) * (1.f / DM); float s2 = 0.f;
#pragma unroll
    for (int j = 0; j < 8; ++j) { v[j] = v[j] - mean; s2 += (v[j].x * v[j].x + v[j].y * v[j].y) + (v[j].z * v[j].z + v[j].w * v[j].w); }
    const float rstd = 1.f / sqrtf(wave_sum(s2) * (1.f / DM) + LN_EPS);
    GAS v2u* o8 = (GAS v2u*)orow + lane; float am = 0.f;
#pragma unroll
    for (int j = 0; j < 8; ++j) { const f32x4 gg = ((LAS const f32x4*)Lgb)[lane + 64 * j], bb = ((LAS const f32x4*)(Lgb + 8192))[lane + 64 * j];
        v[j].x = v[j].x * rstd * gg.x + bb.x; v[j].y = v[j].y * rstd * gg.y + bb.y; v[j].z = v[j].z * rstd * gg.z + bb.z; v[j].w = v[j].w * rstd * gg.w + bb.w;
        am = fmaxf(am, fmaxf(fmaxf(fabsf(v[j].x), fabsf(v[j].y)), fmaxf(fabsf(v[j].z), fabsf(v[j].w))));
        if (orow) { v2u o; o.x = pk2(v[j].x, v[j].y); o.y = pk2(v[j].z, v[j].w); o8[64 * j] = o; } }
    am = fmaxf(wave_max(am), 1e-20f); const float iq = 127.0f / am;
    if (lane == 0) *qscale = am * (1.0f / 127.0f);
#pragma unroll
    for (int j = 0; j < 8; ++j) ((GAS unsigned*)qrow)[lane + 64 * j] = (unsigned)(q8(v[j].x * iq) | (q8(v[j].y * iq) << 8) | (q8(v[j].z * iq) << 16) | (q8(v[j].w * iq) << 24));
}
template <bool F8> __device__ __forceinline__ void w_strip(LAS unsigned char* L, LAS float* red, const float* W, int ld, int ns, signed char* dst, float* sc, int tid) {
    asm volatile("" : "+v"(tid));
    const int kr = tid >> 3, c4 = tid & 7, lane = tid & 63, wave = __builtin_amdgcn_readfirstlane(tid >> 6);
    float mx[4] = {0.f, 0.f, 0.f, 0.f};
    const GAS f32x4* src = (const GAS f32x4*)(W + (size_t)kr * ld + ns) + c4;
#pragma unroll 1
    for (int r0 = 0; r0 < 32; r0 += 16) {
        f32x4 a[16];
#pragma unroll
        for (int i = 0; i < 16; ++i) a[i] = src[(size_t)(64 * (r0 + i)) * (ld / 4)];
#pragma unroll
        for (int i = 0; i < 16; ++i) { const int k = 64 * (r0 + i) + kr; const int so = ((((k >> 3) ^ c4)) << 4) + (k & 7) * 2;
#pragma unroll
            for (int j = 0; j < 4; ++j) { mx[j] = fmaxf(mx[j], fabsf(a[i][j])); *(LAS unsigned short*)(L + (4 * c4 + j) * 4096 + so) = (unsigned short)f2bf(a[i][j]); } }
    }
#pragma unroll
    for (int j = 0; j < 4; ++j) { mx[j] = fmaxf(mx[j], __shfl_xor(mx[j], 8)); mx[j] = fmaxf(mx[j], __shfl_xor(mx[j], 16)); mx[j] = fmaxf(mx[j], __shfl_xor(mx[j], 32)); }
    if (lane < 8) {
#pragma unroll
        for (int j = 0; j < 4; ++j) red[wave * 32 + 4 * c4 + j] = mx[j]; }
    LDS_BAR();
#pragma unroll 1
    for (int nn = 0; nn < 4; ++nn) {
        const int n = 4 * wave + nn; float am = 0.f;
#pragma unroll
        for (int w8 = 0; w8 < 8; ++w8) am = fmaxf(am, red[w8 * 32 + n]);
        am = fmaxf(am, 1e-30f); const float iq = (F8 ? 384.0f : 127.0f) / am;
        if (lane == 0) sc[n] = am * (F8 ? 1.0f / 384.0f : 1.0f / 127.0f);
#pragma unroll
        for (int h = 0; h < 2; ++h) { const int run = h * 64 + lane;
            const v4u w0 = *(LAS const v4u*)(L + n * 4096 + (((2 * run) ^ (wave & 7)) << 4)), w1 = *(LAS const v4u*)(L + n * 4096 + (((2 * run + 1) ^ (wave & 7)) << 4));
            v4u o;
            if constexpr (F8) {
                o.x = fp8x4(bflo(w0.x) * iq, bfhi(w0.x) * iq, bflo(w0.y) * iq, bfhi(w0.y) * iq); o.y = fp8x4(bflo(w0.z) * iq, bfhi(w0.z) * iq, bflo(w0.w) * iq, bfhi(w0.w) * iq);
                o.z = fp8x4(bflo(w1.x) * iq, bfhi(w1.x) * iq, bflo(w1.y) * iq, bfhi(w1.y) * iq); o.w = fp8x4(bflo(w1.z) * iq, bfhi(w1.z) * iq, bflo(w1.w) * iq, bfhi(w1.w) * iq);
            } else {
            o.x = (unsigned)(q8(bflo(w0.x) * iq) | (q8(bfhi(w0.x) * iq) << 8) | (q8(bflo(w0.y) * iq) << 16) | (q8(bfhi(w0.y) * iq) << 24));
            o.y = (unsigned)(q8(bflo(w0.z) * iq) | (q8(bfhi(w0.z) * iq) << 8) | (q8(bflo(w0.w) * iq) << 16) | (q8(bfhi(w0.w) * iq) << 24));
            o.z = (unsigned)(q8(bflo(w1.x) * iq) | (q8(bfhi(w1.x) * iq) << 8) | (q8(bflo(w1.y) * iq) << 16) | (q8(bfhi(w1.y) * iq) << 24));
            o.w = (unsigned)(q8(bflo(w1.z) * iq) | (q8(bfhi(w1.z) * iq) << 8) | (q8(bflo(w1.w) * iq) << 16) | (q8(bfhi(w1.w) * iq) << 24)); }
            *(GAS v4u*)(dst + (size_t)n * DM + 16 * run) = o; }
    }
    LDS_BAR();
}
__device__ __forceinline__ void ln_load_bf16(v4u (&w4)[4], const bf16* xrow, int lane) {
    const GAS v4u* xr = (const GAS v4u*)xrow + lane;
#pragma unroll
    for (int j = 0; j < 4; ++j) w4[j] = xr[64 * j];
}
__device__ __forceinline__ void ln_row_bf16_to_bf16(const v4u (&w4)[4], LAS const unsigned char* Lgb, bf16* orow, signed char* qrow, float* qscale, int lane) {
    float v[32]; float s = 0.f;
#pragma unroll
    for (int j = 0; j < 4; ++j) { const v4u w = w4[j];
        v[8 * j + 0] = bflo(w.x); v[8 * j + 1] = bfhi(w.x); v[8 * j + 2] = bflo(w.y); v[8 * j + 3] = bfhi(w.y);
        v[8 * j + 4] = bflo(w.z); v[8 * j + 5] = bfhi(w.z); v[8 * j + 6] = bflo(w.w); v[8 * j + 7] = bfhi(w.w); }
#pragma unroll
    for (int i = 0; i < 32; ++i) s += v[i];
    const float mean = wave_sum(s) * (1.f / DM); float s2 = 0.f;
#pragma unroll
    for (int i = 0; i < 32; ++i) { v[i] -= mean; s2 += v[i] * v[i]; }
    const float rstd = 1.f / sqrtf(wave_sum(s2) * (1.f / DM) + LN_EPS);
    GAS v4u* o16 = (GAS v4u*)orow + lane;
#pragma unroll
    for (int j = 0; j < 4; ++j) {
        const LAS f32x4* gp = (const LAS f32x4*)Lgb + 2 * (lane + 64 * j); const LAS f32x4* bp = (const LAS f32x4*)(Lgb + 8192) + 2 * (lane + 64 * j);
        const f32x4 g0 = gp[0], g1 = gp[1], b0 = bp[0], b1 = bp[1];
        v4u o; o.x = pk2(v[8 * j + 0] * rstd * g0.x + b0.x, v[8 * j + 1] * rstd * g0.y + b0.y); o.y = pk2(v[8 * j + 2] * rstd * g0.z + b0.z, v[8 * j + 3] * rstd * g0.w + b0.w);
        o.z = pk2(v[8 * j + 4] * rstd * g1.x + b1.x, v[8 * j + 5] * rstd * g1.y + b1.y); o.w = pk2(v[8 * j + 6] * rstd * g1.z + b1.z, v[8 * j + 7] * rstd * g1.w + b1.w);
        if (orow) o16[64 * j] = o;
        v[8 * j + 0] = v[8 * j + 0] * rstd * g0.x + b0.x; v[8 * j + 1] = v[8 * j + 1] * rstd * g0.y + b0.y; v[8 * j + 2] = v[8 * j + 2] * rstd * g0.z + b0.z; v[8 * j + 3] = v[8 * j + 3] * rstd * g0.w + b0.w;
        v[8 * j + 4] = v[8 * j + 4] * rstd * g1.x + b1.x; v[8 * j + 5] = v[8 * j + 5] * rstd * g1.y + b1.y; v[8 * j + 6] = v[8 * j + 6] * rstd * g1.z + b1.z; v[8 * j + 7] = v[8 * j + 7] * rstd * g1.w + b1.w; }
    float am = 0.f;
#pragma unroll
    for (int i = 0; i < 32; ++i) am = fmaxf(am, fabsf(v[i]));
    am = wave_max(am);
    am = fmaxf(am, 1e-20f); const float iq = 127.0f / am;
    if (lane == 0) *qscale = am * (1.0f / 127.0f);
#pragma unroll
    for (int j = 0; j < 4; ++j) { v2u w; w.x = (unsigned)(q8(v[8 * j + 0] * iq) | (q8(v[8 * j + 1] * iq) << 8) | (q8(v[8 * j + 2] * iq) << 16) | (q8(v[8 * j + 3] * iq) << 24));
        w.y = (unsigned)(q8(v[8 * j + 4] * iq) | (q8(v[8 * j + 5] * iq) << 8) | (q8(v[8 * j + 6] * iq) << 16) | (q8(v[8 * j + 7] * iq) << 24)); ((GAS v2u*)qrow)[lane + 64 * j] = w; }
}
__device__ __forceinline__ void row_pos(int r, int& pos, int& ipos) {
    if (r < NTOK) { const int s = r & (SEQ - 1); pos = NMETA + s; ipos = s & 127; }
    else { int j = r - NTOK; if (j > NMETA - 1) j = NMETA - 1; pos = j; ipos = 112 + j; }
}
__device__ __forceinline__ float log2_gamma(int h) { return log2f(1.0f - exp2f(-5.0f - (float)h)); }


typedef short bf16x8 __attribute__((ext_vector_type(8)));
typedef short s16x4 __attribute__((ext_vector_type(4)));
#define MFMA16(a, b, c) __builtin_amdgcn_mfma_f32_16x16x32_bf16((a), (b), (c), 0, 0, 0)
__device__ __forceinline__ s16x4 tr16(LAS const unsigned char* p) { return __builtin_bit_cast(s16x4, __builtin_amdgcn_ds_read_tr16_b64_v4i16((LAS s16x4*)p)); }
__device__ __forceinline__ bf16x8 cat8(s16x4 a, s16x4 b) { return __builtin_shufflevector(a, b, 0, 1, 2, 3, 4, 5, 6, 7); }
__device__ __forceinline__ unsigned cvtpk_s(float lo, float hi) { f32x2 v = {lo, hi}; bf16x2_t b = __builtin_convertvector(v, bf16x2_t); return __builtin_bit_cast(unsigned, b); }
__device__ __forceinline__ unsigned cvtpk(float lo, float hi) { unsigned r; asm("v_cvt_pk_bf16_f32 %0, %1, %2" : "=v"(r) : "v"(lo), "v"(hi)); return r; }

__device__ __forceinline__ void scan_unit(LAS unsigned char* L, int u, const bf16* RK, const bf16* RV, bf16* ST, int tid, int lane, int wave) {
    asm volatile("" : "+v"(tid)); lane = tid & 63;
    const int bh = u >> 4, di = (u >> 2) & 3, ei = u & 3, b = bh >> 2, h = bh & 3;
    const float g128 = exp2f(128.0f * log2_gamma(h));
    const int li = lane & 15, g = lane >> 4, q = li >> 2, p4 = li & 3;
    const int eb = wave >> 1, db0 = 2 * (wave & 1);
    f32x4 acc[2]; acc[0] = (f32x4){0.f, 0.f, 0.f, 0.f}; acc[1] = acc[0];
    const int sw = 2 * (((q >> 1) & 1) | ((g & 1) << 1));
    v4u kA[2], vA[2], kB[2], vB[2];
#define SCAN_LOAD(cc, kreg, vreg) do { _Pragma("unroll") for (int i_ = 0; i_ < 2; ++i_) { const int cid_ = tid + 512 * i_, row_ = cid_ >> 3, c16_ = cid_ & 7; \
        int srow_; bool ok_ = true; if ((cc) < 0) { ok_ = row_ >= 112; srow_ = NTOK + (ok_ ? row_ - 112 : 0); } else srow_ = b * SEQ + (cc) * 128 + row_; \
        const v4u kz_ = *(const GAS v4u*)(RK + (size_t)srow_ * 1024 + h * 256 + di * 64 + c16_ * 8), vz_ = *(const GAS v4u*)(RV + (size_t)srow_ * 1024 + h * 256 + ei * 64 + c16_ * 8); \
        kreg[i_] = ok_ ? kz_ : (v4u){0u, 0u, 0u, 0u}; vreg[i_] = ok_ ? vz_ : (v4u){0u, 0u, 0u, 0u}; } } while (0)
#define SCAN_WRITE(bufp, kreg, vreg) do { _Pragma("unroll") for (int i_ = 0; i_ < 2; ++i_) { const int cid_ = tid + 512 * i_, row_ = cid_ >> 3, c16_ = cid_ & 7; \
        const int sw_ = ((row_ >> 1) & 1) | ((row_ >> 2) & 2); const int off_ = row_ * 128 + ((c16_ ^ (2 * sw_)) << 4); \
        *(LAS v4u*)((bufp) + off_) = kreg[i_]; *(LAS v4u*)((bufp) + 16384 + off_) = vreg[i_]; } } while (0)
#define SCAN_FLUSH(c) do { if ((c) >= 0) { const v4u z_ = *(LAS const v4u*)(L + 65536 + ((c) & 1) * 8192 + (tid >> 3) * 128 + (tid & 7) * 16); \
        *(GAS v4u*)(ST + ((size_t)(bh * 32 + (c)) * 256 + 64 * ei + (tid >> 3)) * 256 + 64 * di + (tid & 7) * 8) = z_; } } while (0)
    SCAN_LOAD(-1, kA, vA); SCAN_WRITE(L, kA, vA); SCAN_LOAD(0, kA, vA); SCAN_LOAD(1, kB, vB); LDS_BAR();
    int cur = 0;
    for (int cc = -1; cc <= 29; cc += 2) {
        { LAS const unsigned char* Kt = L + cur * 32768; LAS const unsigned char* Vt = Kt + 16384;
#pragma unroll
          for (int ks = 0; ks < 4; ++ks) { const int r0 = (32 * ks + 8 * g + q) * 128 + 8 * (p4 & 1);
              const bf16x8 a = cat8(tr16(Vt + r0 + (((2 * eb + (p4 >> 1)) ^ sw) << 4)), tr16(Vt + r0 + 512 + (((2 * eb + (p4 >> 1)) ^ sw) << 4)));
#pragma unroll
              for (int n = 0; n < 2; ++n) { const int cn = ((2 * (db0 + n) + (p4 >> 1)) ^ sw) << 4; const bf16x8 bb = cat8(tr16(Kt + r0 + cn), tr16(Kt + r0 + 512 + cn)); acc[n] = MFMA16(a, bb, acc[n]); } }
          SCAN_FLUSH(cc);
#pragma unroll
          for (int n = 0; n < 2; ++n) { acc[n] = acc[n] * g128;
              LAS bf16* op = (LAS bf16*)(L + 65536 + ((cc + 1) & 1) * 8192) + (16 * eb + 4 * g) * 64 + 16 * (db0 + n) + li;
#pragma unroll
              for (int r = 0; r < 4; ++r) op[r * 64] = (bf16)f2bf(acc[n][r]); }
          SCAN_WRITE(L + (cur ^ 1) * 32768, kA, vA);
          if (cc + 3 <= 30) SCAN_LOAD(cc + 3, kA, vA);
          LDS_BAR(); cur ^= 1; }
        { LAS const unsigned char* Kt = L + cur * 32768; LAS const unsigned char* Vt = Kt + 16384;
#pragma unroll
          for (int ks = 0; ks < 4; ++ks) { const int r0 = (32 * ks + 8 * g + q) * 128 + 8 * (p4 & 1);
              const bf16x8 a = cat8(tr16(Vt + r0 + (((2 * eb + (p4 >> 1)) ^ sw) << 4)), tr16(Vt + r0 + 512 + (((2 * eb + (p4 >> 1)) ^ sw) << 4)));
#pragma unroll
              for (int n = 0; n < 2; ++n) { const int cn = ((2 * (db0 + n) + (p4 >> 1)) ^ sw) << 4; const bf16x8 bb = cat8(tr16(Kt + r0 + cn), tr16(Kt + r0 + 512 + cn)); acc[n] = MFMA16(a, bb, acc[n]); } }
          SCAN_FLUSH(cc + 1);
#pragma unroll
          for (int n = 0; n < 2; ++n) { acc[n] = acc[n] * g128;
              LAS bf16* op = (LAS bf16*)(L + 65536 + ((cc + 2) & 1) * 8192) + (16 * eb + 4 * g) * 64 + 16 * (db0 + n) + li;
#pragma unroll
              for (int r = 0; r < 4; ++r) op[r * 64] = (bf16)f2bf(acc[n][r]); }
          if (cc + 2 <= 30) SCAN_WRITE(L + (cur ^ 1) * 32768, kB, vB);
          if (cc + 4 <= 30) SCAN_LOAD(cc + 4, kB, vB);
          LDS_BAR(); cur ^= 1; }
    }
    SCAN_FLUSH(31);
    LDS_BAR();
#undef SCAN_LOAD
#undef SCAN_WRITE
#undef SCAN_FLUSH
}

__device__ __forceinline__ void retout_unit(LAS unsigned char* L, int u, const bf16* QR, unsigned char* MIX8, const bf16* RK, const bf16* RV, const bf16* RG, const bf16* ST, int tid, int lane, int wave) {
    asm volatile("" : "+v"(tid)); lane = tid & 63;
    const int bh = u >> 5, c = u & 31, b = bh >> 2, h = bh & 3;
    const int R0 = b * SEQ + c * 128;
    const int li = lane & 15, g = lane >> 4, q = li >> 2, p4 = li & 3;
    LAS unsigned char* RA = L; LAS unsigned char* RB = L + 65536;
#pragma unroll
    for (int i = 0; i < 8; ++i) { const int cid = tid + 512 * i, j = cid >> 5, ch = cid & 31;
        const v4u kz = *(const GAS v4u*)(RK + (size_t)(R0 + j) * 1024 + h * 256 + ch * 8), vz = *(const GAS v4u*)(RV + (size_t)(R0 + j) * 1024 + h * 256 + ch * 8);
        *(LAS v4u*)(RA + j * 512 + ((ch ^ (j & 15)) << 4)) = kz; *(LAS v4u*)(RB + j * 512 + ((ch ^ ((j & 7) << 1)) << 4)) = vz; }
    bf16x8 qf[8];
    { const GAS v4u* qp = (const GAS v4u*)(QR + (size_t)(R0 + 16 * wave + li) * 2048 + 1024 + h * 256 + 8 * g);
#pragma unroll
      for (int ks = 0; ks < 8; ++ks) qf[ks] = __builtin_bit_cast(bf16x8, qp[4 * ks]); }
#define RO_LOAD_ST(s0) do { _Pragma("unroll") for (int i_ = 0; i_ < 8; ++i_) { const int cid_ = tid + 512 * i_, sl_ = cid_ >> 11, e_ = (cid_ >> 3) & 255, ch_ = cid_ & 7; \
        stg[i_] = *(const GAS v4u*)(Sg + (size_t)e_ * 256 + 64 * ((s0) + sl_) + ch_ * 8); } } while (0)
#define RO_WRITE_ST(dst) do { _Pragma("unroll") for (int i_ = 0; i_ < 8; ++i_) { const int cid_ = tid + 512 * i_, sl_ = cid_ >> 11, e_ = (cid_ >> 3) & 255, ch_ = cid_ & 7; \
        *(LAS v4u*)((dst) + sl_ * 32768 + e_ * 128 + ((ch_ ^ (e_ & 7)) << 4)) = stg[i_]; } } while (0)
    const bf16* Sg = ST + (size_t)(bh * 32 + c) * 65536; v4u stg[8];
    __syncthreads();
    RO_LOAD_ST(0);
    f32x4 st[8];
#pragma unroll
    for (int jt = 0; jt < 8; ++jt) st[jt] = (f32x4){0.f, 0.f, 0.f, 0.f};
#pragma unroll
    for (int jt = 0; jt < 8; ++jt) if (jt <= wave) {
        const int j = 16 * jt + li;
#pragma unroll
        for (int ks = 0; ks < 8; ++ks) { const bf16x8 a = *(LAS const bf16x8*)(RA + j * 512 + (((4 * ks + g) ^ li) << 4)); st[jt] = MFMA16(a, qf[ks], st[jt]); }
        if (jt == wave) {
#pragma unroll
            for (int r = 0; r < 4; ++r) if (4 * g + r > li) st[jt][r] = 0.f; }
    }
    bf16x8 pf[4];
#pragma unroll
    for (int s = 0; s < 4; ++s) { v4u w; w.x = cvtpk_s(st[2 * s][0], st[2 * s][1]); w.y = cvtpk_s(st[2 * s][2], st[2 * s][3]); w.z = cvtpk_s(st[2 * s + 1][0], st[2 * s + 1][1]); w.w = cvtpk_s(st[2 * s + 1][2], st[2 * s + 1][3]); pf[s] = __builtin_bit_cast(bf16x8, w); }
    __syncthreads();
    RO_WRITE_ST(RA); RO_LOAD_ST(2);
    f32x4 o[16];
#pragma unroll
    for (int et = 0; et < 16; ++et) o[et] = (f32x4){0.f, 0.f, 0.f, 0.f};
#pragma unroll
    for (int s = 0; s < 4; ++s) if (2 * s <= wave) {
        const int r1 = 32 * s + 4 * g + q, r2 = r1 + 16;
#pragma unroll
        for (int et = 0; et < 16; ++et) {
            const int chn = 2 * et + (p4 >> 1);
            const bf16x8 a = cat8(tr16(RB + r1 * 512 + ((chn ^ ((r1 & 7) << 1)) << 4) + (p4 & 1) * 8), tr16(RB + r2 * 512 + ((chn ^ ((r2 & 7) << 1)) << 4) + (p4 & 1) * 8));
            o[et] = MFMA16(a, pf[s], o[et]);
        }
    }
    __syncthreads();
    RO_WRITE_ST(RB);
#define RO_STATE_MMA(src, s0) do { _Pragma("unroll") for (int sl_ = 0; sl_ < 2; ++sl_) _Pragma("unroll") for (int k2_ = 0; k2_ < 2; ++k2_) _Pragma("unroll") for (int et = 0; et < 16; ++et) { \
        const int e_ = 16 * et + li; const bf16x8 a_ = *(LAS const bf16x8*)((src) + sl_ * 32768 + e_ * 128 + (((4 * k2_ + g) ^ (e_ & 7)) << 4)); \
        o[et] = MFMA16(a_, qf[2 * ((s0) + sl_) + k2_], o[et]); } } while (0)
    RO_STATE_MMA(RA, 0);
    __syncthreads();
    RO_STATE_MMA(RB, 2);
#undef RO_LOAD_ST
#undef RO_WRITE_ST
#undef RO_STATE_MMA
    float s1 = 0.f;
#pragma unroll
    for (int et = 0; et < 16; ++et) s1 += (o[et][0] + o[et][1]) + (o[et][2] + o[et][3]);
    s1 += __shfl_xor(s1, 16); s1 += __shfl_xor(s1, 32);
    const float mu = s1 * (1.0f / 256.0f); float s2 = 0.f;
#pragma unroll
    for (int et = 0; et < 16; ++et) { o[et] = o[et] - mu; s2 += (o[et][0] * o[et][0] + o[et][1] * o[et][1]) + (o[et][2] * o[et][2] + o[et][3] * o[et][3]); }
    s2 += __shfl_xor(s2, 16); s2 += __shfl_xor(s2, 32);
    const float rstd = 1.0f / sqrtf(s2 * (1.0f / 256.0f) + GN_EPS);
    const int row = R0 + 16 * wave + li;
    const GAS v2u* gp = (const GAS v2u*)(RG + (size_t)row * 1024 + h * 256 + 4 * g); GAS unsigned* op = (GAS unsigned*)(MIX8 + (size_t)row * 2048 + 1024 + h * 256 + 4 * g);
    const float rstd8 = rstd * MIX_F8_SCALE;
#pragma unroll
    for (int et = 0; et < 16; ++et) { const v2u gz = gp[4 * et];
        op[4 * et] = fp8x4(o[et][0] * rstd8 * bflo(gz.x), o[et][1] * rstd8 * bfhi(gz.x), o[et][2] * rstd8 * bflo(gz.y), o[et][3] * rstd8 * bfhi(gz.y)); }
    __syncthreads();
}

typedef float f32x16 __attribute__((ext_vector_type(16)));
#define MFMA32(a, b, c) __builtin_amdgcn_mfma_f32_32x32x16_bf16((a), (b), (c), 0, 0, 0)
__device__ __forceinline__ int crow32(int reg, int hh) { return (reg & 3) + 8 * (reg >> 2) + 4 * hh; }

__device__ __forceinline__ void attn_unit(LAS unsigned char* L, int u, const bf16* QR, unsigned char* MIX8, const bf16* KA, const bf16* VA, const float* sinks, int tid, int lane, int wave) {
    asm volatile("" : "+v"(tid)); lane = tid & 63;
    const int b = u >> 6, j = (u >> 1) & 31, g2 = u & 1, hq = 8 * g2 + wave;
    const int R0 = b * SEQ + 128 * j;
    LAS unsigned char* Kt = L; LAS unsigned char* Vt = L + 32768;
#pragma unroll
    for (int i = 0; i < 4; ++i) { const int cid = tid + 512 * i, kk = cid >> 3, ch = cid & 7;
        int srow; bool ok = true;
        if (kk >= 128) srow = R0 + kk - 128; else if (j > 0) srow = R0 - 128 + kk; else { ok = kk >= 112; srow = NTOK + (ok ? kk - 112 : 0); }
        const v4u kz = *(const GAS v4u*)(KA + (size_t)srow * 128 + g2 * 64 + ch * 8), vz = *(const GAS v4u*)(VA + (size_t)srow * 128 + g2 * 64 + ch * 8);
        *(LAS v4u*)(Kt + kk * 128 + ((ch ^ (kk & 7)) << 4)) = ok ? kz : (v4u){0u, 0u, 0u, 0u};
        *(LAS v4u*)(Vt + kk * 128 + (ch << 4)) = ok ? vz : (v4u){0u, 0u, 0u, 0u}; }
    __syncthreads();
    const int r = lane & 31, hh = lane >> 5, blk = (lane >> 4) & 1, q = (lane & 15) >> 2, p4 = lane & 3;
    const float sk = sinks[hq] * LOG2E;
    v4u qn[4];
    { const GAS v4u* qp = (const GAS v4u*)(QR + (size_t)(R0 + r) * 2048 + hq * 64 + 8 * hh);
#pragma unroll
      for (int ks = 0; ks < 4; ++ks) qn[ks] = qp[2 * ks]; }
#pragma unroll 1
    for (int t = 0; t < 4; ++t) {
        const int i0 = 32 * t;
        bf16x8 qf[4];
#pragma unroll
        for (int ks = 0; ks < 4; ++ks) qf[ks] = __builtin_bit_cast(bf16x8, qn[ks]);
        if (t < 3) { const GAS v4u* qp = (const GAS v4u*)(QR + (size_t)(R0 + i0 + 32 + r) * 2048 + hq * 64 + 8 * hh);
#pragma unroll
          for (int ks = 0; ks < 4; ++ks) qn[ks] = qp[2 * ks]; }
        f32x16 s[5];
#pragma unroll
        for (int x = 0; x < 5; ++x) {
            const int krow_ = 32 * (t + x) + r;
            f32x16 acc;
#pragma unroll
            for (int e = 0; e < 16; ++e) acc[e] = 0.f;
#pragma unroll
            for (int ks = 0; ks < 4; ++ks) { const bf16x8 a = *(LAS const bf16x8*)(Kt + krow_ * 128 + (((2 * ks + hh) ^ (krow_ & 7)) << 4)); acc = MFMA32(a, qf[ks], acc); }
            s[x] = acc; __builtin_amdgcn_sched_barrier(0);
        }
        float m = sk;
#pragma unroll
        for (int e = 0; e < 16; ++e) { const int cr = crow32(e, hh);
            if (!(cr > r)) s[0][e] = -1.0e30f;
            if (!(cr <= r)) s[4][e] = -1.0e30f; }
        if (j == 0) {
#pragma unroll
            for (int x = 0; x < 4; ++x) if (t + x <= 3) {
#pragma unroll
                for (int e = 0; e < 16; ++e) if (32 * (t + x) + crow32(e, hh) < 112) s[x][e] = -1.0e30f; }
        }
#pragma unroll
        for (int x = 0; x < 5; ++x)
#pragma unroll
            for (int e = 0; e < 16; ++e) m = fmaxf(m, s[x][e]);
        m = fmaxf(m, __shfl_xor(m, 32));
        float l = 0.f;
#pragma unroll
        for (int x = 0; x < 5; ++x)
#pragma unroll
            for (int e = 0; e < 16; ++e) { const float pv = exp2f(s[x][e] - m); s[x][e] = pv; l += pv; }
        l += __shfl_xor(l, 32);
        l += exp2f(sk - m);
        f32x16 o[2];
#pragma unroll
        for (int e = 0; e < 16; ++e) { o[0][e] = 0.f; o[1][e] = 0.f; }
#pragma unroll
        for (int x = 0; x < 5; ++x)
#pragma unroll
            for (int st = 0; st < 2; ++st) {
                v4u w; w.x = cvtpk_s(s[x][8 * st + 0], s[x][8 * st + 1]); w.y = cvtpk_s(s[x][8 * st + 2], s[x][8 * st + 3]); w.z = cvtpk_s(s[x][8 * st + 4], s[x][8 * st + 5]); w.w = cvtpk_s(s[x][8 * st + 6], s[x][8 * st + 7]);
                const bf16x8 pb = __builtin_bit_cast(bf16x8, w);
                const int k1 = 32 * (t + x) + 16 * st + 4 * hh + q, k2 = k1 + 8;
#pragma unroll
                for (int dc = 0; dc < 2; ++dc) {
                    const int cb = ((4 * dc + 2 * blk + (p4 >> 1)) << 4) + 8 * (p4 & 1);
                    const bf16x8 a = cat8(tr16(Vt + k1 * 128 + cb), tr16(Vt + k2 * 128 + cb));
                    o[dc] = MFMA32(a, pb, o[dc]);
                }
                __builtin_amdgcn_sched_barrier(0);
            }
        const float il = 1.0f / l;
        const float il8 = il * MIX_F8_SCALE;
        GAS unsigned* op = (GAS unsigned*)(MIX8 + (size_t)(R0 + i0 + r) * 2048 + hq * 64 + 4 * hh);
#pragma unroll
        for (int dc = 0; dc < 2; ++dc)
#pragma unroll
            for (int g4 = 0; g4 < 4; ++g4) op[8 * dc + 2 * g4] = fp8x4(o[dc][4 * g4 + 0] * il8, o[dc][4 * g4 + 1] * il8, o[dc][4 * g4 + 2] * il8, o[dc][4 * g4 + 3] * il8);
    }
    __syncthreads();
}

__device__ __forceinline__ unsigned ord_key(float f) { const unsigned u = __float_as_uint(f); return u ^ ((unsigned)((int)u >> 31) | 0x80000000u); }
__device__ __forceinline__ float ord_val(unsigned k) { return __uint_as_float(k ^ (((int)k < 0) ? 0x80000000u : 0xffffffffu)); }
__device__ __forceinline__ unsigned umed3(unsigned a, unsigned b, unsigned c) { unsigned r; asm("v_med3_u32 %0, %1, %2, %3" : "=v"(r) : "v"(a), "v"(b), "v"(c)); return r; }
#define TK_INS(arr, val) do { const unsigned v_ = (val); _Pragma("unroll") for (int j_ = 15; j_ >= 1; --j_) arr[j_] = umed3(arr[j_ - 1], arr[j_], v_); arr[0] = arr[0] > v_ ? arr[0] : v_; } while (0)
__device__ __forceinline__ void topk_unit(LAS unsigned* Lw, LAS const unsigned char* Lsk, int tt, int hd, const bf16* Q3, unsigned short* IDS, float* GATES, int lane) {
    asm volatile("" : "+v"(lane));
    const int r = lane & 31, hh = lane >> 5, t0 = tt * 32;
    float sv[2][16];
#pragma unroll
    for (int p = 0; p < 2; ++p) {
        f32x16 acc[4];
#pragma unroll
        for (int nt = 0; nt < 4; ++nt)
#pragma unroll
            for (int e = 0; e < 16; ++e) acc[nt][e] = 0.f;
        const GAS v4u* qp = (const GAS v4u*)(Q3 + (size_t)(t0 + r) * DM + hd * 256 + p * 128 + 8 * hh);
        bf16x8 bq[8];
#pragma unroll
        for (int ks = 0; ks < 8; ++ks) bq[ks] = __builtin_bit_cast(bf16x8, qp[2 * ks]);
#pragma unroll
        for (int ks = 0; ks < 8; ++ks) {
#pragma unroll
            for (int nt = 0; nt < 4; ++nt) { const bf16x8 a = *(LAS const bf16x8*)(Lsk + p * 32768 + (32 * nt + r) * 256 + (((2 * ks + hh) ^ (r & 15)) << 4)); acc[nt] = MFMA32(a, bq[ks], acc[nt]); } }
        unsigned tk[16];
#pragma unroll
        for (int j2 = 0; j2 < 16; ++j2) tk[j2] = 0u;
#pragma unroll
        for (int nt = 0; nt < 4; ++nt)
#pragma unroll
            for (int e = 0; e < 16; ++e) { const int n = 32 * nt + crow32(e, hh); TK_INS(tk, (ord_key(acc[nt][e]) & 0xffffff80u) | (unsigned)(127 - n)); }
        unsigned pk[16];
#pragma unroll
        for (int j2 = 0; j2 < 16; ++j2) pk[j2] = (unsigned)__shfl_xor((int)tk[j2], 32);
#pragma unroll
        for (int j2 = 0; j2 < 16; ++j2) TK_INS(tk, pk[j2]);
#pragma unroll
        for (int j2 = 0; j2 < 16; ++j2) { sv[p][j2] = ord_val(tk[j2] & 0xffffff80u); Lw[(p * 16 + j2) * 64 + lane] = 127u - (tk[j2] & 0x7fu); }
    }
    unsigned fk[16];
#pragma unroll
    for (int j2 = 0; j2 < 16; ++j2) fk[j2] = 0u;
#pragma unroll
    for (int i = 0; i < 16; ++i)
#pragma unroll
        for (int j2 = 0; j2 < 16; ++j2) if ((i + 1) * (j2 + 1) <= 16) TK_INS(fk, (ord_key(sv[0][i] + sv[1][j2]) & 0xffffff00u) | (unsigned)(255 - (16 * i + j2)));
    float ev[16]; int idv[16]; float den = 0.f; const float f0 = ord_val(fk[0] & 0xffffff00u);
    LDS_WAIT();
#pragma unroll
    for (int k = 0; k < 16; ++k) { const unsigned idx = 255u - (fk[k] & 0xffu); const unsigned i1 = Lw[(idx >> 4) * 64 + lane], i2 = Lw[(16 + (idx & 15u)) * 64 + lane];
        idv[k] = (int)(i1 * 128u + i2); ev[k] = __expf(ord_val(fk[k] & 0xffffff00u) - f0); den += ev[k]; }
    const float iden = 1.0f / den;
    if (hh == 0) {
        GAS v4u* ip = (GAS v4u*)(IDS + (size_t)(t0 + r) * 128 + hd * 16); GAS f32x4* gp = (GAS f32x4*)(GATES + (size_t)(t0 + r) * 128 + hd * 16);
#pragma unroll
        for (int k8 = 0; k8 < 2; ++k8) ip[k8] = (v4u){(unsigned)idv[8 * k8] | ((unsigned)idv[8 * k8 + 1] << 16), (unsigned)idv[8 * k8 + 2] | ((unsigned)idv[8 * k8 + 3] << 16), (unsigned)idv[8 * k8 + 4] | ((unsigned)idv[8 * k8 + 5] << 16), (unsigned)idv[8 * k8 + 6] | ((unsigned)idv[8 * k8 + 7] << 16)};
#pragma unroll
        for (int k4 = 0; k4 < 4; ++k4) gp[k4] = (f32x4){ev[4 * k4] * iden, ev[4 * k4 + 1] * iden, ev[4 * k4 + 2] * iden, ev[4 * k4 + 3] * iden};
    }
    LDS_WAIT();
}

template <bool F8, bool PERMW1> __device__ __forceinline__ void w_tile(LAS unsigned char* T, const float* W, int ld, int k0, int n0, signed char* dst, float qs, int tid) {
    asm volatile("" : "+v"(tid));
    const int kq = tid >> 5, c4 = tid & 31;
    const int ncol = PERMW1 ? w1_logical_col(n0 + ((4 * c4) & ~31)) + ((4 * c4) & 31) : n0 + 4 * c4;
    const GAS f32x4* src = (const GAS f32x4*)(W + (size_t)(k0 + 8 * kq) * ld + ncol);
    f32x4 a[8];
#pragma unroll
    for (int i = 0; i < 8; ++i) a[i] = src[(size_t)i * (ld / 4)];
#pragma unroll
    for (int j = 0; j < 4; ++j) { v2u w;
        if constexpr (F8) { w.x = fp8x4(a[0][j] * qs, a[1][j] * qs, a[2][j] * qs, a[3][j] * qs); w.y = fp8x4(a[4][j] * qs, a[5][j] * qs, a[6][j] * qs, a[7][j] * qs); }
        else { w.x = (unsigned)(q8(a[0][j] * qs) | (q8(a[1][j] * qs) << 8) | (q8(a[2][j] * qs) << 16) | (q8(a[3][j] * qs) << 24)); w.y = (unsigned)(q8(a[4][j] * qs) | (q8(a[5][j] * qs) << 8) | (q8(a[6][j] * qs) << 16) | (q8(a[7][j] * qs) << 24)); }
        *(LAS v2u*)(T + (4 * c4 + j) * 128 + ((kq ^ (c4 & 15)) << 3)) = w; }
    LDS_BAR();
    { const int n = tid >> 2, q = tid & 3, sw = (n >> 2) & 15; v2u p[4];
#pragma unroll
      for (int r = 0; r < 4; ++r) p[r] = *(LAS const v2u*)(T + n * 128 + (((4 * q + r) ^ sw) << 3));
      GAS v4u* o = (GAS v4u*)(dst + (size_t)(n0 + n) * DM + k0 + 32 * q);
      o[0] = (v4u){p[0].x, p[0].y, p[1].x, p[1].y}; o[1] = (v4u){p[2].x, p[2].y, p[3].x, p[3].y}; }
    LDS_BAR();
}
constexpr int TAB_NQ = 16384 * DM / 4, TAB_CHQ = 4096, TAB_NCH = 2 * TAB_NQ / TAB_CHQ, TAB_SLOT_CHUNKS = 3;
template <int UNR> __device__ __forceinline__ void tab_chunk(int ch, const float* u_tab, const float* v_tab, void* UT, void* VT, int lane) {
    const int which = ch >= TAB_NCH / 2; const float sc = which ? V_QSCALE : U_QSCALE;
    const GAS f32x4* src = (const GAS f32x4*)(which ? v_tab : u_tab) + (size_t)(ch - which * (TAB_NCH / 2)) * TAB_CHQ + lane;
    GAS unsigned char* dstb = (GAS unsigned char*)(which ? VT : UT);
    const int i4b = (ch - which * (TAB_NCH / 2)) * TAB_CHQ + lane;
#pragma unroll 1
    for (int it = 0; it < TAB_CHQ / 64; it += UNR) {
        f32x4 a[UNR];
#pragma unroll
        for (int u8 = 0; u8 < UNR; ++u8) a[u8] = src[(it + u8) * 64];
#pragma unroll
        for (int u8 = 0; u8 < UNR; ++u8) { const int i4 = i4b + (it + u8) * 64; const int row = i4 >> 9, q4 = i4 & 511;
            const int w = q8(a[u8].x * sc) | (q8(a[u8].y * sc) << 8) | (q8(a[u8].z * sc) << 16) | (q8(a[u8].w * sc) << 24);
            *(GAS unsigned*)(dstb + ((size_t)(q4 >> 5) * 16384 + row) * 128 + (q4 & 31) * 4) = (unsigned)w; }
    }
}
struct TabHook {
    gu32* q; const float* u_tab; const float* v_tab; void* UT; void* VT; int slot;
    __device__ __forceinline__ void operator()(int ui) const {
        if (ui != slot) return;
        int lane = threadIdx.x; asm volatile("" : "+v"(lane)); lane &= 63;
#pragma unroll 1
        for (int n = 0; n < TAB_SLOT_CHUNKS; ++n) {
            int ch = 0; if (lane == 0) ch = (int)__hip_atomic_fetch_add((unsigned*)q, 1u, __ATOMIC_RELAXED, __HIP_MEMORY_SCOPE_AGENT);
            ch = __builtin_amdgcn_readfirstlane(ch); if (ch >= TAB_NCH) return;
            tab_chunk<16>(ch, u_tab, v_tab, UT, VT, lane);
        }
    }
};

__global__ void __launch_bounds__(NWAVES * 64, 2) mk_fwd(Args args) {
    extern __shared__ __attribute__((aligned(16))) unsigned char lds[];
    LAS unsigned char* L = (LAS unsigned char*)lds;
    volatile LAS unsigned* MISC = (volatile LAS unsigned*)(L + MISC_OFF);
    const int tid = threadIdx.x, lane = tid & 63, wave = __builtin_amdgcn_readfirstlane(tid >> 6);
    const int G = gridDim.x, bx = blockIdx.x;
    const int vcu = (G % 8 == 0) ? (bx % 8) * (G / 8) + bx / 8 : bx;
    unsigned char* ws = args.ws;
    gu32* ctl = (gu32*)(ws + WS_CTL);
    const float* x = args.in[0]; const float* meta = args.in[1]; const float* ln_in_g = args.in[2]; const float* ln_in_b = args.in[3];
    const float* w_in = args.in[4]; const float* sinks = args.in[5]; const float* w_out = args.in[6]; const float* ln_mix_g = args.in[7]; const float* ln_mix_b = args.in[8];
    const float* wq = args.in[9]; const float* subkeys = args.in[10]; const float* u_tab = args.in[11]; const float* v_tab = args.in[12];
    const float* ln_ffn_g = args.in[13]; const float* ln_ffn_b = args.in[14];
    float* out = args.out;
    bf16* W1T = (bf16*)(ws + WS_W1T); bf16* W2T = (bf16*)(ws + WS_W2T); bf16* W3T = (bf16*)(ws + WS_W3T);
    bf16* H0 = (bf16*)(ws + WS_H0); bf16* QR = (bf16*)(ws + WS_QR); bf16* KA = (bf16*)(ws + WS_KA); bf16* VA = (bf16*)(ws + WS_VA);
    bf16* RK = (bf16*)(ws + WS_RK); bf16* RV = (bf16*)(ws + WS_RV); bf16* RG = (bf16*)(ws + WS_RG);
    bf16* Y = (bf16*)(ws + WS_Y); bf16* H1 = (bf16*)(ws + WS_H1); bf16* Q3 = (bf16*)(ws + WS_QR);
    bf16* STB = (bf16*)(ws + WS_ST);
    unsigned short* IDS = (unsigned short*)(ws + WS_IDS); float* GATES = (float*)(ws + WS_GATES);
    bf16* SKB = (bf16*)(ws + WS_SK);
    signed char* H1Q = (signed char*)(ws + WS_RG); float* HSC = (float*)(ws + WS_HSC);
    bf16* UT = (bf16*)(ws + WS_UT); bf16* VT = (bf16*)(ws + WS_VT);
    signed char* H0Q = (signed char*)(ws + WS_H0Q); signed char* W1Q = (signed char*)(ws + WS_W1Q); signed char* W3Q = (signed char*)(ws + WS_W3Q);
    float* H0S = (float*)(ws + WS_H0S); float* WS1 = (float*)(ws + WS_WS1); float* WS3 = (float*)(ws + WS_WS3);
    unsigned char* MIX8 = (unsigned char*)(ws + WS_H0);
    signed char* W2Q = (signed char*)(ws + WS_W3T); float* WS2 = (float*)(ws + WS_W1T);

    for (int u = tid; u < (LDS_BYTES - LDSCTL_OFF) / 4; u += NWAVES * 64) ((LAS unsigned*)(L + LDSCTL_OFF))[u] = 0u;
    __syncthreads();
    XcdBarrier bar; bar.bar = (unsigned*)(ctl + CW_BAR); bar.x = xb_xcc_id(); bar.st = MISC + 8;
    if (tid == 0) MISC[10] = xb_add(&bar.bar[XB_XCNT(bar.x)], 1u);
#define GRID_BAR() xcd_barrier(bar)
    const int gw = vcu * NWAVES + wave, NGW = G * NWAVES;
    const int gt = gw * 64 + lane, NGT = NGW * 64;

    {
        int lane = threadIdx.x; asm volatile("" : "+v"(lane)); lane &= 63; const int gt = gw * 64 + lane;
        LAS float* scr = (LAS float*)(L + RING_OFF + wave * 16384);
        float qs1, qs3, qs2;
        { LAS float* red = (LAS float*)(L + LDSCTL_OFF + 4096); float ss[3];
          const float* wp[3] = {w_in, wq, w_out};
          int t0l = threadIdx.x; asm volatile("" : "+v"(t0l));
#pragma unroll
          for (int w3 = 0; w3 < 3; ++w3) { const GAS f32x4* p = (const GAS f32x4*)wp[w3] + t0l; float acc = 0.f;
#pragma unroll
              for (int i = 0; i < 8; ++i) { const f32x4 v = p[512 * i]; acc += (v.x * v.x + v.y * v.y) + (v.z * v.z + v.w * v.w); }
              ss[w3] = wave_sum(acc); }
          if (lane == 0) { red[wave * 4 + 0] = ss[0]; red[wave * 4 + 1] = ss[1]; red[wave * 4 + 2] = ss[2]; }
          LDS_BAR();
          float t0 = 0.f, t1 = 0.f, t2 = 0.f;
#pragma unroll
          for (int w8 = 0; w8 < 8; ++w8) { t0 += red[w8 * 4 + 0]; t1 += red[w8 * 4 + 1]; t2 += red[w8 * 4 + 2]; }
          const float r1 = fmaxf(sqrtf(t0 * (1.0f / 16384.0f)), 1e-30f), r3 = fmaxf(sqrtf(t1 * (1.0f / 16384.0f)), 1e-30f), r2 = fmaxf(sqrtf(t2 * (1.0f / 16384.0f)), 1e-30f);
          qs1 = 127.0f / (5.5f * r1); qs3 = 127.0f / (5.5f * r3); qs2 = 384.0f / (6.0f * r2);
          for (int i = gt; i < IN_COLS + 2 * DM; i += NGT) { if (i < IN_COLS) WS1[i] = 1.0f / qs1; else if (i < IN_COLS + DM) WS3[i - IN_COLS] = 1.0f / qs3; else WS2[i - IN_COLS - DM] = 1.0f / qs2; }
          LDS_BAR(); }
        constexpr int NB1 = IN_COLS / 128, NB3 = DM / 128, IT1 = 16 * NB1, IT3 = 16 * NB3;
        for (int it = bx; it < IT1 + 2 * IT3; it += G) {
            if (it < IT1) w_tile<false, true>(L + RING_OFF, w_in, IN_COLS, 128 * (it / NB1), 128 * (it % NB1), W1Q, qs1, tid);
            else if (it < IT1 + IT3) { const int r = it - IT1; w_tile<false, false>(L + RING_OFF, wq, DM, 128 * (r / NB3), 128 * (r % NB3), W3Q, qs3, tid); }
            else { const int r = it - IT1 - IT3; w_tile<true, false>(L + RING_OFF, w_out, DM, 128 * (r / NB3), 128 * (r % NB3), W2Q, qs2, tid); }
        }
        stage_gb(L + RING_OFF, ln_in_g, ln_in_b, tid);
        {
            f32x4 r0[8], r1[8], r2[8];
            auto ld = [&](f32x4 (&v)[8], int mm) { if (mm < NVALID) ln_load_f32(v, mm < NTOK ? x + (size_t)mm * DM : meta + (size_t)(mm - NTOK) * DM, lane); };
            auto pr = [&](f32x4 (&v)[8], int mm) {
                if (mm < NVALID) ln_row_f32_to_bf16_q(v, L + RING_OFF, nullptr, H0Q + (size_t)mm * DM, H0S + mm, lane);
                else { GAS v4u* oq = (GAS v4u*)(H0Q + (size_t)mm * DM) + lane; oq[0] = (v4u){0u, 0u, 0u, 0u}; oq[64] = (v4u){0u, 0u, 0u, 0u}; if (lane == 0) H0S[mm] = 0.f; } };
            int m = gw; ld(r0, m); ld(r1, m + NGW);
            for (;;) {
                if (m >= MROWS) break; ld(r2, m + 2 * NGW); pr(r0, m); m += NGW;
                if (m >= MROWS) break; ld(r0, m + 2 * NGW); pr(r1, m); m += NGW;
                if (m >= MROWS) break; ld(r1, m + 2 * NGW); pr(r2, m); m += NGW;
            }
        }
        for (int e = gt; e < 16 * 128 * 128 / 8; e += NGT) { const GAS f32x4* src = (const GAS f32x4*)subkeys + 2 * (size_t)e; const f32x4 a = src[0], b2 = src[1];
            v4u o; o.x = pk2(a.x, a.y); o.y = pk2(a.z, a.w); o.z = pk2(b2.x, b2.y); o.w = pk2(b2.z, b2.w); ((GAS v4u*)SKB)[e] = o; }
    }
    GRID_BAR();

    {
        pg8::Gemm g{(const bf16*)H0Q, (const bf16*)W1Q, MROWS, IN_COLS, DM / 2, H0S, WS1}; pg8::StaticOrder S; S.init(MROWS, IN_COLS, G, bx, 5);
        pg8::EpiProj E{QR, KA, VA, RK, RV, RG, QSCALE};
        const int nwg1 = (MROWS / 256) * (IN_COLS / 256), T1 = (nwg1 + G - 1) / G, c0 = nwg1 - (T1 - 1) * G;
        TabHook Hk{ctl + CW_TABQ, u_tab, v_tab, (void*)UT, (void*)VT, (bx >= c0 && T1 > 2) ? (bx - c0) % (T1 - 2) : -1};
        pg8::gemm_phase<pg8::EpiProj, pg8::StaticOrder, true, true, TabHook, true>(L + RING_OFF, g, S, E, Hk);
    }
    {
        for (;;) {
            int ch = 0; if (lane == 0) ch = (int)__hip_atomic_fetch_add((unsigned*)(ctl + CW_TABQ), 1u, __ATOMIC_RELAXED, __HIP_MEMORY_SCOPE_AGENT);
            ch = __builtin_amdgcn_readfirstlane(ch); if (ch >= TAB_NCH) break;
            tab_chunk<8>(ch, u_tab, v_tab, (void*)UT, (void*)VT, lane);
        }
    }
    GRID_BAR();

    for (int u = bx; u < 256; u += G) attn_unit(L + RING_OFF, u, QR, MIX8, KA, VA, sinks, tid, lane, wave);

    for (int u = bx; u < 256; u += G) scan_unit(L + RING_OFF, u, RK, RV, STB, tid, lane, wave);
    GRID_BAR();

    for (int u = bx; u < 512; u += G) retout_unit(L + RING_OFF, u, QR, MIX8, RK, RV, RG, STB, tid, lane, wave);
    GRID_BAR();

    {
        pg8::Gemm g{(const bf16*)MIX8, (const bf16*)W2Q, NTOK, DM, DM / 2, nullptr, WS2, 1.0f / MIX_F8_SCALE}; pg8::StaticOrder S; S.init(NTOK, DM, G, bx);
        pg8::EpiGen<1> E{Y, DM, nullptr, ALPHA, H0Q, H0S, nullptr, nullptr, nullptr, nullptr, nullptr, nullptr};
        pg8::gemm_phase<pg8::EpiGen<1>, pg8::StaticOrder, true, true, pg8::NoHook, false, true>(L + RING_OFF, g, S, E);
    }
    GRID_BAR();

    stage_gb(L + RING_OFF, ln_mix_g, ln_mix_b, tid);
    { int l5 = threadIdx.x; asm volatile("" : "+v"(l5)); l5 &= 63;
      v4u b0[4], b1[4], b2[4];
      auto ld = [&](v4u (&w)[4], int mm) { if (mm < NTOK) ln_load_bf16(w, Y + (size_t)mm * DM, l5); };
      auto pr = [&](v4u (&w)[4], int mm) { ln_row_bf16_to_bf16(w, L + RING_OFF, nullptr, H1Q + (size_t)mm * DM, HSC + mm, l5); };
      int m = gw; ld(b0, m); ld(b1, m + NGW);
      for (;;) {
          if (m >= NTOK) break; ld(b2, m + 2 * NGW); pr(b0, m); m += NGW;
          if (m >= NTOK) break; ld(b0, m + 2 * NGW); pr(b1, m); m += NGW;
          if (m >= NTOK) break; ld(b1, m + 2 * NGW); pr(b2, m); m += NGW;
      } }
    GRID_BAR();

    {
        pg8::Gemm g{(const bf16*)H1Q, (const bf16*)W3Q, NTOK, DM, DM / 2, HSC, WS3}; pg8::StaticOrder S; S.init(NTOK, DM, G, bx);
        pg8::EpiGen<2> E{Q3, DM, nullptr, 0.f, nullptr, nullptr, nullptr, nullptr, nullptr, nullptr};
        pg8::gemm_phase<pg8::EpiGen<2>, pg8::StaticOrder, true, true, pg8::NoHook, true>(L + RING_OFF, g, S, E);
    }
    GRID_BAR();

    const bool g8 = (G & 7) == 0; const int nbh = g8 ? (G >> 3) : G, hb = g8 ? (bx >> 3) : bx;
    int t7 = threadIdx.x; asm volatile("" : "+v"(t7));
    for (int hd = g8 ? (bx & 7) : 0; hd < 8; hd += g8 ? 8 : 1) {
        __syncthreads();
#pragma unroll
        for (int i = 0; i < 8; ++i) { const int cid = t7 + 512 * i, p = cid >> 11, n = (cid >> 4) & 127, ch = cid & 15;
            *(LAS v4u*)(L + RING_OFF + p * 32768 + n * 256 + ((ch ^ (n & 15)) << 4)) = *(const GAS v4u*)(SKB + ((size_t)((hd * 2 + p) * 128 + n)) * 128 + ch * 8); }
        __syncthreads();
        int l7 = threadIdx.x; asm volatile("" : "+v"(l7)); l7 &= 63;
        for (int tt = hb * NWAVES + wave; tt < NTOK / 32; tt += nbh * NWAVES) topk_unit((LAS unsigned*)(L + RING_OFF + 65536 + wave * 8192), L + RING_OFF, tt, hd, Q3, IDS, GATES, l7);
    }
    __syncthreads();
    GRID_BAR();

    int nx = 0, xr = 0, nloc = 1;
    { unsigned* bw = (unsigned*)(ctl + CW_BAR);
#pragma unroll
      for (unsigned j2 = 0; j2 < 16; ++j2) { const unsigned cnt = xb_ld(&bw[XB_XCNT(j2)]); nx += cnt > 0u; xr += (j2 < bar.x && cnt > 0u); if (j2 == bar.x) nloc = (int)cnt; }
      nx = __builtin_amdgcn_readfirstlane(nx); xr = __builtin_amdgcn_readfirstlane(xr); nloc = __builtin_amdgcn_readfirstlane(nloc); if (nx < 1) nx = 1; if (nloc < 1) nloc = 1; }
    const int lrank = __builtin_amdgcn_readfirstlane((int)MISC[10]);
    const int wv = lrank * NWAVES + wave, nwv = nloc * NWAVES;
    float* DOTX = (float*)(ws + WS_RK);
    signed char* CB8 = (signed char*)(ws + WS_KA); float* CSC = (float*)(ws + WS_CSC);
    bf16* YB = (bf16*)(ws + WS_H0);
    {
        int tl = tid; asm volatile("" : "+v"(tl)); const int ln = tl & 63, k = ln >> 3, c8 = ln & 7;
        const unsigned char* UT8 = (const unsigned char*)UT;
        for (int s = xr; s < NSL; s += nx) {
            const unsigned char* Us = UT8 + (size_t)s * 16384 * 128;
            const bool first = (s == xr);
            v4u nid[2][2];
#pragma unroll
            for (int z = 0; z < 2; ++z) { const int tz = wv + z * nwv; const int tc = tz < NTOK ? tz : wv; const GAS v4u* ip = (const GAS v4u*)(IDS + (size_t)tc * 128 + 16 * k);
#pragma unroll
                for (int i = 0; i < 2; ++i) nid[z][i] = ip[i]; }
#pragma unroll 1
            for (int t = wv; t < NTOK; t += 2 * nwv) {
                const bool vB = (t + nwv) < NTOK; const int tt[2] = {t, vB ? t + nwv : t};
                v4u ub[2][16]; v4u hs[2]; int old[2][2];
#pragma unroll
                for (int z = 0; z < 2; ++z) {
#pragma unroll
                    for (int i = 0; i < 16; ++i) { const int pe = 2 * (i & 7) + (i >> 3); const unsigned eid = (nid[z][pe >> 3][(pe >> 1) & 3] >> (16 * (pe & 1))) & 0xffffu; ub[z][i] = *(const GAS v4u*)(Us + (size_t)eid * 128 + 16 * c8); }
                    hs[z] = *(const GAS v4u*)(H1Q + (size_t)tt[z] * DM + 128 * s + 16 * c8); }
#pragma unroll
                for (int z = 0; z < 2; ++z) { const v2u ov = first ? (v2u){0u, 0u} : *(const GAS v2u*)(DOTX + ((size_t)xr * NTOK + tt[z]) * 128 + 2 * ln); old[z][0] = (int)ov.x; old[z][1] = (int)ov.y; }
#pragma unroll
                for (int z = 0; z < 2; ++z) { const int tz = t + (2 + z) * nwv; const int tc = tz < NTOK ? tz : t; const GAS v4u* ip = (const GAS v4u*)(IDS + (size_t)tc * 128 + 16 * k);
#pragma unroll
                    for (int i = 0; i < 2; ++i) nid[z][i] = ip[i]; }
#pragma unroll
                for (int z = 0; z < 2; ++z) {
                    int p[16];
#pragma unroll
                    for (int i = 0; i < 16; ++i) { int d = 0;
                        d = __builtin_amdgcn_sdot4((int)ub[z][i].x, (int)hs[z].x, d, false); d = __builtin_amdgcn_sdot4((int)ub[z][i].y, (int)hs[z].y, d, false);
                        d = __builtin_amdgcn_sdot4((int)ub[z][i].z, (int)hs[z].z, d, false); d = __builtin_amdgcn_sdot4((int)ub[z][i].w, (int)hs[z].w, d, false); p[i] = d; }
                    const bool b0 = (c8 & 1) != 0, b1 = (c8 & 2) != 0, b2 = (c8 & 4) != 0;
                    int r1[8], r2[4], q0, q1;
#define DPPI(v, ctrl) __builtin_amdgcn_update_dpp(0, (v), (ctrl), 0xf, 0xf, true)
#pragma unroll
                    for (int m = 0; m < 8; ++m) { const int keep = b0 ? p[2 * m + 1] : p[2 * m], give = b0 ? p[2 * m] : p[2 * m + 1]; r1[m] = keep + DPPI(give, 0xB1); }
#pragma unroll
                    for (int m = 0; m < 4; ++m) { const int keep = b1 ? r1[2 * m + 1] : r1[2 * m], give = b1 ? r1[2 * m] : r1[2 * m + 1]; r2[m] = keep + DPPI(give, 0x4E); }
                    { const int keep = b2 ? r2[1] : r2[0], give = b2 ? r2[0] : r2[1]; const int gl = DPPI(give, 0x104), gr = DPPI(give, 0x114); q0 = keep + (b2 ? gr : gl); }
                    { const int keep = b2 ? r2[3] : r2[2], give = b2 ? r2[2] : r2[3]; const int gl = DPPI(give, 0x104), gr = DPPI(give, 0x114); q1 = keep + (b2 ? gr : gl); }
#undef DPPI
                    if (z == 0 || vB) *(GAS v2u*)(DOTX + ((size_t)xr * NTOK + tt[z]) * 128 + 2 * ln) = (v2u){(unsigned)(q0 + old[z][0]), (unsigned)(q1 + old[z][1])};
                }
            }
        }
    }
    GRID_BAR();
    int lc = threadIdx.x; asm volatile("" : "+v"(lc)); lc &= 63;
    for (int i8 = gw * 64 + lc; i8 < NTOK * 16; i8 += NGT) {
        const size_t gi = (size_t)i8 * 8; v4u a0 = {0u, 0u, 0u, 0u}, a1 = a0;
        for (int xx = 0; xx < nx; ++xx) { const GAS v4u* dp = (const GAS v4u*)((const int*)DOTX + (size_t)xx * NTOK * 128 + gi); const v4u p0 = dp[0], p1 = dp[1]; a0 += p0; a1 += p1; }
        const GAS f32x4* gp = (const GAS f32x4*)(GATES + gi); const f32x4 g0 = gp[0], g1 = gp[1];
        const float sc = HSC[i8 >> 4] * (1.0f / U_QSCALE);
        float c[8];
        c[0] = g0.x * gelu_erf((float)(int)a0.x * sc); c[1] = g0.y * gelu_erf((float)(int)a0.y * sc); c[2] = g0.z * gelu_erf((float)(int)a0.z * sc); c[3] = g0.w * gelu_erf((float)(int)a0.w * sc);
        c[4] = g1.x * gelu_erf((float)(int)a1.x * sc); c[5] = g1.y * gelu_erf((float)(int)a1.y * sc); c[6] = g1.z * gelu_erf((float)(int)a1.z * sc); c[7] = g1.w * gelu_erf((float)(int)a1.w * sc);
        float am = 0.f;
#pragma unroll
        for (int j2 = 0; j2 < 8; ++j2) am = fmaxf(am, fabsf(c[j2]));
        am = fmaxf(am, DPPF(am, 0xB1)); am = fmaxf(am, DPPF(am, 0x4E)); am = fmaxf(am, DPPF(am, 0x141)); am = fmaxf(am, DPPF(am, 0x128));
        am = fmaxf(am, 1e-30f); const float iq = 127.0f / am;
        v2u o; o.x = (unsigned)(q8(c[0] * iq) | (q8(c[1] * iq) << 8) | (q8(c[2] * iq) << 16) | (q8(c[3] * iq) << 24)); o.y = (unsigned)(q8(c[4] * iq) | (q8(c[5] * iq) << 8) | (q8(c[6] * iq) << 16) | (q8(c[7] * iq) << 24));
        *(GAS v2u*)(CB8 + gi) = o;
        if ((i8 & 15) == 0) CSC[i8 >> 4] = am * (1.0f / (127.0f * V_QSCALE));
    }
    GRID_BAR();
    {
        int tl = tid; asm volatile("" : "+v"(tl)); const int ln = tl & 63, k = ln >> 3, c8 = ln & 7;
        const unsigned char* VT8 = (const unsigned char*)VT;
        for (int s = xr; s < NSL; s += nx) {
            const unsigned char* Vs = VT8 + (size_t)s * 16384 * 128;
            v4u nid[2][2];
#pragma unroll
            for (int z = 0; z < 2; ++z) { const int tz = wv + z * nwv; const int tc = tz < NTOK ? tz : wv; const GAS v4u* ip = (const GAS v4u*)(IDS + (size_t)tc * 128 + 16 * k);
#pragma unroll
                for (int i = 0; i < 2; ++i) nid[z][i] = ip[i]; }
#pragma unroll 1
            for (int t = wv; t < NTOK; t += 2 * nwv) {
                const bool vB = (t + nwv) < NTOK; const int tt[2] = {t, vB ? t + nwv : t};
                v4u vb[2][16]; v4u cf[2]; unsigned hs[2]; float scl[2], hsc[2];
#pragma unroll
                for (int z = 0; z < 2; ++z) {
#pragma unroll
                    for (int i = 0; i < 16; ++i) { const unsigned eid = (nid[z][i >> 3][(i >> 1) & 3] >> (16 * (i & 1))) & 0xffffu; vb[z][i] = *(const GAS v4u*)(Vs + (size_t)eid * 128 + 16 * c8); } }
#pragma unroll
                for (int z = 0; z < 2; ++z) { hs[z] = *(const GAS unsigned short*)(H1Q + (size_t)tt[z] * DM + 128 * s + 16 * c8 + 2 * k); hsc[z] = ALPHA * HSC[tt[z]];
                    cf[z] = *(const GAS v4u*)(CB8 + (size_t)tt[z] * 128 + 16 * k); scl[z] = CSC[tt[z]]; }
#pragma unroll
                for (int z = 0; z < 2; ++z) { const int tz = t + (2 + z) * nwv; const int tc = tz < NTOK ? tz : t; const GAS v4u* ip = (const GAS v4u*)(IDS + (size_t)tc * 128 + 16 * k);
#pragma unroll
                    for (int i = 0; i < 2; ++i) nid[z][i] = ip[i]; }
#pragma unroll
                for (int z = 0; z < 2; ++z) {
                    int ai[16];
#pragma unroll
                    for (int q2 = 0; q2 < 16; ++q2) ai[q2] = 0;
#pragma unroll
                    for (int ig = 0; ig < 4; ++ig) { const int cq = (int)cf[z][ig];
#pragma unroll
                        for (int dw = 0; dw < 4; ++dw) {
                            const unsigned d0 = vb[z][4 * ig][dw], d1 = vb[z][4 * ig + 1][dw], d2 = vb[z][4 * ig + 2][dw], d3 = vb[z][4 * ig + 3][dw];
                            const unsigned p0 = __builtin_amdgcn_perm(d1, d0, 0x05010400u), p1 = __builtin_amdgcn_perm(d1, d0, 0x07030602u), p2 = __builtin_amdgcn_perm(d3, d2, 0x05010400u), p3 = __builtin_amdgcn_perm(d3, d2, 0x07030602u);
                            ai[4 * dw + 0] = __builtin_amdgcn_sdot4((int)__builtin_amdgcn_perm(p2, p0, 0x05040100u), cq, ai[4 * dw + 0], false);
                            ai[4 * dw + 1] = __builtin_amdgcn_sdot4((int)__builtin_amdgcn_perm(p2, p0, 0x07060302u), cq, ai[4 * dw + 1], false);
                            ai[4 * dw + 2] = __builtin_amdgcn_sdot4((int)__builtin_amdgcn_perm(p3, p1, 0x05040100u), cq, ai[4 * dw + 2], false);
                            ai[4 * dw + 3] = __builtin_amdgcn_sdot4((int)__builtin_amdgcn_perm(p3, p1, 0x07060302u), cq, ai[4 * dw + 3], false); } }
                    const bool kb0 = (k & 1) != 0, kb1 = (k & 2) != 0, kb2 = (k & 4) != 0;
                    int rAx[4], rAy[4], rBx[2], rBy[2], rCx, rCy;
#define DPPI(v, ctrl) __builtin_amdgcn_update_dpp(0, (v), (ctrl), 0xf, 0xf, true)
#pragma unroll
                    for (int m = 0; m < 4; ++m) { const int kx = kb0 ? ai[4 * m + 2] : ai[4 * m], ky = kb0 ? ai[4 * m + 3] : ai[4 * m + 1], gx = kb0 ? ai[4 * m] : ai[4 * m + 2], gy = kb0 ? ai[4 * m + 1] : ai[4 * m + 3];
                        rAx[m] = kx + DPPI(gx, 0x128); rAy[m] = ky + DPPI(gy, 0x128); }
#pragma unroll
                    for (int m = 0; m < 2; ++m) { const int kx = kb1 ? rAx[2 * m + 1] : rAx[2 * m], ky = kb1 ? rAy[2 * m + 1] : rAy[2 * m], gx = kb1 ? rAx[2 * m] : rAx[2 * m + 1], gy = kb1 ? rAy[2 * m] : rAy[2 * m + 1];
                        const auto sx = __builtin_amdgcn_permlane16_swap((unsigned)gx, (unsigned)gx, false, false), sy = __builtin_amdgcn_permlane16_swap((unsigned)gy, (unsigned)gy, false, false);
                        rBx[m] = kx + (int)(kb1 ? sx[0] : sx[1]); rBy[m] = ky + (int)(kb1 ? sy[0] : sy[1]); }
                    { const int kx = kb2 ? rBx[1] : rBx[0], ky = kb2 ? rBy[1] : rBy[0], gx = kb2 ? rBx[0] : rBx[1], gy = kb2 ? rBy[0] : rBy[1];
                        const auto sx = __builtin_amdgcn_permlane32_swap((unsigned)gx, (unsigned)gx, false, false), sy = __builtin_amdgcn_permlane32_swap((unsigned)gy, (unsigned)gy, false, false);
                        rCx = kx + (int)(kb2 ? sx[0] : sx[1]); rCy = ky + (int)(kb2 ? sy[0] : sy[1]); }
#undef DPPI
                    if (z == 0 || vB) *(GAS unsigned*)(YB + (size_t)tt[z] * DM + 128 * s + 16 * c8 + 2 * k) = cvtpk_s((float)rCx * scl[z] + hsc[z] * (float)(int)(signed char)(hs[z] & 0xffu), (float)rCy * scl[z] + hsc[z] * (float)(int)(signed char)(hs[z] >> 8));
                }
            }
        }
    }
    GRID_BAR();
    stage_gb(L + RING_OFF, ln_ffn_g, ln_ffn_b, tid);
    { int lane = threadIdx.x; asm volatile("" : "+v"(lane)); lane &= 63;
    v4u b0[4], b1[4], b2[4];
    auto ld = [&](v4u (&w)[4], int mm) { if (mm < NTOK) ln_load_bf16(w, YB + (size_t)mm * DM, lane); };
    auto pr = [&](v4u (&wa)[4], int m) {
        float v[32]; float sm = 0.f;
#pragma unroll
        for (int j2 = 0; j2 < 4; ++j2) { const v4u w = wa[j2];
            v[8 * j2 + 0] = bflo(w.x); v[8 * j2 + 1] = bfhi(w.x); v[8 * j2 + 2] = bflo(w.y); v[8 * j2 + 3] = bfhi(w.y); v[8 * j2 + 4] = bflo(w.z); v[8 * j2 + 5] = bfhi(w.z); v[8 * j2 + 6] = bflo(w.w); v[8 * j2 + 7] = bfhi(w.w); }
#pragma unroll
        for (int i = 0; i < 32; ++i) sm += v[i];
        const float mean = wave_sum(sm) * (1.f / DM); float s2 = 0.f;
#pragma unroll
        for (int i = 0; i < 32; ++i) { v[i] -= mean; s2 += v[i] * v[i]; }
        const float rstd = 1.f / sqrtf(wave_sum(s2) * (1.f / DM) + LN_EPS);
#pragma unroll
        for (int j2 = 0; j2 < 4; ++j2) {
            const LAS f32x4* gp = (const LAS f32x4*)(L + RING_OFF) + 2 * (lane + 64 * j2); const LAS f32x4* bp = (const LAS f32x4*)(L + RING_OFF + 8192) + 2 * (lane + 64 * j2);
            const f32x4 g0 = gp[0], g1 = gp[1], b0 = bp[0], b1 = bp[1];
            GAS f32x4* op = (GAS f32x4*)(out + (size_t)m * DM) + 2 * (lane + 64 * j2);
            op[0] = (f32x4){v[8 * j2 + 0] * rstd * g0.x + b0.x, v[8 * j2 + 1] * rstd * g0.y + b0.y, v[8 * j2 + 2] * rstd * g0.z + b0.z, v[8 * j2 + 3] * rstd * g0.w + b0.w};
            op[1] = (f32x4){v[8 * j2 + 4] * rstd * g1.x + b1.x, v[8 * j2 + 5] * rstd * g1.y + b1.y, v[8 * j2 + 6] * rstd * g1.z + b1.z, v[8 * j2 + 7] * rstd * g1.w + b1.w}; }
    };
    int m = gw; ld(b0, m); ld(b1, m + NGW);
    for (;;) {
        if (m >= NTOK) break; ld(b2, m + 2 * NGW); pr(b0, m); m += NGW;
        if (m >= NTOK) break; ld(b0, m + 2 * NGW); pr(b1, m); m += NGW;
        if (m >= NTOK) break; ld(b1, m + 2 * NGW); pr(b2, m); m += NGW;
    }
    }
}

extern "C" void kernel_launch(void* const* d_in, const int* in_sizes, int n_in, void* d_out, int out_size, void* d_ws, size_t ws_size, hipStream_t stream) {
    static int grid = 0;
    if (grid == 0) {
        if (n_in != 15 || out_size != NTOK * DM || ws_size < WS_END) { fprintf(stderr, "kernel_launch: unexpected shapes (n_in %d out %d ws %zu)\n", n_in, out_size, ws_size); grid = -1; return; }
        int dev = 0, cus = 0, per_cu = 0;
        if (hipGetDevice(&dev) != hipSuccess || hipDeviceGetAttribute(&cus, hipDeviceAttributeMultiprocessorCount, dev) != hipSuccess) { grid = -1; return; }
        if (hipFuncSetAttribute((const void*)mk_fwd, hipFuncAttributeMaxDynamicSharedMemorySize, LDS_BYTES) != hipSuccess) { fprintf(stderr, "kernel_launch: hipFuncSetAttribute failed\n"); grid = -1; return; }
        if (hipOccupancyMaxActiveBlocksPerMultiprocessor(&per_cu, (const void*)mk_fwd, NWAVES * 64, LDS_BYTES) != hipSuccess || per_cu < 1) { fprintf(stderr, "kernel_launch: occupancy query says %d\n", per_cu); }
        (void)hipGetLastError();
        grid = cus;
    }
    if (grid < 0) return;
    if (hipMemsetAsync((char*)d_ws + WS_CTL, 0, CTL_ZERO_BYTES, stream) != hipSuccess) return;
    Args a{};
    for (int i = 0; i < 15; ++i) a.in[i] = (const float*)d_in[i];
    a.out = (float*)d_out; a.ws = (unsigned char*)d_ws;
    hipLaunchKernelGGL(mk_fwd, dim3(grid), dim3(NWAVES * 64), LDS_BYTES, stream, a);
}
```
